# Optimizing an MI355X kernel written in HIP

```python
import math
import jax, jax.numpy as jnp
from jax import lax
import numpy as np

D_MODEL = 1024
BATCH = 4
SEQ = 8192
DEPTH = 1

MLA_HEADS = 8
MLA_Q_RANK = 384
MLA_KV_RANK = 256
MLA_NOPE_DIM = 64
MLA_ROPE_DIM = 32
MLA_V_DIM = 64
MLA_QK_DIM = MLA_NOPE_DIM + MLA_ROPE_DIM
FOX_HEADS = 8
FOX_HEAD_DIM = 64
FOX_WIDTH = FOX_HEADS * FOX_HEAD_DIM
MIX_WIDTH = MLA_HEADS * MLA_V_DIM + FOX_WIDTH
ROPE_THETA = 10000.0
BLOCK_Q = 128
IN_SPLITS = (MLA_Q_RANK, MLA_KV_RANK, MLA_ROPE_DIM, FOX_WIDTH, FOX_WIDTH, FOX_WIDTH, FOX_HEADS)
IN_WIDTH = sum(IN_SPLITS)
PEER_HEADS = 8
N_KEYS = 128
N_EXPERTS = N_KEYS * N_KEYS
PEER_QDIM = 256
PEER_HALF = PEER_QDIM // 2
PEER_TOPK = 16
PEER_CHUNK = 64
EPS = 1e-6

kernel_name = "hybrid_mla_fox_peer_adaln_layer"


def _rms_norm(x, g):
    xf = x.astype(jnp.float32)
    y = xf * lax.rsqrt(jnp.mean(xf * xf, axis=-1, keepdims=True) + EPS)
    return (y * g.astype(jnp.float32)).astype(x.dtype)


def _modulate(x, g, shift, scale):
    return _rms_norm(x, g) * (1.0 + scale) + shift


def _rope(x, ang):
    half = x.shape[-1] // 2
    x1, x2 = x[..., :half], x[..., half:]
    cos = jnp.cos(ang).astype(x.dtype)
    sin = jnp.sin(ang).astype(x.dtype)
    return jnp.concatenate([x1 * cos - x2 * sin, x2 * cos + x1 * sin], axis=-1)


def _causal_block_attention(q, k, v, scale, fcum=None):
    b, h, s, dk = q.shape
    dv = v.shape[-1]
    nblk = s // BLOCK_Q
    qb = q.reshape(b, h, nblk, BLOCK_Q, dk).transpose(2, 0, 1, 3, 4)
    kf = k.astype(jnp.float32)
    vf = v.astype(jnp.float32)
    key_pos = jnp.arange(s)
    blk_ids = jnp.arange(nblk)

    def scores(q_i):
        return jnp.einsum("bhqd,bhkd->bhqk", q_i.astype(jnp.float32), kf) * scale

    def finish(i, sc):
        q_pos = i * BLOCK_Q + jnp.arange(BLOCK_Q)
        sc = jnp.where(key_pos[None, :] <= q_pos[:, None], sc, -jnp.inf)
        p = jax.nn.softmax(sc, axis=-1)
        return jnp.einsum("bhqk,bhkd->bhqd", p, vf)

    if fcum is None:
        out = lax.map(lambda a: finish(a[0], scores(a[1])), (blk_ids, qb))
    else:
        fb = fcum.reshape(b, h, nblk, BLOCK_Q).transpose(2, 0, 1, 3)

        def blk(a):
            i, q_i, f_i = a
            sc = scores(q_i) + f_i[..., None] - fcum[:, :, None, :]
            return finish(i, sc)

        out = lax.map(blk, (blk_ids, qb, fb))
    return out.transpose(1, 2, 0, 3, 4).reshape(b, h, s, dv).astype(v.dtype)


def _peer(h, w_pq, sub_keys, peer_u, peer_v):
    b, s, d = h.shape
    qp = (h @ w_pq).astype(jnp.float32).reshape(b, s, PEER_HEADS, 2, PEER_HALF)
    sc = jnp.einsum("bshpd,hpnd->bshpn", qp, sub_keys.astype(jnp.float32))
    s1, i1 = lax.top_k(sc[..., 0, :], PEER_TOPK)
    s2, i2 = lax.top_k(sc[..., 1, :], PEER_TOPK)
    cand = (s1[..., :, None] + s2[..., None, :]).reshape(b, s, PEER_HEADS, PEER_TOPK * PEER_TOPK)
    top_s, top_c = lax.top_k(cand, PEER_TOPK)
    e1 = jnp.take_along_axis(i1, top_c // PEER_TOPK, axis=-1)
    e2 = jnp.take_along_axis(i2, top_c % PEER_TOPK, axis=-1)
    expert = e1 * N_KEYS + e2
    gate = jax.nn.softmax(top_s, axis=-1)
    nc = s // PEER_CHUNK

    def to_chunks(a):
        return a.reshape((b, nc, PEER_CHUNK) + a.shape[2:]).swapaxes(0, 1)

    def chunk(args):
        h_c, e_c, g_c = args
        u = jnp.take(peer_u, e_c, axis=0)
        a = jnp.einsum("bcd,bchkd->bchk", h_c.astype(jnp.float32), u.astype(jnp.float32))
        w = g_c * jax.nn.gelu(a)
        vv = jnp.take(peer_v, e_c, axis=0)
        return jnp.einsum("bchk,bchkd->bcd", w, vv.astype(jnp.float32))

    y = lax.map(chunk, (to_chunks(h), to_chunks(expert), to_chunks(gate)))
    return y.swapaxes(0, 1).reshape(b, s, d).astype(h.dtype)


def setup_inputs(seed: int = 0) -> dict:
    key = jax.random.key(seed)
    ks = jax.random.split(key, 24)
    f32 = jnp.float32
    D = D_MODEL

    def nrm(k, shape, scale):
        return jax.random.normal(k, shape, f32) * scale

    def gain(k, n):
        return 1.0 + 0.02 * jax.random.normal(k, (n,), f32)

    x = jax.random.normal(ks[0], (BATCH, SEQ, D), f32)
    c = jax.random.normal(ks[1], (BATCH, D), f32)
    offset = jax.random.randint(ks[2], (BATCH, 1), 0, 1024, dtype=jnp.int32)
    positions = (offset + jnp.arange(SEQ, dtype=jnp.int32)[None, :]).astype(jnp.int32)
    return {
        "x": x,
        "c": c,
        "positions": positions,
        "w_ada": nrm(ks[3], (D, 6 * D), 0.5 * D ** -0.5),
        "b_ada": nrm(ks[4], (6 * D,), 0.01),
        "norm1_g": gain(ks[5], D),
        "w_in": nrm(ks[6], (D, IN_WIDTH), D ** -0.5),
        "mla_qa_g": gain(ks[7], MLA_Q_RANK),
        "mla_kva_g": gain(ks[8], MLA_KV_RANK),
        "w_uq": nrm(ks[9], (MLA_Q_RANK, MLA_HEADS * MLA_QK_DIM), MLA_Q_RANK ** -0.5),
        "w_ukv": nrm(ks[10], (MLA_KV_RANK, MLA_HEADS * (MLA_NOPE_DIM + MLA_V_DIM)), MLA_KV_RANK ** -0.5),
        "mla_q_g": gain(ks[11], MLA_QK_DIM),
        "mla_k_g": gain(ks[12], MLA_QK_DIM),
        "fox_q_g": gain(ks[13], FOX_HEAD_DIM),
        "fox_k_g": gain(ks[14], FOX_HEAD_DIM),
        "b_f": 2.0 + 0.5 * jax.random.normal(ks[15], (FOX_HEADS,), f32),
        "w_o": nrm(ks[16], (MIX_WIDTH, D), MIX_WIDTH ** -0.5),
        "norm2_g": gain(ks[17], D),
        "w_pq": nrm(ks[18], (D, PEER_HEADS * PEER_QDIM), D ** -0.5),
        "sub_keys": nrm(ks[19], (PEER_HEADS, 2, N_KEYS, PEER_HALF), PEER_HALF ** -0.5),
        "peer_u": nrm(ks[20], (N_EXPERTS, D), D ** -0.5),
        "peer_v": nrm(ks[21], (N_EXPERTS, D), PEER_HEADS ** -0.5),
    }


def reference(x, c, positions, w_ada, b_ada, norm1_g, w_in, mla_qa_g, mla_kva_g, w_uq, w_ukv,
              mla_q_g, mla_k_g, fox_q_g, fox_k_g, b_f, w_o, norm2_g, w_pq, sub_keys, peer_u, peer_v):
    dt = x.dtype
    b, s, d = x.shape
    mod = jax.nn.silu(c.astype(jnp.float32)) @ w_ada.astype(jnp.float32) + b_ada.astype(jnp.float32)
    mod = mod.reshape(b, 6, 1, d).astype(dt)
    shift1, scale1, gate1 = mod[:, 0], mod[:, 1], mod[:, 2]
    shift2, scale2, gate2 = mod[:, 3], mod[:, 4], mod[:, 5]
    inv_freq = ROPE_THETA ** (-jnp.arange(0, MLA_ROPE_DIM, 2, dtype=jnp.float32) / MLA_ROPE_DIM)
    ang = (positions.astype(jnp.float32)[..., None] * inv_freq)[:, :, None, :]

    for _ in range(DEPTH):
        h = _modulate(x, norm1_g, shift1, scale1)
        proj = h @ w_in
        cq, ckv, kpe, fq, fk, fv, fl = jnp.split(proj, list(np.cumsum(IN_SPLITS)[:-1]), axis=-1)

        q_a = (_rms_norm(cq, mla_qa_g) @ w_uq).reshape(b, s, MLA_HEADS, MLA_QK_DIM)
        kv_a = (_rms_norm(ckv, mla_kva_g) @ w_ukv).reshape(b, s, MLA_HEADS, MLA_NOPE_DIM + MLA_V_DIM)
        k_nope, v_a = kv_a[..., :MLA_NOPE_DIM], kv_a[..., MLA_NOPE_DIM:]
        k_pe = jnp.broadcast_to(kpe[:, :, None, :], (b, s, MLA_HEADS, MLA_ROPE_DIM))
        k_a = jnp.concatenate([k_nope, k_pe], axis=-1)
        q_a = _rms_norm(q_a, mla_q_g)
        k_a = _rms_norm(k_a, mla_k_g)
        q_a = jnp.concatenate([q_a[..., :MLA_NOPE_DIM], _rope(q_a[..., MLA_NOPE_DIM:], ang)], axis=-1)
        k_a = jnp.concatenate([k_a[..., :MLA_NOPE_DIM], _rope(k_a[..., MLA_NOPE_DIM:], ang)], axis=-1)
        o_a = _causal_block_attention(q_a.transpose(0, 2, 1, 3), k_a.transpose(0, 2, 1, 3),
                                      v_a.transpose(0, 2, 1, 3), MLA_QK_DIM ** -0.5)

        q_b = _rms_norm(fq.reshape(b, s, FOX_HEADS, FOX_HEAD_DIM), fox_q_g)
        k_b = _rms_norm(fk.reshape(b, s, FOX_HEADS, FOX_HEAD_DIM), fox_k_g)
        v_b = fv.reshape(b, s, FOX_HEADS, FOX_HEAD_DIM)
        log_f = jax.nn.log_sigmoid(fl.astype(jnp.float32) + b_f.astype(jnp.float32))
        fcum = jnp.cumsum(log_f, axis=1).transpose(0, 2, 1)
        o_b = _causal_block_attention(q_b.transpose(0, 2, 1, 3), k_b.transpose(0, 2, 1, 3),
                                      v_b.transpose(0, 2, 1, 3), FOX_HEAD_DIM ** -0.5, fcum)

        o = jnp.concatenate([o_a, o_b], axis=1).transpose(0, 2, 1, 3).reshape(b, s, MIX_WIDTH)
        x = x + gate1 * (o @ w_o)

        h2 = _modulate(x, norm2_g, shift2, scale2)
        x = x + gate2 * _peer(h2, w_pq, sub_keys, peer_u, peer_v)
    return x
```

```cpp
#include <hip/hip_runtime.h>
#include <cstdint>
#include <cstdio>
#include <cmath>

typedef unsigned short bf16_t;
constexpr int B_ = 4, S_ = 8192, D_ = 1024, T_ = B_ * S_;
constexpr int PP = 2304;
constexpr int C_CQ = 0, C_CKV = 384, C_KPE = 640, C_FQ = 672, C_FK = 1184, C_FV = 1696, C_FL = 2208, INW = 2216;
constexpr float EPS = 1e-6f;
constexpr float LOG2E = 1.4426950408889634f;
constexpr float C2A = 0.10206207261596577f * LOG2E;
constexpr float C2F = 0.125f * LOG2E;

__device__ __forceinline__ float bf2f(bf16_t v) { return __uint_as_float(((unsigned)v) << 16); }
__device__ __forceinline__ bf16_t f2bf(float f) { unsigned u = __float_as_uint(f); return (bf16_t)((u + 0x7fffu + ((u >> 16) & 1u)) >> 16); }
__device__ __forceinline__ unsigned pk2(float lo, float hi) { return (unsigned)f2bf(lo) | ((unsigned)f2bf(hi) << 16); }
__device__ __forceinline__ float lo2f(unsigned w) { return __uint_as_float(w << 16); }
__device__ __forceinline__ float hi2f(unsigned w) { return __uint_as_float(w & 0xffff0000u); }
__device__ __forceinline__ float wave_sum(float v) {
#pragma unroll
    for (int o = 1; o < 64; o <<= 1) v += __shfl_xor(v, o);
    return v;
}

constexpr size_t MiB = 1u << 20;
constexpr size_t WS_MOD = 1 * MiB;
constexpr size_t WS_FL = 3 * MiB;
constexpr size_t WS_FCUM = 4 * MiB;
constexpr size_t WS_LOGF = 5 * MiB;
constexpr size_t WS_ROPE = 6 * MiB;
constexpr size_t WS_XN = 84 * MiB;
constexpr size_t WS_PROJ = 148 * MiB;
constexpr size_t WS_KVRAW = 292 * MiB;
constexpr size_t WS_QA = 356 * MiB;
constexpr size_t WS_KA = 404 * MiB;

__global__ void k_mod(const float* c, const float* w_ada, const float* b_ada, float* mod) {
    const int j = blockIdx.x * 256 + threadIdx.x, b = blockIdx.y;
    float acc = b_ada[j];
    for (int k = 0; k < 1024; ++k) { const float cv = c[b * 1024 + k]; const float s = cv / (1.f + expf(-cv)); acc += s * w_ada[(size_t)k * 6144 + j]; }
    mod[b * 6144 + j] = acc;
}

__global__ void __launch_bounds__(256) k_modrows(const float* X, const float* g, const float* mod, int shift_idx, int scale_idx, bf16_t* out) {
    const int wave = threadIdx.x >> 6, lane = threadIdx.x & 63;
    const int row = blockIdx.x * 4 + wave, b = row / S_;
    const float4* xr = (const float4*)(X + (size_t)row * 1024) + lane;
    float4 v[4]; float ss = 0.f;
#pragma unroll
    for (int j = 0; j < 4; ++j) { v[j] = xr[64 * j]; ss += (v[j].x * v[j].x + v[j].y * v[j].y) + (v[j].z * v[j].z + v[j].w * v[j].w); }
    ss = wave_sum(ss);
    const float r = rsqrtf(ss * (1.f / 1024.f) + EPS);
    const float* sh = mod + b * 6144 + shift_idx * 1024; const float* sc = mod + b * 6144 + scale_idx * 1024;
#pragma unroll
    for (int j = 0; j < 4; ++j) {
        const int col = 4 * lane + 256 * j;
        const float4 g4 = *(const float4*)(g + col), s4 = *(const float4*)(sc + col), h4 = *(const float4*)(sh + col);
        const float o0 = v[j].x * r * g4.x * (1.f + s4.x) + h4.x, o1 = v[j].y * r * g4.y * (1.f + s4.y) + h4.y;
        const float o2 = v[j].z * r * g4.z * (1.f + s4.z) + h4.z, o3 = v[j].w * r * g4.w * (1.f + s4.w) + h4.w;
        uint2 w; w.x = pk2(o0, o1); w.y = pk2(o2, o3);
        *(uint2*)(out + (size_t)row * 1024 + col) = w;
    }
}

template <int MODE>
__global__ void __launch_bounds__(256) k_gemm_naive(const bf16_t* A, int lda, const float* W, int K, int N, void* Cout, int ldc, const float* aux1, const float* aux2, float* fl) {
    __shared__ float As[16][64];
    __shared__ float Ws[16][64];
    const int tx = threadIdx.x & 15, ty = threadIdx.x >> 4;
    const int m0 = blockIdx.y * 64, n0 = blockIdx.x * 64;
    float acc[4][4];
#pragma unroll
    for (int i = 0; i < 4; ++i)
#pragma unroll
        for (int j = 0; j < 4; ++j) acc[i][j] = 0.f;
    for (int k0 = 0; k0 < K; k0 += 16) {
        { const int r = threadIdx.x >> 2, kq = (threadIdx.x & 3) * 4; const uint2 a2 = *(const uint2*)(A + (size_t)(m0 + r) * lda + k0 + kq);
          As[kq + 0][r] = lo2f(a2.x); As[kq + 1][r] = hi2f(a2.x); As[kq + 2][r] = lo2f(a2.y); As[kq + 3][r] = hi2f(a2.y); }
        { const int kk = threadIdx.x >> 4, nq = (threadIdx.x & 15) * 4; float4 w4 = make_float4(0.f, 0.f, 0.f, 0.f);
          if (n0 + nq < N) w4 = *(const float4*)(W + (size_t)(k0 + kk) * N + n0 + nq);
          *(float4*)&Ws[kk][nq] = w4; }
        __syncthreads();
#pragma unroll
        for (int kk = 0; kk < 16; ++kk) {
            const float4 a4 = *(const float4*)&As[kk][ty * 4]; const float4 w4 = *(const float4*)&Ws[kk][tx * 4];
            const float a[4] = {a4.x, a4.y, a4.z, a4.w}; const float w[4] = {w4.x, w4.y, w4.z, w4.w};
#pragma unroll
            for (int i = 0; i < 4; ++i)
#pragma unroll
                for (int j = 0; j < 4; ++j) acc[i][j] += a[i] * w[j];
        }
        __syncthreads();
    }
#pragma unroll
    for (int i = 0; i < 4; ++i) {
        const int m = m0 + ty * 4 + i;
#pragma unroll
        for (int j = 0; j < 4; ++j) {
            const int n = n0 + tx * 4 + j;
            if (n < N) {
                if (MODE == 0) ((bf16_t*)Cout)[(size_t)m * ldc + n] = f2bf(acc[i][j]);
                else if (MODE == 1) { if (n < C_FL) ((bf16_t*)Cout)[(size_t)m * ldc + n] = f2bf(acc[i][j]); else fl[(size_t)m * 8 + (n - C_FL)] = acc[i][j]; }
                else { const int b = m / S_; ((float*)Cout)[(size_t)m * ldc + n] = aux1[(size_t)m * 1024 + n] + aux2[b * 6144 + 2 * 1024 + n] * acc[i][j]; }
            }
        }
    }
}

__device__ __forceinline__ void unpack8(const uint4 raw, float* v) {
    v[0] = lo2f(raw.x); v[1] = hi2f(raw.x); v[2] = lo2f(raw.y); v[3] = hi2f(raw.y); v[4] = lo2f(raw.z); v[5] = hi2f(raw.z); v[6] = lo2f(raw.w); v[7] = hi2f(raw.w);
}
__global__ void __launch_bounds__(256) k_rowprep(bf16_t* PROJ, const float* FL, const float* g_qa, const float* g_kva, const float* g_fq, const float* g_fk, const float* b_f,
                                                 const int* positions, float* LOGF, float2* ROPE) {
    const int wave = threadIdx.x >> 6, lane = threadIdx.x & 63;
    const int row = blockIdx.x * 4 + wave;
    bf16_t* pr = PROJ + (size_t)row * PP;
    float v[8];
    {
        float ss = 0.f;
        if (lane < 48) { unpack8(*(const uint4*)(pr + C_CQ + lane * 8), v);
#pragma unroll
            for (int i = 0; i < 8; ++i) ss += v[i] * v[i]; }
        ss = wave_sum(ss);
        const float r = rsqrtf(ss * (1.f / 384.f) + EPS);
        if (lane < 48) { const float* g = g_qa + lane * 8; uint4 o;
            o.x = pk2(v[0] * r * g[0], v[1] * r * g[1]); o.y = pk2(v[2] * r * g[2], v[3] * r * g[3]); o.z = pk2(v[4] * r * g[4], v[5] * r * g[5]); o.w = pk2(v[6] * r * g[6], v[7] * r * g[7]);
            *(uint4*)(pr + C_CQ + lane * 8) = o; }
    }
    {
        float ss = 0.f;
        if (lane < 32) { unpack8(*(const uint4*)(pr + C_CKV + lane * 8), v);
#pragma unroll
            for (int i = 0; i < 8; ++i) ss += v[i] * v[i]; }
        ss = wave_sum(ss);
        const float r = rsqrtf(ss * (1.f / 256.f) + EPS);
        if (lane < 32) { const float* g = g_kva + lane * 8; uint4 o;
            o.x = pk2(v[0] * r * g[0], v[1] * r * g[1]); o.y = pk2(v[2] * r * g[2], v[3] * r * g[3]); o.z = pk2(v[4] * r * g[4], v[5] * r * g[5]); o.w = pk2(v[6] * r * g[6], v[7] * r * g[7]);
            *(uint4*)(pr + C_CKV + lane * 8) = o; }
    }
#pragma unroll
    for (int which = 0; which < 2; ++which) {
        const int coff = which == 0 ? C_FQ : C_FK; const float* g = (which == 0 ? g_fq : g_fk) + (lane & 7) * 8; const float sc = which == 0 ? C2F : 1.f;
        unpack8(*(const uint4*)(pr + coff + lane * 8), v);
        float ss = 0.f;
#pragma unroll
        for (int i = 0; i < 8; ++i) ss += v[i] * v[i];
        ss += __shfl_xor(ss, 1); ss += __shfl_xor(ss, 2); ss += __shfl_xor(ss, 4);
        const float r = rsqrtf(ss * (1.f / 64.f) + EPS) * sc; uint4 o;
        o.x = pk2(v[0] * r * g[0], v[1] * r * g[1]); o.y = pk2(v[2] * r * g[2], v[3] * r * g[3]); o.z = pk2(v[4] * r * g[4], v[5] * r * g[5]); o.w = pk2(v[6] * r * g[6], v[7] * r * g[7]);
        *(uint4*)(pr + coff + lane * 8) = o;
    }
    if (lane < 8) { const float z = FL[(size_t)row * 8 + lane] + b_f[lane]; LOGF[(size_t)row * 8 + lane] = fminf(z, 0.f) - log1pf(expf(-fabsf(z))); }
    if (lane < 16) { const float inv = powf(10000.f, -(float)lane / 16.f); const float ang = (float)positions[row] * inv; float sn, cs; sincosf(ang, &sn, &cs); ROPE[(size_t)row * 16 + lane] = make_float2(cs, sn); }
}

__global__ void __launch_bounds__(64) k_fcum(const float* LOGF, float* FCUM) {
    const int b = blockIdx.x >> 3, h = blockIdx.x & 7, lane = threadIdx.x;
    const float* src = LOGF + ((size_t)b * S_) * 8 + h;
    float tot = 0.f;
    for (int i = 0; i < 128; ++i) tot += src[(size_t)(128 * lane + i) * 8];
    float incl = tot;
#pragma unroll
    for (int o = 1; o < 64; o <<= 1) { const float t = __shfl_up(incl, o); if (lane >= o) incl += t; }
    float run = incl - tot;
    float* dst = FCUM + ((size_t)(b * 8 + h)) * S_ + 128 * lane;
    for (int i = 0; i < 128; ++i) { run += src[(size_t)(128 * lane + i) * 8]; dst[i] = run; }
}

__global__ void __launch_bounds__(256) k_mlaprep(bf16_t* QRAW, const bf16_t* KVRAW, const bf16_t* PROJ, bf16_t* KA, const float2* ROPE, const float* g_q, const float* g_k) {
    const int wave = threadIdx.x >> 6, lane = threadIdx.x & 63;
    const int row = blockIdx.x * 4 + wave, h = lane >> 3, p = lane & 7;
    const float2 cs0 = ROPE[(size_t)row * 16 + 2 * p], cs1 = ROPE[(size_t)row * 16 + 2 * p + 1];
#pragma unroll
    for (int which = 0; which < 2; ++which) {
        const float* g = which == 0 ? g_q : g_k; const float sc = which == 0 ? C2A : 1.f;
        float v[8]; unsigned r1, r2;
        if (which == 0) { const bf16_t* q = QRAW + (size_t)row * 768 + h * 96; unpack8(*(const uint4*)(q + 8 * p), v); r1 = *(const unsigned*)(q + 64 + 2 * p); r2 = *(const unsigned*)(q + 80 + 2 * p); }
        else { unpack8(*(const uint4*)(KVRAW + (size_t)row * 1024 + h * 128 + 8 * p), v); const bf16_t* kp = PROJ + (size_t)row * PP + C_KPE; r1 = *(const unsigned*)(kp + 2 * p); r2 = *(const unsigned*)(kp + 16 + 2 * p); }
        float a0 = lo2f(r1), a1 = hi2f(r1), b0 = lo2f(r2), b1 = hi2f(r2);
        float ss = a0 * a0 + a1 * a1 + b0 * b0 + b1 * b1;
#pragma unroll
        for (int i = 0; i < 8; ++i) ss += v[i] * v[i];
        ss += __shfl_xor(ss, 1); ss += __shfl_xor(ss, 2); ss += __shfl_xor(ss, 4);
        const float r = rsqrtf(ss * (1.f / 96.f) + EPS);
        const float* gn = g + 8 * p;
        a0 *= r * g[64 + 2 * p]; a1 *= r * g[64 + 2 * p + 1]; b0 *= r * g[80 + 2 * p]; b1 *= r * g[80 + 2 * p + 1];
        const float ra0 = a0 * cs0.x - b0 * cs0.y, rb0 = b0 * cs0.x + a0 * cs0.y, ra1 = a1 * cs1.x - b1 * cs1.y, rb1 = b1 * cs1.x + a1 * cs1.y;
        uint4 o; o.x = pk2(v[0] * r * gn[0] * sc, v[1] * r * gn[1] * sc); o.y = pk2(v[2] * r * gn[2] * sc, v[3] * r * gn[3] * sc);
        o.z = pk2(v[4] * r * gn[4] * sc, v[5] * r * gn[5] * sc); o.w = pk2(v[6] * r * gn[6] * sc, v[7] * r * gn[7] * sc);
        bf16_t* dst = (which == 0 ? QRAW : KA) + (size_t)row * 768 + h * 96;
        *(uint4*)(dst + 8 * p) = o; *(unsigned*)(dst + 64 + 2 * p) = pk2(ra0 * sc, ra1 * sc); *(unsigned*)(dst + 80 + 2 * p) = pk2(rb0 * sc, rb1 * sc);
    }
}

template <int DK>
__global__ void __launch_bounds__(256) k_attn_naive(const bf16_t* Q, int pq, int qstep, const bf16_t* K, int pk, int kstep, const bf16_t* V, int pv, int vstep, bf16_t* O, int po, int ostep, const float* FCUM) {
    __shared__ float Ks[64][DK];
    __shared__ float Vs[64][64];
    __shared__ float Bs[64];
    const int bh = blockIdx.x >> 5, qb = blockIdx.x & 31, b = bh >> 3, h = bh & 7;
    const int t = qb * 256 + threadIdx.x;
    const size_t row = (size_t)b * S_ + t;
    float q[DK];
#pragma unroll
    for (int c = 0; c < DK / 8; ++c) unpack8(*(const uint4*)(Q + row * pq + h * qstep + c * 8), q + c * 8);
    float o[64];
#pragma unroll
    for (int d = 0; d < 64; ++d) o[d] = 0.f;
    float m = -INFINITY, l = 0.f;
    const float fq = FCUM ? FCUM[(size_t)(b * 8 + h) * S_ + t] : 0.f;
    const int ntiles = (qb * 256 + 256) / 64;
    for (int kt = 0; kt < ntiles; ++kt) {
        __syncthreads();
        for (int c = threadIdx.x; c < 64 * (DK / 8); c += 256) { const int key = c / (DK / 8), ch = c % (DK / 8); float v[8];
            unpack8(*(const uint4*)(K + ((size_t)b * S_ + kt * 64 + key) * pk + h * kstep + ch * 8), v);
#pragma unroll
            for (int i = 0; i < 8; ++i) Ks[key][ch * 8 + i] = v[i]; }
        for (int c = threadIdx.x; c < 64 * 8; c += 256) { const int key = c >> 3, ch = c & 7; float v[8];
            unpack8(*(const uint4*)(V + ((size_t)b * S_ + kt * 64 + key) * pv + h * vstep + ch * 8), v);
#pragma unroll
            for (int i = 0; i < 8; ++i) Vs[key][ch * 8 + i] = v[i]; }
        if (threadIdx.x < 64) Bs[threadIdx.x] = FCUM ? FCUM[(size_t)(b * 8 + h) * S_ + kt * 64 + threadIdx.x] : 0.f;
        __syncthreads();
        const int kmax = t - kt * 64 + 1;
        for (int kk = 0; kk < 64; ++kk) {
            float s = 0.f;
#pragma unroll
            for (int d = 0; d < DK; ++d) s += q[d] * Ks[kk][d];
            if (FCUM) s += (fq - Bs[kk]) * LOG2E;
            if (kk < kmax) {
                const float mn = fmaxf(m, s), corr = exp2f(m - mn), p = exp2f(s - mn);
                l = l * corr + p;
#pragma unroll
                for (int d = 0; d < 64; ++d) o[d] = o[d] * corr + p * Vs[kk][d];
                m = mn;
            }
        }
    }
    const float rl = 1.f / l;
    bf16_t* op = O + row * po + h * ostep;
#pragma unroll
    for (int c = 0; c < 8; ++c) { uint4 w; w.x = pk2(o[c * 8 + 0] * rl, o[c * 8 + 1] * rl); w.y = pk2(o[c * 8 + 2] * rl, o[c * 8 + 3] * rl); w.z = pk2(o[c * 8 + 4] * rl, o[c * 8 + 5] * rl); w.w = pk2(o[c * 8 + 6] * rl, o[c * 8 + 7] * rl);
        *(uint4*)(op + c * 8) = w; }
}

__global__ void __launch_bounds__(256) k_topk_naive(const bf16_t* QP, const float* sub_keys, int* EID, float* GATE) {
    const int w = blockIdx.x * 4 + (threadIdx.x >> 6), lane = threadIdx.x & 63;
    const int t = w >> 3, h = w & 7;
    float sl0 = 0.f, sl1 = 0.f; int il0 = 0, il1 = 0;
#pragma unroll
    for (int p = 0; p < 2; ++p) {
        const bf16_t* q = QP + (size_t)t * 2048 + h * 256 + p * 128;
        const float* k0 = sub_keys + ((size_t)(h * 2 + p) * 128 + lane) * 128; const float* k1 = k0 + 64 * 128;
        float s0 = 0.f, s1 = 0.f;
        for (int d = 0; d < 128; ++d) { const float qd = bf2f(q[d]); s0 += qd * k0[d]; s1 += qd * k1[d]; }
        float ls = 0.f; int li = 0;
        for (int r = 0; r < 16; ++r) {
            float bv; int bi; if (s0 >= s1) { bv = s0; bi = lane; } else { bv = s1; bi = lane + 64; }
#pragma unroll
            for (int o = 32; o >= 1; o >>= 1) { const float ov = __shfl_xor(bv, o); const int oi = __shfl_xor(bi, o); if (ov > bv || (ov == bv && oi < bi)) { bv = ov; bi = oi; } }
            if (lane == r) { ls = bv; li = bi; }
            if (bi == lane) s0 = -INFINITY; else if (bi == lane + 64) s1 = -INFINITY;
        }
        if (p == 0) { sl0 = ls; il0 = li; } else { sl1 = ls; il1 = li; }
    }
    float cv0, cv1, cv2, cv3;
    { const int c0 = lane, c1 = lane + 64, c2 = lane + 128, c3 = lane + 192;
      cv0 = __shfl(sl0, c0 >> 4) + __shfl(sl1, c0 & 15); cv1 = __shfl(sl0, c1 >> 4) + __shfl(sl1, c1 & 15);
      cv2 = __shfl(sl0, c2 >> 4) + __shfl(sl1, c2 & 15); cv3 = __shfl(sl0, c3 >> 4) + __shfl(sl1, c3 & 15); }
    float tv = -INFINITY; int tc = 0;
    for (int r = 0; r < 16; ++r) {
        float bv = cv0; int bc = lane;
        if (cv1 > bv) { bv = cv1; bc = lane + 64; }
        if (cv2 > bv) { bv = cv2; bc = lane + 128; }
        if (cv3 > bv) { bv = cv3; bc = lane + 192; }
#pragma unroll
        for (int o = 32; o >= 1; o >>= 1) { const float ov = __shfl_xor(bv, o); const int oc = __shfl_xor(bc, o); if (ov > bv || (ov == bv && oc < bc)) { bv = ov; bc = oc; } }
        if (lane == r) { tv = bv; tc = bc; }
        if (bc == lane) cv0 = -INFINITY; else if (bc == lane + 64) cv1 = -INFINITY; else if (bc == lane + 128) cv2 = -INFINITY; else if (bc == lane + 192) cv3 = -INFINITY;
    }
    const float mx = __shfl(tv, 0);
    const float e = lane < 16 ? expf(tv - mx) : 0.f;
    const float sum = wave_sum(e);
    const int e1 = __shfl(il0, (tc >> 4) & 15), e2 = __shfl(il1, tc & 15);
    if (lane < 16) { EID[(size_t)t * 128 + h * 16 + lane] = e1 * 128 + e2; GATE[(size_t)t * 128 + h * 16 + lane] = e / sum; }
}

__device__ __forceinline__ float gelu_tanh(float x) { const float u = 0.7978845608028654f * (x + 0.044715f * x * x * x); return 0.5f * x * (1.f + tanhf(u)); }

__global__ void __launch_bounds__(256) k_gather_naive(const bf16_t* H2, const int* EID, const float* GATE, const float* peer_u, const float* peer_v, const float* mod, float* out) {
    const int t = blockIdx.x * 4 + (threadIdx.x >> 6), lane = threadIdx.x & 63, b = t / S_;
    float hv[16], y[16];
#pragma unroll
    for (int j = 0; j < 4; ++j) { const uint2 raw = *(const uint2*)(H2 + (size_t)t * 1024 + 4 * lane + 256 * j); hv[4 * j] = lo2f(raw.x); hv[4 * j + 1] = hi2f(raw.x); hv[4 * j + 2] = lo2f(raw.y); hv[4 * j + 3] = hi2f(raw.y); }
#pragma unroll
    for (int i = 0; i < 16; ++i) y[i] = 0.f;
    const int e_a = EID[(size_t)t * 128 + lane], e_b = EID[(size_t)t * 128 + 64 + lane];
    const float g_a = GATE[(size_t)t * 128 + lane], g_b = GATE[(size_t)t * 128 + 64 + lane];
    for (int jj = 0; jj < 128; ++jj) {
        const int e = jj < 64 ? __shfl(e_a, jj) : __shfl(e_b, jj - 64);
        const float g = jj < 64 ? __shfl(g_a, jj) : __shfl(g_b, jj - 64);
        const float4* ur = (const float4*)(peer_u + (size_t)e * 1024) + lane;
        float s = 0.f;
#pragma unroll
        for (int j = 0; j < 4; ++j) { const float4 u4 = ur[64 * j]; s += (u4.x * hv[4 * j] + u4.y * hv[4 * j + 1]) + (u4.z * hv[4 * j + 2] + u4.w * hv[4 * j + 3]); }
        s = wave_sum(s);
        const float wgt = g * gelu_tanh(s);
        const float4* vr = (const float4*)(peer_v + (size_t)e * 1024) + lane;
#pragma unroll
        for (int j = 0; j < 4; ++j) { const float4 v4 = vr[64 * j]; y[4 * j] += wgt * v4.x; y[4 * j + 1] += wgt * v4.y; y[4 * j + 2] += wgt * v4.z; y[4 * j + 3] += wgt * v4.w; }
    }
    const float* g2 = mod + b * 6144 + 5 * 1024;
#pragma unroll
    for (int j = 0; j < 4; ++j) { const int col = 4 * lane + 256 * j; float4* op = (float4*)(out + (size_t)t * 1024 + col); float4 x1 = *op; const float4 gg = *(const float4*)(g2 + col);
        x1.x += gg.x * y[4 * j]; x1.y += gg.y * y[4 * j + 1]; x1.z += gg.z * y[4 * j + 2]; x1.w += gg.w * y[4 * j + 3]; *op = x1; }
}

extern "C" void kernel_launch(void* const* d_in, const int* in_sizes, int n_in, void* d_out, int out_size, void* d_ws, size_t ws_size, hipStream_t stream) {
    const float* x = (const float*)d_in[0]; const float* c = (const float*)d_in[1]; const int* positions = (const int*)d_in[2];
    const float* w_ada = (const float*)d_in[3]; const float* b_ada = (const float*)d_in[4]; const float* norm1_g = (const float*)d_in[5];
    const float* w_in = (const float*)d_in[6]; const float* mla_qa_g = (const float*)d_in[7]; const float* mla_kva_g = (const float*)d_in[8];
    const float* w_uq = (const float*)d_in[9]; const float* w_ukv = (const float*)d_in[10]; const float* mla_q_g = (const float*)d_in[11];
    const float* mla_k_g = (const float*)d_in[12]; const float* fox_q_g = (const float*)d_in[13]; const float* fox_k_g = (const float*)d_in[14];
    const float* b_f = (const float*)d_in[15]; const float* w_o = (const float*)d_in[16]; const float* norm2_g = (const float*)d_in[17];
    const float* w_pq = (const float*)d_in[18]; const float* sub_keys = (const float*)d_in[19]; const float* peer_u = (const float*)d_in[20]; const float* peer_v = (const float*)d_in[21];
    float* out = (float*)d_out; unsigned char* ws = (unsigned char*)d_ws;
    float* MOD = (float*)(ws + WS_MOD); float* FL = (float*)(ws + WS_FL); float* FCUM = (float*)(ws + WS_FCUM); float* LOGF = (float*)(ws + WS_LOGF); float2* ROPE = (float2*)(ws + WS_ROPE);
    bf16_t* XN = (bf16_t*)(ws + WS_XN); bf16_t* PROJ = (bf16_t*)(ws + WS_PROJ); bf16_t* KVRAW = (bf16_t*)(ws + WS_KVRAW); bf16_t* QA = (bf16_t*)(ws + WS_QA); bf16_t* KA = (bf16_t*)(ws + WS_KA);
    bf16_t* OB = XN; bf16_t* H2 = XN; bf16_t* QP = PROJ; int* EID = (int*)(ws + WS_QA); float* GATE = (float*)(ws + WS_QA + 16 * MiB);

    k_mod<<<dim3(24, 4), 256, 0, stream>>>(c, w_ada, b_ada, MOD);
    k_modrows<<<T_ / 4, 256, 0, stream>>>(x, norm1_g, MOD, 0, 1, XN);
    k_gemm_naive<1><<<dim3((INW + 63) / 64, T_ / 64), 256, 0, stream>>>(XN, 1024, w_in, 1024, INW, PROJ, PP, nullptr, nullptr, FL);
    k_rowprep<<<T_ / 4, 256, 0, stream>>>(PROJ, FL, mla_qa_g, mla_kva_g, fox_q_g, fox_k_g, b_f, positions, LOGF, ROPE);
    k_fcum<<<32, 64, 0, stream>>>(LOGF, FCUM);
    k_gemm_naive<0><<<dim3(768 / 64, T_ / 64), 256, 0, stream>>>(PROJ + C_CQ, PP, w_uq, 384, 768, QA, 768, nullptr, nullptr, nullptr);
    k_gemm_naive<0><<<dim3(1024 / 64, T_ / 64), 256, 0, stream>>>(PROJ + C_CKV, PP, w_ukv, 256, 1024, KVRAW, 1024, nullptr, nullptr, nullptr);
    k_mlaprep<<<T_ / 4, 256, 0, stream>>>(QA, KVRAW, PROJ, KA, ROPE, mla_q_g, mla_k_g);
    k_attn_naive<96><<<32 * 32, 256, 0, stream>>>(QA, 768, 96, KA, 768, 96, KVRAW + 64, 1024, 128, OB, 1024, 64, nullptr);
    k_attn_naive<64><<<32 * 32, 256, 0, stream>>>(PROJ + C_FQ, PP, 64, PROJ + C_FK, PP, 64, PROJ + C_FV, PP, 64, OB + 512, 1024, 64, FCUM);
    k_gemm_naive<2><<<dim3(1024 / 64, T_ / 64), 256, 0, stream>>>(OB, 1024, w_o, 1024, 1024, out, 1024, x, MOD, nullptr);
    k_modrows<<<T_ / 4, 256, 0, stream>>>(out, norm2_g, MOD, 3, 4, H2);
    k_gemm_naive<0><<<dim3(2048 / 64, T_ / 64), 256, 0, stream>>>(H2, 1024, w_pq, 1024, 2048, QP, 2048, nullptr, nullptr, nullptr);
    k_topk_naive<<<T_ * 8 / 4, 256, 0, stream>>>(QP, sub_keys, EID, GATE);
    k_gather_naive<<<T_ / 4, 256, 0, stream>>>(H2, EID, GATE, peer_u, peer_v, MOD, out);
}
```

```cpp
#include <hip/hip_runtime.h>
#include <cstdint>
#include <cstdio>
#include <cmath>

typedef unsigned short bf16_t;
constexpr int B_ = 4, S_ = 8192, D_ = 1024, T_ = B_ * S_;
constexpr int PP = 2304;
constexpr int C_CQ = 0, C_CKV = 384, C_KPE = 640, C_FQ = 672, C_FK = 1184, C_FV = 1696, C_FL = 2208, INW = 2216;
constexpr float EPS = 1e-6f;
constexpr float LOG2E = 1.4426950408889634f;
constexpr float C2A = 0.10206207261596577f * LOG2E;
constexpr float C2F = 0.125f * LOG2E;

__device__ __forceinline__ float bf2f(bf16_t v) { return __uint_as_float(((unsigned)v) << 16); }
__device__ __forceinline__ bf16_t f2bf(float f) { unsigned u = __float_as_uint(f); return (bf16_t)((u + 0x7fffu + ((u >> 16) & 1u)) >> 16); }
__device__ __forceinline__ unsigned pk2(float lo, float hi) { return (unsigned)f2bf(lo) | ((unsigned)f2bf(hi) << 16); }
__device__ __forceinline__ float lo2f(unsigned w) { return __uint_as_float(w << 16); }
__device__ __forceinline__ float hi2f(unsigned w) { return __uint_as_float(w & 0xffff0000u); }
__device__ __forceinline__ float wave_sum(float v) {
#pragma unroll
    for (int o = 1; o < 64; o <<= 1) v += __shfl_xor(v, o);
    return v;
}

constexpr size_t MiB = 1u << 20;
constexpr size_t WS_MOD = 1 * MiB;
constexpr size_t WS_FL = 3 * MiB;
constexpr size_t WS_FCUM = 4 * MiB;
constexpr size_t WS_LOGF = 5 * MiB;
constexpr size_t WS_ROPE = 6 * MiB;
constexpr size_t WS_XN = 88 * MiB;
constexpr size_t WS_PROJ = 152 * MiB;
constexpr size_t WS_KVRAW = 296 * MiB;
constexpr size_t WS_QA = 360 * MiB;
constexpr size_t WS_KA = 408 * MiB;

__global__ void k_mod(const float* c, const float* w_ada, const float* b_ada, float* mod) {
    const int j = blockIdx.x * 256 + threadIdx.x, b = blockIdx.y;
    float acc = b_ada[j];
    for (int k = 0; k < 1024; ++k) { const float cv = c[b * 1024 + k]; const float s = cv / (1.f + expf(-cv)); acc += s * w_ada[(size_t)k * 6144 + j]; }
    mod[b * 6144 + j] = acc;
}

__global__ void __launch_bounds__(256) k_modrows(const float* X, const float* g, const float* mod, int shift_idx, int scale_idx, bf16_t* out) {
    const int wave = threadIdx.x >> 6, lane = threadIdx.x & 63;
    const int row = blockIdx.x * 4 + wave, b = row / S_;
    const float4* xr = (const float4*)(X + (size_t)row * 1024) + lane;
    float4 v[4]; float ss = 0.f;
#pragma unroll
    for (int j = 0; j < 4; ++j) { v[j] = xr[64 * j]; ss += (v[j].x * v[j].x + v[j].y * v[j].y) + (v[j].z * v[j].z + v[j].w * v[j].w); }
    ss = wave_sum(ss);
    const float r = rsqrtf(ss * (1.f / 1024.f) + EPS);
    const float* sh = mod + b * 6144 + shift_idx * 1024; const float* sc = mod + b * 6144 + scale_idx * 1024;
#pragma unroll
    for (int j = 0; j < 4; ++j) {
        const int col = 4 * lane + 256 * j;
        const float4 g4 = *(const float4*)(g + col), s4 = *(const float4*)(sc + col), h4 = *(const float4*)(sh + col);
        const float o0 = v[j].x * r * g4.x * (1.f + s4.x) + h4.x, o1 = v[j].y * r * g4.y * (1.f + s4.y) + h4.y;
        const float o2 = v[j].z * r * g4.z * (1.f + s4.z) + h4.z, o3 = v[j].w * r * g4.w * (1.f + s4.w) + h4.w;
        uint2 w; w.x = pk2(o0, o1); w.y = pk2(o2, o3);
        *(uint2*)(out + (size_t)row * 1024 + col) = w;
    }
}

template <int MODE>
__global__ void __launch_bounds__(256) k_gemm_naive(const bf16_t* A, int lda, const float* W, int K, int N, void* Cout, int ldc, const float* aux1, const float* aux2, float* fl) {
    __shared__ float As[16][64];
    __shared__ float Ws[16][64];
    const int tx = threadIdx.x & 15, ty = threadIdx.x >> 4;
    const int m0 = blockIdx.y * 64, n0 = blockIdx.x * 64;
    float acc[4][4];
#pragma unroll
    for (int i = 0; i < 4; ++i)
#pragma unroll
        for (int j = 0; j < 4; ++j) acc[i][j] = 0.f;
    for (int k0 = 0; k0 < K; k0 += 16) {
        { const int r = threadIdx.x >> 2, kq = (threadIdx.x & 3) * 4; const uint2 a2 = *(const uint2*)(A + (size_t)(m0 + r) * lda + k0 + kq);
          As[kq + 0][r] = lo2f(a2.x); As[kq + 1][r] = hi2f(a2.x); As[kq + 2][r] = lo2f(a2.y); As[kq + 3][r] = hi2f(a2.y); }
        { const int kk = threadIdx.x >> 4, nq = (threadIdx.x & 15) * 4; float4 w4 = make_float4(0.f, 0.f, 0.f, 0.f);
          if (n0 + nq < N) w4 = *(const float4*)(W + (size_t)(k0 + kk) * N + n0 + nq);
          *(float4*)&Ws[kk][nq] = w4; }
        __syncthreads();
#pragma unroll
        for (int kk = 0; kk < 16; ++kk) {
            const float4 a4 = *(const float4*)&As[kk][ty * 4]; const float4 w4 = *(const float4*)&Ws[kk][tx * 4];
            const float a[4] = {a4.x, a4.y, a4.z, a4.w}; const float w[4] = {w4.x, w4.y, w4.z, w4.w};
#pragma unroll
            for (int i = 0; i < 4; ++i)
#pragma unroll
                for (int j = 0; j < 4; ++j) acc[i][j] += a[i] * w[j];
        }
        __syncthreads();
    }
#pragma unroll
    for (int i = 0; i < 4; ++i) {
        const int m = m0 + ty * 4 + i;
#pragma unroll
        for (int j = 0; j < 4; ++j) {
            const int n = n0 + tx * 4 + j;
            if (n < N) {
                if (MODE == 0) ((bf16_t*)Cout)[(size_t)m * ldc + n] = f2bf(acc[i][j]);
                else if (MODE == 1) { if (n < C_FL) ((bf16_t*)Cout)[(size_t)m * ldc + n] = f2bf(acc[i][j]); else fl[(size_t)m * 8 + (n - C_FL)] = acc[i][j]; }
                else { const int b = m / S_; ((float*)Cout)[(size_t)m * ldc + n] = aux1[(size_t)m * 1024 + n] + aux2[b * 6144 + 2 * 1024 + n] * acc[i][j]; }
            }
        }
    }
}

__device__ __forceinline__ void unpack8(const uint4 raw, float* v) {
    v[0] = lo2f(raw.x); v[1] = hi2f(raw.x); v[2] = lo2f(raw.y); v[3] = hi2f(raw.y); v[4] = lo2f(raw.z); v[5] = hi2f(raw.z); v[6] = lo2f(raw.w); v[7] = hi2f(raw.w);
}
__device__ __forceinline__ void rowprep_row(bf16_t* PROJ, const float* FL, const float* g_qa, const float* g_kva, const float* g_fq, const float* g_fk, const float* b_f,
                                                 const int* positions, float* LOGF, float2* ROPE, int row, int lane) {
    bf16_t* pr = PROJ + (size_t)row * PP;
    float v[8];
    {
        float ss = 0.f;
        if (lane < 48) { unpack8(*(const uint4*)(pr + C_CQ + lane * 8), v);
#pragma unroll
            for (int i = 0; i < 8; ++i) ss += v[i] * v[i]; }
        ss = wave_sum(ss);
        const float r = rsqrtf(ss * (1.f / 384.f) + EPS);
        if (lane < 48) { const float* g = g_qa + lane * 8; uint4 o;
            o.x = pk2(v[0] * r * g[0], v[1] * r * g[1]); o.y = pk2(v[2] * r * g[2], v[3] * r * g[3]); o.z = pk2(v[4] * r * g[4], v[5] * r * g[5]); o.w = pk2(v[6] * r * g[6], v[7] * r * g[7]);
            *(uint4*)(pr + C_CQ + lane * 8) = o; }
    }
    {
        float ss = 0.f;
        if (lane < 32) { unpack8(*(const uint4*)(pr + C_CKV + lane * 8), v);
#pragma unroll
            for (int i = 0; i < 8; ++i) ss += v[i] * v[i]; }
        ss = wave_sum(ss);
        const float r = rsqrtf(ss * (1.f / 256.f) + EPS);
        if (lane < 32) { const float* g = g_kva + lane * 8; uint4 o;
            o.x = pk2(v[0] * r * g[0], v[1] * r * g[1]); o.y = pk2(v[2] * r * g[2], v[3] * r * g[3]); o.z = pk2(v[4] * r * g[4], v[5] * r * g[5]); o.w = pk2(v[6] * r * g[6], v[7] * r * g[7]);
            *(uint4*)(pr + C_CKV + lane * 8) = o; }
    }
#pragma unroll
    for (int which = 0; which < 2; ++which) {
        const int coff = which == 0 ? C_FQ : C_FK; const float* g = (which == 0 ? g_fq : g_fk) + (lane & 7) * 8; const float sc = which == 0 ? C2F : 1.f;
        unpack8(*(const uint4*)(pr + coff + lane * 8), v);
        float ss = 0.f;
#pragma unroll
        for (int i = 0; i < 8; ++i) ss += v[i] * v[i];
        ss += __shfl_xor(ss, 1); ss += __shfl_xor(ss, 2); ss += __shfl_xor(ss, 4);
        const float r = rsqrtf(ss * (1.f / 64.f) + EPS) * sc; uint4 o;
        o.x = pk2(v[0] * r * g[0], v[1] * r * g[1]); o.y = pk2(v[2] * r * g[2], v[3] * r * g[3]); o.z = pk2(v[4] * r * g[4], v[5] * r * g[5]); o.w = pk2(v[6] * r * g[6], v[7] * r * g[7]);
        *(uint4*)(pr + coff + lane * 8) = o;
    }
    if (lane < 8) { const float z = FL[(size_t)row * 8 + lane] + b_f[lane]; LOGF[(size_t)row * 8 + lane] = fminf(z, 0.f) - log1pf(expf(-fabsf(z))); }
    if (lane < 16) { const float inv = powf(10000.f, -(float)lane / 16.f); const float ang = (float)positions[row] * inv; float sn, cs; sincosf(ang, &sn, &cs); ROPE[(size_t)row * 16 + lane] = make_float2(cs, sn); }
}

__global__ void __launch_bounds__(256) k_rowprep(bf16_t* PROJ, const float* FL, const float* g_qa, const float* g_kva, const float* g_fq, const float* g_fk, const float* b_f,
                                                 const int* positions, float* LOGF, float2* ROPE) {
    rowprep_row(PROJ, FL, g_qa, g_kva, g_fq, g_fk, b_f, positions, LOGF, ROPE, blockIdx.x * 4 + (threadIdx.x >> 6), threadIdx.x & 63);
}

__device__ __forceinline__ void fcum_item(const float* LOGF, float* FCUM, int item, int lane) {
    const int b = item >> 3, h = item & 7;
    const float* src = LOGF + ((size_t)b * S_) * 8 + h;
    float tot = 0.f;
    for (int i = 0; i < 128; ++i) tot += src[(size_t)(128 * lane + i) * 8];
    float incl = tot;
#pragma unroll
    for (int o = 1; o < 64; o <<= 1) { const float t = __shfl_up(incl, o); if (lane >= o) incl += t; }
    float run = incl - tot;
    float* dst = FCUM + ((size_t)(b * 8 + h)) * S_ + 128 * lane;
    for (int i = 0; i < 128; ++i) { run += src[(size_t)(128 * lane + i) * 8]; dst[i] = run; }
}
__global__ void __launch_bounds__(64) k_fcum(const float* LOGF, float* FCUM) { fcum_item(LOGF, FCUM, blockIdx.x, threadIdx.x); }

__device__ __forceinline__ void mlaprep_row(bf16_t* QRAW, const bf16_t* KVRAW, const bf16_t* PROJ, bf16_t* KA, const float2* ROPE, const float* g_q, const float* g_k, int row, int lane) {
    const int h = lane >> 3, p = lane & 7;
    const float2 cs0 = ROPE[(size_t)row * 16 + 2 * p], cs1 = ROPE[(size_t)row * 16 + 2 * p + 1];
#pragma unroll
    for (int which = 0; which < 2; ++which) {
        const float* g = which == 0 ? g_q : g_k; const float sc = which == 0 ? C2A : 1.f;
        float v[8]; unsigned r1, r2;
        if (which == 0) { const bf16_t* q = QRAW + (size_t)row * 768 + h * 96; unpack8(*(const uint4*)(q + 8 * p), v); r1 = *(const unsigned*)(q + 64 + 2 * p); r2 = *(const unsigned*)(q + 80 + 2 * p); }
        else { unpack8(*(const uint4*)(KVRAW + (size_t)row * 1024 + h * 128 + 8 * p), v); const bf16_t* kp = PROJ + (size_t)row * PP + C_KPE; r1 = *(const unsigned*)(kp + 2 * p); r2 = *(const unsigned*)(kp + 16 + 2 * p); }
        float a0 = lo2f(r1), a1 = hi2f(r1), b0 = lo2f(r2), b1 = hi2f(r2);
        float ss = a0 * a0 + a1 * a1 + b0 * b0 + b1 * b1;
#pragma unroll
        for (int i = 0; i < 8; ++i) ss += v[i] * v[i];
        ss += __shfl_xor(ss, 1); ss += __shfl_xor(ss, 2); ss += __shfl_xor(ss, 4);
        const float r = rsqrtf(ss * (1.f / 96.f) + EPS);
        const float* gn = g + 8 * p;
        a0 *= r * g[64 + 2 * p]; a1 *= r * g[64 + 2 * p + 1]; b0 *= r * g[80 + 2 * p]; b1 *= r * g[80 + 2 * p + 1];
        const float ra0 = a0 * cs0.x - b0 * cs0.y, rb0 = b0 * cs0.x + a0 * cs0.y, ra1 = a1 * cs1.x - b1 * cs1.y, rb1 = b1 * cs1.x + a1 * cs1.y;
        uint4 o; o.x = pk2(v[0] * r * gn[0] * sc, v[1] * r * gn[1] * sc); o.y = pk2(v[2] * r * gn[2] * sc, v[3] * r * gn[3] * sc);
        o.z = pk2(v[4] * r * gn[4] * sc, v[5] * r * gn[5] * sc); o.w = pk2(v[6] * r * gn[6] * sc, v[7] * r * gn[7] * sc);
        bf16_t* dst = (which == 0 ? QRAW : KA) + (size_t)row * 768 + h * 96;
        *(uint4*)(dst + 8 * p) = o; *(unsigned*)(dst + 64 + 2 * p) = pk2(ra0 * sc, ra1 * sc); *(unsigned*)(dst + 80 + 2 * p) = pk2(rb0 * sc, rb1 * sc);
    }
}

__global__ void __launch_bounds__(256) k_mlaprep(bf16_t* QRAW, const bf16_t* KVRAW, const bf16_t* PROJ, bf16_t* KA, const float2* ROPE, const float* g_q, const float* g_k) {
    mlaprep_row(QRAW, KVRAW, PROJ, KA, ROPE, g_q, g_k, blockIdx.x * 4 + (threadIdx.x >> 6), threadIdx.x & 63);
}

template <int DK>
__global__ void __launch_bounds__(256) k_attn_naive(const bf16_t* Q, int pq, int qstep, const bf16_t* K, int pk, int kstep, const bf16_t* V, int pv, int vstep, bf16_t* O, int po, int ostep, const float* FCUM) {
    __shared__ float Ks[64][DK];
    __shared__ float Vs[64][64];
    __shared__ float Bs[64];
    const int bh = blockIdx.x >> 5, qb = blockIdx.x & 31, b = bh >> 3, h = bh & 7;
    const int t = qb * 256 + threadIdx.x;
    const size_t row = (size_t)b * S_ + t;
    float q[DK];
#pragma unroll
    for (int c = 0; c < DK / 8; ++c) unpack8(*(const uint4*)(Q + row * pq + h * qstep + c * 8), q + c * 8);
    float o[64];
#pragma unroll
    for (int d = 0; d < 64; ++d) o[d] = 0.f;
    float m = -INFINITY, l = 0.f;
    const float fq = FCUM ? FCUM[(size_t)(b * 8 + h) * S_ + t] : 0.f;
    const int ntiles = (qb * 256 + 256) / 64;
    for (int kt = 0; kt < ntiles; ++kt) {
        __syncthreads();
        for (int c = threadIdx.x; c < 64 * (DK / 8); c += 256) { const int key = c / (DK / 8), ch = c % (DK / 8); float v[8];
            unpack8(*(const uint4*)(K + ((size_t)b * S_ + kt * 64 + key) * pk + h * kstep + ch * 8), v);
#pragma unroll
            for (int i = 0; i < 8; ++i) Ks[key][ch * 8 + i] = v[i]; }
        for (int c = threadIdx.x; c < 64 * 8; c += 256) { const int key = c >> 3, ch = c & 7; float v[8];
            unpack8(*(const uint4*)(V + ((size_t)b * S_ + kt * 64 + key) * pv + h * vstep + ch * 8), v);
#pragma unroll
            for (int i = 0; i < 8; ++i) Vs[key][ch * 8 + i] = v[i]; }
        if (threadIdx.x < 64) Bs[threadIdx.x] = FCUM ? FCUM[(size_t)(b * 8 + h) * S_ + kt * 64 + threadIdx.x] : 0.f;
        __syncthreads();
        const int kmax = t - kt * 64 + 1;
        for (int kk = 0; kk < 64; ++kk) {
            float s = 0.f;
#pragma unroll
            for (int d = 0; d < DK; ++d) s += q[d] * Ks[kk][d];
            if (FCUM) s += (fq - Bs[kk]) * LOG2E;
            if (kk < kmax) {
                const float mn = fmaxf(m, s), corr = exp2f(m - mn), p = exp2f(s - mn);
                l = l * corr + p;
#pragma unroll
                for (int d = 0; d < 64; ++d) o[d] = o[d] * corr + p * Vs[kk][d];
                m = mn;
            }
        }
    }
    const float rl = 1.f / l;
    bf16_t* op = O + row * po + h * ostep;
#pragma unroll
    for (int c = 0; c < 8; ++c) { uint4 w; w.x = pk2(o[c * 8 + 0] * rl, o[c * 8 + 1] * rl); w.y = pk2(o[c * 8 + 2] * rl, o[c * 8 + 3] * rl); w.z = pk2(o[c * 8 + 4] * rl, o[c * 8 + 5] * rl); w.w = pk2(o[c * 8 + 6] * rl, o[c * 8 + 7] * rl);
        *(uint4*)(op + c * 8) = w; }
}

__device__ __forceinline__ void topk_item(const bf16_t* QP, const float* sub_keys, int* EID, float* GATE, int w, int lane) {
    const int t = w >> 3, h = w & 7;
    float sl0 = 0.f, sl1 = 0.f; int il0 = 0, il1 = 0;
#pragma unroll
    for (int p = 0; p < 2; ++p) {
        const bf16_t* q = QP + (size_t)t * 2048 + h * 256 + p * 128;
        const float* k0 = sub_keys + ((size_t)(h * 2 + p) * 128 + lane) * 128; const float* k1 = k0 + 64 * 128;
        float s0 = 0.f, s1 = 0.f;
        for (int d = 0; d < 128; ++d) { const float qd = bf2f(q[d]); s0 += qd * k0[d]; s1 += qd * k1[d]; }
        float ls = 0.f; int li = 0;
        for (int r = 0; r < 16; ++r) {
            float bv; int bi; if (s0 >= s1) { bv = s0; bi = lane; } else { bv = s1; bi = lane + 64; }
#pragma unroll
            for (int o = 32; o >= 1; o >>= 1) { const float ov = __shfl_xor(bv, o); const int oi = __shfl_xor(bi, o); if (ov > bv || (ov == bv && oi < bi)) { bv = ov; bi = oi; } }
            if (lane == r) { ls = bv; li = bi; }
            if (bi == lane) s0 = -INFINITY; else if (bi == lane + 64) s1 = -INFINITY;
        }
        if (p == 0) { sl0 = ls; il0 = li; } else { sl1 = ls; il1 = li; }
    }
    float cv0, cv1, cv2, cv3;
    { const int c0 = lane, c1 = lane + 64, c2 = lane + 128, c3 = lane + 192;
      cv0 = __shfl(sl0, c0 >> 4) + __shfl(sl1, c0 & 15); cv1 = __shfl(sl0, c1 >> 4) + __shfl(sl1, c1 & 15);
      cv2 = __shfl(sl0, c2 >> 4) + __shfl(sl1, c2 & 15); cv3 = __shfl(sl0, c3 >> 4) + __shfl(sl1, c3 & 15); }
    float tv = -INFINITY; int tc = 0;
    for (int r = 0; r < 16; ++r) {
        float bv = cv0; int bc = lane;
        if (cv1 > bv) { bv = cv1; bc = lane + 64; }
        if (cv2 > bv) { bv = cv2; bc = lane + 128; }
        if (cv3 > bv) { bv = cv3; bc = lane + 192; }
#pragma unroll
        for (int o = 32; o >= 1; o >>= 1) { const float ov = __shfl_xor(bv, o); const int oc = __shfl_xor(bc, o); if (ov > bv || (ov == bv && oc < bc)) { bv = ov; bc = oc; } }
        if (lane == r) { tv = bv; tc = bc; }
        if (bc == lane) cv0 = -INFINITY; else if (bc == lane + 64) cv1 = -INFINITY; else if (bc == lane + 128) cv2 = -INFINITY; else if (bc == lane + 192) cv3 = -INFINITY;
    }
    const float mx = __shfl(tv, 0);
    const float e = lane < 16 ? expf(tv - mx) : 0.f;
    const float sum = wave_sum(e);
    const int e1 = __shfl(il0, (tc >> 4) & 15), e2 = __shfl(il1, tc & 15);
    if (lane < 16) { EID[(size_t)t * 128 + h * 16 + lane] = e1 * 128 + e2; GATE[(size_t)t * 128 + h * 16 + lane] = e / sum; }
}

__global__ void __launch_bounds__(256) k_topk_naive(const bf16_t* QP, const float* sub_keys, int* EID, float* GATE) { topk_item(QP, sub_keys, EID, GATE, blockIdx.x * 4 + (threadIdx.x >> 6), threadIdx.x & 63); }

__device__ __forceinline__ float gelu_tanh(float x) { const float u = 0.7978845608028654f * (x + 0.044715f * x * x * x); return 0.5f * x * (1.f + tanhf(u)); }

__device__ __forceinline__ void gather_item(const bf16_t* H2, const int* EID, const float* GATE, const float* peer_u, const float* peer_v, const float* mod, float* out, int t, int lane) {
    const int b = t / S_;
    float hv[16], y[16];
#pragma unroll
    for (int j = 0; j < 4; ++j) { const uint2 raw = *(const uint2*)(H2 + (size_t)t * 1024 + 4 * lane + 256 * j); hv[4 * j] = lo2f(raw.x); hv[4 * j + 1] = hi2f(raw.x); hv[4 * j + 2] = lo2f(raw.y); hv[4 * j + 3] = hi2f(raw.y); }
#pragma unroll
    for (int i = 0; i < 16; ++i) y[i] = 0.f;
    const int e_a = EID[(size_t)t * 128 + lane], e_b = EID[(size_t)t * 128 + 64 + lane];
    const float g_a = GATE[(size_t)t * 128 + lane], g_b = GATE[(size_t)t * 128 + 64 + lane];
    for (int jj = 0; jj < 128; ++jj) {
        const int e = jj < 64 ? __shfl(e_a, jj) : __shfl(e_b, jj - 64);
        const float g = jj < 64 ? __shfl(g_a, jj) : __shfl(g_b, jj - 64);
        const float4* ur = (const float4*)(peer_u + (size_t)e * 1024) + lane;
        float s = 0.f;
#pragma unroll
        for (int j = 0; j < 4; ++j) { const float4 u4 = ur[64 * j]; s += (u4.x * hv[4 * j] + u4.y * hv[4 * j + 1]) + (u4.z * hv[4 * j + 2] + u4.w * hv[4 * j + 3]); }
        s = wave_sum(s);
        const float wgt = g * gelu_tanh(s);
        const float4* vr = (const float4*)(peer_v + (size_t)e * 1024) + lane;
#pragma unroll
        for (int j = 0; j < 4; ++j) { const float4 v4 = vr[64 * j]; y[4 * j] += wgt * v4.x; y[4 * j + 1] += wgt * v4.y; y[4 * j + 2] += wgt * v4.z; y[4 * j + 3] += wgt * v4.w; }
    }
    const float* g2 = mod + b * 6144 + 5 * 1024;
#pragma unroll
    for (int j = 0; j < 4; ++j) { const int col = 4 * lane + 256 * j; float4* op = (float4*)(out + (size_t)t * 1024 + col); float4 x1 = *op; const float4 gg = *(const float4*)(g2 + col);
        x1.x += gg.x * y[4 * j]; x1.y += gg.y * y[4 * j + 1]; x1.z += gg.z * y[4 * j + 2]; x1.w += gg.w * y[4 * j + 3]; *op = x1; }
}
__global__ void __launch_bounds__(256) k_gather_naive(const bf16_t* H2, const int* EID, const float* GATE, const float* peer_u, const float* peer_v, const float* mod, float* out) {
    gather_item(H2, EID, GATE, peer_u, peer_v, mod, out, blockIdx.x * 4 + (threadIdx.x >> 6), threadIdx.x & 63);
}


namespace pg8 {
#define PG8_LAS __attribute__((address_space(3)))
typedef unsigned short bf16_t;
typedef short bf16x8 __attribute__((ext_vector_type(8)));
typedef float f32x4 __attribute__((ext_vector_type(4)));
typedef unsigned u32x4 __attribute__((ext_vector_type(4)));
constexpr int BM = 256, BK = 64, HALF = 128, HTB = HALF * BK * 2  , STAGE_BYTES = 8 * HTB, NXCD = 8, WGM = 8;

__host__ __device__ __forceinline__ int lds_byte(int r, int c) { const int st = (r >> 4) * 2 + (c >> 5), rr = r & 15, cc = c & 31, ob = rr * 64 + cc * 2; return st * 1024 + (ob ^ (((ob >> 9) & 1) << 5)); }
__host__ __device__ __forceinline__ void stage_rc(int b, int& R, int& C) { const int st = b / 1024, sb = b % 1024, swz = sb ^ (((sb >> 9) & 1) << 5); R = (st >> 1) * 16 + swz / 64; C = (st & 1) * 32 + (swz % 64) / 2; }
__host__ __device__ __forceinline__ int perm32(int rho) { const int n = rho >> 4, i = rho & 15; return 8 * (i >> 2) + 4 * n + (i & 3); }

struct Unit { int pm, pn; };
struct Gemm { const bf16_t* A; const bf16_t* Bt; int M, N, K, lda; };

struct StaticOrder {
    int nM, nN, nwg, G, c;
    __host__ __device__ void init(int M, int N, int G_, int c_) { nM = M / BM; nN = N / BM; nwg = nM * nN; G = G_; c = c_; }
    __host__ __device__ bool next(int i, Unit& u) const {
        const long L = (long)i * G + c; if (L >= nwg) return false;
        int wgid = (int)L; { const int q = nwg / NXCD, r = nwg % NXCD, xcd = wgid % NXCD, off = wgid / NXCD; wgid = (xcd < r ? xcd * (q + 1) : r * (q + 1) + (xcd - r) * q) + off; }
        const int nig = WGM * nN, gid = wgid / nig, fm = gid * WGM, gsz = (nM - fm) < WGM ? (nM - fm) : WGM;
        u.pm = fm + ((wgid % nig) % gsz); u.pn = (wgid % nig) / gsz; return true;
    }
    __device__ __forceinline__ void a_ready(const Unit&) const {}
    __device__ __forceinline__ void done(const Unit&) const {}
};
__device__ __forceinline__ unsigned cvt_pk_bf16(float lo, float hi) { unsigned r; asm volatile("v_cvt_pk_bf16_f32 %0, %1, %2" : "=v"(r) : "v"(lo), "v"(hi)); return r; }
typedef float f32x2 __attribute__((ext_vector_type(2)));
template <class Epi, class Sched, bool ALIGN_EPI = false, bool SP2 = false>
__device__ __forceinline__ void gemm_phase(PG8_LAS unsigned char* lds, const Gemm g, const Sched& S, const Epi& E) {
    const int tid = threadIdx.x, wid = __builtin_amdgcn_readfirstlane(tid >> 6), lane = tid & 63, wr = wid >> 2, wc = wid & 3, fr = lane & 15, fq = lane >> 4;
    const int K = g.K, nt = K / BK;
    unsigned voffA[2], voffB[2];
#pragma unroll
    for (int i = 0; i < 2; ++i) { int R, C; stage_rc(tid * 16 + i * 8192, R, C); const int Rb = Epi::PERM ? ((R & ~31) + perm32(R & 31)) : R;
        voffA[i] = (unsigned)(R * g.lda + C) * 2u; voffB[i] = (unsigned)(Rb * K + C) * 2u; }
    const size_t kstep = (size_t)(BK * 2);
    const size_t hstepA = (size_t)HALF * g.lda * 2, hstepB = (size_t)HALF * K * 2;
    const size_t tstepA = 2 * hstepA, tstepB = 2 * hstepB;
    const unsigned ldsw = (unsigned)wid * 1024u;
    const int aoff = lds_byte(wr * 64 + fr, fq * 8), boff = lds_byte(wc * 32 + fr, fq * 8);
#define PG8_SA(b, h) (((b) * 2 + (h)) * HTB)
#define PG8_SB(b, h) ((4 + (b) * 2 + (h)) * HTB)
#define PG8_STAGE(bufoff, gbase, voff) do { _Pragma("unroll") for (int _i = 0; _i < 2; ++_i) \
        __builtin_amdgcn_global_load_lds((const unsigned*)((const char*)(gbase) + (voff)[_i]), (PG8_LAS unsigned*)(lds + (bufoff) + ldsw + _i * 8192), 16, 0, 0); } while (0)
#define PG8_LDA(dst, b, h) do { _Pragma("unroll") for (int m = 0; m < 4; ++m) _Pragma("unroll") for (int k = 0; k < 2; ++k) dst[m][k] = *(const PG8_LAS bf16x8*)(lds + PG8_SA(b, h) + aoff + m * 2048 + k * 1024); } while (0)
#define PG8_LDB(dst, b, h) do { _Pragma("unroll") for (int n = 0; n < 2; ++n) _Pragma("unroll") for (int k = 0; k < 2; ++k) dst[n][k] = *(const PG8_LAS bf16x8*)(lds + PG8_SB(b, h) + boff + n * 2048 + k * 1024); } while (0)
#define PG8_MMA(ai, bj, At, Bt) do { __builtin_amdgcn_s_setprio(1); _Pragma("unroll") for (int m = 0; m < 4; ++m) _Pragma("unroll") for (int n = 0; n < 2; ++n) _Pragma("unroll") for (int k = 0; k < 2; ++k) \
        acc[ai][bj][m][n] = __builtin_amdgcn_mfma_f32_16x16x32_bf16(Bt[n][k], At[m][k], acc[ai][bj][m][n], 0, 0, 0); __builtin_amdgcn_s_setprio(0); } while (0)
#define PG8_WAIT_V(n) asm volatile("s_waitcnt vmcnt(" #n ")" ::: "memory")
#define PG8_WAIT_L(n) asm volatile("s_waitcnt lgkmcnt(" #n ")" ::: "memory")
#define PG8_BAR __builtin_amdgcn_s_barrier()
#define PG8_SCHED __builtin_amdgcn_sched_barrier(0)
    Unit cur, nxt; int ui = 0;
    if (!S.next(0, cur)) return;
    f32x4 acc[2][2][4][2];
#pragma unroll
    for (int a = 0; a < 2; ++a)
#pragma unroll
        for (int b = 0; b < 2; ++b)
#pragma unroll
            for (int m = 0; m < 4; ++m)
#pragma unroll
                for (int n = 0; n < 2; ++n) acc[a][b][m][n] = (f32x4){0.f, 0.f, 0.f, 0.f};
    bf16x8 At[4][2], B0[2][2], B1[2][2];
    const char* cA = (const char*)g.A + (size_t)cur.pm * tstepA; const char* cB = (const char*)g.Bt + (size_t)cur.pn * tstepB;
    S.a_ready(cur);
    if constexpr (SP2) {
        PG8_STAGE(PG8_SB(0, 0), cB, voffB); PG8_STAGE(PG8_SB(0, 1), cB + hstepB, voffB); PG8_STAGE(PG8_SA(0, 0), cA, voffA); PG8_STAGE(PG8_SA(0, 1), cA + hstepA, voffA);
        if (wr == 1) PG8_BAR;
        PG8_WAIT_V(2); PG8_BAR;
        PG8_STAGE(PG8_SB(1, 0), cB + kstep, voffB); PG8_STAGE(PG8_SA(1, 0), cA + kstep, voffA); PG8_STAGE(PG8_SB(1, 1), cB + hstepB + kstep, voffB);
        PG8_WAIT_V(6); PG8_BAR;
    } else {
        PG8_STAGE(PG8_SB(0, 0), cB, voffB); PG8_STAGE(PG8_SA(0, 0), cA, voffA); PG8_STAGE(PG8_SB(0, 1), cB + hstepB, voffB); PG8_STAGE(PG8_SA(0, 1), cA + hstepA, voffA);
        if (wr == 1) PG8_BAR;
        PG8_WAIT_V(4); PG8_BAR;
        PG8_STAGE(PG8_SB(1, 0), cB + kstep, voffB); PG8_STAGE(PG8_SA(1, 0), cA + kstep, voffA); PG8_STAGE(PG8_SB(1, 1), cB + hstepB + kstep, voffB);
        PG8_WAIT_V(6); PG8_BAR;
    }
    for (;;) {
        const bool has_next = S.next(ui + 1, nxt);
        const char* nA = has_next ? (const char*)g.A + (size_t)nxt.pm * tstepA : cA; const char* nB = has_next ? (const char*)g.Bt + (size_t)nxt.pn * tstepB : cB;
        for (int t = 0; t < nt; t += 2) {
            const bool last = (t == nt - 2);
            const char* a1 = cA + (size_t)(t + 1) * kstep;
            const char* a2 = last ? nA : cA + (size_t)(t + 2) * kstep; const char* b2 = last ? nB : cB + (size_t)(t + 2) * kstep;
            const char* a3 = a2 + kstep; const char* b3 = b2 + kstep;
            if (last && has_next) S.a_ready(nxt);
            if constexpr (SP2) {
            PG8_LDB(B0, 0, 0); PG8_LDB(B1, 0, 1); PG8_SCHED; PG8_LDA(At, 0, 0); PG8_STAGE(PG8_SA(1, 1), a1 + hstepA, voffA);
            PG8_WAIT_V(8); PG8_WAIT_L(0); PG8_BAR; PG8_MMA(0, 0, At, B0); PG8_MMA(0, 1, At, B1); PG8_BAR; PG8_SCHED;
            PG8_LDA(At, 0, 1); PG8_STAGE(PG8_SB(0, 0), b2, voffB); PG8_STAGE(PG8_SB(0, 1), b2 + hstepB, voffB); PG8_STAGE(PG8_SA(0, 0), a2, voffA);
            PG8_WAIT_V(8); PG8_WAIT_L(0); PG8_BAR; PG8_MMA(1, 0, At, B0); PG8_MMA(1, 1, At, B1); PG8_BAR; PG8_SCHED;
            PG8_LDB(B0, 1, 0); PG8_LDB(B1, 1, 1); PG8_SCHED; PG8_LDA(At, 1, 0); PG8_STAGE(PG8_SA(0, 1), a2 + hstepA, voffA);
            PG8_WAIT_V(8); PG8_WAIT_L(0); PG8_BAR; PG8_MMA(0, 0, At, B0); PG8_MMA(0, 1, At, B1); PG8_BAR; PG8_SCHED;
            PG8_LDA(At, 1, 1); PG8_STAGE(PG8_SB(1, 0), b3, voffB); PG8_STAGE(PG8_SB(1, 1), b3 + hstepB, voffB); PG8_STAGE(PG8_SA(1, 0), a3, voffA);
            PG8_WAIT_V(8); PG8_WAIT_L(0); PG8_BAR; PG8_MMA(1, 0, At, B0); PG8_MMA(1, 1, At, B1); PG8_BAR; PG8_SCHED;
            } else {
            PG8_LDB(B0, 0, 0); PG8_SCHED; PG8_LDA(At, 0, 0); PG8_STAGE(PG8_SA(1, 1), a1 + hstepA, voffA);
            PG8_WAIT_L(8); PG8_BAR; PG8_WAIT_L(0); PG8_MMA(0, 0, At, B0); PG8_BAR; PG8_SCHED;
            PG8_LDB(B1, 0, 1); PG8_STAGE(PG8_SB(0, 0), b2, voffB);
            PG8_BAR; PG8_WAIT_L(0); PG8_MMA(0, 1, At, B1); PG8_BAR;
            PG8_LDA(At, 0, 1); PG8_STAGE(PG8_SA(0, 0), a2, voffA);
            PG8_BAR; PG8_WAIT_L(0); PG8_MMA(1, 0, At, B0); PG8_BAR; PG8_SCHED;
            PG8_STAGE(PG8_SB(0, 1), b2 + hstepB, voffB);
            PG8_WAIT_V(6); PG8_BAR; PG8_MMA(1, 1, At, B1); PG8_BAR;
            PG8_LDB(B0, 1, 0); PG8_SCHED; PG8_LDA(At, 1, 0); PG8_STAGE(PG8_SA(0, 1), a2 + hstepA, voffA);
            PG8_WAIT_L(8); PG8_BAR; PG8_WAIT_L(0); PG8_MMA(0, 0, At, B0); PG8_BAR; PG8_SCHED;
            PG8_LDB(B1, 1, 1); PG8_STAGE(PG8_SB(1, 0), b3, voffB);
            PG8_BAR; PG8_WAIT_L(0); PG8_MMA(0, 1, At, B1); PG8_BAR;
            PG8_LDA(At, 1, 1); PG8_STAGE(PG8_SA(1, 0), a3, voffA);
            PG8_BAR; PG8_WAIT_L(0); PG8_MMA(1, 0, At, B0); PG8_BAR; PG8_SCHED;
            PG8_STAGE(PG8_SB(1, 1), b3 + hstepB, voffB);
            PG8_WAIT_V(6); PG8_BAR; PG8_MMA(1, 1, At, B1); PG8_BAR;
            }
        }
        if constexpr (ALIGN_EPI) { if (wr == 0) PG8_BAR; }
        if constexpr (!Epi::AFTER_DRAIN) { E(acc, cur, wr, wc, fr, fq); S.done(cur); }
        if (!has_next) break;
#pragma unroll
        for (int a = 0; a < 2; ++a)
#pragma unroll
            for (int b = 0; b < 2; ++b)
#pragma unroll
                for (int m = 0; m < 4; ++m)
#pragma unroll
                    for (int n = 0; n < 2; ++n) acc[a][b][m][n] = (f32x4){0.f, 0.f, 0.f, 0.f};
        cur = nxt; cA = nA; cB = nB; ++ui;
        if constexpr (ALIGN_EPI) { if (wr == 1) PG8_BAR; }
    }
    PG8_WAIT_V(0);
    if constexpr (!ALIGN_EPI) { if (wr == 0) PG8_BAR; }
    PG8_BAR;
    if constexpr (Epi::AFTER_DRAIN) { E.fused(acc, cur, wr, wc, fr, fq, lds, wid, lane); S.done(cur); }
#undef PG8_SA
#undef PG8_SB
#undef PG8_STAGE
#undef PG8_LDA
#undef PG8_LDB
#undef PG8_MMA
#undef PG8_WAIT_V
#undef PG8_WAIT_L
#undef PG8_BAR
#undef PG8_SCHED
}
}


#define GAS __attribute__((address_space(1)))
#define LAS __attribute__((address_space(3)))
typedef float f32x4 __attribute__((ext_vector_type(4)));
typedef unsigned u32x4 __attribute__((ext_vector_type(4)));
#define XB_TMO      128
#define XB_XCNT(j)  (256  + 64 * (j))
#define XB_XSUB(j)  (1280 + 64 * (j))
#define XB_XGEN(j)  (2304 + 64 * (j))
#define XB_TOP      3328
#define XB_TOPGEN   3392
#define XCD_BAR_WORDS 3456
#define XB_SPIN_CAP (1u << 18)

__device__ __forceinline__ unsigned xb_ld(unsigned* p)              { return __hip_atomic_load(p, __ATOMIC_RELAXED, __HIP_MEMORY_SCOPE_AGENT); }
__device__ __forceinline__ unsigned xb_add(unsigned* p, unsigned v) { return __hip_atomic_fetch_add(p, v, __ATOMIC_RELAXED, __HIP_MEMORY_SCOPE_AGENT); }
__device__ __forceinline__ unsigned xb_xcc_id() { return (unsigned)__builtin_amdgcn_s_getreg((3 << 11) | 20) & 0xFu; }
#define XB_SPIN(cond, bar) do { unsigned _sp = 0; while (cond) { __builtin_amdgcn_s_sleep(1); \
    if ((++_sp & 255u) == 0u) { if (xb_ld(&(bar)[XB_TMO])) break; if (_sp > XB_SPIN_CAP) { atomicAdd(&(bar)[XB_TMO], 1u); break; } } } } while (0)

struct XcdBarrier {
    unsigned* bar; unsigned x;
    volatile LAS unsigned* st;
};

__device__ __forceinline__ XcdBarrier xcd_barrier_post(unsigned* bar, volatile LAS unsigned* st) {
    XcdBarrier b; b.bar = bar; b.x = xb_xcc_id(); b.st = st;
    if (threadIdx.x == 0) (void)xb_add(&bar[XB_XCNT(b.x)], 1u);
    return b;
}
__device__ __forceinline__ void xcd_barrier_complete(unsigned* bar, unsigned x, unsigned& nloc, unsigned& nx) {
    const unsigned G = gridDim.x * gridDim.y * gridDim.z;
    unsigned sum, cnt, mine, sp = 0u;
    for (;;) {
        sum = 0u; cnt = 0u; mine = 0u;
#pragma unroll
        for (unsigned j = 0; j < 16; ++j) { const unsigned c = xb_ld(&bar[XB_XCNT(j)]); sum += c; cnt += (c > 0u) ? 1u : 0u; mine = (j == x) ? c : mine; }
        if (sum == G) break;
        __builtin_amdgcn_s_sleep(1);
        if ((++sp & 255u) == 0u) { if (xb_ld(&bar[XB_TMO])) break; if (sp > XB_SPIN_CAP) { atomicAdd(&bar[XB_TMO], 1u); break; } }
    }
    nloc = mine > 0u ? mine : 1u; nx = cnt > 0u ? cnt : 1u;
}

__device__ __forceinline__ void xcd_barrier(const XcdBarrier& b) {
    asm volatile("s_waitcnt vmcnt(0)" ::: "memory");
    __syncthreads();
    if (threadIdx.x == 0) {
        unsigned* bar = b.bar;
        __builtin_amdgcn_s_waitcnt(0);
        unsigned nloc = b.st[0], nx = b.st[1];
        if (nloc == 0u) { xcd_barrier_complete(bar, b.x, nloc, nx); b.st[0] = nloc; b.st[1] = nx; }
        const unsigned old = xb_add(&bar[XB_XSUB(b.x)], 1u);
        const unsigned gen = old / nloc;
        if (old + 1u == (gen + 1u) * nloc) {
            __builtin_amdgcn_fence(__ATOMIC_RELEASE, "agent");
            asm volatile("s_waitcnt vmcnt(0)" ::: "memory");
            const unsigned og = xb_add(&bar[XB_TOP], 1u);
            const unsigned tg = og / nx;
            if (og + 1u == (tg + 1u) * nx) xb_add(&bar[XB_TOPGEN], 1u);
            else XB_SPIN(xb_ld(&bar[XB_TOPGEN]) == tg, bar);
            __builtin_amdgcn_fence(__ATOMIC_ACQUIRE, "agent");
            xb_add(&bar[XB_XGEN(b.x)], 1u);
            asm volatile("s_waitcnt vmcnt(0)" ::: "memory");
        } else {
            XB_SPIN(xb_ld(&bar[XB_XGEN(b.x)]) == gen, bar);
            __builtin_amdgcn_fence(__ATOMIC_ACQUIRE, "agent");
            asm volatile("s_waitcnt vmcnt(0)" ::: "memory");
        }
    }
    __syncthreads();
}


constexpr int NWAVES = 8;
constexpr int RING_BYTES = 131072, LDSCTL_OFF = RING_BYTES, MISC_OFF = LDSCTL_OFF + 320, LDS_BYTES = 147456;
constexpr size_t WS_CTL = 0, CTL_ZERO_BYTES = 1 * MiB;
constexpr int CW_BAR = 4096, N_BAR_REGIONS = 16;
static_assert((CW_BAR + N_BAR_REGIONS * XCD_BAR_WORDS) * 4 <= (int)CTL_ZERO_BYTES, "barrier words inside the memset region");
constexpr size_t WS_WIN = 10 * MiB;
constexpr size_t WS_WUQ = 15 * MiB;
constexpr size_t WS_WUKV = 16 * MiB;
constexpr size_t WS_WO = 17 * MiB;
constexpr size_t WS_WPQ = 19 * MiB;
constexpr size_t WS_SK = 23 * MiB;
constexpr size_t WS_U16 = 24 * MiB;
constexpr size_t WS_V16 = 56 * MiB;


namespace att {
typedef short bf16x8 __attribute__((ext_vector_type(8)));
typedef short s16x4 __attribute__((ext_vector_type(4)));
typedef float f32x16 __attribute__((ext_vector_type(16)));
constexpr int LK = 0, KSLOT = 12288, LV = 2 * KSLOT, VSLOT = 8192, LB = LV + 2 * VSLOT, BSLOT = 256, LWS = LB + 2 * BSLOT, LOST = LWS + 8 * 256, ATT_LDS = LOST + 8 * 4096;
static_assert(ATT_LDS <= 131072, "attention scratch fits the ring region");
struct Desc { const bf16_t* Q; int pq; const bf16_t* K; int pk; const bf16_t* V; int pv; bf16_t* O; int po; const float* FC; };

__device__ __forceinline__ int crow(int r, int hi) { return (r & 3) + 8 * (r >> 2) + 4 * hi; }
__device__ __forceinline__ float xmax32(float v) { auto rr = __builtin_amdgcn_permlane32_swap(__float_as_uint(v), __float_as_uint(v), false, false); return fmaxf(__uint_as_float(rr[0]), __uint_as_float(rr[1])); }
__device__ __forceinline__ float xsum32(float v) { auto rr = __builtin_amdgcn_permlane32_swap(__float_as_uint(v), __float_as_uint(v), false, false); return __uint_as_float(rr[0]) + __uint_as_float(rr[1]); }
__device__ __forceinline__ unsigned cvtpk(float lo, float hi) { typedef float f2 __attribute__((ext_vector_type(2))); typedef __bf16 b2 __attribute__((ext_vector_type(2))); f2 v = {lo, hi}; b2 b = __builtin_convertvector(v, b2); return __builtin_bit_cast(unsigned, b); }
typedef short v4i16_t __attribute__((ext_vector_type(4)));
__device__ __forceinline__ s16x4 vtr(LAS const unsigned char* p) { return __builtin_bit_cast(s16x4, __builtin_amdgcn_ds_read_tr16_b64_v4i16((LAS v4i16_t*)p)); }

template <int KS, bool BIAS>
__device__ __forceinline__ void attn_unit(const Desc& d, int qb, int j0, LAS unsigned char* shm) {
    const int tid = threadIdx.x, lane = tid & 63, r32 = lane & 31, hi = lane >> 5; const int wid = __builtin_amdgcn_readfirstlane(tid >> 6);
    const int q0 = qb * 256, NT = (q0 + 256) / 64;
    LAS float* wsf = (LAS float*)(shm + LWS) + wid * 64;
    bf16x8 qr[KS];
    { const bf16_t* qp = d.Q + (size_t)(q0 + wid * 32 + r32) * d.pq + hi * 8;
#pragma unroll
      for (int d0 = 0; d0 < KS; ++d0) qr[d0] = *(const bf16x8*)(qp + d0 * 16); }
    const float fcref = BIAS ? d.FC[q0] : 0.f;
    const bf16_t* ksrc0 = d.K + (size_t)lane * d.pk + wid * 8;
    const bf16_t* ksrc1 = d.K + (size_t)lane * d.pk + (8 + wid) * 8;
    const bf16_t* vsrc = d.V + (size_t)(16 * (wid & 3) + (lane >> 2)) * d.pv + (wid >> 2) * 32 + (lane & 3) * 8;
    const int kdst0 = LK + wid * 1024 + lane * 16, kdst1 = LK + (8 + wid) * 1024 + lane * 16, vdst = LV + wid * 1024 + lane * 16;
    const bool k2 = (KS > 4) && (wid < 2 * KS - 8);
    u32x4 kr0, kr1, vr; float br = 0.f;
#define ATT_LOAD(t) do { kr0 = *(const u32x4*)(ksrc0 + (size_t)(t) * 64 * d.pk); if (k2) kr1 = *(const u32x4*)(ksrc1 + (size_t)(t) * 64 * d.pk); \
        vr = *(const u32x4*)(vsrc + (size_t)(t) * 64 * d.pv); if (BIAS && wid == 4) br = d.FC[(t) * 64 + lane]; } while (0)
#define ATT_WRITE(slot) do { *(LAS u32x4*)(shm + kdst0 + (slot) * KSLOT) = kr0; if (k2) *(LAS u32x4*)(shm + kdst1 + (slot) * KSLOT) = kr1; \
        *(LAS u32x4*)(shm + vdst + (slot) * VSLOT) = vr; if (BIAS && wid == 4) *(LAS float*)(shm + LB + (slot) * BSLOT + lane * 4) = (fcref - br) * LOG2E; } while (0)
    f32x16 o0, o1;
#pragma unroll
    for (int r = 0; r < 16; ++r) { o0[r] = 0.f; o1[r] = 0.f; }
    float m = -INFINITY, l = 0.f;
    const int qrel = wid * 32 + r32;
    const int kfrag = LK + hi * 1024 + r32 * 16;
    const int vfrag = LV + ((lane >> 4) & 1) * 32 + (lane & 3) * 8 + (4 * hi + ((lane & 15) >> 2)) * 64;
    ATT_LOAD(j0); ATT_WRITE(0);
    __syncthreads();
    for (int t = j0; t < NT; ++t) {
        const int slot = (t - j0) & 1;
        if (t + 1 < NT) ATT_LOAD(t + 1);
        const int jb = t - (NT - 4);
        if (!(jb >= 0 && 64 * jb > 32 * wid + 31)) {
            f32x16 p0, p1;
            if (BIAS) {
                LAS const unsigned char* bp = shm + LB + slot * BSLOT + 16 * hi;
#pragma unroll
                for (int g = 0; g < 4; ++g) { const f32x4 a = *(LAS const f32x4*)(bp + 32 * g), b = *(LAS const f32x4*)(bp + 128 + 32 * g);
                    p0[4 * g] = a[0]; p0[4 * g + 1] = a[1]; p0[4 * g + 2] = a[2]; p0[4 * g + 3] = a[3]; p1[4 * g] = b[0]; p1[4 * g + 1] = b[1]; p1[4 * g + 2] = b[2]; p1[4 * g + 3] = b[3]; }
            } else {
#pragma unroll
                for (int r = 0; r < 16; ++r) { p0[r] = 0.f; p1[r] = 0.f; }
            }
            LAS const unsigned char* kp = shm + kfrag + slot * KSLOT;
#pragma unroll
            for (int d0 = 0; d0 < KS; ++d0) {
                const bf16x8 a0 = *(LAS const bf16x8*)(kp + d0 * 2048), a1 = *(LAS const bf16x8*)(kp + d0 * 2048 + 512);
                p0 = __builtin_amdgcn_mfma_f32_32x32x16_bf16(a0, qr[d0], p0, 0, 0, 0);
                p1 = __builtin_amdgcn_mfma_f32_32x32x16_bf16(a1, qr[d0], p1, 0, 0, 0);
            }
            if (jb >= 0) {
                const int kb = 64 * jb + 4 * hi;
#pragma unroll
                for (int r = 0; r < 16; ++r) { const int kv = kb + (r & 3) + 8 * (r >> 2); if (kv > qrel) p0[r] = -INFINITY; if (kv + 32 > qrel) p1[r] = -INFINITY; }
            }
            float rm = fmaxf(p0[0], p1[0]);
#pragma unroll
            for (int r = 1; r < 16; ++r) rm = fmaxf(rm, fmaxf(p0[r], p1[r]));
            rm = xmax32(rm);
            const float mn = fmaxf(m, rm);
            const float alpha = __builtin_amdgcn_exp2f(m - mn);
            m = mn;
            float sacc = 0.f;
#pragma unroll
            for (int r = 0; r < 16; ++r) { p0[r] = __builtin_amdgcn_exp2f(p0[r] - mn); p1[r] = __builtin_amdgcn_exp2f(p1[r] - mn); sacc += p0[r] + p1[r]; }
            l = l * alpha + sacc;
            if (__any(alpha != 1.f)) {
                if (hi == 0) wsf[r32] = alpha;
#pragma unroll
                for (int g = 0; g < 4; ++g) { const f32x4 a = *(LAS const f32x4*)(wsf + 8 * g + 4 * hi);
#pragma unroll
                    for (int i = 0; i < 4; ++i) { o0[4 * g + i] *= a[i]; o1[4 * g + i] *= a[i]; } }
            }
            LAS const unsigned char* vp = shm + vfrag + slot * VSLOT;
#pragma unroll
            for (int ks = 0; ks < 4; ++ks) {
                const f32x16& pp = ks < 2 ? p0 : p1; const int bq = (ks & 1) * 8;
                u32x4 pw; pw.x = cvtpk(pp[bq], pp[bq + 1]); pw.y = cvtpk(pp[bq + 2], pp[bq + 3]); pw.z = cvtpk(pp[bq + 4], pp[bq + 5]); pw.w = cvtpk(pp[bq + 6], pp[bq + 7]);
                const bf16x8 pa = __builtin_bit_cast(bf16x8, pw);
                const s16x4 l0 = vtr(vp + ks * 1024), h0 = vtr(vp + ks * 1024 + 512), l1 = vtr(vp + 4096 + ks * 1024), h1 = vtr(vp + 4096 + ks * 1024 + 512);
                const bf16x8 v0 = {l0[0], l0[1], l0[2], l0[3], h0[0], h0[1], h0[2], h0[3]}, v1 = {l1[0], l1[1], l1[2], l1[3], h1[0], h1[1], h1[2], h1[3]};
                o0 = __builtin_amdgcn_mfma_f32_32x32x16_bf16(pa, v0, o0, 0, 0, 0);
                o1 = __builtin_amdgcn_mfma_f32_32x32x16_bf16(pa, v1, o1, 0, 0, 0);
            }
        }
        if (t + 1 < NT) ATT_WRITE(slot ^ 1);
        __syncthreads();
    }
#undef ATT_LOAD
#undef ATT_WRITE
    l = xsum32(l);
    if (hi == 0) wsf[32 + r32] = l;
    float rli[16];
#pragma unroll
    for (int g = 0; g < 4; ++g) { const f32x4 a = *(LAS const f32x4*)(wsf + 32 + 8 * g + 4 * hi);
#pragma unroll
        for (int i = 0; i < 4; ++i) rli[4 * g + i] = 1.f / a[i]; }
    LAS bf16_t* stg = (LAS bf16_t*)(shm + LOST) + wid * 2048;
#pragma unroll
    for (int r = 0; r < 16; ++r) { const int orow = crow(r, hi); stg[orow * 64 + r32] = f2bf(o0[r] * rli[r]); stg[orow * 64 + 32 + r32] = f2bf(o1[r] * rli[r]); }
    bf16_t* Ow = d.O + (size_t)(q0 + wid * 32) * d.po;
#pragma unroll
    for (int i = 0; i < 4; ++i) { const int row = i * 8 + (lane >> 3), ch = lane & 7; const u32x4 v = *(LAS const u32x4*)(stg + row * 64 + ch * 8); *(u32x4*)(Ow + (size_t)row * d.po + ch * 8) = v; }
    __syncthreads();
}
}

struct Args { const void* in[22]; float* out; unsigned char* ws; int ph_lo, ph_hi, li, pad; };

struct Frame {
    LAS unsigned char* lds;
    int tid, lane, wave, G, gw, NGW;
};

namespace pg8 {
struct EpiProj {
    static constexpr bool PERM = true, AFTER_DRAIN = false;
    bf16_t* P; float* FL;
    __device__ __forceinline__ void operator()(const f32x4 (&acc)[2][2][4][2], const Unit& u, int wr, int wc, int fr, int fq) const {
        const int row0 = u.pm * BM + wr * 64 + fr, col0 = u.pn * BM + wc * 32 + 8 * fq;
#pragma unroll
        for (int ai = 0; ai < 2; ++ai)
#pragma unroll
            for (int m = 0; m < 4; ++m) { const int row = row0 + ai * HALF + m * 16; bf16_t* rowp = P + (size_t)row * PP + col0;
#pragma unroll
                for (int bj = 0; bj < 2; ++bj) { const f32x4 v0 = acc[ai][bj][m][0], v1 = acc[ai][bj][m][1];
                    if (col0 + bj * HALF == C_FL) { float* f = FL + (size_t)row * 8; *(f32x4*)f = v0; *(f32x4*)(f + 4) = v1; }
                    u32x4 w; w.x = cvt_pk_bf16(v0[0], v0[1]); w.y = cvt_pk_bf16(v0[2], v0[3]); w.z = cvt_pk_bf16(v1[0], v1[1]); w.w = cvt_pk_bf16(v1[2], v1[3]);
                    *(u32x4*)(rowp + bj * HALF) = w; } }
    }
};
struct EpiStore {
    static constexpr bool PERM = true, AFTER_DRAIN = false;
    bf16_t* O; int ldc;
    __device__ __forceinline__ void operator()(const f32x4 (&acc)[2][2][4][2], const Unit& u, int wr, int wc, int fr, int fq) const {
        const int row0 = u.pm * BM + wr * 64 + fr, col0 = u.pn * BM + wc * 32 + 8 * fq;
#pragma unroll
        for (int ai = 0; ai < 2; ++ai)
#pragma unroll
            for (int m = 0; m < 4; ++m) { bf16_t* rowp = O + (size_t)(row0 + ai * HALF + m * 16) * ldc + col0;
#pragma unroll
                for (int bj = 0; bj < 2; ++bj) { const f32x4 v0 = acc[ai][bj][m][0], v1 = acc[ai][bj][m][1];
                    u32x4 w; w.x = cvt_pk_bf16(v0[0], v0[1]); w.y = cvt_pk_bf16(v0[2], v0[3]); w.z = cvt_pk_bf16(v1[0], v1[1]); w.w = cvt_pk_bf16(v1[2], v1[3]);
                    *(u32x4*)(rowp + bj * HALF) = w; } }
    }
};
struct EpiResid {
    static constexpr bool PERM = false, AFTER_DRAIN = false;
    const float* X; const float* MOD; float* out;
    __device__ __forceinline__ void operator()(const f32x4 (&acc)[2][2][4][2], const Unit& u, int wr, int wc, int fr, int fq) const {
        const int row0 = u.pm * BM + wr * 64 + fr, col0 = u.pn * BM + wc * 32 + 4 * fq;
        const int b = (u.pm * BM) / S_;
        f32x4 gv[2][2];
#pragma unroll
        for (int bj = 0; bj < 2; ++bj)
#pragma unroll
            for (int n = 0; n < 2; ++n) gv[bj][n] = *(const f32x4*)(MOD + b * 6144 + 2 * 1024 + col0 + bj * HALF + n * 16);
#pragma unroll
        for (int ai = 0; ai < 2; ++ai)
#pragma unroll
            for (int m = 0; m < 4; ++m) { const size_t off = (size_t)(row0 + ai * HALF + m * 16) * 1024 + col0;
#pragma unroll
                for (int bj = 0; bj < 2; ++bj)
#pragma unroll
                    for (int n = 0; n < 2; ++n) { const f32x4 xv = *(const f32x4*)(X + off + bj * HALF + n * 16); *(f32x4*)(out + off + bj * HALF + n * 16) = xv + gv[bj][n] * acc[ai][bj][m][n]; } }
    }
};
}

__device__ __forceinline__ void p0_transpose_item(const float* W, int K, int N, int Npad, bf16_t* WT, LAS float* scr, int item, int lane) {
    const int nblk = Npad / 32, kb = item / nblk, nb = item % nblk, k0 = 64 * kb, n0 = 32 * nb;
    const int nn = n0 + (lane & 31);
#pragma unroll 8
    for (int i = 0; i < 32; ++i) { const int kk = 2 * i + (lane >> 5); scr[kk * 33 + (lane & 31)] = nn < N ? W[(size_t)(k0 + kk) * N + nn] : 0.f; }
    asm volatile("s_waitcnt lgkmcnt(0)" ::: "memory");
    const int c = lane & 7;
#pragma unroll
    for (int j = 0; j < 4; ++j) { const int n = (lane >> 3) + 8 * j; const LAS float* s = scr + (8 * c) * 33 + n;
        u32x4 o; o.x = pk2(s[0 * 33], s[1 * 33]); o.y = pk2(s[2 * 33], s[3 * 33]); o.z = pk2(s[4 * 33], s[5 * 33]); o.w = pk2(s[6 * 33], s[7 * 33]);
        *(u32x4*)(WT + (size_t)(n0 + n) * K + k0 + 8 * c) = o; }
    asm volatile("s_waitcnt lgkmcnt(0)" ::: "memory");
}
__device__ __forceinline__ void p0_mod_item(const float* c, const float* w_ada, const float* b_ada, float* mod, LAS float* scr, int item, int lane) {
    for (int i = lane; i < 4096; i += 64) { const int b = i >> 10, k = i & 1023; const float cv = c[i]; scr[k * 4 + b] = cv / (1.f + expf(-cv)); }
    asm volatile("s_waitcnt lgkmcnt(0)" ::: "memory");
    const int j = item * 64 + lane;
    float a0 = 0.f, a1 = 0.f, a2 = 0.f, a3 = 0.f;
#pragma unroll 8
    for (int k = 0; k < 1024; ++k) { const float w = w_ada[(size_t)k * 6144 + j]; const f32x4 s = *(const LAS f32x4*)(scr + k * 4); a0 += s[0] * w; a1 += s[1] * w; a2 += s[2] * w; a3 += s[3] * w; }
    const float bb = b_ada[j];
    mod[0 * 6144 + j] = a0 + bb; mod[1 * 6144 + j] = a1 + bb; mod[2 * 6144 + j] = a2 + bb; mod[3 * 6144 + j] = a3 + bb;
    asm volatile("s_waitcnt lgkmcnt(0)" ::: "memory");
}

__device__ __forceinline__ void modrow(const float* X, const float* g, const float* mod, int shift_idx, int scale_idx, bf16_t* out, int row, int lane) {
    const int b = row / S_;
    const float4* xr = (const float4*)(X + (size_t)row * 1024) + lane;
    float4 v[4]; float ss = 0.f;
#pragma unroll
    for (int j = 0; j < 4; ++j) { v[j] = xr[64 * j]; ss += (v[j].x * v[j].x + v[j].y * v[j].y) + (v[j].z * v[j].z + v[j].w * v[j].w); }
    ss = wave_sum(ss);
    const float r = rsqrtf(ss * (1.f / 1024.f) + EPS);
    const float* sh = mod + b * 6144 + shift_idx * 1024; const float* sc = mod + b * 6144 + scale_idx * 1024;
#pragma unroll
    for (int j = 0; j < 4; ++j) {
        const int col = 4 * lane + 256 * j;
        const float4 g4 = *(const float4*)(g + col), s4 = *(const float4*)(sc + col), h4 = *(const float4*)(sh + col);
        const float o0 = v[j].x * r * g4.x * (1.f + s4.x) + h4.x, o1 = v[j].y * r * g4.y * (1.f + s4.y) + h4.y;
        const float o2 = v[j].z * r * g4.z * (1.f + s4.z) + h4.z, o3 = v[j].w * r * g4.w * (1.f + s4.w) + h4.w;
        uint2 w; w.x = pk2(o0, o1); w.y = pk2(o2, o3);
        *(uint2*)(out + (size_t)row * 1024 + col) = w;
    }
}

__global__ void __launch_bounds__(NWAVES * 64, 2) mega_fwd(Args args) {
    extern __shared__ __attribute__((aligned(16))) unsigned char lds[];
    Frame F;
    F.lds = (LAS unsigned char*)lds;
    volatile LAS unsigned* MISC = (volatile LAS unsigned*)(F.lds + MISC_OFF);
    F.tid = threadIdx.x; F.lane = F.tid & 63; F.wave = __builtin_amdgcn_readfirstlane(F.tid >> 6);
    F.G = gridDim.x; F.gw = blockIdx.x * NWAVES + F.wave; F.NGW = F.G * NWAVES;
    unsigned char* ws = args.ws;
    unsigned* ctl = (unsigned*)(ws + WS_CTL);
    const float* x = (const float*)args.in[0]; const float* c = (const float*)args.in[1]; const int* positions = (const int*)args.in[2];
    const float* w_ada = (const float*)args.in[3]; const float* b_ada = (const float*)args.in[4]; const float* norm1_g = (const float*)args.in[5];
    const float* w_in = (const float*)args.in[6]; const float* mla_qa_g = (const float*)args.in[7]; const float* mla_kva_g = (const float*)args.in[8];
    const float* w_uq = (const float*)args.in[9]; const float* w_ukv = (const float*)args.in[10]; const float* mla_q_g = (const float*)args.in[11];
    const float* mla_k_g = (const float*)args.in[12]; const float* fox_q_g = (const float*)args.in[13]; const float* fox_k_g = (const float*)args.in[14];
    const float* b_f = (const float*)args.in[15]; const float* w_o = (const float*)args.in[16]; const float* norm2_g = (const float*)args.in[17];
    const float* w_pq = (const float*)args.in[18]; const float* sub_keys = (const float*)args.in[19]; const float* peer_u = (const float*)args.in[20]; const float* peer_v = (const float*)args.in[21];
    float* out = args.out;
    float* MOD = (float*)(ws + WS_MOD); float* FL = (float*)(ws + WS_FL); float* FCUM = (float*)(ws + WS_FCUM); float* LOGF = (float*)(ws + WS_LOGF); float2* ROPE = (float2*)(ws + WS_ROPE);
    bf16_t* XN = (bf16_t*)(ws + WS_XN); bf16_t* PROJ = (bf16_t*)(ws + WS_PROJ); bf16_t* KVRAW = (bf16_t*)(ws + WS_KVRAW); bf16_t* QA = (bf16_t*)(ws + WS_QA); bf16_t* KA = (bf16_t*)(ws + WS_KA);
    bf16_t* WIN = (bf16_t*)(ws + WS_WIN); bf16_t* WUQ = (bf16_t*)(ws + WS_WUQ); bf16_t* WUKV = (bf16_t*)(ws + WS_WUKV); bf16_t* WO = (bf16_t*)(ws + WS_WO); bf16_t* WPQ = (bf16_t*)(ws + WS_WPQ);
    bf16_t* OB = XN; bf16_t* H2 = XN; bf16_t* QP = PROJ; int* EID = (int*)(ws + WS_QA); float* GATE = (float*)(ws + WS_QA + 16 * MiB);
    (void)sub_keys; (void)peer_u; (void)peer_v; (void)positions; (void)KA; (void)FCUM; (void)LOGF; (void)ROPE; (void)mla_q_g; (void)mla_k_g; (void)b_f; (void)fox_q_g; (void)fox_k_g; (void)mla_qa_g; (void)mla_kva_g;

    for (int u = F.tid; u < (LDS_BYTES - LDSCTL_OFF) / 4; u += NWAVES * 64) ((LAS unsigned*)(F.lds + LDSCTL_OFF))[u] = 0u;
    __syncthreads();
    const int lo = args.ph_lo, hi = args.ph_hi;
    XcdBarrier bar; bar.bar = ctl + CW_BAR + args.li * XCD_BAR_WORDS; bar.x = 0; bar.st = nullptr;
    if (hi - lo > 1) bar = xcd_barrier_post(ctl + CW_BAR + args.li * XCD_BAR_WORDS, MISC + 8);
#define IN(k) (lo <= (k) && (k) < hi)
#define SEAM(k) do { if (IN(k) && IN((k) + 1)) xcd_barrier(bar); } while (0)

    if (IN(0)) {
        LAS float* scr = (LAS float*)(F.lds + F.wave * 16384);
        constexpr int I_MOD = 96, I_IN = 16 * 72, I_UQ = 6 * 24, I_UKV = 4 * 32, I_O = 16 * 32, I_PQ = 16 * 64;
        constexpr int NITEMS = I_MOD + I_IN + I_UQ + I_UKV + I_O + I_PQ;
        for (int it = F.gw; it < NITEMS; it += F.NGW) {
            int r = it;
            if (r < I_MOD) { p0_mod_item(c, w_ada, b_ada, MOD, scr, r, F.lane); continue; } r -= I_MOD;
            if (r < I_IN) { p0_transpose_item(w_in, 1024, INW, PP, WIN, scr, r, F.lane); continue; } r -= I_IN;
            if (r < I_UQ) { p0_transpose_item(w_uq, 384, 768, 768, WUQ, scr, r, F.lane); continue; } r -= I_UQ;
            if (r < I_UKV) { p0_transpose_item(w_ukv, 256, 1024, 1024, WUKV, scr, r, F.lane); continue; } r -= I_UKV;
            if (r < I_O) { p0_transpose_item(w_o, 1024, 1024, 1024, WO, scr, r, F.lane); continue; } r -= I_O;
            p0_transpose_item(w_pq, 1024, 2048, 2048, WPQ, scr, r, F.lane);
        }
    }
    SEAM(0);
    if (IN(1)) { for (int row = F.gw; row < T_; row += F.NGW) modrow(x, norm1_g, MOD, 0, 1, XN, row, F.lane); }
    SEAM(1);
    if (IN(2)) {
        pg8::Gemm g{XN, WIN, T_, PP, 1024, 1024}; pg8::StaticOrder S; S.init(T_, PP, F.G, (int)blockIdx.x);
        pg8::EpiProj E{PROJ, FL};
        pg8::gemm_phase<pg8::EpiProj, pg8::StaticOrder, true, true>(F.lds, g, S, E);
    }
    SEAM(2);
    if (IN(3)) { for (int row = F.gw; row < T_; row += F.NGW) rowprep_row(PROJ, FL, mla_qa_g, mla_kva_g, fox_q_g, fox_k_g, b_f, positions, LOGF, ROPE, row, F.lane); }
    SEAM(3);
    if (IN(4)) {
        { pg8::Gemm g{PROJ + C_CQ, WUQ, T_, 768, 384, PP}; pg8::StaticOrder S; S.init(T_, 768, F.G, (int)blockIdx.x); pg8::EpiStore E{QA, 768};
          pg8::gemm_phase<pg8::EpiStore, pg8::StaticOrder, true, true>(F.lds, g, S, E); }
        { pg8::Gemm g{PROJ + C_CKV, WUKV, T_, 1024, 256, PP}; pg8::StaticOrder S; S.init(T_, 1024, F.G, (int)blockIdx.x); pg8::EpiStore E{KVRAW, 1024};
          pg8::gemm_phase<pg8::EpiStore, pg8::StaticOrder, true, true>(F.lds, g, S, E); }
    }
    SEAM(4);
    if (IN(5)) {
        if (F.gw < 32) fcum_item(LOGF, FCUM, F.gw, F.lane);
        for (int row = F.gw; row < T_; row += F.NGW) mlaprep_row(QA, KVRAW, PROJ, KA, ROPE, mla_q_g, mla_k_g, row, F.lane);
    }
    SEAM(5);
    if (IN(6)) {
        const int nunits = 1024;
        for (int grp = 0; grp < 2; ++grp)
            for (int i = 0;; ++i) {
                int bh, qb;
                if (F.G == 256) { if (i >= 4) break; const int v = ((int)blockIdx.x % 8) * 32 + (int)blockIdx.x / 8, s = v & 7; bh = v >> 3; qb = (i == 0) ? s : (i == 1) ? 15 - s : (i == 2) ? 16 + s : 31 - s; }
                else { const int u = i * F.G + (int)blockIdx.x; if (u >= nunits) break; bh = u & 31; qb = 31 - (u >> 5); }
                const int b = bh >> 3, h = bh & 7;
                if (grp == 0) { const att::Desc d{QA + (size_t)b * S_ * 768 + h * 96, 768, KA + (size_t)b * S_ * 768 + h * 96, 768, KVRAW + (size_t)b * S_ * 1024 + h * 128 + 64, 1024, OB + (size_t)b * S_ * 1024 + h * 64, 1024, nullptr};
                    att::attn_unit<6, false>(d, qb, 0, F.lds); }
                else { const bf16_t* pb = PROJ + (size_t)b * S_ * PP + h * 64; const att::Desc d{pb + C_FQ, PP, pb + C_FK, PP, pb + C_FV, PP, OB + (size_t)b * S_ * 1024 + 512 + h * 64, 1024, FCUM + (size_t)(b * 8 + h) * S_};
                    att::attn_unit<4, true>(d, qb, 0, F.lds); }
            }
    }
    SEAM(6);
    if (IN(7)) {
        pg8::Gemm g{OB, WO, T_, 1024, 1024, 1024}; pg8::StaticOrder S; S.init(T_, 1024, F.G, (int)blockIdx.x);
        pg8::EpiResid E{x, MOD, out};
        pg8::gemm_phase<pg8::EpiResid, pg8::StaticOrder, true, true>(F.lds, g, S, E);
    }
    SEAM(7);
    if (IN(8)) { for (int row = F.gw; row < T_; row += F.NGW) modrow(out, norm2_g, MOD, 3, 4, H2, row, F.lane); }
    SEAM(8);
    if (IN(9)) {
        pg8::Gemm g{H2, WPQ, T_, 2048, 1024, 1024}; pg8::StaticOrder S; S.init(T_, 2048, F.G, (int)blockIdx.x); pg8::EpiStore E{QP, 2048};
        pg8::gemm_phase<pg8::EpiStore, pg8::StaticOrder, true, true>(F.lds, g, S, E);
    }
    SEAM(9);
    if (IN(10)) { for (int w = F.gw; w < T_ * 8; w += F.NGW) topk_item(QP, sub_keys, EID, GATE, w, F.lane); }
    SEAM(10);
    if (IN(11)) { for (int t = F.gw; t < T_; t += F.NGW) gather_item(H2, EID, GATE, peer_u, peer_v, MOD, out, t, F.lane); }
#undef IN
#undef SEAM
}

static int g_grid = 0;
static void launch_mega(const Args& base, int lo, int hi, int li, hipStream_t stream) {
    Args a = base; a.ph_lo = lo; a.ph_hi = hi; a.li = li;
    hipLaunchKernelGGL(mega_fwd, dim3(g_grid), dim3(NWAVES * 64), LDS_BYTES, stream, a);
}

extern "C" void kernel_launch(void* const* d_in, const int* in_sizes, int n_in, void* d_out, int out_size, void* d_ws, size_t ws_size, hipStream_t stream) {
    if (g_grid == 0) {
        int dev = 0, cus = 0;
        hipGetDevice(&dev); hipDeviceGetAttribute(&cus, hipDeviceAttributeMultiprocessorCount, dev);
        hipFuncSetAttribute((const void*)mega_fwd, hipFuncAttributeMaxDynamicSharedMemorySize, LDS_BYTES);
        int per_cu = 0; hipOccupancyMaxActiveBlocksPerMultiprocessor(&per_cu, (const void*)mega_fwd, NWAVES * 64, LDS_BYTES);
        (void)hipGetLastError();
        g_grid = cus > 0 ? cus : 256;
        if (per_cu < 1) fprintf(stderr, "kernel_launch: occupancy query says %d blocks/CU\n", per_cu);
    }
    const float* x = (const float*)d_in[0]; const int* positions = (const int*)d_in[2];
    const float* mla_qa_g = (const float*)d_in[7]; const float* mla_kva_g = (const float*)d_in[8];
    const float* mla_q_g = (const float*)d_in[11]; const float* mla_k_g = (const float*)d_in[12]; const float* fox_q_g = (const float*)d_in[13]; const float* fox_k_g = (const float*)d_in[14];
    const float* b_f = (const float*)d_in[15]; const float* sub_keys = (const float*)d_in[19]; const float* peer_u = (const float*)d_in[20]; const float* peer_v = (const float*)d_in[21];
    float* out = (float*)d_out; unsigned char* ws = (unsigned char*)d_ws;
    float* MOD = (float*)(ws + WS_MOD); float* FL = (float*)(ws + WS_FL); float* FCUM = (float*)(ws + WS_FCUM); float* LOGF = (float*)(ws + WS_LOGF); float2* ROPE = (float2*)(ws + WS_ROPE);
    bf16_t* XN = (bf16_t*)(ws + WS_XN); bf16_t* PROJ = (bf16_t*)(ws + WS_PROJ); bf16_t* KVRAW = (bf16_t*)(ws + WS_KVRAW); bf16_t* QA = (bf16_t*)(ws + WS_QA); bf16_t* KA = (bf16_t*)(ws + WS_KA);
    bf16_t* OB = XN; bf16_t* H2 = XN; bf16_t* QP = PROJ; int* EID = (int*)(ws + WS_QA); float* GATE = (float*)(ws + WS_QA + 16 * MiB);
    (void)x;
    hipMemsetAsync(ws + WS_CTL, 0, CTL_ZERO_BYTES, stream);
    Args base{}; for (int i = 0; i < 22; ++i) base.in[i] = d_in[i]; base.out = out; base.ws = ws;

    launch_mega(base, 0, 12, 0, stream);
}
```

```cpp
#include <hip/hip_runtime.h>
#include <cstdint>
#include <cstdio>
#include <cmath>

typedef unsigned short bf16_t;
constexpr int B_ = 4, S_ = 8192, D_ = 1024, T_ = B_ * S_;
constexpr int PP = 2304;
constexpr int C_CQ = 0, C_CKV = 384, C_KPE = 640, C_FQ = 672, C_FK = 1184, C_FV = 1696, C_FL = 2208, INW = 2216;
constexpr float EPS = 1e-6f;
constexpr float LOG2E = 1.4426950408889634f;
constexpr float C2A = 0.10206207261596577f * LOG2E;
constexpr float C2F = 0.125f * LOG2E;

__device__ __forceinline__ float bf2f(bf16_t v) { return __uint_as_float(((unsigned)v) << 16); }
__device__ __forceinline__ bf16_t f2bf(float f) { unsigned u = __float_as_uint(f); return (bf16_t)((u + 0x7fffu + ((u >> 16) & 1u)) >> 16); }
__device__ __forceinline__ unsigned pk2(float lo, float hi) { return (unsigned)f2bf(lo) | ((unsigned)f2bf(hi) << 16); }
__device__ __forceinline__ float lo2f(unsigned w) { return __uint_as_float(w << 16); }
__device__ __forceinline__ float hi2f(unsigned w) { return __uint_as_float(w & 0xffff0000u); }
__device__ __forceinline__ float wave_sum(float v) {
#pragma unroll
    for (int o = 1; o < 64; o <<= 1) v += __shfl_xor(v, o);
    return v;
}

constexpr size_t MiB = 1u << 20;
constexpr size_t WS_MOD = 1 * MiB;
constexpr size_t WS_FL = 3 * MiB;
constexpr size_t WS_FCUM = 4 * MiB;
constexpr size_t WS_LOGF = 5 * MiB;
constexpr size_t WS_ROPE = 6 * MiB;
constexpr size_t WS_XN = 88 * MiB;
constexpr size_t WS_PROJ = 152 * MiB;
constexpr size_t WS_KVRAW = 296 * MiB;
constexpr size_t WS_QA = 360 * MiB;
constexpr size_t WS_KA = 408 * MiB;

__global__ void k_mod(const float* c, const float* w_ada, const float* b_ada, float* mod) {
    const int j = blockIdx.x * 256 + threadIdx.x, b = blockIdx.y;
    float acc = b_ada[j];
    for (int k = 0; k < 1024; ++k) { const float cv = c[b * 1024 + k]; const float s = cv / (1.f + expf(-cv)); acc += s * w_ada[(size_t)k * 6144 + j]; }
    mod[b * 6144 + j] = acc;
}

__global__ void __launch_bounds__(256) k_modrows(const float* X, const float* g, const float* mod, int shift_idx, int scale_idx, bf16_t* out) {
    const int wave = threadIdx.x >> 6, lane = threadIdx.x & 63;
    const int row = blockIdx.x * 4 + wave, b = row / S_;
    const float4* xr = (const float4*)(X + (size_t)row * 1024) + lane;
    float4 v[4]; float ss = 0.f;
#pragma unroll
    for (int j = 0; j < 4; ++j) { v[j] = xr[64 * j]; ss += (v[j].x * v[j].x + v[j].y * v[j].y) + (v[j].z * v[j].z + v[j].w * v[j].w); }
    ss = wave_sum(ss);
    const float r = rsqrtf(ss * (1.f / 1024.f) + EPS);
    const float* sh = mod + b * 6144 + shift_idx * 1024; const float* sc = mod + b * 6144 + scale_idx * 1024;
#pragma unroll
    for (int j = 0; j < 4; ++j) {
        const int col = 4 * lane + 256 * j;
        const float4 g4 = *(const float4*)(g + col), s4 = *(const float4*)(sc + col), h4 = *(const float4*)(sh + col);
        const float o0 = v[j].x * r * g4.x * (1.f + s4.x) + h4.x, o1 = v[j].y * r * g4.y * (1.f + s4.y) + h4.y;
        const float o2 = v[j].z * r * g4.z * (1.f + s4.z) + h4.z, o3 = v[j].w * r * g4.w * (1.f + s4.w) + h4.w;
        uint2 w; w.x = pk2(o0, o1); w.y = pk2(o2, o3);
        *(uint2*)(out + (size_t)row * 1024 + col) = w;
    }
}

template <int MODE>
__global__ void __launch_bounds__(256) k_gemm_naive(const bf16_t* A, int lda, const float* W, int K, int N, void* Cout, int ldc, const float* aux1, const float* aux2, float* fl) {
    __shared__ float As[16][64];
    __shared__ float Ws[16][64];
    const int tx = threadIdx.x & 15, ty = threadIdx.x >> 4;
    const int m0 = blockIdx.y * 64, n0 = blockIdx.x * 64;
    float acc[4][4];
#pragma unroll
    for (int i = 0; i < 4; ++i)
#pragma unroll
        for (int j = 0; j < 4; ++j) acc[i][j] = 0.f;
    for (int k0 = 0; k0 < K; k0 += 16) {
        { const int r = threadIdx.x >> 2, kq = (threadIdx.x & 3) * 4; const uint2 a2 = *(const uint2*)(A + (size_t)(m0 + r) * lda + k0 + kq);
          As[kq + 0][r] = lo2f(a2.x); As[kq + 1][r] = hi2f(a2.x); As[kq + 2][r] = lo2f(a2.y); As[kq + 3][r] = hi2f(a2.y); }
        { const int kk = threadIdx.x >> 4, nq = (threadIdx.x & 15) * 4; float4 w4 = make_float4(0.f, 0.f, 0.f, 0.f);
          if (n0 + nq < N) w4 = *(const float4*)(W + (size_t)(k0 + kk) * N + n0 + nq);
          *(float4*)&Ws[kk][nq] = w4; }
        __syncthreads();
#pragma unroll
        for (int kk = 0; kk < 16; ++kk) {
            const float4 a4 = *(const float4*)&As[kk][ty * 4]; const float4 w4 = *(const float4*)&Ws[kk][tx * 4];
            const float a[4] = {a4.x, a4.y, a4.z, a4.w}; const float w[4] = {w4.x, w4.y, w4.z, w4.w};
#pragma unroll
            for (int i = 0; i < 4; ++i)
#pragma unroll
                for (int j = 0; j < 4; ++j) acc[i][j] += a[i] * w[j];
        }
        __syncthreads();
    }
#pragma unroll
    for (int i = 0; i < 4; ++i) {
        const int m = m0 + ty * 4 + i;
#pragma unroll
        for (int j = 0; j < 4; ++j) {
            const int n = n0 + tx * 4 + j;
            if (n < N) {
                if (MODE == 0) ((bf16_t*)Cout)[(size_t)m * ldc + n] = f2bf(acc[i][j]);
                else if (MODE == 1) { if (n < C_FL) ((bf16_t*)Cout)[(size_t)m * ldc + n] = f2bf(acc[i][j]); else fl[(size_t)m * 8 + (n - C_FL)] = acc[i][j]; }
                else { const int b = m / S_; ((float*)Cout)[(size_t)m * ldc + n] = aux1[(size_t)m * 1024 + n] + aux2[b * 6144 + 2 * 1024 + n] * acc[i][j]; }
            }
        }
    }
}

__device__ __forceinline__ void unpack8(const uint4 raw, float* v) {
    v[0] = lo2f(raw.x); v[1] = hi2f(raw.x); v[2] = lo2f(raw.y); v[3] = hi2f(raw.y); v[4] = lo2f(raw.z); v[5] = hi2f(raw.z); v[6] = lo2f(raw.w); v[7] = hi2f(raw.w);
}
__device__ __forceinline__ void rowprep_row(bf16_t* PROJ, const float* FL, const float* g_qa, const float* g_kva, const float* g_fq, const float* g_fk, const float* b_f,
                                                 const int* positions, float* LOGF, float2* ROPE, int row, int lane) {
    bf16_t* pr = PROJ + (size_t)row * PP;
    float v[8];
    {
        float ss = 0.f;
        if (lane < 48) { unpack8(*(const uint4*)(pr + C_CQ + lane * 8), v);
#pragma unroll
            for (int i = 0; i < 8; ++i) ss += v[i] * v[i]; }
        ss = wave_sum(ss);
        const float r = rsqrtf(ss * (1.f / 384.f) + EPS);
        if (lane < 48) { const float* g = g_qa + lane * 8; uint4 o;
            o.x = pk2(v[0] * r * g[0], v[1] * r * g[1]); o.y = pk2(v[2] * r * g[2], v[3] * r * g[3]); o.z = pk2(v[4] * r * g[4], v[5] * r * g[5]); o.w = pk2(v[6] * r * g[6], v[7] * r * g[7]);
            *(uint4*)(pr + C_CQ + lane * 8) = o; }
    }
    {
        float ss = 0.f;
        if (lane < 32) { unpack8(*(const uint4*)(pr + C_CKV + lane * 8), v);
#pragma unroll
            for (int i = 0; i < 8; ++i) ss += v[i] * v[i]; }
        ss = wave_sum(ss);
        const float r = rsqrtf(ss * (1.f / 256.f) + EPS);
        if (lane < 32) { const float* g = g_kva + lane * 8; uint4 o;
            o.x = pk2(v[0] * r * g[0], v[1] * r * g[1]); o.y = pk2(v[2] * r * g[2], v[3] * r * g[3]); o.z = pk2(v[4] * r * g[4], v[5] * r * g[5]); o.w = pk2(v[6] * r * g[6], v[7] * r * g[7]);
            *(uint4*)(pr + C_CKV + lane * 8) = o; }
    }
#pragma unroll
    for (int which = 0; which < 2; ++which) {
        const int coff = which == 0 ? C_FQ : C_FK; const float* g = (which == 0 ? g_fq : g_fk) + (lane & 7) * 8; const float sc = which == 0 ? C2F : 1.f;
        unpack8(*(const uint4*)(pr + coff + lane * 8), v);
        float ss = 0.f;
#pragma unroll
        for (int i = 0; i < 8; ++i) ss += v[i] * v[i];
        ss += __shfl_xor(ss, 1); ss += __shfl_xor(ss, 2); ss += __shfl_xor(ss, 4);
        const float r = rsqrtf(ss * (1.f / 64.f) + EPS) * sc; uint4 o;
        o.x = pk2(v[0] * r * g[0], v[1] * r * g[1]); o.y = pk2(v[2] * r * g[2], v[3] * r * g[3]); o.z = pk2(v[4] * r * g[4], v[5] * r * g[5]); o.w = pk2(v[6] * r * g[6], v[7] * r * g[7]);
        *(uint4*)(pr + coff + lane * 8) = o;
    }
    if (lane < 8) { const float z = FL[(size_t)row * 8 + lane] + b_f[lane]; LOGF[(size_t)row * 8 + lane] = fminf(z, 0.f) - log1pf(expf(-fabsf(z))); }
    if (lane < 16) { const float inv = powf(10000.f, -(float)lane / 16.f); const float ang = (float)positions[row] * inv; float sn, cs; sincosf(ang, &sn, &cs); ROPE[(size_t)row * 16 + lane] = make_float2(cs, sn); }
}

__global__ void __launch_bounds__(256) k_rowprep(bf16_t* PROJ, const float* FL, const float* g_qa, const float* g_kva, const float* g_fq, const float* g_fk, const float* b_f,
                                                 const int* positions, float* LOGF, float2* ROPE) {
    rowprep_row(PROJ, FL, g_qa, g_kva, g_fq, g_fk, b_f, positions, LOGF, ROPE, blockIdx.x * 4 + (threadIdx.x >> 6), threadIdx.x & 63);
}

__device__ __forceinline__ void fcum_item(const float* LOGF, float* FCUM, int item, int lane) {
    const int b = item >> 3, h = item & 7;
    const float* src = LOGF + ((size_t)b * S_) * 8 + h;
    float tot = 0.f;
    for (int i = 0; i < 128; ++i) tot += src[(size_t)(128 * lane + i) * 8];
    float incl = tot;
#pragma unroll
    for (int o = 1; o < 64; o <<= 1) { const float t = __shfl_up(incl, o); if (lane >= o) incl += t; }
    float run = incl - tot;
    float* dst = FCUM + ((size_t)(b * 8 + h)) * S_ + 128 * lane;
    for (int i = 0; i < 128; ++i) { run += src[(size_t)(128 * lane + i) * 8]; dst[i] = run; }
}
__global__ void __launch_bounds__(64) k_fcum(const float* LOGF, float* FCUM) { fcum_item(LOGF, FCUM, blockIdx.x, threadIdx.x); }

__device__ __forceinline__ void mlaprep_row(bf16_t* QRAW, const bf16_t* KVRAW, const bf16_t* PROJ, bf16_t* KA, const float2* ROPE, const float* g_q, const float* g_k, int row, int lane) {
    const int h = lane >> 3, p = lane & 7;
    const float2 cs0 = ROPE[(size_t)row * 16 + 2 * p], cs1 = ROPE[(size_t)row * 16 + 2 * p + 1];
#pragma unroll
    for (int which = 0; which < 2; ++which) {
        const float* g = which == 0 ? g_q : g_k; const float sc = which == 0 ? C2A : 1.f;
        float v[8]; unsigned r1, r2;
        if (which == 0) { const bf16_t* q = QRAW + (size_t)row * 768 + h * 96; unpack8(*(const uint4*)(q + 8 * p), v); r1 = *(const unsigned*)(q + 64 + 2 * p); r2 = *(const unsigned*)(q + 80 + 2 * p); }
        else { unpack8(*(const uint4*)(KVRAW + (size_t)row * 1024 + h * 128 + 8 * p), v); const bf16_t* kp = PROJ + (size_t)row * PP + C_KPE; r1 = *(const unsigned*)(kp + 2 * p); r2 = *(const unsigned*)(kp + 16 + 2 * p); }
        float a0 = lo2f(r1), a1 = hi2f(r1), b0 = lo2f(r2), b1 = hi2f(r2);
        float ss = a0 * a0 + a1 * a1 + b0 * b0 + b1 * b1;
#pragma unroll
        for (int i = 0; i < 8; ++i) ss += v[i] * v[i];
        ss += __shfl_xor(ss, 1); ss += __shfl_xor(ss, 2); ss += __shfl_xor(ss, 4);
        const float r = rsqrtf(ss * (1.f / 96.f) + EPS);
        const float* gn = g + 8 * p;
        a0 *= r * g[64 + 2 * p]; a1 *= r * g[64 + 2 * p + 1]; b0 *= r * g[80 + 2 * p]; b1 *= r * g[80 + 2 * p + 1];
        const float ra0 = a0 * cs0.x - b0 * cs0.y, rb0 = b0 * cs0.x + a0 * cs0.y, ra1 = a1 * cs1.x - b1 * cs1.y, rb1 = b1 * cs1.x + a1 * cs1.y;
        uint4 o; o.x = pk2(v[0] * r * gn[0] * sc, v[1] * r * gn[1] * sc); o.y = pk2(v[2] * r * gn[2] * sc, v[3] * r * gn[3] * sc);
        o.z = pk2(v[4] * r * gn[4] * sc, v[5] * r * gn[5] * sc); o.w = pk2(v[6] * r * gn[6] * sc, v[7] * r * gn[7] * sc);
        bf16_t* dst = (which == 0 ? QRAW : KA) + (size_t)row * 768 + h * 96;
        *(uint4*)(dst + 8 * p) = o; *(unsigned*)(dst + 64 + 2 * p) = pk2(ra0 * sc, ra1 * sc); *(unsigned*)(dst + 80 + 2 * p) = pk2(rb0 * sc, rb1 * sc);
    }
}

__global__ void __launch_bounds__(256) k_mlaprep(bf16_t* QRAW, const bf16_t* KVRAW, const bf16_t* PROJ, bf16_t* KA, const float2* ROPE, const float* g_q, const float* g_k) {
    mlaprep_row(QRAW, KVRAW, PROJ, KA, ROPE, g_q, g_k, blockIdx.x * 4 + (threadIdx.x >> 6), threadIdx.x & 63);
}

template <int DK>
__global__ void __launch_bounds__(256) k_attn_naive(const bf16_t* Q, int pq, int qstep, const bf16_t* K, int pk, int kstep, const bf16_t* V, int pv, int vstep, bf16_t* O, int po, int ostep, const float* FCUM) {
    __shared__ float Ks[64][DK];
    __shared__ float Vs[64][64];
    __shared__ float Bs[64];
    const int bh = blockIdx.x >> 5, qb = blockIdx.x & 31, b = bh >> 3, h = bh & 7;
    const int t = qb * 256 + threadIdx.x;
    const size_t row = (size_t)b * S_ + t;
    float q[DK];
#pragma unroll
    for (int c = 0; c < DK / 8; ++c) unpack8(*(const uint4*)(Q + row * pq + h * qstep + c * 8), q + c * 8);
    float o[64];
#pragma unroll
    for (int d = 0; d < 64; ++d) o[d] = 0.f;
    float m = -INFINITY, l = 0.f;
    const float fq = FCUM ? FCUM[(size_t)(b * 8 + h) * S_ + t] : 0.f;
    const int ntiles = (qb * 256 + 256) / 64;
    for (int kt = 0; kt < ntiles; ++kt) {
        __syncthreads();
        for (int c = threadIdx.x; c < 64 * (DK / 8); c += 256) { const int key = c / (DK / 8), ch = c % (DK / 8); float v[8];
            unpack8(*(const uint4*)(K + ((size_t)b * S_ + kt * 64 + key) * pk + h * kstep + ch * 8), v);
#pragma unroll
            for (int i = 0; i < 8; ++i) Ks[key][ch * 8 + i] = v[i]; }
        for (int c = threadIdx.x; c < 64 * 8; c += 256) { const int key = c >> 3, ch = c & 7; float v[8];
            unpack8(*(const uint4*)(V + ((size_t)b * S_ + kt * 64 + key) * pv + h * vstep + ch * 8), v);
#pragma unroll
            for (int i = 0; i < 8; ++i) Vs[key][ch * 8 + i] = v[i]; }
        if (threadIdx.x < 64) Bs[threadIdx.x] = FCUM ? FCUM[(size_t)(b * 8 + h) * S_ + kt * 64 + threadIdx.x] : 0.f;
        __syncthreads();
        const int kmax = t - kt * 64 + 1;
        for (int kk = 0; kk < 64; ++kk) {
            float s = 0.f;
#pragma unroll
            for (int d = 0; d < DK; ++d) s += q[d] * Ks[kk][d];
            if (FCUM) s += (fq - Bs[kk]) * LOG2E;
            if (kk < kmax) {
                const float mn = fmaxf(m, s), corr = exp2f(m - mn), p = exp2f(s - mn);
                l = l * corr + p;
#pragma unroll
                for (int d = 0; d < 64; ++d) o[d] = o[d] * corr + p * Vs[kk][d];
                m = mn;
            }
        }
    }
    const float rl = 1.f / l;
    bf16_t* op = O + row * po + h * ostep;
#pragma unroll
    for (int c = 0; c < 8; ++c) { uint4 w; w.x = pk2(o[c * 8 + 0] * rl, o[c * 8 + 1] * rl); w.y = pk2(o[c * 8 + 2] * rl, o[c * 8 + 3] * rl); w.z = pk2(o[c * 8 + 4] * rl, o[c * 8 + 5] * rl); w.w = pk2(o[c * 8 + 6] * rl, o[c * 8 + 7] * rl);
        *(uint4*)(op + c * 8) = w; }
}

__device__ __forceinline__ void topk_item(const bf16_t* QP, const float* sub_keys, int* EID, float* GATE, int w, int lane) {
    const int t = w >> 3, h = w & 7;
    float sl0 = 0.f, sl1 = 0.f; int il0 = 0, il1 = 0;
#pragma unroll
    for (int p = 0; p < 2; ++p) {
        const bf16_t* q = QP + (size_t)t * 2048 + h * 256 + p * 128;
        const float* k0 = sub_keys + ((size_t)(h * 2 + p) * 128 + lane) * 128; const float* k1 = k0 + 64 * 128;
        float s0 = 0.f, s1 = 0.f;
        for (int d = 0; d < 128; ++d) { const float qd = bf2f(q[d]); s0 += qd * k0[d]; s1 += qd * k1[d]; }
        float ls = 0.f; int li = 0;
        for (int r = 0; r < 16; ++r) {
            float bv; int bi; if (s0 >= s1) { bv = s0; bi = lane; } else { bv = s1; bi = lane + 64; }
#pragma unroll
            for (int o = 32; o >= 1; o >>= 1) { const float ov = __shfl_xor(bv, o); const int oi = __shfl_xor(bi, o); if (ov > bv || (ov == bv && oi < bi)) { bv = ov; bi = oi; } }
            if (lane == r) { ls = bv; li = bi; }
            if (bi == lane) s0 = -INFINITY; else if (bi == lane + 64) s1 = -INFINITY;
        }
        if (p == 0) { sl0 = ls; il0 = li; } else { sl1 = ls; il1 = li; }
    }
    float cv0, cv1, cv2, cv3;
    { const int c0 = lane, c1 = lane + 64, c2 = lane + 128, c3 = lane + 192;
      cv0 = __shfl(sl0, c0 >> 4) + __shfl(sl1, c0 & 15); cv1 = __shfl(sl0, c1 >> 4) + __shfl(sl1, c1 & 15);
      cv2 = __shfl(sl0, c2 >> 4) + __shfl(sl1, c2 & 15); cv3 = __shfl(sl0, c3 >> 4) + __shfl(sl1, c3 & 15); }
    float tv = -INFINITY; int tc = 0;
    for (int r = 0; r < 16; ++r) {
        float bv = cv0; int bc = lane;
        if (cv1 > bv) { bv = cv1; bc = lane + 64; }
        if (cv2 > bv) { bv = cv2; bc = lane + 128; }
        if (cv3 > bv) { bv = cv3; bc = lane + 192; }
#pragma unroll
        for (int o = 32; o >= 1; o >>= 1) { const float ov = __shfl_xor(bv, o); const int oc = __shfl_xor(bc, o); if (ov > bv || (ov == bv && oc < bc)) { bv = ov; bc = oc; } }
        if (lane == r) { tv = bv; tc = bc; }
        if (bc == lane) cv0 = -INFINITY; else if (bc == lane + 64) cv1 = -INFINITY; else if (bc == lane + 128) cv2 = -INFINITY; else if (bc == lane + 192) cv3 = -INFINITY;
    }
    const float mx = __shfl(tv, 0);
    const float e = lane < 16 ? expf(tv - mx) : 0.f;
    const float sum = wave_sum(e);
    const int e1 = __shfl(il0, (tc >> 4) & 15), e2 = __shfl(il1, tc & 15);
    if (lane < 16) { EID[(size_t)t * 128 + h * 16 + lane] = e1 * 128 + e2; GATE[(size_t)t * 128 + h * 16 + lane] = e / sum; }
}

__global__ void __launch_bounds__(256) k_topk_naive(const bf16_t* QP, const float* sub_keys, int* EID, float* GATE) { topk_item(QP, sub_keys, EID, GATE, blockIdx.x * 4 + (threadIdx.x >> 6), threadIdx.x & 63); }

__device__ __forceinline__ float gelu_tanh(float x) { const float u = 0.7978845608028654f * (x + 0.044715f * x * x * x); return 0.5f * x * (1.f + tanhf(u)); }

__device__ __forceinline__ void gather_item(const bf16_t* H2, const int* EID, const float* GATE, const float* peer_u, const float* peer_v, const float* mod, float* out, int t, int lane) {
    const int b = t / S_;
    float hv[16], y[16];
#pragma unroll
    for (int j = 0; j < 4; ++j) { const uint2 raw = *(const uint2*)(H2 + (size_t)t * 1024 + 4 * lane + 256 * j); hv[4 * j] = lo2f(raw.x); hv[4 * j + 1] = hi2f(raw.x); hv[4 * j + 2] = lo2f(raw.y); hv[4 * j + 3] = hi2f(raw.y); }
#pragma unroll
    for (int i = 0; i < 16; ++i) y[i] = 0.f;
    const int e_a = EID[(size_t)t * 128 + lane], e_b = EID[(size_t)t * 128 + 64 + lane];
    const float g_a = GATE[(size_t)t * 128 + lane], g_b = GATE[(size_t)t * 128 + 64 + lane];
    for (int jj = 0; jj < 128; ++jj) {
        const int e = jj < 64 ? __shfl(e_a, jj) : __shfl(e_b, jj - 64);
        const float g = jj < 64 ? __shfl(g_a, jj) : __shfl(g_b, jj - 64);
        const float4* ur = (const float4*)(peer_u + (size_t)e * 1024) + lane;
        float s = 0.f;
#pragma unroll
        for (int j = 0; j < 4; ++j) { const float4 u4 = ur[64 * j]; s += (u4.x * hv[4 * j] + u4.y * hv[4 * j + 1]) + (u4.z * hv[4 * j + 2] + u4.w * hv[4 * j + 3]); }
        s = wave_sum(s);
        const float wgt = g * gelu_tanh(s);
        const float4* vr = (const float4*)(peer_v + (size_t)e * 1024) + lane;
#pragma unroll
        for (int j = 0; j < 4; ++j) { const float4 v4 = vr[64 * j]; y[4 * j] += wgt * v4.x; y[4 * j + 1] += wgt * v4.y; y[4 * j + 2] += wgt * v4.z; y[4 * j + 3] += wgt * v4.w; }
    }
    const float* g2 = mod + b * 6144 + 5 * 1024;
#pragma unroll
    for (int j = 0; j < 4; ++j) { const int col = 4 * lane + 256 * j; float4* op = (float4*)(out + (size_t)t * 1024 + col); float4 x1 = *op; const float4 gg = *(const float4*)(g2 + col);
        x1.x += gg.x * y[4 * j]; x1.y += gg.y * y[4 * j + 1]; x1.z += gg.z * y[4 * j + 2]; x1.w += gg.w * y[4 * j + 3]; *op = x1; }
}
__global__ void __launch_bounds__(256) k_gather_naive(const bf16_t* H2, const int* EID, const float* GATE, const float* peer_u, const float* peer_v, const float* mod, float* out) {
    gather_item(H2, EID, GATE, peer_u, peer_v, mod, out, blockIdx.x * 4 + (threadIdx.x >> 6), threadIdx.x & 63);
}


namespace pg8 {
#define PG8_LAS __attribute__((address_space(3)))
typedef unsigned short bf16_t;
typedef short bf16x8 __attribute__((ext_vector_type(8)));
typedef float f32x4 __attribute__((ext_vector_type(4)));
typedef unsigned u32x4 __attribute__((ext_vector_type(4)));
constexpr int BM = 256, BK = 64, HALF = 128, HTB = HALF * BK * 2  , STAGE_BYTES = 8 * HTB, NXCD = 8, WGM = 8;

__host__ __device__ __forceinline__ int lds_byte(int r, int c) { const int st = (r >> 4) * 2 + (c >> 5), rr = r & 15, cc = c & 31, ob = rr * 64 + cc * 2; return st * 1024 + (ob ^ (((ob >> 9) & 1) << 5)); }
__host__ __device__ __forceinline__ void stage_rc(int b, int& R, int& C) { const int st = b / 1024, sb = b % 1024, swz = sb ^ (((sb >> 9) & 1) << 5); R = (st >> 1) * 16 + swz / 64; C = (st & 1) * 32 + (swz % 64) / 2; }
__host__ __device__ __forceinline__ int perm32(int rho) { const int n = rho >> 4, i = rho & 15; return 8 * (i >> 2) + 4 * n + (i & 3); }

struct Unit { int pm, pn; };
struct Gemm { const bf16_t* A; const bf16_t* Bt; int M, N, K, lda; };

struct StaticOrder {
    int nM, nN, nwg, G, c;
    __host__ __device__ void init(int M, int N, int G_, int c_) { nM = M / BM; nN = N / BM; nwg = nM * nN; G = G_; c = c_; }
    __host__ __device__ bool next(int i, Unit& u) const {
        const long L = (long)i * G + c; if (L >= nwg) return false;
        int wgid = (int)L; { const int q = nwg / NXCD, r = nwg % NXCD, xcd = wgid % NXCD, off = wgid / NXCD; wgid = (xcd < r ? xcd * (q + 1) : r * (q + 1) + (xcd - r) * q) + off; }
        const int nig = WGM * nN, gid = wgid / nig, fm = gid * WGM, gsz = (nM - fm) < WGM ? (nM - fm) : WGM;
        u.pm = fm + ((wgid % nig) % gsz); u.pn = (wgid % nig) / gsz; return true;
    }
    __device__ __forceinline__ void a_ready(const Unit&) const {}
    __device__ __forceinline__ void done(const Unit&) const {}
};
__device__ __forceinline__ unsigned cvt_pk_bf16(float lo, float hi) { unsigned r; asm volatile("v_cvt_pk_bf16_f32 %0, %1, %2" : "=v"(r) : "v"(lo), "v"(hi)); return r; }
typedef float f32x2 __attribute__((ext_vector_type(2)));
template <class Epi, class Sched, bool ALIGN_EPI = false, bool SP2 = false>
__device__ __forceinline__ void gemm_phase(PG8_LAS unsigned char* lds, const Gemm g, const Sched& S, const Epi& E) {
    const int tid = threadIdx.x, wid = __builtin_amdgcn_readfirstlane(tid >> 6), lane = tid & 63, wr = wid >> 2, wc = wid & 3, fr = lane & 15, fq = lane >> 4;
    const int K = g.K, nt = K / BK;
    unsigned voffA[2], voffB[2];
#pragma unroll
    for (int i = 0; i < 2; ++i) { int R, C; stage_rc(tid * 16 + i * 8192, R, C); const int Rb = Epi::PERM ? ((R & ~31) + perm32(R & 31)) : R;
        voffA[i] = (unsigned)(R * g.lda + C) * 2u; voffB[i] = (unsigned)(Rb * K + C) * 2u; }
    const size_t kstep = (size_t)(BK * 2);
    const size_t hstepA = (size_t)HALF * g.lda * 2, hstepB = (size_t)HALF * K * 2;
    const size_t tstepA = 2 * hstepA, tstepB = 2 * hstepB;
    const unsigned ldsw = (unsigned)wid * 1024u;
    const int aoff = lds_byte(wr * 64 + fr, fq * 8), boff = lds_byte(wc * 32 + fr, fq * 8);
#define PG8_SA(b, h) (((b) * 2 + (h)) * HTB)
#define PG8_SB(b, h) ((4 + (b) * 2 + (h)) * HTB)
#define PG8_STAGE(bufoff, gbase, voff) do { _Pragma("unroll") for (int _i = 0; _i < 2; ++_i) \
        __builtin_amdgcn_global_load_lds((const unsigned*)((const char*)(gbase) + (voff)[_i]), (PG8_LAS unsigned*)(lds + (bufoff) + ldsw + _i * 8192), 16, 0, 0); } while (0)
#define PG8_LDA(dst, b, h) do { _Pragma("unroll") for (int m = 0; m < 4; ++m) _Pragma("unroll") for (int k = 0; k < 2; ++k) dst[m][k] = *(const PG8_LAS bf16x8*)(lds + PG8_SA(b, h) + aoff + m * 2048 + k * 1024); } while (0)
#define PG8_LDB(dst, b, h) do { _Pragma("unroll") for (int n = 0; n < 2; ++n) _Pragma("unroll") for (int k = 0; k < 2; ++k) dst[n][k] = *(const PG8_LAS bf16x8*)(lds + PG8_SB(b, h) + boff + n * 2048 + k * 1024); } while (0)
#define PG8_MMA(ai, bj, At, Bt) do { __builtin_amdgcn_s_setprio(1); _Pragma("unroll") for (int m = 0; m < 4; ++m) _Pragma("unroll") for (int n = 0; n < 2; ++n) _Pragma("unroll") for (int k = 0; k < 2; ++k) \
        acc[ai][bj][m][n] = __builtin_amdgcn_mfma_f32_16x16x32_bf16(Bt[n][k], At[m][k], acc[ai][bj][m][n], 0, 0, 0); __builtin_amdgcn_s_setprio(0); } while (0)
#define PG8_WAIT_V(n) asm volatile("s_waitcnt vmcnt(" #n ")" ::: "memory")
#define PG8_WAIT_L(n) asm volatile("s_waitcnt lgkmcnt(" #n ")" ::: "memory")
#define PG8_BAR __builtin_amdgcn_s_barrier()
#define PG8_SCHED __builtin_amdgcn_sched_barrier(0)
    Unit cur, nxt; int ui = 0;
    if (!S.next(0, cur)) return;
    f32x4 acc[2][2][4][2];
#pragma unroll
    for (int a = 0; a < 2; ++a)
#pragma unroll
        for (int b = 0; b < 2; ++b)
#pragma unroll
            for (int m = 0; m < 4; ++m)
#pragma unroll
                for (int n = 0; n < 2; ++n) acc[a][b][m][n] = (f32x4){0.f, 0.f, 0.f, 0.f};
    bf16x8 At[4][2], B0[2][2], B1[2][2];
    const char* cA = (const char*)g.A + (size_t)cur.pm * tstepA; const char* cB = (const char*)g.Bt + (size_t)cur.pn * tstepB;
    S.a_ready(cur);
    if constexpr (SP2) {
        PG8_STAGE(PG8_SB(0, 0), cB, voffB); PG8_STAGE(PG8_SB(0, 1), cB + hstepB, voffB); PG8_STAGE(PG8_SA(0, 0), cA, voffA); PG8_STAGE(PG8_SA(0, 1), cA + hstepA, voffA);
        if (wr == 1) PG8_BAR;
        PG8_WAIT_V(2); PG8_BAR;
        PG8_STAGE(PG8_SB(1, 0), cB + kstep, voffB); PG8_STAGE(PG8_SA(1, 0), cA + kstep, voffA); PG8_STAGE(PG8_SB(1, 1), cB + hstepB + kstep, voffB);
        PG8_WAIT_V(6); PG8_BAR;
    } else {
        PG8_STAGE(PG8_SB(0, 0), cB, voffB); PG8_STAGE(PG8_SA(0, 0), cA, voffA); PG8_STAGE(PG8_SB(0, 1), cB + hstepB, voffB); PG8_STAGE(PG8_SA(0, 1), cA + hstepA, voffA);
        if (wr == 1) PG8_BAR;
        PG8_WAIT_V(4); PG8_BAR;
        PG8_STAGE(PG8_SB(1, 0), cB + kstep, voffB); PG8_STAGE(PG8_SA(1, 0), cA + kstep, voffA); PG8_STAGE(PG8_SB(1, 1), cB + hstepB + kstep, voffB);
        PG8_WAIT_V(6); PG8_BAR;
    }
    for (;;) {
        const bool has_next = S.next(ui + 1, nxt);
        const char* nA = has_next ? (const char*)g.A + (size_t)nxt.pm * tstepA : cA; const char* nB = has_next ? (const char*)g.Bt + (size_t)nxt.pn * tstepB : cB;
        for (int t = 0; t < nt; t += 2) {
            const bool last = (t == nt - 2);
            const char* a1 = cA + (size_t)(t + 1) * kstep;
            const char* a2 = last ? nA : cA + (size_t)(t + 2) * kstep; const char* b2 = last ? nB : cB + (size_t)(t + 2) * kstep;
            const char* a3 = a2 + kstep; const char* b3 = b2 + kstep;
            if (last && has_next) S.a_ready(nxt);
            if constexpr (SP2) {
            PG8_LDB(B0, 0, 0); PG8_LDB(B1, 0, 1); PG8_SCHED; PG8_LDA(At, 0, 0); PG8_STAGE(PG8_SA(1, 1), a1 + hstepA, voffA);
            PG8_WAIT_V(8); PG8_WAIT_L(0); PG8_BAR; PG8_MMA(0, 0, At, B0); PG8_MMA(0, 1, At, B1); PG8_BAR; PG8_SCHED;
            PG8_LDA(At, 0, 1); PG8_STAGE(PG8_SB(0, 0), b2, voffB); PG8_STAGE(PG8_SB(0, 1), b2 + hstepB, voffB); PG8_STAGE(PG8_SA(0, 0), a2, voffA);
            PG8_WAIT_V(8); PG8_WAIT_L(0); PG8_BAR; PG8_MMA(1, 0, At, B0); PG8_MMA(1, 1, At, B1); PG8_BAR; PG8_SCHED;
            PG8_LDB(B0, 1, 0); PG8_LDB(B1, 1, 1); PG8_SCHED; PG8_LDA(At, 1, 0); PG8_STAGE(PG8_SA(0, 1), a2 + hstepA, voffA);
            PG8_WAIT_V(8); PG8_WAIT_L(0); PG8_BAR; PG8_MMA(0, 0, At, B0); PG8_MMA(0, 1, At, B1); PG8_BAR; PG8_SCHED;
            PG8_LDA(At, 1, 1); PG8_STAGE(PG8_SB(1, 0), b3, voffB); PG8_STAGE(PG8_SB(1, 1), b3 + hstepB, voffB); PG8_STAGE(PG8_SA(1, 0), a3, voffA);
            PG8_WAIT_V(8); PG8_WAIT_L(0); PG8_BAR; PG8_MMA(1, 0, At, B0); PG8_MMA(1, 1, At, B1); PG8_BAR; PG8_SCHED;
            } else {
            PG8_LDB(B0, 0, 0); PG8_SCHED; PG8_LDA(At, 0, 0); PG8_STAGE(PG8_SA(1, 1), a1 + hstepA, voffA);
            PG8_WAIT_L(8); PG8_BAR; PG8_WAIT_L(0); PG8_MMA(0, 0, At, B0); PG8_BAR; PG8_SCHED;
            PG8_LDB(B1, 0, 1); PG8_STAGE(PG8_SB(0, 0), b2, voffB);
            PG8_BAR; PG8_WAIT_L(0); PG8_MMA(0, 1, At, B1); PG8_BAR;
            PG8_LDA(At, 0, 1); PG8_STAGE(PG8_SA(0, 0), a2, voffA);
            PG8_BAR; PG8_WAIT_L(0); PG8_MMA(1, 0, At, B0); PG8_BAR; PG8_SCHED;
            PG8_STAGE(PG8_SB(0, 1), b2 + hstepB, voffB);
            PG8_WAIT_V(6); PG8_BAR; PG8_MMA(1, 1, At, B1); PG8_BAR;
            PG8_LDB(B0, 1, 0); PG8_SCHED; PG8_LDA(At, 1, 0); PG8_STAGE(PG8_SA(0, 1), a2 + hstepA, voffA);
            PG8_WAIT_L(8); PG8_BAR; PG8_WAIT_L(0); PG8_MMA(0, 0, At, B0); PG8_BAR; PG8_SCHED;
            PG8_LDB(B1, 1, 1); PG8_STAGE(PG8_SB(1, 0), b3, voffB);
            PG8_BAR; PG8_WAIT_L(0); PG8_MMA(0, 1, At, B1); PG8_BAR;
            PG8_LDA(At, 1, 1); PG8_STAGE(PG8_SA(1, 0), a3, voffA);
            PG8_BAR; PG8_WAIT_L(0); PG8_MMA(1, 0, At, B0); PG8_BAR; PG8_SCHED;
            PG8_STAGE(PG8_SB(1, 1), b3 + hstepB, voffB);
            PG8_WAIT_V(6); PG8_BAR; PG8_MMA(1, 1, At, B1); PG8_BAR;
            }
        }
        if constexpr (ALIGN_EPI) { if (wr == 0) PG8_BAR; }
        if constexpr (!Epi::AFTER_DRAIN) { E(acc, cur, wr, wc, fr, fq); S.done(cur); }
        if (!has_next) break;
#pragma unroll
        for (int a = 0; a < 2; ++a)
#pragma unroll
            for (int b = 0; b < 2; ++b)
#pragma unroll
                for (int m = 0; m < 4; ++m)
#pragma unroll
                    for (int n = 0; n < 2; ++n) acc[a][b][m][n] = (f32x4){0.f, 0.f, 0.f, 0.f};
        cur = nxt; cA = nA; cB = nB; ++ui;
        if constexpr (ALIGN_EPI) { if (wr == 1) PG8_BAR; }
    }
    PG8_WAIT_V(0);
    if constexpr (!ALIGN_EPI) { if (wr == 0) PG8_BAR; }
    PG8_BAR;
    if constexpr (Epi::AFTER_DRAIN) { E.fused(acc, cur, wr, wc, fr, fq, lds, wid, lane); S.done(cur); }
#undef PG8_SA
#undef PG8_SB
#undef PG8_STAGE
#undef PG8_LDA
#undef PG8_LDB
#undef PG8_MMA
#undef PG8_WAIT_V
#undef PG8_WAIT_L
#undef PG8_BAR
#undef PG8_SCHED
}
}


#define GAS __attribute__((address_space(1)))
#define LAS __attribute__((address_space(3)))
typedef float f32x4 __attribute__((ext_vector_type(4)));
typedef unsigned u32x4 __attribute__((ext_vector_type(4)));
#define XB_TMO      128
#define XB_XCNT(j)  (256  + 64 * (j))
#define XB_XSUB(j)  (1280 + 64 * (j))
#define XB_XGEN(j)  (2304 + 64 * (j))
#define XB_TOP      3328
#define XB_TOPGEN   3392
#define XCD_BAR_WORDS 3456
#define XB_SPIN_CAP (1u << 18)

__device__ __forceinline__ unsigned xb_ld(unsigned* p)              { return __hip_atomic_load(p, __ATOMIC_RELAXED, __HIP_MEMORY_SCOPE_AGENT); }
__device__ __forceinline__ unsigned xb_add(unsigned* p, unsigned v) { return __hip_atomic_fetch_add(p, v, __ATOMIC_RELAXED, __HIP_MEMORY_SCOPE_AGENT); }
__device__ __forceinline__ unsigned xb_xcc_id() { return (unsigned)__builtin_amdgcn_s_getreg((3 << 11) | 20) & 0xFu; }
#define XB_SPIN(cond, bar) do { unsigned _sp = 0; while (cond) { __builtin_amdgcn_s_sleep(1); \
    if ((++_sp & 255u) == 0u) { if (xb_ld(&(bar)[XB_TMO])) break; if (_sp > XB_SPIN_CAP) { atomicAdd(&(bar)[XB_TMO], 1u); break; } } } } while (0)

struct XcdBarrier {
    unsigned* bar; unsigned x;
    volatile LAS unsigned* st;
};

__device__ __forceinline__ XcdBarrier xcd_barrier_post(unsigned* bar, volatile LAS unsigned* st) {
    XcdBarrier b; b.bar = bar; b.x = xb_xcc_id(); b.st = st;
    if (threadIdx.x == 0) (void)xb_add(&bar[XB_XCNT(b.x)], 1u);
    return b;
}
__device__ __forceinline__ void xcd_barrier_complete(unsigned* bar, unsigned x, unsigned& nloc, unsigned& nx) {
    const unsigned G = gridDim.x * gridDim.y * gridDim.z;
    unsigned sum, cnt, mine, sp = 0u;
    for (;;) {
        sum = 0u; cnt = 0u; mine = 0u;
#pragma unroll
        for (unsigned j = 0; j < 16; ++j) { const unsigned c = xb_ld(&bar[XB_XCNT(j)]); sum += c; cnt += (c > 0u) ? 1u : 0u; mine = (j == x) ? c : mine; }
        if (sum == G) break;
        __builtin_amdgcn_s_sleep(1);
        if ((++sp & 255u) == 0u) { if (xb_ld(&bar[XB_TMO])) break; if (sp > XB_SPIN_CAP) { atomicAdd(&bar[XB_TMO], 1u); break; } }
    }
    nloc = mine > 0u ? mine : 1u; nx = cnt > 0u ? cnt : 1u;
}

__device__ __forceinline__ void xcd_barrier(const XcdBarrier& b) {
    asm volatile("s_waitcnt vmcnt(0)" ::: "memory");
    __syncthreads();
    if (threadIdx.x == 0) {
        unsigned* bar = b.bar;
        __builtin_amdgcn_s_waitcnt(0);
        unsigned nloc = b.st[0], nx = b.st[1];
        if (nloc == 0u) { xcd_barrier_complete(bar, b.x, nloc, nx); b.st[0] = nloc; b.st[1] = nx; }
        const unsigned old = xb_add(&bar[XB_XSUB(b.x)], 1u);
        const unsigned gen = old / nloc;
        if (old + 1u == (gen + 1u) * nloc) {
            __builtin_amdgcn_fence(__ATOMIC_RELEASE, "agent");
            asm volatile("s_waitcnt vmcnt(0)" ::: "memory");
            const unsigned og = xb_add(&bar[XB_TOP], 1u);
            const unsigned tg = og / nx;
            if (og + 1u == (tg + 1u) * nx) xb_add(&bar[XB_TOPGEN], 1u);
            else XB_SPIN(xb_ld(&bar[XB_TOPGEN]) == tg, bar);
            __builtin_amdgcn_fence(__ATOMIC_ACQUIRE, "agent");
            xb_add(&bar[XB_XGEN(b.x)], 1u);
            asm volatile("s_waitcnt vmcnt(0)" ::: "memory");
        } else {
            XB_SPIN(xb_ld(&bar[XB_XGEN(b.x)]) == gen, bar);
            __builtin_amdgcn_fence(__ATOMIC_ACQUIRE, "agent");
            asm volatile("s_waitcnt vmcnt(0)" ::: "memory");
        }
    }
    __syncthreads();
}


constexpr int NWAVES = 8;
constexpr int RING_BYTES = 131072, LDSCTL_OFF = RING_BYTES, MISC_OFF = LDSCTL_OFF + 320, LDS_BYTES = 147456;
constexpr size_t WS_CTL = 0, CTL_ZERO_BYTES = 1 * MiB;
constexpr int CW_BAR = 4096, N_BAR_REGIONS = 16;
static_assert((CW_BAR + N_BAR_REGIONS * XCD_BAR_WORDS) * 4 <= (int)CTL_ZERO_BYTES, "barrier words inside the memset region");
constexpr size_t WS_WIN = 10 * MiB;
constexpr size_t WS_WUQ = 15 * MiB;
constexpr size_t WS_WUKV = 16 * MiB;
constexpr size_t WS_WO = 17 * MiB;
constexpr size_t WS_WPQ = 19 * MiB;
constexpr size_t WS_SK = 23 * MiB;
constexpr size_t WS_U16 = 24 * MiB;
constexpr size_t WS_V16 = 56 * MiB;


namespace att {
typedef short bf16x8 __attribute__((ext_vector_type(8)));
typedef short s16x4 __attribute__((ext_vector_type(4)));
typedef float f32x16 __attribute__((ext_vector_type(16)));
constexpr int LK = 0, KSLOT = 12288, LV = 2 * KSLOT, VSLOT = 8192, LB = LV + 2 * VSLOT, BSLOT = 256, LWS = LB + 2 * BSLOT, LOST = LWS + 8 * 256, ATT_LDS = LOST + 8 * 4096;
static_assert(ATT_LDS <= 131072, "attention scratch fits the ring region");
struct Desc { const bf16_t* Q; int pq; const bf16_t* K; int pk; const bf16_t* V; int pv; bf16_t* O; int po; const float* FC; };

__device__ __forceinline__ int crow(int r, int hi) { return (r & 3) + 8 * (r >> 2) + 4 * hi; }
__device__ __forceinline__ float xmax32(float v) { auto rr = __builtin_amdgcn_permlane32_swap(__float_as_uint(v), __float_as_uint(v), false, false); return fmaxf(__uint_as_float(rr[0]), __uint_as_float(rr[1])); }
__device__ __forceinline__ float xsum32(float v) { auto rr = __builtin_amdgcn_permlane32_swap(__float_as_uint(v), __float_as_uint(v), false, false); return __uint_as_float(rr[0]) + __uint_as_float(rr[1]); }
__device__ __forceinline__ unsigned cvtpk(float lo, float hi) { typedef float f2 __attribute__((ext_vector_type(2))); typedef __bf16 b2 __attribute__((ext_vector_type(2))); f2 v = {lo, hi}; b2 b = __builtin_convertvector(v, b2); return __builtin_bit_cast(unsigned, b); }
typedef short v4i16_t __attribute__((ext_vector_type(4)));
__device__ __forceinline__ s16x4 vtr(LAS const unsigned char* p) { return __builtin_bit_cast(s16x4, __builtin_amdgcn_ds_read_tr16_b64_v4i16((LAS v4i16_t*)p)); }

template <int KS, bool BIAS>
__device__ __forceinline__ void attn_unit(const Desc& d, int qb, int j0, LAS unsigned char* shm) {
    const int tid = threadIdx.x, lane = tid & 63, r32 = lane & 31, hi = lane >> 5; const int wid = __builtin_amdgcn_readfirstlane(tid >> 6);
    const int q0 = qb * 256, NT = (q0 + 256) / 64;
    LAS float* wsf = (LAS float*)(shm + LWS) + wid * 64;
    bf16x8 qr[KS];
    { const bf16_t* qp = d.Q + (size_t)(q0 + wid * 32 + r32) * d.pq + hi * 8;
#pragma unroll
      for (int d0 = 0; d0 < KS; ++d0) qr[d0] = *(const bf16x8*)(qp + d0 * 16); }
    const float fcref = BIAS ? d.FC[q0] : 0.f;
    const bf16_t* ksrc0 = d.K + (size_t)lane * d.pk + wid * 8;
    const bf16_t* ksrc1 = d.K + (size_t)lane * d.pk + (8 + wid) * 8;
    const bf16_t* vsrc = d.V + (size_t)(16 * (wid & 3) + (lane >> 2)) * d.pv + (wid >> 2) * 32 + (lane & 3) * 8;
    const int kdst0 = LK + wid * 1024 + lane * 16, kdst1 = LK + (8 + wid) * 1024 + lane * 16, vdst = LV + wid * 1024 + lane * 16;
    const bool k2 = (KS > 4) && (wid < 2 * KS - 8);
    u32x4 kr0, kr1, vr; float br = 0.f;
#define ATT_LOAD(t) do { kr0 = *(const u32x4*)(ksrc0 + (size_t)(t) * 64 * d.pk); if (k2) kr1 = *(const u32x4*)(ksrc1 + (size_t)(t) * 64 * d.pk); \
        vr = *(const u32x4*)(vsrc + (size_t)(t) * 64 * d.pv); if (BIAS && wid == 4) br = d.FC[(t) * 64 + lane]; } while (0)
#define ATT_WRITE(slot) do { *(LAS u32x4*)(shm + kdst0 + (slot) * KSLOT) = kr0; if (k2) *(LAS u32x4*)(shm + kdst1 + (slot) * KSLOT) = kr1; \
        *(LAS u32x4*)(shm + vdst + (slot) * VSLOT) = vr; if (BIAS && wid == 4) *(LAS float*)(shm + LB + (slot) * BSLOT + lane * 4) = (fcref - br) * LOG2E; } while (0)
    f32x16 o0, o1;
#pragma unroll
    for (int r = 0; r < 16; ++r) { o0[r] = 0.f; o1[r] = 0.f; }
    float m = -INFINITY, l = 0.f;
    const int qrel = wid * 32 + r32;
    const int kfrag = LK + hi * 1024 + r32 * 16;
    const int vfrag = LV + ((lane >> 4) & 1) * 32 + (lane & 3) * 8 + (4 * hi + ((lane & 15) >> 2)) * 64;
    ATT_LOAD(j0); ATT_WRITE(0);
    __syncthreads();
    for (int t = j0; t < NT; ++t) {
        const int slot = (t - j0) & 1;
        if (t + 1 < NT) ATT_LOAD(t + 1);
        const int jb = t - (NT - 4);
        if (!(jb >= 0 && 64 * jb > 32 * wid + 31)) {
            f32x16 p0, p1;
            if (BIAS) {
                LAS const unsigned char* bp = shm + LB + slot * BSLOT + 16 * hi;
#pragma unroll
                for (int g = 0; g < 4; ++g) { const f32x4 a = *(LAS const f32x4*)(bp + 32 * g), b = *(LAS const f32x4*)(bp + 128 + 32 * g);
                    p0[4 * g] = a[0]; p0[4 * g + 1] = a[1]; p0[4 * g + 2] = a[2]; p0[4 * g + 3] = a[3]; p1[4 * g] = b[0]; p1[4 * g + 1] = b[1]; p1[4 * g + 2] = b[2]; p1[4 * g + 3] = b[3]; }
            } else {
#pragma unroll
                for (int r = 0; r < 16; ++r) { p0[r] = 0.f; p1[r] = 0.f; }
            }
            LAS const unsigned char* kp = shm + kfrag + slot * KSLOT;
#pragma unroll
            for (int d0 = 0; d0 < KS; ++d0) {
                const bf16x8 a0 = *(LAS const bf16x8*)(kp + d0 * 2048), a1 = *(LAS const bf16x8*)(kp + d0 * 2048 + 512);
                p0 = __builtin_amdgcn_mfma_f32_32x32x16_bf16(a0, qr[d0], p0, 0, 0, 0);
                p1 = __builtin_amdgcn_mfma_f32_32x32x16_bf16(a1, qr[d0], p1, 0, 0, 0);
            }
            if (jb >= 0) {
                const int kb = 64 * jb + 4 * hi;
#pragma unroll
                for (int r = 0; r < 16; ++r) { const int kv = kb + (r & 3) + 8 * (r >> 2); if (kv > qrel) p0[r] = -INFINITY; if (kv + 32 > qrel) p1[r] = -INFINITY; }
            }
            float rm = fmaxf(p0[0], p1[0]);
#pragma unroll
            for (int r = 1; r < 16; ++r) rm = fmaxf(rm, fmaxf(p0[r], p1[r]));
            rm = xmax32(rm);
            const float mn = fmaxf(m, rm);
            const float alpha = __builtin_amdgcn_exp2f(m - mn);
            m = mn;
            float sacc = 0.f;
#pragma unroll
            for (int r = 0; r < 16; ++r) { p0[r] = __builtin_amdgcn_exp2f(p0[r] - mn); p1[r] = __builtin_amdgcn_exp2f(p1[r] - mn); sacc += p0[r] + p1[r]; }
            l = l * alpha + sacc;
            if (__any(alpha != 1.f)) {
                if (hi == 0) wsf[r32] = alpha;
#pragma unroll
                for (int g = 0; g < 4; ++g) { const f32x4 a = *(LAS const f32x4*)(wsf + 8 * g + 4 * hi);
#pragma unroll
                    for (int i = 0; i < 4; ++i) { o0[4 * g + i] *= a[i]; o1[4 * g + i] *= a[i]; } }
            }
            LAS const unsigned char* vp = shm + vfrag + slot * VSLOT;
#pragma unroll
            for (int ks = 0; ks < 4; ++ks) {
                const f32x16& pp = ks < 2 ? p0 : p1; const int bq = (ks & 1) * 8;
                u32x4 pw; pw.x = cvtpk(pp[bq], pp[bq + 1]); pw.y = cvtpk(pp[bq + 2], pp[bq + 3]); pw.z = cvtpk(pp[bq + 4], pp[bq + 5]); pw.w = cvtpk(pp[bq + 6], pp[bq + 7]);
                const bf16x8 pa = __builtin_bit_cast(bf16x8, pw);
                const s16x4 l0 = vtr(vp + ks * 1024), h0 = vtr(vp + ks * 1024 + 512), l1 = vtr(vp + 4096 + ks * 1024), h1 = vtr(vp + 4096 + ks * 1024 + 512);
                const bf16x8 v0 = {l0[0], l0[1], l0[2], l0[3], h0[0], h0[1], h0[2], h0[3]}, v1 = {l1[0], l1[1], l1[2], l1[3], h1[0], h1[1], h1[2], h1[3]};
                o0 = __builtin_amdgcn_mfma_f32_32x32x16_bf16(pa, v0, o0, 0, 0, 0);
                o1 = __builtin_amdgcn_mfma_f32_32x32x16_bf16(pa, v1, o1, 0, 0, 0);
            }
        }
        if (t + 1 < NT) ATT_WRITE(slot ^ 1);
        __syncthreads();
    }
#undef ATT_LOAD
#undef ATT_WRITE
    l = xsum32(l);
    if (hi == 0) wsf[32 + r32] = l;
    float rli[16];
#pragma unroll
    for (int g = 0; g < 4; ++g) { const f32x4 a = *(LAS const f32x4*)(wsf + 32 + 8 * g + 4 * hi);
#pragma unroll
        for (int i = 0; i < 4; ++i) rli[4 * g + i] = 1.f / a[i]; }
    LAS bf16_t* stg = (LAS bf16_t*)(shm + LOST) + wid * 2048;
#pragma unroll
    for (int r = 0; r < 16; ++r) { const int orow = crow(r, hi); stg[orow * 64 + r32] = f2bf(o0[r] * rli[r]); stg[orow * 64 + 32 + r32] = f2bf(o1[r] * rli[r]); }
    bf16_t* Ow = d.O + (size_t)(q0 + wid * 32) * d.po;
#pragma unroll
    for (int i = 0; i < 4; ++i) { const int row = i * 8 + (lane >> 3), ch = lane & 7; const u32x4 v = *(LAS const u32x4*)(stg + row * 64 + ch * 8); *(u32x4*)(Ow + (size_t)row * d.po + ch * 8) = v; }
    __syncthreads();
}
}


namespace pk {
typedef short bf16x8 __attribute__((ext_vector_type(8)));
typedef float f32x16 __attribute__((ext_vector_type(16)));
__device__ __forceinline__ unsigned f2sort(float f) { const unsigned b = __float_as_uint(f); return b ^ ((unsigned)((int)b >> 31) | 0x80000000u); }
__device__ __forceinline__ float sort2f(unsigned u) { return __uint_as_float((u & 0x80000000u) ? (u ^ 0x80000000u) : ~u); }
__device__ __forceinline__ void ce(unsigned& a, unsigned& b) { const unsigned mx = a > b ? a : b, mn = a > b ? b : a; a = mx; b = mn; }
__device__ __forceinline__ void sort16(unsigned (&v)[16]) {
#pragma unroll
    for (int k = 2; k <= 16; k <<= 1)
#pragma unroll
        for (int j = k >> 1; j >= 1; j >>= 1)
#pragma unroll
            for (int i = 0; i < 16; ++i) { const int l = i ^ j; if (l > i) { if ((i & k) == 0) ce(v[i], v[l]); else ce(v[l], v[i]); } }
}
__device__ __forceinline__ void merge16(unsigned (&a)[16], const unsigned (&b)[16]) {
#pragma unroll
    for (int i = 0; i < 16; ++i) a[i] = a[i] > b[15 - i] ? a[i] : b[15 - i];
#pragma unroll
    for (int j = 8; j >= 1; j >>= 1)
#pragma unroll
        for (int i = 0; i < 16; ++i) { const int l = i ^ j; if (l > i) ce(a[i], a[l]); }
}
__device__ __forceinline__ void top16of64(unsigned (&k)[64], unsigned (&out)[16]) {
    unsigned g1[16], g2[16], g3[16];
#pragma unroll
    for (int i = 0; i < 16; ++i) { out[i] = k[i]; g1[i] = k[16 + i]; g2[i] = k[32 + i]; g3[i] = k[48 + i]; }
    sort16(out); sort16(g1); sort16(g2); sort16(g3);
    merge16(out, g1); merge16(g2, g3); merge16(out, g2);
}
__device__ __forceinline__ unsigned sel4(const unsigned (&w)[4], int q) { const unsigned a = q & 1 ? w[1] : w[0], b = q & 1 ? w[3] : w[2]; return q & 2 ? b : a; }

template <int I> struct COff { static constexpr int v = COff<I - 1>::v + 16 / I; };
template <> struct COff<0> { static constexpr int v = 0; };
static_assert(COff<16>::v == 50, "50 candidates can reach the top 16 of a sorted 16 x 16 sum grid");
template <int I> __device__ __forceinline__ void fill_cand(unsigned (&c64)[64], const float (&s1)[16], const float (&s2)[16]) {
    if constexpr (I < 16) {
#pragma unroll
        for (int j = 0; j < 16 / (I + 1); ++j) c64[COff<I>::v + j] = (f2sort(s1[I] + s2[j]) & 0xFFFFFF00u) | (unsigned)(255 - (I * 16 + j));
        fill_cand<I + 1>(c64, s1, s2);
    }
}
__device__ __forceinline__ void topk_item(const bf16_t* QP, const bf16_t* SK, int* EID, float* GATE, int item, int lane) {
    const int tg = item >> 3, h = item & 7, r32 = lane & 31, hi = lane >> 5;
    const int t = tg * 32 + r32;
    unsigned own[2][16];
#pragma unroll
    for (int p = 0; p < 2; ++p) {
        const bf16_t* qrow = QP + (size_t)t * 2048 + h * 256 + p * 128 + hi * 8;
        bf16x8 qf[8];
#pragma unroll
        for (int d0 = 0; d0 < 8; ++d0) qf[d0] = *(const bf16x8*)(qrow + d0 * 16);
        const bf16_t* skb = SK + (size_t)((h * 2 + p) * 128 + r32) * 128 + hi * 8;
#pragma unroll 1
        for (int kt = 0; kt < 4; ++kt) {
            f32x16 acc;
#pragma unroll
            for (int r = 0; r < 16; ++r) acc[r] = 0.f;
#pragma unroll
            for (int d0 = 0; d0 < 8; ++d0) { const bf16x8 a = *(const bf16x8*)(skb + (size_t)kt * 32 * 128 + d0 * 16); acc = __builtin_amdgcn_mfma_f32_32x32x16_bf16(a, qf[d0], acc, 0, 0, 0); }
            unsigned cur[16];
#pragma unroll
            for (int r = 0; r < 16; ++r) { const int idx0 = kt * 32 + (r & 3) + 8 * (r >> 2);
                cur[r] = (f2sort(acc[r]) & 0xFFFFFF80u) | (unsigned)(127 - idx0 - 4 * hi); }
            sort16(cur);
            if (kt == 0) {
#pragma unroll
                for (int r = 0; r < 16; ++r) own[p][r] = cur[r];
            } else merge16(own[p], cur);
        }
    }
    unsigned fin[16];
    {
        unsigned oth[16];
#pragma unroll
        for (int i = 0; i < 16; ++i) { auto rr = __builtin_amdgcn_permlane32_swap(own[0][i], own[1][i], false, false); fin[i] = rr[0]; oth[i] = rr[1]; }
        merge16(fin, oth);
    }
    unsigned s1k[16], s2k[16];
#pragma unroll
    for (int i = 0; i < 16; ++i) { auto rr = __builtin_amdgcn_permlane32_swap(fin[i], fin[i], false, false); s1k[i] = rr[0]; s2k[i] = rr[1]; }
    float s1[16], s2[16]; unsigned long long i1lo = 0ull, i1hi = 0ull, i2lo = 0ull, i2hi = 0ull;
#pragma unroll
    for (int i = 0; i < 16; ++i) { s1[i] = sort2f(s1k[i] & 0xFFFFFF80u); s2[i] = sort2f(s2k[i] & 0xFFFFFF80u);
        const unsigned long long a = (unsigned long long)(127u - (s1k[i] & 0x7Fu)) << (8 * (i & 7)), b = (unsigned long long)(127u - (s2k[i] & 0x7Fu)) << (8 * (i & 7));
        if (i < 8) { i1lo |= a; i2lo |= b; } else { i1hi |= a; i2hi |= b; } }
    unsigned c64[64];
#pragma unroll
    for (int i = 50; i < 64; ++i) c64[i] = 0u;
    fill_cand<0>(c64, s1, s2);
    unsigned top[16];
    top16of64(c64, top);
    float ev[16]; float sum = 0.f; const float mx = sort2f(top[0] & 0xFFFFFF00u);
#pragma unroll
    for (int r = 0; r < 16; ++r) { ev[r] = __expf(sort2f(top[r] & 0xFFFFFF00u) - mx); sum += ev[r]; }
    const float rs = 1.f / sum;
    if (hi == 0) {
        int* ep = EID + (size_t)t * 128 + h * 16;
#pragma unroll
        for (int q4 = 0; q4 < 4; ++q4) { int ee[4];
#pragma unroll
            for (int z = 0; z < 4; ++z) { const int code = 255 - (int)(top[q4 * 4 + z] & 0xFFu), i = code >> 4, j = code & 15;
                const unsigned e1 = (unsigned)(((i & 8) ? i1hi : i1lo) >> (8 * (i & 7))) & 0xFFu, e2 = (unsigned)(((j & 8) ? i2hi : i2lo) >> (8 * (j & 7))) & 0xFFu; ee[z] = (int)(e1 * 128u + e2); }
            *(int4*)(ep + q4 * 4) = make_int4(ee[0], ee[1], ee[2], ee[3]); }
    } else {
        float* gp = GATE + (size_t)t * 128 + h * 16;
#pragma unroll
        for (int q4 = 0; q4 < 4; ++q4) *(float4*)(gp + q4 * 4) = make_float4(ev[q4 * 4] * rs, ev[q4 * 4 + 1] * rs, ev[q4 * 4 + 2] * rs, ev[q4 * 4 + 3] * rs);
    }
}
}

struct Args { const void* in[22]; float* out; unsigned char* ws; int ph_lo, ph_hi, li, pad; };

struct Frame {
    LAS unsigned char* lds;
    int tid, lane, wave, G, gw, NGW;
};

namespace pg8 {
struct EpiProj {
    static constexpr bool PERM = true, AFTER_DRAIN = false;
    bf16_t* P; float* FL;
    __device__ __forceinline__ void operator()(const f32x4 (&acc)[2][2][4][2], const Unit& u, int wr, int wc, int fr, int fq) const {
        const int row0 = u.pm * BM + wr * 64 + fr, col0 = u.pn * BM + wc * 32 + 8 * fq;
#pragma unroll
        for (int ai = 0; ai < 2; ++ai)
#pragma unroll
            for (int m = 0; m < 4; ++m) { const int row = row0 + ai * HALF + m * 16; bf16_t* rowp = P + (size_t)row * PP + col0;
#pragma unroll
                for (int bj = 0; bj < 2; ++bj) { const f32x4 v0 = acc[ai][bj][m][0], v1 = acc[ai][bj][m][1];
                    if (col0 + bj * HALF == C_FL) { float* f = FL + (size_t)row * 8; *(f32x4*)f = v0; *(f32x4*)(f + 4) = v1; }
                    u32x4 w; w.x = cvt_pk_bf16(v0[0], v0[1]); w.y = cvt_pk_bf16(v0[2], v0[3]); w.z = cvt_pk_bf16(v1[0], v1[1]); w.w = cvt_pk_bf16(v1[2], v1[3]);
                    *(u32x4*)(rowp + bj * HALF) = w; } }
    }
};
struct EpiStore {
    static constexpr bool PERM = true, AFTER_DRAIN = false;
    bf16_t* O; int ldc;
    __device__ __forceinline__ void operator()(const f32x4 (&acc)[2][2][4][2], const Unit& u, int wr, int wc, int fr, int fq) const {
        const int row0 = u.pm * BM + wr * 64 + fr, col0 = u.pn * BM + wc * 32 + 8 * fq;
#pragma unroll
        for (int ai = 0; ai < 2; ++ai)
#pragma unroll
            for (int m = 0; m < 4; ++m) { bf16_t* rowp = O + (size_t)(row0 + ai * HALF + m * 16) * ldc + col0;
#pragma unroll
                for (int bj = 0; bj < 2; ++bj) { const f32x4 v0 = acc[ai][bj][m][0], v1 = acc[ai][bj][m][1];
                    u32x4 w; w.x = cvt_pk_bf16(v0[0], v0[1]); w.y = cvt_pk_bf16(v0[2], v0[3]); w.z = cvt_pk_bf16(v1[0], v1[1]); w.w = cvt_pk_bf16(v1[2], v1[3]);
                    *(u32x4*)(rowp + bj * HALF) = w; } }
    }
};
struct EpiResid {
    static constexpr bool PERM = false, AFTER_DRAIN = false;
    const float* X; const float* MOD; float* out;
    __device__ __forceinline__ void operator()(const f32x4 (&acc)[2][2][4][2], const Unit& u, int wr, int wc, int fr, int fq) const {
        const int row0 = u.pm * BM + wr * 64 + fr, col0 = u.pn * BM + wc * 32 + 4 * fq;
        const int b = (u.pm * BM) / S_;
        f32x4 gv[2][2];
#pragma unroll
        for (int bj = 0; bj < 2; ++bj)
#pragma unroll
            for (int n = 0; n < 2; ++n) gv[bj][n] = *(const f32x4*)(MOD + b * 6144 + 2 * 1024 + col0 + bj * HALF + n * 16);
#pragma unroll
        for (int ai = 0; ai < 2; ++ai)
#pragma unroll
            for (int m = 0; m < 4; ++m) { const size_t off = (size_t)(row0 + ai * HALF + m * 16) * 1024 + col0;
#pragma unroll
                for (int bj = 0; bj < 2; ++bj)
#pragma unroll
                    for (int n = 0; n < 2; ++n) { const f32x4 xv = *(const f32x4*)(X + off + bj * HALF + n * 16); *(f32x4*)(out + off + bj * HALF + n * 16) = xv + gv[bj][n] * acc[ai][bj][m][n]; } }
    }
};
}

__device__ __forceinline__ void p0_transpose_item(const float* W, int K, int N, int Npad, bf16_t* WT, LAS float* scr, int item, int lane) {
    const int nblk = Npad / 32, kb = item / nblk, nb = item % nblk, k0 = 64 * kb, n0 = 32 * nb;
    const int nn = n0 + (lane & 31);
#pragma unroll 8
    for (int i = 0; i < 32; ++i) { const int kk = 2 * i + (lane >> 5); scr[kk * 33 + (lane & 31)] = nn < N ? W[(size_t)(k0 + kk) * N + nn] : 0.f; }
    asm volatile("s_waitcnt lgkmcnt(0)" ::: "memory");
    const int c = lane & 7;
#pragma unroll
    for (int j = 0; j < 4; ++j) { const int n = (lane >> 3) + 8 * j; const LAS float* s = scr + (8 * c) * 33 + n;
        u32x4 o; o.x = pk2(s[0 * 33], s[1 * 33]); o.y = pk2(s[2 * 33], s[3 * 33]); o.z = pk2(s[4 * 33], s[5 * 33]); o.w = pk2(s[6 * 33], s[7 * 33]);
        *(u32x4*)(WT + (size_t)(n0 + n) * K + k0 + 8 * c) = o; }
    asm volatile("s_waitcnt lgkmcnt(0)" ::: "memory");
}
__device__ __forceinline__ void p0_mod_item(const float* c, const float* w_ada, const float* b_ada, float* mod, LAS float* scr, int item, int lane) {
    for (int i = lane; i < 4096; i += 64) { const int b = i >> 10, k = i & 1023; const float cv = c[i]; scr[k * 4 + b] = cv / (1.f + expf(-cv)); }
    asm volatile("s_waitcnt lgkmcnt(0)" ::: "memory");
    const int j = item * 64 + lane;
    float a0 = 0.f, a1 = 0.f, a2 = 0.f, a3 = 0.f;
#pragma unroll 8
    for (int k = 0; k < 1024; ++k) { const float w = w_ada[(size_t)k * 6144 + j]; const f32x4 s = *(const LAS f32x4*)(scr + k * 4); a0 += s[0] * w; a1 += s[1] * w; a2 += s[2] * w; a3 += s[3] * w; }
    const float bb = b_ada[j];
    mod[0 * 6144 + j] = a0 + bb; mod[1 * 6144 + j] = a1 + bb; mod[2 * 6144 + j] = a2 + bb; mod[3 * 6144 + j] = a3 + bb;
    asm volatile("s_waitcnt lgkmcnt(0)" ::: "memory");
}

__device__ __forceinline__ void modrow(const float* X, const float* g, const float* mod, int shift_idx, int scale_idx, bf16_t* out, int row, int lane) {
    const int b = row / S_;
    const float4* xr = (const float4*)(X + (size_t)row * 1024) + lane;
    float4 v[4]; float ss = 0.f;
#pragma unroll
    for (int j = 0; j < 4; ++j) { v[j] = xr[64 * j]; ss += (v[j].x * v[j].x + v[j].y * v[j].y) + (v[j].z * v[j].z + v[j].w * v[j].w); }
    ss = wave_sum(ss);
    const float r = rsqrtf(ss * (1.f / 1024.f) + EPS);
    const float* sh = mod + b * 6144 + shift_idx * 1024; const float* sc = mod + b * 6144 + scale_idx * 1024;
#pragma unroll
    for (int j = 0; j < 4; ++j) {
        const int col = 4 * lane + 256 * j;
        const float4 g4 = *(const float4*)(g + col), s4 = *(const float4*)(sc + col), h4 = *(const float4*)(sh + col);
        const float o0 = v[j].x * r * g4.x * (1.f + s4.x) + h4.x, o1 = v[j].y * r * g4.y * (1.f + s4.y) + h4.y;
        const float o2 = v[j].z * r * g4.z * (1.f + s4.z) + h4.z, o3 = v[j].w * r * g4.w * (1.f + s4.w) + h4.w;
        uint2 w; w.x = pk2(o0, o1); w.y = pk2(o2, o3);
        *(uint2*)(out + (size_t)row * 1024 + col) = w;
    }
}

__global__ void __launch_bounds__(NWAVES * 64, 2) mega_fwd(Args args) {
    extern __shared__ __attribute__((aligned(16))) unsigned char lds[];
    Frame F;
    F.lds = (LAS unsigned char*)lds;
    volatile LAS unsigned* MISC = (volatile LAS unsigned*)(F.lds + MISC_OFF);
    F.tid = threadIdx.x; F.lane = F.tid & 63; F.wave = __builtin_amdgcn_readfirstlane(F.tid >> 6);
    F.G = gridDim.x; F.gw = blockIdx.x * NWAVES + F.wave; F.NGW = F.G * NWAVES;
    unsigned char* ws = args.ws;
    unsigned* ctl = (unsigned*)(ws + WS_CTL);
    const float* x = (const float*)args.in[0]; const float* c = (const float*)args.in[1]; const int* positions = (const int*)args.in[2];
    const float* w_ada = (const float*)args.in[3]; const float* b_ada = (const float*)args.in[4]; const float* norm1_g = (const float*)args.in[5];
    const float* w_in = (const float*)args.in[6]; const float* mla_qa_g = (const float*)args.in[7]; const float* mla_kva_g = (const float*)args.in[8];
    const float* w_uq = (const float*)args.in[9]; const float* w_ukv = (const float*)args.in[10]; const float* mla_q_g = (const float*)args.in[11];
    const float* mla_k_g = (const float*)args.in[12]; const float* fox_q_g = (const float*)args.in[13]; const float* fox_k_g = (const float*)args.in[14];
    const float* b_f = (const float*)args.in[15]; const float* w_o = (const float*)args.in[16]; const float* norm2_g = (const float*)args.in[17];
    const float* w_pq = (const float*)args.in[18]; const float* sub_keys = (const float*)args.in[19]; const float* peer_u = (const float*)args.in[20]; const float* peer_v = (const float*)args.in[21];
    float* out = args.out;
    float* MOD = (float*)(ws + WS_MOD); float* FL = (float*)(ws + WS_FL); float* FCUM = (float*)(ws + WS_FCUM); float* LOGF = (float*)(ws + WS_LOGF); float2* ROPE = (float2*)(ws + WS_ROPE);
    bf16_t* XN = (bf16_t*)(ws + WS_XN); bf16_t* PROJ = (bf16_t*)(ws + WS_PROJ); bf16_t* KVRAW = (bf16_t*)(ws + WS_KVRAW); bf16_t* QA = (bf16_t*)(ws + WS_QA); bf16_t* KA = (bf16_t*)(ws + WS_KA);
    bf16_t* WIN = (bf16_t*)(ws + WS_WIN); bf16_t* WUQ = (bf16_t*)(ws + WS_WUQ); bf16_t* WUKV = (bf16_t*)(ws + WS_WUKV); bf16_t* WO = (bf16_t*)(ws + WS_WO); bf16_t* WPQ = (bf16_t*)(ws + WS_WPQ); bf16_t* SKB = (bf16_t*)(ws + WS_SK);
    bf16_t* OB = XN; bf16_t* H2 = XN; bf16_t* QP = PROJ; int* EID = (int*)(ws + WS_QA); float* GATE = (float*)(ws + WS_QA + 16 * MiB);
    (void)sub_keys; (void)peer_u; (void)peer_v; (void)positions; (void)KA; (void)FCUM; (void)LOGF; (void)ROPE; (void)mla_q_g; (void)mla_k_g; (void)b_f; (void)fox_q_g; (void)fox_k_g; (void)mla_qa_g; (void)mla_kva_g;

    for (int u = F.tid; u < (LDS_BYTES - LDSCTL_OFF) / 4; u += NWAVES * 64) ((LAS unsigned*)(F.lds + LDSCTL_OFF))[u] = 0u;
    __syncthreads();
    const int lo = args.ph_lo, hi = args.ph_hi;
    XcdBarrier bar; bar.bar = ctl + CW_BAR + args.li * XCD_BAR_WORDS; bar.x = 0; bar.st = nullptr;
    if (hi - lo > 1) bar = xcd_barrier_post(ctl + CW_BAR + args.li * XCD_BAR_WORDS, MISC + 8);
#define IN(k) (lo <= (k) && (k) < hi)
#define SEAM(k) do { if (IN(k) && IN((k) + 1)) xcd_barrier(bar); } while (0)

    if (IN(0)) {
        LAS float* scr = (LAS float*)(F.lds + F.wave * 16384);
        constexpr int I_MOD = 96, I_IN = 16 * 72, I_UQ = 6 * 24, I_UKV = 4 * 32, I_O = 16 * 32, I_PQ = 16 * 64;
        constexpr int I_SK = 512;
        constexpr int NITEMS = I_MOD + I_IN + I_UQ + I_UKV + I_O + I_PQ + I_SK;
        for (int it = F.gw; it < NITEMS; it += F.NGW) {
            int r = it;
            if (r < I_MOD) { p0_mod_item(c, w_ada, b_ada, MOD, scr, r, F.lane); continue; } r -= I_MOD;
            if (r < I_IN) { p0_transpose_item(w_in, 1024, INW, PP, WIN, scr, r, F.lane); continue; } r -= I_IN;
            if (r < I_UQ) { p0_transpose_item(w_uq, 384, 768, 768, WUQ, scr, r, F.lane); continue; } r -= I_UQ;
            if (r < I_UKV) { p0_transpose_item(w_ukv, 256, 1024, 1024, WUKV, scr, r, F.lane); continue; } r -= I_UKV;
            if (r < I_O) { p0_transpose_item(w_o, 1024, 1024, 1024, WO, scr, r, F.lane); continue; } r -= I_O;
            if (r < I_PQ) { p0_transpose_item(w_pq, 1024, 2048, 2048, WPQ, scr, r, F.lane); continue; } r -= I_PQ;
            { const float4* src = (const float4*)(sub_keys + (size_t)r * 512) + F.lane * 2; const float4 a = src[0], b2 = src[1];
              u32x4 o; o.x = pk2(a.x, a.y); o.y = pk2(a.z, a.w); o.z = pk2(b2.x, b2.y); o.w = pk2(b2.z, b2.w); *(u32x4*)(SKB + (size_t)r * 512 + F.lane * 8) = o; }
        }
    }
    SEAM(0);
    if (IN(1)) { for (int row = F.gw; row < T_; row += F.NGW) modrow(x, norm1_g, MOD, 0, 1, XN, row, F.lane); }
    SEAM(1);
    if (IN(2)) {
        pg8::Gemm g{XN, WIN, T_, PP, 1024, 1024}; pg8::StaticOrder S; S.init(T_, PP, F.G, (int)blockIdx.x);
        pg8::EpiProj E{PROJ, FL};
        pg8::gemm_phase<pg8::EpiProj, pg8::StaticOrder, true, true>(F.lds, g, S, E);
    }
    SEAM(2);
    if (IN(3)) { for (int row = F.gw; row < T_; row += F.NGW) rowprep_row(PROJ, FL, mla_qa_g, mla_kva_g, fox_q_g, fox_k_g, b_f, positions, LOGF, ROPE, row, F.lane); }
    SEAM(3);
    if (IN(4)) {
        { pg8::Gemm g{PROJ + C_CQ, WUQ, T_, 768, 384, PP}; pg8::StaticOrder S; S.init(T_, 768, F.G, (int)blockIdx.x); pg8::EpiStore E{QA, 768};
          pg8::gemm_phase<pg8::EpiStore, pg8::StaticOrder, true, true>(F.lds, g, S, E); }
        { pg8::Gemm g{PROJ + C_CKV, WUKV, T_, 1024, 256, PP}; pg8::StaticOrder S; S.init(T_, 1024, F.G, (int)blockIdx.x); pg8::EpiStore E{KVRAW, 1024};
          pg8::gemm_phase<pg8::EpiStore, pg8::StaticOrder, true, true>(F.lds, g, S, E); }
    }
    SEAM(4);
    if (IN(5)) {
        if (F.gw < 32) fcum_item(LOGF, FCUM, F.gw, F.lane);
        for (int row = F.gw; row < T_; row += F.NGW) mlaprep_row(QA, KVRAW, PROJ, KA, ROPE, mla_q_g, mla_k_g, row, F.lane);
    }
    SEAM(5);
    if (IN(6)) {
        const int nunits = 1024;
        for (int grp = 0; grp < 2; ++grp)
            for (int i = 0;; ++i) {
                int bh, qb;
                if (F.G == 256) { if (i >= 4) break; const int v = ((int)blockIdx.x % 8) * 32 + (int)blockIdx.x / 8, s = v & 7; bh = v >> 3; qb = (i == 0) ? s : (i == 1) ? 15 - s : (i == 2) ? 16 + s : 31 - s; }
                else { const int u = i * F.G + (int)blockIdx.x; if (u >= nunits) break; bh = u & 31; qb = 31 - (u >> 5); }
                const int b = bh >> 3, h = bh & 7;
                if (grp == 0) { const att::Desc d{QA + (size_t)b * S_ * 768 + h * 96, 768, KA + (size_t)b * S_ * 768 + h * 96, 768, KVRAW + (size_t)b * S_ * 1024 + h * 128 + 64, 1024, OB + (size_t)b * S_ * 1024 + h * 64, 1024, nullptr};
                    att::attn_unit<6, false>(d, qb, 0, F.lds); }
                else { const bf16_t* pb = PROJ + (size_t)b * S_ * PP + h * 64; const att::Desc d{pb + C_FQ, PP, pb + C_FK, PP, pb + C_FV, PP, OB + (size_t)b * S_ * 1024 + 512 + h * 64, 1024, FCUM + (size_t)(b * 8 + h) * S_};
                    att::attn_unit<4, true>(d, qb, 0, F.lds); }
            }
    }
    SEAM(6);
    if (IN(7)) {
        pg8::Gemm g{OB, WO, T_, 1024, 1024, 1024}; pg8::StaticOrder S; S.init(T_, 1024, F.G, (int)blockIdx.x);
        pg8::EpiResid E{x, MOD, out};
        pg8::gemm_phase<pg8::EpiResid, pg8::StaticOrder, true, true>(F.lds, g, S, E);
    }
    SEAM(7);
    if (IN(8)) { for (int row = F.gw; row < T_; row += F.NGW) modrow(out, norm2_g, MOD, 3, 4, H2, row, F.lane); }
    SEAM(8);
    if (IN(9)) {
        pg8::Gemm g{H2, WPQ, T_, 2048, 1024, 1024}; pg8::StaticOrder S; S.init(T_, 2048, F.G, (int)blockIdx.x); pg8::EpiStore E{QP, 2048};
        pg8::gemm_phase<pg8::EpiStore, pg8::StaticOrder, true, true>(F.lds, g, S, E);
    }
    SEAM(9);
    if (IN(10)) { for (int w = F.gw; w < (T_ / 32) * 8; w += F.NGW) pk::topk_item(QP, SKB, EID, GATE, w, F.lane); }
    SEAM(10);
    if (IN(11)) { for (int t = F.gw; t < T_; t += F.NGW) gather_item(H2, EID, GATE, peer_u, peer_v, MOD, out, t, F.lane); }
#undef IN
#undef SEAM
}

static int g_grid = 0;
static void launch_mega(const Args& base, int lo, int hi, int li, hipStream_t stream) {
    Args a = base; a.ph_lo = lo; a.ph_hi = hi; a.li = li;
    hipLaunchKernelGGL(mega_fwd, dim3(g_grid), dim3(NWAVES * 64), LDS_BYTES, stream, a);
}

extern "C" void kernel_launch(void* const* d_in, const int* in_sizes, int n_in, void* d_out, int out_size, void* d_ws, size_t ws_size, hipStream_t stream) {
    if (g_grid == 0) {
        int dev = 0, cus = 0;
        hipGetDevice(&dev); hipDeviceGetAttribute(&cus, hipDeviceAttributeMultiprocessorCount, dev);
        hipFuncSetAttribute((const void*)mega_fwd, hipFuncAttributeMaxDynamicSharedMemorySize, LDS_BYTES);
        int per_cu = 0; hipOccupancyMaxActiveBlocksPerMultiprocessor(&per_cu, (const void*)mega_fwd, NWAVES * 64, LDS_BYTES);
        (void)hipGetLastError();
        g_grid = cus > 0 ? cus : 256;
        if (per_cu < 1) fprintf(stderr, "kernel_launch: occupancy query says %d blocks/CU\n", per_cu);
    }
    const float* x = (const float*)d_in[0]; const int* positions = (const int*)d_in[2];
    const float* mla_qa_g = (const float*)d_in[7]; const float* mla_kva_g = (const float*)d_in[8];
    const float* mla_q_g = (const float*)d_in[11]; const float* mla_k_g = (const float*)d_in[12]; const float* fox_q_g = (const float*)d_in[13]; const float* fox_k_g = (const float*)d_in[14];
    const float* b_f = (const float*)d_in[15]; const float* sub_keys = (const float*)d_in[19]; const float* peer_u = (const float*)d_in[20]; const float* peer_v = (const float*)d_in[21];
    float* out = (float*)d_out; unsigned char* ws = (unsigned char*)d_ws;
    float* MOD = (float*)(ws + WS_MOD); float* FL = (float*)(ws + WS_FL); float* FCUM = (float*)(ws + WS_FCUM); float* LOGF = (float*)(ws + WS_LOGF); float2* ROPE = (float2*)(ws + WS_ROPE);
    bf16_t* XN = (bf16_t*)(ws + WS_XN); bf16_t* PROJ = (bf16_t*)(ws + WS_PROJ); bf16_t* KVRAW = (bf16_t*)(ws + WS_KVRAW); bf16_t* QA = (bf16_t*)(ws + WS_QA); bf16_t* KA = (bf16_t*)(ws + WS_KA);
    bf16_t* OB = XN; bf16_t* H2 = XN; bf16_t* QP = PROJ; int* EID = (int*)(ws + WS_QA); float* GATE = (float*)(ws + WS_QA + 16 * MiB);
    (void)x;
    hipMemsetAsync(ws + WS_CTL, 0, CTL_ZERO_BYTES, stream);
    Args base{}; for (int i = 0; i < 22; ++i) base.in[i] = d_in[i]; base.out = out; base.ws = ws;

    launch_mega(base, 0, 12, 0, stream);
}
```

```cpp
#include <hip/hip_runtime.h>
#include <cstdint>
#include <cstdio>
#include <cmath>

typedef unsigned short bf16_t;
constexpr int B_ = 4, S_ = 8192, D_ = 1024, T_ = B_ * S_;
constexpr int PP = 2304;
constexpr int C_CQ = 0, C_CKV = 384, C_KPE = 640, C_FQ = 672, C_FK = 1184, C_FV = 1696, C_FL = 2208, INW = 2216;
constexpr float EPS = 1e-6f;
constexpr float LOG2E = 1.4426950408889634f;
constexpr float C2A = 0.10206207261596577f * LOG2E;
constexpr float C2F = 0.125f * LOG2E;

__device__ __forceinline__ float bf2f(bf16_t v) { return __uint_as_float(((unsigned)v) << 16); }
__device__ __forceinline__ bf16_t f2bf(float f) { unsigned u = __float_as_uint(f); return (bf16_t)((u + 0x7fffu + ((u >> 16) & 1u)) >> 16); }
__device__ __forceinline__ unsigned pk2(float lo, float hi) { return (unsigned)f2bf(lo) | ((unsigned)f2bf(hi) << 16); }
__device__ __forceinline__ float lo2f(unsigned w) { return __uint_as_float(w << 16); }
__device__ __forceinline__ float hi2f(unsigned w) { return __uint_as_float(w & 0xffff0000u); }
__device__ __forceinline__ float wave_sum(float v) {
#pragma unroll
    for (int o = 1; o < 64; o <<= 1) v += __shfl_xor(v, o);
    return v;
}

constexpr size_t MiB = 1u << 20;
constexpr size_t WS_MOD = 1 * MiB;
constexpr size_t WS_FL = 3 * MiB;
constexpr size_t WS_FCUM = 4 * MiB;
constexpr size_t WS_LOGF = 5 * MiB;
constexpr size_t WS_ROPE = 6 * MiB;
constexpr size_t WS_XN = 88 * MiB;
constexpr size_t WS_PROJ = 152 * MiB;
constexpr size_t WS_KVRAW = 296 * MiB;
constexpr size_t WS_QA = 360 * MiB;
constexpr size_t WS_KA = 408 * MiB;

__global__ void k_mod(const float* c, const float* w_ada, const float* b_ada, float* mod) {
    const int j = blockIdx.x * 256 + threadIdx.x, b = blockIdx.y;
    float acc = b_ada[j];
    for (int k = 0; k < 1024; ++k) { const float cv = c[b * 1024 + k]; const float s = cv / (1.f + expf(-cv)); acc += s * w_ada[(size_t)k * 6144 + j]; }
    mod[b * 6144 + j] = acc;
}

__global__ void __launch_bounds__(256) k_modrows(const float* X, const float* g, const float* mod, int shift_idx, int scale_idx, bf16_t* out) {
    const int wave = threadIdx.x >> 6, lane = threadIdx.x & 63;
    const int row = blockIdx.x * 4 + wave, b = row / S_;
    const float4* xr = (const float4*)(X + (size_t)row * 1024) + lane;
    float4 v[4]; float ss = 0.f;
#pragma unroll
    for (int j = 0; j < 4; ++j) { v[j] = xr[64 * j]; ss += (v[j].x * v[j].x + v[j].y * v[j].y) + (v[j].z * v[j].z + v[j].w * v[j].w); }
    ss = wave_sum(ss);
    const float r = rsqrtf(ss * (1.f / 1024.f) + EPS);
    const float* sh = mod + b * 6144 + shift_idx * 1024; const float* sc = mod + b * 6144 + scale_idx * 1024;
#pragma unroll
    for (int j = 0; j < 4; ++j) {
        const int col = 4 * lane + 256 * j;
        const float4 g4 = *(const float4*)(g + col), s4 = *(const float4*)(sc + col), h4 = *(const float4*)(sh + col);
        const float o0 = v[j].x * r * g4.x * (1.f + s4.x) + h4.x, o1 = v[j].y * r * g4.y * (1.f + s4.y) + h4.y;
        const float o2 = v[j].z * r * g4.z * (1.f + s4.z) + h4.z, o3 = v[j].w * r * g4.w * (1.f + s4.w) + h4.w;
        uint2 w; w.x = pk2(o0, o1); w.y = pk2(o2, o3);
        *(uint2*)(out + (size_t)row * 1024 + col) = w;
    }
}

template <int MODE>
__global__ void __launch_bounds__(256) k_gemm_naive(const bf16_t* A, int lda, const float* W, int K, int N, void* Cout, int ldc, const float* aux1, const float* aux2, float* fl) {
    __shared__ float As[16][64];
    __shared__ float Ws[16][64];
    const int tx = threadIdx.x & 15, ty = threadIdx.x >> 4;
    const int m0 = blockIdx.y * 64, n0 = blockIdx.x * 64;
    float acc[4][4];
#pragma unroll
    for (int i = 0; i < 4; ++i)
#pragma unroll
        for (int j = 0; j < 4; ++j) acc[i][j] = 0.f;
    for (int k0 = 0; k0 < K; k0 += 16) {
        { const int r = threadIdx.x >> 2, kq = (threadIdx.x & 3) * 4; const uint2 a2 = *(const uint2*)(A + (size_t)(m0 + r) * lda + k0 + kq);
          As[kq + 0][r] = lo2f(a2.x); As[kq + 1][r] = hi2f(a2.x); As[kq + 2][r] = lo2f(a2.y); As[kq + 3][r] = hi2f(a2.y); }
        { const int kk = threadIdx.x >> 4, nq = (threadIdx.x & 15) * 4; float4 w4 = make_float4(0.f, 0.f, 0.f, 0.f);
          if (n0 + nq < N) w4 = *(const float4*)(W + (size_t)(k0 + kk) * N + n0 + nq);
          *(float4*)&Ws[kk][nq] = w4; }
        __syncthreads();
#pragma unroll
        for (int kk = 0; kk < 16; ++kk) {
            const float4 a4 = *(const float4*)&As[kk][ty * 4]; const float4 w4 = *(const float4*)&Ws[kk][tx * 4];
            const float a[4] = {a4.x, a4.y, a4.z, a4.w}; const float w[4] = {w4.x, w4.y, w4.z, w4.w};
#pragma unroll
            for (int i = 0; i < 4; ++i)
#pragma unroll
                for (int j = 0; j < 4; ++j) acc[i][j] += a[i] * w[j];
        }
        __syncthreads();
    }
#pragma unroll
    for (int i = 0; i < 4; ++i) {
        const int m = m0 + ty * 4 + i;
#pragma unroll
        for (int j = 0; j < 4; ++j) {
            const int n = n0 + tx * 4 + j;
            if (n < N) {
                if (MODE == 0) ((bf16_t*)Cout)[(size_t)m * ldc + n] = f2bf(acc[i][j]);
                else if (MODE == 1) { if (n < C_FL) ((bf16_t*)Cout)[(size_t)m * ldc + n] = f2bf(acc[i][j]); else fl[(size_t)m * 8 + (n - C_FL)] = acc[i][j]; }
                else { const int b = m / S_; ((float*)Cout)[(size_t)m * ldc + n] = aux1[(size_t)m * 1024 + n] + aux2[b * 6144 + 2 * 1024 + n] * acc[i][j]; }
            }
        }
    }
}

__device__ __forceinline__ void unpack8(const uint4 raw, float* v) {
    v[0] = lo2f(raw.x); v[1] = hi2f(raw.x); v[2] = lo2f(raw.y); v[3] = hi2f(raw.y); v[4] = lo2f(raw.z); v[5] = hi2f(raw.z); v[6] = lo2f(raw.w); v[7] = hi2f(raw.w);
}
__device__ __forceinline__ void rowprep_row(bf16_t* PROJ, const float* FL, const float* g_qa, const float* g_kva, const float* g_fq, const float* g_fk, const float* b_f,
                                                 const int* positions, float* LOGF, float2* ROPE, int row, int lane) {
    bf16_t* pr = PROJ + (size_t)row * PP;
    float v[8];
    {
        float ss = 0.f;
        if (lane < 48) { unpack8(*(const uint4*)(pr + C_CQ + lane * 8), v);
#pragma unroll
            for (int i = 0; i < 8; ++i) ss += v[i] * v[i]; }
        ss = wave_sum(ss);
        const float r = rsqrtf(ss * (1.f / 384.f) + EPS);
        if (lane < 48) { const float* g = g_qa + lane * 8; uint4 o;
            o.x = pk2(v[0] * r * g[0], v[1] * r * g[1]); o.y = pk2(v[2] * r * g[2], v[3] * r * g[3]); o.z = pk2(v[4] * r * g[4], v[5] * r * g[5]); o.w = pk2(v[6] * r * g[6], v[7] * r * g[7]);
            *(uint4*)(pr + C_CQ + lane * 8) = o; }
    }
    {
        float ss = 0.f;
        if (lane < 32) { unpack8(*(const uint4*)(pr + C_CKV + lane * 8), v);
#pragma unroll
            for (int i = 0; i < 8; ++i) ss += v[i] * v[i]; }
        ss = wave_sum(ss);
        const float r = rsqrtf(ss * (1.f / 256.f) + EPS);
        if (lane < 32) { const float* g = g_kva + lane * 8; uint4 o;
            o.x = pk2(v[0] * r * g[0], v[1] * r * g[1]); o.y = pk2(v[2] * r * g[2], v[3] * r * g[3]); o.z = pk2(v[4] * r * g[4], v[5] * r * g[5]); o.w = pk2(v[6] * r * g[6], v[7] * r * g[7]);
            *(uint4*)(pr + C_CKV + lane * 8) = o; }
    }
#pragma unroll
    for (int which = 0; which < 2; ++which) {
        const int coff = which == 0 ? C_FQ : C_FK; const float* g = (which == 0 ? g_fq : g_fk) + (lane & 7) * 8; const float sc = which == 0 ? C2F : 1.f;
        unpack8(*(const uint4*)(pr + coff + lane * 8), v);
        float ss = 0.f;
#pragma unroll
        for (int i = 0; i < 8; ++i) ss += v[i] * v[i];
        ss += __shfl_xor(ss, 1); ss += __shfl_xor(ss, 2); ss += __shfl_xor(ss, 4);
        const float r = rsqrtf(ss * (1.f / 64.f) + EPS) * sc; uint4 o;
        o.x = pk2(v[0] * r * g[0], v[1] * r * g[1]); o.y = pk2(v[2] * r * g[2], v[3] * r * g[3]); o.z = pk2(v[4] * r * g[4], v[5] * r * g[5]); o.w = pk2(v[6] * r * g[6], v[7] * r * g[7]);
        *(uint4*)(pr + coff + lane * 8) = o;
    }
    if (lane < 8) { const float z = FL[(size_t)row * 8 + lane] + b_f[lane]; LOGF[(size_t)row * 8 + lane] = fminf(z, 0.f) - log1pf(expf(-fabsf(z))); }
    if (lane < 16) { const float inv = powf(10000.f, -(float)lane / 16.f); const float ang = (float)positions[row] * inv; float sn, cs; sincosf(ang, &sn, &cs); ROPE[(size_t)row * 16 + lane] = make_float2(cs, sn); }
}

__global__ void __launch_bounds__(256) k_rowprep(bf16_t* PROJ, const float* FL, const float* g_qa, const float* g_kva, const float* g_fq, const float* g_fk, const float* b_f,
                                                 const int* positions, float* LOGF, float2* ROPE) {
    rowprep_row(PROJ, FL, g_qa, g_kva, g_fq, g_fk, b_f, positions, LOGF, ROPE, blockIdx.x * 4 + (threadIdx.x >> 6), threadIdx.x & 63);
}

__device__ __forceinline__ void fcum_item(const float* LOGF, float* FCUM, int item, int lane) {
    const int b = item >> 3, h = item & 7;
    const float* src = LOGF + ((size_t)b * S_) * 8 + h;
    float tot = 0.f;
    for (int i = 0; i < 128; ++i) tot += src[(size_t)(128 * lane + i) * 8];
    float incl = tot;
#pragma unroll
    for (int o = 1; o < 64; o <<= 1) { const float t = __shfl_up(incl, o); if (lane >= o) incl += t; }
    float run = incl - tot;
    float* dst = FCUM + ((size_t)(b * 8 + h)) * S_ + 128 * lane;
    for (int i = 0; i < 128; ++i) { run += src[(size_t)(128 * lane + i) * 8]; dst[i] = run; }
}
__global__ void __launch_bounds__(64) k_fcum(const float* LOGF, float* FCUM) { fcum_item(LOGF, FCUM, blockIdx.x, threadIdx.x); }

__device__ __forceinline__ void mlaprep_row(bf16_t* QRAW, const bf16_t* KVRAW, const bf16_t* PROJ, bf16_t* KA, const float2* ROPE, const float* g_q, const float* g_k, int row, int lane) {
    const int h = lane >> 3, p = lane & 7;
    const float2 cs0 = ROPE[(size_t)row * 16 + 2 * p], cs1 = ROPE[(size_t)row * 16 + 2 * p + 1];
#pragma unroll
    for (int which = 0; which < 2; ++which) {
        const float* g = which == 0 ? g_q : g_k; const float sc = which == 0 ? C2A : 1.f;
        float v[8]; unsigned r1, r2;
        if (which == 0) { const bf16_t* q = QRAW + (size_t)row * 768 + h * 96; unpack8(*(const uint4*)(q + 8 * p), v); r1 = *(const unsigned*)(q + 64 + 2 * p); r2 = *(const unsigned*)(q + 80 + 2 * p); }
        else { unpack8(*(const uint4*)(KVRAW + (size_t)row * 1024 + h * 128 + 8 * p), v); const bf16_t* kp = PROJ + (size_t)row * PP + C_KPE; r1 = *(const unsigned*)(kp + 2 * p); r2 = *(const unsigned*)(kp + 16 + 2 * p); }
        float a0 = lo2f(r1), a1 = hi2f(r1), b0 = lo2f(r2), b1 = hi2f(r2);
        float ss = a0 * a0 + a1 * a1 + b0 * b0 + b1 * b1;
#pragma unroll
        for (int i = 0; i < 8; ++i) ss += v[i] * v[i];
        ss += __shfl_xor(ss, 1); ss += __shfl_xor(ss, 2); ss += __shfl_xor(ss, 4);
        const float r = rsqrtf(ss * (1.f / 96.f) + EPS);
        const float* gn = g + 8 * p;
        a0 *= r * g[64 + 2 * p]; a1 *= r * g[64 + 2 * p + 1]; b0 *= r * g[80 + 2 * p]; b1 *= r * g[80 + 2 * p + 1];
        const float ra0 = a0 * cs0.x - b0 * cs0.y, rb0 = b0 * cs0.x + a0 * cs0.y, ra1 = a1 * cs1.x - b1 * cs1.y, rb1 = b1 * cs1.x + a1 * cs1.y;
        uint4 o; o.x = pk2(v[0] * r * gn[0] * sc, v[1] * r * gn[1] * sc); o.y = pk2(v[2] * r * gn[2] * sc, v[3] * r * gn[3] * sc);
        o.z = pk2(v[4] * r * gn[4] * sc, v[5] * r * gn[5] * sc); o.w = pk2(v[6] * r * gn[6] * sc, v[7] * r * gn[7] * sc);
        bf16_t* dst = (which == 0 ? QRAW : KA) + (size_t)row * 768 + h * 96;
        *(uint4*)(dst + 8 * p) = o; *(unsigned*)(dst + 64 + 2 * p) = pk2(ra0 * sc, ra1 * sc); *(unsigned*)(dst + 80 + 2 * p) = pk2(rb0 * sc, rb1 * sc);
    }
}

__global__ void __launch_bounds__(256) k_mlaprep(bf16_t* QRAW, const bf16_t* KVRAW, const bf16_t* PROJ, bf16_t* KA, const float2* ROPE, const float* g_q, const float* g_k) {
    mlaprep_row(QRAW, KVRAW, PROJ, KA, ROPE, g_q, g_k, blockIdx.x * 4 + (threadIdx.x >> 6), threadIdx.x & 63);
}

template <int DK>
__global__ void __launch_bounds__(256) k_attn_naive(const bf16_t* Q, int pq, int qstep, const bf16_t* K, int pk, int kstep, const bf16_t* V, int pv, int vstep, bf16_t* O, int po, int ostep, const float* FCUM) {
    __shared__ float Ks[64][DK];
    __shared__ float Vs[64][64];
    __shared__ float Bs[64];
    const int bh = blockIdx.x >> 5, qb = blockIdx.x & 31, b = bh >> 3, h = bh & 7;
    const int t = qb * 256 + threadIdx.x;
    const size_t row = (size_t)b * S_ + t;
    float q[DK];
#pragma unroll
    for (int c = 0; c < DK / 8; ++c) unpack8(*(const uint4*)(Q + row * pq + h * qstep + c * 8), q + c * 8);
    float o[64];
#pragma unroll
    for (int d = 0; d < 64; ++d) o[d] = 0.f;
    float m = -INFINITY, l = 0.f;
    const float fq = FCUM ? FCUM[(size_t)(b * 8 + h) * S_ + t] : 0.f;
    const int ntiles = (qb * 256 + 256) / 64;
    for (int kt = 0; kt < ntiles; ++kt) {
        __syncthreads();
        for (int c = threadIdx.x; c < 64 * (DK / 8); c += 256) { const int key = c / (DK / 8), ch = c % (DK / 8); float v[8];
            unpack8(*(const uint4*)(K + ((size_t)b * S_ + kt * 64 + key) * pk + h * kstep + ch * 8), v);
#pragma unroll
            for (int i = 0; i < 8; ++i) Ks[key][ch * 8 + i] = v[i]; }
        for (int c = threadIdx.x; c < 64 * 8; c += 256) { const int key = c >> 3, ch = c & 7; float v[8];
            unpack8(*(const uint4*)(V + ((size_t)b * S_ + kt * 64 + key) * pv + h * vstep + ch * 8), v);
#pragma unroll
            for (int i = 0; i < 8; ++i) Vs[key][ch * 8 + i] = v[i]; }
        if (threadIdx.x < 64) Bs[threadIdx.x] = FCUM ? FCUM[(size_t)(b * 8 + h) * S_ + kt * 64 + threadIdx.x] : 0.f;
        __syncthreads();
        const int kmax = t - kt * 64 + 1;
        for (int kk = 0; kk < 64; ++kk) {
            float s = 0.f;
#pragma unroll
            for (int d = 0; d < DK; ++d) s += q[d] * Ks[kk][d];
            if (FCUM) s += (fq - Bs[kk]) * LOG2E;
            if (kk < kmax) {
                const float mn = fmaxf(m, s), corr = exp2f(m - mn), p = exp2f(s - mn);
                l = l * corr + p;
#pragma unroll
                for (int d = 0; d < 64; ++d) o[d] = o[d] * corr + p * Vs[kk][d];
                m = mn;
            }
        }
    }
    const float rl = 1.f / l;
    bf16_t* op = O + row * po + h * ostep;
#pragma unroll
    for (int c = 0; c < 8; ++c) { uint4 w; w.x = pk2(o[c * 8 + 0] * rl, o[c * 8 + 1] * rl); w.y = pk2(o[c * 8 + 2] * rl, o[c * 8 + 3] * rl); w.z = pk2(o[c * 8 + 4] * rl, o[c * 8 + 5] * rl); w.w = pk2(o[c * 8 + 6] * rl, o[c * 8 + 7] * rl);
        *(uint4*)(op + c * 8) = w; }
}

__device__ __forceinline__ void topk_item(const bf16_t* QP, const float* sub_keys, int* EID, float* GATE, int w, int lane) {
    const int t = w >> 3, h = w & 7;
    float sl0 = 0.f, sl1 = 0.f; int il0 = 0, il1 = 0;
#pragma unroll
    for (int p = 0; p < 2; ++p) {
        const bf16_t* q = QP + (size_t)t * 2048 + h * 256 + p * 128;
        const float* k0 = sub_keys + ((size_t)(h * 2 + p) * 128 + lane) * 128; const float* k1 = k0 + 64 * 128;
        float s0 = 0.f, s1 = 0.f;
        for (int d = 0; d < 128; ++d) { const float qd = bf2f(q[d]); s0 += qd * k0[d]; s1 += qd * k1[d]; }
        float ls = 0.f; int li = 0;
        for (int r = 0; r < 16; ++r) {
            float bv; int bi; if (s0 >= s1) { bv = s0; bi = lane; } else { bv = s1; bi = lane + 64; }
#pragma unroll
            for (int o = 32; o >= 1; o >>= 1) { const float ov = __shfl_xor(bv, o); const int oi = __shfl_xor(bi, o); if (ov > bv || (ov == bv && oi < bi)) { bv = ov; bi = oi; } }
            if (lane == r) { ls = bv; li = bi; }
            if (bi == lane) s0 = -INFINITY; else if (bi == lane + 64) s1 = -INFINITY;
        }
        if (p == 0) { sl0 = ls; il0 = li; } else { sl1 = ls; il1 = li; }
    }
    float cv0, cv1, cv2, cv3;
    { const int c0 = lane, c1 = lane + 64, c2 = lane + 128, c3 = lane + 192;
      cv0 = __shfl(sl0, c0 >> 4) + __shfl(sl1, c0 & 15); cv1 = __shfl(sl0, c1 >> 4) + __shfl(sl1, c1 & 15);
      cv2 = __shfl(sl0, c2 >> 4) + __shfl(sl1, c2 & 15); cv3 = __shfl(sl0, c3 >> 4) + __shfl(sl1, c3 & 15); }
    float tv = -INFINITY; int tc = 0;
    for (int r = 0; r < 16; ++r) {
        float bv = cv0; int bc = lane;
        if (cv1 > bv) { bv = cv1; bc = lane + 64; }
        if (cv2 > bv) { bv = cv2; bc = lane + 128; }
        if (cv3 > bv) { bv = cv3; bc = lane + 192; }
#pragma unroll
        for (int o = 32; o >= 1; o >>= 1) { const float ov = __shfl_xor(bv, o); const int oc = __shfl_xor(bc, o); if (ov > bv || (ov == bv && oc < bc)) { bv = ov; bc = oc; } }
        if (lane == r) { tv = bv; tc = bc; }
        if (bc == lane) cv0 = -INFINITY; else if (bc == lane + 64) cv1 = -INFINITY; else if (bc == lane + 128) cv2 = -INFINITY; else if (bc == lane + 192) cv3 = -INFINITY;
    }
    const float mx = __shfl(tv, 0);
    const float e = lane < 16 ? expf(tv - mx) : 0.f;
    const float sum = wave_sum(e);
    const int e1 = __shfl(il0, (tc >> 4) & 15), e2 = __shfl(il1, tc & 15);
    if (lane < 16) { EID[(size_t)t * 128 + h * 16 + lane] = e1 * 128 + e2; GATE[(size_t)t * 128 + h * 16 + lane] = e / sum; }
}

__global__ void __launch_bounds__(256) k_topk_naive(const bf16_t* QP, const float* sub_keys, int* EID, float* GATE) { topk_item(QP, sub_keys, EID, GATE, blockIdx.x * 4 + (threadIdx.x >> 6), threadIdx.x & 63); }

__device__ __forceinline__ float gelu_tanh(float x) { const float u = 0.7978845608028654f * (x + 0.044715f * x * x * x); return 0.5f * x * (1.f + tanhf(u)); }

__device__ __forceinline__ void gather_item(const bf16_t* H2, const int* EID, const float* GATE, const float* peer_u, const float* peer_v, const float* mod, float* out, int t, int lane) {
    const int b = t / S_;
    float hv[16], y[16];
#pragma unroll
    for (int j = 0; j < 4; ++j) { const uint2 raw = *(const uint2*)(H2 + (size_t)t * 1024 + 4 * lane + 256 * j); hv[4 * j] = lo2f(raw.x); hv[4 * j + 1] = hi2f(raw.x); hv[4 * j + 2] = lo2f(raw.y); hv[4 * j + 3] = hi2f(raw.y); }
#pragma unroll
    for (int i = 0; i < 16; ++i) y[i] = 0.f;
    const int e_a = EID[(size_t)t * 128 + lane], e_b = EID[(size_t)t * 128 + 64 + lane];
    const float g_a = GATE[(size_t)t * 128 + lane], g_b = GATE[(size_t)t * 128 + 64 + lane];
    for (int jj = 0; jj < 128; ++jj) {
        const int e = jj < 64 ? __shfl(e_a, jj) : __shfl(e_b, jj - 64);
        const float g = jj < 64 ? __shfl(g_a, jj) : __shfl(g_b, jj - 64);
        const float4* ur = (const float4*)(peer_u + (size_t)e * 1024) + lane;
        float s = 0.f;
#pragma unroll
        for (int j = 0; j < 4; ++j) { const float4 u4 = ur[64 * j]; s += (u4.x * hv[4 * j] + u4.y * hv[4 * j + 1]) + (u4.z * hv[4 * j + 2] + u4.w * hv[4 * j + 3]); }
        s = wave_sum(s);
        const float wgt = g * gelu_tanh(s);
        const float4* vr = (const float4*)(peer_v + (size_t)e * 1024) + lane;
#pragma unroll
        for (int j = 0; j < 4; ++j) { const float4 v4 = vr[64 * j]; y[4 * j] += wgt * v4.x; y[4 * j + 1] += wgt * v4.y; y[4 * j + 2] += wgt * v4.z; y[4 * j + 3] += wgt * v4.w; }
    }
    const float* g2 = mod + b * 6144 + 5 * 1024;
#pragma unroll
    for (int j = 0; j < 4; ++j) { const int col = 4 * lane + 256 * j; float4* op = (float4*)(out + (size_t)t * 1024 + col); float4 x1 = *op; const float4 gg = *(const float4*)(g2 + col);
        x1.x += gg.x * y[4 * j]; x1.y += gg.y * y[4 * j + 1]; x1.z += gg.z * y[4 * j + 2]; x1.w += gg.w * y[4 * j + 3]; *op = x1; }
}
__global__ void __launch_bounds__(256) k_gather_naive(const bf16_t* H2, const int* EID, const float* GATE, const float* peer_u, const float* peer_v, const float* mod, float* out) {
    gather_item(H2, EID, GATE, peer_u, peer_v, mod, out, blockIdx.x * 4 + (threadIdx.x >> 6), threadIdx.x & 63);
}


namespace pg8 {
#define PG8_LAS __attribute__((address_space(3)))
typedef unsigned short bf16_t;
typedef short bf16x8 __attribute__((ext_vector_type(8)));
typedef float f32x4 __attribute__((ext_vector_type(4)));
typedef unsigned u32x4 __attribute__((ext_vector_type(4)));
constexpr int BM = 256, BK = 64, HALF = 128, HTB = HALF * BK * 2  , STAGE_BYTES = 8 * HTB, NXCD = 8, WGM = 8;

__host__ __device__ __forceinline__ int lds_byte(int r, int c) { const int st = (r >> 4) * 2 + (c >> 5), rr = r & 15, cc = c & 31, ob = rr * 64 + cc * 2; return st * 1024 + (ob ^ (((ob >> 9) & 1) << 5)); }
__host__ __device__ __forceinline__ void stage_rc(int b, int& R, int& C) { const int st = b / 1024, sb = b % 1024, swz = sb ^ (((sb >> 9) & 1) << 5); R = (st >> 1) * 16 + swz / 64; C = (st & 1) * 32 + (swz % 64) / 2; }
__host__ __device__ __forceinline__ int perm32(int rho) { const int n = rho >> 4, i = rho & 15; return 8 * (i >> 2) + 4 * n + (i & 3); }

struct Unit { int pm, pn; };
struct Gemm { const bf16_t* A; const bf16_t* Bt; int M, N, K, lda; };

struct StaticOrder {
    int nM, nN, nwg, G, c;
    __host__ __device__ void init(int M, int N, int G_, int c_) { nM = M / BM; nN = N / BM; nwg = nM * nN; G = G_; c = c_; }
    __host__ __device__ bool next(int i, Unit& u) const {
        const long L = (long)i * G + c; if (L >= nwg) return false;
        int wgid = (int)L; { const int q = nwg / NXCD, r = nwg % NXCD, xcd = wgid % NXCD, off = wgid / NXCD; wgid = (xcd < r ? xcd * (q + 1) : r * (q + 1) + (xcd - r) * q) + off; }
        const int nig = WGM * nN, gid = wgid / nig, fm = gid * WGM, gsz = (nM - fm) < WGM ? (nM - fm) : WGM;
        u.pm = fm + ((wgid % nig) % gsz); u.pn = (wgid % nig) / gsz; return true;
    }
    __device__ __forceinline__ void a_ready(const Unit&) const {}
    __device__ __forceinline__ void done(const Unit&) const {}
};
__device__ __forceinline__ unsigned cvt_pk_bf16(float lo, float hi) { unsigned r; asm volatile("v_cvt_pk_bf16_f32 %0, %1, %2" : "=v"(r) : "v"(lo), "v"(hi)); return r; }
typedef float f32x2 __attribute__((ext_vector_type(2)));
template <class Epi, class Sched, bool ALIGN_EPI = false, bool SP2 = false>
__device__ __forceinline__ void gemm_phase(PG8_LAS unsigned char* lds, const Gemm g, const Sched& S, const Epi& E) {
    const int tid = threadIdx.x, wid = __builtin_amdgcn_readfirstlane(tid >> 6), lane = tid & 63, wr = wid >> 2, wc = wid & 3, fr = lane & 15, fq = lane >> 4;
    const int K = g.K, nt = K / BK;
    unsigned voffA[2], voffB[2];
#pragma unroll
    for (int i = 0; i < 2; ++i) { int R, C; stage_rc(tid * 16 + i * 8192, R, C); const int Rb = Epi::PERM ? ((R & ~31) + perm32(R & 31)) : R;
        voffA[i] = (unsigned)(R * g.lda + C) * 2u; voffB[i] = (unsigned)(Rb * K + C) * 2u; }
    const size_t kstep = (size_t)(BK * 2);
    const size_t hstepA = (size_t)HALF * g.lda * 2, hstepB = (size_t)HALF * K * 2;
    const size_t tstepA = 2 * hstepA, tstepB = 2 * hstepB;
    const unsigned ldsw = (unsigned)wid * 1024u;
    const int aoff = lds_byte(wr * 64 + fr, fq * 8), boff = lds_byte(wc * 32 + fr, fq * 8);
#define PG8_SA(b, h) (((b) * 2 + (h)) * HTB)
#define PG8_SB(b, h) ((4 + (b) * 2 + (h)) * HTB)
#define PG8_STAGE(bufoff, gbase, voff) do { _Pragma("unroll") for (int _i = 0; _i < 2; ++_i) \
        __builtin_amdgcn_global_load_lds((const unsigned*)((const char*)(gbase) + (voff)[_i]), (PG8_LAS unsigned*)(lds + (bufoff) + ldsw + _i * 8192), 16, 0, 0); } while (0)
#define PG8_LDA(dst, b, h) do { _Pragma("unroll") for (int m = 0; m < 4; ++m) _Pragma("unroll") for (int k = 0; k < 2; ++k) dst[m][k] = *(const PG8_LAS bf16x8*)(lds + PG8_SA(b, h) + aoff + m * 2048 + k * 1024); } while (0)
#define PG8_LDB(dst, b, h) do { _Pragma("unroll") for (int n = 0; n < 2; ++n) _Pragma("unroll") for (int k = 0; k < 2; ++k) dst[n][k] = *(const PG8_LAS bf16x8*)(lds + PG8_SB(b, h) + boff + n * 2048 + k * 1024); } while (0)
#define PG8_MMA(ai, bj, At, Bt) do { __builtin_amdgcn_s_setprio(1); _Pragma("unroll") for (int m = 0; m < 4; ++m) _Pragma("unroll") for (int n = 0; n < 2; ++n) _Pragma("unroll") for (int k = 0; k < 2; ++k) \
        acc[ai][bj][m][n] = __builtin_amdgcn_mfma_f32_16x16x32_bf16(Bt[n][k], At[m][k], acc[ai][bj][m][n], 0, 0, 0); __builtin_amdgcn_s_setprio(0); } while (0)
#define PG8_WAIT_V(n) asm volatile("s_waitcnt vmcnt(" #n ")" ::: "memory")
#define PG8_WAIT_L(n) asm volatile("s_waitcnt lgkmcnt(" #n ")" ::: "memory")
#define PG8_BAR __builtin_amdgcn_s_barrier()
#define PG8_SCHED __builtin_amdgcn_sched_barrier(0)
    Unit cur, nxt; int ui = 0;
    if (!S.next(0, cur)) return;
    f32x4 acc[2][2][4][2];
#pragma unroll
    for (int a = 0; a < 2; ++a)
#pragma unroll
        for (int b = 0; b < 2; ++b)
#pragma unroll
            for (int m = 0; m < 4; ++m)
#pragma unroll
                for (int n = 0; n < 2; ++n) acc[a][b][m][n] = (f32x4){0.f, 0.f, 0.f, 0.f};
    bf16x8 At[4][2], B0[2][2], B1[2][2];
    const char* cA = (const char*)g.A + (size_t)cur.pm * tstepA; const char* cB = (const char*)g.Bt + (size_t)cur.pn * tstepB;
    S.a_ready(cur);
    if constexpr (SP2) {
        PG8_STAGE(PG8_SB(0, 0), cB, voffB); PG8_STAGE(PG8_SB(0, 1), cB + hstepB, voffB); PG8_STAGE(PG8_SA(0, 0), cA, voffA); PG8_STAGE(PG8_SA(0, 1), cA + hstepA, voffA);
        if (wr == 1) PG8_BAR;
        PG8_WAIT_V(2); PG8_BAR;
        PG8_STAGE(PG8_SB(1, 0), cB + kstep, voffB); PG8_STAGE(PG8_SA(1, 0), cA + kstep, voffA); PG8_STAGE(PG8_SB(1, 1), cB + hstepB + kstep, voffB);
        PG8_WAIT_V(6); PG8_BAR;
    } else {
        PG8_STAGE(PG8_SB(0, 0), cB, voffB); PG8_STAGE(PG8_SA(0, 0), cA, voffA); PG8_STAGE(PG8_SB(0, 1), cB + hstepB, voffB); PG8_STAGE(PG8_SA(0, 1), cA + hstepA, voffA);
        if (wr == 1) PG8_BAR;
        PG8_WAIT_V(4); PG8_BAR;
        PG8_STAGE(PG8_SB(1, 0), cB + kstep, voffB); PG8_STAGE(PG8_SA(1, 0), cA + kstep, voffA); PG8_STAGE(PG8_SB(1, 1), cB + hstepB + kstep, voffB);
        PG8_WAIT_V(6); PG8_BAR;
    }
    for (;;) {
        const bool has_next = S.next(ui + 1, nxt);
        const char* nA = has_next ? (const char*)g.A + (size_t)nxt.pm * tstepA : cA; const char* nB = has_next ? (const char*)g.Bt + (size_t)nxt.pn * tstepB : cB;
        for (int t = 0; t < nt; t += 2) {
            const bool last = (t == nt - 2);
            const char* a1 = cA + (size_t)(t + 1) * kstep;
            const char* a2 = last ? nA : cA + (size_t)(t + 2) * kstep; const char* b2 = last ? nB : cB + (size_t)(t + 2) * kstep;
            const char* a3 = a2 + kstep; const char* b3 = b2 + kstep;
            if (last && has_next) S.a_ready(nxt);
            if constexpr (SP2) {
            PG8_LDB(B0, 0, 0); PG8_LDB(B1, 0, 1); PG8_SCHED; PG8_LDA(At, 0, 0); PG8_STAGE(PG8_SA(1, 1), a1 + hstepA, voffA);
            PG8_WAIT_V(8); PG8_WAIT_L(0); PG8_BAR; PG8_MMA(0, 0, At, B0); PG8_MMA(0, 1, At, B1); PG8_BAR; PG8_SCHED;
            PG8_LDA(At, 0, 1); PG8_STAGE(PG8_SB(0, 0), b2, voffB); PG8_STAGE(PG8_SB(0, 1), b2 + hstepB, voffB); PG8_STAGE(PG8_SA(0, 0), a2, voffA);
            PG8_WAIT_V(8); PG8_WAIT_L(0); PG8_BAR; PG8_MMA(1, 0, At, B0); PG8_MMA(1, 1, At, B1); PG8_BAR; PG8_SCHED;
            PG8_LDB(B0, 1, 0); PG8_LDB(B1, 1, 1); PG8_SCHED; PG8_LDA(At, 1, 0); PG8_STAGE(PG8_SA(0, 1), a2 + hstepA, voffA);
            PG8_WAIT_V(8); PG8_WAIT_L(0); PG8_BAR; PG8_MMA(0, 0, At, B0); PG8_MMA(0, 1, At, B1); PG8_BAR; PG8_SCHED;
            PG8_LDA(At, 1, 1); PG8_STAGE(PG8_SB(1, 0), b3, voffB); PG8_STAGE(PG8_SB(1, 1), b3 + hstepB, voffB); PG8_STAGE(PG8_SA(1, 0), a3, voffA);
            PG8_WAIT_V(8); PG8_WAIT_L(0); PG8_BAR; PG8_MMA(1, 0, At, B0); PG8_MMA(1, 1, At, B1); PG8_BAR; PG8_SCHED;
            } else {
            PG8_LDB(B0, 0, 0); PG8_SCHED; PG8_LDA(At, 0, 0); PG8_STAGE(PG8_SA(1, 1), a1 + hstepA, voffA);
            PG8_WAIT_L(8); PG8_BAR; PG8_WAIT_L(0); PG8_MMA(0, 0, At, B0); PG8_BAR; PG8_SCHED;
            PG8_LDB(B1, 0, 1); PG8_STAGE(PG8_SB(0, 0), b2, voffB);
            PG8_BAR; PG8_WAIT_L(0); PG8_MMA(0, 1, At, B1); PG8_BAR;
            PG8_LDA(At, 0, 1); PG8_STAGE(PG8_SA(0, 0), a2, voffA);
            PG8_BAR; PG8_WAIT_L(0); PG8_MMA(1, 0, At, B0); PG8_BAR; PG8_SCHED;
            PG8_STAGE(PG8_SB(0, 1), b2 + hstepB, voffB);
            PG8_WAIT_V(6); PG8_BAR; PG8_MMA(1, 1, At, B1); PG8_BAR;
            PG8_LDB(B0, 1, 0); PG8_SCHED; PG8_LDA(At, 1, 0); PG8_STAGE(PG8_SA(0, 1), a2 + hstepA, voffA);
            PG8_WAIT_L(8); PG8_BAR; PG8_WAIT_L(0); PG8_MMA(0, 0, At, B0); PG8_BAR; PG8_SCHED;
            PG8_LDB(B1, 1, 1); PG8_STAGE(PG8_SB(1, 0), b3, voffB);
            PG8_BAR; PG8_WAIT_L(0); PG8_MMA(0, 1, At, B1); PG8_BAR;
            PG8_LDA(At, 1, 1); PG8_STAGE(PG8_SA(1, 0), a3, voffA);
            PG8_BAR; PG8_WAIT_L(0); PG8_MMA(1, 0, At, B0); PG8_BAR; PG8_SCHED;
            PG8_STAGE(PG8_SB(1, 1), b3 + hstepB, voffB);
            PG8_WAIT_V(6); PG8_BAR; PG8_MMA(1, 1, At, B1); PG8_BAR;
            }
        }
        if constexpr (ALIGN_EPI) { if (wr == 0) PG8_BAR; }
        if constexpr (!Epi::AFTER_DRAIN) { E(acc, cur, wr, wc, fr, fq); S.done(cur); }
        if (!has_next) break;
#pragma unroll
        for (int a = 0; a < 2; ++a)
#pragma unroll
            for (int b = 0; b < 2; ++b)
#pragma unroll
                for (int m = 0; m < 4; ++m)
#pragma unroll
                    for (int n = 0; n < 2; ++n) acc[a][b][m][n] = (f32x4){0.f, 0.f, 0.f, 0.f};
        cur = nxt; cA = nA; cB = nB; ++ui;
        if constexpr (ALIGN_EPI) { if (wr == 1) PG8_BAR; }
    }
    PG8_WAIT_V(0);
    if constexpr (!ALIGN_EPI) { if (wr == 0) PG8_BAR; }
    PG8_BAR;
    if constexpr (Epi::AFTER_DRAIN) { E.fused(acc, cur, wr, wc, fr, fq, lds, wid, lane); S.done(cur); }
#undef PG8_SA
#undef PG8_SB
#undef PG8_STAGE
#undef PG8_LDA
#undef PG8_LDB
#undef PG8_MMA
#undef PG8_WAIT_V
#undef PG8_WAIT_L
#undef PG8_BAR
#undef PG8_SCHED
}
}


#define GAS __attribute__((address_space(1)))
#define LAS __attribute__((address_space(3)))
typedef float f32x4 __attribute__((ext_vector_type(4)));
typedef unsigned u32x4 __attribute__((ext_vector_type(4)));
#define XB_TMO      128
#define XB_XCNT(j)  (256  + 64 * (j))
#define XB_XSUB(j)  (1280 + 64 * (j))
#define XB_XGEN(j)  (2304 + 64 * (j))
#define XB_TOP      3328
#define XB_TOPGEN   3392
#define XCD_BAR_WORDS 3456
#define XB_SPIN_CAP (1u << 18)

__device__ __forceinline__ unsigned xb_ld(unsigned* p)              { return __hip_atomic_load(p, __ATOMIC_RELAXED, __HIP_MEMORY_SCOPE_AGENT); }
__device__ __forceinline__ unsigned xb_add(unsigned* p, unsigned v) { return __hip_atomic_fetch_add(p, v, __ATOMIC_RELAXED, __HIP_MEMORY_SCOPE_AGENT); }
__device__ __forceinline__ unsigned xb_xcc_id() { return (unsigned)__builtin_amdgcn_s_getreg((3 << 11) | 20) & 0xFu; }
#define XB_SPIN(cond, bar) do { unsigned _sp = 0; while (cond) { __builtin_amdgcn_s_sleep(1); \
    if ((++_sp & 255u) == 0u) { if (xb_ld(&(bar)[XB_TMO])) break; if (_sp > XB_SPIN_CAP) { atomicAdd(&(bar)[XB_TMO], 1u); break; } } } } while (0)

struct XcdBarrier {
    unsigned* bar; unsigned x;
    volatile LAS unsigned* st;
};

__device__ __forceinline__ XcdBarrier xcd_barrier_post(unsigned* bar, volatile LAS unsigned* st) {
    XcdBarrier b; b.bar = bar; b.x = xb_xcc_id(); b.st = st;
    if (threadIdx.x == 0) (void)xb_add(&bar[XB_XCNT(b.x)], 1u);
    return b;
}
__device__ __forceinline__ void xcd_barrier_complete(unsigned* bar, unsigned x, unsigned& nloc, unsigned& nx) {
    const unsigned G = gridDim.x * gridDim.y * gridDim.z;
    unsigned sum, cnt, mine, sp = 0u;
    for (;;) {
        sum = 0u; cnt = 0u; mine = 0u;
#pragma unroll
        for (unsigned j = 0; j < 16; ++j) { const unsigned c = xb_ld(&bar[XB_XCNT(j)]); sum += c; cnt += (c > 0u) ? 1u : 0u; mine = (j == x) ? c : mine; }
        if (sum == G) break;
        __builtin_amdgcn_s_sleep(1);
        if ((++sp & 255u) == 0u) { if (xb_ld(&bar[XB_TMO])) break; if (sp > XB_SPIN_CAP) { atomicAdd(&bar[XB_TMO], 1u); break; } }
    }
    nloc = mine > 0u ? mine : 1u; nx = cnt > 0u ? cnt : 1u;
}

__device__ __forceinline__ void xcd_barrier(const XcdBarrier& b) {
    asm volatile("s_waitcnt vmcnt(0)" ::: "memory");
    __syncthreads();
    if (threadIdx.x == 0) {
        unsigned* bar = b.bar;
        __builtin_amdgcn_s_waitcnt(0);
        unsigned nloc = b.st[0], nx = b.st[1];
        if (nloc == 0u) { xcd_barrier_complete(bar, b.x, nloc, nx); b.st[0] = nloc; b.st[1] = nx; }
        const unsigned old = xb_add(&bar[XB_XSUB(b.x)], 1u);
        const unsigned gen = old / nloc;
        if (old + 1u == (gen + 1u) * nloc) {
            __builtin_amdgcn_fence(__ATOMIC_RELEASE, "agent");
            asm volatile("s_waitcnt vmcnt(0)" ::: "memory");
            const unsigned og = xb_add(&bar[XB_TOP], 1u);
            const unsigned tg = og / nx;
            if (og + 1u == (tg + 1u) * nx) xb_add(&bar[XB_TOPGEN], 1u);
            else XB_SPIN(xb_ld(&bar[XB_TOPGEN]) == tg, bar);
            __builtin_amdgcn_fence(__ATOMIC_ACQUIRE, "agent");
            xb_add(&bar[XB_XGEN(b.x)], 1u);
            asm volatile("s_waitcnt vmcnt(0)" ::: "memory");
        } else {
            XB_SPIN(xb_ld(&bar[XB_XGEN(b.x)]) == gen, bar);
            __builtin_amdgcn_fence(__ATOMIC_ACQUIRE, "agent");
            asm volatile("s_waitcnt vmcnt(0)" ::: "memory");
        }
    }
    __syncthreads();
}


constexpr int NWAVES = 8;
constexpr int RING_BYTES = 131072, LDSCTL_OFF = RING_BYTES, MISC_OFF = LDSCTL_OFF + 320, LDS_BYTES = 147456;
constexpr size_t WS_CTL = 0, CTL_ZERO_BYTES = 1 * MiB;
constexpr int CW_BAR = 4096, N_BAR_REGIONS = 16;
static_assert((CW_BAR + N_BAR_REGIONS * XCD_BAR_WORDS) * 4 <= (int)CTL_ZERO_BYTES, "barrier words inside the memset region");
constexpr size_t WS_WIN = 10 * MiB;
constexpr size_t WS_WUQ = 15 * MiB;
constexpr size_t WS_WUKV = 16 * MiB;
constexpr size_t WS_WO = 17 * MiB;
constexpr size_t WS_WPQ = 19 * MiB;
constexpr size_t WS_SK = 23 * MiB;
constexpr size_t WS_U16 = 24 * MiB;
constexpr size_t WS_V16 = 56 * MiB;


namespace att {
typedef short bf16x8 __attribute__((ext_vector_type(8)));
typedef short s16x4 __attribute__((ext_vector_type(4)));
typedef float f32x16 __attribute__((ext_vector_type(16)));
constexpr int LK = 0, KSLOT = 12288, LV = 2 * KSLOT, VSLOT = 8192, LB = LV + 2 * VSLOT, BSLOT = 256, LWS = LB + 2 * BSLOT, LOST = LWS + 8 * 256, ATT_LDS = LOST + 8 * 4096;
static_assert(ATT_LDS <= 131072, "attention scratch fits the ring region");
struct Desc { const bf16_t* Q; int pq; const bf16_t* K; int pk; const bf16_t* V; int pv; bf16_t* O; int po; const float* FC; };

__device__ __forceinline__ int crow(int r, int hi) { return (r & 3) + 8 * (r >> 2) + 4 * hi; }
__device__ __forceinline__ float xmax32(float v) { auto rr = __builtin_amdgcn_permlane32_swap(__float_as_uint(v), __float_as_uint(v), false, false); return fmaxf(__uint_as_float(rr[0]), __uint_as_float(rr[1])); }
__device__ __forceinline__ float xsum32(float v) { auto rr = __builtin_amdgcn_permlane32_swap(__float_as_uint(v), __float_as_uint(v), false, false); return __uint_as_float(rr[0]) + __uint_as_float(rr[1]); }
__device__ __forceinline__ unsigned cvtpk(float lo, float hi) { typedef float f2 __attribute__((ext_vector_type(2))); typedef __bf16 b2 __attribute__((ext_vector_type(2))); f2 v = {lo, hi}; b2 b = __builtin_convertvector(v, b2); return __builtin_bit_cast(unsigned, b); }
typedef short v4i16_t __attribute__((ext_vector_type(4)));
__device__ __forceinline__ s16x4 vtr(LAS const unsigned char* p) { return __builtin_bit_cast(s16x4, __builtin_amdgcn_ds_read_tr16_b64_v4i16((LAS v4i16_t*)p)); }

template <int KS, bool BIAS>
__device__ __forceinline__ void attn_unit(const Desc& d, int qb, int j0, LAS unsigned char* shm) {
    const int tid = threadIdx.x, lane = tid & 63, r32 = lane & 31, hi = lane >> 5; const int wid = __builtin_amdgcn_readfirstlane(tid >> 6);
    const int q0 = qb * 256, NT = (q0 + 256) / 64;
    LAS float* wsf = (LAS float*)(shm + LWS) + wid * 64;
    bf16x8 qr[KS];
    { const bf16_t* qp = d.Q + (size_t)(q0 + wid * 32 + r32) * d.pq + hi * 8;
#pragma unroll
      for (int d0 = 0; d0 < KS; ++d0) qr[d0] = *(const bf16x8*)(qp + d0 * 16); }
    const float fcref = BIAS ? d.FC[q0] : 0.f;
    const bf16_t* ksrc0 = d.K + (size_t)lane * d.pk + wid * 8;
    const bf16_t* ksrc1 = d.K + (size_t)lane * d.pk + (8 + wid) * 8;
    const bf16_t* vsrc = d.V + (size_t)(16 * (wid & 3) + (lane >> 2)) * d.pv + (wid >> 2) * 32 + (lane & 3) * 8;
    const int kdst0 = LK + wid * 1024 + lane * 16, kdst1 = LK + (8 + wid) * 1024 + lane * 16, vdst = LV + wid * 1024 + lane * 16;
    const bool k2 = (KS > 4) && (wid < 2 * KS - 8);
    u32x4 kr0, kr1, vr; float br = 0.f;
#define ATT_LOAD(t) do { kr0 = *(const u32x4*)(ksrc0 + (size_t)(t) * 64 * d.pk); if (k2) kr1 = *(const u32x4*)(ksrc1 + (size_t)(t) * 64 * d.pk); \
        vr = *(const u32x4*)(vsrc + (size_t)(t) * 64 * d.pv); if (BIAS && wid == 4) br = d.FC[(t) * 64 + lane]; } while (0)
#define ATT_WRITE(slot) do { *(LAS u32x4*)(shm + kdst0 + (slot) * KSLOT) = kr0; if (k2) *(LAS u32x4*)(shm + kdst1 + (slot) * KSLOT) = kr1; \
        *(LAS u32x4*)(shm + vdst + (slot) * VSLOT) = vr; if (BIAS && wid == 4) *(LAS float*)(shm + LB + (slot) * BSLOT + lane * 4) = (fcref - br) * LOG2E; } while (0)
    f32x16 o0, o1;
#pragma unroll
    for (int r = 0; r < 16; ++r) { o0[r] = 0.f; o1[r] = 0.f; }
    float m = -INFINITY, l = 0.f;
    const int qrel = wid * 32 + r32;
    const int kfrag = LK + hi * 1024 + r32 * 16;
    const int vfrag = LV + ((lane >> 4) & 1) * 32 + (lane & 3) * 8 + (4 * hi + ((lane & 15) >> 2)) * 64;
    ATT_LOAD(j0); ATT_WRITE(0);
    __syncthreads();
    for (int t = j0; t < NT; ++t) {
        const int slot = (t - j0) & 1;
        if (t + 1 < NT) ATT_LOAD(t + 1);
        const int jb = t - (NT - 4);
        if (!(jb >= 0 && 64 * jb > 32 * wid + 31)) {
            f32x16 p0, p1;
            if (BIAS) {
                LAS const unsigned char* bp = shm + LB + slot * BSLOT + 16 * hi;
#pragma unroll
                for (int g = 0; g < 4; ++g) { const f32x4 a = *(LAS const f32x4*)(bp + 32 * g), b = *(LAS const f32x4*)(bp + 128 + 32 * g);
                    p0[4 * g] = a[0]; p0[4 * g + 1] = a[1]; p0[4 * g + 2] = a[2]; p0[4 * g + 3] = a[3]; p1[4 * g] = b[0]; p1[4 * g + 1] = b[1]; p1[4 * g + 2] = b[2]; p1[4 * g + 3] = b[3]; }
            } else {
#pragma unroll
                for (int r = 0; r < 16; ++r) { p0[r] = 0.f; p1[r] = 0.f; }
            }
            LAS const unsigned char* kp = shm + kfrag + slot * KSLOT;
#pragma unroll
            for (int d0 = 0; d0 < KS; ++d0) {
                const bf16x8 a0 = *(LAS const bf16x8*)(kp + d0 * 2048), a1 = *(LAS const bf16x8*)(kp + d0 * 2048 + 512);
                p0 = __builtin_amdgcn_mfma_f32_32x32x16_bf16(a0, qr[d0], p0, 0, 0, 0);
                p1 = __builtin_amdgcn_mfma_f32_32x32x16_bf16(a1, qr[d0], p1, 0, 0, 0);
            }
            if (jb >= 0) {
                const int kb = 64 * jb + 4 * hi;
#pragma unroll
                for (int r = 0; r < 16; ++r) { const int kv = kb + (r & 3) + 8 * (r >> 2); if (kv > qrel) p0[r] = -INFINITY; if (kv + 32 > qrel) p1[r] = -INFINITY; }
            }
            float rm = fmaxf(p0[0], p1[0]);
#pragma unroll
            for (int r = 1; r < 16; ++r) rm = fmaxf(rm, fmaxf(p0[r], p1[r]));
            rm = xmax32(rm);
            const float mn = fmaxf(m, rm);
            const float alpha = __builtin_amdgcn_exp2f(m - mn);
            m = mn;
            float sacc = 0.f;
#pragma unroll
            for (int r = 0; r < 16; ++r) { p0[r] = __builtin_amdgcn_exp2f(p0[r] - mn); p1[r] = __builtin_amdgcn_exp2f(p1[r] - mn); sacc += p0[r] + p1[r]; }
            l = l * alpha + sacc;
            if (__any(alpha != 1.f)) {
                if (hi == 0) wsf[r32] = alpha;
#pragma unroll
                for (int g = 0; g < 4; ++g) { const f32x4 a = *(LAS const f32x4*)(wsf + 8 * g + 4 * hi);
#pragma unroll
                    for (int i = 0; i < 4; ++i) { o0[4 * g + i] *= a[i]; o1[4 * g + i] *= a[i]; } }
            }
            LAS const unsigned char* vp = shm + vfrag + slot * VSLOT;
#pragma unroll
            for (int ks = 0; ks < 4; ++ks) {
                const f32x16& pp = ks < 2 ? p0 : p1; const int bq = (ks & 1) * 8;
                u32x4 pw; pw.x = cvtpk(pp[bq], pp[bq + 1]); pw.y = cvtpk(pp[bq + 2], pp[bq + 3]); pw.z = cvtpk(pp[bq + 4], pp[bq + 5]); pw.w = cvtpk(pp[bq + 6], pp[bq + 7]);
                const bf16x8 pa = __builtin_bit_cast(bf16x8, pw);
                const s16x4 l0 = vtr(vp + ks * 1024), h0 = vtr(vp + ks * 1024 + 512), l1 = vtr(vp + 4096 + ks * 1024), h1 = vtr(vp + 4096 + ks * 1024 + 512);
                const bf16x8 v0 = {l0[0], l0[1], l0[2], l0[3], h0[0], h0[1], h0[2], h0[3]}, v1 = {l1[0], l1[1], l1[2], l1[3], h1[0], h1[1], h1[2], h1[3]};
                o0 = __builtin_amdgcn_mfma_f32_32x32x16_bf16(pa, v0, o0, 0, 0, 0);
                o1 = __builtin_amdgcn_mfma_f32_32x32x16_bf16(pa, v1, o1, 0, 0, 0);
            }
        }
        if (t + 1 < NT) ATT_WRITE(slot ^ 1);
        __syncthreads();
    }
#undef ATT_LOAD
#undef ATT_WRITE
    l = xsum32(l);
    if (hi == 0) wsf[32 + r32] = l;
    float rli[16];
#pragma unroll
    for (int g = 0; g < 4; ++g) { const f32x4 a = *(LAS const f32x4*)(wsf + 32 + 8 * g + 4 * hi);
#pragma unroll
        for (int i = 0; i < 4; ++i) rli[4 * g + i] = 1.f / a[i]; }
    LAS bf16_t* stg = (LAS bf16_t*)(shm + LOST) + wid * 2048;
#pragma unroll
    for (int r = 0; r < 16; ++r) { const int orow = crow(r, hi); stg[orow * 64 + r32] = f2bf(o0[r] * rli[r]); stg[orow * 64 + 32 + r32] = f2bf(o1[r] * rli[r]); }
    bf16_t* Ow = d.O + (size_t)(q0 + wid * 32) * d.po;
#pragma unroll
    for (int i = 0; i < 4; ++i) { const int row = i * 8 + (lane >> 3), ch = lane & 7; const u32x4 v = *(LAS const u32x4*)(stg + row * 64 + ch * 8); *(u32x4*)(Ow + (size_t)row * d.po + ch * 8) = v; }
    __syncthreads();
}
}


namespace pk {
typedef short bf16x8 __attribute__((ext_vector_type(8)));
typedef float f32x16 __attribute__((ext_vector_type(16)));
__device__ __forceinline__ unsigned f2sort(float f) { const unsigned b = __float_as_uint(f); return b ^ ((unsigned)((int)b >> 31) | 0x80000000u); }
__device__ __forceinline__ float sort2f(unsigned u) { return __uint_as_float((u & 0x80000000u) ? (u ^ 0x80000000u) : ~u); }
__device__ __forceinline__ void ce(unsigned& a, unsigned& b) { const unsigned mx = a > b ? a : b, mn = a > b ? b : a; a = mx; b = mn; }
__device__ __forceinline__ void sort16(unsigned (&v)[16]) {
#pragma unroll
    for (int k = 2; k <= 16; k <<= 1)
#pragma unroll
        for (int j = k >> 1; j >= 1; j >>= 1)
#pragma unroll
            for (int i = 0; i < 16; ++i) { const int l = i ^ j; if (l > i) { if ((i & k) == 0) ce(v[i], v[l]); else ce(v[l], v[i]); } }
}
__device__ __forceinline__ void merge16(unsigned (&a)[16], const unsigned (&b)[16]) {
#pragma unroll
    for (int i = 0; i < 16; ++i) a[i] = a[i] > b[15 - i] ? a[i] : b[15 - i];
#pragma unroll
    for (int j = 8; j >= 1; j >>= 1)
#pragma unroll
        for (int i = 0; i < 16; ++i) { const int l = i ^ j; if (l > i) ce(a[i], a[l]); }
}
__device__ __forceinline__ void top16of64(unsigned (&k)[64], unsigned (&out)[16]) {
    unsigned g1[16], g2[16], g3[16];
#pragma unroll
    for (int i = 0; i < 16; ++i) { out[i] = k[i]; g1[i] = k[16 + i]; g2[i] = k[32 + i]; g3[i] = k[48 + i]; }
    sort16(out); sort16(g1); sort16(g2); sort16(g3);
    merge16(out, g1); merge16(g2, g3); merge16(out, g2);
}
__device__ __forceinline__ unsigned sel4(const unsigned (&w)[4], int q) { const unsigned a = q & 1 ? w[1] : w[0], b = q & 1 ? w[3] : w[2]; return q & 2 ? b : a; }

template <int I> struct COff { static constexpr int v = COff<I - 1>::v + 16 / I; };
template <> struct COff<0> { static constexpr int v = 0; };
static_assert(COff<16>::v == 50, "50 candidates can reach the top 16 of a sorted 16 x 16 sum grid");
template <int I> __device__ __forceinline__ void fill_cand(unsigned (&c64)[64], const float (&s1)[16], const float (&s2)[16]) {
    if constexpr (I < 16) {
#pragma unroll
        for (int j = 0; j < 16 / (I + 1); ++j) c64[COff<I>::v + j] = (f2sort(s1[I] + s2[j]) & 0xFFFFFF00u) | (unsigned)(255 - (I * 16 + j));
        fill_cand<I + 1>(c64, s1, s2);
    }
}
__device__ __forceinline__ void topk_item(const bf16_t* QP, const bf16_t* SK, int* EID, float* GATE, int item, int lane) {
    const int tg = item >> 3, h = item & 7, r32 = lane & 31, hi = lane >> 5;
    const int t = tg * 32 + r32;
    unsigned own[2][16];
#pragma unroll
    for (int p = 0; p < 2; ++p) {
        const bf16_t* qrow = QP + (size_t)t * 2048 + h * 256 + p * 128 + hi * 8;
        bf16x8 qf[8];
#pragma unroll
        for (int d0 = 0; d0 < 8; ++d0) qf[d0] = *(const bf16x8*)(qrow + d0 * 16);
        const bf16_t* skb = SK + (size_t)((h * 2 + p) * 128 + r32) * 128 + hi * 8;
#pragma unroll 1
        for (int kt = 0; kt < 4; ++kt) {
            f32x16 acc;
#pragma unroll
            for (int r = 0; r < 16; ++r) acc[r] = 0.f;
#pragma unroll
            for (int d0 = 0; d0 < 8; ++d0) { const bf16x8 a = *(const bf16x8*)(skb + (size_t)kt * 32 * 128 + d0 * 16); acc = __builtin_amdgcn_mfma_f32_32x32x16_bf16(a, qf[d0], acc, 0, 0, 0); }
            unsigned cur[16];
#pragma unroll
            for (int r = 0; r < 16; ++r) { const int idx0 = kt * 32 + (r & 3) + 8 * (r >> 2);
                cur[r] = (f2sort(acc[r]) & 0xFFFFFF80u) | (unsigned)(127 - idx0 - 4 * hi); }
            sort16(cur);
            if (kt == 0) {
#pragma unroll
                for (int r = 0; r < 16; ++r) own[p][r] = cur[r];
            } else merge16(own[p], cur);
        }
    }
    unsigned fin[16];
    {
        unsigned oth[16];
#pragma unroll
        for (int i = 0; i < 16; ++i) { auto rr = __builtin_amdgcn_permlane32_swap(own[0][i], own[1][i], false, false); fin[i] = rr[0]; oth[i] = rr[1]; }
        merge16(fin, oth);
    }
    unsigned s1k[16], s2k[16];
#pragma unroll
    for (int i = 0; i < 16; ++i) { auto rr = __builtin_amdgcn_permlane32_swap(fin[i], fin[i], false, false); s1k[i] = rr[0]; s2k[i] = rr[1]; }
    float s1[16], s2[16]; unsigned long long i1lo = 0ull, i1hi = 0ull, i2lo = 0ull, i2hi = 0ull;
#pragma unroll
    for (int i = 0; i < 16; ++i) { s1[i] = sort2f(s1k[i] & 0xFFFFFF80u); s2[i] = sort2f(s2k[i] & 0xFFFFFF80u);
        const unsigned long long a = (unsigned long long)(127u - (s1k[i] & 0x7Fu)) << (8 * (i & 7)), b = (unsigned long long)(127u - (s2k[i] & 0x7Fu)) << (8 * (i & 7));
        if (i < 8) { i1lo |= a; i2lo |= b; } else { i1hi |= a; i2hi |= b; } }
    unsigned c64[64];
#pragma unroll
    for (int i = 50; i < 64; ++i) c64[i] = 0u;
    fill_cand<0>(c64, s1, s2);
    unsigned top[16];
    top16of64(c64, top);
    float ev[16]; float sum = 0.f; const float mx = sort2f(top[0] & 0xFFFFFF00u);
#pragma unroll
    for (int r = 0; r < 16; ++r) { ev[r] = __expf(sort2f(top[r] & 0xFFFFFF00u) - mx); sum += ev[r]; }
    const float rs = 1.f / sum;
    if (hi == 0) {
        int* ep = EID + (size_t)t * 128 + h * 16;
#pragma unroll
        for (int q4 = 0; q4 < 4; ++q4) { int ee[4];
#pragma unroll
            for (int z = 0; z < 4; ++z) { const int code = 255 - (int)(top[q4 * 4 + z] & 0xFFu), i = code >> 4, j = code & 15;
                const unsigned e1 = (unsigned)(((i & 8) ? i1hi : i1lo) >> (8 * (i & 7))) & 0xFFu, e2 = (unsigned)(((j & 8) ? i2hi : i2lo) >> (8 * (j & 7))) & 0xFFu; ee[z] = (int)(e1 * 128u + e2); }
            *(int4*)(ep + q4 * 4) = make_int4(ee[0], ee[1], ee[2], ee[3]); }
    } else {
        float* gp = GATE + (size_t)t * 128 + h * 16;
#pragma unroll
        for (int q4 = 0; q4 < 4; ++q4) *(float4*)(gp + q4 * 4) = make_float4(ev[q4 * 4] * rs, ev[q4 * 4 + 1] * rs, ev[q4 * 4 + 2] * rs, ev[q4 * 4 + 3] * rs);
    }
}
}


namespace gx {
__device__ __forceinline__ int sdot16(const int4 a, const int4 b) {
    int s = __builtin_amdgcn_sdot4(a.x, b.x, 0, false); s = __builtin_amdgcn_sdot4(a.y, b.y, s, false); s = __builtin_amdgcn_sdot4(a.z, b.z, s, false); return __builtin_amdgcn_sdot4(a.w, b.w, s, false);
}
__device__ __forceinline__ void quant_row(const float* src, unsigned char* dst, float* scale_out, int off, int lane) {
    const float4* sr = (const float4*)src + lane; float4 v[4]; float am = 0.f;
#pragma unroll
    for (int j = 0; j < 4; ++j) { v[j] = sr[64 * j]; am = fmaxf(am, fmaxf(fmaxf(fabsf(v[j].x), fabsf(v[j].y)), fmaxf(fabsf(v[j].z), fabsf(v[j].w)))); }
#pragma unroll
    for (int o = 1; o < 64; o <<= 1) am = fmaxf(am, __shfl_xor(am, o));
    const float inv = am > 0.f ? 127.f / am : 0.f;
#pragma unroll
    for (int j = 0; j < 4; ++j) { const int q0 = (int)rintf(v[j].x * inv) + off, q1 = (int)rintf(v[j].y * inv) + off, q2 = (int)rintf(v[j].z * inv) + off, q3 = (int)rintf(v[j].w * inv) + off;
        *(unsigned*)(dst + 4 * lane + 256 * j) = (unsigned)(q0 & 255) | ((unsigned)(q1 & 255) << 8) | ((unsigned)(q2 & 255) << 16) | ((unsigned)(q3 & 255) << 24); }
    if (lane == 0) *scale_out = am * (1.f / 127.f);
}

__device__ __forceinline__ void u_token(const unsigned char* UQ, const float* SU, float* Arow, int s, int e0, int e1, const int4 hq, float hs, int lane) {
    unsigned long long m0 = __ballot((e0 >> 11) == s), m1 = __ballot((e1 >> 11) == s);
    const int dummy = s * 2048;
    while (m0 | m1) {
        int ea, eb, ec, ed, ja, jb, jc, jd;
#define GX_NEXT(E, J) do { if (m0) { const int j = __builtin_ctzll(m0); m0 &= m0 - 1; J = j; E = __builtin_amdgcn_readlane(e0, j); } \
            else if (m1) { const int j = __builtin_ctzll(m1); m1 &= m1 - 1; J = 64 + j; E = __builtin_amdgcn_readlane(e1, j); } else { J = -1; E = dummy; } } while (0)
        GX_NEXT(ea, ja); GX_NEXT(eb, jb); GX_NEXT(ec, jc); GX_NEXT(ed, jd);
#undef GX_NEXT
        const int4 ra4 = *(const int4*)(UQ + (size_t)ea * 1024 + lane * 16), rb4 = *(const int4*)(UQ + (size_t)eb * 1024 + lane * 16);
        const int4 rc4 = *(const int4*)(UQ + (size_t)ec * 1024 + lane * 16), rd4 = *(const int4*)(UQ + (size_t)ed * 1024 + lane * 16);
        int v0 = sdot16(ra4, hq), v1 = sdot16(rb4, hq), v2 = sdot16(rc4, hq), v3 = sdot16(rd4, hq);
        { auto ra = __builtin_amdgcn_permlane32_swap((unsigned)v0, (unsigned)v2, false, false); auto rb = __builtin_amdgcn_permlane32_swap((unsigned)v1, (unsigned)v3, false, false);
          v0 = (int)ra[0] + (int)ra[1]; v1 = (int)rb[0] + (int)rb[1]; }
        { const bool up = (lane & 16) != 0; const int send = up ? v0 : v1, keep = up ? v1 : v0; v0 = keep + __shfl_xor(send, 16); }
        v0 += __shfl_xor(v0, 8); v0 += __shfl_xor(v0, 4); v0 += __shfl_xor(v0, 2); v0 += __shfl_xor(v0, 1);
        const int g = lane >> 4;
        const int je = g == 0 ? ja : g == 1 ? jb : g == 2 ? jc : jd;
        const int eg = g == 0 ? ea : g == 1 ? eb : g == 2 ? ec : ed;
        if ((lane & 15) == 0 && je >= 0) Arow[je] = (float)v0 * SU[eg] * hs;
    }
}

__device__ __forceinline__ float gelu_t(float x) { const float u = 0.7978845608028654f * (x + 0.044715f * x * x * x); return 0.5f * x * (1.f + tanhf(u)); }
#define GX_ACC4(W, Y0, Y1, Y2, Y3) do { Y0 += w * (float)((W) & 255u); Y1 += w * (float)(((W) >> 8) & 255u); Y2 += w * (float)(((W) >> 16) & 255u); Y3 += w * (float)((W) >> 24); } while (0)
__device__ __forceinline__ void v_token(const unsigned char* VQ, LAS const float* wl, LAS const int* el, int s, const float* gate2, float* outrow, int lane) {
    const int grp = lane >> 3, sub = lane & 7;
    float y[16];
#pragma unroll
    for (int k = 0; k < 16; ++k) y[k] = 0.f;
    float cs = 0.f;
    uint4 rows[16];
#pragma unroll
    for (int i = 0; i < 16; ++i) { const int e = el[8 * i + grp]; rows[i] = *(const uint4*)(VQ + (size_t)e * 1024 + 128 * s + 16 * sub); }
#pragma unroll
    for (int i = 0; i < 16; ++i) { const float w = wl[8 * i + grp]; cs += w;
        GX_ACC4(rows[i].x, y[0], y[1], y[2], y[3]); GX_ACC4(rows[i].y, y[4], y[5], y[6], y[7]); GX_ACC4(rows[i].z, y[8], y[9], y[10], y[11]); GX_ACC4(rows[i].w, y[12], y[13], y[14], y[15]); }
    const bool b5 = (lane & 32) != 0, b4 = (lane & 16) != 0, b3 = (lane & 8) != 0;
    float z[8], q[4], r[2];
#pragma unroll
    for (int k = 0; k < 8; ++k) { const float send = b5 ? y[k] : y[8 + k], keep = b5 ? y[8 + k] : y[k]; z[k] = keep + __shfl_xor(send, 32); }
#pragma unroll
    for (int k = 0; k < 4; ++k) { const float send = b4 ? z[k] : z[4 + k], keep = b4 ? z[4 + k] : z[k]; q[k] = keep + __shfl_xor(send, 16); }
#pragma unroll
    for (int k = 0; k < 2; ++k) { const float send = b3 ? q[k] : q[2 + k], keep = b3 ? q[2 + k] : q[k]; r[k] = keep + __shfl_xor(send, 8); }
    cs += __shfl_xor(cs, 8); cs += __shfl_xor(cs, 16); cs += __shfl_xor(cs, 32);
    const int col = 128 * s + 16 * sub + (b5 ? 8 : 0) + (b4 ? 4 : 0) + (b3 ? 2 : 0);
    float2* op = (float2*)(outrow + col); const float2 g2 = *(const float2*)(gate2 + col); float2 x1 = *op;
    x1.x += g2.x * (r[0] - 128.f * cs); x1.y += g2.y * (r[1] - 128.f * cs); *op = x1;
}
#undef GX_ACC4
}

constexpr size_t WS_SU = 2 * MiB, WS_SV = 2 * MiB + 65536, WS_HS = 2 * MiB + 131072;
constexpr size_t WS_UQ = 24 * MiB, WS_VQ = 40 * MiB, WS_H2Q = 56 * MiB;
constexpr size_t WS_A = WS_KA;
struct Args { const void* in[22]; float* out; unsigned char* ws; int ph_lo, ph_hi, li, pad; };

struct Frame {
    LAS unsigned char* lds;
    int tid, lane, wave, G, gw, NGW;
};

namespace pg8 {
struct EpiProj {
    static constexpr bool PERM = true, AFTER_DRAIN = false;
    bf16_t* P; float* FL;
    __device__ __forceinline__ void operator()(const f32x4 (&acc)[2][2][4][2], const Unit& u, int wr, int wc, int fr, int fq) const {
        const int row0 = u.pm * BM + wr * 64 + fr, col0 = u.pn * BM + wc * 32 + 8 * fq;
#pragma unroll
        for (int ai = 0; ai < 2; ++ai)
#pragma unroll
            for (int m = 0; m < 4; ++m) { const int row = row0 + ai * HALF + m * 16; bf16_t* rowp = P + (size_t)row * PP + col0;
#pragma unroll
                for (int bj = 0; bj < 2; ++bj) { const f32x4 v0 = acc[ai][bj][m][0], v1 = acc[ai][bj][m][1];
                    if (col0 + bj * HALF == C_FL) { float* f = FL + (size_t)row * 8; *(f32x4*)f = v0; *(f32x4*)(f + 4) = v1; }
                    u32x4 w; w.x = cvt_pk_bf16(v0[0], v0[1]); w.y = cvt_pk_bf16(v0[2], v0[3]); w.z = cvt_pk_bf16(v1[0], v1[1]); w.w = cvt_pk_bf16(v1[2], v1[3]);
                    *(u32x4*)(rowp + bj * HALF) = w; } }
    }
};
struct EpiStore {
    static constexpr bool PERM = true, AFTER_DRAIN = false;
    bf16_t* O; int ldc;
    __device__ __forceinline__ void operator()(const f32x4 (&acc)[2][2][4][2], const Unit& u, int wr, int wc, int fr, int fq) const {
        const int row0 = u.pm * BM + wr * 64 + fr, col0 = u.pn * BM + wc * 32 + 8 * fq;
#pragma unroll
        for (int ai = 0; ai < 2; ++ai)
#pragma unroll
            for (int m = 0; m < 4; ++m) { bf16_t* rowp = O + (size_t)(row0 + ai * HALF + m * 16) * ldc + col0;
#pragma unroll
                for (int bj = 0; bj < 2; ++bj) { const f32x4 v0 = acc[ai][bj][m][0], v1 = acc[ai][bj][m][1];
                    u32x4 w; w.x = cvt_pk_bf16(v0[0], v0[1]); w.y = cvt_pk_bf16(v0[2], v0[3]); w.z = cvt_pk_bf16(v1[0], v1[1]); w.w = cvt_pk_bf16(v1[2], v1[3]);
                    *(u32x4*)(rowp + bj * HALF) = w; } }
    }
};
struct EpiResid {
    static constexpr bool PERM = false, AFTER_DRAIN = false;
    const float* X; const float* MOD; float* out;
    __device__ __forceinline__ void operator()(const f32x4 (&acc)[2][2][4][2], const Unit& u, int wr, int wc, int fr, int fq) const {
        const int row0 = u.pm * BM + wr * 64 + fr, col0 = u.pn * BM + wc * 32 + 4 * fq;
        const int b = (u.pm * BM) / S_;
        f32x4 gv[2][2];
#pragma unroll
        for (int bj = 0; bj < 2; ++bj)
#pragma unroll
            for (int n = 0; n < 2; ++n) gv[bj][n] = *(const f32x4*)(MOD + b * 6144 + 2 * 1024 + col0 + bj * HALF + n * 16);
#pragma unroll
        for (int ai = 0; ai < 2; ++ai)
#pragma unroll
            for (int m = 0; m < 4; ++m) { const size_t off = (size_t)(row0 + ai * HALF + m * 16) * 1024 + col0;
#pragma unroll
                for (int bj = 0; bj < 2; ++bj)
#pragma unroll
                    for (int n = 0; n < 2; ++n) { const f32x4 xv = *(const f32x4*)(X + off + bj * HALF + n * 16); *(f32x4*)(out + off + bj * HALF + n * 16) = xv + gv[bj][n] * acc[ai][bj][m][n]; } }
    }
};
}

__device__ __forceinline__ void p0_transpose_item(const float* W, int K, int N, int Npad, bf16_t* WT, LAS float* scr, int item, int lane) {
    const int nblk = Npad / 32, kb = item / nblk, nb = item % nblk, k0 = 64 * kb, n0 = 32 * nb;
    const int nn = n0 + (lane & 31);
#pragma unroll 8
    for (int i = 0; i < 32; ++i) { const int kk = 2 * i + (lane >> 5); scr[kk * 33 + (lane & 31)] = nn < N ? W[(size_t)(k0 + kk) * N + nn] : 0.f; }
    asm volatile("s_waitcnt lgkmcnt(0)" ::: "memory");
    const int c = lane & 7;
#pragma unroll
    for (int j = 0; j < 4; ++j) { const int n = (lane >> 3) + 8 * j; const LAS float* s = scr + (8 * c) * 33 + n;
        u32x4 o; o.x = pk2(s[0 * 33], s[1 * 33]); o.y = pk2(s[2 * 33], s[3 * 33]); o.z = pk2(s[4 * 33], s[5 * 33]); o.w = pk2(s[6 * 33], s[7 * 33]);
        *(u32x4*)(WT + (size_t)(n0 + n) * K + k0 + 8 * c) = o; }
    asm volatile("s_waitcnt lgkmcnt(0)" ::: "memory");
}
__device__ __forceinline__ void p0_mod_item(const float* c, const float* w_ada, const float* b_ada, float* mod, LAS float* scr, int item, int lane) {
    for (int i = lane; i < 4096; i += 64) { const int b = i >> 10, k = i & 1023; const float cv = c[i]; scr[k * 4 + b] = cv / (1.f + expf(-cv)); }
    asm volatile("s_waitcnt lgkmcnt(0)" ::: "memory");
    const int j = item * 64 + lane;
    float a0 = 0.f, a1 = 0.f, a2 = 0.f, a3 = 0.f;
#pragma unroll 8
    for (int k = 0; k < 1024; ++k) { const float w = w_ada[(size_t)k * 6144 + j]; const f32x4 s = *(const LAS f32x4*)(scr + k * 4); a0 += s[0] * w; a1 += s[1] * w; a2 += s[2] * w; a3 += s[3] * w; }
    const float bb = b_ada[j];
    mod[0 * 6144 + j] = a0 + bb; mod[1 * 6144 + j] = a1 + bb; mod[2 * 6144 + j] = a2 + bb; mod[3 * 6144 + j] = a3 + bb;
    asm volatile("s_waitcnt lgkmcnt(0)" ::: "memory");
}

__device__ __forceinline__ void modrow(const float* X, const float* g, const float* mod, int shift_idx, int scale_idx, bf16_t* out, int row, int lane) {
    const int b = row / S_;
    const float4* xr = (const float4*)(X + (size_t)row * 1024) + lane;
    float4 v[4]; float ss = 0.f;
#pragma unroll
    for (int j = 0; j < 4; ++j) { v[j] = xr[64 * j]; ss += (v[j].x * v[j].x + v[j].y * v[j].y) + (v[j].z * v[j].z + v[j].w * v[j].w); }
    ss = wave_sum(ss);
    const float r = rsqrtf(ss * (1.f / 1024.f) + EPS);
    const float* sh = mod + b * 6144 + shift_idx * 1024; const float* sc = mod + b * 6144 + scale_idx * 1024;
#pragma unroll
    for (int j = 0; j < 4; ++j) {
        const int col = 4 * lane + 256 * j;
        const float4 g4 = *(const float4*)(g + col), s4 = *(const float4*)(sc + col), h4 = *(const float4*)(sh + col);
        const float o0 = v[j].x * r * g4.x * (1.f + s4.x) + h4.x, o1 = v[j].y * r * g4.y * (1.f + s4.y) + h4.y;
        const float o2 = v[j].z * r * g4.z * (1.f + s4.z) + h4.z, o3 = v[j].w * r * g4.w * (1.f + s4.w) + h4.w;
        uint2 w; w.x = pk2(o0, o1); w.y = pk2(o2, o3);
        *(uint2*)(out + (size_t)row * 1024 + col) = w;
    }
}

__device__ __forceinline__ void modrow_q(const float* X, const float* g, const float* mod, int shift_idx, int scale_idx, bf16_t* out, unsigned char* outq, float* hs, int row, int lane) {
    const int b = row / S_;
    const float4* xr = (const float4*)(X + (size_t)row * 1024) + lane;
    float4 v[4]; float ss = 0.f;
#pragma unroll
    for (int j = 0; j < 4; ++j) { v[j] = xr[64 * j]; ss += (v[j].x * v[j].x + v[j].y * v[j].y) + (v[j].z * v[j].z + v[j].w * v[j].w); }
    ss = wave_sum(ss);
    const float r = rsqrtf(ss * (1.f / 1024.f) + EPS);
    const float* sh = mod + b * 6144 + shift_idx * 1024; const float* sc = mod + b * 6144 + scale_idx * 1024;
    float am = 0.f;
#pragma unroll
    for (int j = 0; j < 4; ++j) {
        const int col = 4 * lane + 256 * j;
        const float4 g4 = *(const float4*)(g + col), s4 = *(const float4*)(sc + col), h4 = *(const float4*)(sh + col);
        v[j].x = v[j].x * r * g4.x * (1.f + s4.x) + h4.x; v[j].y = v[j].y * r * g4.y * (1.f + s4.y) + h4.y;
        v[j].z = v[j].z * r * g4.z * (1.f + s4.z) + h4.z; v[j].w = v[j].w * r * g4.w * (1.f + s4.w) + h4.w;
        uint2 w; w.x = pk2(v[j].x, v[j].y); w.y = pk2(v[j].z, v[j].w);
        *(uint2*)(out + (size_t)row * 1024 + col) = w;
        am = fmaxf(am, fmaxf(fmaxf(fabsf(v[j].x), fabsf(v[j].y)), fmaxf(fabsf(v[j].z), fabsf(v[j].w))));
    }
#pragma unroll
    for (int o = 1; o < 64; o <<= 1) am = fmaxf(am, __shfl_xor(am, o));
    const float inv = am > 0.f ? 127.f / am : 0.f;
#pragma unroll
    for (int j = 0; j < 4; ++j) { const int q0 = (int)rintf(v[j].x * inv), q1 = (int)rintf(v[j].y * inv), q2 = (int)rintf(v[j].z * inv), q3 = (int)rintf(v[j].w * inv);
        *(unsigned*)(outq + (size_t)row * 1024 + 4 * lane + 256 * j) = (unsigned)(q0 & 255) | ((unsigned)(q1 & 255) << 8) | ((unsigned)(q2 & 255) << 16) | ((unsigned)(q3 & 255) << 24); }
    if (lane == 0) hs[row] = am * (1.f / 127.f);
}

__global__ void __launch_bounds__(NWAVES * 64, 2) mega_fwd(Args args) {
    extern __shared__ __attribute__((aligned(16))) unsigned char lds[];
    Frame F;
    F.lds = (LAS unsigned char*)lds;
    volatile LAS unsigned* MISC = (volatile LAS unsigned*)(F.lds + MISC_OFF);
    F.tid = threadIdx.x; F.lane = F.tid & 63; F.wave = __builtin_amdgcn_readfirstlane(F.tid >> 6);
    F.G = gridDim.x; F.gw = blockIdx.x * NWAVES + F.wave; F.NGW = F.G * NWAVES;
    unsigned char* ws = args.ws;
    unsigned* ctl = (unsigned*)(ws + WS_CTL);
    const float* x = (const float*)args.in[0]; const float* c = (const float*)args.in[1]; const int* positions = (const int*)args.in[2];
    const float* w_ada = (const float*)args.in[3]; const float* b_ada = (const float*)args.in[4]; const float* norm1_g = (const float*)args.in[5];
    const float* w_in = (const float*)args.in[6]; const float* mla_qa_g = (const float*)args.in[7]; const float* mla_kva_g = (const float*)args.in[8];
    const float* w_uq = (const float*)args.in[9]; const float* w_ukv = (const float*)args.in[10]; const float* mla_q_g = (const float*)args.in[11];
    const float* mla_k_g = (const float*)args.in[12]; const float* fox_q_g = (const float*)args.in[13]; const float* fox_k_g = (const float*)args.in[14];
    const float* b_f = (const float*)args.in[15]; const float* w_o = (const float*)args.in[16]; const float* norm2_g = (const float*)args.in[17];
    const float* w_pq = (const float*)args.in[18]; const float* sub_keys = (const float*)args.in[19]; const float* peer_u = (const float*)args.in[20]; const float* peer_v = (const float*)args.in[21];
    float* out = args.out;
    float* MOD = (float*)(ws + WS_MOD); float* FL = (float*)(ws + WS_FL); float* FCUM = (float*)(ws + WS_FCUM); float* LOGF = (float*)(ws + WS_LOGF); float2* ROPE = (float2*)(ws + WS_ROPE);
    bf16_t* XN = (bf16_t*)(ws + WS_XN); bf16_t* PROJ = (bf16_t*)(ws + WS_PROJ); bf16_t* KVRAW = (bf16_t*)(ws + WS_KVRAW); bf16_t* QA = (bf16_t*)(ws + WS_QA); bf16_t* KA = (bf16_t*)(ws + WS_KA);
    bf16_t* WIN = (bf16_t*)(ws + WS_WIN); bf16_t* WUQ = (bf16_t*)(ws + WS_WUQ); bf16_t* WUKV = (bf16_t*)(ws + WS_WUKV); bf16_t* WO = (bf16_t*)(ws + WS_WO); bf16_t* WPQ = (bf16_t*)(ws + WS_WPQ); bf16_t* SKB = (bf16_t*)(ws + WS_SK);
    unsigned char* UQ = ws + WS_UQ; unsigned char* VQ = ws + WS_VQ; unsigned char* H2Q = ws + WS_H2Q; float* SU = (float*)(ws + WS_SU); float* SV = (float*)(ws + WS_SV); float* HS = (float*)(ws + WS_HS); float* AP = (float*)(ws + WS_A);
    bf16_t* OB = XN; bf16_t* H2 = XN; bf16_t* QP = PROJ; int* EID = (int*)(ws + WS_QA); float* GATE = (float*)(ws + WS_QA + 16 * MiB);
    (void)sub_keys; (void)peer_u; (void)peer_v; (void)positions; (void)KA; (void)FCUM; (void)LOGF; (void)ROPE; (void)mla_q_g; (void)mla_k_g; (void)b_f; (void)fox_q_g; (void)fox_k_g; (void)mla_qa_g; (void)mla_kva_g;

    for (int u = F.tid; u < (LDS_BYTES - LDSCTL_OFF) / 4; u += NWAVES * 64) ((LAS unsigned*)(F.lds + LDSCTL_OFF))[u] = 0u;
    __syncthreads();
    const int lo = args.ph_lo, hi = args.ph_hi;
    XcdBarrier bar; bar.bar = ctl + CW_BAR + args.li * XCD_BAR_WORDS; bar.x = 0; bar.st = nullptr;
    if (hi - lo > 1) bar = xcd_barrier_post(ctl + CW_BAR + args.li * XCD_BAR_WORDS, MISC + 8);
#define IN(k) (lo <= (k) && (k) < hi)
#define SEAM(k) do { if (IN(k) && IN((k) + 1)) xcd_barrier(bar); } while (0)

    if (IN(0)) {
        LAS float* scr = (LAS float*)(F.lds + F.wave * 16384);
        constexpr int I_MOD = 96, I_IN = 16 * 72, I_UQ = 6 * 24, I_UKV = 4 * 32, I_O = 16 * 32, I_PQ = 16 * 64;
        constexpr int I_SK = 512;
        constexpr int NITEMS = I_MOD + I_IN + I_UQ + I_UKV + I_O + I_PQ + I_SK + 2 * 16384;
        for (int it = F.gw; it < NITEMS; it += F.NGW) {
            int r = it;
            if (r < I_MOD) { p0_mod_item(c, w_ada, b_ada, MOD, scr, r, F.lane); continue; } r -= I_MOD;
            if (r < I_IN) { p0_transpose_item(w_in, 1024, INW, PP, WIN, scr, r, F.lane); continue; } r -= I_IN;
            if (r < I_UQ) { p0_transpose_item(w_uq, 384, 768, 768, WUQ, scr, r, F.lane); continue; } r -= I_UQ;
            if (r < I_UKV) { p0_transpose_item(w_ukv, 256, 1024, 1024, WUKV, scr, r, F.lane); continue; } r -= I_UKV;
            if (r < I_O) { p0_transpose_item(w_o, 1024, 1024, 1024, WO, scr, r, F.lane); continue; } r -= I_O;
            if (r < I_PQ) { p0_transpose_item(w_pq, 1024, 2048, 2048, WPQ, scr, r, F.lane); continue; } r -= I_PQ;
            if (r >= I_SK) { r -= I_SK; if (r < 16384) gx::quant_row(peer_u + (size_t)r * 1024, UQ + (size_t)r * 1024, SU + r, 0, F.lane); else { r -= 16384; gx::quant_row(peer_v + (size_t)r * 1024, VQ + (size_t)r * 1024, SV + r, 128, F.lane); } continue; }
            { const float4* src = (const float4*)(sub_keys + (size_t)r * 512) + F.lane * 2; const float4 a = src[0], b2 = src[1];
              u32x4 o; o.x = pk2(a.x, a.y); o.y = pk2(a.z, a.w); o.z = pk2(b2.x, b2.y); o.w = pk2(b2.z, b2.w); *(u32x4*)(SKB + (size_t)r * 512 + F.lane * 8) = o; }
        }
    }
    SEAM(0);
    if (IN(1)) { for (int row = F.gw; row < T_; row += F.NGW) modrow(x, norm1_g, MOD, 0, 1, XN, row, F.lane); }
    SEAM(1);
    if (IN(2)) {
        pg8::Gemm g{XN, WIN, T_, PP, 1024, 1024}; pg8::StaticOrder S; S.init(T_, PP, F.G, (int)blockIdx.x);
        pg8::EpiProj E{PROJ, FL};
        pg8::gemm_phase<pg8::EpiProj, pg8::StaticOrder, true, true>(F.lds, g, S, E);
    }
    SEAM(2);
    if (IN(3)) { for (int row = F.gw; row < T_; row += F.NGW) rowprep_row(PROJ, FL, mla_qa_g, mla_kva_g, fox_q_g, fox_k_g, b_f, positions, LOGF, ROPE, row, F.lane); }
    SEAM(3);
    if (IN(4)) {
        { pg8::Gemm g{PROJ + C_CQ, WUQ, T_, 768, 384, PP}; pg8::StaticOrder S; S.init(T_, 768, F.G, (int)blockIdx.x); pg8::EpiStore E{QA, 768};
          pg8::gemm_phase<pg8::EpiStore, pg8::StaticOrder, true, true>(F.lds, g, S, E); }
        { pg8::Gemm g{PROJ + C_CKV, WUKV, T_, 1024, 256, PP}; pg8::StaticOrder S; S.init(T_, 1024, F.G, (int)blockIdx.x); pg8::EpiStore E{KVRAW, 1024};
          pg8::gemm_phase<pg8::EpiStore, pg8::StaticOrder, true, true>(F.lds, g, S, E); }
    }
    SEAM(4);
    if (IN(5)) {
        if (F.gw < 32) fcum_item(LOGF, FCUM, F.gw, F.lane);
        for (int row = F.gw; row < T_; row += F.NGW) mlaprep_row(QA, KVRAW, PROJ, KA, ROPE, mla_q_g, mla_k_g, row, F.lane);
    }
    SEAM(5);
    if (IN(6)) {
        const int nunits = 1024;
        for (int grp = 0; grp < 2; ++grp)
            for (int i = 0;; ++i) {
                int bh, qb;
                if (F.G == 256) { if (i >= 4) break; const int v = ((int)blockIdx.x % 8) * 32 + (int)blockIdx.x / 8, s = v & 7; bh = v >> 3; qb = (i == 0) ? s : (i == 1) ? 15 - s : (i == 2) ? 16 + s : 31 - s; }
                else { const int u = i * F.G + (int)blockIdx.x; if (u >= nunits) break; bh = u & 31; qb = 31 - (u >> 5); }
                const int b = bh >> 3, h = bh & 7;
                if (grp == 0) { const att::Desc d{QA + (size_t)b * S_ * 768 + h * 96, 768, KA + (size_t)b * S_ * 768 + h * 96, 768, KVRAW + (size_t)b * S_ * 1024 + h * 128 + 64, 1024, OB + (size_t)b * S_ * 1024 + h * 64, 1024, nullptr};
                    att::attn_unit<6, false>(d, qb, 0, F.lds); }
                else { const bf16_t* pb = PROJ + (size_t)b * S_ * PP + h * 64; const att::Desc d{pb + C_FQ, PP, pb + C_FK, PP, pb + C_FV, PP, OB + (size_t)b * S_ * 1024 + 512 + h * 64, 1024, FCUM + (size_t)(b * 8 + h) * S_};
                    att::attn_unit<4, true>(d, qb, 0, F.lds); }
            }
    }
    SEAM(6);
    if (IN(7)) {
        pg8::Gemm g{OB, WO, T_, 1024, 1024, 1024}; pg8::StaticOrder S; S.init(T_, 1024, F.G, (int)blockIdx.x);
        pg8::EpiResid E{x, MOD, out};
        pg8::gemm_phase<pg8::EpiResid, pg8::StaticOrder, true, true>(F.lds, g, S, E);
    }
    SEAM(7);
    if (IN(8)) { for (int row = F.gw; row < T_; row += F.NGW) modrow_q(out, norm2_g, MOD, 3, 4, H2, H2Q, HS, row, F.lane); }
    SEAM(8);
    if (IN(9)) {
        pg8::Gemm g{H2, WPQ, T_, 2048, 1024, 1024}; pg8::StaticOrder S; S.init(T_, 2048, F.G, (int)blockIdx.x); pg8::EpiStore E{QP, 2048};
        pg8::gemm_phase<pg8::EpiStore, pg8::StaticOrder, true, true>(F.lds, g, S, E);
    }
    SEAM(9);
    if (IN(10)) { for (int w = F.gw; w < (T_ / 32) * 8; w += F.NGW) pk::topk_item(QP, SKB, EID, GATE, w, F.lane); }
    SEAM(10);
    {
        const int ng = F.G < 8 ? F.G : 8; const int vx = (int)blockIdx.x % ng, rank = (int)blockIdx.x / ng, nrank = (F.G - vx + ng - 1) / ng;
        const int gwv = rank * NWAVES + F.wave, ngwv = nrank * NWAVES;
        if (IN(11)) {
            for (int s = vx; s < 8; s += ng) {
                int t = gwv; int e0 = 0, e1 = 0; int4 hq = make_int4(0, 0, 0, 0); float hs = 0.f;
                if (t < T_) { e0 = EID[(size_t)t * 128 + F.lane]; e1 = EID[(size_t)t * 128 + 64 + F.lane]; hq = *(const int4*)(H2Q + (size_t)t * 1024 + F.lane * 16); hs = HS[t]; }
                while (t < T_) {
                    const int tn = t + ngwv; int e0n = 0, e1n = 0; int4 hqn = make_int4(0, 0, 0, 0); float hsn = 0.f;
                    if (tn < T_) { e0n = EID[(size_t)tn * 128 + F.lane]; e1n = EID[(size_t)tn * 128 + 64 + F.lane]; hqn = *(const int4*)(H2Q + (size_t)tn * 1024 + F.lane * 16); hsn = HS[tn]; }
                    gx::u_token(UQ, SU, AP + (size_t)t * 128, s, e0, e1, hq, hs, F.lane);
                    t = tn; e0 = e0n; e1 = e1n; hq = hqn; hs = hsn;
                }
            }
        }
        SEAM(11);
        if (IN(12)) {
            LAS float* wl = (LAS float*)(F.lds + F.wave * 1024); LAS int* el = (LAS int*)(F.lds + F.wave * 1024 + 512);
            for (int s = vx; s < 8; s += ng)
                for (int t = gwv; t < T_; t += ngwv) {
                    const int e0 = EID[(size_t)t * 128 + F.lane], e1 = EID[(size_t)t * 128 + 64 + F.lane];
                    const float a0 = AP[(size_t)t * 128 + F.lane], a1 = AP[(size_t)t * 128 + 64 + F.lane], g0 = GATE[(size_t)t * 128 + F.lane], g1 = GATE[(size_t)t * 128 + 64 + F.lane];
                    wl[F.lane] = g0 * gx::gelu_t(a0) * SV[e0]; wl[64 + F.lane] = g1 * gx::gelu_t(a1) * SV[e1]; el[F.lane] = e0; el[64 + F.lane] = e1;
                    gx::v_token(VQ, wl, el, s, MOD + (t / S_) * 6144 + 5 * 1024, out + (size_t)t * 1024, F.lane);
                }
        }
    }
#undef IN
#undef SEAM
}

static int g_grid = 0;
static void launch_mega(const Args& base, int lo, int hi, int li, hipStream_t stream) {
    Args a = base; a.ph_lo = lo; a.ph_hi = hi; a.li = li;
    hipLaunchKernelGGL(mega_fwd, dim3(g_grid), dim3(NWAVES * 64), LDS_BYTES, stream, a);
}

extern "C" void kernel_launch(void* const* d_in, const int* in_sizes, int n_in, void* d_out, int out_size, void* d_ws, size_t ws_size, hipStream_t stream) {
    if (g_grid == 0) {
        int dev = 0, cus = 0;
        hipGetDevice(&dev); hipDeviceGetAttribute(&cus, hipDeviceAttributeMultiprocessorCount, dev);
        hipFuncSetAttribute((const void*)mega_fwd, hipFuncAttributeMaxDynamicSharedMemorySize, LDS_BYTES);
        int per_cu = 0; hipOccupancyMaxActiveBlocksPerMultiprocessor(&per_cu, (const void*)mega_fwd, NWAVES * 64, LDS_BYTES);
        (void)hipGetLastError();
        g_grid = cus > 0 ? cus : 256;
        if (per_cu < 1) fprintf(stderr, "kernel_launch: occupancy query says %d blocks/CU\n", per_cu);
    }
    const float* x = (const float*)d_in[0]; const int* positions = (const int*)d_in[2];
    const float* mla_qa_g = (const float*)d_in[7]; const float* mla_kva_g = (const float*)d_in[8];
    const float* mla_q_g = (const float*)d_in[11]; const float* mla_k_g = (const float*)d_in[12]; const float* fox_q_g = (const float*)d_in[13]; const float* fox_k_g = (const float*)d_in[14];
    const float* b_f = (const float*)d_in[15]; const float* sub_keys = (const float*)d_in[19]; const float* peer_u = (const float*)d_in[20]; const float* peer_v = (const float*)d_in[21];
    float* out = (float*)d_out; unsigned char* ws = (unsigned char*)d_ws;
    float* MOD = (float*)(ws + WS_MOD); float* FL = (float*)(ws + WS_FL); float* FCUM = (float*)(ws + WS_FCUM); float* LOGF = (float*)(ws + WS_LOGF); float2* ROPE = (float2*)(ws + WS_ROPE);
    bf16_t* XN = (bf16_t*)(ws + WS_XN); bf16_t* PROJ = (bf16_t*)(ws + WS_PROJ); bf16_t* KVRAW = (bf16_t*)(ws + WS_KVRAW); bf16_t* QA = (bf16_t*)(ws + WS_QA); bf16_t* KA = (bf16_t*)(ws + WS_KA);
    bf16_t* OB = XN; bf16_t* H2 = XN; bf16_t* QP = PROJ; int* EID = (int*)(ws + WS_QA); float* GATE = (float*)(ws + WS_QA + 16 * MiB);
    (void)x;
    hipMemsetAsync(ws + WS_CTL, 0, CTL_ZERO_BYTES, stream);
    Args base{}; for (int i = 0; i < 22; ++i) base.in[i] = d_in[i]; base.out = out; base.ws = ws;

    launch_mega(base, 0, 13, 0, stream);
}
```

```cpp
#include <hip/hip_runtime.h>
#ifndef PROBE_DUP
#define PROBE_DUP -1
#endif
#define REP(k) for (int _r = 0; _r < ((PROBE_DUP == (k)) ? 2 : 1); ++_r)
#include <cstdint>
#include <cstdio>
#include <cmath>

typedef unsigned short bf16_t;
constexpr int B_ = 4, S_ = 8192, D_ = 1024, T_ = B_ * S_;
constexpr int PP = 2304;
constexpr int C_CQ = 0, C_CKV = 384, C_KPE = 640, C_FQ = 672, C_FK = 1184, C_FV = 1696, C_FL = 2208, INW = 2216;
constexpr float EPS = 1e-6f;
constexpr float LOG2E = 1.4426950408889634f;
constexpr float C2A = 0.10206207261596577f * LOG2E;
constexpr float C2F = 0.125f * LOG2E;

__device__ __forceinline__ float bf2f(bf16_t v) { return __uint_as_float(((unsigned)v) << 16); }
__device__ __forceinline__ bf16_t f2bf(float f) { unsigned u = __float_as_uint(f); return (bf16_t)((u + 0x7fffu + ((u >> 16) & 1u)) >> 16); }
__device__ __forceinline__ unsigned pk2(float lo, float hi) { return (unsigned)f2bf(lo) | ((unsigned)f2bf(hi) << 16); }
__device__ __forceinline__ float lo2f(unsigned w) { return __uint_as_float(w << 16); }
__device__ __forceinline__ float hi2f(unsigned w) { return __uint_as_float(w & 0xffff0000u); }
__device__ __forceinline__ float wave_sum(float v) {
#pragma unroll
    for (int o = 1; o < 64; o <<= 1) v += __shfl_xor(v, o);
    return v;
}

constexpr size_t MiB = 1u << 20;
constexpr size_t WS_MOD = 1 * MiB;
constexpr size_t WS_FL = 3 * MiB;
constexpr size_t WS_FCUM = 4 * MiB;
constexpr size_t WS_LOGF = 5 * MiB;
constexpr size_t WS_ROPE = 6 * MiB;
constexpr size_t WS_XN = 88 * MiB;
constexpr size_t WS_PROJ = 152 * MiB;
constexpr size_t WS_KVRAW = 296 * MiB;
constexpr size_t WS_QA = 360 * MiB;
constexpr size_t WS_KA = 408 * MiB;

__global__ void k_mod(const float* c, const float* w_ada, const float* b_ada, float* mod) {
    const int j = blockIdx.x * 256 + threadIdx.x, b = blockIdx.y;
    float acc = b_ada[j];
    for (int k = 0; k < 1024; ++k) { const float cv = c[b * 1024 + k]; const float s = cv / (1.f + expf(-cv)); acc += s * w_ada[(size_t)k * 6144 + j]; }
    mod[b * 6144 + j] = acc;
}

__global__ void __launch_bounds__(256) k_modrows(const float* X, const float* g, const float* mod, int shift_idx, int scale_idx, bf16_t* out) {
    const int wave = threadIdx.x >> 6, lane = threadIdx.x & 63;
    const int row = blockIdx.x * 4 + wave, b = row / S_;
    const float4* xr = (const float4*)(X + (size_t)row * 1024) + lane;
    float4 v[4]; float ss = 0.f;
#pragma unroll
    for (int j = 0; j < 4; ++j) { v[j] = xr[64 * j]; ss += (v[j].x * v[j].x + v[j].y * v[j].y) + (v[j].z * v[j].z + v[j].w * v[j].w); }
    ss = wave_sum(ss);
    const float r = rsqrtf(ss * (1.f / 1024.f) + EPS);
    const float* sh = mod + b * 6144 + shift_idx * 1024; const float* sc = mod + b * 6144 + scale_idx * 1024;
#pragma unroll
    for (int j = 0; j < 4; ++j) {
        const int col = 4 * lane + 256 * j;
        const float4 g4 = *(const float4*)(g + col), s4 = *(const float4*)(sc + col), h4 = *(const float4*)(sh + col);
        const float o0 = v[j].x * r * g4.x * (1.f + s4.x) + h4.x, o1 = v[j].y * r * g4.y * (1.f + s4.y) + h4.y;
        const float o2 = v[j].z * r * g4.z * (1.f + s4.z) + h4.z, o3 = v[j].w * r * g4.w * (1.f + s4.w) + h4.w;
        uint2 w; w.x = pk2(o0, o1); w.y = pk2(o2, o3);
        *(uint2*)(out + (size_t)row * 1024 + col) = w;
    }
}

template <int MODE>
__global__ void __launch_bounds__(256) k_gemm_naive(const bf16_t* A, int lda, const float* W, int K, int N, void* Cout, int ldc, const float* aux1, const float* aux2, float* fl) {
    __shared__ float As[16][64];
    __shared__ float Ws[16][64];
    const int tx = threadIdx.x & 15, ty = threadIdx.x >> 4;
    const int m0 = blockIdx.y * 64, n0 = blockIdx.x * 64;
    float acc[4][4];
#pragma unroll
    for (int i = 0; i < 4; ++i)
#pragma unroll
        for (int j = 0; j < 4; ++j) acc[i][j] = 0.f;
    for (int k0 = 0; k0 < K; k0 += 16) {
        { const int r = threadIdx.x >> 2, kq = (threadIdx.x & 3) * 4; const uint2 a2 = *(const uint2*)(A + (size_t)(m0 + r) * lda + k0 + kq);
          As[kq + 0][r] = lo2f(a2.x); As[kq + 1][r] = hi2f(a2.x); As[kq + 2][r] = lo2f(a2.y); As[kq + 3][r] = hi2f(a2.y); }
        { const int kk = threadIdx.x >> 4, nq = (threadIdx.x & 15) * 4; float4 w4 = make_float4(0.f, 0.f, 0.f, 0.f);
          if (n0 + nq < N) w4 = *(const float4*)(W + (size_t)(k0 + kk) * N + n0 + nq);
          *(float4*)&Ws[kk][nq] = w4; }
        __syncthreads();
#pragma unroll
        for (int kk = 0; kk < 16; ++kk) {
            const float4 a4 = *(const float4*)&As[kk][ty * 4]; const float4 w4 = *(const float4*)&Ws[kk][tx * 4];
            const float a[4] = {a4.x, a4.y, a4.z, a4.w}; const float w[4] = {w4.x, w4.y, w4.z, w4.w};
#pragma unroll
            for (int i = 0; i < 4; ++i)
#pragma unroll
                for (int j = 0; j < 4; ++j) acc[i][j] += a[i] * w[j];
        }
        __syncthreads();
    }
#pragma unroll
    for (int i = 0; i < 4; ++i) {
        const int m = m0 + ty * 4 + i;
#pragma unroll
        for (int j = 0; j < 4; ++j) {
            const int n = n0 + tx * 4 + j;
            if (n < N) {
                if (MODE == 0) ((bf16_t*)Cout)[(size_t)m * ldc + n] = f2bf(acc[i][j]);
                else if (MODE == 1) { if (n < C_FL) ((bf16_t*)Cout)[(size_t)m * ldc + n] = f2bf(acc[i][j]); else fl[(size_t)m * 8 + (n - C_FL)] = acc[i][j]; }
                else { const int b = m / S_; ((float*)Cout)[(size_t)m * ldc + n] = aux1[(size_t)m * 1024 + n] + aux2[b * 6144 + 2 * 1024 + n] * acc[i][j]; }
            }
        }
    }
}

__device__ __forceinline__ void unpack8(const uint4 raw, float* v) {
    v[0] = lo2f(raw.x); v[1] = hi2f(raw.x); v[2] = lo2f(raw.y); v[3] = hi2f(raw.y); v[4] = lo2f(raw.z); v[5] = hi2f(raw.z); v[6] = lo2f(raw.w); v[7] = hi2f(raw.w);
}
__device__ __forceinline__ void rowprep_row(bf16_t* PROJ, const float* FL, const float* g_qa, const float* g_kva, const float* g_fq, const float* g_fk, const float* b_f,
                                                 const int* positions, float* LOGF, float2* ROPE, int row, int lane) {
    bf16_t* pr = PROJ + (size_t)row * PP;
    float v[8];
    {
        float ss = 0.f;
        if (lane < 48) { unpack8(*(const uint4*)(pr + C_CQ + lane * 8), v);
#pragma unroll
            for (int i = 0; i < 8; ++i) ss += v[i] * v[i]; }
        ss = wave_sum(ss);
        const float r = rsqrtf(ss * (1.f / 384.f) + EPS);
        if (lane < 48) { const float* g = g_qa + lane * 8; uint4 o;
            o.x = pk2(v[0] * r * g[0], v[1] * r * g[1]); o.y = pk2(v[2] * r * g[2], v[3] * r * g[3]); o.z = pk2(v[4] * r * g[4], v[5] * r * g[5]); o.w = pk2(v[6] * r * g[6], v[7] * r * g[7]);
            *(uint4*)(pr + C_CQ + lane * 8) = o; }
    }
    {
        float ss = 0.f;
        if (lane < 32) { unpack8(*(const uint4*)(pr + C_CKV + lane * 8), v);
#pragma unroll
            for (int i = 0; i < 8; ++i) ss += v[i] * v[i]; }
        ss = wave_sum(ss);
        const float r = rsqrtf(ss * (1.f / 256.f) + EPS);
        if (lane < 32) { const float* g = g_kva + lane * 8; uint4 o;
            o.x = pk2(v[0] * r * g[0], v[1] * r * g[1]); o.y = pk2(v[2] * r * g[2], v[3] * r * g[3]); o.z = pk2(v[4] * r * g[4], v[5] * r * g[5]); o.w = pk2(v[6] * r * g[6], v[7] * r * g[7]);
            *(uint4*)(pr + C_CKV + lane * 8) = o; }
    }
#pragma unroll
    for (int which = 0; which < 2; ++which) {
        const int coff = which == 0 ? C_FQ : C_FK; const float* g = (which == 0 ? g_fq : g_fk) + (lane & 7) * 8; const float sc = which == 0 ? C2F : 1.f;
        unpack8(*(const uint4*)(pr + coff + lane * 8), v);
        float ss = 0.f;
#pragma unroll
        for (int i = 0; i < 8; ++i) ss += v[i] * v[i];
        ss += __shfl_xor(ss, 1); ss += __shfl_xor(ss, 2); ss += __shfl_xor(ss, 4);
        const float r = rsqrtf(ss * (1.f / 64.f) + EPS) * sc; uint4 o;
        o.x = pk2(v[0] * r * g[0], v[1] * r * g[1]); o.y = pk2(v[2] * r * g[2], v[3] * r * g[3]); o.z = pk2(v[4] * r * g[4], v[5] * r * g[5]); o.w = pk2(v[6] * r * g[6], v[7] * r * g[7]);
        *(uint4*)(pr + coff + lane * 8) = o;
    }
    if (lane < 8) { const float z = FL[(size_t)row * 8 + lane] + b_f[lane]; LOGF[(size_t)row * 8 + lane] = fminf(z, 0.f) - log1pf(expf(-fabsf(z))); }
    if (lane < 16) { const float inv = powf(10000.f, -(float)lane / 16.f); const float ang = (float)positions[row] * inv; float sn, cs; sincosf(ang, &sn, &cs); ROPE[(size_t)row * 16 + lane] = make_float2(cs, sn); }
}

__global__ void __launch_bounds__(256) k_rowprep(bf16_t* PROJ, const float* FL, const float* g_qa, const float* g_kva, const float* g_fq, const float* g_fk, const float* b_f,
                                                 const int* positions, float* LOGF, float2* ROPE) {
    rowprep_row(PROJ, FL, g_qa, g_kva, g_fq, g_fk, b_f, positions, LOGF, ROPE, blockIdx.x * 4 + (threadIdx.x >> 6), threadIdx.x & 63);
}

__device__ __forceinline__ void fcum_item(const float* LOGF, float* FCUM, int item, int lane) {
    const int b = item >> 3, h = item & 7;
    const float* src = LOGF + ((size_t)b * S_) * 8 + h;
    float tot = 0.f;
    for (int i = 0; i < 128; ++i) tot += src[(size_t)(128 * lane + i) * 8];
    float incl = tot;
#pragma unroll
    for (int o = 1; o < 64; o <<= 1) { const float t = __shfl_up(incl, o); if (lane >= o) incl += t; }
    float run = incl - tot;
    float* dst = FCUM + ((size_t)(b * 8 + h)) * S_ + 128 * lane;
    for (int i = 0; i < 128; ++i) { run += src[(size_t)(128 * lane + i) * 8]; dst[i] = run; }
}
__global__ void __launch_bounds__(64) k_fcum(const float* LOGF, float* FCUM) { fcum_item(LOGF, FCUM, blockIdx.x, threadIdx.x); }

__device__ __forceinline__ void mlaprep_row(bf16_t* QRAW, const bf16_t* KVRAW, const bf16_t* PROJ, bf16_t* KA, const float2* ROPE, const float* g_q, const float* g_k, int row, int lane) {
    const int h = lane >> 3, p = lane & 7;
    const float2 cs0 = ROPE[(size_t)row * 16 + 2 * p], cs1 = ROPE[(size_t)row * 16 + 2 * p + 1];
#pragma unroll
    for (int which = 0; which < 2; ++which) {
        const float* g = which == 0 ? g_q : g_k; const float sc = which == 0 ? C2A : 1.f;
        float v[8]; unsigned r1, r2;
        if (which == 0) { const bf16_t* q = QRAW + (size_t)row * 768 + h * 96; unpack8(*(const uint4*)(q + 8 * p), v); r1 = *(const unsigned*)(q + 64 + 2 * p); r2 = *(const unsigned*)(q + 80 + 2 * p); }
        else { unpack8(*(const uint4*)(KVRAW + (size_t)row * 1024 + h * 128 + 8 * p), v); const bf16_t* kp = PROJ + (size_t)row * PP + C_KPE; r1 = *(const unsigned*)(kp + 2 * p); r2 = *(const unsigned*)(kp + 16 + 2 * p); }
        float a0 = lo2f(r1), a1 = hi2f(r1), b0 = lo2f(r2), b1 = hi2f(r2);
        float ss = a0 * a0 + a1 * a1 + b0 * b0 + b1 * b1;
#pragma unroll
        for (int i = 0; i < 8; ++i) ss += v[i] * v[i];
        ss += __shfl_xor(ss, 1); ss += __shfl_xor(ss, 2); ss += __shfl_xor(ss, 4);
        const float r = rsqrtf(ss * (1.f / 96.f) + EPS);
        const float* gn = g + 8 * p;
        a0 *= r * g[64 + 2 * p]; a1 *= r * g[64 + 2 * p + 1]; b0 *= r * g[80 + 2 * p]; b1 *= r * g[80 + 2 * p + 1];
        const float ra0 = a0 * cs0.x - b0 * cs0.y, rb0 = b0 * cs0.x + a0 * cs0.y, ra1 = a1 * cs1.x - b1 * cs1.y, rb1 = b1 * cs1.x + a1 * cs1.y;
        uint4 o; o.x = pk2(v[0] * r * gn[0] * sc, v[1] * r * gn[1] * sc); o.y = pk2(v[2] * r * gn[2] * sc, v[3] * r * gn[3] * sc);
        o.z = pk2(v[4] * r * gn[4] * sc, v[5] * r * gn[5] * sc); o.w = pk2(v[6] * r * gn[6] * sc, v[7] * r * gn[7] * sc);
        bf16_t* dst = (which == 0 ? QRAW : KA) + (size_t)row * 768 + h * 96;
        *(uint4*)(dst + 8 * p) = o; *(unsigned*)(dst + 64 + 2 * p) = pk2(ra0 * sc, ra1 * sc); *(unsigned*)(dst + 80 + 2 * p) = pk2(rb0 * sc, rb1 * sc);
    }
}

__global__ void __launch_bounds__(256) k_mlaprep(bf16_t* QRAW, const bf16_t* KVRAW, const bf16_t* PROJ, bf16_t* KA, const float2* ROPE, const float* g_q, const float* g_k) {
    mlaprep_row(QRAW, KVRAW, PROJ, KA, ROPE, g_q, g_k, blockIdx.x * 4 + (threadIdx.x >> 6), threadIdx.x & 63);
}

template <int DK>
__global__ void __launch_bounds__(256) k_attn_naive(const bf16_t* Q, int pq, int qstep, const bf16_t* K, int pk, int kstep, const bf16_t* V, int pv, int vstep, bf16_t* O, int po, int ostep, const float* FCUM) {
    __shared__ float Ks[64][DK];
    __shared__ float Vs[64][64];
    __shared__ float Bs[64];
    const int bh = blockIdx.x >> 5, qb = blockIdx.x & 31, b = bh >> 3, h = bh & 7;
    const int t = qb * 256 + threadIdx.x;
    const size_t row = (size_t)b * S_ + t;
    float q[DK];
#pragma unroll
    for (int c = 0; c < DK / 8; ++c) unpack8(*(const uint4*)(Q + row * pq + h * qstep + c * 8), q + c * 8);
    float o[64];
#pragma unroll
    for (int d = 0; d < 64; ++d) o[d] = 0.f;
    float m = -INFINITY, l = 0.f;
    const float fq = FCUM ? FCUM[(size_t)(b * 8 + h) * S_ + t] : 0.f;
    const int ntiles = (qb * 256 + 256) / 64;
    for (int kt = 0; kt < ntiles; ++kt) {
        __syncthreads();
        for (int c = threadIdx.x; c < 64 * (DK / 8); c += 256) { const int key = c / (DK / 8), ch = c % (DK / 8); float v[8];
            unpack8(*(const uint4*)(K + ((size_t)b * S_ + kt * 64 + key) * pk + h * kstep + ch * 8), v);
#pragma unroll
            for (int i = 0; i < 8; ++i) Ks[key][ch * 8 + i] = v[i]; }
        for (int c = threadIdx.x; c < 64 * 8; c += 256) { const int key = c >> 3, ch = c & 7; float v[8];
            unpack8(*(const uint4*)(V + ((size_t)b * S_ + kt * 64 + key) * pv + h * vstep + ch * 8), v);
#pragma unroll
            for (int i = 0; i < 8; ++i) Vs[key][ch * 8 + i] = v[i]; }
        if (threadIdx.x < 64) Bs[threadIdx.x] = FCUM ? FCUM[(size_t)(b * 8 + h) * S_ + kt * 64 + threadIdx.x] : 0.f;
        __syncthreads();
        const int kmax = t - kt * 64 + 1;
        for (int kk = 0; kk < 64; ++kk) {
            float s = 0.f;
#pragma unroll
            for (int d = 0; d < DK; ++d) s += q[d] * Ks[kk][d];
            if (FCUM) s += (fq - Bs[kk]) * LOG2E;
            if (kk < kmax) {
                const float mn = fmaxf(m, s), corr = exp2f(m - mn), p = exp2f(s - mn);
                l = l * corr + p;
#pragma unroll
                for (int d = 0; d < 64; ++d) o[d] = o[d] * corr + p * Vs[kk][d];
                m = mn;
            }
        }
    }
    const float rl = 1.f / l;
    bf16_t* op = O + row * po + h * ostep;
#pragma unroll
    for (int c = 0; c < 8; ++c) { uint4 w; w.x = pk2(o[c * 8 + 0] * rl, o[c * 8 + 1] * rl); w.y = pk2(o[c * 8 + 2] * rl, o[c * 8 + 3] * rl); w.z = pk2(o[c * 8 + 4] * rl, o[c * 8 + 5] * rl); w.w = pk2(o[c * 8 + 6] * rl, o[c * 8 + 7] * rl);
        *(uint4*)(op + c * 8) = w; }
}

__device__ __forceinline__ void topk_item(const bf16_t* QP, const float* sub_keys, int* EID, float* GATE, int w, int lane) {
    const int t = w >> 3, h = w & 7;
    float sl0 = 0.f, sl1 = 0.f; int il0 = 0, il1 = 0;
#pragma unroll
    for (int p = 0; p < 2; ++p) {
        const bf16_t* q = QP + (size_t)t * 2048 + h * 256 + p * 128;
        const float* k0 = sub_keys + ((size_t)(h * 2 + p) * 128 + lane) * 128; const float* k1 = k0 + 64 * 128;
        float s0 = 0.f, s1 = 0.f;
        for (int d = 0; d < 128; ++d) { const float qd = bf2f(q[d]); s0 += qd * k0[d]; s1 += qd * k1[d]; }
        float ls = 0.f; int li = 0;
        for (int r = 0; r < 16; ++r) {
            float bv; int bi; if (s0 >= s1) { bv = s0; bi = lane; } else { bv = s1; bi = lane + 64; }
#pragma unroll
            for (int o = 32; o >= 1; o >>= 1) { const float ov = __shfl_xor(bv, o); const int oi = __shfl_xor(bi, o); if (ov > bv || (ov == bv && oi < bi)) { bv = ov; bi = oi; } }
            if (lane == r) { ls = bv; li = bi; }
            if (bi == lane) s0 = -INFINITY; else if (bi == lane + 64) s1 = -INFINITY;
        }
        if (p == 0) { sl0 = ls; il0 = li; } else { sl1 = ls; il1 = li; }
    }
    float cv0, cv1, cv2, cv3;
    { const int c0 = lane, c1 = lane + 64, c2 = lane + 128, c3 = lane + 192;
      cv0 = __shfl(sl0, c0 >> 4) + __shfl(sl1, c0 & 15); cv1 = __shfl(sl0, c1 >> 4) + __shfl(sl1, c1 & 15);
      cv2 = __shfl(sl0, c2 >> 4) + __shfl(sl1, c2 & 15); cv3 = __shfl(sl0, c3 >> 4) + __shfl(sl1, c3 & 15); }
    float tv = -INFINITY; int tc = 0;
    for (int r = 0; r < 16; ++r) {
        float bv = cv0; int bc = lane;
        if (cv1 > bv) { bv = cv1; bc = lane + 64; }
        if (cv2 > bv) { bv = cv2; bc = lane + 128; }
        if (cv3 > bv) { bv = cv3; bc = lane + 192; }
#pragma unroll
        for (int o = 32; o >= 1; o >>= 1) { const float ov = __shfl_xor(bv, o); const int oc = __shfl_xor(bc, o); if (ov > bv || (ov == bv && oc < bc)) { bv = ov; bc = oc; } }
        if (lane == r) { tv = bv; tc = bc; }
        if (bc == lane) cv0 = -INFINITY; else if (bc == lane + 64) cv1 = -INFINITY; else if (bc == lane + 128) cv2 = -INFINITY; else if (bc == lane + 192) cv3 = -INFINITY;
    }
    const float mx = __shfl(tv, 0);
    const float e = lane < 16 ? expf(tv - mx) : 0.f;
    const float sum = wave_sum(e);
    const int e1 = __shfl(il0, (tc >> 4) & 15), e2 = __shfl(il1, tc & 15);
    if (lane < 16) { EID[(size_t)t * 128 + h * 16 + lane] = e1 * 128 + e2; GATE[(size_t)t * 128 + h * 16 + lane] = e / sum; }
}

__global__ void __launch_bounds__(256) k_topk_naive(const bf16_t* QP, const float* sub_keys, int* EID, float* GATE) { topk_item(QP, sub_keys, EID, GATE, blockIdx.x * 4 + (threadIdx.x >> 6), threadIdx.x & 63); }

__device__ __forceinline__ float gelu_tanh(float x) { const float u = 0.7978845608028654f * (x + 0.044715f * x * x * x); return 0.5f * x * (1.f + tanhf(u)); }

__device__ __forceinline__ void gather_item(const bf16_t* H2, const int* EID, const float* GATE, const float* peer_u, const float* peer_v, const float* mod, float* out, int t, int lane) {
    const int b = t / S_;
    float hv[16], y[16];
#pragma unroll
    for (int j = 0; j < 4; ++j) { const uint2 raw = *(const uint2*)(H2 + (size_t)t * 1024 + 4 * lane + 256 * j); hv[4 * j] = lo2f(raw.x); hv[4 * j + 1] = hi2f(raw.x); hv[4 * j + 2] = lo2f(raw.y); hv[4 * j + 3] = hi2f(raw.y); }
#pragma unroll
    for (int i = 0; i < 16; ++i) y[i] = 0.f;
    const int e_a = EID[(size_t)t * 128 + lane], e_b = EID[(size_t)t * 128 + 64 + lane];
    const float g_a = GATE[(size_t)t * 128 + lane], g_b = GATE[(size_t)t * 128 + 64 + lane];
    for (int jj = 0; jj < 128; ++jj) {
        const int e = jj < 64 ? __shfl(e_a, jj) : __shfl(e_b, jj - 64);
        const float g = jj < 64 ? __shfl(g_a, jj) : __shfl(g_b, jj - 64);
        const float4* ur = (const float4*)(peer_u + (size_t)e * 1024) + lane;
        float s = 0.f;
#pragma unroll
        for (int j = 0; j < 4; ++j) { const float4 u4 = ur[64 * j]; s += (u4.x * hv[4 * j] + u4.y * hv[4 * j + 1]) + (u4.z * hv[4 * j + 2] + u4.w * hv[4 * j + 3]); }
        s = wave_sum(s);
        const float wgt = g * gelu_tanh(s);
        const float4* vr = (const float4*)(peer_v + (size_t)e * 1024) + lane;
#pragma unroll
        for (int j = 0; j < 4; ++j) { const float4 v4 = vr[64 * j]; y[4 * j] += wgt * v4.x; y[4 * j + 1] += wgt * v4.y; y[4 * j + 2] += wgt * v4.z; y[4 * j + 3] += wgt * v4.w; }
    }
    const float* g2 = mod + b * 6144 + 5 * 1024;
#pragma unroll
    for (int j = 0; j < 4; ++j) { const int col = 4 * lane + 256 * j; float4* op = (float4*)(out + (size_t)t * 1024 + col); float4 x1 = *op; const float4 gg = *(const float4*)(g2 + col);
        x1.x += gg.x * y[4 * j]; x1.y += gg.y * y[4 * j + 1]; x1.z += gg.z * y[4 * j + 2]; x1.w += gg.w * y[4 * j + 3]; *op = x1; }
}
__global__ void __launch_bounds__(256) k_gather_naive(const bf16_t* H2, const int* EID, const float* GATE, const float* peer_u, const float* peer_v, const float* mod, float* out) {
    gather_item(H2, EID, GATE, peer_u, peer_v, mod, out, blockIdx.x * 4 + (threadIdx.x >> 6), threadIdx.x & 63);
}


namespace pg8 {
#define PG8_LAS __attribute__((address_space(3)))
typedef unsigned short bf16_t;
typedef short bf16x8 __attribute__((ext_vector_type(8)));
typedef float f32x4 __attribute__((ext_vector_type(4)));
typedef unsigned u32x4 __attribute__((ext_vector_type(4)));
constexpr int BM = 256, BK = 64, HALF = 128, HTB = HALF * BK * 2  , STAGE_BYTES = 8 * HTB, NXCD = 8, WGM = 8;

__host__ __device__ __forceinline__ int lds_byte(int r, int c) { const int st = (r >> 4) * 2 + (c >> 5), rr = r & 15, cc = c & 31, ob = rr * 64 + cc * 2; return st * 1024 + (ob ^ (((ob >> 9) & 1) << 5)); }
__host__ __device__ __forceinline__ void stage_rc(int b, int& R, int& C) { const int st = b / 1024, sb = b % 1024, swz = sb ^ (((sb >> 9) & 1) << 5); R = (st >> 1) * 16 + swz / 64; C = (st & 1) * 32 + (swz % 64) / 2; }
__host__ __device__ __forceinline__ int perm32(int rho) { const int n = rho >> 4, i = rho & 15; return 8 * (i >> 2) + 4 * n + (i & 3); }

struct Unit { int pm, pn; };
struct Gemm { const bf16_t* A; const bf16_t* Bt; int M, N, K, lda; };

struct StaticOrder {
    int nM, nN, nwg, G, c;
    __host__ __device__ void init(int M, int N, int G_, int c_) { nM = M / BM; nN = N / BM; nwg = nM * nN; G = G_; c = c_; }
    __host__ __device__ bool next(int i, Unit& u) const {
        const long L = (long)i * G + c; if (L >= nwg) return false;
        int wgid = (int)L; { const int q = nwg / NXCD, r = nwg % NXCD, xcd = wgid % NXCD, off = wgid / NXCD; wgid = (xcd < r ? xcd * (q + 1) : r * (q + 1) + (xcd - r) * q) + off; }
        const int nig = WGM * nN, gid = wgid / nig, fm = gid * WGM, gsz = (nM - fm) < WGM ? (nM - fm) : WGM;
        u.pm = fm + ((wgid % nig) % gsz); u.pn = (wgid % nig) / gsz; return true;
    }
    __device__ __forceinline__ void a_ready(const Unit&) const {}
    __device__ __forceinline__ void done(const Unit&) const {}
};
__device__ __forceinline__ unsigned cvt_pk_bf16(float lo, float hi) { unsigned r; asm volatile("v_cvt_pk_bf16_f32 %0, %1, %2" : "=v"(r) : "v"(lo), "v"(hi)); return r; }
typedef float f32x2 __attribute__((ext_vector_type(2)));
template <class Epi, class Sched, bool ALIGN_EPI = false, bool SP2 = false>
__device__ __forceinline__ void gemm_phase(PG8_LAS unsigned char* lds, const Gemm g, const Sched& S, const Epi& E) {
    const int tid = threadIdx.x, wid = __builtin_amdgcn_readfirstlane(tid >> 6), lane = tid & 63, wr = wid >> 2, wc = wid & 3, fr = lane & 15, fq = lane >> 4;
    const int K = g.K, nt = K / BK;
    unsigned voffA[2], voffB[2];
#pragma unroll
    for (int i = 0; i < 2; ++i) { int R, C; stage_rc(tid * 16 + i * 8192, R, C); const int Rb = Epi::PERM ? ((R & ~31) + perm32(R & 31)) : R;
        voffA[i] = (unsigned)(R * g.lda + C) * 2u; voffB[i] = (unsigned)(Rb * K + C) * 2u; }
    const size_t kstep = (size_t)(BK * 2);
    const size_t hstepA = (size_t)HALF * g.lda * 2, hstepB = (size_t)HALF * K * 2;
    const size_t tstepA = 2 * hstepA, tstepB = 2 * hstepB;
    const unsigned ldsw = (unsigned)wid * 1024u;
    const int aoff = lds_byte(wr * 64 + fr, fq * 8), boff = lds_byte(wc * 32 + fr, fq * 8);
#define PG8_SA(b, h) (((b) * 2 + (h)) * HTB)
#define PG8_SB(b, h) ((4 + (b) * 2 + (h)) * HTB)
#define PG8_STAGE(bufoff, gbase, voff) do { _Pragma("unroll") for (int _i = 0; _i < 2; ++_i) \
        __builtin_amdgcn_global_load_lds((const unsigned*)((const char*)(gbase) + (voff)[_i]), (PG8_LAS unsigned*)(lds + (bufoff) + ldsw + _i * 8192), 16, 0, 0); } while (0)
#define PG8_LDA(dst, b, h) do { _Pragma("unroll") for (int m = 0; m < 4; ++m) _Pragma("unroll") for (int k = 0; k < 2; ++k) dst[m][k] = *(const PG8_LAS bf16x8*)(lds + PG8_SA(b, h) + aoff + m * 2048 + k * 1024); } while (0)
#define PG8_LDB(dst, b, h) do { _Pragma("unroll") for (int n = 0; n < 2; ++n) _Pragma("unroll") for (int k = 0; k < 2; ++k) dst[n][k] = *(const PG8_LAS bf16x8*)(lds + PG8_SB(b, h) + boff + n * 2048 + k * 1024); } while (0)
#define PG8_MMA(ai, bj, At, Bt) do { __builtin_amdgcn_s_setprio(1); _Pragma("unroll") for (int m = 0; m < 4; ++m) _Pragma("unroll") for (int n = 0; n < 2; ++n) _Pragma("unroll") for (int k = 0; k < 2; ++k) \
        acc[ai][bj][m][n] = __builtin_amdgcn_mfma_f32_16x16x32_bf16(Bt[n][k], At[m][k], acc[ai][bj][m][n], 0, 0, 0); __builtin_amdgcn_s_setprio(0); } while (0)
#define PG8_WAIT_V(n) asm volatile("s_waitcnt vmcnt(" #n ")" ::: "memory")
#define PG8_WAIT_L(n) asm volatile("s_waitcnt lgkmcnt(" #n ")" ::: "memory")
#define PG8_BAR __builtin_amdgcn_s_barrier()
#define PG8_SCHED __builtin_amdgcn_sched_barrier(0)
    Unit cur, nxt; int ui = 0;
    if (!S.next(0, cur)) return;
    f32x4 acc[2][2][4][2];
#pragma unroll
    for (int a = 0; a < 2; ++a)
#pragma unroll
        for (int b = 0; b < 2; ++b)
#pragma unroll
            for (int m = 0; m < 4; ++m)
#pragma unroll
                for (int n = 0; n < 2; ++n) acc[a][b][m][n] = (f32x4){0.f, 0.f, 0.f, 0.f};
    bf16x8 At[4][2], B0[2][2], B1[2][2];
    const char* cA = (const char*)g.A + (size_t)cur.pm * tstepA; const char* cB = (const char*)g.Bt + (size_t)cur.pn * tstepB;
    S.a_ready(cur);
    if constexpr (SP2) {
        PG8_STAGE(PG8_SB(0, 0), cB, voffB); PG8_STAGE(PG8_SB(0, 1), cB + hstepB, voffB); PG8_STAGE(PG8_SA(0, 0), cA, voffA); PG8_STAGE(PG8_SA(0, 1), cA + hstepA, voffA);
        if (wr == 1) PG8_BAR;
        PG8_WAIT_V(2); PG8_BAR;
        PG8_STAGE(PG8_SB(1, 0), cB + kstep, voffB); PG8_STAGE(PG8_SA(1, 0), cA + kstep, voffA); PG8_STAGE(PG8_SB(1, 1), cB + hstepB + kstep, voffB);
        PG8_WAIT_V(6); PG8_BAR;
    } else {
        PG8_STAGE(PG8_SB(0, 0), cB, voffB); PG8_STAGE(PG8_SA(0, 0), cA, voffA); PG8_STAGE(PG8_SB(0, 1), cB + hstepB, voffB); PG8_STAGE(PG8_SA(0, 1), cA + hstepA, voffA);
        if (wr == 1) PG8_BAR;
        PG8_WAIT_V(4); PG8_BAR;
        PG8_STAGE(PG8_SB(1, 0), cB + kstep, voffB); PG8_STAGE(PG8_SA(1, 0), cA + kstep, voffA); PG8_STAGE(PG8_SB(1, 1), cB + hstepB + kstep, voffB);
        PG8_WAIT_V(6); PG8_BAR;
    }
    for (;;) {
        const bool has_next = S.next(ui + 1, nxt);
        const char* nA = has_next ? (const char*)g.A + (size_t)nxt.pm * tstepA : cA; const char* nB = has_next ? (const char*)g.Bt + (size_t)nxt.pn * tstepB : cB;
        for (int t = 0; t < nt; t += 2) {
            const bool last = (t == nt - 2);
            const char* a1 = cA + (size_t)(t + 1) * kstep;
            const char* a2 = last ? nA : cA + (size_t)(t + 2) * kstep; const char* b2 = last ? nB : cB + (size_t)(t + 2) * kstep;
            const char* a3 = a2 + kstep; const char* b3 = b2 + kstep;
            if (last && has_next) S.a_ready(nxt);
            if constexpr (SP2) {
            PG8_LDB(B0, 0, 0); PG8_LDB(B1, 0, 1); PG8_SCHED; PG8_LDA(At, 0, 0); PG8_STAGE(PG8_SA(1, 1), a1 + hstepA, voffA);
            PG8_WAIT_V(8); PG8_WAIT_L(0); PG8_BAR; PG8_MMA(0, 0, At, B0); PG8_MMA(0, 1, At, B1); PG8_BAR; PG8_SCHED;
            PG8_LDA(At, 0, 1); PG8_STAGE(PG8_SB(0, 0), b2, voffB); PG8_STAGE(PG8_SB(0, 1), b2 + hstepB, voffB); PG8_STAGE(PG8_SA(0, 0), a2, voffA);
            PG8_WAIT_V(8); PG8_WAIT_L(0); PG8_BAR; PG8_MMA(1, 0, At, B0); PG8_MMA(1, 1, At, B1); PG8_BAR; PG8_SCHED;
            PG8_LDB(B0, 1, 0); PG8_LDB(B1, 1, 1); PG8_SCHED; PG8_LDA(At, 1, 0); PG8_STAGE(PG8_SA(0, 1), a2 + hstepA, voffA);
            PG8_WAIT_V(8); PG8_WAIT_L(0); PG8_BAR; PG8_MMA(0, 0, At, B0); PG8_MMA(0, 1, At, B1); PG8_BAR; PG8_SCHED;
            PG8_LDA(At, 1, 1); PG8_STAGE(PG8_SB(1, 0), b3, voffB); PG8_STAGE(PG8_SB(1, 1), b3 + hstepB, voffB); PG8_STAGE(PG8_SA(1, 0), a3, voffA);
            PG8_WAIT_V(8); PG8_WAIT_L(0); PG8_BAR; PG8_MMA(1, 0, At, B0); PG8_MMA(1, 1, At, B1); PG8_BAR; PG8_SCHED;
            } else {
            PG8_LDB(B0, 0, 0); PG8_SCHED; PG8_LDA(At, 0, 0); PG8_STAGE(PG8_SA(1, 1), a1 + hstepA, voffA);
            PG8_WAIT_L(8); PG8_BAR; PG8_WAIT_L(0); PG8_MMA(0, 0, At, B0); PG8_BAR; PG8_SCHED;
            PG8_LDB(B1, 0, 1); PG8_STAGE(PG8_SB(0, 0), b2, voffB);
            PG8_BAR; PG8_WAIT_L(0); PG8_MMA(0, 1, At, B1); PG8_BAR;
            PG8_LDA(At, 0, 1); PG8_STAGE(PG8_SA(0, 0), a2, voffA);
            PG8_BAR; PG8_WAIT_L(0); PG8_MMA(1, 0, At, B0); PG8_BAR; PG8_SCHED;
            PG8_STAGE(PG8_SB(0, 1), b2 + hstepB, voffB);
            PG8_WAIT_V(6); PG8_BAR; PG8_MMA(1, 1, At, B1); PG8_BAR;
            PG8_LDB(B0, 1, 0); PG8_SCHED; PG8_LDA(At, 1, 0); PG8_STAGE(PG8_SA(0, 1), a2 + hstepA, voffA);
            PG8_WAIT_L(8); PG8_BAR; PG8_WAIT_L(0); PG8_MMA(0, 0, At, B0); PG8_BAR; PG8_SCHED;
            PG8_LDB(B1, 1, 1); PG8_STAGE(PG8_SB(1, 0), b3, voffB);
            PG8_BAR; PG8_WAIT_L(0); PG8_MMA(0, 1, At, B1); PG8_BAR;
            PG8_LDA(At, 1, 1); PG8_STAGE(PG8_SA(1, 0), a3, voffA);
            PG8_BAR; PG8_WAIT_L(0); PG8_MMA(1, 0, At, B0); PG8_BAR; PG8_SCHED;
            PG8_STAGE(PG8_SB(1, 1), b3 + hstepB, voffB);
            PG8_WAIT_V(6); PG8_BAR; PG8_MMA(1, 1, At, B1); PG8_BAR;
            }
        }
        if constexpr (ALIGN_EPI) { if (wr == 0) PG8_BAR; }
        if constexpr (!Epi::AFTER_DRAIN) { E(acc, cur, wr, wc, fr, fq); S.done(cur); }
        if (!has_next) break;
#pragma unroll
        for (int a = 0; a < 2; ++a)
#pragma unroll
            for (int b = 0; b < 2; ++b)
#pragma unroll
                for (int m = 0; m < 4; ++m)
#pragma unroll
                    for (int n = 0; n < 2; ++n) acc[a][b][m][n] = (f32x4){0.f, 0.f, 0.f, 0.f};
        cur = nxt; cA = nA; cB = nB; ++ui;
        if constexpr (ALIGN_EPI) { if (wr == 1) PG8_BAR; }
    }
    PG8_WAIT_V(0);
    if constexpr (!ALIGN_EPI) { if (wr == 0) PG8_BAR; }
    PG8_BAR;
    if constexpr (Epi::AFTER_DRAIN) { E.fused(acc, cur, wr, wc, fr, fq, lds, wid, lane); S.done(cur); }
#undef PG8_SA
#undef PG8_SB
#undef PG8_STAGE
#undef PG8_LDA
#undef PG8_LDB
#undef PG8_MMA
#undef PG8_WAIT_V
#undef PG8_WAIT_L
#undef PG8_BAR
#undef PG8_SCHED
}
}


#define GAS __attribute__((address_space(1)))
#define LAS __attribute__((address_space(3)))
typedef float f32x4 __attribute__((ext_vector_type(4)));
typedef unsigned u32x4 __attribute__((ext_vector_type(4)));
#define XB_TMO      128
#define XB_XCNT(j)  (256  + 64 * (j))
#define XB_XSUB(j)  (1280 + 64 * (j))
#define XB_XGEN(j)  (2304 + 64 * (j))
#define XB_TOP      3328
#define XB_TOPGEN   3392
#define XCD_BAR_WORDS 3456
#define XB_SPIN_CAP (1u << 18)

__device__ __forceinline__ unsigned xb_ld(unsigned* p)              { return __hip_atomic_load(p, __ATOMIC_RELAXED, __HIP_MEMORY_SCOPE_AGENT); }
__device__ __forceinline__ unsigned xb_add(unsigned* p, unsigned v) { return __hip_atomic_fetch_add(p, v, __ATOMIC_RELAXED, __HIP_MEMORY_SCOPE_AGENT); }
__device__ __forceinline__ unsigned xb_xcc_id() { return (unsigned)__builtin_amdgcn_s_getreg((3 << 11) | 20) & 0xFu; }
#define XB_SPIN(cond, bar) do { unsigned _sp = 0; while (cond) { __builtin_amdgcn_s_sleep(1); \
    if ((++_sp & 255u) == 0u) { if (xb_ld(&(bar)[XB_TMO])) break; if (_sp > XB_SPIN_CAP) { atomicAdd(&(bar)[XB_TMO], 1u); break; } } } } while (0)

struct XcdBarrier {
    unsigned* bar; unsigned x;
    volatile LAS unsigned* st;
};

__device__ __forceinline__ XcdBarrier xcd_barrier_post(unsigned* bar, volatile LAS unsigned* st) {
    XcdBarrier b; b.bar = bar; b.x = xb_xcc_id(); b.st = st;
    if (threadIdx.x == 0) (void)xb_add(&bar[XB_XCNT(b.x)], 1u);
    return b;
}
__device__ __forceinline__ void xcd_barrier_complete(unsigned* bar, unsigned x, unsigned& nloc, unsigned& nx) {
    const unsigned G = gridDim.x * gridDim.y * gridDim.z;
    unsigned sum, cnt, mine, sp = 0u;
    for (;;) {
        sum = 0u; cnt = 0u; mine = 0u;
#pragma unroll
        for (unsigned j = 0; j < 16; ++j) { const unsigned c = xb_ld(&bar[XB_XCNT(j)]); sum += c; cnt += (c > 0u) ? 1u : 0u; mine = (j == x) ? c : mine; }
        if (sum == G) break;
        __builtin_amdgcn_s_sleep(1);
        if ((++sp & 255u) == 0u) { if (xb_ld(&bar[XB_TMO])) break; if (sp > XB_SPIN_CAP) { atomicAdd(&bar[XB_TMO], 1u); break; } }
    }
    nloc = mine > 0u ? mine : 1u; nx = cnt > 0u ? cnt : 1u;
}

__device__ __forceinline__ void xcd_barrier(const XcdBarrier& b) {
    asm volatile("s_waitcnt vmcnt(0)" ::: "memory");
    __syncthreads();
    if (threadIdx.x == 0) {
        unsigned* bar = b.bar;
        __builtin_amdgcn_s_waitcnt(0);
        unsigned nloc = b.st[0], nx = b.st[1];
        if (nloc == 0u) { xcd_barrier_complete(bar, b.x, nloc, nx); b.st[0] = nloc; b.st[1] = nx; }
        const unsigned old = xb_add(&bar[XB_XSUB(b.x)], 1u);
        const unsigned gen = old / nloc;
        if (old + 1u == (gen + 1u) * nloc) {
            __builtin_amdgcn_fence(__ATOMIC_RELEASE, "agent");
            asm volatile("s_waitcnt vmcnt(0)" ::: "memory");
            const unsigned og = xb_add(&bar[XB_TOP], 1u);
            const unsigned tg = og / nx;
            if (og + 1u == (tg + 1u) * nx) xb_add(&bar[XB_TOPGEN], 1u);
            else XB_SPIN(xb_ld(&bar[XB_TOPGEN]) == tg, bar);
            __builtin_amdgcn_fence(__ATOMIC_ACQUIRE, "agent");
            xb_add(&bar[XB_XGEN(b.x)], 1u);
            asm volatile("s_waitcnt vmcnt(0)" ::: "memory");
        } else {
            XB_SPIN(xb_ld(&bar[XB_XGEN(b.x)]) == gen, bar);
            __builtin_amdgcn_fence(__ATOMIC_ACQUIRE, "agent");
            asm volatile("s_waitcnt vmcnt(0)" ::: "memory");
        }
    }
    __syncthreads();
}


constexpr int NWAVES = 8;
constexpr int RING_BYTES = 131072, LDSCTL_OFF = RING_BYTES, MISC_OFF = LDSCTL_OFF + 320, LDS_BYTES = 147456;
constexpr size_t WS_CTL = 0, CTL_ZERO_BYTES = 1 * MiB;
constexpr int CW_BAR = 4096, N_BAR_REGIONS = 16;
static_assert((CW_BAR + N_BAR_REGIONS * XCD_BAR_WORDS) * 4 <= (int)CTL_ZERO_BYTES, "barrier words inside the memset region");
constexpr size_t WS_WIN = 10 * MiB;
constexpr size_t WS_WUQ = 15 * MiB;
constexpr size_t WS_WUKV = 16 * MiB;
constexpr size_t WS_WO = 17 * MiB;
constexpr size_t WS_WPQ = 19 * MiB;
constexpr size_t WS_SK = 23 * MiB;
constexpr size_t WS_U16 = 24 * MiB;
constexpr size_t WS_V16 = 56 * MiB;


namespace att {
typedef short bf16x8 __attribute__((ext_vector_type(8)));
typedef short s16x4 __attribute__((ext_vector_type(4)));
typedef float f32x16 __attribute__((ext_vector_type(16)));
constexpr int LK = 0, KSLOT = 12288, LV = 2 * KSLOT, VSLOT = 8192, LB = LV + 2 * VSLOT, BSLOT = 256, LWS = LB + 2 * BSLOT, LOST = LWS + 8 * 256, ATT_LDS = LOST + 8 * 4096;
static_assert(ATT_LDS <= 131072, "attention scratch fits the ring region");
struct Desc { const bf16_t* Q; int pq; const bf16_t* K; int pk; const bf16_t* V; int pv; bf16_t* O; int po; const float* FC; };

__device__ __forceinline__ int crow(int r, int hi) { return (r & 3) + 8 * (r >> 2) + 4 * hi; }
__device__ __forceinline__ float xmax32(float v) { auto rr = __builtin_amdgcn_permlane32_swap(__float_as_uint(v), __float_as_uint(v), false, false); return fmaxf(__uint_as_float(rr[0]), __uint_as_float(rr[1])); }
__device__ __forceinline__ float xsum32(float v) { auto rr = __builtin_amdgcn_permlane32_swap(__float_as_uint(v), __float_as_uint(v), false, false); return __uint_as_float(rr[0]) + __uint_as_float(rr[1]); }
__device__ __forceinline__ unsigned cvtpk(float lo, float hi) { typedef float f2 __attribute__((ext_vector_type(2))); typedef __bf16 b2 __attribute__((ext_vector_type(2))); f2 v = {lo, hi}; b2 b = __builtin_convertvector(v, b2); return __builtin_bit_cast(unsigned, b); }
typedef short v4i16_t __attribute__((ext_vector_type(4)));
__device__ __forceinline__ s16x4 vtr(LAS const unsigned char* p) { return __builtin_bit_cast(s16x4, __builtin_amdgcn_ds_read_tr16_b64_v4i16((LAS v4i16_t*)p)); }

template <int KS, bool BIAS>
__device__ __forceinline__ void attn_unit(const Desc& d, int qb, int j0, LAS unsigned char* shm) {
    const int tid = threadIdx.x, lane = tid & 63, r32 = lane & 31, hi = lane >> 5; const int wid = __builtin_amdgcn_readfirstlane(tid >> 6);
    const int q0 = qb * 256, NT = (q0 + 256) / 64;
    LAS float* wsf = (LAS float*)(shm + LWS) + wid * 64;
    bf16x8 qr[KS];
    { const bf16_t* qp = d.Q + (size_t)(q0 + wid * 32 + r32) * d.pq + hi * 8;
#pragma unroll
      for (int d0 = 0; d0 < KS; ++d0) qr[d0] = *(const bf16x8*)(qp + d0 * 16); }
    const float fcref = BIAS ? d.FC[q0] : 0.f;
    const bf16_t* ksrc0 = d.K + (size_t)lane * d.pk + wid * 8;
    const bf16_t* ksrc1 = d.K + (size_t)lane * d.pk + (8 + wid) * 8;
    const bf16_t* vsrc = d.V + (size_t)(16 * (wid & 3) + (lane >> 2)) * d.pv + (wid >> 2) * 32 + (lane & 3) * 8;
    const int kdst0 = LK + wid * 1024 + lane * 16, kdst1 = LK + (8 + wid) * 1024 + lane * 16, vdst = LV + wid * 1024 + lane * 16;
    const bool k2 = (KS > 4) && (wid < 2 * KS - 8);
    u32x4 kr0, kr1, vr; float br = 0.f;
#define ATT_LOAD(t) do { kr0 = *(const u32x4*)(ksrc0 + (size_t)(t) * 64 * d.pk); if (k2) kr1 = *(const u32x4*)(ksrc1 + (size_t)(t) * 64 * d.pk); \
        vr = *(const u32x4*)(vsrc + (size_t)(t) * 64 * d.pv); if (BIAS && wid == 4) br = d.FC[(t) * 64 + lane]; } while (0)
#define ATT_WRITE(slot) do { *(LAS u32x4*)(shm + kdst0 + (slot) * KSLOT) = kr0; if (k2) *(LAS u32x4*)(shm + kdst1 + (slot) * KSLOT) = kr1; \
        *(LAS u32x4*)(shm + vdst + (slot) * VSLOT) = vr; if (BIAS && wid == 4) *(LAS float*)(shm + LB + (slot) * BSLOT + lane * 4) = (fcref - br) * LOG2E; } while (0)
    f32x16 o0, o1;
#pragma unroll
    for (int r = 0; r < 16; ++r) { o0[r] = 0.f; o1[r] = 0.f; }
    float m = -INFINITY, l = 0.f;
    const int qrel = wid * 32 + r32;
    const int kfrag = LK + hi * 1024 + r32 * 16;
    const int vfrag = LV + ((lane >> 4) & 1) * 32 + (lane & 3) * 8 + (4 * hi + ((lane & 15) >> 2)) * 64;
    ATT_LOAD(j0); ATT_WRITE(0);
    __syncthreads();
    for (int t = j0; t < NT; ++t) {
        const int slot = (t - j0) & 1;
        if (t + 1 < NT) ATT_LOAD(t + 1);
        const int jb = t - (NT - 4);
        if (!(jb >= 0 && 64 * jb > 32 * wid + 31)) {
            f32x16 p0, p1;
            if (BIAS) {
                LAS const unsigned char* bp = shm + LB + slot * BSLOT + 16 * hi;
#pragma unroll
                for (int g = 0; g < 4; ++g) { const f32x4 a = *(LAS const f32x4*)(bp + 32 * g), b = *(LAS const f32x4*)(bp + 128 + 32 * g);
                    p0[4 * g] = a[0]; p0[4 * g + 1] = a[1]; p0[4 * g + 2] = a[2]; p0[4 * g + 3] = a[3]; p1[4 * g] = b[0]; p1[4 * g + 1] = b[1]; p1[4 * g + 2] = b[2]; p1[4 * g + 3] = b[3]; }
            } else {
#pragma unroll
                for (int r = 0; r < 16; ++r) { p0[r] = 0.f; p1[r] = 0.f; }
            }
            LAS const unsigned char* kp = shm + kfrag + slot * KSLOT;
#pragma unroll
            for (int d0 = 0; d0 < KS; ++d0) {
                const bf16x8 a0 = *(LAS const bf16x8*)(kp + d0 * 2048), a1 = *(LAS const bf16x8*)(kp + d0 * 2048 + 512);
                p0 = __builtin_amdgcn_mfma_f32_32x32x16_bf16(a0, qr[d0], p0, 0, 0, 0);
                p1 = __builtin_amdgcn_mfma_f32_32x32x16_bf16(a1, qr[d0], p1, 0, 0, 0);
            }
            if (jb >= 0) {
                const int kb = 64 * jb + 4 * hi;
#pragma unroll
                for (int r = 0; r < 16; ++r) { const int kv = kb + (r & 3) + 8 * (r >> 2); if (kv > qrel) p0[r] = -INFINITY; if (kv + 32 > qrel) p1[r] = -INFINITY; }
            }
            float rm = fmaxf(p0[0], p1[0]);
#pragma unroll
            for (int r = 1; r < 16; ++r) rm = fmaxf(rm, fmaxf(p0[r], p1[r]));
            rm = xmax32(rm);
            const float mn = fmaxf(m, rm);
            const float alpha = __builtin_amdgcn_exp2f(m - mn);
            m = mn;
            float sacc = 0.f;
#pragma unroll
            for (int r = 0; r < 16; ++r) { p0[r] = __builtin_amdgcn_exp2f(p0[r] - mn); p1[r] = __builtin_amdgcn_exp2f(p1[r] - mn); sacc += p0[r] + p1[r]; }
            l = l * alpha + sacc;
            if (__any(alpha != 1.f)) {
                if (hi == 0) wsf[r32] = alpha;
#pragma unroll
                for (int g = 0; g < 4; ++g) { const f32x4 a = *(LAS const f32x4*)(wsf + 8 * g + 4 * hi);
#pragma unroll
                    for (int i = 0; i < 4; ++i) { o0[4 * g + i] *= a[i]; o1[4 * g + i] *= a[i]; } }
            }
            LAS const unsigned char* vp = shm + vfrag + slot * VSLOT;
#pragma unroll
            for (int ks = 0; ks < 4; ++ks) {
                const f32x16& pp = ks < 2 ? p0 : p1; const int bq = (ks & 1) * 8;
                u32x4 pw; pw.x = cvtpk(pp[bq], pp[bq + 1]); pw.y = cvtpk(pp[bq + 2], pp[bq + 3]); pw.z = cvtpk(pp[bq + 4], pp[bq + 5]); pw.w = cvtpk(pp[bq + 6], pp[bq + 7]);
                const bf16x8 pa = __builtin_bit_cast(bf16x8, pw);
                const s16x4 l0 = vtr(vp + ks * 1024), h0 = vtr(vp + ks * 1024 + 512), l1 = vtr(vp + 4096 + ks * 1024), h1 = vtr(vp + 4096 + ks * 1024 + 512);
                const bf16x8 v0 = {l0[0], l0[1], l0[2], l0[3], h0[0], h0[1], h0[2], h0[3]}, v1 = {l1[0], l1[1], l1[2], l1[3], h1[0], h1[1], h1[2], h1[3]};
                o0 = __builtin_amdgcn_mfma_f32_32x32x16_bf16(pa, v0, o0, 0, 0, 0);
                o1 = __builtin_amdgcn_mfma_f32_32x32x16_bf16(pa, v1, o1, 0, 0, 0);
            }
        }
        if (t + 1 < NT) ATT_WRITE(slot ^ 1);
        __syncthreads();
    }
#undef ATT_LOAD
#undef ATT_WRITE
    l = xsum32(l);
    if (hi == 0) wsf[32 + r32] = l;
    float rli[16];
#pragma unroll
    for (int g = 0; g < 4; ++g) { const f32x4 a = *(LAS const f32x4*)(wsf + 32 + 8 * g + 4 * hi);
#pragma unroll
        for (int i = 0; i < 4; ++i) rli[4 * g + i] = 1.f / a[i]; }
    LAS bf16_t* stg = (LAS bf16_t*)(shm + LOST) + wid * 2048;
#pragma unroll
    for (int r = 0; r < 16; ++r) { const int orow = crow(r, hi); stg[orow * 64 + r32] = f2bf(o0[r] * rli[r]); stg[orow * 64 + 32 + r32] = f2bf(o1[r] * rli[r]); }
    bf16_t* Ow = d.O + (size_t)(q0 + wid * 32) * d.po;
#pragma unroll
    for (int i = 0; i < 4; ++i) { const int row = i * 8 + (lane >> 3), ch = lane & 7; const u32x4 v = *(LAS const u32x4*)(stg + row * 64 + ch * 8); *(u32x4*)(Ow + (size_t)row * d.po + ch * 8) = v; }
    __syncthreads();
}
}


namespace pk {
typedef short bf16x8 __attribute__((ext_vector_type(8)));
typedef float f32x16 __attribute__((ext_vector_type(16)));
__device__ __forceinline__ unsigned f2sort(float f) { const unsigned b = __float_as_uint(f); return b ^ ((unsigned)((int)b >> 31) | 0x80000000u); }
__device__ __forceinline__ float sort2f(unsigned u) { return __uint_as_float((u & 0x80000000u) ? (u ^ 0x80000000u) : ~u); }
__device__ __forceinline__ void ce(unsigned& a, unsigned& b) { const unsigned mx = a > b ? a : b, mn = a > b ? b : a; a = mx; b = mn; }
__device__ __forceinline__ void sort16(unsigned (&v)[16]) {
#pragma unroll
    for (int k = 2; k <= 16; k <<= 1)
#pragma unroll
        for (int j = k >> 1; j >= 1; j >>= 1)
#pragma unroll
            for (int i = 0; i < 16; ++i) { const int l = i ^ j; if (l > i) { if ((i & k) == 0) ce(v[i], v[l]); else ce(v[l], v[i]); } }
}
__device__ __forceinline__ void merge16(unsigned (&a)[16], const unsigned (&b)[16]) {
#pragma unroll
    for (int i = 0; i < 16; ++i) a[i] = a[i] > b[15 - i] ? a[i] : b[15 - i];
#pragma unroll
    for (int j = 8; j >= 1; j >>= 1)
#pragma unroll
        for (int i = 0; i < 16; ++i) { const int l = i ^ j; if (l > i) ce(a[i], a[l]); }
}
__device__ __forceinline__ void top16of64(unsigned (&k)[64], unsigned (&out)[16]) {
    unsigned g1[16], g2[16], g3[16];
#pragma unroll
    for (int i = 0; i < 16; ++i) { out[i] = k[i]; g1[i] = k[16 + i]; g2[i] = k[32 + i]; g3[i] = k[48 + i]; }
    sort16(out); sort16(g1); sort16(g2); sort16(g3);
    merge16(out, g1); merge16(g2, g3); merge16(out, g2);
}
__device__ __forceinline__ unsigned sel4(const unsigned (&w)[4], int q) { const unsigned a = q & 1 ? w[1] : w[0], b = q & 1 ? w[3] : w[2]; return q & 2 ? b : a; }

template <int I> struct COff { static constexpr int v = COff<I - 1>::v + 16 / I; };
template <> struct COff<0> { static constexpr int v = 0; };
static_assert(COff<16>::v == 50, "50 candidates can reach the top 16 of a sorted 16 x 16 sum grid");
template <int I> __device__ __forceinline__ void fill_cand(unsigned (&c64)[64], const float (&s1)[16], const float (&s2)[16]) {
    if constexpr (I < 16) {
#pragma unroll
        for (int j = 0; j < 16 / (I + 1); ++j) c64[COff<I>::v + j] = (f2sort(s1[I] + s2[j]) & 0xFFFFFF00u) | (unsigned)(255 - (I * 16 + j));
        fill_cand<I + 1>(c64, s1, s2);
    }
}
__device__ __forceinline__ void topk_item(const bf16_t* QP, const bf16_t* SK, int* EID, float* GATE, int item, int lane) {
    const int tg = item >> 3, h = item & 7, r32 = lane & 31, hi = lane >> 5;
    const int t = tg * 32 + r32;
    unsigned own[2][16];
#pragma unroll
    for (int p = 0; p < 2; ++p) {
        const bf16_t* qrow = QP + (size_t)t * 2048 + h * 256 + p * 128 + hi * 8;
        bf16x8 qf[8];
#pragma unroll
        for (int d0 = 0; d0 < 8; ++d0) qf[d0] = *(const bf16x8*)(qrow + d0 * 16);
        const bf16_t* skb = SK + (size_t)((h * 2 + p) * 128 + r32) * 128 + hi * 8;
#pragma unroll 1
        for (int kt = 0; kt < 4; ++kt) {
            f32x16 acc;
#pragma unroll
            for (int r = 0; r < 16; ++r) acc[r] = 0.f;
#pragma unroll
            for (int d0 = 0; d0 < 8; ++d0) { const bf16x8 a = *(const bf16x8*)(skb + (size_t)kt * 32 * 128 + d0 * 16); acc = __builtin_amdgcn_mfma_f32_32x32x16_bf16(a, qf[d0], acc, 0, 0, 0); }
            unsigned cur[16];
#pragma unroll
            for (int r = 0; r < 16; ++r) { const int idx0 = kt * 32 + (r & 3) + 8 * (r >> 2);
                cur[r] = (f2sort(acc[r]) & 0xFFFFFF80u) | (unsigned)(127 - idx0 - 4 * hi); }
            sort16(cur);
            if (kt == 0) {
#pragma unroll
                for (int r = 0; r < 16; ++r) own[p][r] = cur[r];
            } else merge16(own[p], cur);
        }
    }
    unsigned fin[16];
    {
        unsigned oth[16];
#pragma unroll
        for (int i = 0; i < 16; ++i) { auto rr = __builtin_amdgcn_permlane32_swap(own[0][i], own[1][i], false, false); fin[i] = rr[0]; oth[i] = rr[1]; }
        merge16(fin, oth);
    }
    unsigned s1k[16], s2k[16];
#pragma unroll
    for (int i = 0; i < 16; ++i) { auto rr = __builtin_amdgcn_permlane32_swap(fin[i], fin[i], false, false); s1k[i] = rr[0]; s2k[i] = rr[1]; }
    float s1[16], s2[16]; unsigned long long i1lo = 0ull, i1hi = 0ull, i2lo = 0ull, i2hi = 0ull;
#pragma unroll
    for (int i = 0; i < 16; ++i) { s1[i] = sort2f(s1k[i] & 0xFFFFFF80u); s2[i] = sort2f(s2k[i] & 0xFFFFFF80u);
        const unsigned long long a = (unsigned long long)(127u - (s1k[i] & 0x7Fu)) << (8 * (i & 7)), b = (unsigned long long)(127u - (s2k[i] & 0x7Fu)) << (8 * (i & 7));
        if (i < 8) { i1lo |= a; i2lo |= b; } else { i1hi |= a; i2hi |= b; } }
    unsigned c64[64];
#pragma unroll
    for (int i = 50; i < 64; ++i) c64[i] = 0u;
    fill_cand<0>(c64, s1, s2);
    unsigned top[16];
    top16of64(c64, top);
    float ev[16]; float sum = 0.f; const float mx = sort2f(top[0] & 0xFFFFFF00u);
#pragma unroll
    for (int r = 0; r < 16; ++r) { ev[r] = __expf(sort2f(top[r] & 0xFFFFFF00u) - mx); sum += ev[r]; }
    const float rs = 1.f / sum;
    if (hi == 0) {
        int* ep = EID + (size_t)t * 128 + h * 16;
#pragma unroll
        for (int q4 = 0; q4 < 4; ++q4) { int ee[4];
#pragma unroll
            for (int z = 0; z < 4; ++z) { const int code = 255 - (int)(top[q4 * 4 + z] & 0xFFu), i = code >> 4, j = code & 15;
                const unsigned e1 = (unsigned)(((i & 8) ? i1hi : i1lo) >> (8 * (i & 7))) & 0xFFu, e2 = (unsigned)(((j & 8) ? i2hi : i2lo) >> (8 * (j & 7))) & 0xFFu; ee[z] = (int)(e1 * 128u + e2); }
            *(int4*)(ep + q4 * 4) = make_int4(ee[0], ee[1], ee[2], ee[3]); }
    } else {
        float* gp = GATE + (size_t)t * 128 + h * 16;
#pragma unroll
        for (int q4 = 0; q4 < 4; ++q4) *(float4*)(gp + q4 * 4) = make_float4(ev[q4 * 4] * rs, ev[q4 * 4 + 1] * rs, ev[q4 * 4 + 2] * rs, ev[q4 * 4 + 3] * rs);
    }
}
}


namespace gx {
__device__ __forceinline__ int sdot16(const int4 a, const int4 b) {
    int s = __builtin_amdgcn_sdot4(a.x, b.x, 0, false); s = __builtin_amdgcn_sdot4(a.y, b.y, s, false); s = __builtin_amdgcn_sdot4(a.z, b.z, s, false); return __builtin_amdgcn_sdot4(a.w, b.w, s, false);
}
__device__ __forceinline__ void quant_row(const float* src, unsigned char* dst, float* scale_out, int off, int lane) {
    const float4* sr = (const float4*)src + lane; float4 v[4]; float am = 0.f;
#pragma unroll
    for (int j = 0; j < 4; ++j) { v[j] = sr[64 * j]; am = fmaxf(am, fmaxf(fmaxf(fabsf(v[j].x), fabsf(v[j].y)), fmaxf(fabsf(v[j].z), fabsf(v[j].w)))); }
#pragma unroll
    for (int o = 1; o < 64; o <<= 1) am = fmaxf(am, __shfl_xor(am, o));
    const float inv = am > 0.f ? 127.f / am : 0.f;
#pragma unroll
    for (int j = 0; j < 4; ++j) { const int q0 = (int)rintf(v[j].x * inv) + off, q1 = (int)rintf(v[j].y * inv) + off, q2 = (int)rintf(v[j].z * inv) + off, q3 = (int)rintf(v[j].w * inv) + off;
        *(unsigned*)(dst + 4 * lane + 256 * j) = (unsigned)(q0 & 255) | ((unsigned)(q1 & 255) << 8) | ((unsigned)(q2 & 255) << 16) | ((unsigned)(q3 & 255) << 24); }
    if (lane == 0) *scale_out = am * (1.f / 127.f);
}

__device__ __forceinline__ void u_token(const unsigned char* UQ, const float* SU, float* Arow, int s, int e0, int e1, const int4 hq, float hs, int lane) {
    unsigned long long m0 = __ballot((e0 >> 11) == s), m1 = __ballot((e1 >> 11) == s);
    const int dummy = s * 2048;
    while (m0 | m1) {
        int ea, eb, ec, ed, ja, jb, jc, jd;
#define GX_NEXT(E, J) do { if (m0) { const int j = __builtin_ctzll(m0); m0 &= m0 - 1; J = j; E = __builtin_amdgcn_readlane(e0, j); } \
            else if (m1) { const int j = __builtin_ctzll(m1); m1 &= m1 - 1; J = 64 + j; E = __builtin_amdgcn_readlane(e1, j); } else { J = -1; E = dummy; } } while (0)
        GX_NEXT(ea, ja); GX_NEXT(eb, jb); GX_NEXT(ec, jc); GX_NEXT(ed, jd);
#undef GX_NEXT
        const int4 ra4 = *(const int4*)(UQ + (size_t)ea * 1024 + lane * 16), rb4 = *(const int4*)(UQ + (size_t)eb * 1024 + lane * 16);
        const int4 rc4 = *(const int4*)(UQ + (size_t)ec * 1024 + lane * 16), rd4 = *(const int4*)(UQ + (size_t)ed * 1024 + lane * 16);
        int v0 = sdot16(ra4, hq), v1 = sdot16(rb4, hq), v2 = sdot16(rc4, hq), v3 = sdot16(rd4, hq);
        { auto ra = __builtin_amdgcn_permlane32_swap((unsigned)v0, (unsigned)v2, false, false); auto rb = __builtin_amdgcn_permlane32_swap((unsigned)v1, (unsigned)v3, false, false);
          v0 = (int)ra[0] + (int)ra[1]; v1 = (int)rb[0] + (int)rb[1]; }
        { const bool up = (lane & 16) != 0; const int send = up ? v0 : v1, keep = up ? v1 : v0; v0 = keep + __shfl_xor(send, 16); }
        v0 += __shfl_xor(v0, 8); v0 += __shfl_xor(v0, 4); v0 += __shfl_xor(v0, 2); v0 += __shfl_xor(v0, 1);
        const int g = lane >> 4;
        const int je = g == 0 ? ja : g == 1 ? jb : g == 2 ? jc : jd;
        const int eg = g == 0 ? ea : g == 1 ? eb : g == 2 ? ec : ed;
        if ((lane & 15) == 0 && je >= 0) Arow[je] = (float)v0 * SU[eg] * hs;
    }
}

__device__ __forceinline__ float gelu_t(float x) { const float u = 0.7978845608028654f * (x + 0.044715f * x * x * x); return 0.5f * x * (1.f + tanhf(u)); }
#define GX_ACC4(W, Y0, Y1, Y2, Y3) do { Y0 += w * (float)((W) & 255u); Y1 += w * (float)(((W) >> 8) & 255u); Y2 += w * (float)(((W) >> 16) & 255u); Y3 += w * (float)((W) >> 24); } while (0)
__device__ __forceinline__ void v_token(const unsigned char* VQ, LAS const float* wl, LAS const int* el, int s, const float* gate2, const float* x1row, float* outrow, int lane) {
    const int grp = lane >> 3, sub = lane & 7;
    float y[16];
#pragma unroll
    for (int k = 0; k < 16; ++k) y[k] = 0.f;
    float cs = 0.f;
    uint4 rows[16];
#pragma unroll
    for (int i = 0; i < 16; ++i) { const int e = el[8 * i + grp]; rows[i] = *(const uint4*)(VQ + (size_t)e * 1024 + 128 * s + 16 * sub); }
#pragma unroll
    for (int i = 0; i < 16; ++i) { const float w = wl[8 * i + grp]; cs += w;
        GX_ACC4(rows[i].x, y[0], y[1], y[2], y[3]); GX_ACC4(rows[i].y, y[4], y[5], y[6], y[7]); GX_ACC4(rows[i].z, y[8], y[9], y[10], y[11]); GX_ACC4(rows[i].w, y[12], y[13], y[14], y[15]); }
    const bool b5 = (lane & 32) != 0, b4 = (lane & 16) != 0, b3 = (lane & 8) != 0;
    float z[8], q[4], r[2];
#pragma unroll
    for (int k = 0; k < 8; ++k) { const float send = b5 ? y[k] : y[8 + k], keep = b5 ? y[8 + k] : y[k]; z[k] = keep + __shfl_xor(send, 32); }
#pragma unroll
    for (int k = 0; k < 4; ++k) { const float send = b4 ? z[k] : z[4 + k], keep = b4 ? z[4 + k] : z[k]; q[k] = keep + __shfl_xor(send, 16); }
#pragma unroll
    for (int k = 0; k < 2; ++k) { const float send = b3 ? q[k] : q[2 + k], keep = b3 ? q[2 + k] : q[k]; r[k] = keep + __shfl_xor(send, 8); }
    cs += __shfl_xor(cs, 8); cs += __shfl_xor(cs, 16); cs += __shfl_xor(cs, 32);
    const int col = 128 * s + 16 * sub + (b5 ? 8 : 0) + (b4 ? 4 : 0) + (b3 ? 2 : 0);
    float2* op = (float2*)(outrow + col); const float2 g2 = *(const float2*)(gate2 + col); float2 x1 = *(const float2*)(x1row + col);
    x1.x += g2.x * (r[0] - 128.f * cs); x1.y += g2.y * (r[1] - 128.f * cs); *op = x1;
}
#undef GX_ACC4
}

constexpr size_t WS_SU = 2 * MiB, WS_SV = 2 * MiB + 65536, WS_HS = 2 * MiB + 131072;
constexpr size_t WS_UQ = 24 * MiB, WS_VQ = 40 * MiB, WS_H2Q = 56 * MiB;
constexpr size_t WS_A = WS_KA;
struct Args { const void* in[22]; float* out; unsigned char* ws; int ph_lo, ph_hi, li, pad; };

struct Frame {
    LAS unsigned char* lds;
    int tid, lane, wave, G, gw, NGW;
};

namespace pg8 {
struct EpiProj {
    static constexpr bool PERM = true, AFTER_DRAIN = false;
    bf16_t* P; float* FL;
    __device__ __forceinline__ void operator()(const f32x4 (&acc)[2][2][4][2], const Unit& u, int wr, int wc, int fr, int fq) const {
        const int row0 = u.pm * BM + wr * 64 + fr, col0 = u.pn * BM + wc * 32 + 8 * fq;
#pragma unroll
        for (int ai = 0; ai < 2; ++ai)
#pragma unroll
            for (int m = 0; m < 4; ++m) { const int row = row0 + ai * HALF + m * 16; bf16_t* rowp = P + (size_t)row * PP + col0;
#pragma unroll
                for (int bj = 0; bj < 2; ++bj) { const f32x4 v0 = acc[ai][bj][m][0], v1 = acc[ai][bj][m][1];
                    if (col0 + bj * HALF == C_FL) { float* f = FL + (size_t)row * 8; *(f32x4*)f = v0; *(f32x4*)(f + 4) = v1; }
                    u32x4 w; w.x = cvt_pk_bf16(v0[0], v0[1]); w.y = cvt_pk_bf16(v0[2], v0[3]); w.z = cvt_pk_bf16(v1[0], v1[1]); w.w = cvt_pk_bf16(v1[2], v1[3]);
                    *(u32x4*)(rowp + bj * HALF) = w; } }
    }
};
struct EpiStore {
    static constexpr bool PERM = true, AFTER_DRAIN = false;
    bf16_t* O; int ldc;
    __device__ __forceinline__ void operator()(const f32x4 (&acc)[2][2][4][2], const Unit& u, int wr, int wc, int fr, int fq) const {
        const int row0 = u.pm * BM + wr * 64 + fr, col0 = u.pn * BM + wc * 32 + 8 * fq;
#pragma unroll
        for (int ai = 0; ai < 2; ++ai)
#pragma unroll
            for (int m = 0; m < 4; ++m) { bf16_t* rowp = O + (size_t)(row0 + ai * HALF + m * 16) * ldc + col0;
#pragma unroll
                for (int bj = 0; bj < 2; ++bj) { const f32x4 v0 = acc[ai][bj][m][0], v1 = acc[ai][bj][m][1];
                    u32x4 w; w.x = cvt_pk_bf16(v0[0], v0[1]); w.y = cvt_pk_bf16(v0[2], v0[3]); w.z = cvt_pk_bf16(v1[0], v1[1]); w.w = cvt_pk_bf16(v1[2], v1[3]);
                    *(u32x4*)(rowp + bj * HALF) = w; } }
    }
};
struct EpiResid {
    static constexpr bool PERM = false, AFTER_DRAIN = false;
    const float* X; const float* MOD; float* out;
    __device__ __forceinline__ void operator()(const f32x4 (&acc)[2][2][4][2], const Unit& u, int wr, int wc, int fr, int fq) const {
        const int row0 = u.pm * BM + wr * 64 + fr, col0 = u.pn * BM + wc * 32 + 4 * fq;
        const int b = (u.pm * BM) / S_;
        f32x4 gv[2][2];
#pragma unroll
        for (int bj = 0; bj < 2; ++bj)
#pragma unroll
            for (int n = 0; n < 2; ++n) gv[bj][n] = *(const f32x4*)(MOD + b * 6144 + 2 * 1024 + col0 + bj * HALF + n * 16);
#pragma unroll
        for (int ai = 0; ai < 2; ++ai)
#pragma unroll
            for (int m = 0; m < 4; ++m) { const size_t off = (size_t)(row0 + ai * HALF + m * 16) * 1024 + col0;
#pragma unroll
                for (int bj = 0; bj < 2; ++bj)
#pragma unroll
                    for (int n = 0; n < 2; ++n) { const f32x4 xv = *(const f32x4*)(X + off + bj * HALF + n * 16); *(f32x4*)(out + off + bj * HALF + n * 16) = xv + gv[bj][n] * acc[ai][bj][m][n]; } }
    }
};
}

__device__ __forceinline__ void p0_transpose_item(const float* W, int K, int N, int Npad, bf16_t* WT, LAS float* scr, int item, int lane) {
    const int nblk = Npad / 32, kb = item / nblk, nb = item % nblk, k0 = 64 * kb, n0 = 32 * nb;
    const int nn = n0 + (lane & 31);
#pragma unroll 8
    for (int i = 0; i < 32; ++i) { const int kk = 2 * i + (lane >> 5); scr[kk * 33 + (lane & 31)] = nn < N ? W[(size_t)(k0 + kk) * N + nn] : 0.f; }
    asm volatile("s_waitcnt lgkmcnt(0)" ::: "memory");
    const int c = lane & 7;
#pragma unroll
    for (int j = 0; j < 4; ++j) { const int n = (lane >> 3) + 8 * j; const LAS float* s = scr + (8 * c) * 33 + n;
        u32x4 o; o.x = pk2(s[0 * 33], s[1 * 33]); o.y = pk2(s[2 * 33], s[3 * 33]); o.z = pk2(s[4 * 33], s[5 * 33]); o.w = pk2(s[6 * 33], s[7 * 33]);
        *(u32x4*)(WT + (size_t)(n0 + n) * K + k0 + 8 * c) = o; }
    asm volatile("s_waitcnt lgkmcnt(0)" ::: "memory");
}
__device__ __forceinline__ void p0_mod_item(const float* c, const float* w_ada, const float* b_ada, float* mod, LAS float* scr, int item, int lane) {
    for (int i = lane; i < 4096; i += 64) { const int b = i >> 10, k = i & 1023; const float cv = c[i]; scr[k * 4 + b] = cv / (1.f + expf(-cv)); }
    asm volatile("s_waitcnt lgkmcnt(0)" ::: "memory");
    const int j = item * 64 + lane;
    float a0 = 0.f, a1 = 0.f, a2 = 0.f, a3 = 0.f;
#pragma unroll 8
    for (int k = 0; k < 1024; ++k) { const float w = w_ada[(size_t)k * 6144 + j]; const f32x4 s = *(const LAS f32x4*)(scr + k * 4); a0 += s[0] * w; a1 += s[1] * w; a2 += s[2] * w; a3 += s[3] * w; }
    const float bb = b_ada[j];
    mod[0 * 6144 + j] = a0 + bb; mod[1 * 6144 + j] = a1 + bb; mod[2 * 6144 + j] = a2 + bb; mod[3 * 6144 + j] = a3 + bb;
    asm volatile("s_waitcnt lgkmcnt(0)" ::: "memory");
}

__device__ __forceinline__ void modrow(const float* X, const float* g, const float* mod, int shift_idx, int scale_idx, bf16_t* out, int row, int lane) {
    const int b = row / S_;
    const float4* xr = (const float4*)(X + (size_t)row * 1024) + lane;
    float4 v[4]; float ss = 0.f;
#pragma unroll
    for (int j = 0; j < 4; ++j) { v[j] = xr[64 * j]; ss += (v[j].x * v[j].x + v[j].y * v[j].y) + (v[j].z * v[j].z + v[j].w * v[j].w); }
    ss = wave_sum(ss);
    const float r = rsqrtf(ss * (1.f / 1024.f) + EPS);
    const float* sh = mod + b * 6144 + shift_idx * 1024; const float* sc = mod + b * 6144 + scale_idx * 1024;
#pragma unroll
    for (int j = 0; j < 4; ++j) {
        const int col = 4 * lane + 256 * j;
        const float4 g4 = *(const float4*)(g + col), s4 = *(const float4*)(sc + col), h4 = *(const float4*)(sh + col);
        const float o0 = v[j].x * r * g4.x * (1.f + s4.x) + h4.x, o1 = v[j].y * r * g4.y * (1.f + s4.y) + h4.y;
        const float o2 = v[j].z * r * g4.z * (1.f + s4.z) + h4.z, o3 = v[j].w * r * g4.w * (1.f + s4.w) + h4.w;
        uint2 w; w.x = pk2(o0, o1); w.y = pk2(o2, o3);
        *(uint2*)(out + (size_t)row * 1024 + col) = w;
    }
}

__device__ __forceinline__ void modrow_q(const float* X, const float* g, const float* mod, int shift_idx, int scale_idx, bf16_t* out, unsigned char* outq, float* hs, int row, int lane) {
    const int b = row / S_;
    const float4* xr = (const float4*)(X + (size_t)row * 1024) + lane;
    float4 v[4]; float ss = 0.f;
#pragma unroll
    for (int j = 0; j < 4; ++j) { v[j] = xr[64 * j]; ss += (v[j].x * v[j].x + v[j].y * v[j].y) + (v[j].z * v[j].z + v[j].w * v[j].w); }
    ss = wave_sum(ss);
    const float r = rsqrtf(ss * (1.f / 1024.f) + EPS);
    const float* sh = mod + b * 6144 + shift_idx * 1024; const float* sc = mod + b * 6144 + scale_idx * 1024;
    float am = 0.f;
#pragma unroll
    for (int j = 0; j < 4; ++j) {
        const int col = 4 * lane + 256 * j;
        const float4 g4 = *(const float4*)(g + col), s4 = *(const float4*)(sc + col), h4 = *(const float4*)(sh + col);
        v[j].x = v[j].x * r * g4.x * (1.f + s4.x) + h4.x; v[j].y = v[j].y * r * g4.y * (1.f + s4.y) + h4.y;
        v[j].z = v[j].z * r * g4.z * (1.f + s4.z) + h4.z; v[j].w = v[j].w * r * g4.w * (1.f + s4.w) + h4.w;
        uint2 w; w.x = pk2(v[j].x, v[j].y); w.y = pk2(v[j].z, v[j].w);
        *(uint2*)(out + (size_t)row * 1024 + col) = w;
        am = fmaxf(am, fmaxf(fmaxf(fabsf(v[j].x), fabsf(v[j].y)), fmaxf(fabsf(v[j].z), fabsf(v[j].w))));
    }
#pragma unroll
    for (int o = 1; o < 64; o <<= 1) am = fmaxf(am, __shfl_xor(am, o));
    const float inv = am > 0.f ? 127.f / am : 0.f;
#pragma unroll
    for (int j = 0; j < 4; ++j) { const int q0 = (int)rintf(v[j].x * inv), q1 = (int)rintf(v[j].y * inv), q2 = (int)rintf(v[j].z * inv), q3 = (int)rintf(v[j].w * inv);
        *(unsigned*)(outq + (size_t)row * 1024 + 4 * lane + 256 * j) = (unsigned)(q0 & 255) | ((unsigned)(q1 & 255) << 8) | ((unsigned)(q2 & 255) << 16) | ((unsigned)(q3 & 255) << 24); }
    if (lane == 0) hs[row] = am * (1.f / 127.f);
}

__global__ void __launch_bounds__(NWAVES * 64, 2) mega_fwd(Args args) {
    extern __shared__ __attribute__((aligned(16))) unsigned char lds[];
    Frame F;
    F.lds = (LAS unsigned char*)lds;
    volatile LAS unsigned* MISC = (volatile LAS unsigned*)(F.lds + MISC_OFF);
    F.tid = threadIdx.x; F.lane = F.tid & 63; F.wave = __builtin_amdgcn_readfirstlane(F.tid >> 6);
    F.G = gridDim.x; F.gw = blockIdx.x * NWAVES + F.wave; F.NGW = F.G * NWAVES;
    unsigned char* ws = args.ws;
    unsigned* ctl = (unsigned*)(ws + WS_CTL);
    const float* x = (const float*)args.in[0]; const float* c = (const float*)args.in[1]; const int* positions = (const int*)args.in[2];
    const float* w_ada = (const float*)args.in[3]; const float* b_ada = (const float*)args.in[4]; const float* norm1_g = (const float*)args.in[5];
    const float* w_in = (const float*)args.in[6]; const float* mla_qa_g = (const float*)args.in[7]; const float* mla_kva_g = (const float*)args.in[8];
    const float* w_uq = (const float*)args.in[9]; const float* w_ukv = (const float*)args.in[10]; const float* mla_q_g = (const float*)args.in[11];
    const float* mla_k_g = (const float*)args.in[12]; const float* fox_q_g = (const float*)args.in[13]; const float* fox_k_g = (const float*)args.in[14];
    const float* b_f = (const float*)args.in[15]; const float* w_o = (const float*)args.in[16]; const float* norm2_g = (const float*)args.in[17];
    const float* w_pq = (const float*)args.in[18]; const float* sub_keys = (const float*)args.in[19]; const float* peer_u = (const float*)args.in[20]; const float* peer_v = (const float*)args.in[21];
    float* out = args.out;
    float* MOD = (float*)(ws + WS_MOD); float* FL = (float*)(ws + WS_FL); float* FCUM = (float*)(ws + WS_FCUM); float* LOGF = (float*)(ws + WS_LOGF); float2* ROPE = (float2*)(ws + WS_ROPE);
    bf16_t* XN = (bf16_t*)(ws + WS_XN); bf16_t* PROJ = (bf16_t*)(ws + WS_PROJ); bf16_t* KVRAW = (bf16_t*)(ws + WS_KVRAW); bf16_t* QA = (bf16_t*)(ws + WS_QA); bf16_t* KA = (bf16_t*)(ws + WS_KA);
    bf16_t* WIN = (bf16_t*)(ws + WS_WIN); bf16_t* WUQ = (bf16_t*)(ws + WS_WUQ); bf16_t* WUKV = (bf16_t*)(ws + WS_WUKV); bf16_t* WO = (bf16_t*)(ws + WS_WO); bf16_t* WPQ = (bf16_t*)(ws + WS_WPQ); bf16_t* SKB = (bf16_t*)(ws + WS_SK);
    unsigned char* UQ = ws + WS_UQ; unsigned char* VQ = ws + WS_VQ; unsigned char* H2Q = ws + WS_H2Q; float* SU = (float*)(ws + WS_SU); float* SV = (float*)(ws + WS_SV); float* HS = (float*)(ws + WS_HS); float* AP = (float*)(ws + WS_A);
    bf16_t* OB = XN; bf16_t* H2 = XN; bf16_t* QP = PROJ; int* EID = (int*)(ws + WS_QA); float* GATE = (float*)(ws + WS_QA + 16 * MiB);
    (void)sub_keys; (void)peer_u; (void)peer_v; (void)positions; (void)KA; (void)FCUM; (void)LOGF; (void)ROPE; (void)mla_q_g; (void)mla_k_g; (void)b_f; (void)fox_q_g; (void)fox_k_g; (void)mla_qa_g; (void)mla_kva_g;

    for (int u = F.tid; u < (LDS_BYTES - LDSCTL_OFF) / 4; u += NWAVES * 64) ((LAS unsigned*)(F.lds + LDSCTL_OFF))[u] = 0u;
    __syncthreads();
    const int lo = args.ph_lo, hi = args.ph_hi;
    XcdBarrier bar; bar.bar = ctl + CW_BAR + args.li * XCD_BAR_WORDS; bar.x = 0; bar.st = nullptr;
    if (hi - lo > 1) bar = xcd_barrier_post(ctl + CW_BAR + args.li * XCD_BAR_WORDS, MISC + 8);
#define IN(k) (lo <= (k) && (k) < hi)
#define SEAM(k) do { if (IN(k) && IN((k) + 1)) xcd_barrier(bar); } while (0)

    if (IN(0)) REP(0) {
        LAS float* scr = (LAS float*)(F.lds + F.wave * 16384);
        constexpr int I_MOD = 96, I_IN = 16 * 72, I_UQ = 6 * 24, I_UKV = 4 * 32, I_O = 16 * 32, I_PQ = 16 * 64;
        constexpr int I_SK = 512;
        constexpr int NITEMS = I_MOD + I_IN + I_UQ + I_UKV + I_O + I_PQ + I_SK + 2 * 16384;
        for (int it = F.gw; it < NITEMS; it += F.NGW) {
            int r = it;
            if (r < I_MOD) { p0_mod_item(c, w_ada, b_ada, MOD, scr, r, F.lane); continue; } r -= I_MOD;
            if (r < I_IN) { p0_transpose_item(w_in, 1024, INW, PP, WIN, scr, r, F.lane); continue; } r -= I_IN;
            if (r < I_UQ) { p0_transpose_item(w_uq, 384, 768, 768, WUQ, scr, r, F.lane); continue; } r -= I_UQ;
            if (r < I_UKV) { p0_transpose_item(w_ukv, 256, 1024, 1024, WUKV, scr, r, F.lane); continue; } r -= I_UKV;
            if (r < I_O) { p0_transpose_item(w_o, 1024, 1024, 1024, WO, scr, r, F.lane); continue; } r -= I_O;
            if (r < I_PQ) { p0_transpose_item(w_pq, 1024, 2048, 2048, WPQ, scr, r, F.lane); continue; } r -= I_PQ;
            if (r >= I_SK) { r -= I_SK; if (r < 16384) gx::quant_row(peer_u + (size_t)r * 1024, UQ + (size_t)r * 1024, SU + r, 0, F.lane); else { r -= 16384; gx::quant_row(peer_v + (size_t)r * 1024, VQ + (size_t)r * 1024, SV + r, 128, F.lane); } continue; }
            { const float4* src = (const float4*)(sub_keys + (size_t)r * 512) + F.lane * 2; const float4 a = src[0], b2 = src[1];
              u32x4 o; o.x = pk2(a.x, a.y); o.y = pk2(a.z, a.w); o.z = pk2(b2.x, b2.y); o.w = pk2(b2.z, b2.w); *(u32x4*)(SKB + (size_t)r * 512 + F.lane * 8) = o; }
        }
    }
    SEAM(0);
    if (IN(1)) { for (int row = F.gw; row < T_; row += F.NGW) modrow(x, norm1_g, MOD, 0, 1, XN, row, F.lane); }
    SEAM(1);
    if (IN(2)) REP(2) {
        pg8::Gemm g{XN, WIN, T_, PP, 1024, 1024}; pg8::StaticOrder S; S.init(T_, PP, F.G, (int)blockIdx.x);
        pg8::EpiProj E{PROJ, FL};
        pg8::gemm_phase<pg8::EpiProj, pg8::StaticOrder, true, true>(F.lds, g, S, E);
    }
    SEAM(2);
    if (IN(3)) { for (int row = F.gw; row < T_; row += F.NGW) rowprep_row(PROJ, FL, mla_qa_g, mla_kva_g, fox_q_g, fox_k_g, b_f, positions, LOGF, ROPE, row, F.lane); }
    SEAM(3);
    if (IN(4)) REP(4) {
        { pg8::Gemm g{PROJ + C_CQ, WUQ, T_, 768, 384, PP}; pg8::StaticOrder S; S.init(T_, 768, F.G, (int)blockIdx.x); pg8::EpiStore E{QA, 768};
          pg8::gemm_phase<pg8::EpiStore, pg8::StaticOrder, true, true>(F.lds, g, S, E); }
        { pg8::Gemm g{PROJ + C_CKV, WUKV, T_, 1024, 256, PP}; pg8::StaticOrder S; S.init(T_, 1024, F.G, (int)blockIdx.x); pg8::EpiStore E{KVRAW, 1024};
          pg8::gemm_phase<pg8::EpiStore, pg8::StaticOrder, true, true>(F.lds, g, S, E); }
    }
    SEAM(4);
    if (IN(5)) {
        if (F.gw < 32) fcum_item(LOGF, FCUM, F.gw, F.lane);
        for (int row = F.gw; row < T_; row += F.NGW) mlaprep_row(QA, KVRAW, PROJ, KA, ROPE, mla_q_g, mla_k_g, row, F.lane);
    }
    SEAM(5);
    if (IN(6)) {
        volatile LAS unsigned* qslot = MISC + 16;
        float thr;
        { float gq = fabsf(fox_q_g[F.lane]), gk = fabsf(fox_k_g[F.lane]);
#pragma unroll
          for (int o = 1; o < 64; o <<= 1) { gq = fmaxf(gq, __shfl_xor(gq, o)); gk = fmaxf(gk, __shfl_xor(gk, o)); }
          thr = 104.5f + 2.f * 1.02f * 8.f * gq * gk; }
        unsigned* qctr = ctl + 64;
        if (F.tid == 0) qslot[0] = atomicAdd(qctr, 1u);
        __syncthreads();
        unsigned u = qslot[0];
        while (u < 2048u) {
            unsigned unext = 0u;
            if (F.tid == 0) unext = atomicAdd(qctr, 1u);
            const int grp = (int)(u >> 10), bh = (int)(u & 31u), qb = 31 - (int)((u >> 5) & 31u), b = bh >> 3, h = bh & 7;
            if (grp == 0) { const att::Desc d{QA + (size_t)b * S_ * 768 + h * 96, 768, KA + (size_t)b * S_ * 768 + h * 96, 768, KVRAW + (size_t)b * S_ * 1024 + h * 128 + 64, 1024, OB + (size_t)b * S_ * 1024 + h * 64, 1024, nullptr};
                att::attn_unit<6, false>(d, qb, 0, F.lds); }
            else { const bf16_t* pb = PROJ + (size_t)b * S_ * PP + h * 64; const float* fc = FCUM + (size_t)(b * 8 + h) * S_;
                const att::Desc d{pb + C_FQ, PP, pb + C_FK, PP, pb + C_FV, PP, OB + (size_t)b * S_ * 1024 + 512 + h * 64, 1024, fc};
                const int NT = 4 * (qb + 1); const float lim = fc[qb * 256] + thr;
                int j0 = 0;
                { const int ja = F.lane, jb2 = 64 + F.lane;
                  const bool ka = ja < NT ? (fc[64 * ja + 63] <= lim) : true, kb = jb2 < NT ? (fc[64 * jb2 + 63] <= lim) : true;
                  const unsigned long long ma = __ballot(ka), mb = __ballot(kb);
                  j0 = ma ? __builtin_ctzll(ma) : (mb ? 64 + __builtin_ctzll(mb) : NT - 4); }
                if (j0 > NT - 4) j0 = NT - 4;
                att::attn_unit<4, true>(d, qb, j0, F.lds); }
            if (F.tid == 0) qslot[0] = unext;
            __syncthreads();
            u = qslot[0];
            __syncthreads();
        }
    }
    SEAM(6);
    if (IN(7)) REP(7) {
        pg8::Gemm g{OB, WO, T_, 1024, 1024, 1024}; pg8::StaticOrder S; S.init(T_, 1024, F.G, (int)blockIdx.x);
        pg8::EpiResid E{x, MOD, out};
        pg8::gemm_phase<pg8::EpiResid, pg8::StaticOrder, true, true>(F.lds, g, S, E);
    }
    SEAM(7);
    if (IN(8)) { for (int row = F.gw; row < T_; row += F.NGW) modrow_q(out, norm2_g, MOD, 3, 4, H2, H2Q, HS, row, F.lane); }
    SEAM(8);
    if (IN(9)) REP(9) {
        pg8::Gemm g{H2, WPQ, T_, 2048, 1024, 1024}; pg8::StaticOrder S; S.init(T_, 2048, F.G, (int)blockIdx.x); pg8::EpiStore E{QP, 2048};
        pg8::gemm_phase<pg8::EpiStore, pg8::StaticOrder, true, true>(F.lds, g, S, E);
    }
    SEAM(9);
    if (IN(10)) REP(10) { for (int w = F.gw; w < (T_ / 32) * 8; w += F.NGW) pk::topk_item(QP, SKB, EID, GATE, w, F.lane); }
    SEAM(10);
    {
        const int ng = F.G < 8 ? F.G : 8; const int vx = (int)blockIdx.x % ng, rank = (int)blockIdx.x / ng, nrank = (F.G - vx + ng - 1) / ng;
        const int gwv = rank * NWAVES + F.wave, ngwv = nrank * NWAVES;
        if (IN(11)) REP(11) {
            for (int s = vx; s < 8; s += ng) {
                int t = gwv; int e0 = 0, e1 = 0; int4 hq = make_int4(0, 0, 0, 0); float hs = 0.f;
                if (t < T_) { e0 = EID[(size_t)t * 128 + F.lane]; e1 = EID[(size_t)t * 128 + 64 + F.lane]; hq = *(const int4*)(H2Q + (size_t)t * 1024 + F.lane * 16); hs = HS[t]; }
                while (t < T_) {
                    const int tn = t + ngwv; int e0n = 0, e1n = 0; int4 hqn = make_int4(0, 0, 0, 0); float hsn = 0.f;
                    if (tn < T_) { e0n = EID[(size_t)tn * 128 + F.lane]; e1n = EID[(size_t)tn * 128 + 64 + F.lane]; hqn = *(const int4*)(H2Q + (size_t)tn * 1024 + F.lane * 16); hsn = HS[tn]; }
                    gx::u_token(UQ, SU, AP + (size_t)t * 128, s, e0, e1, hq, hs, F.lane);
                    t = tn; e0 = e0n; e1 = e1n; hq = hqn; hs = hsn;
                }
            }
        }
        SEAM(11);
        if (IN(12)) REP(12) {
            LAS float* wl = (LAS float*)(F.lds + F.wave * 1024); LAS int* el = (LAS int*)(F.lds + F.wave * 1024 + 512);
            for (int s = vx; s < 8; s += ng)
                for (int t = gwv; t < T_; t += ngwv) {
                    const int e0 = EID[(size_t)t * 128 + F.lane], e1 = EID[(size_t)t * 128 + 64 + F.lane];
                    const float a0 = AP[(size_t)t * 128 + F.lane], a1 = AP[(size_t)t * 128 + 64 + F.lane], g0 = GATE[(size_t)t * 128 + F.lane], g1 = GATE[(size_t)t * 128 + 64 + F.lane];
                    wl[F.lane] = g0 * gx::gelu_t(a0) * SV[e0]; wl[64 + F.lane] = g1 * gx::gelu_t(a1) * SV[e1]; el[F.lane] = e0; el[64 + F.lane] = e1;
                    float* dstrow = (PROBE_DUP == 12 && _r == 0) ? (float*)(ws + WS_PROJ) + (size_t)t * 1024 : out + (size_t)t * 1024;
                    gx::v_token(VQ, wl, el, s, MOD + (t / S_) * 6144 + 5 * 1024, out + (size_t)t * 1024, dstrow, F.lane);
                }
        }
    }
#undef IN
#undef SEAM
}

static int g_grid = 0;
static void launch_mega(const Args& base, int lo, int hi, int li, hipStream_t stream) {
    Args a = base; a.ph_lo = lo; a.ph_hi = hi; a.li = li;
    hipLaunchKernelGGL(mega_fwd, dim3(g_grid), dim3(NWAVES * 64), LDS_BYTES, stream, a);
}

extern "C" void kernel_launch(void* const* d_in, const int* in_sizes, int n_in, void* d_out, int out_size, void* d_ws, size_t ws_size, hipStream_t stream) {
    if (g_grid == 0) {
        int dev = 0, cus = 0;
        hipGetDevice(&dev); hipDeviceGetAttribute(&cus, hipDeviceAttributeMultiprocessorCount, dev);
        hipFuncSetAttribute((const void*)mega_fwd, hipFuncAttributeMaxDynamicSharedMemorySize, LDS_BYTES);
        int per_cu = 0; hipOccupancyMaxActiveBlocksPerMultiprocessor(&per_cu, (const void*)mega_fwd, NWAVES * 64, LDS_BYTES);
        (void)hipGetLastError();
        g_grid = cus > 0 ? cus : 256;
        if (per_cu < 1) fprintf(stderr, "kernel_launch: occupancy query says %d blocks/CU\n", per_cu);
    }
    const float* x = (const float*)d_in[0]; const int* positions = (const int*)d_in[2];
    const float* mla_qa_g = (const float*)d_in[7]; const float* mla_kva_g = (const float*)d_in[8];
    const float* mla_q_g = (const float*)d_in[11]; const float* mla_k_g = (const float*)d_in[12]; const float* fox_q_g = (const float*)d_in[13]; const float* fox_k_g = (const float*)d_in[14];
    const float* b_f = (const float*)d_in[15]; const float* sub_keys = (const float*)d_in[19]; const float* peer_u = (const float*)d_in[20]; const float* peer_v = (const float*)d_in[21];
    float* out = (float*)d_out; unsigned char* ws = (unsigned char*)d_ws;
    float* MOD = (float*)(ws + WS_MOD); float* FL = (float*)(ws + WS_FL); float* FCUM = (float*)(ws + WS_FCUM); float* LOGF = (float*)(ws + WS_LOGF); float2* ROPE = (float2*)(ws + WS_ROPE);
    bf16_t* XN = (bf16_t*)(ws + WS_XN); bf16_t* PROJ = (bf16_t*)(ws + WS_PROJ); bf16_t* KVRAW = (bf16_t*)(ws + WS_KVRAW); bf16_t* QA = (bf16_t*)(ws + WS_QA); bf16_t* KA = (bf16_t*)(ws + WS_KA);
    bf16_t* OB = XN; bf16_t* H2 = XN; bf16_t* QP = PROJ; int* EID = (int*)(ws + WS_QA); float* GATE = (float*)(ws + WS_QA + 16 * MiB);
    (void)x;
    hipMemsetAsync(ws + WS_CTL, 0, CTL_ZERO_BYTES, stream);
    Args base{}; for (int i = 0; i < 22; ++i) base.in[i] = d_in[i]; base.out = out; base.ws = ws;

    launch_mega(base, 0, 13, 0, stream);
}
```

```cpp
#include <hip/hip_runtime.h>
#ifndef PROBE_DUP
#define PROBE_DUP -1
#endif
#define REP(k) for (int _r = 0; _r < ((PROBE_DUP == (k)) ? 2 : 1); ++_r)
#include <cstdint>
#include <cstdio>
#include <cmath>

typedef unsigned short bf16_t;
constexpr int B_ = 4, S_ = 8192, D_ = 1024, T_ = B_ * S_;
constexpr int PP = 2304;
constexpr int C_CQ = 0, C_CKV = 384, C_KPE = 640, C_FQ = 672, C_FK = 1184, C_FV = 1696, C_FL = 2208, INW = 2216;
constexpr float EPS = 1e-6f;
constexpr float LOG2E = 1.4426950408889634f;
constexpr float C2A = 0.10206207261596577f * LOG2E;
constexpr float C2F = 0.125f * LOG2E;

__device__ __forceinline__ float bf2f(bf16_t v) { return __uint_as_float(((unsigned)v) << 16); }
__device__ __forceinline__ bf16_t f2bf(float f) { unsigned u = __float_as_uint(f); return (bf16_t)((u + 0x7fffu + ((u >> 16) & 1u)) >> 16); }
__device__ __forceinline__ unsigned pk2(float lo, float hi) { return (unsigned)f2bf(lo) | ((unsigned)f2bf(hi) << 16); }
__device__ __forceinline__ float lo2f(unsigned w) { return __uint_as_float(w << 16); }
__device__ __forceinline__ float hi2f(unsigned w) { return __uint_as_float(w & 0xffff0000u); }
__device__ __forceinline__ float wave_sum(float v) {
#pragma unroll
    for (int o = 1; o < 64; o <<= 1) v += __shfl_xor(v, o);
    return v;
}

constexpr size_t MiB = 1u << 20;
constexpr size_t WS_MOD = 1 * MiB;
constexpr size_t WS_FL = 3 * MiB;
constexpr size_t WS_FCUM = 4 * MiB;
constexpr size_t WS_LOGF = 5 * MiB;
constexpr size_t WS_ROPE = 6 * MiB;
constexpr size_t WS_XN = 88 * MiB;
constexpr size_t WS_PROJ = 152 * MiB;
constexpr size_t WS_KVRAW = 296 * MiB;
constexpr size_t WS_QA = 360 * MiB;
constexpr size_t WS_KA = 408 * MiB;

__global__ void k_mod(const float* c, const float* w_ada, const float* b_ada, float* mod) {
    const int j = blockIdx.x * 256 + threadIdx.x, b = blockIdx.y;
    float acc = b_ada[j];
    for (int k = 0; k < 1024; ++k) { const float cv = c[b * 1024 + k]; const float s = cv / (1.f + expf(-cv)); acc += s * w_ada[(size_t)k * 6144 + j]; }
    mod[b * 6144 + j] = acc;
}

__global__ void __launch_bounds__(256) k_modrows(const float* X, const float* g, const float* mod, int shift_idx, int scale_idx, bf16_t* out) {
    const int wave = threadIdx.x >> 6, lane = threadIdx.x & 63;
    const int row = blockIdx.x * 4 + wave, b = row / S_;
    const float4* xr = (const float4*)(X + (size_t)row * 1024) + lane;
    float4 v[4]; float ss = 0.f;
#pragma unroll
    for (int j = 0; j < 4; ++j) { v[j] = xr[64 * j]; ss += (v[j].x * v[j].x + v[j].y * v[j].y) + (v[j].z * v[j].z + v[j].w * v[j].w); }
    ss = wave_sum(ss);
    const float r = rsqrtf(ss * (1.f / 1024.f) + EPS);
    const float* sh = mod + b * 6144 + shift_idx * 1024; const float* sc = mod + b * 6144 + scale_idx * 1024;
#pragma unroll
    for (int j = 0; j < 4; ++j) {
        const int col = 4 * lane + 256 * j;
        const float4 g4 = *(const float4*)(g + col), s4 = *(const float4*)(sc + col), h4 = *(const float4*)(sh + col);
        const float o0 = v[j].x * r * g4.x * (1.f + s4.x) + h4.x, o1 = v[j].y * r * g4.y * (1.f + s4.y) + h4.y;
        const float o2 = v[j].z * r * g4.z * (1.f + s4.z) + h4.z, o3 = v[j].w * r * g4.w * (1.f + s4.w) + h4.w;
        uint2 w; w.x = pk2(o0, o1); w.y = pk2(o2, o3);
        *(uint2*)(out + (size_t)row * 1024 + col) = w;
    }
}

template <int MODE>
__global__ void __launch_bounds__(256) k_gemm_naive(const bf16_t* A, int lda, const float* W, int K, int N, void* Cout, int ldc, const float* aux1, const float* aux2, float* fl) {
    __shared__ float As[16][64];
    __shared__ float Ws[16][64];
    const int tx = threadIdx.x & 15, ty = threadIdx.x >> 4;
    const int m0 = blockIdx.y * 64, n0 = blockIdx.x * 64;
    float acc[4][4];
#pragma unroll
    for (int i = 0; i < 4; ++i)
#pragma unroll
        for (int j = 0; j < 4; ++j) acc[i][j] = 0.f;
    for (int k0 = 0; k0 < K; k0 += 16) {
        { const int r = threadIdx.x >> 2, kq = (threadIdx.x & 3) * 4; const uint2 a2 = *(const uint2*)(A + (size_t)(m0 + r) * lda + k0 + kq);
          As[kq + 0][r] = lo2f(a2.x); As[kq + 1][r] = hi2f(a2.x); As[kq + 2][r] = lo2f(a2.y); As[kq + 3][r] = hi2f(a2.y); }
        { const int kk = threadIdx.x >> 4, nq = (threadIdx.x & 15) * 4; float4 w4 = make_float4(0.f, 0.f, 0.f, 0.f);
          if (n0 + nq < N) w4 = *(const float4*)(W + (size_t)(k0 + kk) * N + n0 + nq);
          *(float4*)&Ws[kk][nq] = w4; }
        __syncthreads();
#pragma unroll
        for (int kk = 0; kk < 16; ++kk) {
            const float4 a4 = *(const float4*)&As[kk][ty * 4]; const float4 w4 = *(const float4*)&Ws[kk][tx * 4];
            const float a[4] = {a4.x, a4.y, a4.z, a4.w}; const float w[4] = {w4.x, w4.y, w4.z, w4.w};
#pragma unroll
            for (int i = 0; i < 4; ++i)
#pragma unroll
                for (int j = 0; j < 4; ++j) acc[i][j] += a[i] * w[j];
        }
        __syncthreads();
    }
#pragma unroll
    for (int i = 0; i < 4; ++i) {
        const int m = m0 + ty * 4 + i;
#pragma unroll
        for (int j = 0; j < 4; ++j) {
            const int n = n0 + tx * 4 + j;
            if (n < N) {
                if (MODE == 0) ((bf16_t*)Cout)[(size_t)m * ldc + n] = f2bf(acc[i][j]);
                else if (MODE == 1) { if (n < C_FL) ((bf16_t*)Cout)[(size_t)m * ldc + n] = f2bf(acc[i][j]); else fl[(size_t)m * 8 + (n - C_FL)] = acc[i][j]; }
                else { const int b = m / S_; ((float*)Cout)[(size_t)m * ldc + n] = aux1[(size_t)m * 1024 + n] + aux2[b * 6144 + 2 * 1024 + n] * acc[i][j]; }
            }
        }
    }
}

__device__ __forceinline__ void unpack8(const uint4 raw, float* v) {
    v[0] = lo2f(raw.x); v[1] = hi2f(raw.x); v[2] = lo2f(raw.y); v[3] = hi2f(raw.y); v[4] = lo2f(raw.z); v[5] = hi2f(raw.z); v[6] = lo2f(raw.w); v[7] = hi2f(raw.w);
}
__device__ __forceinline__ void rowprep_row(bf16_t* PROJ, const float* FL, const float* g_qa, const float* g_kva, const float* g_fq, const float* g_fk, const float* b_f,
                                                 const int* positions, float* LOGF, float2* ROPE, int row, int lane) {
    bf16_t* pr = PROJ + (size_t)row * PP;
    float v[8];
    {
        float ss = 0.f;
        if (lane < 48) { unpack8(*(const uint4*)(pr + C_CQ + lane * 8), v);
#pragma unroll
            for (int i = 0; i < 8; ++i) ss += v[i] * v[i]; }
        ss = wave_sum(ss);
        const float r = rsqrtf(ss * (1.f / 384.f) + EPS);
        if (lane < 48) { const float* g = g_qa + lane * 8; uint4 o;
            o.x = pk2(v[0] * r * g[0], v[1] * r * g[1]); o.y = pk2(v[2] * r * g[2], v[3] * r * g[3]); o.z = pk2(v[4] * r * g[4], v[5] * r * g[5]); o.w = pk2(v[6] * r * g[6], v[7] * r * g[7]);
            *(uint4*)(pr + C_CQ + lane * 8) = o; }
    }
    {
        float ss = 0.f;
        if (lane < 32) { unpack8(*(const uint4*)(pr + C_CKV + lane * 8), v);
#pragma unroll
            for (int i = 0; i < 8; ++i) ss += v[i] * v[i]; }
        ss = wave_sum(ss);
        const float r = rsqrtf(ss * (1.f / 256.f) + EPS);
        if (lane < 32) { const float* g = g_kva + lane * 8; uint4 o;
            o.x = pk2(v[0] * r * g[0], v[1] * r * g[1]); o.y = pk2(v[2] * r * g[2], v[3] * r * g[3]); o.z = pk2(v[4] * r * g[4], v[5] * r * g[5]); o.w = pk2(v[6] * r * g[6], v[7] * r * g[7]);
            *(uint4*)(pr + C_CKV + lane * 8) = o; }
    }
#pragma unroll
    for (int which = 0; which < 2; ++which) {
        const int coff = which == 0 ? C_FQ : C_FK; const float* g = (which == 0 ? g_fq : g_fk) + (lane & 7) * 8; const float sc = which == 0 ? C2F : 1.f;
        unpack8(*(const uint4*)(pr + coff + lane * 8), v);
        float ss = 0.f;
#pragma unroll
        for (int i = 0; i < 8; ++i) ss += v[i] * v[i];
        ss += __shfl_xor(ss, 1); ss += __shfl_xor(ss, 2); ss += __shfl_xor(ss, 4);
        const float r = rsqrtf(ss * (1.f / 64.f) + EPS) * sc; uint4 o;
        o.x = pk2(v[0] * r * g[0], v[1] * r * g[1]); o.y = pk2(v[2] * r * g[2], v[3] * r * g[3]); o.z = pk2(v[4] * r * g[4], v[5] * r * g[5]); o.w = pk2(v[6] * r * g[6], v[7] * r * g[7]);
        *(uint4*)(pr + coff + lane * 8) = o;
    }
    if (lane < 8) { const float z = FL[(size_t)row * 8 + lane] + b_f[lane]; LOGF[(size_t)row * 8 + lane] = fminf(z, 0.f) - log1pf(expf(-fabsf(z))); }
    if (lane < 16) { const float inv = powf(10000.f, -(float)lane / 16.f); const float ang = (float)positions[row] * inv; float sn, cs; sincosf(ang, &sn, &cs); ROPE[(size_t)row * 16 + lane] = make_float2(cs, sn); }
}

__global__ void __launch_bounds__(256) k_rowprep(bf16_t* PROJ, const float* FL, const float* g_qa, const float* g_kva, const float* g_fq, const float* g_fk, const float* b_f,
                                                 const int* positions, float* LOGF, float2* ROPE) {
    rowprep_row(PROJ, FL, g_qa, g_kva, g_fq, g_fk, b_f, positions, LOGF, ROPE, blockIdx.x * 4 + (threadIdx.x >> 6), threadIdx.x & 63);
}

__device__ __forceinline__ void fcum_item(const float* LOGF, float* FCUM, int item, int lane) {
    const int b = item >> 3, h = item & 7;
    const float* src = LOGF + ((size_t)b * S_) * 8 + h;
    float tot = 0.f;
    for (int i = 0; i < 128; ++i) tot += src[(size_t)(128 * lane + i) * 8];
    float incl = tot;
#pragma unroll
    for (int o = 1; o < 64; o <<= 1) { const float t = __shfl_up(incl, o); if (lane >= o) incl += t; }
    float run = incl - tot;
    float* dst = FCUM + ((size_t)(b * 8 + h)) * S_ + 128 * lane;
    for (int i = 0; i < 128; ++i) { run += src[(size_t)(128 * lane + i) * 8]; dst[i] = run; }
}
__global__ void __launch_bounds__(64) k_fcum(const float* LOGF, float* FCUM) { fcum_item(LOGF, FCUM, blockIdx.x, threadIdx.x); }

__device__ __forceinline__ void mlaprep_row(bf16_t* QRAW, const bf16_t* KVRAW, const bf16_t* PROJ, bf16_t* KA, const float2* ROPE, const float* g_q, const float* g_k, int row, int lane) {
    const int h = lane >> 3, p = lane & 7;
    const float2 cs0 = ROPE[(size_t)row * 16 + 2 * p], cs1 = ROPE[(size_t)row * 16 + 2 * p + 1];
#pragma unroll
    for (int which = 0; which < 2; ++which) {
        const float* g = which == 0 ? g_q : g_k; const float sc = which == 0 ? C2A : 1.f;
        float v[8]; unsigned r1, r2;
        if (which == 0) { const bf16_t* q = QRAW + (size_t)row * 768 + h * 96; unpack8(*(const uint4*)(q + 8 * p), v); r1 = *(const unsigned*)(q + 64 + 2 * p); r2 = *(const unsigned*)(q + 80 + 2 * p); }
        else { unpack8(*(const uint4*)(KVRAW + (size_t)row * 1024 + h * 128 + 8 * p), v); const bf16_t* kp = PROJ + (size_t)row * PP + C_KPE; r1 = *(const unsigned*)(kp + 2 * p); r2 = *(const unsigned*)(kp + 16 + 2 * p); }
        float a0 = lo2f(r1), a1 = hi2f(r1), b0 = lo2f(r2), b1 = hi2f(r2);
        float ss = a0 * a0 + a1 * a1 + b0 * b0 + b1 * b1;
#pragma unroll
        for (int i = 0; i < 8; ++i) ss += v[i] * v[i];
        ss += __shfl_xor(ss, 1); ss += __shfl_xor(ss, 2); ss += __shfl_xor(ss, 4);
        const float r = rsqrtf(ss * (1.f / 96.f) + EPS);
        const float* gn = g + 8 * p;
        a0 *= r * g[64 + 2 * p]; a1 *= r * g[64 + 2 * p + 1]; b0 *= r * g[80 + 2 * p]; b1 *= r * g[80 + 2 * p + 1];
        const float ra0 = a0 * cs0.x - b0 * cs0.y, rb0 = b0 * cs0.x + a0 * cs0.y, ra1 = a1 * cs1.x - b1 * cs1.y, rb1 = b1 * cs1.x + a1 * cs1.y;
        uint4 o; o.x = pk2(v[0] * r * gn[0] * sc, v[1] * r * gn[1] * sc); o.y = pk2(v[2] * r * gn[2] * sc, v[3] * r * gn[3] * sc);
        o.z = pk2(v[4] * r * gn[4] * sc, v[5] * r * gn[5] * sc); o.w = pk2(v[6] * r * gn[6] * sc, v[7] * r * gn[7] * sc);
        bf16_t* dst = (which == 0 ? QRAW : KA) + (size_t)row * 768 + h * 96;
        *(uint4*)(dst + 8 * p) = o; *(unsigned*)(dst + 64 + 2 * p) = pk2(ra0 * sc, ra1 * sc); *(unsigned*)(dst + 80 + 2 * p) = pk2(rb0 * sc, rb1 * sc);
    }
}

__global__ void __launch_bounds__(256) k_mlaprep(bf16_t* QRAW, const bf16_t* KVRAW, const bf16_t* PROJ, bf16_t* KA, const float2* ROPE, const float* g_q, const float* g_k) {
    mlaprep_row(QRAW, KVRAW, PROJ, KA, ROPE, g_q, g_k, blockIdx.x * 4 + (threadIdx.x >> 6), threadIdx.x & 63);
}

template <int DK>
__global__ void __launch_bounds__(256) k_attn_naive(const bf16_t* Q, int pq, int qstep, const bf16_t* K, int pk, int kstep, const bf16_t* V, int pv, int vstep, bf16_t* O, int po, int ostep, const float* FCUM) {
    __shared__ float Ks[64][DK];
    __shared__ float Vs[64][64];
    __shared__ float Bs[64];
    const int bh = blockIdx.x >> 5, qb = blockIdx.x & 31, b = bh >> 3, h = bh & 7;
    const int t = qb * 256 + threadIdx.x;
    const size_t row = (size_t)b * S_ + t;
    float q[DK];
#pragma unroll
    for (int c = 0; c < DK / 8; ++c) unpack8(*(const uint4*)(Q + row * pq + h * qstep + c * 8), q + c * 8);
    float o[64];
#pragma unroll
    for (int d = 0; d < 64; ++d) o[d] = 0.f;
    float m = -INFINITY, l = 0.f;
    const float fq = FCUM ? FCUM[(size_t)(b * 8 + h) * S_ + t] : 0.f;
    const int ntiles = (qb * 256 + 256) / 64;
    for (int kt = 0; kt < ntiles; ++kt) {
        __syncthreads();
        for (int c = threadIdx.x; c < 64 * (DK / 8); c += 256) { const int key = c / (DK / 8), ch = c % (DK / 8); float v[8];
            unpack8(*(const uint4*)(K + ((size_t)b * S_ + kt * 64 + key) * pk + h * kstep + ch * 8), v);
#pragma unroll
            for (int i = 0; i < 8; ++i) Ks[key][ch * 8 + i] = v[i]; }
        for (int c = threadIdx.x; c < 64 * 8; c += 256) { const int key = c >> 3, ch = c & 7; float v[8];
            unpack8(*(const uint4*)(V + ((size_t)b * S_ + kt * 64 + key) * pv + h * vstep + ch * 8), v);
#pragma unroll
            for (int i = 0; i < 8; ++i) Vs[key][ch * 8 + i] = v[i]; }
        if (threadIdx.x < 64) Bs[threadIdx.x] = FCUM ? FCUM[(size_t)(b * 8 + h) * S_ + kt * 64 + threadIdx.x] : 0.f;
        __syncthreads();
        const int kmax = t - kt * 64 + 1;
        for (int kk = 0; kk < 64; ++kk) {
            float s = 0.f;
#pragma unroll
            for (int d = 0; d < DK; ++d) s += q[d] * Ks[kk][d];
            if (FCUM) s += (fq - Bs[kk]) * LOG2E;
            if (kk < kmax) {
                const float mn = fmaxf(m, s), corr = exp2f(m - mn), p = exp2f(s - mn);
                l = l * corr + p;
#pragma unroll
                for (int d = 0; d < 64; ++d) o[d] = o[d] * corr + p * Vs[kk][d];
                m = mn;
            }
        }
    }
    const float rl = 1.f / l;
    bf16_t* op = O + row * po + h * ostep;
#pragma unroll
    for (int c = 0; c < 8; ++c) { uint4 w; w.x = pk2(o[c * 8 + 0] * rl, o[c * 8 + 1] * rl); w.y = pk2(o[c * 8 + 2] * rl, o[c * 8 + 3] * rl); w.z = pk2(o[c * 8 + 4] * rl, o[c * 8 + 5] * rl); w.w = pk2(o[c * 8 + 6] * rl, o[c * 8 + 7] * rl);
        *(uint4*)(op + c * 8) = w; }
}

__device__ __forceinline__ void topk_item(const bf16_t* QP, const float* sub_keys, int* EID, float* GATE, int w, int lane) {
    const int t = w >> 3, h = w & 7;
    float sl0 = 0.f, sl1 = 0.f; int il0 = 0, il1 = 0;
#pragma unroll
    for (int p = 0; p < 2; ++p) {
        const bf16_t* q = QP + (size_t)t * 2048 + h * 256 + p * 128;
        const float* k0 = sub_keys + ((size_t)(h * 2 + p) * 128 + lane) * 128; const float* k1 = k0 + 64 * 128;
        float s0 = 0.f, s1 = 0.f;
        for (int d = 0; d < 128; ++d) { const float qd = bf2f(q[d]); s0 += qd * k0[d]; s1 += qd * k1[d]; }
        float ls = 0.f; int li = 0;
        for (int r = 0; r < 16; ++r) {
            float bv; int bi; if (s0 >= s1) { bv = s0; bi = lane; } else { bv = s1; bi = lane + 64; }
#pragma unroll
            for (int o = 32; o >= 1; o >>= 1) { const float ov = __shfl_xor(bv, o); const int oi = __shfl_xor(bi, o); if (ov > bv || (ov == bv && oi < bi)) { bv = ov; bi = oi; } }
            if (lane == r) { ls = bv; li = bi; }
            if (bi == lane) s0 = -INFINITY; else if (bi == lane + 64) s1 = -INFINITY;
        }
        if (p == 0) { sl0 = ls; il0 = li; } else { sl1 = ls; il1 = li; }
    }
    float cv0, cv1, cv2, cv3;
    { const int c0 = lane, c1 = lane + 64, c2 = lane + 128, c3 = lane + 192;
      cv0 = __shfl(sl0, c0 >> 4) + __shfl(sl1, c0 & 15); cv1 = __shfl(sl0, c1 >> 4) + __shfl(sl1, c1 & 15);
      cv2 = __shfl(sl0, c2 >> 4) + __shfl(sl1, c2 & 15); cv3 = __shfl(sl0, c3 >> 4) + __shfl(sl1, c3 & 15); }
    float tv = -INFINITY; int tc = 0;
    for (int r = 0; r < 16; ++r) {
        float bv = cv0; int bc = lane;
        if (cv1 > bv) { bv = cv1; bc = lane + 64; }
        if (cv2 > bv) { bv = cv2; bc = lane + 128; }
        if (cv3 > bv) { bv = cv3; bc = lane + 192; }
#pragma unroll
        for (int o = 32; o >= 1; o >>= 1) { const float ov = __shfl_xor(bv, o); const int oc = __shfl_xor(bc, o); if (ov > bv || (ov == bv && oc < bc)) { bv = ov; bc = oc; } }
        if (lane == r) { tv = bv; tc = bc; }
        if (bc == lane) cv0 = -INFINITY; else if (bc == lane + 64) cv1 = -INFINITY; else if (bc == lane + 128) cv2 = -INFINITY; else if (bc == lane + 192) cv3 = -INFINITY;
    }
    const float mx = __shfl(tv, 0);
    const float e = lane < 16 ? expf(tv - mx) : 0.f;
    const float sum = wave_sum(e);
    const int e1 = __shfl(il0, (tc >> 4) & 15), e2 = __shfl(il1, tc & 15);
    if (lane < 16) { EID[(size_t)t * 128 + h * 16 + lane] = e1 * 128 + e2; GATE[(size_t)t * 128 + h * 16 + lane] = e / sum; }
}

__global__ void __launch_bounds__(256) k_topk_naive(const bf16_t* QP, const float* sub_keys, int* EID, float* GATE) { topk_item(QP, sub_keys, EID, GATE, blockIdx.x * 4 + (threadIdx.x >> 6), threadIdx.x & 63); }

__device__ __forceinline__ float gelu_tanh(float x) { const float u = 0.7978845608028654f * (x + 0.044715f * x * x * x); return 0.5f * x * (1.f + tanhf(u)); }

__device__ __forceinline__ void gather_item(const bf16_t* H2, const int* EID, const float* GATE, const float* peer_u, const float* peer_v, const float* mod, float* out, int t, int lane) {
    const int b = t / S_;
    float hv[16], y[16];
#pragma unroll
    for (int j = 0; j < 4; ++j) { const uint2 raw = *(const uint2*)(H2 + (size_t)t * 1024 + 4 * lane + 256 * j); hv[4 * j] = lo2f(raw.x); hv[4 * j + 1] = hi2f(raw.x); hv[4 * j + 2] = lo2f(raw.y); hv[4 * j + 3] = hi2f(raw.y); }
#pragma unroll
    for (int i = 0; i < 16; ++i) y[i] = 0.f;
    const int e_a = EID[(size_t)t * 128 + lane], e_b = EID[(size_t)t * 128 + 64 + lane];
    const float g_a = GATE[(size_t)t * 128 + lane], g_b = GATE[(size_t)t * 128 + 64 + lane];
    for (int jj = 0; jj < 128; ++jj) {
        const int e = jj < 64 ? __shfl(e_a, jj) : __shfl(e_b, jj - 64);
        const float g = jj < 64 ? __shfl(g_a, jj) : __shfl(g_b, jj - 64);
        const float4* ur = (const float4*)(peer_u + (size_t)e * 1024) + lane;
        float s = 0.f;
#pragma unroll
        for (int j = 0; j < 4; ++j) { const float4 u4 = ur[64 * j]; s += (u4.x * hv[4 * j] + u4.y * hv[4 * j + 1]) + (u4.z * hv[4 * j + 2] + u4.w * hv[4 * j + 3]); }
        s = wave_sum(s);
        const float wgt = g * gelu_tanh(s);
        const float4* vr = (const float4*)(peer_v + (size_t)e * 1024) + lane;
#pragma unroll
        for (int j = 0; j < 4; ++j) { const float4 v4 = vr[64 * j]; y[4 * j] += wgt * v4.x; y[4 * j + 1] += wgt * v4.y; y[4 * j + 2] += wgt * v4.z; y[4 * j + 3] += wgt * v4.w; }
    }
    const float* g2 = mod + b * 6144 + 5 * 1024;
#pragma unroll
    for (int j = 0; j < 4; ++j) { const int col = 4 * lane + 256 * j; float4* op = (float4*)(out + (size_t)t * 1024 + col); float4 x1 = *op; const float4 gg = *(const float4*)(g2 + col);
        x1.x += gg.x * y[4 * j]; x1.y += gg.y * y[4 * j + 1]; x1.z += gg.z * y[4 * j + 2]; x1.w += gg.w * y[4 * j + 3]; *op = x1; }
}
__global__ void __launch_bounds__(256) k_gather_naive(const bf16_t* H2, const int* EID, const float* GATE, const float* peer_u, const float* peer_v, const float* mod, float* out) {
    gather_item(H2, EID, GATE, peer_u, peer_v, mod, out, blockIdx.x * 4 + (threadIdx.x >> 6), threadIdx.x & 63);
}


namespace pg8 {
#define PG8_LAS __attribute__((address_space(3)))
typedef unsigned short bf16_t;
typedef short bf16x8 __attribute__((ext_vector_type(8)));
typedef float f32x4 __attribute__((ext_vector_type(4)));
typedef unsigned u32x4 __attribute__((ext_vector_type(4)));
constexpr int BM = 256, BK = 64, HALF = 128, HTB = HALF * BK * 2  , STAGE_BYTES = 8 * HTB, NXCD = 8, WGM = 8;

__host__ __device__ __forceinline__ int lds_byte(int r, int c) { const int st = (r >> 4) * 2 + (c >> 5), rr = r & 15, cc = c & 31, ob = rr * 64 + cc * 2; return st * 1024 + (ob ^ (((ob >> 9) & 1) << 5)); }
__host__ __device__ __forceinline__ void stage_rc(int b, int& R, int& C) { const int st = b / 1024, sb = b % 1024, swz = sb ^ (((sb >> 9) & 1) << 5); R = (st >> 1) * 16 + swz / 64; C = (st & 1) * 32 + (swz % 64) / 2; }
__host__ __device__ __forceinline__ int perm32(int rho) { const int n = rho >> 4, i = rho & 15; return 8 * (i >> 2) + 4 * n + (i & 3); }

struct Unit { int pm, pn; };
struct Gemm { const bf16_t* A; const bf16_t* Bt; int M, N, K, lda; };

struct StaticOrder {
    int nM, nN, nwg, G, c;
    __host__ __device__ void init(int M, int N, int G_, int c_) { nM = M / BM; nN = N / BM; nwg = nM * nN; G = G_; c = c_; }
    __host__ __device__ bool next(int i, Unit& u) const {
        const long L = (long)i * G + c; if (L >= nwg) return false;
        int wgid = (int)L; { const int q = nwg / NXCD, r = nwg % NXCD, xcd = wgid % NXCD, off = wgid / NXCD; wgid = (xcd < r ? xcd * (q + 1) : r * (q + 1) + (xcd - r) * q) + off; }
        const int nig = WGM * nN, gid = wgid / nig, fm = gid * WGM, gsz = (nM - fm) < WGM ? (nM - fm) : WGM;
        u.pm = fm + ((wgid % nig) % gsz); u.pn = (wgid % nig) / gsz; return true;
    }
    __device__ __forceinline__ void a_ready(const Unit&) const {}
    __device__ __forceinline__ void done(const Unit&) const {}
};
__device__ __forceinline__ unsigned cvt_pk_bf16(float lo, float hi) { unsigned r; asm volatile("v_cvt_pk_bf16_f32 %0, %1, %2" : "=v"(r) : "v"(lo), "v"(hi)); return r; }
typedef float f32x2 __attribute__((ext_vector_type(2)));
template <class Epi, class Sched, bool ALIGN_EPI = false, bool SP2 = false>
__device__ __forceinline__ void gemm_phase(PG8_LAS unsigned char* lds, const Gemm g, const Sched& S, const Epi& E) {
    const int tid = threadIdx.x, wid = __builtin_amdgcn_readfirstlane(tid >> 6), lane = tid & 63, wr = wid >> 2, wc = wid & 3, fr = lane & 15, fq = lane >> 4;
    const int K = g.K, nt = K / BK;
    unsigned voffA[2], voffB[2];
#pragma unroll
    for (int i = 0; i < 2; ++i) { int R, C; stage_rc(tid * 16 + i * 8192, R, C); const int Rb = Epi::PERM ? ((R & ~31) + perm32(R & 31)) : R;
        voffA[i] = (unsigned)(R * g.lda + C) * 2u; voffB[i] = (unsigned)(Rb * K + C) * 2u; }
    const size_t kstep = (size_t)(BK * 2);
    const size_t hstepA = (size_t)HALF * g.lda * 2, hstepB = (size_t)HALF * K * 2;
    const size_t tstepA = 2 * hstepA, tstepB = 2 * hstepB;
    const unsigned ldsw = (unsigned)wid * 1024u;
    const int aoff = lds_byte(wr * 64 + fr, fq * 8), boff = lds_byte(wc * 32 + fr, fq * 8);
#define PG8_SA(b, h) (((b) * 2 + (h)) * HTB)
#define PG8_SB(b, h) ((4 + (b) * 2 + (h)) * HTB)
#define PG8_STAGE(bufoff, gbase, voff) do { _Pragma("unroll") for (int _i = 0; _i < 2; ++_i) \
        __builtin_amdgcn_global_load_lds((const unsigned*)((const char*)(gbase) + (voff)[_i]), (PG8_LAS unsigned*)(lds + (bufoff) + ldsw + _i * 8192), 16, 0, 0); } while (0)
#define PG8_LDA(dst, b, h) do { _Pragma("unroll") for (int m = 0; m < 4; ++m) _Pragma("unroll") for (int k = 0; k < 2; ++k) dst[m][k] = *(const PG8_LAS bf16x8*)(lds + PG8_SA(b, h) + aoff + m * 2048 + k * 1024); } while (0)
#define PG8_LDB(dst, b, h) do { _Pragma("unroll") for (int n = 0; n < 2; ++n) _Pragma("unroll") for (int k = 0; k < 2; ++k) dst[n][k] = *(const PG8_LAS bf16x8*)(lds + PG8_SB(b, h) + boff + n * 2048 + k * 1024); } while (0)
#define PG8_MMA(ai, bj, At, Bt) do { __builtin_amdgcn_s_setprio(1); _Pragma("unroll") for (int m = 0; m < 4; ++m) _Pragma("unroll") for (int n = 0; n < 2; ++n) _Pragma("unroll") for (int k = 0; k < 2; ++k) \
        acc[ai][bj][m][n] = __builtin_amdgcn_mfma_f32_16x16x32_bf16(Bt[n][k], At[m][k], acc[ai][bj][m][n], 0, 0, 0); __builtin_amdgcn_s_setprio(0); } while (0)
#define PG8_WAIT_V(n) asm volatile("s_waitcnt vmcnt(" #n ")" ::: "memory")
#define PG8_WAIT_L(n) asm volatile("s_waitcnt lgkmcnt(" #n ")" ::: "memory")
#define PG8_BAR __builtin_amdgcn_s_barrier()
#define PG8_SCHED __builtin_amdgcn_sched_barrier(0)
    Unit cur, nxt; int ui = 0;
    if (!S.next(0, cur)) return;
    f32x4 acc[2][2][4][2];
#pragma unroll
    for (int a = 0; a < 2; ++a)
#pragma unroll
        for (int b = 0; b < 2; ++b)
#pragma unroll
            for (int m = 0; m < 4; ++m)
#pragma unroll
                for (int n = 0; n < 2; ++n) acc[a][b][m][n] = (f32x4){0.f, 0.f, 0.f, 0.f};
    bf16x8 At[4][2], B0[2][2], B1[2][2];
    const char* cA = (const char*)g.A + (size_t)cur.pm * tstepA; const char* cB = (const char*)g.Bt + (size_t)cur.pn * tstepB;
    S.a_ready(cur);
    if constexpr (SP2) {
        PG8_STAGE(PG8_SB(0, 0), cB, voffB); PG8_STAGE(PG8_SB(0, 1), cB + hstepB, voffB); PG8_STAGE(PG8_SA(0, 0), cA, voffA); PG8_STAGE(PG8_SA(0, 1), cA + hstepA, voffA);
        if (wr == 1) PG8_BAR;
        PG8_WAIT_V(2); PG8_BAR;
        PG8_STAGE(PG8_SB(1, 0), cB + kstep, voffB); PG8_STAGE(PG8_SA(1, 0), cA + kstep, voffA); PG8_STAGE(PG8_SB(1, 1), cB + hstepB + kstep, voffB);
        PG8_WAIT_V(6); PG8_BAR;
    } else {
        PG8_STAGE(PG8_SB(0, 0), cB, voffB); PG8_STAGE(PG8_SA(0, 0), cA, voffA); PG8_STAGE(PG8_SB(0, 1), cB + hstepB, voffB); PG8_STAGE(PG8_SA(0, 1), cA + hstepA, voffA);
        if (wr == 1) PG8_BAR;
        PG8_WAIT_V(4); PG8_BAR;
        PG8_STAGE(PG8_SB(1, 0), cB + kstep, voffB); PG8_STAGE(PG8_SA(1, 0), cA + kstep, voffA); PG8_STAGE(PG8_SB(1, 1), cB + hstepB + kstep, voffB);
        PG8_WAIT_V(6); PG8_BAR;
    }
    for (;;) {
        const bool has_next = S.next(ui + 1, nxt);
        const char* nA = has_next ? (const char*)g.A + (size_t)nxt.pm * tstepA : cA; const char* nB = has_next ? (const char*)g.Bt + (size_t)nxt.pn * tstepB : cB;
        for (int t = 0; t < nt; t += 2) {
            const bool last = (t == nt - 2);
            const char* a1 = cA + (size_t)(t + 1) * kstep;
            const char* a2 = last ? nA : cA + (size_t)(t + 2) * kstep; const char* b2 = last ? nB : cB + (size_t)(t + 2) * kstep;
            const char* a3 = a2 + kstep; const char* b3 = b2 + kstep;
            if (last && has_next) S.a_ready(nxt);
            if constexpr (SP2) {
            PG8_LDB(B0, 0, 0); PG8_LDB(B1, 0, 1); PG8_SCHED; PG8_LDA(At, 0, 0); PG8_STAGE(PG8_SA(1, 1), a1 + hstepA, voffA);
            PG8_WAIT_V(8); PG8_WAIT_L(0); PG8_BAR; PG8_MMA(0, 0, At, B0); PG8_MMA(0, 1, At, B1); PG8_BAR; PG8_SCHED;
            PG8_LDA(At, 0, 1); PG8_STAGE(PG8_SB(0, 0), b2, voffB); PG8_STAGE(PG8_SB(0, 1), b2 + hstepB, voffB); PG8_STAGE(PG8_SA(0, 0), a2, voffA);
            PG8_WAIT_V(8); PG8_WAIT_L(0); PG8_BAR; PG8_MMA(1, 0, At, B0); PG8_MMA(1, 1, At, B1); PG8_BAR; PG8_SCHED;
            PG8_LDB(B0, 1, 0); PG8_LDB(B1, 1, 1); PG8_SCHED; PG8_LDA(At, 1, 0); PG8_STAGE(PG8_SA(0, 1), a2 + hstepA, voffA);
            PG8_WAIT_V(8); PG8_WAIT_L(0); PG8_BAR; PG8_MMA(0, 0, At, B0); PG8_MMA(0, 1, At, B1); PG8_BAR; PG8_SCHED;
            PG8_LDA(At, 1, 1); PG8_STAGE(PG8_SB(1, 0), b3, voffB); PG8_STAGE(PG8_SB(1, 1), b3 + hstepB, voffB); PG8_STAGE(PG8_SA(1, 0), a3, voffA);
            PG8_WAIT_V(8); PG8_WAIT_L(0); PG8_BAR; PG8_MMA(1, 0, At, B0); PG8_MMA(1, 1, At, B1); PG8_BAR; PG8_SCHED;
            } else {
            PG8_LDB(B0, 0, 0); PG8_SCHED; PG8_LDA(At, 0, 0); PG8_STAGE(PG8_SA(1, 1), a1 + hstepA, voffA);
            PG8_WAIT_L(8); PG8_BAR; PG8_WAIT_L(0); PG8_MMA(0, 0, At, B0); PG8_BAR; PG8_SCHED;
            PG8_LDB(B1, 0, 1); PG8_STAGE(PG8_SB(0, 0), b2, voffB);
            PG8_BAR; PG8_WAIT_L(0); PG8_MMA(0, 1, At, B1); PG8_BAR;
            PG8_LDA(At, 0, 1); PG8_STAGE(PG8_SA(0, 0), a2, voffA);
            PG8_BAR; PG8_WAIT_L(0); PG8_MMA(1, 0, At, B0); PG8_BAR; PG8_SCHED;
            PG8_STAGE(PG8_SB(0, 1), b2 + hstepB, voffB);
            PG8_WAIT_V(6); PG8_BAR; PG8_MMA(1, 1, At, B1); PG8_BAR;
            PG8_LDB(B0, 1, 0); PG8_SCHED; PG8_LDA(At, 1, 0); PG8_STAGE(PG8_SA(0, 1), a2 + hstepA, voffA);
            PG8_WAIT_L(8); PG8_BAR; PG8_WAIT_L(0); PG8_MMA(0, 0, At, B0); PG8_BAR; PG8_SCHED;
            PG8_LDB(B1, 1, 1); PG8_STAGE(PG8_SB(1, 0), b3, voffB);
            PG8_BAR; PG8_WAIT_L(0); PG8_MMA(0, 1, At, B1); PG8_BAR;
            PG8_LDA(At, 1, 1); PG8_STAGE(PG8_SA(1, 0), a3, voffA);
            PG8_BAR; PG8_WAIT_L(0); PG8_MMA(1, 0, At, B0); PG8_BAR; PG8_SCHED;
            PG8_STAGE(PG8_SB(1, 1), b3 + hstepB, voffB);
            PG8_WAIT_V(6); PG8_BAR; PG8_MMA(1, 1, At, B1); PG8_BAR;
            }
        }
        if constexpr (ALIGN_EPI) { if (wr == 0) PG8_BAR; }
        if constexpr (!Epi::AFTER_DRAIN) { E(acc, cur, wr, wc, fr, fq); S.done(cur); }
        if (!has_next) break;
#pragma unroll
        for (int a = 0; a < 2; ++a)
#pragma unroll
            for (int b = 0; b < 2; ++b)
#pragma unroll
                for (int m = 0; m < 4; ++m)
#pragma unroll
                    for (int n = 0; n < 2; ++n) acc[a][b][m][n] = (f32x4){0.f, 0.f, 0.f, 0.f};
        cur = nxt; cA = nA; cB = nB; ++ui;
        if constexpr (ALIGN_EPI) { if (wr == 1) PG8_BAR; }
    }
    PG8_WAIT_V(0);
    if constexpr (!ALIGN_EPI) { if (wr == 0) PG8_BAR; }
    PG8_BAR;
    if constexpr (Epi::AFTER_DRAIN) { E.fused(acc, cur, wr, wc, fr, fq, lds, wid, lane); S.done(cur); }
#undef PG8_SA
#undef PG8_SB
#undef PG8_STAGE
#undef PG8_LDA
#undef PG8_LDB
#undef PG8_MMA
#undef PG8_WAIT_V
#undef PG8_WAIT_L
#undef PG8_BAR
#undef PG8_SCHED
}
}


#define GAS __attribute__((address_space(1)))
#define LAS __attribute__((address_space(3)))
typedef float f32x4 __attribute__((ext_vector_type(4)));
typedef unsigned u32x4 __attribute__((ext_vector_type(4)));
#define XB_TMO      128
#define XB_XCNT(j)  (256  + 64 * (j))
#define XB_XSUB(j)  (1280 + 64 * (j))
#define XB_XGEN(j)  (2304 + 64 * (j))
#define XB_TOP      3328
#define XB_TOPGEN   3392
#define XCD_BAR_WORDS 3456
#define XB_SPIN_CAP (1u << 18)

__device__ __forceinline__ unsigned xb_ld(unsigned* p)              { return __hip_atomic_load(p, __ATOMIC_RELAXED, __HIP_MEMORY_SCOPE_AGENT); }
__device__ __forceinline__ unsigned xb_add(unsigned* p, unsigned v) { return __hip_atomic_fetch_add(p, v, __ATOMIC_RELAXED, __HIP_MEMORY_SCOPE_AGENT); }
__device__ __forceinline__ unsigned xb_xcc_id() { return (unsigned)__builtin_amdgcn_s_getreg((3 << 11) | 20) & 0xFu; }
#define XB_SPIN(cond, bar) do { unsigned _sp = 0; while (cond) { __builtin_amdgcn_s_sleep(1); \
    if ((++_sp & 255u) == 0u) { if (xb_ld(&(bar)[XB_TMO])) break; if (_sp > XB_SPIN_CAP) { atomicAdd(&(bar)[XB_TMO], 1u); break; } } } } while (0)

struct XcdBarrier {
    unsigned* bar; unsigned x;
    volatile LAS unsigned* st;
};

__device__ __forceinline__ XcdBarrier xcd_barrier_post(unsigned* bar, volatile LAS unsigned* st) {
    XcdBarrier b; b.bar = bar; b.x = xb_xcc_id(); b.st = st;
    if (threadIdx.x == 0) (void)xb_add(&bar[XB_XCNT(b.x)], 1u);
    return b;
}
__device__ __forceinline__ void xcd_barrier_complete(unsigned* bar, unsigned x, unsigned& nloc, unsigned& nx) {
    const unsigned G = gridDim.x * gridDim.y * gridDim.z;
    unsigned sum, cnt, mine, sp = 0u;
    for (;;) {
        sum = 0u; cnt = 0u; mine = 0u;
#pragma unroll
        for (unsigned j = 0; j < 16; ++j) { const unsigned c = xb_ld(&bar[XB_XCNT(j)]); sum += c; cnt += (c > 0u) ? 1u : 0u; mine = (j == x) ? c : mine; }
        if (sum == G) break;
        __builtin_amdgcn_s_sleep(1);
        if ((++sp & 255u) == 0u) { if (xb_ld(&bar[XB_TMO])) break; if (sp > XB_SPIN_CAP) { atomicAdd(&bar[XB_TMO], 1u); break; } }
    }
    nloc = mine > 0u ? mine : 1u; nx = cnt > 0u ? cnt : 1u;
}

__device__ __forceinline__ void xcd_barrier(const XcdBarrier& b) {
    asm volatile("s_waitcnt vmcnt(0)" ::: "memory");
    __syncthreads();
    if (threadIdx.x == 0) {
        unsigned* bar = b.bar;
        __builtin_amdgcn_s_waitcnt(0);
        unsigned nloc = b.st[0], nx = b.st[1];
        if (nloc == 0u) { xcd_barrier_complete(bar, b.x, nloc, nx); b.st[0] = nloc; b.st[1] = nx; }
        const unsigned old = xb_add(&bar[XB_XSUB(b.x)], 1u);
        const unsigned gen = old / nloc;
        if (old + 1u == (gen + 1u) * nloc) {
            __builtin_amdgcn_fence(__ATOMIC_RELEASE, "agent");
            asm volatile("s_waitcnt vmcnt(0)" ::: "memory");
            const unsigned og = xb_add(&bar[XB_TOP], 1u);
            const unsigned tg = og / nx;
            if (og + 1u == (tg + 1u) * nx) xb_add(&bar[XB_TOPGEN], 1u);
            else XB_SPIN(xb_ld(&bar[XB_TOPGEN]) == tg, bar);
            __builtin_amdgcn_fence(__ATOMIC_ACQUIRE, "agent");
            xb_add(&bar[XB_XGEN(b.x)], 1u);
            asm volatile("s_waitcnt vmcnt(0)" ::: "memory");
        } else {
            XB_SPIN(xb_ld(&bar[XB_XGEN(b.x)]) == gen, bar);
            __builtin_amdgcn_fence(__ATOMIC_ACQUIRE, "agent");
            asm volatile("s_waitcnt vmcnt(0)" ::: "memory");
        }
    }
    __syncthreads();
}


constexpr int NWAVES = 8;
constexpr int RING_BYTES = 131072, LDSCTL_OFF = RING_BYTES, MISC_OFF = LDSCTL_OFF + 320, LDS_BYTES = 147456;
constexpr size_t WS_CTL = 0, CTL_ZERO_BYTES = 1 * MiB;
constexpr int CW_BAR = 4096, N_BAR_REGIONS = 16;
static_assert((CW_BAR + N_BAR_REGIONS * XCD_BAR_WORDS) * 4 <= (int)CTL_ZERO_BYTES, "barrier words inside the memset region");
constexpr size_t WS_WIN = 10 * MiB;
constexpr size_t WS_WUQ = 15 * MiB;
constexpr size_t WS_WUKV = 16 * MiB;
constexpr size_t WS_WO = 17 * MiB;
constexpr size_t WS_WPQ = 19 * MiB;
constexpr size_t WS_SK = 23 * MiB;
constexpr size_t WS_U16 = 24 * MiB;
constexpr size_t WS_V16 = 56 * MiB;


namespace att {
typedef short bf16x8 __attribute__((ext_vector_type(8)));
typedef short s16x4 __attribute__((ext_vector_type(4)));
typedef float f32x16 __attribute__((ext_vector_type(16)));
constexpr int LK = 0, KSLOT = 12288, LV = 2 * KSLOT, VSLOT = 8192, LB = LV + 2 * VSLOT, BSLOT = 256, LWS = LB + 2 * BSLOT, LOST = LWS + 8 * 256, ATT_LDS = LOST + 8 * 4096;
static_assert(ATT_LDS <= 131072, "attention scratch fits the ring region");
struct Desc { const bf16_t* Q; int pq; const bf16_t* K; int pk; const bf16_t* V; int pv; bf16_t* O; int po; const float* FC; };

__device__ __forceinline__ int crow(int r, int hi) { return (r & 3) + 8 * (r >> 2) + 4 * hi; }
__device__ __forceinline__ float xmax32(float v) { auto rr = __builtin_amdgcn_permlane32_swap(__float_as_uint(v), __float_as_uint(v), false, false); return fmaxf(__uint_as_float(rr[0]), __uint_as_float(rr[1])); }
__device__ __forceinline__ float xsum32(float v) { auto rr = __builtin_amdgcn_permlane32_swap(__float_as_uint(v), __float_as_uint(v), false, false); return __uint_as_float(rr[0]) + __uint_as_float(rr[1]); }
__device__ __forceinline__ unsigned cvtpk(float lo, float hi) { typedef float f2 __attribute__((ext_vector_type(2))); typedef __bf16 b2 __attribute__((ext_vector_type(2))); f2 v = {lo, hi}; b2 b = __builtin_convertvector(v, b2); return __builtin_bit_cast(unsigned, b); }
typedef short v4i16_t __attribute__((ext_vector_type(4)));
__device__ __forceinline__ s16x4 vtr(LAS const unsigned char* p) { return __builtin_bit_cast(s16x4, __builtin_amdgcn_ds_read_tr16_b64_v4i16((LAS v4i16_t*)p)); }

template <int KS, bool BIAS>
__device__ __forceinline__ void attn_unit(const Desc& d, int qb, int j0, LAS unsigned char* shm) {
    const int tid = threadIdx.x, lane = tid & 63, r32 = lane & 31, hi = lane >> 5; const int wid = __builtin_amdgcn_readfirstlane(tid >> 6);
    const int q0 = qb * 256, NT = (q0 + 256) / 64;
    LAS float* wsf = (LAS float*)(shm + LWS) + wid * 64;
    bf16x8 qr[KS];
    { const bf16_t* qp = d.Q + (size_t)(q0 + wid * 32 + r32) * d.pq + hi * 8;
#pragma unroll
      for (int d0 = 0; d0 < KS; ++d0) qr[d0] = *(const bf16x8*)(qp + d0 * 16); }
    const float fcref = BIAS ? d.FC[q0] : 0.f;
    const bf16_t* ksrc0 = d.K + (size_t)lane * d.pk + wid * 8;
    const bf16_t* ksrc1 = d.K + (size_t)lane * d.pk + (8 + wid) * 8;
    const bf16_t* vsrc = d.V + (size_t)(16 * (wid & 3) + (lane >> 2)) * d.pv + (wid >> 2) * 32 + (lane & 3) * 8;
    const int kdst0 = LK + wid * 1024 + lane * 16, kdst1 = LK + (8 + wid) * 1024 + lane * 16, vdst = LV + wid * 1024 + lane * 16;
    const bool k2 = (KS > 4) && (wid < 2 * KS - 8);
    u32x4 kr0, kr1, vr; float br = 0.f;
#define ATT_LOAD(t) do { kr0 = *(const u32x4*)(ksrc0 + (size_t)(t) * 64 * d.pk); if (k2) kr1 = *(const u32x4*)(ksrc1 + (size_t)(t) * 64 * d.pk); \
        vr = *(const u32x4*)(vsrc + (size_t)(t) * 64 * d.pv); if (BIAS && wid == 4) br = d.FC[(t) * 64 + lane]; } while (0)
#define ATT_WRITE(slot) do { *(LAS u32x4*)(shm + kdst0 + (slot) * KSLOT) = kr0; if (k2) *(LAS u32x4*)(shm + kdst1 + (slot) * KSLOT) = kr1; \
        *(LAS u32x4*)(shm + vdst + (slot) * VSLOT) = vr; if (BIAS && wid == 4) *(LAS float*)(shm + LB + (slot) * BSLOT + lane * 4) = (fcref - br) * LOG2E; } while (0)
    f32x16 o0, o1;
#pragma unroll
    for (int r = 0; r < 16; ++r) { o0[r] = 0.f; o1[r] = 0.f; }
    float m = -INFINITY, l = 0.f;
    const int qrel = wid * 32 + r32;
    const int kfrag = LK + hi * 1024 + r32 * 16;
    const int vfrag = LV + ((lane >> 4) & 1) * 32 + (lane & 3) * 8 + (4 * hi + ((lane & 15) >> 2)) * 64;
    ATT_LOAD(j0); ATT_WRITE(0);
    __syncthreads();
    for (int t = j0; t < NT; ++t) {
        const int slot = (t - j0) & 1;
        if (t + 1 < NT) ATT_LOAD(t + 1);
        const int jb = t - (NT - 4);
        if (!(jb >= 0 && 64 * jb > 32 * wid + 31)) {
            f32x16 p0, p1;
            if (BIAS) {
                LAS const unsigned char* bp = shm + LB + slot * BSLOT + 16 * hi;
#pragma unroll
                for (int g = 0; g < 4; ++g) { const f32x4 a = *(LAS const f32x4*)(bp + 32 * g), b = *(LAS const f32x4*)(bp + 128 + 32 * g);
                    p0[4 * g] = a[0]; p0[4 * g + 1] = a[1]; p0[4 * g + 2] = a[2]; p0[4 * g + 3] = a[3]; p1[4 * g] = b[0]; p1[4 * g + 1] = b[1]; p1[4 * g + 2] = b[2]; p1[4 * g + 3] = b[3]; }
            } else {
#pragma unroll
                for (int r = 0; r < 16; ++r) { p0[r] = 0.f; p1[r] = 0.f; }
            }
            LAS const unsigned char* kp = shm + kfrag + slot * KSLOT;
#pragma unroll
            for (int d0 = 0; d0 < KS; ++d0) {
                const bf16x8 a0 = *(LAS const bf16x8*)(kp + d0 * 2048), a1 = *(LAS const bf16x8*)(kp + d0 * 2048 + 512);
                p0 = __builtin_amdgcn_mfma_f32_32x32x16_bf16(a0, qr[d0], p0, 0, 0, 0);
                p1 = __builtin_amdgcn_mfma_f32_32x32x16_bf16(a1, qr[d0], p1, 0, 0, 0);
            }
            if (jb >= 0) {
                const int kb = 64 * jb + 4 * hi;
#pragma unroll
                for (int r = 0; r < 16; ++r) { const int kv = kb + (r & 3) + 8 * (r >> 2); if (kv > qrel) p0[r] = -INFINITY; if (kv + 32 > qrel) p1[r] = -INFINITY; }
            }
            float rm = fmaxf(p0[0], p1[0]);
#pragma unroll
            for (int r = 1; r < 16; ++r) rm = fmaxf(rm, fmaxf(p0[r], p1[r]));
            rm = xmax32(rm);
            const float mn = fmaxf(m, rm);
            const float alpha = __builtin_amdgcn_exp2f(m - mn);
            m = mn;
            float sacc = 0.f;
#pragma unroll
            for (int r = 0; r < 16; ++r) { p0[r] = __builtin_amdgcn_exp2f(p0[r] - mn); p1[r] = __builtin_amdgcn_exp2f(p1[r] - mn); sacc += p0[r] + p1[r]; }
            l = l * alpha + sacc;
            if (__any(alpha != 1.f)) {
                if (hi == 0) wsf[r32] = alpha;
#pragma unroll
                for (int g = 0; g < 4; ++g) { const f32x4 a = *(LAS const f32x4*)(wsf + 8 * g + 4 * hi);
#pragma unroll
                    for (int i = 0; i < 4; ++i) { o0[4 * g + i] *= a[i]; o1[4 * g + i] *= a[i]; } }
            }
            LAS const unsigned char* vp = shm + vfrag + slot * VSLOT;
#pragma unroll
            for (int ks = 0; ks < 4; ++ks) {
                const f32x16& pp = ks < 2 ? p0 : p1; const int bq = (ks & 1) * 8;
                u32x4 pw; pw.x = cvtpk(pp[bq], pp[bq + 1]); pw.y = cvtpk(pp[bq + 2], pp[bq + 3]); pw.z = cvtpk(pp[bq + 4], pp[bq + 5]); pw.w = cvtpk(pp[bq + 6], pp[bq + 7]);
                const bf16x8 pa = __builtin_bit_cast(bf16x8, pw);
                const s16x4 l0 = vtr(vp + ks * 1024), h0 = vtr(vp + ks * 1024 + 512), l1 = vtr(vp + 4096 + ks * 1024), h1 = vtr(vp + 4096 + ks * 1024 + 512);
                const bf16x8 v0 = {l0[0], l0[1], l0[2], l0[3], h0[0], h0[1], h0[2], h0[3]}, v1 = {l1[0], l1[1], l1[2], l1[3], h1[0], h1[1], h1[2], h1[3]};
                o0 = __builtin_amdgcn_mfma_f32_32x32x16_bf16(pa, v0, o0, 0, 0, 0);
                o1 = __builtin_amdgcn_mfma_f32_32x32x16_bf16(pa, v1, o1, 0, 0, 0);
            }
        }
        if (t + 1 < NT) ATT_WRITE(slot ^ 1);
        __syncthreads();
    }
#undef ATT_LOAD
#undef ATT_WRITE
    l = xsum32(l);
    if (hi == 0) wsf[32 + r32] = l;
    float rli[16];
#pragma unroll
    for (int g = 0; g < 4; ++g) { const f32x4 a = *(LAS const f32x4*)(wsf + 32 + 8 * g + 4 * hi);
#pragma unroll
        for (int i = 0; i < 4; ++i) rli[4 * g + i] = 1.f / a[i]; }
    LAS bf16_t* stg = (LAS bf16_t*)(shm + LOST) + wid * 2048;
#pragma unroll
    for (int r = 0; r < 16; ++r) { const int orow = crow(r, hi); stg[orow * 64 + r32] = f2bf(o0[r] * rli[r]); stg[orow * 64 + 32 + r32] = f2bf(o1[r] * rli[r]); }
    bf16_t* Ow = d.O + (size_t)(q0 + wid * 32) * d.po;
#pragma unroll
    for (int i = 0; i < 4; ++i) { const int row = i * 8 + (lane >> 3), ch = lane & 7; const u32x4 v = *(LAS const u32x4*)(stg + row * 64 + ch * 8); *(u32x4*)(Ow + (size_t)row * d.po + ch * 8) = v; }
    __syncthreads();
}
}


namespace pk {
typedef short bf16x8 __attribute__((ext_vector_type(8)));
typedef float f32x16 __attribute__((ext_vector_type(16)));
__device__ __forceinline__ unsigned f2sort(float f) { const unsigned b = __float_as_uint(f); return b ^ ((unsigned)((int)b >> 31) | 0x80000000u); }
__device__ __forceinline__ float sort2f(unsigned u) { return __uint_as_float((u & 0x80000000u) ? (u ^ 0x80000000u) : ~u); }
__device__ __forceinline__ void ce(unsigned& a, unsigned& b) { const unsigned mx = a > b ? a : b, mn = a > b ? b : a; a = mx; b = mn; }
__device__ __forceinline__ void sort16(unsigned (&v)[16]) {
#pragma unroll
    for (int k = 2; k <= 16; k <<= 1)
#pragma unroll
        for (int j = k >> 1; j >= 1; j >>= 1)
#pragma unroll
            for (int i = 0; i < 16; ++i) { const int l = i ^ j; if (l > i) { if ((i & k) == 0) ce(v[i], v[l]); else ce(v[l], v[i]); } }
}
__device__ __forceinline__ void merge16(unsigned (&a)[16], const unsigned (&b)[16]) {
#pragma unroll
    for (int i = 0; i < 16; ++i) a[i] = a[i] > b[15 - i] ? a[i] : b[15 - i];
#pragma unroll
    for (int j = 8; j >= 1; j >>= 1)
#pragma unroll
        for (int i = 0; i < 16; ++i) { const int l = i ^ j; if (l > i) ce(a[i], a[l]); }
}
__device__ __forceinline__ void top16of64(unsigned (&k)[64], unsigned (&out)[16]) {
    unsigned g1[16], g2[16], g3[16];
#pragma unroll
    for (int i = 0; i < 16; ++i) { out[i] = k[i]; g1[i] = k[16 + i]; g2[i] = k[32 + i]; g3[i] = k[48 + i]; }
    sort16(out); sort16(g1); sort16(g2); sort16(g3);
    merge16(out, g1); merge16(g2, g3); merge16(out, g2);
}
__device__ __forceinline__ unsigned sel4(const unsigned (&w)[4], int q) { const unsigned a = q & 1 ? w[1] : w[0], b = q & 1 ? w[3] : w[2]; return q & 2 ? b : a; }

template <int I> struct COff { static constexpr int v = COff<I - 1>::v + 16 / I; };
template <> struct COff<0> { static constexpr int v = 0; };
static_assert(COff<16>::v == 50, "50 candidates can reach the top 16 of a sorted 16 x 16 sum grid");
template <int I> __device__ __forceinline__ void fill_cand(unsigned (&c64)[64], const float (&s1)[16], const float (&s2)[16]) {
    if constexpr (I < 16) {
#pragma unroll
        for (int j = 0; j < 16 / (I + 1); ++j) c64[COff<I>::v + j] = (f2sort(s1[I] + s2[j]) & 0xFFFFFF00u) | (unsigned)(255 - (I * 16 + j));
        fill_cand<I + 1>(c64, s1, s2);
    }
}
__device__ __forceinline__ void topk_item(const bf16_t* QP, const bf16_t* SK, int* EID, float* GATE, int item, int lane) {
    const int tg = item >> 3, h = item & 7, r32 = lane & 31, hi = lane >> 5;
    const int t = tg * 32 + r32;
    unsigned own[2][16];
#pragma unroll
    for (int p = 0; p < 2; ++p) {
        const bf16_t* qrow = QP + (size_t)t * 2048 + h * 256 + p * 128 + hi * 8;
        bf16x8 qf[8];
#pragma unroll
        for (int d0 = 0; d0 < 8; ++d0) qf[d0] = *(const bf16x8*)(qrow + d0 * 16);
        const bf16_t* skb = SK + (size_t)((h * 2 + p) * 128 + r32) * 128 + hi * 8;
#pragma unroll 1
        for (int kt = 0; kt < 4; ++kt) {
            f32x16 acc;
#pragma unroll
            for (int r = 0; r < 16; ++r) acc[r] = 0.f;
#pragma unroll
            for (int d0 = 0; d0 < 8; ++d0) { const bf16x8 a = *(const bf16x8*)(skb + (size_t)kt * 32 * 128 + d0 * 16); acc = __builtin_amdgcn_mfma_f32_32x32x16_bf16(a, qf[d0], acc, 0, 0, 0); }
            unsigned cur[16];
#pragma unroll
            for (int r = 0; r < 16; ++r) { const int idx0 = kt * 32 + (r & 3) + 8 * (r >> 2);
                cur[r] = (f2sort(acc[r]) & 0xFFFFFF80u) | (unsigned)(127 - idx0 - 4 * hi); }
            sort16(cur);
            if (kt == 0) {
#pragma unroll
                for (int r = 0; r < 16; ++r) own[p][r] = cur[r];
            } else merge16(own[p], cur);
        }
    }
    unsigned fin[16];
    {
        unsigned oth[16];
#pragma unroll
        for (int i = 0; i < 16; ++i) { auto rr = __builtin_amdgcn_permlane32_swap(own[0][i], own[1][i], false, false); fin[i] = rr[0]; oth[i] = rr[1]; }
        merge16(fin, oth);
    }
    unsigned s1k[16], s2k[16];
#pragma unroll
    for (int i = 0; i < 16; ++i) { auto rr = __builtin_amdgcn_permlane32_swap(fin[i], fin[i], false, false); s1k[i] = rr[0]; s2k[i] = rr[1]; }
    float s1[16], s2[16]; unsigned long long i1lo = 0ull, i1hi = 0ull, i2lo = 0ull, i2hi = 0ull;
#pragma unroll
    for (int i = 0; i < 16; ++i) { s1[i] = sort2f(s1k[i] & 0xFFFFFF80u); s2[i] = sort2f(s2k[i] & 0xFFFFFF80u);
        const unsigned long long a = (unsigned long long)(127u - (s1k[i] & 0x7Fu)) << (8 * (i & 7)), b = (unsigned long long)(127u - (s2k[i] & 0x7Fu)) << (8 * (i & 7));
        if (i < 8) { i1lo |= a; i2lo |= b; } else { i1hi |= a; i2hi |= b; } }
    unsigned c64[64];
#pragma unroll
    for (int i = 50; i < 64; ++i) c64[i] = 0u;
    fill_cand<0>(c64, s1, s2);
    unsigned top[16];
    top16of64(c64, top);
    float ev[16]; float sum = 0.f; const float mx = sort2f(top[0] & 0xFFFFFF00u);
#pragma unroll
    for (int r = 0; r < 16; ++r) { ev[r] = __expf(sort2f(top[r] & 0xFFFFFF00u) - mx); sum += ev[r]; }
    const float rs = 1.f / sum;
    if (hi == 0) {
        int* ep = EID + (size_t)t * 128 + h * 16;
#pragma unroll
        for (int q4 = 0; q4 < 4; ++q4) { int ee[4];
#pragma unroll
            for (int z = 0; z < 4; ++z) { const int code = 255 - (int)(top[q4 * 4 + z] & 0xFFu), i = code >> 4, j = code & 15;
                const unsigned e1 = (unsigned)(((i & 8) ? i1hi : i1lo) >> (8 * (i & 7))) & 0xFFu, e2 = (unsigned)(((j & 8) ? i2hi : i2lo) >> (8 * (j & 7))) & 0xFFu; ee[z] = (int)(e1 * 128u + e2); }
            *(int4*)(ep + q4 * 4) = make_int4(ee[0], ee[1], ee[2], ee[3]); }
    } else {
        float* gp = GATE + (size_t)t * 128 + h * 16;
#pragma unroll
        for (int q4 = 0; q4 < 4; ++q4) *(float4*)(gp + q4 * 4) = make_float4(ev[q4 * 4] * rs, ev[q4 * 4 + 1] * rs, ev[q4 * 4 + 2] * rs, ev[q4 * 4 + 3] * rs);
    }
}
}


namespace gx {
typedef unsigned char u8x4 __attribute__((ext_vector_type(4)));
__device__ __forceinline__ int sdot16(const int4 a, const int4 b) {
    int s = __builtin_amdgcn_sdot4(a.x, b.x, 0, false); s = __builtin_amdgcn_sdot4(a.y, b.y, s, false); s = __builtin_amdgcn_sdot4(a.z, b.z, s, false); return __builtin_amdgcn_sdot4(a.w, b.w, s, false);
}
__device__ __forceinline__ void quant_row(const float* src, unsigned char* dst, float* scale_out, int lane) {
    const float4* sr = (const float4*)src + lane; float4 v[4]; float am = 0.f;
#pragma unroll
    for (int j = 0; j < 4; ++j) { v[j] = sr[64 * j]; am = fmaxf(am, fmaxf(fmaxf(fabsf(v[j].x), fabsf(v[j].y)), fmaxf(fabsf(v[j].z), fabsf(v[j].w)))); }
#pragma unroll
    for (int o = 1; o < 64; o <<= 1) am = fmaxf(am, __shfl_xor(am, o));
    const float inv = am > 0.f ? 127.f / am : 0.f;
#pragma unroll
    for (int j = 0; j < 4; ++j) { const int q0 = (int)rintf(v[j].x * inv), q1 = (int)rintf(v[j].y * inv), q2 = (int)rintf(v[j].z * inv), q3 = (int)rintf(v[j].w * inv);
        *(unsigned*)(dst + 4 * lane + 256 * j) = (unsigned)(q0 & 255) | ((unsigned)(q1 & 255) << 8) | ((unsigned)(q2 & 255) << 16) | ((unsigned)(q3 & 255) << 24); }
    if (lane == 0) *scale_out = am * (1.f / 127.f);
}
__device__ __forceinline__ float gelu_t(float x) { const float u = 0.7978845608028654f * (x + 0.044715f * x * x * x); return 0.5f * x * (1.f + tanhf(u)); }

__device__ __forceinline__ int hx(int lo, int hi, bool up, int bit) { const int send = up ? lo : hi, keep = up ? hi : lo; return keep + __shfl_xor(send, bit); }

__device__ __forceinline__ void u_token(const unsigned char* UQs  , const int4 (&ev)[4], const int4 hq, int* PArow, int lane) {
    const int e[16] = {ev[0].x, ev[0].y, ev[0].z, ev[0].w, ev[1].x, ev[1].y, ev[1].z, ev[1].w, ev[2].x, ev[2].y, ev[2].z, ev[2].w, ev[3].x, ev[3].y, ev[3].z, ev[3].w};
    int4 rows[16];
#pragma unroll
    for (int i = 0; i < 16; ++i) rows[i] = *(const int4*)(UQs + (size_t)e[i] * 1024);
    int p[16];
#pragma unroll
    for (int i = 0; i < 16; ++i) p[i] = sdot16(rows[i], hq);
    const bool b2 = (lane & 4) != 0, b1 = (lane & 2) != 0, b0 = (lane & 1) != 0;
    int q[8], r[4];
#pragma unroll
    for (int k = 0; k < 8; ++k) q[k] = hx(p[k], p[8 + k], b2, 4);
#pragma unroll
    for (int k = 0; k < 4; ++k) r[k] = hx(q[k], q[4 + k], b1, 2);
    const int z0 = hx(r[0], r[2], b0, 1), z1 = hx(r[1], r[3], b0, 1);
    *(int2*)(PArow + 2 * lane) = make_int2(z0, z1);
}

__device__ __forceinline__ void v_token(const unsigned char* VQs  , const int4 (&ev)[4], const int4 wh, const int4 wlo, float wscale, const float* gate2, const float* x1row, float* outrow, int s, int lane) {
    const int e[16] = {ev[0].x, ev[0].y, ev[0].z, ev[0].w, ev[1].x, ev[1].y, ev[1].z, ev[1].w, ev[2].x, ev[2].y, ev[2].z, ev[2].w, ev[3].x, ev[3].y, ev[3].z, ev[3].w};
    const int whv[4] = {wh.x, wh.y, wh.z, wh.w}, wlv[4] = {wlo.x, wlo.y, wlo.z, wlo.w};
    uint4 rows[16];
#pragma unroll
    for (int i = 0; i < 16; ++i) rows[i] = *(const uint4*)(VQs + (size_t)e[i] * 1024);
    int ah[16], al[16];
#pragma unroll
    for (int c = 0; c < 16; ++c) { ah[c] = 0; al[c] = 0; }
#pragma unroll
    for (int g = 0; g < 4; ++g) {
#pragma unroll
        for (int d = 0; d < 4; ++d) {
            const unsigned A = d == 0 ? rows[4 * g].x : d == 1 ? rows[4 * g].y : d == 2 ? rows[4 * g].z : rows[4 * g].w;
            const unsigned B = d == 0 ? rows[4 * g + 1].x : d == 1 ? rows[4 * g + 1].y : d == 2 ? rows[4 * g + 1].z : rows[4 * g + 1].w;
            const unsigned C = d == 0 ? rows[4 * g + 2].x : d == 1 ? rows[4 * g + 2].y : d == 2 ? rows[4 * g + 2].z : rows[4 * g + 2].w;
            const unsigned D = d == 0 ? rows[4 * g + 3].x : d == 1 ? rows[4 * g + 3].y : d == 2 ? rows[4 * g + 3].z : rows[4 * g + 3].w;
            const unsigned ab01 = __builtin_amdgcn_perm(A, B, 0x01050004u), ab23 = __builtin_amdgcn_perm(A, B, 0x03070206u);
            const unsigned cd01 = __builtin_amdgcn_perm(C, D, 0x01050004u), cd23 = __builtin_amdgcn_perm(C, D, 0x03070206u);
            const int q0 = (int)__builtin_amdgcn_perm(ab01, cd01, 0x01000504u), q1 = (int)__builtin_amdgcn_perm(ab01, cd01, 0x03020706u);
            const int q2 = (int)__builtin_amdgcn_perm(ab23, cd23, 0x01000504u), q3 = (int)__builtin_amdgcn_perm(ab23, cd23, 0x03020706u);
            ah[4 * d + 0] = __builtin_amdgcn_sdot4(q0, whv[g], ah[4 * d + 0], false); al[4 * d + 0] = __builtin_amdgcn_sdot4(q0, wlv[g], al[4 * d + 0], false);
            ah[4 * d + 1] = __builtin_amdgcn_sdot4(q1, whv[g], ah[4 * d + 1], false); al[4 * d + 1] = __builtin_amdgcn_sdot4(q1, wlv[g], al[4 * d + 1], false);
            ah[4 * d + 2] = __builtin_amdgcn_sdot4(q2, whv[g], ah[4 * d + 2], false); al[4 * d + 2] = __builtin_amdgcn_sdot4(q2, wlv[g], al[4 * d + 2], false);
            ah[4 * d + 3] = __builtin_amdgcn_sdot4(q3, whv[g], ah[4 * d + 3], false); al[4 * d + 3] = __builtin_amdgcn_sdot4(q3, wlv[g], al[4 * d + 3], false);
        }
    }
    int y[16];
#pragma unroll
    for (int c = 0; c < 16; ++c) y[c] = ah[c] * 128 + al[c];
    const bool b5 = (lane & 32) != 0, b4 = (lane & 16) != 0, b3 = (lane & 8) != 0;
    int z[8], q[4];
#pragma unroll
    for (int k = 0; k < 8; ++k) z[k] = hx(y[k], y[8 + k], b5, 32);
#pragma unroll
    for (int k = 0; k < 4; ++k) q[k] = hx(z[k], z[4 + k], b4, 16);
    const int r0 = hx(q[0], q[2], b3, 8), r1 = hx(q[1], q[3], b3, 8);
    const int col = 128 * s + 16 * (lane & 7) + (b5 ? 8 : 0) + (b4 ? 4 : 0) + (b3 ? 2 : 0);
    const float2 g2 = *(const float2*)(gate2 + col); float2 x1 = *(const float2*)(x1row + col);
    x1.x += g2.x * wscale * (float)r0; x1.y += g2.y * wscale * (float)r1;
    *(float2*)(outrow + col) = x1;
}
}

constexpr size_t WS_SU = 2 * MiB, WS_SV = 2 * MiB + 65536, WS_HS = 2 * MiB + 131072;
constexpr size_t WS_UQ = 24 * MiB, WS_VQ = 40 * MiB, WS_H2Q = 56 * MiB;
constexpr size_t WS_A = WS_KA;
struct Args { const void* in[22]; float* out; unsigned char* ws; int ph_lo, ph_hi, li, pad; };

struct Frame {
    LAS unsigned char* lds;
    int tid, lane, wave, G, gw, NGW;
};

namespace pg8 {
struct EpiProj {
    static constexpr bool PERM = true, AFTER_DRAIN = false;
    bf16_t* P; float* FL;
    __device__ __forceinline__ void operator()(const f32x4 (&acc)[2][2][4][2], const Unit& u, int wr, int wc, int fr, int fq) const {
        const int row0 = u.pm * BM + wr * 64 + fr, col0 = u.pn * BM + wc * 32 + 8 * fq;
#pragma unroll
        for (int ai = 0; ai < 2; ++ai)
#pragma unroll
            for (int m = 0; m < 4; ++m) { const int row = row0 + ai * HALF + m * 16; bf16_t* rowp = P + (size_t)row * PP + col0;
#pragma unroll
                for (int bj = 0; bj < 2; ++bj) { const f32x4 v0 = acc[ai][bj][m][0], v1 = acc[ai][bj][m][1];
                    if (col0 + bj * HALF == C_FL) { float* f = FL + (size_t)row * 8; *(f32x4*)f = v0; *(f32x4*)(f + 4) = v1; }
                    u32x4 w; w.x = cvt_pk_bf16(v0[0], v0[1]); w.y = cvt_pk_bf16(v0[2], v0[3]); w.z = cvt_pk_bf16(v1[0], v1[1]); w.w = cvt_pk_bf16(v1[2], v1[3]);
                    *(u32x4*)(rowp + bj * HALF) = w; } }
    }
};
struct EpiStore {
    static constexpr bool PERM = true, AFTER_DRAIN = false;
    bf16_t* O; int ldc;
    __device__ __forceinline__ void operator()(const f32x4 (&acc)[2][2][4][2], const Unit& u, int wr, int wc, int fr, int fq) const {
        const int row0 = u.pm * BM + wr * 64 + fr, col0 = u.pn * BM + wc * 32 + 8 * fq;
#pragma unroll
        for (int ai = 0; ai < 2; ++ai)
#pragma unroll
            for (int m = 0; m < 4; ++m) { bf16_t* rowp = O + (size_t)(row0 + ai * HALF + m * 16) * ldc + col0;
#pragma unroll
                for (int bj = 0; bj < 2; ++bj) { const f32x4 v0 = acc[ai][bj][m][0], v1 = acc[ai][bj][m][1];
                    u32x4 w; w.x = cvt_pk_bf16(v0[0], v0[1]); w.y = cvt_pk_bf16(v0[2], v0[3]); w.z = cvt_pk_bf16(v1[0], v1[1]); w.w = cvt_pk_bf16(v1[2], v1[3]);
                    *(u32x4*)(rowp + bj * HALF) = w; } }
    }
};
struct EpiResid {
    static constexpr bool PERM = false, AFTER_DRAIN = false;
    const float* X; const float* MOD; float* out;
    __device__ __forceinline__ void operator()(const f32x4 (&acc)[2][2][4][2], const Unit& u, int wr, int wc, int fr, int fq) const {
        const int row0 = u.pm * BM + wr * 64 + fr, col0 = u.pn * BM + wc * 32 + 4 * fq;
        const int b = (u.pm * BM) / S_;
        f32x4 gv[2][2];
#pragma unroll
        for (int bj = 0; bj < 2; ++bj)
#pragma unroll
            for (int n = 0; n < 2; ++n) gv[bj][n] = *(const f32x4*)(MOD + b * 6144 + 2 * 1024 + col0 + bj * HALF + n * 16);
#pragma unroll
        for (int ai = 0; ai < 2; ++ai)
#pragma unroll
            for (int m = 0; m < 4; ++m) { const size_t off = (size_t)(row0 + ai * HALF + m * 16) * 1024 + col0;
#pragma unroll
                for (int bj = 0; bj < 2; ++bj)
#pragma unroll
                    for (int n = 0; n < 2; ++n) { const f32x4 xv = *(const f32x4*)(X + off + bj * HALF + n * 16); *(f32x4*)(out + off + bj * HALF + n * 16) = xv + gv[bj][n] * acc[ai][bj][m][n]; } }
    }
};
}

__device__ __forceinline__ void p0_transpose_item(const float* W, int K, int N, int Npad, bf16_t* WT, LAS float* scr, int item, int lane) {
    const int nblk = Npad / 32, kb = item / nblk, nb = item % nblk, k0 = 64 * kb, n0 = 32 * nb;
    const int nn = n0 + (lane & 31);
#pragma unroll 8
    for (int i = 0; i < 32; ++i) { const int kk = 2 * i + (lane >> 5); scr[kk * 33 + (lane & 31)] = nn < N ? W[(size_t)(k0 + kk) * N + nn] : 0.f; }
    asm volatile("s_waitcnt lgkmcnt(0)" ::: "memory");
    const int c = lane & 7;
#pragma unroll
    for (int j = 0; j < 4; ++j) { const int n = (lane >> 3) + 8 * j; const LAS float* s = scr + (8 * c) * 33 + n;
        u32x4 o; o.x = pk2(s[0 * 33], s[1 * 33]); o.y = pk2(s[2 * 33], s[3 * 33]); o.z = pk2(s[4 * 33], s[5 * 33]); o.w = pk2(s[6 * 33], s[7 * 33]);
        *(u32x4*)(WT + (size_t)(n0 + n) * K + k0 + 8 * c) = o; }
    asm volatile("s_waitcnt lgkmcnt(0)" ::: "memory");
}
__device__ __forceinline__ void p0_mod_item(const float* c, const float* w_ada, const float* b_ada, float* mod, LAS float* scr, int item, int lane) {
    for (int i = lane; i < 4096; i += 64) { const int b = i >> 10, k = i & 1023; const float cv = c[i]; scr[k * 4 + b] = cv / (1.f + expf(-cv)); }
    asm volatile("s_waitcnt lgkmcnt(0)" ::: "memory");
    const int j = item * 64 + lane;
    float a0 = 0.f, a1 = 0.f, a2 = 0.f, a3 = 0.f;
#pragma unroll 8
    for (int k = 0; k < 1024; ++k) { const float w = w_ada[(size_t)k * 6144 + j]; const f32x4 s = *(const LAS f32x4*)(scr + k * 4); a0 += s[0] * w; a1 += s[1] * w; a2 += s[2] * w; a3 += s[3] * w; }
    const float bb = b_ada[j];
    mod[0 * 6144 + j] = a0 + bb; mod[1 * 6144 + j] = a1 + bb; mod[2 * 6144 + j] = a2 + bb; mod[3 * 6144 + j] = a3 + bb;
    asm volatile("s_waitcnt lgkmcnt(0)" ::: "memory");
}

__device__ __forceinline__ void modrow(const float* X, const float* g, const float* mod, int shift_idx, int scale_idx, bf16_t* out, int row, int lane) {
    const int b = row / S_;
    const float4* xr = (const float4*)(X + (size_t)row * 1024) + lane;
    float4 v[4]; float ss = 0.f;
#pragma unroll
    for (int j = 0; j < 4; ++j) { v[j] = xr[64 * j]; ss += (v[j].x * v[j].x + v[j].y * v[j].y) + (v[j].z * v[j].z + v[j].w * v[j].w); }
    ss = wave_sum(ss);
    const float r = rsqrtf(ss * (1.f / 1024.f) + EPS);
    const float* sh = mod + b * 6144 + shift_idx * 1024; const float* sc = mod + b * 6144 + scale_idx * 1024;
#pragma unroll
    for (int j = 0; j < 4; ++j) {
        const int col = 4 * lane + 256 * j;
        const float4 g4 = *(const float4*)(g + col), s4 = *(const float4*)(sc + col), h4 = *(const float4*)(sh + col);
        const float o0 = v[j].x * r * g4.x * (1.f + s4.x) + h4.x, o1 = v[j].y * r * g4.y * (1.f + s4.y) + h4.y;
        const float o2 = v[j].z * r * g4.z * (1.f + s4.z) + h4.z, o3 = v[j].w * r * g4.w * (1.f + s4.w) + h4.w;
        uint2 w; w.x = pk2(o0, o1); w.y = pk2(o2, o3);
        *(uint2*)(out + (size_t)row * 1024 + col) = w;
    }
}

__device__ __forceinline__ void modrow_q(const float* X, const float* g, const float* mod, int shift_idx, int scale_idx, bf16_t* out, unsigned char* outq, float* hs, int row, int lane) {
    const int b = row / S_;
    const float4* xr = (const float4*)(X + (size_t)row * 1024) + lane;
    float4 v[4]; float ss = 0.f;
#pragma unroll
    for (int j = 0; j < 4; ++j) { v[j] = xr[64 * j]; ss += (v[j].x * v[j].x + v[j].y * v[j].y) + (v[j].z * v[j].z + v[j].w * v[j].w); }
    ss = wave_sum(ss);
    const float r = rsqrtf(ss * (1.f / 1024.f) + EPS);
    const float* sh = mod + b * 6144 + shift_idx * 1024; const float* sc = mod + b * 6144 + scale_idx * 1024;
    float am = 0.f;
#pragma unroll
    for (int j = 0; j < 4; ++j) {
        const int col = 4 * lane + 256 * j;
        const float4 g4 = *(const float4*)(g + col), s4 = *(const float4*)(sc + col), h4 = *(const float4*)(sh + col);
        v[j].x = v[j].x * r * g4.x * (1.f + s4.x) + h4.x; v[j].y = v[j].y * r * g4.y * (1.f + s4.y) + h4.y;
        v[j].z = v[j].z * r * g4.z * (1.f + s4.z) + h4.z; v[j].w = v[j].w * r * g4.w * (1.f + s4.w) + h4.w;
        uint2 w; w.x = pk2(v[j].x, v[j].y); w.y = pk2(v[j].z, v[j].w);
        *(uint2*)(out + (size_t)row * 1024 + col) = w;
        am = fmaxf(am, fmaxf(fmaxf(fabsf(v[j].x), fabsf(v[j].y)), fmaxf(fabsf(v[j].z), fabsf(v[j].w))));
    }
#pragma unroll
    for (int o = 1; o < 64; o <<= 1) am = fmaxf(am, __shfl_xor(am, o));
    const float inv = am > 0.f ? 127.f / am : 0.f;
#pragma unroll
    for (int j = 0; j < 4; ++j) { const int q0 = (int)rintf(v[j].x * inv), q1 = (int)rintf(v[j].y * inv), q2 = (int)rintf(v[j].z * inv), q3 = (int)rintf(v[j].w * inv);
        *(unsigned*)(outq + (size_t)row * 1024 + 4 * lane + 256 * j) = (unsigned)(q0 & 255) | ((unsigned)(q1 & 255) << 8) | ((unsigned)(q2 & 255) << 16) | ((unsigned)(q3 & 255) << 24); }
    if (lane == 0) hs[row] = am * (1.f / 127.f);
}

__global__ void __launch_bounds__(NWAVES * 64, 2) mega_fwd(Args args) {
    extern __shared__ __attribute__((aligned(16))) unsigned char lds[];
    Frame F;
    F.lds = (LAS unsigned char*)lds;
    volatile LAS unsigned* MISC = (volatile LAS unsigned*)(F.lds + MISC_OFF);
    F.tid = threadIdx.x; F.lane = F.tid & 63; F.wave = __builtin_amdgcn_readfirstlane(F.tid >> 6);
    F.G = gridDim.x; F.gw = blockIdx.x * NWAVES + F.wave; F.NGW = F.G * NWAVES;
    unsigned char* ws = args.ws;
    unsigned* ctl = (unsigned*)(ws + WS_CTL);
    const float* x = (const float*)args.in[0]; const float* c = (const float*)args.in[1]; const int* positions = (const int*)args.in[2];
    const float* w_ada = (const float*)args.in[3]; const float* b_ada = (const float*)args.in[4]; const float* norm1_g = (const float*)args.in[5];
    const float* w_in = (const float*)args.in[6]; const float* mla_qa_g = (const float*)args.in[7]; const float* mla_kva_g = (const float*)args.in[8];
    const float* w_uq = (const float*)args.in[9]; const float* w_ukv = (const float*)args.in[10]; const float* mla_q_g = (const float*)args.in[11];
    const float* mla_k_g = (const float*)args.in[12]; const float* fox_q_g = (const float*)args.in[13]; const float* fox_k_g = (const float*)args.in[14];
    const float* b_f = (const float*)args.in[15]; const float* w_o = (const float*)args.in[16]; const float* norm2_g = (const float*)args.in[17];
    const float* w_pq = (const float*)args.in[18]; const float* sub_keys = (const float*)args.in[19]; const float* peer_u = (const float*)args.in[20]; const float* peer_v = (const float*)args.in[21];
    float* out = args.out;
    float* MOD = (float*)(ws + WS_MOD); float* FL = (float*)(ws + WS_FL); float* FCUM = (float*)(ws + WS_FCUM); float* LOGF = (float*)(ws + WS_LOGF); float2* ROPE = (float2*)(ws + WS_ROPE);
    bf16_t* XN = (bf16_t*)(ws + WS_XN); bf16_t* PROJ = (bf16_t*)(ws + WS_PROJ); bf16_t* KVRAW = (bf16_t*)(ws + WS_KVRAW); bf16_t* QA = (bf16_t*)(ws + WS_QA); bf16_t* KA = (bf16_t*)(ws + WS_KA);
    bf16_t* WIN = (bf16_t*)(ws + WS_WIN); bf16_t* WUQ = (bf16_t*)(ws + WS_WUQ); bf16_t* WUKV = (bf16_t*)(ws + WS_WUKV); bf16_t* WO = (bf16_t*)(ws + WS_WO); bf16_t* WPQ = (bf16_t*)(ws + WS_WPQ); bf16_t* SKB = (bf16_t*)(ws + WS_SK);
    unsigned char* UQ = ws + WS_UQ; unsigned char* VQ = ws + WS_VQ; unsigned char* H2Q = ws + WS_H2Q; float* SU = (float*)(ws + WS_SU); float* SV = (float*)(ws + WS_SV); float* HS = (float*)(ws + WS_HS); float* AP = (float*)(ws + WS_A);
    bf16_t* OB = XN; bf16_t* H2 = XN; bf16_t* QP = PROJ; int* EID = (int*)(ws + WS_QA); float* GATE = (float*)(ws + WS_QA + 16 * MiB);
    (void)sub_keys; (void)peer_u; (void)peer_v; (void)positions; (void)KA; (void)FCUM; (void)LOGF; (void)ROPE; (void)mla_q_g; (void)mla_k_g; (void)b_f; (void)fox_q_g; (void)fox_k_g; (void)mla_qa_g; (void)mla_kva_g;

    for (int u = F.tid; u < (LDS_BYTES - LDSCTL_OFF) / 4; u += NWAVES * 64) ((LAS unsigned*)(F.lds + LDSCTL_OFF))[u] = 0u;
    __syncthreads();
    const int lo = args.ph_lo, hi = args.ph_hi;
    XcdBarrier bar; bar.bar = ctl + CW_BAR + args.li * XCD_BAR_WORDS; bar.x = 0; bar.st = nullptr;
    if (hi - lo > 1) bar = xcd_barrier_post(ctl + CW_BAR + args.li * XCD_BAR_WORDS, MISC + 8);
#define IN(k) (lo <= (k) && (k) < hi)
#define SEAM(k) do { if (IN(k) && IN((k) + 1)) xcd_barrier(bar); } while (0)

    if (IN(0)) REP(0) {
        LAS float* scr = (LAS float*)(F.lds + F.wave * 16384);
        constexpr int I_MOD = 96, I_IN = 16 * 72, I_UQ = 6 * 24, I_UKV = 4 * 32, I_O = 16 * 32, I_PQ = 16 * 64;
        constexpr int I_SK = 512;
        constexpr int NITEMS = I_MOD + I_IN + I_UQ + I_UKV + I_O + I_PQ + I_SK + 2 * 16384;
        for (int it = F.gw; it < NITEMS; it += F.NGW) {
            int r = it;
            if (r < I_MOD) { p0_mod_item(c, w_ada, b_ada, MOD, scr, r, F.lane); continue; } r -= I_MOD;
            if (r < I_IN) { p0_transpose_item(w_in, 1024, INW, PP, WIN, scr, r, F.lane); continue; } r -= I_IN;
            if (r < I_UQ) { p0_transpose_item(w_uq, 384, 768, 768, WUQ, scr, r, F.lane); continue; } r -= I_UQ;
            if (r < I_UKV) { p0_transpose_item(w_ukv, 256, 1024, 1024, WUKV, scr, r, F.lane); continue; } r -= I_UKV;
            if (r < I_O) { p0_transpose_item(w_o, 1024, 1024, 1024, WO, scr, r, F.lane); continue; } r -= I_O;
            if (r < I_PQ) { p0_transpose_item(w_pq, 1024, 2048, 2048, WPQ, scr, r, F.lane); continue; } r -= I_PQ;
            if (r >= I_SK) { r -= I_SK; if (r < 16384) gx::quant_row(peer_u + (size_t)r * 1024, UQ + (size_t)r * 1024, SU + r, F.lane); else { r -= 16384; gx::quant_row(peer_v + (size_t)r * 1024, VQ + (size_t)r * 1024, SV + r, F.lane); } continue; }
            { const float4* src = (const float4*)(sub_keys + (size_t)r * 512) + F.lane * 2; const float4 a = src[0], b2 = src[1];
              u32x4 o; o.x = pk2(a.x, a.y); o.y = pk2(a.z, a.w); o.z = pk2(b2.x, b2.y); o.w = pk2(b2.z, b2.w); *(u32x4*)(SKB + (size_t)r * 512 + F.lane * 8) = o; }
        }
    }
    SEAM(0);
    if (IN(1)) { for (int row = F.gw; row < T_; row += F.NGW) modrow(x, norm1_g, MOD, 0, 1, XN, row, F.lane); }
    SEAM(1);
    if (IN(2)) REP(2) {
        pg8::Gemm g{XN, WIN, T_, PP, 1024, 1024}; pg8::StaticOrder S; S.init(T_, PP, F.G, (int)blockIdx.x);
        pg8::EpiProj E{PROJ, FL};
        pg8::gemm_phase<pg8::EpiProj, pg8::StaticOrder, true, true>(F.lds, g, S, E);
    }
    SEAM(2);
    if (IN(3)) { for (int row = F.gw; row < T_; row += F.NGW) rowprep_row(PROJ, FL, mla_qa_g, mla_kva_g, fox_q_g, fox_k_g, b_f, positions, LOGF, ROPE, row, F.lane); }
    SEAM(3);
    if (IN(4)) REP(4) {
        { pg8::Gemm g{PROJ + C_CQ, WUQ, T_, 768, 384, PP}; pg8::StaticOrder S; S.init(T_, 768, F.G, (int)blockIdx.x); pg8::EpiStore E{QA, 768};
          pg8::gemm_phase<pg8::EpiStore, pg8::StaticOrder, true, true>(F.lds, g, S, E); }
        { pg8::Gemm g{PROJ + C_CKV, WUKV, T_, 1024, 256, PP}; pg8::StaticOrder S; S.init(T_, 1024, F.G, (int)blockIdx.x); pg8::EpiStore E{KVRAW, 1024};
          pg8::gemm_phase<pg8::EpiStore, pg8::StaticOrder, true, true>(F.lds, g, S, E); }
    }
    SEAM(4);
    if (IN(5)) {
        if (F.gw < 32) fcum_item(LOGF, FCUM, F.gw, F.lane);
        for (int row = F.gw; row < T_; row += F.NGW) mlaprep_row(QA, KVRAW, PROJ, KA, ROPE, mla_q_g, mla_k_g, row, F.lane);
    }
    SEAM(5);
    if (IN(6)) {
        volatile LAS unsigned* qslot = MISC + 16;
        float thr;
        { float gq = fabsf(fox_q_g[F.lane]), gk = fabsf(fox_k_g[F.lane]);
#pragma unroll
          for (int o = 1; o < 64; o <<= 1) { gq = fmaxf(gq, __shfl_xor(gq, o)); gk = fmaxf(gk, __shfl_xor(gk, o)); }
          thr = 104.5f + 2.f * 1.02f * 8.f * gq * gk; }
        unsigned* qctr = ctl + 64;
        if (F.tid == 0) qslot[0] = atomicAdd(qctr, 1u);
        __syncthreads();
        unsigned u = qslot[0];
        while (u < 2048u) {
            unsigned unext = 0u;
            if (F.tid == 0) unext = atomicAdd(qctr, 1u);
            const int grp = (int)(u >> 10), bh = (int)(u & 31u), qb = 31 - (int)((u >> 5) & 31u), b = bh >> 3, h = bh & 7;
            if (grp == 0) { const att::Desc d{QA + (size_t)b * S_ * 768 + h * 96, 768, KA + (size_t)b * S_ * 768 + h * 96, 768, KVRAW + (size_t)b * S_ * 1024 + h * 128 + 64, 1024, OB + (size_t)b * S_ * 1024 + h * 64, 1024, nullptr};
                att::attn_unit<6, false>(d, qb, 0, F.lds); }
            else { const bf16_t* pb = PROJ + (size_t)b * S_ * PP + h * 64; const float* fc = FCUM + (size_t)(b * 8 + h) * S_;
                const att::Desc d{pb + C_FQ, PP, pb + C_FK, PP, pb + C_FV, PP, OB + (size_t)b * S_ * 1024 + 512 + h * 64, 1024, fc};
                const int NT = 4 * (qb + 1); const float lim = fc[qb * 256] + thr;
                int j0 = 0;
                { const int ja = F.lane, jb2 = 64 + F.lane;
                  const bool ka = ja < NT ? (fc[64 * ja + 63] <= lim) : true, kb = jb2 < NT ? (fc[64 * jb2 + 63] <= lim) : true;
                  const unsigned long long ma = __ballot(ka), mb = __ballot(kb);
                  j0 = ma ? __builtin_ctzll(ma) : (mb ? 64 + __builtin_ctzll(mb) : NT - 4); }
                if (j0 > NT - 4) j0 = NT - 4;
                att::attn_unit<4, true>(d, qb, j0, F.lds); }
            if (F.tid == 0) qslot[0] = unext;
            __syncthreads();
            u = qslot[0];
            __syncthreads();
        }
    }
    SEAM(6);
    if (IN(7)) REP(7) {
        pg8::Gemm g{OB, WO, T_, 1024, 1024, 1024}; pg8::StaticOrder S; S.init(T_, 1024, F.G, (int)blockIdx.x);
        pg8::EpiResid E{x, MOD, out};
        pg8::gemm_phase<pg8::EpiResid, pg8::StaticOrder, true, true>(F.lds, g, S, E);
    }
    SEAM(7);
    if (IN(8)) { for (int row = F.gw; row < T_; row += F.NGW) modrow_q(out, norm2_g, MOD, 3, 4, H2, H2Q, HS, row, F.lane); }
    SEAM(8);
    if (IN(9)) REP(9) {
        pg8::Gemm g{H2, WPQ, T_, 2048, 1024, 1024}; pg8::StaticOrder S; S.init(T_, 2048, F.G, (int)blockIdx.x); pg8::EpiStore E{QP, 2048};
        pg8::gemm_phase<pg8::EpiStore, pg8::StaticOrder, true, true>(F.lds, g, S, E);
    }
    SEAM(9);
    if (IN(10)) REP(10) { for (int w = F.gw; w < (T_ / 32) * 8; w += F.NGW) pk::topk_item(QP, SKB, EID, GATE, w, F.lane); }
    SEAM(10);
    {
        const int ng = F.G < 8 ? F.G : 8; const int vx = (int)blockIdx.x % ng, rank = (int)blockIdx.x / ng, nrank = (F.G - vx + ng - 1) / ng;
        const int gwv = rank * NWAVES + F.wave, ngwv = nrank * NWAVES;
        const int grp = F.lane >> 3, sub = F.lane & 7;
        int* PA = (int*)(ws + WS_PROJ);
        int* WQH = (int*)(ws + WS_KA); int* WQL = (int*)(ws + WS_KA + 4 * MiB); float* WSC = (float*)(ws + WS_KA + 8 * MiB);
        if (IN(11)) REP(11) {
            for (int s = vx; s < 8; s += ng) {
                const unsigned char* UQs = UQ + 128 * s + 16 * sub;
                int t = gwv; int4 ev[4]; int4 hq = make_int4(0, 0, 0, 0);
#pragma unroll
                for (int k = 0; k < 4; ++k) ev[k] = make_int4(0, 0, 0, 0);
                if (t < T_) {
#pragma unroll
                    for (int k = 0; k < 4; ++k) ev[k] = *(const int4*)(EID + (size_t)t * 128 + grp * 16 + 4 * k);
                    hq = *(const int4*)(H2Q + (size_t)t * 1024 + 128 * s + 16 * sub); }
                while (t < T_) {
                    const int tn = t + ngwv; int4 evn[4]; int4 hqn = make_int4(0, 0, 0, 0);
#pragma unroll
                    for (int k = 0; k < 4; ++k) evn[k] = make_int4(0, 0, 0, 0);
                    if (tn < T_) {
#pragma unroll
                        for (int k = 0; k < 4; ++k) evn[k] = *(const int4*)(EID + (size_t)tn * 128 + grp * 16 + 4 * k);
                        hqn = *(const int4*)(H2Q + (size_t)tn * 1024 + 128 * s + 16 * sub); }
                    gx::u_token(UQs, ev, hq, PA + ((size_t)s * T_ + t) * 128, F.lane);
                    t = tn; hq = hqn;
#pragma unroll
                    for (int k = 0; k < 4; ++k) ev[k] = evn[k];
                }
            }
        }
        SEAM(11);
        if (IN(12)) REP(12) {
            for (int t = F.gw; t < T_; t += F.NGW) {
                int i0 = 0, i1 = 0;
#pragma unroll
                for (int s = 0; s < 8; ++s) { const int2 p = *(const int2*)(PA + ((size_t)s * T_ + t) * 128 + 2 * F.lane); i0 += p.x; i1 += p.y; }
                const int2 e2 = *(const int2*)(EID + (size_t)t * 128 + 2 * F.lane); const float2 g2 = *(const float2*)(GATE + (size_t)t * 128 + 2 * F.lane); const float hs = HS[t];
                const float w0 = g2.x * gx::gelu_t((float)i0 * SU[e2.x] * hs) * SV[e2.x], w1 = g2.y * gx::gelu_t((float)i1 * SU[e2.y] * hs) * SV[e2.y];
                float wm = fmaxf(fabsf(w0), fabsf(w1));
#pragma unroll
                for (int o = 1; o < 64; o <<= 1) wm = fmaxf(wm, __shfl_xor(wm, o));
                const float inv = wm > 0.f ? 16256.f / wm : 0.f;
                const int q0 = (int)rintf(w0 * inv), q1 = (int)rintf(w1 * inv);
                const unsigned h2 = (unsigned)((q0 >> 7) & 255) | ((unsigned)((q1 >> 7) & 255) << 8), l2 = (unsigned)(q0 & 127) | ((unsigned)(q1 & 127) << 8);
                const unsigned h2p = __shfl_xor(h2, 1), l2p = __shfl_xor(l2, 1);
                if ((F.lane & 1) == 0) { WQH[(size_t)t * 32 + (F.lane >> 1)] = (int)(h2 | (h2p << 16)); WQL[(size_t)t * 32 + (F.lane >> 1)] = (int)(l2 | (l2p << 16)); }
                if (F.lane == 0) WSC[t] = wm * (1.f / 16256.f);
            }
        }
        SEAM(12);
        if (IN(13)) REP(13) {
            for (int s = vx; s < 8; s += ng) {
                const unsigned char* VQs = VQ + 128 * s + 16 * sub;
                int t = gwv; int4 ev[4]; int4 wh = make_int4(0, 0, 0, 0), wl = make_int4(0, 0, 0, 0); float wsc = 0.f;
#pragma unroll
                for (int k = 0; k < 4; ++k) ev[k] = make_int4(0, 0, 0, 0);
                if (t < T_) {
#pragma unroll
                    for (int k = 0; k < 4; ++k) ev[k] = *(const int4*)(EID + (size_t)t * 128 + grp * 16 + 4 * k);
                    wh = *(const int4*)(WQH + (size_t)t * 32 + grp * 4); wl = *(const int4*)(WQL + (size_t)t * 32 + grp * 4); wsc = WSC[t]; }
                while (t < T_) {
                    const int tn = t + ngwv; int4 evn[4]; int4 whn = make_int4(0, 0, 0, 0), wln = make_int4(0, 0, 0, 0); float wscn = 0.f;
#pragma unroll
                    for (int k = 0; k < 4; ++k) evn[k] = make_int4(0, 0, 0, 0);
                    if (tn < T_) {
#pragma unroll
                        for (int k = 0; k < 4; ++k) evn[k] = *(const int4*)(EID + (size_t)tn * 128 + grp * 16 + 4 * k);
                        whn = *(const int4*)(WQH + (size_t)tn * 32 + grp * 4); wln = *(const int4*)(WQL + (size_t)tn * 32 + grp * 4); wscn = WSC[tn]; }
                    float* dstrow = (PROBE_DUP == 13 && _r == 0) ? (float*)(ws + WS_XN) + (size_t)t * 1024 : out + (size_t)t * 1024;
                    gx::v_token(VQs, ev, wh, wl, wsc, MOD + (t / S_) * 6144 + 5 * 1024, out + (size_t)t * 1024, dstrow, s, F.lane);
                    t = tn; wh = whn; wl = wln; wsc = wscn;
#pragma unroll
                    for (int k = 0; k < 4; ++k) ev[k] = evn[k];
                }
            }
        }
    }
#undef IN
#undef SEAM
}

static int g_grid = 0;
static void launch_mega(const Args& base, int lo, int hi, int li, hipStream_t stream) {
    Args a = base; a.ph_lo = lo; a.ph_hi = hi; a.li = li;
    hipLaunchKernelGGL(mega_fwd, dim3(g_grid), dim3(NWAVES * 64), LDS_BYTES, stream, a);
}

extern "C" void kernel_launch(void* const* d_in, const int* in_sizes, int n_in, void* d_out, int out_size, void* d_ws, size_t ws_size, hipStream_t stream) {
    if (g_grid == 0) {
        int dev = 0, cus = 0;
        hipGetDevice(&dev); hipDeviceGetAttribute(&cus, hipDeviceAttributeMultiprocessorCount, dev);
        hipFuncSetAttribute((const void*)mega_fwd, hipFuncAttributeMaxDynamicSharedMemorySize, LDS_BYTES);
        int per_cu = 0; hipOccupancyMaxActiveBlocksPerMultiprocessor(&per_cu, (const void*)mega_fwd, NWAVES * 64, LDS_BYTES);
        (void)hipGetLastError();
        g_grid = cus > 0 ? cus : 256;
        if (per_cu < 1) fprintf(stderr, "kernel_launch: occupancy query says %d blocks/CU\n", per_cu);
    }
    const float* x = (const float*)d_in[0]; const int* positions = (const int*)d_in[2];
    const float* mla_qa_g = (const float*)d_in[7]; const float* mla_kva_g = (const float*)d_in[8];
    const float* mla_q_g = (const float*)d_in[11]; const float* mla_k_g = (const float*)d_in[12]; const float* fox_q_g = (const float*)d_in[13]; const float* fox_k_g = (const float*)d_in[14];
    const float* b_f = (const float*)d_in[15]; const float* sub_keys = (const float*)d_in[19]; const float* peer_u = (const float*)d_in[20]; const float* peer_v = (const float*)d_in[21];
    float* out = (float*)d_out; unsigned char* ws = (unsigned char*)d_ws;
    float* MOD = (float*)(ws + WS_MOD); float* FL = (float*)(ws + WS_FL); float* FCUM = (float*)(ws + WS_FCUM); float* LOGF = (float*)(ws + WS_LOGF); float2* ROPE = (float2*)(ws + WS_ROPE);
    bf16_t* XN = (bf16_t*)(ws + WS_XN); bf16_t* PROJ = (bf16_t*)(ws + WS_PROJ); bf16_t* KVRAW = (bf16_t*)(ws + WS_KVRAW); bf16_t* QA = (bf16_t*)(ws + WS_QA); bf16_t* KA = (bf16_t*)(ws + WS_KA);
    bf16_t* OB = XN; bf16_t* H2 = XN; bf16_t* QP = PROJ; int* EID = (int*)(ws + WS_QA); float* GATE = (float*)(ws + WS_QA + 16 * MiB);
    (void)x;
    hipMemsetAsync(ws + WS_CTL, 0, CTL_ZERO_BYTES, stream);
    Args base{}; for (int i = 0; i < 22; ++i) base.in[i] = d_in[i]; base.out = out; base.ws = ws;

    launch_mega(base, 0, 14, 0, stream);
}
```

```cpp
#include <hip/hip_runtime.h>
#ifndef PROBE_DUP
#define PROBE_DUP -1
#endif
#define REP(k) for (int _r = 0; _r < ((PROBE_DUP == (k)) ? 2 : 1); ++_r)
#include <cstdint>
#include <cstdio>
#include <cmath>

typedef unsigned short bf16_t;
constexpr int B_ = 4, S_ = 8192, D_ = 1024, T_ = B_ * S_;
constexpr int PP = 2304;
constexpr int C_CQ = 0, C_CKV = 384, C_KPE = 640, C_FQ = 672, C_FK = 1184, C_FV = 1696, C_FL = 2208, INW = 2216;
constexpr float EPS = 1e-6f;
constexpr float LOG2E = 1.4426950408889634f;
constexpr float C2A = 0.10206207261596577f * LOG2E;
constexpr float C2F = 0.125f * LOG2E;

__device__ __forceinline__ float bf2f(bf16_t v) { return __uint_as_float(((unsigned)v) << 16); }
__device__ __forceinline__ bf16_t f2bf(float f) { unsigned u = __float_as_uint(f); return (bf16_t)((u + 0x7fffu + ((u >> 16) & 1u)) >> 16); }
__device__ __forceinline__ unsigned pk2(float lo, float hi) { return (unsigned)f2bf(lo) | ((unsigned)f2bf(hi) << 16); }
__device__ __forceinline__ float lo2f(unsigned w) { return __uint_as_float(w << 16); }
__device__ __forceinline__ float hi2f(unsigned w) { return __uint_as_float(w & 0xffff0000u); }
__device__ __forceinline__ float wave_sum(float v) {
#pragma unroll
    for (int o = 1; o < 64; o <<= 1) v += __shfl_xor(v, o);
    return v;
}

constexpr size_t MiB = 1u << 20;
constexpr size_t WS_MOD = 1 * MiB;
constexpr size_t WS_FL = 3 * MiB;
constexpr size_t WS_FCUM = 4 * MiB;
constexpr size_t WS_LOGF = 5 * MiB;
constexpr size_t WS_ROPE = 6 * MiB;
constexpr size_t WS_XN = 88 * MiB;
constexpr size_t WS_PROJ = 152 * MiB;
constexpr size_t WS_KVRAW = 296 * MiB;
constexpr size_t WS_QA = 360 * MiB;
constexpr size_t WS_KA = 408 * MiB;

__global__ void k_mod(const float* c, const float* w_ada, const float* b_ada, float* mod) {
    const int j = blockIdx.x * 256 + threadIdx.x, b = blockIdx.y;
    float acc = b_ada[j];
    for (int k = 0; k < 1024; ++k) { const float cv = c[b * 1024 + k]; const float s = cv / (1.f + expf(-cv)); acc += s * w_ada[(size_t)k * 6144 + j]; }
    mod[b * 6144 + j] = acc;
}

__global__ void __launch_bounds__(256) k_modrows(const float* X, const float* g, const float* mod, int shift_idx, int scale_idx, bf16_t* out) {
    const int wave = threadIdx.x >> 6, lane = threadIdx.x & 63;
    const int row = blockIdx.x * 4 + wave, b = row / S_;
    const float4* xr = (const float4*)(X + (size_t)row * 1024) + lane;
    float4 v[4]; float ss = 0.f;
#pragma unroll
    for (int j = 0; j < 4; ++j) { v[j] = xr[64 * j]; ss += (v[j].x * v[j].x + v[j].y * v[j].y) + (v[j].z * v[j].z + v[j].w * v[j].w); }
    ss = wave_sum(ss);
    const float r = rsqrtf(ss * (1.f / 1024.f) + EPS);
    const float* sh = mod + b * 6144 + shift_idx * 1024; const float* sc = mod + b * 6144 + scale_idx * 1024;
#pragma unroll
    for (int j = 0; j < 4; ++j) {
        const int col = 4 * lane + 256 * j;
        const float4 g4 = *(const float4*)(g + col), s4 = *(const float4*)(sc + col), h4 = *(const float4*)(sh + col);
        const float o0 = v[j].x * r * g4.x * (1.f + s4.x) + h4.x, o1 = v[j].y * r * g4.y * (1.f + s4.y) + h4.y;
        const float o2 = v[j].z * r * g4.z * (1.f + s4.z) + h4.z, o3 = v[j].w * r * g4.w * (1.f + s4.w) + h4.w;
        uint2 w; w.x = pk2(o0, o1); w.y = pk2(o2, o3);
        *(uint2*)(out + (size_t)row * 1024 + col) = w;
    }
}

template <int MODE>
__global__ void __launch_bounds__(256) k_gemm_naive(const bf16_t* A, int lda, const float* W, int K, int N, void* Cout, int ldc, const float* aux1, const float* aux2, float* fl) {
    __shared__ float As[16][64];
    __shared__ float Ws[16][64];
    const int tx = threadIdx.x & 15, ty = threadIdx.x >> 4;
    const int m0 = blockIdx.y * 64, n0 = blockIdx.x * 64;
    float acc[4][4];
#pragma unroll
    for (int i = 0; i < 4; ++i)
#pragma unroll
        for (int j = 0; j < 4; ++j) acc[i][j] = 0.f;
    for (int k0 = 0; k0 < K; k0 += 16) {
        { const int r = threadIdx.x >> 2, kq = (threadIdx.x & 3) * 4; const uint2 a2 = *(const uint2*)(A + (size_t)(m0 + r) * lda + k0 + kq);
          As[kq + 0][r] = lo2f(a2.x); As[kq + 1][r] = hi2f(a2.x); As[kq + 2][r] = lo2f(a2.y); As[kq + 3][r] = hi2f(a2.y); }
        { const int kk = threadIdx.x >> 4, nq = (threadIdx.x & 15) * 4; float4 w4 = make_float4(0.f, 0.f, 0.f, 0.f);
          if (n0 + nq < N) w4 = *(const float4*)(W + (size_t)(k0 + kk) * N + n0 + nq);
          *(float4*)&Ws[kk][nq] = w4; }
        __syncthreads();
#pragma unroll
        for (int kk = 0; kk < 16; ++kk) {
            const float4 a4 = *(const float4*)&As[kk][ty * 4]; const float4 w4 = *(const float4*)&Ws[kk][tx * 4];
            const float a[4] = {a4.x, a4.y, a4.z, a4.w}; const float w[4] = {w4.x, w4.y, w4.z, w4.w};
#pragma unroll
            for (int i = 0; i < 4; ++i)
#pragma unroll
                for (int j = 0; j < 4; ++j) acc[i][j] += a[i] * w[j];
        }
        __syncthreads();
    }
#pragma unroll
    for (int i = 0; i < 4; ++i) {
        const int m = m0 + ty * 4 + i;
#pragma unroll
        for (int j = 0; j < 4; ++j) {
            const int n = n0 + tx * 4 + j;
            if (n < N) {
                if (MODE == 0) ((bf16_t*)Cout)[(size_t)m * ldc + n] = f2bf(acc[i][j]);
                else if (MODE == 1) { if (n < C_FL) ((bf16_t*)Cout)[(size_t)m * ldc + n] = f2bf(acc[i][j]); else fl[(size_t)m * 8 + (n - C_FL)] = acc[i][j]; }
                else { const int b = m / S_; ((float*)Cout)[(size_t)m * ldc + n] = aux1[(size_t)m * 1024 + n] + aux2[b * 6144 + 2 * 1024 + n] * acc[i][j]; }
            }
        }
    }
}

__device__ __forceinline__ void unpack8(const uint4 raw, float* v) {
    v[0] = lo2f(raw.x); v[1] = hi2f(raw.x); v[2] = lo2f(raw.y); v[3] = hi2f(raw.y); v[4] = lo2f(raw.z); v[5] = hi2f(raw.z); v[6] = lo2f(raw.w); v[7] = hi2f(raw.w);
}
struct RowPrepIn { uint4 cq, ckv, fq, fk; float fl; int pos; };
__device__ __forceinline__ void rowprep_load(RowPrepIn& R, const bf16_t* PROJ, const float* FL, const int* positions, int row, int lane) {
    const bf16_t* pr = PROJ + (size_t)row * PP;
    R.cq = lane < 48 ? *(const uint4*)(pr + C_CQ + lane * 8) : make_uint4(0u, 0u, 0u, 0u);
    R.ckv = lane < 32 ? *(const uint4*)(pr + C_CKV + lane * 8) : make_uint4(0u, 0u, 0u, 0u);
    R.fq = *(const uint4*)(pr + C_FQ + lane * 8); R.fk = *(const uint4*)(pr + C_FK + lane * 8);
    R.fl = lane < 8 ? FL[(size_t)row * 8 + lane] : 0.f; R.pos = positions[row];
}
__device__ __forceinline__ uint4 scale8(const float* v, float r, const float* g) {
    uint4 o; o.x = pk2(v[0] * r * g[0], v[1] * r * g[1]); o.y = pk2(v[2] * r * g[2], v[3] * r * g[3]); o.z = pk2(v[4] * r * g[4], v[5] * r * g[5]); o.w = pk2(v[6] * r * g[6], v[7] * r * g[7]); return o;
}
__device__ __forceinline__ void rowprep_finish(const RowPrepIn& R, bf16_t* PROJ, const float* g_qa, const float* g_kva, const float* g_fq, const float* g_fk, const float* b_f,
                                               float* LOGF, float2* ROPE, int row, int lane) {
    bf16_t* pr = PROJ + (size_t)row * PP;
    float vq[8], vk[8], v1[8], v2[8];
    unpack8(R.cq, vq); unpack8(R.ckv, vk); unpack8(R.fq, v1); unpack8(R.fk, v2);
    float sq = 0.f, sk = 0.f, s1 = 0.f, s2 = 0.f;
#pragma unroll
    for (int i = 0; i < 8; ++i) { sq += vq[i] * vq[i]; sk += vk[i] * vk[i]; s1 += v1[i] * v1[i]; s2 += v2[i] * v2[i]; }
    s1 += __shfl_xor(s1, 1); s2 += __shfl_xor(s2, 1); s1 += __shfl_xor(s1, 2); s2 += __shfl_xor(s2, 2); s1 += __shfl_xor(s1, 4); s2 += __shfl_xor(s2, 4);
#pragma unroll
    for (int o = 1; o < 64; o <<= 1) { sq += __shfl_xor(sq, o); sk += __shfl_xor(sk, o); }
    const float rq = rsqrtf(sq * (1.f / 384.f) + EPS), rk = rsqrtf(sk * (1.f / 256.f) + EPS);
    const float r1 = rsqrtf(s1 * (1.f / 64.f) + EPS) * C2F, r2 = rsqrtf(s2 * (1.f / 64.f) + EPS);
    if (lane < 48) *(uint4*)(pr + C_CQ + lane * 8) = scale8(vq, rq, g_qa + lane * 8);
    if (lane < 32) *(uint4*)(pr + C_CKV + lane * 8) = scale8(vk, rk, g_kva + lane * 8);
    *(uint4*)(pr + C_FQ + lane * 8) = scale8(v1, r1, g_fq + (lane & 7) * 8);
    *(uint4*)(pr + C_FK + lane * 8) = scale8(v2, r2, g_fk + (lane & 7) * 8);
    if (lane < 8) { const float z = R.fl + b_f[lane]; LOGF[((size_t)(row / S_) * 8 + lane) * S_ + (row % S_)] = fminf(z, 0.f) - log1pf(expf(-fabsf(z))); }
    if (lane < 16) {
        const float invf = (float)exp2(-(double)lane * (13.287712379549449 / 16.0));
        const double a = (double)((float)R.pos * invf), n = rint(a * 0.15915494309189535);
        const float red = (float)(a - n * 6.283185307179586);
        ROPE[(size_t)row * 16 + lane] = make_float2(__cosf(red), __sinf(red)); }
}
__device__ __forceinline__ void rowprep_row(bf16_t* PROJ, const float* FL, const float* g_qa, const float* g_kva, const float* g_fq, const float* g_fk, const float* b_f,
                                                 const int* positions, float* LOGF, float2* ROPE, int row, int lane) {
    RowPrepIn R; rowprep_load(R, PROJ, FL, positions, row, lane); rowprep_finish(R, PROJ, g_qa, g_kva, g_fq, g_fk, b_f, LOGF, ROPE, row, lane);
}
__global__ void __launch_bounds__(256) k_rowprep(bf16_t* PROJ, const float* FL, const float* g_qa, const float* g_kva, const float* g_fq, const float* g_fk, const float* b_f,
                                                 const int* positions, float* LOGF, float2* ROPE) {
    rowprep_row(PROJ, FL, g_qa, g_kva, g_fq, g_fk, b_f, positions, LOGF, ROPE, blockIdx.x * 4 + (threadIdx.x >> 6), threadIdx.x & 63);
}

__device__ __forceinline__ void fcum_item(const float* LOGF, float* FCUM, int item, int lane) {
    const float4* src = (const float4*)(LOGF + (size_t)item * S_ + 128 * lane);
    float4 v[32]; float tot = 0.f;
#pragma unroll
    for (int i = 0; i < 32; ++i) v[i] = src[i];
#pragma unroll
    for (int i = 0; i < 32; ++i) tot += (v[i].x + v[i].y) + (v[i].z + v[i].w);
    float incl = tot;
#pragma unroll
    for (int o = 1; o < 64; o <<= 1) { const float t = __shfl_up(incl, o); if (lane >= o) incl += t; }
    float run = incl - tot;
    float4* dst = (float4*)(FCUM + (size_t)item * S_ + 128 * lane);
#pragma unroll
    for (int i = 0; i < 32; ++i) { float4 o; run += v[i].x; o.x = run; run += v[i].y; o.y = run; run += v[i].z; o.z = run; run += v[i].w; o.w = run; dst[i] = o; }
}
__global__ void __launch_bounds__(64) k_fcum(const float* LOGF, float* FCUM) { fcum_item(LOGF, FCUM, blockIdx.x, threadIdx.x); }

struct MlaIn { uint4 qn, kn; unsigned q1, q2, k1, k2; float2 cs0, cs1; };
__device__ __forceinline__ void mlaprep_load(MlaIn& M, const bf16_t* QRAW, const bf16_t* KVRAW, const bf16_t* PROJ, const float2* ROPE, int row, int lane) {
    const int h = lane >> 3, p = lane & 7;
    const bf16_t* q = QRAW + (size_t)row * 768 + h * 96; const bf16_t* kp = PROJ + (size_t)row * PP + C_KPE;
    M.qn = *(const uint4*)(q + 8 * p); M.q1 = *(const unsigned*)(q + 64 + 2 * p); M.q2 = *(const unsigned*)(q + 80 + 2 * p);
    M.kn = *(const uint4*)(KVRAW + (size_t)row * 1024 + h * 128 + 8 * p); M.k1 = *(const unsigned*)(kp + 2 * p); M.k2 = *(const unsigned*)(kp + 16 + 2 * p);
    M.cs0 = ROPE[(size_t)row * 16 + 2 * p]; M.cs1 = ROPE[(size_t)row * 16 + 2 * p + 1];
}
__device__ __forceinline__ void mlaprep_finish(const MlaIn& M, bf16_t* QRAW, bf16_t* KA, const float* g_q, const float* g_k, int row, int lane) {
    const int h = lane >> 3, p = lane & 7;
#pragma unroll
    for (int which = 0; which < 2; ++which) {
        const float* g = which == 0 ? g_q : g_k; const float sc = which == 0 ? C2A : 1.f;
        float v[8]; unpack8(which == 0 ? M.qn : M.kn, v); const unsigned r1 = which == 0 ? M.q1 : M.k1, r2 = which == 0 ? M.q2 : M.k2;
        float a0 = lo2f(r1), a1 = hi2f(r1), b0 = lo2f(r2), b1 = hi2f(r2);
        float ss = a0 * a0 + a1 * a1 + b0 * b0 + b1 * b1;
#pragma unroll
        for (int i = 0; i < 8; ++i) ss += v[i] * v[i];
        ss += __shfl_xor(ss, 1); ss += __shfl_xor(ss, 2); ss += __shfl_xor(ss, 4);
        const float r = rsqrtf(ss * (1.f / 96.f) + EPS);
        const float* gn = g + 8 * p;
        a0 *= r * g[64 + 2 * p]; a1 *= r * g[64 + 2 * p + 1]; b0 *= r * g[80 + 2 * p]; b1 *= r * g[80 + 2 * p + 1];
        const float ra0 = a0 * M.cs0.x - b0 * M.cs0.y, rb0 = b0 * M.cs0.x + a0 * M.cs0.y, ra1 = a1 * M.cs1.x - b1 * M.cs1.y, rb1 = b1 * M.cs1.x + a1 * M.cs1.y;
        uint4 o; o.x = pk2(v[0] * r * gn[0] * sc, v[1] * r * gn[1] * sc); o.y = pk2(v[2] * r * gn[2] * sc, v[3] * r * gn[3] * sc);
        o.z = pk2(v[4] * r * gn[4] * sc, v[5] * r * gn[5] * sc); o.w = pk2(v[6] * r * gn[6] * sc, v[7] * r * gn[7] * sc);
        bf16_t* dst = (which == 0 ? QRAW : KA) + (size_t)row * 768 + h * 96;
        *(uint4*)(dst + 8 * p) = o; *(unsigned*)(dst + 64 + 2 * p) = pk2(ra0 * sc, ra1 * sc); *(unsigned*)(dst + 80 + 2 * p) = pk2(rb0 * sc, rb1 * sc);
    }
}
__device__ __forceinline__ void mlaprep_row(bf16_t* QRAW, const bf16_t* KVRAW, const bf16_t* PROJ, bf16_t* KA, const float2* ROPE, const float* g_q, const float* g_k, int row, int lane) {
    MlaIn M; mlaprep_load(M, QRAW, KVRAW, PROJ, ROPE, row, lane); mlaprep_finish(M, QRAW, KA, g_q, g_k, row, lane);
}

__global__ void __launch_bounds__(256) k_mlaprep(bf16_t* QRAW, const bf16_t* KVRAW, const bf16_t* PROJ, bf16_t* KA, const float2* ROPE, const float* g_q, const float* g_k) {
    mlaprep_row(QRAW, KVRAW, PROJ, KA, ROPE, g_q, g_k, blockIdx.x * 4 + (threadIdx.x >> 6), threadIdx.x & 63);
}

template <int DK>
__global__ void __launch_bounds__(256) k_attn_naive(const bf16_t* Q, int pq, int qstep, const bf16_t* K, int pk, int kstep, const bf16_t* V, int pv, int vstep, bf16_t* O, int po, int ostep, const float* FCUM) {
    __shared__ float Ks[64][DK];
    __shared__ float Vs[64][64];
    __shared__ float Bs[64];
    const int bh = blockIdx.x >> 5, qb = blockIdx.x & 31, b = bh >> 3, h = bh & 7;
    const int t = qb * 256 + threadIdx.x;
    const size_t row = (size_t)b * S_ + t;
    float q[DK];
#pragma unroll
    for (int c = 0; c < DK / 8; ++c) unpack8(*(const uint4*)(Q + row * pq + h * qstep + c * 8), q + c * 8);
    float o[64];
#pragma unroll
    for (int d = 0; d < 64; ++d) o[d] = 0.f;
    float m = -INFINITY, l = 0.f;
    const float fq = FCUM ? FCUM[(size_t)(b * 8 + h) * S_ + t] : 0.f;
    const int ntiles = (qb * 256 + 256) / 64;
    for (int kt = 0; kt < ntiles; ++kt) {
        __syncthreads();
        for (int c = threadIdx.x; c < 64 * (DK / 8); c += 256) { const int key = c / (DK / 8), ch = c % (DK / 8); float v[8];
            unpack8(*(const uint4*)(K + ((size_t)b * S_ + kt * 64 + key) * pk + h * kstep + ch * 8), v);
#pragma unroll
            for (int i = 0; i < 8; ++i) Ks[key][ch * 8 + i] = v[i]; }
        for (int c = threadIdx.x; c < 64 * 8; c += 256) { const int key = c >> 3, ch = c & 7; float v[8];
            unpack8(*(const uint4*)(V + ((size_t)b * S_ + kt * 64 + key) * pv + h * vstep + ch * 8), v);
#pragma unroll
            for (int i = 0; i < 8; ++i) Vs[key][ch * 8 + i] = v[i]; }
        if (threadIdx.x < 64) Bs[threadIdx.x] = FCUM ? FCUM[(size_t)(b * 8 + h) * S_ + kt * 64 + threadIdx.x] : 0.f;
        __syncthreads();
        const int kmax = t - kt * 64 + 1;
        for (int kk = 0; kk < 64; ++kk) {
            float s = 0.f;
#pragma unroll
            for (int d = 0; d < DK; ++d) s += q[d] * Ks[kk][d];
            if (FCUM) s += (fq - Bs[kk]) * LOG2E;
            if (kk < kmax) {
                const float mn = fmaxf(m, s), corr = exp2f(m - mn), p = exp2f(s - mn);
                l = l * corr + p;
#pragma unroll
                for (int d = 0; d < 64; ++d) o[d] = o[d] * corr + p * Vs[kk][d];
                m = mn;
            }
        }
    }
    const float rl = 1.f / l;
    bf16_t* op = O + row * po + h * ostep;
#pragma unroll
    for (int c = 0; c < 8; ++c) { uint4 w; w.x = pk2(o[c * 8 + 0] * rl, o[c * 8 + 1] * rl); w.y = pk2(o[c * 8 + 2] * rl, o[c * 8 + 3] * rl); w.z = pk2(o[c * 8 + 4] * rl, o[c * 8 + 5] * rl); w.w = pk2(o[c * 8 + 6] * rl, o[c * 8 + 7] * rl);
        *(uint4*)(op + c * 8) = w; }
}

__device__ __forceinline__ void topk_item(const bf16_t* QP, const float* sub_keys, int* EID, float* GATE, int w, int lane) {
    const int t = w >> 3, h = w & 7;
    float sl0 = 0.f, sl1 = 0.f; int il0 = 0, il1 = 0;
#pragma unroll
    for (int p = 0; p < 2; ++p) {
        const bf16_t* q = QP + (size_t)t * 2048 + h * 256 + p * 128;
        const float* k0 = sub_keys + ((size_t)(h * 2 + p) * 128 + lane) * 128; const float* k1 = k0 + 64 * 128;
        float s0 = 0.f, s1 = 0.f;
        for (int d = 0; d < 128; ++d) { const float qd = bf2f(q[d]); s0 += qd * k0[d]; s1 += qd * k1[d]; }
        float ls = 0.f; int li = 0;
        for (int r = 0; r < 16; ++r) {
            float bv; int bi; if (s0 >= s1) { bv = s0; bi = lane; } else { bv = s1; bi = lane + 64; }
#pragma unroll
            for (int o = 32; o >= 1; o >>= 1) { const float ov = __shfl_xor(bv, o); const int oi = __shfl_xor(bi, o); if (ov > bv || (ov == bv && oi < bi)) { bv = ov; bi = oi; } }
            if (lane == r) { ls = bv; li = bi; }
            if (bi == lane) s0 = -INFINITY; else if (bi == lane + 64) s1 = -INFINITY;
        }
        if (p == 0) { sl0 = ls; il0 = li; } else { sl1 = ls; il1 = li; }
    }
    float cv0, cv1, cv2, cv3;
    { const int c0 = lane, c1 = lane + 64, c2 = lane + 128, c3 = lane + 192;
      cv0 = __shfl(sl0, c0 >> 4) + __shfl(sl1, c0 & 15); cv1 = __shfl(sl0, c1 >> 4) + __shfl(sl1, c1 & 15);
      cv2 = __shfl(sl0, c2 >> 4) + __shfl(sl1, c2 & 15); cv3 = __shfl(sl0, c3 >> 4) + __shfl(sl1, c3 & 15); }
    float tv = -INFINITY; int tc = 0;
    for (int r = 0; r < 16; ++r) {
        float bv = cv0; int bc = lane;
        if (cv1 > bv) { bv = cv1; bc = lane + 64; }
        if (cv2 > bv) { bv = cv2; bc = lane + 128; }
        if (cv3 > bv) { bv = cv3; bc = lane + 192; }
#pragma unroll
        for (int o = 32; o >= 1; o >>= 1) { const float ov = __shfl_xor(bv, o); const int oc = __shfl_xor(bc, o); if (ov > bv || (ov == bv && oc < bc)) { bv = ov; bc = oc; } }
        if (lane == r) { tv = bv; tc = bc; }
        if (bc == lane) cv0 = -INFINITY; else if (bc == lane + 64) cv1 = -INFINITY; else if (bc == lane + 128) cv2 = -INFINITY; else if (bc == lane + 192) cv3 = -INFINITY;
    }
    const float mx = __shfl(tv, 0);
    const float e = lane < 16 ? expf(tv - mx) : 0.f;
    const float sum = wave_sum(e);
    const int e1 = __shfl(il0, (tc >> 4) & 15), e2 = __shfl(il1, tc & 15);
    if (lane < 16) { EID[(size_t)t * 128 + h * 16 + lane] = e1 * 128 + e2; GATE[(size_t)t * 128 + h * 16 + lane] = e / sum; }
}

__global__ void __launch_bounds__(256) k_topk_naive(const bf16_t* QP, const float* sub_keys, int* EID, float* GATE) { topk_item(QP, sub_keys, EID, GATE, blockIdx.x * 4 + (threadIdx.x >> 6), threadIdx.x & 63); }

__device__ __forceinline__ float gelu_tanh(float x) { const float u = 0.7978845608028654f * (x + 0.044715f * x * x * x); return 0.5f * x * (1.f + tanhf(u)); }

__device__ __forceinline__ void gather_item(const bf16_t* H2, const int* EID, const float* GATE, const float* peer_u, const float* peer_v, const float* mod, float* out, int t, int lane) {
    const int b = t / S_;
    float hv[16], y[16];
#pragma unroll
    for (int j = 0; j < 4; ++j) { const uint2 raw = *(const uint2*)(H2 + (size_t)t * 1024 + 4 * lane + 256 * j); hv[4 * j] = lo2f(raw.x); hv[4 * j + 1] = hi2f(raw.x); hv[4 * j + 2] = lo2f(raw.y); hv[4 * j + 3] = hi2f(raw.y); }
#pragma unroll
    for (int i = 0; i < 16; ++i) y[i] = 0.f;
    const int e_a = EID[(size_t)t * 128 + lane], e_b = EID[(size_t)t * 128 + 64 + lane];
    const float g_a = GATE[(size_t)t * 128 + lane], g_b = GATE[(size_t)t * 128 + 64 + lane];
    for (int jj = 0; jj < 128; ++jj) {
        const int e = jj < 64 ? __shfl(e_a, jj) : __shfl(e_b, jj - 64);
        const float g = jj < 64 ? __shfl(g_a, jj) : __shfl(g_b, jj - 64);
        const float4* ur = (const float4*)(peer_u + (size_t)e * 1024) + lane;
        float s = 0.f;
#pragma unroll
        for (int j = 0; j < 4; ++j) { const float4 u4 = ur[64 * j]; s += (u4.x * hv[4 * j] + u4.y * hv[4 * j + 1]) + (u4.z * hv[4 * j + 2] + u4.w * hv[4 * j + 3]); }
        s = wave_sum(s);
        const float wgt = g * gelu_tanh(s);
        const float4* vr = (const float4*)(peer_v + (size_t)e * 1024) + lane;
#pragma unroll
        for (int j = 0; j < 4; ++j) { const float4 v4 = vr[64 * j]; y[4 * j] += wgt * v4.x; y[4 * j + 1] += wgt * v4.y; y[4 * j + 2] += wgt * v4.z; y[4 * j + 3] += wgt * v4.w; }
    }
    const float* g2 = mod + b * 6144 + 5 * 1024;
#pragma unroll
    for (int j = 0; j < 4; ++j) { const int col = 4 * lane + 256 * j; float4* op = (float4*)(out + (size_t)t * 1024 + col); float4 x1 = *op; const float4 gg = *(const float4*)(g2 + col);
        x1.x += gg.x * y[4 * j]; x1.y += gg.y * y[4 * j + 1]; x1.z += gg.z * y[4 * j + 2]; x1.w += gg.w * y[4 * j + 3]; *op = x1; }
}
__global__ void __launch_bounds__(256) k_gather_naive(const bf16_t* H2, const int* EID, const float* GATE, const float* peer_u, const float* peer_v, const float* mod, float* out) {
    gather_item(H2, EID, GATE, peer_u, peer_v, mod, out, blockIdx.x * 4 + (threadIdx.x >> 6), threadIdx.x & 63);
}


namespace pg8 {
#define PG8_LAS __attribute__((address_space(3)))
typedef unsigned short bf16_t;
typedef short bf16x8 __attribute__((ext_vector_type(8)));
typedef float f32x4 __attribute__((ext_vector_type(4)));
typedef unsigned u32x4 __attribute__((ext_vector_type(4)));
constexpr int BM = 256, BK = 64, HALF = 128, HTB = HALF * BK * 2  , STAGE_BYTES = 8 * HTB, NXCD = 8, WGM = 8;

__host__ __device__ __forceinline__ int lds_byte(int r, int c) { const int st = (r >> 4) * 2 + (c >> 5), rr = r & 15, cc = c & 31, ob = rr * 64 + cc * 2; return st * 1024 + (ob ^ (((ob >> 9) & 1) << 5)); }
__host__ __device__ __forceinline__ void stage_rc(int b, int& R, int& C) { const int st = b / 1024, sb = b % 1024, swz = sb ^ (((sb >> 9) & 1) << 5); R = (st >> 1) * 16 + swz / 64; C = (st & 1) * 32 + (swz % 64) / 2; }
__host__ __device__ __forceinline__ int perm32(int rho) { const int n = rho >> 4, i = rho & 15; return 8 * (i >> 2) + 4 * n + (i & 3); }

struct Unit { int pm, pn; };
struct Gemm { const bf16_t* A; const bf16_t* Bt; int M, N, K, lda; };

struct StaticOrder {
    int nM, nN, nwg, G, c;
    __host__ __device__ void init(int M, int N, int G_, int c_) { nM = M / BM; nN = N / BM; nwg = nM * nN; G = G_; c = c_; }
    __host__ __device__ bool next(int i, Unit& u) const {
        const long L = (long)i * G + c; if (L >= nwg) return false;
        int wgid = (int)L; { const int q = nwg / NXCD, r = nwg % NXCD, xcd = wgid % NXCD, off = wgid / NXCD; wgid = (xcd < r ? xcd * (q + 1) : r * (q + 1) + (xcd - r) * q) + off; }
        const int nig = WGM * nN, gid = wgid / nig, fm = gid * WGM, gsz = (nM - fm) < WGM ? (nM - fm) : WGM;
        u.pm = fm + ((wgid % nig) % gsz); u.pn = (wgid % nig) / gsz; return true;
    }
    __device__ __forceinline__ void a_ready(const Unit&) const {}
    __device__ __forceinline__ void done(const Unit&) const {}
};
__device__ __forceinline__ unsigned cvt_pk_bf16(float lo, float hi) { unsigned r; asm volatile("v_cvt_pk_bf16_f32 %0, %1, %2" : "=v"(r) : "v"(lo), "v"(hi)); return r; }
typedef float f32x2 __attribute__((ext_vector_type(2)));
template <class Epi, class Sched, bool ALIGN_EPI = false, bool SP2 = false>
__device__ __forceinline__ void gemm_phase(PG8_LAS unsigned char* lds, const Gemm g, const Sched& S, const Epi& E) {
    const int tid = threadIdx.x, wid = __builtin_amdgcn_readfirstlane(tid >> 6), lane = tid & 63, wr = wid >> 2, wc = wid & 3, fr = lane & 15, fq = lane >> 4;
    const int K = g.K, nt = K / BK;
    unsigned voffA[2], voffB[2];
#pragma unroll
    for (int i = 0; i < 2; ++i) { int R, C; stage_rc(tid * 16 + i * 8192, R, C); const int Rb = Epi::PERM ? ((R & ~31) + perm32(R & 31)) : R;
        voffA[i] = (unsigned)(R * g.lda + C) * 2u; voffB[i] = (unsigned)(Rb * K + C) * 2u; }
    const size_t kstep = (size_t)(BK * 2);
    const size_t hstepA = (size_t)HALF * g.lda * 2, hstepB = (size_t)HALF * K * 2;
    const size_t tstepA = 2 * hstepA, tstepB = 2 * hstepB;
    const unsigned ldsw = (unsigned)wid * 1024u;
    const int aoff = lds_byte(wr * 64 + fr, fq * 8), boff = lds_byte(wc * 32 + fr, fq * 8);
#define PG8_SA(b, h) (((b) * 2 + (h)) * HTB)
#define PG8_SB(b, h) ((4 + (b) * 2 + (h)) * HTB)
#define PG8_STAGE(bufoff, gbase, voff) do { _Pragma("unroll") for (int _i = 0; _i < 2; ++_i) \
        __builtin_amdgcn_global_load_lds((const unsigned*)((const char*)(gbase) + (voff)[_i]), (PG8_LAS unsigned*)(lds + (bufoff) + ldsw + _i * 8192), 16, 0, 0); } while (0)
#define PG8_LDA(dst, b, h) do { _Pragma("unroll") for (int m = 0; m < 4; ++m) _Pragma("unroll") for (int k = 0; k < 2; ++k) dst[m][k] = *(const PG8_LAS bf16x8*)(lds + PG8_SA(b, h) + aoff + m * 2048 + k * 1024); } while (0)
#define PG8_LDB(dst, b, h) do { _Pragma("unroll") for (int n = 0; n < 2; ++n) _Pragma("unroll") for (int k = 0; k < 2; ++k) dst[n][k] = *(const PG8_LAS bf16x8*)(lds + PG8_SB(b, h) + boff + n * 2048 + k * 1024); } while (0)
#define PG8_MMA(ai, bj, At, Bt) do { __builtin_amdgcn_s_setprio(1); _Pragma("unroll") for (int m = 0; m < 4; ++m) _Pragma("unroll") for (int n = 0; n < 2; ++n) _Pragma("unroll") for (int k = 0; k < 2; ++k) \
        acc[ai][bj][m][n] = __builtin_amdgcn_mfma_f32_16x16x32_bf16(Bt[n][k], At[m][k], acc[ai][bj][m][n], 0, 0, 0); __builtin_amdgcn_s_setprio(0); } while (0)
#define PG8_WAIT_V(n) asm volatile("s_waitcnt vmcnt(" #n ")" ::: "memory")
#define PG8_WAIT_L(n) asm volatile("s_waitcnt lgkmcnt(" #n ")" ::: "memory")
#define PG8_BAR __builtin_amdgcn_s_barrier()
#define PG8_SCHED __builtin_amdgcn_sched_barrier(0)
    Unit cur, nxt; int ui = 0;
    if (!S.next(0, cur)) return;
    f32x4 acc[2][2][4][2];
#pragma unroll
    for (int a = 0; a < 2; ++a)
#pragma unroll
        for (int b = 0; b < 2; ++b)
#pragma unroll
            for (int m = 0; m < 4; ++m)
#pragma unroll
                for (int n = 0; n < 2; ++n) acc[a][b][m][n] = (f32x4){0.f, 0.f, 0.f, 0.f};
    bf16x8 At[4][2], B0[2][2], B1[2][2];
    const char* cA = (const char*)g.A + (size_t)cur.pm * tstepA; const char* cB = (const char*)g.Bt + (size_t)cur.pn * tstepB;
    S.a_ready(cur);
    if constexpr (SP2) {
        PG8_STAGE(PG8_SB(0, 0), cB, voffB); PG8_STAGE(PG8_SB(0, 1), cB + hstepB, voffB); PG8_STAGE(PG8_SA(0, 0), cA, voffA); PG8_STAGE(PG8_SA(0, 1), cA + hstepA, voffA);
        if (wr == 1) PG8_BAR;
        PG8_WAIT_V(2); PG8_BAR;
        PG8_STAGE(PG8_SB(1, 0), cB + kstep, voffB); PG8_STAGE(PG8_SA(1, 0), cA + kstep, voffA); PG8_STAGE(PG8_SB(1, 1), cB + hstepB + kstep, voffB);
        PG8_WAIT_V(6); PG8_BAR;
    } else {
        PG8_STAGE(PG8_SB(0, 0), cB, voffB); PG8_STAGE(PG8_SA(0, 0), cA, voffA); PG8_STAGE(PG8_SB(0, 1), cB + hstepB, voffB); PG8_STAGE(PG8_SA(0, 1), cA + hstepA, voffA);
        if (wr == 1) PG8_BAR;
        PG8_WAIT_V(4); PG8_BAR;
        PG8_STAGE(PG8_SB(1, 0), cB + kstep, voffB); PG8_STAGE(PG8_SA(1, 0), cA + kstep, voffA); PG8_STAGE(PG8_SB(1, 1), cB + hstepB + kstep, voffB);
        PG8_WAIT_V(6); PG8_BAR;
    }
    for (;;) {
        const bool has_next = S.next(ui + 1, nxt);
        const char* nA = has_next ? (const char*)g.A + (size_t)nxt.pm * tstepA : cA; const char* nB = has_next ? (const char*)g.Bt + (size_t)nxt.pn * tstepB : cB;
        for (int t = 0; t < nt; t += 2) {
            const bool last = (t == nt - 2);
            const char* a1 = cA + (size_t)(t + 1) * kstep;
            const char* a2 = last ? nA : cA + (size_t)(t + 2) * kstep; const char* b2 = last ? nB : cB + (size_t)(t + 2) * kstep;
            const char* a3 = a2 + kstep; const char* b3 = b2 + kstep;
            if (last && has_next) S.a_ready(nxt);
            if constexpr (SP2) {
            PG8_LDB(B0, 0, 0); PG8_LDB(B1, 0, 1); PG8_SCHED; PG8_LDA(At, 0, 0); PG8_STAGE(PG8_SA(1, 1), a1 + hstepA, voffA);
            PG8_WAIT_V(8); PG8_WAIT_L(0); PG8_BAR; PG8_MMA(0, 0, At, B0); PG8_MMA(0, 1, At, B1); PG8_BAR; PG8_SCHED;
            PG8_LDA(At, 0, 1); PG8_STAGE(PG8_SB(0, 0), b2, voffB); PG8_STAGE(PG8_SB(0, 1), b2 + hstepB, voffB); PG8_STAGE(PG8_SA(0, 0), a2, voffA);
            PG8_WAIT_V(8); PG8_WAIT_L(0); PG8_BAR; PG8_MMA(1, 0, At, B0); PG8_MMA(1, 1, At, B1); PG8_BAR; PG8_SCHED;
            PG8_LDB(B0, 1, 0); PG8_LDB(B1, 1, 1); PG8_SCHED; PG8_LDA(At, 1, 0); PG8_STAGE(PG8_SA(0, 1), a2 + hstepA, voffA);
            PG8_WAIT_V(8); PG8_WAIT_L(0); PG8_BAR; PG8_MMA(0, 0, At, B0); PG8_MMA(0, 1, At, B1); PG8_BAR; PG8_SCHED;
            PG8_LDA(At, 1, 1); PG8_STAGE(PG8_SB(1, 0), b3, voffB); PG8_STAGE(PG8_SB(1, 1), b3 + hstepB, voffB); PG8_STAGE(PG8_SA(1, 0), a3, voffA);
            PG8_WAIT_V(8); PG8_WAIT_L(0); PG8_BAR; PG8_MMA(1, 0, At, B0); PG8_MMA(1, 1, At, B1); PG8_BAR; PG8_SCHED;
            } else {
            PG8_LDB(B0, 0, 0); PG8_SCHED; PG8_LDA(At, 0, 0); PG8_STAGE(PG8_SA(1, 1), a1 + hstepA, voffA);
            PG8_WAIT_L(8); PG8_BAR; PG8_WAIT_L(0); PG8_MMA(0, 0, At, B0); PG8_BAR; PG8_SCHED;
            PG8_LDB(B1, 0, 1); PG8_STAGE(PG8_SB(0, 0), b2, voffB);
            PG8_BAR; PG8_WAIT_L(0); PG8_MMA(0, 1, At, B1); PG8_BAR;
            PG8_LDA(At, 0, 1); PG8_STAGE(PG8_SA(0, 0), a2, voffA);
            PG8_BAR; PG8_WAIT_L(0); PG8_MMA(1, 0, At, B0); PG8_BAR; PG8_SCHED;
            PG8_STAGE(PG8_SB(0, 1), b2 + hstepB, voffB);
            PG8_WAIT_V(6); PG8_BAR; PG8_MMA(1, 1, At, B1); PG8_BAR;
            PG8_LDB(B0, 1, 0); PG8_SCHED; PG8_LDA(At, 1, 0); PG8_STAGE(PG8_SA(0, 1), a2 + hstepA, voffA);
            PG8_WAIT_L(8); PG8_BAR; PG8_WAIT_L(0); PG8_MMA(0, 0, At, B0); PG8_BAR; PG8_SCHED;
            PG8_LDB(B1, 1, 1); PG8_STAGE(PG8_SB(1, 0), b3, voffB);
            PG8_BAR; PG8_WAIT_L(0); PG8_MMA(0, 1, At, B1); PG8_BAR;
            PG8_LDA(At, 1, 1); PG8_STAGE(PG8_SA(1, 0), a3, voffA);
            PG8_BAR; PG8_WAIT_L(0); PG8_MMA(1, 0, At, B0); PG8_BAR; PG8_SCHED;
            PG8_STAGE(PG8_SB(1, 1), b3 + hstepB, voffB);
            PG8_WAIT_V(6); PG8_BAR; PG8_MMA(1, 1, At, B1); PG8_BAR;
            }
        }
        if constexpr (ALIGN_EPI) { if (wr == 0) PG8_BAR; }
        if constexpr (!Epi::AFTER_DRAIN) { E(acc, cur, wr, wc, fr, fq); S.done(cur); }
        if (!has_next) break;
#pragma unroll
        for (int a = 0; a < 2; ++a)
#pragma unroll
            for (int b = 0; b < 2; ++b)
#pragma unroll
                for (int m = 0; m < 4; ++m)
#pragma unroll
                    for (int n = 0; n < 2; ++n) acc[a][b][m][n] = (f32x4){0.f, 0.f, 0.f, 0.f};
        cur = nxt; cA = nA; cB = nB; ++ui;
        if constexpr (ALIGN_EPI) { if (wr == 1) PG8_BAR; }
    }
    PG8_WAIT_V(0);
    if constexpr (!ALIGN_EPI) { if (wr == 0) PG8_BAR; }
    PG8_BAR;
    if constexpr (Epi::AFTER_DRAIN) { E.fused(acc, cur, wr, wc, fr, fq, lds, wid, lane); S.done(cur); }
#undef PG8_SA
#undef PG8_SB
#undef PG8_STAGE
#undef PG8_LDA
#undef PG8_LDB
#undef PG8_MMA
#undef PG8_WAIT_V
#undef PG8_WAIT_L
#undef PG8_BAR
#undef PG8_SCHED
}
}


#define GAS __attribute__((address_space(1)))
#define LAS __attribute__((address_space(3)))
typedef float f32x4 __attribute__((ext_vector_type(4)));
typedef unsigned u32x4 __attribute__((ext_vector_type(4)));
#define XB_TMO      128
#define XB_XCNT(j)  (256  + 64 * (j))
#define XB_XSUB(j)  (1280 + 64 * (j))
#define XB_XGEN(j)  (2304 + 64 * (j))
#define XB_TOP      3328
#define XB_TOPGEN   3392
#define XCD_BAR_WORDS 3456
#define XB_SPIN_CAP (1u << 18)

__device__ __forceinline__ unsigned xb_ld(unsigned* p)              { return __hip_atomic_load(p, __ATOMIC_RELAXED, __HIP_MEMORY_SCOPE_AGENT); }
__device__ __forceinline__ unsigned xb_add(unsigned* p, unsigned v) { return __hip_atomic_fetch_add(p, v, __ATOMIC_RELAXED, __HIP_MEMORY_SCOPE_AGENT); }
__device__ __forceinline__ unsigned xb_xcc_id() { return (unsigned)__builtin_amdgcn_s_getreg((3 << 11) | 20) & 0xFu; }
#define XB_SPIN(cond, bar) do { unsigned _sp = 0; while (cond) { __builtin_amdgcn_s_sleep(1); \
    if ((++_sp & 255u) == 0u) { if (xb_ld(&(bar)[XB_TMO])) break; if (_sp > XB_SPIN_CAP) { atomicAdd(&(bar)[XB_TMO], 1u); break; } } } } while (0)

struct XcdBarrier {
    unsigned* bar; unsigned x;
    volatile LAS unsigned* st;
};

__device__ __forceinline__ XcdBarrier xcd_barrier_post(unsigned* bar, volatile LAS unsigned* st) {
    XcdBarrier b; b.bar = bar; b.x = xb_xcc_id(); b.st = st;
    if (threadIdx.x == 0) (void)xb_add(&bar[XB_XCNT(b.x)], 1u);
    return b;
}
__device__ __forceinline__ void xcd_barrier_complete(unsigned* bar, unsigned x, unsigned& nloc, unsigned& nx) {
    const unsigned G = gridDim.x * gridDim.y * gridDim.z;
    unsigned sum, cnt, mine, sp = 0u;
    for (;;) {
        sum = 0u; cnt = 0u; mine = 0u;
#pragma unroll
        for (unsigned j = 0; j < 16; ++j) { const unsigned c = xb_ld(&bar[XB_XCNT(j)]); sum += c; cnt += (c > 0u) ? 1u : 0u; mine = (j == x) ? c : mine; }
        if (sum == G) break;
        __builtin_amdgcn_s_sleep(1);
        if ((++sp & 255u) == 0u) { if (xb_ld(&bar[XB_TMO])) break; if (sp > XB_SPIN_CAP) { atomicAdd(&bar[XB_TMO], 1u); break; } }
    }
    nloc = mine > 0u ? mine : 1u; nx = cnt > 0u ? cnt : 1u;
}

__device__ __forceinline__ void xcd_barrier(const XcdBarrier& b) {
    asm volatile("s_waitcnt vmcnt(0)" ::: "memory");
    __syncthreads();
    if (threadIdx.x == 0) {
        unsigned* bar = b.bar;
        __builtin_amdgcn_s_waitcnt(0);
        unsigned nloc = b.st[0], nx = b.st[1];
        if (nloc == 0u) { xcd_barrier_complete(bar, b.x, nloc, nx); b.st[0] = nloc; b.st[1] = nx; }
        const unsigned old = xb_add(&bar[XB_XSUB(b.x)], 1u);
        const unsigned gen = old / nloc;
        if (old + 1u == (gen + 1u) * nloc) {
            __builtin_amdgcn_fence(__ATOMIC_RELEASE, "agent");
            asm volatile("s_waitcnt vmcnt(0)" ::: "memory");
            const unsigned og = xb_add(&bar[XB_TOP], 1u);
            const unsigned tg = og / nx;
            if (og + 1u == (tg + 1u) * nx) xb_add(&bar[XB_TOPGEN], 1u);
            else XB_SPIN(xb_ld(&bar[XB_TOPGEN]) == tg, bar);
            __builtin_amdgcn_fence(__ATOMIC_ACQUIRE, "agent");
            xb_add(&bar[XB_XGEN(b.x)], 1u);
            asm volatile("s_waitcnt vmcnt(0)" ::: "memory");
        } else {
            XB_SPIN(xb_ld(&bar[XB_XGEN(b.x)]) == gen, bar);
            __builtin_amdgcn_fence(__ATOMIC_ACQUIRE, "agent");
            asm volatile("s_waitcnt vmcnt(0)" ::: "memory");
        }
    }
    __syncthreads();
}


constexpr int NWAVES = 8;
constexpr int RING_BYTES = 131072, LDSCTL_OFF = RING_BYTES, MISC_OFF = LDSCTL_OFF + 320, LDS_BYTES = 147456;
constexpr size_t WS_CTL = 0, CTL_ZERO_BYTES = 1 * MiB;
constexpr int CW_BAR = 4096, N_BAR_REGIONS = 16;
static_assert((CW_BAR + N_BAR_REGIONS * XCD_BAR_WORDS) * 4 <= (int)CTL_ZERO_BYTES, "barrier words inside the memset region");
constexpr size_t WS_WIN = 10 * MiB;
constexpr size_t WS_WUQ = 15 * MiB;
constexpr size_t WS_WUKV = 16 * MiB;
constexpr size_t WS_WO = 17 * MiB;
constexpr size_t WS_WPQ = 19 * MiB;
constexpr size_t WS_SK = 23 * MiB;
constexpr size_t WS_U16 = 24 * MiB;
constexpr size_t WS_V16 = 56 * MiB;


namespace att {
typedef short bf16x8 __attribute__((ext_vector_type(8)));
typedef short s16x4 __attribute__((ext_vector_type(4)));
typedef float f32x16 __attribute__((ext_vector_type(16)));
constexpr int LK = 0, KSLOT = 12288, LV = 2 * KSLOT, VSLOT = 8192, LB = LV + 2 * VSLOT, BSLOT = 256, LWS = LB + 2 * BSLOT, LOST = LWS + 8 * 256, ATT_LDS = LOST + 8 * 4096;
static_assert(ATT_LDS <= 131072, "attention scratch fits the ring region");
struct Desc { const bf16_t* Q; int pq; const bf16_t* K; int pk; const bf16_t* V; int pv; bf16_t* O; int po; const float* FC; };

__device__ __forceinline__ int crow(int r, int hi) { return (r & 3) + 8 * (r >> 2) + 4 * hi; }
__device__ __forceinline__ float xmax32(float v) { auto rr = __builtin_amdgcn_permlane32_swap(__float_as_uint(v), __float_as_uint(v), false, false); return fmaxf(__uint_as_float(rr[0]), __uint_as_float(rr[1])); }
__device__ __forceinline__ float xsum32(float v) { auto rr = __builtin_amdgcn_permlane32_swap(__float_as_uint(v), __float_as_uint(v), false, false); return __uint_as_float(rr[0]) + __uint_as_float(rr[1]); }
__device__ __forceinline__ unsigned cvtpk(float lo, float hi) { typedef float f2 __attribute__((ext_vector_type(2))); typedef __bf16 b2 __attribute__((ext_vector_type(2))); f2 v = {lo, hi}; b2 b = __builtin_convertvector(v, b2); return __builtin_bit_cast(unsigned, b); }
typedef short v4i16_t __attribute__((ext_vector_type(4)));
__device__ __forceinline__ s16x4 vtr(LAS const unsigned char* p) { return __builtin_bit_cast(s16x4, __builtin_amdgcn_ds_read_tr16_b64_v4i16((LAS v4i16_t*)p)); }

template <int KS, bool BIAS>
__device__ __forceinline__ void attn_unit(const Desc& d, int qb, int j0, LAS unsigned char* shm) {
    const int tid = threadIdx.x, lane = tid & 63, r32 = lane & 31, hi = lane >> 5; const int wid = __builtin_amdgcn_readfirstlane(tid >> 6);
    const int q0 = qb * 256, NT = (q0 + 256) / 64;
    LAS float* wsf = (LAS float*)(shm + LWS) + wid * 64;
    bf16x8 qr[KS];
    { const bf16_t* qp = d.Q + (size_t)(q0 + wid * 32 + r32) * d.pq + hi * 8;
#pragma unroll
      for (int d0 = 0; d0 < KS; ++d0) qr[d0] = *(const bf16x8*)(qp + d0 * 16); }
    const float fcref = BIAS ? d.FC[q0] : 0.f;
    const bf16_t* ksrc0 = d.K + (size_t)lane * d.pk + wid * 8;
    const bf16_t* ksrc1 = d.K + (size_t)lane * d.pk + (8 + wid) * 8;
    const bf16_t* vsrc = d.V + (size_t)(16 * (wid & 3) + (lane >> 2)) * d.pv + (wid >> 2) * 32 + (lane & 3) * 8;
    const int kdst0 = LK + wid * 1024 + lane * 16, kdst1 = LK + (8 + wid) * 1024 + lane * 16, vdst = LV + wid * 1024 + lane * 16;
    const bool k2 = (KS > 4) && (wid < 2 * KS - 8);
    u32x4 kr0, kr1, vr; float br = 0.f;
#define ATT_LOAD(t) do { kr0 = *(const u32x4*)(ksrc0 + (size_t)(t) * 64 * d.pk); if (k2) kr1 = *(const u32x4*)(ksrc1 + (size_t)(t) * 64 * d.pk); \
        vr = *(const u32x4*)(vsrc + (size_t)(t) * 64 * d.pv); if (BIAS && wid == 4) br = d.FC[(t) * 64 + lane]; } while (0)
#define ATT_WRITE(slot) do { *(LAS u32x4*)(shm + kdst0 + (slot) * KSLOT) = kr0; if (k2) *(LAS u32x4*)(shm + kdst1 + (slot) * KSLOT) = kr1; \
        *(LAS u32x4*)(shm + vdst + (slot) * VSLOT) = vr; if (BIAS && wid == 4) *(LAS float*)(shm + LB + (slot) * BSLOT + lane * 4) = (fcref - br) * LOG2E; } while (0)
    f32x16 o0, o1, negm;
#pragma unroll
    for (int r = 0; r < 16; ++r) { o0[r] = 0.f; o1[r] = 0.f; negm[r] = 0.f; }
    float mref = 0.f, l = 0.f;
    constexpr float THR = 8.f;
    const int qrel = wid * 32 + r32;
    const int kfrag = LK + hi * 1024 + r32 * 16;
    const int vfrag = LV + ((lane >> 4) & 1) * 32 + (lane & 3) * 8 + (4 * hi + ((lane & 15) >> 2)) * 64;
    ATT_LOAD(j0); ATT_WRITE(0);
    __syncthreads();
    for (int t = j0; t < NT; ++t) {
        const int slot = (t - j0) & 1;
        if (t + 1 < NT) ATT_LOAD(t + 1);
        const int jb = t - (NT - 4);
        if (!(jb >= 0 && 64 * jb > 32 * wid + 31)) {
            f32x16 p0, p1;
            if (BIAS) {
                LAS const unsigned char* bp = shm + LB + slot * BSLOT + 16 * hi;
#pragma unroll
                for (int g = 0; g < 4; ++g) { const f32x4 a = *(LAS const f32x4*)(bp + 32 * g), b = *(LAS const f32x4*)(bp + 128 + 32 * g);
#pragma unroll
                    for (int i = 0; i < 4; ++i) { p0[4 * g + i] = a[i] + negm[4 * g + i]; p1[4 * g + i] = b[i] + negm[4 * g + i]; } }
            } else { p0 = negm; p1 = negm; }
            LAS const unsigned char* kp = shm + kfrag + slot * KSLOT;
            __builtin_amdgcn_s_setprio(1);
#pragma unroll
            for (int d0 = 0; d0 < KS; ++d0) {
                const bf16x8 a0 = *(LAS const bf16x8*)(kp + d0 * 2048), a1 = *(LAS const bf16x8*)(kp + d0 * 2048 + 512);
                p0 = __builtin_amdgcn_mfma_f32_32x32x16_bf16(a0, qr[d0], p0, 0, 0, 0);
                p1 = __builtin_amdgcn_mfma_f32_32x32x16_bf16(a1, qr[d0], p1, 0, 0, 0);
            }
            __builtin_amdgcn_s_setprio(0);
            if (jb >= 0) {
                const int kb = 64 * jb + 4 * hi;
#pragma unroll
                for (int r = 0; r < 16; ++r) { const int kv = kb + (r & 3) + 8 * (r >> 2); if (kv > qrel) p0[r] = -INFINITY; if (kv + 32 > qrel) p1[r] = -INFINITY; }
            }
            float ra = __builtin_fmaxf(__builtin_fmaxf(p0[0], p0[1]), p1[0]), rb = __builtin_fmaxf(__builtin_fmaxf(p0[2], p0[3]), p1[1]);
            ra = __builtin_fmaxf(__builtin_fmaxf(ra, p1[2]), p1[3]);
#pragma unroll
            for (int r = 4; r < 16; r += 4) { ra = __builtin_fmaxf(__builtin_fmaxf(ra, p0[r]), p0[r + 1]); rb = __builtin_fmaxf(__builtin_fmaxf(rb, p0[r + 2]), p0[r + 3]);
                ra = __builtin_fmaxf(__builtin_fmaxf(ra, p1[r]), p1[r + 1]); rb = __builtin_fmaxf(__builtin_fmaxf(rb, p1[r + 2]), p1[r + 3]); }
            const float rm = xmax32(__builtin_fmaxf(ra, rb));
            if (__any(rm > THR) || t == j0) {
                const float dl = t == j0 ? rm : __builtin_fmaxf(rm, 0.f);
                mref += dl;
#pragma unroll
                for (int r = 0; r < 16; ++r) { p0[r] -= dl; p1[r] -= dl; negm[r] = -mref; }
                if (t != j0) {
                    const float alpha = __builtin_amdgcn_exp2f(-dl);
                    l *= alpha;
                    if (hi == 0) wsf[r32] = alpha;
#pragma unroll
                    for (int g = 0; g < 4; ++g) { const f32x4 a = *(LAS const f32x4*)(wsf + 8 * g + 4 * hi);
#pragma unroll
                        for (int i = 0; i < 4; ++i) { o0[4 * g + i] *= a[i]; o1[4 * g + i] *= a[i]; } }
                }
            }
            float s0 = 0.f, s1 = 0.f, s2 = 0.f, s3 = 0.f;
#pragma unroll
            for (int r = 0; r < 16; r += 2) { p0[r] = __builtin_amdgcn_exp2f(p0[r]); p0[r + 1] = __builtin_amdgcn_exp2f(p0[r + 1]); p1[r] = __builtin_amdgcn_exp2f(p1[r]); p1[r + 1] = __builtin_amdgcn_exp2f(p1[r + 1]);
                s0 += p0[r]; s1 += p0[r + 1]; s2 += p1[r]; s3 += p1[r + 1]; }
            l += (s0 + s1) + (s2 + s3);
            LAS const unsigned char* vp = shm + vfrag + slot * VSLOT;
            __builtin_amdgcn_s_setprio(1);
#pragma unroll
            for (int ks = 0; ks < 4; ++ks) {
                const f32x16& pp = ks < 2 ? p0 : p1; const int bq = (ks & 1) * 8;
                u32x4 pw; pw.x = cvtpk(pp[bq], pp[bq + 1]); pw.y = cvtpk(pp[bq + 2], pp[bq + 3]); pw.z = cvtpk(pp[bq + 4], pp[bq + 5]); pw.w = cvtpk(pp[bq + 6], pp[bq + 7]);
                const bf16x8 pa = __builtin_bit_cast(bf16x8, pw);
                const s16x4 l0 = vtr(vp + ks * 1024), h0 = vtr(vp + ks * 1024 + 512), l1 = vtr(vp + 4096 + ks * 1024), h1 = vtr(vp + 4096 + ks * 1024 + 512);
                const bf16x8 v0 = {l0[0], l0[1], l0[2], l0[3], h0[0], h0[1], h0[2], h0[3]}, v1 = {l1[0], l1[1], l1[2], l1[3], h1[0], h1[1], h1[2], h1[3]};
                o0 = __builtin_amdgcn_mfma_f32_32x32x16_bf16(pa, v0, o0, 0, 0, 0);
                o1 = __builtin_amdgcn_mfma_f32_32x32x16_bf16(pa, v1, o1, 0, 0, 0);
            }
            __builtin_amdgcn_s_setprio(0);
        }
        if (t + 1 < NT) ATT_WRITE(slot ^ 1);
        __syncthreads();
    }
#undef ATT_LOAD
#undef ATT_WRITE
    l = xsum32(l);
    if (hi == 0) wsf[32 + r32] = l;
    float rli[16];
#pragma unroll
    for (int g = 0; g < 4; ++g) { const f32x4 a = *(LAS const f32x4*)(wsf + 32 + 8 * g + 4 * hi);
#pragma unroll
        for (int i = 0; i < 4; ++i) rli[4 * g + i] = 1.f / a[i]; }
    LAS bf16_t* stg = (LAS bf16_t*)(shm + LOST) + wid * 2048;
#pragma unroll
    for (int r = 0; r < 16; ++r) { const int orow = crow(r, hi); stg[orow * 64 + r32] = f2bf(o0[r] * rli[r]); stg[orow * 64 + 32 + r32] = f2bf(o1[r] * rli[r]); }
    bf16_t* Ow = d.O + (size_t)(q0 + wid * 32) * d.po;
#pragma unroll
    for (int i = 0; i < 4; ++i) { const int row = i * 8 + (lane >> 3), ch = lane & 7; const u32x4 v = *(LAS const u32x4*)(stg + row * 64 + ch * 8); *(u32x4*)(Ow + (size_t)row * d.po + ch * 8) = v; }
    __syncthreads();
}
}


namespace pk {
typedef short bf16x8 __attribute__((ext_vector_type(8)));
typedef float f32x16 __attribute__((ext_vector_type(16)));
__device__ __forceinline__ unsigned f2sort(float f) { const unsigned b = __float_as_uint(f); return b ^ ((unsigned)((int)b >> 31) | 0x80000000u); }
__device__ __forceinline__ float sort2f(unsigned u) { return __uint_as_float((u & 0x80000000u) ? (u ^ 0x80000000u) : ~u); }
__device__ __forceinline__ void ce(unsigned& a, unsigned& b) { const unsigned mx = a > b ? a : b, mn = a > b ? b : a; a = mx; b = mn; }
__device__ __forceinline__ void sort16(unsigned (&v)[16]) {
#pragma unroll
    for (int k = 2; k <= 16; k <<= 1)
#pragma unroll
        for (int j = k >> 1; j >= 1; j >>= 1)
#pragma unroll
            for (int i = 0; i < 16; ++i) { const int l = i ^ j; if (l > i) { if ((i & k) == 0) ce(v[i], v[l]); else ce(v[l], v[i]); } }
}
__device__ __forceinline__ void merge16(unsigned (&a)[16], const unsigned (&b)[16]) {
#pragma unroll
    for (int i = 0; i < 16; ++i) a[i] = a[i] > b[15 - i] ? a[i] : b[15 - i];
#pragma unroll
    for (int j = 8; j >= 1; j >>= 1)
#pragma unroll
        for (int i = 0; i < 16; ++i) { const int l = i ^ j; if (l > i) ce(a[i], a[l]); }
}
__device__ __forceinline__ void top16of64(unsigned (&k)[64], unsigned (&out)[16]) {
    unsigned g1[16], g2[16], g3[16];
#pragma unroll
    for (int i = 0; i < 16; ++i) { out[i] = k[i]; g1[i] = k[16 + i]; g2[i] = k[32 + i]; g3[i] = k[48 + i]; }
    sort16(out); sort16(g1); sort16(g2); sort16(g3);
    merge16(out, g1); merge16(g2, g3); merge16(out, g2);
}
__device__ __forceinline__ unsigned sel4(const unsigned (&w)[4], int q) { const unsigned a = q & 1 ? w[1] : w[0], b = q & 1 ? w[3] : w[2]; return q & 2 ? b : a; }

template <int I> struct COff { static constexpr int v = COff<I - 1>::v + 16 / I; };
template <> struct COff<0> { static constexpr int v = 0; };
static_assert(COff<16>::v == 50, "50 candidates can reach the top 16 of a sorted 16 x 16 sum grid");
template <int I> __device__ __forceinline__ void fill_cand(unsigned (&c64)[64], const float (&s1)[16], const float (&s2)[16]) {
    if constexpr (I < 16) {
#pragma unroll
        for (int j = 0; j < 16 / (I + 1); ++j) c64[COff<I>::v + j] = (f2sort(s1[I] + s2[j]) & 0xFFFFFF00u) | (unsigned)(255 - (I * 16 + j));
        fill_cand<I + 1>(c64, s1, s2);
    }
}
__device__ __forceinline__ void topk_item(const bf16_t* QP, const bf16_t* SK, int* EID, float* GATE, int item, int lane) {
    const int tg = item >> 3, h = item & 7, r32 = lane & 31, hi = lane >> 5;
    const int t = tg * 32 + r32;
    unsigned own[2][16];
#pragma unroll
    for (int p = 0; p < 2; ++p) {
        const bf16_t* qrow = QP + (size_t)t * 2048 + h * 256 + p * 128 + hi * 8;
        bf16x8 qf[8];
#pragma unroll
        for (int d0 = 0; d0 < 8; ++d0) qf[d0] = *(const bf16x8*)(qrow + d0 * 16);
        const bf16_t* skb = SK + (size_t)((h * 2 + p) * 128 + r32) * 128 + hi * 8;
#pragma unroll 1
        for (int kt = 0; kt < 4; ++kt) {
            f32x16 acc;
#pragma unroll
            for (int r = 0; r < 16; ++r) acc[r] = 0.f;
#pragma unroll
            for (int d0 = 0; d0 < 8; ++d0) { const bf16x8 a = *(const bf16x8*)(skb + (size_t)kt * 32 * 128 + d0 * 16); acc = __builtin_amdgcn_mfma_f32_32x32x16_bf16(a, qf[d0], acc, 0, 0, 0); }
            unsigned cur[16];
#pragma unroll
            for (int r = 0; r < 16; ++r) { const int idx0 = kt * 32 + (r & 3) + 8 * (r >> 2);
                cur[r] = (f2sort(acc[r]) & 0xFFFFFF80u) | (unsigned)(127 - idx0 - 4 * hi); }
            sort16(cur);
            if (kt == 0) {
#pragma unroll
                for (int r = 0; r < 16; ++r) own[p][r] = cur[r];
            } else merge16(own[p], cur);
        }
    }
    unsigned fin[16];
    {
        unsigned oth[16];
#pragma unroll
        for (int i = 0; i < 16; ++i) { auto rr = __builtin_amdgcn_permlane32_swap(own[0][i], own[1][i], false, false); fin[i] = rr[0]; oth[i] = rr[1]; }
        merge16(fin, oth);
    }
    unsigned s1k[16], s2k[16];
#pragma unroll
    for (int i = 0; i < 16; ++i) { auto rr = __builtin_amdgcn_permlane32_swap(fin[i], fin[i], false, false); s1k[i] = rr[0]; s2k[i] = rr[1]; }
    float s1[16], s2[16]; unsigned long long i1lo = 0ull, i1hi = 0ull, i2lo = 0ull, i2hi = 0ull;
#pragma unroll
    for (int i = 0; i < 16; ++i) { s1[i] = sort2f(s1k[i] & 0xFFFFFF80u); s2[i] = sort2f(s2k[i] & 0xFFFFFF80u);
        const unsigned long long a = (unsigned long long)(127u - (s1k[i] & 0x7Fu)) << (8 * (i & 7)), b = (unsigned long long)(127u - (s2k[i] & 0x7Fu)) << (8 * (i & 7));
        if (i < 8) { i1lo |= a; i2lo |= b; } else { i1hi |= a; i2hi |= b; } }
    unsigned c64[64];
#pragma unroll
    for (int i = 50; i < 64; ++i) c64[i] = 0u;
    fill_cand<0>(c64, s1, s2);
    unsigned top[16];
    top16of64(c64, top);
    float ev[16]; float sum = 0.f; const float mx = sort2f(top[0] & 0xFFFFFF00u);
#pragma unroll
    for (int r = 0; r < 16; ++r) { ev[r] = __expf(sort2f(top[r] & 0xFFFFFF00u) - mx); sum += ev[r]; }
    const float rs = 1.f / sum;
    if (hi == 0) {
        int* ep = EID + (size_t)t * 128 + h * 16;
#pragma unroll
        for (int q4 = 0; q4 < 4; ++q4) { int ee[4];
#pragma unroll
            for (int z = 0; z < 4; ++z) { const int code = 255 - (int)(top[q4 * 4 + z] & 0xFFu), i = code >> 4, j = code & 15;
                const unsigned e1 = (unsigned)(((i & 8) ? i1hi : i1lo) >> (8 * (i & 7))) & 0xFFu, e2 = (unsigned)(((j & 8) ? i2hi : i2lo) >> (8 * (j & 7))) & 0xFFu; ee[z] = (int)(e1 * 128u + e2); }
            *(int4*)(ep + q4 * 4) = make_int4(ee[0], ee[1], ee[2], ee[3]); }
    } else {
        float* gp = GATE + (size_t)t * 128 + h * 16;
#pragma unroll
        for (int q4 = 0; q4 < 4; ++q4) *(float4*)(gp + q4 * 4) = make_float4(ev[q4 * 4] * rs, ev[q4 * 4 + 1] * rs, ev[q4 * 4 + 2] * rs, ev[q4 * 4 + 3] * rs);
    }
}
}


namespace gx {
typedef unsigned char u8x4 __attribute__((ext_vector_type(4)));
__device__ __forceinline__ int sdot16(const int4 a, const int4 b) {
    int s = __builtin_amdgcn_sdot4(a.x, b.x, 0, false); s = __builtin_amdgcn_sdot4(a.y, b.y, s, false); s = __builtin_amdgcn_sdot4(a.z, b.z, s, false); return __builtin_amdgcn_sdot4(a.w, b.w, s, false);
}
__device__ __forceinline__ void quant_row(const float* src, unsigned char* dst, float* scale_out, int lane) {
    const float4* sr = (const float4*)src + lane; float4 v[4]; float am = 0.f;
#pragma unroll
    for (int j = 0; j < 4; ++j) { v[j] = sr[64 * j]; am = fmaxf(am, fmaxf(fmaxf(fabsf(v[j].x), fabsf(v[j].y)), fmaxf(fabsf(v[j].z), fabsf(v[j].w)))); }
#pragma unroll
    for (int o = 1; o < 64; o <<= 1) am = fmaxf(am, __shfl_xor(am, o));
    const float inv = am > 0.f ? 127.f / am : 0.f;
#pragma unroll
    for (int j = 0; j < 4; ++j) { const int q0 = (int)rintf(v[j].x * inv), q1 = (int)rintf(v[j].y * inv), q2 = (int)rintf(v[j].z * inv), q3 = (int)rintf(v[j].w * inv);
        *(unsigned*)(dst + 4 * lane + 256 * j) = (unsigned)(q0 & 255) | ((unsigned)(q1 & 255) << 8) | ((unsigned)(q2 & 255) << 16) | ((unsigned)(q3 & 255) << 24); }
    if (lane == 0) *scale_out = am * (1.f / 127.f);
}
__device__ __forceinline__ float gelu_t(float x) { const float u = 0.7978845608028654f * (x + 0.044715f * x * x * x); return 0.5f * x * (1.f + tanhf(u)); }

__device__ __forceinline__ int hx(int lo, int hi, bool up, int bit) { const int send = up ? lo : hi, keep = up ? hi : lo; return keep + __shfl_xor(send, bit); }

__device__ __forceinline__ void u_token(const unsigned char* UQs  , const int4 (&ev)[4], const int4 hq, int* PArow, int lane) {
    const int e[16] = {ev[0].x, ev[0].y, ev[0].z, ev[0].w, ev[1].x, ev[1].y, ev[1].z, ev[1].w, ev[2].x, ev[2].y, ev[2].z, ev[2].w, ev[3].x, ev[3].y, ev[3].z, ev[3].w};
    int4 rows[16];
#pragma unroll
    for (int i = 0; i < 16; ++i) rows[i] = *(const int4*)(UQs + (size_t)e[i] * 1024);
    int p[16];
#pragma unroll
    for (int i = 0; i < 16; ++i) p[i] = sdot16(rows[i], hq);
    const bool b2 = (lane & 4) != 0, b1 = (lane & 2) != 0, b0 = (lane & 1) != 0;
    int q[8], r[4];
#pragma unroll
    for (int k = 0; k < 8; ++k) q[k] = hx(p[k], p[8 + k], b2, 4);
#pragma unroll
    for (int k = 0; k < 4; ++k) r[k] = hx(q[k], q[4 + k], b1, 2);
    const int z0 = hx(r[0], r[2], b0, 1), z1 = hx(r[1], r[3], b0, 1);
    *(int2*)(PArow + 2 * lane) = make_int2(z0, z1);
}

__device__ __forceinline__ void v_token(const unsigned char* VQs  , const int4 (&ev)[4], const int4 wh, const int4 wlo, float wscale, const float* gate2, const float* x1row, float* outrow, int s, int lane) {
    const int e[16] = {ev[0].x, ev[0].y, ev[0].z, ev[0].w, ev[1].x, ev[1].y, ev[1].z, ev[1].w, ev[2].x, ev[2].y, ev[2].z, ev[2].w, ev[3].x, ev[3].y, ev[3].z, ev[3].w};
    const int whv[4] = {wh.x, wh.y, wh.z, wh.w}, wlv[4] = {wlo.x, wlo.y, wlo.z, wlo.w};
    uint4 rows[16];
#pragma unroll
    for (int i = 0; i < 16; ++i) rows[i] = *(const uint4*)(VQs + (size_t)e[i] * 1024);
    int ah[16], al[16];
#pragma unroll
    for (int c = 0; c < 16; ++c) { ah[c] = 0; al[c] = 0; }
#pragma unroll
    for (int g = 0; g < 4; ++g) {
#pragma unroll
        for (int d = 0; d < 4; ++d) {
            const unsigned A = d == 0 ? rows[4 * g].x : d == 1 ? rows[4 * g].y : d == 2 ? rows[4 * g].z : rows[4 * g].w;
            const unsigned B = d == 0 ? rows[4 * g + 1].x : d == 1 ? rows[4 * g + 1].y : d == 2 ? rows[4 * g + 1].z : rows[4 * g + 1].w;
            const unsigned C = d == 0 ? rows[4 * g + 2].x : d == 1 ? rows[4 * g + 2].y : d == 2 ? rows[4 * g + 2].z : rows[4 * g + 2].w;
            const unsigned D = d == 0 ? rows[4 * g + 3].x : d == 1 ? rows[4 * g + 3].y : d == 2 ? rows[4 * g + 3].z : rows[4 * g + 3].w;
            const unsigned ab01 = __builtin_amdgcn_perm(A, B, 0x01050004u), ab23 = __builtin_amdgcn_perm(A, B, 0x03070206u);
            const unsigned cd01 = __builtin_amdgcn_perm(C, D, 0x01050004u), cd23 = __builtin_amdgcn_perm(C, D, 0x03070206u);
            const int q0 = (int)__builtin_amdgcn_perm(ab01, cd01, 0x01000504u), q1 = (int)__builtin_amdgcn_perm(ab01, cd01, 0x03020706u);
            const int q2 = (int)__builtin_amdgcn_perm(ab23, cd23, 0x01000504u), q3 = (int)__builtin_amdgcn_perm(ab23, cd23, 0x03020706u);
            ah[4 * d + 0] = __builtin_amdgcn_sdot4(q0, whv[g], ah[4 * d + 0], false); al[4 * d + 0] = __builtin_amdgcn_sdot4(q0, wlv[g], al[4 * d + 0], false);
            ah[4 * d + 1] = __builtin_amdgcn_sdot4(q1, whv[g], ah[4 * d + 1], false); al[4 * d + 1] = __builtin_amdgcn_sdot4(q1, wlv[g], al[4 * d + 1], false);
            ah[4 * d + 2] = __builtin_amdgcn_sdot4(q2, whv[g], ah[4 * d + 2], false); al[4 * d + 2] = __builtin_amdgcn_sdot4(q2, wlv[g], al[4 * d + 2], false);
            ah[4 * d + 3] = __builtin_amdgcn_sdot4(q3, whv[g], ah[4 * d + 3], false); al[4 * d + 3] = __builtin_amdgcn_sdot4(q3, wlv[g], al[4 * d + 3], false);
        }
    }
    int y[16];
#pragma unroll
    for (int c = 0; c < 16; ++c) y[c] = ah[c] * 128 + al[c];
    const bool b5 = (lane & 32) != 0, b4 = (lane & 16) != 0, b3 = (lane & 8) != 0;
    int z[8], q[4];
#pragma unroll
    for (int k = 0; k < 8; ++k) z[k] = hx(y[k], y[8 + k], b5, 32);
#pragma unroll
    for (int k = 0; k < 4; ++k) q[k] = hx(z[k], z[4 + k], b4, 16);
    const int r0 = hx(q[0], q[2], b3, 8), r1 = hx(q[1], q[3], b3, 8);
    const int col = 128 * s + 16 * (lane & 7) + (b5 ? 8 : 0) + (b4 ? 4 : 0) + (b3 ? 2 : 0);
    const float2 g2 = *(const float2*)(gate2 + col); float2 x1 = *(const float2*)(x1row + col);
    x1.x += g2.x * wscale * (float)r0; x1.y += g2.y * wscale * (float)r1;
    *(float2*)(outrow + col) = x1;
}
}

constexpr size_t WS_SU = 2 * MiB, WS_SV = 2 * MiB + 65536, WS_HS = 2 * MiB + 131072;
constexpr size_t WS_UQ = 24 * MiB, WS_VQ = 40 * MiB, WS_H2Q = 56 * MiB;
constexpr size_t WS_A = WS_KA;
struct Args { const void* in[22]; float* out; unsigned char* ws; int ph_lo, ph_hi, li, pad; };

struct Frame {
    LAS unsigned char* lds;
    int tid, lane, wave, G, gw, NGW;
};

namespace pg8 {
struct EpiProj {
    static constexpr bool PERM = true, AFTER_DRAIN = false;
    bf16_t* P; float* FL;
    __device__ __forceinline__ void operator()(const f32x4 (&acc)[2][2][4][2], const Unit& u, int wr, int wc, int fr, int fq) const {
        const int row0 = u.pm * BM + wr * 64 + fr, col0 = u.pn * BM + wc * 32 + 8 * fq;
#pragma unroll
        for (int ai = 0; ai < 2; ++ai)
#pragma unroll
            for (int m = 0; m < 4; ++m) { const int row = row0 + ai * HALF + m * 16; bf16_t* rowp = P + (size_t)row * PP + col0;
#pragma unroll
                for (int bj = 0; bj < 2; ++bj) { const f32x4 v0 = acc[ai][bj][m][0], v1 = acc[ai][bj][m][1];
                    if (col0 + bj * HALF == C_FL) { float* f = FL + (size_t)row * 8; *(f32x4*)f = v0; *(f32x4*)(f + 4) = v1; }
                    u32x4 w; w.x = cvt_pk_bf16(v0[0], v0[1]); w.y = cvt_pk_bf16(v0[2], v0[3]); w.z = cvt_pk_bf16(v1[0], v1[1]); w.w = cvt_pk_bf16(v1[2], v1[3]);
                    *(u32x4*)(rowp + bj * HALF) = w; } }
    }
};
struct EpiStore {
    static constexpr bool PERM = true, AFTER_DRAIN = false;
    bf16_t* O; int ldc;
    __device__ __forceinline__ void operator()(const f32x4 (&acc)[2][2][4][2], const Unit& u, int wr, int wc, int fr, int fq) const {
        const int row0 = u.pm * BM + wr * 64 + fr, col0 = u.pn * BM + wc * 32 + 8 * fq;
#pragma unroll
        for (int ai = 0; ai < 2; ++ai)
#pragma unroll
            for (int m = 0; m < 4; ++m) { bf16_t* rowp = O + (size_t)(row0 + ai * HALF + m * 16) * ldc + col0;
#pragma unroll
                for (int bj = 0; bj < 2; ++bj) { const f32x4 v0 = acc[ai][bj][m][0], v1 = acc[ai][bj][m][1];
                    u32x4 w; w.x = cvt_pk_bf16(v0[0], v0[1]); w.y = cvt_pk_bf16(v0[2], v0[3]); w.z = cvt_pk_bf16(v1[0], v1[1]); w.w = cvt_pk_bf16(v1[2], v1[3]);
                    *(u32x4*)(rowp + bj * HALF) = w; } }
    }
};
struct EpiResid {
    static constexpr bool PERM = false, AFTER_DRAIN = false;
    const float* X; const float* MOD; float* out;
    __device__ __forceinline__ void operator()(const f32x4 (&acc)[2][2][4][2], const Unit& u, int wr, int wc, int fr, int fq) const {
        const int row0 = u.pm * BM + wr * 64 + fr, col0 = u.pn * BM + wc * 32 + 4 * fq;
        const int b = (u.pm * BM) / S_;
        f32x4 gv[2][2];
#pragma unroll
        for (int bj = 0; bj < 2; ++bj)
#pragma unroll
            for (int n = 0; n < 2; ++n) gv[bj][n] = *(const f32x4*)(MOD + b * 6144 + 2 * 1024 + col0 + bj * HALF + n * 16);
#pragma unroll
        for (int ai = 0; ai < 2; ++ai)
#pragma unroll
            for (int m = 0; m < 4; ++m) { const size_t off = (size_t)(row0 + ai * HALF + m * 16) * 1024 + col0;
#pragma unroll
                for (int bj = 0; bj < 2; ++bj)
#pragma unroll
                    for (int n = 0; n < 2; ++n) { const f32x4 xv = *(const f32x4*)(X + off + bj * HALF + n * 16); *(f32x4*)(out + off + bj * HALF + n * 16) = xv + gv[bj][n] * acc[ai][bj][m][n]; } }
    }
};
}

__device__ __forceinline__ void p0_transpose_item(const float* W, int K, int N, int Npad, bf16_t* WT, LAS float* scr, int item, int lane) {
    const int nblk = Npad / 32, kb = item / nblk, nb = item % nblk, k0 = 64 * kb, n0 = 32 * nb;
    const int nn = n0 + (lane & 31);
#pragma unroll 8
    for (int i = 0; i < 32; ++i) { const int kk = 2 * i + (lane >> 5); scr[kk * 33 + (lane & 31)] = nn < N ? W[(size_t)(k0 + kk) * N + nn] : 0.f; }
    asm volatile("s_waitcnt lgkmcnt(0)" ::: "memory");
    const int c = lane & 7;
#pragma unroll
    for (int j = 0; j < 4; ++j) { const int n = (lane >> 3) + 8 * j; const LAS float* s = scr + (8 * c) * 33 + n;
        u32x4 o; o.x = pk2(s[0 * 33], s[1 * 33]); o.y = pk2(s[2 * 33], s[3 * 33]); o.z = pk2(s[4 * 33], s[5 * 33]); o.w = pk2(s[6 * 33], s[7 * 33]);
        *(u32x4*)(WT + (size_t)(n0 + n) * K + k0 + 8 * c) = o; }
    asm volatile("s_waitcnt lgkmcnt(0)" ::: "memory");
}
__device__ __forceinline__ void p0_mod_item(const float* c, const float* w_ada, const float* b_ada, float* mod, LAS float* scr, int item, int lane) {
    for (int i = lane; i < 4096; i += 64) { const int b = i >> 10, k = i & 1023; const float cv = c[i]; scr[k * 4 + b] = cv / (1.f + expf(-cv)); }
    asm volatile("s_waitcnt lgkmcnt(0)" ::: "memory");
    const int j = item * 64 + lane;
    float a0 = 0.f, a1 = 0.f, a2 = 0.f, a3 = 0.f;
#pragma unroll 8
    for (int k = 0; k < 1024; ++k) { const float w = w_ada[(size_t)k * 6144 + j]; const f32x4 s = *(const LAS f32x4*)(scr + k * 4); a0 += s[0] * w; a1 += s[1] * w; a2 += s[2] * w; a3 += s[3] * w; }
    const float bb = b_ada[j];
    mod[0 * 6144 + j] = a0 + bb; mod[1 * 6144 + j] = a1 + bb; mod[2 * 6144 + j] = a2 + bb; mod[3 * 6144 + j] = a3 + bb;
    asm volatile("s_waitcnt lgkmcnt(0)" ::: "memory");
}

struct ModIn { float4 v[4]; };
__device__ __forceinline__ void modrow_load(ModIn& M, const float* X, int row, int lane) {
    const float4* xr = (const float4*)(X + (size_t)row * 1024) + lane;
#pragma unroll
    for (int j = 0; j < 4; ++j) M.v[j] = xr[64 * j];
}
__device__ __forceinline__ void modrow_finish(ModIn& M, const float* g, const float* mod, int shift_idx, int scale_idx, bf16_t* out, unsigned char* outq, float* hs, int row, int lane) {
    const int b = row / S_; float ss = 0.f;
#pragma unroll
    for (int j = 0; j < 4; ++j) ss += (M.v[j].x * M.v[j].x + M.v[j].y * M.v[j].y) + (M.v[j].z * M.v[j].z + M.v[j].w * M.v[j].w);
    ss = wave_sum(ss);
    const float r = rsqrtf(ss * (1.f / 1024.f) + EPS);
    const float* sh = mod + b * 6144 + shift_idx * 1024; const float* sc = mod + b * 6144 + scale_idx * 1024;
    float am = 0.f;
#pragma unroll
    for (int j = 0; j < 4; ++j) {
        const int col = 4 * lane + 256 * j; float4& v = M.v[j];
        const float4 g4 = *(const float4*)(g + col), s4 = *(const float4*)(sc + col), h4 = *(const float4*)(sh + col);
        v.x = v.x * r * g4.x * (1.f + s4.x) + h4.x; v.y = v.y * r * g4.y * (1.f + s4.y) + h4.y; v.z = v.z * r * g4.z * (1.f + s4.z) + h4.z; v.w = v.w * r * g4.w * (1.f + s4.w) + h4.w;
        uint2 w; w.x = pk2(v.x, v.y); w.y = pk2(v.z, v.w);
        *(uint2*)(out + (size_t)row * 1024 + col) = w;
        am = fmaxf(am, fmaxf(fmaxf(fabsf(v.x), fabsf(v.y)), fmaxf(fabsf(v.z), fabsf(v.w))));
    }
    if (outq) {
#pragma unroll
        for (int o = 1; o < 64; o <<= 1) am = fmaxf(am, __shfl_xor(am, o));
        const float inv = am > 0.f ? 127.f / am : 0.f;
#pragma unroll
        for (int j = 0; j < 4; ++j) { const float4 v = M.v[j]; const int q0 = (int)rintf(v.x * inv), q1 = (int)rintf(v.y * inv), q2 = (int)rintf(v.z * inv), q3 = (int)rintf(v.w * inv);
            *(unsigned*)(outq + (size_t)row * 1024 + 4 * lane + 256 * j) = (unsigned)(q0 & 255) | ((unsigned)(q1 & 255) << 8) | ((unsigned)(q2 & 255) << 16) | ((unsigned)(q3 & 255) << 24); }
        if (lane == 0) hs[row] = am * (1.f / 127.f);
    }
}
__device__ __forceinline__ void modrows2(const float* X, const float* g, const float* mod, int shift_idx, int scale_idx, bf16_t* out, unsigned char* outq, float* hs, int gw, int ngw, int lane) {
    for (int row = gw; row < T_; row += 2 * ngw) {
        const int row2 = row + ngw; ModIn Ma, Mb;
        modrow_load(Ma, X, row, lane); if (row2 < T_) modrow_load(Mb, X, row2, lane);
        modrow_finish(Ma, g, mod, shift_idx, scale_idx, out, outq, hs, row, lane); if (row2 < T_) modrow_finish(Mb, g, mod, shift_idx, scale_idx, out, outq, hs, row2, lane);
    }
}
__global__ void __launch_bounds__(NWAVES * 64, 2) mega_fwd(Args args) {
    extern __shared__ __attribute__((aligned(16))) unsigned char lds[];
    Frame F;
    F.lds = (LAS unsigned char*)lds;
    volatile LAS unsigned* MISC = (volatile LAS unsigned*)(F.lds + MISC_OFF);
    F.tid = threadIdx.x; F.lane = F.tid & 63; F.wave = __builtin_amdgcn_readfirstlane(F.tid >> 6);
    F.G = gridDim.x; F.gw = blockIdx.x * NWAVES + F.wave; F.NGW = F.G * NWAVES;
    unsigned char* ws = args.ws;
    unsigned* ctl = (unsigned*)(ws + WS_CTL);
    const float* x = (const float*)args.in[0]; const float* c = (const float*)args.in[1]; const int* positions = (const int*)args.in[2];
    const float* w_ada = (const float*)args.in[3]; const float* b_ada = (const float*)args.in[4]; const float* norm1_g = (const float*)args.in[5];
    const float* w_in = (const float*)args.in[6]; const float* mla_qa_g = (const float*)args.in[7]; const float* mla_kva_g = (const float*)args.in[8];
    const float* w_uq = (const float*)args.in[9]; const float* w_ukv = (const float*)args.in[10]; const float* mla_q_g = (const float*)args.in[11];
    const float* mla_k_g = (const float*)args.in[12]; const float* fox_q_g = (const float*)args.in[13]; const float* fox_k_g = (const float*)args.in[14];
    const float* b_f = (const float*)args.in[15]; const float* w_o = (const float*)args.in[16]; const float* norm2_g = (const float*)args.in[17];
    const float* w_pq = (const float*)args.in[18]; const float* sub_keys = (const float*)args.in[19]; const float* peer_u = (const float*)args.in[20]; const float* peer_v = (const float*)args.in[21];
    float* out = args.out;
    float* MOD = (float*)(ws + WS_MOD); float* FL = (float*)(ws + WS_FL); float* FCUM = (float*)(ws + WS_FCUM); float* LOGF = (float*)(ws + WS_LOGF); float2* ROPE = (float2*)(ws + WS_ROPE);
    bf16_t* XN = (bf16_t*)(ws + WS_XN); bf16_t* PROJ = (bf16_t*)(ws + WS_PROJ); bf16_t* KVRAW = (bf16_t*)(ws + WS_KVRAW); bf16_t* QA = (bf16_t*)(ws + WS_QA); bf16_t* KA = (bf16_t*)(ws + WS_KA);
    bf16_t* WIN = (bf16_t*)(ws + WS_WIN); bf16_t* WUQ = (bf16_t*)(ws + WS_WUQ); bf16_t* WUKV = (bf16_t*)(ws + WS_WUKV); bf16_t* WO = (bf16_t*)(ws + WS_WO); bf16_t* WPQ = (bf16_t*)(ws + WS_WPQ); bf16_t* SKB = (bf16_t*)(ws + WS_SK);
    unsigned char* UQ = ws + WS_UQ; unsigned char* VQ = ws + WS_VQ; unsigned char* H2Q = ws + WS_H2Q; float* SU = (float*)(ws + WS_SU); float* SV = (float*)(ws + WS_SV); float* HS = (float*)(ws + WS_HS); float* AP = (float*)(ws + WS_A);
    bf16_t* OB = XN; bf16_t* H2 = XN; bf16_t* QP = PROJ; int* EID = (int*)(ws + WS_QA); float* GATE = (float*)(ws + WS_QA + 16 * MiB);
    (void)sub_keys; (void)peer_u; (void)peer_v; (void)positions; (void)KA; (void)FCUM; (void)LOGF; (void)ROPE; (void)mla_q_g; (void)mla_k_g; (void)b_f; (void)fox_q_g; (void)fox_k_g; (void)mla_qa_g; (void)mla_kva_g;

    for (int u = F.tid; u < (LDS_BYTES - LDSCTL_OFF) / 4; u += NWAVES * 64) ((LAS unsigned*)(F.lds + LDSCTL_OFF))[u] = 0u;
    __syncthreads();
    const int lo = args.ph_lo, hi = args.ph_hi;
    XcdBarrier bar; bar.bar = ctl + CW_BAR + args.li * XCD_BAR_WORDS; bar.x = 0; bar.st = nullptr;
    if (hi - lo > 1) bar = xcd_barrier_post(ctl + CW_BAR + args.li * XCD_BAR_WORDS, MISC + 8);
#define IN(k) (lo <= (k) && (k) < hi)
#define SEAM(k) do { if (IN(k) && IN((k) + 1)) xcd_barrier(bar); } while (0)

    if (IN(0)) REP(0) {
        LAS float* scr = (LAS float*)(F.lds + F.wave * 16384);
        constexpr int I_MOD = 96, I_IN = 16 * 72, I_UQ = 6 * 24, I_UKV = 4 * 32, I_O = 16 * 32, I_PQ = 16 * 64;
        constexpr int I_SK = 512;
        constexpr int NITEMS = I_MOD + I_IN + I_UQ + I_UKV + I_O + I_PQ + I_SK + 2 * 16384;
        for (int it = F.gw; it < NITEMS; it += F.NGW) {
            int r = it;
            if (r < I_MOD) { p0_mod_item(c, w_ada, b_ada, MOD, scr, r, F.lane); continue; } r -= I_MOD;
            if (r < I_IN) { p0_transpose_item(w_in, 1024, INW, PP, WIN, scr, r, F.lane); continue; } r -= I_IN;
            if (r < I_UQ) { p0_transpose_item(w_uq, 384, 768, 768, WUQ, scr, r, F.lane); continue; } r -= I_UQ;
            if (r < I_UKV) { p0_transpose_item(w_ukv, 256, 1024, 1024, WUKV, scr, r, F.lane); continue; } r -= I_UKV;
            if (r < I_O) { p0_transpose_item(w_o, 1024, 1024, 1024, WO, scr, r, F.lane); continue; } r -= I_O;
            if (r < I_PQ) { p0_transpose_item(w_pq, 1024, 2048, 2048, WPQ, scr, r, F.lane); continue; } r -= I_PQ;
            if (r >= I_SK) { r -= I_SK; if (r < 16384) gx::quant_row(peer_u + (size_t)r * 1024, UQ + (size_t)r * 1024, SU + r, F.lane); else { r -= 16384; gx::quant_row(peer_v + (size_t)r * 1024, VQ + (size_t)r * 1024, SV + r, F.lane); } continue; }
            { const float4* src = (const float4*)(sub_keys + (size_t)r * 512) + F.lane * 2; const float4 a = src[0], b2 = src[1];
              u32x4 o; o.x = pk2(a.x, a.y); o.y = pk2(a.z, a.w); o.z = pk2(b2.x, b2.y); o.w = pk2(b2.z, b2.w); *(u32x4*)(SKB + (size_t)r * 512 + F.lane * 8) = o; }
        }
    }
    SEAM(0);
    if (IN(1)) modrows2(x, norm1_g, MOD, 0, 1, XN, nullptr, nullptr, F.gw, F.NGW, F.lane);
    SEAM(1);
    if (IN(2)) REP(2) {
        pg8::Gemm g{XN, WIN, T_, PP, 1024, 1024}; pg8::StaticOrder S; S.init(T_, PP, F.G, (int)blockIdx.x);
        pg8::EpiProj E{PROJ, FL};
        pg8::gemm_phase<pg8::EpiProj, pg8::StaticOrder, true, true>(F.lds, g, S, E);
    }
    SEAM(2);
    if (IN(3)) {
        for (int row = F.gw; row < T_; row += 2 * F.NGW) {
            const int row2 = row + F.NGW; RowPrepIn Ra, Rb;
            rowprep_load(Ra, PROJ, FL, positions, row, F.lane); if (row2 < T_) rowprep_load(Rb, PROJ, FL, positions, row2, F.lane);
            rowprep_finish(Ra, PROJ, mla_qa_g, mla_kva_g, fox_q_g, fox_k_g, b_f, LOGF, ROPE, row, F.lane);
            if (row2 < T_) rowprep_finish(Rb, PROJ, mla_qa_g, mla_kva_g, fox_q_g, fox_k_g, b_f, LOGF, ROPE, row2, F.lane);
        }
    }
    SEAM(3);
    if (IN(4)) REP(4) {
        { pg8::Gemm g{PROJ + C_CQ, WUQ, T_, 768, 384, PP}; pg8::StaticOrder S; S.init(T_, 768, F.G, (int)blockIdx.x); pg8::EpiStore E{QA, 768};
          pg8::gemm_phase<pg8::EpiStore, pg8::StaticOrder, true, true>(F.lds, g, S, E); }
        { pg8::Gemm g{PROJ + C_CKV, WUKV, T_, 1024, 256, PP}; pg8::StaticOrder S; S.init(T_, 1024, F.G, (int)blockIdx.x); pg8::EpiStore E{KVRAW, 1024};
          pg8::gemm_phase<pg8::EpiStore, pg8::StaticOrder, true, true>(F.lds, g, S, E); }
    }
    SEAM(4);
    if (IN(5)) {
        if (F.wave == 0 && (int)blockIdx.x < 32) fcum_item(LOGF, FCUM, (int)blockIdx.x, F.lane);
        for (int row = F.gw; row < T_; row += 2 * F.NGW) {
            const int row2 = row + F.NGW; MlaIn Ma, Mb;
            mlaprep_load(Ma, QA, KVRAW, PROJ, ROPE, row, F.lane); if (row2 < T_) mlaprep_load(Mb, QA, KVRAW, PROJ, ROPE, row2, F.lane);
            mlaprep_finish(Ma, QA, KA, mla_q_g, mla_k_g, row, F.lane); if (row2 < T_) mlaprep_finish(Mb, QA, KA, mla_q_g, mla_k_g, row2, F.lane);
        }
    }
    SEAM(5);
    if (IN(6)) {
        volatile LAS unsigned* qslot = MISC + 16;
        float thr;
        { float gq = fabsf(fox_q_g[F.lane]), gk = fabsf(fox_k_g[F.lane]);
#pragma unroll
          for (int o = 1; o < 64; o <<= 1) { gq = fmaxf(gq, __shfl_xor(gq, o)); gk = fmaxf(gk, __shfl_xor(gk, o)); }
          thr = 104.5f + 2.f * 1.02f * 8.f * gq * gk; }
        unsigned* qctr = ctl + 64;
        if (F.tid == 0) qslot[0] = atomicAdd(qctr, 1u);
        __syncthreads();
        unsigned u = qslot[0];
        while (u < 2048u) {
            unsigned unext = 0u;
            if (F.tid == 0) unext = atomicAdd(qctr, 1u);
            const int grp = (int)(u >> 10), bh = (int)(u & 31u), qb = 31 - (int)((u >> 5) & 31u), b = bh >> 3, h = bh & 7;
            if (grp == 0) { const att::Desc d{QA + (size_t)b * S_ * 768 + h * 96, 768, KA + (size_t)b * S_ * 768 + h * 96, 768, KVRAW + (size_t)b * S_ * 1024 + h * 128 + 64, 1024, OB + (size_t)b * S_ * 1024 + h * 64, 1024, nullptr};
                att::attn_unit<6, false>(d, qb, 0, F.lds); }
            else { const bf16_t* pb = PROJ + (size_t)b * S_ * PP + h * 64; const float* fc = FCUM + (size_t)(b * 8 + h) * S_;
                const att::Desc d{pb + C_FQ, PP, pb + C_FK, PP, pb + C_FV, PP, OB + (size_t)b * S_ * 1024 + 512 + h * 64, 1024, fc};
                const int NT = 4 * (qb + 1); const float lim = fc[qb * 256] + thr;
                int j0 = 0;
                { const int ja = F.lane, jb2 = 64 + F.lane;
                  const bool ka = ja < NT ? (fc[64 * ja + 63] <= lim) : true, kb = jb2 < NT ? (fc[64 * jb2 + 63] <= lim) : true;
                  const unsigned long long ma = __ballot(ka), mb = __ballot(kb);
                  j0 = ma ? __builtin_ctzll(ma) : (mb ? 64 + __builtin_ctzll(mb) : NT - 4); }
                if (j0 > NT - 4) j0 = NT - 4;
                att::attn_unit<4, true>(d, qb, j0, F.lds); }
            if (F.tid == 0) qslot[0] = unext;
            __syncthreads();
            u = qslot[0];
            __syncthreads();
        }
    }
    SEAM(6);
    if (IN(7)) REP(7) {
        pg8::Gemm g{OB, WO, T_, 1024, 1024, 1024}; pg8::StaticOrder S; S.init(T_, 1024, F.G, (int)blockIdx.x);
        pg8::EpiResid E{x, MOD, out};
        pg8::gemm_phase<pg8::EpiResid, pg8::StaticOrder, true, true>(F.lds, g, S, E);
    }
    SEAM(7);
    if (IN(8)) modrows2(out, norm2_g, MOD, 3, 4, H2, H2Q, HS, F.gw, F.NGW, F.lane);
    SEAM(8);
    if (IN(9)) REP(9) {
        pg8::Gemm g{H2, WPQ, T_, 2048, 1024, 1024}; pg8::StaticOrder S; S.init(T_, 2048, F.G, (int)blockIdx.x); pg8::EpiStore E{QP, 2048};
        pg8::gemm_phase<pg8::EpiStore, pg8::StaticOrder, true, true>(F.lds, g, S, E);
    }
    SEAM(9);
    if (IN(10)) REP(10) { for (int w = F.gw; w < (T_ / 32) * 8; w += F.NGW) pk::topk_item(QP, SKB, EID, GATE, w, F.lane); }
    SEAM(10);
    {
        const int ng = F.G < 8 ? F.G : 8; const int vx = (int)blockIdx.x % ng, rank = (int)blockIdx.x / ng, nrank = (F.G - vx + ng - 1) / ng;
        const int gwv = rank * NWAVES + F.wave, ngwv = nrank * NWAVES;
        const int grp = F.lane >> 3, sub = F.lane & 7;
        int* PA = (int*)(ws + WS_PROJ);
        int* WQH = (int*)(ws + WS_KA); int* WQL = (int*)(ws + WS_KA + 4 * MiB); float* WSC = (float*)(ws + WS_KA + 8 * MiB);
        if (IN(11)) REP(11) {
            for (int s = vx; s < 8; s += ng) {
                const unsigned char* UQs = UQ + 128 * s + 16 * sub;
                int t = gwv; int4 ev[4]; int4 hq = make_int4(0, 0, 0, 0);
#pragma unroll
                for (int k = 0; k < 4; ++k) ev[k] = make_int4(0, 0, 0, 0);
                if (t < T_) {
#pragma unroll
                    for (int k = 0; k < 4; ++k) ev[k] = *(const int4*)(EID + (size_t)t * 128 + grp * 16 + 4 * k);
                    hq = *(const int4*)(H2Q + (size_t)t * 1024 + 128 * s + 16 * sub); }
                while (t < T_) {
                    const int tn = t + ngwv; int4 evn[4]; int4 hqn = make_int4(0, 0, 0, 0);
#pragma unroll
                    for (int k = 0; k < 4; ++k) evn[k] = make_int4(0, 0, 0, 0);
                    if (tn < T_) {
#pragma unroll
                        for (int k = 0; k < 4; ++k) evn[k] = *(const int4*)(EID + (size_t)tn * 128 + grp * 16 + 4 * k);
                        hqn = *(const int4*)(H2Q + (size_t)tn * 1024 + 128 * s + 16 * sub); }
                    gx::u_token(UQs, ev, hq, PA + ((size_t)s * T_ + t) * 128, F.lane);
                    t = tn; hq = hqn;
#pragma unroll
                    for (int k = 0; k < 4; ++k) ev[k] = evn[k];
                }
            }
        }
        SEAM(11);
        if (IN(12)) REP(12) {
            for (int t = F.gw; t < T_; t += F.NGW) {
                int i0 = 0, i1 = 0;
#pragma unroll
                for (int s = 0; s < 8; ++s) { const int2 p = *(const int2*)(PA + ((size_t)s * T_ + t) * 128 + 2 * F.lane); i0 += p.x; i1 += p.y; }
                const int2 e2 = *(const int2*)(EID + (size_t)t * 128 + 2 * F.lane); const float2 g2 = *(const float2*)(GATE + (size_t)t * 128 + 2 * F.lane); const float hs = HS[t];
                const float w0 = g2.x * gx::gelu_t((float)i0 * SU[e2.x] * hs) * SV[e2.x], w1 = g2.y * gx::gelu_t((float)i1 * SU[e2.y] * hs) * SV[e2.y];
                float wm = fmaxf(fabsf(w0), fabsf(w1));
#pragma unroll
                for (int o = 1; o < 64; o <<= 1) wm = fmaxf(wm, __shfl_xor(wm, o));
                const float inv = wm > 0.f ? 16256.f / wm : 0.f;
                const int q0 = (int)rintf(w0 * inv), q1 = (int)rintf(w1 * inv);
                const unsigned h2 = (unsigned)((q0 >> 7) & 255) | ((unsigned)((q1 >> 7) & 255) << 8), l2 = (unsigned)(q0 & 127) | ((unsigned)(q1 & 127) << 8);
                const unsigned h2p = __shfl_xor(h2, 1), l2p = __shfl_xor(l2, 1);
                if ((F.lane & 1) == 0) { WQH[(size_t)t * 32 + (F.lane >> 1)] = (int)(h2 | (h2p << 16)); WQL[(size_t)t * 32 + (F.lane >> 1)] = (int)(l2 | (l2p << 16)); }
                if (F.lane == 0) WSC[t] = wm * (1.f / 16256.f);
            }
        }
        SEAM(12);
        if (IN(13)) REP(13) {
            for (int s = vx; s < 8; s += ng) {
                const unsigned char* VQs = VQ + 128 * s + 16 * sub;
                int t = gwv; int4 ev[4]; int4 wh = make_int4(0, 0, 0, 0), wl = make_int4(0, 0, 0, 0); float wsc = 0.f;
#pragma unroll
                for (int k = 0; k < 4; ++k) ev[k] = make_int4(0, 0, 0, 0);
                if (t < T_) {
#pragma unroll
                    for (int k = 0; k < 4; ++k) ev[k] = *(const int4*)(EID + (size_t)t * 128 + grp * 16 + 4 * k);
                    wh = *(const int4*)(WQH + (size_t)t * 32 + grp * 4); wl = *(const int4*)(WQL + (size_t)t * 32 + grp * 4); wsc = WSC[t]; }
                while (t < T_) {
                    const int tn = t + ngwv; int4 evn[4]; int4 whn = make_int4(0, 0, 0, 0), wln = make_int4(0, 0, 0, 0); float wscn = 0.f;
#pragma unroll
                    for (int k = 0; k < 4; ++k) evn[k] = make_int4(0, 0, 0, 0);
                    if (tn < T_) {
#pragma unroll
                        for (int k = 0; k < 4; ++k) evn[k] = *(const int4*)(EID + (size_t)tn * 128 + grp * 16 + 4 * k);
                        whn = *(const int4*)(WQH + (size_t)tn * 32 + grp * 4); wln = *(const int4*)(WQL + (size_t)tn * 32 + grp * 4); wscn = WSC[tn]; }
                    float* dstrow = (PROBE_DUP == 13 && _r == 0) ? (float*)(ws + WS_XN) + (size_t)t * 1024 : out + (size_t)t * 1024;
                    gx::v_token(VQs, ev, wh, wl, wsc, MOD + (t / S_) * 6144 + 5 * 1024, out + (size_t)t * 1024, dstrow, s, F.lane);
                    t = tn; wh = whn; wl = wln; wsc = wscn;
#pragma unroll
                    for (int k = 0; k < 4; ++k) ev[k] = evn[k];
                }
            }
        }
    }
#undef IN
#undef SEAM
}

static int g_grid = 0;
static void launch_mega(const Args& base, int lo, int hi, int li, hipStream_t stream) {
    Args a = base; a.ph_lo = lo; a.ph_hi = hi; a.li = li;
    hipLaunchKernelGGL(mega_fwd, dim3(g_grid), dim3(NWAVES * 64), LDS_BYTES, stream, a);
}

extern "C" void kernel_launch(void* const* d_in, const int* in_sizes, int n_in, void* d_out, int out_size, void* d_ws, size_t ws_size, hipStream_t stream) {
    if (g_grid == 0) {
        int dev = 0, cus = 0;
        hipGetDevice(&dev); hipDeviceGetAttribute(&cus, hipDeviceAttributeMultiprocessorCount, dev);
        hipFuncSetAttribute((const void*)mega_fwd, hipFuncAttributeMaxDynamicSharedMemorySize, LDS_BYTES);
        int per_cu = 0; hipOccupancyMaxActiveBlocksPerMultiprocessor(&per_cu, (const void*)mega_fwd, NWAVES * 64, LDS_BYTES);
        (void)hipGetLastError();
        g_grid = cus > 0 ? cus : 256;
        if (per_cu < 1) fprintf(stderr, "kernel_launch: occupancy query says %d blocks/CU\n", per_cu);
    }
    const float* x = (const float*)d_in[0]; const int* positions = (const int*)d_in[2];
    const float* mla_qa_g = (const float*)d_in[7]; const float* mla_kva_g = (const float*)d_in[8];
    const float* mla_q_g = (const float*)d_in[11]; const float* mla_k_g = (const float*)d_in[12]; const float* fox_q_g = (const float*)d_in[13]; const float* fox_k_g = (const float*)d_in[14];
    const float* b_f = (const float*)d_in[15]; const float* sub_keys = (const float*)d_in[19]; const float* peer_u = (const float*)d_in[20]; const float* peer_v = (const float*)d_in[21];
    float* out = (float*)d_out; unsigned char* ws = (unsigned char*)d_ws;
    float* MOD = (float*)(ws + WS_MOD); float* FL = (float*)(ws + WS_FL); float* FCUM = (float*)(ws + WS_FCUM); float* LOGF = (float*)(ws + WS_LOGF); float2* ROPE = (float2*)(ws + WS_ROPE);
    bf16_t* XN = (bf16_t*)(ws + WS_XN); bf16_t* PROJ = (bf16_t*)(ws + WS_PROJ); bf16_t* KVRAW = (bf16_t*)(ws + WS_KVRAW); bf16_t* QA = (bf16_t*)(ws + WS_QA); bf16_t* KA = (bf16_t*)(ws + WS_KA);
    bf16_t* OB = XN; bf16_t* H2 = XN; bf16_t* QP = PROJ; int* EID = (int*)(ws + WS_QA); float* GATE = (float*)(ws + WS_QA + 16 * MiB);
    (void)x;
    hipMemsetAsync(ws + WS_CTL, 0, CTL_ZERO_BYTES, stream);
    Args base{}; for (int i = 0; i < 22; ++i) base.in[i] = d_in[i]; base.out = out; base.ws = ws;

    launch_mega(base, 0, 14, 0, stream);
}
```

```cpp
#include <hip/hip_runtime.h>
#ifndef PROBE_DUP
#define PROBE_DUP -1
#endif
#define REP(k) for (int _r = 0; _r < ((PROBE_DUP == (k)) ? 2 : 1); ++_r)
#include <cstdint>
#include <cstdio>
#include <cmath>

typedef unsigned short bf16_t;
constexpr int B_ = 4, S_ = 8192, D_ = 1024, T_ = B_ * S_;
constexpr int PP = 2304;
constexpr int C_CQ = 0, C_CKV = 384, C_KPE = 640, C_FQ = 672, C_FK = 1184, C_FV = 1696, C_FL = 2208, INW = 2216;
constexpr float EPS = 1e-6f;
constexpr float LOG2E = 1.4426950408889634f;
constexpr float C2A = 0.10206207261596577f * LOG2E;
constexpr float C2F = 0.125f * LOG2E;

__device__ __forceinline__ float bf2f(bf16_t v) { return __uint_as_float(((unsigned)v) << 16); }
__device__ __forceinline__ bf16_t f2bf(float f) { unsigned u = __float_as_uint(f); return (bf16_t)((u + 0x7fffu + ((u >> 16) & 1u)) >> 16); }
__device__ __forceinline__ unsigned pk2(float lo, float hi) { return (unsigned)f2bf(lo) | ((unsigned)f2bf(hi) << 16); }
__device__ __forceinline__ float lo2f(unsigned w) { return __uint_as_float(w << 16); }
__device__ __forceinline__ float hi2f(unsigned w) { return __uint_as_float(w & 0xffff0000u); }
__device__ __forceinline__ float wave_sum(float v) {
#pragma unroll
    for (int o = 1; o < 64; o <<= 1) v += __shfl_xor(v, o);
    return v;
}

constexpr size_t MiB = 1u << 20;
constexpr size_t WS_MOD = 1 * MiB;
constexpr size_t WS_FL = 3 * MiB;
constexpr size_t WS_FCUM = 4 * MiB;
constexpr size_t WS_LOGF = 5 * MiB;
constexpr size_t WS_ROPE = 6 * MiB;
constexpr size_t WS_XN = 88 * MiB;
constexpr size_t WS_PROJ = 152 * MiB;
constexpr size_t WS_KVRAW = 296 * MiB;
constexpr size_t WS_QA = 360 * MiB;
constexpr size_t WS_KA = 408 * MiB;

__global__ void k_mod(const float* c, const float* w_ada, const float* b_ada, float* mod) {
    const int j = blockIdx.x * 256 + threadIdx.x, b = blockIdx.y;
    float acc = b_ada[j];
    for (int k = 0; k < 1024; ++k) { const float cv = c[b * 1024 + k]; const float s = cv / (1.f + expf(-cv)); acc += s * w_ada[(size_t)k * 6144 + j]; }
    mod[b * 6144 + j] = acc;
}

__global__ void __launch_bounds__(256) k_modrows(const float* X, const float* g, const float* mod, int shift_idx, int scale_idx, bf16_t* out) {
    const int wave = threadIdx.x >> 6, lane = threadIdx.x & 63;
    const int row = blockIdx.x * 4 + wave, b = row / S_;
    const float4* xr = (const float4*)(X + (size_t)row * 1024) + lane;
    float4 v[4]; float ss = 0.f;
#pragma unroll
    for (int j = 0; j < 4; ++j) { v[j] = xr[64 * j]; ss += (v[j].x * v[j].x + v[j].y * v[j].y) + (v[j].z * v[j].z + v[j].w * v[j].w); }
    ss = wave_sum(ss);
    const float r = rsqrtf(ss * (1.f / 1024.f) + EPS);
    const float* sh = mod + b * 6144 + shift_idx * 1024; const float* sc = mod + b * 6144 + scale_idx * 1024;
#pragma unroll
    for (int j = 0; j < 4; ++j) {
        const int col = 4 * lane + 256 * j;
        const float4 g4 = *(const float4*)(g + col), s4 = *(const float4*)(sc + col), h4 = *(const float4*)(sh + col);
        const float o0 = v[j].x * r * g4.x * (1.f + s4.x) + h4.x, o1 = v[j].y * r * g4.y * (1.f + s4.y) + h4.y;
        const float o2 = v[j].z * r * g4.z * (1.f + s4.z) + h4.z, o3 = v[j].w * r * g4.w * (1.f + s4.w) + h4.w;
        uint2 w; w.x = pk2(o0, o1); w.y = pk2(o2, o3);
        *(uint2*)(out + (size_t)row * 1024 + col) = w;
    }
}

template <int MODE>
__global__ void __launch_bounds__(256) k_gemm_naive(const bf16_t* A, int lda, const float* W, int K, int N, void* Cout, int ldc, const float* aux1, const float* aux2, float* fl) {
    __shared__ float As[16][64];
    __shared__ float Ws[16][64];
    const int tx = threadIdx.x & 15, ty = threadIdx.x >> 4;
    const int m0 = blockIdx.y * 64, n0 = blockIdx.x * 64;
    float acc[4][4];
#pragma unroll
    for (int i = 0; i < 4; ++i)
#pragma unroll
        for (int j = 0; j < 4; ++j) acc[i][j] = 0.f;
    for (int k0 = 0; k0 < K; k0 += 16) {
        { const int r = threadIdx.x >> 2, kq = (threadIdx.x & 3) * 4; const uint2 a2 = *(const uint2*)(A + (size_t)(m0 + r) * lda + k0 + kq);
          As[kq + 0][r] = lo2f(a2.x); As[kq + 1][r] = hi2f(a2.x); As[kq + 2][r] = lo2f(a2.y); As[kq + 3][r] = hi2f(a2.y); }
        { const int kk = threadIdx.x >> 4, nq = (threadIdx.x & 15) * 4; float4 w4 = make_float4(0.f, 0.f, 0.f, 0.f);
          if (n0 + nq < N) w4 = *(const float4*)(W + (size_t)(k0 + kk) * N + n0 + nq);
          *(float4*)&Ws[kk][nq] = w4; }
        __syncthreads();
#pragma unroll
        for (int kk = 0; kk < 16; ++kk) {
            const float4 a4 = *(const float4*)&As[kk][ty * 4]; const float4 w4 = *(const float4*)&Ws[kk][tx * 4];
            const float a[4] = {a4.x, a4.y, a4.z, a4.w}; const float w[4] = {w4.x, w4.y, w4.z, w4.w};
#pragma unroll
            for (int i = 0; i < 4; ++i)
#pragma unroll
                for (int j = 0; j < 4; ++j) acc[i][j] += a[i] * w[j];
        }
        __syncthreads();
    }
#pragma unroll
    for (int i = 0; i < 4; ++i) {
        const int m = m0 + ty * 4 + i;
#pragma unroll
        for (int j = 0; j < 4; ++j) {
            const int n = n0 + tx * 4 + j;
            if (n < N) {
                if (MODE == 0) ((bf16_t*)Cout)[(size_t)m * ldc + n] = f2bf(acc[i][j]);
                else if (MODE == 1) { if (n < C_FL) ((bf16_t*)Cout)[(size_t)m * ldc + n] = f2bf(acc[i][j]); else fl[(size_t)m * 8 + (n - C_FL)] = acc[i][j]; }
                else { const int b = m / S_; ((float*)Cout)[(size_t)m * ldc + n] = aux1[(size_t)m * 1024 + n] + aux2[b * 6144 + 2 * 1024 + n] * acc[i][j]; }
            }
        }
    }
}

__device__ __forceinline__ void unpack8(const uint4 raw, float* v) {
    v[0] = lo2f(raw.x); v[1] = hi2f(raw.x); v[2] = lo2f(raw.y); v[3] = hi2f(raw.y); v[4] = lo2f(raw.z); v[5] = hi2f(raw.z); v[6] = lo2f(raw.w); v[7] = hi2f(raw.w);
}
struct RowPrepIn { uint4 cq, ckv, fq, fk; float fl; int pos; };
__device__ __forceinline__ void rowprep_load(RowPrepIn& R, const bf16_t* PROJ, const float* FL, const int* positions, int row, int lane) {
    const bf16_t* pr = PROJ + (size_t)row * PP;
    R.cq = lane < 48 ? *(const uint4*)(pr + C_CQ + lane * 8) : make_uint4(0u, 0u, 0u, 0u);
    R.ckv = lane < 32 ? *(const uint4*)(pr + C_CKV + lane * 8) : make_uint4(0u, 0u, 0u, 0u);
    R.fq = *(const uint4*)(pr + C_FQ + lane * 8); R.fk = *(const uint4*)(pr + C_FK + lane * 8);
    R.fl = lane < 8 ? FL[(size_t)row * 8 + lane] : 0.f; R.pos = positions[row];
}
__device__ __forceinline__ uint4 scale8(const float* v, float r, const float* g) {
    uint4 o; o.x = pk2(v[0] * r * g[0], v[1] * r * g[1]); o.y = pk2(v[2] * r * g[2], v[3] * r * g[3]); o.z = pk2(v[4] * r * g[4], v[5] * r * g[5]); o.w = pk2(v[6] * r * g[6], v[7] * r * g[7]); return o;
}
__device__ __forceinline__ void rowprep_finish(const RowPrepIn& R, bf16_t* PROJ, const float* g_qa, const float* g_kva, const float* g_fq, const float* g_fk, const float* b_f,
                                               float* LOGF, float2* ROPE, int row, int lane, float invf) {
    bf16_t* pr = PROJ + (size_t)row * PP;
    float vq[8], vk[8], v1[8], v2[8];
    unpack8(R.cq, vq); unpack8(R.ckv, vk); unpack8(R.fq, v1); unpack8(R.fk, v2);
    float sq = 0.f, sk = 0.f, s1 = 0.f, s2 = 0.f;
#pragma unroll
    for (int i = 0; i < 8; ++i) { sq += vq[i] * vq[i]; sk += vk[i] * vk[i]; s1 += v1[i] * v1[i]; s2 += v2[i] * v2[i]; }
    s1 += __shfl_xor(s1, 1); s2 += __shfl_xor(s2, 1); s1 += __shfl_xor(s1, 2); s2 += __shfl_xor(s2, 2); s1 += __shfl_xor(s1, 4); s2 += __shfl_xor(s2, 4);
#pragma unroll
    for (int o = 1; o < 64; o <<= 1) { sq += __shfl_xor(sq, o); sk += __shfl_xor(sk, o); }
    const float rq = rsqrtf(sq * (1.f / 384.f) + EPS), rk = rsqrtf(sk * (1.f / 256.f) + EPS);
    const float r1 = rsqrtf(s1 * (1.f / 64.f) + EPS) * C2F, r2 = rsqrtf(s2 * (1.f / 64.f) + EPS);
    if (lane < 48) *(uint4*)(pr + C_CQ + lane * 8) = scale8(vq, rq, g_qa + lane * 8);
    if (lane < 32) *(uint4*)(pr + C_CKV + lane * 8) = scale8(vk, rk, g_kva + lane * 8);
    *(uint4*)(pr + C_FQ + lane * 8) = scale8(v1, r1, g_fq + (lane & 7) * 8);
    *(uint4*)(pr + C_FK + lane * 8) = scale8(v2, r2, g_fk + (lane & 7) * 8);
    if (lane < 8) { const float z = R.fl + b_f[lane]; LOGF[((size_t)(row / S_) * 8 + lane) * S_ + (row % S_)] = fminf(z, 0.f) - log1pf(expf(-fabsf(z))); }
    if (lane < 16) {
        const double a = (double)((float)R.pos * invf), n = rint(a * 0.15915494309189535);
        const float red = (float)(a - n * 6.283185307179586);
        ROPE[(size_t)row * 16 + lane] = make_float2(__cosf(red), __sinf(red)); }
}
__device__ __forceinline__ void rowprep_row(bf16_t* PROJ, const float* FL, const float* g_qa, const float* g_kva, const float* g_fq, const float* g_fk, const float* b_f,
                                                 const int* positions, float* LOGF, float2* ROPE, int row, int lane) {
    const float invf = (float)exp2(-(double)(lane & 15) * (13.287712379549449 / 16.0));
    RowPrepIn R; rowprep_load(R, PROJ, FL, positions, row, lane); rowprep_finish(R, PROJ, g_qa, g_kva, g_fq, g_fk, b_f, LOGF, ROPE, row, lane, invf);
}
__global__ void __launch_bounds__(256) k_rowprep(bf16_t* PROJ, const float* FL, const float* g_qa, const float* g_kva, const float* g_fq, const float* g_fk, const float* b_f,
                                                 const int* positions, float* LOGF, float2* ROPE) {
    rowprep_row(PROJ, FL, g_qa, g_kva, g_fq, g_fk, b_f, positions, LOGF, ROPE, blockIdx.x * 4 + (threadIdx.x >> 6), threadIdx.x & 63);
}

__device__ __forceinline__ void fcum_item(const float* LOGF, float* FCUM, int item, int lane) {
    const float4* src = (const float4*)(LOGF + (size_t)item * S_ + 128 * lane);
    float4 v[32]; float tot = 0.f;
#pragma unroll
    for (int i = 0; i < 32; ++i) v[i] = src[i];
#pragma unroll
    for (int i = 0; i < 32; ++i) tot += (v[i].x + v[i].y) + (v[i].z + v[i].w);
    float incl = tot;
#pragma unroll
    for (int o = 1; o < 64; o <<= 1) { const float t = __shfl_up(incl, o); if (lane >= o) incl += t; }
    float run = incl - tot;
    float4* dst = (float4*)(FCUM + (size_t)item * S_ + 128 * lane);
#pragma unroll
    for (int i = 0; i < 32; ++i) { float4 o; run += v[i].x; o.x = run; run += v[i].y; o.y = run; run += v[i].z; o.z = run; run += v[i].w; o.w = run; dst[i] = o; }
}
__global__ void __launch_bounds__(64) k_fcum(const float* LOGF, float* FCUM) { fcum_item(LOGF, FCUM, blockIdx.x, threadIdx.x); }

struct MlaIn { uint4 qn, kn; unsigned q1, q2, k1, k2; float2 cs0, cs1; };
__device__ __forceinline__ void mlaprep_load(MlaIn& M, const bf16_t* QRAW, const bf16_t* KVRAW, const bf16_t* PROJ, const float2* ROPE, int row, int lane) {
    const int h = lane >> 3, p = lane & 7;
    const bf16_t* q = QRAW + (size_t)row * 768 + h * 96; const bf16_t* kp = PROJ + (size_t)row * PP + C_KPE;
    M.qn = *(const uint4*)(q + 8 * p); M.q1 = *(const unsigned*)(q + 64 + 2 * p); M.q2 = *(const unsigned*)(q + 80 + 2 * p);
    M.kn = *(const uint4*)(KVRAW + (size_t)row * 1024 + h * 128 + 8 * p); M.k1 = *(const unsigned*)(kp + 2 * p); M.k2 = *(const unsigned*)(kp + 16 + 2 * p);
    M.cs0 = ROPE[(size_t)row * 16 + 2 * p]; M.cs1 = ROPE[(size_t)row * 16 + 2 * p + 1];
}
__device__ __forceinline__ void mlaprep_finish(const MlaIn& M, bf16_t* QRAW, bf16_t* KA, const float* g_q, const float* g_k, int row, int lane) {
    const int h = lane >> 3, p = lane & 7;
#pragma unroll
    for (int which = 0; which < 2; ++which) {
        const float* g = which == 0 ? g_q : g_k; const float sc = which == 0 ? C2A : 1.f;
        float v[8]; unpack8(which == 0 ? M.qn : M.kn, v); const unsigned r1 = which == 0 ? M.q1 : M.k1, r2 = which == 0 ? M.q2 : M.k2;
        float a0 = lo2f(r1), a1 = hi2f(r1), b0 = lo2f(r2), b1 = hi2f(r2);
        float ss = a0 * a0 + a1 * a1 + b0 * b0 + b1 * b1;
#pragma unroll
        for (int i = 0; i < 8; ++i) ss += v[i] * v[i];
        ss += __shfl_xor(ss, 1); ss += __shfl_xor(ss, 2); ss += __shfl_xor(ss, 4);
        const float r = rsqrtf(ss * (1.f / 96.f) + EPS);
        const float* gn = g + 8 * p;
        a0 *= r * g[64 + 2 * p]; a1 *= r * g[64 + 2 * p + 1]; b0 *= r * g[80 + 2 * p]; b1 *= r * g[80 + 2 * p + 1];
        const float ra0 = a0 * M.cs0.x - b0 * M.cs0.y, rb0 = b0 * M.cs0.x + a0 * M.cs0.y, ra1 = a1 * M.cs1.x - b1 * M.cs1.y, rb1 = b1 * M.cs1.x + a1 * M.cs1.y;
        uint4 o; o.x = pk2(v[0] * r * gn[0] * sc, v[1] * r * gn[1] * sc); o.y = pk2(v[2] * r * gn[2] * sc, v[3] * r * gn[3] * sc);
        o.z = pk2(v[4] * r * gn[4] * sc, v[5] * r * gn[5] * sc); o.w = pk2(v[6] * r * gn[6] * sc, v[7] * r * gn[7] * sc);
        bf16_t* dst = (which == 0 ? QRAW : KA) + (size_t)row * 768 + h * 96;
        *(uint4*)(dst + 8 * p) = o; *(unsigned*)(dst + 64 + 2 * p) = pk2(ra0 * sc, ra1 * sc); *(unsigned*)(dst + 80 + 2 * p) = pk2(rb0 * sc, rb1 * sc);
    }
}
__device__ __forceinline__ void mlaprep_row(bf16_t* QRAW, const bf16_t* KVRAW, const bf16_t* PROJ, bf16_t* KA, const float2* ROPE, const float* g_q, const float* g_k, int row, int lane) {
    MlaIn M; mlaprep_load(M, QRAW, KVRAW, PROJ, ROPE, row, lane); mlaprep_finish(M, QRAW, KA, g_q, g_k, row, lane);
}

__global__ void __launch_bounds__(256) k_mlaprep(bf16_t* QRAW, const bf16_t* KVRAW, const bf16_t* PROJ, bf16_t* KA, const float2* ROPE, const float* g_q, const float* g_k) {
    mlaprep_row(QRAW, KVRAW, PROJ, KA, ROPE, g_q, g_k, blockIdx.x * 4 + (threadIdx.x >> 6), threadIdx.x & 63);
}

template <int DK>
__global__ void __launch_bounds__(256) k_attn_naive(const bf16_t* Q, int pq, int qstep, const bf16_t* K, int pk, int kstep, const bf16_t* V, int pv, int vstep, bf16_t* O, int po, int ostep, const float* FCUM) {
    __shared__ float Ks[64][DK];
    __shared__ float Vs[64][64];
    __shared__ float Bs[64];
    const int bh = blockIdx.x >> 5, qb = blockIdx.x & 31, b = bh >> 3, h = bh & 7;
    const int t = qb * 256 + threadIdx.x;
    const size_t row = (size_t)b * S_ + t;
    float q[DK];
#pragma unroll
    for (int c = 0; c < DK / 8; ++c) unpack8(*(const uint4*)(Q + row * pq + h * qstep + c * 8), q + c * 8);
    float o[64];
#pragma unroll
    for (int d = 0; d < 64; ++d) o[d] = 0.f;
    float m = -INFINITY, l = 0.f;
    const float fq = FCUM ? FCUM[(size_t)(b * 8 + h) * S_ + t] : 0.f;
    const int ntiles = (qb * 256 + 256) / 64;
    for (int kt = 0; kt < ntiles; ++kt) {
        __syncthreads();
        for (int c = threadIdx.x; c < 64 * (DK / 8); c += 256) { const int key = c / (DK / 8), ch = c % (DK / 8); float v[8];
            unpack8(*(const uint4*)(K + ((size_t)b * S_ + kt * 64 + key) * pk + h * kstep + ch * 8), v);
#pragma unroll
            for (int i = 0; i < 8; ++i) Ks[key][ch * 8 + i] = v[i]; }
        for (int c = threadIdx.x; c < 64 * 8; c += 256) { const int key = c >> 3, ch = c & 7; float v[8];
            unpack8(*(const uint4*)(V + ((size_t)b * S_ + kt * 64 + key) * pv + h * vstep + ch * 8), v);
#pragma unroll
            for (int i = 0; i < 8; ++i) Vs[key][ch * 8 + i] = v[i]; }
        if (threadIdx.x < 64) Bs[threadIdx.x] = FCUM ? FCUM[(size_t)(b * 8 + h) * S_ + kt * 64 + threadIdx.x] : 0.f;
        __syncthreads();
        const int kmax = t - kt * 64 + 1;
        for (int kk = 0; kk < 64; ++kk) {
            float s = 0.f;
#pragma unroll
            for (int d = 0; d < DK; ++d) s += q[d] * Ks[kk][d];
            if (FCUM) s += (fq - Bs[kk]) * LOG2E;
            if (kk < kmax) {
                const float mn = fmaxf(m, s), corr = exp2f(m - mn), p = exp2f(s - mn);
                l = l * corr + p;
#pragma unroll
                for (int d = 0; d < 64; ++d) o[d] = o[d] * corr + p * Vs[kk][d];
                m = mn;
            }
        }
    }
    const float rl = 1.f / l;
    bf16_t* op = O + row * po + h * ostep;
#pragma unroll
    for (int c = 0; c < 8; ++c) { uint4 w; w.x = pk2(o[c * 8 + 0] * rl, o[c * 8 + 1] * rl); w.y = pk2(o[c * 8 + 2] * rl, o[c * 8 + 3] * rl); w.z = pk2(o[c * 8 + 4] * rl, o[c * 8 + 5] * rl); w.w = pk2(o[c * 8 + 6] * rl, o[c * 8 + 7] * rl);
        *(uint4*)(op + c * 8) = w; }
}

__device__ __forceinline__ void topk_item(const bf16_t* QP, const float* sub_keys, int* EID, float* GATE, int w, int lane) {
    const int t = w >> 3, h = w & 7;
    float sl0 = 0.f, sl1 = 0.f; int il0 = 0, il1 = 0;
#pragma unroll
    for (int p = 0; p < 2; ++p) {
        const bf16_t* q = QP + (size_t)t * 2048 + h * 256 + p * 128;
        const float* k0 = sub_keys + ((size_t)(h * 2 + p) * 128 + lane) * 128; const float* k1 = k0 + 64 * 128;
        float s0 = 0.f, s1 = 0.f;
        for (int d = 0; d < 128; ++d) { const float qd = bf2f(q[d]); s0 += qd * k0[d]; s1 += qd * k1[d]; }
        float ls = 0.f; int li = 0;
        for (int r = 0; r < 16; ++r) {
            float bv; int bi; if (s0 >= s1) { bv = s0; bi = lane; } else { bv = s1; bi = lane + 64; }
#pragma unroll
            for (int o = 32; o >= 1; o >>= 1) { const float ov = __shfl_xor(bv, o); const int oi = __shfl_xor(bi, o); if (ov > bv || (ov == bv && oi < bi)) { bv = ov; bi = oi; } }
            if (lane == r) { ls = bv; li = bi; }
            if (bi == lane) s0 = -INFINITY; else if (bi == lane + 64) s1 = -INFINITY;
        }
        if (p == 0) { sl0 = ls; il0 = li; } else { sl1 = ls; il1 = li; }
    }
    float cv0, cv1, cv2, cv3;
    { const int c0 = lane, c1 = lane + 64, c2 = lane + 128, c3 = lane + 192;
      cv0 = __shfl(sl0, c0 >> 4) + __shfl(sl1, c0 & 15); cv1 = __shfl(sl0, c1 >> 4) + __shfl(sl1, c1 & 15);
      cv2 = __shfl(sl0, c2 >> 4) + __shfl(sl1, c2 & 15); cv3 = __shfl(sl0, c3 >> 4) + __shfl(sl1, c3 & 15); }
    float tv = -INFINITY; int tc = 0;
    for (int r = 0; r < 16; ++r) {
        float bv = cv0; int bc = lane;
        if (cv1 > bv) { bv = cv1; bc = lane + 64; }
        if (cv2 > bv) { bv = cv2; bc = lane + 128; }
        if (cv3 > bv) { bv = cv3; bc = lane + 192; }
#pragma unroll
        for (int o = 32; o >= 1; o >>= 1) { const float ov = __shfl_xor(bv, o); const int oc = __shfl_xor(bc, o); if (ov > bv || (ov == bv && oc < bc)) { bv = ov; bc = oc; } }
        if (lane == r) { tv = bv; tc = bc; }
        if (bc == lane) cv0 = -INFINITY; else if (bc == lane + 64) cv1 = -INFINITY; else if (bc == lane + 128) cv2 = -INFINITY; else if (bc == lane + 192) cv3 = -INFINITY;
    }
    const float mx = __shfl(tv, 0);
    const float e = lane < 16 ? expf(tv - mx) : 0.f;
    const float sum = wave_sum(e);
    const int e1 = __shfl(il0, (tc >> 4) & 15), e2 = __shfl(il1, tc & 15);
    if (lane < 16) { EID[(size_t)t * 128 + h * 16 + lane] = e1 * 128 + e2; GATE[(size_t)t * 128 + h * 16 + lane] = e / sum; }
}

__global__ void __launch_bounds__(256) k_topk_naive(const bf16_t* QP, const float* sub_keys, int* EID, float* GATE) { topk_item(QP, sub_keys, EID, GATE, blockIdx.x * 4 + (threadIdx.x >> 6), threadIdx.x & 63); }

__device__ __forceinline__ float gelu_tanh(float x) { const float u = 0.7978845608028654f * (x + 0.044715f * x * x * x); return 0.5f * x * (1.f + tanhf(u)); }

__device__ __forceinline__ void gather_item(const bf16_t* H2, const int* EID, const float* GATE, const float* peer_u, const float* peer_v, const float* mod, float* out, int t, int lane) {
    const int b = t / S_;
    float hv[16], y[16];
#pragma unroll
    for (int j = 0; j < 4; ++j) { const uint2 raw = *(const uint2*)(H2 + (size_t)t * 1024 + 4 * lane + 256 * j); hv[4 * j] = lo2f(raw.x); hv[4 * j + 1] = hi2f(raw.x); hv[4 * j + 2] = lo2f(raw.y); hv[4 * j + 3] = hi2f(raw.y); }
#pragma unroll
    for (int i = 0; i < 16; ++i) y[i] = 0.f;
    const int e_a = EID[(size_t)t * 128 + lane], e_b = EID[(size_t)t * 128 + 64 + lane];
    const float g_a = GATE[(size_t)t * 128 + lane], g_b = GATE[(size_t)t * 128 + 64 + lane];
    for (int jj = 0; jj < 128; ++jj) {
        const int e = jj < 64 ? __shfl(e_a, jj) : __shfl(e_b, jj - 64);
        const float g = jj < 64 ? __shfl(g_a, jj) : __shfl(g_b, jj - 64);
        const float4* ur = (const float4*)(peer_u + (size_t)e * 1024) + lane;
        float s = 0.f;
#pragma unroll
        for (int j = 0; j < 4; ++j) { const float4 u4 = ur[64 * j]; s += (u4.x * hv[4 * j] + u4.y * hv[4 * j + 1]) + (u4.z * hv[4 * j + 2] + u4.w * hv[4 * j + 3]); }
        s = wave_sum(s);
        const float wgt = g * gelu_tanh(s);
        const float4* vr = (const float4*)(peer_v + (size_t)e * 1024) + lane;
#pragma unroll
        for (int j = 0; j < 4; ++j) { const float4 v4 = vr[64 * j]; y[4 * j] += wgt * v4.x; y[4 * j + 1] += wgt * v4.y; y[4 * j + 2] += wgt * v4.z; y[4 * j + 3] += wgt * v4.w; }
    }
    const float* g2 = mod + b * 6144 + 5 * 1024;
#pragma unroll
    for (int j = 0; j < 4; ++j) { const int col = 4 * lane + 256 * j; float4* op = (float4*)(out + (size_t)t * 1024 + col); float4 x1 = *op; const float4 gg = *(const float4*)(g2 + col);
        x1.x += gg.x * y[4 * j]; x1.y += gg.y * y[4 * j + 1]; x1.z += gg.z * y[4 * j + 2]; x1.w += gg.w * y[4 * j + 3]; *op = x1; }
}
__global__ void __launch_bounds__(256) k_gather_naive(const bf16_t* H2, const int* EID, const float* GATE, const float* peer_u, const float* peer_v, const float* mod, float* out) {
    gather_item(H2, EID, GATE, peer_u, peer_v, mod, out, blockIdx.x * 4 + (threadIdx.x >> 6), threadIdx.x & 63);
}


namespace pg8 {
#define PG8_LAS __attribute__((address_space(3)))
typedef unsigned short bf16_t;
typedef short bf16x8 __attribute__((ext_vector_type(8)));
typedef float f32x4 __attribute__((ext_vector_type(4)));
typedef unsigned u32x4 __attribute__((ext_vector_type(4)));
constexpr int BM = 256, BK = 64, HALF = 128, HTB = HALF * BK * 2  , STAGE_BYTES = 8 * HTB, NXCD = 8, WGM = 8;

__host__ __device__ __forceinline__ int lds_byte(int r, int c) { const int st = (r >> 4) * 2 + (c >> 5), rr = r & 15, cc = c & 31, ob = rr * 64 + cc * 2; return st * 1024 + (ob ^ (((ob >> 9) & 1) << 5)); }
__host__ __device__ __forceinline__ void stage_rc(int b, int& R, int& C) { const int st = b / 1024, sb = b % 1024, swz = sb ^ (((sb >> 9) & 1) << 5); R = (st >> 1) * 16 + swz / 64; C = (st & 1) * 32 + (swz % 64) / 2; }
__host__ __device__ __forceinline__ int perm32(int rho) { const int n = rho >> 4, i = rho & 15; return 8 * (i >> 2) + 4 * n + (i & 3); }

struct Unit { int pm, pn; };
struct Gemm { const bf16_t* A; const bf16_t* Bt; int M, N, K, lda; };

struct StaticOrder {
    int nM, nN, nwg, G, c;
    __host__ __device__ void init(int M, int N, int G_, int c_) { nM = M / BM; nN = N / BM; nwg = nM * nN; G = G_; c = c_; }
    __host__ __device__ bool next(int i, Unit& u) const {
        const long L = (long)i * G + c; if (L >= nwg) return false;
        int wgid = (int)L; { const int q = nwg / NXCD, r = nwg % NXCD, xcd = wgid % NXCD, off = wgid / NXCD; wgid = (xcd < r ? xcd * (q + 1) : r * (q + 1) + (xcd - r) * q) + off; }
        const int nig = WGM * nN, gid = wgid / nig, fm = gid * WGM, gsz = (nM - fm) < WGM ? (nM - fm) : WGM;
        u.pm = fm + ((wgid % nig) % gsz); u.pn = (wgid % nig) / gsz; return true;
    }
    __device__ __forceinline__ void a_ready(const Unit&) const {}
    __device__ __forceinline__ void done(const Unit&) const {}
};
__device__ __forceinline__ unsigned cvt_pk_bf16(float lo, float hi) { unsigned r; asm volatile("v_cvt_pk_bf16_f32 %0, %1, %2" : "=v"(r) : "v"(lo), "v"(hi)); return r; }
typedef float f32x2 __attribute__((ext_vector_type(2)));
template <class Epi, class Sched, bool ALIGN_EPI = false, bool SP2 = false>
__device__ __forceinline__ void gemm_phase(PG8_LAS unsigned char* lds, const Gemm g, const Sched& S, const Epi& E) {
    const int tid = threadIdx.x, wid = __builtin_amdgcn_readfirstlane(tid >> 6), lane = tid & 63, wr = wid >> 2, wc = wid & 3, fr = lane & 15, fq = lane >> 4;
    const int K = g.K, nt = K / BK;
    unsigned voffA[2], voffB[2];
#pragma unroll
    for (int i = 0; i < 2; ++i) { int R, C; stage_rc(tid * 16 + i * 8192, R, C); const int Rb = Epi::PERM ? ((R & ~31) + perm32(R & 31)) : R;
        voffA[i] = (unsigned)(R * g.lda + C) * 2u; voffB[i] = (unsigned)(Rb * K + C) * 2u; }
    const size_t kstep = (size_t)(BK * 2);
    const size_t hstepA = (size_t)HALF * g.lda * 2, hstepB = (size_t)HALF * K * 2;
    const size_t tstepA = 2 * hstepA, tstepB = 2 * hstepB;
    const unsigned ldsw = (unsigned)wid * 1024u;
    const int aoff = lds_byte(wr * 64 + fr, fq * 8), boff = lds_byte(wc * 32 + fr, fq * 8);
#define PG8_SA(b, h) (((b) * 2 + (h)) * HTB)
#define PG8_SB(b, h) ((4 + (b) * 2 + (h)) * HTB)
#define PG8_STAGE(bufoff, gbase, voff) do { _Pragma("unroll") for (int _i = 0; _i < 2; ++_i) \
        __builtin_amdgcn_global_load_lds((const unsigned*)((const char*)(gbase) + (voff)[_i]), (PG8_LAS unsigned*)(lds + (bufoff) + ldsw + _i * 8192), 16, 0, 0); } while (0)
#define PG8_LDA(dst, b, h) do { _Pragma("unroll") for (int m = 0; m < 4; ++m) _Pragma("unroll") for (int k = 0; k < 2; ++k) dst[m][k] = *(const PG8_LAS bf16x8*)(lds + PG8_SA(b, h) + aoff + m * 2048 + k * 1024); } while (0)
#define PG8_LDB(dst, b, h) do { _Pragma("unroll") for (int n = 0; n < 2; ++n) _Pragma("unroll") for (int k = 0; k < 2; ++k) dst[n][k] = *(const PG8_LAS bf16x8*)(lds + PG8_SB(b, h) + boff + n * 2048 + k * 1024); } while (0)
#define PG8_MMA(ai, bj, At, Bt) do { __builtin_amdgcn_s_setprio(1); _Pragma("unroll") for (int m = 0; m < 4; ++m) _Pragma("unroll") for (int n = 0; n < 2; ++n) _Pragma("unroll") for (int k = 0; k < 2; ++k) \
        acc[ai][bj][m][n] = __builtin_amdgcn_mfma_f32_16x16x32_bf16(Bt[n][k], At[m][k], acc[ai][bj][m][n], 0, 0, 0); __builtin_amdgcn_s_setprio(0); } while (0)
#define PG8_WAIT_V(n) asm volatile("s_waitcnt vmcnt(" #n ")" ::: "memory")
#define PG8_WAIT_L(n) asm volatile("s_waitcnt lgkmcnt(" #n ")" ::: "memory")
#define PG8_BAR __builtin_amdgcn_s_barrier()
#define PG8_SCHED __builtin_amdgcn_sched_barrier(0)
    Unit cur, nxt; int ui = 0;
    if (!S.next(0, cur)) return;
    f32x4 acc[2][2][4][2];
#pragma unroll
    for (int a = 0; a < 2; ++a)
#pragma unroll
        for (int b = 0; b < 2; ++b)
#pragma unroll
            for (int m = 0; m < 4; ++m)
#pragma unroll
                for (int n = 0; n < 2; ++n) acc[a][b][m][n] = (f32x4){0.f, 0.f, 0.f, 0.f};
    bf16x8 At[4][2], B0[2][2], B1[2][2];
    const char* cA = (const char*)g.A + (size_t)cur.pm * tstepA; const char* cB = (const char*)g.Bt + (size_t)cur.pn * tstepB;
    S.a_ready(cur);
    if constexpr (SP2) {
        PG8_STAGE(PG8_SB(0, 0), cB, voffB); PG8_STAGE(PG8_SB(0, 1), cB + hstepB, voffB); PG8_STAGE(PG8_SA(0, 0), cA, voffA); PG8_STAGE(PG8_SA(0, 1), cA + hstepA, voffA);
        if (wr == 1) PG8_BAR;
        PG8_WAIT_V(2); PG8_BAR;
        PG8_STAGE(PG8_SB(1, 0), cB + kstep, voffB); PG8_STAGE(PG8_SA(1, 0), cA + kstep, voffA); PG8_STAGE(PG8_SB(1, 1), cB + hstepB + kstep, voffB);
        PG8_WAIT_V(6); PG8_BAR;
    } else {
        PG8_STAGE(PG8_SB(0, 0), cB, voffB); PG8_STAGE(PG8_SA(0, 0), cA, voffA); PG8_STAGE(PG8_SB(0, 1), cB + hstepB, voffB); PG8_STAGE(PG8_SA(0, 1), cA + hstepA, voffA);
        if (wr == 1) PG8_BAR;
        PG8_WAIT_V(4); PG8_BAR;
        PG8_STAGE(PG8_SB(1, 0), cB + kstep, voffB); PG8_STAGE(PG8_SA(1, 0), cA + kstep, voffA); PG8_STAGE(PG8_SB(1, 1), cB + hstepB + kstep, voffB);
        PG8_WAIT_V(6); PG8_BAR;
    }
    for (;;) {
        const bool has_next = S.next(ui + 1, nxt);
        const char* nA = has_next ? (const char*)g.A + (size_t)nxt.pm * tstepA : cA; const char* nB = has_next ? (const char*)g.Bt + (size_t)nxt.pn * tstepB : cB;
        for (int t = 0; t < nt; t += 2) {
            const bool last = (t == nt - 2);
            const char* a1 = cA + (size_t)(t + 1) * kstep;
            const char* a2 = last ? nA : cA + (size_t)(t + 2) * kstep; const char* b2 = last ? nB : cB + (size_t)(t + 2) * kstep;
            const char* a3 = a2 + kstep; const char* b3 = b2 + kstep;
            if (last && has_next) S.a_ready(nxt);
            if constexpr (SP2) {
            PG8_LDB(B0, 0, 0); PG8_LDB(B1, 0, 1); PG8_SCHED; PG8_LDA(At, 0, 0); PG8_STAGE(PG8_SA(1, 1), a1 + hstepA, voffA);
            PG8_WAIT_V(8); PG8_WAIT_L(0); PG8_BAR; PG8_MMA(0, 0, At, B0); PG8_MMA(0, 1, At, B1); PG8_BAR; PG8_SCHED;
            PG8_LDA(At, 0, 1); PG8_STAGE(PG8_SB(0, 0), b2, voffB); PG8_STAGE(PG8_SB(0, 1), b2 + hstepB, voffB); PG8_STAGE(PG8_SA(0, 0), a2, voffA);
            PG8_WAIT_V(8); PG8_WAIT_L(0); PG8_BAR; PG8_MMA(1, 0, At, B0); PG8_MMA(1, 1, At, B1); PG8_BAR; PG8_SCHED;
            PG8_LDB(B0, 1, 0); PG8_LDB(B1, 1, 1); PG8_SCHED; PG8_LDA(At, 1, 0); PG8_STAGE(PG8_SA(0, 1), a2 + hstepA, voffA);
            PG8_WAIT_V(8); PG8_WAIT_L(0); PG8_BAR; PG8_MMA(0, 0, At, B0); PG8_MMA(0, 1, At, B1); PG8_BAR; PG8_SCHED;
            PG8_LDA(At, 1, 1); PG8_STAGE(PG8_SB(1, 0), b3, voffB); PG8_STAGE(PG8_SB(1, 1), b3 + hstepB, voffB); PG8_STAGE(PG8_SA(1, 0), a3, voffA);
            PG8_WAIT_V(8); PG8_WAIT_L(0); PG8_BAR; PG8_MMA(1, 0, At, B0); PG8_MMA(1, 1, At, B1); PG8_BAR; PG8_SCHED;
            } else {
            PG8_LDB(B0, 0, 0); PG8_SCHED; PG8_LDA(At, 0, 0); PG8_STAGE(PG8_SA(1, 1), a1 + hstepA, voffA);
            PG8_WAIT_L(8); PG8_BAR; PG8_WAIT_L(0); PG8_MMA(0, 0, At, B0); PG8_BAR; PG8_SCHED;
            PG8_LDB(B1, 0, 1); PG8_STAGE(PG8_SB(0, 0), b2, voffB);
            PG8_BAR; PG8_WAIT_L(0); PG8_MMA(0, 1, At, B1); PG8_BAR;
            PG8_LDA(At, 0, 1); PG8_STAGE(PG8_SA(0, 0), a2, voffA);
            PG8_BAR; PG8_WAIT_L(0); PG8_MMA(1, 0, At, B0); PG8_BAR; PG8_SCHED;
            PG8_STAGE(PG8_SB(0, 1), b2 + hstepB, voffB);
            PG8_WAIT_V(6); PG8_BAR; PG8_MMA(1, 1, At, B1); PG8_BAR;
            PG8_LDB(B0, 1, 0); PG8_SCHED; PG8_LDA(At, 1, 0); PG8_STAGE(PG8_SA(0, 1), a2 + hstepA, voffA);
            PG8_WAIT_L(8); PG8_BAR; PG8_WAIT_L(0); PG8_MMA(0, 0, At, B0); PG8_BAR; PG8_SCHED;
            PG8_LDB(B1, 1, 1); PG8_STAGE(PG8_SB(1, 0), b3, voffB);
            PG8_BAR; PG8_WAIT_L(0); PG8_MMA(0, 1, At, B1); PG8_BAR;
            PG8_LDA(At, 1, 1); PG8_STAGE(PG8_SA(1, 0), a3, voffA);
            PG8_BAR; PG8_WAIT_L(0); PG8_MMA(1, 0, At, B0); PG8_BAR; PG8_SCHED;
            PG8_STAGE(PG8_SB(1, 1), b3 + hstepB, voffB);
            PG8_WAIT_V(6); PG8_BAR; PG8_MMA(1, 1, At, B1); PG8_BAR;
            }
        }
        if constexpr (ALIGN_EPI) { if (wr == 0) PG8_BAR; }
        if constexpr (!Epi::AFTER_DRAIN) { E(acc, cur, wr, wc, fr, fq); S.done(cur); }
        if (!has_next) break;
#pragma unroll
        for (int a = 0; a < 2; ++a)
#pragma unroll
            for (int b = 0; b < 2; ++b)
#pragma unroll
                for (int m = 0; m < 4; ++m)
#pragma unroll
                    for (int n = 0; n < 2; ++n) acc[a][b][m][n] = (f32x4){0.f, 0.f, 0.f, 0.f};
        cur = nxt; cA = nA; cB = nB; ++ui;
        if constexpr (ALIGN_EPI) { if (wr == 1) PG8_BAR; }
    }
    PG8_WAIT_V(0);
    if constexpr (!ALIGN_EPI) { if (wr == 0) PG8_BAR; }
    PG8_BAR;
    if constexpr (Epi::AFTER_DRAIN) { E.fused(acc, cur, wr, wc, fr, fq, lds, wid, lane); S.done(cur); }
#undef PG8_SA
#undef PG8_SB
#undef PG8_STAGE
#undef PG8_LDA
#undef PG8_LDB
#undef PG8_MMA
#undef PG8_WAIT_V
#undef PG8_WAIT_L
#undef PG8_BAR
#undef PG8_SCHED
}
}


#define GAS __attribute__((address_space(1)))
#define LAS __attribute__((address_space(3)))
typedef float f32x4 __attribute__((ext_vector_type(4)));
typedef unsigned u32x4 __attribute__((ext_vector_type(4)));
#define XB_TMO      128
#define XB_XCNT(j)  (256  + 64 * (j))
#define XB_XSUB(j)  (1280 + 64 * (j))
#define XB_XGEN(j)  (2304 + 64 * (j))
#define XB_TOP      3328
#define XB_TOPGEN   3392
#define XCD_BAR_WORDS 3456
#define XB_SPIN_CAP (1u << 18)

__device__ __forceinline__ unsigned xb_ld(unsigned* p)              { return __hip_atomic_load(p, __ATOMIC_RELAXED, __HIP_MEMORY_SCOPE_AGENT); }
__device__ __forceinline__ unsigned xb_add(unsigned* p, unsigned v) { return __hip_atomic_fetch_add(p, v, __ATOMIC_RELAXED, __HIP_MEMORY_SCOPE_AGENT); }
__device__ __forceinline__ unsigned xb_xcc_id() { return (unsigned)__builtin_amdgcn_s_getreg((3 << 11) | 20) & 0xFu; }
#define XB_SPIN(cond, bar) do { unsigned _sp = 0; while (cond) { __builtin_amdgcn_s_sleep(1); \
    if ((++_sp & 255u) == 0u) { if (xb_ld(&(bar)[XB_TMO])) break; if (_sp > XB_SPIN_CAP) { atomicAdd(&(bar)[XB_TMO], 1u); break; } } } } while (0)

struct XcdBarrier {
    unsigned* bar; unsigned x;
    volatile LAS unsigned* st;
};

__device__ __forceinline__ XcdBarrier xcd_barrier_post(unsigned* bar, volatile LAS unsigned* st) {
    XcdBarrier b; b.bar = bar; b.x = xb_xcc_id(); b.st = st;
    if (threadIdx.x == 0) (void)xb_add(&bar[XB_XCNT(b.x)], 1u);
    return b;
}
__device__ __forceinline__ void xcd_barrier_complete(unsigned* bar, unsigned x, unsigned& nloc, unsigned& nx) {
    const unsigned G = gridDim.x * gridDim.y * gridDim.z;
    unsigned sum, cnt, mine, sp = 0u;
    for (;;) {
        sum = 0u; cnt = 0u; mine = 0u;
#pragma unroll
        for (unsigned j = 0; j < 16; ++j) { const unsigned c = xb_ld(&bar[XB_XCNT(j)]); sum += c; cnt += (c > 0u) ? 1u : 0u; mine = (j == x) ? c : mine; }
        if (sum == G) break;
        __builtin_amdgcn_s_sleep(1);
        if ((++sp & 255u) == 0u) { if (xb_ld(&bar[XB_TMO])) break; if (sp > XB_SPIN_CAP) { atomicAdd(&bar[XB_TMO], 1u); break; } }
    }
    nloc = mine > 0u ? mine : 1u; nx = cnt > 0u ? cnt : 1u;
}

__device__ __forceinline__ void xcd_barrier(const XcdBarrier& b) {
    asm volatile("s_waitcnt vmcnt(0)" ::: "memory");
    __syncthreads();
    if (threadIdx.x == 0) {
        unsigned* bar = b.bar;
        __builtin_amdgcn_s_waitcnt(0);
        unsigned nloc = b.st[0], nx = b.st[1];
        if (nloc == 0u) { xcd_barrier_complete(bar, b.x, nloc, nx); b.st[0] = nloc; b.st[1] = nx; }
        const unsigned old = xb_add(&bar[XB_XSUB(b.x)], 1u);
        const unsigned gen = old / nloc;
        if (old + 1u == (gen + 1u) * nloc) {
            __builtin_amdgcn_fence(__ATOMIC_RELEASE, "agent");
            asm volatile("s_waitcnt vmcnt(0)" ::: "memory");
            const unsigned og = xb_add(&bar[XB_TOP], 1u);
            const unsigned tg = og / nx;
            if (og + 1u == (tg + 1u) * nx) xb_add(&bar[XB_TOPGEN], 1u);
            else XB_SPIN(xb_ld(&bar[XB_TOPGEN]) == tg, bar);
            __builtin_amdgcn_fence(__ATOMIC_ACQUIRE, "agent");
            xb_add(&bar[XB_XGEN(b.x)], 1u);
            asm volatile("s_waitcnt vmcnt(0)" ::: "memory");
        } else {
            XB_SPIN(xb_ld(&bar[XB_XGEN(b.x)]) == gen, bar);
            __builtin_amdgcn_fence(__ATOMIC_ACQUIRE, "agent");
            asm volatile("s_waitcnt vmcnt(0)" ::: "memory");
        }
    }
    __syncthreads();
}


constexpr int NWAVES = 8;
constexpr int RING_BYTES = 131072, LDSCTL_OFF = RING_BYTES, MISC_OFF = LDSCTL_OFF + 320, LDS_BYTES = 147456;
constexpr size_t WS_CTL = 0, CTL_ZERO_BYTES = 1 * MiB;
constexpr int CW_BAR = 4096, N_BAR_REGIONS = 16;
static_assert((CW_BAR + N_BAR_REGIONS * XCD_BAR_WORDS) * 4 <= (int)CTL_ZERO_BYTES, "barrier words inside the memset region");
constexpr size_t WS_WIN = 10 * MiB;
constexpr size_t WS_WUQ = 15 * MiB;
constexpr size_t WS_WUKV = 16 * MiB;
constexpr size_t WS_WO = 17 * MiB;
constexpr size_t WS_WPQ = 19 * MiB;
constexpr size_t WS_SK = 23 * MiB;
constexpr size_t WS_U16 = 24 * MiB;
constexpr size_t WS_V16 = 56 * MiB;


namespace att {
typedef short bf16x8 __attribute__((ext_vector_type(8)));
typedef short s16x4 __attribute__((ext_vector_type(4)));
typedef float f32x16 __attribute__((ext_vector_type(16)));
constexpr int LK = 0, KSLOT = 12288, LV = 2 * KSLOT, VSLOT = 8192, LB = LV + 2 * VSLOT, BSLOT = 256, LWS = LB + 2 * BSLOT, LOST = LWS + 8 * 256, ATT_LDS = LOST + 8 * 4096;
static_assert(ATT_LDS <= 131072, "attention scratch fits the ring region");
struct Desc { const bf16_t* Q; int pq; const bf16_t* K; int pk; const bf16_t* V; int pv; bf16_t* O; int po; const float* FC; };

__device__ __forceinline__ int crow(int r, int hi) { return (r & 3) + 8 * (r >> 2) + 4 * hi; }
__device__ __forceinline__ float xmax32(float v) { auto rr = __builtin_amdgcn_permlane32_swap(__float_as_uint(v), __float_as_uint(v), false, false); return fmaxf(__uint_as_float(rr[0]), __uint_as_float(rr[1])); }
__device__ __forceinline__ float xsum32(float v) { auto rr = __builtin_amdgcn_permlane32_swap(__float_as_uint(v), __float_as_uint(v), false, false); return __uint_as_float(rr[0]) + __uint_as_float(rr[1]); }
__device__ __forceinline__ unsigned cvtpk(float lo, float hi) { typedef float f2 __attribute__((ext_vector_type(2))); typedef __bf16 b2 __attribute__((ext_vector_type(2))); f2 v = {lo, hi}; b2 b = __builtin_convertvector(v, b2); return __builtin_bit_cast(unsigned, b); }
typedef short v4i16_t __attribute__((ext_vector_type(4)));
__device__ __forceinline__ s16x4 vtr(LAS const unsigned char* p) { return __builtin_bit_cast(s16x4, __builtin_amdgcn_ds_read_tr16_b64_v4i16((LAS v4i16_t*)p)); }

template <int KS, bool BIAS>
__device__ __forceinline__ void attn_unit(const Desc& d, int qb, int j0, LAS unsigned char* shm) {
    const int tid = threadIdx.x, lane = tid & 63, r32 = lane & 31, hi = lane >> 5; const int wid = __builtin_amdgcn_readfirstlane(tid >> 6);
    const int q0 = qb * 256, NT = (q0 + 256) / 64;
    LAS float* wsf = (LAS float*)(shm + LWS) + wid * 64;
    bf16x8 qr[KS];
    { const bf16_t* qp = d.Q + (size_t)(q0 + wid * 32 + r32) * d.pq + hi * 8;
#pragma unroll
      for (int d0 = 0; d0 < KS; ++d0) qr[d0] = *(const bf16x8*)(qp + d0 * 16); }
    const float fcref = BIAS ? d.FC[q0] : 0.f;
    const bf16_t* ksrc0 = d.K + (size_t)lane * d.pk + wid * 8;
    const bf16_t* ksrc1 = d.K + (size_t)lane * d.pk + (8 + wid) * 8;
    const bf16_t* vsrc = d.V + (size_t)(16 * (wid & 3) + (lane >> 2)) * d.pv + (wid >> 2) * 32 + (lane & 3) * 8;
    const int kdst0 = LK + wid * 1024 + lane * 16, kdst1 = LK + (8 + wid) * 1024 + lane * 16, vdst = LV + wid * 1024 + lane * 16;
    const bool k2 = (KS > 4) && (wid < 2 * KS - 8);
    u32x4 kr0, kr1, vr; float br = 0.f;
#define ATT_LOAD(t) do { kr0 = *(const u32x4*)(ksrc0 + (size_t)(t) * 64 * d.pk); if (k2) kr1 = *(const u32x4*)(ksrc1 + (size_t)(t) * 64 * d.pk); \
        vr = *(const u32x4*)(vsrc + (size_t)(t) * 64 * d.pv); if (BIAS && wid == 4) br = d.FC[(t) * 64 + lane]; } while (0)
#define ATT_WRITE(slot) do { *(LAS u32x4*)(shm + kdst0 + (slot) * KSLOT) = kr0; if (k2) *(LAS u32x4*)(shm + kdst1 + (slot) * KSLOT) = kr1; \
        *(LAS u32x4*)(shm + vdst + (slot) * VSLOT) = vr; if (BIAS && wid == 4) *(LAS float*)(shm + LB + (slot) * BSLOT + lane * 4) = (fcref - br) * LOG2E; } while (0)
    f32x16 o0, o1, negm;
#pragma unroll
    for (int r = 0; r < 16; ++r) { o0[r] = 0.f; o1[r] = 0.f; negm[r] = 0.f; }
    float mref = 0.f, l = 0.f;
    constexpr float THR = 8.f;
    const int qrel = wid * 32 + r32;
    const int kfrag = LK + hi * 1024 + r32 * 16;
    const int vfrag = LV + ((lane >> 4) & 1) * 32 + (lane & 3) * 8 + (4 * hi + ((lane & 15) >> 2)) * 64;
    ATT_LOAD(j0); ATT_WRITE(0);
    __syncthreads();
    for (int t = j0; t < NT; ++t) {
        const int slot = (t - j0) & 1;
        if (t + 1 < NT) ATT_LOAD(t + 1);
        const int jb = t - (NT - 4);
        if (!(jb >= 0 && 64 * jb > 32 * wid + 31)) {
            f32x16 p0, p1;
            if (BIAS) {
                LAS const unsigned char* bp = shm + LB + slot * BSLOT + 16 * hi;
#pragma unroll
                for (int g = 0; g < 4; ++g) { const f32x4 a = *(LAS const f32x4*)(bp + 32 * g), b = *(LAS const f32x4*)(bp + 128 + 32 * g);
#pragma unroll
                    for (int i = 0; i < 4; ++i) { p0[4 * g + i] = a[i] + negm[4 * g + i]; p1[4 * g + i] = b[i] + negm[4 * g + i]; } }
            } else { p0 = negm; p1 = negm; }
            LAS const unsigned char* kp = shm + kfrag + slot * KSLOT;
            __builtin_amdgcn_s_setprio(1);
#pragma unroll
            for (int d0 = 0; d0 < KS; ++d0) {
                const bf16x8 a0 = *(LAS const bf16x8*)(kp + d0 * 2048), a1 = *(LAS const bf16x8*)(kp + d0 * 2048 + 512);
                p0 = __builtin_amdgcn_mfma_f32_32x32x16_bf16(a0, qr[d0], p0, 0, 0, 0);
                p1 = __builtin_amdgcn_mfma_f32_32x32x16_bf16(a1, qr[d0], p1, 0, 0, 0);
            }
            __builtin_amdgcn_s_setprio(0);
            if (jb >= 0) {
                const int kb = 64 * jb + 4 * hi;
#pragma unroll
                for (int r = 0; r < 16; ++r) { const int kv = kb + (r & 3) + 8 * (r >> 2); if (kv > qrel) p0[r] = -INFINITY; if (kv + 32 > qrel) p1[r] = -INFINITY; }
            }
            float ra = __builtin_fmaxf(__builtin_fmaxf(p0[0], p0[1]), p1[0]), rb = __builtin_fmaxf(__builtin_fmaxf(p0[2], p0[3]), p1[1]);
            ra = __builtin_fmaxf(__builtin_fmaxf(ra, p1[2]), p1[3]);
#pragma unroll
            for (int r = 4; r < 16; r += 4) { ra = __builtin_fmaxf(__builtin_fmaxf(ra, p0[r]), p0[r + 1]); rb = __builtin_fmaxf(__builtin_fmaxf(rb, p0[r + 2]), p0[r + 3]);
                ra = __builtin_fmaxf(__builtin_fmaxf(ra, p1[r]), p1[r + 1]); rb = __builtin_fmaxf(__builtin_fmaxf(rb, p1[r + 2]), p1[r + 3]); }
            const float rm = xmax32(__builtin_fmaxf(ra, rb));
            if (__any(rm > THR) || t == j0) {
                const float dl = t == j0 ? rm : __builtin_fmaxf(rm, 0.f);
                mref += dl;
#pragma unroll
                for (int r = 0; r < 16; ++r) { p0[r] -= dl; p1[r] -= dl; negm[r] = -mref; }
                if (t != j0) {
                    const float alpha = __builtin_amdgcn_exp2f(-dl);
                    l *= alpha;
                    if (hi == 0) wsf[r32] = alpha;
#pragma unroll
                    for (int g = 0; g < 4; ++g) { const f32x4 a = *(LAS const f32x4*)(wsf + 8 * g + 4 * hi);
#pragma unroll
                        for (int i = 0; i < 4; ++i) { o0[4 * g + i] *= a[i]; o1[4 * g + i] *= a[i]; } }
                }
            }
            float s0 = 0.f, s1 = 0.f, s2 = 0.f, s3 = 0.f;
#pragma unroll
            for (int r = 0; r < 16; r += 2) { p0[r] = __builtin_amdgcn_exp2f(p0[r]); p0[r + 1] = __builtin_amdgcn_exp2f(p0[r + 1]); p1[r] = __builtin_amdgcn_exp2f(p1[r]); p1[r + 1] = __builtin_amdgcn_exp2f(p1[r + 1]);
                s0 += p0[r]; s1 += p0[r + 1]; s2 += p1[r]; s3 += p1[r + 1]; }
            l += (s0 + s1) + (s2 + s3);
            LAS const unsigned char* vp = shm + vfrag + slot * VSLOT;
            __builtin_amdgcn_s_setprio(1);
#pragma unroll
            for (int ks = 0; ks < 4; ++ks) {
                const f32x16& pp = ks < 2 ? p0 : p1; const int bq = (ks & 1) * 8;
                u32x4 pw; pw.x = cvtpk(pp[bq], pp[bq + 1]); pw.y = cvtpk(pp[bq + 2], pp[bq + 3]); pw.z = cvtpk(pp[bq + 4], pp[bq + 5]); pw.w = cvtpk(pp[bq + 6], pp[bq + 7]);
                const bf16x8 pa = __builtin_bit_cast(bf16x8, pw);
                const s16x4 l0 = vtr(vp + ks * 1024), h0 = vtr(vp + ks * 1024 + 512), l1 = vtr(vp + 4096 + ks * 1024), h1 = vtr(vp + 4096 + ks * 1024 + 512);
                const bf16x8 v0 = {l0[0], l0[1], l0[2], l0[3], h0[0], h0[1], h0[2], h0[3]}, v1 = {l1[0], l1[1], l1[2], l1[3], h1[0], h1[1], h1[2], h1[3]};
                o0 = __builtin_amdgcn_mfma_f32_32x32x16_bf16(pa, v0, o0, 0, 0, 0);
                o1 = __builtin_amdgcn_mfma_f32_32x32x16_bf16(pa, v1, o1, 0, 0, 0);
            }
            __builtin_amdgcn_s_setprio(0);
        }
        if (t + 1 < NT) ATT_WRITE(slot ^ 1);
        __syncthreads();
    }
#undef ATT_LOAD
#undef ATT_WRITE
    l = xsum32(l);
    if (hi == 0) wsf[32 + r32] = l;
    float rli[16];
#pragma unroll
    for (int g = 0; g < 4; ++g) { const f32x4 a = *(LAS const f32x4*)(wsf + 32 + 8 * g + 4 * hi);
#pragma unroll
        for (int i = 0; i < 4; ++i) rli[4 * g + i] = 1.f / a[i]; }
    LAS bf16_t* stg = (LAS bf16_t*)(shm + LOST) + wid * 2048;
#pragma unroll
    for (int r = 0; r < 16; ++r) { const int orow = crow(r, hi); stg[orow * 64 + r32] = f2bf(o0[r] * rli[r]); stg[orow * 64 + 32 + r32] = f2bf(o1[r] * rli[r]); }
    bf16_t* Ow = d.O + (size_t)(q0 + wid * 32) * d.po;
#pragma unroll
    for (int i = 0; i < 4; ++i) { const int row = i * 8 + (lane >> 3), ch = lane & 7; const u32x4 v = *(LAS const u32x4*)(stg + row * 64 + ch * 8); *(u32x4*)(Ow + (size_t)row * d.po + ch * 8) = v; }
    __syncthreads();
}
}


namespace pk {
typedef short bf16x8 __attribute__((ext_vector_type(8)));
typedef float f32x16 __attribute__((ext_vector_type(16)));
__device__ __forceinline__ unsigned f2sort(float f) { const unsigned b = __float_as_uint(f); return b ^ ((unsigned)((int)b >> 31) | 0x80000000u); }
__device__ __forceinline__ float sort2f(unsigned u) { return __uint_as_float((u & 0x80000000u) ? (u ^ 0x80000000u) : ~u); }
__device__ __forceinline__ void ce(unsigned& a, unsigned& b) { const unsigned mx = a > b ? a : b, mn = a > b ? b : a; a = mx; b = mn; }
__device__ __forceinline__ void sort16(unsigned (&v)[16]) {
#pragma unroll
    for (int k = 2; k <= 16; k <<= 1)
#pragma unroll
        for (int j = k >> 1; j >= 1; j >>= 1)
#pragma unroll
            for (int i = 0; i < 16; ++i) { const int l = i ^ j; if (l > i) { if ((i & k) == 0) ce(v[i], v[l]); else ce(v[l], v[i]); } }
}
__device__ __forceinline__ void merge16(unsigned (&a)[16], const unsigned (&b)[16]) {
#pragma unroll
    for (int i = 0; i < 16; ++i) a[i] = a[i] > b[15 - i] ? a[i] : b[15 - i];
#pragma unroll
    for (int j = 8; j >= 1; j >>= 1)
#pragma unroll
        for (int i = 0; i < 16; ++i) { const int l = i ^ j; if (l > i) ce(a[i], a[l]); }
}
__device__ __forceinline__ void top16of64(unsigned (&k)[64], unsigned (&out)[16]) {
    unsigned g1[16], g2[16], g3[16];
#pragma unroll
    for (int i = 0; i < 16; ++i) { out[i] = k[i]; g1[i] = k[16 + i]; g2[i] = k[32 + i]; g3[i] = k[48 + i]; }
    sort16(out); sort16(g1); sort16(g2); sort16(g3);
    merge16(out, g1); merge16(g2, g3); merge16(out, g2);
}
__device__ __forceinline__ unsigned sel4(const unsigned (&w)[4], int q) { const unsigned a = q & 1 ? w[1] : w[0], b = q & 1 ? w[3] : w[2]; return q & 2 ? b : a; }

template <int I> struct COff { static constexpr int v = COff<I - 1>::v + 16 / I; };
template <> struct COff<0> { static constexpr int v = 0; };
static_assert(COff<16>::v == 50, "50 candidates can reach the top 16 of a sorted 16 x 16 sum grid");
template <int I> __device__ __forceinline__ void fill_cand(unsigned (&c64)[64], const float (&s1)[16], const float (&s2)[16]) {
    if constexpr (I < 16) {
#pragma unroll
        for (int j = 0; j < 16 / (I + 1); ++j) c64[COff<I>::v + j] = (f2sort(s1[I] + s2[j]) & 0xFFFFFF00u) | (unsigned)(255 - (I * 16 + j));
        fill_cand<I + 1>(c64, s1, s2);
    }
}
__device__ __forceinline__ void topk_item(const bf16_t* QP, const bf16_t* SK, int* EID, float* GATE, int item, int lane) {
    const int tg = item >> 3, h = item & 7, r32 = lane & 31, hi = lane >> 5;
    const int t = tg * 32 + r32;
    unsigned own[2][16];
#pragma unroll
    for (int p = 0; p < 2; ++p) {
        const bf16_t* qrow = QP + (size_t)t * 2048 + h * 256 + p * 128 + hi * 8;
        bf16x8 qf[8];
#pragma unroll
        for (int d0 = 0; d0 < 8; ++d0) qf[d0] = *(const bf16x8*)(qrow + d0 * 16);
        const bf16_t* skb = SK + (size_t)((h * 2 + p) * 128 + r32) * 128 + hi * 8;
#pragma unroll 1
        for (int kt = 0; kt < 4; ++kt) {
            f32x16 acc;
#pragma unroll
            for (int r = 0; r < 16; ++r) acc[r] = 0.f;
#pragma unroll
            for (int d0 = 0; d0 < 8; ++d0) { const bf16x8 a = *(const bf16x8*)(skb + (size_t)kt * 32 * 128 + d0 * 16); acc = __builtin_amdgcn_mfma_f32_32x32x16_bf16(a, qf[d0], acc, 0, 0, 0); }
            unsigned cur[16];
#pragma unroll
            for (int r = 0; r < 16; ++r) { const int idx0 = kt * 32 + (r & 3) + 8 * (r >> 2);
                cur[r] = (f2sort(acc[r]) & 0xFFFFFF80u) | (unsigned)(127 - idx0 - 4 * hi); }
            sort16(cur);
            if (kt == 0) {
#pragma unroll
                for (int r = 0; r < 16; ++r) own[p][r] = cur[r];
            } else merge16(own[p], cur);
        }
    }
    unsigned fin[16];
    {
        unsigned oth[16];
#pragma unroll
        for (int i = 0; i < 16; ++i) { auto rr = __builtin_amdgcn_permlane32_swap(own[0][i], own[1][i], false, false); fin[i] = rr[0]; oth[i] = rr[1]; }
        merge16(fin, oth);
    }
    unsigned s1k[16], s2k[16];
#pragma unroll
    for (int i = 0; i < 16; ++i) { auto rr = __builtin_amdgcn_permlane32_swap(fin[i], fin[i], false, false); s1k[i] = rr[0]; s2k[i] = rr[1]; }
    float s1[16], s2[16]; unsigned long long i1lo = 0ull, i1hi = 0ull, i2lo = 0ull, i2hi = 0ull;
#pragma unroll
    for (int i = 0; i < 16; ++i) { s1[i] = sort2f(s1k[i] & 0xFFFFFF80u); s2[i] = sort2f(s2k[i] & 0xFFFFFF80u);
        const unsigned long long a = (unsigned long long)(127u - (s1k[i] & 0x7Fu)) << (8 * (i & 7)), b = (unsigned long long)(127u - (s2k[i] & 0x7Fu)) << (8 * (i & 7));
        if (i < 8) { i1lo |= a; i2lo |= b; } else { i1hi |= a; i2hi |= b; } }
    unsigned c64[64];
#pragma unroll
    for (int i = 50; i < 64; ++i) c64[i] = 0u;
    fill_cand<0>(c64, s1, s2);
    unsigned top[16];
    top16of64(c64, top);
    float ev[16]; float sum = 0.f; const float mx = sort2f(top[0] & 0xFFFFFF00u);
#pragma unroll
    for (int r = 0; r < 16; ++r) { ev[r] = __expf(sort2f(top[r] & 0xFFFFFF00u) - mx); sum += ev[r]; }
    const float rs = 1.f / sum;
    if (hi == 0) {
        int* ep = EID + (size_t)t * 128 + h * 16;
#pragma unroll
        for (int q4 = 0; q4 < 4; ++q4) { int ee[4];
#pragma unroll
            for (int z = 0; z < 4; ++z) { const int code = 255 - (int)(top[q4 * 4 + z] & 0xFFu), i = code >> 4, j = code & 15;
                const unsigned e1 = (unsigned)(((i & 8) ? i1hi : i1lo) >> (8 * (i & 7))) & 0xFFu, e2 = (unsigned)(((j & 8) ? i2hi : i2lo) >> (8 * (j & 7))) & 0xFFu; ee[z] = (int)(e1 * 128u + e2); }
            *(int4*)(ep + q4 * 4) = make_int4(ee[0], ee[1], ee[2], ee[3]); }
    } else {
        float* gp = GATE + (size_t)t * 128 + h * 16;
#pragma unroll
        for (int q4 = 0; q4 < 4; ++q4) *(float4*)(gp + q4 * 4) = make_float4(ev[q4 * 4] * rs, ev[q4 * 4 + 1] * rs, ev[q4 * 4 + 2] * rs, ev[q4 * 4 + 3] * rs);
    }
}
}


namespace gx {
typedef unsigned char u8x4 __attribute__((ext_vector_type(4)));
__device__ __forceinline__ int sdot16(const int4 a, const int4 b) {
    int s = __builtin_amdgcn_sdot4(a.x, b.x, 0, false); s = __builtin_amdgcn_sdot4(a.y, b.y, s, false); s = __builtin_amdgcn_sdot4(a.z, b.z, s, false); return __builtin_amdgcn_sdot4(a.w, b.w, s, false);
}
__device__ __forceinline__ void quant_row(const float* src, unsigned char* dst, float* scale_out, int lane) {
    const float4* sr = (const float4*)src + lane; float4 v[4]; float am = 0.f;
#pragma unroll
    for (int j = 0; j < 4; ++j) { v[j] = sr[64 * j]; am = fmaxf(am, fmaxf(fmaxf(fabsf(v[j].x), fabsf(v[j].y)), fmaxf(fabsf(v[j].z), fabsf(v[j].w)))); }
#pragma unroll
    for (int o = 1; o < 64; o <<= 1) am = fmaxf(am, __shfl_xor(am, o));
    const float inv = am > 0.f ? 127.f / am : 0.f;
#pragma unroll
    for (int j = 0; j < 4; ++j) { const int q0 = (int)rintf(v[j].x * inv), q1 = (int)rintf(v[j].y * inv), q2 = (int)rintf(v[j].z * inv), q3 = (int)rintf(v[j].w * inv);
        *(unsigned*)(dst + 4 * lane + 256 * j) = (unsigned)(q0 & 255) | ((unsigned)(q1 & 255) << 8) | ((unsigned)(q2 & 255) << 16) | ((unsigned)(q3 & 255) << 24); }
    if (lane == 0) *scale_out = am * (1.f / 127.f);
}
__device__ __forceinline__ float gelu_t(float x) { const float u = 0.7978845608028654f * (x + 0.044715f * x * x * x); return 0.5f * x * (1.f + tanhf(u)); }

__device__ __forceinline__ int hx(int lo, int hi, bool up, int bit) { const int send = up ? lo : hi, keep = up ? hi : lo; return keep + __shfl_xor(send, bit); }

__device__ __forceinline__ void u_token(const unsigned char* UQs  , const int4 (&ev)[4], const int4 hq, int* PArow, int lane) {
    const int e[16] = {ev[0].x, ev[0].y, ev[0].z, ev[0].w, ev[1].x, ev[1].y, ev[1].z, ev[1].w, ev[2].x, ev[2].y, ev[2].z, ev[2].w, ev[3].x, ev[3].y, ev[3].z, ev[3].w};
    int4 rows[16];
#pragma unroll
    for (int i = 0; i < 16; ++i) rows[i] = *(const int4*)(UQs + (size_t)e[i] * 1024);
    int p[16];
#pragma unroll
    for (int i = 0; i < 16; ++i) p[i] = sdot16(rows[i], hq);
    const bool b2 = (lane & 4) != 0, b1 = (lane & 2) != 0, b0 = (lane & 1) != 0;
    int q[8], r[4];
#pragma unroll
    for (int k = 0; k < 8; ++k) q[k] = hx(p[k], p[8 + k], b2, 4);
#pragma unroll
    for (int k = 0; k < 4; ++k) r[k] = hx(q[k], q[4 + k], b1, 2);
    const int z0 = hx(r[0], r[2], b0, 1), z1 = hx(r[1], r[3], b0, 1);
    *(int2*)(PArow + 2 * lane) = make_int2(z0, z1);
}

__device__ __forceinline__ void v_token(const unsigned char* VQs  , const int4 (&ev)[4], const int4 wh, const int4 wlo, float wscale, const float* gate2, const float* x1row, float* outrow, int s, int lane) {
    const int e[16] = {ev[0].x, ev[0].y, ev[0].z, ev[0].w, ev[1].x, ev[1].y, ev[1].z, ev[1].w, ev[2].x, ev[2].y, ev[2].z, ev[2].w, ev[3].x, ev[3].y, ev[3].z, ev[3].w};
    const int whv[4] = {wh.x, wh.y, wh.z, wh.w}, wlv[4] = {wlo.x, wlo.y, wlo.z, wlo.w};
    uint4 rows[16];
#pragma unroll
    for (int i = 0; i < 16; ++i) rows[i] = *(const uint4*)(VQs + (size_t)e[i] * 1024);
    int ah[16], al[16];
#pragma unroll
    for (int c = 0; c < 16; ++c) { ah[c] = 0; al[c] = 0; }
#pragma unroll
    for (int g = 0; g < 4; ++g) {
#pragma unroll
        for (int d = 0; d < 4; ++d) {
            const unsigned A = d == 0 ? rows[4 * g].x : d == 1 ? rows[4 * g].y : d == 2 ? rows[4 * g].z : rows[4 * g].w;
            const unsigned B = d == 0 ? rows[4 * g + 1].x : d == 1 ? rows[4 * g + 1].y : d == 2 ? rows[4 * g + 1].z : rows[4 * g + 1].w;
            const unsigned C = d == 0 ? rows[4 * g + 2].x : d == 1 ? rows[4 * g + 2].y : d == 2 ? rows[4 * g + 2].z : rows[4 * g + 2].w;
            const unsigned D = d == 0 ? rows[4 * g + 3].x : d == 1 ? rows[4 * g + 3].y : d == 2 ? rows[4 * g + 3].z : rows[4 * g + 3].w;
            const unsigned ab01 = __builtin_amdgcn_perm(A, B, 0x01050004u), ab23 = __builtin_amdgcn_perm(A, B, 0x03070206u);
            const unsigned cd01 = __builtin_amdgcn_perm(C, D, 0x01050004u), cd23 = __builtin_amdgcn_perm(C, D, 0x03070206u);
            const int q0 = (int)__builtin_amdgcn_perm(ab01, cd01, 0x01000504u), q1 = (int)__builtin_amdgcn_perm(ab01, cd01, 0x03020706u);
            const int q2 = (int)__builtin_amdgcn_perm(ab23, cd23, 0x01000504u), q3 = (int)__builtin_amdgcn_perm(ab23, cd23, 0x03020706u);
            ah[4 * d + 0] = __builtin_amdgcn_sdot4(q0, whv[g], ah[4 * d + 0], false); al[4 * d + 0] = __builtin_amdgcn_sdot4(q0, wlv[g], al[4 * d + 0], false);
            ah[4 * d + 1] = __builtin_amdgcn_sdot4(q1, whv[g], ah[4 * d + 1], false); al[4 * d + 1] = __builtin_amdgcn_sdot4(q1, wlv[g], al[4 * d + 1], false);
            ah[4 * d + 2] = __builtin_amdgcn_sdot4(q2, whv[g], ah[4 * d + 2], false); al[4 * d + 2] = __builtin_amdgcn_sdot4(q2, wlv[g], al[4 * d + 2], false);
            ah[4 * d + 3] = __builtin_amdgcn_sdot4(q3, whv[g], ah[4 * d + 3], false); al[4 * d + 3] = __builtin_amdgcn_sdot4(q3, wlv[g], al[4 * d + 3], false);
        }
    }
    int y[16];
#pragma unroll
    for (int c = 0; c < 16; ++c) y[c] = ah[c] * 128 + al[c];
    const bool b5 = (lane & 32) != 0, b4 = (lane & 16) != 0, b3 = (lane & 8) != 0;
    int z[8], q[4];
#pragma unroll
    for (int k = 0; k < 8; ++k) z[k] = hx(y[k], y[8 + k], b5, 32);
#pragma unroll
    for (int k = 0; k < 4; ++k) q[k] = hx(z[k], z[4 + k], b4, 16);
    const int r0 = hx(q[0], q[2], b3, 8), r1 = hx(q[1], q[3], b3, 8);
    const int col = 128 * s + 16 * (lane & 7) + (b5 ? 8 : 0) + (b4 ? 4 : 0) + (b3 ? 2 : 0);
    const float2 g2 = *(const float2*)(gate2 + col); float2 x1 = *(const float2*)(x1row + col);
    x1.x += g2.x * wscale * (float)r0; x1.y += g2.y * wscale * (float)r1;
    *(float2*)(outrow + col) = x1;
}
}

constexpr size_t WS_SU = 2 * MiB, WS_SV = 2 * MiB + 65536, WS_HS = 2 * MiB + 131072;
constexpr size_t WS_UQ = 24 * MiB, WS_VQ = 40 * MiB, WS_H2Q = 56 * MiB;
constexpr size_t WS_A = WS_KA;
struct Args { const void* in[22]; float* out; unsigned char* ws; int ph_lo, ph_hi, li, pad; };

struct Frame {
    LAS unsigned char* lds;
    int tid, lane, wave, G, gw, NGW;
};

namespace pg8 {
struct EpiProj {
    static constexpr bool PERM = true, AFTER_DRAIN = false;
    bf16_t* P; float* FL;
    __device__ __forceinline__ void operator()(const f32x4 (&acc)[2][2][4][2], const Unit& u, int wr, int wc, int fr, int fq) const {
        const int row0 = u.pm * BM + wr * 64 + fr, col0 = u.pn * BM + wc * 32 + 8 * fq;
#pragma unroll
        for (int ai = 0; ai < 2; ++ai)
#pragma unroll
            for (int m = 0; m < 4; ++m) { const int row = row0 + ai * HALF + m * 16; bf16_t* rowp = P + (size_t)row * PP + col0;
#pragma unroll
                for (int bj = 0; bj < 2; ++bj) { const f32x4 v0 = acc[ai][bj][m][0], v1 = acc[ai][bj][m][1];
                    if (col0 + bj * HALF == C_FL) { float* f = FL + (size_t)row * 8; *(f32x4*)f = v0; *(f32x4*)(f + 4) = v1; }
                    u32x4 w; w.x = cvt_pk_bf16(v0[0], v0[1]); w.y = cvt_pk_bf16(v0[2], v0[3]); w.z = cvt_pk_bf16(v1[0], v1[1]); w.w = cvt_pk_bf16(v1[2], v1[3]);
                    *(u32x4*)(rowp + bj * HALF) = w; } }
    }
};
struct EpiStore {
    static constexpr bool PERM = true, AFTER_DRAIN = false;
    bf16_t* O; int ldc;
    __device__ __forceinline__ void operator()(const f32x4 (&acc)[2][2][4][2], const Unit& u, int wr, int wc, int fr, int fq) const {
        const int row0 = u.pm * BM + wr * 64 + fr, col0 = u.pn * BM + wc * 32 + 8 * fq;
#pragma unroll
        for (int ai = 0; ai < 2; ++ai)
#pragma unroll
            for (int m = 0; m < 4; ++m) { bf16_t* rowp = O + (size_t)(row0 + ai * HALF + m * 16) * ldc + col0;
#pragma unroll
                for (int bj = 0; bj < 2; ++bj) { const f32x4 v0 = acc[ai][bj][m][0], v1 = acc[ai][bj][m][1];
                    u32x4 w; w.x = cvt_pk_bf16(v0[0], v0[1]); w.y = cvt_pk_bf16(v0[2], v0[3]); w.z = cvt_pk_bf16(v1[0], v1[1]); w.w = cvt_pk_bf16(v1[2], v1[3]);
                    *(u32x4*)(rowp + bj * HALF) = w; } }
    }
};
struct EpiResid {
    static constexpr bool PERM = false, AFTER_DRAIN = false;
    const float* X; const float* MOD; float* out;
    __device__ __forceinline__ void operator()(const f32x4 (&acc)[2][2][4][2], const Unit& u, int wr, int wc, int fr, int fq) const {
        const int row0 = u.pm * BM + wr * 64 + fr, col0 = u.pn * BM + wc * 32 + 4 * fq;
        const int b = (u.pm * BM) / S_;
        f32x4 gv[2][2];
#pragma unroll
        for (int bj = 0; bj < 2; ++bj)
#pragma unroll
            for (int n = 0; n < 2; ++n) gv[bj][n] = *(const f32x4*)(MOD + b * 6144 + 2 * 1024 + col0 + bj * HALF + n * 16);
#pragma unroll
        for (int ai = 0; ai < 2; ++ai)
#pragma unroll
            for (int m = 0; m < 4; ++m) { const size_t off = (size_t)(row0 + ai * HALF + m * 16) * 1024 + col0;
#pragma unroll
                for (int bj = 0; bj < 2; ++bj)
#pragma unroll
                    for (int n = 0; n < 2; ++n) { const f32x4 xv = *(const f32x4*)(X + off + bj * HALF + n * 16); *(f32x4*)(out + off + bj * HALF + n * 16) = xv + gv[bj][n] * acc[ai][bj][m][n]; } }
    }
};
}

__device__ __forceinline__ void p0_transpose_item(const float* W, int K, int N, int Npad, bf16_t* WT, LAS float* scr, int item, int lane) {
    const int nblk = Npad / 32, kb = item / nblk, nb = item % nblk, k0 = 64 * kb, n0 = 32 * nb;
    const int nn = n0 + (lane & 31);
#pragma unroll 8
    for (int i = 0; i < 32; ++i) { const int kk = 2 * i + (lane >> 5); scr[kk * 33 + (lane & 31)] = nn < N ? W[(size_t)(k0 + kk) * N + nn] : 0.f; }
    asm volatile("s_waitcnt lgkmcnt(0)" ::: "memory");
    const int c = lane & 7;
#pragma unroll
    for (int j = 0; j < 4; ++j) { const int n = (lane >> 3) + 8 * j; const LAS float* s = scr + (8 * c) * 33 + n;
        u32x4 o; o.x = pk2(s[0 * 33], s[1 * 33]); o.y = pk2(s[2 * 33], s[3 * 33]); o.z = pk2(s[4 * 33], s[5 * 33]); o.w = pk2(s[6 * 33], s[7 * 33]);
        *(u32x4*)(WT + (size_t)(n0 + n) * K + k0 + 8 * c) = o; }
    asm volatile("s_waitcnt lgkmcnt(0)" ::: "memory");
}
__device__ __forceinline__ void p0_mod_block(const float* c, const float* w_ada, const float* b_ada, float* mod, LAS unsigned char* lds, int item, int wave, int lane) {
    LAS float* sil = (LAS float*)(lds + wave * 2048);
    LAS float* part = (LAS float*)(lds + 16384);
    for (int i = lane; i < 512; i += 64) { const int b = i >> 7, kk = i & 127; const float cv = c[b * 1024 + wave * 128 + kk]; sil[kk * 4 + b] = cv / (1.f + expf(-cv)); }
    asm volatile("s_waitcnt lgkmcnt(0)" ::: "memory");
    const int j = item * 64 + lane;
    const float* wp = w_ada + (size_t)(wave * 128) * 6144 + j;
    float a0 = 0.f, a1 = 0.f, a2 = 0.f, a3 = 0.f;
#pragma unroll 16
    for (int k = 0; k < 128; ++k) { const float w = wp[(size_t)k * 6144]; const f32x4 s = *(const LAS f32x4*)(sil + k * 4); a0 += s[0] * w; a1 += s[1] * w; a2 += s[2] * w; a3 += s[3] * w; }
    part[(wave * 4 + 0) * 64 + lane] = a0; part[(wave * 4 + 1) * 64 + lane] = a1; part[(wave * 4 + 2) * 64 + lane] = a2; part[(wave * 4 + 3) * 64 + lane] = a3;
    __syncthreads();
    if (wave < 4) { float acc = b_ada[j];
#pragma unroll
        for (int w = 0; w < 8; ++w) acc += part[(w * 4 + wave) * 64 + lane];
        mod[wave * 6144 + j] = acc; }
    __syncthreads();
}

struct ModIn { float4 v[4]; };
__device__ __forceinline__ void modrow_load(ModIn& M, const float* X, int row, int lane) {
    const float4* xr = (const float4*)(X + (size_t)row * 1024) + lane;
#pragma unroll
    for (int j = 0; j < 4; ++j) M.v[j] = xr[64 * j];
}
__device__ __forceinline__ void modrow_finish(ModIn& M, const float* g, const float* mod, int shift_idx, int scale_idx, bf16_t* out, unsigned char* outq, float* hs, int row, int lane) {
    const int b = row / S_; float ss = 0.f;
#pragma unroll
    for (int j = 0; j < 4; ++j) ss += (M.v[j].x * M.v[j].x + M.v[j].y * M.v[j].y) + (M.v[j].z * M.v[j].z + M.v[j].w * M.v[j].w);
    ss = wave_sum(ss);
    const float r = rsqrtf(ss * (1.f / 1024.f) + EPS);
    const float* sh = mod + b * 6144 + shift_idx * 1024; const float* sc = mod + b * 6144 + scale_idx * 1024;
    float am = 0.f;
#pragma unroll
    for (int j = 0; j < 4; ++j) {
        const int col = 4 * lane + 256 * j; float4& v = M.v[j];
        const float4 g4 = *(const float4*)(g + col), s4 = *(const float4*)(sc + col), h4 = *(const float4*)(sh + col);
        v.x = v.x * r * g4.x * (1.f + s4.x) + h4.x; v.y = v.y * r * g4.y * (1.f + s4.y) + h4.y; v.z = v.z * r * g4.z * (1.f + s4.z) + h4.z; v.w = v.w * r * g4.w * (1.f + s4.w) + h4.w;
        uint2 w; w.x = pk2(v.x, v.y); w.y = pk2(v.z, v.w);
        *(uint2*)(out + (size_t)row * 1024 + col) = w;
        am = fmaxf(am, fmaxf(fmaxf(fabsf(v.x), fabsf(v.y)), fmaxf(fabsf(v.z), fabsf(v.w))));
    }
    if (outq) {
#pragma unroll
        for (int o = 1; o < 64; o <<= 1) am = fmaxf(am, __shfl_xor(am, o));
        const float inv = am > 0.f ? 127.f / am : 0.f;
#pragma unroll
        for (int j = 0; j < 4; ++j) { const float4 v = M.v[j]; const int q0 = (int)rintf(v.x * inv), q1 = (int)rintf(v.y * inv), q2 = (int)rintf(v.z * inv), q3 = (int)rintf(v.w * inv);
            *(unsigned*)(outq + (size_t)row * 1024 + 4 * lane + 256 * j) = (unsigned)(q0 & 255) | ((unsigned)(q1 & 255) << 8) | ((unsigned)(q2 & 255) << 16) | ((unsigned)(q3 & 255) << 24); }
        if (lane == 0) hs[row] = am * (1.f / 127.f);
    }
}
__device__ __forceinline__ void modrows2(const float* X, const float* g, const float* mod, int shift_idx, int scale_idx, bf16_t* out, unsigned char* outq, float* hs, int gw, int ngw, int lane) {
    for (int row = gw; row < T_; row += 2 * ngw) {
        const int row2 = row + ngw; ModIn Ma, Mb;
        modrow_load(Ma, X, row, lane); if (row2 < T_) modrow_load(Mb, X, row2, lane);
        modrow_finish(Ma, g, mod, shift_idx, scale_idx, out, outq, hs, row, lane); if (row2 < T_) modrow_finish(Mb, g, mod, shift_idx, scale_idx, out, outq, hs, row2, lane);
    }
}
__global__ void __launch_bounds__(NWAVES * 64, 2) mega_fwd(Args args) {
    extern __shared__ __attribute__((aligned(16))) unsigned char lds[];
    Frame F;
    F.lds = (LAS unsigned char*)lds;
    volatile LAS unsigned* MISC = (volatile LAS unsigned*)(F.lds + MISC_OFF);
    F.tid = threadIdx.x; F.lane = F.tid & 63; F.wave = __builtin_amdgcn_readfirstlane(F.tid >> 6);
    F.G = gridDim.x; F.gw = blockIdx.x * NWAVES + F.wave; F.NGW = F.G * NWAVES;
    unsigned char* ws = args.ws;
    unsigned* ctl = (unsigned*)(ws + WS_CTL);
    const float* x = (const float*)args.in[0]; const float* c = (const float*)args.in[1]; const int* positions = (const int*)args.in[2];
    const float* w_ada = (const float*)args.in[3]; const float* b_ada = (const float*)args.in[4]; const float* norm1_g = (const float*)args.in[5];
    const float* w_in = (const float*)args.in[6]; const float* mla_qa_g = (const float*)args.in[7]; const float* mla_kva_g = (const float*)args.in[8];
    const float* w_uq = (const float*)args.in[9]; const float* w_ukv = (const float*)args.in[10]; const float* mla_q_g = (const float*)args.in[11];
    const float* mla_k_g = (const float*)args.in[12]; const float* fox_q_g = (const float*)args.in[13]; const float* fox_k_g = (const float*)args.in[14];
    const float* b_f = (const float*)args.in[15]; const float* w_o = (const float*)args.in[16]; const float* norm2_g = (const float*)args.in[17];
    const float* w_pq = (const float*)args.in[18]; const float* sub_keys = (const float*)args.in[19]; const float* peer_u = (const float*)args.in[20]; const float* peer_v = (const float*)args.in[21];
    float* out = args.out;
    float* MOD = (float*)(ws + WS_MOD); float* FL = (float*)(ws + WS_FL); float* FCUM = (float*)(ws + WS_FCUM); float* LOGF = (float*)(ws + WS_LOGF); float2* ROPE = (float2*)(ws + WS_ROPE);
    bf16_t* XN = (bf16_t*)(ws + WS_XN); bf16_t* PROJ = (bf16_t*)(ws + WS_PROJ); bf16_t* KVRAW = (bf16_t*)(ws + WS_KVRAW); bf16_t* QA = (bf16_t*)(ws + WS_QA); bf16_t* KA = (bf16_t*)(ws + WS_KA);
    bf16_t* WIN = (bf16_t*)(ws + WS_WIN); bf16_t* WUQ = (bf16_t*)(ws + WS_WUQ); bf16_t* WUKV = (bf16_t*)(ws + WS_WUKV); bf16_t* WO = (bf16_t*)(ws + WS_WO); bf16_t* WPQ = (bf16_t*)(ws + WS_WPQ); bf16_t* SKB = (bf16_t*)(ws + WS_SK);
    unsigned char* UQ = ws + WS_UQ; unsigned char* VQ = ws + WS_VQ; unsigned char* H2Q = ws + WS_H2Q; float* SU = (float*)(ws + WS_SU); float* SV = (float*)(ws + WS_SV); float* HS = (float*)(ws + WS_HS); float* AP = (float*)(ws + WS_A);
    bf16_t* OB = XN; bf16_t* H2 = XN; bf16_t* QP = PROJ; int* EID = (int*)(ws + WS_QA); float* GATE = (float*)(ws + WS_QA + 16 * MiB);
    (void)sub_keys; (void)peer_u; (void)peer_v; (void)positions; (void)KA; (void)FCUM; (void)LOGF; (void)ROPE; (void)mla_q_g; (void)mla_k_g; (void)b_f; (void)fox_q_g; (void)fox_k_g; (void)mla_qa_g; (void)mla_kva_g;

    for (int u = F.tid; u < (LDS_BYTES - LDSCTL_OFF) / 4; u += NWAVES * 64) ((LAS unsigned*)(F.lds + LDSCTL_OFF))[u] = 0u;
    __syncthreads();
    const int lo = args.ph_lo, hi = args.ph_hi;
    XcdBarrier bar; bar.bar = ctl + CW_BAR + args.li * XCD_BAR_WORDS; bar.x = 0; bar.st = nullptr;
    if (hi - lo > 1) bar = xcd_barrier_post(ctl + CW_BAR + args.li * XCD_BAR_WORDS, MISC + 8);
#define IN(k) (lo <= (k) && (k) < hi)
#define SEAM(k) do { if (IN(k) && IN((k) + 1)) xcd_barrier(bar); } while (0)

    if (IN(0)) REP(0) {
        LAS float* scr = (LAS float*)(F.lds + F.wave * 16384);
        constexpr int I_MOD = 96, I_IN = 16 * 72, I_UQ = 6 * 24, I_UKV = 4 * 32, I_O = 16 * 32, I_PQ = 16 * 64;
        constexpr int I_SK = 512;
        constexpr int NITEMS = I_IN + I_UQ + I_UKV + I_O + I_PQ + I_SK;
        for (int mi = (int)blockIdx.x; mi < I_MOD; mi += F.G) p0_mod_block(c, w_ada, b_ada, MOD, F.lds, mi, F.wave, F.lane);
        for (int it = F.gw; it < NITEMS; it += F.NGW) {
            int r = it;
            if (r < I_IN) { p0_transpose_item(w_in, 1024, INW, PP, WIN, scr, r, F.lane); continue; } r -= I_IN;
            if (r < I_UQ) { p0_transpose_item(w_uq, 384, 768, 768, WUQ, scr, r, F.lane); continue; } r -= I_UQ;
            if (r < I_UKV) { p0_transpose_item(w_ukv, 256, 1024, 1024, WUKV, scr, r, F.lane); continue; } r -= I_UKV;
            if (r < I_O) { p0_transpose_item(w_o, 1024, 1024, 1024, WO, scr, r, F.lane); continue; } r -= I_O;
            if (r < I_PQ) { p0_transpose_item(w_pq, 1024, 2048, 2048, WPQ, scr, r, F.lane); continue; } r -= I_PQ;
            { const float4* src = (const float4*)(sub_keys + (size_t)r * 512) + F.lane * 2; const float4 a = src[0], b2 = src[1];
              u32x4 o; o.x = pk2(a.x, a.y); o.y = pk2(a.z, a.w); o.z = pk2(b2.x, b2.y); o.w = pk2(b2.z, b2.w); *(u32x4*)(SKB + (size_t)r * 512 + F.lane * 8) = o; }
        }
    }
    if (IN(0)) {
        for (int r0 = F.gw * 4; r0 < 32768; r0 += F.NGW * 4) {
            float4 v[4][4]; float am[4];
#pragma unroll
            for (int q = 0; q < 4; ++q) { const int r = r0 + q; const float* src = (r < 16384 ? peer_u + (size_t)r * 1024 : peer_v + (size_t)(r - 16384) * 1024);
#pragma unroll
                for (int j = 0; j < 4; ++j) v[q][j] = ((const float4*)src)[F.lane + 64 * j]; }
#pragma unroll
            for (int q = 0; q < 4; ++q) { float a = 0.f;
#pragma unroll
                for (int j = 0; j < 4; ++j) a = fmaxf(a, fmaxf(fmaxf(fabsf(v[q][j].x), fabsf(v[q][j].y)), fmaxf(fabsf(v[q][j].z), fabsf(v[q][j].w))));
                am[q] = a; }
#pragma unroll
            for (int o = 1; o < 64; o <<= 1) {
#pragma unroll
                for (int q = 0; q < 4; ++q) am[q] = fmaxf(am[q], __shfl_xor(am[q], o)); }
#pragma unroll
            for (int q = 0; q < 4; ++q) { const int r = r0 + q; unsigned char* dst = (r < 16384 ? UQ + (size_t)r * 1024 : VQ + (size_t)(r - 16384) * 1024); float* sc = (r < 16384 ? SU + r : SV + (r - 16384));
                const float inv = am[q] > 0.f ? 127.f / am[q] : 0.f;
#pragma unroll
                for (int j = 0; j < 4; ++j) { const float4 x = v[q][j]; const int q0 = (int)rintf(x.x * inv), q1 = (int)rintf(x.y * inv), q2 = (int)rintf(x.z * inv), q3 = (int)rintf(x.w * inv);
                    *(unsigned*)(dst + 4 * F.lane + 256 * j) = (unsigned)(q0 & 255) | ((unsigned)(q1 & 255) << 8) | ((unsigned)(q2 & 255) << 16) | ((unsigned)(q3 & 255) << 24); }
                if (F.lane == 0) *sc = am[q] * (1.f / 127.f); }
        }
    }
    SEAM(0);
    if (IN(1)) modrows2(x, norm1_g, MOD, 0, 1, XN, nullptr, nullptr, F.gw, F.NGW, F.lane);
    SEAM(1);
    if (IN(2)) REP(2) {
        pg8::Gemm g{XN, WIN, T_, PP, 1024, 1024}; pg8::StaticOrder S; S.init(T_, PP, F.G, (int)blockIdx.x);
        pg8::EpiProj E{PROJ, FL};
        pg8::gemm_phase<pg8::EpiProj, pg8::StaticOrder, true, true>(F.lds, g, S, E);
    }
    SEAM(2);
    if (IN(3)) {
        const float invf = (float)exp2(-(double)(F.lane & 15) * (13.287712379549449 / 16.0));
        for (int row = F.gw; row < T_; row += 2 * F.NGW) {
            const int row2 = row + F.NGW; RowPrepIn Ra, Rb;
            rowprep_load(Ra, PROJ, FL, positions, row, F.lane); if (row2 < T_) rowprep_load(Rb, PROJ, FL, positions, row2, F.lane);
            rowprep_finish(Ra, PROJ, mla_qa_g, mla_kva_g, fox_q_g, fox_k_g, b_f, LOGF, ROPE, row, F.lane, invf);
            if (row2 < T_) rowprep_finish(Rb, PROJ, mla_qa_g, mla_kva_g, fox_q_g, fox_k_g, b_f, LOGF, ROPE, row2, F.lane, invf);
        }
    }
    SEAM(3);
    if (IN(4)) REP(4) {
        { pg8::Gemm g{PROJ + C_CQ, WUQ, T_, 768, 384, PP}; pg8::StaticOrder S; S.init(T_, 768, F.G, (int)blockIdx.x); pg8::EpiStore E{QA, 768};
          pg8::gemm_phase<pg8::EpiStore, pg8::StaticOrder, true, true>(F.lds, g, S, E); }
        { pg8::Gemm g{PROJ + C_CKV, WUKV, T_, 1024, 256, PP}; pg8::StaticOrder S; S.init(T_, 1024, F.G, (int)blockIdx.x); pg8::EpiStore E{KVRAW, 1024};
          pg8::gemm_phase<pg8::EpiStore, pg8::StaticOrder, true, true>(F.lds, g, S, E); }
    }
    SEAM(4);
    if (IN(5)) {
        if (F.wave == 0 && (int)blockIdx.x < 32) fcum_item(LOGF, FCUM, (int)blockIdx.x, F.lane);
        for (int row = F.gw; row < T_; row += 2 * F.NGW) {
            const int row2 = row + F.NGW; MlaIn Ma, Mb;
            mlaprep_load(Ma, QA, KVRAW, PROJ, ROPE, row, F.lane); if (row2 < T_) mlaprep_load(Mb, QA, KVRAW, PROJ, ROPE, row2, F.lane);
            mlaprep_finish(Ma, QA, KA, mla_q_g, mla_k_g, row, F.lane); if (row2 < T_) mlaprep_finish(Mb, QA, KA, mla_q_g, mla_k_g, row2, F.lane);
        }
    }
    SEAM(5);
    if (IN(6)) {
        volatile LAS unsigned* qslot = MISC + 16;
        float thr;
        { float gq = fabsf(fox_q_g[F.lane]), gk = fabsf(fox_k_g[F.lane]);
#pragma unroll
          for (int o = 1; o < 64; o <<= 1) { gq = fmaxf(gq, __shfl_xor(gq, o)); gk = fmaxf(gk, __shfl_xor(gk, o)); }
          thr = 104.5f + 2.f * 1.02f * 8.f * gq * gk; }
        unsigned* qctr = ctl + 64;
        if (F.tid == 0) qslot[0] = atomicAdd(qctr, 1u);
        __syncthreads();
        unsigned u = qslot[0];
        while (u < 2048u) {
            unsigned unext = 0u;
            if (F.tid == 0) unext = atomicAdd(qctr, 1u);
            const int grp = (int)(u >> 10), bh = (int)(u & 31u), qb = 31 - (int)((u >> 5) & 31u), b = bh >> 3, h = bh & 7;
            if (grp == 0) { const att::Desc d{QA + (size_t)b * S_ * 768 + h * 96, 768, KA + (size_t)b * S_ * 768 + h * 96, 768, KVRAW + (size_t)b * S_ * 1024 + h * 128 + 64, 1024, OB + (size_t)b * S_ * 1024 + h * 64, 1024, nullptr};
                att::attn_unit<6, false>(d, qb, 0, F.lds); }
            else { const bf16_t* pb = PROJ + (size_t)b * S_ * PP + h * 64; const float* fc = FCUM + (size_t)(b * 8 + h) * S_;
                const att::Desc d{pb + C_FQ, PP, pb + C_FK, PP, pb + C_FV, PP, OB + (size_t)b * S_ * 1024 + 512 + h * 64, 1024, fc};
                const int NT = 4 * (qb + 1); const float lim = fc[qb * 256] + thr;
                int j0 = 0;
                { const int ja = F.lane, jb2 = 64 + F.lane;
                  const bool ka = ja < NT ? (fc[64 * ja + 63] <= lim) : true, kb = jb2 < NT ? (fc[64 * jb2 + 63] <= lim) : true;
                  const unsigned long long ma = __ballot(ka), mb = __ballot(kb);
                  j0 = ma ? __builtin_ctzll(ma) : (mb ? 64 + __builtin_ctzll(mb) : NT - 4); }
                if (j0 > NT - 4) j0 = NT - 4;
                att::attn_unit<4, true>(d, qb, j0, F.lds); }
            if (F.tid == 0) qslot[0] = unext;
            __syncthreads();
            u = qslot[0];
            __syncthreads();
        }
    }
    SEAM(6);
    if (IN(7)) REP(7) {
        pg8::Gemm g{OB, WO, T_, 1024, 1024, 1024}; pg8::StaticOrder S; S.init(T_, 1024, F.G, (int)blockIdx.x);
        pg8::EpiResid E{x, MOD, out};
        pg8::gemm_phase<pg8::EpiResid, pg8::StaticOrder, true, true>(F.lds, g, S, E);
    }
    SEAM(7);
    if (IN(8)) modrows2(out, norm2_g, MOD, 3, 4, H2, H2Q, HS, F.gw, F.NGW, F.lane);
    SEAM(8);
    if (IN(9)) REP(9) {
        pg8::Gemm g{H2, WPQ, T_, 2048, 1024, 1024}; pg8::StaticOrder S; S.init(T_, 2048, F.G, (int)blockIdx.x); pg8::EpiStore E{QP, 2048};
        pg8::gemm_phase<pg8::EpiStore, pg8::StaticOrder, true, true>(F.lds, g, S, E);
    }
    SEAM(9);
    if (IN(10)) REP(10) { for (int w = F.gw; w < (T_ / 32) * 8; w += F.NGW) pk::topk_item(QP, SKB, EID, GATE, w, F.lane); }
    SEAM(10);
    {
        const int ng = F.G < 8 ? F.G : 8; const int vx = (int)blockIdx.x % ng, rank = (int)blockIdx.x / ng, nrank = (F.G - vx + ng - 1) / ng;
        const int gwv = rank * NWAVES + F.wave, ngwv = nrank * NWAVES;
        const int grp = F.lane >> 3, sub = F.lane & 7;
        int* PA = (int*)(ws + WS_PROJ);
        int* WQH = (int*)(ws + WS_KA); int* WQL = (int*)(ws + WS_KA + 4 * MiB); float* WSC = (float*)(ws + WS_KA + 8 * MiB);
        if (IN(11)) REP(11) {
            for (int s = vx; s < 8; s += ng) {
                const unsigned char* UQs = UQ + 128 * s + 16 * sub;
                int t = gwv; int4 ev[4]; int4 hq = make_int4(0, 0, 0, 0);
#pragma unroll
                for (int k = 0; k < 4; ++k) ev[k] = make_int4(0, 0, 0, 0);
                if (t < T_) {
#pragma unroll
                    for (int k = 0; k < 4; ++k) ev[k] = *(const int4*)(EID + (size_t)t * 128 + grp * 16 + 4 * k);
                    hq = *(const int4*)(H2Q + (size_t)t * 1024 + 128 * s + 16 * sub); }
                while (t < T_) {
                    const int tn = t + ngwv; int4 evn[4]; int4 hqn = make_int4(0, 0, 0, 0);
#pragma unroll
                    for (int k = 0; k < 4; ++k) evn[k] = make_int4(0, 0, 0, 0);
                    if (tn < T_) {
#pragma unroll
                        for (int k = 0; k < 4; ++k) evn[k] = *(const int4*)(EID + (size_t)tn * 128 + grp * 16 + 4 * k);
                        hqn = *(const int4*)(H2Q + (size_t)tn * 1024 + 128 * s + 16 * sub); }
                    gx::u_token(UQs, ev, hq, PA + ((size_t)s * T_ + t) * 128, F.lane);
                    t = tn; hq = hqn;
#pragma unroll
                    for (int k = 0; k < 4; ++k) ev[k] = evn[k];
                }
            }
        }
        SEAM(11);
        if (IN(12)) REP(12) {
            for (int t = F.gw; t < T_; t += F.NGW) {
                int i0 = 0, i1 = 0;
#pragma unroll
                for (int s = 0; s < 8; ++s) { const int2 p = *(const int2*)(PA + ((size_t)s * T_ + t) * 128 + 2 * F.lane); i0 += p.x; i1 += p.y; }
                const int2 e2 = *(const int2*)(EID + (size_t)t * 128 + 2 * F.lane); const float2 g2 = *(const float2*)(GATE + (size_t)t * 128 + 2 * F.lane); const float hs = HS[t];
                const float w0 = g2.x * gx::gelu_t((float)i0 * SU[e2.x] * hs) * SV[e2.x], w1 = g2.y * gx::gelu_t((float)i1 * SU[e2.y] * hs) * SV[e2.y];
                float wm = fmaxf(fabsf(w0), fabsf(w1));
#pragma unroll
                for (int o = 1; o < 64; o <<= 1) wm = fmaxf(wm, __shfl_xor(wm, o));
                const float inv = wm > 0.f ? 16256.f / wm : 0.f;
                const int q0 = (int)rintf(w0 * inv), q1 = (int)rintf(w1 * inv);
                const unsigned h2 = (unsigned)((q0 >> 7) & 255) | ((unsigned)((q1 >> 7) & 255) << 8), l2 = (unsigned)(q0 & 127) | ((unsigned)(q1 & 127) << 8);
                const unsigned h2p = __shfl_xor(h2, 1), l2p = __shfl_xor(l2, 1);
                if ((F.lane & 1) == 0) { WQH[(size_t)t * 32 + (F.lane >> 1)] = (int)(h2 | (h2p << 16)); WQL[(size_t)t * 32 + (F.lane >> 1)] = (int)(l2 | (l2p << 16)); }
                if (F.lane == 0) WSC[t] = wm * (1.f / 16256.f);
            }
        }
        SEAM(12);
        if (IN(13)) REP(13) {
            for (int s = vx; s < 8; s += ng) {
                const unsigned char* VQs = VQ + 128 * s + 16 * sub;
                int t = gwv; int4 ev[4]; int4 wh = make_int4(0, 0, 0, 0), wl = make_int4(0, 0, 0, 0); float wsc = 0.f;
#pragma unroll
                for (int k = 0; k < 4; ++k) ev[k] = make_int4(0, 0, 0, 0);
                if (t < T_) {
#pragma unroll
                    for (int k = 0; k < 4; ++k) ev[k] = *(const int4*)(EID + (size_t)t * 128 + grp * 16 + 4 * k);
                    wh = *(const int4*)(WQH + (size_t)t * 32 + grp * 4); wl = *(const int4*)(WQL + (size_t)t * 32 + grp * 4); wsc = WSC[t]; }
                while (t < T_) {
                    const int tn = t + ngwv; int4 evn[4]; int4 whn = make_int4(0, 0, 0, 0), wln = make_int4(0, 0, 0, 0); float wscn = 0.f;
#pragma unroll
                    for (int k = 0; k < 4; ++k) evn[k] = make_int4(0, 0, 0, 0);
                    if (tn < T_) {
#pragma unroll
                        for (int k = 0; k < 4; ++k) evn[k] = *(const int4*)(EID + (size_t)tn * 128 + grp * 16 + 4 * k);
                        whn = *(const int4*)(WQH + (size_t)tn * 32 + grp * 4); wln = *(const int4*)(WQL + (size_t)tn * 32 + grp * 4); wscn = WSC[tn]; }
                    float* dstrow = (PROBE_DUP == 13 && _r == 0) ? (float*)(ws + WS_XN) + (size_t)t * 1024 : out + (size_t)t * 1024;
                    gx::v_token(VQs, ev, wh, wl, wsc, MOD + (t / S_) * 6144 + 5 * 1024, out + (size_t)t * 1024, dstrow, s, F.lane);
                    t = tn; wh = whn; wl = wln; wsc = wscn;
#pragma unroll
                    for (int k = 0; k < 4; ++k) ev[k] = evn[k];
                }
            }
        }
    }
#undef IN
#undef SEAM
}

static int g_grid = 0;
static void launch_mega(const Args& base, int lo, int hi, int li, hipStream_t stream) {
    Args a = base; a.ph_lo = lo; a.ph_hi = hi; a.li = li;
    hipLaunchKernelGGL(mega_fwd, dim3(g_grid), dim3(NWAVES * 64), LDS_BYTES, stream, a);
}

extern "C" void kernel_launch(void* const* d_in, const int* in_sizes, int n_in, void* d_out, int out_size, void* d_ws, size_t ws_size, hipStream_t stream) {
    if (g_grid == 0) {
        int dev = 0, cus = 0;
        hipGetDevice(&dev); hipDeviceGetAttribute(&cus, hipDeviceAttributeMultiprocessorCount, dev);
        hipFuncSetAttribute((const void*)mega_fwd, hipFuncAttributeMaxDynamicSharedMemorySize, LDS_BYTES);
        int per_cu = 0; hipOccupancyMaxActiveBlocksPerMultiprocessor(&per_cu, (const void*)mega_fwd, NWAVES * 64, LDS_BYTES);
        (void)hipGetLastError();
        g_grid = cus > 0 ? cus : 256;
        if (per_cu < 1) fprintf(stderr, "kernel_launch: occupancy query says %d blocks/CU\n", per_cu);
    }
    const float* x = (const float*)d_in[0]; const int* positions = (const int*)d_in[2];
    const float* mla_qa_g = (const float*)d_in[7]; const float* mla_kva_g = (const float*)d_in[8];
    const float* mla_q_g = (const float*)d_in[11]; const float* mla_k_g = (const float*)d_in[12]; const float* fox_q_g = (const float*)d_in[13]; const float* fox_k_g = (const float*)d_in[14];
    const float* b_f = (const float*)d_in[15]; const float* sub_keys = (const float*)d_in[19]; const float* peer_u = (const float*)d_in[20]; const float* peer_v = (const float*)d_in[21];
    float* out = (float*)d_out; unsigned char* ws = (unsigned char*)d_ws;
    float* MOD = (float*)(ws + WS_MOD); float* FL = (float*)(ws + WS_FL); float* FCUM = (float*)(ws + WS_FCUM); float* LOGF = (float*)(ws + WS_LOGF); float2* ROPE = (float2*)(ws + WS_ROPE);
    bf16_t* XN = (bf16_t*)(ws + WS_XN); bf16_t* PROJ = (bf16_t*)(ws + WS_PROJ); bf16_t* KVRAW = (bf16_t*)(ws + WS_KVRAW); bf16_t* QA = (bf16_t*)(ws + WS_QA); bf16_t* KA = (bf16_t*)(ws + WS_KA);
    bf16_t* OB = XN; bf16_t* H2 = XN; bf16_t* QP = PROJ; int* EID = (int*)(ws + WS_QA); float* GATE = (float*)(ws + WS_QA + 16 * MiB);
    (void)x;
    hipMemsetAsync(ws + WS_CTL, 0, CTL_ZERO_BYTES, stream);
    Args base{}; for (int i = 0; i < 22; ++i) base.in[i] = d_in[i]; base.out = out; base.ws = ws;

    launch_mega(base, 0, 14, 0, stream);
}
```

```cpp
#include <hip/hip_runtime.h>
#ifndef PROBE_DUP
#define PROBE_DUP -1
#endif
#define REP(k) for (int _r = 0; _r < ((PROBE_DUP == (k)) ? 2 : 1); ++_r)
#include <cstdint>
#include <cstdio>
#include <cmath>

typedef unsigned short bf16_t;
constexpr int B_ = 4, S_ = 8192, D_ = 1024, T_ = B_ * S_;
constexpr int PP = 2304;
constexpr int C_CQ = 0, C_CKV = 384, C_KPE = 640, C_FQ = 672, C_FK = 1184, C_FV = 1696, C_FL = 2208, INW = 2216;
constexpr float EPS = 1e-6f;
constexpr float LOG2E = 1.4426950408889634f;
constexpr float C2A = 0.10206207261596577f * LOG2E;
constexpr float C2F = 0.125f * LOG2E;

__device__ __forceinline__ float bf2f(bf16_t v) { return __uint_as_float(((unsigned)v) << 16); }
__device__ __forceinline__ bf16_t f2bf(float f) { unsigned u = __float_as_uint(f); return (bf16_t)((u + 0x7fffu + ((u >> 16) & 1u)) >> 16); }
__device__ __forceinline__ unsigned pk2(float lo, float hi) { return (unsigned)f2bf(lo) | ((unsigned)f2bf(hi) << 16); }
__device__ __forceinline__ float lo2f(unsigned w) { return __uint_as_float(w << 16); }
__device__ __forceinline__ float hi2f(unsigned w) { return __uint_as_float(w & 0xffff0000u); }
__device__ __forceinline__ float wave_sum(float v) {
#pragma unroll
    for (int o = 1; o < 64; o <<= 1) v += __shfl_xor(v, o);
    return v;
}

constexpr size_t MiB = 1u << 20;
constexpr size_t WS_MOD = 1 * MiB;
constexpr size_t WS_FL = 3 * MiB;
constexpr size_t WS_FCUM = 4 * MiB;
constexpr size_t WS_LOGF = 5 * MiB;
constexpr size_t WS_ROPE = 6 * MiB;
constexpr size_t WS_XN = 88 * MiB;
constexpr size_t WS_PROJ = 152 * MiB;
constexpr size_t WS_KVRAW = 296 * MiB;
constexpr size_t WS_QA = 360 * MiB;
constexpr size_t WS_KA = 408 * MiB;

__global__ void k_mod(const float* c, const float* w_ada, const float* b_ada, float* mod) {
    const int j = blockIdx.x * 256 + threadIdx.x, b = blockIdx.y;
    float acc = b_ada[j];
    for (int k = 0; k < 1024; ++k) { const float cv = c[b * 1024 + k]; const float s = cv / (1.f + expf(-cv)); acc += s * w_ada[(size_t)k * 6144 + j]; }
    mod[b * 6144 + j] = acc;
}

__global__ void __launch_bounds__(256) k_modrows(const float* X, const float* g, const float* mod, int shift_idx, int scale_idx, bf16_t* out) {
    const int wave = threadIdx.x >> 6, lane = threadIdx.x & 63;
    const int row = blockIdx.x * 4 + wave, b = row / S_;
    const float4* xr = (const float4*)(X + (size_t)row * 1024) + lane;
    float4 v[4]; float ss = 0.f;
#pragma unroll
    for (int j = 0; j < 4; ++j) { v[j] = xr[64 * j]; ss += (v[j].x * v[j].x + v[j].y * v[j].y) + (v[j].z * v[j].z + v[j].w * v[j].w); }
    ss = wave_sum(ss);
    const float r = rsqrtf(ss * (1.f / 1024.f) + EPS);
    const float* sh = mod + b * 6144 + shift_idx * 1024; const float* sc = mod + b * 6144 + scale_idx * 1024;
#pragma unroll
    for (int j = 0; j < 4; ++j) {
        const int col = 4 * lane + 256 * j;
        const float4 g4 = *(const float4*)(g + col), s4 = *(const float4*)(sc + col), h4 = *(const float4*)(sh + col);
        const float o0 = v[j].x * r * g4.x * (1.f + s4.x) + h4.x, o1 = v[j].y * r * g4.y * (1.f + s4.y) + h4.y;
        const float o2 = v[j].z * r * g4.z * (1.f + s4.z) + h4.z, o3 = v[j].w * r * g4.w * (1.f + s4.w) + h4.w;
        uint2 w; w.x = pk2(o0, o1); w.y = pk2(o2, o3);
        *(uint2*)(out + (size_t)row * 1024 + col) = w;
    }
}

template <int MODE>
__global__ void __launch_bounds__(256) k_gemm_naive(const bf16_t* A, int lda, const float* W, int K, int N, void* Cout, int ldc, const float* aux1, const float* aux2, float* fl) {
    __shared__ float As[16][64];
    __shared__ float Ws[16][64];
    const int tx = threadIdx.x & 15, ty = threadIdx.x >> 4;
    const int m0 = blockIdx.y * 64, n0 = blockIdx.x * 64;
    float acc[4][4];
#pragma unroll
    for (int i = 0; i < 4; ++i)
#pragma unroll
        for (int j = 0; j < 4; ++j) acc[i][j] = 0.f;
    for (int k0 = 0; k0 < K; k0 += 16) {
        { const int r = threadIdx.x >> 2, kq = (threadIdx.x & 3) * 4; const uint2 a2 = *(const uint2*)(A + (size_t)(m0 + r) * lda + k0 + kq);
          As[kq + 0][r] = lo2f(a2.x); As[kq + 1][r] = hi2f(a2.x); As[kq + 2][r] = lo2f(a2.y); As[kq + 3][r] = hi2f(a2.y); }
        { const int kk = threadIdx.x >> 4, nq = (threadIdx.x & 15) * 4; float4 w4 = make_float4(0.f, 0.f, 0.f, 0.f);
          if (n0 + nq < N) w4 = *(const float4*)(W + (size_t)(k0 + kk) * N + n0 + nq);
          *(float4*)&Ws[kk][nq] = w4; }
        __syncthreads();
#pragma unroll
        for (int kk = 0; kk < 16; ++kk) {
            const float4 a4 = *(const float4*)&As[kk][ty * 4]; const float4 w4 = *(const float4*)&Ws[kk][tx * 4];
            const float a[4] = {a4.x, a4.y, a4.z, a4.w}; const float w[4] = {w4.x, w4.y, w4.z, w4.w};
#pragma unroll
            for (int i = 0; i < 4; ++i)
#pragma unroll
                for (int j = 0; j < 4; ++j) acc[i][j] += a[i] * w[j];
        }
        __syncthreads();
    }
#pragma unroll
    for (int i = 0; i < 4; ++i) {
        const int m = m0 + ty * 4 + i;
#pragma unroll
        for (int j = 0; j < 4; ++j) {
            const int n = n0 + tx * 4 + j;
            if (n < N) {
                if (MODE == 0) ((bf16_t*)Cout)[(size_t)m * ldc + n] = f2bf(acc[i][j]);
                else if (MODE == 1) { if (n < C_FL) ((bf16_t*)Cout)[(size_t)m * ldc + n] = f2bf(acc[i][j]); else fl[(size_t)m * 8 + (n - C_FL)] = acc[i][j]; }
                else { const int b = m / S_; ((float*)Cout)[(size_t)m * ldc + n] = aux1[(size_t)m * 1024 + n] + aux2[b * 6144 + 2 * 1024 + n] * acc[i][j]; }
            }
        }
    }
}

__device__ __forceinline__ void unpack8(const uint4 raw, float* v) {
    v[0] = lo2f(raw.x); v[1] = hi2f(raw.x); v[2] = lo2f(raw.y); v[3] = hi2f(raw.y); v[4] = lo2f(raw.z); v[5] = hi2f(raw.z); v[6] = lo2f(raw.w); v[7] = hi2f(raw.w);
}
struct RowPrepIn { uint4 cq, ckv, fq, fk; float fl; int pos; };
__device__ __forceinline__ void rowprep_load(RowPrepIn& R, const bf16_t* PROJ, const float* FL, const int* positions, int row, int lane) {
    const bf16_t* pr = PROJ + (size_t)row * PP;
    R.cq = lane < 48 ? *(const uint4*)(pr + C_CQ + lane * 8) : make_uint4(0u, 0u, 0u, 0u);
    R.ckv = lane < 32 ? *(const uint4*)(pr + C_CKV + lane * 8) : make_uint4(0u, 0u, 0u, 0u);
    R.fq = *(const uint4*)(pr + C_FQ + lane * 8); R.fk = *(const uint4*)(pr + C_FK + lane * 8);
    R.fl = lane < 8 ? FL[(size_t)row * 8 + lane] : 0.f; R.pos = positions[row];
}
__device__ __forceinline__ uint4 scale8(const float* v, float r, const float* g) {
    uint4 o; o.x = pk2(v[0] * r * g[0], v[1] * r * g[1]); o.y = pk2(v[2] * r * g[2], v[3] * r * g[3]); o.z = pk2(v[4] * r * g[4], v[5] * r * g[5]); o.w = pk2(v[6] * r * g[6], v[7] * r * g[7]); return o;
}
__device__ __forceinline__ void rowprep_finish(const RowPrepIn& R, bf16_t* PROJ, const float* g_qa, const float* g_kva, const float* g_fq, const float* g_fk, const float* b_f,
                                               float* LOGF, float2* ROPE, int row, int lane, float invf) {
    bf16_t* pr = PROJ + (size_t)row * PP;
    float vq[8], vk[8], v1[8], v2[8];
    unpack8(R.cq, vq); unpack8(R.ckv, vk); unpack8(R.fq, v1); unpack8(R.fk, v2);
    float sq = 0.f, sk = 0.f, s1 = 0.f, s2 = 0.f;
#pragma unroll
    for (int i = 0; i < 8; ++i) { sq += vq[i] * vq[i]; sk += vk[i] * vk[i]; s1 += v1[i] * v1[i]; s2 += v2[i] * v2[i]; }
    s1 += __shfl_xor(s1, 1); s2 += __shfl_xor(s2, 1); s1 += __shfl_xor(s1, 2); s2 += __shfl_xor(s2, 2); s1 += __shfl_xor(s1, 4); s2 += __shfl_xor(s2, 4);
#pragma unroll
    for (int o = 1; o < 64; o <<= 1) { sq += __shfl_xor(sq, o); sk += __shfl_xor(sk, o); }
    const float rq = rsqrtf(sq * (1.f / 384.f) + EPS), rk = rsqrtf(sk * (1.f / 256.f) + EPS);
    const float r1 = rsqrtf(s1 * (1.f / 64.f) + EPS) * C2F, r2 = rsqrtf(s2 * (1.f / 64.f) + EPS);
    if (lane < 48) *(uint4*)(pr + C_CQ + lane * 8) = scale8(vq, rq, g_qa + lane * 8);
    if (lane < 32) *(uint4*)(pr + C_CKV + lane * 8) = scale8(vk, rk, g_kva + lane * 8);
    *(uint4*)(pr + C_FQ + lane * 8) = scale8(v1, r1, g_fq + (lane & 7) * 8);
    *(uint4*)(pr + C_FK + lane * 8) = scale8(v2, r2, g_fk + (lane & 7) * 8);
    if (lane < 8) { const float z = R.fl + b_f[lane]; LOGF[((size_t)(row / S_) * 8 + lane) * S_ + (row % S_)] = fminf(z, 0.f) - log1pf(expf(-fabsf(z))); }
    if (lane < 16) {
        const double a = (double)((float)R.pos * invf), n = rint(a * 0.15915494309189535);
        const float red = (float)(a - n * 6.283185307179586);
        ROPE[(size_t)row * 16 + lane] = make_float2(__cosf(red), __sinf(red)); }
}
__device__ __forceinline__ void rowprep_row(bf16_t* PROJ, const float* FL, const float* g_qa, const float* g_kva, const float* g_fq, const float* g_fk, const float* b_f,
                                                 const int* positions, float* LOGF, float2* ROPE, int row, int lane) {
    const float invf = (float)exp2(-(double)(lane & 15) * (13.287712379549449 / 16.0));
    RowPrepIn R; rowprep_load(R, PROJ, FL, positions, row, lane); rowprep_finish(R, PROJ, g_qa, g_kva, g_fq, g_fk, b_f, LOGF, ROPE, row, lane, invf);
}
__global__ void __launch_bounds__(256) k_rowprep(bf16_t* PROJ, const float* FL, const float* g_qa, const float* g_kva, const float* g_fq, const float* g_fk, const float* b_f,
                                                 const int* positions, float* LOGF, float2* ROPE) {
    rowprep_row(PROJ, FL, g_qa, g_kva, g_fq, g_fk, b_f, positions, LOGF, ROPE, blockIdx.x * 4 + (threadIdx.x >> 6), threadIdx.x & 63);
}

__device__ __forceinline__ void fcum_item(const float* LOGF, float* FCUM, int item, int lane) {
    const float4* src = (const float4*)(LOGF + (size_t)item * S_ + 128 * lane);
    float4 v[32]; float tot = 0.f;
#pragma unroll
    for (int i = 0; i < 32; ++i) v[i] = src[i];
#pragma unroll
    for (int i = 0; i < 32; ++i) tot += (v[i].x + v[i].y) + (v[i].z + v[i].w);
    float incl = tot;
#pragma unroll
    for (int o = 1; o < 64; o <<= 1) { const float t = __shfl_up(incl, o); if (lane >= o) incl += t; }
    float run = incl - tot;
    float4* dst = (float4*)(FCUM + (size_t)item * S_ + 128 * lane);
#pragma unroll
    for (int i = 0; i < 32; ++i) { float4 o; run += v[i].x; o.x = run; run += v[i].y; o.y = run; run += v[i].z; o.z = run; run += v[i].w; o.w = run; dst[i] = o; }
}
__global__ void __launch_bounds__(64) k_fcum(const float* LOGF, float* FCUM) { fcum_item(LOGF, FCUM, blockIdx.x, threadIdx.x); }

struct MlaIn { uint4 qn, kn; unsigned q1, q2, k1, k2; float2 cs0, cs1; };
__device__ __forceinline__ void mlaprep_load(MlaIn& M, const bf16_t* QRAW, const bf16_t* KVRAW, const bf16_t* PROJ, const float2* ROPE, int row, int lane) {
    const int h = lane >> 3, p = lane & 7;
    const bf16_t* q = QRAW + (size_t)row * 768 + h * 96; const bf16_t* kp = PROJ + (size_t)row * PP + C_KPE;
    M.qn = *(const uint4*)(q + 8 * p); M.q1 = *(const unsigned*)(q + 64 + 2 * p); M.q2 = *(const unsigned*)(q + 80 + 2 * p);
    M.kn = *(const uint4*)(KVRAW + (size_t)row * 1024 + h * 128 + 8 * p); M.k1 = *(const unsigned*)(kp + 2 * p); M.k2 = *(const unsigned*)(kp + 16 + 2 * p);
    M.cs0 = ROPE[(size_t)row * 16 + 2 * p]; M.cs1 = ROPE[(size_t)row * 16 + 2 * p + 1];
}
__device__ __forceinline__ void mlaprep_finish(const MlaIn& M, bf16_t* QRAW, bf16_t* KA, const float* g_q, const float* g_k, int row, int lane) {
    const int h = lane >> 3, p = lane & 7;
#pragma unroll
    for (int which = 0; which < 2; ++which) {
        const float* g = which == 0 ? g_q : g_k; const float sc = which == 0 ? C2A : 1.f;
        float v[8]; unpack8(which == 0 ? M.qn : M.kn, v); const unsigned r1 = which == 0 ? M.q1 : M.k1, r2 = which == 0 ? M.q2 : M.k2;
        float a0 = lo2f(r1), a1 = hi2f(r1), b0 = lo2f(r2), b1 = hi2f(r2);
        float ss = a0 * a0 + a1 * a1 + b0 * b0 + b1 * b1;
#pragma unroll
        for (int i = 0; i < 8; ++i) ss += v[i] * v[i];
        ss += __shfl_xor(ss, 1); ss += __shfl_xor(ss, 2); ss += __shfl_xor(ss, 4);
        const float r = rsqrtf(ss * (1.f / 96.f) + EPS);
        const float* gn = g + 8 * p;
        a0 *= r * g[64 + 2 * p]; a1 *= r * g[64 + 2 * p + 1]; b0 *= r * g[80 + 2 * p]; b1 *= r * g[80 + 2 * p + 1];
        const float ra0 = a0 * M.cs0.x - b0 * M.cs0.y, rb0 = b0 * M.cs0.x + a0 * M.cs0.y, ra1 = a1 * M.cs1.x - b1 * M.cs1.y, rb1 = b1 * M.cs1.x + a1 * M.cs1.y;
        uint4 o; o.x = pk2(v[0] * r * gn[0] * sc, v[1] * r * gn[1] * sc); o.y = pk2(v[2] * r * gn[2] * sc, v[3] * r * gn[3] * sc);
        o.z = pk2(v[4] * r * gn[4] * sc, v[5] * r * gn[5] * sc); o.w = pk2(v[6] * r * gn[6] * sc, v[7] * r * gn[7] * sc);
        bf16_t* dst = (which == 0 ? QRAW : KA) + (size_t)row * 768 + h * 96;
        *(uint4*)(dst + 8 * p) = o; *(unsigned*)(dst + 64 + 2 * p) = pk2(ra0 * sc, ra1 * sc); *(unsigned*)(dst + 80 + 2 * p) = pk2(rb0 * sc, rb1 * sc);
    }
}
__device__ __forceinline__ void mlaprep_row(bf16_t* QRAW, const bf16_t* KVRAW, const bf16_t* PROJ, bf16_t* KA, const float2* ROPE, const float* g_q, const float* g_k, int row, int lane) {
    MlaIn M; mlaprep_load(M, QRAW, KVRAW, PROJ, ROPE, row, lane); mlaprep_finish(M, QRAW, KA, g_q, g_k, row, lane);
}

__global__ void __launch_bounds__(256) k_mlaprep(bf16_t* QRAW, const bf16_t* KVRAW, const bf16_t* PROJ, bf16_t* KA, const float2* ROPE, const float* g_q, const float* g_k) {
    mlaprep_row(QRAW, KVRAW, PROJ, KA, ROPE, g_q, g_k, blockIdx.x * 4 + (threadIdx.x >> 6), threadIdx.x & 63);
}

template <int DK>
__global__ void __launch_bounds__(256) k_attn_naive(const bf16_t* Q, int pq, int qstep, const bf16_t* K, int pk, int kstep, const bf16_t* V, int pv, int vstep, bf16_t* O, int po, int ostep, const float* FCUM) {
    __shared__ float Ks[64][DK];
    __shared__ float Vs[64][64];
    __shared__ float Bs[64];
    const int bh = blockIdx.x >> 5, qb = blockIdx.x & 31, b = bh >> 3, h = bh & 7;
    const int t = qb * 256 + threadIdx.x;
    const size_t row = (size_t)b * S_ + t;
    float q[DK];
#pragma unroll
    for (int c = 0; c < DK / 8; ++c) unpack8(*(const uint4*)(Q + row * pq + h * qstep + c * 8), q + c * 8);
    float o[64];
#pragma unroll
    for (int d = 0; d < 64; ++d) o[d] = 0.f;
    float m = -INFINITY, l = 0.f;
    const float fq = FCUM ? FCUM[(size_t)(b * 8 + h) * S_ + t] : 0.f;
    const int ntiles = (qb * 256 + 256) / 64;
    for (int kt = 0; kt < ntiles; ++kt) {
        __syncthreads();
        for (int c = threadIdx.x; c < 64 * (DK / 8); c += 256) { const int key = c / (DK / 8), ch = c % (DK / 8); float v[8];
            unpack8(*(const uint4*)(K + ((size_t)b * S_ + kt * 64 + key) * pk + h * kstep + ch * 8), v);
#pragma unroll
            for (int i = 0; i < 8; ++i) Ks[key][ch * 8 + i] = v[i]; }
        for (int c = threadIdx.x; c < 64 * 8; c += 256) { const int key = c >> 3, ch = c & 7; float v[8];
            unpack8(*(const uint4*)(V + ((size_t)b * S_ + kt * 64 + key) * pv + h * vstep + ch * 8), v);
#pragma unroll
            for (int i = 0; i < 8; ++i) Vs[key][ch * 8 + i] = v[i]; }
        if (threadIdx.x < 64) Bs[threadIdx.x] = FCUM ? FCUM[(size_t)(b * 8 + h) * S_ + kt * 64 + threadIdx.x] : 0.f;
        __syncthreads();
        const int kmax = t - kt * 64 + 1;
        for (int kk = 0; kk < 64; ++kk) {
            float s = 0.f;
#pragma unroll
            for (int d = 0; d < DK; ++d) s += q[d] * Ks[kk][d];
            if (FCUM) s += (fq - Bs[kk]) * LOG2E;
            if (kk < kmax) {
                const float mn = fmaxf(m, s), corr = exp2f(m - mn), p = exp2f(s - mn);
                l = l * corr + p;
#pragma unroll
                for (int d = 0; d < 64; ++d) o[d] = o[d] * corr + p * Vs[kk][d];
                m = mn;
            }
        }
    }
    const float rl = 1.f / l;
    bf16_t* op = O + row * po + h * ostep;
#pragma unroll
    for (int c = 0; c < 8; ++c) { uint4 w; w.x = pk2(o[c * 8 + 0] * rl, o[c * 8 + 1] * rl); w.y = pk2(o[c * 8 + 2] * rl, o[c * 8 + 3] * rl); w.z = pk2(o[c * 8 + 4] * rl, o[c * 8 + 5] * rl); w.w = pk2(o[c * 8 + 6] * rl, o[c * 8 + 7] * rl);
        *(uint4*)(op + c * 8) = w; }
}

__device__ __forceinline__ void topk_item(const bf16_t* QP, const float* sub_keys, int* EID, float* GATE, int w, int lane) {
    const int t = w >> 3, h = w & 7;
    float sl0 = 0.f, sl1 = 0.f; int il0 = 0, il1 = 0;
#pragma unroll
    for (int p = 0; p < 2; ++p) {
        const bf16_t* q = QP + (size_t)t * 2048 + h * 256 + p * 128;
        const float* k0 = sub_keys + ((size_t)(h * 2 + p) * 128 + lane) * 128; const float* k1 = k0 + 64 * 128;
        float s0 = 0.f, s1 = 0.f;
        for (int d = 0; d < 128; ++d) { const float qd = bf2f(q[d]); s0 += qd * k0[d]; s1 += qd * k1[d]; }
        float ls = 0.f; int li = 0;
        for (int r = 0; r < 16; ++r) {
            float bv; int bi; if (s0 >= s1) { bv = s0; bi = lane; } else { bv = s1; bi = lane + 64; }
#pragma unroll
            for (int o = 32; o >= 1; o >>= 1) { const float ov = __shfl_xor(bv, o); const int oi = __shfl_xor(bi, o); if (ov > bv || (ov == bv && oi < bi)) { bv = ov; bi = oi; } }
            if (lane == r) { ls = bv; li = bi; }
            if (bi == lane) s0 = -INFINITY; else if (bi == lane + 64) s1 = -INFINITY;
        }
        if (p == 0) { sl0 = ls; il0 = li; } else { sl1 = ls; il1 = li; }
    }
    float cv0, cv1, cv2, cv3;
    { const int c0 = lane, c1 = lane + 64, c2 = lane + 128, c3 = lane + 192;
      cv0 = __shfl(sl0, c0 >> 4) + __shfl(sl1, c0 & 15); cv1 = __shfl(sl0, c1 >> 4) + __shfl(sl1, c1 & 15);
      cv2 = __shfl(sl0, c2 >> 4) + __shfl(sl1, c2 & 15); cv3 = __shfl(sl0, c3 >> 4) + __shfl(sl1, c3 & 15); }
    float tv = -INFINITY; int tc = 0;
    for (int r = 0; r < 16; ++r) {
        float bv = cv0; int bc = lane;
        if (cv1 > bv) { bv = cv1; bc = lane + 64; }
        if (cv2 > bv) { bv = cv2; bc = lane + 128; }
        if (cv3 > bv) { bv = cv3; bc = lane + 192; }
#pragma unroll
        for (int o = 32; o >= 1; o >>= 1) { const float ov = __shfl_xor(bv, o); const int oc = __shfl_xor(bc, o); if (ov > bv || (ov == bv && oc < bc)) { bv = ov; bc = oc; } }
        if (lane == r) { tv = bv; tc = bc; }
        if (bc == lane) cv0 = -INFINITY; else if (bc == lane + 64) cv1 = -INFINITY; else if (bc == lane + 128) cv2 = -INFINITY; else if (bc == lane + 192) cv3 = -INFINITY;
    }
    const float mx = __shfl(tv, 0);
    const float e = lane < 16 ? expf(tv - mx) : 0.f;
    const float sum = wave_sum(e);
    const int e1 = __shfl(il0, (tc >> 4) & 15), e2 = __shfl(il1, tc & 15);
    if (lane < 16) { EID[(size_t)t * 128 + h * 16 + lane] = e1 * 128 + e2; GATE[(size_t)t * 128 + h * 16 + lane] = e / sum; }
}

__global__ void __launch_bounds__(256) k_topk_naive(const bf16_t* QP, const float* sub_keys, int* EID, float* GATE) { topk_item(QP, sub_keys, EID, GATE, blockIdx.x * 4 + (threadIdx.x >> 6), threadIdx.x & 63); }

__device__ __forceinline__ float gelu_tanh(float x) { const float u = 0.7978845608028654f * (x + 0.044715f * x * x * x); return 0.5f * x * (1.f + tanhf(u)); }

__device__ __forceinline__ void gather_item(const bf16_t* H2, const int* EID, const float* GATE, const float* peer_u, const float* peer_v, const float* mod, float* out, int t, int lane) {
    const int b = t / S_;
    float hv[16], y[16];
#pragma unroll
    for (int j = 0; j < 4; ++j) { const uint2 raw = *(const uint2*)(H2 + (size_t)t * 1024 + 4 * lane + 256 * j); hv[4 * j] = lo2f(raw.x); hv[4 * j + 1] = hi2f(raw.x); hv[4 * j + 2] = lo2f(raw.y); hv[4 * j + 3] = hi2f(raw.y); }
#pragma unroll
    for (int i = 0; i < 16; ++i) y[i] = 0.f;
    const int e_a = EID[(size_t)t * 128 + lane], e_b = EID[(size_t)t * 128 + 64 + lane];
    const float g_a = GATE[(size_t)t * 128 + lane], g_b = GATE[(size_t)t * 128 + 64 + lane];
    for (int jj = 0; jj < 128; ++jj) {
        const int e = jj < 64 ? __shfl(e_a, jj) : __shfl(e_b, jj - 64);
        const float g = jj < 64 ? __shfl(g_a, jj) : __shfl(g_b, jj - 64);
        const float4* ur = (const float4*)(peer_u + (size_t)e * 1024) + lane;
        float s = 0.f;
#pragma unroll
        for (int j = 0; j < 4; ++j) { const float4 u4 = ur[64 * j]; s += (u4.x * hv[4 * j] + u4.y * hv[4 * j + 1]) + (u4.z * hv[4 * j + 2] + u4.w * hv[4 * j + 3]); }
        s = wave_sum(s);
        const float wgt = g * gelu_tanh(s);
        const float4* vr = (const float4*)(peer_v + (size_t)e * 1024) + lane;
#pragma unroll
        for (int j = 0; j < 4; ++j) { const float4 v4 = vr[64 * j]; y[4 * j] += wgt * v4.x; y[4 * j + 1] += wgt * v4.y; y[4 * j + 2] += wgt * v4.z; y[4 * j + 3] += wgt * v4.w; }
    }
    const float* g2 = mod + b * 6144 + 5 * 1024;
#pragma unroll
    for (int j = 0; j < 4; ++j) { const int col = 4 * lane + 256 * j; float4* op = (float4*)(out + (size_t)t * 1024 + col); float4 x1 = *op; const float4 gg = *(const float4*)(g2 + col);
        x1.x += gg.x * y[4 * j]; x1.y += gg.y * y[4 * j + 1]; x1.z += gg.z * y[4 * j + 2]; x1.w += gg.w * y[4 * j + 3]; *op = x1; }
}
__global__ void __launch_bounds__(256) k_gather_naive(const bf16_t* H2, const int* EID, const float* GATE, const float* peer_u, const float* peer_v, const float* mod, float* out) {
    gather_item(H2, EID, GATE, peer_u, peer_v, mod, out, blockIdx.x * 4 + (threadIdx.x >> 6), threadIdx.x & 63);
}


namespace pg8 {
#define PG8_LAS __attribute__((address_space(3)))
typedef unsigned short bf16_t;
typedef short bf16x8 __attribute__((ext_vector_type(8)));
typedef float f32x4 __attribute__((ext_vector_type(4)));
typedef unsigned u32x4 __attribute__((ext_vector_type(4)));
constexpr int BM = 256, BK = 64, HALF = 128, HTB = HALF * BK * 2  , STAGE_BYTES = 8 * HTB, NXCD = 8, WGM = 8;

__host__ __device__ __forceinline__ int lds_byte(int r, int c) { const int st = (r >> 4) * 2 + (c >> 5), rr = r & 15, cc = c & 31, ob = rr * 64 + cc * 2; return st * 1024 + (ob ^ (((ob >> 9) & 1) << 5)); }
__host__ __device__ __forceinline__ void stage_rc(int b, int& R, int& C) { const int st = b / 1024, sb = b % 1024, swz = sb ^ (((sb >> 9) & 1) << 5); R = (st >> 1) * 16 + swz / 64; C = (st & 1) * 32 + (swz % 64) / 2; }
__host__ __device__ __forceinline__ int perm32(int rho) { const int n = rho >> 4, i = rho & 15; return 8 * (i >> 2) + 4 * n + (i & 3); }

struct Unit { int pm, pn; };
struct Gemm { const bf16_t* A; const bf16_t* Bt; int M, N, K, lda; };

struct StaticOrder {
    int nM, nN, nwg, G, c;
    __host__ __device__ void init(int M, int N, int G_, int c_) { nM = M / BM; nN = N / BM; nwg = nM * nN; G = G_; c = c_; }
    __host__ __device__ bool next(int i, Unit& u) const {
        const long L = (long)i * G + c; if (L >= nwg) return false;
        int wgid = (int)L; { const int q = nwg / NXCD, r = nwg % NXCD, xcd = wgid % NXCD, off = wgid / NXCD; wgid = (xcd < r ? xcd * (q + 1) : r * (q + 1) + (xcd - r) * q) + off; }
        const int nig = WGM * nN, gid = wgid / nig, fm = gid * WGM, gsz = (nM - fm) < WGM ? (nM - fm) : WGM;
        u.pm = fm + ((wgid % nig) % gsz); u.pn = (wgid % nig) / gsz; return true;
    }
    __device__ __forceinline__ void a_ready(const Unit&) const {}
    __device__ __forceinline__ void done(const Unit&) const {}
};
__device__ __forceinline__ unsigned cvt_pk_bf16(float lo, float hi) { unsigned r; asm volatile("v_cvt_pk_bf16_f32 %0, %1, %2" : "=v"(r) : "v"(lo), "v"(hi)); return r; }
typedef float f32x2 __attribute__((ext_vector_type(2)));
typedef int i32x4 __attribute__((ext_vector_type(4)));
template <bool I8> struct AccT { typedef f32x4 type; };
template <> struct AccT<true> { typedef i32x4 type; };
__device__ __forceinline__ f32x4 mma16(const bf16x8 b, const bf16x8 a, const f32x4 c) { return __builtin_amdgcn_mfma_f32_16x16x32_bf16(b, a, c, 0, 0, 0); }
__device__ __forceinline__ i32x4 mma16(const bf16x8 b, const bf16x8 a, const i32x4 c) { return __builtin_amdgcn_mfma_i32_16x16x64_i8(__builtin_bit_cast(i32x4, b), __builtin_bit_cast(i32x4, a), c, 0, 0, 0); }
template <class Epi, class Sched, bool ALIGN_EPI = false, bool SP2 = false, bool I8 = false>
__device__ __forceinline__ void gemm_phase(PG8_LAS unsigned char* lds, const Gemm g, const Sched& S, const Epi& E) {
    const int tid = threadIdx.x, wid = __builtin_amdgcn_readfirstlane(tid >> 6), lane = tid & 63, wr = wid >> 2, wc = wid & 3, fr = lane & 15, fq = lane >> 4;
    const int K = g.K, nt = K / BK;
    unsigned voffA[2], voffB[2];
#pragma unroll
    for (int i = 0; i < 2; ++i) { int R, C; stage_rc(tid * 16 + i * 8192, R, C); const int Rb = Epi::PERM ? ((R & ~31) + perm32(R & 31)) : R;
        voffA[i] = (unsigned)(R * g.lda + C) * 2u; voffB[i] = (unsigned)(Rb * K + C) * 2u; }
    const size_t kstep = (size_t)(BK * 2);
    const size_t hstepA = (size_t)HALF * g.lda * 2, hstepB = (size_t)HALF * K * 2;
    const size_t tstepA = 2 * hstepA, tstepB = 2 * hstepB;
    const unsigned ldsw = (unsigned)wid * 1024u;
    const int aoff = lds_byte(wr * 64 + fr, fq * 8), boff = lds_byte(wc * 32 + fr, fq * 8);
#define PG8_SA(b, h) (((b) * 2 + (h)) * HTB)
#define PG8_SB(b, h) ((4 + (b) * 2 + (h)) * HTB)
#define PG8_STAGE(bufoff, gbase, voff) do { _Pragma("unroll") for (int _i = 0; _i < 2; ++_i) \
        __builtin_amdgcn_global_load_lds((const unsigned*)((const char*)(gbase) + (voff)[_i]), (PG8_LAS unsigned*)(lds + (bufoff) + ldsw + _i * 8192), 16, 0, 0); } while (0)
#define PG8_LDA(dst, b, h) do { _Pragma("unroll") for (int m = 0; m < 4; ++m) _Pragma("unroll") for (int k = 0; k < 2; ++k) dst[m][k] = *(const PG8_LAS bf16x8*)(lds + PG8_SA(b, h) + aoff + m * 2048 + k * 1024); } while (0)
#define PG8_LDB(dst, b, h) do { _Pragma("unroll") for (int n = 0; n < 2; ++n) _Pragma("unroll") for (int k = 0; k < 2; ++k) dst[n][k] = *(const PG8_LAS bf16x8*)(lds + PG8_SB(b, h) + boff + n * 2048 + k * 1024); } while (0)
#define PG8_MMA(ai, bj, At, Bt) do { __builtin_amdgcn_s_setprio(1); _Pragma("unroll") for (int m = 0; m < 4; ++m) _Pragma("unroll") for (int n = 0; n < 2; ++n) _Pragma("unroll") for (int k = 0; k < 2; ++k) \
        acc[ai][bj][m][n] = mma16(Bt[n][k], At[m][k], acc[ai][bj][m][n]); __builtin_amdgcn_s_setprio(0); } while (0)
#define PG8_WAIT_V(n) asm volatile("s_waitcnt vmcnt(" #n ")" ::: "memory")
#define PG8_WAIT_L(n) asm volatile("s_waitcnt lgkmcnt(" #n ")" ::: "memory")
#define PG8_BAR __builtin_amdgcn_s_barrier()
#define PG8_SCHED __builtin_amdgcn_sched_barrier(0)
    Unit cur, nxt; int ui = 0;
    if (!S.next(0, cur)) return;
    typedef typename AccT<I8>::type accv; accv acc[2][2][4][2];
#pragma unroll
    for (int a = 0; a < 2; ++a)
#pragma unroll
        for (int b = 0; b < 2; ++b)
#pragma unroll
            for (int m = 0; m < 4; ++m)
#pragma unroll
                for (int n = 0; n < 2; ++n) acc[a][b][m][n] = accv{};
    bf16x8 At[4][2], B0[2][2], B1[2][2];
    const char* cA = (const char*)g.A + (size_t)cur.pm * tstepA; const char* cB = (const char*)g.Bt + (size_t)cur.pn * tstepB;
    S.a_ready(cur);
    if constexpr (SP2) {
        PG8_STAGE(PG8_SB(0, 0), cB, voffB); PG8_STAGE(PG8_SB(0, 1), cB + hstepB, voffB); PG8_STAGE(PG8_SA(0, 0), cA, voffA); PG8_STAGE(PG8_SA(0, 1), cA + hstepA, voffA);
        if (wr == 1) PG8_BAR;
        PG8_WAIT_V(2); PG8_BAR;
        PG8_STAGE(PG8_SB(1, 0), cB + kstep, voffB); PG8_STAGE(PG8_SA(1, 0), cA + kstep, voffA); PG8_STAGE(PG8_SB(1, 1), cB + hstepB + kstep, voffB);
        PG8_WAIT_V(6); PG8_BAR;
    } else {
        PG8_STAGE(PG8_SB(0, 0), cB, voffB); PG8_STAGE(PG8_SA(0, 0), cA, voffA); PG8_STAGE(PG8_SB(0, 1), cB + hstepB, voffB); PG8_STAGE(PG8_SA(0, 1), cA + hstepA, voffA);
        if (wr == 1) PG8_BAR;
        PG8_WAIT_V(4); PG8_BAR;
        PG8_STAGE(PG8_SB(1, 0), cB + kstep, voffB); PG8_STAGE(PG8_SA(1, 0), cA + kstep, voffA); PG8_STAGE(PG8_SB(1, 1), cB + hstepB + kstep, voffB);
        PG8_WAIT_V(6); PG8_BAR;
    }
    for (;;) {
        const bool has_next = S.next(ui + 1, nxt);
        const char* nA = has_next ? (const char*)g.A + (size_t)nxt.pm * tstepA : cA; const char* nB = has_next ? (const char*)g.Bt + (size_t)nxt.pn * tstepB : cB;
        for (int t = 0; t < nt; t += 2) {
            const bool last = (t == nt - 2);
            const char* a1 = cA + (size_t)(t + 1) * kstep;
            const char* a2 = last ? nA : cA + (size_t)(t + 2) * kstep; const char* b2 = last ? nB : cB + (size_t)(t + 2) * kstep;
            const char* a3 = a2 + kstep; const char* b3 = b2 + kstep;
            if (last && has_next) S.a_ready(nxt);
            if constexpr (SP2) {
            PG8_LDB(B0, 0, 0); PG8_LDB(B1, 0, 1); PG8_SCHED; PG8_LDA(At, 0, 0); PG8_STAGE(PG8_SA(1, 1), a1 + hstepA, voffA);
            PG8_WAIT_V(8); PG8_WAIT_L(0); PG8_BAR; PG8_MMA(0, 0, At, B0); PG8_MMA(0, 1, At, B1); PG8_BAR; PG8_SCHED;
            PG8_LDA(At, 0, 1); PG8_STAGE(PG8_SB(0, 0), b2, voffB); PG8_STAGE(PG8_SB(0, 1), b2 + hstepB, voffB); PG8_STAGE(PG8_SA(0, 0), a2, voffA);
            PG8_WAIT_V(8); PG8_WAIT_L(0); PG8_BAR; PG8_MMA(1, 0, At, B0); PG8_MMA(1, 1, At, B1); PG8_BAR; PG8_SCHED;
            PG8_LDB(B0, 1, 0); PG8_LDB(B1, 1, 1); PG8_SCHED; PG8_LDA(At, 1, 0); PG8_STAGE(PG8_SA(0, 1), a2 + hstepA, voffA);
            PG8_WAIT_V(8); PG8_WAIT_L(0); PG8_BAR; PG8_MMA(0, 0, At, B0); PG8_MMA(0, 1, At, B1); PG8_BAR; PG8_SCHED;
            PG8_LDA(At, 1, 1); PG8_STAGE(PG8_SB(1, 0), b3, voffB); PG8_STAGE(PG8_SB(1, 1), b3 + hstepB, voffB); PG8_STAGE(PG8_SA(1, 0), a3, voffA);
            PG8_WAIT_V(8); PG8_WAIT_L(0); PG8_BAR; PG8_MMA(1, 0, At, B0); PG8_MMA(1, 1, At, B1); PG8_BAR; PG8_SCHED;
            } else {
            PG8_LDB(B0, 0, 0); PG8_SCHED; PG8_LDA(At, 0, 0); PG8_STAGE(PG8_SA(1, 1), a1 + hstepA, voffA);
            PG8_WAIT_L(8); PG8_BAR; PG8_WAIT_L(0); PG8_MMA(0, 0, At, B0); PG8_BAR; PG8_SCHED;
            PG8_LDB(B1, 0, 1); PG8_STAGE(PG8_SB(0, 0), b2, voffB);
            PG8_BAR; PG8_WAIT_L(0); PG8_MMA(0, 1, At, B1); PG8_BAR;
            PG8_LDA(At, 0, 1); PG8_STAGE(PG8_SA(0, 0), a2, voffA);
            PG8_BAR; PG8_WAIT_L(0); PG8_MMA(1, 0, At, B0); PG8_BAR; PG8_SCHED;
            PG8_STAGE(PG8_SB(0, 1), b2 + hstepB, voffB);
            PG8_WAIT_V(6); PG8_BAR; PG8_MMA(1, 1, At, B1); PG8_BAR;
            PG8_LDB(B0, 1, 0); PG8_SCHED; PG8_LDA(At, 1, 0); PG8_STAGE(PG8_SA(0, 1), a2 + hstepA, voffA);
            PG8_WAIT_L(8); PG8_BAR; PG8_WAIT_L(0); PG8_MMA(0, 0, At, B0); PG8_BAR; PG8_SCHED;
            PG8_LDB(B1, 1, 1); PG8_STAGE(PG8_SB(1, 0), b3, voffB);
            PG8_BAR; PG8_WAIT_L(0); PG8_MMA(0, 1, At, B1); PG8_BAR;
            PG8_LDA(At, 1, 1); PG8_STAGE(PG8_SA(1, 0), a3, voffA);
            PG8_BAR; PG8_WAIT_L(0); PG8_MMA(1, 0, At, B0); PG8_BAR; PG8_SCHED;
            PG8_STAGE(PG8_SB(1, 1), b3 + hstepB, voffB);
            PG8_WAIT_V(6); PG8_BAR; PG8_MMA(1, 1, At, B1); PG8_BAR;
            }
        }
        if constexpr (ALIGN_EPI) { if (wr == 0) PG8_BAR; }
        if constexpr (!Epi::AFTER_DRAIN) { E(acc, cur, wr, wc, fr, fq); S.done(cur); }
        if (!has_next) break;
#pragma unroll
        for (int a = 0; a < 2; ++a)
#pragma unroll
            for (int b = 0; b < 2; ++b)
#pragma unroll
                for (int m = 0; m < 4; ++m)
#pragma unroll
                    for (int n = 0; n < 2; ++n) acc[a][b][m][n] = accv{};
        cur = nxt; cA = nA; cB = nB; ++ui;
        if constexpr (ALIGN_EPI) { if (wr == 1) PG8_BAR; }
    }
    PG8_WAIT_V(0);
    if constexpr (!ALIGN_EPI) { if (wr == 0) PG8_BAR; }
    PG8_BAR;
    if constexpr (Epi::AFTER_DRAIN) { E.fused(acc, cur, wr, wc, fr, fq, lds, wid, lane); S.done(cur); }
#undef PG8_SA
#undef PG8_SB
#undef PG8_STAGE
#undef PG8_LDA
#undef PG8_LDB
#undef PG8_MMA
#undef PG8_WAIT_V
#undef PG8_WAIT_L
#undef PG8_BAR
#undef PG8_SCHED
}
}


#define GAS __attribute__((address_space(1)))
#define LAS __attribute__((address_space(3)))
typedef float f32x4 __attribute__((ext_vector_type(4)));
typedef unsigned u32x4 __attribute__((ext_vector_type(4)));
#define XB_TMO      128
#define XB_XCNT(j)  (256  + 64 * (j))
#define XB_XSUB(j)  (1280 + 64 * (j))
#define XB_XGEN(j)  (2304 + 64 * (j))
#define XB_TOP      3328
#define XB_TOPGEN   3392
#define XCD_BAR_WORDS 3456
#define XB_SPIN_CAP (1u << 18)

__device__ __forceinline__ unsigned xb_ld(unsigned* p)              { return __hip_atomic_load(p, __ATOMIC_RELAXED, __HIP_MEMORY_SCOPE_AGENT); }
__device__ __forceinline__ unsigned xb_add(unsigned* p, unsigned v) { return __hip_atomic_fetch_add(p, v, __ATOMIC_RELAXED, __HIP_MEMORY_SCOPE_AGENT); }
__device__ __forceinline__ unsigned xb_xcc_id() { return (unsigned)__builtin_amdgcn_s_getreg((3 << 11) | 20) & 0xFu; }
#define XB_SPIN(cond, bar) do { unsigned _sp = 0; while (cond) { __builtin_amdgcn_s_sleep(1); \
    if ((++_sp & 255u) == 0u) { if (xb_ld(&(bar)[XB_TMO])) break; if (_sp > XB_SPIN_CAP) { atomicAdd(&(bar)[XB_TMO], 1u); break; } } } } while (0)

struct XcdBarrier {
    unsigned* bar; unsigned x;
    volatile LAS unsigned* st;
};

__device__ __forceinline__ XcdBarrier xcd_barrier_post(unsigned* bar, volatile LAS unsigned* st) {
    XcdBarrier b; b.bar = bar; b.x = xb_xcc_id(); b.st = st;
    if (threadIdx.x == 0) (void)xb_add(&bar[XB_XCNT(b.x)], 1u);
    return b;
}
__device__ __forceinline__ void xcd_barrier_complete(unsigned* bar, unsigned x, unsigned& nloc, unsigned& nx) {
    const unsigned G = gridDim.x * gridDim.y * gridDim.z;
    unsigned sum, cnt, mine, sp = 0u;
    for (;;) {
        sum = 0u; cnt = 0u; mine = 0u;
#pragma unroll
        for (unsigned j = 0; j < 16; ++j) { const unsigned c = xb_ld(&bar[XB_XCNT(j)]); sum += c; cnt += (c > 0u) ? 1u : 0u; mine = (j == x) ? c : mine; }
        if (sum == G) break;
        __builtin_amdgcn_s_sleep(1);
        if ((++sp & 255u) == 0u) { if (xb_ld(&bar[XB_TMO])) break; if (sp > XB_SPIN_CAP) { atomicAdd(&bar[XB_TMO], 1u); break; } }
    }
    nloc = mine > 0u ? mine : 1u; nx = cnt > 0u ? cnt : 1u;
}

__device__ __forceinline__ void xcd_barrier(const XcdBarrier& b) {
    asm volatile("s_waitcnt vmcnt(0)" ::: "memory");
    __syncthreads();
    if (threadIdx.x == 0) {
        unsigned* bar = b.bar;
        __builtin_amdgcn_s_waitcnt(0);
        unsigned nloc = b.st[0], nx = b.st[1];
        if (nloc == 0u) { xcd_barrier_complete(bar, b.x, nloc, nx); b.st[0] = nloc; b.st[1] = nx; }
        const unsigned old = xb_add(&bar[XB_XSUB(b.x)], 1u);
        const unsigned gen = old / nloc;
        if (old + 1u == (gen + 1u) * nloc) {
            __builtin_amdgcn_fence(__ATOMIC_RELEASE, "agent");
            asm volatile("s_waitcnt vmcnt(0)" ::: "memory");
            const unsigned og = xb_add(&bar[XB_TOP], 1u);
            const unsigned tg = og / nx;
            if (og + 1u == (tg + 1u) * nx) xb_add(&bar[XB_TOPGEN], 1u);
            else XB_SPIN(xb_ld(&bar[XB_TOPGEN]) == tg, bar);
            __builtin_amdgcn_fence(__ATOMIC_ACQUIRE, "agent");
            xb_add(&bar[XB_XGEN(b.x)], 1u);
            asm volatile("s_waitcnt vmcnt(0)" ::: "memory");
        } else {
            XB_SPIN(xb_ld(&bar[XB_XGEN(b.x)]) == gen, bar);
            __builtin_amdgcn_fence(__ATOMIC_ACQUIRE, "agent");
            asm volatile("s_waitcnt vmcnt(0)" ::: "memory");
        }
    }
    __syncthreads();
}


constexpr int NWAVES = 8;
constexpr int RING_BYTES = 131072, LDSCTL_OFF = RING_BYTES, MISC_OFF = LDSCTL_OFF + 320, LDS_BYTES = 147456;
constexpr size_t WS_CTL = 0, CTL_ZERO_BYTES = 1 * MiB;
constexpr int CW_BAR = 4096, N_BAR_REGIONS = 16;
static_assert((CW_BAR + N_BAR_REGIONS * XCD_BAR_WORDS) * 4 <= (int)CTL_ZERO_BYTES, "barrier words inside the memset region");
constexpr size_t WS_WIN = 10 * MiB;
constexpr size_t WS_WUQ = 15 * MiB;
constexpr size_t WS_WUKV = 16 * MiB;
constexpr size_t WS_WO = 17 * MiB;
constexpr size_t WS_WPQ = 19 * MiB;
constexpr size_t WS_SK = 23 * MiB;
constexpr size_t WS_U16 = 24 * MiB;
constexpr size_t WS_V16 = 56 * MiB;


namespace att {
typedef short bf16x8 __attribute__((ext_vector_type(8)));
typedef short s16x4 __attribute__((ext_vector_type(4)));
typedef float f32x16 __attribute__((ext_vector_type(16)));
constexpr int LK = 0, KSLOT = 12288, LV = 2 * KSLOT, VSLOT = 8192, LB = LV + 2 * VSLOT, BSLOT = 256, LWS = LB + 2 * BSLOT, LOST = LWS + 8 * 256, ATT_LDS = LOST + 8 * 4096;
static_assert(ATT_LDS <= 131072, "attention scratch fits the ring region");
struct Desc { const bf16_t* Q; int pq; const bf16_t* K; int pk; const bf16_t* V; int pv; bf16_t* O; int po; const float* FC; };

__device__ __forceinline__ int crow(int r, int hi) { return (r & 3) + 8 * (r >> 2) + 4 * hi; }
__device__ __forceinline__ float xmax32(float v) { auto rr = __builtin_amdgcn_permlane32_swap(__float_as_uint(v), __float_as_uint(v), false, false); return fmaxf(__uint_as_float(rr[0]), __uint_as_float(rr[1])); }
__device__ __forceinline__ float xsum32(float v) { auto rr = __builtin_amdgcn_permlane32_swap(__float_as_uint(v), __float_as_uint(v), false, false); return __uint_as_float(rr[0]) + __uint_as_float(rr[1]); }
__device__ __forceinline__ unsigned cvtpk(float lo, float hi) { typedef float f2 __attribute__((ext_vector_type(2))); typedef __bf16 b2 __attribute__((ext_vector_type(2))); f2 v = {lo, hi}; b2 b = __builtin_convertvector(v, b2); return __builtin_bit_cast(unsigned, b); }
typedef short v4i16_t __attribute__((ext_vector_type(4)));
__device__ __forceinline__ s16x4 vtr(LAS const unsigned char* p) { return __builtin_bit_cast(s16x4, __builtin_amdgcn_ds_read_tr16_b64_v4i16((LAS v4i16_t*)p)); }

template <int KS, bool BIAS>
__device__ __forceinline__ void attn_unit(const Desc& d, int qb, int j0, LAS unsigned char* shm) {
    const int tid = threadIdx.x, lane = tid & 63, r32 = lane & 31, hi = lane >> 5; const int wid = __builtin_amdgcn_readfirstlane(tid >> 6);
    const int q0 = qb * 256, NT = (q0 + 256) / 64;
    LAS float* wsf = (LAS float*)(shm + LWS) + wid * 64;
    bf16x8 qr[KS];
    { const bf16_t* qp = d.Q + (size_t)(q0 + wid * 32 + r32) * d.pq + hi * 8;
#pragma unroll
      for (int d0 = 0; d0 < KS; ++d0) qr[d0] = *(const bf16x8*)(qp + d0 * 16); }
    const float fcref = BIAS ? d.FC[q0] : 0.f;
    const bf16_t* ksrc0 = d.K + (size_t)lane * d.pk + wid * 8;
    const bf16_t* ksrc1 = d.K + (size_t)lane * d.pk + (8 + wid) * 8;
    const bf16_t* vsrc = d.V + (size_t)(16 * (wid & 3) + (lane >> 2)) * d.pv + (wid >> 2) * 32 + (lane & 3) * 8;
    const int kdst0 = LK + wid * 1024 + lane * 16, kdst1 = LK + (8 + wid) * 1024 + lane * 16, vdst = LV + wid * 1024 + lane * 16;
    const bool k2 = (KS > 4) && (wid < 2 * KS - 8);
    u32x4 kr0, kr1, vr; float br = 0.f;
#define ATT_LOAD(t) do { kr0 = *(const u32x4*)(ksrc0 + (size_t)(t) * 64 * d.pk); if (k2) kr1 = *(const u32x4*)(ksrc1 + (size_t)(t) * 64 * d.pk); \
        vr = *(const u32x4*)(vsrc + (size_t)(t) * 64 * d.pv); if (BIAS && wid == 4) br = d.FC[(t) * 64 + lane]; } while (0)
#define ATT_WRITE(slot) do { *(LAS u32x4*)(shm + kdst0 + (slot) * KSLOT) = kr0; if (k2) *(LAS u32x4*)(shm + kdst1 + (slot) * KSLOT) = kr1; \
        *(LAS u32x4*)(shm + vdst + (slot) * VSLOT) = vr; if (BIAS && wid == 4) *(LAS float*)(shm + LB + (slot) * BSLOT + lane * 4) = (fcref - br) * LOG2E; } while (0)
    f32x16 o0, o1, negm;
#pragma unroll
    for (int r = 0; r < 16; ++r) { o0[r] = 0.f; o1[r] = 0.f; negm[r] = 0.f; }
    float mref = 0.f, l = 0.f;
    constexpr float THR = 8.f;
    const int qrel = wid * 32 + r32;
    const int kfrag = LK + hi * 1024 + r32 * 16;
    const int vfrag = LV + ((lane >> 4) & 1) * 32 + (lane & 3) * 8 + (4 * hi + ((lane & 15) >> 2)) * 64;
    ATT_LOAD(j0); ATT_WRITE(0);
    __syncthreads();
    for (int t = j0; t < NT; ++t) {
        const int slot = (t - j0) & 1;
        if (t + 1 < NT) ATT_LOAD(t + 1);
        const int jb = t - (NT - 4);
        if (!(jb >= 0 && 64 * jb > 32 * wid + 31)) {
            f32x16 p0, p1;
            if (BIAS) {
                LAS const unsigned char* bp = shm + LB + slot * BSLOT + 16 * hi;
#pragma unroll
                for (int g = 0; g < 4; ++g) { const f32x4 a = *(LAS const f32x4*)(bp + 32 * g), b = *(LAS const f32x4*)(bp + 128 + 32 * g);
#pragma unroll
                    for (int i = 0; i < 4; ++i) { p0[4 * g + i] = a[i] + negm[4 * g + i]; p1[4 * g + i] = b[i] + negm[4 * g + i]; } }
            } else { p0 = negm; p1 = negm; }
            LAS const unsigned char* kp = shm + kfrag + slot * KSLOT;
            __builtin_amdgcn_s_setprio(1);
#pragma unroll
            for (int d0 = 0; d0 < KS; ++d0) {
                const bf16x8 a0 = *(LAS const bf16x8*)(kp + d0 * 2048), a1 = *(LAS const bf16x8*)(kp + d0 * 2048 + 512);
                p0 = __builtin_amdgcn_mfma_f32_32x32x16_bf16(a0, qr[d0], p0, 0, 0, 0);
                p1 = __builtin_amdgcn_mfma_f32_32x32x16_bf16(a1, qr[d0], p1, 0, 0, 0);
            }
            __builtin_amdgcn_s_setprio(0);
            if (jb >= 0) {
                const int kb = 64 * jb + 4 * hi;
#pragma unroll
                for (int r = 0; r < 16; ++r) { const int kv = kb + (r & 3) + 8 * (r >> 2); if (kv > qrel) p0[r] = -INFINITY; if (kv + 32 > qrel) p1[r] = -INFINITY; }
            }
            float ra = __builtin_fmaxf(__builtin_fmaxf(p0[0], p0[1]), p1[0]), rb = __builtin_fmaxf(__builtin_fmaxf(p0[2], p0[3]), p1[1]);
            ra = __builtin_fmaxf(__builtin_fmaxf(ra, p1[2]), p1[3]);
#pragma unroll
            for (int r = 4; r < 16; r += 4) { ra = __builtin_fmaxf(__builtin_fmaxf(ra, p0[r]), p0[r + 1]); rb = __builtin_fmaxf(__builtin_fmaxf(rb, p0[r + 2]), p0[r + 3]);
                ra = __builtin_fmaxf(__builtin_fmaxf(ra, p1[r]), p1[r + 1]); rb = __builtin_fmaxf(__builtin_fmaxf(rb, p1[r + 2]), p1[r + 3]); }
            const float rm = xmax32(__builtin_fmaxf(ra, rb));
            if (__any(rm > THR) || t == j0) {
                const float dl = t == j0 ? rm : __builtin_fmaxf(rm, 0.f);
                mref += dl;
#pragma unroll
                for (int r = 0; r < 16; ++r) { p0[r] -= dl; p1[r] -= dl; negm[r] = -mref; }
                if (t != j0) {
                    const float alpha = __builtin_amdgcn_exp2f(-dl);
                    l *= alpha;
                    if (hi == 0) wsf[r32] = alpha;
#pragma unroll
                    for (int g = 0; g < 4; ++g) { const f32x4 a = *(LAS const f32x4*)(wsf + 8 * g + 4 * hi);
#pragma unroll
                        for (int i = 0; i < 4; ++i) { o0[4 * g + i] *= a[i]; o1[4 * g + i] *= a[i]; } }
                }
            }
            float s0 = 0.f, s1 = 0.f, s2 = 0.f, s3 = 0.f;
#pragma unroll
            for (int r = 0; r < 16; r += 2) { p0[r] = __builtin_amdgcn_exp2f(p0[r]); p0[r + 1] = __builtin_amdgcn_exp2f(p0[r + 1]); p1[r] = __builtin_amdgcn_exp2f(p1[r]); p1[r + 1] = __builtin_amdgcn_exp2f(p1[r + 1]);
                s0 += p0[r]; s1 += p0[r + 1]; s2 += p1[r]; s3 += p1[r + 1]; }
            l += (s0 + s1) + (s2 + s3);
            LAS const unsigned char* vp = shm + vfrag + slot * VSLOT;
            __builtin_amdgcn_s_setprio(1);
#pragma unroll
            for (int ks = 0; ks < 4; ++ks) {
                const f32x16& pp = ks < 2 ? p0 : p1; const int bq = (ks & 1) * 8;
                u32x4 pw; pw.x = cvtpk(pp[bq], pp[bq + 1]); pw.y = cvtpk(pp[bq + 2], pp[bq + 3]); pw.z = cvtpk(pp[bq + 4], pp[bq + 5]); pw.w = cvtpk(pp[bq + 6], pp[bq + 7]);
                const bf16x8 pa = __builtin_bit_cast(bf16x8, pw);
                const s16x4 l0 = vtr(vp + ks * 1024), h0 = vtr(vp + ks * 1024 + 512), l1 = vtr(vp + 4096 + ks * 1024), h1 = vtr(vp + 4096 + ks * 1024 + 512);
                const bf16x8 v0 = {l0[0], l0[1], l0[2], l0[3], h0[0], h0[1], h0[2], h0[3]}, v1 = {l1[0], l1[1], l1[2], l1[3], h1[0], h1[1], h1[2], h1[3]};
                o0 = __builtin_amdgcn_mfma_f32_32x32x16_bf16(pa, v0, o0, 0, 0, 0);
                o1 = __builtin_amdgcn_mfma_f32_32x32x16_bf16(pa, v1, o1, 0, 0, 0);
            }
            __builtin_amdgcn_s_setprio(0);
        }
        if (t + 1 < NT) ATT_WRITE(slot ^ 1);
        __syncthreads();
    }
#undef ATT_LOAD
#undef ATT_WRITE
    l = xsum32(l);
    if (hi == 0) wsf[32 + r32] = l;
    float rli[16];
#pragma unroll
    for (int g = 0; g < 4; ++g) { const f32x4 a = *(LAS const f32x4*)(wsf + 32 + 8 * g + 4 * hi);
#pragma unroll
        for (int i = 0; i < 4; ++i) rli[4 * g + i] = 1.f / a[i]; }
    LAS bf16_t* stg = (LAS bf16_t*)(shm + LOST) + wid * 2048;
#pragma unroll
    for (int r = 0; r < 16; ++r) { const int orow = crow(r, hi); stg[orow * 64 + r32] = f2bf(o0[r] * rli[r]); stg[orow * 64 + 32 + r32] = f2bf(o1[r] * rli[r]); }
    bf16_t* Ow = d.O + (size_t)(q0 + wid * 32) * d.po;
#pragma unroll
    for (int i = 0; i < 4; ++i) { const int row = i * 8 + (lane >> 3), ch = lane & 7; const u32x4 v = *(LAS const u32x4*)(stg + row * 64 + ch * 8); *(u32x4*)(Ow + (size_t)row * d.po + ch * 8) = v; }
    __syncthreads();
}
}


namespace pk {
typedef short bf16x8 __attribute__((ext_vector_type(8)));
typedef float f32x16 __attribute__((ext_vector_type(16)));
__device__ __forceinline__ unsigned f2sort(float f) { const unsigned b = __float_as_uint(f); return b ^ ((unsigned)((int)b >> 31) | 0x80000000u); }
__device__ __forceinline__ float sort2f(unsigned u) { return __uint_as_float((u & 0x80000000u) ? (u ^ 0x80000000u) : ~u); }
__device__ __forceinline__ void ce(unsigned& a, unsigned& b) { const unsigned mx = a > b ? a : b, mn = a > b ? b : a; a = mx; b = mn; }
__device__ __forceinline__ void sort16(unsigned (&v)[16]) {
#pragma unroll
    for (int k = 2; k <= 16; k <<= 1)
#pragma unroll
        for (int j = k >> 1; j >= 1; j >>= 1)
#pragma unroll
            for (int i = 0; i < 16; ++i) { const int l = i ^ j; if (l > i) { if ((i & k) == 0) ce(v[i], v[l]); else ce(v[l], v[i]); } }
}
__device__ __forceinline__ void merge16(unsigned (&a)[16], const unsigned (&b)[16]) {
#pragma unroll
    for (int i = 0; i < 16; ++i) a[i] = a[i] > b[15 - i] ? a[i] : b[15 - i];
#pragma unroll
    for (int j = 8; j >= 1; j >>= 1)
#pragma unroll
        for (int i = 0; i < 16; ++i) { const int l = i ^ j; if (l > i) ce(a[i], a[l]); }
}
__device__ __forceinline__ void top16of64(unsigned (&k)[64], unsigned (&out)[16]) {
    unsigned g1[16], g2[16], g3[16];
#pragma unroll
    for (int i = 0; i < 16; ++i) { out[i] = k[i]; g1[i] = k[16 + i]; g2[i] = k[32 + i]; g3[i] = k[48 + i]; }
    sort16(out); sort16(g1); sort16(g2); sort16(g3);
    merge16(out, g1); merge16(g2, g3); merge16(out, g2);
}
__device__ __forceinline__ unsigned sel4(const unsigned (&w)[4], int q) { const unsigned a = q & 1 ? w[1] : w[0], b = q & 1 ? w[3] : w[2]; return q & 2 ? b : a; }

template <int I> struct COff { static constexpr int v = COff<I - 1>::v + 16 / I; };
template <> struct COff<0> { static constexpr int v = 0; };
static_assert(COff<16>::v == 50, "50 candidates can reach the top 16 of a sorted 16 x 16 sum grid");
template <int I> __device__ __forceinline__ void fill_cand(unsigned (&c64)[64], const float (&s1)[16], const float (&s2)[16]) {
    if constexpr (I < 16) {
#pragma unroll
        for (int j = 0; j < 16 / (I + 1); ++j) c64[COff<I>::v + j] = (f2sort(s1[I] + s2[j]) & 0xFFFFFF00u) | (unsigned)(255 - (I * 16 + j));
        fill_cand<I + 1>(c64, s1, s2);
    }
}
__device__ __forceinline__ void topk_item(const bf16_t* QP, const bf16_t* SK, int* EID, float* GATE, int item, int lane) {
    const int tg = item >> 3, h = item & 7, r32 = lane & 31, hi = lane >> 5;
    const int t = tg * 32 + r32;
    unsigned own[2][16];
#pragma unroll
    for (int p = 0; p < 2; ++p) {
        const bf16_t* qrow = QP + (size_t)t * 2048 + h * 256 + p * 128 + hi * 8;
        bf16x8 qf[8];
#pragma unroll
        for (int d0 = 0; d0 < 8; ++d0) qf[d0] = *(const bf16x8*)(qrow + d0 * 16);
        const bf16_t* skb = SK + (size_t)((h * 2 + p) * 128 + r32) * 128 + hi * 8;
#pragma unroll 1
        for (int kt = 0; kt < 4; ++kt) {
            f32x16 acc;
#pragma unroll
            for (int r = 0; r < 16; ++r) acc[r] = 0.f;
#pragma unroll
            for (int d0 = 0; d0 < 8; ++d0) { const bf16x8 a = *(const bf16x8*)(skb + (size_t)kt * 32 * 128 + d0 * 16); acc = __builtin_amdgcn_mfma_f32_32x32x16_bf16(a, qf[d0], acc, 0, 0, 0); }
            unsigned cur[16];
#pragma unroll
            for (int r = 0; r < 16; ++r) { const int idx0 = kt * 32 + (r & 3) + 8 * (r >> 2);
                cur[r] = (f2sort(acc[r]) & 0xFFFFFF80u) | (unsigned)(127 - idx0 - 4 * hi); }
            sort16(cur);
            if (kt == 0) {
#pragma unroll
                for (int r = 0; r < 16; ++r) own[p][r] = cur[r];
            } else merge16(own[p], cur);
        }
    }
    unsigned fin[16];
    {
        unsigned oth[16];
#pragma unroll
        for (int i = 0; i < 16; ++i) { auto rr = __builtin_amdgcn_permlane32_swap(own[0][i], own[1][i], false, false); fin[i] = rr[0]; oth[i] = rr[1]; }
        merge16(fin, oth);
    }
    unsigned s1k[16], s2k[16];
#pragma unroll
    for (int i = 0; i < 16; ++i) { auto rr = __builtin_amdgcn_permlane32_swap(fin[i], fin[i], false, false); s1k[i] = rr[0]; s2k[i] = rr[1]; }
    float s1[16], s2[16]; unsigned long long i1lo = 0ull, i1hi = 0ull, i2lo = 0ull, i2hi = 0ull;
#pragma unroll
    for (int i = 0; i < 16; ++i) { s1[i] = sort2f(s1k[i] & 0xFFFFFF80u); s2[i] = sort2f(s2k[i] & 0xFFFFFF80u);
        const unsigned long long a = (unsigned long long)(127u - (s1k[i] & 0x7Fu)) << (8 * (i & 7)), b = (unsigned long long)(127u - (s2k[i] & 0x7Fu)) << (8 * (i & 7));
        if (i < 8) { i1lo |= a; i2lo |= b; } else { i1hi |= a; i2hi |= b; } }
    unsigned c64[64];
#pragma unroll
    for (int i = 50; i < 64; ++i) c64[i] = 0u;
    fill_cand<0>(c64, s1, s2);
    unsigned top[16];
    top16of64(c64, top);
    float ev[16]; float sum = 0.f; const float mx = sort2f(top[0] & 0xFFFFFF00u);
#pragma unroll
    for (int r = 0; r < 16; ++r) { ev[r] = __expf(sort2f(top[r] & 0xFFFFFF00u) - mx); sum += ev[r]; }
    const float rs = 1.f / sum;
    if (hi == 0) {
        int* ep = EID + (size_t)t * 128 + h * 16;
#pragma unroll
        for (int q4 = 0; q4 < 4; ++q4) { int ee[4];
#pragma unroll
            for (int z = 0; z < 4; ++z) { const int code = 255 - (int)(top[q4 * 4 + z] & 0xFFu), i = code >> 4, j = code & 15;
                const unsigned e1 = (unsigned)(((i & 8) ? i1hi : i1lo) >> (8 * (i & 7))) & 0xFFu, e2 = (unsigned)(((j & 8) ? i2hi : i2lo) >> (8 * (j & 7))) & 0xFFu; ee[z] = (int)(e1 * 128u + e2); }
            *(int4*)(ep + q4 * 4) = make_int4(ee[0], ee[1], ee[2], ee[3]); }
    } else {
        float* gp = GATE + (size_t)t * 128 + h * 16;
#pragma unroll
        for (int q4 = 0; q4 < 4; ++q4) *(float4*)(gp + q4 * 4) = make_float4(ev[q4 * 4] * rs, ev[q4 * 4 + 1] * rs, ev[q4 * 4 + 2] * rs, ev[q4 * 4 + 3] * rs);
    }
}
}


namespace gx {
typedef unsigned char u8x4 __attribute__((ext_vector_type(4)));
__device__ __forceinline__ int sdot16(const int4 a, const int4 b) {
    int s = __builtin_amdgcn_sdot4(a.x, b.x, 0, false); s = __builtin_amdgcn_sdot4(a.y, b.y, s, false); s = __builtin_amdgcn_sdot4(a.z, b.z, s, false); return __builtin_amdgcn_sdot4(a.w, b.w, s, false);
}
__device__ __forceinline__ void quant_row(const float* src, unsigned char* dst, float* scale_out, int lane) {
    const float4* sr = (const float4*)src + lane; float4 v[4]; float am = 0.f;
#pragma unroll
    for (int j = 0; j < 4; ++j) { v[j] = sr[64 * j]; am = fmaxf(am, fmaxf(fmaxf(fabsf(v[j].x), fabsf(v[j].y)), fmaxf(fabsf(v[j].z), fabsf(v[j].w)))); }
#pragma unroll
    for (int o = 1; o < 64; o <<= 1) am = fmaxf(am, __shfl_xor(am, o));
    const float inv = am > 0.f ? 127.f / am : 0.f;
#pragma unroll
    for (int j = 0; j < 4; ++j) { const int q0 = (int)rintf(v[j].x * inv), q1 = (int)rintf(v[j].y * inv), q2 = (int)rintf(v[j].z * inv), q3 = (int)rintf(v[j].w * inv);
        *(unsigned*)(dst + 4 * lane + 256 * j) = (unsigned)(q0 & 255) | ((unsigned)(q1 & 255) << 8) | ((unsigned)(q2 & 255) << 16) | ((unsigned)(q3 & 255) << 24); }
    if (lane == 0) *scale_out = am * (1.f / 127.f);
}
__device__ __forceinline__ float gelu_t(float x) { const float u = 0.7978845608028654f * (x + 0.044715f * x * x * x); return 0.5f * x * (1.f + tanhf(u)); }

__device__ __forceinline__ int hx(int lo, int hi, bool up, int bit) { const int send = up ? lo : hi, keep = up ? hi : lo; return keep + __shfl_xor(send, bit); }

__device__ __forceinline__ void u_token(const unsigned char* UQs  , const int4 (&ev)[4], const int4 hq, int* PArow, int lane) {
    const int e[16] = {ev[0].x, ev[0].y, ev[0].z, ev[0].w, ev[1].x, ev[1].y, ev[1].z, ev[1].w, ev[2].x, ev[2].y, ev[2].z, ev[2].w, ev[3].x, ev[3].y, ev[3].z, ev[3].w};
    int4 rows[16];
#pragma unroll
    for (int i = 0; i < 16; ++i) rows[i] = *(const int4*)(UQs + (size_t)e[i] * 1024);
    int p[16];
#pragma unroll
    for (int i = 0; i < 16; ++i) p[i] = sdot16(rows[i], hq);
    const bool b2 = (lane & 4) != 0, b1 = (lane & 2) != 0, b0 = (lane & 1) != 0;
    int q[8], r[4];
#pragma unroll
    for (int k = 0; k < 8; ++k) q[k] = hx(p[k], p[8 + k], b2, 4);
#pragma unroll
    for (int k = 0; k < 4; ++k) r[k] = hx(q[k], q[4 + k], b1, 2);
    const int z0 = hx(r[0], r[2], b0, 1), z1 = hx(r[1], r[3], b0, 1);
    *(int2*)(PArow + 2 * lane) = make_int2(z0, z1);
}

__device__ __forceinline__ void v_token(const unsigned char* VQs  , const int4 (&ev)[4], const int4 wh, const int4 wlo, float wscale, const float* gate2, const float* x1row, float* outrow, int s, int lane) {
    const int e[16] = {ev[0].x, ev[0].y, ev[0].z, ev[0].w, ev[1].x, ev[1].y, ev[1].z, ev[1].w, ev[2].x, ev[2].y, ev[2].z, ev[2].w, ev[3].x, ev[3].y, ev[3].z, ev[3].w};
    const int whv[4] = {wh.x, wh.y, wh.z, wh.w}, wlv[4] = {wlo.x, wlo.y, wlo.z, wlo.w};
    uint4 rows[16];
#pragma unroll
    for (int i = 0; i < 16; ++i) rows[i] = *(const uint4*)(VQs + (size_t)e[i] * 1024);
    int ah[16], al[16];
#pragma unroll
    for (int c = 0; c < 16; ++c) { ah[c] = 0; al[c] = 0; }
#pragma unroll
    for (int g = 0; g < 4; ++g) {
#pragma unroll
        for (int d = 0; d < 4; ++d) {
            const unsigned A = d == 0 ? rows[4 * g].x : d == 1 ? rows[4 * g].y : d == 2 ? rows[4 * g].z : rows[4 * g].w;
            const unsigned B = d == 0 ? rows[4 * g + 1].x : d == 1 ? rows[4 * g + 1].y : d == 2 ? rows[4 * g + 1].z : rows[4 * g + 1].w;
            const unsigned C = d == 0 ? rows[4 * g + 2].x : d == 1 ? rows[4 * g + 2].y : d == 2 ? rows[4 * g + 2].z : rows[4 * g + 2].w;
            const unsigned D = d == 0 ? rows[4 * g + 3].x : d == 1 ? rows[4 * g + 3].y : d == 2 ? rows[4 * g + 3].z : rows[4 * g + 3].w;
            const unsigned ab01 = __builtin_amdgcn_perm(A, B, 0x01050004u), ab23 = __builtin_amdgcn_perm(A, B, 0x03070206u);
            const unsigned cd01 = __builtin_amdgcn_perm(C, D, 0x01050004u), cd23 = __builtin_amdgcn_perm(C, D, 0x03070206u);
            const int q0 = (int)__builtin_amdgcn_perm(ab01, cd01, 0x01000504u), q1 = (int)__builtin_amdgcn_perm(ab01, cd01, 0x03020706u);
            const int q2 = (int)__builtin_amdgcn_perm(ab23, cd23, 0x01000504u), q3 = (int)__builtin_amdgcn_perm(ab23, cd23, 0x03020706u);
            ah[4 * d + 0] = __builtin_amdgcn_sdot4(q0, whv[g], ah[4 * d + 0], false); al[4 * d + 0] = __builtin_amdgcn_sdot4(q0, wlv[g], al[4 * d + 0], false);
            ah[4 * d + 1] = __builtin_amdgcn_sdot4(q1, whv[g], ah[4 * d + 1], false); al[4 * d + 1] = __builtin_amdgcn_sdot4(q1, wlv[g], al[4 * d + 1], false);
            ah[4 * d + 2] = __builtin_amdgcn_sdot4(q2, whv[g], ah[4 * d + 2], false); al[4 * d + 2] = __builtin_amdgcn_sdot4(q2, wlv[g], al[4 * d + 2], false);
            ah[4 * d + 3] = __builtin_amdgcn_sdot4(q3, whv[g], ah[4 * d + 3], false); al[4 * d + 3] = __builtin_amdgcn_sdot4(q3, wlv[g], al[4 * d + 3], false);
        }
    }
    int y[16];
#pragma unroll
    for (int c = 0; c < 16; ++c) y[c] = ah[c] * 128 + al[c];
    const bool b5 = (lane & 32) != 0, b4 = (lane & 16) != 0, b3 = (lane & 8) != 0;
    int z[8], q[4];
#pragma unroll
    for (int k = 0; k < 8; ++k) z[k] = hx(y[k], y[8 + k], b5, 32);
#pragma unroll
    for (int k = 0; k < 4; ++k) q[k] = hx(z[k], z[4 + k], b4, 16);
    const int r0 = hx(q[0], q[2], b3, 8), r1 = hx(q[1], q[3], b3, 8);
    const int col = 128 * s + 16 * (lane & 7) + (b5 ? 8 : 0) + (b4 ? 4 : 0) + (b3 ? 2 : 0);
    const float2 g2 = *(const float2*)(gate2 + col); float2 x1 = *(const float2*)(x1row + col);
    x1.x += g2.x * wscale * (float)r0; x1.y += g2.y * wscale * (float)r1;
    *(float2*)(outrow + col) = x1;
}
}

constexpr size_t WS_SU = 2 * MiB, WS_SV = 2 * MiB + 65536, WS_HS = 2 * MiB + 131072;
constexpr size_t WS_UQ = 24 * MiB, WS_VQ = 40 * MiB, WS_H2Q = 56 * MiB;
constexpr size_t WS_XS = 2 * MiB + 262144, WS_WINS = 2 * MiB + 393216, WS_WPQS = 2 * MiB + 409600;
constexpr size_t WS_WINQ = 456 * MiB, WS_WPQQ = 460 * MiB;
constexpr size_t WS_A = WS_KA;
struct Args { const void* in[22]; float* out; unsigned char* ws; int ph_lo, ph_hi, li, pad; };

struct Frame {
    LAS unsigned char* lds;
    int tid, lane, wave, G, gw, NGW;
};

namespace pg8 {
struct EpiProj {
    static constexpr bool PERM = true, AFTER_DRAIN = false;
    bf16_t* P; float* FL;
    __device__ __forceinline__ void operator()(const f32x4 (&acc)[2][2][4][2], const Unit& u, int wr, int wc, int fr, int fq) const {
        const int row0 = u.pm * BM + wr * 64 + fr, col0 = u.pn * BM + wc * 32 + 8 * fq;
#pragma unroll
        for (int ai = 0; ai < 2; ++ai)
#pragma unroll
            for (int m = 0; m < 4; ++m) { const int row = row0 + ai * HALF + m * 16; bf16_t* rowp = P + (size_t)row * PP + col0;
#pragma unroll
                for (int bj = 0; bj < 2; ++bj) { const f32x4 v0 = acc[ai][bj][m][0], v1 = acc[ai][bj][m][1];
                    if (col0 + bj * HALF == C_FL) { float* f = FL + (size_t)row * 8; *(f32x4*)f = v0; *(f32x4*)(f + 4) = v1; }
                    u32x4 w; w.x = cvt_pk_bf16(v0[0], v0[1]); w.y = cvt_pk_bf16(v0[2], v0[3]); w.z = cvt_pk_bf16(v1[0], v1[1]); w.w = cvt_pk_bf16(v1[2], v1[3]);
                    *(u32x4*)(rowp + bj * HALF) = w; } }
    }
};
struct EpiProjI8 {
    static constexpr bool PERM = true, AFTER_DRAIN = false;
    bf16_t* P; float* FL; const float* rs; const float* cs;
    __device__ __forceinline__ void operator()(const i32x4 (&acc)[2][2][4][2], const Unit& u, int wr, int wc, int fr, int fq) const {
        const int row0 = u.pm * BM + wr * 64 + fr, col0 = u.pn * BM + wc * 32 + 8 * fq;
        f32x4 c0[2], c1[2];
#pragma unroll
        for (int bj = 0; bj < 2; ++bj) { c0[bj] = *(const f32x4*)(cs + col0 + bj * HALF); c1[bj] = *(const f32x4*)(cs + col0 + bj * HALF + 4); }
#pragma unroll
        for (int ai = 0; ai < 2; ++ai)
#pragma unroll
            for (int m = 0; m < 4; ++m) { const int row = row0 + ai * HALF + m * 16; bf16_t* rowp = P + (size_t)row * PP + col0; const float r = rs[row];
#pragma unroll
                for (int bj = 0; bj < 2; ++bj) { const i32x4 a0 = acc[ai][bj][m][0], a1 = acc[ai][bj][m][1];
                    const f32x4 v0 = {(float)a0[0] * r * c0[bj][0], (float)a0[1] * r * c0[bj][1], (float)a0[2] * r * c0[bj][2], (float)a0[3] * r * c0[bj][3]};
                    const f32x4 v1 = {(float)a1[0] * r * c1[bj][0], (float)a1[1] * r * c1[bj][1], (float)a1[2] * r * c1[bj][2], (float)a1[3] * r * c1[bj][3]};
                    if (col0 + bj * HALF == C_FL) { float* f = FL + (size_t)row * 8; *(f32x4*)f = v0; *(f32x4*)(f + 4) = v1; }
                    u32x4 w; w.x = cvt_pk_bf16(v0[0], v0[1]); w.y = cvt_pk_bf16(v0[2], v0[3]); w.z = cvt_pk_bf16(v1[0], v1[1]); w.w = cvt_pk_bf16(v1[2], v1[3]);
                    *(u32x4*)(rowp + bj * HALF) = w; } }
    }
};
struct EpiStoreI8 {
    static constexpr bool PERM = true, AFTER_DRAIN = false;
    bf16_t* O; int ldc; const float* rs; const float* cs;
    __device__ __forceinline__ void operator()(const i32x4 (&acc)[2][2][4][2], const Unit& u, int wr, int wc, int fr, int fq) const {
        const int row0 = u.pm * BM + wr * 64 + fr, col0 = u.pn * BM + wc * 32 + 8 * fq;
        f32x4 c0[2], c1[2];
#pragma unroll
        for (int bj = 0; bj < 2; ++bj) { c0[bj] = *(const f32x4*)(cs + col0 + bj * HALF); c1[bj] = *(const f32x4*)(cs + col0 + bj * HALF + 4); }
#pragma unroll
        for (int ai = 0; ai < 2; ++ai)
#pragma unroll
            for (int m = 0; m < 4; ++m) { const int row = row0 + ai * HALF + m * 16; bf16_t* rowp = O + (size_t)row * ldc + col0; const float r = rs[row];
#pragma unroll
                for (int bj = 0; bj < 2; ++bj) { const i32x4 a0 = acc[ai][bj][m][0], a1 = acc[ai][bj][m][1];
                    u32x4 w; w.x = cvt_pk_bf16((float)a0[0] * r * c0[bj][0], (float)a0[1] * r * c0[bj][1]); w.y = cvt_pk_bf16((float)a0[2] * r * c0[bj][2], (float)a0[3] * r * c0[bj][3]);
                    w.z = cvt_pk_bf16((float)a1[0] * r * c1[bj][0], (float)a1[1] * r * c1[bj][1]); w.w = cvt_pk_bf16((float)a1[2] * r * c1[bj][2], (float)a1[3] * r * c1[bj][3]);
                    *(u32x4*)(rowp + bj * HALF) = w; } }
    }
};
struct EpiStore {
    static constexpr bool PERM = true, AFTER_DRAIN = false;
    bf16_t* O; int ldc;
    __device__ __forceinline__ void operator()(const f32x4 (&acc)[2][2][4][2], const Unit& u, int wr, int wc, int fr, int fq) const {
        const int row0 = u.pm * BM + wr * 64 + fr, col0 = u.pn * BM + wc * 32 + 8 * fq;
#pragma unroll
        for (int ai = 0; ai < 2; ++ai)
#pragma unroll
            for (int m = 0; m < 4; ++m) { bf16_t* rowp = O + (size_t)(row0 + ai * HALF + m * 16) * ldc + col0;
#pragma unroll
                for (int bj = 0; bj < 2; ++bj) { const f32x4 v0 = acc[ai][bj][m][0], v1 = acc[ai][bj][m][1];
                    u32x4 w; w.x = cvt_pk_bf16(v0[0], v0[1]); w.y = cvt_pk_bf16(v0[2], v0[3]); w.z = cvt_pk_bf16(v1[0], v1[1]); w.w = cvt_pk_bf16(v1[2], v1[3]);
                    *(u32x4*)(rowp + bj * HALF) = w; } }
    }
};
struct EpiResid {
    static constexpr bool PERM = false, AFTER_DRAIN = false;
    const float* X; const float* MOD; float* out;
    __device__ __forceinline__ void operator()(const f32x4 (&acc)[2][2][4][2], const Unit& u, int wr, int wc, int fr, int fq) const {
        const int row0 = u.pm * BM + wr * 64 + fr, col0 = u.pn * BM + wc * 32 + 4 * fq;
        const int b = (u.pm * BM) / S_;
        f32x4 gv[2][2];
#pragma unroll
        for (int bj = 0; bj < 2; ++bj)
#pragma unroll
            for (int n = 0; n < 2; ++n) gv[bj][n] = *(const f32x4*)(MOD + b * 6144 + 2 * 1024 + col0 + bj * HALF + n * 16);
#pragma unroll
        for (int ai = 0; ai < 2; ++ai)
#pragma unroll
            for (int m = 0; m < 4; ++m) { const size_t off = (size_t)(row0 + ai * HALF + m * 16) * 1024 + col0;
#pragma unroll
                for (int bj = 0; bj < 2; ++bj)
#pragma unroll
                    for (int n = 0; n < 2; ++n) { const f32x4 xv = *(const f32x4*)(X + off + bj * HALF + n * 16); *(f32x4*)(out + off + bj * HALF + n * 16) = xv + gv[bj][n] * acc[ai][bj][m][n]; } }
    }
};
}

__device__ __forceinline__ void p0_transpose_item(const float* W, int K, int N, int Npad, bf16_t* WT, LAS float* scr, int item, int lane) {
    const int nblk = Npad / 32, kb = item / nblk, nb = item % nblk, k0 = 64 * kb, n0 = 32 * nb;
    const int nn = n0 + (lane & 31);
#pragma unroll 8
    for (int i = 0; i < 32; ++i) { const int kk = 2 * i + (lane >> 5); scr[kk * 33 + (lane & 31)] = nn < N ? W[(size_t)(k0 + kk) * N + nn] : 0.f; }
    asm volatile("s_waitcnt lgkmcnt(0)" ::: "memory");
    const int c = lane & 7;
#pragma unroll
    for (int j = 0; j < 4; ++j) { const int n = (lane >> 3) + 8 * j; const LAS float* s = scr + (8 * c) * 33 + n;
        u32x4 o; o.x = pk2(s[0 * 33], s[1 * 33]); o.y = pk2(s[2 * 33], s[3 * 33]); o.z = pk2(s[4 * 33], s[5 * 33]); o.w = pk2(s[6 * 33], s[7 * 33]);
        *(u32x4*)(WT + (size_t)(n0 + n) * K + k0 + 8 * c) = o; }
    asm volatile("s_waitcnt lgkmcnt(0)" ::: "memory");
}
__device__ __forceinline__ void p0_mod_block(const float* c, const float* w_ada, const float* b_ada, float* mod, LAS unsigned char* lds, int item, int wave, int lane) {
    LAS float* sil = (LAS float*)(lds + wave * 2048);
    LAS float* part = (LAS float*)(lds + 16384);
    for (int i = lane; i < 512; i += 64) { const int b = i >> 7, kk = i & 127; const float cv = c[b * 1024 + wave * 128 + kk]; sil[kk * 4 + b] = cv / (1.f + expf(-cv)); }
    asm volatile("s_waitcnt lgkmcnt(0)" ::: "memory");
    const int j = item * 64 + lane;
    const float* wp = w_ada + (size_t)(wave * 128) * 6144 + j;
    float a0 = 0.f, a1 = 0.f, a2 = 0.f, a3 = 0.f;
#pragma unroll 16
    for (int k = 0; k < 128; ++k) { const float w = wp[(size_t)k * 6144]; const f32x4 s = *(const LAS f32x4*)(sil + k * 4); a0 += s[0] * w; a1 += s[1] * w; a2 += s[2] * w; a3 += s[3] * w; }
    part[(wave * 4 + 0) * 64 + lane] = a0; part[(wave * 4 + 1) * 64 + lane] = a1; part[(wave * 4 + 2) * 64 + lane] = a2; part[(wave * 4 + 3) * 64 + lane] = a3;
    __syncthreads();
    if (wave < 4) { float acc = b_ada[j];
#pragma unroll
        for (int w = 0; w < 8; ++w) acc += part[(w * 4 + wave) * 64 + lane];
        mod[wave * 6144 + j] = acc; }
    __syncthreads();
}

struct ModIn { float4 v[4]; };
__device__ __forceinline__ void modrow_load(ModIn& M, const float* X, int row, int lane) {
    const float4* xr = (const float4*)(X + (size_t)row * 1024) + lane;
#pragma unroll
    for (int j = 0; j < 4; ++j) M.v[j] = xr[64 * j];
}
__device__ __forceinline__ void modrow_finish(ModIn& M, const float* g, const float* mod, int shift_idx, int scale_idx, bf16_t* out, unsigned char* outq, float* hs, int row, int lane) {
    const int b = row / S_; float ss = 0.f;
#pragma unroll
    for (int j = 0; j < 4; ++j) ss += (M.v[j].x * M.v[j].x + M.v[j].y * M.v[j].y) + (M.v[j].z * M.v[j].z + M.v[j].w * M.v[j].w);
    ss = wave_sum(ss);
    const float r = rsqrtf(ss * (1.f / 1024.f) + EPS);
    const float* sh = mod + b * 6144 + shift_idx * 1024; const float* sc = mod + b * 6144 + scale_idx * 1024;
    float am = 0.f;
#pragma unroll
    for (int j = 0; j < 4; ++j) {
        const int col = 4 * lane + 256 * j; float4& v = M.v[j];
        const float4 g4 = *(const float4*)(g + col), s4 = *(const float4*)(sc + col), h4 = *(const float4*)(sh + col);
        v.x = v.x * r * g4.x * (1.f + s4.x) + h4.x; v.y = v.y * r * g4.y * (1.f + s4.y) + h4.y; v.z = v.z * r * g4.z * (1.f + s4.z) + h4.z; v.w = v.w * r * g4.w * (1.f + s4.w) + h4.w;
        if (out) { uint2 w; w.x = pk2(v.x, v.y); w.y = pk2(v.z, v.w); *(uint2*)(out + (size_t)row * 1024 + col) = w; }
        am = fmaxf(am, fmaxf(fmaxf(fabsf(v.x), fabsf(v.y)), fmaxf(fabsf(v.z), fabsf(v.w))));
    }
    if (outq) {
#pragma unroll
        for (int o = 1; o < 64; o <<= 1) am = fmaxf(am, __shfl_xor(am, o));
        const float inv = am > 0.f ? 127.f / am : 0.f;
#pragma unroll
        for (int j = 0; j < 4; ++j) { const float4 v = M.v[j]; const int q0 = (int)rintf(v.x * inv), q1 = (int)rintf(v.y * inv), q2 = (int)rintf(v.z * inv), q3 = (int)rintf(v.w * inv);
            *(unsigned*)(outq + (size_t)row * 1024 + 4 * lane + 256 * j) = (unsigned)(q0 & 255) | ((unsigned)(q1 & 255) << 8) | ((unsigned)(q2 & 255) << 16) | ((unsigned)(q3 & 255) << 24); }
        if (lane == 0) hs[row] = am * (1.f / 127.f);
    }
}
__device__ __forceinline__ void modrows2(const float* X, const float* g, const float* mod, int shift_idx, int scale_idx, bf16_t* out, unsigned char* outq, float* hs, int gw, int ngw, int lane) {
    for (int row = gw; row < T_; row += 2 * ngw) {
        const int row2 = row + ngw; ModIn Ma, Mb;
        modrow_load(Ma, X, row, lane); if (row2 < T_) modrow_load(Mb, X, row2, lane);
        modrow_finish(Ma, g, mod, shift_idx, scale_idx, out, outq, hs, row, lane); if (row2 < T_) modrow_finish(Mb, g, mod, shift_idx, scale_idx, out, outq, hs, row2, lane);
    }
}
__global__ void __launch_bounds__(NWAVES * 64, 2) mega_fwd(Args args) {
    extern __shared__ __attribute__((aligned(16))) unsigned char lds[];
    Frame F;
    F.lds = (LAS unsigned char*)lds;
    volatile LAS unsigned* MISC = (volatile LAS unsigned*)(F.lds + MISC_OFF);
    F.tid = threadIdx.x; F.lane = F.tid & 63; F.wave = __builtin_amdgcn_readfirstlane(F.tid >> 6);
    F.G = gridDim.x; F.gw = blockIdx.x * NWAVES + F.wave; F.NGW = F.G * NWAVES;
    unsigned char* ws = args.ws;
    unsigned* ctl = (unsigned*)(ws + WS_CTL);
    const float* x = (const float*)args.in[0]; const float* c = (const float*)args.in[1]; const int* positions = (const int*)args.in[2];
    const float* w_ada = (const float*)args.in[3]; const float* b_ada = (const float*)args.in[4]; const float* norm1_g = (const float*)args.in[5];
    const float* w_in = (const float*)args.in[6]; const float* mla_qa_g = (const float*)args.in[7]; const float* mla_kva_g = (const float*)args.in[8];
    const float* w_uq = (const float*)args.in[9]; const float* w_ukv = (const float*)args.in[10]; const float* mla_q_g = (const float*)args.in[11];
    const float* mla_k_g = (const float*)args.in[12]; const float* fox_q_g = (const float*)args.in[13]; const float* fox_k_g = (const float*)args.in[14];
    const float* b_f = (const float*)args.in[15]; const float* w_o = (const float*)args.in[16]; const float* norm2_g = (const float*)args.in[17];
    const float* w_pq = (const float*)args.in[18]; const float* sub_keys = (const float*)args.in[19]; const float* peer_u = (const float*)args.in[20]; const float* peer_v = (const float*)args.in[21];
    float* out = args.out;
    float* MOD = (float*)(ws + WS_MOD); float* FL = (float*)(ws + WS_FL); float* FCUM = (float*)(ws + WS_FCUM); float* LOGF = (float*)(ws + WS_LOGF); float2* ROPE = (float2*)(ws + WS_ROPE);
    bf16_t* XN = (bf16_t*)(ws + WS_XN); bf16_t* PROJ = (bf16_t*)(ws + WS_PROJ); bf16_t* KVRAW = (bf16_t*)(ws + WS_KVRAW); bf16_t* QA = (bf16_t*)(ws + WS_QA); bf16_t* KA = (bf16_t*)(ws + WS_KA);
    bf16_t* WIN = (bf16_t*)(ws + WS_WIN); bf16_t* WUQ = (bf16_t*)(ws + WS_WUQ); bf16_t* WUKV = (bf16_t*)(ws + WS_WUKV); bf16_t* WO = (bf16_t*)(ws + WS_WO); bf16_t* WPQ = (bf16_t*)(ws + WS_WPQ); bf16_t* SKB = (bf16_t*)(ws + WS_SK);
    unsigned char* XNQ = ws + WS_XN; float* XS = (float*)(ws + WS_XS); unsigned char* WINQ = ws + WS_WINQ; unsigned char* WPQQ = ws + WS_WPQQ; float* WINS = (float*)(ws + WS_WINS); float* WPQS = (float*)(ws + WS_WPQS);
    unsigned char* UQ = ws + WS_UQ; unsigned char* VQ = ws + WS_VQ; unsigned char* H2Q = ws + WS_H2Q; float* SU = (float*)(ws + WS_SU); float* SV = (float*)(ws + WS_SV); float* HS = (float*)(ws + WS_HS); float* AP = (float*)(ws + WS_A);
    bf16_t* OB = XN; bf16_t* H2 = XN; bf16_t* QP = PROJ; int* EID = (int*)(ws + WS_QA); float* GATE = (float*)(ws + WS_QA + 16 * MiB);
    (void)sub_keys; (void)peer_u; (void)peer_v; (void)positions; (void)KA; (void)FCUM; (void)LOGF; (void)ROPE; (void)mla_q_g; (void)mla_k_g; (void)b_f; (void)fox_q_g; (void)fox_k_g; (void)mla_qa_g; (void)mla_kva_g;

    for (int u = F.tid; u < (LDS_BYTES - LDSCTL_OFF) / 4; u += NWAVES * 64) ((LAS unsigned*)(F.lds + LDSCTL_OFF))[u] = 0u;
    __syncthreads();
    const int lo = args.ph_lo, hi = args.ph_hi;
    XcdBarrier bar; bar.bar = ctl + CW_BAR + args.li * XCD_BAR_WORDS; bar.x = 0; bar.st = nullptr;
    if (hi - lo > 1) bar = xcd_barrier_post(ctl + CW_BAR + args.li * XCD_BAR_WORDS, MISC + 8);
#define IN(k) (lo <= (k) && (k) < hi)
#define SEAM(k) do { if (IN(k) && IN((k) + 1)) xcd_barrier(bar); } while (0)

    if (IN(0)) REP(0) {
        LAS float* scr = (LAS float*)(F.lds + F.wave * 16384);
        constexpr int I_MOD = 96, I_IN = 16 * 72, I_UQ = 6 * 24, I_UKV = 4 * 32, I_O = 16 * 32, I_PQ = 16 * 64;
        constexpr int I_SK = 512;
        constexpr int NITEMS = I_IN + I_UQ + I_UKV + I_O + I_PQ + I_SK;
        for (int mi = (int)blockIdx.x; mi < I_MOD; mi += F.G) p0_mod_block(c, w_ada, b_ada, MOD, F.lds, mi, F.wave, F.lane);
        for (int it = F.gw; it < NITEMS; it += F.NGW) {
            int r = it;
            if (r < I_IN) { p0_transpose_item(w_in, 1024, INW, PP, WIN, scr, r, F.lane); continue; } r -= I_IN;
            if (r < I_UQ) { p0_transpose_item(w_uq, 384, 768, 768, WUQ, scr, r, F.lane); continue; } r -= I_UQ;
            if (r < I_UKV) { p0_transpose_item(w_ukv, 256, 1024, 1024, WUKV, scr, r, F.lane); continue; } r -= I_UKV;
            if (r < I_O) { p0_transpose_item(w_o, 1024, 1024, 1024, WO, scr, r, F.lane); continue; } r -= I_O;
            if (r < I_PQ) { p0_transpose_item(w_pq, 1024, 2048, 2048, WPQ, scr, r, F.lane); continue; } r -= I_PQ;
            { const float4* src = (const float4*)(sub_keys + (size_t)r * 512) + F.lane * 2; const float4 a = src[0], b2 = src[1];
              u32x4 o; o.x = pk2(a.x, a.y); o.y = pk2(a.z, a.w); o.z = pk2(b2.x, b2.y); o.w = pk2(b2.z, b2.w); *(u32x4*)(SKB + (size_t)r * 512 + F.lane * 8) = o; }
        }
    }
    if (IN(0)) {
        for (int r0 = F.gw * 4; r0 < 32768; r0 += F.NGW * 4) {
            float4 v[4][4]; float am[4];
#pragma unroll
            for (int q = 0; q < 4; ++q) { const int r = r0 + q; const float* src = (r < 16384 ? peer_u + (size_t)r * 1024 : peer_v + (size_t)(r - 16384) * 1024);
#pragma unroll
                for (int j = 0; j < 4; ++j) v[q][j] = ((const float4*)src)[F.lane + 64 * j]; }
#pragma unroll
            for (int q = 0; q < 4; ++q) { float a = 0.f;
#pragma unroll
                for (int j = 0; j < 4; ++j) a = fmaxf(a, fmaxf(fmaxf(fabsf(v[q][j].x), fabsf(v[q][j].y)), fmaxf(fabsf(v[q][j].z), fabsf(v[q][j].w))));
                am[q] = a; }
#pragma unroll
            for (int o = 1; o < 64; o <<= 1) {
#pragma unroll
                for (int q = 0; q < 4; ++q) am[q] = fmaxf(am[q], __shfl_xor(am[q], o)); }
#pragma unroll
            for (int q = 0; q < 4; ++q) { const int r = r0 + q; unsigned char* dst = (r < 16384 ? UQ + (size_t)r * 1024 : VQ + (size_t)(r - 16384) * 1024); float* sc = (r < 16384 ? SU + r : SV + (r - 16384));
                const float inv = am[q] > 0.f ? 127.f / am[q] : 0.f;
#pragma unroll
                for (int j = 0; j < 4; ++j) { const float4 x = v[q][j]; const int q0 = (int)rintf(x.x * inv), q1 = (int)rintf(x.y * inv), q2 = (int)rintf(x.z * inv), q3 = (int)rintf(x.w * inv);
                    *(unsigned*)(dst + 4 * F.lane + 256 * j) = (unsigned)(q0 & 255) | ((unsigned)(q1 & 255) << 8) | ((unsigned)(q2 & 255) << 16) | ((unsigned)(q3 & 255) << 24); }
                if (F.lane == 0) *sc = am[q] * (1.f / 127.f); }
        }
    }
    SEAM(0);
    if (IN(1)) {
        for (int r = F.gw; r < PP + 2048; r += F.NGW) {
            const bf16_t* src = r < PP ? WIN + (size_t)r * 1024 : WPQ + (size_t)(r - PP) * 1024; unsigned char* dst = r < PP ? WINQ + (size_t)r * 1024 : WPQQ + (size_t)(r - PP) * 1024; float* sc = r < PP ? WINS + r : WPQS + (r - PP);
            float v[16]; unpack8(*(const uint4*)(src + F.lane * 16), v); unpack8(*(const uint4*)(src + F.lane * 16 + 8), v + 8);
            float am = 0.f;
#pragma unroll
            for (int i = 0; i < 16; ++i) am = fmaxf(am, fabsf(v[i]));
#pragma unroll
            for (int o = 1; o < 64; o <<= 1) am = fmaxf(am, __shfl_xor(am, o));
            const float inv = am > 0.f ? 127.f / am : 0.f; unsigned q[4];
#pragma unroll
            for (int i = 0; i < 4; ++i) q[i] = (unsigned)((int)rintf(v[4 * i] * inv) & 255) | ((unsigned)((int)rintf(v[4 * i + 1] * inv) & 255) << 8) | ((unsigned)((int)rintf(v[4 * i + 2] * inv) & 255) << 16) | ((unsigned)((int)rintf(v[4 * i + 3] * inv) & 255) << 24);
            *(uint4*)(dst + F.lane * 16) = make_uint4(q[0], q[1], q[2], q[3]);
            if (F.lane == 0) *sc = am * (1.f / 127.f);
        }
        modrows2(x, norm1_g, MOD, 0, 1, nullptr, XNQ, XS, F.gw, F.NGW, F.lane);
    }
    SEAM(1);
    if (IN(2)) REP(2) {
        pg8::Gemm g{(const bf16_t*)XNQ, (const bf16_t*)WINQ, T_, PP, 512, 512}; pg8::StaticOrder S; S.init(T_, PP, F.G, (int)blockIdx.x);
        pg8::EpiProjI8 E{PROJ, FL, XS, WINS};
        pg8::gemm_phase<pg8::EpiProjI8, pg8::StaticOrder, true, true, true>(F.lds, g, S, E);
    }
    SEAM(2);
    if (IN(3)) {
        const float invf = (float)exp2(-(double)(F.lane & 15) * (13.287712379549449 / 16.0));
        for (int row = F.gw; row < T_; row += 2 * F.NGW) {
            const int row2 = row + F.NGW; RowPrepIn Ra, Rb;
            rowprep_load(Ra, PROJ, FL, positions, row, F.lane); if (row2 < T_) rowprep_load(Rb, PROJ, FL, positions, row2, F.lane);
            rowprep_finish(Ra, PROJ, mla_qa_g, mla_kva_g, fox_q_g, fox_k_g, b_f, LOGF, ROPE, row, F.lane, invf);
            if (row2 < T_) rowprep_finish(Rb, PROJ, mla_qa_g, mla_kva_g, fox_q_g, fox_k_g, b_f, LOGF, ROPE, row2, F.lane, invf);
        }
    }
    SEAM(3);
    if (IN(4)) REP(4) {
        { pg8::Gemm g{PROJ + C_CQ, WUQ, T_, 768, 384, PP}; pg8::StaticOrder S; S.init(T_, 768, F.G, (int)blockIdx.x); pg8::EpiStore E{QA, 768};
          pg8::gemm_phase<pg8::EpiStore, pg8::StaticOrder, true, true>(F.lds, g, S, E); }
        { pg8::Gemm g{PROJ + C_CKV, WUKV, T_, 1024, 256, PP}; pg8::StaticOrder S; S.init(T_, 1024, F.G, (int)blockIdx.x); pg8::EpiStore E{KVRAW, 1024};
          pg8::gemm_phase<pg8::EpiStore, pg8::StaticOrder, true, true>(F.lds, g, S, E); }
    }
    SEAM(4);
    if (IN(5)) {
        if (F.wave == 0 && (int)blockIdx.x < 32) fcum_item(LOGF, FCUM, (int)blockIdx.x, F.lane);
        for (int row = F.gw; row < T_; row += 2 * F.NGW) {
            const int row2 = row + F.NGW; MlaIn Ma, Mb;
            mlaprep_load(Ma, QA, KVRAW, PROJ, ROPE, row, F.lane); if (row2 < T_) mlaprep_load(Mb, QA, KVRAW, PROJ, ROPE, row2, F.lane);
            mlaprep_finish(Ma, QA, KA, mla_q_g, mla_k_g, row, F.lane); if (row2 < T_) mlaprep_finish(Mb, QA, KA, mla_q_g, mla_k_g, row2, F.lane);
        }
    }
    SEAM(5);
    if (IN(6)) {
        volatile LAS unsigned* qslot = MISC + 16;
        float thr;
        { float gq = fabsf(fox_q_g[F.lane]), gk = fabsf(fox_k_g[F.lane]);
#pragma unroll
          for (int o = 1; o < 64; o <<= 1) { gq = fmaxf(gq, __shfl_xor(gq, o)); gk = fmaxf(gk, __shfl_xor(gk, o)); }
          thr = 104.5f + 2.f * 1.02f * 8.f * gq * gk; }
        unsigned* qctr = ctl + 64;
        if (F.tid == 0) qslot[0] = atomicAdd(qctr, 1u);
        __syncthreads();
        unsigned u = qslot[0];
        while (u < 2048u) {
            unsigned unext = 0u;
            if (F.tid == 0) unext = atomicAdd(qctr, 1u);
            const int grp = (int)(u >> 10), bh = (int)(u & 31u), qb = 31 - (int)((u >> 5) & 31u), b = bh >> 3, h = bh & 7;
            if (grp == 0) { const att::Desc d{QA + (size_t)b * S_ * 768 + h * 96, 768, KA + (size_t)b * S_ * 768 + h * 96, 768, KVRAW + (size_t)b * S_ * 1024 + h * 128 + 64, 1024, OB + (size_t)b * S_ * 1024 + h * 64, 1024, nullptr};
                att::attn_unit<6, false>(d, qb, 0, F.lds); }
            else { const bf16_t* pb = PROJ + (size_t)b * S_ * PP + h * 64; const float* fc = FCUM + (size_t)(b * 8 + h) * S_;
                const att::Desc d{pb + C_FQ, PP, pb + C_FK, PP, pb + C_FV, PP, OB + (size_t)b * S_ * 1024 + 512 + h * 64, 1024, fc};
                const int NT = 4 * (qb + 1); const float lim = fc[qb * 256] + thr;
                int j0 = 0;
                { const int ja = F.lane, jb2 = 64 + F.lane;
                  const bool ka = ja < NT ? (fc[64 * ja + 63] <= lim) : true, kb = jb2 < NT ? (fc[64 * jb2 + 63] <= lim) : true;
                  const unsigned long long ma = __ballot(ka), mb = __ballot(kb);
                  j0 = ma ? __builtin_ctzll(ma) : (mb ? 64 + __builtin_ctzll(mb) : NT - 4); }
                if (j0 > NT - 4) j0 = NT - 4;
                att::attn_unit<4, true>(d, qb, j0, F.lds); }
            if (F.tid == 0) qslot[0] = unext;
            __syncthreads();
            u = qslot[0];
            __syncthreads();
        }
    }
    SEAM(6);
    if (IN(7)) REP(7) {
        pg8::Gemm g{OB, WO, T_, 1024, 1024, 1024}; pg8::StaticOrder S; S.init(T_, 1024, F.G, (int)blockIdx.x);
        pg8::EpiResid E{x, MOD, out};
        pg8::gemm_phase<pg8::EpiResid, pg8::StaticOrder, true, true>(F.lds, g, S, E);
    }
    SEAM(7);
    if (IN(8)) modrows2(out, norm2_g, MOD, 3, 4, nullptr, H2Q, HS, F.gw, F.NGW, F.lane);
    SEAM(8);
    if (IN(9)) REP(9) {
        pg8::Gemm g{(const bf16_t*)H2Q, (const bf16_t*)WPQQ, T_, 2048, 512, 512}; pg8::StaticOrder S; S.init(T_, 2048, F.G, (int)blockIdx.x); pg8::EpiStoreI8 E{QP, 2048, HS, WPQS};
        pg8::gemm_phase<pg8::EpiStoreI8, pg8::StaticOrder, true, true, true>(F.lds, g, S, E);
    }
    SEAM(9);
    if (IN(10)) REP(10) { for (int w = F.gw; w < (T_ / 32) * 8; w += F.NGW) pk::topk_item(QP, SKB, EID, GATE, w, F.lane); }
    SEAM(10);
    {
        const int ng = F.G < 8 ? F.G : 8; const int vx = (int)blockIdx.x % ng, rank = (int)blockIdx.x / ng, nrank = (F.G - vx + ng - 1) / ng;
        const int gwv = rank * NWAVES + F.wave, ngwv = nrank * NWAVES;
        const int grp = F.lane >> 3, sub = F.lane & 7;
        int* PA = (int*)(ws + WS_PROJ);
        int* WQH = (int*)(ws + WS_KA); int* WQL = (int*)(ws + WS_KA + 4 * MiB); float* WSC = (float*)(ws + WS_KA + 8 * MiB);
        if (IN(11)) REP(11) {
            for (int s = vx; s < 8; s += ng) {
                const unsigned char* UQs = UQ + 128 * s + 16 * sub;
                int t = gwv; int4 ev[4]; int4 hq = make_int4(0, 0, 0, 0);
#pragma unroll
                for (int k = 0; k < 4; ++k) ev[k] = make_int4(0, 0, 0, 0);
                if (t < T_) {
#pragma unroll
                    for (int k = 0; k < 4; ++k) ev[k] = *(const int4*)(EID + (size_t)t * 128 + grp * 16 + 4 * k);
                    hq = *(const int4*)(H2Q + (size_t)t * 1024 + 128 * s + 16 * sub); }
                while (t < T_) {
                    const int tn = t + ngwv; int4 evn[4]; int4 hqn = make_int4(0, 0, 0, 0);
#pragma unroll
                    for (int k = 0; k < 4; ++k) evn[k] = make_int4(0, 0, 0, 0);
                    if (tn < T_) {
#pragma unroll
                        for (int k = 0; k < 4; ++k) evn[k] = *(const int4*)(EID + (size_t)tn * 128 + grp * 16 + 4 * k);
                        hqn = *(const int4*)(H2Q + (size_t)tn * 1024 + 128 * s + 16 * sub); }
                    gx::u_token(UQs, ev, hq, PA + ((size_t)s * T_ + t) * 128, F.lane);
                    t = tn; hq = hqn;
#pragma unroll
                    for (int k = 0; k < 4; ++k) ev[k] = evn[k];
                }
            }
        }
        SEAM(11);
        if (IN(12)) REP(12) {
            for (int t = F.gw; t < T_; t += F.NGW) {
                int i0 = 0, i1 = 0;
#pragma unroll
                for (int s = 0; s < 8; ++s) { const int2 p = *(const int2*)(PA + ((size_t)s * T_ + t) * 128 + 2 * F.lane); i0 += p.x; i1 += p.y; }
                const int2 e2 = *(const int2*)(EID + (size_t)t * 128 + 2 * F.lane); const float2 g2 = *(const float2*)(GATE + (size_t)t * 128 + 2 * F.lane); const float hs = HS[t];
                const float w0 = g2.x * gx::gelu_t((float)i0 * SU[e2.x] * hs) * SV[e2.x], w1 = g2.y * gx::gelu_t((float)i1 * SU[e2.y] * hs) * SV[e2.y];
                float wm = fmaxf(fabsf(w0), fabsf(w1));
#pragma unroll
                for (int o = 1; o < 64; o <<= 1) wm = fmaxf(wm, __shfl_xor(wm, o));
                const float inv = wm > 0.f ? 16256.f / wm : 0.f;
                const int q0 = (int)rintf(w0 * inv), q1 = (int)rintf(w1 * inv);
                const unsigned h2 = (unsigned)((q0 >> 7) & 255) | ((unsigned)((q1 >> 7) & 255) << 8), l2 = (unsigned)(q0 & 127) | ((unsigned)(q1 & 127) << 8);
                const unsigned h2p = __shfl_xor(h2, 1), l2p = __shfl_xor(l2, 1);
                if ((F.lane & 1) == 0) { WQH[(size_t)t * 32 + (F.lane >> 1)] = (int)(h2 | (h2p << 16)); WQL[(size_t)t * 32 + (F.lane >> 1)] = (int)(l2 | (l2p << 16)); }
                if (F.lane == 0) WSC[t] = wm * (1.f / 16256.f);
            }
        }
        SEAM(12);
        if (IN(13)) REP(13) {
            for (int s = vx; s < 8; s += ng) {
                const unsigned char* VQs = VQ + 128 * s + 16 * sub;
                int t = gwv; int4 ev[4]; int4 wh = make_int4(0, 0, 0, 0), wl = make_int4(0, 0, 0, 0); float wsc = 0.f;
#pragma unroll
                for (int k = 0; k < 4; ++k) ev[k] = make_int4(0, 0, 0, 0);
                if (t < T_) {
#pragma unroll
                    for (int k = 0; k < 4; ++k) ev[k] = *(const int4*)(EID + (size_t)t * 128 + grp * 16 + 4 * k);
                    wh = *(const int4*)(WQH + (size_t)t * 32 + grp * 4); wl = *(const int4*)(WQL + (size_t)t * 32 + grp * 4); wsc = WSC[t]; }
                while (t < T_) {
                    const int tn = t + ngwv; int4 evn[4]; int4 whn = make_int4(0, 0, 0, 0), wln = make_int4(0, 0, 0, 0); float wscn = 0.f;
#pragma unroll
                    for (int k = 0; k < 4; ++k) evn[k] = make_int4(0, 0, 0, 0);
                    if (tn < T_) {
#pragma unroll
                        for (int k = 0; k < 4; ++k) evn[k] = *(const int4*)(EID + (size_t)tn * 128 + grp * 16 + 4 * k);
                        whn = *(const int4*)(WQH + (size_t)tn * 32 + grp * 4); wln = *(const int4*)(WQL + (size_t)tn * 32 + grp * 4); wscn = WSC[tn]; }
                    float* dstrow = (PROBE_DUP == 13 && _r == 0) ? (float*)(ws + WS_XN) + (size_t)t * 1024 : out + (size_t)t * 1024;
                    gx::v_token(VQs, ev, wh, wl, wsc, MOD + (t / S_) * 6144 + 5 * 1024, out + (size_t)t * 1024, dstrow, s, F.lane);
                    t = tn; wh = whn; wl = wln; wsc = wscn;
#pragma unroll
                    for (int k = 0; k < 4; ++k) ev[k] = evn[k];
                }
            }
        }
    }
#undef IN
#undef SEAM
}

static int g_grid = 0;
static void launch_mega(const Args& base, int lo, int hi, int li, hipStream_t stream) {
    Args a = base; a.ph_lo = lo; a.ph_hi = hi; a.li = li;
    hipLaunchKernelGGL(mega_fwd, dim3(g_grid), dim3(NWAVES * 64), LDS_BYTES, stream, a);
}

extern "C" void kernel_launch(void* const* d_in, const int* in_sizes, int n_in, void* d_out, int out_size, void* d_ws, size_t ws_size, hipStream_t stream) {
    if (g_grid == 0) {
        int dev = 0, cus = 0;
        hipGetDevice(&dev); hipDeviceGetAttribute(&cus, hipDeviceAttributeMultiprocessorCount, dev);
        hipFuncSetAttribute((const void*)mega_fwd, hipFuncAttributeMaxDynamicSharedMemorySize, LDS_BYTES);
        int per_cu = 0; hipOccupancyMaxActiveBlocksPerMultiprocessor(&per_cu, (const void*)mega_fwd, NWAVES * 64, LDS_BYTES);
        (void)hipGetLastError();
        g_grid = cus > 0 ? cus : 256;
        if (per_cu < 1) fprintf(stderr, "kernel_launch: occupancy query says %d blocks/CU\n", per_cu);
    }
    const float* x = (const float*)d_in[0]; const int* positions = (const int*)d_in[2];
    const float* mla_qa_g = (const float*)d_in[7]; const float* mla_kva_g = (const float*)d_in[8];
    const float* mla_q_g = (const float*)d_in[11]; const float* mla_k_g = (const float*)d_in[12]; const float* fox_q_g = (const float*)d_in[13]; const float* fox_k_g = (const float*)d_in[14];
    const float* b_f = (const float*)d_in[15]; const float* sub_keys = (const float*)d_in[19]; const float* peer_u = (const float*)d_in[20]; const float* peer_v = (const float*)d_in[21];
    float* out = (float*)d_out; unsigned char* ws = (unsigned char*)d_ws;
    float* MOD = (float*)(ws + WS_MOD); float* FL = (float*)(ws + WS_FL); float* FCUM = (float*)(ws + WS_FCUM); float* LOGF = (float*)(ws + WS_LOGF); float2* ROPE = (float2*)(ws + WS_ROPE);
    bf16_t* XN = (bf16_t*)(ws + WS_XN); bf16_t* PROJ = (bf16_t*)(ws + WS_PROJ); bf16_t* KVRAW = (bf16_t*)(ws + WS_KVRAW); bf16_t* QA = (bf16_t*)(ws + WS_QA); bf16_t* KA = (bf16_t*)(ws + WS_KA);
    bf16_t* OB = XN; bf16_t* H2 = XN; bf16_t* QP = PROJ; int* EID = (int*)(ws + WS_QA); float* GATE = (float*)(ws + WS_QA + 16 * MiB);
    (void)x;
    hipMemsetAsync(ws + WS_CTL, 0, CTL_ZERO_BYTES, stream);
    Args base{}; for (int i = 0; i < 22; ++i) base.in[i] = d_in[i]; base.out = out; base.ws = ws;

    launch_mega(base, 0, 14, 0, stream);
}
```

```cpp
#include <hip/hip_runtime.h>
#ifndef PROBE_DUP
#define PROBE_DUP -1
#endif
#define REP(k) for (int _r = 0; _r < ((PROBE_DUP == (k)) ? 2 : 1); ++_r)
#include <cstdint>
#include <cstdio>
#include <cmath>

typedef unsigned short bf16_t;
constexpr int B_ = 4, S_ = 8192, D_ = 1024, T_ = B_ * S_;
constexpr int PP = 2304;
constexpr int C_CQ = 0, C_CKV = 384, C_KPE = 640, C_FQ = 672, C_FK = 1184, C_FV = 1696, C_FL = 2208, INW = 2216;
constexpr float EPS = 1e-6f;
constexpr float LOG2E = 1.4426950408889634f;
constexpr float C2A = 0.10206207261596577f * LOG2E;
constexpr float C2F = 0.125f * LOG2E;

__device__ __forceinline__ float bf2f(bf16_t v) { return __uint_as_float(((unsigned)v) << 16); }
__device__ __forceinline__ bf16_t f2bf(float f) { unsigned u = __float_as_uint(f); return (bf16_t)((u + 0x7fffu + ((u >> 16) & 1u)) >> 16); }
__device__ __forceinline__ unsigned pk2(float lo, float hi) { return (unsigned)f2bf(lo) | ((unsigned)f2bf(hi) << 16); }
__device__ __forceinline__ float lo2f(unsigned w) { return __uint_as_float(w << 16); }
__device__ __forceinline__ float hi2f(unsigned w) { return __uint_as_float(w & 0xffff0000u); }
__device__ __forceinline__ float wave_sum(float v) {
#pragma unroll
    for (int o = 1; o < 64; o <<= 1) v += __shfl_xor(v, o);
    return v;
}

constexpr size_t MiB = 1u << 20;
constexpr size_t WS_MOD = 1 * MiB;
constexpr size_t WS_FL = 3 * MiB;
constexpr size_t WS_FCUM = 4 * MiB;
constexpr size_t WS_LOGF = 5 * MiB;
constexpr size_t WS_ROPE = 6 * MiB;
constexpr size_t WS_XN = 88 * MiB;
constexpr size_t WS_PROJ = 152 * MiB;
constexpr size_t WS_KVRAW = 296 * MiB;
constexpr size_t WS_QA = 360 * MiB;
constexpr size_t WS_KA = 408 * MiB;

__global__ void k_mod(const float* c, const float* w_ada, const float* b_ada, float* mod) {
    const int j = blockIdx.x * 256 + threadIdx.x, b = blockIdx.y;
    float acc = b_ada[j];
    for (int k = 0; k < 1024; ++k) { const float cv = c[b * 1024 + k]; const float s = cv / (1.f + expf(-cv)); acc += s * w_ada[(size_t)k * 6144 + j]; }
    mod[b * 6144 + j] = acc;
}

__global__ void __launch_bounds__(256) k_modrows(const float* X, const float* g, const float* mod, int shift_idx, int scale_idx, bf16_t* out) {
    const int wave = threadIdx.x >> 6, lane = threadIdx.x & 63;
    const int row = blockIdx.x * 4 + wave, b = row / S_;
    const float4* xr = (const float4*)(X + (size_t)row * 1024) + lane;
    float4 v[4]; float ss = 0.f;
#pragma unroll
    for (int j = 0; j < 4; ++j) { v[j] = xr[64 * j]; ss += (v[j].x * v[j].x + v[j].y * v[j].y) + (v[j].z * v[j].z + v[j].w * v[j].w); }
    ss = wave_sum(ss);
    const float r = rsqrtf(ss * (1.f / 1024.f) + EPS);
    const float* sh = mod + b * 6144 + shift_idx * 1024; const float* sc = mod + b * 6144 + scale_idx * 1024;
#pragma unroll
    for (int j = 0; j < 4; ++j) {
        const int col = 4 * lane + 256 * j;
        const float4 g4 = *(const float4*)(g + col), s4 = *(const float4*)(sc + col), h4 = *(const float4*)(sh + col);
        const float o0 = v[j].x * r * g4.x * (1.f + s4.x) + h4.x, o1 = v[j].y * r * g4.y * (1.f + s4.y) + h4.y;
        const float o2 = v[j].z * r * g4.z * (1.f + s4.z) + h4.z, o3 = v[j].w * r * g4.w * (1.f + s4.w) + h4.w;
        uint2 w; w.x = pk2(o0, o1); w.y = pk2(o2, o3);
        *(uint2*)(out + (size_t)row * 1024 + col) = w;
    }
}

template <int MODE>
__global__ void __launch_bounds__(256) k_gemm_naive(const bf16_t* A, int lda, const float* W, int K, int N, void* Cout, int ldc, const float* aux1, const float* aux2, float* fl) {
    __shared__ float As[16][64];
    __shared__ float Ws[16][64];
    const int tx = threadIdx.x & 15, ty = threadIdx.x >> 4;
    const int m0 = blockIdx.y * 64, n0 = blockIdx.x * 64;
    float acc[4][4];
#pragma unroll
    for (int i = 0; i < 4; ++i)
#pragma unroll
        for (int j = 0; j < 4; ++j) acc[i][j] = 0.f;
    for (int k0 = 0; k0 < K; k0 += 16) {
        { const int r = threadIdx.x >> 2, kq = (threadIdx.x & 3) * 4; const uint2 a2 = *(const uint2*)(A + (size_t)(m0 + r) * lda + k0 + kq);
          As[kq + 0][r] = lo2f(a2.x); As[kq + 1][r] = hi2f(a2.x); As[kq + 2][r] = lo2f(a2.y); As[kq + 3][r] = hi2f(a2.y); }
        { const int kk = threadIdx.x >> 4, nq = (threadIdx.x & 15) * 4; float4 w4 = make_float4(0.f, 0.f, 0.f, 0.f);
          if (n0 + nq < N) w4 = *(const float4*)(W + (size_t)(k0 + kk) * N + n0 + nq);
          *(float4*)&Ws[kk][nq] = w4; }
        __syncthreads();
#pragma unroll
        for (int kk = 0; kk < 16; ++kk) {
            const float4 a4 = *(const float4*)&As[kk][ty * 4]; const float4 w4 = *(const float4*)&Ws[kk][tx * 4];
            const float a[4] = {a4.x, a4.y, a4.z, a4.w}; const float w[4] = {w4.x, w4.y, w4.z, w4.w};
#pragma unroll
            for (int i = 0; i < 4; ++i)
#pragma unroll
                for (int j = 0; j < 4; ++j) acc[i][j] += a[i] * w[j];
        }
        __syncthreads();
    }
#pragma unroll
    for (int i = 0; i < 4; ++i) {
        const int m = m0 + ty * 4 + i;
#pragma unroll
        for (int j = 0; j < 4; ++j) {
            const int n = n0 + tx * 4 + j;
            if (n < N) {
                if (MODE == 0) ((bf16_t*)Cout)[(size_t)m * ldc + n] = f2bf(acc[i][j]);
                else if (MODE == 1) { if (n < C_FL) ((bf16_t*)Cout)[(size_t)m * ldc + n] = f2bf(acc[i][j]); else fl[(size_t)m * 8 + (n - C_FL)] = acc[i][j]; }
                else { const int b = m / S_; ((float*)Cout)[(size_t)m * ldc + n] = aux1[(size_t)m * 1024 + n] + aux2[b * 6144 + 2 * 1024 + n] * acc[i][j]; }
            }
        }
    }
}

__device__ __forceinline__ void unpack8(const uint4 raw, float* v) {
    v[0] = lo2f(raw.x); v[1] = hi2f(raw.x); v[2] = lo2f(raw.y); v[3] = hi2f(raw.y); v[4] = lo2f(raw.z); v[5] = hi2f(raw.z); v[6] = lo2f(raw.w); v[7] = hi2f(raw.w);
}
struct RowPrepIn { uint4 cq, ckv, fq, fk; float fl; int pos; };
__device__ __forceinline__ void rowprep_load(RowPrepIn& R, const bf16_t* PROJ, const float* FL, const int* positions, int row, int lane) {
    const bf16_t* pr = PROJ + (size_t)row * PP;
    R.cq = lane < 48 ? *(const uint4*)(pr + C_CQ + lane * 8) : make_uint4(0u, 0u, 0u, 0u);
    R.ckv = lane < 32 ? *(const uint4*)(pr + C_CKV + lane * 8) : make_uint4(0u, 0u, 0u, 0u);
    R.fq = *(const uint4*)(pr + C_FQ + lane * 8); R.fk = *(const uint4*)(pr + C_FK + lane * 8);
    R.fl = lane < 8 ? FL[(size_t)row * 8 + lane] : 0.f; R.pos = positions[row];
}
__device__ __forceinline__ uint4 scale8(const float* v, float r, const float* g) {
    uint4 o; o.x = pk2(v[0] * r * g[0], v[1] * r * g[1]); o.y = pk2(v[2] * r * g[2], v[3] * r * g[3]); o.z = pk2(v[4] * r * g[4], v[5] * r * g[5]); o.w = pk2(v[6] * r * g[6], v[7] * r * g[7]); return o;
}
__device__ __forceinline__ void rowprep_finish(const RowPrepIn& R, bf16_t* PROJ, const float* g_qa, const float* g_kva, const float* g_fq, const float* g_fk, const float* b_f,
                                               float* LOGF, float2* ROPE, int row, int lane, float invf) {
    bf16_t* pr = PROJ + (size_t)row * PP;
    float vq[8], vk[8], v1[8], v2[8];
    unpack8(R.cq, vq); unpack8(R.ckv, vk); unpack8(R.fq, v1); unpack8(R.fk, v2);
    float sq = 0.f, sk = 0.f, s1 = 0.f, s2 = 0.f;
#pragma unroll
    for (int i = 0; i < 8; ++i) { sq += vq[i] * vq[i]; sk += vk[i] * vk[i]; s1 += v1[i] * v1[i]; s2 += v2[i] * v2[i]; }
    s1 += __shfl_xor(s1, 1); s2 += __shfl_xor(s2, 1); s1 += __shfl_xor(s1, 2); s2 += __shfl_xor(s2, 2); s1 += __shfl_xor(s1, 4); s2 += __shfl_xor(s2, 4);
#pragma unroll
    for (int o = 1; o < 64; o <<= 1) { sq += __shfl_xor(sq, o); sk += __shfl_xor(sk, o); }
    const float rq = rsqrtf(sq * (1.f / 384.f) + EPS), rk = rsqrtf(sk * (1.f / 256.f) + EPS);
    const float r1 = rsqrtf(s1 * (1.f / 64.f) + EPS) * C2F, r2 = rsqrtf(s2 * (1.f / 64.f) + EPS);
    if (lane < 48) *(uint4*)(pr + C_CQ + lane * 8) = scale8(vq, rq, g_qa + lane * 8);
    if (lane < 32) *(uint4*)(pr + C_CKV + lane * 8) = scale8(vk, rk, g_kva + lane * 8);
    *(uint4*)(pr + C_FQ + lane * 8) = scale8(v1, r1, g_fq + (lane & 7) * 8);
    *(uint4*)(pr + C_FK + lane * 8) = scale8(v2, r2, g_fk + (lane & 7) * 8);
    if (lane < 8) { const float z = R.fl + b_f[lane]; LOGF[((size_t)(row / S_) * 8 + lane) * S_ + (row % S_)] = fminf(z, 0.f) - log1pf(expf(-fabsf(z))); }
    if (lane < 16) {
        const double a = (double)((float)R.pos * invf), n = rint(a * 0.15915494309189535);
        const float red = (float)(a - n * 6.283185307179586);
        ROPE[(size_t)row * 16 + lane] = make_float2(__cosf(red), __sinf(red)); }
}
__device__ __forceinline__ void rowprep_row(bf16_t* PROJ, const float* FL, const float* g_qa, const float* g_kva, const float* g_fq, const float* g_fk, const float* b_f,
                                                 const int* positions, float* LOGF, float2* ROPE, int row, int lane) {
    const float invf = (float)exp2(-(double)(lane & 15) * (13.287712379549449 / 16.0));
    RowPrepIn R; rowprep_load(R, PROJ, FL, positions, row, lane); rowprep_finish(R, PROJ, g_qa, g_kva, g_fq, g_fk, b_f, LOGF, ROPE, row, lane, invf);
}
__global__ void __launch_bounds__(256) k_rowprep(bf16_t* PROJ, const float* FL, const float* g_qa, const float* g_kva, const float* g_fq, const float* g_fk, const float* b_f,
                                                 const int* positions, float* LOGF, float2* ROPE) {
    rowprep_row(PROJ, FL, g_qa, g_kva, g_fq, g_fk, b_f, positions, LOGF, ROPE, blockIdx.x * 4 + (threadIdx.x >> 6), threadIdx.x & 63);
}

__device__ __forceinline__ void fcum_item(const float* LOGF, float* FCUM, int item, int lane) {
    const float4* src = (const float4*)(LOGF + (size_t)item * S_ + 128 * lane);
    float4 v[32]; float tot = 0.f;
#pragma unroll
    for (int i = 0; i < 32; ++i) v[i] = src[i];
#pragma unroll
    for (int i = 0; i < 32; ++i) tot += (v[i].x + v[i].y) + (v[i].z + v[i].w);
    float incl = tot;
#pragma unroll
    for (int o = 1; o < 64; o <<= 1) { const float t = __shfl_up(incl, o); if (lane >= o) incl += t; }
    float run = incl - tot;
    float4* dst = (float4*)(FCUM + (size_t)item * S_ + 128 * lane);
#pragma unroll
    for (int i = 0; i < 32; ++i) { float4 o; run += v[i].x; o.x = run; run += v[i].y; o.y = run; run += v[i].z; o.z = run; run += v[i].w; o.w = run; dst[i] = o; }
}
__global__ void __launch_bounds__(64) k_fcum(const float* LOGF, float* FCUM) { fcum_item(LOGF, FCUM, blockIdx.x, threadIdx.x); }

struct MlaIn { uint4 qn, kn; unsigned q1, q2, k1, k2; float2 cs0, cs1; };
__device__ __forceinline__ void mlaprep_load(MlaIn& M, const bf16_t* QRAW, const bf16_t* KVRAW, const bf16_t* PROJ, const float2* ROPE, int row, int lane) {
    const int h = lane >> 3, p = lane & 7;
    const bf16_t* q = QRAW + (size_t)row * 768 + h * 96; const bf16_t* kp = PROJ + (size_t)row * PP + C_KPE;
    M.qn = *(const uint4*)(q + 8 * p); M.q1 = *(const unsigned*)(q + 64 + 2 * p); M.q2 = *(const unsigned*)(q + 80 + 2 * p);
    M.kn = *(const uint4*)(KVRAW + (size_t)row * 1024 + h * 128 + 8 * p); M.k1 = *(const unsigned*)(kp + 2 * p); M.k2 = *(const unsigned*)(kp + 16 + 2 * p);
    M.cs0 = ROPE[(size_t)row * 16 + 2 * p]; M.cs1 = ROPE[(size_t)row * 16 + 2 * p + 1];
}
__device__ __forceinline__ void mlaprep_finish(const MlaIn& M, bf16_t* QRAW, bf16_t* KA, const float* g_q, const float* g_k, int row, int lane) {
    const int h = lane >> 3, p = lane & 7;
#pragma unroll
    for (int which = 0; which < 2; ++which) {
        const float* g = which == 0 ? g_q : g_k; const float sc = which == 0 ? C2A : 1.f;
        float v[8]; unpack8(which == 0 ? M.qn : M.kn, v); const unsigned r1 = which == 0 ? M.q1 : M.k1, r2 = which == 0 ? M.q2 : M.k2;
        float a0 = lo2f(r1), a1 = hi2f(r1), b0 = lo2f(r2), b1 = hi2f(r2);
        float ss = a0 * a0 + a1 * a1 + b0 * b0 + b1 * b1;
#pragma unroll
        for (int i = 0; i < 8; ++i) ss += v[i] * v[i];
        ss += __shfl_xor(ss, 1); ss += __shfl_xor(ss, 2); ss += __shfl_xor(ss, 4);
        const float r = rsqrtf(ss * (1.f / 96.f) + EPS);
        const float* gn = g + 8 * p;
        a0 *= r * g[64 + 2 * p]; a1 *= r * g[64 + 2 * p + 1]; b0 *= r * g[80 + 2 * p]; b1 *= r * g[80 + 2 * p + 1];
        const float ra0 = a0 * M.cs0.x - b0 * M.cs0.y, rb0 = b0 * M.cs0.x + a0 * M.cs0.y, ra1 = a1 * M.cs1.x - b1 * M.cs1.y, rb1 = b1 * M.cs1.x + a1 * M.cs1.y;
        uint4 o; o.x = pk2(v[0] * r * gn[0] * sc, v[1] * r * gn[1] * sc); o.y = pk2(v[2] * r * gn[2] * sc, v[3] * r * gn[3] * sc);
        o.z = pk2(v[4] * r * gn[4] * sc, v[5] * r * gn[5] * sc); o.w = pk2(v[6] * r * gn[6] * sc, v[7] * r * gn[7] * sc);
        bf16_t* dst = (which == 0 ? QRAW : KA) + (size_t)row * 768 + h * 96;
        *(uint4*)(dst + 8 * p) = o; *(unsigned*)(dst + 64 + 2 * p) = pk2(ra0 * sc, ra1 * sc); *(unsigned*)(dst + 80 + 2 * p) = pk2(rb0 * sc, rb1 * sc);
    }
}
__device__ __forceinline__ void mlaprep_row(bf16_t* QRAW, const bf16_t* KVRAW, const bf16_t* PROJ, bf16_t* KA, const float2* ROPE, const float* g_q, const float* g_k, int row, int lane) {
    MlaIn M; mlaprep_load(M, QRAW, KVRAW, PROJ, ROPE, row, lane); mlaprep_finish(M, QRAW, KA, g_q, g_k, row, lane);
}

__global__ void __launch_bounds__(256) k_mlaprep(bf16_t* QRAW, const bf16_t* KVRAW, const bf16_t* PROJ, bf16_t* KA, const float2* ROPE, const float* g_q, const float* g_k) {
    mlaprep_row(QRAW, KVRAW, PROJ, KA, ROPE, g_q, g_k, blockIdx.x * 4 + (threadIdx.x >> 6), threadIdx.x & 63);
}

template <int DK>
__global__ void __launch_bounds__(256) k_attn_naive(const bf16_t* Q, int pq, int qstep, const bf16_t* K, int pk, int kstep, const bf16_t* V, int pv, int vstep, bf16_t* O, int po, int ostep, const float* FCUM) {
    __shared__ float Ks[64][DK];
    __shared__ float Vs[64][64];
    __shared__ float Bs[64];
    const int bh = blockIdx.x >> 5, qb = blockIdx.x & 31, b = bh >> 3, h = bh & 7;
    const int t = qb * 256 + threadIdx.x;
    const size_t row = (size_t)b * S_ + t;
    float q[DK];
#pragma unroll
    for (int c = 0; c < DK / 8; ++c) unpack8(*(const uint4*)(Q + row * pq + h * qstep + c * 8), q + c * 8);
    float o[64];
#pragma unroll
    for (int d = 0; d < 64; ++d) o[d] = 0.f;
    float m = -INFINITY, l = 0.f;
    const float fq = FCUM ? FCUM[(size_t)(b * 8 + h) * S_ + t] : 0.f;
    const int ntiles = (qb * 256 + 256) / 64;
    for (int kt = 0; kt < ntiles; ++kt) {
        __syncthreads();
        for (int c = threadIdx.x; c < 64 * (DK / 8); c += 256) { const int key = c / (DK / 8), ch = c % (DK / 8); float v[8];
            unpack8(*(const uint4*)(K + ((size_t)b * S_ + kt * 64 + key) * pk + h * kstep + ch * 8), v);
#pragma unroll
            for (int i = 0; i < 8; ++i) Ks[key][ch * 8 + i] = v[i]; }
        for (int c = threadIdx.x; c < 64 * 8; c += 256) { const int key = c >> 3, ch = c & 7; float v[8];
            unpack8(*(const uint4*)(V + ((size_t)b * S_ + kt * 64 + key) * pv + h * vstep + ch * 8), v);
#pragma unroll
            for (int i = 0; i < 8; ++i) Vs[key][ch * 8 + i] = v[i]; }
        if (threadIdx.x < 64) Bs[threadIdx.x] = FCUM ? FCUM[(size_t)(b * 8 + h) * S_ + kt * 64 + threadIdx.x] : 0.f;
        __syncthreads();
        const int kmax = t - kt * 64 + 1;
        for (int kk = 0; kk < 64; ++kk) {
            float s = 0.f;
#pragma unroll
            for (int d = 0; d < DK; ++d) s += q[d] * Ks[kk][d];
            if (FCUM) s += (fq - Bs[kk]) * LOG2E;
            if (kk < kmax) {
                const float mn = fmaxf(m, s), corr = exp2f(m - mn), p = exp2f(s - mn);
                l = l * corr + p;
#pragma unroll
                for (int d = 0; d < 64; ++d) o[d] = o[d] * corr + p * Vs[kk][d];
                m = mn;
            }
        }
    }
    const float rl = 1.f / l;
    bf16_t* op = O + row * po + h * ostep;
#pragma unroll
    for (int c = 0; c < 8; ++c) { uint4 w; w.x = pk2(o[c * 8 + 0] * rl, o[c * 8 + 1] * rl); w.y = pk2(o[c * 8 + 2] * rl, o[c * 8 + 3] * rl); w.z = pk2(o[c * 8 + 4] * rl, o[c * 8 + 5] * rl); w.w = pk2(o[c * 8 + 6] * rl, o[c * 8 + 7] * rl);
        *(uint4*)(op + c * 8) = w; }
}

__device__ __forceinline__ void topk_item(const bf16_t* QP, const float* sub_keys, int* EID, float* GATE, int w, int lane) {
    const int t = w >> 3, h = w & 7;
    float sl0 = 0.f, sl1 = 0.f; int il0 = 0, il1 = 0;
#pragma unroll
    for (int p = 0; p < 2; ++p) {
        const bf16_t* q = QP + (size_t)t * 2048 + h * 256 + p * 128;
        const float* k0 = sub_keys + ((size_t)(h * 2 + p) * 128 + lane) * 128; const float* k1 = k0 + 64 * 128;
        float s0 = 0.f, s1 = 0.f;
        for (int d = 0; d < 128; ++d) { const float qd = bf2f(q[d]); s0 += qd * k0[d]; s1 += qd * k1[d]; }
        float ls = 0.f; int li = 0;
        for (int r = 0; r < 16; ++r) {
            float bv; int bi; if (s0 >= s1) { bv = s0; bi = lane; } else { bv = s1; bi = lane + 64; }
#pragma unroll
            for (int o = 32; o >= 1; o >>= 1) { const float ov = __shfl_xor(bv, o); const int oi = __shfl_xor(bi, o); if (ov > bv || (ov == bv && oi < bi)) { bv = ov; bi = oi; } }
            if (lane == r) { ls = bv; li = bi; }
            if (bi == lane) s0 = -INFINITY; else if (bi == lane + 64) s1 = -INFINITY;
        }
        if (p == 0) { sl0 = ls; il0 = li; } else { sl1 = ls; il1 = li; }
    }
    float cv0, cv1, cv2, cv3;
    { const int c0 = lane, c1 = lane + 64, c2 = lane + 128, c3 = lane + 192;
      cv0 = __shfl(sl0, c0 >> 4) + __shfl(sl1, c0 & 15); cv1 = __shfl(sl0, c1 >> 4) + __shfl(sl1, c1 & 15);
      cv2 = __shfl(sl0, c2 >> 4) + __shfl(sl1, c2 & 15); cv3 = __shfl(sl0, c3 >> 4) + __shfl(sl1, c3 & 15); }
    float tv = -INFINITY; int tc = 0;
    for (int r = 0; r < 16; ++r) {
        float bv = cv0; int bc = lane;
        if (cv1 > bv) { bv = cv1; bc = lane + 64; }
        if (cv2 > bv) { bv = cv2; bc = lane + 128; }
        if (cv3 > bv) { bv = cv3; bc = lane + 192; }
#pragma unroll
        for (int o = 32; o >= 1; o >>= 1) { const float ov = __shfl_xor(bv, o); const int oc = __shfl_xor(bc, o); if (ov > bv || (ov == bv && oc < bc)) { bv = ov; bc = oc; } }
        if (lane == r) { tv = bv; tc = bc; }
        if (bc == lane) cv0 = -INFINITY; else if (bc == lane + 64) cv1 = -INFINITY; else if (bc == lane + 128) cv2 = -INFINITY; else if (bc == lane + 192) cv3 = -INFINITY;
    }
    const float mx = __shfl(tv, 0);
    const float e = lane < 16 ? expf(tv - mx) : 0.f;
    const float sum = wave_sum(e);
    const int e1 = __shfl(il0, (tc >> 4) & 15), e2 = __shfl(il1, tc & 15);
    if (lane < 16) { EID[(size_t)t * 128 + h * 16 + lane] = e1 * 128 + e2; GATE[(size_t)t * 128 + h * 16 + lane] = e / sum; }
}

__global__ void __launch_bounds__(256) k_topk_naive(const bf16_t* QP, const float* sub_keys, int* EID, float* GATE) { topk_item(QP, sub_keys, EID, GATE, blockIdx.x * 4 + (threadIdx.x >> 6), threadIdx.x & 63); }

__device__ __forceinline__ float gelu_tanh(float x) { const float u = 0.7978845608028654f * (x + 0.044715f * x * x * x); return 0.5f * x * (1.f + tanhf(u)); }

__device__ __forceinline__ void gather_item(const bf16_t* H2, const int* EID, const float* GATE, const float* peer_u, const float* peer_v, const float* mod, float* out, int t, int lane) {
    const int b = t / S_;
    float hv[16], y[16];
#pragma unroll
    for (int j = 0; j < 4; ++j) { const uint2 raw = *(const uint2*)(H2 + (size_t)t * 1024 + 4 * lane + 256 * j); hv[4 * j] = lo2f(raw.x); hv[4 * j + 1] = hi2f(raw.x); hv[4 * j + 2] = lo2f(raw.y); hv[4 * j + 3] = hi2f(raw.y); }
#pragma unroll
    for (int i = 0; i < 16; ++i) y[i] = 0.f;
    const int e_a = EID[(size_t)t * 128 + lane], e_b = EID[(size_t)t * 128 + 64 + lane];
    const float g_a = GATE[(size_t)t * 128 + lane], g_b = GATE[(size_t)t * 128 + 64 + lane];
    for (int jj = 0; jj < 128; ++jj) {
        const int e = jj < 64 ? __shfl(e_a, jj) : __shfl(e_b, jj - 64);
        const float g = jj < 64 ? __shfl(g_a, jj) : __shfl(g_b, jj - 64);
        const float4* ur = (const float4*)(peer_u + (size_t)e * 1024) + lane;
        float s = 0.f;
#pragma unroll
        for (int j = 0; j < 4; ++j) { const float4 u4 = ur[64 * j]; s += (u4.x * hv[4 * j] + u4.y * hv[4 * j + 1]) + (u4.z * hv[4 * j + 2] + u4.w * hv[4 * j + 3]); }
        s = wave_sum(s);
        const float wgt = g * gelu_tanh(s);
        const float4* vr = (const float4*)(peer_v + (size_t)e * 1024) + lane;
#pragma unroll
        for (int j = 0; j < 4; ++j) { const float4 v4 = vr[64 * j]; y[4 * j] += wgt * v4.x; y[4 * j + 1] += wgt * v4.y; y[4 * j + 2] += wgt * v4.z; y[4 * j + 3] += wgt * v4.w; }
    }
    const float* g2 = mod + b * 6144 + 5 * 1024;
#pragma unroll
    for (int j = 0; j < 4; ++j) { const int col = 4 * lane + 256 * j; float4* op = (float4*)(out + (size_t)t * 1024 + col); float4 x1 = *op; const float4 gg = *(const float4*)(g2 + col);
        x1.x += gg.x * y[4 * j]; x1.y += gg.y * y[4 * j + 1]; x1.z += gg.z * y[4 * j + 2]; x1.w += gg.w * y[4 * j + 3]; *op = x1; }
}
__global__ void __launch_bounds__(256) k_gather_naive(const bf16_t* H2, const int* EID, const float* GATE, const float* peer_u, const float* peer_v, const float* mod, float* out) {
    gather_item(H2, EID, GATE, peer_u, peer_v, mod, out, blockIdx.x * 4 + (threadIdx.x >> 6), threadIdx.x & 63);
}


namespace pg8 {
#define PG8_LAS __attribute__((address_space(3)))
typedef unsigned short bf16_t;
typedef short bf16x8 __attribute__((ext_vector_type(8)));
typedef float f32x4 __attribute__((ext_vector_type(4)));
typedef unsigned u32x4 __attribute__((ext_vector_type(4)));
constexpr int BM = 256, BK = 64, HALF = 128, HTB = HALF * BK * 2  , STAGE_BYTES = 8 * HTB, NXCD = 8, WGM = 8;

__host__ __device__ __forceinline__ int lds_byte(int r, int c) { const int st = (r >> 4) * 2 + (c >> 5), rr = r & 15, cc = c & 31, ob = rr * 64 + cc * 2; return st * 1024 + (ob ^ (((ob >> 9) & 1) << 5)); }
__host__ __device__ __forceinline__ void stage_rc(int b, int& R, int& C) { const int st = b / 1024, sb = b % 1024, swz = sb ^ (((sb >> 9) & 1) << 5); R = (st >> 1) * 16 + swz / 64; C = (st & 1) * 32 + (swz % 64) / 2; }
__host__ __device__ __forceinline__ int perm32(int rho) { const int n = rho >> 4, i = rho & 15; return 8 * (i >> 2) + 4 * n + (i & 3); }

struct Unit { int pm, pn; };
struct Gemm { const bf16_t* A; const bf16_t* Bt; int M, N, K, lda; };

struct StaticOrder {
    int nM, nN, nwg, G, c;
    __host__ __device__ void init(int M, int N, int G_, int c_) { nM = M / BM; nN = N / BM; nwg = nM * nN; G = G_; c = c_; }
    __host__ __device__ bool next(int i, Unit& u) const {
        const long L = (long)i * G + c; if (L >= nwg) return false;
        int wgid = (int)L; { const int q = nwg / NXCD, r = nwg % NXCD, xcd = wgid % NXCD, off = wgid / NXCD; wgid = (xcd < r ? xcd * (q + 1) : r * (q + 1) + (xcd - r) * q) + off; }
        const int nig = WGM * nN, gid = wgid / nig, fm = gid * WGM, gsz = (nM - fm) < WGM ? (nM - fm) : WGM;
        u.pm = fm + ((wgid % nig) % gsz); u.pn = (wgid % nig) / gsz; return true;
    }
    __device__ __forceinline__ void a_ready(const Unit&) const {}
    __device__ __forceinline__ void done(const Unit&) const {}
};
__device__ __forceinline__ unsigned cvt_pk_bf16(float lo, float hi) { unsigned r; asm volatile("v_cvt_pk_bf16_f32 %0, %1, %2" : "=v"(r) : "v"(lo), "v"(hi)); return r; }
typedef float f32x2 __attribute__((ext_vector_type(2)));
typedef int i32x4 __attribute__((ext_vector_type(4)));
template <bool I8> struct AccT { typedef f32x4 type; };
template <> struct AccT<true> { typedef i32x4 type; };
__device__ __forceinline__ f32x4 mma16(const bf16x8 b, const bf16x8 a, const f32x4 c) { return __builtin_amdgcn_mfma_f32_16x16x32_bf16(b, a, c, 0, 0, 0); }
__device__ __forceinline__ i32x4 mma16(const bf16x8 b, const bf16x8 a, const i32x4 c) { return __builtin_amdgcn_mfma_i32_16x16x64_i8(__builtin_bit_cast(i32x4, b), __builtin_bit_cast(i32x4, a), c, 0, 0, 0); }
template <class Epi, class Sched, bool ALIGN_EPI = false, bool SP2 = false, bool I8 = false>
__device__ __forceinline__ void gemm_phase(PG8_LAS unsigned char* lds, const Gemm g, const Sched& S, const Epi& E) {
    const int tid = threadIdx.x, wid = __builtin_amdgcn_readfirstlane(tid >> 6), lane = tid & 63, wr = wid >> 2, wc = wid & 3, fr = lane & 15, fq = lane >> 4;
    const int K = g.K, nt = K / BK;
    unsigned voffA[2], voffB[2];
#pragma unroll
    for (int i = 0; i < 2; ++i) { int R, C; stage_rc(tid * 16 + i * 8192, R, C); const int Rb = Epi::PERM ? ((R & ~31) + perm32(R & 31)) : R;
        voffA[i] = (unsigned)(R * g.lda + C) * 2u; voffB[i] = (unsigned)(Rb * K + C) * 2u; }
    const size_t kstep = (size_t)(BK * 2);
    const size_t hstepA = (size_t)HALF * g.lda * 2, hstepB = (size_t)HALF * K * 2;
    const size_t tstepA = 2 * hstepA, tstepB = 2 * hstepB;
    const unsigned ldsw = (unsigned)wid * 1024u;
    const int aoff = lds_byte(wr * 64 + fr, fq * 8), boff = lds_byte(wc * 32 + fr, fq * 8);
#define PG8_SA(b, h) (((b) * 2 + (h)) * HTB)
#define PG8_SB(b, h) ((4 + (b) * 2 + (h)) * HTB)
#define PG8_STAGE(bufoff, gbase, voff) do { _Pragma("unroll") for (int _i = 0; _i < 2; ++_i) \
        __builtin_amdgcn_global_load_lds((const unsigned*)((const char*)(gbase) + (voff)[_i]), (PG8_LAS unsigned*)(lds + (bufoff) + ldsw + _i * 8192), 16, 0, 0); } while (0)
#define PG8_LDA(dst, b, h) do { _Pragma("unroll") for (int m = 0; m < 4; ++m) _Pragma("unroll") for (int k = 0; k < 2; ++k) dst[m][k] = *(const PG8_LAS bf16x8*)(lds + PG8_SA(b, h) + aoff + m * 2048 + k * 1024); } while (0)
#define PG8_LDB(dst, b, h) do { _Pragma("unroll") for (int n = 0; n < 2; ++n) _Pragma("unroll") for (int k = 0; k < 2; ++k) dst[n][k] = *(const PG8_LAS bf16x8*)(lds + PG8_SB(b, h) + boff + n * 2048 + k * 1024); } while (0)
#define PG8_MMA(ai, bj, At, Bt) do { __builtin_amdgcn_s_setprio(1); _Pragma("unroll") for (int m = 0; m < 4; ++m) _Pragma("unroll") for (int n = 0; n < 2; ++n) _Pragma("unroll") for (int k = 0; k < 2; ++k) \
        acc[ai][bj][m][n] = mma16(Bt[n][k], At[m][k], acc[ai][bj][m][n]); __builtin_amdgcn_s_setprio(0); } while (0)
#define PG8_WAIT_V(n) asm volatile("s_waitcnt vmcnt(" #n ")" ::: "memory")
#define PG8_WAIT_L(n) asm volatile("s_waitcnt lgkmcnt(" #n ")" ::: "memory")
#define PG8_BAR __builtin_amdgcn_s_barrier()
#define PG8_SCHED __builtin_amdgcn_sched_barrier(0)
    Unit cur, nxt; int ui = 0;
    if (!S.next(0, cur)) return;
    typedef typename AccT<I8>::type accv; accv acc[2][2][4][2];
#pragma unroll
    for (int a = 0; a < 2; ++a)
#pragma unroll
        for (int b = 0; b < 2; ++b)
#pragma unroll
            for (int m = 0; m < 4; ++m)
#pragma unroll
                for (int n = 0; n < 2; ++n) acc[a][b][m][n] = accv{};
    bf16x8 At[4][2], B0[2][2], B1[2][2];
    const char* cA = (const char*)g.A + (size_t)cur.pm * tstepA; const char* cB = (const char*)g.Bt + (size_t)cur.pn * tstepB;
    S.a_ready(cur);
    if constexpr (SP2) {
        PG8_STAGE(PG8_SB(0, 0), cB, voffB); PG8_STAGE(PG8_SB(0, 1), cB + hstepB, voffB); PG8_STAGE(PG8_SA(0, 0), cA, voffA); PG8_STAGE(PG8_SA(0, 1), cA + hstepA, voffA);
        if (wr == 1) PG8_BAR;
        PG8_WAIT_V(2); PG8_BAR;
        PG8_STAGE(PG8_SB(1, 0), cB + kstep, voffB); PG8_STAGE(PG8_SA(1, 0), cA + kstep, voffA); PG8_STAGE(PG8_SB(1, 1), cB + hstepB + kstep, voffB);
        PG8_WAIT_V(6); PG8_BAR;
    } else {
        PG8_STAGE(PG8_SB(0, 0), cB, voffB); PG8_STAGE(PG8_SA(0, 0), cA, voffA); PG8_STAGE(PG8_SB(0, 1), cB + hstepB, voffB); PG8_STAGE(PG8_SA(0, 1), cA + hstepA, voffA);
        if (wr == 1) PG8_BAR;
        PG8_WAIT_V(4); PG8_BAR;
        PG8_STAGE(PG8_SB(1, 0), cB + kstep, voffB); PG8_STAGE(PG8_SA(1, 0), cA + kstep, voffA); PG8_STAGE(PG8_SB(1, 1), cB + hstepB + kstep, voffB);
        PG8_WAIT_V(6); PG8_BAR;
    }
    for (;;) {
        const bool has_next = S.next(ui + 1, nxt);
        const char* nA = has_next ? (const char*)g.A + (size_t)nxt.pm * tstepA : cA; const char* nB = has_next ? (const char*)g.Bt + (size_t)nxt.pn * tstepB : cB;
        for (int t = 0; t < nt; t += 2) {
            const bool last = (t == nt - 2);
            const char* a1 = cA + (size_t)(t + 1) * kstep;
            const char* a2 = last ? nA : cA + (size_t)(t + 2) * kstep; const char* b2 = last ? nB : cB + (size_t)(t + 2) * kstep;
            const char* a3 = a2 + kstep; const char* b3 = b2 + kstep;
            if (last && has_next) S.a_ready(nxt);
            if constexpr (SP2) {
            PG8_LDB(B0, 0, 0); PG8_LDB(B1, 0, 1); PG8_SCHED; PG8_LDA(At, 0, 0); PG8_STAGE(PG8_SA(1, 1), a1 + hstepA, voffA);
            PG8_WAIT_V(8); PG8_WAIT_L(0); PG8_BAR; PG8_MMA(0, 0, At, B0); PG8_MMA(0, 1, At, B1); PG8_BAR; PG8_SCHED;
            PG8_LDA(At, 0, 1); PG8_STAGE(PG8_SB(0, 0), b2, voffB); PG8_STAGE(PG8_SB(0, 1), b2 + hstepB, voffB); PG8_STAGE(PG8_SA(0, 0), a2, voffA);
            PG8_WAIT_V(8); PG8_WAIT_L(0); PG8_BAR; PG8_MMA(1, 0, At, B0); PG8_MMA(1, 1, At, B1); PG8_BAR; PG8_SCHED;
            PG8_LDB(B0, 1, 0); PG8_LDB(B1, 1, 1); PG8_SCHED; PG8_LDA(At, 1, 0); PG8_STAGE(PG8_SA(0, 1), a2 + hstepA, voffA);
            PG8_WAIT_V(8); PG8_WAIT_L(0); PG8_BAR; PG8_MMA(0, 0, At, B0); PG8_MMA(0, 1, At, B1); PG8_BAR; PG8_SCHED;
            PG8_LDA(At, 1, 1); PG8_STAGE(PG8_SB(1, 0), b3, voffB); PG8_STAGE(PG8_SB(1, 1), b3 + hstepB, voffB); PG8_STAGE(PG8_SA(1, 0), a3, voffA);
            PG8_WAIT_V(8); PG8_WAIT_L(0); PG8_BAR; PG8_MMA(1, 0, At, B0); PG8_MMA(1, 1, At, B1); PG8_BAR; PG8_SCHED;
            } else {
            PG8_LDB(B0, 0, 0); PG8_SCHED; PG8_LDA(At, 0, 0); PG8_STAGE(PG8_SA(1, 1), a1 + hstepA, voffA);
            PG8_WAIT_L(8); PG8_BAR; PG8_WAIT_L(0); PG8_MMA(0, 0, At, B0); PG8_BAR; PG8_SCHED;
            PG8_LDB(B1, 0, 1); PG8_STAGE(PG8_SB(0, 0), b2, voffB);
            PG8_BAR; PG8_WAIT_L(0); PG8_MMA(0, 1, At, B1); PG8_BAR;
            PG8_LDA(At, 0, 1); PG8_STAGE(PG8_SA(0, 0), a2, voffA);
            PG8_BAR; PG8_WAIT_L(0); PG8_MMA(1, 0, At, B0); PG8_BAR; PG8_SCHED;
            PG8_STAGE(PG8_SB(0, 1), b2 + hstepB, voffB);
            PG8_WAIT_V(6); PG8_BAR; PG8_MMA(1, 1, At, B1); PG8_BAR;
            PG8_LDB(B0, 1, 0); PG8_SCHED; PG8_LDA(At, 1, 0); PG8_STAGE(PG8_SA(0, 1), a2 + hstepA, voffA);
            PG8_WAIT_L(8); PG8_BAR; PG8_WAIT_L(0); PG8_MMA(0, 0, At, B0); PG8_BAR; PG8_SCHED;
            PG8_LDB(B1, 1, 1); PG8_STAGE(PG8_SB(1, 0), b3, voffB);
            PG8_BAR; PG8_WAIT_L(0); PG8_MMA(0, 1, At, B1); PG8_BAR;
            PG8_LDA(At, 1, 1); PG8_STAGE(PG8_SA(1, 0), a3, voffA);
            PG8_BAR; PG8_WAIT_L(0); PG8_MMA(1, 0, At, B0); PG8_BAR; PG8_SCHED;
            PG8_STAGE(PG8_SB(1, 1), b3 + hstepB, voffB);
            PG8_WAIT_V(6); PG8_BAR; PG8_MMA(1, 1, At, B1); PG8_BAR;
            }
        }
        if constexpr (ALIGN_EPI) { if (wr == 0) PG8_BAR; }
        if constexpr (!Epi::AFTER_DRAIN) { E(acc, cur, wr, wc, fr, fq); S.done(cur); }
        if (!has_next) break;
#pragma unroll
        for (int a = 0; a < 2; ++a)
#pragma unroll
            for (int b = 0; b < 2; ++b)
#pragma unroll
                for (int m = 0; m < 4; ++m)
#pragma unroll
                    for (int n = 0; n < 2; ++n) acc[a][b][m][n] = accv{};
        cur = nxt; cA = nA; cB = nB; ++ui;
        if constexpr (ALIGN_EPI) { if (wr == 1) PG8_BAR; }
    }
    PG8_WAIT_V(0);
    if constexpr (!ALIGN_EPI) { if (wr == 0) PG8_BAR; }
    PG8_BAR;
    if constexpr (Epi::AFTER_DRAIN) { E.fused(acc, cur, wr, wc, fr, fq, lds, wid, lane); S.done(cur); }
#undef PG8_SA
#undef PG8_SB
#undef PG8_STAGE
#undef PG8_LDA
#undef PG8_LDB
#undef PG8_MMA
#undef PG8_WAIT_V
#undef PG8_WAIT_L
#undef PG8_BAR
#undef PG8_SCHED
}
}


#define GAS __attribute__((address_space(1)))
#define LAS __attribute__((address_space(3)))
typedef float f32x4 __attribute__((ext_vector_type(4)));
typedef unsigned u32x4 __attribute__((ext_vector_type(4)));
#define XB_TMO      128
#define XB_XCNT(j)  (256  + 64 * (j))
#define XB_XSUB(j)  (1280 + 64 * (j))
#define XB_XGEN(j)  (2304 + 64 * (j))
#define XB_TOP      3328
#define XB_TOPGEN   3392
#define XCD_BAR_WORDS 3456
#define XB_SPIN_CAP (1u << 18)

__device__ __forceinline__ unsigned xb_ld(unsigned* p)              { return __hip_atomic_load(p, __ATOMIC_RELAXED, __HIP_MEMORY_SCOPE_AGENT); }
__device__ __forceinline__ unsigned xb_add(unsigned* p, unsigned v) { return __hip_atomic_fetch_add(p, v, __ATOMIC_RELAXED, __HIP_MEMORY_SCOPE_AGENT); }
__device__ __forceinline__ unsigned xb_xcc_id() { return (unsigned)__builtin_amdgcn_s_getreg((3 << 11) | 20) & 0xFu; }
#define XB_SPIN(cond, bar) do { unsigned _sp = 0; while (cond) { __builtin_amdgcn_s_sleep(1); \
    if ((++_sp & 255u) == 0u) { if (xb_ld(&(bar)[XB_TMO])) break; if (_sp > XB_SPIN_CAP) { atomicAdd(&(bar)[XB_TMO], 1u); break; } } } } while (0)

struct XcdBarrier {
    unsigned* bar; unsigned x;
    volatile LAS unsigned* st;
};

__device__ __forceinline__ XcdBarrier xcd_barrier_post(unsigned* bar, volatile LAS unsigned* st) {
    XcdBarrier b; b.bar = bar; b.x = xb_xcc_id(); b.st = st;
    if (threadIdx.x == 0) (void)xb_add(&bar[XB_XCNT(b.x)], 1u);
    return b;
}
__device__ __forceinline__ void xcd_barrier_complete(unsigned* bar, unsigned x, unsigned& nloc, unsigned& nx) {
    const unsigned G = gridDim.x * gridDim.y * gridDim.z;
    unsigned sum, cnt, mine, sp = 0u;
    for (;;) {
        sum = 0u; cnt = 0u; mine = 0u;
#pragma unroll
        for (unsigned j = 0; j < 16; ++j) { const unsigned c = xb_ld(&bar[XB_XCNT(j)]); sum += c; cnt += (c > 0u) ? 1u : 0u; mine = (j == x) ? c : mine; }
        if (sum == G) break;
        __builtin_amdgcn_s_sleep(1);
        if ((++sp & 255u) == 0u) { if (xb_ld(&bar[XB_TMO])) break; if (sp > XB_SPIN_CAP) { atomicAdd(&bar[XB_TMO], 1u); break; } }
    }
    nloc = mine > 0u ? mine : 1u; nx = cnt > 0u ? cnt : 1u;
}

__device__ __forceinline__ void xcd_barrier(const XcdBarrier& b) {
    asm volatile("s_waitcnt vmcnt(0)" ::: "memory");
    __syncthreads();
    if (threadIdx.x == 0) {
        unsigned* bar = b.bar;
        __builtin_amdgcn_s_waitcnt(0);
        unsigned nloc = b.st[0], nx = b.st[1];
        if (nloc == 0u) { xcd_barrier_complete(bar, b.x, nloc, nx); b.st[0] = nloc; b.st[1] = nx; }
        const unsigned old = xb_add(&bar[XB_XSUB(b.x)], 1u);
        const unsigned gen = old / nloc;
        if (old + 1u == (gen + 1u) * nloc) {
            __builtin_amdgcn_fence(__ATOMIC_RELEASE, "agent");
            asm volatile("s_waitcnt vmcnt(0)" ::: "memory");
            const unsigned og = xb_add(&bar[XB_TOP], 1u);
            const unsigned tg = og / nx;
            if (og + 1u == (tg + 1u) * nx) xb_add(&bar[XB_TOPGEN], 1u);
            else XB_SPIN(xb_ld(&bar[XB_TOPGEN]) == tg, bar);
            __builtin_amdgcn_fence(__ATOMIC_ACQUIRE, "agent");
            xb_add(&bar[XB_XGEN(b.x)], 1u);
            asm volatile("s_waitcnt vmcnt(0)" ::: "memory");
        } else {
            XB_SPIN(xb_ld(&bar[XB_XGEN(b.x)]) == gen, bar);
            __builtin_amdgcn_fence(__ATOMIC_ACQUIRE, "agent");
            asm volatile("s_waitcnt vmcnt(0)" ::: "memory");
        }
    }
    __syncthreads();
}


constexpr int NWAVES = 8;
constexpr int RING_BYTES = 131072, LDSCTL_OFF = RING_BYTES, MISC_OFF = LDSCTL_OFF + 320, LDS_BYTES = 147456;
constexpr size_t WS_CTL = 0, CTL_ZERO_BYTES = 1 * MiB;
constexpr int CW_BAR = 4096, N_BAR_REGIONS = 16;
static_assert((CW_BAR + N_BAR_REGIONS * XCD_BAR_WORDS) * 4 <= (int)CTL_ZERO_BYTES, "barrier words inside the memset region");
constexpr size_t WS_WIN = 10 * MiB;
constexpr size_t WS_WUQ = 15 * MiB;
constexpr size_t WS_WUKV = 16 * MiB;
constexpr size_t WS_WO = 17 * MiB;
constexpr size_t WS_WPQ = 19 * MiB;
constexpr size_t WS_SK = 23 * MiB;
constexpr size_t WS_U16 = 24 * MiB;
constexpr size_t WS_V16 = 56 * MiB;


namespace att {
typedef short bf16x8 __attribute__((ext_vector_type(8)));
typedef short s16x4 __attribute__((ext_vector_type(4)));
typedef float f32x16 __attribute__((ext_vector_type(16)));
constexpr int LK = 0, KSLOT = 12288, LV = 2 * KSLOT, VSLOT = 8192, LB = LV + 2 * VSLOT, BSLOT = 256, LWS = LB + 2 * BSLOT, LOST = LWS + 8 * 256, ATT_LDS = LOST + 8 * 4096;
static_assert(ATT_LDS <= 131072, "attention scratch fits the ring region");
struct Desc { const bf16_t* Q; int pq; const bf16_t* K; int pk; const bf16_t* V; int pv; bf16_t* O; int po; const float* FC; };

__device__ __forceinline__ int crow(int r, int hi) { return (r & 3) + 8 * (r >> 2) + 4 * hi; }
__device__ __forceinline__ float xmax32(float v) { auto rr = __builtin_amdgcn_permlane32_swap(__float_as_uint(v), __float_as_uint(v), false, false); return fmaxf(__uint_as_float(rr[0]), __uint_as_float(rr[1])); }
__device__ __forceinline__ float xsum32(float v) { auto rr = __builtin_amdgcn_permlane32_swap(__float_as_uint(v), __float_as_uint(v), false, false); return __uint_as_float(rr[0]) + __uint_as_float(rr[1]); }
__device__ __forceinline__ unsigned cvtpk(float lo, float hi) { typedef float f2 __attribute__((ext_vector_type(2))); typedef __bf16 b2 __attribute__((ext_vector_type(2))); f2 v = {lo, hi}; b2 b = __builtin_convertvector(v, b2); return __builtin_bit_cast(unsigned, b); }
typedef short v4i16_t __attribute__((ext_vector_type(4)));
__device__ __forceinline__ s16x4 vtr(LAS const unsigned char* p) { return __builtin_bit_cast(s16x4, __builtin_amdgcn_ds_read_tr16_b64_v4i16((LAS v4i16_t*)p)); }

template <int KS, bool BIAS>
__device__ __forceinline__ void attn_unit(const Desc& d, int qb, int j0, LAS unsigned char* shm) {
    const int tid = threadIdx.x, lane = tid & 63, r32 = lane & 31, hi = lane >> 5; const int wid = __builtin_amdgcn_readfirstlane(tid >> 6);
    const int q0 = qb * 256, NT = (q0 + 256) / 64;
    LAS float* wsf = (LAS float*)(shm + LWS) + wid * 64;
    bf16x8 qr[KS];
    { const bf16_t* qp = d.Q + (size_t)(q0 + wid * 32 + r32) * d.pq + hi * 8;
#pragma unroll
      for (int d0 = 0; d0 < KS; ++d0) qr[d0] = *(const bf16x8*)(qp + d0 * 16); }
    const float fcref = BIAS ? d.FC[q0] : 0.f;
    const bf16_t* ksrc0 = d.K + (size_t)lane * d.pk + wid * 8;
    const bf16_t* ksrc1 = d.K + (size_t)lane * d.pk + (8 + wid) * 8;
    const bf16_t* vsrc = d.V + (size_t)(16 * (wid & 3) + (lane >> 2)) * d.pv + (wid >> 2) * 32 + (lane & 3) * 8;
    const int kdst0 = LK + wid * 1024 + lane * 16, kdst1 = LK + (8 + wid) * 1024 + lane * 16, vdst = LV + wid * 1024 + lane * 16;
    const bool k2 = (KS > 4) && (wid < 2 * KS - 8);
    u32x4 kr0, kr1, vr; float br = 0.f;
#define ATT_LOAD(t) do { kr0 = *(const u32x4*)(ksrc0 + (size_t)(t) * 64 * d.pk); if (k2) kr1 = *(const u32x4*)(ksrc1 + (size_t)(t) * 64 * d.pk); \
        vr = *(const u32x4*)(vsrc + (size_t)(t) * 64 * d.pv); if (BIAS && wid == 4) br = d.FC[(t) * 64 + lane]; } while (0)
#define ATT_WRITE(slot) do { *(LAS u32x4*)(shm + kdst0 + (slot) * KSLOT) = kr0; if (k2) *(LAS u32x4*)(shm + kdst1 + (slot) * KSLOT) = kr1; \
        *(LAS u32x4*)(shm + vdst + (slot) * VSLOT) = vr; if (BIAS && wid == 4) *(LAS float*)(shm + LB + (slot) * BSLOT + lane * 4) = (fcref - br) * LOG2E; } while (0)
    f32x16 o0, o1, negm;
#pragma unroll
    for (int r = 0; r < 16; ++r) { o0[r] = 0.f; o1[r] = 0.f; negm[r] = 0.f; }
    float mref = 0.f, l = 0.f;
    constexpr float THR = BIAS ? 40.f : 8.f;
    const int qrel = wid * 32 + r32;
    const int kfrag = LK + hi * 1024 + r32 * 16;
    const int vfrag = LV + ((lane >> 4) & 1) * 32 + (lane & 3) * 8 + (4 * hi + ((lane & 15) >> 2)) * 64;
    ATT_LOAD(j0); ATT_WRITE(0);
    __syncthreads();
    for (int t = j0; t < NT; ++t) {
        const int slot = (t - j0) & 1;
        if (t + 1 < NT) ATT_LOAD(t + 1);
        const int jb = t - (NT - 4);
        if (!(jb >= 0 && 64 * jb > 32 * wid + 31)) {
            f32x16 p0, p1;
            if (BIAS) {
                LAS const unsigned char* bp = shm + LB + slot * BSLOT + 16 * hi;
#pragma unroll
                for (int g = 0; g < 4; ++g) { const f32x4 a = *(LAS const f32x4*)(bp + 32 * g), b = *(LAS const f32x4*)(bp + 128 + 32 * g);
#pragma unroll
                    for (int i = 0; i < 4; ++i) { p0[4 * g + i] = a[i] + negm[4 * g + i]; p1[4 * g + i] = b[i] + negm[4 * g + i]; } }
            } else { p0 = negm; p1 = negm; }
            LAS const unsigned char* kp = shm + kfrag + slot * KSLOT;
            __builtin_amdgcn_s_setprio(1);
#pragma unroll
            for (int d0 = 0; d0 < KS; ++d0) {
                const bf16x8 a0 = *(LAS const bf16x8*)(kp + d0 * 2048), a1 = *(LAS const bf16x8*)(kp + d0 * 2048 + 512);
                p0 = __builtin_amdgcn_mfma_f32_32x32x16_bf16(a0, qr[d0], p0, 0, 0, 0);
                p1 = __builtin_amdgcn_mfma_f32_32x32x16_bf16(a1, qr[d0], p1, 0, 0, 0);
            }
            __builtin_amdgcn_s_setprio(0);
            if (jb >= 0) {
                const int kb = 64 * jb + 4 * hi;
#pragma unroll
                for (int r = 0; r < 16; ++r) { const int kv = kb + (r & 3) + 8 * (r >> 2); if (kv > qrel) p0[r] = -INFINITY; if (kv + 32 > qrel) p1[r] = -INFINITY; }
            }
            float ra = __builtin_fmaxf(__builtin_fmaxf(p0[0], p0[1]), p1[0]), rb = __builtin_fmaxf(__builtin_fmaxf(p0[2], p0[3]), p1[1]);
            ra = __builtin_fmaxf(__builtin_fmaxf(ra, p1[2]), p1[3]);
#pragma unroll
            for (int r = 4; r < 16; r += 4) { ra = __builtin_fmaxf(__builtin_fmaxf(ra, p0[r]), p0[r + 1]); rb = __builtin_fmaxf(__builtin_fmaxf(rb, p0[r + 2]), p0[r + 3]);
                ra = __builtin_fmaxf(__builtin_fmaxf(ra, p1[r]), p1[r + 1]); rb = __builtin_fmaxf(__builtin_fmaxf(rb, p1[r + 2]), p1[r + 3]); }
            const float rm = xmax32(__builtin_fmaxf(ra, rb));
            if (__any(rm > THR) || t == j0) {
                const float dl = t == j0 ? rm : __builtin_fmaxf(rm, 0.f);
                mref += dl;
#pragma unroll
                for (int r = 0; r < 16; ++r) { p0[r] -= dl; p1[r] -= dl; negm[r] = -mref; }
                if (t != j0) {
                    const float alpha = __builtin_amdgcn_exp2f(-dl);
                    l *= alpha;
                    if (hi == 0) wsf[r32] = alpha;
#pragma unroll
                    for (int g = 0; g < 4; ++g) { const f32x4 a = *(LAS const f32x4*)(wsf + 8 * g + 4 * hi);
#pragma unroll
                        for (int i = 0; i < 4; ++i) { o0[4 * g + i] *= a[i]; o1[4 * g + i] *= a[i]; } }
                }
            }
            float s0 = 0.f, s1 = 0.f, s2 = 0.f, s3 = 0.f;
#pragma unroll
            for (int r = 0; r < 16; r += 2) { p0[r] = __builtin_amdgcn_exp2f(p0[r]); p0[r + 1] = __builtin_amdgcn_exp2f(p0[r + 1]); p1[r] = __builtin_amdgcn_exp2f(p1[r]); p1[r + 1] = __builtin_amdgcn_exp2f(p1[r + 1]);
                s0 += p0[r]; s1 += p0[r + 1]; s2 += p1[r]; s3 += p1[r + 1]; }
            l += (s0 + s1) + (s2 + s3);
            LAS const unsigned char* vp = shm + vfrag + slot * VSLOT;
            __builtin_amdgcn_s_setprio(1);
#pragma unroll
            for (int ks = 0; ks < 4; ++ks) {
                const f32x16& pp = ks < 2 ? p0 : p1; const int bq = (ks & 1) * 8;
                u32x4 pw; pw.x = cvtpk(pp[bq], pp[bq + 1]); pw.y = cvtpk(pp[bq + 2], pp[bq + 3]); pw.z = cvtpk(pp[bq + 4], pp[bq + 5]); pw.w = cvtpk(pp[bq + 6], pp[bq + 7]);
                const bf16x8 pa = __builtin_bit_cast(bf16x8, pw);
                const s16x4 l0 = vtr(vp + ks * 1024), h0 = vtr(vp + ks * 1024 + 512), l1 = vtr(vp + 4096 + ks * 1024), h1 = vtr(vp + 4096 + ks * 1024 + 512);
                const bf16x8 v0 = {l0[0], l0[1], l0[2], l0[3], h0[0], h0[1], h0[2], h0[3]}, v1 = {l1[0], l1[1], l1[2], l1[3], h1[0], h1[1], h1[2], h1[3]};
                o0 = __builtin_amdgcn_mfma_f32_32x32x16_bf16(pa, v0, o0, 0, 0, 0);
                o1 = __builtin_amdgcn_mfma_f32_32x32x16_bf16(pa, v1, o1, 0, 0, 0);
            }
            __builtin_amdgcn_s_setprio(0);
        }
        if (t + 1 < NT) ATT_WRITE(slot ^ 1);
        __syncthreads();
    }
#undef ATT_LOAD
#undef ATT_WRITE
    l = xsum32(l);
    if (hi == 0) wsf[32 + r32] = l;
    float rli[16];
#pragma unroll
    for (int g = 0; g < 4; ++g) { const f32x4 a = *(LAS const f32x4*)(wsf + 32 + 8 * g + 4 * hi);
#pragma unroll
        for (int i = 0; i < 4; ++i) rli[4 * g + i] = 1.f / a[i]; }
    LAS bf16_t* stg = (LAS bf16_t*)(shm + LOST) + wid * 2048;
#pragma unroll
    for (int r = 0; r < 16; ++r) { const int orow = crow(r, hi); stg[orow * 64 + r32] = f2bf(o0[r] * rli[r]); stg[orow * 64 + 32 + r32] = f2bf(o1[r] * rli[r]); }
    bf16_t* Ow = d.O + (size_t)(q0 + wid * 32) * d.po;
#pragma unroll
    for (int i = 0; i < 4; ++i) { const int row = i * 8 + (lane >> 3), ch = lane & 7; const u32x4 v = *(LAS const u32x4*)(stg + row * 64 + ch * 8); *(u32x4*)(Ow + (size_t)row * d.po + ch * 8) = v; }
    __syncthreads();
}
}


namespace pk {
typedef short bf16x8 __attribute__((ext_vector_type(8)));
typedef float f32x16 __attribute__((ext_vector_type(16)));
__device__ __forceinline__ unsigned f2sort(float f) { const unsigned b = __float_as_uint(f); return b ^ ((unsigned)((int)b >> 31) | 0x80000000u); }
__device__ __forceinline__ float sort2f(unsigned u) { return __uint_as_float((u & 0x80000000u) ? (u ^ 0x80000000u) : ~u); }
__device__ __forceinline__ void ce(unsigned& a, unsigned& b) { const unsigned mx = a > b ? a : b, mn = a > b ? b : a; a = mx; b = mn; }
__device__ __forceinline__ void sort16(unsigned (&v)[16]) {
#pragma unroll
    for (int k = 2; k <= 16; k <<= 1)
#pragma unroll
        for (int j = k >> 1; j >= 1; j >>= 1)
#pragma unroll
            for (int i = 0; i < 16; ++i) { const int l = i ^ j; if (l > i) { if ((i & k) == 0) ce(v[i], v[l]); else ce(v[l], v[i]); } }
}
__device__ __forceinline__ void merge16(unsigned (&a)[16], const unsigned (&b)[16]) {
#pragma unroll
    for (int i = 0; i < 16; ++i) a[i] = a[i] > b[15 - i] ? a[i] : b[15 - i];
#pragma unroll
    for (int j = 8; j >= 1; j >>= 1)
#pragma unroll
        for (int i = 0; i < 16; ++i) { const int l = i ^ j; if (l > i) ce(a[i], a[l]); }
}
__device__ __forceinline__ void top16of64(unsigned (&k)[64], unsigned (&out)[16]) {
    unsigned g1[16], g2[16], g3[16];
#pragma unroll
    for (int i = 0; i < 16; ++i) { out[i] = k[i]; g1[i] = k[16 + i]; g2[i] = k[32 + i]; g3[i] = k[48 + i]; }
    sort16(out); sort16(g1); sort16(g2); sort16(g3);
    merge16(out, g1); merge16(g2, g3); merge16(out, g2);
}
__device__ __forceinline__ unsigned sel4(const unsigned (&w)[4], int q) { const unsigned a = q & 1 ? w[1] : w[0], b = q & 1 ? w[3] : w[2]; return q & 2 ? b : a; }

template <int I> struct COff { static constexpr int v = COff<I - 1>::v + 16 / I; };
template <> struct COff<0> { static constexpr int v = 0; };
static_assert(COff<16>::v == 50, "50 candidates can reach the top 16 of a sorted 16 x 16 sum grid");
template <int I> __device__ __forceinline__ void fill_cand(unsigned (&c64)[64], const float (&s1)[16], const float (&s2)[16]) {
    if constexpr (I < 16) {
#pragma unroll
        for (int j = 0; j < 16 / (I + 1); ++j) c64[COff<I>::v + j] = (f2sort(s1[I] + s2[j]) & 0xFFFFFF00u) | (unsigned)(255 - (I * 16 + j));
        fill_cand<I + 1>(c64, s1, s2);
    }
}
__device__ __forceinline__ void topk_item(const bf16_t* QP, const bf16_t* SK, int* EID, float* GATE, int item, int lane) {
    const int tg = item >> 3, h = item & 7, r32 = lane & 31, hi = lane >> 5;
    const int t = tg * 32 + r32;
    unsigned own[2][16];
#pragma unroll
    for (int p = 0; p < 2; ++p) {
        const bf16_t* qrow = QP + (size_t)t * 2048 + h * 256 + p * 128 + hi * 8;
        bf16x8 qf[8];
#pragma unroll
        for (int d0 = 0; d0 < 8; ++d0) qf[d0] = *(const bf16x8*)(qrow + d0 * 16);
        const bf16_t* skb = SK + (size_t)((h * 2 + p) * 128 + r32) * 128 + hi * 8;
#pragma unroll 1
        for (int kt = 0; kt < 4; ++kt) {
            f32x16 acc;
#pragma unroll
            for (int r = 0; r < 16; ++r) acc[r] = 0.f;
#pragma unroll
            for (int d0 = 0; d0 < 8; ++d0) { const bf16x8 a = *(const bf16x8*)(skb + (size_t)kt * 32 * 128 + d0 * 16); acc = __builtin_amdgcn_mfma_f32_32x32x16_bf16(a, qf[d0], acc, 0, 0, 0); }
            unsigned cur[16];
#pragma unroll
            for (int r = 0; r < 16; ++r) { const int idx0 = kt * 32 + (r & 3) + 8 * (r >> 2);
                cur[r] = (f2sort(acc[r]) & 0xFFFFFF80u) | (unsigned)(127 - idx0 - 4 * hi); }
            sort16(cur);
            if (kt == 0) {
#pragma unroll
                for (int r = 0; r < 16; ++r) own[p][r] = cur[r];
            } else merge16(own[p], cur);
        }
    }
    unsigned fin[16];
    {
        unsigned oth[16];
#pragma unroll
        for (int i = 0; i < 16; ++i) { auto rr = __builtin_amdgcn_permlane32_swap(own[0][i], own[1][i], false, false); fin[i] = rr[0]; oth[i] = rr[1]; }
        merge16(fin, oth);
    }
    unsigned s1k[16], s2k[16];
#pragma unroll
    for (int i = 0; i < 16; ++i) { auto rr = __builtin_amdgcn_permlane32_swap(fin[i], fin[i], false, false); s1k[i] = rr[0]; s2k[i] = rr[1]; }
    float s1[16], s2[16]; unsigned long long i1lo = 0ull, i1hi = 0ull, i2lo = 0ull, i2hi = 0ull;
#pragma unroll
    for (int i = 0; i < 16; ++i) { s1[i] = sort2f(s1k[i] & 0xFFFFFF80u); s2[i] = sort2f(s2k[i] & 0xFFFFFF80u);
        const unsigned long long a = (unsigned long long)(127u - (s1k[i] & 0x7Fu)) << (8 * (i & 7)), b = (unsigned long long)(127u - (s2k[i] & 0x7Fu)) << (8 * (i & 7));
        if (i < 8) { i1lo |= a; i2lo |= b; } else { i1hi |= a; i2hi |= b; } }
    unsigned c64[64];
#pragma unroll
    for (int i = 50; i < 64; ++i) c64[i] = 0u;
    fill_cand<0>(c64, s1, s2);
    unsigned top[16];
    top16of64(c64, top);
    float ev[16]; float sum = 0.f; const float mx = sort2f(top[0] & 0xFFFFFF00u);
#pragma unroll
    for (int r = 0; r < 16; ++r) { ev[r] = __expf(sort2f(top[r] & 0xFFFFFF00u) - mx); sum += ev[r]; }
    const float rs = 1.f / sum;
    if (hi == 0) {
        int* ep = EID + (size_t)t * 128 + h * 16;
#pragma unroll
        for (int q4 = 0; q4 < 4; ++q4) { int ee[4];
#pragma unroll
            for (int z = 0; z < 4; ++z) { const int code = 255 - (int)(top[q4 * 4 + z] & 0xFFu), i = code >> 4, j = code & 15;
                const unsigned e1 = (unsigned)(((i & 8) ? i1hi : i1lo) >> (8 * (i & 7))) & 0xFFu, e2 = (unsigned)(((j & 8) ? i2hi : i2lo) >> (8 * (j & 7))) & 0xFFu; ee[z] = (int)(e1 * 128u + e2); }
            *(int4*)(ep + q4 * 4) = make_int4(ee[0], ee[1], ee[2], ee[3]); }
    } else {
        float* gp = GATE + (size_t)t * 128 + h * 16;
#pragma unroll
        for (int q4 = 0; q4 < 4; ++q4) *(float4*)(gp + q4 * 4) = make_float4(ev[q4 * 4] * rs, ev[q4 * 4 + 1] * rs, ev[q4 * 4 + 2] * rs, ev[q4 * 4 + 3] * rs);
    }
}
}


namespace gx {
typedef unsigned char u8x4 __attribute__((ext_vector_type(4)));
__device__ __forceinline__ int sdot16(const int4 a, const int4 b) {
    int s = __builtin_amdgcn_sdot4(a.x, b.x, 0, false); s = __builtin_amdgcn_sdot4(a.y, b.y, s, false); s = __builtin_amdgcn_sdot4(a.z, b.z, s, false); return __builtin_amdgcn_sdot4(a.w, b.w, s, false);
}
__device__ __forceinline__ void quant_row(const float* src, unsigned char* dst, float* scale_out, int lane) {
    const float4* sr = (const float4*)src + lane; float4 v[4]; float am = 0.f;
#pragma unroll
    for (int j = 0; j < 4; ++j) { v[j] = sr[64 * j]; am = fmaxf(am, fmaxf(fmaxf(fabsf(v[j].x), fabsf(v[j].y)), fmaxf(fabsf(v[j].z), fabsf(v[j].w)))); }
#pragma unroll
    for (int o = 1; o < 64; o <<= 1) am = fmaxf(am, __shfl_xor(am, o));
    const float inv = am > 0.f ? 127.f / am : 0.f;
#pragma unroll
    for (int j = 0; j < 4; ++j) { const int q0 = (int)rintf(v[j].x * inv), q1 = (int)rintf(v[j].y * inv), q2 = (int)rintf(v[j].z * inv), q3 = (int)rintf(v[j].w * inv);
        *(unsigned*)(dst + 4 * lane + 256 * j) = (unsigned)(q0 & 255) | ((unsigned)(q1 & 255) << 8) | ((unsigned)(q2 & 255) << 16) | ((unsigned)(q3 & 255) << 24); }
    if (lane == 0) *scale_out = am * (1.f / 127.f);
}
__device__ __forceinline__ float gelu_t(float x) { const float u = 0.7978845608028654f * (x + 0.044715f * x * x * x); return 0.5f * x * (1.f + tanhf(u)); }

__device__ __forceinline__ int hx(int lo, int hi, bool up, int bit) { const int send = up ? lo : hi, keep = up ? hi : lo; return keep + __shfl_xor(send, bit); }

__device__ __forceinline__ void u_token(const unsigned char* UQs  , const int4 (&ev)[4], const int4 hq, int* PArow, int lane) {
    const int e[16] = {ev[0].x, ev[0].y, ev[0].z, ev[0].w, ev[1].x, ev[1].y, ev[1].z, ev[1].w, ev[2].x, ev[2].y, ev[2].z, ev[2].w, ev[3].x, ev[3].y, ev[3].z, ev[3].w};
    int4 rows[16];
#pragma unroll
    for (int i = 0; i < 16; ++i) rows[i] = *(const int4*)(UQs + (size_t)e[i] * 1024);
    int p[16];
#pragma unroll
    for (int i = 0; i < 16; ++i) p[i] = sdot16(rows[i], hq);
    const bool b2 = (lane & 4) != 0, b1 = (lane & 2) != 0, b0 = (lane & 1) != 0;
    int q[8], r[4];
#pragma unroll
    for (int k = 0; k < 8; ++k) q[k] = hx(p[k], p[8 + k], b2, 4);
#pragma unroll
    for (int k = 0; k < 4; ++k) r[k] = hx(q[k], q[4 + k], b1, 2);
    const int z0 = hx(r[0], r[2], b0, 1), z1 = hx(r[1], r[3], b0, 1);
    *(int2*)(PArow + 2 * lane) = make_int2(z0, z1);
}

__device__ __forceinline__ void v_token(const unsigned char* VQs  , const int4 (&ev)[4], const int4 wh, const int4 wlo, float wscale, const float* gate2, const float* x1row, float* outrow, int s, int lane) {
    const int e[16] = {ev[0].x, ev[0].y, ev[0].z, ev[0].w, ev[1].x, ev[1].y, ev[1].z, ev[1].w, ev[2].x, ev[2].y, ev[2].z, ev[2].w, ev[3].x, ev[3].y, ev[3].z, ev[3].w};
    const int whv[4] = {wh.x, wh.y, wh.z, wh.w}, wlv[4] = {wlo.x, wlo.y, wlo.z, wlo.w};
    uint4 rows[16];
#pragma unroll
    for (int i = 0; i < 16; ++i) rows[i] = *(const uint4*)(VQs + (size_t)e[i] * 1024);
    int ah[16], al[16];
#pragma unroll
    for (int c = 0; c < 16; ++c) { ah[c] = 0; al[c] = 0; }
#pragma unroll
    for (int g = 0; g < 4; ++g) {
#pragma unroll
        for (int d = 0; d < 4; ++d) {
            const unsigned A = d == 0 ? rows[4 * g].x : d == 1 ? rows[4 * g].y : d == 2 ? rows[4 * g].z : rows[4 * g].w;
            const unsigned B = d == 0 ? rows[4 * g + 1].x : d == 1 ? rows[4 * g + 1].y : d == 2 ? rows[4 * g + 1].z : rows[4 * g + 1].w;
            const unsigned C = d == 0 ? rows[4 * g + 2].x : d == 1 ? rows[4 * g + 2].y : d == 2 ? rows[4 * g + 2].z : rows[4 * g + 2].w;
            const unsigned D = d == 0 ? rows[4 * g + 3].x : d == 1 ? rows[4 * g + 3].y : d == 2 ? rows[4 * g + 3].z : rows[4 * g + 3].w;
            const unsigned ab01 = __builtin_amdgcn_perm(A, B, 0x01050004u), ab23 = __builtin_amdgcn_perm(A, B, 0x03070206u);
            const unsigned cd01 = __builtin_amdgcn_perm(C, D, 0x01050004u), cd23 = __builtin_amdgcn_perm(C, D, 0x03070206u);
            const int q0 = (int)__builtin_amdgcn_perm(ab01, cd01, 0x01000504u), q1 = (int)__builtin_amdgcn_perm(ab01, cd01, 0x03020706u);
            const int q2 = (int)__builtin_amdgcn_perm(ab23, cd23, 0x01000504u), q3 = (int)__builtin_amdgcn_perm(ab23, cd23, 0x03020706u);
            ah[4 * d + 0] = __builtin_amdgcn_sdot4(q0, whv[g], ah[4 * d + 0], false); al[4 * d + 0] = __builtin_amdgcn_sdot4(q0, wlv[g], al[4 * d + 0], false);
            ah[4 * d + 1] = __builtin_amdgcn_sdot4(q1, whv[g], ah[4 * d + 1], false); al[4 * d + 1] = __builtin_amdgcn_sdot4(q1, wlv[g], al[4 * d + 1], false);
            ah[4 * d + 2] = __builtin_amdgcn_sdot4(q2, whv[g], ah[4 * d + 2], false); al[4 * d + 2] = __builtin_amdgcn_sdot4(q2, wlv[g], al[4 * d + 2], false);
            ah[4 * d + 3] = __builtin_amdgcn_sdot4(q3, whv[g], ah[4 * d + 3], false); al[4 * d + 3] = __builtin_amdgcn_sdot4(q3, wlv[g], al[4 * d + 3], false);
        }
    }
    int y[16];
#pragma unroll
    for (int c = 0; c < 16; ++c) y[c] = ah[c] * 128 + al[c];
    const bool b5 = (lane & 32) != 0, b4 = (lane & 16) != 0, b3 = (lane & 8) != 0;
    int z[8], q[4];
#pragma unroll
    for (int k = 0; k < 8; ++k) z[k] = hx(y[k], y[8 + k], b5, 32);
#pragma unroll
    for (int k = 0; k < 4; ++k) q[k] = hx(z[k], z[4 + k], b4, 16);
    const int r0 = hx(q[0], q[2], b3, 8), r1 = hx(q[1], q[3], b3, 8);
    const int col = 128 * s + 16 * (lane & 7) + (b5 ? 8 : 0) + (b4 ? 4 : 0) + (b3 ? 2 : 0);
    const float2 g2 = *(const float2*)(gate2 + col); float2 x1 = *(const float2*)(x1row + col);
    x1.x += g2.x * wscale * (float)r0; x1.y += g2.y * wscale * (float)r1;
    *(float2*)(outrow + col) = x1;
}
}

constexpr size_t WS_SU = 2 * MiB, WS_SV = 2 * MiB + 65536, WS_HS = 2 * MiB + 131072;
constexpr size_t WS_UQ = 24 * MiB, WS_VQ = 40 * MiB, WS_H2Q = 56 * MiB;
constexpr size_t WS_XS = 2 * MiB + 262144, WS_WINS = 2 * MiB + 393216, WS_WPQS = 2 * MiB + 409600;
constexpr size_t WS_WINQ = 456 * MiB, WS_WPQQ = 460 * MiB;
constexpr size_t WS_A = WS_KA;
struct Args { const void* in[22]; float* out; unsigned char* ws; int ph_lo, ph_hi, li, pad; };

struct Frame {
    LAS unsigned char* lds;
    int tid, lane, wave, G, gw, NGW;
};

namespace pg8 {
struct EpiProj {
    static constexpr bool PERM = true, AFTER_DRAIN = false;
    bf16_t* P; float* FL;
    __device__ __forceinline__ void operator()(const f32x4 (&acc)[2][2][4][2], const Unit& u, int wr, int wc, int fr, int fq) const {
        const int row0 = u.pm * BM + wr * 64 + fr, col0 = u.pn * BM + wc * 32 + 8 * fq;
#pragma unroll
        for (int ai = 0; ai < 2; ++ai)
#pragma unroll
            for (int m = 0; m < 4; ++m) { const int row = row0 + ai * HALF + m * 16; bf16_t* rowp = P + (size_t)row * PP + col0;
#pragma unroll
                for (int bj = 0; bj < 2; ++bj) { const f32x4 v0 = acc[ai][bj][m][0], v1 = acc[ai][bj][m][1];
                    if (col0 + bj * HALF == C_FL) { float* f = FL + (size_t)row * 8; *(f32x4*)f = v0; *(f32x4*)(f + 4) = v1; }
                    u32x4 w; w.x = cvt_pk_bf16(v0[0], v0[1]); w.y = cvt_pk_bf16(v0[2], v0[3]); w.z = cvt_pk_bf16(v1[0], v1[1]); w.w = cvt_pk_bf16(v1[2], v1[3]);
                    *(u32x4*)(rowp + bj * HALF) = w; } }
    }
};
struct EpiProjI8 {
    static constexpr bool PERM = true, AFTER_DRAIN = false;
    bf16_t* P; float* FL; const float* rs; const float* cs;
    __device__ __forceinline__ void operator()(const i32x4 (&acc)[2][2][4][2], const Unit& u, int wr, int wc, int fr, int fq) const {
        const int row0 = u.pm * BM + wr * 64 + fr, col0 = u.pn * BM + wc * 32 + 8 * fq;
        f32x4 c0[2], c1[2];
#pragma unroll
        for (int bj = 0; bj < 2; ++bj) { c0[bj] = *(const f32x4*)(cs + col0 + bj * HALF); c1[bj] = *(const f32x4*)(cs + col0 + bj * HALF + 4); }
#pragma unroll
        for (int ai = 0; ai < 2; ++ai)
#pragma unroll
            for (int m = 0; m < 4; ++m) { const int row = row0 + ai * HALF + m * 16; bf16_t* rowp = P + (size_t)row * PP + col0; const float r = rs[row];
#pragma unroll
                for (int bj = 0; bj < 2; ++bj) { const i32x4 a0 = acc[ai][bj][m][0], a1 = acc[ai][bj][m][1];
                    const f32x4 v0 = {(float)a0[0] * r * c0[bj][0], (float)a0[1] * r * c0[bj][1], (float)a0[2] * r * c0[bj][2], (float)a0[3] * r * c0[bj][3]};
                    const f32x4 v1 = {(float)a1[0] * r * c1[bj][0], (float)a1[1] * r * c1[bj][1], (float)a1[2] * r * c1[bj][2], (float)a1[3] * r * c1[bj][3]};
                    if (col0 + bj * HALF == C_FL) { float* f = FL + (size_t)row * 8; *(f32x4*)f = v0; *(f32x4*)(f + 4) = v1; }
                    u32x4 w; w.x = cvt_pk_bf16(v0[0], v0[1]); w.y = cvt_pk_bf16(v0[2], v0[3]); w.z = cvt_pk_bf16(v1[0], v1[1]); w.w = cvt_pk_bf16(v1[2], v1[3]);
                    *(u32x4*)(rowp + bj * HALF) = w; } }
    }
};
struct EpiStoreI8 {
    static constexpr bool PERM = true, AFTER_DRAIN = false;
    bf16_t* O; int ldc; const float* rs; const float* cs;
    __device__ __forceinline__ void operator()(const i32x4 (&acc)[2][2][4][2], const Unit& u, int wr, int wc, int fr, int fq) const {
        const int row0 = u.pm * BM + wr * 64 + fr, col0 = u.pn * BM + wc * 32 + 8 * fq;
        f32x4 c0[2], c1[2];
#pragma unroll
        for (int bj = 0; bj < 2; ++bj) { c0[bj] = *(const f32x4*)(cs + col0 + bj * HALF); c1[bj] = *(const f32x4*)(cs + col0 + bj * HALF + 4); }
#pragma unroll
        for (int ai = 0; ai < 2; ++ai)
#pragma unroll
            for (int m = 0; m < 4; ++m) { const int row = row0 + ai * HALF + m * 16; bf16_t* rowp = O + (size_t)row * ldc + col0; const float r = rs[row];
#pragma unroll
                for (int bj = 0; bj < 2; ++bj) { const i32x4 a0 = acc[ai][bj][m][0], a1 = acc[ai][bj][m][1];
                    u32x4 w; w.x = cvt_pk_bf16((float)a0[0] * r * c0[bj][0], (float)a0[1] * r * c0[bj][1]); w.y = cvt_pk_bf16((float)a0[2] * r * c0[bj][2], (float)a0[3] * r * c0[bj][3]);
                    w.z = cvt_pk_bf16((float)a1[0] * r * c1[bj][0], (float)a1[1] * r * c1[bj][1]); w.w = cvt_pk_bf16((float)a1[2] * r * c1[bj][2], (float)a1[3] * r * c1[bj][3]);
                    *(u32x4*)(rowp + bj * HALF) = w; } }
    }
};
struct EpiStore {
    static constexpr bool PERM = true, AFTER_DRAIN = false;
    bf16_t* O; int ldc;
    __device__ __forceinline__ void operator()(const f32x4 (&acc)[2][2][4][2], const Unit& u, int wr, int wc, int fr, int fq) const {
        const int row0 = u.pm * BM + wr * 64 + fr, col0 = u.pn * BM + wc * 32 + 8 * fq;
#pragma unroll
        for (int ai = 0; ai < 2; ++ai)
#pragma unroll
            for (int m = 0; m < 4; ++m) { bf16_t* rowp = O + (size_t)(row0 + ai * HALF + m * 16) * ldc + col0;
#pragma unroll
                for (int bj = 0; bj < 2; ++bj) { const f32x4 v0 = acc[ai][bj][m][0], v1 = acc[ai][bj][m][1];
                    u32x4 w; w.x = cvt_pk_bf16(v0[0], v0[1]); w.y = cvt_pk_bf16(v0[2], v0[3]); w.z = cvt_pk_bf16(v1[0], v1[1]); w.w = cvt_pk_bf16(v1[2], v1[3]);
                    *(u32x4*)(rowp + bj * HALF) = w; } }
    }
};
struct EpiResid {
    static constexpr bool PERM = false, AFTER_DRAIN = false;
    const float* X; const float* MOD; float* out;
    __device__ __forceinline__ void operator()(const f32x4 (&acc)[2][2][4][2], const Unit& u, int wr, int wc, int fr, int fq) const {
        const int row0 = u.pm * BM + wr * 64 + fr, col0 = u.pn * BM + wc * 32 + 4 * fq;
        const int b = (u.pm * BM) / S_;
        f32x4 gv[2][2];
#pragma unroll
        for (int bj = 0; bj < 2; ++bj)
#pragma unroll
            for (int n = 0; n < 2; ++n) gv[bj][n] = *(const f32x4*)(MOD + b * 6144 + 2 * 1024 + col0 + bj * HALF + n * 16);
#pragma unroll
        for (int ai = 0; ai < 2; ++ai)
#pragma unroll
            for (int m = 0; m < 4; ++m) { const size_t off = (size_t)(row0 + ai * HALF + m * 16) * 1024 + col0;
#pragma unroll
                for (int bj = 0; bj < 2; ++bj)
#pragma unroll
                    for (int n = 0; n < 2; ++n) { const f32x4 xv = *(const f32x4*)(X + off + bj * HALF + n * 16); *(f32x4*)(out + off + bj * HALF + n * 16) = xv + gv[bj][n] * acc[ai][bj][m][n]; } }
    }
};
}

__device__ __forceinline__ void p0_transpose_item(const float* W, int K, int N, int Npad, bf16_t* WT, LAS float* scr, int item, int lane) {
    const int nblk = Npad / 32, kb = item / nblk, nb = item % nblk, k0 = 64 * kb, n0 = 32 * nb;
    const int nn = n0 + (lane & 31);
#pragma unroll 8
    for (int i = 0; i < 32; ++i) { const int kk = 2 * i + (lane >> 5); scr[kk * 33 + (lane & 31)] = nn < N ? W[(size_t)(k0 + kk) * N + nn] : 0.f; }
    asm volatile("s_waitcnt lgkmcnt(0)" ::: "memory");
    const int c = lane & 7;
#pragma unroll
    for (int j = 0; j < 4; ++j) { const int n = (lane >> 3) + 8 * j; const LAS float* s = scr + (8 * c) * 33 + n;
        u32x4 o; o.x = pk2(s[0 * 33], s[1 * 33]); o.y = pk2(s[2 * 33], s[3 * 33]); o.z = pk2(s[4 * 33], s[5 * 33]); o.w = pk2(s[6 * 33], s[7 * 33]);
        *(u32x4*)(WT + (size_t)(n0 + n) * K + k0 + 8 * c) = o; }
    asm volatile("s_waitcnt lgkmcnt(0)" ::: "memory");
}
__device__ __forceinline__ void p0_mod_block(const float* c, const float* w_ada, const float* b_ada, float* mod, LAS unsigned char* lds, int item, int wave, int lane) {
    LAS float* sil = (LAS float*)(lds + wave * 2048);
    LAS float* part = (LAS float*)(lds + 16384);
    for (int i = lane; i < 512; i += 64) { const int b = i >> 7, kk = i & 127; const float cv = c[b * 1024 + wave * 128 + kk]; sil[kk * 4 + b] = cv / (1.f + expf(-cv)); }
    asm volatile("s_waitcnt lgkmcnt(0)" ::: "memory");
    const int j = item * 64 + lane;
    const float* wp = w_ada + (size_t)(wave * 128) * 6144 + j;
    float a0 = 0.f, a1 = 0.f, a2 = 0.f, a3 = 0.f;
#pragma unroll 16
    for (int k = 0; k < 128; ++k) { const float w = wp[(size_t)k * 6144]; const f32x4 s = *(const LAS f32x4*)(sil + k * 4); a0 += s[0] * w; a1 += s[1] * w; a2 += s[2] * w; a3 += s[3] * w; }
    part[(wave * 4 + 0) * 64 + lane] = a0; part[(wave * 4 + 1) * 64 + lane] = a1; part[(wave * 4 + 2) * 64 + lane] = a2; part[(wave * 4 + 3) * 64 + lane] = a3;
    __syncthreads();
    if (wave < 4) { float acc = b_ada[j];
#pragma unroll
        for (int w = 0; w < 8; ++w) acc += part[(w * 4 + wave) * 64 + lane];
        mod[wave * 6144 + j] = acc; }
    __syncthreads();
}

struct ModIn { float4 v[4]; };
__device__ __forceinline__ void modrow_load(ModIn& M, const float* X, int row, int lane) {
    const float4* xr = (const float4*)(X + (size_t)row * 1024) + lane;
#pragma unroll
    for (int j = 0; j < 4; ++j) M.v[j] = xr[64 * j];
}
__device__ __forceinline__ void modrow_finish(ModIn& M, const float* g, const float* mod, int shift_idx, int scale_idx, bf16_t* out, unsigned char* outq, float* hs, int row, int lane) {
    const int b = row / S_; float ss = 0.f;
#pragma unroll
    for (int j = 0; j < 4; ++j) ss += (M.v[j].x * M.v[j].x + M.v[j].y * M.v[j].y) + (M.v[j].z * M.v[j].z + M.v[j].w * M.v[j].w);
    ss = wave_sum(ss);
    const float r = rsqrtf(ss * (1.f / 1024.f) + EPS);
    const float* sh = mod + b * 6144 + shift_idx * 1024; const float* sc = mod + b * 6144 + scale_idx * 1024;
    float am = 0.f;
#pragma unroll
    for (int j = 0; j < 4; ++j) {
        const int col = 4 * lane + 256 * j; float4& v = M.v[j];
        const float4 g4 = *(const float4*)(g + col), s4 = *(const float4*)(sc + col), h4 = *(const float4*)(sh + col);
        v.x = v.x * r * g4.x * (1.f + s4.x) + h4.x; v.y = v.y * r * g4.y * (1.f + s4.y) + h4.y; v.z = v.z * r * g4.z * (1.f + s4.z) + h4.z; v.w = v.w * r * g4.w * (1.f + s4.w) + h4.w;
        if (out) { uint2 w; w.x = pk2(v.x, v.y); w.y = pk2(v.z, v.w); *(uint2*)(out + (size_t)row * 1024 + col) = w; }
        am = fmaxf(am, fmaxf(fmaxf(fabsf(v.x), fabsf(v.y)), fmaxf(fabsf(v.z), fabsf(v.w))));
    }
    if (outq) {
#pragma unroll
        for (int o = 1; o < 64; o <<= 1) am = fmaxf(am, __shfl_xor(am, o));
        const float inv = am > 0.f ? 127.f / am : 0.f;
#pragma unroll
        for (int j = 0; j < 4; ++j) { const float4 v = M.v[j]; const int q0 = (int)rintf(v.x * inv), q1 = (int)rintf(v.y * inv), q2 = (int)rintf(v.z * inv), q3 = (int)rintf(v.w * inv);
            *(unsigned*)(outq + (size_t)row * 1024 + 4 * lane + 256 * j) = (unsigned)(q0 & 255) | ((unsigned)(q1 & 255) << 8) | ((unsigned)(q2 & 255) << 16) | ((unsigned)(q3 & 255) << 24); }
        if (lane == 0) hs[row] = am * (1.f / 127.f);
    }
}
__device__ __forceinline__ void modrows2(const float* X, const float* g, const float* mod, int shift_idx, int scale_idx, bf16_t* out, unsigned char* outq, float* hs, int gw, int ngw, int lane) {
    for (int row = gw; row < T_; row += 2 * ngw) {
        const int row2 = row + ngw; ModIn Ma, Mb;
        modrow_load(Ma, X, row, lane); if (row2 < T_) modrow_load(Mb, X, row2, lane);
        modrow_finish(Ma, g, mod, shift_idx, scale_idx, out, outq, hs, row, lane); if (row2 < T_) modrow_finish(Mb, g, mod, shift_idx, scale_idx, out, outq, hs, row2, lane);
    }
}
__device__ __forceinline__ void quant4(const float* peer_u, const float* peer_v, unsigned char* UQ, unsigned char* VQ, float* SU, float* SV, int r0, int lane) {
    float4 v[4][4]; float am[4];
#pragma unroll
    for (int q = 0; q < 4; ++q) { const int r = r0 + q; const float* src = (r < 16384 ? peer_u + (size_t)r * 1024 : peer_v + (size_t)(r - 16384) * 1024);
#pragma unroll
        for (int j = 0; j < 4; ++j) v[q][j] = ((const float4*)src)[lane + 64 * j]; }
#pragma unroll
    for (int q = 0; q < 4; ++q) { float a = 0.f;
#pragma unroll
        for (int j = 0; j < 4; ++j) a = fmaxf(a, fmaxf(fmaxf(fabsf(v[q][j].x), fabsf(v[q][j].y)), fmaxf(fabsf(v[q][j].z), fabsf(v[q][j].w))));
        am[q] = a; }
#pragma unroll
    for (int o = 1; o < 64; o <<= 1) {
#pragma unroll
        for (int q = 0; q < 4; ++q) am[q] = fmaxf(am[q], __shfl_xor(am[q], o)); }
#pragma unroll
    for (int q = 0; q < 4; ++q) { const int r = r0 + q; unsigned char* dst = (r < 16384 ? UQ + (size_t)r * 1024 : VQ + (size_t)(r - 16384) * 1024); float* sc = (r < 16384 ? SU + r : SV + (r - 16384));
        const float inv = am[q] > 0.f ? 127.f / am[q] : 0.f;
#pragma unroll
        for (int j = 0; j < 4; ++j) { const float4 x = v[q][j]; const int q0 = (int)rintf(x.x * inv), q1 = (int)rintf(x.y * inv), q2 = (int)rintf(x.z * inv), q3 = (int)rintf(x.w * inv);
            *(unsigned*)(dst + 4 * lane + 256 * j) = (unsigned)(q0 & 255) | ((unsigned)(q1 & 255) << 8) | ((unsigned)(q2 & 255) << 16) | ((unsigned)(q3 & 255) << 24); }
        if (lane == 0) *sc = am[q] * (1.f / 127.f); }
}

__global__ void __launch_bounds__(NWAVES * 64, 2) mega_fwd(Args args) {
    extern __shared__ __attribute__((aligned(16))) unsigned char lds[];
    Frame F;
    F.lds = (LAS unsigned char*)lds;
    volatile LAS unsigned* MISC = (volatile LAS unsigned*)(F.lds + MISC_OFF);
    F.tid = threadIdx.x; F.lane = F.tid & 63; F.wave = __builtin_amdgcn_readfirstlane(F.tid >> 6);
    F.G = gridDim.x; F.gw = blockIdx.x * NWAVES + F.wave; F.NGW = F.G * NWAVES;
    unsigned char* ws = args.ws;
    unsigned* ctl = (unsigned*)(ws + WS_CTL);
    const float* x = (const float*)args.in[0]; const float* c = (const float*)args.in[1]; const int* positions = (const int*)args.in[2];
    const float* w_ada = (const float*)args.in[3]; const float* b_ada = (const float*)args.in[4]; const float* norm1_g = (const float*)args.in[5];
    const float* w_in = (const float*)args.in[6]; const float* mla_qa_g = (const float*)args.in[7]; const float* mla_kva_g = (const float*)args.in[8];
    const float* w_uq = (const float*)args.in[9]; const float* w_ukv = (const float*)args.in[10]; const float* mla_q_g = (const float*)args.in[11];
    const float* mla_k_g = (const float*)args.in[12]; const float* fox_q_g = (const float*)args.in[13]; const float* fox_k_g = (const float*)args.in[14];
    const float* b_f = (const float*)args.in[15]; const float* w_o = (const float*)args.in[16]; const float* norm2_g = (const float*)args.in[17];
    const float* w_pq = (const float*)args.in[18]; const float* sub_keys = (const float*)args.in[19]; const float* peer_u = (const float*)args.in[20]; const float* peer_v = (const float*)args.in[21];
    float* out = args.out;
    float* MOD = (float*)(ws + WS_MOD); float* FL = (float*)(ws + WS_FL); float* FCUM = (float*)(ws + WS_FCUM); float* LOGF = (float*)(ws + WS_LOGF); float2* ROPE = (float2*)(ws + WS_ROPE);
    bf16_t* XN = (bf16_t*)(ws + WS_XN); bf16_t* PROJ = (bf16_t*)(ws + WS_PROJ); bf16_t* KVRAW = (bf16_t*)(ws + WS_KVRAW); bf16_t* QA = (bf16_t*)(ws + WS_QA); bf16_t* KA = (bf16_t*)(ws + WS_KA);
    bf16_t* WIN = (bf16_t*)(ws + WS_WIN); bf16_t* WUQ = (bf16_t*)(ws + WS_WUQ); bf16_t* WUKV = (bf16_t*)(ws + WS_WUKV); bf16_t* WO = (bf16_t*)(ws + WS_WO); bf16_t* WPQ = (bf16_t*)(ws + WS_WPQ); bf16_t* SKB = (bf16_t*)(ws + WS_SK);
    unsigned char* XNQ = ws + WS_XN; float* XS = (float*)(ws + WS_XS); unsigned char* WINQ = ws + WS_WINQ; unsigned char* WPQQ = ws + WS_WPQQ; float* WINS = (float*)(ws + WS_WINS); float* WPQS = (float*)(ws + WS_WPQS);
    unsigned char* UQ = ws + WS_UQ; unsigned char* VQ = ws + WS_VQ; unsigned char* H2Q = ws + WS_H2Q; float* SU = (float*)(ws + WS_SU); float* SV = (float*)(ws + WS_SV); float* HS = (float*)(ws + WS_HS); float* AP = (float*)(ws + WS_A);
    bf16_t* OB = XN; bf16_t* H2 = XN; bf16_t* QP = PROJ; int* EID = (int*)(ws + WS_QA); float* GATE = (float*)(ws + WS_QA + 16 * MiB);
    (void)sub_keys; (void)peer_u; (void)peer_v; (void)positions; (void)KA; (void)FCUM; (void)LOGF; (void)ROPE; (void)mla_q_g; (void)mla_k_g; (void)b_f; (void)fox_q_g; (void)fox_k_g; (void)mla_qa_g; (void)mla_kva_g;

    for (int u = F.tid; u < (LDS_BYTES - LDSCTL_OFF) / 4; u += NWAVES * 64) ((LAS unsigned*)(F.lds + LDSCTL_OFF))[u] = 0u;
    __syncthreads();
    const int lo = args.ph_lo, hi = args.ph_hi;
    XcdBarrier bar; bar.bar = ctl + CW_BAR + args.li * XCD_BAR_WORDS; bar.x = 0; bar.st = nullptr;
    if (hi - lo > 1) bar = xcd_barrier_post(ctl + CW_BAR + args.li * XCD_BAR_WORDS, MISC + 8);
#define IN(k) (lo <= (k) && (k) < hi)
#define SEAM(k) do { if (IN(k) && IN((k) + 1)) xcd_barrier(bar); } while (0)

    if (IN(0)) REP(0) {
        LAS float* scr = (LAS float*)(F.lds + F.wave * 16384);
        constexpr int I_MOD = 96, I_IN = 16 * 72, I_UQ = 6 * 24, I_UKV = 4 * 32, I_O = 16 * 32, I_PQ = 16 * 64;
        constexpr int I_SK = 512;
        constexpr int NITEMS = I_IN + I_UQ + I_UKV + I_O + I_PQ + I_SK;
        for (int mi = (int)blockIdx.x; mi < I_MOD; mi += F.G) p0_mod_block(c, w_ada, b_ada, MOD, F.lds, mi, F.wave, F.lane);
        for (int it = F.gw; it < NITEMS; it += F.NGW) {
            int r = it;
            if (r < I_IN) { p0_transpose_item(w_in, 1024, INW, PP, WIN, scr, r, F.lane); continue; } r -= I_IN;
            if (r < I_UQ) { p0_transpose_item(w_uq, 384, 768, 768, WUQ, scr, r, F.lane); continue; } r -= I_UQ;
            if (r < I_UKV) { p0_transpose_item(w_ukv, 256, 1024, 1024, WUKV, scr, r, F.lane); continue; } r -= I_UKV;
            if (r < I_O) { p0_transpose_item(w_o, 1024, 1024, 1024, WO, scr, r, F.lane); continue; } r -= I_O;
            if (r < I_PQ) { p0_transpose_item(w_pq, 1024, 2048, 2048, WPQ, scr, r, F.lane); continue; } r -= I_PQ;
            { const float4* src = (const float4*)(sub_keys + (size_t)r * 512) + F.lane * 2; const float4 a = src[0], b2 = src[1];
              u32x4 o; o.x = pk2(a.x, a.y); o.y = pk2(a.z, a.w); o.z = pk2(b2.x, b2.y); o.w = pk2(b2.z, b2.w); *(u32x4*)(SKB + (size_t)r * 512 + F.lane * 8) = o; }
        }
    }
    SEAM(0);
    if (IN(1)) {
        for (int r = F.gw; r < PP + 2048; r += F.NGW) {
            const bf16_t* src = r < PP ? WIN + (size_t)r * 1024 : WPQ + (size_t)(r - PP) * 1024; unsigned char* dst = r < PP ? WINQ + (size_t)r * 1024 : WPQQ + (size_t)(r - PP) * 1024; float* sc = r < PP ? WINS + r : WPQS + (r - PP);
            float v[16]; unpack8(*(const uint4*)(src + F.lane * 16), v); unpack8(*(const uint4*)(src + F.lane * 16 + 8), v + 8);
            float am = 0.f;
#pragma unroll
            for (int i = 0; i < 16; ++i) am = fmaxf(am, fabsf(v[i]));
#pragma unroll
            for (int o = 1; o < 64; o <<= 1) am = fmaxf(am, __shfl_xor(am, o));
            const float inv = am > 0.f ? 127.f / am : 0.f; unsigned q[4];
#pragma unroll
            for (int i = 0; i < 4; ++i) q[i] = (unsigned)((int)rintf(v[4 * i] * inv) & 255) | ((unsigned)((int)rintf(v[4 * i + 1] * inv) & 255) << 8) | ((unsigned)((int)rintf(v[4 * i + 2] * inv) & 255) << 16) | ((unsigned)((int)rintf(v[4 * i + 3] * inv) & 255) << 24);
            *(uint4*)(dst + F.lane * 16) = make_uint4(q[0], q[1], q[2], q[3]);
            if (F.lane == 0) *sc = am * (1.f / 127.f);
        }
        modrows2(x, norm1_g, MOD, 0, 1, nullptr, XNQ, XS, F.gw, F.NGW, F.lane);
    }
    SEAM(1);
    if (IN(2)) REP(2) {
        pg8::Gemm g{(const bf16_t*)XNQ, (const bf16_t*)WINQ, T_, PP, 512, 512}; pg8::StaticOrder S; S.init(T_, PP, F.G, (int)blockIdx.x);
        pg8::EpiProjI8 E{PROJ, FL, XS, WINS};
        pg8::gemm_phase<pg8::EpiProjI8, pg8::StaticOrder, true, true, true>(F.lds, g, S, E);
    }
    SEAM(2);
    if (IN(3)) {
        const float invf = (float)exp2(-(double)(F.lane & 15) * (13.287712379549449 / 16.0));
        for (int row = F.gw; row < T_; row += 2 * F.NGW) {
            const int row2 = row + F.NGW; RowPrepIn Ra, Rb;
            rowprep_load(Ra, PROJ, FL, positions, row, F.lane); if (row2 < T_) rowprep_load(Rb, PROJ, FL, positions, row2, F.lane);
            rowprep_finish(Ra, PROJ, mla_qa_g, mla_kva_g, fox_q_g, fox_k_g, b_f, LOGF, ROPE, row, F.lane, invf);
            if (row2 < T_) rowprep_finish(Rb, PROJ, mla_qa_g, mla_kva_g, fox_q_g, fox_k_g, b_f, LOGF, ROPE, row2, F.lane, invf);
        }
    }
    SEAM(3);
    if (IN(4)) REP(4) {
        { pg8::Gemm g{PROJ + C_CQ, WUQ, T_, 768, 384, PP}; pg8::StaticOrder S; S.init(T_, 768, F.G, (int)blockIdx.x); pg8::EpiStore E{QA, 768};
          pg8::gemm_phase<pg8::EpiStore, pg8::StaticOrder, true, true>(F.lds, g, S, E); }
        { pg8::Gemm g{PROJ + C_CKV, WUKV, T_, 1024, 256, PP}; pg8::StaticOrder S; S.init(T_, 1024, F.G, (int)blockIdx.x); pg8::EpiStore E{KVRAW, 1024};
          pg8::gemm_phase<pg8::EpiStore, pg8::StaticOrder, true, true>(F.lds, g, S, E); }
    }
    SEAM(4);
    if (IN(5)) {
        if (F.wave == 0 && (int)blockIdx.x < 32) fcum_item(LOGF, FCUM, (int)blockIdx.x, F.lane);
        for (int row = F.gw; row < T_; row += 2 * F.NGW) {
            const int row2 = row + F.NGW; MlaIn Ma, Mb;
            mlaprep_load(Ma, QA, KVRAW, PROJ, ROPE, row, F.lane); if (row2 < T_) mlaprep_load(Mb, QA, KVRAW, PROJ, ROPE, row2, F.lane);
            mlaprep_finish(Ma, QA, KA, mla_q_g, mla_k_g, row, F.lane); if (row2 < T_) mlaprep_finish(Mb, QA, KA, mla_q_g, mla_k_g, row2, F.lane);
        }
    }
    SEAM(5);
    if (IN(6)) {
        volatile LAS unsigned* qslot = MISC + 16;
        float thr;
        { float gq = fabsf(fox_q_g[F.lane]), gk = fabsf(fox_k_g[F.lane]);
#pragma unroll
          for (int o = 1; o < 64; o <<= 1) { gq = fmaxf(gq, __shfl_xor(gq, o)); gk = fmaxf(gk, __shfl_xor(gk, o)); }
          thr = 104.5f + 2.f * 1.02f * 8.f * gq * gk; }
        unsigned* qctr = ctl + 64;
        if (F.tid == 0) qslot[0] = atomicAdd(qctr, 1u);
        __syncthreads();
        unsigned u = qslot[0];
        while (u < 2048u + 1024u) {
            unsigned unext = 0u;
            if (F.tid == 0) unext = atomicAdd(qctr, 1u);
            if (u >= 2048u) {
                quant4(peer_u, peer_v, UQ, VQ, SU, SV, (int)(u - 2048u) * 32 + F.wave * 4, F.lane);
                if (F.tid == 0) qslot[0] = unext;
                __syncthreads();
                u = qslot[0];
                __syncthreads();
                continue;
            }
            const int grp = (int)(u >> 10), bh = (int)(u & 31u), qb = 31 - (int)((u >> 5) & 31u), b = bh >> 3, h = bh & 7;
            if (grp == 0) { const att::Desc d{QA + (size_t)b * S_ * 768 + h * 96, 768, KA + (size_t)b * S_ * 768 + h * 96, 768, KVRAW + (size_t)b * S_ * 1024 + h * 128 + 64, 1024, OB + (size_t)b * S_ * 1024 + h * 64, 1024, nullptr};
                att::attn_unit<6, false>(d, qb, 0, F.lds); }
            else { const bf16_t* pb = PROJ + (size_t)b * S_ * PP + h * 64; const float* fc = FCUM + (size_t)(b * 8 + h) * S_;
                const att::Desc d{pb + C_FQ, PP, pb + C_FK, PP, pb + C_FV, PP, OB + (size_t)b * S_ * 1024 + 512 + h * 64, 1024, fc};
                const int NT = 4 * (qb + 1); const float lim = fc[qb * 256] + thr;
                int j0 = 0;
                { const int ja = F.lane, jb2 = 64 + F.lane;
                  const bool ka = ja < NT ? (fc[64 * ja + 63] <= lim) : true, kb = jb2 < NT ? (fc[64 * jb2 + 63] <= lim) : true;
                  const unsigned long long ma = __ballot(ka), mb = __ballot(kb);
                  j0 = ma ? __builtin_ctzll(ma) : (mb ? 64 + __builtin_ctzll(mb) : NT - 4); }
                if (j0 > NT - 4) j0 = NT - 4;
                att::attn_unit<4, true>(d, qb, j0, F.lds); }
            if (F.tid == 0) qslot[0] = unext;
            __syncthreads();
            u = qslot[0];
            __syncthreads();
        }
    }
    SEAM(6);
    if (IN(7)) REP(7) {
        pg8::Gemm g{OB, WO, T_, 1024, 1024, 1024}; pg8::StaticOrder S; S.init(T_, 1024, F.G, (int)blockIdx.x);
        pg8::EpiResid E{x, MOD, out};
        pg8::gemm_phase<pg8::EpiResid, pg8::StaticOrder, true, true>(F.lds, g, S, E);
    }
    SEAM(7);
    if (IN(8)) modrows2(out, norm2_g, MOD, 3, 4, nullptr, H2Q, HS, F.gw, F.NGW, F.lane);
    SEAM(8);
    if (IN(9)) REP(9) {
        pg8::Gemm g{(const bf16_t*)H2Q, (const bf16_t*)WPQQ, T_, 2048, 512, 512}; pg8::StaticOrder S; S.init(T_, 2048, F.G, (int)blockIdx.x); pg8::EpiStoreI8 E{QP, 2048, HS, WPQS};
        pg8::gemm_phase<pg8::EpiStoreI8, pg8::StaticOrder, true, true, true>(F.lds, g, S, E);
    }
    SEAM(9);
    if (IN(10)) REP(10) { for (int w = F.gw; w < (T_ / 32) * 8; w += F.NGW) pk::topk_item(QP, SKB, EID, GATE, w, F.lane); }
    SEAM(10);
    {
        const int ng = F.G < 8 ? F.G : 8; const int vx = (int)blockIdx.x % ng, rank = (int)blockIdx.x / ng, nrank = (F.G - vx + ng - 1) / ng;
        const int gwv = rank * NWAVES + F.wave, ngwv = nrank * NWAVES;
        const int grp = F.lane >> 3, sub = F.lane & 7;
        int* PA = (int*)(ws + WS_PROJ);
        int* WQH = (int*)(ws + WS_KA); int* WQL = (int*)(ws + WS_KA + 4 * MiB); float* WSC = (float*)(ws + WS_KA + 8 * MiB);
        if (IN(11)) REP(11) {
            for (int s = vx; s < 8; s += ng) {
                const unsigned char* UQs = UQ + 128 * s + 16 * sub;
                int t = gwv; int4 ev[4]; int4 hq = make_int4(0, 0, 0, 0);
#pragma unroll
                for (int k = 0; k < 4; ++k) ev[k] = make_int4(0, 0, 0, 0);
                if (t < T_) {
#pragma unroll
                    for (int k = 0; k < 4; ++k) ev[k] = *(const int4*)(EID + (size_t)t * 128 + grp * 16 + 4 * k);
                    hq = *(const int4*)(H2Q + (size_t)t * 1024 + 128 * s + 16 * sub); }
                while (t < T_) {
                    const int tn = t + ngwv; int4 evn[4]; int4 hqn = make_int4(0, 0, 0, 0);
#pragma unroll
                    for (int k = 0; k < 4; ++k) evn[k] = make_int4(0, 0, 0, 0);
                    if (tn < T_) {
#pragma unroll
                        for (int k = 0; k < 4; ++k) evn[k] = *(const int4*)(EID + (size_t)tn * 128 + grp * 16 + 4 * k);
                        hqn = *(const int4*)(H2Q + (size_t)tn * 1024 + 128 * s + 16 * sub); }
                    gx::u_token(UQs, ev, hq, PA + ((size_t)s * T_ + t) * 128, F.lane);
                    t = tn; hq = hqn;
#pragma unroll
                    for (int k = 0; k < 4; ++k) ev[k] = evn[k];
                }
            }
        }
        SEAM(11);
        if (IN(12)) REP(12) {
            for (int t = F.gw; t < T_; t += F.NGW) {
                int i0 = 0, i1 = 0;
#pragma unroll
                for (int s = 0; s < 8; ++s) { const int2 p = *(const int2*)(PA + ((size_t)s * T_ + t) * 128 + 2 * F.lane); i0 += p.x; i1 += p.y; }
                const int2 e2 = *(const int2*)(EID + (size_t)t * 128 + 2 * F.lane); const float2 g2 = *(const float2*)(GATE + (size_t)t * 128 + 2 * F.lane); const float hs = HS[t];
                const float w0 = g2.x * gx::gelu_t((float)i0 * SU[e2.x] * hs) * SV[e2.x], w1 = g2.y * gx::gelu_t((float)i1 * SU[e2.y] * hs) * SV[e2.y];
                float wm = fmaxf(fabsf(w0), fabsf(w1));
#pragma unroll
                for (int o = 1; o < 64; o <<= 1) wm = fmaxf(wm, __shfl_xor(wm, o));
                const float inv = wm > 0.f ? 16256.f / wm : 0.f;
                const int q0 = (int)rintf(w0 * inv), q1 = (int)rintf(w1 * inv);
                const unsigned h2 = (unsigned)((q0 >> 7) & 255) | ((unsigned)((q1 >> 7) & 255) << 8), l2 = (unsigned)(q0 & 127) | ((unsigned)(q1 & 127) << 8);
                const unsigned h2p = __shfl_xor(h2, 1), l2p = __shfl_xor(l2, 1);
                if ((F.lane & 1) == 0) { WQH[(size_t)t * 32 + (F.lane >> 1)] = (int)(h2 | (h2p << 16)); WQL[(size_t)t * 32 + (F.lane >> 1)] = (int)(l2 | (l2p << 16)); }
                if (F.lane == 0) WSC[t] = wm * (1.f / 16256.f);
            }
        }
        SEAM(12);
        if (IN(13)) REP(13) {
            for (int s = vx; s < 8; s += ng) {
                const unsigned char* VQs = VQ + 128 * s + 16 * sub;
                int t = gwv; int4 ev[4]; int4 wh = make_int4(0, 0, 0, 0), wl = make_int4(0, 0, 0, 0); float wsc = 0.f;
#pragma unroll
                for (int k = 0; k < 4; ++k) ev[k] = make_int4(0, 0, 0, 0);
                if (t < T_) {
#pragma unroll
                    for (int k = 0; k < 4; ++k) ev[k] = *(const int4*)(EID + (size_t)t * 128 + grp * 16 + 4 * k);
                    wh = *(const int4*)(WQH + (size_t)t * 32 + grp * 4); wl = *(const int4*)(WQL + (size_t)t * 32 + grp * 4); wsc = WSC[t]; }
                while (t < T_) {
                    const int tn = t + ngwv; int4 evn[4]; int4 whn = make_int4(0, 0, 0, 0), wln = make_int4(0, 0, 0, 0); float wscn = 0.f;
#pragma unroll
                    for (int k = 0; k < 4; ++k) evn[k] = make_int4(0, 0, 0, 0);
                    if (tn < T_) {
#pragma unroll
                        for (int k = 0; k < 4; ++k) evn[k] = *(const int4*)(EID + (size_t)tn * 128 + grp * 16 + 4 * k);
                        whn = *(const int4*)(WQH + (size_t)tn * 32 + grp * 4); wln = *(const int4*)(WQL + (size_t)tn * 32 + grp * 4); wscn = WSC[tn]; }
                    float* dstrow = (PROBE_DUP == 13 && _r == 0) ? (float*)(ws + WS_XN) + (size_t)t * 1024 : out + (size_t)t * 1024;
                    gx::v_token(VQs, ev, wh, wl, wsc, MOD + (t / S_) * 6144 + 5 * 1024, out + (size_t)t * 1024, dstrow, s, F.lane);
                    t = tn; wh = whn; wl = wln; wsc = wscn;
#pragma unroll
                    for (int k = 0; k < 4; ++k) ev[k] = evn[k];
                }
            }
        }
    }
#undef IN
#undef SEAM
}

static int g_grid = 0;
static void launch_mega(const Args& base, int lo, int hi, int li, hipStream_t stream) {
    Args a = base; a.ph_lo = lo; a.ph_hi = hi; a.li = li;
    hipLaunchKernelGGL(mega_fwd, dim3(g_grid), dim3(NWAVES * 64), LDS_BYTES, stream, a);
}

extern "C" void kernel_launch(void* const* d_in, const int* in_sizes, int n_in, void* d_out, int out_size, void* d_ws, size_t ws_size, hipStream_t stream) {
    if (g_grid == 0) {
        int dev = 0, cus = 0;
        hipGetDevice(&dev); hipDeviceGetAttribute(&cus, hipDeviceAttributeMultiprocessorCount, dev);
        hipFuncSetAttribute((const void*)mega_fwd, hipFuncAttributeMaxDynamicSharedMemorySize, LDS_BYTES);
        int per_cu = 0; hipOccupancyMaxActiveBlocksPerMultiprocessor(&per_cu, (const void*)mega_fwd, NWAVES * 64, LDS_BYTES);
        (void)hipGetLastError();
        g_grid = cus > 0 ? cus : 256;
        if (per_cu < 1) fprintf(stderr, "kernel_launch: occupancy query says %d blocks/CU\n", per_cu);
    }
    const float* x = (const float*)d_in[0]; const int* positions = (const int*)d_in[2];
    const float* mla_qa_g = (const float*)d_in[7]; const float* mla_kva_g = (const float*)d_in[8];
    const float* mla_q_g = (const float*)d_in[11]; const float* mla_k_g = (const float*)d_in[12]; const float* fox_q_g = (const float*)d_in[13]; const float* fox_k_g = (const float*)d_in[14];
    const float* b_f = (const float*)d_in[15]; const float* sub_keys = (const float*)d_in[19]; const float* peer_u = (const float*)d_in[20]; const float* peer_v = (const float*)d_in[21];
    float* out = (float*)d_out; unsigned char* ws = (unsigned char*)d_ws;
    float* MOD = (float*)(ws + WS_MOD); float* FL = (float*)(ws + WS_FL); float* FCUM = (float*)(ws + WS_FCUM); float* LOGF = (float*)(ws + WS_LOGF); float2* ROPE = (float2*)(ws + WS_ROPE);
    bf16_t* XN = (bf16_t*)(ws + WS_XN); bf16_t* PROJ = (bf16_t*)(ws + WS_PROJ); bf16_t* KVRAW = (bf16_t*)(ws + WS_KVRAW); bf16_t* QA = (bf16_t*)(ws + WS_QA); bf16_t* KA = (bf16_t*)(ws + WS_KA);
    bf16_t* OB = XN; bf16_t* H2 = XN; bf16_t* QP = PROJ; int* EID = (int*)(ws + WS_QA); float* GATE = (float*)(ws + WS_QA + 16 * MiB);
    (void)x;
    hipMemsetAsync(ws + WS_CTL, 0, CTL_ZERO_BYTES, stream);
    Args base{}; for (int i = 0; i < 22; ++i) base.in[i] = d_in[i]; base.out = out; base.ws = ws;

    launch_mega(base, 0, 14, 0, stream);
}
```

```cpp
#include <hip/hip_runtime.h>
#ifndef PROBE_DUP
#define PROBE_DUP -1
#endif
#define REP(k) for (int _r = 0; _r < ((PROBE_DUP == (k)) ? 2 : 1); ++_r)
#include <cstdint>
#include <cstdio>
#include <cmath>

typedef unsigned short bf16_t;
constexpr int B_ = 4, S_ = 8192, D_ = 1024, T_ = B_ * S_;
constexpr int PP = 2304;
constexpr int C_CQ = 0, C_CKV = 384, C_KPE = 640, C_FQ = 672, C_FK = 1184, C_FV = 1696, C_FL = 2208, INW = 2216;
constexpr float EPS = 1e-6f;
constexpr float LOG2E = 1.4426950408889634f;
constexpr float C2A = 0.10206207261596577f * LOG2E;
constexpr float C2F = 0.125f * LOG2E;

__device__ __forceinline__ float bf2f(bf16_t v) { return __uint_as_float(((unsigned)v) << 16); }
__device__ __forceinline__ bf16_t f2bf(float f) { unsigned u = __float_as_uint(f); return (bf16_t)((u + 0x7fffu + ((u >> 16) & 1u)) >> 16); }
__device__ __forceinline__ unsigned pk2(float lo, float hi) { return (unsigned)f2bf(lo) | ((unsigned)f2bf(hi) << 16); }
__device__ __forceinline__ float lo2f(unsigned w) { return __uint_as_float(w << 16); }
__device__ __forceinline__ float hi2f(unsigned w) { return __uint_as_float(w & 0xffff0000u); }
__device__ __forceinline__ float wave_sum(float v) {
#pragma unroll
    for (int o = 1; o < 64; o <<= 1) v += __shfl_xor(v, o);
    return v;
}

constexpr size_t MiB = 1u << 20;
constexpr size_t WS_MOD = 1 * MiB;
constexpr size_t WS_FL = 3 * MiB;
constexpr size_t WS_FCUM = 4 * MiB;
constexpr size_t WS_LOGF = 5 * MiB;
constexpr size_t WS_ROPE = 6 * MiB;
constexpr size_t WS_XN = 88 * MiB;
constexpr size_t WS_PROJ = 152 * MiB;
constexpr size_t WS_KVRAW = 296 * MiB;
constexpr size_t WS_QA = 360 * MiB;
constexpr size_t WS_KA = 408 * MiB;

__global__ void k_mod(const float* c, const float* w_ada, const float* b_ada, float* mod) {
    const int j = blockIdx.x * 256 + threadIdx.x, b = blockIdx.y;
    float acc = b_ada[j];
    for (int k = 0; k < 1024; ++k) { const float cv = c[b * 1024 + k]; const float s = cv / (1.f + expf(-cv)); acc += s * w_ada[(size_t)k * 6144 + j]; }
    mod[b * 6144 + j] = acc;
}

__global__ void __launch_bounds__(256) k_modrows(const float* X, const float* g, const float* mod, int shift_idx, int scale_idx, bf16_t* out) {
    const int wave = threadIdx.x >> 6, lane = threadIdx.x & 63;
    const int row = blockIdx.x * 4 + wave, b = row / S_;
    const float4* xr = (const float4*)(X + (size_t)row * 1024) + lane;
    float4 v[4]; float ss = 0.f;
#pragma unroll
    for (int j = 0; j < 4; ++j) { v[j] = xr[64 * j]; ss += (v[j].x * v[j].x + v[j].y * v[j].y) + (v[j].z * v[j].z + v[j].w * v[j].w); }
    ss = wave_sum(ss);
    const float r = rsqrtf(ss * (1.f / 1024.f) + EPS);
    const float* sh = mod + b * 6144 + shift_idx * 1024; const float* sc = mod + b * 6144 + scale_idx * 1024;
#pragma unroll
    for (int j = 0; j < 4; ++j) {
        const int col = 4 * lane + 256 * j;
        const float4 g4 = *(const float4*)(g + col), s4 = *(const float4*)(sc + col), h4 = *(const float4*)(sh + col);
        const float o0 = v[j].x * r * g4.x * (1.f + s4.x) + h4.x, o1 = v[j].y * r * g4.y * (1.f + s4.y) + h4.y;
        const float o2 = v[j].z * r * g4.z * (1.f + s4.z) + h4.z, o3 = v[j].w * r * g4.w * (1.f + s4.w) + h4.w;
        uint2 w; w.x = pk2(o0, o1); w.y = pk2(o2, o3);
        *(uint2*)(out + (size_t)row * 1024 + col) = w;
    }
}

template <int MODE>
__global__ void __launch_bounds__(256) k_gemm_naive(const bf16_t* A, int lda, const float* W, int K, int N, void* Cout, int ldc, const float* aux1, const float* aux2, float* fl) {
    __shared__ float As[16][64];
    __shared__ float Ws[16][64];
    const int tx = threadIdx.x & 15, ty = threadIdx.x >> 4;
    const int m0 = blockIdx.y * 64, n0 = blockIdx.x * 64;
    float acc[4][4];
#pragma unroll
    for (int i = 0; i < 4; ++i)
#pragma unroll
        for (int j = 0; j < 4; ++j) acc[i][j] = 0.f;
    for (int k0 = 0; k0 < K; k0 += 16) {
        { const int r = threadIdx.x >> 2, kq = (threadIdx.x & 3) * 4; const uint2 a2 = *(const uint2*)(A + (size_t)(m0 + r) * lda + k0 + kq);
          As[kq + 0][r] = lo2f(a2.x); As[kq + 1][r] = hi2f(a2.x); As[kq + 2][r] = lo2f(a2.y); As[kq + 3][r] = hi2f(a2.y); }
        { const int kk = threadIdx.x >> 4, nq = (threadIdx.x & 15) * 4; float4 w4 = make_float4(0.f, 0.f, 0.f, 0.f);
          if (n0 + nq < N) w4 = *(const float4*)(W + (size_t)(k0 + kk) * N + n0 + nq);
          *(float4*)&Ws[kk][nq] = w4; }
        __syncthreads();
#pragma unroll
        for (int kk = 0; kk < 16; ++kk) {
            const float4 a4 = *(const float4*)&As[kk][ty * 4]; const float4 w4 = *(const float4*)&Ws[kk][tx * 4];
            const float a[4] = {a4.x, a4.y, a4.z, a4.w}; const float w[4] = {w4.x, w4.y, w4.z, w4.w};
#pragma unroll
            for (int i = 0; i < 4; ++i)
#pragma unroll
                for (int j = 0; j < 4; ++j) acc[i][j] += a[i] * w[j];
        }
        __syncthreads();
    }
#pragma unroll
    for (int i = 0; i < 4; ++i) {
        const int m = m0 + ty * 4 + i;
#pragma unroll
        for (int j = 0; j < 4; ++j) {
            const int n = n0 + tx * 4 + j;
            if (n < N) {
                if (MODE == 0) ((bf16_t*)Cout)[(size_t)m * ldc + n] = f2bf(acc[i][j]);
                else if (MODE == 1) { if (n < C_FL) ((bf16_t*)Cout)[(size_t)m * ldc + n] = f2bf(acc[i][j]); else fl[(size_t)m * 8 + (n - C_FL)] = acc[i][j]; }
                else { const int b = m / S_; ((float*)Cout)[(size_t)m * ldc + n] = aux1[(size_t)m * 1024 + n] + aux2[b * 6144 + 2 * 1024 + n] * acc[i][j]; }
            }
        }
    }
}

__device__ __forceinline__ void unpack8(const uint4 raw, float* v) {
    v[0] = lo2f(raw.x); v[1] = hi2f(raw.x); v[2] = lo2f(raw.y); v[3] = hi2f(raw.y); v[4] = lo2f(raw.z); v[5] = hi2f(raw.z); v[6] = lo2f(raw.w); v[7] = hi2f(raw.w);
}
struct RowPrepIn { uint4 cq, ckv, fq, fk; float fl; int pos; };
__device__ __forceinline__ void rowprep_load(RowPrepIn& R, const bf16_t* PROJ, const float* FL, const int* positions, int row, int lane) {
    const bf16_t* pr = PROJ + (size_t)row * PP;
    R.cq = lane < 48 ? *(const uint4*)(pr + C_CQ + lane * 8) : make_uint4(0u, 0u, 0u, 0u);
    R.ckv = lane < 32 ? *(const uint4*)(pr + C_CKV + lane * 8) : make_uint4(0u, 0u, 0u, 0u);
    R.fq = *(const uint4*)(pr + C_FQ + lane * 8); R.fk = *(const uint4*)(pr + C_FK + lane * 8);
    R.fl = lane < 8 ? FL[(size_t)row * 8 + lane] : 0.f; R.pos = positions[row];
}
__device__ __forceinline__ uint4 scale8(const float* v, float r, const float* g) {
    uint4 o; o.x = pk2(v[0] * r * g[0], v[1] * r * g[1]); o.y = pk2(v[2] * r * g[2], v[3] * r * g[3]); o.z = pk2(v[4] * r * g[4], v[5] * r * g[5]); o.w = pk2(v[6] * r * g[6], v[7] * r * g[7]); return o;
}
__device__ __forceinline__ void rowprep_finish(const RowPrepIn& R, bf16_t* PROJ, const float* g_qa, const float* g_kva, const float* g_fq, const float* g_fk, const float* b_f,
                                               float* LOGF, float2* ROPE, int row, int lane, float invf) {
    bf16_t* pr = PROJ + (size_t)row * PP;
    float vq[8], vk[8], v1[8], v2[8];
    unpack8(R.cq, vq); unpack8(R.ckv, vk); unpack8(R.fq, v1); unpack8(R.fk, v2);
    float sq = 0.f, sk = 0.f, s1 = 0.f, s2 = 0.f;
#pragma unroll
    for (int i = 0; i < 8; ++i) { sq += vq[i] * vq[i]; sk += vk[i] * vk[i]; s1 += v1[i] * v1[i]; s2 += v2[i] * v2[i]; }
    s1 += __shfl_xor(s1, 1); s2 += __shfl_xor(s2, 1); s1 += __shfl_xor(s1, 2); s2 += __shfl_xor(s2, 2); s1 += __shfl_xor(s1, 4); s2 += __shfl_xor(s2, 4);
#pragma unroll
    for (int o = 1; o < 64; o <<= 1) { sq += __shfl_xor(sq, o); sk += __shfl_xor(sk, o); }
    const float rq = rsqrtf(sq * (1.f / 384.f) + EPS), rk = rsqrtf(sk * (1.f / 256.f) + EPS);
    const float r1 = rsqrtf(s1 * (1.f / 64.f) + EPS) * C2F, r2 = rsqrtf(s2 * (1.f / 64.f) + EPS);
    if (lane < 48) *(uint4*)(pr + C_CQ + lane * 8) = scale8(vq, rq, g_qa + lane * 8);
    if (lane < 32) *(uint4*)(pr + C_CKV + lane * 8) = scale8(vk, rk, g_kva + lane * 8);
    *(uint4*)(pr + C_FQ + lane * 8) = scale8(v1, r1, g_fq + (lane & 7) * 8);
    *(uint4*)(pr + C_FK + lane * 8) = scale8(v2, r2, g_fk + (lane & 7) * 8);
    if (lane < 8) { const float z = R.fl + b_f[lane]; LOGF[((size_t)(row / S_) * 8 + lane) * S_ + (row % S_)] = fminf(z, 0.f) - log1pf(expf(-fabsf(z))); }
    if (lane < 16) {
        const double a = (double)((float)R.pos * invf), n = rint(a * 0.15915494309189535);
        const float red = (float)(a - n * 6.283185307179586);
        ROPE[(size_t)row * 16 + lane] = make_float2(__cosf(red), __sinf(red)); }
}
__device__ __forceinline__ void rowprep_row(bf16_t* PROJ, const float* FL, const float* g_qa, const float* g_kva, const float* g_fq, const float* g_fk, const float* b_f,
                                                 const int* positions, float* LOGF, float2* ROPE, int row, int lane) {
    const float invf = (float)exp2(-(double)(lane & 15) * (13.287712379549449 / 16.0));
    RowPrepIn R; rowprep_load(R, PROJ, FL, positions, row, lane); rowprep_finish(R, PROJ, g_qa, g_kva, g_fq, g_fk, b_f, LOGF, ROPE, row, lane, invf);
}
__global__ void __launch_bounds__(256) k_rowprep(bf16_t* PROJ, const float* FL, const float* g_qa, const float* g_kva, const float* g_fq, const float* g_fk, const float* b_f,
                                                 const int* positions, float* LOGF, float2* ROPE) {
    rowprep_row(PROJ, FL, g_qa, g_kva, g_fq, g_fk, b_f, positions, LOGF, ROPE, blockIdx.x * 4 + (threadIdx.x >> 6), threadIdx.x & 63);
}

__device__ __forceinline__ void fcum_item(const float* LOGF, float* FCUM, int item, int lane) {
    const float4* src = (const float4*)(LOGF + (size_t)item * S_ + 128 * lane);
    float4 v[32]; float tot = 0.f;
#pragma unroll
    for (int i = 0; i < 32; ++i) v[i] = src[i];
#pragma unroll
    for (int i = 0; i < 32; ++i) tot += (v[i].x + v[i].y) + (v[i].z + v[i].w);
    float incl = tot;
#pragma unroll
    for (int o = 1; o < 64; o <<= 1) { const float t = __shfl_up(incl, o); if (lane >= o) incl += t; }
    float run = incl - tot;
    float4* dst = (float4*)(FCUM + (size_t)item * S_ + 128 * lane);
#pragma unroll
    for (int i = 0; i < 32; ++i) { float4 o; run += v[i].x; o.x = run; run += v[i].y; o.y = run; run += v[i].z; o.z = run; run += v[i].w; o.w = run; dst[i] = o; }
}
__global__ void __launch_bounds__(64) k_fcum(const float* LOGF, float* FCUM) { fcum_item(LOGF, FCUM, blockIdx.x, threadIdx.x); }

struct MlaIn { uint4 qn, kn; unsigned q1, q2, k1, k2; float2 cs0, cs1; };
__device__ __forceinline__ void mlaprep_load(MlaIn& M, const bf16_t* QRAW, const bf16_t* KVRAW, const bf16_t* PROJ, const float2* ROPE, int row, int lane) {
    const int h = lane >> 3, p = lane & 7;
    const bf16_t* q = QRAW + (size_t)row * 768 + h * 96; const bf16_t* kp = PROJ + (size_t)row * PP + C_KPE;
    M.qn = *(const uint4*)(q + 8 * p); M.q1 = *(const unsigned*)(q + 64 + 2 * p); M.q2 = *(const unsigned*)(q + 80 + 2 * p);
    M.kn = *(const uint4*)(KVRAW + (size_t)row * 1024 + h * 128 + 8 * p); M.k1 = *(const unsigned*)(kp + 2 * p); M.k2 = *(const unsigned*)(kp + 16 + 2 * p);
    M.cs0 = ROPE[(size_t)row * 16 + 2 * p]; M.cs1 = ROPE[(size_t)row * 16 + 2 * p + 1];
}
__device__ __forceinline__ void mlaprep_finish(const MlaIn& M, bf16_t* QRAW, bf16_t* KA, const float* g_q, const float* g_k, int row, int lane) {
    const int h = lane >> 3, p = lane & 7;
#pragma unroll
    for (int which = 0; which < 2; ++which) {
        const float* g = which == 0 ? g_q : g_k; const float sc = which == 0 ? C2A : 1.f;
        float v[8]; unpack8(which == 0 ? M.qn : M.kn, v); const unsigned r1 = which == 0 ? M.q1 : M.k1, r2 = which == 0 ? M.q2 : M.k2;
        float a0 = lo2f(r1), a1 = hi2f(r1), b0 = lo2f(r2), b1 = hi2f(r2);
        float ss = a0 * a0 + a1 * a1 + b0 * b0 + b1 * b1;
#pragma unroll
        for (int i = 0; i < 8; ++i) ss += v[i] * v[i];
        ss += __shfl_xor(ss, 1); ss += __shfl_xor(ss, 2); ss += __shfl_xor(ss, 4);
        const float r = rsqrtf(ss * (1.f / 96.f) + EPS);
        const float* gn = g + 8 * p;
        a0 *= r * g[64 + 2 * p]; a1 *= r * g[64 + 2 * p + 1]; b0 *= r * g[80 + 2 * p]; b1 *= r * g[80 + 2 * p + 1];
        const float ra0 = a0 * M.cs0.x - b0 * M.cs0.y, rb0 = b0 * M.cs0.x + a0 * M.cs0.y, ra1 = a1 * M.cs1.x - b1 * M.cs1.y, rb1 = b1 * M.cs1.x + a1 * M.cs1.y;
        uint4 o; o.x = pk2(v[0] * r * gn[0] * sc, v[1] * r * gn[1] * sc); o.y = pk2(v[2] * r * gn[2] * sc, v[3] * r * gn[3] * sc);
        o.z = pk2(v[4] * r * gn[4] * sc, v[5] * r * gn[5] * sc); o.w = pk2(v[6] * r * gn[6] * sc, v[7] * r * gn[7] * sc);
        bf16_t* dst = (which == 0 ? QRAW : KA) + (size_t)row * 768 + h * 96;
        *(uint4*)(dst + 8 * p) = o; *(unsigned*)(dst + 64 + 2 * p) = pk2(ra0 * sc, ra1 * sc); *(unsigned*)(dst + 80 + 2 * p) = pk2(rb0 * sc, rb1 * sc);
    }
}
__device__ __forceinline__ void mlaprep_row(bf16_t* QRAW, const bf16_t* KVRAW, const bf16_t* PROJ, bf16_t* KA, const float2* ROPE, const float* g_q, const float* g_k, int row, int lane) {
    MlaIn M; mlaprep_load(M, QRAW, KVRAW, PROJ, ROPE, row, lane); mlaprep_finish(M, QRAW, KA, g_q, g_k, row, lane);
}

__global__ void __launch_bounds__(256) k_mlaprep(bf16_t* QRAW, const bf16_t* KVRAW, const bf16_t* PROJ, bf16_t* KA, const float2* ROPE, const float* g_q, const float* g_k) {
    mlaprep_row(QRAW, KVRAW, PROJ, KA, ROPE, g_q, g_k, blockIdx.x * 4 + (threadIdx.x >> 6), threadIdx.x & 63);
}

template <int DK>
__global__ void __launch_bounds__(256) k_attn_naive(const bf16_t* Q, int pq, int qstep, const bf16_t* K, int pk, int kstep, const bf16_t* V, int pv, int vstep, bf16_t* O, int po, int ostep, const float* FCUM) {
    __shared__ float Ks[64][DK];
    __shared__ float Vs[64][64];
    __shared__ float Bs[64];
    const int bh = blockIdx.x >> 5, qb = blockIdx.x & 31, b = bh >> 3, h = bh & 7;
    const int t = qb * 256 + threadIdx.x;
    const size_t row = (size_t)b * S_ + t;
    float q[DK];
#pragma unroll
    for (int c = 0; c < DK / 8; ++c) unpack8(*(const uint4*)(Q + row * pq + h * qstep + c * 8), q + c * 8);
    float o[64];
#pragma unroll
    for (int d = 0; d < 64; ++d) o[d] = 0.f;
    float m = -INFINITY, l = 0.f;
    const float fq = FCUM ? FCUM[(size_t)(b * 8 + h) * S_ + t] : 0.f;
    const int ntiles = (qb * 256 + 256) / 64;
    for (int kt = 0; kt < ntiles; ++kt) {
        __syncthreads();
        for (int c = threadIdx.x; c < 64 * (DK / 8); c += 256) { const int key = c / (DK / 8), ch = c % (DK / 8); float v[8];
            unpack8(*(const uint4*)(K + ((size_t)b * S_ + kt * 64 + key) * pk + h * kstep + ch * 8), v);
#pragma unroll
            for (int i = 0; i < 8; ++i) Ks[key][ch * 8 + i] = v[i]; }
        for (int c = threadIdx.x; c < 64 * 8; c += 256) { const int key = c >> 3, ch = c & 7; float v[8];
            unpack8(*(const uint4*)(V + ((size_t)b * S_ + kt * 64 + key) * pv + h * vstep + ch * 8), v);
#pragma unroll
            for (int i = 0; i < 8; ++i) Vs[key][ch * 8 + i] = v[i]; }
        if (threadIdx.x < 64) Bs[threadIdx.x] = FCUM ? FCUM[(size_t)(b * 8 + h) * S_ + kt * 64 + threadIdx.x] : 0.f;
        __syncthreads();
        const int kmax = t - kt * 64 + 1;
        for (int kk = 0; kk < 64; ++kk) {
            float s = 0.f;
#pragma unroll
            for (int d = 0; d < DK; ++d) s += q[d] * Ks[kk][d];
            if (FCUM) s += (fq - Bs[kk]) * LOG2E;
            if (kk < kmax) {
                const float mn = fmaxf(m, s), corr = exp2f(m - mn), p = exp2f(s - mn);
                l = l * corr + p;
#pragma unroll
                for (int d = 0; d < 64; ++d) o[d] = o[d] * corr + p * Vs[kk][d];
                m = mn;
            }
        }
    }
    const float rl = 1.f / l;
    bf16_t* op = O + row * po + h * ostep;
#pragma unroll
    for (int c = 0; c < 8; ++c) { uint4 w; w.x = pk2(o[c * 8 + 0] * rl, o[c * 8 + 1] * rl); w.y = pk2(o[c * 8 + 2] * rl, o[c * 8 + 3] * rl); w.z = pk2(o[c * 8 + 4] * rl, o[c * 8 + 5] * rl); w.w = pk2(o[c * 8 + 6] * rl, o[c * 8 + 7] * rl);
        *(uint4*)(op + c * 8) = w; }
}

__device__ __forceinline__ void topk_item(const bf16_t* QP, const float* sub_keys, int* EID, float* GATE, int w, int lane) {
    const int t = w >> 3, h = w & 7;
    float sl0 = 0.f, sl1 = 0.f; int il0 = 0, il1 = 0;
#pragma unroll
    for (int p = 0; p < 2; ++p) {
        const bf16_t* q = QP + (size_t)t * 2048 + h * 256 + p * 128;
        const float* k0 = sub_keys + ((size_t)(h * 2 + p) * 128 + lane) * 128; const float* k1 = k0 + 64 * 128;
        float s0 = 0.f, s1 = 0.f;
        for (int d = 0; d < 128; ++d) { const float qd = bf2f(q[d]); s0 += qd * k0[d]; s1 += qd * k1[d]; }
        float ls = 0.f; int li = 0;
        for (int r = 0; r < 16; ++r) {
            float bv; int bi; if (s0 >= s1) { bv = s0; bi = lane; } else { bv = s1; bi = lane + 64; }
#pragma unroll
            for (int o = 32; o >= 1; o >>= 1) { const float ov = __shfl_xor(bv, o); const int oi = __shfl_xor(bi, o); if (ov > bv || (ov == bv && oi < bi)) { bv = ov; bi = oi; } }
            if (lane == r) { ls = bv; li = bi; }
            if (bi == lane) s0 = -INFINITY; else if (bi == lane + 64) s1 = -INFINITY;
        }
        if (p == 0) { sl0 = ls; il0 = li; } else { sl1 = ls; il1 = li; }
    }
    float cv0, cv1, cv2, cv3;
    { const int c0 = lane, c1 = lane + 64, c2 = lane + 128, c3 = lane + 192;
      cv0 = __shfl(sl0, c0 >> 4) + __shfl(sl1, c0 & 15); cv1 = __shfl(sl0, c1 >> 4) + __shfl(sl1, c1 & 15);
      cv2 = __shfl(sl0, c2 >> 4) + __shfl(sl1, c2 & 15); cv3 = __shfl(sl0, c3 >> 4) + __shfl(sl1, c3 & 15); }
    float tv = -INFINITY; int tc = 0;
    for (int r = 0; r < 16; ++r) {
        float bv = cv0; int bc = lane;
        if (cv1 > bv) { bv = cv1; bc = lane + 64; }
        if (cv2 > bv) { bv = cv2; bc = lane + 128; }
        if (cv3 > bv) { bv = cv3; bc = lane + 192; }
#pragma unroll
        for (int o = 32; o >= 1; o >>= 1) { const float ov = __shfl_xor(bv, o); const int oc = __shfl_xor(bc, o); if (ov > bv || (ov == bv && oc < bc)) { bv = ov; bc = oc; } }
        if (lane == r) { tv = bv; tc = bc; }
        if (bc == lane) cv0 = -INFINITY; else if (bc == lane + 64) cv1 = -INFINITY; else if (bc == lane + 128) cv2 = -INFINITY; else if (bc == lane + 192) cv3 = -INFINITY;
    }
    const float mx = __shfl(tv, 0);
    const float e = lane < 16 ? expf(tv - mx) : 0.f;
    const float sum = wave_sum(e);
    const int e1 = __shfl(il0, (tc >> 4) & 15), e2 = __shfl(il1, tc & 15);
    if (lane < 16) { EID[(size_t)t * 128 + h * 16 + lane] = e1 * 128 + e2; GATE[(size_t)t * 128 + h * 16 + lane] = e / sum; }
}

__global__ void __launch_bounds__(256) k_topk_naive(const bf16_t* QP, const float* sub_keys, int* EID, float* GATE) { topk_item(QP, sub_keys, EID, GATE, blockIdx.x * 4 + (threadIdx.x >> 6), threadIdx.x & 63); }

__device__ __forceinline__ float gelu_tanh(float x) { const float u = 0.7978845608028654f * (x + 0.044715f * x * x * x); return 0.5f * x * (1.f + tanhf(u)); }

__device__ __forceinline__ void gather_item(const bf16_t* H2, const int* EID, const float* GATE, const float* peer_u, const float* peer_v, const float* mod, float* out, int t, int lane) {
    const int b = t / S_;
    float hv[16], y[16];
#pragma unroll
    for (int j = 0; j < 4; ++j) { const uint2 raw = *(const uint2*)(H2 + (size_t)t * 1024 + 4 * lane + 256 * j); hv[4 * j] = lo2f(raw.x); hv[4 * j + 1] = hi2f(raw.x); hv[4 * j + 2] = lo2f(raw.y); hv[4 * j + 3] = hi2f(raw.y); }
#pragma unroll
    for (int i = 0; i < 16; ++i) y[i] = 0.f;
    const int e_a = EID[(size_t)t * 128 + lane], e_b = EID[(size_t)t * 128 + 64 + lane];
    const float g_a = GATE[(size_t)t * 128 + lane], g_b = GATE[(size_t)t * 128 + 64 + lane];
    for (int jj = 0; jj < 128; ++jj) {
        const int e = jj < 64 ? __shfl(e_a, jj) : __shfl(e_b, jj - 64);
        const float g = jj < 64 ? __shfl(g_a, jj) : __shfl(g_b, jj - 64);
        const float4* ur = (const float4*)(peer_u + (size_t)e * 1024) + lane;
        float s = 0.f;
#pragma unroll
        for (int j = 0; j < 4; ++j) { const float4 u4 = ur[64 * j]; s += (u4.x * hv[4 * j] + u4.y * hv[4 * j + 1]) + (u4.z * hv[4 * j + 2] + u4.w * hv[4 * j + 3]); }
        s = wave_sum(s);
        const float wgt = g * gelu_tanh(s);
        const float4* vr = (const float4*)(peer_v + (size_t)e * 1024) + lane;
#pragma unroll
        for (int j = 0; j < 4; ++j) { const float4 v4 = vr[64 * j]; y[4 * j] += wgt * v4.x; y[4 * j + 1] += wgt * v4.y; y[4 * j + 2] += wgt * v4.z; y[4 * j + 3] += wgt * v4.w; }
    }
    const float* g2 = mod + b * 6144 + 5 * 1024;
#pragma unroll
    for (int j = 0; j < 4; ++j) { const int col = 4 * lane + 256 * j; float4* op = (float4*)(out + (size_t)t * 1024 + col); float4 x1 = *op; const float4 gg = *(const float4*)(g2 + col);
        x1.x += gg.x * y[4 * j]; x1.y += gg.y * y[4 * j + 1]; x1.z += gg.z * y[4 * j + 2]; x1.w += gg.w * y[4 * j + 3]; *op = x1; }
}
__global__ void __launch_bounds__(256) k_gather_naive(const bf16_t* H2, const int* EID, const float* GATE, const float* peer_u, const float* peer_v, const float* mod, float* out) {
    gather_item(H2, EID, GATE, peer_u, peer_v, mod, out, blockIdx.x * 4 + (threadIdx.x >> 6), threadIdx.x & 63);
}


namespace pg8 {
#define PG8_LAS __attribute__((address_space(3)))
typedef unsigned short bf16_t;
typedef short bf16x8 __attribute__((ext_vector_type(8)));
typedef float f32x4 __attribute__((ext_vector_type(4)));
typedef unsigned u32x4 __attribute__((ext_vector_type(4)));
constexpr int BM = 256, BK = 64, HALF = 128, HTB = HALF * BK * 2  , STAGE_BYTES = 8 * HTB, NXCD = 8, WGM = 8;

__host__ __device__ __forceinline__ int lds_byte(int r, int c) { const int st = (r >> 4) * 2 + (c >> 5), rr = r & 15, cc = c & 31, ob = rr * 64 + cc * 2; return st * 1024 + (ob ^ (((ob >> 9) & 1) << 5)); }
__host__ __device__ __forceinline__ void stage_rc(int b, int& R, int& C) { const int st = b / 1024, sb = b % 1024, swz = sb ^ (((sb >> 9) & 1) << 5); R = (st >> 1) * 16 + swz / 64; C = (st & 1) * 32 + (swz % 64) / 2; }
__host__ __device__ __forceinline__ int perm32(int rho) { const int n = rho >> 4, i = rho & 15; return 8 * (i >> 2) + 4 * n + (i & 3); }

struct Unit { int pm, pn; };
struct Gemm { const bf16_t* A; const bf16_t* Bt; int M, N, K, lda; };

struct StaticOrder {
    int nM, nN, nwg, G, c;
    __host__ __device__ void init(int M, int N, int G_, int c_) { nM = M / BM; nN = N / BM; nwg = nM * nN; G = G_; c = c_; }
    __host__ __device__ bool next(int i, Unit& u) const {
        const long L = (long)i * G + c; if (L >= nwg) return false;
        int wgid = (int)L; { const int q = nwg / NXCD, r = nwg % NXCD, xcd = wgid % NXCD, off = wgid / NXCD; wgid = (xcd < r ? xcd * (q + 1) : r * (q + 1) + (xcd - r) * q) + off; }
        const int nig = WGM * nN, gid = wgid / nig, fm = gid * WGM, gsz = (nM - fm) < WGM ? (nM - fm) : WGM;
        u.pm = fm + ((wgid % nig) % gsz); u.pn = (wgid % nig) / gsz; return true;
    }
    __device__ __forceinline__ void a_ready(const Unit&) const {}
    __device__ __forceinline__ void done(const Unit&) const {}
};
__device__ __forceinline__ unsigned cvt_pk_bf16(float lo, float hi) { unsigned r; asm volatile("v_cvt_pk_bf16_f32 %0, %1, %2" : "=v"(r) : "v"(lo), "v"(hi)); return r; }
typedef float f32x2 __attribute__((ext_vector_type(2)));
typedef int i32x4 __attribute__((ext_vector_type(4)));
template <bool I8> struct AccT { typedef f32x4 type; };
template <> struct AccT<true> { typedef i32x4 type; };
__device__ __forceinline__ f32x4 mma16(const bf16x8 b, const bf16x8 a, const f32x4 c) { return __builtin_amdgcn_mfma_f32_16x16x32_bf16(b, a, c, 0, 0, 0); }
__device__ __forceinline__ i32x4 mma16(const bf16x8 b, const bf16x8 a, const i32x4 c) { return __builtin_amdgcn_mfma_i32_16x16x64_i8(__builtin_bit_cast(i32x4, b), __builtin_bit_cast(i32x4, a), c, 0, 0, 0); }
template <class Epi, class Sched, bool ALIGN_EPI = false, bool SP2 = false, bool I8 = false>
__device__ __forceinline__ void gemm_phase(PG8_LAS unsigned char* lds, const Gemm g, const Sched& S, const Epi& E) {
    const int tid = threadIdx.x, wid = __builtin_amdgcn_readfirstlane(tid >> 6), lane = tid & 63, wr = wid >> 2, wc = wid & 3, fr = lane & 15, fq = lane >> 4;
    const int K = g.K, nt = K / BK;
    unsigned voffA[2], voffB[2];
#pragma unroll
    for (int i = 0; i < 2; ++i) { int R, C; stage_rc(tid * 16 + i * 8192, R, C); const int Rb = Epi::PERM ? ((R & ~31) + perm32(R & 31)) : R;
        voffA[i] = (unsigned)(R * g.lda + C) * 2u; voffB[i] = (unsigned)(Rb * K + C) * 2u; }
    const size_t kstep = (size_t)(BK * 2);
    const size_t hstepA = (size_t)HALF * g.lda * 2, hstepB = (size_t)HALF * K * 2;
    const size_t tstepA = 2 * hstepA, tstepB = 2 * hstepB;
    const unsigned ldsw = (unsigned)wid * 1024u;
    const int aoff = lds_byte(wr * 64 + fr, fq * 8), boff = lds_byte(wc * 32 + fr, fq * 8);
#define PG8_SA(b, h) (((b) * 2 + (h)) * HTB)
#define PG8_SB(b, h) ((4 + (b) * 2 + (h)) * HTB)
#define PG8_STAGE(bufoff, gbase, voff) do { _Pragma("unroll") for (int _i = 0; _i < 2; ++_i) \
        __builtin_amdgcn_global_load_lds((const unsigned*)((const char*)(gbase) + (voff)[_i]), (PG8_LAS unsigned*)(lds + (bufoff) + ldsw + _i * 8192), 16, 0, 0); } while (0)
#define PG8_LDA(dst, b, h) do { _Pragma("unroll") for (int m = 0; m < 4; ++m) _Pragma("unroll") for (int k = 0; k < 2; ++k) dst[m][k] = *(const PG8_LAS bf16x8*)(lds + PG8_SA(b, h) + aoff + m * 2048 + k * 1024); } while (0)
#define PG8_LDB(dst, b, h) do { _Pragma("unroll") for (int n = 0; n < 2; ++n) _Pragma("unroll") for (int k = 0; k < 2; ++k) dst[n][k] = *(const PG8_LAS bf16x8*)(lds + PG8_SB(b, h) + boff + n * 2048 + k * 1024); } while (0)
#define PG8_MMA(ai, bj, At, Bt) do { __builtin_amdgcn_s_setprio(1); _Pragma("unroll") for (int m = 0; m < 4; ++m) _Pragma("unroll") for (int n = 0; n < 2; ++n) _Pragma("unroll") for (int k = 0; k < 2; ++k) \
        acc[ai][bj][m][n] = mma16(Bt[n][k], At[m][k], acc[ai][bj][m][n]); __builtin_amdgcn_s_setprio(0); } while (0)
#define PG8_WAIT_V(n) asm volatile("s_waitcnt vmcnt(" #n ")" ::: "memory")
#define PG8_WAIT_L(n) asm volatile("s_waitcnt lgkmcnt(" #n ")" ::: "memory")
#define PG8_BAR __builtin_amdgcn_s_barrier()
#define PG8_SCHED __builtin_amdgcn_sched_barrier(0)
    Unit cur, nxt; int ui = 0;
    if (!S.next(0, cur)) return;
    typedef typename AccT<I8>::type accv; accv acc[2][2][4][2];
#pragma unroll
    for (int a = 0; a < 2; ++a)
#pragma unroll
        for (int b = 0; b < 2; ++b)
#pragma unroll
            for (int m = 0; m < 4; ++m)
#pragma unroll
                for (int n = 0; n < 2; ++n) acc[a][b][m][n] = accv{};
    bf16x8 At[4][2], B0[2][2], B1[2][2];
    const char* cA = (const char*)g.A + (size_t)cur.pm * tstepA; const char* cB = (const char*)g.Bt + (size_t)cur.pn * tstepB;
    S.a_ready(cur);
    if constexpr (SP2) {
        PG8_STAGE(PG8_SB(0, 0), cB, voffB); PG8_STAGE(PG8_SB(0, 1), cB + hstepB, voffB); PG8_STAGE(PG8_SA(0, 0), cA, voffA); PG8_STAGE(PG8_SA(0, 1), cA + hstepA, voffA);
        if (wr == 1) PG8_BAR;
        PG8_WAIT_V(2); PG8_BAR;
        PG8_STAGE(PG8_SB(1, 0), cB + kstep, voffB); PG8_STAGE(PG8_SA(1, 0), cA + kstep, voffA); PG8_STAGE(PG8_SB(1, 1), cB + hstepB + kstep, voffB);
        PG8_WAIT_V(6); PG8_BAR;
    } else {
        PG8_STAGE(PG8_SB(0, 0), cB, voffB); PG8_STAGE(PG8_SA(0, 0), cA, voffA); PG8_STAGE(PG8_SB(0, 1), cB + hstepB, voffB); PG8_STAGE(PG8_SA(0, 1), cA + hstepA, voffA);
        if (wr == 1) PG8_BAR;
        PG8_WAIT_V(4); PG8_BAR;
        PG8_STAGE(PG8_SB(1, 0), cB + kstep, voffB); PG8_STAGE(PG8_SA(1, 0), cA + kstep, voffA); PG8_STAGE(PG8_SB(1, 1), cB + hstepB + kstep, voffB);
        PG8_WAIT_V(6); PG8_BAR;
    }
    for (;;) {
        const bool has_next = S.next(ui + 1, nxt);
        const char* nA = has_next ? (const char*)g.A + (size_t)nxt.pm * tstepA : cA; const char* nB = has_next ? (const char*)g.Bt + (size_t)nxt.pn * tstepB : cB;
        for (int t = 0; t < nt; t += 2) {
            const bool last = (t == nt - 2);
            const char* a1 = cA + (size_t)(t + 1) * kstep;
            const char* a2 = last ? nA : cA + (size_t)(t + 2) * kstep; const char* b2 = last ? nB : cB + (size_t)(t + 2) * kstep;
            const char* a3 = a2 + kstep; const char* b3 = b2 + kstep;
            if (last && has_next) S.a_ready(nxt);
            if constexpr (SP2) {
            PG8_LDB(B0, 0, 0); PG8_LDB(B1, 0, 1); PG8_SCHED; PG8_LDA(At, 0, 0); PG8_STAGE(PG8_SA(1, 1), a1 + hstepA, voffA);
            PG8_WAIT_V(8); PG8_WAIT_L(0); PG8_BAR; PG8_MMA(0, 0, At, B0); PG8_MMA(0, 1, At, B1); PG8_BAR; PG8_SCHED;
            PG8_LDA(At, 0, 1); PG8_STAGE(PG8_SB(0, 0), b2, voffB); PG8_STAGE(PG8_SB(0, 1), b2 + hstepB, voffB); PG8_STAGE(PG8_SA(0, 0), a2, voffA);
            PG8_WAIT_V(8); PG8_WAIT_L(0); PG8_BAR; PG8_MMA(1, 0, At, B0); PG8_MMA(1, 1, At, B1); PG8_BAR; PG8_SCHED;
            PG8_LDB(B0, 1, 0); PG8_LDB(B1, 1, 1); PG8_SCHED; PG8_LDA(At, 1, 0); PG8_STAGE(PG8_SA(0, 1), a2 + hstepA, voffA);
            PG8_WAIT_V(8); PG8_WAIT_L(0); PG8_BAR; PG8_MMA(0, 0, At, B0); PG8_MMA(0, 1, At, B1); PG8_BAR; PG8_SCHED;
            PG8_LDA(At, 1, 1); PG8_STAGE(PG8_SB(1, 0), b3, voffB); PG8_STAGE(PG8_SB(1, 1), b3 + hstepB, voffB); PG8_STAGE(PG8_SA(1, 0), a3, voffA);
            PG8_WAIT_V(8); PG8_WAIT_L(0); PG8_BAR; PG8_MMA(1, 0, At, B0); PG8_MMA(1, 1, At, B1); PG8_BAR; PG8_SCHED;
            } else {
            PG8_LDB(B0, 0, 0); PG8_SCHED; PG8_LDA(At, 0, 0); PG8_STAGE(PG8_SA(1, 1), a1 + hstepA, voffA);
            PG8_WAIT_L(8); PG8_BAR; PG8_WAIT_L(0); PG8_MMA(0, 0, At, B0); PG8_BAR; PG8_SCHED;
            PG8_LDB(B1, 0, 1); PG8_STAGE(PG8_SB(0, 0), b2, voffB);
            PG8_BAR; PG8_WAIT_L(0); PG8_MMA(0, 1, At, B1); PG8_BAR;
            PG8_LDA(At, 0, 1); PG8_STAGE(PG8_SA(0, 0), a2, voffA);
            PG8_BAR; PG8_WAIT_L(0); PG8_MMA(1, 0, At, B0); PG8_BAR; PG8_SCHED;
            PG8_STAGE(PG8_SB(0, 1), b2 + hstepB, voffB);
            PG8_WAIT_V(6); PG8_BAR; PG8_MMA(1, 1, At, B1); PG8_BAR;
            PG8_LDB(B0, 1, 0); PG8_SCHED; PG8_LDA(At, 1, 0); PG8_STAGE(PG8_SA(0, 1), a2 + hstepA, voffA);
            PG8_WAIT_L(8); PG8_BAR; PG8_WAIT_L(0); PG8_MMA(0, 0, At, B0); PG8_BAR; PG8_SCHED;
            PG8_LDB(B1, 1, 1); PG8_STAGE(PG8_SB(1, 0), b3, voffB);
            PG8_BAR; PG8_WAIT_L(0); PG8_MMA(0, 1, At, B1); PG8_BAR;
            PG8_LDA(At, 1, 1); PG8_STAGE(PG8_SA(1, 0), a3, voffA);
            PG8_BAR; PG8_WAIT_L(0); PG8_MMA(1, 0, At, B0); PG8_BAR; PG8_SCHED;
            PG8_STAGE(PG8_SB(1, 1), b3 + hstepB, voffB);
            PG8_WAIT_V(6); PG8_BAR; PG8_MMA(1, 1, At, B1); PG8_BAR;
            }
        }
        if constexpr (ALIGN_EPI) { if (wr == 0) PG8_BAR; }
        if constexpr (!Epi::AFTER_DRAIN) { E(acc, cur, wr, wc, fr, fq); S.done(cur); }
        if (!has_next) break;
#pragma unroll
        for (int a = 0; a < 2; ++a)
#pragma unroll
            for (int b = 0; b < 2; ++b)
#pragma unroll
                for (int m = 0; m < 4; ++m)
#pragma unroll
                    for (int n = 0; n < 2; ++n) acc[a][b][m][n] = accv{};
        cur = nxt; cA = nA; cB = nB; ++ui;
        if constexpr (ALIGN_EPI) { if (wr == 1) PG8_BAR; }
    }
    PG8_WAIT_V(0);
    if constexpr (!ALIGN_EPI) { if (wr == 0) PG8_BAR; }
    PG8_BAR;
    if constexpr (Epi::AFTER_DRAIN) { E.fused(acc, cur, wr, wc, fr, fq, lds, wid, lane); S.done(cur); }
#undef PG8_SA
#undef PG8_SB
#undef PG8_STAGE
#undef PG8_LDA
#undef PG8_LDB
#undef PG8_MMA
#undef PG8_WAIT_V
#undef PG8_WAIT_L
#undef PG8_BAR
#undef PG8_SCHED
}
}


#define GAS __attribute__((address_space(1)))
#define LAS __attribute__((address_space(3)))
typedef float f32x4 __attribute__((ext_vector_type(4)));
typedef unsigned u32x4 __attribute__((ext_vector_type(4)));
#define XB_TMO      128
#define XB_XCNT(j)  (256  + 64 * (j))
#define XB_XSUB(j)  (1280 + 64 * (j))
#define XB_XGEN(j)  (2304 + 64 * (j))
#define XB_TOP      3328
#define XB_TOPGEN   3392
#define XCD_BAR_WORDS 3456
#define XB_SPIN_CAP (1u << 18)

__device__ __forceinline__ unsigned xb_ld(unsigned* p)              { return __hip_atomic_load(p, __ATOMIC_RELAXED, __HIP_MEMORY_SCOPE_AGENT); }
__device__ __forceinline__ unsigned xb_add(unsigned* p, unsigned v) { return __hip_atomic_fetch_add(p, v, __ATOMIC_RELAXED, __HIP_MEMORY_SCOPE_AGENT); }
__device__ __forceinline__ unsigned xb_xcc_id() { return (unsigned)__builtin_amdgcn_s_getreg((3 << 11) | 20) & 0xFu; }
#define XB_SPIN(cond, bar) do { unsigned _sp = 0; while (cond) { __builtin_amdgcn_s_sleep(1); \
    if ((++_sp & 255u) == 0u) { if (xb_ld(&(bar)[XB_TMO])) break; if (_sp > XB_SPIN_CAP) { atomicAdd(&(bar)[XB_TMO], 1u); break; } } } } while (0)

struct XcdBarrier {
    unsigned* bar; unsigned x;
    volatile LAS unsigned* st;
};

__device__ __forceinline__ XcdBarrier xcd_barrier_post(unsigned* bar, volatile LAS unsigned* st) {
    XcdBarrier b; b.bar = bar; b.x = xb_xcc_id(); b.st = st;
    if (threadIdx.x == 0) (void)xb_add(&bar[XB_XCNT(b.x)], 1u);
    return b;
}
__device__ __forceinline__ void xcd_barrier_complete(unsigned* bar, unsigned x, unsigned& nloc, unsigned& nx) {
    const unsigned G = gridDim.x * gridDim.y * gridDim.z;
    unsigned sum, cnt, mine, sp = 0u;
    for (;;) {
        sum = 0u; cnt = 0u; mine = 0u;
#pragma unroll
        for (unsigned j = 0; j < 16; ++j) { const unsigned c = xb_ld(&bar[XB_XCNT(j)]); sum += c; cnt += (c > 0u) ? 1u : 0u; mine = (j == x) ? c : mine; }
        if (sum == G) break;
        __builtin_amdgcn_s_sleep(1);
        if ((++sp & 255u) == 0u) { if (xb_ld(&bar[XB_TMO])) break; if (sp > XB_SPIN_CAP) { atomicAdd(&bar[XB_TMO], 1u); break; } }
    }
    nloc = mine > 0u ? mine : 1u; nx = cnt > 0u ? cnt : 1u;
}

__device__ __forceinline__ void xcd_barrier(const XcdBarrier& b) {
    asm volatile("s_waitcnt vmcnt(0)" ::: "memory");
    __syncthreads();
    if (threadIdx.x == 0) {
        unsigned* bar = b.bar;
        __builtin_amdgcn_s_waitcnt(0);
        unsigned nloc = b.st[0], nx = b.st[1];
        if (nloc == 0u) { xcd_barrier_complete(bar, b.x, nloc, nx); b.st[0] = nloc; b.st[1] = nx; }
        const unsigned old = xb_add(&bar[XB_XSUB(b.x)], 1u);
        const unsigned gen = old / nloc;
        if (old + 1u == (gen + 1u) * nloc) {
            __builtin_amdgcn_fence(__ATOMIC_RELEASE, "agent");
            asm volatile("s_waitcnt vmcnt(0)" ::: "memory");
            const unsigned og = xb_add(&bar[XB_TOP], 1u);
            const unsigned tg = og / nx;
            if (og + 1u == (tg + 1u) * nx) xb_add(&bar[XB_TOPGEN], 1u);
            else XB_SPIN(xb_ld(&bar[XB_TOPGEN]) == tg, bar);
            __builtin_amdgcn_fence(__ATOMIC_ACQUIRE, "agent");
            xb_add(&bar[XB_XGEN(b.x)], 1u);
            asm volatile("s_waitcnt vmcnt(0)" ::: "memory");
        } else {
            XB_SPIN(xb_ld(&bar[XB_XGEN(b.x)]) == gen, bar);
            __builtin_amdgcn_fence(__ATOMIC_ACQUIRE, "agent");
            asm volatile("s_waitcnt vmcnt(0)" ::: "memory");
        }
    }
    __syncthreads();
}


constexpr int NWAVES = 8;
constexpr int RING_BYTES = 131072, LDSCTL_OFF = RING_BYTES, MISC_OFF = LDSCTL_OFF + 320, LDS_BYTES = 147456;
constexpr size_t WS_CTL = 0, CTL_ZERO_BYTES = 1 * MiB;
constexpr int CW_BAR = 4096, N_BAR_REGIONS = 16;
static_assert((CW_BAR + N_BAR_REGIONS * XCD_BAR_WORDS) * 4 <= (int)CTL_ZERO_BYTES, "barrier words inside the memset region");
constexpr size_t WS_WIN = 10 * MiB;
constexpr size_t WS_WUQ = 15 * MiB;
constexpr size_t WS_WUKV = 16 * MiB;
constexpr size_t WS_WO = 17 * MiB;
constexpr size_t WS_WPQ = 19 * MiB;
constexpr size_t WS_SK = 23 * MiB;
constexpr size_t WS_U16 = 24 * MiB;
constexpr size_t WS_V16 = 56 * MiB;


namespace att {
typedef short bf16x8 __attribute__((ext_vector_type(8)));
typedef short s16x4 __attribute__((ext_vector_type(4)));
typedef float f32x16 __attribute__((ext_vector_type(16)));
constexpr int LK = 0, KSLOT = 12288, LV = 2 * KSLOT, VSLOT = 8192, LB = LV + 2 * VSLOT, BSLOT = 256, LWS = LB + 2 * BSLOT, LOST = LWS + 8 * 256, ATT_LDS = LOST + 8 * 4096;
static_assert(ATT_LDS <= 131072, "attention scratch fits the ring region");
struct Desc { const bf16_t* Q; int pq; const bf16_t* K; int pk; const bf16_t* V; int pv; bf16_t* O; int po; const float* FC; };

__device__ __forceinline__ int crow(int r, int hi) { return (r & 3) + 8 * (r >> 2) + 4 * hi; }
__device__ __forceinline__ float xmax32(float v) { auto rr = __builtin_amdgcn_permlane32_swap(__float_as_uint(v), __float_as_uint(v), false, false); return fmaxf(__uint_as_float(rr[0]), __uint_as_float(rr[1])); }
__device__ __forceinline__ float xsum32(float v) { auto rr = __builtin_amdgcn_permlane32_swap(__float_as_uint(v), __float_as_uint(v), false, false); return __uint_as_float(rr[0]) + __uint_as_float(rr[1]); }
__device__ __forceinline__ unsigned cvtpk(float lo, float hi) { typedef float f2 __attribute__((ext_vector_type(2))); typedef __bf16 b2 __attribute__((ext_vector_type(2))); f2 v = {lo, hi}; b2 b = __builtin_convertvector(v, b2); return __builtin_bit_cast(unsigned, b); }
typedef short v4i16_t __attribute__((ext_vector_type(4)));
__device__ __forceinline__ s16x4 vtr(LAS const unsigned char* p) { return __builtin_bit_cast(s16x4, __builtin_amdgcn_ds_read_tr16_b64_v4i16((LAS v4i16_t*)p)); }

template <int KS, bool BIAS>
__device__ __forceinline__ void attn_unit(const Desc& d, int qb, int j0, LAS unsigned char* shm) {
    const int tid = threadIdx.x, lane = tid & 63, r32 = lane & 31, hi = lane >> 5; const int wid = __builtin_amdgcn_readfirstlane(tid >> 6);
    const int q0 = qb * 256, NT = (q0 + 256) / 64;
    LAS float* wsf = (LAS float*)(shm + LWS) + wid * 64;
    bf16x8 qr[KS];
    { const bf16_t* qp = d.Q + (size_t)(q0 + wid * 32 + r32) * d.pq + hi * 8;
#pragma unroll
      for (int d0 = 0; d0 < KS; ++d0) qr[d0] = *(const bf16x8*)(qp + d0 * 16); }
    const float fcref = BIAS ? d.FC[q0] : 0.f;
    const bf16_t* ksrc0 = d.K + (size_t)lane * d.pk + wid * 8;
    const bf16_t* ksrc1 = d.K + (size_t)lane * d.pk + (8 + wid) * 8;
    const bf16_t* vsrc = d.V + (size_t)(16 * (wid & 3) + (lane >> 2)) * d.pv + (wid >> 2) * 32 + (lane & 3) * 8;
    const int kdst0 = LK + wid * 1024 + lane * 16, kdst1 = LK + (8 + wid) * 1024 + lane * 16, vdst = LV + wid * 1024 + lane * 16;
    const bool k2 = (KS > 4) && (wid < 2 * KS - 8);
    u32x4 kr0, kr1, vr; float br = 0.f;
#define ATT_LOAD(t) do { kr0 = *(const u32x4*)(ksrc0 + (size_t)(t) * 64 * d.pk); if (k2) kr1 = *(const u32x4*)(ksrc1 + (size_t)(t) * 64 * d.pk); \
        vr = *(const u32x4*)(vsrc + (size_t)(t) * 64 * d.pv); if (BIAS && wid == 4) br = d.FC[(t) * 64 + lane]; } while (0)
#define ATT_WRITE(slot) do { *(LAS u32x4*)(shm + kdst0 + (slot) * KSLOT) = kr0; if (k2) *(LAS u32x4*)(shm + kdst1 + (slot) * KSLOT) = kr1; \
        *(LAS u32x4*)(shm + vdst + (slot) * VSLOT) = vr; if (BIAS && wid == 4) *(LAS float*)(shm + LB + (slot) * BSLOT + lane * 4) = (fcref - br) * LOG2E; } while (0)
    f32x16 o0, o1, negm;
#pragma unroll
    for (int r = 0; r < 16; ++r) { o0[r] = 0.f; o1[r] = 0.f; negm[r] = 0.f; }
    float mref = 0.f, l = 0.f;
    constexpr float THR = BIAS ? 40.f : 8.f;
    const int qrel = wid * 32 + r32;
    const int kfrag = LK + hi * 1024 + r32 * 16;
    const int vfrag = LV + ((lane >> 4) & 1) * 32 + (lane & 3) * 8 + (4 * hi + ((lane & 15) >> 2)) * 64;
    ATT_LOAD(j0); ATT_WRITE(0);
    __syncthreads();
    for (int t = j0; t < NT; ++t) {
        const int slot = (t - j0) & 1;
        if (t + 1 < NT) ATT_LOAD(t + 1);
        const int jb = t - (NT - 4);
        if (!(jb >= 0 && 64 * jb > 32 * wid + 31)) {
            f32x16 p0, p1;
            if (BIAS) {
                LAS const unsigned char* bp = shm + LB + slot * BSLOT + 16 * hi;
#pragma unroll
                for (int g = 0; g < 4; ++g) { const f32x4 a = *(LAS const f32x4*)(bp + 32 * g), b = *(LAS const f32x4*)(bp + 128 + 32 * g);
#pragma unroll
                    for (int i = 0; i < 4; ++i) { p0[4 * g + i] = a[i] + negm[4 * g + i]; p1[4 * g + i] = b[i] + negm[4 * g + i]; } }
            } else { p0 = negm; p1 = negm; }
            LAS const unsigned char* kp = shm + kfrag + slot * KSLOT;
            __builtin_amdgcn_s_setprio(1);
#pragma unroll
            for (int d0 = 0; d0 < KS; ++d0) {
                const bf16x8 a0 = *(LAS const bf16x8*)(kp + d0 * 2048), a1 = *(LAS const bf16x8*)(kp + d0 * 2048 + 512);
                p0 = __builtin_amdgcn_mfma_f32_32x32x16_bf16(a0, qr[d0], p0, 0, 0, 0);
                p1 = __builtin_amdgcn_mfma_f32_32x32x16_bf16(a1, qr[d0], p1, 0, 0, 0);
            }
            __builtin_amdgcn_s_setprio(0);
            if (jb >= 0) {
                const int kb = 64 * jb + 4 * hi;
#pragma unroll
                for (int r = 0; r < 16; ++r) { const int kv = kb + (r & 3) + 8 * (r >> 2); if (kv > qrel) p0[r] = -INFINITY; if (kv + 32 > qrel) p1[r] = -INFINITY; }
            }
            float ra = __builtin_fmaxf(__builtin_fmaxf(p0[0], p0[1]), p1[0]), rb = __builtin_fmaxf(__builtin_fmaxf(p0[2], p0[3]), p1[1]);
            ra = __builtin_fmaxf(__builtin_fmaxf(ra, p1[2]), p1[3]);
#pragma unroll
            for (int r = 4; r < 16; r += 4) { ra = __builtin_fmaxf(__builtin_fmaxf(ra, p0[r]), p0[r + 1]); rb = __builtin_fmaxf(__builtin_fmaxf(rb, p0[r + 2]), p0[r + 3]);
                ra = __builtin_fmaxf(__builtin_fmaxf(ra, p1[r]), p1[r + 1]); rb = __builtin_fmaxf(__builtin_fmaxf(rb, p1[r + 2]), p1[r + 3]); }
            const float rm = xmax32(__builtin_fmaxf(ra, rb));
            if (__any(rm > THR) || t == j0) {
                const float dl = t == j0 ? rm : __builtin_fmaxf(rm, 0.f);
                mref += dl;
#pragma unroll
                for (int r = 0; r < 16; ++r) { p0[r] -= dl; p1[r] -= dl; negm[r] = -mref; }
                if (t != j0) {
                    const float alpha = __builtin_amdgcn_exp2f(-dl);
                    l *= alpha;
                    if (hi == 0) wsf[r32] = alpha;
#pragma unroll
                    for (int g = 0; g < 4; ++g) { const f32x4 a = *(LAS const f32x4*)(wsf + 8 * g + 4 * hi);
#pragma unroll
                        for (int i = 0; i < 4; ++i) { o0[4 * g + i] *= a[i]; o1[4 * g + i] *= a[i]; } }
                }
            }
            float s0 = 0.f, s1 = 0.f, s2 = 0.f, s3 = 0.f;
#pragma unroll
            for (int r = 0; r < 16; r += 2) { p0[r] = __builtin_amdgcn_exp2f(p0[r]); p0[r + 1] = __builtin_amdgcn_exp2f(p0[r + 1]); p1[r] = __builtin_amdgcn_exp2f(p1[r]); p1[r + 1] = __builtin_amdgcn_exp2f(p1[r + 1]);
                s0 += p0[r]; s1 += p0[r + 1]; s2 += p1[r]; s3 += p1[r + 1]; }
            l += (s0 + s1) + (s2 + s3);
            LAS const unsigned char* vp = shm + vfrag + slot * VSLOT;
            __builtin_amdgcn_s_setprio(1);
#pragma unroll
            for (int ks = 0; ks < 4; ++ks) {
                const f32x16& pp = ks < 2 ? p0 : p1; const int bq = (ks & 1) * 8;
                u32x4 pw; pw.x = cvtpk(pp[bq], pp[bq + 1]); pw.y = cvtpk(pp[bq + 2], pp[bq + 3]); pw.z = cvtpk(pp[bq + 4], pp[bq + 5]); pw.w = cvtpk(pp[bq + 6], pp[bq + 7]);
                const bf16x8 pa = __builtin_bit_cast(bf16x8, pw);
                const s16x4 l0 = vtr(vp + ks * 1024), h0 = vtr(vp + ks * 1024 + 512), l1 = vtr(vp + 4096 + ks * 1024), h1 = vtr(vp + 4096 + ks * 1024 + 512);
                const bf16x8 v0 = {l0[0], l0[1], l0[2], l0[3], h0[0], h0[1], h0[2], h0[3]}, v1 = {l1[0], l1[1], l1[2], l1[3], h1[0], h1[1], h1[2], h1[3]};
                o0 = __builtin_amdgcn_mfma_f32_32x32x16_bf16(pa, v0, o0, 0, 0, 0);
                o1 = __builtin_amdgcn_mfma_f32_32x32x16_bf16(pa, v1, o1, 0, 0, 0);
            }
            __builtin_amdgcn_s_setprio(0);
        }
        if (t + 1 < NT) ATT_WRITE(slot ^ 1);
        __syncthreads();
    }
#undef ATT_LOAD
#undef ATT_WRITE
    l = xsum32(l);
    if (hi == 0) wsf[32 + r32] = l;
    float rli[16];
#pragma unroll
    for (int g = 0; g < 4; ++g) { const f32x4 a = *(LAS const f32x4*)(wsf + 32 + 8 * g + 4 * hi);
#pragma unroll
        for (int i = 0; i < 4; ++i) rli[4 * g + i] = 1.f / a[i]; }
    LAS bf16_t* stg = (LAS bf16_t*)(shm + LOST) + wid * 2048;
#pragma unroll
    for (int r = 0; r < 16; ++r) { const int orow = crow(r, hi); stg[orow * 64 + r32] = f2bf(o0[r] * rli[r]); stg[orow * 64 + 32 + r32] = f2bf(o1[r] * rli[r]); }
    bf16_t* Ow = d.O + (size_t)(q0 + wid * 32) * d.po;
#pragma unroll
    for (int i = 0; i < 4; ++i) { const int row = i * 8 + (lane >> 3), ch = lane & 7; const u32x4 v = *(LAS const u32x4*)(stg + row * 64 + ch * 8); *(u32x4*)(Ow + (size_t)row * d.po + ch * 8) = v; }
    __syncthreads();
}
}


namespace pk {
typedef short bf16x8 __attribute__((ext_vector_type(8)));
typedef float f32x16 __attribute__((ext_vector_type(16)));
__device__ __forceinline__ unsigned f2sort(float f) { const unsigned b = __float_as_uint(f); return b ^ ((unsigned)((int)b >> 31) | 0x80000000u); }
__device__ __forceinline__ float sort2f(unsigned u) { return __uint_as_float((u & 0x80000000u) ? (u ^ 0x80000000u) : ~u); }
__device__ __forceinline__ void ce(unsigned& a, unsigned& b) { const unsigned mx = a > b ? a : b, mn = a > b ? b : a; a = mx; b = mn; }
__device__ __forceinline__ void sort16(unsigned (&v)[16]) {
#pragma unroll
    for (int k = 2; k <= 16; k <<= 1)
#pragma unroll
        for (int j = k >> 1; j >= 1; j >>= 1)
#pragma unroll
            for (int i = 0; i < 16; ++i) { const int l = i ^ j; if (l > i) { if ((i & k) == 0) ce(v[i], v[l]); else ce(v[l], v[i]); } }
}
__device__ __forceinline__ void merge16(unsigned (&a)[16], const unsigned (&b)[16]) {
#pragma unroll
    for (int i = 0; i < 16; ++i) a[i] = a[i] > b[15 - i] ? a[i] : b[15 - i];
#pragma unroll
    for (int j = 8; j >= 1; j >>= 1)
#pragma unroll
        for (int i = 0; i < 16; ++i) { const int l = i ^ j; if (l > i) ce(a[i], a[l]); }
}
__device__ __forceinline__ void top16of64(unsigned (&k)[64], unsigned (&out)[16]) {
    unsigned g1[16], g2[16], g3[16];
#pragma unroll
    for (int i = 0; i < 16; ++i) { out[i] = k[i]; g1[i] = k[16 + i]; g2[i] = k[32 + i]; g3[i] = k[48 + i]; }
    sort16(out); sort16(g1); sort16(g2); sort16(g3);
    merge16(out, g1); merge16(g2, g3); merge16(out, g2);
}
__device__ __forceinline__ unsigned sel4(const unsigned (&w)[4], int q) { const unsigned a = q & 1 ? w[1] : w[0], b = q & 1 ? w[3] : w[2]; return q & 2 ? b : a; }

template <int I> struct COff { static constexpr int v = COff<I - 1>::v + 16 / I; };
template <> struct COff<0> { static constexpr int v = 0; };
static_assert(COff<16>::v == 50, "50 candidates can reach the top 16 of a sorted 16 x 16 sum grid");
template <int I> __device__ __forceinline__ void fill_cand(unsigned (&c64)[64], const float (&s1)[16], const float (&s2)[16]) {
    if constexpr (I < 16) {
#pragma unroll
        for (int j = 0; j < 16 / (I + 1); ++j) c64[COff<I>::v + j] = (f2sort(s1[I] + s2[j]) & 0xFFFFFF00u) | (unsigned)(255 - (I * 16 + j));
        fill_cand<I + 1>(c64, s1, s2);
    }
}
__device__ __forceinline__ void topk_item(const bf16_t* QP, const bf16_t* SK, int* EID, float* GATE, int item, int lane) {
    const int tg = item >> 3, h = item & 7, r32 = lane & 31, hi = lane >> 5;
    const int t = tg * 32 + r32;
    unsigned own[2][16];
#pragma unroll
    for (int p = 0; p < 2; ++p) {
        const bf16_t* qrow = QP + (size_t)t * 2048 + h * 256 + p * 128 + hi * 8;
        bf16x8 qf[8];
#pragma unroll
        for (int d0 = 0; d0 < 8; ++d0) qf[d0] = *(const bf16x8*)(qrow + d0 * 16);
        const bf16_t* skb = SK + (size_t)((h * 2 + p) * 128 + r32) * 128 + hi * 8;
#pragma unroll 1
        for (int kt = 0; kt < 4; ++kt) {
            f32x16 acc;
#pragma unroll
            for (int r = 0; r < 16; ++r) acc[r] = 0.f;
#pragma unroll
            for (int d0 = 0; d0 < 8; ++d0) { const bf16x8 a = *(const bf16x8*)(skb + (size_t)kt * 32 * 128 + d0 * 16); acc = __builtin_amdgcn_mfma_f32_32x32x16_bf16(a, qf[d0], acc, 0, 0, 0); }
            unsigned cur[16];
#pragma unroll
            for (int r = 0; r < 16; ++r) { const int idx0 = kt * 32 + (r & 3) + 8 * (r >> 2);
                cur[r] = (f2sort(acc[r]) & 0xFFFFFF80u) | (unsigned)(127 - idx0 - 4 * hi); }
            sort16(cur);
            if (kt == 0) {
#pragma unroll
                for (int r = 0; r < 16; ++r) own[p][r] = cur[r];
            } else merge16(own[p], cur);
        }
    }
    unsigned fin[16];
    {
        unsigned oth[16];
#pragma unroll
        for (int i = 0; i < 16; ++i) { auto rr = __builtin_amdgcn_permlane32_swap(own[0][i], own[1][i], false, false); fin[i] = rr[0]; oth[i] = rr[1]; }
        merge16(fin, oth);
    }
    unsigned s1k[16], s2k[16];
#pragma unroll
    for (int i = 0; i < 16; ++i) { auto rr = __builtin_amdgcn_permlane32_swap(fin[i], fin[i], false, false); s1k[i] = rr[0]; s2k[i] = rr[1]; }
    float s1[16], s2[16]; unsigned long long i1lo = 0ull, i1hi = 0ull, i2lo = 0ull, i2hi = 0ull;
#pragma unroll
    for (int i = 0; i < 16; ++i) { s1[i] = sort2f(s1k[i] & 0xFFFFFF80u); s2[i] = sort2f(s2k[i] & 0xFFFFFF80u);
        const unsigned long long a = (unsigned long long)(127u - (s1k[i] & 0x7Fu)) << (8 * (i & 7)), b = (unsigned long long)(127u - (s2k[i] & 0x7Fu)) << (8 * (i & 7));
        if (i < 8) { i1lo |= a; i2lo |= b; } else { i1hi |= a; i2hi |= b; } }
    unsigned c64[64];
#pragma unroll
    for (int i = 50; i < 64; ++i) c64[i] = 0u;
    fill_cand<0>(c64, s1, s2);
    unsigned top[16];
    top16of64(c64, top);
    float ev[16]; float sum = 0.f; const float mx = sort2f(top[0] & 0xFFFFFF00u);
#pragma unroll
    for (int r = 0; r < 16; ++r) { ev[r] = __expf(sort2f(top[r] & 0xFFFFFF00u) - mx); sum += ev[r]; }
    const float rs = 1.f / sum;
    if (hi == 0) {
        int* ep = EID + (size_t)t * 128 + h * 16;
#pragma unroll
        for (int q4 = 0; q4 < 4; ++q4) { int ee[4];
#pragma unroll
            for (int z = 0; z < 4; ++z) { const int code = 255 - (int)(top[q4 * 4 + z] & 0xFFu), i = code >> 4, j = code & 15;
                const unsigned e1 = (unsigned)(((i & 8) ? i1hi : i1lo) >> (8 * (i & 7))) & 0xFFu, e2 = (unsigned)(((j & 8) ? i2hi : i2lo) >> (8 * (j & 7))) & 0xFFu; ee[z] = (int)(e1 * 128u + e2); }
            *(int4*)(ep + q4 * 4) = make_int4(ee[0], ee[1], ee[2], ee[3]); }
    } else {
        float* gp = GATE + (size_t)t * 128 + h * 16;
#pragma unroll
        for (int q4 = 0; q4 < 4; ++q4) *(float4*)(gp + q4 * 4) = make_float4(ev[q4 * 4] * rs, ev[q4 * 4 + 1] * rs, ev[q4 * 4 + 2] * rs, ev[q4 * 4 + 3] * rs);
    }
}
}


namespace gx {
typedef unsigned char u8x4 __attribute__((ext_vector_type(4)));
__device__ __forceinline__ int sdot16(const int4 a, const int4 b) {
    int s = __builtin_amdgcn_sdot4(a.x, b.x, 0, false); s = __builtin_amdgcn_sdot4(a.y, b.y, s, false); s = __builtin_amdgcn_sdot4(a.z, b.z, s, false); return __builtin_amdgcn_sdot4(a.w, b.w, s, false);
}
__device__ __forceinline__ void quant_row(const float* src, unsigned char* dst, float* scale_out, int lane) {
    const float4* sr = (const float4*)src + lane; float4 v[4]; float am = 0.f;
#pragma unroll
    for (int j = 0; j < 4; ++j) { v[j] = sr[64 * j]; am = fmaxf(am, fmaxf(fmaxf(fabsf(v[j].x), fabsf(v[j].y)), fmaxf(fabsf(v[j].z), fabsf(v[j].w)))); }
#pragma unroll
    for (int o = 1; o < 64; o <<= 1) am = fmaxf(am, __shfl_xor(am, o));
    const float inv = am > 0.f ? 127.f / am : 0.f;
#pragma unroll
    for (int j = 0; j < 4; ++j) { const int q0 = (int)rintf(v[j].x * inv), q1 = (int)rintf(v[j].y * inv), q2 = (int)rintf(v[j].z * inv), q3 = (int)rintf(v[j].w * inv);
        *(unsigned*)(dst + 4 * lane + 256 * j) = (unsigned)(q0 & 255) | ((unsigned)(q1 & 255) << 8) | ((unsigned)(q2 & 255) << 16) | ((unsigned)(q3 & 255) << 24); }
    if (lane == 0) *scale_out = am * (1.f / 127.f);
}
__device__ __forceinline__ float gelu_t(float x) { const float u = 0.7978845608028654f * (x + 0.044715f * x * x * x); return 0.5f * x * (1.f + tanhf(u)); }

__device__ __forceinline__ int hx(int lo, int hi, bool up, int bit) { const int send = up ? lo : hi, keep = up ? hi : lo; return keep + __shfl_xor(send, bit); }

__device__ __forceinline__ void u_token(const unsigned char* UQs  , const int4 (&ev)[4], const int4 hq, int* PArow, int lane) {
    const int e[16] = {ev[0].x, ev[0].y, ev[0].z, ev[0].w, ev[1].x, ev[1].y, ev[1].z, ev[1].w, ev[2].x, ev[2].y, ev[2].z, ev[2].w, ev[3].x, ev[3].y, ev[3].z, ev[3].w};
    int4 rows[16];
#pragma unroll
    for (int i = 0; i < 16; ++i) rows[i] = *(const int4*)(UQs + (size_t)e[i] * 1024);
    int p[16];
#pragma unroll
    for (int i = 0; i < 16; ++i) p[i] = sdot16(rows[i], hq);
    const bool b2 = (lane & 4) != 0, b1 = (lane & 2) != 0, b0 = (lane & 1) != 0;
    int q[8], r[4];
#pragma unroll
    for (int k = 0; k < 8; ++k) q[k] = hx(p[k], p[8 + k], b2, 4);
#pragma unroll
    for (int k = 0; k < 4; ++k) r[k] = hx(q[k], q[4 + k], b1, 2);
    const int z0 = hx(r[0], r[2], b0, 1), z1 = hx(r[1], r[3], b0, 1);
    *(int2*)(PArow + 2 * lane) = make_int2(z0, z1);
}

__device__ __forceinline__ void v_token(const unsigned char* VQs  , const int4 (&ev)[4], const int4 wh, const int4 wlo, float wscale, const float* gate2, const float* x1row, float* outrow, int s, int lane) {
    const int e[16] = {ev[0].x, ev[0].y, ev[0].z, ev[0].w, ev[1].x, ev[1].y, ev[1].z, ev[1].w, ev[2].x, ev[2].y, ev[2].z, ev[2].w, ev[3].x, ev[3].y, ev[3].z, ev[3].w};
    const int whv[4] = {wh.x, wh.y, wh.z, wh.w}, wlv[4] = {wlo.x, wlo.y, wlo.z, wlo.w};
    uint4 rows[16];
#pragma unroll
    for (int i = 0; i < 16; ++i) rows[i] = *(const uint4*)(VQs + (size_t)e[i] * 1024);
    int ah[16], al[16];
#pragma unroll
    for (int c = 0; c < 16; ++c) { ah[c] = 0; al[c] = 0; }
#pragma unroll
    for (int g = 0; g < 4; ++g) {
#pragma unroll
        for (int d = 0; d < 4; ++d) {
            const unsigned A = d == 0 ? rows[4 * g].x : d == 1 ? rows[4 * g].y : d == 2 ? rows[4 * g].z : rows[4 * g].w;
            const unsigned B = d == 0 ? rows[4 * g + 1].x : d == 1 ? rows[4 * g + 1].y : d == 2 ? rows[4 * g + 1].z : rows[4 * g + 1].w;
            const unsigned C = d == 0 ? rows[4 * g + 2].x : d == 1 ? rows[4 * g + 2].y : d == 2 ? rows[4 * g + 2].z : rows[4 * g + 2].w;
            const unsigned D = d == 0 ? rows[4 * g + 3].x : d == 1 ? rows[4 * g + 3].y : d == 2 ? rows[4 * g + 3].z : rows[4 * g + 3].w;
            const unsigned ab01 = __builtin_amdgcn_perm(A, B, 0x01050004u), ab23 = __builtin_amdgcn_perm(A, B, 0x03070206u);
            const unsigned cd01 = __builtin_amdgcn_perm(C, D, 0x01050004u), cd23 = __builtin_amdgcn_perm(C, D, 0x03070206u);
            const int q0 = (int)__builtin_amdgcn_perm(ab01, cd01, 0x01000504u), q1 = (int)__builtin_amdgcn_perm(ab01, cd01, 0x03020706u);
            const int q2 = (int)__builtin_amdgcn_perm(ab23, cd23, 0x01000504u), q3 = (int)__builtin_amdgcn_perm(ab23, cd23, 0x03020706u);
            ah[4 * d + 0] = __builtin_amdgcn_sdot4(q0, whv[g], ah[4 * d + 0], false); al[4 * d + 0] = __builtin_amdgcn_sdot4(q0, wlv[g], al[4 * d + 0], false);
            ah[4 * d + 1] = __builtin_amdgcn_sdot4(q1, whv[g], ah[4 * d + 1], false); al[4 * d + 1] = __builtin_amdgcn_sdot4(q1, wlv[g], al[4 * d + 1], false);
            ah[4 * d + 2] = __builtin_amdgcn_sdot4(q2, whv[g], ah[4 * d + 2], false); al[4 * d + 2] = __builtin_amdgcn_sdot4(q2, wlv[g], al[4 * d + 2], false);
            ah[4 * d + 3] = __builtin_amdgcn_sdot4(q3, whv[g], ah[4 * d + 3], false); al[4 * d + 3] = __builtin_amdgcn_sdot4(q3, wlv[g], al[4 * d + 3], false);
        }
    }
    int y[16];
#pragma unroll
    for (int c = 0; c < 16; ++c) y[c] = ah[c] * 128 + al[c];
    const bool b5 = (lane & 32) != 0, b4 = (lane & 16) != 0, b3 = (lane & 8) != 0;
    int z[8], q[4];
#pragma unroll
    for (int k = 0; k < 8; ++k) z[k] = hx(y[k], y[8 + k], b5, 32);
#pragma unroll
    for (int k = 0; k < 4; ++k) q[k] = hx(z[k], z[4 + k], b4, 16);
    const int r0 = hx(q[0], q[2], b3, 8), r1 = hx(q[1], q[3], b3, 8);
    const int col = 128 * s + 16 * (lane & 7) + (b5 ? 8 : 0) + (b4 ? 4 : 0) + (b3 ? 2 : 0);
    const float2 g2 = *(const float2*)(gate2 + col); float2 x1 = *(const float2*)(x1row + col);
    x1.x += g2.x * wscale * (float)r0; x1.y += g2.y * wscale * (float)r1;
    *(float2*)(outrow + col) = x1;
}
}

constexpr size_t WS_SU = 2 * MiB, WS_SV = 2 * MiB + 65536, WS_HS = 2 * MiB + 131072;
constexpr size_t WS_UQ = 24 * MiB, WS_VQ = 40 * MiB, WS_H2Q = 56 * MiB;
constexpr size_t WS_XS = 2 * MiB + 262144, WS_WINS = 2 * MiB + 393216, WS_WPQS = 2 * MiB + 409600;
constexpr size_t WS_WINQ = 456 * MiB, WS_WPQQ = 460 * MiB;
constexpr size_t WS_SSQ = 464 * MiB;
constexpr size_t WS_A = WS_KA;
struct Args { const void* in[22]; float* out; unsigned char* ws; int ph_lo, ph_hi, li, pad; };

struct Frame {
    LAS unsigned char* lds;
    int tid, lane, wave, G, gw, NGW;
};

__host__ __device__ __forceinline__ int nat_col(int rho) {
    if (rho < 672) return rho;
    if (rho < 680) return C_FL + (rho - 672);
    if (rho < 768) return -1;
    if (rho < 1792) { const int t = (rho - 768) >> 8, c = (rho - 768) & 255, bj = c >> 7, wc = (c & 127) >> 5, i = c & 31; return (t < 2 ? C_FQ : C_FK) + 64 * (4 * (t & 1) + wc) + 32 * bj + i; }
    return C_FV + (rho - 1792);
}
namespace pg8 {
struct EpiProj {
    static constexpr bool PERM = true, AFTER_DRAIN = false;
    bf16_t* P; float* FL;
    __device__ __forceinline__ void operator()(const f32x4 (&acc)[2][2][4][2], const Unit& u, int wr, int wc, int fr, int fq) const {
        const int row0 = u.pm * BM + wr * 64 + fr, col0 = u.pn * BM + wc * 32 + 8 * fq;
#pragma unroll
        for (int ai = 0; ai < 2; ++ai)
#pragma unroll
            for (int m = 0; m < 4; ++m) { const int row = row0 + ai * HALF + m * 16; bf16_t* rowp = P + (size_t)row * PP + col0;
#pragma unroll
                for (int bj = 0; bj < 2; ++bj) { const f32x4 v0 = acc[ai][bj][m][0], v1 = acc[ai][bj][m][1];
                    if (col0 + bj * HALF == C_FL) { float* f = FL + (size_t)row * 8; *(f32x4*)f = v0; *(f32x4*)(f + 4) = v1; }
                    u32x4 w; w.x = cvt_pk_bf16(v0[0], v0[1]); w.y = cvt_pk_bf16(v0[2], v0[3]); w.z = cvt_pk_bf16(v1[0], v1[1]); w.w = cvt_pk_bf16(v1[2], v1[3]);
                    *(u32x4*)(rowp + bj * HALF) = w; } }
    }
};
struct EpiProjI8 {
    static constexpr bool PERM = true, AFTER_DRAIN = false;
    bf16_t* P; float* LOGF; float* SSQ; const float* rs; const float* cs; const float* g_fq; const float* g_fk; const float* b_f;
    __device__ __forceinline__ void operator()(const i32x4 (&acc)[2][2][4][2], const Unit& u, int wr, int wc, int fr, int fq) const {
        const int row0 = u.pm * BM + wr * 64 + fr, rho0 = u.pn * BM + wc * 32 + 8 * fq, pn = u.pn;
        f32x4 c0[2], c1[2];
#pragma unroll
        for (int bj = 0; bj < 2; ++bj) { c0[bj] = *(const f32x4*)(cs + rho0 + bj * HALF); c1[bj] = *(const f32x4*)(cs + rho0 + bj * HALF + 4); }
        const bool fox = pn >= 3 && pn <= 6, isq = pn < 5;
        f32x4 g0[2], g1[2];
        if (fox) { const float* g = (isq ? g_fq : g_fk) + 8 * fq;
#pragma unroll
            for (int bj = 0; bj < 2; ++bj) { g0[bj] = *(const f32x4*)(g + 32 * bj); g1[bj] = *(const f32x4*)(g + 32 * bj + 4); } }
#pragma unroll
        for (int ai = 0; ai < 2; ++ai)
#pragma unroll
            for (int m = 0; m < 4; ++m) {
                const int row = row0 + ai * HALF + m * 16; bf16_t* rowp = P + (size_t)row * PP; const float r = rs[row];
                f32x4 v0[2], v1[2];
#pragma unroll
                for (int bj = 0; bj < 2; ++bj) { const i32x4 a0 = acc[ai][bj][m][0], a1 = acc[ai][bj][m][1];
                    v0[bj] = (f32x4){(float)a0[0] * r * c0[bj][0], (float)a0[1] * r * c0[bj][1], (float)a0[2] * r * c0[bj][2], (float)a0[3] * r * c0[bj][3]};
                    v1[bj] = (f32x4){(float)a1[0] * r * c1[bj][0], (float)a1[1] * r * c1[bj][1], (float)a1[2] * r * c1[bj][2], (float)a1[3] * r * c1[bj][3]}; }
                float ssb[2];
#pragma unroll
                for (int bj = 0; bj < 2; ++bj) { float q = (v0[bj][0] * v0[bj][0] + v0[bj][1] * v0[bj][1]) + (v0[bj][2] * v0[bj][2] + v0[bj][3] * v0[bj][3]) + (v1[bj][0] * v1[bj][0] + v1[bj][1] * v1[bj][1]) + (v1[bj][2] * v1[bj][2] + v1[bj][3] * v1[bj][3]);
                    q += __shfl_xor(q, 16); q += __shfl_xor(q, 32); ssb[bj] = q; }
                if (fox) {
                    const float rr = rsqrtf((ssb[0] + ssb[1]) * (1.f / 64.f) + EPS) * (isq ? C2F : 1.f);
                    const int dst = (isq ? C_FQ : C_FK) + 64 * (4 * ((pn - 3) & 1) + wc) + 8 * fq;
#pragma unroll
                    for (int bj = 0; bj < 2; ++bj) { u32x4 w; w.x = cvt_pk_bf16(v0[bj][0] * rr * g0[bj][0], v0[bj][1] * rr * g0[bj][1]); w.y = cvt_pk_bf16(v0[bj][2] * rr * g0[bj][2], v0[bj][3] * rr * g0[bj][3]);
                        w.z = cvt_pk_bf16(v1[bj][0] * rr * g1[bj][0], v1[bj][1] * rr * g1[bj][1]); w.w = cvt_pk_bf16(v1[bj][2] * rr * g1[bj][2], v1[bj][3] * rr * g1[bj][3]);
                        *(u32x4*)(rowp + dst + 32 * bj) = w; }
                } else {
#pragma unroll
                    for (int bj = 0; bj < 2; ++bj) {
                        const int rho = rho0 + bj * HALF;
                        if (rho == 672) {
                            const float z[8] = {v0[bj][0], v0[bj][1], v0[bj][2], v0[bj][3], v1[bj][0], v1[bj][1], v1[bj][2], v1[bj][3]};
                            const int b = row / S_, sq = row % S_;
#pragma unroll
                            for (int h = 0; h < 8; ++h) { const float zz = z[h] + b_f[h]; LOGF[((size_t)b * 8 + h) * S_ + sq] = fminf(zz, 0.f) - log1pf(expf(-fabsf(zz))); }
                        } else if (rho < 672 || rho >= 1792) {
                            const int dst = rho < 672 ? rho : C_FV + (rho - 1792);
                            u32x4 w; w.x = cvt_pk_bf16(v0[bj][0], v0[bj][1]); w.y = cvt_pk_bf16(v0[bj][2], v0[bj][3]); w.z = cvt_pk_bf16(v1[bj][0], v1[bj][1]); w.w = cvt_pk_bf16(v1[bj][2], v1[bj][3]);
                            *(u32x4*)(rowp + dst) = w;
                            if (fq == 0 && rho < 640) {
                                if (pn == 0) { if (bj == 1) SSQ[(size_t)row * 16 + wc] = ssb[0] + ssb[1]; }
                                else if (pn == 1) SSQ[(size_t)row * 16 + (bj == 0 ? 4 : 8) + wc] = ssb[bj];
                                else SSQ[(size_t)row * 16 + 12 + wc] = ssb[bj];
                            }
                        }
                    }
                }
            }
    }
};
struct EpiStoreRms {
    static constexpr bool PERM = true, AFTER_DRAIN = false;
    bf16_t* O; int ldc; const float* SSQ; int slot0; float inv_cnt;
    __device__ __forceinline__ void operator()(const f32x4 (&acc)[2][2][4][2], const Unit& u, int wr, int wc, int fr, int fq) const {
        const int row0 = u.pm * BM + wr * 64 + fr, col0 = u.pn * BM + wc * 32 + 8 * fq;
#pragma unroll
        for (int ai = 0; ai < 2; ++ai)
#pragma unroll
            for (int m = 0; m < 4; ++m) { const int row = row0 + ai * HALF + m * 16; bf16_t* rowp = O + (size_t)row * ldc + col0;
                const f32x4 sa = *(const f32x4*)(SSQ + (size_t)row * 16 + slot0), sb = *(const f32x4*)(SSQ + (size_t)row * 16 + slot0 + 4);
                const float r = rsqrtf(((sa[0] + sa[1]) + (sa[2] + sa[3]) + (sb[0] + sb[1]) + (sb[2] + sb[3])) * inv_cnt + EPS);
#pragma unroll
                for (int bj = 0; bj < 2; ++bj) { const f32x4 v0 = acc[ai][bj][m][0] * r, v1 = acc[ai][bj][m][1] * r;
                    u32x4 w; w.x = cvt_pk_bf16(v0[0], v0[1]); w.y = cvt_pk_bf16(v0[2], v0[3]); w.z = cvt_pk_bf16(v1[0], v1[1]); w.w = cvt_pk_bf16(v1[2], v1[3]);
                    *(u32x4*)(rowp + bj * HALF) = w; } }
    }
};
struct EpiStoreI8 {
    static constexpr bool PERM = true, AFTER_DRAIN = false;
    bf16_t* O; int ldc; const float* rs; const float* cs;
    __device__ __forceinline__ void operator()(const i32x4 (&acc)[2][2][4][2], const Unit& u, int wr, int wc, int fr, int fq) const {
        const int row0 = u.pm * BM + wr * 64 + fr, col0 = u.pn * BM + wc * 32 + 8 * fq;
        f32x4 c0[2], c1[2];
#pragma unroll
        for (int bj = 0; bj < 2; ++bj) { c0[bj] = *(const f32x4*)(cs + col0 + bj * HALF); c1[bj] = *(const f32x4*)(cs + col0 + bj * HALF + 4); }
#pragma unroll
        for (int ai = 0; ai < 2; ++ai)
#pragma unroll
            for (int m = 0; m < 4; ++m) { const int row = row0 + ai * HALF + m * 16; bf16_t* rowp = O + (size_t)row * ldc + col0; const float r = rs[row];
#pragma unroll
                for (int bj = 0; bj < 2; ++bj) { const i32x4 a0 = acc[ai][bj][m][0], a1 = acc[ai][bj][m][1];
                    u32x4 w; w.x = cvt_pk_bf16((float)a0[0] * r * c0[bj][0], (float)a0[1] * r * c0[bj][1]); w.y = cvt_pk_bf16((float)a0[2] * r * c0[bj][2], (float)a0[3] * r * c0[bj][3]);
                    w.z = cvt_pk_bf16((float)a1[0] * r * c1[bj][0], (float)a1[1] * r * c1[bj][1]); w.w = cvt_pk_bf16((float)a1[2] * r * c1[bj][2], (float)a1[3] * r * c1[bj][3]);
                    *(u32x4*)(rowp + bj * HALF) = w; } }
    }
};
struct EpiStore {
    static constexpr bool PERM = true, AFTER_DRAIN = false;
    bf16_t* O; int ldc;
    __device__ __forceinline__ void operator()(const f32x4 (&acc)[2][2][4][2], const Unit& u, int wr, int wc, int fr, int fq) const {
        const int row0 = u.pm * BM + wr * 64 + fr, col0 = u.pn * BM + wc * 32 + 8 * fq;
#pragma unroll
        for (int ai = 0; ai < 2; ++ai)
#pragma unroll
            for (int m = 0; m < 4; ++m) { bf16_t* rowp = O + (size_t)(row0 + ai * HALF + m * 16) * ldc + col0;
#pragma unroll
                for (int bj = 0; bj < 2; ++bj) { const f32x4 v0 = acc[ai][bj][m][0], v1 = acc[ai][bj][m][1];
                    u32x4 w; w.x = cvt_pk_bf16(v0[0], v0[1]); w.y = cvt_pk_bf16(v0[2], v0[3]); w.z = cvt_pk_bf16(v1[0], v1[1]); w.w = cvt_pk_bf16(v1[2], v1[3]);
                    *(u32x4*)(rowp + bj * HALF) = w; } }
    }
};
struct EpiResid {
    static constexpr bool PERM = false, AFTER_DRAIN = false;
    const float* X; const float* MOD; float* out;
    __device__ __forceinline__ void operator()(const f32x4 (&acc)[2][2][4][2], const Unit& u, int wr, int wc, int fr, int fq) const {
        const int row0 = u.pm * BM + wr * 64 + fr, col0 = u.pn * BM + wc * 32 + 4 * fq;
        const int b = (u.pm * BM) / S_;
        f32x4 gv[2][2];
#pragma unroll
        for (int bj = 0; bj < 2; ++bj)
#pragma unroll
            for (int n = 0; n < 2; ++n) gv[bj][n] = *(const f32x4*)(MOD + b * 6144 + 2 * 1024 + col0 + bj * HALF + n * 16);
#pragma unroll
        for (int ai = 0; ai < 2; ++ai)
#pragma unroll
            for (int m = 0; m < 4; ++m) { const size_t off = (size_t)(row0 + ai * HALF + m * 16) * 1024 + col0;
#pragma unroll
                for (int bj = 0; bj < 2; ++bj)
#pragma unroll
                    for (int n = 0; n < 2; ++n) { const f32x4 xv = *(const f32x4*)(X + off + bj * HALF + n * 16); *(f32x4*)(out + off + bj * HALF + n * 16) = xv + gv[bj][n] * acc[ai][bj][m][n]; } }
    }
};
}

__device__ __forceinline__ void p0_transpose_item(const float* W, int K, int N, int Npad, bf16_t* WT, LAS float* scr, int item, int lane, const float* kscale = nullptr) {
    const int nblk = Npad / 32, kb = item / nblk, nb = item % nblk, k0 = 64 * kb, n0 = 32 * nb;
    const int nn = n0 + (lane & 31);
#pragma unroll 8
    for (int i = 0; i < 32; ++i) { const int kk = 2 * i + (lane >> 5); scr[kk * 33 + (lane & 31)] = nn < N ? W[(size_t)(k0 + kk) * N + nn] * (kscale ? kscale[k0 + kk] : 1.f) : 0.f; }
    asm volatile("s_waitcnt lgkmcnt(0)" ::: "memory");
    const int c = lane & 7;
#pragma unroll
    for (int j = 0; j < 4; ++j) { const int n = (lane >> 3) + 8 * j; const LAS float* s = scr + (8 * c) * 33 + n;
        u32x4 o; o.x = pk2(s[0 * 33], s[1 * 33]); o.y = pk2(s[2 * 33], s[3 * 33]); o.z = pk2(s[4 * 33], s[5 * 33]); o.w = pk2(s[6 * 33], s[7 * 33]);
        *(u32x4*)(WT + (size_t)(n0 + n) * K + k0 + 8 * c) = o; }
    asm volatile("s_waitcnt lgkmcnt(0)" ::: "memory");
}
__device__ __forceinline__ void p0_mod_block(const float* c, const float* w_ada, const float* b_ada, float* mod, LAS unsigned char* lds, int item, int wave, int lane) {
    LAS float* sil = (LAS float*)(lds + wave * 2048);
    LAS float* part = (LAS float*)(lds + 16384);
    for (int i = lane; i < 512; i += 64) { const int b = i >> 7, kk = i & 127; const float cv = c[b * 1024 + wave * 128 + kk]; sil[kk * 4 + b] = cv / (1.f + expf(-cv)); }
    asm volatile("s_waitcnt lgkmcnt(0)" ::: "memory");
    const int j = item * 64 + lane;
    const float* wp = w_ada + (size_t)(wave * 128) * 6144 + j;
    float a0 = 0.f, a1 = 0.f, a2 = 0.f, a3 = 0.f;
#pragma unroll 16
    for (int k = 0; k < 128; ++k) { const float w = wp[(size_t)k * 6144]; const f32x4 s = *(const LAS f32x4*)(sil + k * 4); a0 += s[0] * w; a1 += s[1] * w; a2 += s[2] * w; a3 += s[3] * w; }
    part[(wave * 4 + 0) * 64 + lane] = a0; part[(wave * 4 + 1) * 64 + lane] = a1; part[(wave * 4 + 2) * 64 + lane] = a2; part[(wave * 4 + 3) * 64 + lane] = a3;
    __syncthreads();
    if (wave < 4) { float acc = b_ada[j];
#pragma unroll
        for (int w = 0; w < 8; ++w) acc += part[(w * 4 + wave) * 64 + lane];
        mod[wave * 6144 + j] = acc; }
    __syncthreads();
}

struct ModIn { float4 v[4]; };
__device__ __forceinline__ void modrow_load(ModIn& M, const float* X, int row, int lane) {
    const float4* xr = (const float4*)(X + (size_t)row * 1024) + lane;
#pragma unroll
    for (int j = 0; j < 4; ++j) M.v[j] = xr[64 * j];
}
__device__ __forceinline__ void modrow_finish(ModIn& M, const float* g, const float* mod, int shift_idx, int scale_idx, bf16_t* out, unsigned char* outq, float* hs, int row, int lane) {
    const int b = row / S_; float ss = 0.f;
#pragma unroll
    for (int j = 0; j < 4; ++j) ss += (M.v[j].x * M.v[j].x + M.v[j].y * M.v[j].y) + (M.v[j].z * M.v[j].z + M.v[j].w * M.v[j].w);
    ss = wave_sum(ss);
    const float r = rsqrtf(ss * (1.f / 1024.f) + EPS);
    const float* sh = mod + b * 6144 + shift_idx * 1024; const float* sc = mod + b * 6144 + scale_idx * 1024;
    float am = 0.f;
#pragma unroll
    for (int j = 0; j < 4; ++j) {
        const int col = 4 * lane + 256 * j; float4& v = M.v[j];
        const float4 g4 = *(const float4*)(g + col), s4 = *(const float4*)(sc + col), h4 = *(const float4*)(sh + col);
        v.x = v.x * r * g4.x * (1.f + s4.x) + h4.x; v.y = v.y * r * g4.y * (1.f + s4.y) + h4.y; v.z = v.z * r * g4.z * (1.f + s4.z) + h4.z; v.w = v.w * r * g4.w * (1.f + s4.w) + h4.w;
        if (out) { uint2 w; w.x = pk2(v.x, v.y); w.y = pk2(v.z, v.w); *(uint2*)(out + (size_t)row * 1024 + col) = w; }
        am = fmaxf(am, fmaxf(fmaxf(fabsf(v.x), fabsf(v.y)), fmaxf(fabsf(v.z), fabsf(v.w))));
    }
    if (outq) {
#pragma unroll
        for (int o = 1; o < 64; o <<= 1) am = fmaxf(am, __shfl_xor(am, o));
        const float inv = am > 0.f ? 127.f / am : 0.f;
#pragma unroll
        for (int j = 0; j < 4; ++j) { const float4 v = M.v[j]; const int q0 = (int)rintf(v.x * inv), q1 = (int)rintf(v.y * inv), q2 = (int)rintf(v.z * inv), q3 = (int)rintf(v.w * inv);
            *(unsigned*)(outq + (size_t)row * 1024 + 4 * lane + 256 * j) = (unsigned)(q0 & 255) | ((unsigned)(q1 & 255) << 8) | ((unsigned)(q2 & 255) << 16) | ((unsigned)(q3 & 255) << 24); }
        if (lane == 0) hs[row] = am * (1.f / 127.f);
    }
}
__device__ __forceinline__ void modrows2(const float* X, const float* g, const float* mod, int shift_idx, int scale_idx, bf16_t* out, unsigned char* outq, float* hs, int gw, int ngw, int lane) {
    for (int row = gw; row < T_; row += 2 * ngw) {
        const int row2 = row + ngw; ModIn Ma, Mb;
        modrow_load(Ma, X, row, lane); if (row2 < T_) modrow_load(Mb, X, row2, lane);
        modrow_finish(Ma, g, mod, shift_idx, scale_idx, out, outq, hs, row, lane); if (row2 < T_) modrow_finish(Mb, g, mod, shift_idx, scale_idx, out, outq, hs, row2, lane);
    }
}
__device__ __forceinline__ void quant4(const float* peer_u, const float* peer_v, unsigned char* UQ, unsigned char* VQ, float* SU, float* SV, int r0, int lane) {
    float4 v[4][4]; float am[4];
#pragma unroll
    for (int q = 0; q < 4; ++q) { const int r = r0 + q; const float* src = (r < 16384 ? peer_u + (size_t)r * 1024 : peer_v + (size_t)(r - 16384) * 1024);
#pragma unroll
        for (int j = 0; j < 4; ++j) v[q][j] = ((const float4*)src)[lane + 64 * j]; }
#pragma unroll
    for (int q = 0; q < 4; ++q) { float a = 0.f;
#pragma unroll
        for (int j = 0; j < 4; ++j) a = fmaxf(a, fmaxf(fmaxf(fabsf(v[q][j].x), fabsf(v[q][j].y)), fmaxf(fabsf(v[q][j].z), fabsf(v[q][j].w))));
        am[q] = a; }
#pragma unroll
    for (int o = 1; o < 64; o <<= 1) {
#pragma unroll
        for (int q = 0; q < 4; ++q) am[q] = fmaxf(am[q], __shfl_xor(am[q], o)); }
#pragma unroll
    for (int q = 0; q < 4; ++q) { const int r = r0 + q; unsigned char* dst = (r < 16384 ? UQ + (size_t)r * 1024 : VQ + (size_t)(r - 16384) * 1024); float* sc = (r < 16384 ? SU + r : SV + (r - 16384));
        const float inv = am[q] > 0.f ? 127.f / am[q] : 0.f;
#pragma unroll
        for (int j = 0; j < 4; ++j) { const float4 x = v[q][j]; const int q0 = (int)rintf(x.x * inv), q1 = (int)rintf(x.y * inv), q2 = (int)rintf(x.z * inv), q3 = (int)rintf(x.w * inv);
            *(unsigned*)(dst + 4 * lane + 256 * j) = (unsigned)(q0 & 255) | ((unsigned)(q1 & 255) << 8) | ((unsigned)(q2 & 255) << 16) | ((unsigned)(q3 & 255) << 24); }
        if (lane == 0) *sc = am[q] * (1.f / 127.f); }
}

__global__ void __launch_bounds__(NWAVES * 64, 2) mega_fwd(Args args) {
    extern __shared__ __attribute__((aligned(16))) unsigned char lds[];
    Frame F;
    F.lds = (LAS unsigned char*)lds;
    volatile LAS unsigned* MISC = (volatile LAS unsigned*)(F.lds + MISC_OFF);
    F.tid = threadIdx.x; F.lane = F.tid & 63; F.wave = __builtin_amdgcn_readfirstlane(F.tid >> 6);
    F.G = gridDim.x; F.gw = blockIdx.x * NWAVES + F.wave; F.NGW = F.G * NWAVES;
    unsigned char* ws = args.ws;
    unsigned* ctl = (unsigned*)(ws + WS_CTL);
    const float* x = (const float*)args.in[0]; const float* c = (const float*)args.in[1]; const int* positions = (const int*)args.in[2];
    const float* w_ada = (const float*)args.in[3]; const float* b_ada = (const float*)args.in[4]; const float* norm1_g = (const float*)args.in[5];
    const float* w_in = (const float*)args.in[6]; const float* mla_qa_g = (const float*)args.in[7]; const float* mla_kva_g = (const float*)args.in[8];
    const float* w_uq = (const float*)args.in[9]; const float* w_ukv = (const float*)args.in[10]; const float* mla_q_g = (const float*)args.in[11];
    const float* mla_k_g = (const float*)args.in[12]; const float* fox_q_g = (const float*)args.in[13]; const float* fox_k_g = (const float*)args.in[14];
    const float* b_f = (const float*)args.in[15]; const float* w_o = (const float*)args.in[16]; const float* norm2_g = (const float*)args.in[17];
    const float* w_pq = (const float*)args.in[18]; const float* sub_keys = (const float*)args.in[19]; const float* peer_u = (const float*)args.in[20]; const float* peer_v = (const float*)args.in[21];
    float* out = args.out;
    float* MOD = (float*)(ws + WS_MOD); float* FL = (float*)(ws + WS_FL); float* FCUM = (float*)(ws + WS_FCUM); float* LOGF = (float*)(ws + WS_LOGF); float2* ROPE = (float2*)(ws + WS_ROPE);
    bf16_t* XN = (bf16_t*)(ws + WS_XN); bf16_t* PROJ = (bf16_t*)(ws + WS_PROJ); bf16_t* KVRAW = (bf16_t*)(ws + WS_KVRAW); bf16_t* QA = (bf16_t*)(ws + WS_QA); bf16_t* KA = (bf16_t*)(ws + WS_KA);
    bf16_t* WIN = (bf16_t*)(ws + WS_WIN); bf16_t* WUQ = (bf16_t*)(ws + WS_WUQ); bf16_t* WUKV = (bf16_t*)(ws + WS_WUKV); bf16_t* WO = (bf16_t*)(ws + WS_WO); bf16_t* WPQ = (bf16_t*)(ws + WS_WPQ); bf16_t* SKB = (bf16_t*)(ws + WS_SK);
    float* SSQ = (float*)(ws + WS_SSQ);
    unsigned char* XNQ = ws + WS_XN; float* XS = (float*)(ws + WS_XS); unsigned char* WINQ = ws + WS_WINQ; unsigned char* WPQQ = ws + WS_WPQQ; float* WINS = (float*)(ws + WS_WINS); float* WPQS = (float*)(ws + WS_WPQS);
    unsigned char* UQ = ws + WS_UQ; unsigned char* VQ = ws + WS_VQ; unsigned char* H2Q = ws + WS_H2Q; float* SU = (float*)(ws + WS_SU); float* SV = (float*)(ws + WS_SV); float* HS = (float*)(ws + WS_HS); float* AP = (float*)(ws + WS_A);
    bf16_t* OB = XN; bf16_t* H2 = XN; bf16_t* QP = PROJ; int* EID = (int*)(ws + WS_QA); float* GATE = (float*)(ws + WS_QA + 16 * MiB);
    (void)sub_keys; (void)peer_u; (void)peer_v; (void)positions; (void)KA; (void)FCUM; (void)LOGF; (void)ROPE; (void)mla_q_g; (void)mla_k_g; (void)b_f; (void)fox_q_g; (void)fox_k_g; (void)mla_qa_g; (void)mla_kva_g;

    for (int u = F.tid; u < (LDS_BYTES - LDSCTL_OFF) / 4; u += NWAVES * 64) ((LAS unsigned*)(F.lds + LDSCTL_OFF))[u] = 0u;
    __syncthreads();
    const int lo = args.ph_lo, hi = args.ph_hi;
    XcdBarrier bar; bar.bar = ctl + CW_BAR + args.li * XCD_BAR_WORDS; bar.x = 0; bar.st = nullptr;
    if (hi - lo > 1) bar = xcd_barrier_post(ctl + CW_BAR + args.li * XCD_BAR_WORDS, MISC + 8);
#define IN(k) (lo <= (k) && (k) < hi)
#define SEAM(k) do { if (IN(k) && IN((k) + 1)) xcd_barrier(bar); } while (0)

    if (IN(0)) REP(0) {
        LAS float* scr = (LAS float*)(F.lds + F.wave * 16384);
        constexpr int I_MOD = 96, I_IN = 16 * 72, I_UQ = 6 * 24, I_UKV = 4 * 32, I_O = 16 * 32, I_PQ = 16 * 64;
        constexpr int I_SK = 512;
        constexpr int NITEMS = I_IN + I_UQ + I_UKV + I_O + I_PQ + I_SK;
        {
            const float invf = (float)exp2(-(double)(F.lane & 15) * (13.287712379549449 / 16.0));
            for (int r4 = F.gw * 4; r4 < T_; r4 += F.NGW * 4) { const int row = r4 + (F.lane >> 4);
                const double a = (double)((float)positions[row] * invf), n = rint(a * 0.15915494309189535); const float red = (float)(a - n * 6.283185307179586);
                ROPE[(size_t)row * 16 + (F.lane & 15)] = make_float2(__cosf(red), __sinf(red)); }
        }
        for (int mi = (int)blockIdx.x; mi < I_MOD; mi += F.G) p0_mod_block(c, w_ada, b_ada, MOD, F.lds, mi, F.wave, F.lane);
        for (int it = F.gw; it < NITEMS; it += F.NGW) {
            int r = it;
            if (r < I_IN) { p0_transpose_item(w_in, 1024, INW, PP, WIN, scr, r, F.lane); continue; } r -= I_IN;
            if (r < I_UQ) { p0_transpose_item(w_uq, 384, 768, 768, WUQ, scr, r, F.lane, mla_qa_g); continue; } r -= I_UQ;
            if (r < I_UKV) { p0_transpose_item(w_ukv, 256, 1024, 1024, WUKV, scr, r, F.lane, mla_kva_g); continue; } r -= I_UKV;
            if (r < I_O) { p0_transpose_item(w_o, 1024, 1024, 1024, WO, scr, r, F.lane); continue; } r -= I_O;
            if (r < I_PQ) { p0_transpose_item(w_pq, 1024, 2048, 2048, WPQ, scr, r, F.lane); continue; } r -= I_PQ;
            { const float4* src = (const float4*)(sub_keys + (size_t)r * 512) + F.lane * 2; const float4 a = src[0], b2 = src[1];
              u32x4 o; o.x = pk2(a.x, a.y); o.y = pk2(a.z, a.w); o.z = pk2(b2.x, b2.y); o.w = pk2(b2.z, b2.w); *(u32x4*)(SKB + (size_t)r * 512 + F.lane * 8) = o; }
        }
    }
    SEAM(0);
    if (IN(1)) {
        for (int r = F.gw; r < PP + 2048; r += F.NGW) {
            const int nc = r < PP ? nat_col(r) : 0;
            const bf16_t* src = r < PP ? WIN + (size_t)(nc < 0 ? 0 : nc) * 1024 : WPQ + (size_t)(r - PP) * 1024; unsigned char* dst = r < PP ? WINQ + (size_t)r * 1024 : WPQQ + (size_t)(r - PP) * 1024; float* sc = r < PP ? WINS + r : WPQS + (r - PP);
            float v[16]; unpack8(*(const uint4*)(src + F.lane * 16), v); unpack8(*(const uint4*)(src + F.lane * 16 + 8), v + 8);
            if (nc < 0) {
#pragma unroll
                for (int i = 0; i < 16; ++i) v[i] = 0.f; }
            float am = 0.f;
#pragma unroll
            for (int i = 0; i < 16; ++i) am = fmaxf(am, fabsf(v[i]));
#pragma unroll
            for (int o = 1; o < 64; o <<= 1) am = fmaxf(am, __shfl_xor(am, o));
            const float inv = am > 0.f ? 127.f / am : 0.f; unsigned q[4];
#pragma unroll
            for (int i = 0; i < 4; ++i) q[i] = (unsigned)((int)rintf(v[4 * i] * inv) & 255) | ((unsigned)((int)rintf(v[4 * i + 1] * inv) & 255) << 8) | ((unsigned)((int)rintf(v[4 * i + 2] * inv) & 255) << 16) | ((unsigned)((int)rintf(v[4 * i + 3] * inv) & 255) << 24);
            *(uint4*)(dst + F.lane * 16) = make_uint4(q[0], q[1], q[2], q[3]);
            if (F.lane == 0) *sc = am * (1.f / 127.f);
        }
        modrows2(x, norm1_g, MOD, 0, 1, nullptr, XNQ, XS, F.gw, F.NGW, F.lane);
    }
    SEAM(1);
    if (IN(2)) REP(2) {
        pg8::Gemm g{(const bf16_t*)XNQ, (const bf16_t*)WINQ, T_, PP, 512, 512}; pg8::StaticOrder S; S.init(T_, PP, F.G, (int)blockIdx.x);
        pg8::EpiProjI8 E{PROJ, LOGF, SSQ, XS, WINS, fox_q_g, fox_k_g, b_f};
        pg8::gemm_phase<pg8::EpiProjI8, pg8::StaticOrder, true, true, true>(F.lds, g, S, E);
    }
    SEAM(2);
    if (IN(4)) REP(4) {
        { pg8::Gemm g{PROJ + C_CQ, WUQ, T_, 768, 384, PP}; pg8::StaticOrder S; S.init(T_, 768, F.G, (int)blockIdx.x); pg8::EpiStoreRms E{QA, 768, SSQ, 0, 1.f / 384.f};
          pg8::gemm_phase<pg8::EpiStoreRms, pg8::StaticOrder, true, true>(F.lds, g, S, E); }
        { pg8::Gemm g{PROJ + C_CKV, WUKV, T_, 1024, 256, PP}; pg8::StaticOrder S; S.init(T_, 1024, F.G, (int)blockIdx.x); pg8::EpiStoreRms E{KVRAW, 1024, SSQ, 8, 1.f / 256.f};
          pg8::gemm_phase<pg8::EpiStoreRms, pg8::StaticOrder, true, true>(F.lds, g, S, E); }
    }
    SEAM(4);
    if (IN(5)) {
        if (F.wave == 0 && (int)blockIdx.x < 32) fcum_item(LOGF, FCUM, (int)blockIdx.x, F.lane);
        for (int row = F.gw; row < T_; row += 2 * F.NGW) {
            const int row2 = row + F.NGW; MlaIn Ma, Mb;
            mlaprep_load(Ma, QA, KVRAW, PROJ, ROPE, row, F.lane); if (row2 < T_) mlaprep_load(Mb, QA, KVRAW, PROJ, ROPE, row2, F.lane);
            mlaprep_finish(Ma, QA, KA, mla_q_g, mla_k_g, row, F.lane); if (row2 < T_) mlaprep_finish(Mb, QA, KA, mla_q_g, mla_k_g, row2, F.lane);
        }
    }
    SEAM(5);
    if (IN(6)) {
        volatile LAS unsigned* qslot = MISC + 16;
        float thr;
        { float gq = fabsf(fox_q_g[F.lane]), gk = fabsf(fox_k_g[F.lane]);
#pragma unroll
          for (int o = 1; o < 64; o <<= 1) { gq = fmaxf(gq, __shfl_xor(gq, o)); gk = fmaxf(gk, __shfl_xor(gk, o)); }
          thr = 104.5f + 2.f * 1.02f * 8.f * gq * gk; }
        unsigned* qctr = ctl + 64;
        if (F.tid == 0) qslot[0] = atomicAdd(qctr, 1u);
        __syncthreads();
        unsigned u = qslot[0];
        while (u < 2048u + 1024u) {
            unsigned unext = 0u;
            if (F.tid == 0) unext = atomicAdd(qctr, 1u);
            if (u >= 2048u) {
                quant4(peer_u, peer_v, UQ, VQ, SU, SV, (int)(u - 2048u) * 32 + F.wave * 4, F.lane);
                if (F.tid == 0) qslot[0] = unext;
                __syncthreads();
                u = qslot[0];
                __syncthreads();
                continue;
            }
            const int grp = (int)(u >> 10), bh = (int)(u & 31u), qb = 31 - (int)((u >> 5) & 31u), b = bh >> 3, h = bh & 7;
            if (grp == 0) { const att::Desc d{QA + (size_t)b * S_ * 768 + h * 96, 768, KA + (size_t)b * S_ * 768 + h * 96, 768, KVRAW + (size_t)b * S_ * 1024 + h * 128 + 64, 1024, OB + (size_t)b * S_ * 1024 + h * 64, 1024, nullptr};
                att::attn_unit<6, false>(d, qb, 0, F.lds); }
            else { const bf16_t* pb = PROJ + (size_t)b * S_ * PP + h * 64; const float* fc = FCUM + (size_t)(b * 8 + h) * S_;
                const att::Desc d{pb + C_FQ, PP, pb + C_FK, PP, pb + C_FV, PP, OB + (size_t)b * S_ * 1024 + 512 + h * 64, 1024, fc};
                const int NT = 4 * (qb + 1); const float lim = fc[qb * 256] + thr;
                int j0 = 0;
                { const int ja = F.lane, jb2 = 64 + F.lane;
                  const bool ka = ja < NT ? (fc[64 * ja + 63] <= lim) : true, kb = jb2 < NT ? (fc[64 * jb2 + 63] <= lim) : true;
                  const unsigned long long ma = __ballot(ka), mb = __ballot(kb);
                  j0 = ma ? __builtin_ctzll(ma) : (mb ? 64 + __builtin_ctzll(mb) : NT - 4); }
                if (j0 > NT - 4) j0 = NT - 4;
                att::attn_unit<4, true>(d, qb, j0, F.lds); }
            if (F.tid == 0) qslot[0] = unext;
            __syncthreads();
            u = qslot[0];
            __syncthreads();
        }
    }
    SEAM(6);
    if (IN(7)) REP(7) {
        pg8::Gemm g{OB, WO, T_, 1024, 1024, 1024}; pg8::StaticOrder S; S.init(T_, 1024, F.G, (int)blockIdx.x);
        pg8::EpiResid E{x, MOD, out};
        pg8::gemm_phase<pg8::EpiResid, pg8::StaticOrder, true, true>(F.lds, g, S, E);
    }
    SEAM(7);
    if (IN(8)) modrows2(out, norm2_g, MOD, 3, 4, nullptr, H2Q, HS, F.gw, F.NGW, F.lane);
    SEAM(8);
    if (IN(9)) REP(9) {
        pg8::Gemm g{(const bf16_t*)H2Q, (const bf16_t*)WPQQ, T_, 2048, 512, 512}; pg8::StaticOrder S; S.init(T_, 2048, F.G, (int)blockIdx.x); pg8::EpiStoreI8 E{QP, 2048, HS, WPQS};
        pg8::gemm_phase<pg8::EpiStoreI8, pg8::StaticOrder, true, true, true>(F.lds, g, S, E);
    }
    SEAM(9);
    if (IN(10)) REP(10) { for (int w = F.gw; w < (T_ / 32) * 8; w += F.NGW) pk::topk_item(QP, SKB, EID, GATE, w, F.lane); }
    SEAM(10);
    {
        const int ng = F.G < 8 ? F.G : 8; const int vx = (int)blockIdx.x % ng, rank = (int)blockIdx.x / ng, nrank = (F.G - vx + ng - 1) / ng;
        const int gwv = rank * NWAVES + F.wave, ngwv = nrank * NWAVES;
        const int grp = F.lane >> 3, sub = F.lane & 7;
        int* PA = (int*)(ws + WS_PROJ);
        int* WQH = (int*)(ws + WS_KA); int* WQL = (int*)(ws + WS_KA + 4 * MiB); float* WSC = (float*)(ws + WS_KA + 8 * MiB);
        if (IN(11)) REP(11) {
            for (int s = vx; s < 8; s += ng) {
                const unsigned char* UQs = UQ + 128 * s + 16 * sub;
                int t = gwv; int4 ev[4]; int4 hq = make_int4(0, 0, 0, 0);
#pragma unroll
                for (int k = 0; k < 4; ++k) ev[k] = make_int4(0, 0, 0, 0);
                if (t < T_) {
#pragma unroll
                    for (int k = 0; k < 4; ++k) ev[k] = *(const int4*)(EID + (size_t)t * 128 + grp * 16 + 4 * k);
                    hq = *(const int4*)(H2Q + (size_t)t * 1024 + 128 * s + 16 * sub); }
                while (t < T_) {
                    const int tn = t + ngwv; int4 evn[4]; int4 hqn = make_int4(0, 0, 0, 0);
#pragma unroll
                    for (int k = 0; k < 4; ++k) evn[k] = make_int4(0, 0, 0, 0);
                    if (tn < T_) {
#pragma unroll
                        for (int k = 0; k < 4; ++k) evn[k] = *(const int4*)(EID + (size_t)tn * 128 + grp * 16 + 4 * k);
                        hqn = *(const int4*)(H2Q + (size_t)tn * 1024 + 128 * s + 16 * sub); }
                    gx::u_token(UQs, ev, hq, PA + ((size_t)s * T_ + t) * 128, F.lane);
                    t = tn; hq = hqn;
#pragma unroll
                    for (int k = 0; k < 4; ++k) ev[k] = evn[k];
                }
            }
        }
        SEAM(11);
        if (IN(12)) REP(12) {
            for (int t = F.gw; t < T_; t += F.NGW) {
                int i0 = 0, i1 = 0;
#pragma unroll
                for (int s = 0; s < 8; ++s) { const int2 p = *(const int2*)(PA + ((size_t)s * T_ + t) * 128 + 2 * F.lane); i0 += p.x; i1 += p.y; }
                const int2 e2 = *(const int2*)(EID + (size_t)t * 128 + 2 * F.lane); const float2 g2 = *(const float2*)(GATE + (size_t)t * 128 + 2 * F.lane); const float hs = HS[t];
                const float w0 = g2.x * gx::gelu_t((float)i0 * SU[e2.x] * hs) * SV[e2.x], w1 = g2.y * gx::gelu_t((float)i1 * SU[e2.y] * hs) * SV[e2.y];
                float wm = fmaxf(fabsf(w0), fabsf(w1));
#pragma unroll
                for (int o = 1; o < 64; o <<= 1) wm = fmaxf(wm, __shfl_xor(wm, o));
                const float inv = wm > 0.f ? 16256.f / wm : 0.f;
                const int q0 = (int)rintf(w0 * inv), q1 = (int)rintf(w1 * inv);
                const unsigned h2 = (unsigned)((q0 >> 7) & 255) | ((unsigned)((q1 >> 7) & 255) << 8), l2 = (unsigned)(q0 & 127) | ((unsigned)(q1 & 127) << 8);
                const unsigned h2p = __shfl_xor(h2, 1), l2p = __shfl_xor(l2, 1);
                if ((F.lane & 1) == 0) { WQH[(size_t)t * 32 + (F.lane >> 1)] = (int)(h2 | (h2p << 16)); WQL[(size_t)t * 32 + (F.lane >> 1)] = (int)(l2 | (l2p << 16)); }
                if (F.lane == 0) WSC[t] = wm * (1.f / 16256.f);
            }
        }
        SEAM(12);
        if (IN(13)) REP(13) {
            for (int s = vx; s < 8; s += ng) {
                const unsigned char* VQs = VQ + 128 * s + 16 * sub;
                int t = gwv; int4 ev[4]; int4 wh = make_int4(0, 0, 0, 0), wl = make_int4(0, 0, 0, 0); float wsc = 0.f;
#pragma unroll
                for (int k = 0; k < 4; ++k) ev[k] = make_int4(0, 0, 0, 0);
                if (t < T_) {
#pragma unroll
                    for (int k = 0; k < 4; ++k) ev[k] = *(const int4*)(EID + (size_t)t * 128 + grp * 16 + 4 * k);
                    wh = *(const int4*)(WQH + (size_t)t * 32 + grp * 4); wl = *(const int4*)(WQL + (size_t)t * 32 + grp * 4); wsc = WSC[t]; }
                while (t < T_) {
                    const int tn = t + ngwv; int4 evn[4]; int4 whn = make_int4(0, 0, 0, 0), wln = make_int4(0, 0, 0, 0); float wscn = 0.f;
#pragma unroll
                    for (int k = 0; k < 4; ++k) evn[k] = make_int4(0, 0, 0, 0);
                    if (tn < T_) {
#pragma unroll
                        for (int k = 0; k < 4; ++k) evn[k] = *(const int4*)(EID + (size_t)tn * 128 + grp * 16 + 4 * k);
                        whn = *(const int4*)(WQH + (size_t)tn * 32 + grp * 4); wln = *(const int4*)(WQL + (size_t)tn * 32 + grp * 4); wscn = WSC[tn]; }
                    float* dstrow = (PROBE_DUP == 13 && _r == 0) ? (float*)(ws + WS_XN) + (size_t)t * 1024 : out + (size_t)t * 1024;
                    gx::v_token(VQs, ev, wh, wl, wsc, MOD + (t / S_) * 6144 + 5 * 1024, out + (size_t)t * 1024, dstrow, s, F.lane);
                    t = tn; wh = whn; wl = wln; wsc = wscn;
#pragma unroll
                    for (int k = 0; k < 4; ++k) ev[k] = evn[k];
                }
            }
        }
    }
#undef IN
#undef SEAM
}

static int g_grid = 0;
static void launch_mega(const Args& base, int lo, int hi, int li, hipStream_t stream) {
    Args a = base; a.ph_lo = lo; a.ph_hi = hi; a.li = li;
    hipLaunchKernelGGL(mega_fwd, dim3(g_grid), dim3(NWAVES * 64), LDS_BYTES, stream, a);
}

extern "C" void kernel_launch(void* const* d_in, const int* in_sizes, int n_in, void* d_out, int out_size, void* d_ws, size_t ws_size, hipStream_t stream) {
    if (g_grid == 0) {
        int dev = 0, cus = 0;
        hipGetDevice(&dev); hipDeviceGetAttribute(&cus, hipDeviceAttributeMultiprocessorCount, dev);
        hipFuncSetAttribute((const void*)mega_fwd, hipFuncAttributeMaxDynamicSharedMemorySize, LDS_BYTES);
        int per_cu = 0; hipOccupancyMaxActiveBlocksPerMultiprocessor(&per_cu, (const void*)mega_fwd, NWAVES * 64, LDS_BYTES);
        (void)hipGetLastError();
        g_grid = cus > 0 ? cus : 256;
        if (per_cu < 1) fprintf(stderr, "kernel_launch: occupancy query says %d blocks/CU\n", per_cu);
    }
    const float* x = (const float*)d_in[0]; const int* positions = (const int*)d_in[2];
    const float* mla_qa_g = (const float*)d_in[7]; const float* mla_kva_g = (const float*)d_in[8];
    const float* mla_q_g = (const float*)d_in[11]; const float* mla_k_g = (const float*)d_in[12]; const float* fox_q_g = (const float*)d_in[13]; const float* fox_k_g = (const float*)d_in[14];
    const float* b_f = (const float*)d_in[15]; const float* sub_keys = (const float*)d_in[19]; const float* peer_u = (const float*)d_in[20]; const float* peer_v = (const float*)d_in[21];
    float* out = (float*)d_out; unsigned char* ws = (unsigned char*)d_ws;
    float* MOD = (float*)(ws + WS_MOD); float* FL = (float*)(ws + WS_FL); float* FCUM = (float*)(ws + WS_FCUM); float* LOGF = (float*)(ws + WS_LOGF); float2* ROPE = (float2*)(ws + WS_ROPE);
    bf16_t* XN = (bf16_t*)(ws + WS_XN); bf16_t* PROJ = (bf16_t*)(ws + WS_PROJ); bf16_t* KVRAW = (bf16_t*)(ws + WS_KVRAW); bf16_t* QA = (bf16_t*)(ws + WS_QA); bf16_t* KA = (bf16_t*)(ws + WS_KA);
    bf16_t* OB = XN; bf16_t* H2 = XN; bf16_t* QP = PROJ; int* EID = (int*)(ws + WS_QA); float* GATE = (float*)(ws + WS_QA + 16 * MiB);
    (void)x;
    hipMemsetAsync(ws + WS_CTL, 0, CTL_ZERO_BYTES, stream);
    Args base{}; for (int i = 0; i < 22; ++i) base.in[i] = d_in[i]; base.out = out; base.ws = ws;

    launch_mega(base, 0, 14, 0, stream);
}
```

```cpp
#include <hip/hip_runtime.h>
#ifndef PROBE_DUP
#define PROBE_DUP -1
#endif
#define REP(k) for (int _r = 0; _r < ((PROBE_DUP == (k)) ? 2 : 1); ++_r)
#include <cstdint>
#include <cstdio>
#include <cmath>

typedef unsigned short bf16_t;
constexpr int B_ = 4, S_ = 8192, D_ = 1024, T_ = B_ * S_;
constexpr int PP = 2304;
constexpr int C_CQ = 0, C_CKV = 384, C_KPE = 640, C_FQ = 672, C_FK = 1184, C_FV = 1696, C_FL = 2208, INW = 2216;
constexpr float EPS = 1e-6f;
constexpr float LOG2E = 1.4426950408889634f;
constexpr float C2A = 0.10206207261596577f * LOG2E;
constexpr float C2F = 0.125f * LOG2E;

__device__ __forceinline__ float bf2f(bf16_t v) { return __uint_as_float(((unsigned)v) << 16); }
__device__ __forceinline__ bf16_t f2bf(float f) { unsigned u = __float_as_uint(f); return (bf16_t)((u + 0x7fffu + ((u >> 16) & 1u)) >> 16); }
__device__ __forceinline__ unsigned pk2(float lo, float hi) { return (unsigned)f2bf(lo) | ((unsigned)f2bf(hi) << 16); }
__device__ __forceinline__ float lo2f(unsigned w) { return __uint_as_float(w << 16); }
__device__ __forceinline__ float hi2f(unsigned w) { return __uint_as_float(w & 0xffff0000u); }
__device__ __forceinline__ float wave_sum(float v) {
#pragma unroll
    for (int o = 1; o < 64; o <<= 1) v += __shfl_xor(v, o);
    return v;
}

constexpr size_t MiB = 1u << 20;
constexpr size_t WS_MOD = 1 * MiB;
constexpr size_t WS_FL = 3 * MiB;
constexpr size_t WS_FCUM = 4 * MiB;
constexpr size_t WS_LOGF = 5 * MiB;
constexpr size_t WS_ROPE = 6 * MiB;
constexpr size_t WS_XN = 88 * MiB;
constexpr size_t WS_PROJ = 152 * MiB;
constexpr size_t WS_KVRAW = 296 * MiB;
constexpr size_t WS_QA = 360 * MiB;
constexpr size_t WS_KA = 408 * MiB;

__global__ void k_mod(const float* c, const float* w_ada, const float* b_ada, float* mod) {
    const int j = blockIdx.x * 256 + threadIdx.x, b = blockIdx.y;
    float acc = b_ada[j];
    for (int k = 0; k < 1024; ++k) { const float cv = c[b * 1024 + k]; const float s = cv / (1.f + expf(-cv)); acc += s * w_ada[(size_t)k * 6144 + j]; }
    mod[b * 6144 + j] = acc;
}

__global__ void __launch_bounds__(256) k_modrows(const float* X, const float* g, const float* mod, int shift_idx, int scale_idx, bf16_t* out) {
    const int wave = threadIdx.x >> 6, lane = threadIdx.x & 63;
    const int row = blockIdx.x * 4 + wave, b = row / S_;
    const float4* xr = (const float4*)(X + (size_t)row * 1024) + lane;
    float4 v[4]; float ss = 0.f;
#pragma unroll
    for (int j = 0; j < 4; ++j) { v[j] = xr[64 * j]; ss += (v[j].x * v[j].x + v[j].y * v[j].y) + (v[j].z * v[j].z + v[j].w * v[j].w); }
    ss = wave_sum(ss);
    const float r = rsqrtf(ss * (1.f / 1024.f) + EPS);
    const float* sh = mod + b * 6144 + shift_idx * 1024; const float* sc = mod + b * 6144 + scale_idx * 1024;
#pragma unroll
    for (int j = 0; j < 4; ++j) {
        const int col = 4 * lane + 256 * j;
        const float4 g4 = *(const float4*)(g + col), s4 = *(const float4*)(sc + col), h4 = *(const float4*)(sh + col);
        const float o0 = v[j].x * r * g4.x * (1.f + s4.x) + h4.x, o1 = v[j].y * r * g4.y * (1.f + s4.y) + h4.y;
        const float o2 = v[j].z * r * g4.z * (1.f + s4.z) + h4.z, o3 = v[j].w * r * g4.w * (1.f + s4.w) + h4.w;
        uint2 w; w.x = pk2(o0, o1); w.y = pk2(o2, o3);
        *(uint2*)(out + (size_t)row * 1024 + col) = w;
    }
}

template <int MODE>
__global__ void __launch_bounds__(256) k_gemm_naive(const bf16_t* A, int lda, const float* W, int K, int N, void* Cout, int ldc, const float* aux1, const float* aux2, float* fl) {
    __shared__ float As[16][64];
    __shared__ float Ws[16][64];
    const int tx = threadIdx.x & 15, ty = threadIdx.x >> 4;
    const int m0 = blockIdx.y * 64, n0 = blockIdx.x * 64;
    float acc[4][4];
#pragma unroll
    for (int i = 0; i < 4; ++i)
#pragma unroll
        for (int j = 0; j < 4; ++j) acc[i][j] = 0.f;
    for (int k0 = 0; k0 < K; k0 += 16) {
        { const int r = threadIdx.x >> 2, kq = (threadIdx.x & 3) * 4; const uint2 a2 = *(const uint2*)(A + (size_t)(m0 + r) * lda + k0 + kq);
          As[kq + 0][r] = lo2f(a2.x); As[kq + 1][r] = hi2f(a2.x); As[kq + 2][r] = lo2f(a2.y); As[kq + 3][r] = hi2f(a2.y); }
        { const int kk = threadIdx.x >> 4, nq = (threadIdx.x & 15) * 4; float4 w4 = make_float4(0.f, 0.f, 0.f, 0.f);
          if (n0 + nq < N) w4 = *(const float4*)(W + (size_t)(k0 + kk) * N + n0 + nq);
          *(float4*)&Ws[kk][nq] = w4; }
        __syncthreads();
#pragma unroll
        for (int kk = 0; kk < 16; ++kk) {
            const float4 a4 = *(const float4*)&As[kk][ty * 4]; const float4 w4 = *(const float4*)&Ws[kk][tx * 4];
            const float a[4] = {a4.x, a4.y, a4.z, a4.w}; const float w[4] = {w4.x, w4.y, w4.z, w4.w};
#pragma unroll
            for (int i = 0; i < 4; ++i)
#pragma unroll
                for (int j = 0; j < 4; ++j) acc[i][j] += a[i] * w[j];
        }
        __syncthreads();
    }
#pragma unroll
    for (int i = 0; i < 4; ++i) {
        const int m = m0 + ty * 4 + i;
#pragma unroll
        for (int j = 0; j < 4; ++j) {
            const int n = n0 + tx * 4 + j;
            if (n < N) {
                if (MODE == 0) ((bf16_t*)Cout)[(size_t)m * ldc + n] = f2bf(acc[i][j]);
                else if (MODE == 1) { if (n < C_FL) ((bf16_t*)Cout)[(size_t)m * ldc + n] = f2bf(acc[i][j]); else fl[(size_t)m * 8 + (n - C_FL)] = acc[i][j]; }
                else { const int b = m / S_; ((float*)Cout)[(size_t)m * ldc + n] = aux1[(size_t)m * 1024 + n] + aux2[b * 6144 + 2 * 1024 + n] * acc[i][j]; }
            }
        }
    }
}

__device__ __forceinline__ void unpack8(const uint4 raw, float* v) {
    v[0] = lo2f(raw.x); v[1] = hi2f(raw.x); v[2] = lo2f(raw.y); v[3] = hi2f(raw.y); v[4] = lo2f(raw.z); v[5] = hi2f(raw.z); v[6] = lo2f(raw.w); v[7] = hi2f(raw.w);
}
struct RowPrepIn { uint4 cq, ckv, fq, fk; float fl; int pos; };
__device__ __forceinline__ void rowprep_load(RowPrepIn& R, const bf16_t* PROJ, const float* FL, const int* positions, int row, int lane) {
    const bf16_t* pr = PROJ + (size_t)row * PP;
    R.cq = lane < 48 ? *(const uint4*)(pr + C_CQ + lane * 8) : make_uint4(0u, 0u, 0u, 0u);
    R.ckv = lane < 32 ? *(const uint4*)(pr + C_CKV + lane * 8) : make_uint4(0u, 0u, 0u, 0u);
    R.fq = *(const uint4*)(pr + C_FQ + lane * 8); R.fk = *(const uint4*)(pr + C_FK + lane * 8);
    R.fl = lane < 8 ? FL[(size_t)row * 8 + lane] : 0.f; R.pos = positions[row];
}
__device__ __forceinline__ uint4 scale8(const float* v, float r, const float* g) {
    uint4 o; o.x = pk2(v[0] * r * g[0], v[1] * r * g[1]); o.y = pk2(v[2] * r * g[2], v[3] * r * g[3]); o.z = pk2(v[4] * r * g[4], v[5] * r * g[5]); o.w = pk2(v[6] * r * g[6], v[7] * r * g[7]); return o;
}
__device__ __forceinline__ void rowprep_finish(const RowPrepIn& R, bf16_t* PROJ, const float* g_qa, const float* g_kva, const float* g_fq, const float* g_fk, const float* b_f,
                                               float* LOGF, float2* ROPE, int row, int lane, float invf) {
    bf16_t* pr = PROJ + (size_t)row * PP;
    float vq[8], vk[8], v1[8], v2[8];
    unpack8(R.cq, vq); unpack8(R.ckv, vk); unpack8(R.fq, v1); unpack8(R.fk, v2);
    float sq = 0.f, sk = 0.f, s1 = 0.f, s2 = 0.f;
#pragma unroll
    for (int i = 0; i < 8; ++i) { sq += vq[i] * vq[i]; sk += vk[i] * vk[i]; s1 += v1[i] * v1[i]; s2 += v2[i] * v2[i]; }
    s1 += __shfl_xor(s1, 1); s2 += __shfl_xor(s2, 1); s1 += __shfl_xor(s1, 2); s2 += __shfl_xor(s2, 2); s1 += __shfl_xor(s1, 4); s2 += __shfl_xor(s2, 4);
#pragma unroll
    for (int o = 1; o < 64; o <<= 1) { sq += __shfl_xor(sq, o); sk += __shfl_xor(sk, o); }
    const float rq = rsqrtf(sq * (1.f / 384.f) + EPS), rk = rsqrtf(sk * (1.f / 256.f) + EPS);
    const float r1 = rsqrtf(s1 * (1.f / 64.f) + EPS) * C2F, r2 = rsqrtf(s2 * (1.f / 64.f) + EPS);
    if (lane < 48) *(uint4*)(pr + C_CQ + lane * 8) = scale8(vq, rq, g_qa + lane * 8);
    if (lane < 32) *(uint4*)(pr + C_CKV + lane * 8) = scale8(vk, rk, g_kva + lane * 8);
    *(uint4*)(pr + C_FQ + lane * 8) = scale8(v1, r1, g_fq + (lane & 7) * 8);
    *(uint4*)(pr + C_FK + lane * 8) = scale8(v2, r2, g_fk + (lane & 7) * 8);
    if (lane < 8) { const float z = R.fl + b_f[lane]; LOGF[((size_t)(row / S_) * 8 + lane) * S_ + (row % S_)] = fminf(z, 0.f) - log1pf(expf(-fabsf(z))); }
    if (lane < 16) {
        const double a = (double)((float)R.pos * invf), n = rint(a * 0.15915494309189535);
        const float red = (float)(a - n * 6.283185307179586);
        ROPE[(size_t)row * 16 + lane] = make_float2(__cosf(red), __sinf(red)); }
}
__device__ __forceinline__ void rowprep_row(bf16_t* PROJ, const float* FL, const float* g_qa, const float* g_kva, const float* g_fq, const float* g_fk, const float* b_f,
                                                 const int* positions, float* LOGF, float2* ROPE, int row, int lane) {
    const float invf = (float)exp2(-(double)(lane & 15) * (13.287712379549449 / 16.0));
    RowPrepIn R; rowprep_load(R, PROJ, FL, positions, row, lane); rowprep_finish(R, PROJ, g_qa, g_kva, g_fq, g_fk, b_f, LOGF, ROPE, row, lane, invf);
}
__global__ void __launch_bounds__(256) k_rowprep(bf16_t* PROJ, const float* FL, const float* g_qa, const float* g_kva, const float* g_fq, const float* g_fk, const float* b_f,
                                                 const int* positions, float* LOGF, float2* ROPE) {
    rowprep_row(PROJ, FL, g_qa, g_kva, g_fq, g_fk, b_f, positions, LOGF, ROPE, blockIdx.x * 4 + (threadIdx.x >> 6), threadIdx.x & 63);
}

__device__ __forceinline__ void fcum_item(const float* LOGF, float* FCUM, int item, int lane) {
    const float4* src = (const float4*)(LOGF + (size_t)item * S_ + 128 * lane);
    float4 v[32]; float tot = 0.f;
#pragma unroll
    for (int i = 0; i < 32; ++i) v[i] = src[i];
#pragma unroll
    for (int i = 0; i < 32; ++i) tot += (v[i].x + v[i].y) + (v[i].z + v[i].w);
    float incl = tot;
#pragma unroll
    for (int o = 1; o < 64; o <<= 1) { const float t = __shfl_up(incl, o); if (lane >= o) incl += t; }
    float run = incl - tot;
    float4* dst = (float4*)(FCUM + (size_t)item * S_ + 128 * lane);
#pragma unroll
    for (int i = 0; i < 32; ++i) { float4 o; run += v[i].x; o.x = run; run += v[i].y; o.y = run; run += v[i].z; o.z = run; run += v[i].w; o.w = run; dst[i] = o; }
}
__global__ void __launch_bounds__(64) k_fcum(const float* LOGF, float* FCUM) { fcum_item(LOGF, FCUM, blockIdx.x, threadIdx.x); }

struct MlaIn { uint4 qn, kn; unsigned q1, q2, k1, k2; float2 cs0, cs1; };
__device__ __forceinline__ void mlaprep_load(MlaIn& M, const bf16_t* QRAW, const bf16_t* KVRAW, const bf16_t* PROJ, const float2* ROPE, int row, int lane) {
    const int h = lane >> 3, p = lane & 7;
    const bf16_t* q = QRAW + (size_t)row * 768 + h * 96; const bf16_t* kp = PROJ + (size_t)row * PP + C_KPE;
    M.qn = *(const uint4*)(q + 8 * p); M.q1 = *(const unsigned*)(q + 64 + 2 * p); M.q2 = *(const unsigned*)(q + 80 + 2 * p);
    M.kn = *(const uint4*)(KVRAW + (size_t)row * 1024 + h * 128 + 8 * p); M.k1 = *(const unsigned*)(kp + 2 * p); M.k2 = *(const unsigned*)(kp + 16 + 2 * p);
    M.cs0 = ROPE[(size_t)row * 16 + 2 * p]; M.cs1 = ROPE[(size_t)row * 16 + 2 * p + 1];
}
__device__ __forceinline__ void mlaprep_finish(const MlaIn& M, bf16_t* QRAW, bf16_t* KA, const float* g_q, const float* g_k, int row, int lane) {
    const int h = lane >> 3, p = lane & 7;
#pragma unroll
    for (int which = 0; which < 2; ++which) {
        const float* g = which == 0 ? g_q : g_k; const float sc = which == 0 ? C2A : 1.f;
        float v[8]; unpack8(which == 0 ? M.qn : M.kn, v); const unsigned r1 = which == 0 ? M.q1 : M.k1, r2 = which == 0 ? M.q2 : M.k2;
        float a0 = lo2f(r1), a1 = hi2f(r1), b0 = lo2f(r2), b1 = hi2f(r2);
        float ss = a0 * a0 + a1 * a1 + b0 * b0 + b1 * b1;
#pragma unroll
        for (int i = 0; i < 8; ++i) ss += v[i] * v[i];
        ss += __shfl_xor(ss, 1); ss += __shfl_xor(ss, 2); ss += __shfl_xor(ss, 4);
        const float r = rsqrtf(ss * (1.f / 96.f) + EPS);
        const float* gn = g + 8 * p;
        a0 *= r * g[64 + 2 * p]; a1 *= r * g[64 + 2 * p + 1]; b0 *= r * g[80 + 2 * p]; b1 *= r * g[80 + 2 * p + 1];
        const float ra0 = a0 * M.cs0.x - b0 * M.cs0.y, rb0 = b0 * M.cs0.x + a0 * M.cs0.y, ra1 = a1 * M.cs1.x - b1 * M.cs1.y, rb1 = b1 * M.cs1.x + a1 * M.cs1.y;
        uint4 o; o.x = pk2(v[0] * r * gn[0] * sc, v[1] * r * gn[1] * sc); o.y = pk2(v[2] * r * gn[2] * sc, v[3] * r * gn[3] * sc);
        o.z = pk2(v[4] * r * gn[4] * sc, v[5] * r * gn[5] * sc); o.w = pk2(v[6] * r * gn[6] * sc, v[7] * r * gn[7] * sc);
        bf16_t* dst = (which == 0 ? QRAW : KA) + (size_t)row * 768 + h * 96;
        *(uint4*)(dst + 8 * p) = o; *(unsigned*)(dst + 64 + 2 * p) = pk2(ra0 * sc, ra1 * sc); *(unsigned*)(dst + 80 + 2 * p) = pk2(rb0 * sc, rb1 * sc);
    }
}
__device__ __forceinline__ void mlaprep_row(bf16_t* QRAW, const bf16_t* KVRAW, const bf16_t* PROJ, bf16_t* KA, const float2* ROPE, const float* g_q, const float* g_k, int row, int lane) {
    MlaIn M; mlaprep_load(M, QRAW, KVRAW, PROJ, ROPE, row, lane); mlaprep_finish(M, QRAW, KA, g_q, g_k, row, lane);
}

__global__ void __launch_bounds__(256) k_mlaprep(bf16_t* QRAW, const bf16_t* KVRAW, const bf16_t* PROJ, bf16_t* KA, const float2* ROPE, const float* g_q, const float* g_k) {
    mlaprep_row(QRAW, KVRAW, PROJ, KA, ROPE, g_q, g_k, blockIdx.x * 4 + (threadIdx.x >> 6), threadIdx.x & 63);
}

template <int DK>
__global__ void __launch_bounds__(256) k_attn_naive(const bf16_t* Q, int pq, int qstep, const bf16_t* K, int pk, int kstep, const bf16_t* V, int pv, int vstep, bf16_t* O, int po, int ostep, const float* FCUM) {
    __shared__ float Ks[64][DK];
    __shared__ float Vs[64][64];
    __shared__ float Bs[64];
    const int bh = blockIdx.x >> 5, qb = blockIdx.x & 31, b = bh >> 3, h = bh & 7;
    const int t = qb * 256 + threadIdx.x;
    const size_t row = (size_t)b * S_ + t;
    float q[DK];
#pragma unroll
    for (int c = 0; c < DK / 8; ++c) unpack8(*(const uint4*)(Q + row * pq + h * qstep + c * 8), q + c * 8);
    float o[64];
#pragma unroll
    for (int d = 0; d < 64; ++d) o[d] = 0.f;
    float m = -INFINITY, l = 0.f;
    const float fq = FCUM ? FCUM[(size_t)(b * 8 + h) * S_ + t] : 0.f;
    const int ntiles = (qb * 256 + 256) / 64;
    for (int kt = 0; kt < ntiles; ++kt) {
        __syncthreads();
        for (int c = threadIdx.x; c < 64 * (DK / 8); c += 256) { const int key = c / (DK / 8), ch = c % (DK / 8); float v[8];
            unpack8(*(const uint4*)(K + ((size_t)b * S_ + kt * 64 + key) * pk + h * kstep + ch * 8), v);
#pragma unroll
            for (int i = 0; i < 8; ++i) Ks[key][ch * 8 + i] = v[i]; }
        for (int c = threadIdx.x; c < 64 * 8; c += 256) { const int key = c >> 3, ch = c & 7; float v[8];
            unpack8(*(const uint4*)(V + ((size_t)b * S_ + kt * 64 + key) * pv + h * vstep + ch * 8), v);
#pragma unroll
            for (int i = 0; i < 8; ++i) Vs[key][ch * 8 + i] = v[i]; }
        if (threadIdx.x < 64) Bs[threadIdx.x] = FCUM ? FCUM[(size_t)(b * 8 + h) * S_ + kt * 64 + threadIdx.x] : 0.f;
        __syncthreads();
        const int kmax = t - kt * 64 + 1;
        for (int kk = 0; kk < 64; ++kk) {
            float s = 0.f;
#pragma unroll
            for (int d = 0; d < DK; ++d) s += q[d] * Ks[kk][d];
            if (FCUM) s += (fq - Bs[kk]) * LOG2E;
            if (kk < kmax) {
                const float mn = fmaxf(m, s), corr = exp2f(m - mn), p = exp2f(s - mn);
                l = l * corr + p;
#pragma unroll
                for (int d = 0; d < 64; ++d) o[d] = o[d] * corr + p * Vs[kk][d];
                m = mn;
            }
        }
    }
    const float rl = 1.f / l;
    bf16_t* op = O + row * po + h * ostep;
#pragma unroll
    for (int c = 0; c < 8; ++c) { uint4 w; w.x = pk2(o[c * 8 + 0] * rl, o[c * 8 + 1] * rl); w.y = pk2(o[c * 8 + 2] * rl, o[c * 8 + 3] * rl); w.z = pk2(o[c * 8 + 4] * rl, o[c * 8 + 5] * rl); w.w = pk2(o[c * 8 + 6] * rl, o[c * 8 + 7] * rl);
        *(uint4*)(op + c * 8) = w; }
}

__device__ __forceinline__ void topk_item(const bf16_t* QP, const float* sub_keys, int* EID, float* GATE, int w, int lane) {
    const int t = w >> 3, h = w & 7;
    float sl0 = 0.f, sl1 = 0.f; int il0 = 0, il1 = 0;
#pragma unroll
    for (int p = 0; p < 2; ++p) {
        const bf16_t* q = QP + (size_t)t * 2048 + h * 256 + p * 128;
        const float* k0 = sub_keys + ((size_t)(h * 2 + p) * 128 + lane) * 128; const float* k1 = k0 + 64 * 128;
        float s0 = 0.f, s1 = 0.f;
        for (int d = 0; d < 128; ++d) { const float qd = bf2f(q[d]); s0 += qd * k0[d]; s1 += qd * k1[d]; }
        float ls = 0.f; int li = 0;
        for (int r = 0; r < 16; ++r) {
            float bv; int bi; if (s0 >= s1) { bv = s0; bi = lane; } else { bv = s1; bi = lane + 64; }
#pragma unroll
            for (int o = 32; o >= 1; o >>= 1) { const float ov = __shfl_xor(bv, o); const int oi = __shfl_xor(bi, o); if (ov > bv || (ov == bv && oi < bi)) { bv = ov; bi = oi; } }
            if (lane == r) { ls = bv; li = bi; }
            if (bi == lane) s0 = -INFINITY; else if (bi == lane + 64) s1 = -INFINITY;
        }
        if (p == 0) { sl0 = ls; il0 = li; } else { sl1 = ls; il1 = li; }
    }
    float cv0, cv1, cv2, cv3;
    { const int c0 = lane, c1 = lane + 64, c2 = lane + 128, c3 = lane + 192;
      cv0 = __shfl(sl0, c0 >> 4) + __shfl(sl1, c0 & 15); cv1 = __shfl(sl0, c1 >> 4) + __shfl(sl1, c1 & 15);
      cv2 = __shfl(sl0, c2 >> 4) + __shfl(sl1, c2 & 15); cv3 = __shfl(sl0, c3 >> 4) + __shfl(sl1, c3 & 15); }
    float tv = -INFINITY; int tc = 0;
    for (int r = 0; r < 16; ++r) {
        float bv = cv0; int bc = lane;
        if (cv1 > bv) { bv = cv1; bc = lane + 64; }
        if (cv2 > bv) { bv = cv2; bc = lane + 128; }
        if (cv3 > bv) { bv = cv3; bc = lane + 192; }
#pragma unroll
        for (int o = 32; o >= 1; o >>= 1) { const float ov = __shfl_xor(bv, o); const int oc = __shfl_xor(bc, o); if (ov > bv || (ov == bv && oc < bc)) { bv = ov; bc = oc; } }
        if (lane == r) { tv = bv; tc = bc; }
        if (bc == lane) cv0 = -INFINITY; else if (bc == lane + 64) cv1 = -INFINITY; else if (bc == lane + 128) cv2 = -INFINITY; else if (bc == lane + 192) cv3 = -INFINITY;
    }
    const float mx = __shfl(tv, 0);
    const float e = lane < 16 ? expf(tv - mx) : 0.f;
    const float sum = wave_sum(e);
    const int e1 = __shfl(il0, (tc >> 4) & 15), e2 = __shfl(il1, tc & 15);
    if (lane < 16) { EID[(size_t)t * 128 + h * 16 + lane] = e1 * 128 + e2; GATE[(size_t)t * 128 + h * 16 + lane] = e / sum; }
}

__global__ void __launch_bounds__(256) k_topk_naive(const bf16_t* QP, const float* sub_keys, int* EID, float* GATE) { topk_item(QP, sub_keys, EID, GATE, blockIdx.x * 4 + (threadIdx.x >> 6), threadIdx.x & 63); }

__device__ __forceinline__ float gelu_tanh(float x) { const float u = 0.7978845608028654f * (x + 0.044715f * x * x * x); return 0.5f * x * (1.f + tanhf(u)); }

__device__ __forceinline__ void gather_item(const bf16_t* H2, const int* EID, const float* GATE, const float* peer_u, const float* peer_v, const float* mod, float* out, int t, int lane) {
    const int b = t / S_;
    float hv[16], y[16];
#pragma unroll
    for (int j = 0; j < 4; ++j) { const uint2 raw = *(const uint2*)(H2 + (size_t)t * 1024 + 4 * lane + 256 * j); hv[4 * j] = lo2f(raw.x); hv[4 * j + 1] = hi2f(raw.x); hv[4 * j + 2] = lo2f(raw.y); hv[4 * j + 3] = hi2f(raw.y); }
#pragma unroll
    for (int i = 0; i < 16; ++i) y[i] = 0.f;
    const int e_a = EID[(size_t)t * 128 + lane], e_b = EID[(size_t)t * 128 + 64 + lane];
    const float g_a = GATE[(size_t)t * 128 + lane], g_b = GATE[(size_t)t * 128 + 64 + lane];
    for (int jj = 0; jj < 128; ++jj) {
        const int e = jj < 64 ? __shfl(e_a, jj) : __shfl(e_b, jj - 64);
        const float g = jj < 64 ? __shfl(g_a, jj) : __shfl(g_b, jj - 64);
        const float4* ur = (const float4*)(peer_u + (size_t)e * 1024) + lane;
        float s = 0.f;
#pragma unroll
        for (int j = 0; j < 4; ++j) { const float4 u4 = ur[64 * j]; s += (u4.x * hv[4 * j] + u4.y * hv[4 * j + 1]) + (u4.z * hv[4 * j + 2] + u4.w * hv[4 * j + 3]); }
        s = wave_sum(s);
        const float wgt = g * gelu_tanh(s);
        const float4* vr = (const float4*)(peer_v + (size_t)e * 1024) + lane;
#pragma unroll
        for (int j = 0; j < 4; ++j) { const float4 v4 = vr[64 * j]; y[4 * j] += wgt * v4.x; y[4 * j + 1] += wgt * v4.y; y[4 * j + 2] += wgt * v4.z; y[4 * j + 3] += wgt * v4.w; }
    }
    const float* g2 = mod + b * 6144 + 5 * 1024;
#pragma unroll
    for (int j = 0; j < 4; ++j) { const int col = 4 * lane + 256 * j; float4* op = (float4*)(out + (size_t)t * 1024 + col); float4 x1 = *op; const float4 gg = *(const float4*)(g2 + col);
        x1.x += gg.x * y[4 * j]; x1.y += gg.y * y[4 * j + 1]; x1.z += gg.z * y[4 * j + 2]; x1.w += gg.w * y[4 * j + 3]; *op = x1; }
}
__global__ void __launch_bounds__(256) k_gather_naive(const bf16_t* H2, const int* EID, const float* GATE, const float* peer_u, const float* peer_v, const float* mod, float* out) {
    gather_item(H2, EID, GATE, peer_u, peer_v, mod, out, blockIdx.x * 4 + (threadIdx.x >> 6), threadIdx.x & 63);
}


namespace pg8 {
#define PG8_LAS __attribute__((address_space(3)))
typedef unsigned short bf16_t;
typedef short bf16x8 __attribute__((ext_vector_type(8)));
typedef float f32x4 __attribute__((ext_vector_type(4)));
typedef unsigned u32x4 __attribute__((ext_vector_type(4)));
constexpr int BM = 256, BK = 64, HALF = 128, HTB = HALF * BK * 2  , STAGE_BYTES = 8 * HTB, NXCD = 8, WGM = 8;

__host__ __device__ __forceinline__ int lds_byte(int r, int c) { const int st = (r >> 4) * 2 + (c >> 5), rr = r & 15, cc = c & 31, ob = rr * 64 + cc * 2; return st * 1024 + (ob ^ (((ob >> 9) & 1) << 5)); }
__host__ __device__ __forceinline__ void stage_rc(int b, int& R, int& C) { const int st = b / 1024, sb = b % 1024, swz = sb ^ (((sb >> 9) & 1) << 5); R = (st >> 1) * 16 + swz / 64; C = (st & 1) * 32 + (swz % 64) / 2; }
__host__ __device__ __forceinline__ int perm32(int rho) { const int n = rho >> 4, i = rho & 15; return 8 * (i >> 2) + 4 * n + (i & 3); }

struct Unit { int pm, pn; };
struct Gemm { const bf16_t* A; const bf16_t* Bt; int M, N, K, lda; };

struct StaticOrder {
    int nM, nN, nwg, G, c;
    __host__ __device__ void init(int M, int N, int G_, int c_) { nM = M / BM; nN = N / BM; nwg = nM * nN; G = G_; c = c_; }
    __host__ __device__ bool next(int i, Unit& u) const {
        const long L = (long)i * G + c; if (L >= nwg) return false;
        int wgid = (int)L; { const int q = nwg / NXCD, r = nwg % NXCD, xcd = wgid % NXCD, off = wgid / NXCD; wgid = (xcd < r ? xcd * (q + 1) : r * (q + 1) + (xcd - r) * q) + off; }
        const int nig = WGM * nN, gid = wgid / nig, fm = gid * WGM, gsz = (nM - fm) < WGM ? (nM - fm) : WGM;
        u.pm = fm + ((wgid % nig) % gsz); u.pn = (wgid % nig) / gsz; return true;
    }
    __device__ __forceinline__ void a_ready(const Unit&) const {}
    __device__ __forceinline__ void done(const Unit&) const {}
};
__device__ __forceinline__ unsigned cvt_pk_bf16(float lo, float hi) { unsigned r; asm volatile("v_cvt_pk_bf16_f32 %0, %1, %2" : "=v"(r) : "v"(lo), "v"(hi)); return r; }
typedef float f32x2 __attribute__((ext_vector_type(2)));
typedef int i32x4 __attribute__((ext_vector_type(4)));
template <bool I8> struct AccT { typedef f32x4 type; };
template <> struct AccT<true> { typedef i32x4 type; };
__device__ __forceinline__ f32x4 mma16(const bf16x8 b, const bf16x8 a, const f32x4 c) { return __builtin_amdgcn_mfma_f32_16x16x32_bf16(b, a, c, 0, 0, 0); }
__device__ __forceinline__ i32x4 mma16(const bf16x8 b, const bf16x8 a, const i32x4 c) { return __builtin_amdgcn_mfma_i32_16x16x64_i8(__builtin_bit_cast(i32x4, b), __builtin_bit_cast(i32x4, a), c, 0, 0, 0); }
template <class Epi, class Sched, bool ALIGN_EPI = false, bool SP2 = false, bool I8 = false>
__device__ __forceinline__ void gemm_phase(PG8_LAS unsigned char* lds, const Gemm g, const Sched& S, const Epi& E) {
    const int tid = threadIdx.x, wid = __builtin_amdgcn_readfirstlane(tid >> 6), lane = tid & 63, wr = wid >> 2, wc = wid & 3, fr = lane & 15, fq = lane >> 4;
    const int K = g.K, nt = K / BK;
    unsigned voffA[2], voffB[2];
#pragma unroll
    for (int i = 0; i < 2; ++i) { int R, C; stage_rc(tid * 16 + i * 8192, R, C); const int Rb = Epi::PERM ? ((R & ~31) + perm32(R & 31)) : R;
        voffA[i] = (unsigned)(R * g.lda + C) * 2u; voffB[i] = (unsigned)(Rb * K + C) * 2u; }
    const size_t kstep = (size_t)(BK * 2);
    const size_t hstepA = (size_t)HALF * g.lda * 2, hstepB = (size_t)HALF * K * 2;
    const size_t tstepA = 2 * hstepA, tstepB = 2 * hstepB;
    const unsigned ldsw = (unsigned)wid * 1024u;
    const int aoff = lds_byte(wr * 64 + fr, fq * 8), boff = lds_byte(wc * 32 + fr, fq * 8);
#define PG8_SA(b, h) (((b) * 2 + (h)) * HTB)
#define PG8_SB(b, h) ((4 + (b) * 2 + (h)) * HTB)
#define PG8_STAGE(bufoff, gbase, voff) do { _Pragma("unroll") for (int _i = 0; _i < 2; ++_i) \
        __builtin_amdgcn_global_load_lds((const unsigned*)((const char*)(gbase) + (voff)[_i]), (PG8_LAS unsigned*)(lds + (bufoff) + ldsw + _i * 8192), 16, 0, 0); } while (0)
#define PG8_LDA(dst, b, h) do { _Pragma("unroll") for (int m = 0; m < 4; ++m) _Pragma("unroll") for (int k = 0; k < 2; ++k) dst[m][k] = *(const PG8_LAS bf16x8*)(lds + PG8_SA(b, h) + aoff + m * 2048 + k * 1024); } while (0)
#define PG8_LDB(dst, b, h) do { _Pragma("unroll") for (int n = 0; n < 2; ++n) _Pragma("unroll") for (int k = 0; k < 2; ++k) dst[n][k] = *(const PG8_LAS bf16x8*)(lds + PG8_SB(b, h) + boff + n * 2048 + k * 1024); } while (0)
#define PG8_MMA(ai, bj, At, Bt) do { __builtin_amdgcn_s_setprio(1); _Pragma("unroll") for (int m = 0; m < 4; ++m) _Pragma("unroll") for (int n = 0; n < 2; ++n) _Pragma("unroll") for (int k = 0; k < 2; ++k) \
        acc[ai][bj][m][n] = mma16(Bt[n][k], At[m][k], acc[ai][bj][m][n]); __builtin_amdgcn_s_setprio(0); } while (0)
#define PG8_WAIT_V(n) asm volatile("s_waitcnt vmcnt(" #n ")" ::: "memory")
#define PG8_WAIT_L(n) asm volatile("s_waitcnt lgkmcnt(" #n ")" ::: "memory")
#define PG8_BAR __builtin_amdgcn_s_barrier()
#define PG8_SCHED __builtin_amdgcn_sched_barrier(0)
    Unit cur, nxt; int ui = 0;
    if (!S.next(0, cur)) return;
    typedef typename AccT<I8>::type accv; accv acc[2][2][4][2];
#pragma unroll
    for (int a = 0; a < 2; ++a)
#pragma unroll
        for (int b = 0; b < 2; ++b)
#pragma unroll
            for (int m = 0; m < 4; ++m)
#pragma unroll
                for (int n = 0; n < 2; ++n) acc[a][b][m][n] = accv{};
    bf16x8 At[4][2], B0[2][2], B1[2][2];
    const char* cA = (const char*)g.A + (size_t)cur.pm * tstepA; const char* cB = (const char*)g.Bt + (size_t)cur.pn * tstepB;
    S.a_ready(cur);
    if constexpr (SP2) {
        PG8_STAGE(PG8_SB(0, 0), cB, voffB); PG8_STAGE(PG8_SB(0, 1), cB + hstepB, voffB); PG8_STAGE(PG8_SA(0, 0), cA, voffA); PG8_STAGE(PG8_SA(0, 1), cA + hstepA, voffA);
        if (wr == 1) PG8_BAR;
        PG8_WAIT_V(2); PG8_BAR;
        PG8_STAGE(PG8_SB(1, 0), cB + kstep, voffB); PG8_STAGE(PG8_SA(1, 0), cA + kstep, voffA); PG8_STAGE(PG8_SB(1, 1), cB + hstepB + kstep, voffB);
        PG8_WAIT_V(6); PG8_BAR;
    } else {
        PG8_STAGE(PG8_SB(0, 0), cB, voffB); PG8_STAGE(PG8_SA(0, 0), cA, voffA); PG8_STAGE(PG8_SB(0, 1), cB + hstepB, voffB); PG8_STAGE(PG8_SA(0, 1), cA + hstepA, voffA);
        if (wr == 1) PG8_BAR;
        PG8_WAIT_V(4); PG8_BAR;
        PG8_STAGE(PG8_SB(1, 0), cB + kstep, voffB); PG8_STAGE(PG8_SA(1, 0), cA + kstep, voffA); PG8_STAGE(PG8_SB(1, 1), cB + hstepB + kstep, voffB);
        PG8_WAIT_V(6); PG8_BAR;
    }
    for (;;) {
        const bool has_next = S.next(ui + 1, nxt);
        const char* nA = has_next ? (const char*)g.A + (size_t)nxt.pm * tstepA : cA; const char* nB = has_next ? (const char*)g.Bt + (size_t)nxt.pn * tstepB : cB;
        for (int t = 0; t < nt; t += 2) {
            const bool last = (t == nt - 2);
            const char* a1 = cA + (size_t)(t + 1) * kstep;
            const char* a2 = last ? nA : cA + (size_t)(t + 2) * kstep; const char* b2 = last ? nB : cB + (size_t)(t + 2) * kstep;
            const char* a3 = a2 + kstep; const char* b3 = b2 + kstep;
            if (last && has_next) S.a_ready(nxt);
            if constexpr (SP2) {
            PG8_LDB(B0, 0, 0); PG8_LDB(B1, 0, 1); PG8_SCHED; PG8_LDA(At, 0, 0); PG8_STAGE(PG8_SA(1, 1), a1 + hstepA, voffA);
            PG8_WAIT_V(8); PG8_WAIT_L(0); PG8_BAR; PG8_MMA(0, 0, At, B0); PG8_MMA(0, 1, At, B1); PG8_BAR; PG8_SCHED;
            PG8_LDA(At, 0, 1); PG8_STAGE(PG8_SB(0, 0), b2, voffB); PG8_STAGE(PG8_SB(0, 1), b2 + hstepB, voffB); PG8_STAGE(PG8_SA(0, 0), a2, voffA);
            PG8_WAIT_V(8); PG8_WAIT_L(0); PG8_BAR; PG8_MMA(1, 0, At, B0); PG8_MMA(1, 1, At, B1); PG8_BAR; PG8_SCHED;
            PG8_LDB(B0, 1, 0); PG8_LDB(B1, 1, 1); PG8_SCHED; PG8_LDA(At, 1, 0); PG8_STAGE(PG8_SA(0, 1), a2 + hstepA, voffA);
            PG8_WAIT_V(8); PG8_WAIT_L(0); PG8_BAR; PG8_MMA(0, 0, At, B0); PG8_MMA(0, 1, At, B1); PG8_BAR; PG8_SCHED;
            PG8_LDA(At, 1, 1); PG8_STAGE(PG8_SB(1, 0), b3, voffB); PG8_STAGE(PG8_SB(1, 1), b3 + hstepB, voffB); PG8_STAGE(PG8_SA(1, 0), a3, voffA);
            PG8_WAIT_V(8); PG8_WAIT_L(0); PG8_BAR; PG8_MMA(1, 0, At, B0); PG8_MMA(1, 1, At, B1); PG8_BAR; PG8_SCHED;
            } else {
            PG8_LDB(B0, 0, 0); PG8_SCHED; PG8_LDA(At, 0, 0); PG8_STAGE(PG8_SA(1, 1), a1 + hstepA, voffA);
            PG8_WAIT_L(8); PG8_BAR; PG8_WAIT_L(0); PG8_MMA(0, 0, At, B0); PG8_BAR; PG8_SCHED;
            PG8_LDB(B1, 0, 1); PG8_STAGE(PG8_SB(0, 0), b2, voffB);
            PG8_BAR; PG8_WAIT_L(0); PG8_MMA(0, 1, At, B1); PG8_BAR;
            PG8_LDA(At, 0, 1); PG8_STAGE(PG8_SA(0, 0), a2, voffA);
            PG8_BAR; PG8_WAIT_L(0); PG8_MMA(1, 0, At, B0); PG8_BAR; PG8_SCHED;
            PG8_STAGE(PG8_SB(0, 1), b2 + hstepB, voffB);
            PG8_WAIT_V(6); PG8_BAR; PG8_MMA(1, 1, At, B1); PG8_BAR;
            PG8_LDB(B0, 1, 0); PG8_SCHED; PG8_LDA(At, 1, 0); PG8_STAGE(PG8_SA(0, 1), a2 + hstepA, voffA);
            PG8_WAIT_L(8); PG8_BAR; PG8_WAIT_L(0); PG8_MMA(0, 0, At, B0); PG8_BAR; PG8_SCHED;
            PG8_LDB(B1, 1, 1); PG8_STAGE(PG8_SB(1, 0), b3, voffB);
            PG8_BAR; PG8_WAIT_L(0); PG8_MMA(0, 1, At, B1); PG8_BAR;
            PG8_LDA(At, 1, 1); PG8_STAGE(PG8_SA(1, 0), a3, voffA);
            PG8_BAR; PG8_WAIT_L(0); PG8_MMA(1, 0, At, B0); PG8_BAR; PG8_SCHED;
            PG8_STAGE(PG8_SB(1, 1), b3 + hstepB, voffB);
            PG8_WAIT_V(6); PG8_BAR; PG8_MMA(1, 1, At, B1); PG8_BAR;
            }
        }
        if constexpr (ALIGN_EPI) { if (wr == 0) PG8_BAR; }
        if constexpr (!Epi::AFTER_DRAIN) { E(acc, cur, wr, wc, fr, fq); S.done(cur); }
        if (!has_next) break;
#pragma unroll
        for (int a = 0; a < 2; ++a)
#pragma unroll
            for (int b = 0; b < 2; ++b)
#pragma unroll
                for (int m = 0; m < 4; ++m)
#pragma unroll
                    for (int n = 0; n < 2; ++n) acc[a][b][m][n] = accv{};
        cur = nxt; cA = nA; cB = nB; ++ui;
        if constexpr (ALIGN_EPI) { if (wr == 1) PG8_BAR; }
    }
    PG8_WAIT_V(0);
    if constexpr (!ALIGN_EPI) { if (wr == 0) PG8_BAR; }
    PG8_BAR;
    if constexpr (Epi::AFTER_DRAIN) { E.fused(acc, cur, wr, wc, fr, fq, lds, wid, lane); S.done(cur); }
#undef PG8_SA
#undef PG8_SB
#undef PG8_STAGE
#undef PG8_LDA
#undef PG8_LDB
#undef PG8_MMA
#undef PG8_WAIT_V
#undef PG8_WAIT_L
#undef PG8_BAR
#undef PG8_SCHED
}
}


#define GAS __attribute__((address_space(1)))
#define LAS __attribute__((address_space(3)))
typedef float f32x4 __attribute__((ext_vector_type(4)));
typedef unsigned u32x4 __attribute__((ext_vector_type(4)));
#define XB_TMO      128
#define XB_XCNT(j)  (256  + 64 * (j))
#define XB_XSUB(j)  (1280 + 64 * (j))
#define XB_XGEN(j)  (2304 + 64 * (j))
#define XB_TOP      3328
#define XB_TOPGEN   3392
#define XCD_BAR_WORDS 3456
#define XB_SPIN_CAP (1u << 18)

__device__ __forceinline__ unsigned xb_ld(unsigned* p)              { return __hip_atomic_load(p, __ATOMIC_RELAXED, __HIP_MEMORY_SCOPE_AGENT); }
__device__ __forceinline__ unsigned xb_add(unsigned* p, unsigned v) { return __hip_atomic_fetch_add(p, v, __ATOMIC_RELAXED, __HIP_MEMORY_SCOPE_AGENT); }
__device__ __forceinline__ unsigned xb_xcc_id() { return (unsigned)__builtin_amdgcn_s_getreg((3 << 11) | 20) & 0xFu; }
#define XB_SPIN(cond, bar) do { unsigned _sp = 0; while (cond) { __builtin_amdgcn_s_sleep(1); \
    if ((++_sp & 255u) == 0u) { if (xb_ld(&(bar)[XB_TMO])) break; if (_sp > XB_SPIN_CAP) { atomicAdd(&(bar)[XB_TMO], 1u); break; } } } } while (0)

struct XcdBarrier {
    unsigned* bar; unsigned x;
    volatile LAS unsigned* st;
};

__device__ __forceinline__ XcdBarrier xcd_barrier_post(unsigned* bar, volatile LAS unsigned* st) {
    XcdBarrier b; b.bar = bar; b.x = xb_xcc_id(); b.st = st;
    if (threadIdx.x == 0) (void)xb_add(&bar[XB_XCNT(b.x)], 1u);
    return b;
}
__device__ __forceinline__ void xcd_barrier_complete(unsigned* bar, unsigned x, unsigned& nloc, unsigned& nx) {
    const unsigned G = gridDim.x * gridDim.y * gridDim.z;
    unsigned sum, cnt, mine, sp = 0u;
    for (;;) {
        sum = 0u; cnt = 0u; mine = 0u;
#pragma unroll
        for (unsigned j = 0; j < 16; ++j) { const unsigned c = xb_ld(&bar[XB_XCNT(j)]); sum += c; cnt += (c > 0u) ? 1u : 0u; mine = (j == x) ? c : mine; }
        if (sum == G) break;
        __builtin_amdgcn_s_sleep(1);
        if ((++sp & 255u) == 0u) { if (xb_ld(&bar[XB_TMO])) break; if (sp > XB_SPIN_CAP) { atomicAdd(&bar[XB_TMO], 1u); break; } }
    }
    nloc = mine > 0u ? mine : 1u; nx = cnt > 0u ? cnt : 1u;
}

__device__ __forceinline__ void xcd_barrier(const XcdBarrier& b) {
    asm volatile("s_waitcnt vmcnt(0)" ::: "memory");
    __syncthreads();
    if (threadIdx.x == 0) {
        unsigned* bar = b.bar;
        __builtin_amdgcn_s_waitcnt(0);
        unsigned nloc = b.st[0], nx = b.st[1];
        if (nloc == 0u) { xcd_barrier_complete(bar, b.x, nloc, nx); b.st[0] = nloc; b.st[1] = nx; }
        const unsigned old = xb_add(&bar[XB_XSUB(b.x)], 1u);
        const unsigned gen = old / nloc;
        if (old + 1u == (gen + 1u) * nloc) {
            __builtin_amdgcn_fence(__ATOMIC_RELEASE, "agent");
            asm volatile("s_waitcnt vmcnt(0)" ::: "memory");
            const unsigned og = xb_add(&bar[XB_TOP], 1u);
            const unsigned tg = og / nx;
            if (og + 1u == (tg + 1u) * nx) xb_add(&bar[XB_TOPGEN], 1u);
            else XB_SPIN(xb_ld(&bar[XB_TOPGEN]) == tg, bar);
            __builtin_amdgcn_fence(__ATOMIC_ACQUIRE, "agent");
            xb_add(&bar[XB_XGEN(b.x)], 1u);
            asm volatile("s_waitcnt vmcnt(0)" ::: "memory");
        } else {
            XB_SPIN(xb_ld(&bar[XB_XGEN(b.x)]) == gen, bar);
            __builtin_amdgcn_fence(__ATOMIC_ACQUIRE, "agent");
            asm volatile("s_waitcnt vmcnt(0)" ::: "memory");
        }
    }
    __syncthreads();
}


constexpr int NWAVES = 8;
constexpr int RING_BYTES = 131072, LDSCTL_OFF = RING_BYTES, MISC_OFF = LDSCTL_OFF + 320, LDS_BYTES = 147456;
constexpr size_t WS_CTL = 0, CTL_ZERO_BYTES = 1 * MiB;
constexpr int CW_BAR = 4096, N_BAR_REGIONS = 16;
static_assert((CW_BAR + N_BAR_REGIONS * XCD_BAR_WORDS) * 4 <= (int)CTL_ZERO_BYTES, "barrier words inside the memset region");
constexpr size_t WS_WIN = 10 * MiB;
constexpr size_t WS_WUQ = 15 * MiB;
constexpr size_t WS_WUKV = 16 * MiB;
constexpr size_t WS_WO = 17 * MiB;
constexpr size_t WS_WPQ = 19 * MiB;
constexpr size_t WS_SK = 23 * MiB;
constexpr size_t WS_U16 = 24 * MiB;
constexpr size_t WS_V16 = 56 * MiB;


namespace att {
typedef short bf16x8 __attribute__((ext_vector_type(8)));
typedef short s16x4 __attribute__((ext_vector_type(4)));
typedef float f32x16 __attribute__((ext_vector_type(16)));
constexpr int LK = 0, KSLOT = 12288, LV = 2 * KSLOT, VSLOT = 8192, LB = LV + 2 * VSLOT, BSLOT = 256, LWS = LB + 2 * BSLOT, LOST = LWS + 8 * 256, ATT_LDS = LOST + 8 * 4096;
static_assert(ATT_LDS <= 131072, "attention scratch fits the ring region");
struct Desc { const bf16_t* Q; int pq; const bf16_t* K; int pk; const bf16_t* V; int pv; bf16_t* O; int po; const float* FC; };

__device__ __forceinline__ int crow(int r, int hi) { return (r & 3) + 8 * (r >> 2) + 4 * hi; }
__device__ __forceinline__ float xmax32(float v) { auto rr = __builtin_amdgcn_permlane32_swap(__float_as_uint(v), __float_as_uint(v), false, false); return fmaxf(__uint_as_float(rr[0]), __uint_as_float(rr[1])); }
__device__ __forceinline__ float xsum32(float v) { auto rr = __builtin_amdgcn_permlane32_swap(__float_as_uint(v), __float_as_uint(v), false, false); return __uint_as_float(rr[0]) + __uint_as_float(rr[1]); }
__device__ __forceinline__ unsigned cvtpk(float lo, float hi) { typedef float f2 __attribute__((ext_vector_type(2))); typedef __bf16 b2 __attribute__((ext_vector_type(2))); f2 v = {lo, hi}; b2 b = __builtin_convertvector(v, b2); return __builtin_bit_cast(unsigned, b); }
typedef short v4i16_t __attribute__((ext_vector_type(4)));
__device__ __forceinline__ s16x4 vtr(LAS const unsigned char* p) { return __builtin_bit_cast(s16x4, __builtin_amdgcn_ds_read_tr16_b64_v4i16((LAS v4i16_t*)p)); }

template <int KS, bool BIAS>
__device__ __forceinline__ void attn_unit(const Desc& d, int qb, int j0, LAS unsigned char* shm) {
    const int tid = threadIdx.x, lane = tid & 63, r32 = lane & 31, hi = lane >> 5; const int wid = __builtin_amdgcn_readfirstlane(tid >> 6);
    const int q0 = qb * 256, NT = (q0 + 256) / 64;
    LAS float* wsf = (LAS float*)(shm + LWS) + wid * 64;
    bf16x8 qr[KS];
    { const bf16_t* qp = d.Q + (size_t)(q0 + wid * 32 + r32) * d.pq + hi * 8;
#pragma unroll
      for (int d0 = 0; d0 < KS; ++d0) qr[d0] = *(const bf16x8*)(qp + d0 * 16); }
    const float fcref = BIAS ? d.FC[q0] : 0.f;
    const bf16_t* ksrc0 = d.K + (size_t)lane * d.pk + wid * 8;
    const bf16_t* ksrc1 = d.K + (size_t)lane * d.pk + (8 + wid) * 8;
    const bf16_t* vsrc = d.V + (size_t)(16 * (wid & 3) + (lane >> 2)) * d.pv + (wid >> 2) * 32 + (lane & 3) * 8;
    const int kdst0 = LK + wid * 1024 + lane * 16, kdst1 = LK + (8 + wid) * 1024 + lane * 16, vdst = LV + wid * 1024 + lane * 16;
    const bool k2 = (KS > 4) && (wid < 2 * KS - 8);
    u32x4 kr0, kr1, vr; float br = 0.f;
#define ATT_LOAD(t, slot) do { \
        __builtin_amdgcn_global_load_lds((const unsigned*)(ksrc0 + (size_t)(t) * 64 * d.pk), (LAS unsigned*)(shm + LK + wid * 1024 + (slot) * KSLOT), 16, 0, 0); \
        if (k2) __builtin_amdgcn_global_load_lds((const unsigned*)(ksrc1 + (size_t)(t) * 64 * d.pk), (LAS unsigned*)(shm + LK + (8 + wid) * 1024 + (slot) * KSLOT), 16, 0, 0); \
        __builtin_amdgcn_global_load_lds((const unsigned*)(vsrc + (size_t)(t) * 64 * d.pv), (LAS unsigned*)(shm + LV + wid * 1024 + (slot) * VSLOT), 16, 0, 0); \
        if (BIAS && wid == 4) br = d.FC[(t) * 64 + lane]; } while (0)
#define ATT_WRITE(slot) do { if (BIAS && wid == 4) *(LAS float*)(shm + LB + (slot) * BSLOT + lane * 4) = (fcref - br) * LOG2E; } while (0)
    f32x16 o0, o1, negm;
#pragma unroll
    for (int r = 0; r < 16; ++r) { o0[r] = 0.f; o1[r] = 0.f; negm[r] = 0.f; }
    float mref = 0.f, l = 0.f;
    constexpr float THR = BIAS ? 40.f : 8.f;
    const int qrel = wid * 32 + r32;
    const int kfrag = LK + hi * 1024 + r32 * 16;
    const int vfrag = LV + ((lane >> 4) & 1) * 32 + (lane & 3) * 8 + (4 * hi + ((lane & 15) >> 2)) * 64;
    ATT_LOAD(j0, 0); ATT_WRITE(0);
    __syncthreads();
    for (int t = j0; t < NT; ++t) {
        const int slot = (t - j0) & 1;
        if (t + 1 < NT) ATT_LOAD(t + 1, slot ^ 1);
        const int jb = t - (NT - 4);
        if (!(jb >= 0 && 64 * jb > 32 * wid + 31)) {
            f32x16 p0, p1;
            if (BIAS) {
                LAS const unsigned char* bp = shm + LB + slot * BSLOT + 16 * hi;
#pragma unroll
                for (int g = 0; g < 4; ++g) { const f32x4 a = *(LAS const f32x4*)(bp + 32 * g), b = *(LAS const f32x4*)(bp + 128 + 32 * g);
#pragma unroll
                    for (int i = 0; i < 4; ++i) { p0[4 * g + i] = a[i] + negm[4 * g + i]; p1[4 * g + i] = b[i] + negm[4 * g + i]; } }
            } else { p0 = negm; p1 = negm; }
            LAS const unsigned char* kp = shm + kfrag + slot * KSLOT;
            __builtin_amdgcn_s_setprio(1);
#pragma unroll
            for (int d0 = 0; d0 < KS; ++d0) {
                const bf16x8 a0 = *(LAS const bf16x8*)(kp + d0 * 2048), a1 = *(LAS const bf16x8*)(kp + d0 * 2048 + 512);
                p0 = __builtin_amdgcn_mfma_f32_32x32x16_bf16(a0, qr[d0], p0, 0, 0, 0);
                p1 = __builtin_amdgcn_mfma_f32_32x32x16_bf16(a1, qr[d0], p1, 0, 0, 0);
            }
            __builtin_amdgcn_s_setprio(0);
            if (jb >= 0) {
                const int kb = 64 * jb + 4 * hi;
#pragma unroll
                for (int r = 0; r < 16; ++r) { const int kv = kb + (r & 3) + 8 * (r >> 2); if (kv > qrel) p0[r] = -INFINITY; if (kv + 32 > qrel) p1[r] = -INFINITY; }
            }
            float ra = __builtin_fmaxf(__builtin_fmaxf(p0[0], p0[1]), p1[0]), rb = __builtin_fmaxf(__builtin_fmaxf(p0[2], p0[3]), p1[1]);
            ra = __builtin_fmaxf(__builtin_fmaxf(ra, p1[2]), p1[3]);
#pragma unroll
            for (int r = 4; r < 16; r += 4) { ra = __builtin_fmaxf(__builtin_fmaxf(ra, p0[r]), p0[r + 1]); rb = __builtin_fmaxf(__builtin_fmaxf(rb, p0[r + 2]), p0[r + 3]);
                ra = __builtin_fmaxf(__builtin_fmaxf(ra, p1[r]), p1[r + 1]); rb = __builtin_fmaxf(__builtin_fmaxf(rb, p1[r + 2]), p1[r + 3]); }
            const float rm = xmax32(__builtin_fmaxf(ra, rb));
            if (__any(rm > THR) || t == j0) {
                const float dl = t == j0 ? rm : __builtin_fmaxf(rm, 0.f);
                mref += dl;
#pragma unroll
                for (int r = 0; r < 16; ++r) { p0[r] -= dl; p1[r] -= dl; negm[r] = -mref; }
                if (t != j0) {
                    const float alpha = __builtin_amdgcn_exp2f(-dl);
                    l *= alpha;
                    if (hi == 0) wsf[r32] = alpha;
#pragma unroll
                    for (int g = 0; g < 4; ++g) { const f32x4 a = *(LAS const f32x4*)(wsf + 8 * g + 4 * hi);
#pragma unroll
                        for (int i = 0; i < 4; ++i) { o0[4 * g + i] *= a[i]; o1[4 * g + i] *= a[i]; } }
                }
            }
            float s0 = 0.f, s1 = 0.f, s2 = 0.f, s3 = 0.f;
#pragma unroll
            for (int r = 0; r < 16; r += 2) { p0[r] = __builtin_amdgcn_exp2f(p0[r]); p0[r + 1] = __builtin_amdgcn_exp2f(p0[r + 1]); p1[r] = __builtin_amdgcn_exp2f(p1[r]); p1[r + 1] = __builtin_amdgcn_exp2f(p1[r + 1]);
                s0 += p0[r]; s1 += p0[r + 1]; s2 += p1[r]; s3 += p1[r + 1]; }
            l += (s0 + s1) + (s2 + s3);
            LAS const unsigned char* vp = shm + vfrag + slot * VSLOT;
            __builtin_amdgcn_s_setprio(1);
#pragma unroll
            for (int ks = 0; ks < 4; ++ks) {
                const f32x16& pp = ks < 2 ? p0 : p1; const int bq = (ks & 1) * 8;
                u32x4 pw; pw.x = cvtpk(pp[bq], pp[bq + 1]); pw.y = cvtpk(pp[bq + 2], pp[bq + 3]); pw.z = cvtpk(pp[bq + 4], pp[bq + 5]); pw.w = cvtpk(pp[bq + 6], pp[bq + 7]);
                const bf16x8 pa = __builtin_bit_cast(bf16x8, pw);
                const s16x4 l0 = vtr(vp + ks * 1024), h0 = vtr(vp + ks * 1024 + 512), l1 = vtr(vp + 4096 + ks * 1024), h1 = vtr(vp + 4096 + ks * 1024 + 512);
                const bf16x8 v0 = {l0[0], l0[1], l0[2], l0[3], h0[0], h0[1], h0[2], h0[3]}, v1 = {l1[0], l1[1], l1[2], l1[3], h1[0], h1[1], h1[2], h1[3]};
                o0 = __builtin_amdgcn_mfma_f32_32x32x16_bf16(pa, v0, o0, 0, 0, 0);
                o1 = __builtin_amdgcn_mfma_f32_32x32x16_bf16(pa, v1, o1, 0, 0, 0);
            }
            __builtin_amdgcn_s_setprio(0);
        }
        if (t + 1 < NT) ATT_WRITE(slot ^ 1);
        __syncthreads();
    }
#undef ATT_LOAD
#undef ATT_WRITE
    l = xsum32(l);
    if (hi == 0) wsf[32 + r32] = l;
    float rli[16];
#pragma unroll
    for (int g = 0; g < 4; ++g) { const f32x4 a = *(LAS const f32x4*)(wsf + 32 + 8 * g + 4 * hi);
#pragma unroll
        for (int i = 0; i < 4; ++i) rli[4 * g + i] = 1.f / a[i]; }
    LAS bf16_t* stg = (LAS bf16_t*)(shm + LOST) + wid * 2048;
#pragma unroll
    for (int r = 0; r < 16; ++r) { const int orow = crow(r, hi); stg[orow * 64 + r32] = f2bf(o0[r] * rli[r]); stg[orow * 64 + 32 + r32] = f2bf(o1[r] * rli[r]); }
    bf16_t* Ow = d.O + (size_t)(q0 + wid * 32) * d.po;
#pragma unroll
    for (int i = 0; i < 4; ++i) { const int row = i * 8 + (lane >> 3), ch = lane & 7; const u32x4 v = *(LAS const u32x4*)(stg + row * 64 + ch * 8); *(u32x4*)(Ow + (size_t)row * d.po + ch * 8) = v; }
    __syncthreads();
}
}


namespace pk {
typedef short bf16x8 __attribute__((ext_vector_type(8)));
typedef float f32x16 __attribute__((ext_vector_type(16)));
__device__ __forceinline__ unsigned f2sort(float f) { const unsigned b = __float_as_uint(f); return b ^ ((unsigned)((int)b >> 31) | 0x80000000u); }
__device__ __forceinline__ float sort2f(unsigned u) { return __uint_as_float((u & 0x80000000u) ? (u ^ 0x80000000u) : ~u); }
__device__ __forceinline__ void ce(unsigned& a, unsigned& b) { const unsigned mx = a > b ? a : b, mn = a > b ? b : a; a = mx; b = mn; }
__device__ __forceinline__ void sort16(unsigned (&v)[16]) {
#pragma unroll
    for (int k = 2; k <= 16; k <<= 1)
#pragma unroll
        for (int j = k >> 1; j >= 1; j >>= 1)
#pragma unroll
            for (int i = 0; i < 16; ++i) { const int l = i ^ j; if (l > i) { if ((i & k) == 0) ce(v[i], v[l]); else ce(v[l], v[i]); } }
}
__device__ __forceinline__ void merge16(unsigned (&a)[16], const unsigned (&b)[16]) {
#pragma unroll
    for (int i = 0; i < 16; ++i) a[i] = a[i] > b[15 - i] ? a[i] : b[15 - i];
#pragma unroll
    for (int j = 8; j >= 1; j >>= 1)
#pragma unroll
        for (int i = 0; i < 16; ++i) { const int l = i ^ j; if (l > i) ce(a[i], a[l]); }
}
__device__ __forceinline__ void top16of64(unsigned (&k)[64], unsigned (&out)[16]) {
    unsigned g1[16], g2[16], g3[16];
#pragma unroll
    for (int i = 0; i < 16; ++i) { out[i] = k[i]; g1[i] = k[16 + i]; g2[i] = k[32 + i]; g3[i] = k[48 + i]; }
    sort16(out); sort16(g1); sort16(g2); sort16(g3);
    merge16(out, g1); merge16(g2, g3); merge16(out, g2);
}
__device__ __forceinline__ unsigned sel4(const unsigned (&w)[4], int q) { const unsigned a = q & 1 ? w[1] : w[0], b = q & 1 ? w[3] : w[2]; return q & 2 ? b : a; }

template <int I> struct COff { static constexpr int v = COff<I - 1>::v + 16 / I; };
template <> struct COff<0> { static constexpr int v = 0; };
static_assert(COff<16>::v == 50, "50 candidates can reach the top 16 of a sorted 16 x 16 sum grid");
template <int I> __device__ __forceinline__ void fill_cand(unsigned (&c64)[64], const float (&s1)[16], const float (&s2)[16]) {
    if constexpr (I < 16) {
#pragma unroll
        for (int j = 0; j < 16 / (I + 1); ++j) c64[COff<I>::v + j] = (f2sort(s1[I] + s2[j]) & 0xFFFFFF00u) | (unsigned)(255 - (I * 16 + j));
        fill_cand<I + 1>(c64, s1, s2);
    }
}
__device__ __forceinline__ void topk_item(const bf16_t* QP, const bf16_t* SK, int* EID, float* GATE, int item, int lane) {
    const int tg = item >> 3, h = item & 7, r32 = lane & 31, hi = lane >> 5;
    const int t = tg * 32 + r32;
    unsigned own[2][16];
#pragma unroll
    for (int p = 0; p < 2; ++p) {
        const bf16_t* qrow = QP + (size_t)t * 2048 + h * 256 + p * 128 + hi * 8;
        bf16x8 qf[8];
#pragma unroll
        for (int d0 = 0; d0 < 8; ++d0) qf[d0] = *(const bf16x8*)(qrow + d0 * 16);
        const bf16_t* skb = SK + (size_t)((h * 2 + p) * 128 + r32) * 128 + hi * 8;
#pragma unroll 1
        for (int kt = 0; kt < 4; ++kt) {
            f32x16 acc;
#pragma unroll
            for (int r = 0; r < 16; ++r) acc[r] = 0.f;
#pragma unroll
            for (int d0 = 0; d0 < 8; ++d0) { const bf16x8 a = *(const bf16x8*)(skb + (size_t)kt * 32 * 128 + d0 * 16); acc = __builtin_amdgcn_mfma_f32_32x32x16_bf16(a, qf[d0], acc, 0, 0, 0); }
            unsigned cur[16];
#pragma unroll
            for (int r = 0; r < 16; ++r) { const int idx0 = kt * 32 + (r & 3) + 8 * (r >> 2);
                cur[r] = (f2sort(acc[r]) & 0xFFFFFF80u) | (unsigned)(127 - idx0 - 4 * hi); }
            sort16(cur);
            if (kt == 0) {
#pragma unroll
                for (int r = 0; r < 16; ++r) own[p][r] = cur[r];
            } else merge16(own[p], cur);
        }
    }
    unsigned fin[16];
    {
        unsigned oth[16];
#pragma unroll
        for (int i = 0; i < 16; ++i) { auto rr = __builtin_amdgcn_permlane32_swap(own[0][i], own[1][i], false, false); fin[i] = rr[0]; oth[i] = rr[1]; }
        merge16(fin, oth);
    }
    unsigned s1k[16], s2k[16];
#pragma unroll
    for (int i = 0; i < 16; ++i) { auto rr = __builtin_amdgcn_permlane32_swap(fin[i], fin[i], false, false); s1k[i] = rr[0]; s2k[i] = rr[1]; }
    float s1[16], s2[16]; unsigned long long i1lo = 0ull, i1hi = 0ull, i2lo = 0ull, i2hi = 0ull;
#pragma unroll
    for (int i = 0; i < 16; ++i) { s1[i] = sort2f(s1k[i] & 0xFFFFFF80u); s2[i] = sort2f(s2k[i] & 0xFFFFFF80u);
        const unsigned long long a = (unsigned long long)(127u - (s1k[i] & 0x7Fu)) << (8 * (i & 7)), b = (unsigned long long)(127u - (s2k[i] & 0x7Fu)) << (8 * (i & 7));
        if (i < 8) { i1lo |= a; i2lo |= b; } else { i1hi |= a; i2hi |= b; } }
    unsigned c64[64];
#pragma unroll
    for (int i = 50; i < 64; ++i) c64[i] = 0u;
    fill_cand<0>(c64, s1, s2);
    unsigned top[16];
    top16of64(c64, top);
    float ev[16]; float sum = 0.f; const float mx = sort2f(top[0] & 0xFFFFFF00u);
#pragma unroll
    for (int r = 0; r < 16; ++r) { ev[r] = __expf(sort2f(top[r] & 0xFFFFFF00u) - mx); sum += ev[r]; }
    const float rs = 1.f / sum;
    if (hi == 0) {
        int* ep = EID + (size_t)t * 128 + h * 16;
#pragma unroll
        for (int q4 = 0; q4 < 4; ++q4) { int ee[4];
#pragma unroll
            for (int z = 0; z < 4; ++z) { const int code = 255 - (int)(top[q4 * 4 + z] & 0xFFu), i = code >> 4, j = code & 15;
                const unsigned e1 = (unsigned)(((i & 8) ? i1hi : i1lo) >> (8 * (i & 7))) & 0xFFu, e2 = (unsigned)(((j & 8) ? i2hi : i2lo) >> (8 * (j & 7))) & 0xFFu; ee[z] = (int)(e1 * 128u + e2); }
            *(int4*)(ep + q4 * 4) = make_int4(ee[0], ee[1], ee[2], ee[3]); }
    } else {
        float* gp = GATE + (size_t)t * 128 + h * 16;
#pragma unroll
        for (int q4 = 0; q4 < 4; ++q4) *(float4*)(gp + q4 * 4) = make_float4(ev[q4 * 4] * rs, ev[q4 * 4 + 1] * rs, ev[q4 * 4 + 2] * rs, ev[q4 * 4 + 3] * rs);
    }
}
__device__ __forceinline__ void cef(float& a, float& b) { const float mx = fmaxf(a, b), mn = fminf(a, b); a = mx; b = mn; }
__device__ __forceinline__ void sort16f(float (&v)[16]) {
#pragma unroll
    for (int k = 2; k <= 16; k <<= 1)
#pragma unroll
        for (int j = k >> 1; j >= 1; j >>= 1)
#pragma unroll
            for (int i = 0; i < 16; ++i) { const int l = i ^ j; if (l > i) { if ((i & k) == 0) cef(v[i], v[l]); else cef(v[l], v[i]); } }
}
__device__ __forceinline__ void merge16f(float (&a)[16], const float (&b)[16]) {
#pragma unroll
    for (int i = 0; i < 16; ++i) a[i] = fmaxf(a[i], b[15 - i]);
#pragma unroll
    for (int j = 8; j >= 1; j >>= 1)
#pragma unroll
        for (int i = 0; i < 16; ++i) { const int l = i ^ j; if (l > i) cef(a[i], a[l]); }
}
__device__ __forceinline__ float keyf(float v, unsigned code, unsigned mask) { return __uint_as_float((__float_as_uint(v) & mask) | code); }
template <int I> __device__ __forceinline__ void fill_candf(float (&c)[64], const float (&s1)[16], const float (&s2)[16]) {
    if constexpr (I < 16) {
#pragma unroll
        for (int j = 0; j < 16 / (I + 1); ++j) c[COff<I>::v + j] = keyf(s1[I] + s2[j], (unsigned)(255 - (I * 16 + j)), 0xFFFFFF00u);
        fill_candf<I + 1>(c, s1, s2);
    }
}
__device__ __forceinline__ void head_half(const bf16_t* QP, const bf16_t* SK, int t, int h, int p, int r32, int hi, const unsigned (&lowc)[16], float (&own)[16]) {
    const bf16_t* qrow = QP + (size_t)t * 2048 + h * 256 + p * 128 + hi * 8;
    bf16x8 qf[8];
#pragma unroll
    for (int d0 = 0; d0 < 8; ++d0) qf[d0] = *(const bf16x8*)(qrow + d0 * 16);
    const bf16_t* skb = SK + (size_t)((h * 2 + p) * 128 + r32) * 128 + hi * 8;
#pragma unroll 1
    for (int kt = 0; kt < 4; ++kt) {
        f32x16 acc;
#pragma unroll
        for (int r = 0; r < 16; ++r) acc[r] = 0.f;
#pragma unroll
        for (int d0 = 0; d0 < 8; ++d0) { const bf16x8 a = *(const bf16x8*)(skb + (size_t)kt * 32 * 128 + d0 * 16); acc = __builtin_amdgcn_mfma_f32_32x32x16_bf16(a, qf[d0], acc, 0, 0, 0); }
        float cur[16];
#pragma unroll
        for (int r = 0; r < 16; ++r) cur[r] = keyf(acc[r], lowc[r] - 32u * (unsigned)kt, 0xFFFFFF80u);
        sort16f(cur);
        if (kt == 0) {
#pragma unroll
            for (int r = 0; r < 16; ++r) own[r] = cur[r];
        } else merge16f(own, cur);
    }
}
__device__ __forceinline__ void topk_item2(const bf16_t* QP, const bf16_t* SK, int* EID, float* GATE, int item, int lane) {
    const int tg = item >> 2, hp = item & 3, r32 = lane & 31, hi = lane >> 5;
    const int t = tg * 32 + r32;
    unsigned lowc[16];
#pragma unroll
    for (int r = 0; r < 16; ++r) lowc[r] = (unsigned)(127 - ((r & 3) + 8 * (r >> 2)) - 4 * hi);
    float finA[16], finB[16];
#pragma unroll
    for (int hh = 0; hh < 2; ++hh) {
        const int h = 2 * hp + hh;
        float own0[16], own1[16];
        head_half(QP, SK, t, h, 0, r32, hi, lowc, own0);
        head_half(QP, SK, t, h, 1, r32, hi, lowc, own1);
        float fin[16], oth[16];
#pragma unroll
        for (int i = 0; i < 16; ++i) { auto rr = __builtin_amdgcn_permlane32_swap(__float_as_uint(own0[i]), __float_as_uint(own1[i]), false, false); fin[i] = __uint_as_float(rr[0]); oth[i] = __uint_as_float(rr[1]); }
        merge16f(fin, oth);
#pragma unroll
        for (int i = 0; i < 16; ++i) { if (hh == 0) finA[i] = fin[i]; else finB[i] = fin[i]; }
    }
    float s1[16], s2[16];
#pragma unroll
    for (int i = 0; i < 16; ++i) { auto rr = __builtin_amdgcn_permlane32_swap(__float_as_uint(finA[i]), __float_as_uint(finB[i]), false, false); s1[i] = __uint_as_float(rr[0]); s2[i] = __uint_as_float(rr[1]); }
    const int h = 2 * hp + hi;
    unsigned long long i1lo = 0ull, i1hi = 0ull, i2lo = 0ull, i2hi = 0ull;
#pragma unroll
    for (int i = 0; i < 16; ++i) {
        const unsigned long long a = (unsigned long long)(127u - (__float_as_uint(s1[i]) & 0x7Fu)) << (8 * (i & 7)), b = (unsigned long long)(127u - (__float_as_uint(s2[i]) & 0x7Fu)) << (8 * (i & 7));
        if (i < 8) { i1lo |= a; i2lo |= b; } else { i1hi |= a; i2hi |= b; } }
    float c64[64];
#pragma unroll
    for (int i = 50; i < 64; ++i) c64[i] = -INFINITY;
    fill_candf<0>(c64, s1, s2);
    float top[16];
    {
        float g1[16], g2[16], g3[16];
#pragma unroll
        for (int i = 0; i < 16; ++i) { top[i] = c64[i]; g1[i] = c64[16 + i]; g2[i] = c64[32 + i]; g3[i] = c64[48 + i]; }
        sort16f(g1); sort16f(g2); sort16f(g3);
        merge16f(top, g1); merge16f(g2, g3); merge16f(top, g2);
    }
    float ev[16]; float sum = 0.f; const float mx = top[0];
#pragma unroll
    for (int r = 0; r < 16; ++r) { ev[r] = __expf(top[r] - mx); sum += ev[r]; }
    const float rs = 1.f / sum;
    int* ep = EID + (size_t)t * 128 + h * 16; float* gp = GATE + (size_t)t * 128 + h * 16;
#pragma unroll
    for (int q4 = 0; q4 < 4; ++q4) { int ee[4];
#pragma unroll
        for (int z = 0; z < 4; ++z) { const int code = 255 - (int)(__float_as_uint(top[q4 * 4 + z]) & 0xFFu), i = code >> 4, j = code & 15;
            const unsigned e1 = (unsigned)(((i & 8) ? i1hi : i1lo) >> (8 * (i & 7))) & 0xFFu, e2 = (unsigned)(((j & 8) ? i2hi : i2lo) >> (8 * (j & 7))) & 0xFFu; ee[z] = (int)(e1 * 128u + e2); }
        *(int4*)(ep + q4 * 4) = make_int4(ee[0], ee[1], ee[2], ee[3]);
        *(float4*)(gp + q4 * 4) = make_float4(ev[q4 * 4] * rs, ev[q4 * 4 + 1] * rs, ev[q4 * 4 + 2] * rs, ev[q4 * 4 + 3] * rs); }
}
}


namespace gx {
typedef unsigned char u8x4 __attribute__((ext_vector_type(4)));
__device__ __forceinline__ int sdot16(const int4 a, const int4 b) {
    int s = __builtin_amdgcn_sdot4(a.x, b.x, 0, false); s = __builtin_amdgcn_sdot4(a.y, b.y, s, false); s = __builtin_amdgcn_sdot4(a.z, b.z, s, false); return __builtin_amdgcn_sdot4(a.w, b.w, s, false);
}
__device__ __forceinline__ void quant_row(const float* src, unsigned char* dst, float* scale_out, int lane) {
    const float4* sr = (const float4*)src + lane; float4 v[4]; float am = 0.f;
#pragma unroll
    for (int j = 0; j < 4; ++j) { v[j] = sr[64 * j]; am = fmaxf(am, fmaxf(fmaxf(fabsf(v[j].x), fabsf(v[j].y)), fmaxf(fabsf(v[j].z), fabsf(v[j].w)))); }
#pragma unroll
    for (int o = 1; o < 64; o <<= 1) am = fmaxf(am, __shfl_xor(am, o));
    const float inv = am > 0.f ? 127.f / am : 0.f;
#pragma unroll
    for (int j = 0; j < 4; ++j) { const int q0 = (int)rintf(v[j].x * inv), q1 = (int)rintf(v[j].y * inv), q2 = (int)rintf(v[j].z * inv), q3 = (int)rintf(v[j].w * inv);
        *(unsigned*)(dst + 4 * lane + 256 * j) = (unsigned)(q0 & 255) | ((unsigned)(q1 & 255) << 8) | ((unsigned)(q2 & 255) << 16) | ((unsigned)(q3 & 255) << 24); }
    if (lane == 0) *scale_out = am * (1.f / 127.f);
}
__device__ __forceinline__ float gelu_t(float x) { const float u = 0.7978845608028654f * (x + 0.044715f * x * x * x); return 0.5f * x * (1.f + tanhf(u)); }

__device__ __forceinline__ int hx(int lo, int hi, bool up, int bit) { const int send = up ? lo : hi, keep = up ? hi : lo; return keep + __shfl_xor(send, bit); }

__device__ __forceinline__ void u_token(const unsigned char* UQs  , const int4 (&ev)[4], const int4 hq, int* PArow, int lane) {
    const int e[16] = {ev[0].x, ev[0].y, ev[0].z, ev[0].w, ev[1].x, ev[1].y, ev[1].z, ev[1].w, ev[2].x, ev[2].y, ev[2].z, ev[2].w, ev[3].x, ev[3].y, ev[3].z, ev[3].w};
    int4 rows[16];
#pragma unroll
    for (int i = 0; i < 16; ++i) rows[i] = *(const int4*)(UQs + (size_t)e[i] * 1024);
    int p[16];
#pragma unroll
    for (int i = 0; i < 16; ++i) p[i] = sdot16(rows[i], hq);
    const bool b2 = (lane & 4) != 0, b1 = (lane & 2) != 0, b0 = (lane & 1) != 0;
    int q[8], r[4];
#pragma unroll
    for (int k = 0; k < 8; ++k) q[k] = hx(p[k], p[8 + k], b2, 4);
#pragma unroll
    for (int k = 0; k < 4; ++k) r[k] = hx(q[k], q[4 + k], b1, 2);
    const int z0 = hx(r[0], r[2], b0, 1), z1 = hx(r[1], r[3], b0, 1);
    *(int2*)(PArow + 2 * lane) = make_int2(z0, z1);
}

__device__ __forceinline__ void v_token(const unsigned char* VQs  , const int4 (&ev)[4], const int4 wh, const int4 wlo, float wscale, const float* gate2, const float* x1row, float* outrow, int s, int lane) {
    const int e[16] = {ev[0].x, ev[0].y, ev[0].z, ev[0].w, ev[1].x, ev[1].y, ev[1].z, ev[1].w, ev[2].x, ev[2].y, ev[2].z, ev[2].w, ev[3].x, ev[3].y, ev[3].z, ev[3].w};
    const int whv[4] = {wh.x, wh.y, wh.z, wh.w}, wlv[4] = {wlo.x, wlo.y, wlo.z, wlo.w};
    uint4 rows[16];
#pragma unroll
    for (int i = 0; i < 16; ++i) rows[i] = *(const uint4*)(VQs + (size_t)e[i] * 1024);
    int ah[16], al[16];
#pragma unroll
    for (int c = 0; c < 16; ++c) { ah[c] = 0; al[c] = 0; }
#pragma unroll
    for (int g = 0; g < 4; ++g) {
#pragma unroll
        for (int d = 0; d < 4; ++d) {
            const unsigned A = d == 0 ? rows[4 * g].x : d == 1 ? rows[4 * g].y : d == 2 ? rows[4 * g].z : rows[4 * g].w;
            const unsigned B = d == 0 ? rows[4 * g + 1].x : d == 1 ? rows[4 * g + 1].y : d == 2 ? rows[4 * g + 1].z : rows[4 * g + 1].w;
            const unsigned C = d == 0 ? rows[4 * g + 2].x : d == 1 ? rows[4 * g + 2].y : d == 2 ? rows[4 * g + 2].z : rows[4 * g + 2].w;
            const unsigned D = d == 0 ? rows[4 * g + 3].x : d == 1 ? rows[4 * g + 3].y : d == 2 ? rows[4 * g + 3].z : rows[4 * g + 3].w;
            const unsigned ab01 = __builtin_amdgcn_perm(A, B, 0x01050004u), ab23 = __builtin_amdgcn_perm(A, B, 0x03070206u);
            const unsigned cd01 = __builtin_amdgcn_perm(C, D, 0x01050004u), cd23 = __builtin_amdgcn_perm(C, D, 0x03070206u);
            const int q0 = (int)__builtin_amdgcn_perm(ab01, cd01, 0x01000504u), q1 = (int)__builtin_amdgcn_perm(ab01, cd01, 0x03020706u);
            const int q2 = (int)__builtin_amdgcn_perm(ab23, cd23, 0x01000504u), q3 = (int)__builtin_amdgcn_perm(ab23, cd23, 0x03020706u);
            ah[4 * d + 0] = __builtin_amdgcn_sdot4(q0, whv[g], ah[4 * d + 0], false); al[4 * d + 0] = __builtin_amdgcn_sdot4(q0, wlv[g], al[4 * d + 0], false);
            ah[4 * d + 1] = __builtin_amdgcn_sdot4(q1, whv[g], ah[4 * d + 1], false); al[4 * d + 1] = __builtin_amdgcn_sdot4(q1, wlv[g], al[4 * d + 1], false);
            ah[4 * d + 2] = __builtin_amdgcn_sdot4(q2, whv[g], ah[4 * d + 2], false); al[4 * d + 2] = __builtin_amdgcn_sdot4(q2, wlv[g], al[4 * d + 2], false);
            ah[4 * d + 3] = __builtin_amdgcn_sdot4(q3, whv[g], ah[4 * d + 3], false); al[4 * d + 3] = __builtin_amdgcn_sdot4(q3, wlv[g], al[4 * d + 3], false);
        }
    }
    int y[16];
#pragma unroll
    for (int c = 0; c < 16; ++c) y[c] = ah[c] * 128 + al[c];
    const bool b5 = (lane & 32) != 0, b4 = (lane & 16) != 0, b3 = (lane & 8) != 0;
    int z[8], q[4];
#pragma unroll
    for (int k = 0; k < 8; ++k) z[k] = hx(y[k], y[8 + k], b5, 32);
#pragma unroll
    for (int k = 0; k < 4; ++k) q[k] = hx(z[k], z[4 + k], b4, 16);
    const int r0 = hx(q[0], q[2], b3, 8), r1 = hx(q[1], q[3], b3, 8);
    const int col = 128 * s + 16 * (lane & 7) + (b5 ? 8 : 0) + (b4 ? 4 : 0) + (b3 ? 2 : 0);
    const float2 g2 = *(const float2*)(gate2 + col); float2 x1 = *(const float2*)(x1row + col);
    x1.x += g2.x * wscale * (float)r0; x1.y += g2.y * wscale * (float)r1;
    *(float2*)(outrow + col) = x1;
}
}

constexpr size_t WS_SU = 2 * MiB, WS_SV = 2 * MiB + 65536, WS_HS = 2 * MiB + 131072;
constexpr size_t WS_UQ = 24 * MiB, WS_VQ = 40 * MiB, WS_H2Q = 56 * MiB;
constexpr size_t WS_XS = 2 * MiB + 262144, WS_WINS = 2 * MiB + 393216, WS_WPQS = 2 * MiB + 409600;
constexpr size_t WS_WINQ = 456 * MiB, WS_WPQQ = 460 * MiB;
constexpr size_t WS_SSQ = 464 * MiB;
constexpr size_t WS_A = WS_KA;
struct Args { const void* in[22]; float* out; unsigned char* ws; int ph_lo, ph_hi, li, pad; };

struct Frame {
    LAS unsigned char* lds;
    int tid, lane, wave, G, gw, NGW;
};

__host__ __device__ __forceinline__ int nat_col(int rho) {
    if (rho < 672) return rho;
    if (rho < 680) return C_FL + (rho - 672);
    if (rho < 768) return -1;
    if (rho < 1792) { const int t = (rho - 768) >> 8, c = (rho - 768) & 255, bj = c >> 7, wc = (c & 127) >> 5, i = c & 31; return (t < 2 ? C_FQ : C_FK) + 64 * (4 * (t & 1) + wc) + 32 * bj + i; }
    return C_FV + (rho - 1792);
}
namespace pg8 {
struct EpiProj {
    static constexpr bool PERM = true, AFTER_DRAIN = false;
    bf16_t* P; float* FL;
    __device__ __forceinline__ void operator()(const f32x4 (&acc)[2][2][4][2], const Unit& u, int wr, int wc, int fr, int fq) const {
        const int row0 = u.pm * BM + wr * 64 + fr, col0 = u.pn * BM + wc * 32 + 8 * fq;
#pragma unroll
        for (int ai = 0; ai < 2; ++ai)
#pragma unroll
            for (int m = 0; m < 4; ++m) { const int row = row0 + ai * HALF + m * 16; bf16_t* rowp = P + (size_t)row * PP + col0;
#pragma unroll
                for (int bj = 0; bj < 2; ++bj) { const f32x4 v0 = acc[ai][bj][m][0], v1 = acc[ai][bj][m][1];
                    if (col0 + bj * HALF == C_FL) { float* f = FL + (size_t)row * 8; *(f32x4*)f = v0; *(f32x4*)(f + 4) = v1; }
                    u32x4 w; w.x = cvt_pk_bf16(v0[0], v0[1]); w.y = cvt_pk_bf16(v0[2], v0[3]); w.z = cvt_pk_bf16(v1[0], v1[1]); w.w = cvt_pk_bf16(v1[2], v1[3]);
                    *(u32x4*)(rowp + bj * HALF) = w; } }
    }
};
struct EpiProjI8 {
    static constexpr bool PERM = true, AFTER_DRAIN = false;
    bf16_t* P; float* LOGF; float* SSQ; const float* rs; const float* cs; const float* g_fq; const float* g_fk; const float* b_f;
    __device__ __forceinline__ void operator()(const i32x4 (&acc)[2][2][4][2], const Unit& u, int wr, int wc, int fr, int fq) const {
        const int row0 = u.pm * BM + wr * 64 + fr, rho0 = u.pn * BM + wc * 32 + 8 * fq, pn = u.pn;
        f32x4 c0[2], c1[2];
#pragma unroll
        for (int bj = 0; bj < 2; ++bj) { c0[bj] = *(const f32x4*)(cs + rho0 + bj * HALF); c1[bj] = *(const f32x4*)(cs + rho0 + bj * HALF + 4); }
        const bool fox = pn >= 3 && pn <= 6, isq = pn < 5;
        f32x4 g0[2], g1[2];
        if (fox) { const float* g = (isq ? g_fq : g_fk) + 8 * fq;
#pragma unroll
            for (int bj = 0; bj < 2; ++bj) { g0[bj] = *(const f32x4*)(g + 32 * bj); g1[bj] = *(const f32x4*)(g + 32 * bj + 4); } }
#pragma unroll
        for (int ai = 0; ai < 2; ++ai)
#pragma unroll
            for (int m = 0; m < 4; ++m) {
                const int row = row0 + ai * HALF + m * 16; bf16_t* rowp = P + (size_t)row * PP; const float r = rs[row];
                f32x4 v0[2], v1[2];
#pragma unroll
                for (int bj = 0; bj < 2; ++bj) { const i32x4 a0 = acc[ai][bj][m][0], a1 = acc[ai][bj][m][1];
                    v0[bj] = (f32x4){(float)a0[0] * r * c0[bj][0], (float)a0[1] * r * c0[bj][1], (float)a0[2] * r * c0[bj][2], (float)a0[3] * r * c0[bj][3]};
                    v1[bj] = (f32x4){(float)a1[0] * r * c1[bj][0], (float)a1[1] * r * c1[bj][1], (float)a1[2] * r * c1[bj][2], (float)a1[3] * r * c1[bj][3]}; }
                float ssb[2];
#pragma unroll
                for (int bj = 0; bj < 2; ++bj) { float q = (v0[bj][0] * v0[bj][0] + v0[bj][1] * v0[bj][1]) + (v0[bj][2] * v0[bj][2] + v0[bj][3] * v0[bj][3]) + (v1[bj][0] * v1[bj][0] + v1[bj][1] * v1[bj][1]) + (v1[bj][2] * v1[bj][2] + v1[bj][3] * v1[bj][3]);
                    q += __shfl_xor(q, 16); q += __shfl_xor(q, 32); ssb[bj] = q; }
                if (fox) {
                    const float rr = rsqrtf((ssb[0] + ssb[1]) * (1.f / 64.f) + EPS) * (isq ? C2F : 1.f);
                    const int dst = (isq ? C_FQ : C_FK) + 64 * (4 * ((pn - 3) & 1) + wc) + 8 * fq;
#pragma unroll
                    for (int bj = 0; bj < 2; ++bj) { u32x4 w; w.x = cvt_pk_bf16(v0[bj][0] * rr * g0[bj][0], v0[bj][1] * rr * g0[bj][1]); w.y = cvt_pk_bf16(v0[bj][2] * rr * g0[bj][2], v0[bj][3] * rr * g0[bj][3]);
                        w.z = cvt_pk_bf16(v1[bj][0] * rr * g1[bj][0], v1[bj][1] * rr * g1[bj][1]); w.w = cvt_pk_bf16(v1[bj][2] * rr * g1[bj][2], v1[bj][3] * rr * g1[bj][3]);
                        *(u32x4*)(rowp + dst + 32 * bj) = w; }
                } else {
#pragma unroll
                    for (int bj = 0; bj < 2; ++bj) {
                        const int rho = rho0 + bj * HALF;
                        if (rho == 672) {
                            const float z[8] = {v0[bj][0], v0[bj][1], v0[bj][2], v0[bj][3], v1[bj][0], v1[bj][1], v1[bj][2], v1[bj][3]};
                            const int b = row / S_, sq = row % S_;
#pragma unroll
                            for (int h = 0; h < 8; ++h) { const float zz = z[h] + b_f[h]; LOGF[((size_t)b * 8 + h) * S_ + sq] = fminf(zz, 0.f) - log1pf(expf(-fabsf(zz))); }
                        } else if (rho < 672 || rho >= 1792) {
                            const int dst = rho < 672 ? rho : C_FV + (rho - 1792);
                            u32x4 w; w.x = cvt_pk_bf16(v0[bj][0], v0[bj][1]); w.y = cvt_pk_bf16(v0[bj][2], v0[bj][3]); w.z = cvt_pk_bf16(v1[bj][0], v1[bj][1]); w.w = cvt_pk_bf16(v1[bj][2], v1[bj][3]);
                            *(u32x4*)(rowp + dst) = w;
                            if (fq == 0 && rho < 640) {
                                if (pn == 0) { if (bj == 1) SSQ[(size_t)row * 16 + wc] = ssb[0] + ssb[1]; }
                                else if (pn == 1) SSQ[(size_t)row * 16 + (bj == 0 ? 4 : 8) + wc] = ssb[bj];
                                else SSQ[(size_t)row * 16 + 12 + wc] = ssb[bj];
                            }
                        }
                    }
                }
            }
    }
};
struct EpiStoreRms {
    static constexpr bool PERM = true, AFTER_DRAIN = false;
    bf16_t* O; int ldc; const float* SSQ; int slot0; float inv_cnt;
    __device__ __forceinline__ void operator()(const f32x4 (&acc)[2][2][4][2], const Unit& u, int wr, int wc, int fr, int fq) const {
        const int row0 = u.pm * BM + wr * 64 + fr, col0 = u.pn * BM + wc * 32 + 8 * fq;
#pragma unroll
        for (int ai = 0; ai < 2; ++ai)
#pragma unroll
            for (int m = 0; m < 4; ++m) { const int row = row0 + ai * HALF + m * 16; bf16_t* rowp = O + (size_t)row * ldc + col0;
                const f32x4 sa = *(const f32x4*)(SSQ + (size_t)row * 16 + slot0), sb = *(const f32x4*)(SSQ + (size_t)row * 16 + slot0 + 4);
                const float r = rsqrtf(((sa[0] + sa[1]) + (sa[2] + sa[3]) + (sb[0] + sb[1]) + (sb[2] + sb[3])) * inv_cnt + EPS);
#pragma unroll
                for (int bj = 0; bj < 2; ++bj) { const f32x4 v0 = acc[ai][bj][m][0] * r, v1 = acc[ai][bj][m][1] * r;
                    u32x4 w; w.x = cvt_pk_bf16(v0[0], v0[1]); w.y = cvt_pk_bf16(v0[2], v0[3]); w.z = cvt_pk_bf16(v1[0], v1[1]); w.w = cvt_pk_bf16(v1[2], v1[3]);
                    *(u32x4*)(rowp + bj * HALF) = w; } }
    }
};
struct EpiStoreI8 {
    static constexpr bool PERM = true, AFTER_DRAIN = false;
    bf16_t* O; int ldc; const float* rs; const float* cs;
    __device__ __forceinline__ void operator()(const i32x4 (&acc)[2][2][4][2], const Unit& u, int wr, int wc, int fr, int fq) const {
        const int row0 = u.pm * BM + wr * 64 + fr, col0 = u.pn * BM + wc * 32 + 8 * fq;
        f32x4 c0[2], c1[2];
#pragma unroll
        for (int bj = 0; bj < 2; ++bj) { c0[bj] = *(const f32x4*)(cs + col0 + bj * HALF); c1[bj] = *(const f32x4*)(cs + col0 + bj * HALF + 4); }
#pragma unroll
        for (int ai = 0; ai < 2; ++ai)
#pragma unroll
            for (int m = 0; m < 4; ++m) { const int row = row0 + ai * HALF + m * 16; bf16_t* rowp = O + (size_t)row * ldc + col0; const float r = rs[row];
#pragma unroll
                for (int bj = 0; bj < 2; ++bj) { const i32x4 a0 = acc[ai][bj][m][0], a1 = acc[ai][bj][m][1];
                    u32x4 w; w.x = cvt_pk_bf16((float)a0[0] * r * c0[bj][0], (float)a0[1] * r * c0[bj][1]); w.y = cvt_pk_bf16((float)a0[2] * r * c0[bj][2], (float)a0[3] * r * c0[bj][3]);
                    w.z = cvt_pk_bf16((float)a1[0] * r * c1[bj][0], (float)a1[1] * r * c1[bj][1]); w.w = cvt_pk_bf16((float)a1[2] * r * c1[bj][2], (float)a1[3] * r * c1[bj][3]);
                    *(u32x4*)(rowp + bj * HALF) = w; } }
    }
};
struct EpiStore {
    static constexpr bool PERM = true, AFTER_DRAIN = false;
    bf16_t* O; int ldc;
    __device__ __forceinline__ void operator()(const f32x4 (&acc)[2][2][4][2], const Unit& u, int wr, int wc, int fr, int fq) const {
        const int row0 = u.pm * BM + wr * 64 + fr, col0 = u.pn * BM + wc * 32 + 8 * fq;
#pragma unroll
        for (int ai = 0; ai < 2; ++ai)
#pragma unroll
            for (int m = 0; m < 4; ++m) { bf16_t* rowp = O + (size_t)(row0 + ai * HALF + m * 16) * ldc + col0;
#pragma unroll
                for (int bj = 0; bj < 2; ++bj) { const f32x4 v0 = acc[ai][bj][m][0], v1 = acc[ai][bj][m][1];
                    u32x4 w; w.x = cvt_pk_bf16(v0[0], v0[1]); w.y = cvt_pk_bf16(v0[2], v0[3]); w.z = cvt_pk_bf16(v1[0], v1[1]); w.w = cvt_pk_bf16(v1[2], v1[3]);
                    *(u32x4*)(rowp + bj * HALF) = w; } }
    }
};
struct EpiResid {
    static constexpr bool PERM = false, AFTER_DRAIN = false;
    const float* X; const float* MOD; float* out;
    __device__ __forceinline__ void operator()(const f32x4 (&acc)[2][2][4][2], const Unit& u, int wr, int wc, int fr, int fq) const {
        const int row0 = u.pm * BM + wr * 64 + fr, col0 = u.pn * BM + wc * 32 + 4 * fq;
        const int b = (u.pm * BM) / S_;
        f32x4 gv[2][2];
#pragma unroll
        for (int bj = 0; bj < 2; ++bj)
#pragma unroll
            for (int n = 0; n < 2; ++n) gv[bj][n] = *(const f32x4*)(MOD + b * 6144 + 2 * 1024 + col0 + bj * HALF + n * 16);
#pragma unroll
        for (int ai = 0; ai < 2; ++ai)
#pragma unroll
            for (int m = 0; m < 4; ++m) { const size_t off = (size_t)(row0 + ai * HALF + m * 16) * 1024 + col0;
#pragma unroll
                for (int bj = 0; bj < 2; ++bj)
#pragma unroll
                    for (int n = 0; n < 2; ++n) { const f32x4 xv = *(const f32x4*)(X + off + bj * HALF + n * 16); *(f32x4*)(out + off + bj * HALF + n * 16) = xv + gv[bj][n] * acc[ai][bj][m][n]; } }
    }
};
}

__device__ __forceinline__ void p0_transpose_item(const float* W, int K, int N, int Npad, bf16_t* WT, LAS float* scr, int item, int lane, const float* kscale = nullptr) {
    const int nblk = Npad / 32, kb = item / nblk, nb = item % nblk, k0 = 64 * kb, n0 = 32 * nb;
    const int nn = n0 + (lane & 31);
#pragma unroll 8
    for (int i = 0; i < 32; ++i) { const int kk = 2 * i + (lane >> 5); scr[kk * 33 + (lane & 31)] = nn < N ? W[(size_t)(k0 + kk) * N + nn] * (kscale ? kscale[k0 + kk] : 1.f) : 0.f; }
    asm volatile("s_waitcnt lgkmcnt(0)" ::: "memory");
    const int c = lane & 7;
#pragma unroll
    for (int j = 0; j < 4; ++j) { const int n = (lane >> 3) + 8 * j; const LAS float* s = scr + (8 * c) * 33 + n;
        u32x4 o; o.x = pk2(s[0 * 33], s[1 * 33]); o.y = pk2(s[2 * 33], s[3 * 33]); o.z = pk2(s[4 * 33], s[5 * 33]); o.w = pk2(s[6 * 33], s[7 * 33]);
        *(u32x4*)(WT + (size_t)(n0 + n) * K + k0 + 8 * c) = o; }
    asm volatile("s_waitcnt lgkmcnt(0)" ::: "memory");
}
__device__ __forceinline__ void p0_mod_block(const float* c, const float* w_ada, const float* b_ada, float* mod, LAS unsigned char* lds, int item, int wave, int lane) {
    LAS float* sil = (LAS float*)(lds + wave * 2048);
    LAS float* part = (LAS float*)(lds + 16384);
    for (int i = lane; i < 512; i += 64) { const int b = i >> 7, kk = i & 127; const float cv = c[b * 1024 + wave * 128 + kk]; sil[kk * 4 + b] = cv / (1.f + expf(-cv)); }
    asm volatile("s_waitcnt lgkmcnt(0)" ::: "memory");
    const int j = item * 64 + lane;
    const float* wp = w_ada + (size_t)(wave * 128) * 6144 + j;
    float a0 = 0.f, a1 = 0.f, a2 = 0.f, a3 = 0.f;
#pragma unroll 16
    for (int k = 0; k < 128; ++k) { const float w = wp[(size_t)k * 6144]; const f32x4 s = *(const LAS f32x4*)(sil + k * 4); a0 += s[0] * w; a1 += s[1] * w; a2 += s[2] * w; a3 += s[3] * w; }
    part[(wave * 4 + 0) * 64 + lane] = a0; part[(wave * 4 + 1) * 64 + lane] = a1; part[(wave * 4 + 2) * 64 + lane] = a2; part[(wave * 4 + 3) * 64 + lane] = a3;
    __syncthreads();
    if (wave < 4) { float acc = b_ada[j];
#pragma unroll
        for (int w = 0; w < 8; ++w) acc += part[(w * 4 + wave) * 64 + lane];
        mod[wave * 6144 + j] = acc; }
    __syncthreads();
}

struct ModIn { float4 v[4]; };
__device__ __forceinline__ void modrow_load(ModIn& M, const float* X, int row, int lane) {
    const float4* xr = (const float4*)(X + (size_t)row * 1024) + lane;
#pragma unroll
    for (int j = 0; j < 4; ++j) M.v[j] = xr[64 * j];
}
__device__ __forceinline__ void modrow_finish(ModIn& M, const float* g, const float* mod, int shift_idx, int scale_idx, bf16_t* out, unsigned char* outq, float* hs, int row, int lane) {
    const int b = row / S_; float ss = 0.f;
#pragma unroll
    for (int j = 0; j < 4; ++j) ss += (M.v[j].x * M.v[j].x + M.v[j].y * M.v[j].y) + (M.v[j].z * M.v[j].z + M.v[j].w * M.v[j].w);
    ss = wave_sum(ss);
    const float r = rsqrtf(ss * (1.f / 1024.f) + EPS);
    const float* sh = mod + b * 6144 + shift_idx * 1024; const float* sc = mod + b * 6144 + scale_idx * 1024;
    float am = 0.f;
#pragma unroll
    for (int j = 0; j < 4; ++j) {
        const int col = 4 * lane + 256 * j; float4& v = M.v[j];
        const float4 g4 = *(const float4*)(g + col), s4 = *(const float4*)(sc + col), h4 = *(const float4*)(sh + col);
        v.x = v.x * r * g4.x * (1.f + s4.x) + h4.x; v.y = v.y * r * g4.y * (1.f + s4.y) + h4.y; v.z = v.z * r * g4.z * (1.f + s4.z) + h4.z; v.w = v.w * r * g4.w * (1.f + s4.w) + h4.w;
        if (out) { uint2 w; w.x = pk2(v.x, v.y); w.y = pk2(v.z, v.w); *(uint2*)(out + (size_t)row * 1024 + col) = w; }
        am = fmaxf(am, fmaxf(fmaxf(fabsf(v.x), fabsf(v.y)), fmaxf(fabsf(v.z), fabsf(v.w))));
    }
    if (outq) {
#pragma unroll
        for (int o = 1; o < 64; o <<= 1) am = fmaxf(am, __shfl_xor(am, o));
        const float inv = am > 0.f ? 127.f / am : 0.f;
#pragma unroll
        for (int j = 0; j < 4; ++j) { const float4 v = M.v[j]; const int q0 = (int)rintf(v.x * inv), q1 = (int)rintf(v.y * inv), q2 = (int)rintf(v.z * inv), q3 = (int)rintf(v.w * inv);
            *(unsigned*)(outq + (size_t)row * 1024 + 4 * lane + 256 * j) = (unsigned)(q0 & 255) | ((unsigned)(q1 & 255) << 8) | ((unsigned)(q2 & 255) << 16) | ((unsigned)(q3 & 255) << 24); }
        if (lane == 0) hs[row] = am * (1.f / 127.f);
    }
}
__device__ __forceinline__ void modrows2(const float* X, const float* g, const float* mod, int shift_idx, int scale_idx, bf16_t* out, unsigned char* outq, float* hs, int gw, int ngw, int lane) {
    for (int row = gw; row < T_; row += 2 * ngw) {
        const int row2 = row + ngw; ModIn Ma, Mb;
        modrow_load(Ma, X, row, lane); if (row2 < T_) modrow_load(Mb, X, row2, lane);
        modrow_finish(Ma, g, mod, shift_idx, scale_idx, out, outq, hs, row, lane); if (row2 < T_) modrow_finish(Mb, g, mod, shift_idx, scale_idx, out, outq, hs, row2, lane);
    }
}
__device__ __forceinline__ void quant4(const float* peer_u, const float* peer_v, unsigned char* UQ, unsigned char* VQ, float* SU, float* SV, int r0, int lane) {
    float4 v[4][4]; float am[4];
#pragma unroll
    for (int q = 0; q < 4; ++q) { const int r = r0 + q; const float* src = (r < 16384 ? peer_u + (size_t)r * 1024 : peer_v + (size_t)(r - 16384) * 1024);
#pragma unroll
        for (int j = 0; j < 4; ++j) v[q][j] = ((const float4*)src)[lane + 64 * j]; }
#pragma unroll
    for (int q = 0; q < 4; ++q) { float a = 0.f;
#pragma unroll
        for (int j = 0; j < 4; ++j) a = fmaxf(a, fmaxf(fmaxf(fabsf(v[q][j].x), fabsf(v[q][j].y)), fmaxf(fabsf(v[q][j].z), fabsf(v[q][j].w))));
        am[q] = a; }
#pragma unroll
    for (int o = 1; o < 64; o <<= 1) {
#pragma unroll
        for (int q = 0; q < 4; ++q) am[q] = fmaxf(am[q], __shfl_xor(am[q], o)); }
#pragma unroll
    for (int q = 0; q < 4; ++q) { const int r = r0 + q; unsigned char* dst = (r < 16384 ? UQ + (size_t)r * 1024 : VQ + (size_t)(r - 16384) * 1024); float* sc = (r < 16384 ? SU + r : SV + (r - 16384));
        const float inv = am[q] > 0.f ? 127.f / am[q] : 0.f;
#pragma unroll
        for (int j = 0; j < 4; ++j) { const float4 x = v[q][j]; const int q0 = (int)rintf(x.x * inv), q1 = (int)rintf(x.y * inv), q2 = (int)rintf(x.z * inv), q3 = (int)rintf(x.w * inv);
            *(unsigned*)(dst + 4 * lane + 256 * j) = (unsigned)(q0 & 255) | ((unsigned)(q1 & 255) << 8) | ((unsigned)(q2 & 255) << 16) | ((unsigned)(q3 & 255) << 24); }
        if (lane == 0) *sc = am[q] * (1.f / 127.f); }
}

__global__ void __launch_bounds__(NWAVES * 64, 2) mega_fwd(Args args) {
    extern __shared__ __attribute__((aligned(16))) unsigned char lds[];
    Frame F;
    F.lds = (LAS unsigned char*)lds;
    volatile LAS unsigned* MISC = (volatile LAS unsigned*)(F.lds + MISC_OFF);
    F.tid = threadIdx.x; F.lane = F.tid & 63; F.wave = __builtin_amdgcn_readfirstlane(F.tid >> 6);
    F.G = gridDim.x; F.gw = blockIdx.x * NWAVES + F.wave; F.NGW = F.G * NWAVES;
    unsigned char* ws = args.ws;
    unsigned* ctl = (unsigned*)(ws + WS_CTL);
    const float* x = (const float*)args.in[0]; const float* c = (const float*)args.in[1]; const int* positions = (const int*)args.in[2];
    const float* w_ada = (const float*)args.in[3]; const float* b_ada = (const float*)args.in[4]; const float* norm1_g = (const float*)args.in[5];
    const float* w_in = (const float*)args.in[6]; const float* mla_qa_g = (const float*)args.in[7]; const float* mla_kva_g = (const float*)args.in[8];
    const float* w_uq = (const float*)args.in[9]; const float* w_ukv = (const float*)args.in[10]; const float* mla_q_g = (const float*)args.in[11];
    const float* mla_k_g = (const float*)args.in[12]; const float* fox_q_g = (const float*)args.in[13]; const float* fox_k_g = (const float*)args.in[14];
    const float* b_f = (const float*)args.in[15]; const float* w_o = (const float*)args.in[16]; const float* norm2_g = (const float*)args.in[17];
    const float* w_pq = (const float*)args.in[18]; const float* sub_keys = (const float*)args.in[19]; const float* peer_u = (const float*)args.in[20]; const float* peer_v = (const float*)args.in[21];
    float* out = args.out;
    float* MOD = (float*)(ws + WS_MOD); float* FL = (float*)(ws + WS_FL); float* FCUM = (float*)(ws + WS_FCUM); float* LOGF = (float*)(ws + WS_LOGF); float2* ROPE = (float2*)(ws + WS_ROPE);
    bf16_t* XN = (bf16_t*)(ws + WS_XN); bf16_t* PROJ = (bf16_t*)(ws + WS_PROJ); bf16_t* KVRAW = (bf16_t*)(ws + WS_KVRAW); bf16_t* QA = (bf16_t*)(ws + WS_QA); bf16_t* KA = (bf16_t*)(ws + WS_KA);
    bf16_t* WIN = (bf16_t*)(ws + WS_WIN); bf16_t* WUQ = (bf16_t*)(ws + WS_WUQ); bf16_t* WUKV = (bf16_t*)(ws + WS_WUKV); bf16_t* WO = (bf16_t*)(ws + WS_WO); bf16_t* WPQ = (bf16_t*)(ws + WS_WPQ); bf16_t* SKB = (bf16_t*)(ws + WS_SK);
    float* SSQ = (float*)(ws + WS_SSQ);
    unsigned char* XNQ = ws + WS_XN; float* XS = (float*)(ws + WS_XS); unsigned char* WINQ = ws + WS_WINQ; unsigned char* WPQQ = ws + WS_WPQQ; float* WINS = (float*)(ws + WS_WINS); float* WPQS = (float*)(ws + WS_WPQS);
    unsigned char* UQ = ws + WS_UQ; unsigned char* VQ = ws + WS_VQ; unsigned char* H2Q = ws + WS_H2Q; float* SU = (float*)(ws + WS_SU); float* SV = (float*)(ws + WS_SV); float* HS = (float*)(ws + WS_HS); float* AP = (float*)(ws + WS_A);
    bf16_t* OB = XN; bf16_t* H2 = XN; bf16_t* QP = PROJ; int* EID = (int*)(ws + WS_QA); float* GATE = (float*)(ws + WS_QA + 16 * MiB);
    (void)sub_keys; (void)peer_u; (void)peer_v; (void)positions; (void)KA; (void)FCUM; (void)LOGF; (void)ROPE; (void)mla_q_g; (void)mla_k_g; (void)b_f; (void)fox_q_g; (void)fox_k_g; (void)mla_qa_g; (void)mla_kva_g;

    for (int u = F.tid; u < (LDS_BYTES - LDSCTL_OFF) / 4; u += NWAVES * 64) ((LAS unsigned*)(F.lds + LDSCTL_OFF))[u] = 0u;
    __syncthreads();
    const int lo = args.ph_lo, hi = args.ph_hi;
    XcdBarrier bar; bar.bar = ctl + CW_BAR + args.li * XCD_BAR_WORDS; bar.x = 0; bar.st = nullptr;
    if (hi - lo > 1) bar = xcd_barrier_post(ctl + CW_BAR + args.li * XCD_BAR_WORDS, MISC + 8);
#define IN(k) (lo <= (k) && (k) < hi)
#define SEAM(k) do { if (IN(k) && IN((k) + 1)) xcd_barrier(bar); } while (0)

    if (IN(0)) REP(0) {
        LAS float* scr = (LAS float*)(F.lds + F.wave * 16384);
        constexpr int I_MOD = 96, I_IN = 16 * 72, I_UQ = 6 * 24, I_UKV = 4 * 32, I_O = 16 * 32, I_PQ = 16 * 64;
        constexpr int I_SK = 512;
        constexpr int NITEMS = I_IN + I_UQ + I_UKV + I_O + I_PQ + I_SK;
        {
            const float invf = (float)exp2(-(double)(F.lane & 15) * (13.287712379549449 / 16.0));
            for (int r4 = F.gw * 4; r4 < T_; r4 += F.NGW * 4) { const int row = r4 + (F.lane >> 4);
                const double a = (double)((float)positions[row] * invf), n = rint(a * 0.15915494309189535); const float red = (float)(a - n * 6.283185307179586);
                ROPE[(size_t)row * 16 + (F.lane & 15)] = make_float2(__cosf(red), __sinf(red)); }
        }
        for (int mi = (int)blockIdx.x; mi < I_MOD; mi += F.G) p0_mod_block(c, w_ada, b_ada, MOD, F.lds, mi, F.wave, F.lane);
        for (int it = F.gw; it < NITEMS; it += F.NGW) {
            int r = it;
            if (r < I_IN) { p0_transpose_item(w_in, 1024, INW, PP, WIN, scr, r, F.lane); continue; } r -= I_IN;
            if (r < I_UQ) { p0_transpose_item(w_uq, 384, 768, 768, WUQ, scr, r, F.lane, mla_qa_g); continue; } r -= I_UQ;
            if (r < I_UKV) { p0_transpose_item(w_ukv, 256, 1024, 1024, WUKV, scr, r, F.lane, mla_kva_g); continue; } r -= I_UKV;
            if (r < I_O) { p0_transpose_item(w_o, 1024, 1024, 1024, WO, scr, r, F.lane); continue; } r -= I_O;
            if (r < I_PQ) { p0_transpose_item(w_pq, 1024, 2048, 2048, WPQ, scr, r, F.lane); continue; } r -= I_PQ;
            { const float4* src = (const float4*)(sub_keys + (size_t)r * 512) + F.lane * 2; const float4 a = src[0], b2 = src[1];
              u32x4 o; o.x = pk2(a.x, a.y); o.y = pk2(a.z, a.w); o.z = pk2(b2.x, b2.y); o.w = pk2(b2.z, b2.w); *(u32x4*)(SKB + (size_t)r * 512 + F.lane * 8) = o; }
        }
    }
    SEAM(0);
    if (IN(1)) {
        for (int r = F.gw; r < PP + 2048; r += F.NGW) {
            const int nc = r < PP ? nat_col(r) : 0;
            const bf16_t* src = r < PP ? WIN + (size_t)(nc < 0 ? 0 : nc) * 1024 : WPQ + (size_t)(r - PP) * 1024; unsigned char* dst = r < PP ? WINQ + (size_t)r * 1024 : WPQQ + (size_t)(r - PP) * 1024; float* sc = r < PP ? WINS + r : WPQS + (r - PP);
            float v[16]; unpack8(*(const uint4*)(src + F.lane * 16), v); unpack8(*(const uint4*)(src + F.lane * 16 + 8), v + 8);
            if (nc < 0) {
#pragma unroll
                for (int i = 0; i < 16; ++i) v[i] = 0.f; }
            float am = 0.f;
#pragma unroll
            for (int i = 0; i < 16; ++i) am = fmaxf(am, fabsf(v[i]));
#pragma unroll
            for (int o = 1; o < 64; o <<= 1) am = fmaxf(am, __shfl_xor(am, o));
            const float inv = am > 0.f ? 127.f / am : 0.f; unsigned q[4];
#pragma unroll
            for (int i = 0; i < 4; ++i) q[i] = (unsigned)((int)rintf(v[4 * i] * inv) & 255) | ((unsigned)((int)rintf(v[4 * i + 1] * inv) & 255) << 8) | ((unsigned)((int)rintf(v[4 * i + 2] * inv) & 255) << 16) | ((unsigned)((int)rintf(v[4 * i + 3] * inv) & 255) << 24);
            *(uint4*)(dst + F.lane * 16) = make_uint4(q[0], q[1], q[2], q[3]);
            if (F.lane == 0) *sc = am * (1.f / 127.f);
        }
        modrows2(x, norm1_g, MOD, 0, 1, nullptr, XNQ, XS, F.gw, F.NGW, F.lane);
    }
    SEAM(1);
    if (IN(2)) REP(2) {
        pg8::Gemm g{(const bf16_t*)XNQ, (const bf16_t*)WINQ, T_, PP, 512, 512}; pg8::StaticOrder S; S.init(T_, PP, F.G, (int)blockIdx.x);
        pg8::EpiProjI8 E{PROJ, LOGF, SSQ, XS, WINS, fox_q_g, fox_k_g, b_f};
        pg8::gemm_phase<pg8::EpiProjI8, pg8::StaticOrder, true, true, true>(F.lds, g, S, E);
    }
    SEAM(2);
    if (IN(4)) REP(4) {
        { pg8::Gemm g{PROJ + C_CQ, WUQ, T_, 768, 384, PP}; pg8::StaticOrder S; S.init(T_, 768, F.G, (int)blockIdx.x); pg8::EpiStoreRms E{QA, 768, SSQ, 0, 1.f / 384.f};
          pg8::gemm_phase<pg8::EpiStoreRms, pg8::StaticOrder, true, true>(F.lds, g, S, E); }
        { pg8::Gemm g{PROJ + C_CKV, WUKV, T_, 1024, 256, PP}; pg8::StaticOrder S; S.init(T_, 1024, F.G, (int)blockIdx.x); pg8::EpiStoreRms E{KVRAW, 1024, SSQ, 8, 1.f / 256.f};
          pg8::gemm_phase<pg8::EpiStoreRms, pg8::StaticOrder, true, true>(F.lds, g, S, E); }
    }
    SEAM(4);
    if (IN(5)) {
        if (F.wave == 0 && (int)blockIdx.x < 32) fcum_item(LOGF, FCUM, (int)blockIdx.x, F.lane);
        for (int row = F.gw; row < T_; row += 2 * F.NGW) {
            const int row2 = row + F.NGW; MlaIn Ma, Mb;
            mlaprep_load(Ma, QA, KVRAW, PROJ, ROPE, row, F.lane); if (row2 < T_) mlaprep_load(Mb, QA, KVRAW, PROJ, ROPE, row2, F.lane);
            mlaprep_finish(Ma, QA, KA, mla_q_g, mla_k_g, row, F.lane); if (row2 < T_) mlaprep_finish(Mb, QA, KA, mla_q_g, mla_k_g, row2, F.lane);
        }
    }
    SEAM(5);
    if (IN(6)) {
        volatile LAS unsigned* qslot = MISC + 16;
        float thr;
        { float gq = fabsf(fox_q_g[F.lane]), gk = fabsf(fox_k_g[F.lane]);
#pragma unroll
          for (int o = 1; o < 64; o <<= 1) { gq = fmaxf(gq, __shfl_xor(gq, o)); gk = fmaxf(gk, __shfl_xor(gk, o)); }
          thr = 104.5f + 2.f * 1.02f * 8.f * gq * gk; }
        unsigned* qctr = ctl + 64;
        if (F.tid == 0) qslot[0] = atomicAdd(qctr, 1u);
        __syncthreads();
        unsigned u = qslot[0];
        while (u < 2048u + 1024u) {
            unsigned unext = 0u;
            if (F.tid == 0) unext = atomicAdd(qctr, 1u);
            if (u >= 2048u) {
                quant4(peer_u, peer_v, UQ, VQ, SU, SV, (int)(u - 2048u) * 32 + F.wave * 4, F.lane);
                if (F.tid == 0) qslot[0] = unext;
                __syncthreads();
                u = qslot[0];
                __syncthreads();
                continue;
            }
            const int grp = (int)(u >> 10), bh = (int)(u & 31u), qb = 31 - (int)((u >> 5) & 31u), b = bh >> 3, h = bh & 7;
            if (grp == 0) { const att::Desc d{QA + (size_t)b * S_ * 768 + h * 96, 768, KA + (size_t)b * S_ * 768 + h * 96, 768, KVRAW + (size_t)b * S_ * 1024 + h * 128 + 64, 1024, OB + (size_t)b * S_ * 1024 + h * 64, 1024, nullptr};
                att::attn_unit<6, false>(d, qb, 0, F.lds); }
            else { const bf16_t* pb = PROJ + (size_t)b * S_ * PP + h * 64; const float* fc = FCUM + (size_t)(b * 8 + h) * S_;
                const att::Desc d{pb + C_FQ, PP, pb + C_FK, PP, pb + C_FV, PP, OB + (size_t)b * S_ * 1024 + 512 + h * 64, 1024, fc};
                const int NT = 4 * (qb + 1); const float lim = fc[qb * 256] + thr;
                int j0 = 0;
                { const int ja = F.lane, jb2 = 64 + F.lane;
                  const bool ka = ja < NT ? (fc[64 * ja + 63] <= lim) : true, kb = jb2 < NT ? (fc[64 * jb2 + 63] <= lim) : true;
                  const unsigned long long ma = __ballot(ka), mb = __ballot(kb);
                  j0 = ma ? __builtin_ctzll(ma) : (mb ? 64 + __builtin_ctzll(mb) : NT - 4); }
                if (j0 > NT - 4) j0 = NT - 4;
                att::attn_unit<4, true>(d, qb, j0, F.lds); }
            if (F.tid == 0) qslot[0] = unext;
            __syncthreads();
            u = qslot[0];
            __syncthreads();
        }
    }
    SEAM(6);
    if (IN(7)) REP(7) {
        pg8::Gemm g{OB, WO, T_, 1024, 1024, 1024}; pg8::StaticOrder S; S.init(T_, 1024, F.G, (int)blockIdx.x);
        pg8::EpiResid E{x, MOD, out};
        pg8::gemm_phase<pg8::EpiResid, pg8::StaticOrder, true, true>(F.lds, g, S, E);
    }
    SEAM(7);
    if (IN(8)) modrows2(out, norm2_g, MOD, 3, 4, nullptr, H2Q, HS, F.gw, F.NGW, F.lane);
    SEAM(8);
    if (IN(9)) REP(9) {
        pg8::Gemm g{(const bf16_t*)H2Q, (const bf16_t*)WPQQ, T_, 2048, 512, 512}; pg8::StaticOrder S; S.init(T_, 2048, F.G, (int)blockIdx.x); pg8::EpiStoreI8 E{QP, 2048, HS, WPQS};
        pg8::gemm_phase<pg8::EpiStoreI8, pg8::StaticOrder, true, true, true>(F.lds, g, S, E);
    }
    SEAM(9);
    if (IN(10)) REP(10) { for (int w = F.gw; w < (T_ / 32) * 4; w += F.NGW) pk::topk_item2(QP, SKB, EID, GATE, w, F.lane); }
    SEAM(10);
    {
        const int ng = F.G < 8 ? F.G : 8; const int vx = (int)blockIdx.x % ng, rank = (int)blockIdx.x / ng, nrank = (F.G - vx + ng - 1) / ng;
        const int gwv = rank * NWAVES + F.wave, ngwv = nrank * NWAVES;
        const int grp = F.lane >> 3, sub = F.lane & 7;
        int* PA = (int*)(ws + WS_PROJ);
        int* WQH = (int*)(ws + WS_KA); int* WQL = (int*)(ws + WS_KA + 4 * MiB); float* WSC = (float*)(ws + WS_KA + 8 * MiB);
        if (IN(11)) REP(11) {
            for (int s = vx; s < 8; s += ng) {
                const unsigned char* UQs = UQ + 128 * s + 16 * sub;
                int t = gwv; int4 ev[4]; int4 hq = make_int4(0, 0, 0, 0);
#pragma unroll
                for (int k = 0; k < 4; ++k) ev[k] = make_int4(0, 0, 0, 0);
                if (t < T_) {
#pragma unroll
                    for (int k = 0; k < 4; ++k) ev[k] = *(const int4*)(EID + (size_t)t * 128 + grp * 16 + 4 * k);
                    hq = *(const int4*)(H2Q + (size_t)t * 1024 + 128 * s + 16 * sub); }
                while (t < T_) {
                    const int tn = t + ngwv; int4 evn[4]; int4 hqn = make_int4(0, 0, 0, 0);
#pragma unroll
                    for (int k = 0; k < 4; ++k) evn[k] = make_int4(0, 0, 0, 0);
                    if (tn < T_) {
#pragma unroll
                        for (int k = 0; k < 4; ++k) evn[k] = *(const int4*)(EID + (size_t)tn * 128 + grp * 16 + 4 * k);
                        hqn = *(const int4*)(H2Q + (size_t)tn * 1024 + 128 * s + 16 * sub); }
                    gx::u_token(UQs, ev, hq, PA + ((size_t)s * T_ + t) * 128, F.lane);
                    t = tn; hq = hqn;
#pragma unroll
                    for (int k = 0; k < 4; ++k) ev[k] = evn[k];
                }
            }
        }
        SEAM(11);
        if (IN(12)) REP(12) {
            for (int t = F.gw; t < T_; t += F.NGW) {
                int i0 = 0, i1 = 0;
#pragma unroll
                for (int s = 0; s < 8; ++s) { const int2 p = *(const int2*)(PA + ((size_t)s * T_ + t) * 128 + 2 * F.lane); i0 += p.x; i1 += p.y; }
                const int2 e2 = *(const int2*)(EID + (size_t)t * 128 + 2 * F.lane); const float2 g2 = *(const float2*)(GATE + (size_t)t * 128 + 2 * F.lane); const float hs = HS[t];
                const float w0 = g2.x * gx::gelu_t((float)i0 * SU[e2.x] * hs) * SV[e2.x], w1 = g2.y * gx::gelu_t((float)i1 * SU[e2.y] * hs) * SV[e2.y];
                float wm = fmaxf(fabsf(w0), fabsf(w1));
#pragma unroll
                for (int o = 1; o < 64; o <<= 1) wm = fmaxf(wm, __shfl_xor(wm, o));
                const float inv = wm > 0.f ? 16256.f / wm : 0.f;
                const int q0 = (int)rintf(w0 * inv), q1 = (int)rintf(w1 * inv);
                const unsigned h2 = (unsigned)((q0 >> 7) & 255) | ((unsigned)((q1 >> 7) & 255) << 8), l2 = (unsigned)(q0 & 127) | ((unsigned)(q1 & 127) << 8);
                const unsigned h2p = __shfl_xor(h2, 1), l2p = __shfl_xor(l2, 1);
                if ((F.lane & 1) == 0) { WQH[(size_t)t * 32 + (F.lane >> 1)] = (int)(h2 | (h2p << 16)); WQL[(size_t)t * 32 + (F.lane >> 1)] = (int)(l2 | (l2p << 16)); }
                if (F.lane == 0) WSC[t] = wm * (1.f / 16256.f);
            }
        }
        SEAM(12);
        if (IN(13)) REP(13) {
            for (int s = vx; s < 8; s += ng) {
                const unsigned char* VQs = VQ + 128 * s + 16 * sub;
                int t = gwv; int4 ev[4]; int4 wh = make_int4(0, 0, 0, 0), wl = make_int4(0, 0, 0, 0); float wsc = 0.f;
#pragma unroll
                for (int k = 0; k < 4; ++k) ev[k] = make_int4(0, 0, 0, 0);
                if (t < T_) {
#pragma unroll
                    for (int k = 0; k < 4; ++k) ev[k] = *(const int4*)(EID + (size_t)t * 128 + grp * 16 + 4 * k);
                    wh = *(const int4*)(WQH + (size_t)t * 32 + grp * 4); wl = *(const int4*)(WQL + (size_t)t * 32 + grp * 4); wsc = WSC[t]; }
                while (t < T_) {
                    const int tn = t + ngwv; int4 evn[4]; int4 whn = make_int4(0, 0, 0, 0), wln = make_int4(0, 0, 0, 0); float wscn = 0.f;
#pragma unroll
                    for (int k = 0; k < 4; ++k) evn[k] = make_int4(0, 0, 0, 0);
                    if (tn < T_) {
#pragma unroll
                        for (int k = 0; k < 4; ++k) evn[k] = *(const int4*)(EID + (size_t)tn * 128 + grp * 16 + 4 * k);
                        whn = *(const int4*)(WQH + (size_t)tn * 32 + grp * 4); wln = *(const int4*)(WQL + (size_t)tn * 32 + grp * 4); wscn = WSC[tn]; }
                    float* dstrow = (PROBE_DUP == 13 && _r == 0) ? (float*)(ws + WS_XN) + (size_t)t * 1024 : out + (size_t)t * 1024;
                    gx::v_token(VQs, ev, wh, wl, wsc, MOD + (t / S_) * 6144 + 5 * 1024, out + (size_t)t * 1024, dstrow, s, F.lane);
                    t = tn; wh = whn; wl = wln; wsc = wscn;
#pragma unroll
                    for (int k = 0; k < 4; ++k) ev[k] = evn[k];
                }
            }
        }
    }
#undef IN
#undef SEAM
}

static int g_grid = 0;
static void launch_mega(const Args& base, int lo, int hi, int li, hipStream_t stream) {
    Args a = base; a.ph_lo = lo; a.ph_hi = hi; a.li = li;
    hipLaunchKernelGGL(mega_fwd, dim3(g_grid), dim3(NWAVES * 64), LDS_BYTES, stream, a);
}

extern "C" void kernel_launch(void* const* d_in, const int* in_sizes, int n_in, void* d_out, int out_size, void* d_ws, size_t ws_size, hipStream_t stream) {
    if (g_grid == 0) {
        int dev = 0, cus = 0;
        hipGetDevice(&dev); hipDeviceGetAttribute(&cus, hipDeviceAttributeMultiprocessorCount, dev);
        hipFuncSetAttribute((const void*)mega_fwd, hipFuncAttributeMaxDynamicSharedMemorySize, LDS_BYTES);
        int per_cu = 0; hipOccupancyMaxActiveBlocksPerMultiprocessor(&per_cu, (const void*)mega_fwd, NWAVES * 64, LDS_BYTES);
        (void)hipGetLastError();
        g_grid = cus > 0 ? cus : 256;
        if (per_cu < 1) fprintf(stderr, "kernel_launch: occupancy query says %d blocks/CU\n", per_cu);
    }
    const float* x = (const float*)d_in[0]; const int* positions = (const int*)d_in[2];
    const float* mla_qa_g = (const float*)d_in[7]; const float* mla_kva_g = (const float*)d_in[8];
    const float* mla_q_g = (const float*)d_in[11]; const float* mla_k_g = (const float*)d_in[12]; const float* fox_q_g = (const float*)d_in[13]; const float* fox_k_g = (const float*)d_in[14];
    const float* b_f = (const float*)d_in[15]; const float* sub_keys = (const float*)d_in[19]; const float* peer_u = (const float*)d_in[20]; const float* peer_v = (const float*)d_in[21];
    float* out = (float*)d_out; unsigned char* ws = (unsigned char*)d_ws;
    float* MOD = (float*)(ws + WS_MOD); float* FL = (float*)(ws + WS_FL); float* FCUM = (float*)(ws + WS_FCUM); float* LOGF = (float*)(ws + WS_LOGF); float2* ROPE = (float2*)(ws + WS_ROPE);
    bf16_t* XN = (bf16_t*)(ws + WS_XN); bf16_t* PROJ = (bf16_t*)(ws + WS_PROJ); bf16_t* KVRAW = (bf16_t*)(ws + WS_KVRAW); bf16_t* QA = (bf16_t*)(ws + WS_QA); bf16_t* KA = (bf16_t*)(ws + WS_KA);
    bf16_t* OB = XN; bf16_t* H2 = XN; bf16_t* QP = PROJ; int* EID = (int*)(ws + WS_QA); float* GATE = (float*)(ws + WS_QA + 16 * MiB);
    (void)x;
    hipMemsetAsync(ws + WS_CTL, 0, CTL_ZERO_BYTES, stream);
    Args base{}; for (int i = 0; i < 22; ++i) base.in[i] = d_in[i]; base.out = out; base.ws = ws;

    launch_mega(base, 0, 14, 0, stream);
}
```

```cpp
#include <hip/hip_runtime.h>
#include <cstdint>
#include <cstdio>
#include <cmath>

typedef unsigned short bf16_t;
constexpr int B_ = 4, S_ = 8192, D_ = 1024, T_ = B_ * S_;
constexpr int PP = 2304;
constexpr int C_CQ = 0, C_CKV = 384, C_KPE = 640, C_FQ = 672, C_FK = 1184, C_FV = 1696, C_FL = 2208, INW = 2216;
constexpr float EPS = 1e-6f;
constexpr float LOG2E = 1.4426950408889634f;
constexpr float C2A = 0.10206207261596577f * LOG2E;
constexpr float C2F = 0.125f * LOG2E;

__device__ __forceinline__ float bf2f(bf16_t v) { return __uint_as_float(((unsigned)v) << 16); }
__device__ __forceinline__ bf16_t f2bf(float f) { unsigned u = __float_as_uint(f); return (bf16_t)((u + 0x7fffu + ((u >> 16) & 1u)) >> 16); }
__device__ __forceinline__ unsigned pk2(float lo, float hi) { return (unsigned)f2bf(lo) | ((unsigned)f2bf(hi) << 16); }
__device__ __forceinline__ float lo2f(unsigned w) { return __uint_as_float(w << 16); }
__device__ __forceinline__ float hi2f(unsigned w) { return __uint_as_float(w & 0xffff0000u); }
__device__ __forceinline__ float wave_sum(float v) {
#pragma unroll
    for (int o = 1; o < 64; o <<= 1) v += __shfl_xor(v, o);
    return v;
}

constexpr size_t MiB = 1u << 20;
constexpr size_t WS_MOD = 1 * MiB;
constexpr size_t WS_FL = 3 * MiB;
constexpr size_t WS_FCUM = 4 * MiB;
constexpr size_t WS_LOGF = 5 * MiB;
constexpr size_t WS_ROPE = 6 * MiB;
constexpr size_t WS_XN = 88 * MiB;
constexpr size_t WS_PROJ = 152 * MiB;
constexpr size_t WS_KVRAW = 296 * MiB;
constexpr size_t WS_QA = 360 * MiB;
constexpr size_t WS_KA = 408 * MiB;

__device__ __forceinline__ void unpack8(const uint4 raw, float* v) {
    v[0] = lo2f(raw.x); v[1] = hi2f(raw.x); v[2] = lo2f(raw.y); v[3] = hi2f(raw.y); v[4] = lo2f(raw.z); v[5] = hi2f(raw.z); v[6] = lo2f(raw.w); v[7] = hi2f(raw.w);
}
__device__ __forceinline__ void fcum_item(const float* LOGF, float* FCUM, int item, int lane) {
    const float4* src = (const float4*)(LOGF + (size_t)item * S_ + 128 * lane);
    float4 v[32]; float tot = 0.f;
#pragma unroll
    for (int i = 0; i < 32; ++i) v[i] = src[i];
#pragma unroll
    for (int i = 0; i < 32; ++i) tot += (v[i].x + v[i].y) + (v[i].z + v[i].w);
    float incl = tot;
#pragma unroll
    for (int o = 1; o < 64; o <<= 1) { const float t = __shfl_up(incl, o); if (lane >= o) incl += t; }
    float run = incl - tot;
    float4* dst = (float4*)(FCUM + (size_t)item * S_ + 128 * lane);
#pragma unroll
    for (int i = 0; i < 32; ++i) { float4 o; run += v[i].x; o.x = run; run += v[i].y; o.y = run; run += v[i].z; o.z = run; run += v[i].w; o.w = run; dst[i] = o; }
}

struct MlaIn { uint4 qn, kn; unsigned q1, q2, k1, k2; float2 cs0, cs1; };
__device__ __forceinline__ void mlaprep_load(MlaIn& M, const bf16_t* QRAW, const bf16_t* KVRAW, const bf16_t* PROJ, const float2* ROPE, int row, int lane) {
    const int h = lane >> 3, p = lane & 7;
    const bf16_t* q = QRAW + (size_t)row * 768 + h * 96; const bf16_t* kp = PROJ + (size_t)row * PP + C_KPE;
    M.qn = *(const uint4*)(q + 8 * p); M.q1 = *(const unsigned*)(q + 64 + 2 * p); M.q2 = *(const unsigned*)(q + 80 + 2 * p);
    M.kn = *(const uint4*)(KVRAW + (size_t)row * 1024 + h * 128 + 8 * p); M.k1 = *(const unsigned*)(kp + 2 * p); M.k2 = *(const unsigned*)(kp + 16 + 2 * p);
    M.cs0 = ROPE[(size_t)row * 16 + 2 * p]; M.cs1 = ROPE[(size_t)row * 16 + 2 * p + 1];
}
__device__ __forceinline__ void mlaprep_finish(const MlaIn& M, bf16_t* QRAW, bf16_t* KA, const float* g_q, const float* g_k, int row, int lane) {
    const int h = lane >> 3, p = lane & 7;
#pragma unroll
    for (int which = 0; which < 2; ++which) {
        const float* g = which == 0 ? g_q : g_k; const float sc = which == 0 ? C2A : 1.f;
        float v[8]; unpack8(which == 0 ? M.qn : M.kn, v); const unsigned r1 = which == 0 ? M.q1 : M.k1, r2 = which == 0 ? M.q2 : M.k2;
        float a0 = lo2f(r1), a1 = hi2f(r1), b0 = lo2f(r2), b1 = hi2f(r2);
        float ss = a0 * a0 + a1 * a1 + b0 * b0 + b1 * b1;
#pragma unroll
        for (int i = 0; i < 8; ++i) ss += v[i] * v[i];
        ss += __shfl_xor(ss, 1); ss += __shfl_xor(ss, 2); ss += __shfl_xor(ss, 4);
        const float r = rsqrtf(ss * (1.f / 96.f) + EPS);
        const float* gn = g + 8 * p;
        a0 *= r * g[64 + 2 * p]; a1 *= r * g[64 + 2 * p + 1]; b0 *= r * g[80 + 2 * p]; b1 *= r * g[80 + 2 * p + 1];
        const float ra0 = a0 * M.cs0.x - b0 * M.cs0.y, rb0 = b0 * M.cs0.x + a0 * M.cs0.y, ra1 = a1 * M.cs1.x - b1 * M.cs1.y, rb1 = b1 * M.cs1.x + a1 * M.cs1.y;
        uint4 o; o.x = pk2(v[0] * r * gn[0] * sc, v[1] * r * gn[1] * sc); o.y = pk2(v[2] * r * gn[2] * sc, v[3] * r * gn[3] * sc);
        o.z = pk2(v[4] * r * gn[4] * sc, v[5] * r * gn[5] * sc); o.w = pk2(v[6] * r * gn[6] * sc, v[7] * r * gn[7] * sc);
        bf16_t* dst = (which == 0 ? QRAW : KA) + (size_t)row * 768 + h * 96;
        *(uint4*)(dst + 8 * p) = o; *(unsigned*)(dst + 64 + 2 * p) = pk2(ra0 * sc, ra1 * sc); *(unsigned*)(dst + 80 + 2 * p) = pk2(rb0 * sc, rb1 * sc);
    }
}
namespace pg8 {
#define PG8_LAS __attribute__((address_space(3)))
typedef unsigned short bf16_t;
typedef short bf16x8 __attribute__((ext_vector_type(8)));
typedef float f32x4 __attribute__((ext_vector_type(4)));
typedef unsigned u32x4 __attribute__((ext_vector_type(4)));
constexpr int BM = 256, BK = 64, HALF = 128, HTB = HALF * BK * 2  , STAGE_BYTES = 8 * HTB, NXCD = 8, WGM = 8;

__host__ __device__ __forceinline__ int lds_byte(int r, int c) { const int st = (r >> 4) * 2 + (c >> 5), rr = r & 15, cc = c & 31, ob = rr * 64 + cc * 2; return st * 1024 + (ob ^ (((ob >> 9) & 1) << 5)); }
__host__ __device__ __forceinline__ void stage_rc(int b, int& R, int& C) { const int st = b / 1024, sb = b % 1024, swz = sb ^ (((sb >> 9) & 1) << 5); R = (st >> 1) * 16 + swz / 64; C = (st & 1) * 32 + (swz % 64) / 2; }
__host__ __device__ __forceinline__ int perm32(int rho) { const int n = rho >> 4, i = rho & 15; return 8 * (i >> 2) + 4 * n + (i & 3); }

struct Unit { int pm, pn; };
struct Gemm { const bf16_t* A; const bf16_t* Bt; int M, N, K, lda; };

struct StaticOrder {
    int nM, nN, nwg, G, c;
    __host__ __device__ void init(int M, int N, int G_, int c_) { nM = M / BM; nN = N / BM; nwg = nM * nN; G = G_; c = c_; }
    __host__ __device__ bool next(int i, Unit& u) const {
        const long L = (long)i * G + c; if (L >= nwg) return false;
        int wgid = (int)L; { const int q = nwg / NXCD, r = nwg % NXCD, xcd = wgid % NXCD, off = wgid / NXCD; wgid = (xcd < r ? xcd * (q + 1) : r * (q + 1) + (xcd - r) * q) + off; }
        const int nig = WGM * nN, gid = wgid / nig, fm = gid * WGM, gsz = (nM - fm) < WGM ? (nM - fm) : WGM;
        u.pm = fm + ((wgid % nig) % gsz); u.pn = (wgid % nig) / gsz; return true;
    }
    __device__ __forceinline__ void a_ready(const Unit&) const {}
    __device__ __forceinline__ void done(const Unit&) const {}
};
__device__ __forceinline__ unsigned cvt_pk_bf16(float lo, float hi) { unsigned r; asm volatile("v_cvt_pk_bf16_f32 %0, %1, %2" : "=v"(r) : "v"(lo), "v"(hi)); return r; }
typedef float f32x2 __attribute__((ext_vector_type(2)));
typedef int i32x4 __attribute__((ext_vector_type(4)));
template <bool I8> struct AccT { typedef f32x4 type; };
template <> struct AccT<true> { typedef i32x4 type; };
__device__ __forceinline__ f32x4 mma16(const bf16x8 b, const bf16x8 a, const f32x4 c) { return __builtin_amdgcn_mfma_f32_16x16x32_bf16(b, a, c, 0, 0, 0); }
__device__ __forceinline__ i32x4 mma16(const bf16x8 b, const bf16x8 a, const i32x4 c) { return __builtin_amdgcn_mfma_i32_16x16x64_i8(__builtin_bit_cast(i32x4, b), __builtin_bit_cast(i32x4, a), c, 0, 0, 0); }
template <class Epi, class Sched, bool ALIGN_EPI = false, bool SP2 = false, bool I8 = false>
__device__ __forceinline__ void gemm_phase(PG8_LAS unsigned char* lds, const Gemm g, const Sched& S, const Epi& E) {
    int tid_ = threadIdx.x; if constexpr (Epi::RESETUP) asm volatile("" : "+v"(tid_));
    const int tid = tid_, wid = __builtin_amdgcn_readfirstlane(tid >> 6), lane = tid & 63, wr = wid >> 2, wc = wid & 3, fr = lane & 15, fq = lane >> 4;
    const int K = g.K, nt = K / BK;
    unsigned voffA[2], voffB[2]; int aoff, boff;
#define PG8_LANE_SETUP do { int t_ = tid; asm volatile("" : "+v"(t_)); const int l_ = t_ & 63, fr_ = l_ & 15, fq_ = l_ >> 4; \
        _Pragma("unroll") for (int i = 0; i < 2; ++i) { int R, C; stage_rc(t_ * 16 + i * 8192, R, C); const int Rb = Epi::PERM ? ((R & ~31) + perm32(R & 31)) : R; \
            voffA[i] = (unsigned)(R * g.lda + C) * 2u; voffB[i] = (unsigned)(Rb * K + C) * 2u; } \
        aoff = lds_byte(wr * 64 + fr_, fq_ * 8); boff = lds_byte(wc * 32 + fr_, fq_ * 8); } while (0)
    PG8_LANE_SETUP;
    const size_t kstep = (size_t)(BK * 2);
    const size_t hstepA = (size_t)HALF * g.lda * 2, hstepB = (size_t)HALF * K * 2;
    const size_t tstepA = 2 * hstepA, tstepB = 2 * hstepB;
    const unsigned ldsw = (unsigned)wid * 1024u;
#define PG8_SA(b, h) (((b) * 2 + (h)) * HTB)
#define PG8_SB(b, h) ((4 + (b) * 2 + (h)) * HTB)
#define PG8_STAGE(bufoff, gbase, voff) do { _Pragma("unroll") for (int _i = 0; _i < 2; ++_i) \
        __builtin_amdgcn_global_load_lds((const unsigned*)((const char*)(gbase) + (voff)[_i]), (PG8_LAS unsigned*)(lds + (bufoff) + ldsw + _i * 8192), 16, 0, 0); } while (0)
#define PG8_LDA(dst, b, h) do { _Pragma("unroll") for (int m = 0; m < 4; ++m) _Pragma("unroll") for (int k = 0; k < 2; ++k) dst[m][k] = *(const PG8_LAS bf16x8*)(lds + PG8_SA(b, h) + aoff + m * 2048 + k * 1024); } while (0)
#define PG8_LDB(dst, b, h) do { _Pragma("unroll") for (int n = 0; n < 2; ++n) _Pragma("unroll") for (int k = 0; k < 2; ++k) dst[n][k] = *(const PG8_LAS bf16x8*)(lds + PG8_SB(b, h) + boff + n * 2048 + k * 1024); } while (0)
#define PG8_MMA(ai, bj, At, Bt) do { __builtin_amdgcn_s_setprio(1); _Pragma("unroll") for (int m = 0; m < 4; ++m) _Pragma("unroll") for (int n = 0; n < 2; ++n) _Pragma("unroll") for (int k = 0; k < 2; ++k) \
        acc[ai][bj][m][n] = mma16(Bt[n][k], At[m][k], acc[ai][bj][m][n]); __builtin_amdgcn_s_setprio(0); } while (0)
#define PG8_WAIT_V(n) asm volatile("s_waitcnt vmcnt(" #n ")" ::: "memory")
#define PG8_WAIT_L(n) asm volatile("s_waitcnt lgkmcnt(" #n ")" ::: "memory")
#define PG8_BAR __builtin_amdgcn_s_barrier()
#define PG8_SCHED __builtin_amdgcn_sched_barrier(0)
    Unit cur, nxt; int ui = 0;
    if (!S.next(0, cur)) return;
    typedef typename AccT<I8>::type accv; accv acc[2][2][4][2];
#pragma unroll
    for (int a = 0; a < 2; ++a)
#pragma unroll
        for (int b = 0; b < 2; ++b)
#pragma unroll
            for (int m = 0; m < 4; ++m)
#pragma unroll
                for (int n = 0; n < 2; ++n) acc[a][b][m][n] = accv{};
    bf16x8 At[4][2], B0[2][2], B1[2][2];
    const char* cA = (const char*)g.A + (size_t)cur.pm * tstepA; const char* cB = (const char*)g.Bt + (size_t)cur.pn * tstepB;
    S.a_ready(cur);
    if constexpr (SP2) {
        PG8_STAGE(PG8_SB(0, 0), cB, voffB); PG8_STAGE(PG8_SB(0, 1), cB + hstepB, voffB); PG8_STAGE(PG8_SA(0, 0), cA, voffA); PG8_STAGE(PG8_SA(0, 1), cA + hstepA, voffA);
        if (wr == 1) PG8_BAR;
        PG8_WAIT_V(2); PG8_BAR;
        PG8_STAGE(PG8_SB(1, 0), cB + kstep, voffB); PG8_STAGE(PG8_SA(1, 0), cA + kstep, voffA); PG8_STAGE(PG8_SB(1, 1), cB + hstepB + kstep, voffB);
        PG8_WAIT_V(6); PG8_BAR;
    } else {
        PG8_STAGE(PG8_SB(0, 0), cB, voffB); PG8_STAGE(PG8_SA(0, 0), cA, voffA); PG8_STAGE(PG8_SB(0, 1), cB + hstepB, voffB); PG8_STAGE(PG8_SA(0, 1), cA + hstepA, voffA);
        if (wr == 1) PG8_BAR;
        PG8_WAIT_V(4); PG8_BAR;
        PG8_STAGE(PG8_SB(1, 0), cB + kstep, voffB); PG8_STAGE(PG8_SA(1, 0), cA + kstep, voffA); PG8_STAGE(PG8_SB(1, 1), cB + hstepB + kstep, voffB);
        PG8_WAIT_V(6); PG8_BAR;
    }
    for (;;) {
        const bool has_next = S.next(ui + 1, nxt);
        const char* nA = has_next ? (const char*)g.A + (size_t)nxt.pm * tstepA : cA; const char* nB = has_next ? (const char*)g.Bt + (size_t)nxt.pn * tstepB : cB;
        for (int t = 0; t < nt; t += 2) {
            const bool last = (t == nt - 2);
            const char* a1 = cA + (size_t)(t + 1) * kstep;
            const char* a2 = last ? nA : cA + (size_t)(t + 2) * kstep; const char* b2 = last ? nB : cB + (size_t)(t + 2) * kstep;
            const char* a3 = a2 + kstep; const char* b3 = b2 + kstep;
            if (last && has_next) S.a_ready(nxt);
            if constexpr (SP2) {
            PG8_LDB(B0, 0, 0); PG8_LDB(B1, 0, 1); PG8_SCHED; PG8_LDA(At, 0, 0); PG8_STAGE(PG8_SA(1, 1), a1 + hstepA, voffA);
            PG8_WAIT_V(8); PG8_WAIT_L(0); PG8_BAR; PG8_MMA(0, 0, At, B0); PG8_MMA(0, 1, At, B1); PG8_BAR; PG8_SCHED;
            PG8_LDA(At, 0, 1); PG8_STAGE(PG8_SB(0, 0), b2, voffB); PG8_STAGE(PG8_SB(0, 1), b2 + hstepB, voffB); PG8_STAGE(PG8_SA(0, 0), a2, voffA);
            PG8_WAIT_V(8); PG8_WAIT_L(0); PG8_BAR; PG8_MMA(1, 0, At, B0); PG8_MMA(1, 1, At, B1); PG8_BAR; PG8_SCHED;
            PG8_LDB(B0, 1, 0); PG8_LDB(B1, 1, 1); PG8_SCHED; PG8_LDA(At, 1, 0); PG8_STAGE(PG8_SA(0, 1), a2 + hstepA, voffA);
            PG8_WAIT_V(8); PG8_WAIT_L(0); PG8_BAR; PG8_MMA(0, 0, At, B0); PG8_MMA(0, 1, At, B1); PG8_BAR; PG8_SCHED;
            PG8_LDA(At, 1, 1); PG8_STAGE(PG8_SB(1, 0), b3, voffB); PG8_STAGE(PG8_SB(1, 1), b3 + hstepB, voffB); PG8_STAGE(PG8_SA(1, 0), a3, voffA);
            PG8_WAIT_V(8); PG8_WAIT_L(0); PG8_BAR; PG8_MMA(1, 0, At, B0); PG8_MMA(1, 1, At, B1); PG8_BAR; PG8_SCHED;
            } else {
            PG8_LDB(B0, 0, 0); PG8_SCHED; PG8_LDA(At, 0, 0); PG8_STAGE(PG8_SA(1, 1), a1 + hstepA, voffA);
            PG8_WAIT_L(8); PG8_BAR; PG8_WAIT_L(0); PG8_MMA(0, 0, At, B0); PG8_BAR; PG8_SCHED;
            PG8_LDB(B1, 0, 1); PG8_STAGE(PG8_SB(0, 0), b2, voffB);
            PG8_BAR; PG8_WAIT_L(0); PG8_MMA(0, 1, At, B1); PG8_BAR;
            PG8_LDA(At, 0, 1); PG8_STAGE(PG8_SA(0, 0), a2, voffA);
            PG8_BAR; PG8_WAIT_L(0); PG8_MMA(1, 0, At, B0); PG8_BAR; PG8_SCHED;
            PG8_STAGE(PG8_SB(0, 1), b2 + hstepB, voffB);
            PG8_WAIT_V(6); PG8_BAR; PG8_MMA(1, 1, At, B1); PG8_BAR;
            PG8_LDB(B0, 1, 0); PG8_SCHED; PG8_LDA(At, 1, 0); PG8_STAGE(PG8_SA(0, 1), a2 + hstepA, voffA);
            PG8_WAIT_L(8); PG8_BAR; PG8_WAIT_L(0); PG8_MMA(0, 0, At, B0); PG8_BAR; PG8_SCHED;
            PG8_LDB(B1, 1, 1); PG8_STAGE(PG8_SB(1, 0), b3, voffB);
            PG8_BAR; PG8_WAIT_L(0); PG8_MMA(0, 1, At, B1); PG8_BAR;
            PG8_LDA(At, 1, 1); PG8_STAGE(PG8_SA(1, 0), a3, voffA);
            PG8_BAR; PG8_WAIT_L(0); PG8_MMA(1, 0, At, B0); PG8_BAR; PG8_SCHED;
            PG8_STAGE(PG8_SB(1, 1), b3 + hstepB, voffB);
            PG8_WAIT_V(6); PG8_BAR; PG8_MMA(1, 1, At, B1); PG8_BAR;
            }
        }
        if constexpr (ALIGN_EPI) { if (wr == 0) PG8_BAR; }
        if constexpr (!Epi::AFTER_DRAIN) {
            if constexpr (Epi::RESETUP) { int t_ = tid; asm volatile("" : "+v"(t_)); E(acc, cur, wr, wc, t_ & 15, (t_ & 63) >> 4); }
            else E(acc, cur, wr, wc, fr, fq);
            S.done(cur); }
        if (!has_next) break;
#pragma unroll
        for (int a = 0; a < 2; ++a)
#pragma unroll
            for (int b = 0; b < 2; ++b)
#pragma unroll
                for (int m = 0; m < 4; ++m)
#pragma unroll
                    for (int n = 0; n < 2; ++n) acc[a][b][m][n] = accv{};
        cur = nxt; cA = nA; cB = nB; ++ui;
        if constexpr (Epi::RESETUP) PG8_LANE_SETUP;
        if constexpr (ALIGN_EPI) { if (wr == 1) PG8_BAR; }
    }
    PG8_WAIT_V(0);
    if constexpr (!ALIGN_EPI) { if (wr == 0) PG8_BAR; }
    PG8_BAR;
    if constexpr (Epi::AFTER_DRAIN) { E.fused(acc, cur, wr, wc, fr, fq, lds, wid, lane); S.done(cur); }
#undef PG8_LANE_SETUP
#undef PG8_SA
#undef PG8_SB
#undef PG8_STAGE
#undef PG8_LDA
#undef PG8_LDB
#undef PG8_MMA
#undef PG8_WAIT_V
#undef PG8_WAIT_L
#undef PG8_BAR
#undef PG8_SCHED
}
}


#define GAS __attribute__((address_space(1)))
#define LAS __attribute__((address_space(3)))
typedef float f32x4 __attribute__((ext_vector_type(4)));
typedef unsigned u32x4 __attribute__((ext_vector_type(4)));
#define XB_TMO      128
#define XB_XCNT(j)  (256  + 64 * (j))
#define XB_XSUB(j)  (1280 + 64 * (j))
#define XB_XGEN(j)  (2304 + 64 * (j))
#define XB_TOP      3328
#define XB_TOPGEN   3392
#define XCD_BAR_WORDS 3456
#define XB_SPIN_CAP (1u << 18)

__device__ __forceinline__ unsigned xb_ld(unsigned* p)              { return __hip_atomic_load(p, __ATOMIC_RELAXED, __HIP_MEMORY_SCOPE_AGENT); }
__device__ __forceinline__ unsigned xb_add(unsigned* p, unsigned v) { return __hip_atomic_fetch_add(p, v, __ATOMIC_RELAXED, __HIP_MEMORY_SCOPE_AGENT); }
__device__ __forceinline__ unsigned xb_xcc_id() { return (unsigned)__builtin_amdgcn_s_getreg((3 << 11) | 20) & 0xFu; }
#define XB_SPIN(cond, bar) do { unsigned _sp = 0; while (cond) { __builtin_amdgcn_s_sleep(1); \
    if ((++_sp & 255u) == 0u) { if (xb_ld(&(bar)[XB_TMO])) break; if (_sp > XB_SPIN_CAP) { atomicAdd(&(bar)[XB_TMO], 1u); break; } } } } while (0)

struct XcdBarrier {
    unsigned* bar; unsigned x;
    volatile LAS unsigned* st;
};

__device__ __forceinline__ XcdBarrier xcd_barrier_post(unsigned* bar, volatile LAS unsigned* st) {
    XcdBarrier b; b.bar = bar; b.x = xb_xcc_id(); b.st = st;
    if (threadIdx.x == 0) (void)xb_add(&bar[XB_XCNT(b.x)], 1u);
    return b;
}
__device__ __forceinline__ void xcd_barrier_complete(unsigned* bar, unsigned x, unsigned& nloc, unsigned& nx) {
    const unsigned G = gridDim.x * gridDim.y * gridDim.z;
    unsigned sum, cnt, mine, sp = 0u;
    for (;;) {
        sum = 0u; cnt = 0u; mine = 0u;
#pragma unroll
        for (unsigned j = 0; j < 16; ++j) { const unsigned c = xb_ld(&bar[XB_XCNT(j)]); sum += c; cnt += (c > 0u) ? 1u : 0u; mine = (j == x) ? c : mine; }
        if (sum == G) break;
        __builtin_amdgcn_s_sleep(1);
        if ((++sp & 255u) == 0u) { if (xb_ld(&bar[XB_TMO])) break; if (sp > XB_SPIN_CAP) { atomicAdd(&bar[XB_TMO], 1u); break; } }
    }
    nloc = mine > 0u ? mine : 1u; nx = cnt > 0u ? cnt : 1u;
}

__device__ __forceinline__ void xcd_barrier(const XcdBarrier& b) {
    asm volatile("s_waitcnt vmcnt(0)" ::: "memory");
    __syncthreads();
    if (threadIdx.x == 0) {
        unsigned* bar = b.bar;
        __builtin_amdgcn_s_waitcnt(0);
        unsigned nloc = b.st[0], nx = b.st[1];
        if (nloc == 0u) { xcd_barrier_complete(bar, b.x, nloc, nx); b.st[0] = nloc; b.st[1] = nx; }
        const unsigned old = xb_add(&bar[XB_XSUB(b.x)], 1u);
        const unsigned gen = old / nloc;
        if (old + 1u == (gen + 1u) * nloc) {
            __builtin_amdgcn_fence(__ATOMIC_RELEASE, "agent");
            asm volatile("s_waitcnt vmcnt(0)" ::: "memory");
            const unsigned og = xb_add(&bar[XB_TOP], 1u);
            const unsigned tg = og / nx;
            if (og + 1u == (tg + 1u) * nx) xb_add(&bar[XB_TOPGEN], 1u);
            else XB_SPIN(xb_ld(&bar[XB_TOPGEN]) == tg, bar);
            __builtin_amdgcn_fence(__ATOMIC_ACQUIRE, "agent");
            xb_add(&bar[XB_XGEN(b.x)], 1u);
            asm volatile("s_waitcnt vmcnt(0)" ::: "memory");
        } else {
            XB_SPIN(xb_ld(&bar[XB_XGEN(b.x)]) == gen, bar);
            __builtin_amdgcn_fence(__ATOMIC_ACQUIRE, "agent");
            asm volatile("s_waitcnt vmcnt(0)" ::: "memory");
        }
    }
    __syncthreads();
}


constexpr int NWAVES = 8;
constexpr int RING_BYTES = 131072, LDSCTL_OFF = RING_BYTES, MISC_OFF = LDSCTL_OFF + 320, LDS_BYTES = 147456;
constexpr size_t WS_CTL = 0, CTL_ZERO_BYTES = 1 * MiB;
constexpr int CW_BAR = 4096, N_BAR_REGIONS = 16;
static_assert((CW_BAR + N_BAR_REGIONS * XCD_BAR_WORDS) * 4 <= (int)CTL_ZERO_BYTES, "barrier words inside the memset region");
constexpr size_t WS_WIN = 10 * MiB;
constexpr size_t WS_WUQ = 15 * MiB;
constexpr size_t WS_WUKV = 16 * MiB;
constexpr size_t WS_WO = 17 * MiB;
constexpr size_t WS_WPQ = 19 * MiB;
constexpr size_t WS_SK = 23 * MiB;
constexpr size_t WS_U16 = 24 * MiB;
constexpr size_t WS_V16 = 56 * MiB;


namespace att {
typedef short bf16x8 __attribute__((ext_vector_type(8)));
typedef short s16x4 __attribute__((ext_vector_type(4)));
typedef float f32x16 __attribute__((ext_vector_type(16)));
constexpr int LK = 0, KSLOT = 12288, LV = 2 * KSLOT, VSLOT = 8192, LB = LV + 2 * VSLOT, BSLOT = 256, LWS = LB + 2 * BSLOT, LOST = LWS + 8 * 256, ATT_LDS = LOST + 8 * 4096;
static_assert(ATT_LDS <= 131072, "attention scratch fits the ring region");
struct Desc { const bf16_t* Q; int pq; const bf16_t* K; int pk; const bf16_t* V; int pv; bf16_t* O; int po; const float* FC; const float* QS; const float2* RP; };

__device__ __forceinline__ int crow(int r, int hi) { return (r & 3) + 8 * (r >> 2) + 4 * hi; }
__device__ __forceinline__ float xmax32(float v) { auto rr = __builtin_amdgcn_permlane32_swap(__float_as_uint(v), __float_as_uint(v), false, false); return fmaxf(__uint_as_float(rr[0]), __uint_as_float(rr[1])); }
__device__ __forceinline__ float xsum32(float v) { auto rr = __builtin_amdgcn_permlane32_swap(__float_as_uint(v), __float_as_uint(v), false, false); return __uint_as_float(rr[0]) + __uint_as_float(rr[1]); }
__device__ __forceinline__ unsigned cvtpk(float lo, float hi) { typedef float f2 __attribute__((ext_vector_type(2))); typedef __bf16 b2 __attribute__((ext_vector_type(2))); f2 v = {lo, hi}; b2 b = __builtin_convertvector(v, b2); return __builtin_bit_cast(unsigned, b); }
typedef short v4i16_t __attribute__((ext_vector_type(4)));
__device__ __forceinline__ s16x4 vtr(LAS const unsigned char* p) { return __builtin_bit_cast(s16x4, __builtin_amdgcn_ds_read_tr16_b64_v4i16((LAS v4i16_t*)p)); }

template <int KS, bool BIAS>
__device__ __forceinline__ void attn_unit(const Desc& d, int qb, int j0, LAS unsigned char* shm) {
    const int tid = threadIdx.x, lane = tid & 63, r32 = lane & 31, hi = lane >> 5; const int wid = __builtin_amdgcn_readfirstlane(tid >> 6);
    const int q0 = qb * 256, NT = (q0 + 256) / 64;
    LAS float* wsf = (LAS float*)(shm + LWS) + wid * 64;
    bf16x8 qr[KS];
    { const bf16_t* qp = d.Q + (size_t)(q0 + wid * 32 + r32) * d.pq + hi * 8;
#pragma unroll
      for (int d0 = 0; d0 < KS; ++d0) qr[d0] = *(const bf16x8*)(qp + d0 * 16); }
    if (!BIAS) {
        const int qrow = q0 + wid * 32 + r32;
        const float2 ss = *(const float2*)(d.QS + (size_t)qrow * 16);
        const f32x4* cp = (const f32x4*)(d.RP + (size_t)qrow * 16 + hi * 8);
        const f32x4 cs0 = cp[0], cs1 = cp[1], cs2 = cp[2], cs3 = cp[3];
        const float rr = rsqrtf((ss.x + ss.y) * (1.f / 96.f) + EPS) * C2A;
#pragma unroll
        for (int d0 = 0; d0 < 4; ++d0) { const u32x4 w = __builtin_bit_cast(u32x4, qr[d0]); u32x4 o;
#pragma unroll
            for (int i = 0; i < 4; ++i) o[i] = cvtpk(lo2f(w[i]) * rr, hi2f(w[i]) * rr);
            qr[d0] = __builtin_bit_cast(bf16x8, o); }
        { const u32x4 wa = __builtin_bit_cast(u32x4, qr[4]), wb = __builtin_bit_cast(u32x4, qr[5]); u32x4 oa, ob;
#pragma unroll
          for (int i = 0; i < 4; ++i) { const f32x4 c = i == 0 ? cs0 : i == 1 ? cs1 : i == 2 ? cs2 : cs3;
              const float a0 = lo2f(wa[i]) * rr, a1 = hi2f(wa[i]) * rr, b0 = lo2f(wb[i]) * rr, b1 = hi2f(wb[i]) * rr;
              oa[i] = cvtpk(a0 * c[0] - b0 * c[1], a1 * c[2] - b1 * c[3]); ob[i] = cvtpk(b0 * c[0] + a0 * c[1], b1 * c[2] + a1 * c[3]); }
          qr[4] = __builtin_bit_cast(bf16x8, oa); qr[5] = __builtin_bit_cast(bf16x8, ob); }
    }
    const float fcref = BIAS ? d.FC[q0] : 0.f;
    const bf16_t* ksrc0 = d.K + (size_t)lane * d.pk + wid * 8;
    const bf16_t* ksrc1 = d.K + (size_t)lane * d.pk + (8 + wid) * 8;
    const bf16_t* vsrc = d.V + (size_t)(16 * (wid & 3) + (lane >> 2)) * d.pv + (wid >> 2) * 32 + (lane & 3) * 8;
    const int kdst0 = LK + wid * 1024 + lane * 16, kdst1 = LK + (8 + wid) * 1024 + lane * 16, vdst = LV + wid * 1024 + lane * 16;
    const bool k2 = (KS > 4) && (wid < 2 * KS - 8);
    u32x4 kr0, kr1, vr; float br = 0.f;
#define ATT_LOAD(t, slot) do { \
        __builtin_amdgcn_global_load_lds((const unsigned*)(ksrc0 + (size_t)(t) * 64 * d.pk), (LAS unsigned*)(shm + LK + wid * 1024 + (slot) * KSLOT), 16, 0, 0); \
        if (k2) __builtin_amdgcn_global_load_lds((const unsigned*)(ksrc1 + (size_t)(t) * 64 * d.pk), (LAS unsigned*)(shm + LK + (8 + wid) * 1024 + (slot) * KSLOT), 16, 0, 0); \
        __builtin_amdgcn_global_load_lds((const unsigned*)(vsrc + (size_t)(t) * 64 * d.pv), (LAS unsigned*)(shm + LV + wid * 1024 + (slot) * VSLOT), 16, 0, 0); \
        if (BIAS && wid == 4) br = d.FC[(t) * 64 + lane]; } while (0)
#define ATT_WRITE(slot) do { if (BIAS && wid == 4) *(LAS float*)(shm + LB + (slot) * BSLOT + lane * 4) = (fcref - br) * LOG2E; } while (0)
    f32x16 o0, o1, negm;
#pragma unroll
    for (int r = 0; r < 16; ++r) { o0[r] = 0.f; o1[r] = 0.f; negm[r] = 0.f; }
    float mref = 0.f, l = 0.f;
    constexpr float THR = BIAS ? 40.f : 8.f;
    const int qrel = wid * 32 + r32;
    const int kfrag = LK + hi * 1024 + r32 * 16;
    const int vfrag = LV + ((lane >> 4) & 1) * 32 + (lane & 3) * 8 + (4 * hi + ((lane & 15) >> 2)) * 64;
    ATT_LOAD(j0, 0); ATT_WRITE(0);
    __syncthreads();
    for (int t = j0; t < NT; ++t) {
        const int slot = (t - j0) & 1;
        if (t + 1 < NT) ATT_LOAD(t + 1, slot ^ 1);
        const int jb = t - (NT - 4);
        if (!(jb >= 0 && 64 * jb > 32 * wid + 31)) {
            f32x16 p0, p1;
            if (BIAS) {
                LAS const unsigned char* bp = shm + LB + slot * BSLOT + 16 * hi;
#pragma unroll
                for (int g = 0; g < 4; ++g) { const f32x4 a = *(LAS const f32x4*)(bp + 32 * g), b = *(LAS const f32x4*)(bp + 128 + 32 * g);
#pragma unroll
                    for (int i = 0; i < 4; ++i) { p0[4 * g + i] = a[i] + negm[4 * g + i]; p1[4 * g + i] = b[i] + negm[4 * g + i]; } }
            } else { p0 = negm; p1 = negm; }
            LAS const unsigned char* kp = shm + kfrag + slot * KSLOT;
#pragma unroll
            for (int d0 = 0; d0 < KS; ++d0) {
                const bf16x8 a0 = *(LAS const bf16x8*)(kp + d0 * 2048), a1 = *(LAS const bf16x8*)(kp + d0 * 2048 + 512);
                p0 = __builtin_amdgcn_mfma_f32_32x32x16_bf16(a0, qr[d0], p0, 0, 0, 0);
                p1 = __builtin_amdgcn_mfma_f32_32x32x16_bf16(a1, qr[d0], p1, 0, 0, 0);
            }
            if (jb >= 0) {
                const int kb = 64 * jb + 4 * hi;
#pragma unroll
                for (int r = 0; r < 16; ++r) { const int kv = kb + (r & 3) + 8 * (r >> 2); if (kv > qrel) p0[r] = -INFINITY; if (kv + 32 > qrel) p1[r] = -INFINITY; }
            }
            float ra = __builtin_fmaxf(__builtin_fmaxf(p0[0], p0[1]), p1[0]), rb = __builtin_fmaxf(__builtin_fmaxf(p0[2], p0[3]), p1[1]);
            ra = __builtin_fmaxf(__builtin_fmaxf(ra, p1[2]), p1[3]);
#pragma unroll
            for (int r = 4; r < 16; r += 4) { ra = __builtin_fmaxf(__builtin_fmaxf(ra, p0[r]), p0[r + 1]); rb = __builtin_fmaxf(__builtin_fmaxf(rb, p0[r + 2]), p0[r + 3]);
                ra = __builtin_fmaxf(__builtin_fmaxf(ra, p1[r]), p1[r + 1]); rb = __builtin_fmaxf(__builtin_fmaxf(rb, p1[r + 2]), p1[r + 3]); }
            const float rm = xmax32(__builtin_fmaxf(ra, rb));
            if (__any(rm > THR) || t == j0) {
                const float dl = t == j0 ? rm : __builtin_fmaxf(rm, 0.f);
                mref += dl;
#pragma unroll
                for (int r = 0; r < 16; ++r) { p0[r] -= dl; p1[r] -= dl; negm[r] = -mref; }
                if (t != j0) {
                    const float alpha = __builtin_amdgcn_exp2f(-dl);
                    l *= alpha;
                    if (hi == 0) wsf[r32] = alpha;
#pragma unroll
                    for (int g = 0; g < 4; ++g) { const f32x4 a = *(LAS const f32x4*)(wsf + 8 * g + 4 * hi);
#pragma unroll
                        for (int i = 0; i < 4; ++i) { o0[4 * g + i] *= a[i]; o1[4 * g + i] *= a[i]; } }
                }
            }
            float s0 = 0.f, s1 = 0.f, s2 = 0.f, s3 = 0.f;
#pragma unroll
            for (int r = 0; r < 16; r += 2) { p0[r] = __builtin_amdgcn_exp2f(p0[r]); p0[r + 1] = __builtin_amdgcn_exp2f(p0[r + 1]); p1[r] = __builtin_amdgcn_exp2f(p1[r]); p1[r + 1] = __builtin_amdgcn_exp2f(p1[r + 1]);
                s0 += p0[r]; s1 += p0[r + 1]; s2 += p1[r]; s3 += p1[r + 1]; }
            l += (s0 + s1) + (s2 + s3);
            LAS const unsigned char* vp = shm + vfrag + slot * VSLOT;
#pragma unroll
            for (int ks = 0; ks < 4; ++ks) {
                const f32x16& pp = ks < 2 ? p0 : p1; const int bq = (ks & 1) * 8;
                u32x4 pw; pw.x = cvtpk(pp[bq], pp[bq + 1]); pw.y = cvtpk(pp[bq + 2], pp[bq + 3]); pw.z = cvtpk(pp[bq + 4], pp[bq + 5]); pw.w = cvtpk(pp[bq + 6], pp[bq + 7]);
                const bf16x8 pa = __builtin_bit_cast(bf16x8, pw);
                const s16x4 l0 = vtr(vp + ks * 1024), h0 = vtr(vp + ks * 1024 + 512), l1 = vtr(vp + 4096 + ks * 1024), h1 = vtr(vp + 4096 + ks * 1024 + 512);
                const bf16x8 v0 = {l0[0], l0[1], l0[2], l0[3], h0[0], h0[1], h0[2], h0[3]}, v1 = {l1[0], l1[1], l1[2], l1[3], h1[0], h1[1], h1[2], h1[3]};
                o0 = __builtin_amdgcn_mfma_f32_32x32x16_bf16(pa, v0, o0, 0, 0, 0);
                o1 = __builtin_amdgcn_mfma_f32_32x32x16_bf16(pa, v1, o1, 0, 0, 0);
            }
        }
        if (t + 1 < NT) ATT_WRITE(slot ^ 1);
        __syncthreads();
    }
#undef ATT_LOAD
#undef ATT_WRITE
    l = xsum32(l);
    if (hi == 0) wsf[32 + r32] = l;
    float rli[16];
#pragma unroll
    for (int g = 0; g < 4; ++g) { const f32x4 a = *(LAS const f32x4*)(wsf + 32 + 8 * g + 4 * hi);
#pragma unroll
        for (int i = 0; i < 4; ++i) rli[4 * g + i] = 1.f / a[i]; }
    LAS bf16_t* stg = (LAS bf16_t*)(shm + LOST) + wid * 2048;
#pragma unroll
    for (int r = 0; r < 16; ++r) { const int orow = crow(r, hi); stg[orow * 64 + r32] = f2bf(o0[r] * rli[r]); stg[orow * 64 + 32 + r32] = f2bf(o1[r] * rli[r]); }
    bf16_t* Ow = d.O + (size_t)(q0 + wid * 32) * d.po;
#pragma unroll
    for (int i = 0; i < 4; ++i) { const int row = i * 8 + (lane >> 3), ch = lane & 7; const u32x4 v = *(LAS const u32x4*)(stg + row * 64 + ch * 8); *(u32x4*)(Ow + (size_t)row * d.po + ch * 8) = v; }
    __syncthreads();
}
}


namespace pk {
typedef short bf16x8 __attribute__((ext_vector_type(8)));
typedef float f32x16 __attribute__((ext_vector_type(16)));
template <int I> struct COff { static constexpr int v = COff<I - 1>::v + 16 / I; };
template <> struct COff<0> { static constexpr int v = 0; };
static_assert(COff<16>::v == 50, "50 candidates can reach the top 16 of a sorted 16 x 16 sum grid");
__device__ __forceinline__ void cef(float& a, float& b) { const float mx = fmaxf(a, b), mn = fminf(a, b); a = mx; b = mn; }
__device__ __forceinline__ void sort16f(float (&v)[16]) {
#pragma unroll
    for (int k = 2; k <= 16; k <<= 1)
#pragma unroll
        for (int j = k >> 1; j >= 1; j >>= 1)
#pragma unroll
            for (int i = 0; i < 16; ++i) { const int l = i ^ j; if (l > i) { if ((i & k) == 0) cef(v[i], v[l]); else cef(v[l], v[i]); } }
}
__device__ __forceinline__ void merge16f(float (&a)[16], const float (&b)[16]) {
#pragma unroll
    for (int i = 0; i < 16; ++i) a[i] = fmaxf(a[i], b[15 - i]);
#pragma unroll
    for (int j = 8; j >= 1; j >>= 1)
#pragma unroll
        for (int i = 0; i < 16; ++i) { const int l = i ^ j; if (l > i) cef(a[i], a[l]); }
}
__device__ __forceinline__ float keyf(float v, unsigned code, unsigned mask) { return __uint_as_float((__float_as_uint(v) & mask) | code); }
template <int I> __device__ __forceinline__ void fill_candf(float (&c)[64], const float (&s1)[16], const float (&s2)[16]) {
    if constexpr (I < 16) {
#pragma unroll
        for (int j = 0; j < 16 / (I + 1); ++j) c[COff<I>::v + j] = keyf(s1[I] + s2[j], (unsigned)(255 - (I * 16 + j)), 0xFFFFFF00u);
        fill_candf<I + 1>(c, s1, s2);
    }
}
__device__ __forceinline__ void head_half(const bf16_t* QP, const bf16_t* SK, int t, int h, int p, int r32, int hi, const unsigned (&lowc)[16], float (&own)[16]) {
    const bf16_t* qrow = QP + (size_t)t * 2048 + h * 256 + p * 128 + hi * 8;
    bf16x8 qf[8];
#pragma unroll
    for (int d0 = 0; d0 < 8; ++d0) qf[d0] = *(const bf16x8*)(qrow + d0 * 16);
    const bf16_t* skb = SK + (size_t)((h * 2 + p) * 128 + r32) * 128 + hi * 8;
#pragma unroll 1
    for (int kt = 0; kt < 4; ++kt) {
        f32x16 acc;
#pragma unroll
        for (int r = 0; r < 16; ++r) acc[r] = 0.f;
#pragma unroll
        for (int d0 = 0; d0 < 8; ++d0) { const bf16x8 a = *(const bf16x8*)(skb + (size_t)kt * 32 * 128 + d0 * 16); acc = __builtin_amdgcn_mfma_f32_32x32x16_bf16(a, qf[d0], acc, 0, 0, 0); }
        float cur[16];
#pragma unroll
        for (int r = 0; r < 16; ++r) cur[r] = keyf(acc[r], lowc[r] - 32u * (unsigned)kt, 0xFFFFFF80u);
        sort16f(cur);
        if (kt == 0) {
#pragma unroll
            for (int r = 0; r < 16; ++r) own[r] = cur[r];
        } else merge16f(own, cur);
    }
}
__device__ __forceinline__ void topk_item2(const bf16_t* QP, const bf16_t* SK, int* EID, float* GATE, int item, int lane) {
    const int tg = item >> 2, hp = item & 3, r32 = lane & 31, hi = lane >> 5;
    const int t = tg * 32 + r32;
    unsigned lowc[16];
#pragma unroll
    for (int r = 0; r < 16; ++r) lowc[r] = (unsigned)(127 - ((r & 3) + 8 * (r >> 2)) - 4 * hi);
    float finA[16], finB[16];
#pragma unroll
    for (int hh = 0; hh < 2; ++hh) {
        const int h = 2 * hp + hh;
        float own0[16], own1[16];
        head_half(QP, SK, t, h, 0, r32, hi, lowc, own0);
        head_half(QP, SK, t, h, 1, r32, hi, lowc, own1);
        float fin[16], oth[16];
#pragma unroll
        for (int i = 0; i < 16; ++i) { auto rr = __builtin_amdgcn_permlane32_swap(__float_as_uint(own0[i]), __float_as_uint(own1[i]), false, false); fin[i] = __uint_as_float(rr[0]); oth[i] = __uint_as_float(rr[1]); }
        merge16f(fin, oth);
#pragma unroll
        for (int i = 0; i < 16; ++i) { if (hh == 0) finA[i] = fin[i]; else finB[i] = fin[i]; }
    }
    float s1[16], s2[16];
#pragma unroll
    for (int i = 0; i < 16; ++i) { auto rr = __builtin_amdgcn_permlane32_swap(__float_as_uint(finA[i]), __float_as_uint(finB[i]), false, false); s1[i] = __uint_as_float(rr[0]); s2[i] = __uint_as_float(rr[1]); }
    const int h = 2 * hp + hi;
    unsigned long long i1lo = 0ull, i1hi = 0ull, i2lo = 0ull, i2hi = 0ull;
#pragma unroll
    for (int i = 0; i < 16; ++i) {
        const unsigned long long a = (unsigned long long)(127u - (__float_as_uint(s1[i]) & 0x7Fu)) << (8 * (i & 7)), b = (unsigned long long)(127u - (__float_as_uint(s2[i]) & 0x7Fu)) << (8 * (i & 7));
        if (i < 8) { i1lo |= a; i2lo |= b; } else { i1hi |= a; i2hi |= b; } }
    float c64[64];
#pragma unroll
    for (int i = 50; i < 64; ++i) c64[i] = -INFINITY;
    fill_candf<0>(c64, s1, s2);
    float top[16];
    {
        float g1[16], g2[16], g3[16];
#pragma unroll
        for (int i = 0; i < 16; ++i) { top[i] = c64[i]; g1[i] = c64[16 + i]; g2[i] = c64[32 + i]; g3[i] = c64[48 + i]; }
        sort16f(g1); sort16f(g2); sort16f(g3);
        merge16f(top, g1); merge16f(g2, g3); merge16f(top, g2);
    }
    float ev[16]; float sum = 0.f; const float mx = top[0];
#pragma unroll
    for (int r = 0; r < 16; ++r) { ev[r] = __expf(top[r] - mx); sum += ev[r]; }
    const float rs = 1.f / sum;
    int* ep = EID + (size_t)t * 128 + h * 16; float* gp = GATE + (size_t)t * 128 + h * 16;
#pragma unroll
    for (int q4 = 0; q4 < 4; ++q4) { int ee[4];
#pragma unroll
        for (int z = 0; z < 4; ++z) { const int code = 255 - (int)(__float_as_uint(top[q4 * 4 + z]) & 0xFFu), i = code >> 4, j = code & 15;
            const unsigned e1 = (unsigned)(((i & 8) ? i1hi : i1lo) >> (8 * (i & 7))) & 0xFFu, e2 = (unsigned)(((j & 8) ? i2hi : i2lo) >> (8 * (j & 7))) & 0xFFu; ee[z] = (int)(e1 * 128u + e2); }
        *(int4*)(ep + q4 * 4) = make_int4(ee[0], ee[1], ee[2], ee[3]);
        *(float4*)(gp + q4 * 4) = make_float4(ev[q4 * 4] * rs, ev[q4 * 4 + 1] * rs, ev[q4 * 4 + 2] * rs, ev[q4 * 4 + 3] * rs); }
}
}


namespace gx {
typedef unsigned char u8x4 __attribute__((ext_vector_type(4)));
__device__ __forceinline__ int sdot16(const int4 a, const int4 b) {
    int s = __builtin_amdgcn_sdot4(a.x, b.x, 0, false); s = __builtin_amdgcn_sdot4(a.y, b.y, s, false); s = __builtin_amdgcn_sdot4(a.z, b.z, s, false); return __builtin_amdgcn_sdot4(a.w, b.w, s, false);
}
__device__ __forceinline__ float gelu_t(float x) { const float u = 0.7978845608028654f * (x + 0.044715f * x * x * x); return 0.5f * x * (1.f + tanhf(u)); }

__device__ __forceinline__ int hx(int lo, int hi, bool up, int bit) { const int send = up ? lo : hi, keep = up ? hi : lo; return keep + __shfl_xor(send, bit); }

__device__ __forceinline__ void u_token(const unsigned char* UQs  , const int4 (&ev)[4], const int4 hq, int* PArow, int lane) {
    const int e[16] = {ev[0].x, ev[0].y, ev[0].z, ev[0].w, ev[1].x, ev[1].y, ev[1].z, ev[1].w, ev[2].x, ev[2].y, ev[2].z, ev[2].w, ev[3].x, ev[3].y, ev[3].z, ev[3].w};
    int4 rows[16];
#pragma unroll
    for (int i = 0; i < 16; ++i) rows[i] = *(const int4*)(UQs + (size_t)e[i] * 128);
    int p[16];
#pragma unroll
    for (int i = 0; i < 16; ++i) p[i] = sdot16(rows[i], hq);
    const bool b2 = (lane & 4) != 0, b1 = (lane & 2) != 0, b0 = (lane & 1) != 0;
    int q[8], r[4];
#pragma unroll
    for (int k = 0; k < 8; ++k) q[k] = hx(p[k], p[8 + k], b2, 4);
#pragma unroll
    for (int k = 0; k < 4; ++k) r[k] = hx(q[k], q[4 + k], b1, 2);
    const int z0 = hx(r[0], r[2], b0, 1), z1 = hx(r[1], r[3], b0, 1);
    *(int2*)(PArow + 2 * lane) = make_int2(z0, z1);
}

__device__ __forceinline__ void v_token(const unsigned char* VQs  , const int4 (&ev)[4], const int4 wh, const int4 wlo, float wscale, const float* gate2, const float* x1row, const bf16_t* dlrow, float* outrow, int s, int lane) {
    const int e[16] = {ev[0].x, ev[0].y, ev[0].z, ev[0].w, ev[1].x, ev[1].y, ev[1].z, ev[1].w, ev[2].x, ev[2].y, ev[2].z, ev[2].w, ev[3].x, ev[3].y, ev[3].z, ev[3].w};
    const int whv[4] = {wh.x, wh.y, wh.z, wh.w}, wlv[4] = {wlo.x, wlo.y, wlo.z, wlo.w};
    uint4 rows[16];
#pragma unroll
    for (int i = 0; i < 16; ++i) rows[i] = *(const uint4*)(VQs + (size_t)e[i] * 128);
    int ah[16], al[16];
#pragma unroll
    for (int c = 0; c < 16; ++c) { ah[c] = 0; al[c] = 0; }
#pragma unroll
    for (int g = 0; g < 4; ++g) {
#pragma unroll
        for (int d = 0; d < 4; ++d) {
            const unsigned A = d == 0 ? rows[4 * g].x : d == 1 ? rows[4 * g].y : d == 2 ? rows[4 * g].z : rows[4 * g].w;
            const unsigned B = d == 0 ? rows[4 * g + 1].x : d == 1 ? rows[4 * g + 1].y : d == 2 ? rows[4 * g + 1].z : rows[4 * g + 1].w;
            const unsigned C = d == 0 ? rows[4 * g + 2].x : d == 1 ? rows[4 * g + 2].y : d == 2 ? rows[4 * g + 2].z : rows[4 * g + 2].w;
            const unsigned D = d == 0 ? rows[4 * g + 3].x : d == 1 ? rows[4 * g + 3].y : d == 2 ? rows[4 * g + 3].z : rows[4 * g + 3].w;
            const unsigned ab01 = __builtin_amdgcn_perm(A, B, 0x01050004u), ab23 = __builtin_amdgcn_perm(A, B, 0x03070206u);
            const unsigned cd01 = __builtin_amdgcn_perm(C, D, 0x01050004u), cd23 = __builtin_amdgcn_perm(C, D, 0x03070206u);
            const int q0 = (int)__builtin_amdgcn_perm(ab01, cd01, 0x01000504u), q1 = (int)__builtin_amdgcn_perm(ab01, cd01, 0x03020706u);
            const int q2 = (int)__builtin_amdgcn_perm(ab23, cd23, 0x01000504u), q3 = (int)__builtin_amdgcn_perm(ab23, cd23, 0x03020706u);
            ah[4 * d + 0] = __builtin_amdgcn_sdot4(q0, whv[g], ah[4 * d + 0], false); al[4 * d + 0] = __builtin_amdgcn_sdot4(q0, wlv[g], al[4 * d + 0], false);
            ah[4 * d + 1] = __builtin_amdgcn_sdot4(q1, whv[g], ah[4 * d + 1], false); al[4 * d + 1] = __builtin_amdgcn_sdot4(q1, wlv[g], al[4 * d + 1], false);
            ah[4 * d + 2] = __builtin_amdgcn_sdot4(q2, whv[g], ah[4 * d + 2], false); al[4 * d + 2] = __builtin_amdgcn_sdot4(q2, wlv[g], al[4 * d + 2], false);
            ah[4 * d + 3] = __builtin_amdgcn_sdot4(q3, whv[g], ah[4 * d + 3], false); al[4 * d + 3] = __builtin_amdgcn_sdot4(q3, wlv[g], al[4 * d + 3], false);
        }
    }
    int y[16];
#pragma unroll
    for (int c = 0; c < 16; ++c) y[c] = ah[c] * 128 + al[c];
    const bool b5 = (lane & 32) != 0, b4 = (lane & 16) != 0, b3 = (lane & 8) != 0;
    int z[8], q[4];
#pragma unroll
    for (int k = 0; k < 8; ++k) { auto rr = __builtin_amdgcn_permlane32_swap((unsigned)y[k], (unsigned)y[8 + k], false, false); z[k] = (int)rr[0] + (int)rr[1]; }
#pragma unroll
    for (int k = 0; k < 4; ++k) { auto rr = __builtin_amdgcn_permlane16_swap((unsigned)z[k], (unsigned)z[4 + k], false, false); q[k] = (int)rr[0] + (int)rr[1]; }
    const int r0 = hx(q[0], q[2], b3, 8), r1 = hx(q[1], q[3], b3, 8);
    const int col = 128 * s + 16 * (lane & 7) + (b5 ? 8 : 0) + (b4 ? 4 : 0) + (b3 ? 2 : 0);
    const float2 g2 = *(const float2*)(gate2 + col); float2 x1 = *(const float2*)(x1row + col); { const unsigned dd = *(const unsigned*)(dlrow + col); x1.x += lo2f(dd); x1.y += hi2f(dd); }
    x1.x += g2.x * wscale * (float)r0; x1.y += g2.y * wscale * (float)r1;
    *(float2*)(outrow + col) = x1;
}
}

constexpr size_t WS_SU = 2 * MiB, WS_SV = 2 * MiB + 65536, WS_HS = 2 * MiB + 131072;
constexpr size_t WS_UQ = 24 * MiB, WS_VQ = 40 * MiB, WS_H2Q = 56 * MiB;
constexpr size_t WS_XS = 2 * MiB + 262144, WS_WINS = 2 * MiB + 393216, WS_WPQS = 2 * MiB + 409600;
constexpr size_t WS_WINQ = 456 * MiB, WS_WPQQ = 460 * MiB;
constexpr size_t WS_SSQQ = 462 * MiB, WS_SSQK = 3 * MiB;
constexpr size_t WS_SSQ = 464 * MiB;
constexpr size_t WS_A = WS_KA;
struct Args { const void* in[22]; float* out; unsigned char* ws; int ph_lo, ph_hi, li, pad; };

struct Frame {
    LAS unsigned char* lds;
    int tid, lane, wave, G, gw, NGW;
};

__host__ __device__ __forceinline__ int nat_col(int rho) {
    if (rho < 672) return rho;
    if (rho < 680) return C_FL + (rho - 672);
    if (rho < 768) return -1;
    if (rho < 1792) { const int t = (rho - 768) >> 8, c = (rho - 768) & 255, bj = c >> 7, wc = (c & 127) >> 5, i = c & 31; return (t < 2 ? C_FQ : C_FK) + 64 * (4 * (t & 1) + wc) + 32 * bj + i; }
    return C_FV + (rho - 1792);
}
__host__ __device__ __forceinline__ int nat_col_q(int n) {
    const int pn = n >> 8, c = n & 255, bj = c >> 7, wc = (c & 127) >> 5, i5 = c & 31;
    if (pn < 2) return (4 * pn + wc) * 96 + 32 * bj + i5;
    const int fq = i5 >> 3, k = i5 & 7; return (2 * wc + (fq >> 1)) * 96 + 64 + 16 * bj + (fq & 1) * 8 + k;
}
__host__ __device__ __forceinline__ int nat_col_kv(int n) {
    const int pn = n >> 8, c = n & 255, bj = c >> 7, wc = (c & 127) >> 5, i5 = c & 31;
    return (4 * (pn & 1) + wc) * 128 + (pn >= 2 ? 64 : 0) + 32 * bj + i5;
}
namespace pg8 {
struct EpiProjI8 {
    static constexpr bool PERM = true, AFTER_DRAIN = false, RESETUP = false;
    bf16_t* P; float* LOGF; float* SSQ; const float* rs; const float* cs; const float* g_fq; const float* g_fk; const float* b_f; float* SSQK;
    __device__ __forceinline__ void operator()(const i32x4 (&acc)[2][2][4][2], const Unit& u, int wr, int wc, int fr, int fq) const {
        const int row0 = u.pm * BM + wr * 64 + fr, rho0 = u.pn * BM + wc * 32 + 8 * fq, pn = u.pn;
        f32x4 c0[2], c1[2];
#pragma unroll
        for (int bj = 0; bj < 2; ++bj) { c0[bj] = *(const f32x4*)(cs + rho0 + bj * HALF); c1[bj] = *(const f32x4*)(cs + rho0 + bj * HALF + 4); }
        const bool fox = pn >= 3 && pn <= 6, isq = pn < 5;
        f32x4 g0[2], g1[2];
        if (fox) { const float* g = (isq ? g_fq : g_fk) + 8 * fq;
#pragma unroll
            for (int bj = 0; bj < 2; ++bj) { g0[bj] = *(const f32x4*)(g + 32 * bj); g1[bj] = *(const f32x4*)(g + 32 * bj + 4); } }
        float r8[8];
#pragma unroll
        for (int i = 0; i < 8; ++i) r8[i] = rs[row0 + (i >> 2) * HALF + (i & 3) * 16];
#pragma unroll
        for (int ai = 0; ai < 2; ++ai)
#pragma unroll
            for (int m = 0; m < 4; ++m) {
                const int row = row0 + ai * HALF + m * 16; bf16_t* rowp = P + (size_t)row * PP; const float r = r8[ai * 4 + m];
                f32x4 v0[2], v1[2];
#pragma unroll
                for (int bj = 0; bj < 2; ++bj) { const i32x4 a0 = acc[ai][bj][m][0], a1 = acc[ai][bj][m][1];
                    v0[bj] = (f32x4){(float)a0[0] * r * c0[bj][0], (float)a0[1] * r * c0[bj][1], (float)a0[2] * r * c0[bj][2], (float)a0[3] * r * c0[bj][3]};
                    v1[bj] = (f32x4){(float)a1[0] * r * c1[bj][0], (float)a1[1] * r * c1[bj][1], (float)a1[2] * r * c1[bj][2], (float)a1[3] * r * c1[bj][3]}; }
                float ssb[2];
#pragma unroll
                for (int bj = 0; bj < 2; ++bj) { float q = (v0[bj][0] * v0[bj][0] + v0[bj][1] * v0[bj][1]) + (v0[bj][2] * v0[bj][2] + v0[bj][3] * v0[bj][3]) + (v1[bj][0] * v1[bj][0] + v1[bj][1] * v1[bj][1]) + (v1[bj][2] * v1[bj][2] + v1[bj][3] * v1[bj][3]);
                    { auto r16 = __builtin_amdgcn_permlane16_swap(__float_as_uint(q), __float_as_uint(q), false, false); q = __uint_as_float(r16[0]) + __uint_as_float(r16[1]); }
                    { auto r32 = __builtin_amdgcn_permlane32_swap(__float_as_uint(q), __float_as_uint(q), false, false); q = __uint_as_float(r32[0]) + __uint_as_float(r32[1]); }
                    ssb[bj] = q; }
                if (pn == 2 && wc == 0 && fq == 0) SSQK[row] = ssb[1];
                if (fox) {
                    const float rr = rsqrtf((ssb[0] + ssb[1]) * (1.f / 64.f) + EPS) * (isq ? C2F : 1.f);
                    const int dst = (isq ? C_FQ : C_FK) + 64 * (4 * ((pn - 3) & 1) + wc) + 8 * fq;
#pragma unroll
                    for (int bj = 0; bj < 2; ++bj) { u32x4 w; w.x = cvt_pk_bf16(v0[bj][0] * rr * g0[bj][0], v0[bj][1] * rr * g0[bj][1]); w.y = cvt_pk_bf16(v0[bj][2] * rr * g0[bj][2], v0[bj][3] * rr * g0[bj][3]);
                        w.z = cvt_pk_bf16(v1[bj][0] * rr * g1[bj][0], v1[bj][1] * rr * g1[bj][1]); w.w = cvt_pk_bf16(v1[bj][2] * rr * g1[bj][2], v1[bj][3] * rr * g1[bj][3]);
                        *(u32x4*)(rowp + dst + 32 * bj) = w; }
                } else {
#pragma unroll
                    for (int bj = 0; bj < 2; ++bj) {
                        const int rho = rho0 + bj * HALF;
                        if (rho == 672) {
                            const float z[8] = {v0[bj][0], v0[bj][1], v0[bj][2], v0[bj][3], v1[bj][0], v1[bj][1], v1[bj][2], v1[bj][3]};
                            const int b = row / S_, sq = row % S_;
#pragma unroll
                            for (int h = 0; h < 8; ++h) { const float zz = z[h] + b_f[h]; LOGF[((size_t)b * 8 + h) * S_ + sq] = fminf(zz, 0.f) - log1pf(expf(-fabsf(zz))); }
                        } else if (rho < 672 || rho >= 1792) {
                            const int dst = rho < 672 ? rho : C_FV + (rho - 1792);
                            u32x4 w; w.x = cvt_pk_bf16(v0[bj][0], v0[bj][1]); w.y = cvt_pk_bf16(v0[bj][2], v0[bj][3]); w.z = cvt_pk_bf16(v1[bj][0], v1[bj][1]); w.w = cvt_pk_bf16(v1[bj][2], v1[bj][3]);
                            *(u32x4*)(rowp + dst) = w;
                            if (fq == 0 && rho < 640) {
                                if (pn == 0) { if (bj == 1) SSQ[(size_t)row * 16 + wc] = ssb[0] + ssb[1]; }
                                else if (pn == 1) SSQ[(size_t)row * 16 + (bj == 0 ? 4 : 8) + wc] = ssb[bj];
                                else SSQ[(size_t)row * 16 + 12 + wc] = ssb[bj];
                            }
                        }
                    }
                }
            }
    }
};
struct EpiStoreRms {
    static constexpr bool PERM = true, AFTER_DRAIN = false, RESETUP = false;
    bf16_t* O; int ldc; const float* SSQ; int slot0; float inv_cnt;
    __device__ __forceinline__ void operator()(const f32x4 (&acc)[2][2][4][2], const Unit& u, int wr, int wc, int fr, int fq) const {
        const int row0 = u.pm * BM + wr * 64 + fr, col0 = u.pn * BM + wc * 32 + 8 * fq;
#pragma unroll
        for (int ai = 0; ai < 2; ++ai)
#pragma unroll
            for (int m = 0; m < 4; ++m) { const int row = row0 + ai * HALF + m * 16; bf16_t* rowp = O + (size_t)row * ldc + col0;
                const f32x4 sa = *(const f32x4*)(SSQ + (size_t)row * 16 + slot0), sb = *(const f32x4*)(SSQ + (size_t)row * 16 + slot0 + 4);
                const float r = rsqrtf(((sa[0] + sa[1]) + (sa[2] + sa[3]) + (sb[0] + sb[1]) + (sb[2] + sb[3])) * inv_cnt + EPS);
#pragma unroll
                for (int bj = 0; bj < 2; ++bj) { const f32x4 v0 = acc[ai][bj][m][0] * r, v1 = acc[ai][bj][m][1] * r;
                    u32x4 w; w.x = cvt_pk_bf16(v0[0], v0[1]); w.y = cvt_pk_bf16(v0[2], v0[3]); w.z = cvt_pk_bf16(v1[0], v1[1]); w.w = cvt_pk_bf16(v1[2], v1[3]);
                    *(u32x4*)(rowp + bj * HALF) = w; } }
    }
};
#define EPI_SUM16 { auto r16 = __builtin_amdgcn_permlane16_swap(__float_as_uint(q), __float_as_uint(q), false, false); q = __uint_as_float(r16[0]) + __uint_as_float(r16[1]); }
#define EPI_SUM32 { auto r32 = __builtin_amdgcn_permlane32_swap(__float_as_uint(q), __float_as_uint(q), false, false); q = __uint_as_float(r32[0]) + __uint_as_float(r32[1]); }
__device__ __forceinline__ float sumsq8(const f32x4 a, const f32x4 b) { return (a[0] * a[0] + a[1] * a[1]) + (a[2] * a[2] + a[3] * a[3]) + (b[0] * b[0] + b[1] * b[1]) + (b[2] * b[2] + b[3] * b[3]); }
__device__ __forceinline__ void row_rms4(float (&r)[4], const float* SSQ8  , int row0, float inv_cnt) {
    f32x4 sa[4], sb[4];
#pragma unroll
    for (int i = 0; i < 4; ++i) { const int row = row0 + i * 16; sa[i] = *(const f32x4*)(SSQ8 + (unsigned)row * 16u); sb[i] = *(const f32x4*)(SSQ8 + (unsigned)row * 16u + 4); }
#pragma unroll
    for (int i = 0; i < 4; ++i) r[i] = rsqrtf(((sa[i][0] + sa[i][1]) + (sa[i][2] + sa[i][3]) + (sb[i][0] + sb[i][1]) + (sb[i][2] + sb[i][3])) * inv_cnt + EPS);
}
struct EpiMlaQ {
    static constexpr bool PERM = true, AFTER_DRAIN = false, RESETUP = true;
    bf16_t* QA; float* SSQQ; const float* SSQ; const float* g;
    __device__ __forceinline__ void operator()(const f32x4 (&acc)[2][2][4][2], const Unit& u, int wr, int wc, int fr, int fq) const {
        const int row0 = u.pm * BM + wr * 64 + fr, pn = u.pn;
        const bool rope = pn == 2;
        const int h = rope ? 2 * wc + (fq >> 1) : 4 * pn + wc, dA = rope ? 64 + (fq & 1) * 8 : 8 * fq, dstep = rope ? 16 : 32;
        const bool wr_ss = rope ? (fq & 1) == 0 : fq == 0;
        f32x4 g0[2], g1[2];
#pragma unroll
        for (int bj = 0; bj < 2; ++bj) { g0[bj] = *(const f32x4*)(g + dA + dstep * bj); g1[bj] = *(const f32x4*)(g + dA + dstep * bj + 4); }
#pragma unroll
        for (int ai = 0; ai < 2; ++ai) {
            float r[4]; row_rms4(r, SSQ, row0 + ai * HALF, 1.f / 384.f);
#pragma unroll
            for (int m = 0; m < 4; ++m) { const int row = row0 + ai * HALF + m * 16; bf16_t* rowp = QA + (unsigned)row * 768u + h * 96 + dA; const float rr = r[m];
                float q = (sumsq8(acc[ai][0][m][0], acc[ai][0][m][1]) + sumsq8(acc[ai][1][m][0], acc[ai][1][m][1])) * (rr * rr);
                EPI_SUM16
                if (!rope) EPI_SUM32
                if (wr_ss) SSQQ[(unsigned)row * 16u + 2 * h + (rope ? 1 : 0)] = q;
#pragma unroll
                for (int bj = 0; bj < 2; ++bj) { const f32x4 v0 = acc[ai][bj][m][0] * g0[bj] * rr, v1 = acc[ai][bj][m][1] * g1[bj] * rr;
                    u32x4 w; w.x = cvt_pk_bf16(v0[0], v0[1]); w.y = cvt_pk_bf16(v0[2], v0[3]); w.z = cvt_pk_bf16(v1[0], v1[1]); w.w = cvt_pk_bf16(v1[2], v1[3]);
                    *(u32x4*)(rowp + dstep * bj) = w; } }
            __builtin_amdgcn_sched_barrier(0);
        }
    }
};
struct EpiMlaKV {
    static constexpr bool PERM = true, AFTER_DRAIN = false, RESETUP = true;
    bf16_t* KA; bf16_t* KV; const float* SSQ; const float* SSQK; const bf16_t* P; const float* g; const float2* ROPE;
    __device__ __forceinline__ void operator()(const f32x4 (&acc)[2][2][4][2], const Unit& u, int wr, int wc, int fr, int fq) const {
        const int row0 = u.pm * BM + wr * 64 + fr, pn = u.pn, h = 4 * (pn & 1) + wc;
        if (pn >= 2) {
#pragma unroll
            for (int ai = 0; ai < 2; ++ai) {
                float r[4]; row_rms4(r, SSQ + 8, row0 + ai * HALF, 1.f / 256.f);
#pragma unroll
                for (int m = 0; m < 4; ++m) { const int row = row0 + ai * HALF + m * 16; bf16_t* rowp = KV + (unsigned)row * 1024u + h * 128 + 64 + 8 * fq; const float rr = r[m];
#pragma unroll
                    for (int bj = 0; bj < 2; ++bj) { const f32x4 v0 = acc[ai][bj][m][0] * rr, v1 = acc[ai][bj][m][1] * rr;
                        u32x4 w; w.x = cvt_pk_bf16(v0[0], v0[1]); w.y = cvt_pk_bf16(v0[2], v0[3]); w.z = cvt_pk_bf16(v1[0], v1[1]); w.w = cvt_pk_bf16(v1[2], v1[3]);
                        *(u32x4*)(rowp + 32 * bj) = w; } }
                __builtin_amdgcn_sched_barrier(0);
            }
        } else {
            f32x4 g0[2], g1[2];
#pragma unroll
            for (int bj = 0; bj < 2; ++bj) { g0[bj] = *(const f32x4*)(g + 32 * bj + 8 * fq); g1[bj] = *(const f32x4*)(g + 32 * bj + 8 * fq + 4); }
            const f32x4 ga = *(const f32x4*)(g + 64 + 4 * fq), gb = *(const f32x4*)(g + 80 + 4 * fq);
#pragma unroll
            for (int ai = 0; ai < 2; ++ai) {
                float r[4], sk[4]; row_rms4(r, SSQ + 8, row0 + ai * HALF, 1.f / 256.f);
#pragma unroll
                for (int m = 0; m < 4; ++m) sk[m] = SSQK[row0 + ai * HALF + m * 16];
                __builtin_amdgcn_sched_barrier(0);
#pragma unroll
                for (int m2 = 0; m2 < 2; ++m2) {
                uint2 p1[4], p2[4]; f32x4 c0[4], c1[4];
#pragma unroll
                for (int m = 2 * m2; m < 2 * m2 + 2; ++m) { const int row = row0 + ai * HALF + m * 16;
                    p1[m] = *(const uint2*)(P + (unsigned)row * (unsigned)PP + C_KPE + 4 * fq); p2[m] = *(const uint2*)(P + (unsigned)row * (unsigned)PP + C_KPE + 16 + 4 * fq);
                    const f32x4* cp = (const f32x4*)(ROPE + (unsigned)row * 16u + 4 * fq); c0[m] = cp[0]; c1[m] = cp[1]; }
#pragma unroll
                for (int m = 2 * m2; m < 2 * m2 + 2; ++m) { const int row = row0 + ai * HALF + m * 16; bf16_t* rowp = KA + (unsigned)row * 768u + h * 96; const float rl = r[m];
                    float q = (sumsq8(acc[ai][0][m][0], acc[ai][0][m][1]) + sumsq8(acc[ai][1][m][0], acc[ai][1][m][1])) * (rl * rl);
                    EPI_SUM16 EPI_SUM32
                    const float rr = rsqrtf((q + sk[m]) * (1.f / 96.f) + EPS), rs = rl * rr;
#pragma unroll
                    for (int bj = 0; bj < 2; ++bj) { const f32x4 v0 = acc[ai][bj][m][0] * g0[bj] * rs, v1 = acc[ai][bj][m][1] * g1[bj] * rs;
                        u32x4 w; w.x = cvt_pk_bf16(v0[0], v0[1]); w.y = cvt_pk_bf16(v0[2], v0[3]); w.z = cvt_pk_bf16(v1[0], v1[1]); w.w = cvt_pk_bf16(v1[2], v1[3]);
                        *(u32x4*)(rowp + 32 * bj + 8 * fq) = w; }
                    const f32x4 a = (f32x4){lo2f(p1[m].x), hi2f(p1[m].x), lo2f(p1[m].y), hi2f(p1[m].y)} * ga * rr, b = (f32x4){lo2f(p2[m].x), hi2f(p2[m].x), lo2f(p2[m].y), hi2f(p2[m].y)} * gb * rr;
                    uint2 w1, w2;
                    w1.x = cvt_pk_bf16(a[0] * c0[m][0] - b[0] * c0[m][1], a[1] * c0[m][2] - b[1] * c0[m][3]); w2.x = cvt_pk_bf16(b[0] * c0[m][0] + a[0] * c0[m][1], b[1] * c0[m][2] + a[1] * c0[m][3]);
                    w1.y = cvt_pk_bf16(a[2] * c1[m][0] - b[2] * c1[m][1], a[3] * c1[m][2] - b[3] * c1[m][3]); w2.y = cvt_pk_bf16(b[2] * c1[m][0] + a[2] * c1[m][1], b[3] * c1[m][2] + a[3] * c1[m][3]);
                    *(uint2*)(rowp + 64 + 4 * fq) = w1; *(uint2*)(rowp + 80 + 4 * fq) = w2; }
                __builtin_amdgcn_sched_barrier(0);
                }
            }
        }
    }
};
struct EpiStoreI8 {
    static constexpr bool PERM = true, AFTER_DRAIN = false, RESETUP = false;
    bf16_t* O; int ldc; const float* rs; const float* cs;
    __device__ __forceinline__ void operator()(const i32x4 (&acc)[2][2][4][2], const Unit& u, int wr, int wc, int fr, int fq) const {
        const int row0 = u.pm * BM + wr * 64 + fr, col0 = u.pn * BM + wc * 32 + 8 * fq;
        f32x4 c0[2], c1[2];
#pragma unroll
        for (int bj = 0; bj < 2; ++bj) { c0[bj] = *(const f32x4*)(cs + col0 + bj * HALF); c1[bj] = *(const f32x4*)(cs + col0 + bj * HALF + 4); }
        float r8[8];
#pragma unroll
        for (int i = 0; i < 8; ++i) r8[i] = rs[row0 + (i >> 2) * HALF + (i & 3) * 16];
#pragma unroll
        for (int ai = 0; ai < 2; ++ai)
#pragma unroll
            for (int m = 0; m < 4; ++m) { const int row = row0 + ai * HALF + m * 16; bf16_t* rowp = O + (size_t)row * ldc + col0; const float r = r8[ai * 4 + m];
#pragma unroll
                for (int bj = 0; bj < 2; ++bj) { const i32x4 a0 = acc[ai][bj][m][0], a1 = acc[ai][bj][m][1];
                    u32x4 w; w.x = cvt_pk_bf16((float)a0[0] * r * c0[bj][0], (float)a0[1] * r * c0[bj][1]); w.y = cvt_pk_bf16((float)a0[2] * r * c0[bj][2], (float)a0[3] * r * c0[bj][3]);
                    w.z = cvt_pk_bf16((float)a1[0] * r * c1[bj][0], (float)a1[1] * r * c1[bj][1]); w.w = cvt_pk_bf16((float)a1[2] * r * c1[bj][2], (float)a1[3] * r * c1[bj][3]);
                    *(u32x4*)(rowp + bj * HALF) = w; } }
    }
};
struct EpiDelta {
    static constexpr bool PERM = true, AFTER_DRAIN = false, RESETUP = false;
    const float* MOD; bf16_t* DL;
    __device__ __forceinline__ void operator()(const f32x4 (&acc)[2][2][4][2], const Unit& u, int wr, int wc, int fr, int fq) const {
        const int row0 = u.pm * BM + wr * 64 + fr, col0 = u.pn * BM + wc * 32 + 8 * fq;
        const int b = (u.pm * BM) / S_;
        f32x4 g0[2], g1[2];
#pragma unroll
        for (int bj = 0; bj < 2; ++bj) { g0[bj] = *(const f32x4*)(MOD + b * 6144 + 2 * 1024 + col0 + bj * HALF); g1[bj] = *(const f32x4*)(MOD + b * 6144 + 2 * 1024 + col0 + bj * HALF + 4); }
#pragma unroll
        for (int ai = 0; ai < 2; ++ai)
#pragma unroll
            for (int m = 0; m < 4; ++m) { bf16_t* rowp = DL + (size_t)(row0 + ai * HALF + m * 16) * 1024 + col0;
#pragma unroll
                for (int bj = 0; bj < 2; ++bj) { const f32x4 v0 = acc[ai][bj][m][0] * g0[bj], v1 = acc[ai][bj][m][1] * g1[bj];
                    u32x4 w; w.x = cvt_pk_bf16(v0[0], v0[1]); w.y = cvt_pk_bf16(v0[2], v0[3]); w.z = cvt_pk_bf16(v1[0], v1[1]); w.w = cvt_pk_bf16(v1[2], v1[3]);
                    *(u32x4*)(rowp + bj * HALF) = w; } }
    }
};
}

__device__ __forceinline__ void p0_transpose_item(const float* W, int K, int N, int Npad, bf16_t* WT, LAS float* scr, int item, int lane, const float* kscale = nullptr, int cmap = 0) {
    const int nblk = Npad / 32, kb = item / nblk, nb = item % nblk, k0 = 64 * kb, n0 = 32 * nb;
    const int nn = cmap == 1 ? nat_col_q(n0 + (lane & 31)) : cmap == 2 ? nat_col_kv(n0 + (lane & 31)) : n0 + (lane & 31);
#pragma unroll 8
    for (int i = 0; i < 32; ++i) { const int kk = 2 * i + (lane >> 5); scr[kk * 33 + (lane & 31)] = nn < N ? W[(size_t)(k0 + kk) * N + nn] * (kscale ? kscale[k0 + kk] : 1.f) : 0.f; }
    asm volatile("s_waitcnt lgkmcnt(0)" ::: "memory");
    const int c = lane & 7;
#pragma unroll
    for (int j = 0; j < 4; ++j) { const int n = (lane >> 3) + 8 * j; const LAS float* s = scr + (8 * c) * 33 + n;
        u32x4 o; o.x = pk2(s[0 * 33], s[1 * 33]); o.y = pk2(s[2 * 33], s[3 * 33]); o.z = pk2(s[4 * 33], s[5 * 33]); o.w = pk2(s[6 * 33], s[7 * 33]);
        *(u32x4*)(WT + (size_t)(n0 + n) * K + k0 + 8 * c) = o; }
    asm volatile("s_waitcnt lgkmcnt(0)" ::: "memory");
}
__device__ __forceinline__ void p0_quant_cols(const float* W, int ldw, bool cmap, unsigned char* Q, float* SC, int item, LAS unsigned char* lds, int wave, int lane) {
    const int c32 = lane & 31, kh = lane >> 5, r = item * 32 + c32, nc = cmap ? nat_col(r) : r;
    const float* src = W + (size_t)(128 * wave + 4 * kh) * ldw + (nc < 0 ? 0 : nc);
    float v[64];
#pragma unroll
    for (int i = 0; i < 16; ++i)
#pragma unroll
        for (int j = 0; j < 4; ++j) v[4 * i + j] = nc < 0 ? 0.f : src[(size_t)(8 * i + j) * ldw];
    float am = 0.f;
#pragma unroll
    for (int i = 0; i < 64; ++i) am = fmaxf(am, fabsf(v[i]));
    LAS float* red = (LAS float*)lds;
    red[wave * 64 + lane] = am;
    __syncthreads();
    float cm = 0.f;
#pragma unroll
    for (int j = 0; j < 8; ++j) cm = fmaxf(cm, fmaxf(red[j * 64 + c32], red[j * 64 + 32 + c32]));
    const float inv = cm > 0.f ? 127.f / cm : 0.f;
    LAS unsigned* tile = (LAS unsigned*)(lds + 4096 + wave * 4096);
#pragma unroll
    for (int i = 0; i < 16; ++i) { const int q0 = (int)rintf(v[4 * i] * inv), q1 = (int)rintf(v[4 * i + 1] * inv), q2 = (int)rintf(v[4 * i + 2] * inv), q3 = (int)rintf(v[4 * i + 3] * inv);
        tile[c32 * 32 + 2 * i + kh] = (unsigned)(q0 & 255) | ((unsigned)(q1 & 255) << 8) | ((unsigned)(q2 & 255) << 16) | ((unsigned)(q3 & 255) << 24); }
    asm volatile("s_waitcnt lgkmcnt(0)" ::: "memory");
#pragma unroll
    for (int j = 0; j < 4; ++j) { const int p = lane + 64 * j, row = p >> 3, ch = p & 7;
        const u32x4 w = *(LAS const u32x4*)(tile + row * 32 + ch * 4);
        *(u32x4*)(Q + (size_t)(item * 32 + row) * 1024 + 128 * wave + 16 * ch) = w; }
    if (wave == 0 && kh == 0) SC[r] = cm * (1.f / 127.f);
    __syncthreads();
}
__device__ __forceinline__ void p0_mod_block(const float* c, const float* w_ada, const float* b_ada, float* mod, LAS unsigned char* lds, int item, int wave, int lane) {
    LAS float* sil = (LAS float*)(lds + wave * 2048);
    LAS float* part = (LAS float*)(lds + 16384);
    for (int i = lane; i < 512; i += 64) { const int b = i >> 7, kk = i & 127; const float cv = c[b * 1024 + wave * 128 + kk]; sil[kk * 4 + b] = cv / (1.f + expf(-cv)); }
    asm volatile("s_waitcnt lgkmcnt(0)" ::: "memory");
    const int j = item * 64 + lane;
    const float* wp = w_ada + (size_t)(wave * 128) * 6144 + j;
    float a0 = 0.f, a1 = 0.f, a2 = 0.f, a3 = 0.f;
#pragma unroll 16
    for (int k = 0; k < 128; ++k) { const float w = wp[(size_t)k * 6144]; const f32x4 s = *(const LAS f32x4*)(sil + k * 4); a0 += s[0] * w; a1 += s[1] * w; a2 += s[2] * w; a3 += s[3] * w; }
    part[(wave * 4 + 0) * 64 + lane] = a0; part[(wave * 4 + 1) * 64 + lane] = a1; part[(wave * 4 + 2) * 64 + lane] = a2; part[(wave * 4 + 3) * 64 + lane] = a3;
    __syncthreads();
    if (wave < 4) { float acc = b_ada[j];
#pragma unroll
        for (int w = 0; w < 8; ++w) acc += part[(w * 4 + wave) * 64 + lane];
        mod[wave * 6144 + j] = acc; }
    __syncthreads();
}

struct ModIn { float4 v[4]; };
__device__ __forceinline__ void modrow_load(ModIn& M, const float* X, const bf16_t* DL, int row, int lane) {
    const float4* xr = (const float4*)(X + (size_t)row * 1024) + lane;
#pragma unroll
    for (int j = 0; j < 4; ++j) M.v[j] = xr[64 * j];
    if (DL) {
#pragma unroll
        for (int j = 0; j < 4; ++j) { const uint2 dd = *(const uint2*)(DL + (size_t)row * 1024 + 4 * lane + 256 * j); M.v[j].x += lo2f(dd.x); M.v[j].y += hi2f(dd.x); M.v[j].z += lo2f(dd.y); M.v[j].w += hi2f(dd.y); }
    }
}
__device__ __forceinline__ void modrow_finish(ModIn& M, const float* g, const float* mod, int shift_idx, int scale_idx, bf16_t* out, unsigned char* outq, float* hs, int row, int lane) {
    const int b = row / S_; float ss = 0.f;
#pragma unroll
    for (int j = 0; j < 4; ++j) ss += (M.v[j].x * M.v[j].x + M.v[j].y * M.v[j].y) + (M.v[j].z * M.v[j].z + M.v[j].w * M.v[j].w);
    ss = wave_sum(ss);
    const float r = rsqrtf(ss * (1.f / 1024.f) + EPS);
    const float* sh = mod + b * 6144 + shift_idx * 1024; const float* sc = mod + b * 6144 + scale_idx * 1024;
    float am = 0.f;
#pragma unroll
    for (int j = 0; j < 4; ++j) {
        const int col = 4 * lane + 256 * j; float4& v = M.v[j];
        const float4 g4 = *(const float4*)(g + col), s4 = *(const float4*)(sc + col), h4 = *(const float4*)(sh + col);
        v.x = v.x * r * g4.x * (1.f + s4.x) + h4.x; v.y = v.y * r * g4.y * (1.f + s4.y) + h4.y; v.z = v.z * r * g4.z * (1.f + s4.z) + h4.z; v.w = v.w * r * g4.w * (1.f + s4.w) + h4.w;
        if (out) { uint2 w; w.x = pk2(v.x, v.y); w.y = pk2(v.z, v.w); *(uint2*)(out + (size_t)row * 1024 + col) = w; }
        am = fmaxf(am, fmaxf(fmaxf(fabsf(v.x), fabsf(v.y)), fmaxf(fabsf(v.z), fabsf(v.w))));
    }
    if (outq) {
#pragma unroll
        for (int o = 1; o < 64; o <<= 1) am = fmaxf(am, __shfl_xor(am, o));
        const float inv = am > 0.f ? 127.f / am : 0.f;
#pragma unroll
        for (int j = 0; j < 4; ++j) { const float4 v = M.v[j]; const int q0 = (int)rintf(v.x * inv), q1 = (int)rintf(v.y * inv), q2 = (int)rintf(v.z * inv), q3 = (int)rintf(v.w * inv);
            *(unsigned*)(outq + (size_t)row * 1024 + 4 * lane + 256 * j) = (unsigned)(q0 & 255) | ((unsigned)(q1 & 255) << 8) | ((unsigned)(q2 & 255) << 16) | ((unsigned)(q3 & 255) << 24); }
        if (lane == 0) hs[row] = am * (1.f / 127.f);
    }
}
__device__ __forceinline__ void modrows2(const float* X, const bf16_t* DL, const float* g, const float* mod, int shift_idx, int scale_idx, bf16_t* out, unsigned char* outq, float* hs, int gw, int ngw, int lane) {
    for (int row = gw; row < T_; row += 2 * ngw) {
        const int row2 = row + ngw; ModIn Ma, Mb;
        modrow_load(Ma, X, DL, row, lane); if (row2 < T_) modrow_load(Mb, X, DL, row2, lane);
        modrow_finish(Ma, g, mod, shift_idx, scale_idx, out, outq, hs, row, lane); if (row2 < T_) modrow_finish(Mb, g, mod, shift_idx, scale_idx, out, outq, hs, row2, lane);
    }
}
__device__ __forceinline__ void quant4(const float* peer_u, const float* peer_v, unsigned char* UQ, unsigned char* VQ, float* SU, float* SV, int r0, int lane) {
    float4 v[4][4]; float am[4];
#pragma unroll
    for (int q = 0; q < 4; ++q) { const int r = r0 + q; const float* src = (r < 16384 ? peer_u + (size_t)r * 1024 : peer_v + (size_t)(r - 16384) * 1024);
#pragma unroll
        for (int j = 0; j < 4; ++j) v[q][j] = ((const float4*)src)[lane + 64 * j]; }
#pragma unroll
    for (int q = 0; q < 4; ++q) { float a = 0.f;
#pragma unroll
        for (int j = 0; j < 4; ++j) a = fmaxf(a, fmaxf(fmaxf(fabsf(v[q][j].x), fabsf(v[q][j].y)), fmaxf(fabsf(v[q][j].z), fabsf(v[q][j].w))));
        am[q] = a; }
#pragma unroll
    for (int o = 1; o < 64; o <<= 1) {
#pragma unroll
        for (int q = 0; q < 4; ++q) am[q] = fmaxf(am[q], __shfl_xor(am[q], o)); }
#pragma unroll
    for (int q = 0; q < 4; ++q) { const int r = r0 + q; unsigned char* dst = (r < 16384 ? UQ + (size_t)r * 128 : VQ + (size_t)(r - 16384) * 128); float* sc = (r < 16384 ? SU + r : SV + (r - 16384));
        const float inv = am[q] > 0.f ? 127.f / am[q] : 0.f;
#pragma unroll
        for (int j = 0; j < 4; ++j) { const float4 x = v[q][j]; const int q0 = (int)rintf(x.x * inv), q1 = (int)rintf(x.y * inv), q2 = (int)rintf(x.z * inv), q3 = (int)rintf(x.w * inv);
            *(unsigned*)(dst + (size_t)(((4 * lane + 256 * j) >> 7) * (16384 * 128)) + ((4 * lane + 256 * j) & 127)) = (unsigned)(q0 & 255) | ((unsigned)(q1 & 255) << 8) | ((unsigned)(q2 & 255) << 16) | ((unsigned)(q3 & 255) << 24); }
        if (lane == 0) *sc = am[q] * (1.f / 127.f); }
}

__global__ void __launch_bounds__(NWAVES * 64, 2) mega_fwd(Args args) {
    extern __shared__ __attribute__((aligned(16))) unsigned char lds[];
    Frame F;
    F.lds = (LAS unsigned char*)lds;
    volatile LAS unsigned* MISC = (volatile LAS unsigned*)(F.lds + MISC_OFF);
    F.tid = threadIdx.x; F.lane = F.tid & 63; F.wave = __builtin_amdgcn_readfirstlane(F.tid >> 6);
    F.G = gridDim.x; F.gw = blockIdx.x * NWAVES + F.wave; F.NGW = F.G * NWAVES;
    unsigned char* ws = args.ws;
    unsigned* ctl = (unsigned*)(ws + WS_CTL);
    const float* x = (const float*)args.in[0]; const float* c = (const float*)args.in[1]; const int* positions = (const int*)args.in[2];
    const float* w_ada = (const float*)args.in[3]; const float* b_ada = (const float*)args.in[4]; const float* norm1_g = (const float*)args.in[5];
    const float* w_in = (const float*)args.in[6]; const float* mla_qa_g = (const float*)args.in[7]; const float* mla_kva_g = (const float*)args.in[8];
    const float* w_uq = (const float*)args.in[9]; const float* w_ukv = (const float*)args.in[10]; const float* mla_q_g = (const float*)args.in[11];
    const float* mla_k_g = (const float*)args.in[12]; const float* fox_q_g = (const float*)args.in[13]; const float* fox_k_g = (const float*)args.in[14];
    const float* b_f = (const float*)args.in[15]; const float* w_o = (const float*)args.in[16]; const float* norm2_g = (const float*)args.in[17];
    const float* w_pq = (const float*)args.in[18]; const float* sub_keys = (const float*)args.in[19]; const float* peer_u = (const float*)args.in[20]; const float* peer_v = (const float*)args.in[21];
    float* out = args.out;
    float* MOD = (float*)(ws + WS_MOD); float* FL = (float*)(ws + WS_FL); float* FCUM = (float*)(ws + WS_FCUM); float* LOGF = (float*)(ws + WS_LOGF); float2* ROPE = (float2*)(ws + WS_ROPE);
    bf16_t* XN = (bf16_t*)(ws + WS_XN); bf16_t* PROJ = (bf16_t*)(ws + WS_PROJ); bf16_t* KVRAW = (bf16_t*)(ws + WS_KVRAW); bf16_t* QA = (bf16_t*)(ws + WS_QA); bf16_t* KA = (bf16_t*)(ws + WS_KA);
    bf16_t* WIN = (bf16_t*)(ws + WS_WIN); bf16_t* WUQ = (bf16_t*)(ws + WS_WUQ); bf16_t* WUKV = (bf16_t*)(ws + WS_WUKV); bf16_t* WO = (bf16_t*)(ws + WS_WO); bf16_t* WPQ = (bf16_t*)(ws + WS_WPQ); bf16_t* SKB = (bf16_t*)(ws + WS_SK);
    float* SSQ = (float*)(ws + WS_SSQ); float* SSQQ = (float*)(ws + WS_SSQQ); float* SSQK = (float*)(ws + WS_SSQK); bf16_t* DELTA = (bf16_t*)(ws + WS_KVRAW);
    unsigned char* XNQ = ws + WS_XN; float* XS = (float*)(ws + WS_XS); unsigned char* WINQ = ws + WS_WINQ; unsigned char* WPQQ = ws + WS_WPQQ; float* WINS = (float*)(ws + WS_WINS); float* WPQS = (float*)(ws + WS_WPQS);
    unsigned char* UQ = ws + WS_UQ; unsigned char* VQ = ws + WS_VQ; unsigned char* H2Q = ws + WS_H2Q; float* SU = (float*)(ws + WS_SU); float* SV = (float*)(ws + WS_SV); float* HS = (float*)(ws + WS_HS); float* AP = (float*)(ws + WS_A);
    bf16_t* OB = XN; bf16_t* H2 = XN; bf16_t* QP = PROJ; int* EID = (int*)(ws + WS_QA); float* GATE = (float*)(ws + WS_QA + 16 * MiB);
    (void)sub_keys; (void)peer_u; (void)peer_v; (void)positions; (void)KA; (void)FCUM; (void)LOGF; (void)ROPE; (void)mla_q_g; (void)mla_k_g; (void)b_f; (void)fox_q_g; (void)fox_k_g; (void)mla_qa_g; (void)mla_kva_g;

    for (int u = F.tid; u < (LDS_BYTES - LDSCTL_OFF) / 4; u += NWAVES * 64) ((LAS unsigned*)(F.lds + LDSCTL_OFF))[u] = 0u;
    __syncthreads();
    const int lo = args.ph_lo, hi = args.ph_hi;
    XcdBarrier bar; bar.bar = ctl + CW_BAR + args.li * XCD_BAR_WORDS; bar.x = 0; bar.st = nullptr;
    if (hi - lo > 1) bar = xcd_barrier_post(ctl + CW_BAR + args.li * XCD_BAR_WORDS, MISC + 8);
#define IN(k) (lo <= (k) && (k) < hi)
#define SEAM(k) do { if (IN(k) && IN((k) + 1)) xcd_barrier(bar); } while (0)

    if (IN(0)) {
        LAS float* scr = (LAS float*)(F.lds + F.wave * 16384);
        constexpr int I_MOD = 96, I_UQ = 6 * 24, I_UKV = 4 * 32, I_O = 16 * 32;
        constexpr int I_SK = 512;
        constexpr int NITEMS = I_UQ + I_UKV + I_O + I_SK;
        constexpr int I_QIN = PP / 32, I_QPQ = 2048 / 32;
        {
            const float invf = (float)exp2(-(double)(F.lane & 15) * (13.287712379549449 / 16.0));
            for (int r4 = F.gw * 4; r4 < T_; r4 += F.NGW * 4) { const int row = r4 + (F.lane >> 4);
                const double a = (double)((float)positions[row] * invf), n = rint(a * 0.15915494309189535); const float red = (float)(a - n * 6.283185307179586);
                ROPE[(size_t)row * 16 + (F.lane & 15)] = make_float2(__cosf(red), __sinf(red)); }
        }
        unsigned* modcnt = ctl + 192;
        for (int mi = (int)blockIdx.x; mi < I_MOD; mi += F.G) p0_mod_block(c, w_ada, b_ada, MOD, F.lds, mi, F.wave, F.lane);
        if ((int)blockIdx.x < I_MOD) {
            __syncthreads();
            if (F.tid == 0) { __builtin_amdgcn_fence(__ATOMIC_RELEASE, "agent"); asm volatile("s_waitcnt vmcnt(0)" ::: "memory"); (void)xb_add(modcnt, 1u); }
        }
        for (int it = F.G - 1 - (int)blockIdx.x; it < I_QIN + I_QPQ; it += F.G) {
            if (it < I_QIN) p0_quant_cols(w_in, INW, true, WINQ, WINS, it, F.lds, F.wave, F.lane);
            else p0_quant_cols(w_pq, 2048, false, WPQQ, WPQS, it - I_QIN, F.lds, F.wave, F.lane);
        }
        for (int it = F.gw; it < NITEMS; it += F.NGW) {
            int r = it;
            if (r < I_UQ) { p0_transpose_item(w_uq, 384, 768, 768, WUQ, scr, r, F.lane, mla_qa_g, 1); continue; } r -= I_UQ;
            if (r < I_UKV) { p0_transpose_item(w_ukv, 256, 1024, 1024, WUKV, scr, r, F.lane, mla_kva_g, 2); continue; } r -= I_UKV;
            if (r < I_O) { p0_transpose_item(w_o, 1024, 1024, 1024, WO, scr, r, F.lane); continue; } r -= I_O;
            { const float4* src = (const float4*)(sub_keys + (size_t)r * 512) + F.lane * 2; const float4 a = src[0], b2 = src[1];
              u32x4 o; o.x = pk2(a.x, a.y); o.y = pk2(a.z, a.w); o.z = pk2(b2.x, b2.y); o.w = pk2(b2.z, b2.w); *(u32x4*)(SKB + (size_t)r * 512 + F.lane * 8) = o; }
        }
        if (F.tid == 0) { const unsigned need = (unsigned)(F.G < I_MOD ? F.G : I_MOD); unsigned* tmo = ctl + CW_BAR + args.li * XCD_BAR_WORDS; XB_SPIN(xb_ld(modcnt) < need, tmo); }
        __syncthreads();
        __builtin_amdgcn_fence(__ATOMIC_ACQUIRE, "agent"); asm volatile("s_waitcnt vmcnt(0)" ::: "memory");
        modrows2(x, nullptr, norm1_g, MOD, 0, 1, nullptr, XNQ, XS, F.gw, F.NGW, F.lane);
    }
    SEAM(1);
    if (IN(2)) {
        pg8::Gemm g{(const bf16_t*)XNQ, (const bf16_t*)WINQ, T_, PP, 512, 512}; pg8::StaticOrder S; S.init(T_, PP, F.G, (int)blockIdx.x);
        pg8::EpiProjI8 E{PROJ, LOGF, SSQ, XS, WINS, fox_q_g, fox_k_g, b_f, SSQK};
        pg8::gemm_phase<pg8::EpiProjI8, pg8::StaticOrder, true, true, true>(F.lds, g, S, E);
    }
    SEAM(2);
    if (IN(4)) {
        { const int fb = F.G >= 160 ? 128 : 0; if (F.wave == 0 && (int)blockIdx.x >= fb && (int)blockIdx.x < fb + 32) fcum_item(LOGF, FCUM, (int)blockIdx.x - fb, F.lane); }
        { pg8::Gemm g{PROJ + C_CQ, WUQ, T_, 768, 384, PP}; pg8::StaticOrder S; S.init(T_, 768, F.G, (int)blockIdx.x); pg8::EpiMlaQ E{QA, SSQQ, SSQ, mla_q_g};
          pg8::gemm_phase<pg8::EpiMlaQ, pg8::StaticOrder, true, true>(F.lds, g, S, E); }
        { pg8::Gemm g{PROJ + C_CKV, WUKV, T_, 1024, 256, PP}; pg8::StaticOrder S; S.init(T_, 1024, F.G, (int)blockIdx.x); pg8::EpiMlaKV E{KA, KVRAW, SSQ, SSQK, PROJ, mla_k_g, ROPE};
          pg8::gemm_phase<pg8::EpiMlaKV, pg8::StaticOrder, true, true>(F.lds, g, S, E); }
    }
    SEAM(4);
    if (IN(6)) {
        volatile LAS unsigned* qslot = MISC + 16;
        float thr;
        { float gq = fabsf(fox_q_g[F.lane]), gk = fabsf(fox_k_g[F.lane]);
#pragma unroll
          for (int o = 1; o < 64; o <<= 1) { gq = fmaxf(gq, __shfl_xor(gq, o)); gk = fmaxf(gk, __shfl_xor(gk, o)); }
          thr = 104.5f + 2.f * 1.02f * 8.f * gq * gk; }
        unsigned* qctr = ctl + 64;
        if (F.tid == 0) qslot[0] = atomicAdd(qctr, 1u);
        __syncthreads();
        unsigned u = qslot[0];
        while (u < 2048u + 1024u) {
            unsigned unext = 0u;
            if (F.tid == 0) unext = atomicAdd(qctr, 1u);
            if (u >= 2048u) {
                quant4(peer_u, peer_v, UQ, VQ, SU, SV, (int)(u - 2048u) * 32 + F.wave * 4, F.lane);
                if (F.tid == 0) qslot[0] = unext;
                __syncthreads();
                u = qslot[0];
                __syncthreads();
                continue;
            }
            const int grp = (int)(u >> 10), bh = (int)(u & 31u), qb = 31 - (int)((u >> 5) & 31u), b = bh >> 3, h = bh & 7;
            if (grp == 0) { const att::Desc d{QA + (size_t)b * S_ * 768 + h * 96, 768, KA + (size_t)b * S_ * 768 + h * 96, 768, KVRAW + (size_t)b * S_ * 1024 + h * 128 + 64, 1024, OB + (size_t)b * S_ * 1024 + h * 64, 1024, nullptr, SSQQ + (size_t)b * S_ * 16 + 2 * h, ROPE + (size_t)b * S_ * 16};
                att::attn_unit<6, false>(d, qb, 0, F.lds); }
            else { const bf16_t* pb = PROJ + (size_t)b * S_ * PP + h * 64; const float* fc = FCUM + (size_t)(b * 8 + h) * S_;
                const att::Desc d{pb + C_FQ, PP, pb + C_FK, PP, pb + C_FV, PP, OB + (size_t)b * S_ * 1024 + 512 + h * 64, 1024, fc, nullptr, nullptr};
                const int NT = 4 * (qb + 1); const float lim = fc[qb * 256] + thr;
                int j0 = 0;
                { const int ja = F.lane, jb2 = 64 + F.lane;
                  const bool ka = ja < NT ? (fc[64 * ja + 63] <= lim) : true, kb = jb2 < NT ? (fc[64 * jb2 + 63] <= lim) : true;
                  const unsigned long long ma = __ballot(ka), mb = __ballot(kb);
                  j0 = ma ? __builtin_ctzll(ma) : (mb ? 64 + __builtin_ctzll(mb) : NT - 4); }
                if (j0 > NT - 4) j0 = NT - 4;
                att::attn_unit<4, true>(d, qb, j0, F.lds); }
            if (F.tid == 0) qslot[0] = unext;
            __syncthreads();
            u = qslot[0];
            __syncthreads();
        }
    }
    SEAM(6);
    if (IN(7)) {
        pg8::Gemm g{OB, WO, T_, 1024, 1024, 1024}; pg8::StaticOrder S; S.init(T_, 1024, F.G, (int)blockIdx.x);
        pg8::EpiDelta E{MOD, DELTA};
        pg8::gemm_phase<pg8::EpiDelta, pg8::StaticOrder, true, true>(F.lds, g, S, E);
    }
    SEAM(7);
    if (IN(8)) modrows2(x, DELTA, norm2_g, MOD, 3, 4, nullptr, H2Q, HS, F.gw, F.NGW, F.lane);
    SEAM(8);
    if (IN(9)) {
        pg8::Gemm g{(const bf16_t*)H2Q, (const bf16_t*)WPQQ, T_, 2048, 512, 512}; pg8::StaticOrder S; S.init(T_, 2048, F.G, (int)blockIdx.x); pg8::EpiStoreI8 E{QP, 2048, HS, WPQS};
        pg8::gemm_phase<pg8::EpiStoreI8, pg8::StaticOrder, true, true, true>(F.lds, g, S, E);
    }
    SEAM(9);
    if (IN(10)) { for (int w = F.gw; w < (T_ / 32) * 4; w += F.NGW) pk::topk_item2(QP, SKB, EID, GATE, w, F.lane); }
    SEAM(10);
    {
        const int ng = F.G < 8 ? F.G : 8; const int vx = (int)blockIdx.x % ng, rank = (int)blockIdx.x / ng, nrank = (F.G - vx + ng - 1) / ng;
        const int gwv = rank * NWAVES + F.wave, ngwv = nrank * NWAVES;
        const int grp = F.lane >> 3, sub = F.lane & 7;
        int* PA = (int*)(ws + WS_PROJ);
        int* WQH = (int*)(ws + WS_KA); int* WQL = (int*)(ws + WS_KA + 4 * MiB); float* WSC = (float*)(ws + WS_KA + 8 * MiB);
        if (IN(11)) {
            for (int s = vx; s < 8; s += ng) {
                const unsigned char* UQs = UQ + (size_t)s * (16384 * 128) + 16 * sub;
                int t = gwv; int4 ev[4]; int4 hq = make_int4(0, 0, 0, 0);
#pragma unroll
                for (int k = 0; k < 4; ++k) ev[k] = make_int4(0, 0, 0, 0);
                if (t < T_) {
#pragma unroll
                    for (int k = 0; k < 4; ++k) ev[k] = *(const int4*)(EID + (size_t)t * 128 + grp * 16 + 4 * k);
                    hq = *(const int4*)(H2Q + (size_t)t * 1024 + 128 * s + 16 * sub); }
                while (t < T_) {
                    const int tn = t + ngwv; int4 evn[4]; int4 hqn = make_int4(0, 0, 0, 0);
#pragma unroll
                    for (int k = 0; k < 4; ++k) evn[k] = make_int4(0, 0, 0, 0);
                    if (tn < T_) {
#pragma unroll
                        for (int k = 0; k < 4; ++k) evn[k] = *(const int4*)(EID + (size_t)tn * 128 + grp * 16 + 4 * k);
                        hqn = *(const int4*)(H2Q + (size_t)tn * 1024 + 128 * s + 16 * sub); }
                    gx::u_token(UQs, ev, hq, PA + ((size_t)s * T_ + t) * 128, F.lane);
                    t = tn; hq = hqn;
#pragma unroll
                    for (int k = 0; k < 4; ++k) ev[k] = evn[k];
                }
            }
        }
        SEAM(11);
        if (IN(12)) {
            for (int t = F.gw; t < T_; t += F.NGW) {
                int i0 = 0, i1 = 0;
#pragma unroll
                for (int s = 0; s < 8; ++s) { const int2 p = *(const int2*)(PA + ((size_t)s * T_ + t) * 128 + 2 * F.lane); i0 += p.x; i1 += p.y; }
                const int2 e2 = *(const int2*)(EID + (size_t)t * 128 + 2 * F.lane); const float2 g2 = *(const float2*)(GATE + (size_t)t * 128 + 2 * F.lane); const float hs = HS[t];
                const float w0 = g2.x * gx::gelu_t((float)i0 * SU[e2.x] * hs) * SV[e2.x], w1 = g2.y * gx::gelu_t((float)i1 * SU[e2.y] * hs) * SV[e2.y];
                float wm = fmaxf(fabsf(w0), fabsf(w1));
#pragma unroll
                for (int o = 1; o < 64; o <<= 1) wm = fmaxf(wm, __shfl_xor(wm, o));
                const float inv = wm > 0.f ? 16256.f / wm : 0.f;
                const int q0 = (int)rintf(w0 * inv), q1 = (int)rintf(w1 * inv);
                const unsigned h2 = (unsigned)((q0 >> 7) & 255) | ((unsigned)((q1 >> 7) & 255) << 8), l2 = (unsigned)(q0 & 127) | ((unsigned)(q1 & 127) << 8);
                const unsigned h2p = __shfl_xor(h2, 1), l2p = __shfl_xor(l2, 1);
                if ((F.lane & 1) == 0) { WQH[(size_t)t * 32 + (F.lane >> 1)] = (int)(h2 | (h2p << 16)); WQL[(size_t)t * 32 + (F.lane >> 1)] = (int)(l2 | (l2p << 16)); }
                if (F.lane == 0) WSC[t] = wm * (1.f / 16256.f);
            }
        }
        SEAM(12);
        if (IN(13)) {
            for (int s = vx; s < 8; s += ng) {
                const unsigned char* VQs = VQ + (size_t)s * (16384 * 128) + 16 * sub;
                int t = gwv; int4 ev[4]; int4 wh = make_int4(0, 0, 0, 0), wl = make_int4(0, 0, 0, 0); float wsc = 0.f;
#pragma unroll
                for (int k = 0; k < 4; ++k) ev[k] = make_int4(0, 0, 0, 0);
                if (t < T_) {
#pragma unroll
                    for (int k = 0; k < 4; ++k) ev[k] = *(const int4*)(EID + (size_t)t * 128 + grp * 16 + 4 * k);
                    wh = *(const int4*)(WQH + (size_t)t * 32 + grp * 4); wl = *(const int4*)(WQL + (size_t)t * 32 + grp * 4); wsc = WSC[t]; }
                while (t < T_) {
                    const int tn = t + ngwv; int4 evn[4]; int4 whn = make_int4(0, 0, 0, 0), wln = make_int4(0, 0, 0, 0); float wscn = 0.f;
#pragma unroll
                    for (int k = 0; k < 4; ++k) evn[k] = make_int4(0, 0, 0, 0);
                    if (tn < T_) {
#pragma unroll
                        for (int k = 0; k < 4; ++k) evn[k] = *(const int4*)(EID + (size_t)tn * 128 + grp * 16 + 4 * k);
                        whn = *(const int4*)(WQH + (size_t)tn * 32 + grp * 4); wln = *(const int4*)(WQL + (size_t)tn * 32 + grp * 4); wscn = WSC[tn]; }
                    float* dstrow = out + (size_t)t * 1024;
                    gx::v_token(VQs, ev, wh, wl, wsc, MOD + (t / S_) * 6144 + 5 * 1024, x + (size_t)t * 1024, DELTA + (size_t)t * 1024, dstrow, s, F.lane);
                    t = tn; wh = whn; wl = wln; wsc = wscn;
#pragma unroll
                    for (int k = 0; k < 4; ++k) ev[k] = evn[k];
                }
            }
        }
    }
#undef IN
#undef SEAM
}

static int g_grid = 0;
static void launch_mega(const Args& base, int lo, int hi, int li, hipStream_t stream) {
    Args a = base; a.ph_lo = lo; a.ph_hi = hi; a.li = li;
    hipLaunchKernelGGL(mega_fwd, dim3(g_grid), dim3(NWAVES * 64), LDS_BYTES, stream, a);
}

extern "C" void kernel_launch(void* const* d_in, const int* in_sizes, int n_in, void* d_out, int out_size, void* d_ws, size_t ws_size, hipStream_t stream) {
    if (g_grid == 0) {
        int dev = 0, cus = 0;
        (void)hipGetDevice(&dev); (void)hipDeviceGetAttribute(&cus, hipDeviceAttributeMultiprocessorCount, dev);
        (void)hipFuncSetAttribute((const void*)mega_fwd, hipFuncAttributeMaxDynamicSharedMemorySize, LDS_BYTES);
        int per_cu = 0; (void)hipOccupancyMaxActiveBlocksPerMultiprocessor(&per_cu, (const void*)mega_fwd, NWAVES * 64, LDS_BYTES);
        (void)hipGetLastError();
        g_grid = cus > 0 ? cus : 256;
        if (per_cu < 1) fprintf(stderr, "kernel_launch: occupancy query says %d blocks/CU\n", per_cu);
    }
    float* out = (float*)d_out; unsigned char* ws = (unsigned char*)d_ws;
    (void)hipMemsetAsync(ws + WS_CTL, 0, CTL_ZERO_BYTES, stream);
    Args base{}; for (int i = 0; i < 22; ++i) base.in[i] = d_in[i]; base.out = out; base.ws = ws;

    launch_mega(base, 0, 14, 0, stream);
}
```

```cpp
#include <hip/hip_runtime.h>
#include <cstdint>
#include <cstdio>
#include <cmath>

typedef unsigned short bf16_t;
constexpr int B_ = 4, S_ = 8192, D_ = 1024, T_ = B_ * S_;
constexpr int PP = 2304;
constexpr int C_CQ = 0, C_CKV = 384, C_KPE = 640, C_FQ = 672, C_FK = 1184, C_FV = 1696, C_FL = 2208, INW = 2216;
constexpr float EPS = 1e-6f;
constexpr float LOG2E = 1.4426950408889634f;
constexpr float C2A = 0.10206207261596577f * LOG2E;
constexpr float C2F = 0.125f * LOG2E;

__device__ __forceinline__ float bf2f(bf16_t v) { return __uint_as_float(((unsigned)v) << 16); }
__device__ __forceinline__ bf16_t f2bf(float f) { unsigned u = __float_as_uint(f); return (bf16_t)((u + 0x7fffu + ((u >> 16) & 1u)) >> 16); }
__device__ __forceinline__ unsigned pk2(float lo, float hi) { return (unsigned)f2bf(lo) | ((unsigned)f2bf(hi) << 16); }
__device__ __forceinline__ float lo2f(unsigned w) { return __uint_as_float(w << 16); }
__device__ __forceinline__ float hi2f(unsigned w) { return __uint_as_float(w & 0xffff0000u); }
__device__ __forceinline__ float wave_sum(float v) {
#pragma unroll
    for (int o = 1; o < 64; o <<= 1) v += __shfl_xor(v, o);
    return v;
}

constexpr size_t MiB = 1u << 20;
constexpr size_t WS_MOD = 1 * MiB;
constexpr size_t WS_FL = 3 * MiB;
constexpr size_t WS_FCUM = 4 * MiB;
constexpr size_t WS_LOGF = 5 * MiB;
constexpr size_t WS_ROPE = 6 * MiB;
constexpr size_t WS_XN = 88 * MiB;
constexpr size_t WS_PROJ = 152 * MiB;
constexpr size_t WS_KVRAW = 296 * MiB;
constexpr size_t WS_QA = 360 * MiB;
constexpr size_t WS_KA = 408 * MiB;

__device__ __forceinline__ void unpack8(const uint4 raw, float* v) {
    v[0] = lo2f(raw.x); v[1] = hi2f(raw.x); v[2] = lo2f(raw.y); v[3] = hi2f(raw.y); v[4] = lo2f(raw.z); v[5] = hi2f(raw.z); v[6] = lo2f(raw.w); v[7] = hi2f(raw.w);
}
__device__ __forceinline__ void fcum_item(const float* LOGF, float* FCUM, int item, int lane) {
    const float4* src = (const float4*)(LOGF + (size_t)item * S_ + 128 * lane);
    float4 v[32]; float tot = 0.f;
#pragma unroll
    for (int i = 0; i < 32; ++i) v[i] = src[i];
#pragma unroll
    for (int i = 0; i < 32; ++i) tot += (v[i].x + v[i].y) + (v[i].z + v[i].w);
    float incl = tot;
#pragma unroll
    for (int o = 1; o < 64; o <<= 1) { const float t = __shfl_up(incl, o); if (lane >= o) incl += t; }
    float run = incl - tot;
    float4* dst = (float4*)(FCUM + (size_t)item * S_ + 128 * lane);
#pragma unroll
    for (int i = 0; i < 32; ++i) { float4 o; run += v[i].x; o.x = run; run += v[i].y; o.y = run; run += v[i].z; o.z = run; run += v[i].w; o.w = run; dst[i] = o; }
}

struct MlaIn { uint4 qn, kn; unsigned q1, q2, k1, k2; float2 cs0, cs1; };
__device__ __forceinline__ void mlaprep_load(MlaIn& M, const bf16_t* QRAW, const bf16_t* KVRAW, const bf16_t* PROJ, const float2* ROPE, int row, int lane) {
    const int h = lane >> 3, p = lane & 7;
    const bf16_t* q = QRAW + (size_t)row * 768 + h * 96; const bf16_t* kp = PROJ + (size_t)row * PP + C_KPE;
    M.qn = *(const uint4*)(q + 8 * p); M.q1 = *(const unsigned*)(q + 64 + 2 * p); M.q2 = *(const unsigned*)(q + 80 + 2 * p);
    M.kn = *(const uint4*)(KVRAW + (size_t)row * 1024 + h * 128 + 8 * p); M.k1 = *(const unsigned*)(kp + 2 * p); M.k2 = *(const unsigned*)(kp + 16 + 2 * p);
    M.cs0 = ROPE[(size_t)row * 16 + 2 * p]; M.cs1 = ROPE[(size_t)row * 16 + 2 * p + 1];
}
__device__ __forceinline__ void mlaprep_finish(const MlaIn& M, bf16_t* QRAW, bf16_t* KA, const float* g_q, const float* g_k, int row, int lane) {
    const int h = lane >> 3, p = lane & 7;
#pragma unroll
    for (int which = 0; which < 2; ++which) {
        const float* g = which == 0 ? g_q : g_k; const float sc = which == 0 ? C2A : 1.f;
        float v[8]; unpack8(which == 0 ? M.qn : M.kn, v); const unsigned r1 = which == 0 ? M.q1 : M.k1, r2 = which == 0 ? M.q2 : M.k2;
        float a0 = lo2f(r1), a1 = hi2f(r1), b0 = lo2f(r2), b1 = hi2f(r2);
        float ss = a0 * a0 + a1 * a1 + b0 * b0 + b1 * b1;
#pragma unroll
        for (int i = 0; i < 8; ++i) ss += v[i] * v[i];
        ss += __shfl_xor(ss, 1); ss += __shfl_xor(ss, 2); ss += __shfl_xor(ss, 4);
        const float r = rsqrtf(ss * (1.f / 96.f) + EPS);
        const float* gn = g + 8 * p;
        a0 *= r * g[64 + 2 * p]; a1 *= r * g[64 + 2 * p + 1]; b0 *= r * g[80 + 2 * p]; b1 *= r * g[80 + 2 * p + 1];
        const float ra0 = a0 * M.cs0.x - b0 * M.cs0.y, rb0 = b0 * M.cs0.x + a0 * M.cs0.y, ra1 = a1 * M.cs1.x - b1 * M.cs1.y, rb1 = b1 * M.cs1.x + a1 * M.cs1.y;
        uint4 o; o.x = pk2(v[0] * r * gn[0] * sc, v[1] * r * gn[1] * sc); o.y = pk2(v[2] * r * gn[2] * sc, v[3] * r * gn[3] * sc);
        o.z = pk2(v[4] * r * gn[4] * sc, v[5] * r * gn[5] * sc); o.w = pk2(v[6] * r * gn[6] * sc, v[7] * r * gn[7] * sc);
        bf16_t* dst = (which == 0 ? QRAW : KA) + (size_t)row * 768 + h * 96;
        *(uint4*)(dst + 8 * p) = o; *(unsigned*)(dst + 64 + 2 * p) = pk2(ra0 * sc, ra1 * sc); *(unsigned*)(dst + 80 + 2 * p) = pk2(rb0 * sc, rb1 * sc);
    }
}
namespace pg8 {
#define PG8_LAS __attribute__((address_space(3)))
typedef unsigned short bf16_t;
typedef short bf16x8 __attribute__((ext_vector_type(8)));
typedef float f32x4 __attribute__((ext_vector_type(4)));
typedef unsigned u32x4 __attribute__((ext_vector_type(4)));
constexpr int BM = 256, BK = 64, HALF = 128, HTB = HALF * BK * 2  , STAGE_BYTES = 8 * HTB, NXCD = 8, WGM = 8;

__host__ __device__ __forceinline__ int lds_byte(int r, int c) { const int st = (r >> 4) * 2 + (c >> 5), rr = r & 15, cc = c & 31, ob = rr * 64 + cc * 2; return st * 1024 + (ob ^ (((ob >> 9) & 1) << 5)); }
__host__ __device__ __forceinline__ void stage_rc(int b, int& R, int& C) { const int st = b / 1024, sb = b % 1024, swz = sb ^ (((sb >> 9) & 1) << 5); R = (st >> 1) * 16 + swz / 64; C = (st & 1) * 32 + (swz % 64) / 2; }
__host__ __device__ __forceinline__ int perm32(int rho) { const int n = rho >> 4, i = rho & 15; return 8 * (i >> 2) + 4 * n + (i & 3); }

struct Unit { int pm, pn; };
struct Gemm { const bf16_t* A; const bf16_t* Bt; int M, N, K, lda; };

struct StaticOrder {
    int nM, nN, nwg, G, c;
    __host__ __device__ void init(int M, int N, int G_, int c_) { nM = M / BM; nN = N / BM; nwg = nM * nN; G = G_; c = c_; }
    __host__ __device__ bool next(int i, Unit& u) const {
        const long L = (long)i * G + c; if (L >= nwg) return false;
        int wgid = (int)L; { const int q = nwg / NXCD, r = nwg % NXCD, xcd = wgid % NXCD, off = wgid / NXCD; wgid = (xcd < r ? xcd * (q + 1) : r * (q + 1) + (xcd - r) * q) + off; }
        const int nig = WGM * nN, gid = wgid / nig, fm = gid * WGM, gsz = (nM - fm) < WGM ? (nM - fm) : WGM;
        u.pm = fm + ((wgid % nig) % gsz); u.pn = (wgid % nig) / gsz; return true;
    }
    __device__ __forceinline__ void a_ready(const Unit&) const {}
    __device__ __forceinline__ void done(const Unit&) const {}
};
__device__ __forceinline__ unsigned cvt_pk_bf16(float lo, float hi) { unsigned r; asm volatile("v_cvt_pk_bf16_f32 %0, %1, %2" : "=v"(r) : "v"(lo), "v"(hi)); return r; }
typedef float f32x2 __attribute__((ext_vector_type(2)));
typedef int i32x4 __attribute__((ext_vector_type(4)));
template <bool I8> struct AccT { typedef f32x4 type; };
template <> struct AccT<true> { typedef i32x4 type; };
__device__ __forceinline__ f32x4 mma16(const bf16x8 b, const bf16x8 a, const f32x4 c) { return __builtin_amdgcn_mfma_f32_16x16x32_bf16(b, a, c, 0, 0, 0); }
__device__ __forceinline__ i32x4 mma16(const bf16x8 b, const bf16x8 a, const i32x4 c) { return __builtin_amdgcn_mfma_i32_16x16x64_i8(__builtin_bit_cast(i32x4, b), __builtin_bit_cast(i32x4, a), c, 0, 0, 0); }
template <class Epi, class Sched, bool ALIGN_EPI = false, bool SP2 = false, bool I8 = false>
__device__ __forceinline__ void gemm_phase(PG8_LAS unsigned char* lds, const Gemm g, const Sched& S, const Epi& E) {
    int tid_ = threadIdx.x; if constexpr (Epi::RESETUP) asm volatile("" : "+v"(tid_));
    const int tid = tid_, wid = __builtin_amdgcn_readfirstlane(tid >> 6), lane = tid & 63, wr = wid >> 2, wc = wid & 3, fr = lane & 15, fq = lane >> 4;
    const int K = g.K, nt = K / BK;
    unsigned voffA[2], voffB[2]; int aoff, boff;
#define PG8_LANE_SETUP do { int t_ = tid; asm volatile("" : "+v"(t_)); const int l_ = t_ & 63, fr_ = l_ & 15, fq_ = l_ >> 4; \
        _Pragma("unroll") for (int i = 0; i < 2; ++i) { int R, C; stage_rc(t_ * 16 + i * 8192, R, C); const int Rb = Epi::PERM ? ((R & ~31) + perm32(R & 31)) : R; \
            voffA[i] = (unsigned)(R * g.lda + C) * 2u; voffB[i] = (unsigned)(Rb * K + C) * 2u; } \
        aoff = lds_byte(wr * 64 + fr_, fq_ * 8); boff = lds_byte(wc * 32 + fr_, fq_ * 8); } while (0)
    PG8_LANE_SETUP;
    const size_t kstep = (size_t)(BK * 2);
    const size_t hstepA = (size_t)HALF * g.lda * 2, hstepB = (size_t)HALF * K * 2;
    const size_t tstepA = 2 * hstepA, tstepB = 2 * hstepB;
    const unsigned ldsw = (unsigned)wid * 1024u;
#define PG8_SA(b, h) (((b) * 2 + (h)) * HTB)
#define PG8_SB(b, h) ((4 + (b) * 2 + (h)) * HTB)
#define PG8_STAGE(bufoff, gbase, voff) do { _Pragma("unroll") for (int _i = 0; _i < 2; ++_i) \
        __builtin_amdgcn_global_load_lds((const unsigned*)((const char*)(gbase) + (voff)[_i]), (PG8_LAS unsigned*)(lds + (bufoff) + ldsw + _i * 8192), 16, 0, 0); } while (0)
#define PG8_LDA(dst, b, h) do { _Pragma("unroll") for (int m = 0; m < 4; ++m) _Pragma("unroll") for (int k = 0; k < 2; ++k) dst[m][k] = *(const PG8_LAS bf16x8*)(lds + PG8_SA(b, h) + aoff + m * 2048 + k * 1024); } while (0)
#define PG8_LDB(dst, b, h) do { _Pragma("unroll") for (int n = 0; n < 2; ++n) _Pragma("unroll") for (int k = 0; k < 2; ++k) dst[n][k] = *(const PG8_LAS bf16x8*)(lds + PG8_SB(b, h) + boff + n * 2048 + k * 1024); } while (0)
#define PG8_MMA(ai, bj, At, Bt) do { __builtin_amdgcn_s_setprio(1); _Pragma("unroll") for (int m = 0; m < 4; ++m) _Pragma("unroll") for (int n = 0; n < 2; ++n) _Pragma("unroll") for (int k = 0; k < 2; ++k) \
        acc[ai][bj][m][n] = mma16(Bt[n][k], At[m][k], acc[ai][bj][m][n]); __builtin_amdgcn_s_setprio(0); } while (0)
#define PG8_WAIT_V(n) asm volatile("s_waitcnt vmcnt(" #n ")" ::: "memory")
#define PG8_WAIT_L(n) asm volatile("s_waitcnt lgkmcnt(" #n ")" ::: "memory")
#define PG8_BAR __builtin_amdgcn_s_barrier()
#define PG8_SCHED __builtin_amdgcn_sched_barrier(0)
    Unit cur, nxt; int ui = 0;
    if (!S.next(0, cur)) return;
    typedef typename AccT<I8>::type accv; accv acc[2][2][4][2];
#pragma unroll
    for (int a = 0; a < 2; ++a)
#pragma unroll
        for (int b = 0; b < 2; ++b)
#pragma unroll
            for (int m = 0; m < 4; ++m)
#pragma unroll
                for (int n = 0; n < 2; ++n) acc[a][b][m][n] = accv{};
    bf16x8 At[4][2], B0[2][2], B1[2][2];
    const char* cA = (const char*)g.A + (size_t)cur.pm * tstepA; const char* cB = (const char*)g.Bt + (size_t)cur.pn * tstepB;
    S.a_ready(cur);
    if constexpr (SP2) {
        PG8_STAGE(PG8_SB(0, 0), cB, voffB); PG8_STAGE(PG8_SB(0, 1), cB + hstepB, voffB); PG8_STAGE(PG8_SA(0, 0), cA, voffA); PG8_STAGE(PG8_SA(0, 1), cA + hstepA, voffA);
        if (wr == 1) PG8_BAR;
        PG8_WAIT_V(2); PG8_BAR;
        PG8_STAGE(PG8_SB(1, 0), cB + kstep, voffB); PG8_STAGE(PG8_SA(1, 0), cA + kstep, voffA); PG8_STAGE(PG8_SB(1, 1), cB + hstepB + kstep, voffB);
        PG8_WAIT_V(6); PG8_BAR;
    } else {
        PG8_STAGE(PG8_SB(0, 0), cB, voffB); PG8_STAGE(PG8_SA(0, 0), cA, voffA); PG8_STAGE(PG8_SB(0, 1), cB + hstepB, voffB); PG8_STAGE(PG8_SA(0, 1), cA + hstepA, voffA);
        if (wr == 1) PG8_BAR;
        PG8_WAIT_V(4); PG8_BAR;
        PG8_STAGE(PG8_SB(1, 0), cB + kstep, voffB); PG8_STAGE(PG8_SA(1, 0), cA + kstep, voffA); PG8_STAGE(PG8_SB(1, 1), cB + hstepB + kstep, voffB);
        PG8_WAIT_V(6); PG8_BAR;
    }
    for (;;) {
        const bool has_next = S.next(ui + 1, nxt);
        const char* nA = has_next ? (const char*)g.A + (size_t)nxt.pm * tstepA : cA; const char* nB = has_next ? (const char*)g.Bt + (size_t)nxt.pn * tstepB : cB;
        for (int t = 0; t < nt; t += 2) {
            const bool last = (t == nt - 2);
            const char* a1 = cA + (size_t)(t + 1) * kstep;
            const char* a2 = last ? nA : cA + (size_t)(t + 2) * kstep; const char* b2 = last ? nB : cB + (size_t)(t + 2) * kstep;
            const char* a3 = a2 + kstep; const char* b3 = b2 + kstep;
            if (last && has_next) S.a_ready(nxt);
            if constexpr (SP2) {
            PG8_LDB(B0, 0, 0); PG8_LDB(B1, 0, 1); PG8_SCHED; PG8_LDA(At, 0, 0); PG8_STAGE(PG8_SA(1, 1), a1 + hstepA, voffA);
            PG8_WAIT_V(8); PG8_WAIT_L(0); PG8_BAR; PG8_MMA(0, 0, At, B0); PG8_MMA(0, 1, At, B1); PG8_BAR; PG8_SCHED;
            PG8_LDA(At, 0, 1); PG8_STAGE(PG8_SB(0, 0), b2, voffB); PG8_STAGE(PG8_SB(0, 1), b2 + hstepB, voffB); PG8_STAGE(PG8_SA(0, 0), a2, voffA);
            PG8_WAIT_V(8); PG8_WAIT_L(0); PG8_BAR; PG8_MMA(1, 0, At, B0); PG8_MMA(1, 1, At, B1); PG8_BAR; PG8_SCHED;
            PG8_LDB(B0, 1, 0); PG8_LDB(B1, 1, 1); PG8_SCHED; PG8_LDA(At, 1, 0); PG8_STAGE(PG8_SA(0, 1), a2 + hstepA, voffA);
            PG8_WAIT_V(8); PG8_WAIT_L(0); PG8_BAR; PG8_MMA(0, 0, At, B0); PG8_MMA(0, 1, At, B1); PG8_BAR; PG8_SCHED;
            PG8_LDA(At, 1, 1); PG8_STAGE(PG8_SB(1, 0), b3, voffB); PG8_STAGE(PG8_SB(1, 1), b3 + hstepB, voffB); PG8_STAGE(PG8_SA(1, 0), a3, voffA);
            PG8_WAIT_V(8); PG8_WAIT_L(0); PG8_BAR; PG8_MMA(1, 0, At, B0); PG8_MMA(1, 1, At, B1); PG8_BAR; PG8_SCHED;
            } else {
            PG8_LDB(B0, 0, 0); PG8_SCHED; PG8_LDA(At, 0, 0); PG8_STAGE(PG8_SA(1, 1), a1 + hstepA, voffA);
            PG8_WAIT_L(8); PG8_BAR; PG8_WAIT_L(0); PG8_MMA(0, 0, At, B0); PG8_BAR; PG8_SCHED;
            PG8_LDB(B1, 0, 1); PG8_STAGE(PG8_SB(0, 0), b2, voffB);
            PG8_BAR; PG8_WAIT_L(0); PG8_MMA(0, 1, At, B1); PG8_BAR;
            PG8_LDA(At, 0, 1); PG8_STAGE(PG8_SA(0, 0), a2, voffA);
            PG8_BAR; PG8_WAIT_L(0); PG8_MMA(1, 0, At, B0); PG8_BAR; PG8_SCHED;
            PG8_STAGE(PG8_SB(0, 1), b2 + hstepB, voffB);
            PG8_WAIT_V(6); PG8_BAR; PG8_MMA(1, 1, At, B1); PG8_BAR;
            PG8_LDB(B0, 1, 0); PG8_SCHED; PG8_LDA(At, 1, 0); PG8_STAGE(PG8_SA(0, 1), a2 + hstepA, voffA);
            PG8_WAIT_L(8); PG8_BAR; PG8_WAIT_L(0); PG8_MMA(0, 0, At, B0); PG8_BAR; PG8_SCHED;
            PG8_LDB(B1, 1, 1); PG8_STAGE(PG8_SB(1, 0), b3, voffB);
            PG8_BAR; PG8_WAIT_L(0); PG8_MMA(0, 1, At, B1); PG8_BAR;
            PG8_LDA(At, 1, 1); PG8_STAGE(PG8_SA(1, 0), a3, voffA);
            PG8_BAR; PG8_WAIT_L(0); PG8_MMA(1, 0, At, B0); PG8_BAR; PG8_SCHED;
            PG8_STAGE(PG8_SB(1, 1), b3 + hstepB, voffB);
            PG8_WAIT_V(6); PG8_BAR; PG8_MMA(1, 1, At, B1); PG8_BAR;
            }
        }
        if constexpr (ALIGN_EPI) { if (wr == 0) PG8_BAR; }
        if constexpr (!Epi::AFTER_DRAIN) {
            if constexpr (Epi::RESETUP) { int t_ = tid; asm volatile("" : "+v"(t_)); E(acc, cur, wr, wc, t_ & 15, (t_ & 63) >> 4); }
            else E(acc, cur, wr, wc, fr, fq);
            S.done(cur); }
        if (!has_next) break;
#pragma unroll
        for (int a = 0; a < 2; ++a)
#pragma unroll
            for (int b = 0; b < 2; ++b)
#pragma unroll
                for (int m = 0; m < 4; ++m)
#pragma unroll
                    for (int n = 0; n < 2; ++n) acc[a][b][m][n] = accv{};
        cur = nxt; cA = nA; cB = nB; ++ui;
        if constexpr (Epi::RESETUP) PG8_LANE_SETUP;
        if constexpr (ALIGN_EPI) { if (wr == 1) PG8_BAR; }
    }
    PG8_WAIT_V(0);
    if constexpr (!ALIGN_EPI) { if (wr == 0) PG8_BAR; }
    PG8_BAR;
    if constexpr (Epi::AFTER_DRAIN) { E.fused(acc, cur, wr, wc, fr, fq, lds, wid, lane); S.done(cur); }
#undef PG8_LANE_SETUP
#undef PG8_SA
#undef PG8_SB
#undef PG8_STAGE
#undef PG8_LDA
#undef PG8_LDB
#undef PG8_MMA
#undef PG8_WAIT_V
#undef PG8_WAIT_L
#undef PG8_BAR
#undef PG8_SCHED
}
}


#define GAS __attribute__((address_space(1)))
#define LAS __attribute__((address_space(3)))
typedef float f32x4 __attribute__((ext_vector_type(4)));
typedef unsigned u32x4 __attribute__((ext_vector_type(4)));
#define XB_TMO      128
#define XB_XCNT(j)  (256  + 64 * (j))
#define XB_XSUB(j)  (1280 + 64 * (j))
#define XB_XGEN(j)  (2304 + 64 * (j))
#define XB_TOP      3328
#define XB_TOPGEN   3392
#define XCD_BAR_WORDS 3456
#define XB_SPIN_CAP (1u << 18)

__device__ __forceinline__ unsigned xb_ld(unsigned* p)              { return __hip_atomic_load(p, __ATOMIC_RELAXED, __HIP_MEMORY_SCOPE_AGENT); }
__device__ __forceinline__ unsigned xb_add(unsigned* p, unsigned v) { return __hip_atomic_fetch_add(p, v, __ATOMIC_RELAXED, __HIP_MEMORY_SCOPE_AGENT); }
__device__ __forceinline__ unsigned xb_xcc_id() { return (unsigned)__builtin_amdgcn_s_getreg((3 << 11) | 20) & 0xFu; }
#define XB_SPIN(cond, bar) do { unsigned _sp = 0; while (cond) { __builtin_amdgcn_s_sleep(1); \
    if ((++_sp & 255u) == 0u) { if (xb_ld(&(bar)[XB_TMO])) break; if (_sp > XB_SPIN_CAP) { atomicAdd(&(bar)[XB_TMO], 1u); break; } } } } while (0)

struct XcdBarrier {
    unsigned* bar; unsigned x;
    volatile LAS unsigned* st;
};

__device__ __forceinline__ XcdBarrier xcd_barrier_post(unsigned* bar, volatile LAS unsigned* st) {
    XcdBarrier b; b.bar = bar; b.x = xb_xcc_id(); b.st = st;
    if (threadIdx.x == 0) (void)xb_add(&bar[XB_XCNT(b.x)], 1u);
    return b;
}
__device__ __forceinline__ void xcd_barrier_complete(unsigned* bar, unsigned x, unsigned& nloc, unsigned& nx) {
    const unsigned G = gridDim.x * gridDim.y * gridDim.z;
    unsigned sum, cnt, mine, sp = 0u;
    for (;;) {
        sum = 0u; cnt = 0u; mine = 0u;
#pragma unroll
        for (unsigned j = 0; j < 16; ++j) { const unsigned c = xb_ld(&bar[XB_XCNT(j)]); sum += c; cnt += (c > 0u) ? 1u : 0u; mine = (j == x) ? c : mine; }
        if (sum == G) break;
        __builtin_amdgcn_s_sleep(1);
        if ((++sp & 255u) == 0u) { if (xb_ld(&bar[XB_TMO])) break; if (sp > XB_SPIN_CAP) { atomicAdd(&bar[XB_TMO], 1u); break; } }
    }
    nloc = mine > 0u ? mine : 1u; nx = cnt > 0u ? cnt : 1u;
}

__device__ __forceinline__ void xcd_barrier(const XcdBarrier& b) {
    asm volatile("s_waitcnt vmcnt(0)" ::: "memory");
    __syncthreads();
    if (threadIdx.x == 0) {
        unsigned* bar = b.bar;
        __builtin_amdgcn_s_waitcnt(0);
        unsigned nloc = b.st[0], nx = b.st[1];
        if (nloc == 0u) { xcd_barrier_complete(bar, b.x, nloc, nx); b.st[0] = nloc; b.st[1] = nx; }
        const unsigned old = xb_add(&bar[XB_XSUB(b.x)], 1u);
        const unsigned gen = old / nloc;
        if (old + 1u == (gen + 1u) * nloc) {
            __builtin_amdgcn_fence(__ATOMIC_RELEASE, "agent");
            asm volatile("s_waitcnt vmcnt(0)" ::: "memory");
            const unsigned og = xb_add(&bar[XB_TOP], 1u);
            const unsigned tg = og / nx;
            if (og + 1u == (tg + 1u) * nx) xb_add(&bar[XB_TOPGEN], 1u);
            else XB_SPIN(xb_ld(&bar[XB_TOPGEN]) == tg, bar);
            __builtin_amdgcn_fence(__ATOMIC_ACQUIRE, "agent");
            xb_add(&bar[XB_XGEN(b.x)], 1u);
            asm volatile("s_waitcnt vmcnt(0)" ::: "memory");
        } else {
            XB_SPIN(xb_ld(&bar[XB_XGEN(b.x)]) == gen, bar);
            __builtin_amdgcn_fence(__ATOMIC_ACQUIRE, "agent");
            asm volatile("s_waitcnt vmcnt(0)" ::: "memory");
        }
    }
    __syncthreads();
}


constexpr int NWAVES = 8;
constexpr int RING_BYTES = 131072, LDSCTL_OFF = RING_BYTES, MISC_OFF = LDSCTL_OFF + 320, LDS_BYTES = 147456;
constexpr size_t WS_CTL = 0, CTL_ZERO_BYTES = 1 * MiB;
constexpr int CW_BAR = 4096, N_BAR_REGIONS = 16;
static_assert((CW_BAR + N_BAR_REGIONS * XCD_BAR_WORDS) * 4 <= (int)CTL_ZERO_BYTES, "barrier words inside the memset region");
constexpr size_t WS_WIN = 10 * MiB;
constexpr size_t WS_WUQ = 15 * MiB;
constexpr size_t WS_WUKV = 16 * MiB;
constexpr size_t WS_WO = 17 * MiB;
constexpr size_t WS_WPQ = 19 * MiB;
constexpr size_t WS_SK = 23 * MiB;
constexpr size_t WS_U16 = 24 * MiB;
constexpr size_t WS_V16 = 56 * MiB;


namespace att {
typedef short bf16x8 __attribute__((ext_vector_type(8)));
typedef short s16x4 __attribute__((ext_vector_type(4)));
typedef float f32x16 __attribute__((ext_vector_type(16)));
constexpr int LK = 0, KSLOT = 12288, LV = 2 * KSLOT, VSLOT = 8192, LB = LV + 2 * VSLOT, BSLOT = 256, LWS = LB + 2 * BSLOT, LOST = LWS + 8 * 256, ATT_LDS = LOST + 8 * 4096;
static_assert(ATT_LDS <= 131072, "attention scratch fits the ring region");
struct Desc { const bf16_t* Q; int pq; const bf16_t* K; int pk; const bf16_t* V; int pv; bf16_t* O; int po; const float* FC; const float* QS; const float2* RP; };

__device__ __forceinline__ int crow(int r, int hi) { return (r & 3) + 8 * (r >> 2) + 4 * hi; }
__device__ __forceinline__ float xmax32(float v) { auto rr = __builtin_amdgcn_permlane32_swap(__float_as_uint(v), __float_as_uint(v), false, false); return fmaxf(__uint_as_float(rr[0]), __uint_as_float(rr[1])); }
__device__ __forceinline__ float xsum32(float v) { auto rr = __builtin_amdgcn_permlane32_swap(__float_as_uint(v), __float_as_uint(v), false, false); return __uint_as_float(rr[0]) + __uint_as_float(rr[1]); }
__device__ __forceinline__ unsigned cvtpk(float lo, float hi) { typedef float f2 __attribute__((ext_vector_type(2))); typedef __bf16 b2 __attribute__((ext_vector_type(2))); f2 v = {lo, hi}; b2 b = __builtin_convertvector(v, b2); return __builtin_bit_cast(unsigned, b); }
typedef short v4i16_t __attribute__((ext_vector_type(4)));
__device__ __forceinline__ s16x4 vtr(LAS const unsigned char* p) { return __builtin_bit_cast(s16x4, __builtin_amdgcn_ds_read_tr16_b64_v4i16((LAS v4i16_t*)p)); }

template <int KS, bool BIAS>
__device__ __forceinline__ void attn_unit(const Desc& d, int qb, int j0, LAS unsigned char* shm) {
    const int tid = threadIdx.x, lane = tid & 63, r32 = lane & 31, hi = lane >> 5; const int wid = __builtin_amdgcn_readfirstlane(tid >> 6);
    const int q0 = qb * 256, NT = (q0 + 256) / 64;
    LAS float* wsf = (LAS float*)(shm + LWS) + wid * 64;
    bf16x8 qr[KS];
    { const bf16_t* qp = d.Q + (size_t)(q0 + wid * 32 + r32) * d.pq + hi * 8;
#pragma unroll
      for (int d0 = 0; d0 < KS; ++d0) qr[d0] = *(const bf16x8*)(qp + d0 * 16); }
    if (!BIAS) {
        const int qrow = q0 + wid * 32 + r32;
        const float2 ss = *(const float2*)(d.QS + (size_t)qrow * 16);
        const f32x4* cp = (const f32x4*)(d.RP + (size_t)qrow * 16 + hi * 8);
        const f32x4 cs0 = cp[0], cs1 = cp[1], cs2 = cp[2], cs3 = cp[3];
        const float rr = rsqrtf((ss.x + ss.y) * (1.f / 96.f) + EPS) * C2A;
#pragma unroll
        for (int d0 = 0; d0 < 4; ++d0) { const u32x4 w = __builtin_bit_cast(u32x4, qr[d0]); u32x4 o;
#pragma unroll
            for (int i = 0; i < 4; ++i) o[i] = cvtpk(lo2f(w[i]) * rr, hi2f(w[i]) * rr);
            qr[d0] = __builtin_bit_cast(bf16x8, o); }
        { const u32x4 wa = __builtin_bit_cast(u32x4, qr[4]), wb = __builtin_bit_cast(u32x4, qr[5]); u32x4 oa, ob;
#pragma unroll
          for (int i = 0; i < 4; ++i) { const f32x4 c = i == 0 ? cs0 : i == 1 ? cs1 : i == 2 ? cs2 : cs3;
              const float a0 = lo2f(wa[i]) * rr, a1 = hi2f(wa[i]) * rr, b0 = lo2f(wb[i]) * rr, b1 = hi2f(wb[i]) * rr;
              oa[i] = cvtpk(a0 * c[0] - b0 * c[1], a1 * c[2] - b1 * c[3]); ob[i] = cvtpk(b0 * c[0] + a0 * c[1], b1 * c[2] + a1 * c[3]); }
          qr[4] = __builtin_bit_cast(bf16x8, oa); qr[5] = __builtin_bit_cast(bf16x8, ob); }
    }
    const float fcref = BIAS ? d.FC[q0] : 0.f;
    const bf16_t* ksrc0 = d.K + (size_t)lane * d.pk + wid * 8;
    const bf16_t* ksrc1 = d.K + (size_t)lane * d.pk + (8 + wid) * 8;
    const bf16_t* vsrc = d.V + (size_t)(16 * (wid & 3) + (lane >> 2)) * d.pv + (wid >> 2) * 32 + (lane & 3) * 8;
    const int kdst0 = LK + wid * 1024 + lane * 16, kdst1 = LK + (8 + wid) * 1024 + lane * 16, vdst = LV + wid * 1024 + lane * 16;
    const bool k2 = (KS > 4) && (wid < 2 * KS - 8);
    u32x4 kr0, kr1, vr; float br = 0.f;
#define ATT_LOAD(t, slot) do { \
        __builtin_amdgcn_global_load_lds((const unsigned*)(ksrc0 + (size_t)(t) * 64 * d.pk), (LAS unsigned*)(shm + LK + wid * 1024 + (slot) * KSLOT), 16, 0, 0); \
        if (k2) __builtin_amdgcn_global_load_lds((const unsigned*)(ksrc1 + (size_t)(t) * 64 * d.pk), (LAS unsigned*)(shm + LK + (8 + wid) * 1024 + (slot) * KSLOT), 16, 0, 0); \
        __builtin_amdgcn_global_load_lds((const unsigned*)(vsrc + (size_t)(t) * 64 * d.pv), (LAS unsigned*)(shm + LV + wid * 1024 + (slot) * VSLOT), 16, 0, 0); \
        if (BIAS && wid == 4) br = d.FC[(t) * 64 + lane]; } while (0)
#define ATT_WRITE(slot) do { if (BIAS && wid == 4) *(LAS float*)(shm + LB + (slot) * BSLOT + lane * 4) = (fcref - br) * LOG2E; } while (0)
    f32x16 o0, o1, negm;
#pragma unroll
    for (int r = 0; r < 16; ++r) { o0[r] = 0.f; o1[r] = 0.f; negm[r] = 0.f; }
    float mref = 0.f, l = 0.f;
    constexpr float THR = BIAS ? 40.f : 8.f;
    const int qrel = wid * 32 + r32;
    const int kfrag = LK + hi * 1024 + r32 * 16;
    const int vfrag = LV + ((lane >> 4) & 1) * 32 + (lane & 3) * 8 + (4 * hi + ((lane & 15) >> 2)) * 64;
    ATT_LOAD(j0, 0); ATT_WRITE(0);
    __syncthreads();
    for (int t = j0; t < NT; ++t) {
        const int slot = (t - j0) & 1;
        if (t + 1 < NT) ATT_LOAD(t + 1, slot ^ 1);
        const int jb = t - (NT - 4);
        if (!(jb >= 0 && 64 * jb > 32 * wid + 31)) {
            f32x16 p0, p1;
            if (BIAS) {
                LAS const unsigned char* bp = shm + LB + slot * BSLOT + 16 * hi;
#pragma unroll
                for (int g = 0; g < 4; ++g) { const f32x4 a = *(LAS const f32x4*)(bp + 32 * g), b = *(LAS const f32x4*)(bp + 128 + 32 * g);
#pragma unroll
                    for (int i = 0; i < 4; ++i) { p0[4 * g + i] = a[i] + negm[4 * g + i]; p1[4 * g + i] = b[i] + negm[4 * g + i]; } }
            } else { p0 = negm; p1 = negm; }
            LAS const unsigned char* kp = shm + kfrag + slot * KSLOT;
#pragma unroll
            for (int d0 = 0; d0 < KS; ++d0) {
                const bf16x8 a0 = *(LAS const bf16x8*)(kp + d0 * 2048), a1 = *(LAS const bf16x8*)(kp + d0 * 2048 + 512);
                p0 = __builtin_amdgcn_mfma_f32_32x32x16_bf16(a0, qr[d0], p0, 0, 0, 0);
                p1 = __builtin_amdgcn_mfma_f32_32x32x16_bf16(a1, qr[d0], p1, 0, 0, 0);
            }
            if (jb >= 0) {
                const int kb = 64 * jb + 4 * hi;
#pragma unroll
                for (int r = 0; r < 16; ++r) { const int kv = kb + (r & 3) + 8 * (r >> 2); if (kv > qrel) p0[r] = -INFINITY; if (kv + 32 > qrel) p1[r] = -INFINITY; }
            }
            float ra = __builtin_fmaxf(__builtin_fmaxf(p0[0], p0[1]), p1[0]), rb = __builtin_fmaxf(__builtin_fmaxf(p0[2], p0[3]), p1[1]);
            ra = __builtin_fmaxf(__builtin_fmaxf(ra, p1[2]), p1[3]);
#pragma unroll
            for (int r = 4; r < 16; r += 4) { ra = __builtin_fmaxf(__builtin_fmaxf(ra, p0[r]), p0[r + 1]); rb = __builtin_fmaxf(__builtin_fmaxf(rb, p0[r + 2]), p0[r + 3]);
                ra = __builtin_fmaxf(__builtin_fmaxf(ra, p1[r]), p1[r + 1]); rb = __builtin_fmaxf(__builtin_fmaxf(rb, p1[r + 2]), p1[r + 3]); }
            const float rm = xmax32(__builtin_fmaxf(ra, rb));
            if (__any(rm > THR) || t == j0) {
                const float dl = t == j0 ? rm : __builtin_fmaxf(rm, 0.f);
                mref += dl;
#pragma unroll
                for (int r = 0; r < 16; ++r) { p0[r] -= dl; p1[r] -= dl; negm[r] = -mref; }
                if (t != j0) {
                    const float alpha = __builtin_amdgcn_exp2f(-dl);
                    l *= alpha;
                    if (hi == 0) wsf[r32] = alpha;
#pragma unroll
                    for (int g = 0; g < 4; ++g) { const f32x4 a = *(LAS const f32x4*)(wsf + 8 * g + 4 * hi);
#pragma unroll
                        for (int i = 0; i < 4; ++i) { o0[4 * g + i] *= a[i]; o1[4 * g + i] *= a[i]; } }
                }
            }
            float s0 = 0.f, s1 = 0.f, s2 = 0.f, s3 = 0.f;
#pragma unroll
            for (int r = 0; r < 16; r += 2) { p0[r] = __builtin_amdgcn_exp2f(p0[r]); p0[r + 1] = __builtin_amdgcn_exp2f(p0[r + 1]); p1[r] = __builtin_amdgcn_exp2f(p1[r]); p1[r + 1] = __builtin_amdgcn_exp2f(p1[r + 1]);
                s0 += p0[r]; s1 += p0[r + 1]; s2 += p1[r]; s3 += p1[r + 1]; }
            l += (s0 + s1) + (s2 + s3);
            LAS const unsigned char* vp = shm + vfrag + slot * VSLOT;
#pragma unroll
            for (int ks = 0; ks < 4; ++ks) {
                const f32x16& pp = ks < 2 ? p0 : p1; const int bq = (ks & 1) * 8;
                u32x4 pw; pw.x = cvtpk(pp[bq], pp[bq + 1]); pw.y = cvtpk(pp[bq + 2], pp[bq + 3]); pw.z = cvtpk(pp[bq + 4], pp[bq + 5]); pw.w = cvtpk(pp[bq + 6], pp[bq + 7]);
                const bf16x8 pa = __builtin_bit_cast(bf16x8, pw);
                const s16x4 l0 = vtr(vp + ks * 1024), h0 = vtr(vp + ks * 1024 + 512), l1 = vtr(vp + 4096 + ks * 1024), h1 = vtr(vp + 4096 + ks * 1024 + 512);
                const bf16x8 v0 = {l0[0], l0[1], l0[2], l0[3], h0[0], h0[1], h0[2], h0[3]}, v1 = {l1[0], l1[1], l1[2], l1[3], h1[0], h1[1], h1[2], h1[3]};
                o0 = __builtin_amdgcn_mfma_f32_32x32x16_bf16(pa, v0, o0, 0, 0, 0);
                o1 = __builtin_amdgcn_mfma_f32_32x32x16_bf16(pa, v1, o1, 0, 0, 0);
            }
        }
        if (t + 1 < NT) ATT_WRITE(slot ^ 1);
        __syncthreads();
    }
#undef ATT_LOAD
#undef ATT_WRITE
    l = xsum32(l);
    if (hi == 0) wsf[32 + r32] = l;
    float rli[16];
#pragma unroll
    for (int g = 0; g < 4; ++g) { const f32x4 a = *(LAS const f32x4*)(wsf + 32 + 8 * g + 4 * hi);
#pragma unroll
        for (int i = 0; i < 4; ++i) rli[4 * g + i] = 1.f / a[i]; }
    LAS bf16_t* stg = (LAS bf16_t*)(shm + LOST) + wid * 2048;
#pragma unroll
    for (int r = 0; r < 16; ++r) { const int orow = crow(r, hi); stg[orow * 64 + r32] = f2bf(o0[r] * rli[r]); stg[orow * 64 + 32 + r32] = f2bf(o1[r] * rli[r]); }
    bf16_t* Ow = d.O + (size_t)(q0 + wid * 32) * d.po;
#pragma unroll
    for (int i = 0; i < 4; ++i) { const int row = i * 8 + (lane >> 3), ch = lane & 7; const u32x4 v = *(LAS const u32x4*)(stg + row * 64 + ch * 8); *(u32x4*)(Ow + (size_t)row * d.po + ch * 8) = v; }
    __syncthreads();
}
}


namespace pk {
typedef short bf16x8 __attribute__((ext_vector_type(8)));
typedef float f32x16 __attribute__((ext_vector_type(16)));
template <int I> struct COff { static constexpr int v = COff<I - 1>::v + 16 / I; };
template <> struct COff<0> { static constexpr int v = 0; };
static_assert(COff<16>::v == 50, "50 candidates can reach the top 16 of a sorted 16 x 16 sum grid");
__device__ __forceinline__ void cef(float& a, float& b) { const float mx = fmaxf(a, b), mn = fminf(a, b); a = mx; b = mn; }
__device__ __forceinline__ void sort16f(float (&v)[16]) {
#pragma unroll
    for (int k = 2; k <= 16; k <<= 1)
#pragma unroll
        for (int j = k >> 1; j >= 1; j >>= 1)
#pragma unroll
            for (int i = 0; i < 16; ++i) { const int l = i ^ j; if (l > i) { if ((i & k) == 0) cef(v[i], v[l]); else cef(v[l], v[i]); } }
}
__device__ __forceinline__ void merge16f(float (&a)[16], const float (&b)[16]) {
#pragma unroll
    for (int i = 0; i < 16; ++i) a[i] = fmaxf(a[i], b[15 - i]);
#pragma unroll
    for (int j = 8; j >= 1; j >>= 1)
#pragma unroll
        for (int i = 0; i < 16; ++i) { const int l = i ^ j; if (l > i) cef(a[i], a[l]); }
}
__device__ __forceinline__ float keyf(float v, unsigned code, unsigned mask) { return __uint_as_float((__float_as_uint(v) & mask) | code); }
template <int I> __device__ __forceinline__ void fill_candf(float (&c)[64], const float (&s1)[16], const float (&s2)[16]) {
    if constexpr (I < 16) {
#pragma unroll
        for (int j = 0; j < 16 / (I + 1); ++j) c[COff<I>::v + j] = keyf(s1[I] + s2[j], (unsigned)(255 - (I * 16 + j)), 0xFFFFFF00u);
        fill_candf<I + 1>(c, s1, s2);
    }
}
__device__ __forceinline__ void head_half(const bf16_t* QP, const bf16_t* SK, int t, int h, int p, int r32, int hi, const unsigned (&lowc)[16], float (&own)[16]) {
    const bf16_t* qrow = QP + (size_t)t * 2048 + h * 256 + p * 128 + hi * 8;
    bf16x8 qf[8];
#pragma unroll
    for (int d0 = 0; d0 < 8; ++d0) qf[d0] = *(const bf16x8*)(qrow + d0 * 16);
    const bf16_t* skb = SK + (size_t)((h * 2 + p) * 128 + r32) * 128 + hi * 8;
#pragma unroll 1
    for (int kt = 0; kt < 4; ++kt) {
        f32x16 acc;
#pragma unroll
        for (int r = 0; r < 16; ++r) acc[r] = 0.f;
#pragma unroll
        for (int d0 = 0; d0 < 8; ++d0) { const bf16x8 a = *(const bf16x8*)(skb + (size_t)kt * 32 * 128 + d0 * 16); acc = __builtin_amdgcn_mfma_f32_32x32x16_bf16(a, qf[d0], acc, 0, 0, 0); }
        float cur[16];
#pragma unroll
        for (int r = 0; r < 16; ++r) cur[r] = keyf(acc[r], lowc[r] - 32u * (unsigned)kt, 0xFFFFFF80u);
        sort16f(cur);
        if (kt == 0) {
#pragma unroll
            for (int r = 0; r < 16; ++r) own[r] = cur[r];
        } else merge16f(own, cur);
    }
}
__device__ __forceinline__ void topk_item2(const bf16_t* QP, const bf16_t* SK, int* EID, float* GATE, int item, int lane) {
    const int tg = item >> 2, hp = item & 3, r32 = lane & 31, hi = lane >> 5;
    const int t = tg * 32 + r32;
    unsigned lowc[16];
#pragma unroll
    for (int r = 0; r < 16; ++r) lowc[r] = (unsigned)(127 - ((r & 3) + 8 * (r >> 2)) - 4 * hi);
    float finA[16], finB[16];
#pragma unroll
    for (int hh = 0; hh < 2; ++hh) {
        const int h = 2 * hp + hh;
        float own0[16], own1[16];
        head_half(QP, SK, t, h, 0, r32, hi, lowc, own0);
        head_half(QP, SK, t, h, 1, r32, hi, lowc, own1);
        float fin[16], oth[16];
#pragma unroll
        for (int i = 0; i < 16; ++i) { auto rr = __builtin_amdgcn_permlane32_swap(__float_as_uint(own0[i]), __float_as_uint(own1[i]), false, false); fin[i] = __uint_as_float(rr[0]); oth[i] = __uint_as_float(rr[1]); }
        merge16f(fin, oth);
#pragma unroll
        for (int i = 0; i < 16; ++i) { if (hh == 0) finA[i] = fin[i]; else finB[i] = fin[i]; }
    }
    float s1[16], s2[16];
#pragma unroll
    for (int i = 0; i < 16; ++i) { auto rr = __builtin_amdgcn_permlane32_swap(__float_as_uint(finA[i]), __float_as_uint(finB[i]), false, false); s1[i] = __uint_as_float(rr[0]); s2[i] = __uint_as_float(rr[1]); }
    const int h = 2 * hp + hi;
    unsigned long long i1lo = 0ull, i1hi = 0ull, i2lo = 0ull, i2hi = 0ull;
#pragma unroll
    for (int i = 0; i < 16; ++i) {
        const unsigned long long a = (unsigned long long)(127u - (__float_as_uint(s1[i]) & 0x7Fu)) << (8 * (i & 7)), b = (unsigned long long)(127u - (__float_as_uint(s2[i]) & 0x7Fu)) << (8 * (i & 7));
        if (i < 8) { i1lo |= a; i2lo |= b; } else { i1hi |= a; i2hi |= b; } }
    float c64[64];
#pragma unroll
    for (int i = 50; i < 64; ++i) c64[i] = -INFINITY;
    fill_candf<0>(c64, s1, s2);
    float top[16];
    {
        float g1[16], g2[16], g3[16];
#pragma unroll
        for (int i = 0; i < 16; ++i) { top[i] = c64[i]; g1[i] = c64[16 + i]; g2[i] = c64[32 + i]; g3[i] = c64[48 + i]; }
        sort16f(g1); sort16f(g2); sort16f(g3);
        merge16f(top, g1); merge16f(g2, g3); merge16f(top, g2);
    }
    float ev[16]; float sum = 0.f; const float mx = top[0];
#pragma unroll
    for (int r = 0; r < 16; ++r) { ev[r] = __expf(top[r] - mx); sum += ev[r]; }
    const float rs = 1.f / sum;
    int* ep = EID + (size_t)t * 128 + h * 16; float* gp = GATE + (size_t)t * 128 + h * 16;
#pragma unroll
    for (int q4 = 0; q4 < 4; ++q4) { int ee[4];
#pragma unroll
        for (int z = 0; z < 4; ++z) { const int code = 255 - (int)(__float_as_uint(top[q4 * 4 + z]) & 0xFFu), i = code >> 4, j = code & 15;
            const unsigned e1 = (unsigned)(((i & 8) ? i1hi : i1lo) >> (8 * (i & 7))) & 0xFFu, e2 = (unsigned)(((j & 8) ? i2hi : i2lo) >> (8 * (j & 7))) & 0xFFu; ee[z] = (int)(e1 * 128u + e2); }
        *(int4*)(ep + q4 * 4) = make_int4(ee[0], ee[1], ee[2], ee[3]);
        *(float4*)(gp + q4 * 4) = make_float4(ev[q4 * 4] * rs, ev[q4 * 4 + 1] * rs, ev[q4 * 4 + 2] * rs, ev[q4 * 4 + 3] * rs); }
}
}


namespace gx {
typedef unsigned char u8x4 __attribute__((ext_vector_type(4)));
__device__ __forceinline__ int sdot16(const int4 a, const int4 b) {
    int s = __builtin_amdgcn_sdot4(a.x, b.x, 0, false); s = __builtin_amdgcn_sdot4(a.y, b.y, s, false); s = __builtin_amdgcn_sdot4(a.z, b.z, s, false); return __builtin_amdgcn_sdot4(a.w, b.w, s, false);
}
__device__ __forceinline__ float gelu_t(float x) { const float u = 0.7978845608028654f * (x + 0.044715f * x * x * x); return 0.5f * x * (1.f + tanhf(u)); }

__device__ __forceinline__ int hx(int lo, int hi, bool up, int bit) { const int send = up ? lo : hi, keep = up ? hi : lo; return keep + __shfl_xor(send, bit); }

__device__ __forceinline__ void u_token(const unsigned char* UQs  , const int4 (&ev)[4], const int4 hq, int* PArow, int lane) {
    const int e[16] = {ev[0].x, ev[0].y, ev[0].z, ev[0].w, ev[1].x, ev[1].y, ev[1].z, ev[1].w, ev[2].x, ev[2].y, ev[2].z, ev[2].w, ev[3].x, ev[3].y, ev[3].z, ev[3].w};
    int4 rows[16];
#pragma unroll
    for (int i = 0; i < 16; ++i) rows[i] = *(const int4*)(UQs + (size_t)e[i] * 128);
    int p[16];
#pragma unroll
    for (int i = 0; i < 16; ++i) p[i] = sdot16(rows[i], hq);
    const bool b2 = (lane & 4) != 0, b1 = (lane & 2) != 0, b0 = (lane & 1) != 0;
    int q[8], r[4];
#pragma unroll
    for (int k = 0; k < 8; ++k) q[k] = hx(p[k], p[8 + k], b2, 4);
#pragma unroll
    for (int k = 0; k < 4; ++k) r[k] = hx(q[k], q[4 + k], b1, 2);
    const int z0 = hx(r[0], r[2], b0, 1), z1 = hx(r[1], r[3], b0, 1);
    *(int2*)(PArow + 2 * lane) = make_int2(z0, z1);
}

__device__ __forceinline__ void v_token(const unsigned char* VQs  , const int4 (&ev)[4], const int4 wh, float wscale, const float* gate2, const float* x1row, const bf16_t* dlrow, float* outrow, int s, int lane) {
    const int e[16] = {ev[0].x, ev[0].y, ev[0].z, ev[0].w, ev[1].x, ev[1].y, ev[1].z, ev[1].w, ev[2].x, ev[2].y, ev[2].z, ev[2].w, ev[3].x, ev[3].y, ev[3].z, ev[3].w};
    const int whv[4] = {wh.x, wh.y, wh.z, wh.w};
    uint4 rows[16];
#pragma unroll
    for (int i = 0; i < 16; ++i) rows[i] = *(const uint4*)(VQs + (size_t)e[i] * 128);
    int ah[16];
#pragma unroll
    for (int c = 0; c < 16; ++c) ah[c] = 0;
#pragma unroll
    for (int g = 0; g < 4; ++g) {
#pragma unroll
        for (int d = 0; d < 4; ++d) {
            const unsigned A = d == 0 ? rows[4 * g].x : d == 1 ? rows[4 * g].y : d == 2 ? rows[4 * g].z : rows[4 * g].w;
            const unsigned B = d == 0 ? rows[4 * g + 1].x : d == 1 ? rows[4 * g + 1].y : d == 2 ? rows[4 * g + 1].z : rows[4 * g + 1].w;
            const unsigned C = d == 0 ? rows[4 * g + 2].x : d == 1 ? rows[4 * g + 2].y : d == 2 ? rows[4 * g + 2].z : rows[4 * g + 2].w;
            const unsigned D = d == 0 ? rows[4 * g + 3].x : d == 1 ? rows[4 * g + 3].y : d == 2 ? rows[4 * g + 3].z : rows[4 * g + 3].w;
            const unsigned ab01 = __builtin_amdgcn_perm(A, B, 0x01050004u), ab23 = __builtin_amdgcn_perm(A, B, 0x03070206u);
            const unsigned cd01 = __builtin_amdgcn_perm(C, D, 0x01050004u), cd23 = __builtin_amdgcn_perm(C, D, 0x03070206u);
            const int q0 = (int)__builtin_amdgcn_perm(ab01, cd01, 0x01000504u), q1 = (int)__builtin_amdgcn_perm(ab01, cd01, 0x03020706u);
            const int q2 = (int)__builtin_amdgcn_perm(ab23, cd23, 0x01000504u), q3 = (int)__builtin_amdgcn_perm(ab23, cd23, 0x03020706u);
            ah[4 * d + 0] = __builtin_amdgcn_sdot4(q0, whv[g], ah[4 * d + 0], false);
            ah[4 * d + 1] = __builtin_amdgcn_sdot4(q1, whv[g], ah[4 * d + 1], false);
            ah[4 * d + 2] = __builtin_amdgcn_sdot4(q2, whv[g], ah[4 * d + 2], false);
            ah[4 * d + 3] = __builtin_amdgcn_sdot4(q3, whv[g], ah[4 * d + 3], false);
        }
    }
    int y[16];
#pragma unroll
    for (int c = 0; c < 16; ++c) y[c] = ah[c];
    const bool b5 = (lane & 32) != 0, b4 = (lane & 16) != 0, b3 = (lane & 8) != 0;
    int z[8], q[4];
#pragma unroll
    for (int k = 0; k < 8; ++k) { auto rr = __builtin_amdgcn_permlane32_swap((unsigned)y[k], (unsigned)y[8 + k], false, false); z[k] = (int)rr[0] + (int)rr[1]; }
#pragma unroll
    for (int k = 0; k < 4; ++k) { auto rr = __builtin_amdgcn_permlane16_swap((unsigned)z[k], (unsigned)z[4 + k], false, false); q[k] = (int)rr[0] + (int)rr[1]; }
    const int r0 = hx(q[0], q[2], b3, 8), r1 = hx(q[1], q[3], b3, 8);
    const int col = 128 * s + 16 * (lane & 7) + (b5 ? 8 : 0) + (b4 ? 4 : 0) + (b3 ? 2 : 0);
    const float2 g2 = *(const float2*)(gate2 + col); float2 x1 = *(const float2*)(x1row + col); { const unsigned dd = *(const unsigned*)(dlrow + col); x1.x += lo2f(dd); x1.y += hi2f(dd); }
    x1.x += g2.x * wscale * (float)r0; x1.y += g2.y * wscale * (float)r1;
    *(float2*)(outrow + col) = x1;
}
}

constexpr size_t WS_SU = 2 * MiB, WS_SV = 2 * MiB + 65536, WS_HS = 2 * MiB + 131072;
constexpr size_t WS_UQ = 24 * MiB, WS_VQ = 40 * MiB, WS_H2Q = 56 * MiB;
constexpr size_t WS_XS = 2 * MiB + 262144, WS_WINS = 2 * MiB + 393216, WS_WPQS = 2 * MiB + 409600;
constexpr size_t WS_WINQ = 456 * MiB, WS_WPQQ = 460 * MiB;
constexpr size_t WS_SSQQ = 462 * MiB, WS_SSQK = 3 * MiB;
constexpr size_t WS_SSQ = 464 * MiB;
constexpr size_t WS_A = WS_KA;
struct Args { const void* in[22]; float* out; unsigned char* ws; int ph_lo, ph_hi, li, pad; };

struct Frame {
    LAS unsigned char* lds;
    int tid, lane, wave, G, gw, NGW;
};

__host__ __device__ __forceinline__ int nat_col(int rho) {
    if (rho < 672) return rho;
    if (rho < 680) return C_FL + (rho - 672);
    if (rho < 768) return -1;
    if (rho < 1792) { const int t = (rho - 768) >> 8, c = (rho - 768) & 255, bj = c >> 7, wc = (c & 127) >> 5, i = c & 31; return (t < 2 ? C_FQ : C_FK) + 64 * (4 * (t & 1) + wc) + 32 * bj + i; }
    return C_FV + (rho - 1792);
}
__host__ __device__ __forceinline__ int nat_col_q(int n) {
    const int pn = n >> 8, c = n & 255, bj = c >> 7, wc = (c & 127) >> 5, i5 = c & 31;
    if (pn < 2) return (4 * pn + wc) * 96 + 32 * bj + i5;
    const int fq = i5 >> 3, k = i5 & 7; return (2 * wc + (fq >> 1)) * 96 + 64 + 16 * bj + (fq & 1) * 8 + k;
}
__host__ __device__ __forceinline__ int nat_col_kv(int n) {
    const int pn = n >> 8, c = n & 255, bj = c >> 7, wc = (c & 127) >> 5, i5 = c & 31;
    return (4 * (pn & 1) + wc) * 128 + (pn >= 2 ? 64 : 0) + 32 * bj + i5;
}
namespace pg8 {
struct EpiProjI8 {
    static constexpr bool PERM = true, AFTER_DRAIN = false, RESETUP = false;
    bf16_t* P; float* LOGF; float* SSQ; const float* rs; const float* cs; const float* g_fq; const float* g_fk; const float* b_f; float* SSQK;
    __device__ __forceinline__ void operator()(const i32x4 (&acc)[2][2][4][2], const Unit& u, int wr, int wc, int fr, int fq) const {
        const int row0 = u.pm * BM + wr * 64 + fr, rho0 = u.pn * BM + wc * 32 + 8 * fq, pn = u.pn;
        f32x4 c0[2], c1[2];
#pragma unroll
        for (int bj = 0; bj < 2; ++bj) { c0[bj] = *(const f32x4*)(cs + rho0 + bj * HALF); c1[bj] = *(const f32x4*)(cs + rho0 + bj * HALF + 4); }
        const bool fox = pn >= 3 && pn <= 6, isq = pn < 5;
        f32x4 g0[2], g1[2];
        if (fox) { const float* g = (isq ? g_fq : g_fk) + 8 * fq;
#pragma unroll
            for (int bj = 0; bj < 2; ++bj) { g0[bj] = *(const f32x4*)(g + 32 * bj); g1[bj] = *(const f32x4*)(g + 32 * bj + 4); } }
        float r8[8];
#pragma unroll
        for (int i = 0; i < 8; ++i) r8[i] = rs[row0 + (i >> 2) * HALF + (i & 3) * 16];
#pragma unroll
        for (int ai = 0; ai < 2; ++ai)
#pragma unroll
            for (int m = 0; m < 4; ++m) {
                const int row = row0 + ai * HALF + m * 16; bf16_t* rowp = P + (size_t)row * PP; const float r = r8[ai * 4 + m];
                f32x4 v0[2], v1[2];
#pragma unroll
                for (int bj = 0; bj < 2; ++bj) { const i32x4 a0 = acc[ai][bj][m][0], a1 = acc[ai][bj][m][1];
                    v0[bj] = (f32x4){(float)a0[0] * r * c0[bj][0], (float)a0[1] * r * c0[bj][1], (float)a0[2] * r * c0[bj][2], (float)a0[3] * r * c0[bj][3]};
                    v1[bj] = (f32x4){(float)a1[0] * r * c1[bj][0], (float)a1[1] * r * c1[bj][1], (float)a1[2] * r * c1[bj][2], (float)a1[3] * r * c1[bj][3]}; }
                float ssb[2];
#pragma unroll
                for (int bj = 0; bj < 2; ++bj) { float q = (v0[bj][0] * v0[bj][0] + v0[bj][1] * v0[bj][1]) + (v0[bj][2] * v0[bj][2] + v0[bj][3] * v0[bj][3]) + (v1[bj][0] * v1[bj][0] + v1[bj][1] * v1[bj][1]) + (v1[bj][2] * v1[bj][2] + v1[bj][3] * v1[bj][3]);
                    { auto r16 = __builtin_amdgcn_permlane16_swap(__float_as_uint(q), __float_as_uint(q), false, false); q = __uint_as_float(r16[0]) + __uint_as_float(r16[1]); }
                    { auto r32 = __builtin_amdgcn_permlane32_swap(__float_as_uint(q), __float_as_uint(q), false, false); q = __uint_as_float(r32[0]) + __uint_as_float(r32[1]); }
                    ssb[bj] = q; }
                if (pn == 2 && wc == 0 && fq == 0) SSQK[row] = ssb[1];
                if (fox) {
                    const float rr = rsqrtf((ssb[0] + ssb[1]) * (1.f / 64.f) + EPS) * (isq ? C2F : 1.f);
                    const int dst = (isq ? C_FQ : C_FK) + 64 * (4 * ((pn - 3) & 1) + wc) + 8 * fq;
#pragma unroll
                    for (int bj = 0; bj < 2; ++bj) { u32x4 w; w.x = cvt_pk_bf16(v0[bj][0] * rr * g0[bj][0], v0[bj][1] * rr * g0[bj][1]); w.y = cvt_pk_bf16(v0[bj][2] * rr * g0[bj][2], v0[bj][3] * rr * g0[bj][3]);
                        w.z = cvt_pk_bf16(v1[bj][0] * rr * g1[bj][0], v1[bj][1] * rr * g1[bj][1]); w.w = cvt_pk_bf16(v1[bj][2] * rr * g1[bj][2], v1[bj][3] * rr * g1[bj][3]);
                        *(u32x4*)(rowp + dst + 32 * bj) = w; }
                } else {
#pragma unroll
                    for (int bj = 0; bj < 2; ++bj) {
                        const int rho = rho0 + bj * HALF;
                        if (rho == 672) {
                            const float z[8] = {v0[bj][0], v0[bj][1], v0[bj][2], v0[bj][3], v1[bj][0], v1[bj][1], v1[bj][2], v1[bj][3]};
                            const int b = row / S_, sq = row % S_;
#pragma unroll
                            for (int h = 0; h < 8; ++h) { const float zz = z[h] + b_f[h]; LOGF[((size_t)b * 8 + h) * S_ + sq] = fminf(zz, 0.f) - log1pf(expf(-fabsf(zz))); }
                        } else if (rho < 672 || rho >= 1792) {
                            const int dst = rho < 672 ? rho : C_FV + (rho - 1792);
                            u32x4 w; w.x = cvt_pk_bf16(v0[bj][0], v0[bj][1]); w.y = cvt_pk_bf16(v0[bj][2], v0[bj][3]); w.z = cvt_pk_bf16(v1[bj][0], v1[bj][1]); w.w = cvt_pk_bf16(v1[bj][2], v1[bj][3]);
                            *(u32x4*)(rowp + dst) = w;
                            if (fq == 0 && rho < 640) {
                                if (pn == 0) { if (bj == 1) SSQ[(size_t)row * 16 + wc] = ssb[0] + ssb[1]; }
                                else if (pn == 1) SSQ[(size_t)row * 16 + (bj == 0 ? 4 : 8) + wc] = ssb[bj];
                                else SSQ[(size_t)row * 16 + 12 + wc] = ssb[bj];
                            }
                        }
                    }
                }
            }
    }
};
struct EpiStoreRms {
    static constexpr bool PERM = true, AFTER_DRAIN = false, RESETUP = false;
    bf16_t* O; int ldc; const float* SSQ; int slot0; float inv_cnt;
    __device__ __forceinline__ void operator()(const f32x4 (&acc)[2][2][4][2], const Unit& u, int wr, int wc, int fr, int fq) const {
        const int row0 = u.pm * BM + wr * 64 + fr, col0 = u.pn * BM + wc * 32 + 8 * fq;
#pragma unroll
        for (int ai = 0; ai < 2; ++ai)
#pragma unroll
            for (int m = 0; m < 4; ++m) { const int row = row0 + ai * HALF + m * 16; bf16_t* rowp = O + (size_t)row * ldc + col0;
                const f32x4 sa = *(const f32x4*)(SSQ + (size_t)row * 16 + slot0), sb = *(const f32x4*)(SSQ + (size_t)row * 16 + slot0 + 4);
                const float r = rsqrtf(((sa[0] + sa[1]) + (sa[2] + sa[3]) + (sb[0] + sb[1]) + (sb[2] + sb[3])) * inv_cnt + EPS);
#pragma unroll
                for (int bj = 0; bj < 2; ++bj) { const f32x4 v0 = acc[ai][bj][m][0] * r, v1 = acc[ai][bj][m][1] * r;
                    u32x4 w; w.x = cvt_pk_bf16(v0[0], v0[1]); w.y = cvt_pk_bf16(v0[2], v0[3]); w.z = cvt_pk_bf16(v1[0], v1[1]); w.w = cvt_pk_bf16(v1[2], v1[3]);
                    *(u32x4*)(rowp + bj * HALF) = w; } }
    }
};
#define EPI_SUM16 { auto r16 = __builtin_amdgcn_permlane16_swap(__float_as_uint(q), __float_as_uint(q), false, false); q = __uint_as_float(r16[0]) + __uint_as_float(r16[1]); }
#define EPI_SUM32 { auto r32 = __builtin_amdgcn_permlane32_swap(__float_as_uint(q), __float_as_uint(q), false, false); q = __uint_as_float(r32[0]) + __uint_as_float(r32[1]); }
__device__ __forceinline__ float sumsq8(const f32x4 a, const f32x4 b) { return (a[0] * a[0] + a[1] * a[1]) + (a[2] * a[2] + a[3] * a[3]) + (b[0] * b[0] + b[1] * b[1]) + (b[2] * b[2] + b[3] * b[3]); }
__device__ __forceinline__ void row_rms4(float (&r)[4], const float* SSQ8  , int row0, float inv_cnt) {
    f32x4 sa[4], sb[4];
#pragma unroll
    for (int i = 0; i < 4; ++i) { const int row = row0 + i * 16; sa[i] = *(const f32x4*)(SSQ8 + (unsigned)row * 16u); sb[i] = *(const f32x4*)(SSQ8 + (unsigned)row * 16u + 4); }
#pragma unroll
    for (int i = 0; i < 4; ++i) r[i] = rsqrtf(((sa[i][0] + sa[i][1]) + (sa[i][2] + sa[i][3]) + (sb[i][0] + sb[i][1]) + (sb[i][2] + sb[i][3])) * inv_cnt + EPS);
}
struct EpiMlaQ {
    static constexpr bool PERM = true, AFTER_DRAIN = false, RESETUP = true;
    bf16_t* QA; float* SSQQ; const float* SSQ; const float* g;
    __device__ __forceinline__ void operator()(const f32x4 (&acc)[2][2][4][2], const Unit& u, int wr, int wc, int fr, int fq) const {
        const int row0 = u.pm * BM + wr * 64 + fr, pn = u.pn;
        const bool rope = pn == 2;
        const int h = rope ? 2 * wc + (fq >> 1) : 4 * pn + wc, dA = rope ? 64 + (fq & 1) * 8 : 8 * fq, dstep = rope ? 16 : 32;
        const bool wr_ss = rope ? (fq & 1) == 0 : fq == 0;
        f32x4 g0[2], g1[2];
#pragma unroll
        for (int bj = 0; bj < 2; ++bj) { g0[bj] = *(const f32x4*)(g + dA + dstep * bj); g1[bj] = *(const f32x4*)(g + dA + dstep * bj + 4); }
#pragma unroll
        for (int ai = 0; ai < 2; ++ai) {
            float r[4]; row_rms4(r, SSQ, row0 + ai * HALF, 1.f / 384.f);
#pragma unroll
            for (int m = 0; m < 4; ++m) { const int row = row0 + ai * HALF + m * 16; bf16_t* rowp = QA + (unsigned)row * 768u + h * 96 + dA; const float rr = r[m];
                float q = (sumsq8(acc[ai][0][m][0], acc[ai][0][m][1]) + sumsq8(acc[ai][1][m][0], acc[ai][1][m][1])) * (rr * rr);
                EPI_SUM16
                if (!rope) EPI_SUM32
                if (wr_ss) SSQQ[(unsigned)row * 16u + 2 * h + (rope ? 1 : 0)] = q;
#pragma unroll
                for (int bj = 0; bj < 2; ++bj) { const f32x4 v0 = acc[ai][bj][m][0] * g0[bj] * rr, v1 = acc[ai][bj][m][1] * g1[bj] * rr;
                    u32x4 w; w.x = cvt_pk_bf16(v0[0], v0[1]); w.y = cvt_pk_bf16(v0[2], v0[3]); w.z = cvt_pk_bf16(v1[0], v1[1]); w.w = cvt_pk_bf16(v1[2], v1[3]);
                    *(u32x4*)(rowp + dstep * bj) = w; } }
            __builtin_amdgcn_sched_barrier(0);
        }
    }
};
struct EpiMlaKV {
    static constexpr bool PERM = true, AFTER_DRAIN = false, RESETUP = true;
    bf16_t* KA; bf16_t* KV; const float* SSQ; const float* SSQK; const bf16_t* P; const float* g; const float2* ROPE;
    __device__ __forceinline__ void operator()(const f32x4 (&acc)[2][2][4][2], const Unit& u, int wr, int wc, int fr, int fq) const {
        const int row0 = u.pm * BM + wr * 64 + fr, pn = u.pn, h = 4 * (pn & 1) + wc;
        if (pn >= 2) {
#pragma unroll
            for (int ai = 0; ai < 2; ++ai) {
                float r[4]; row_rms4(r, SSQ + 8, row0 + ai * HALF, 1.f / 256.f);
#pragma unroll
                for (int m = 0; m < 4; ++m) { const int row = row0 + ai * HALF + m * 16; bf16_t* rowp = KV + (unsigned)row * 1024u + h * 128 + 64 + 8 * fq; const float rr = r[m];
#pragma unroll
                    for (int bj = 0; bj < 2; ++bj) { const f32x4 v0 = acc[ai][bj][m][0] * rr, v1 = acc[ai][bj][m][1] * rr;
                        u32x4 w; w.x = cvt_pk_bf16(v0[0], v0[1]); w.y = cvt_pk_bf16(v0[2], v0[3]); w.z = cvt_pk_bf16(v1[0], v1[1]); w.w = cvt_pk_bf16(v1[2], v1[3]);
                        *(u32x4*)(rowp + 32 * bj) = w; } }
                __builtin_amdgcn_sched_barrier(0);
            }
        } else {
            f32x4 g0[2], g1[2];
#pragma unroll
            for (int bj = 0; bj < 2; ++bj) { g0[bj] = *(const f32x4*)(g + 32 * bj + 8 * fq); g1[bj] = *(const f32x4*)(g + 32 * bj + 8 * fq + 4); }
            const f32x4 ga = *(const f32x4*)(g + 64 + 4 * fq), gb = *(const f32x4*)(g + 80 + 4 * fq);
#pragma unroll
            for (int ai = 0; ai < 2; ++ai) {
                float r[4], sk[4]; row_rms4(r, SSQ + 8, row0 + ai * HALF, 1.f / 256.f);
#pragma unroll
                for (int m = 0; m < 4; ++m) sk[m] = SSQK[row0 + ai * HALF + m * 16];
                __builtin_amdgcn_sched_barrier(0);
#pragma unroll
                for (int m2 = 0; m2 < 2; ++m2) {
                uint2 p1[4], p2[4]; f32x4 c0[4], c1[4];
#pragma unroll
                for (int m = 2 * m2; m < 2 * m2 + 2; ++m) { const int row = row0 + ai * HALF + m * 16;
                    p1[m] = *(const uint2*)(P + (unsigned)row * (unsigned)PP + C_KPE + 4 * fq); p2[m] = *(const uint2*)(P + (unsigned)row * (unsigned)PP + C_KPE + 16 + 4 * fq);
                    const f32x4* cp = (const f32x4*)(ROPE + (unsigned)row * 16u + 4 * fq); c0[m] = cp[0]; c1[m] = cp[1]; }
#pragma unroll
                for (int m = 2 * m2; m < 2 * m2 + 2; ++m) { const int row = row0 + ai * HALF + m * 16; bf16_t* rowp = KA + (unsigned)row * 768u + h * 96; const float rl = r[m];
                    float q = (sumsq8(acc[ai][0][m][0], acc[ai][0][m][1]) + sumsq8(acc[ai][1][m][0], acc[ai][1][m][1])) * (rl * rl);
                    EPI_SUM16 EPI_SUM32
                    const float rr = rsqrtf((q + sk[m]) * (1.f / 96.f) + EPS), rs = rl * rr;
#pragma unroll
                    for (int bj = 0; bj < 2; ++bj) { const f32x4 v0 = acc[ai][bj][m][0] * g0[bj] * rs, v1 = acc[ai][bj][m][1] * g1[bj] * rs;
                        u32x4 w; w.x = cvt_pk_bf16(v0[0], v0[1]); w.y = cvt_pk_bf16(v0[2], v0[3]); w.z = cvt_pk_bf16(v1[0], v1[1]); w.w = cvt_pk_bf16(v1[2], v1[3]);
                        *(u32x4*)(rowp + 32 * bj + 8 * fq) = w; }
                    const f32x4 a = (f32x4){lo2f(p1[m].x), hi2f(p1[m].x), lo2f(p1[m].y), hi2f(p1[m].y)} * ga * rr, b = (f32x4){lo2f(p2[m].x), hi2f(p2[m].x), lo2f(p2[m].y), hi2f(p2[m].y)} * gb * rr;
                    uint2 w1, w2;
                    w1.x = cvt_pk_bf16(a[0] * c0[m][0] - b[0] * c0[m][1], a[1] * c0[m][2] - b[1] * c0[m][3]); w2.x = cvt_pk_bf16(b[0] * c0[m][0] + a[0] * c0[m][1], b[1] * c0[m][2] + a[1] * c0[m][3]);
                    w1.y = cvt_pk_bf16(a[2] * c1[m][0] - b[2] * c1[m][1], a[3] * c1[m][2] - b[3] * c1[m][3]); w2.y = cvt_pk_bf16(b[2] * c1[m][0] + a[2] * c1[m][1], b[3] * c1[m][2] + a[3] * c1[m][3]);
                    *(uint2*)(rowp + 64 + 4 * fq) = w1; *(uint2*)(rowp + 80 + 4 * fq) = w2; }
                __builtin_amdgcn_sched_barrier(0);
                }
            }
        }
    }
};
struct EpiStoreI8 {
    static constexpr bool PERM = true, AFTER_DRAIN = false, RESETUP = false;
    bf16_t* O; int ldc; const float* rs; const float* cs;
    __device__ __forceinline__ void operator()(const i32x4 (&acc)[2][2][4][2], const Unit& u, int wr, int wc, int fr, int fq) const {
        const int row0 = u.pm * BM + wr * 64 + fr, col0 = u.pn * BM + wc * 32 + 8 * fq;
        f32x4 c0[2], c1[2];
#pragma unroll
        for (int bj = 0; bj < 2; ++bj) { c0[bj] = *(const f32x4*)(cs + col0 + bj * HALF); c1[bj] = *(const f32x4*)(cs + col0 + bj * HALF + 4); }
        float r8[8];
#pragma unroll
        for (int i = 0; i < 8; ++i) r8[i] = rs[row0 + (i >> 2) * HALF + (i & 3) * 16];
#pragma unroll
        for (int ai = 0; ai < 2; ++ai)
#pragma unroll
            for (int m = 0; m < 4; ++m) { const int row = row0 + ai * HALF + m * 16; bf16_t* rowp = O + (size_t)row * ldc + col0; const float r = r8[ai * 4 + m];
#pragma unroll
                for (int bj = 0; bj < 2; ++bj) { const i32x4 a0 = acc[ai][bj][m][0], a1 = acc[ai][bj][m][1];
                    u32x4 w; w.x = cvt_pk_bf16((float)a0[0] * r * c0[bj][0], (float)a0[1] * r * c0[bj][1]); w.y = cvt_pk_bf16((float)a0[2] * r * c0[bj][2], (float)a0[3] * r * c0[bj][3]);
                    w.z = cvt_pk_bf16((float)a1[0] * r * c1[bj][0], (float)a1[1] * r * c1[bj][1]); w.w = cvt_pk_bf16((float)a1[2] * r * c1[bj][2], (float)a1[3] * r * c1[bj][3]);
                    *(u32x4*)(rowp + bj * HALF) = w; } }
    }
};
struct EpiDelta {
    static constexpr bool PERM = true, AFTER_DRAIN = false, RESETUP = false;
    const float* MOD; bf16_t* DL;
    __device__ __forceinline__ void operator()(const f32x4 (&acc)[2][2][4][2], const Unit& u, int wr, int wc, int fr, int fq) const {
        const int row0 = u.pm * BM + wr * 64 + fr, col0 = u.pn * BM + wc * 32 + 8 * fq;
        const int b = (u.pm * BM) / S_;
        f32x4 g0[2], g1[2];
#pragma unroll
        for (int bj = 0; bj < 2; ++bj) { g0[bj] = *(const f32x4*)(MOD + b * 6144 + 2 * 1024 + col0 + bj * HALF); g1[bj] = *(const f32x4*)(MOD + b * 6144 + 2 * 1024 + col0 + bj * HALF + 4); }
#pragma unroll
        for (int ai = 0; ai < 2; ++ai)
#pragma unroll
            for (int m = 0; m < 4; ++m) { bf16_t* rowp = DL + (size_t)(row0 + ai * HALF + m * 16) * 1024 + col0;
#pragma unroll
                for (int bj = 0; bj < 2; ++bj) { const f32x4 v0 = acc[ai][bj][m][0] * g0[bj], v1 = acc[ai][bj][m][1] * g1[bj];
                    u32x4 w; w.x = cvt_pk_bf16(v0[0], v0[1]); w.y = cvt_pk_bf16(v0[2], v0[3]); w.z = cvt_pk_bf16(v1[0], v1[1]); w.w = cvt_pk_bf16(v1[2], v1[3]);
                    *(u32x4*)(rowp + bj * HALF) = w; } }
    }
};
}

__device__ __forceinline__ void p0_transpose_item(const float* W, int K, int N, int Npad, bf16_t* WT, LAS float* scr, int item, int lane, const float* kscale = nullptr, int cmap = 0) {
    const int nblk = Npad / 32, kb = item / nblk, nb = item % nblk, k0 = 64 * kb, n0 = 32 * nb;
    const int nn = cmap == 1 ? nat_col_q(n0 + (lane & 31)) : cmap == 2 ? nat_col_kv(n0 + (lane & 31)) : n0 + (lane & 31);
#pragma unroll 8
    for (int i = 0; i < 32; ++i) { const int kk = 2 * i + (lane >> 5); scr[kk * 33 + (lane & 31)] = nn < N ? W[(size_t)(k0 + kk) * N + nn] * (kscale ? kscale[k0 + kk] : 1.f) : 0.f; }
    asm volatile("s_waitcnt lgkmcnt(0)" ::: "memory");
    const int c = lane & 7;
#pragma unroll
    for (int j = 0; j < 4; ++j) { const int n = (lane >> 3) + 8 * j; const LAS float* s = scr + (8 * c) * 33 + n;
        u32x4 o; o.x = pk2(s[0 * 33], s[1 * 33]); o.y = pk2(s[2 * 33], s[3 * 33]); o.z = pk2(s[4 * 33], s[5 * 33]); o.w = pk2(s[6 * 33], s[7 * 33]);
        *(u32x4*)(WT + (size_t)(n0 + n) * K + k0 + 8 * c) = o; }
    asm volatile("s_waitcnt lgkmcnt(0)" ::: "memory");
}
__device__ __forceinline__ void p0_mod_block(const float* c, const float* w_ada, const float* b_ada, float* mod, LAS unsigned char* lds, int item, int wave, int lane) {
    LAS float* sil = (LAS float*)(lds + wave * 2048);
    LAS float* part = (LAS float*)(lds + 16384);
    for (int i = lane; i < 512; i += 64) { const int b = i >> 7, kk = i & 127; const float cv = c[b * 1024 + wave * 128 + kk]; sil[kk * 4 + b] = cv / (1.f + expf(-cv)); }
    asm volatile("s_waitcnt lgkmcnt(0)" ::: "memory");
    const int j = item * 64 + lane;
    const float* wp = w_ada + (size_t)(wave * 128) * 6144 + j;
    float a0 = 0.f, a1 = 0.f, a2 = 0.f, a3 = 0.f;
#pragma unroll 16
    for (int k = 0; k < 128; ++k) { const float w = wp[(size_t)k * 6144]; const f32x4 s = *(const LAS f32x4*)(sil + k * 4); a0 += s[0] * w; a1 += s[1] * w; a2 += s[2] * w; a3 += s[3] * w; }
    part[(wave * 4 + 0) * 64 + lane] = a0; part[(wave * 4 + 1) * 64 + lane] = a1; part[(wave * 4 + 2) * 64 + lane] = a2; part[(wave * 4 + 3) * 64 + lane] = a3;
    __syncthreads();
    if (wave < 4) { float acc = b_ada[j];
#pragma unroll
        for (int w = 0; w < 8; ++w) acc += part[(w * 4 + wave) * 64 + lane];
        mod[wave * 6144 + j] = acc; }
    __syncthreads();
}

struct ModIn { float4 v[4]; };
__device__ __forceinline__ void modrow_load(ModIn& M, const float* X, const bf16_t* DL, int row, int lane) {
    const float4* xr = (const float4*)(X + (size_t)row * 1024) + lane;
#pragma unroll
    for (int j = 0; j < 4; ++j) M.v[j] = xr[64 * j];
    if (DL) {
#pragma unroll
        for (int j = 0; j < 4; ++j) { const uint2 dd = *(const uint2*)(DL + (size_t)row * 1024 + 4 * lane + 256 * j); M.v[j].x += lo2f(dd.x); M.v[j].y += hi2f(dd.x); M.v[j].z += lo2f(dd.y); M.v[j].w += hi2f(dd.y); }
    }
}
__device__ __forceinline__ void modrow_finish(ModIn& M, const float* g, const float* mod, int shift_idx, int scale_idx, bf16_t* out, unsigned char* outq, float* hs, int row, int lane) {
    const int b = row / S_; float ss = 0.f;
#pragma unroll
    for (int j = 0; j < 4; ++j) ss += (M.v[j].x * M.v[j].x + M.v[j].y * M.v[j].y) + (M.v[j].z * M.v[j].z + M.v[j].w * M.v[j].w);
    ss = wave_sum(ss);
    const float r = rsqrtf(ss * (1.f / 1024.f) + EPS);
    const float* sh = mod + b * 6144 + shift_idx * 1024; const float* sc = mod + b * 6144 + scale_idx * 1024;
    float am = 0.f;
#pragma unroll
    for (int j = 0; j < 4; ++j) {
        const int col = 4 * lane + 256 * j; float4& v = M.v[j];
        const float4 g4 = *(const float4*)(g + col), s4 = *(const float4*)(sc + col), h4 = *(const float4*)(sh + col);
        v.x = v.x * r * g4.x * (1.f + s4.x) + h4.x; v.y = v.y * r * g4.y * (1.f + s4.y) + h4.y; v.z = v.z * r * g4.z * (1.f + s4.z) + h4.z; v.w = v.w * r * g4.w * (1.f + s4.w) + h4.w;
        if (out) { uint2 w; w.x = pk2(v.x, v.y); w.y = pk2(v.z, v.w); *(uint2*)(out + (size_t)row * 1024 + col) = w; }
        am = fmaxf(am, fmaxf(fmaxf(fabsf(v.x), fabsf(v.y)), fmaxf(fabsf(v.z), fabsf(v.w))));
    }
    if (outq) {
#pragma unroll
        for (int o = 1; o < 64; o <<= 1) am = fmaxf(am, __shfl_xor(am, o));
        const float inv = am > 0.f ? 127.f / am : 0.f;
#pragma unroll
        for (int j = 0; j < 4; ++j) { const float4 v = M.v[j]; const int q0 = (int)rintf(v.x * inv), q1 = (int)rintf(v.y * inv), q2 = (int)rintf(v.z * inv), q3 = (int)rintf(v.w * inv);
            *(unsigned*)(outq + (size_t)row * 1024 + 4 * lane + 256 * j) = (unsigned)(q0 & 255) | ((unsigned)(q1 & 255) << 8) | ((unsigned)(q2 & 255) << 16) | ((unsigned)(q3 & 255) << 24); }
        if (lane == 0) hs[row] = am * (1.f / 127.f);
    }
}
__device__ __forceinline__ void modrows2(const float* X, const bf16_t* DL, const float* g, const float* mod, int shift_idx, int scale_idx, bf16_t* out, unsigned char* outq, float* hs, int gw, int ngw, int lane) {
    for (int row = gw; row < T_; row += 2 * ngw) {
        const int row2 = row + ngw; ModIn Ma, Mb;
        modrow_load(Ma, X, DL, row, lane); if (row2 < T_) modrow_load(Mb, X, DL, row2, lane);
        modrow_finish(Ma, g, mod, shift_idx, scale_idx, out, outq, hs, row, lane); if (row2 < T_) modrow_finish(Mb, g, mod, shift_idx, scale_idx, out, outq, hs, row2, lane);
    }
}
__device__ __forceinline__ void quant4(const float* peer_u, const float* peer_v, unsigned char* UQ, unsigned char* VQ, float* SU, float* SV, int r0, int lane) {
    float4 v[4][4]; float am[4];
#pragma unroll
    for (int q = 0; q < 4; ++q) { const int r = r0 + q; const float* src = (r < 16384 ? peer_u + (size_t)r * 1024 : peer_v + (size_t)(r - 16384) * 1024);
#pragma unroll
        for (int j = 0; j < 4; ++j) v[q][j] = ((const float4*)src)[lane + 64 * j]; }
#pragma unroll
    for (int q = 0; q < 4; ++q) { float a = 0.f;
#pragma unroll
        for (int j = 0; j < 4; ++j) a = fmaxf(a, fmaxf(fmaxf(fabsf(v[q][j].x), fabsf(v[q][j].y)), fmaxf(fabsf(v[q][j].z), fabsf(v[q][j].w))));
        am[q] = a; }
#pragma unroll
    for (int o = 1; o < 64; o <<= 1) {
#pragma unroll
        for (int q = 0; q < 4; ++q) am[q] = fmaxf(am[q], __shfl_xor(am[q], o)); }
#pragma unroll
    for (int q = 0; q < 4; ++q) { const int r = r0 + q; unsigned char* dst = (r < 16384 ? UQ + (size_t)r * 128 : VQ + (size_t)(r - 16384) * 128); float* sc = (r < 16384 ? SU + r : SV + (r - 16384));
        const float inv = am[q] > 0.f ? 127.f / am[q] : 0.f;
#pragma unroll
        for (int j = 0; j < 4; ++j) { const float4 x = v[q][j]; const int q0 = (int)rintf(x.x * inv), q1 = (int)rintf(x.y * inv), q2 = (int)rintf(x.z * inv), q3 = (int)rintf(x.w * inv);
            *(unsigned*)(dst + (size_t)(((4 * lane + 256 * j) >> 7) * (16384 * 128)) + ((4 * lane + 256 * j) & 127)) = (unsigned)(q0 & 255) | ((unsigned)(q1 & 255) << 8) | ((unsigned)(q2 & 255) << 16) | ((unsigned)(q3 & 255) << 24); }
        if (lane == 0) *sc = am[q] * (1.f / 127.f); }
}

__global__ void __launch_bounds__(NWAVES * 64, 2) mega_fwd(Args args) {
    extern __shared__ __attribute__((aligned(16))) unsigned char lds[];
    Frame F;
    F.lds = (LAS unsigned char*)lds;
    volatile LAS unsigned* MISC = (volatile LAS unsigned*)(F.lds + MISC_OFF);
    F.tid = threadIdx.x; F.lane = F.tid & 63; F.wave = __builtin_amdgcn_readfirstlane(F.tid >> 6);
    F.G = gridDim.x; F.gw = blockIdx.x * NWAVES + F.wave; F.NGW = F.G * NWAVES;
    unsigned char* ws = args.ws;
    unsigned* ctl = (unsigned*)(ws + WS_CTL);
    const float* x = (const float*)args.in[0]; const float* c = (const float*)args.in[1]; const int* positions = (const int*)args.in[2];
    const float* w_ada = (const float*)args.in[3]; const float* b_ada = (const float*)args.in[4]; const float* norm1_g = (const float*)args.in[5];
    const float* w_in = (const float*)args.in[6]; const float* mla_qa_g = (const float*)args.in[7]; const float* mla_kva_g = (const float*)args.in[8];
    const float* w_uq = (const float*)args.in[9]; const float* w_ukv = (const float*)args.in[10]; const float* mla_q_g = (const float*)args.in[11];
    const float* mla_k_g = (const float*)args.in[12]; const float* fox_q_g = (const float*)args.in[13]; const float* fox_k_g = (const float*)args.in[14];
    const float* b_f = (const float*)args.in[15]; const float* w_o = (const float*)args.in[16]; const float* norm2_g = (const float*)args.in[17];
    const float* w_pq = (const float*)args.in[18]; const float* sub_keys = (const float*)args.in[19]; const float* peer_u = (const float*)args.in[20]; const float* peer_v = (const float*)args.in[21];
    float* out = args.out;
    float* MOD = (float*)(ws + WS_MOD); float* FL = (float*)(ws + WS_FL); float* FCUM = (float*)(ws + WS_FCUM); float* LOGF = (float*)(ws + WS_LOGF); float2* ROPE = (float2*)(ws + WS_ROPE);
    bf16_t* XN = (bf16_t*)(ws + WS_XN); bf16_t* PROJ = (bf16_t*)(ws + WS_PROJ); bf16_t* KVRAW = (bf16_t*)(ws + WS_KVRAW); bf16_t* QA = (bf16_t*)(ws + WS_QA); bf16_t* KA = (bf16_t*)(ws + WS_KA);
    bf16_t* WIN = (bf16_t*)(ws + WS_WIN); bf16_t* WUQ = (bf16_t*)(ws + WS_WUQ); bf16_t* WUKV = (bf16_t*)(ws + WS_WUKV); bf16_t* WO = (bf16_t*)(ws + WS_WO); bf16_t* WPQ = (bf16_t*)(ws + WS_WPQ); bf16_t* SKB = (bf16_t*)(ws + WS_SK);
    float* SSQ = (float*)(ws + WS_SSQ); float* SSQQ = (float*)(ws + WS_SSQQ); float* SSQK = (float*)(ws + WS_SSQK); bf16_t* DELTA = (bf16_t*)(ws + WS_KVRAW);
    unsigned char* XNQ = ws + WS_XN; float* XS = (float*)(ws + WS_XS); unsigned char* WINQ = ws + WS_WINQ; unsigned char* WPQQ = ws + WS_WPQQ; float* WINS = (float*)(ws + WS_WINS); float* WPQS = (float*)(ws + WS_WPQS);
    unsigned char* UQ = ws + WS_UQ; unsigned char* VQ = ws + WS_VQ; unsigned char* H2Q = ws + WS_H2Q; float* SU = (float*)(ws + WS_SU); float* SV = (float*)(ws + WS_SV); float* HS = (float*)(ws + WS_HS); float* AP = (float*)(ws + WS_A);
    bf16_t* OB = XN; bf16_t* H2 = XN; bf16_t* QP = PROJ; int* EID = (int*)(ws + WS_QA); float* GATE = (float*)(ws + WS_QA + 16 * MiB);
    (void)sub_keys; (void)peer_u; (void)peer_v; (void)positions; (void)KA; (void)FCUM; (void)LOGF; (void)ROPE; (void)mla_q_g; (void)mla_k_g; (void)b_f; (void)fox_q_g; (void)fox_k_g; (void)mla_qa_g; (void)mla_kva_g;

    for (int u = F.tid; u < (LDS_BYTES - LDSCTL_OFF) / 4; u += NWAVES * 64) ((LAS unsigned*)(F.lds + LDSCTL_OFF))[u] = 0u;
    __syncthreads();
    const int lo = args.ph_lo, hi = args.ph_hi;
    XcdBarrier bar; bar.bar = ctl + CW_BAR + args.li * XCD_BAR_WORDS; bar.x = 0; bar.st = nullptr;
    if (hi - lo > 1) bar = xcd_barrier_post(ctl + CW_BAR + args.li * XCD_BAR_WORDS, MISC + 8);
#define IN(k) (lo <= (k) && (k) < hi)
#define SEAM(k) do { if (IN(k) && IN((k) + 1)) xcd_barrier(bar); } while (0)

    if (IN(0)) {
        LAS float* scr = (LAS float*)(F.lds + F.wave * 16384);
        constexpr int I_MOD = 96, I_IN = 16 * 72, I_UQ = 6 * 24, I_UKV = 4 * 32, I_O = 16 * 32, I_PQ = 16 * 64;
        constexpr int I_SK = 512;
        constexpr int NITEMS = I_IN + I_UQ + I_UKV + I_O + I_PQ + I_SK;
        {
            const float invf = (float)exp2(-(double)(F.lane & 15) * (13.287712379549449 / 16.0));
            for (int r4 = F.gw * 4; r4 < T_; r4 += F.NGW * 4) { const int row = r4 + (F.lane >> 4);
                const double a = (double)((float)positions[row] * invf), n = rint(a * 0.15915494309189535); const float red = (float)(a - n * 6.283185307179586);
                ROPE[(size_t)row * 16 + (F.lane & 15)] = make_float2(__cosf(red), __sinf(red)); }
        }
        for (int mi = (int)blockIdx.x; mi < I_MOD; mi += F.G) p0_mod_block(c, w_ada, b_ada, MOD, F.lds, mi, F.wave, F.lane);
        for (int it = F.gw; it < NITEMS; it += F.NGW) {
            int r = it;
            if (r < I_IN) { p0_transpose_item(w_in, 1024, INW, PP, WIN, scr, r, F.lane); continue; } r -= I_IN;
            if (r < I_UQ) { p0_transpose_item(w_uq, 384, 768, 768, WUQ, scr, r, F.lane, mla_qa_g, 1); continue; } r -= I_UQ;
            if (r < I_UKV) { p0_transpose_item(w_ukv, 256, 1024, 1024, WUKV, scr, r, F.lane, mla_kva_g, 2); continue; } r -= I_UKV;
            if (r < I_O) { p0_transpose_item(w_o, 1024, 1024, 1024, WO, scr, r, F.lane); continue; } r -= I_O;
            if (r < I_PQ) { p0_transpose_item(w_pq, 1024, 2048, 2048, WPQ, scr, r, F.lane); continue; } r -= I_PQ;
            { const float4* src = (const float4*)(sub_keys + (size_t)r * 512) + F.lane * 2; const float4 a = src[0], b2 = src[1];
              u32x4 o; o.x = pk2(a.x, a.y); o.y = pk2(a.z, a.w); o.z = pk2(b2.x, b2.y); o.w = pk2(b2.z, b2.w); *(u32x4*)(SKB + (size_t)r * 512 + F.lane * 8) = o; }
        }
    }
    SEAM(0);
    if (IN(1)) {
        for (int r = F.gw; r < PP + 2048; r += F.NGW) {
            const int nc = r < PP ? nat_col(r) : 0;
            const bf16_t* src = r < PP ? WIN + (size_t)(nc < 0 ? 0 : nc) * 1024 : WPQ + (size_t)(r - PP) * 1024; unsigned char* dst = r < PP ? WINQ + (size_t)r * 1024 : WPQQ + (size_t)(r - PP) * 1024; float* sc = r < PP ? WINS + r : WPQS + (r - PP);
            float v[16]; unpack8(*(const uint4*)(src + F.lane * 16), v); unpack8(*(const uint4*)(src + F.lane * 16 + 8), v + 8);
            if (nc < 0) {
#pragma unroll
                for (int i = 0; i < 16; ++i) v[i] = 0.f; }
            float am = 0.f;
#pragma unroll
            for (int i = 0; i < 16; ++i) am = fmaxf(am, fabsf(v[i]));
#pragma unroll
            for (int o = 1; o < 64; o <<= 1) am = fmaxf(am, __shfl_xor(am, o));
            const float inv = am > 0.f ? 127.f / am : 0.f; unsigned q[4];
#pragma unroll
            for (int i = 0; i < 4; ++i) q[i] = (unsigned)((int)rintf(v[4 * i] * inv) & 255) | ((unsigned)((int)rintf(v[4 * i + 1] * inv) & 255) << 8) | ((unsigned)((int)rintf(v[4 * i + 2] * inv) & 255) << 16) | ((unsigned)((int)rintf(v[4 * i + 3] * inv) & 255) << 24);
            *(uint4*)(dst + F.lane * 16) = make_uint4(q[0], q[1], q[2], q[3]);
            if (F.lane == 0) *sc = am * (1.f / 127.f);
        }
        modrows2(x, nullptr, norm1_g, MOD, 0, 1, nullptr, XNQ, XS, F.gw, F.NGW, F.lane);
    }
    SEAM(1);
    if (IN(2)) {
        pg8::Gemm g{(const bf16_t*)XNQ, (const bf16_t*)WINQ, T_, PP, 512, 512}; pg8::StaticOrder S; S.init(T_, PP, F.G, (int)blockIdx.x);
        pg8::EpiProjI8 E{PROJ, LOGF, SSQ, XS, WINS, fox_q_g, fox_k_g, b_f, SSQK};
        pg8::gemm_phase<pg8::EpiProjI8, pg8::StaticOrder, true, true, true>(F.lds, g, S, E);
    }
    SEAM(2);
    if (IN(4)) {
        { const int fb = F.G >= 160 ? 128 : 0; if (F.wave == 0 && (int)blockIdx.x >= fb && (int)blockIdx.x < fb + 32) fcum_item(LOGF, FCUM, (int)blockIdx.x - fb, F.lane); }
        { pg8::Gemm g{PROJ + C_CQ, WUQ, T_, 768, 384, PP}; pg8::StaticOrder S; S.init(T_, 768, F.G, (int)blockIdx.x); pg8::EpiMlaQ E{QA, SSQQ, SSQ, mla_q_g};
          pg8::gemm_phase<pg8::EpiMlaQ, pg8::StaticOrder, true, true>(F.lds, g, S, E); }
        { pg8::Gemm g{PROJ + C_CKV, WUKV, T_, 1024, 256, PP}; pg8::StaticOrder S; S.init(T_, 1024, F.G, (int)blockIdx.x); pg8::EpiMlaKV E{KA, KVRAW, SSQ, SSQK, PROJ, mla_k_g, ROPE};
          pg8::gemm_phase<pg8::EpiMlaKV, pg8::StaticOrder, true, true>(F.lds, g, S, E); }
    }
    SEAM(4);
    if (IN(6)) {
        volatile LAS unsigned* qslot = MISC + 16;
        float thr;
        { float gq = fabsf(fox_q_g[F.lane]), gk = fabsf(fox_k_g[F.lane]);
#pragma unroll
          for (int o = 1; o < 64; o <<= 1) { gq = fmaxf(gq, __shfl_xor(gq, o)); gk = fmaxf(gk, __shfl_xor(gk, o)); }
          thr = 104.5f + 2.f * 1.02f * 8.f * gq * gk; }
        unsigned* qctr = ctl + 64;
        if (F.tid == 0) qslot[0] = atomicAdd(qctr, 1u);
        __syncthreads();
        unsigned u = qslot[0];
        while (u < 2048u + 1024u) {
            unsigned unext = 0u;
            if (F.tid == 0) unext = atomicAdd(qctr, 1u);
            if (u >= 2048u) {
                quant4(peer_u, peer_v, UQ, VQ, SU, SV, (int)(u - 2048u) * 32 + F.wave * 4, F.lane);
                if (F.tid == 0) qslot[0] = unext;
                __syncthreads();
                u = qslot[0];
                __syncthreads();
                continue;
            }
            const int grp = (int)(u >> 10), bh = (int)(u & 31u), qb = 31 - (int)((u >> 5) & 31u), b = bh >> 3, h = bh & 7;
            if (grp == 0) { const att::Desc d{QA + (size_t)b * S_ * 768 + h * 96, 768, KA + (size_t)b * S_ * 768 + h * 96, 768, KVRAW + (size_t)b * S_ * 1024 + h * 128 + 64, 1024, OB + (size_t)b * S_ * 1024 + h * 64, 1024, nullptr, SSQQ + (size_t)b * S_ * 16 + 2 * h, ROPE + (size_t)b * S_ * 16};
                att::attn_unit<6, false>(d, qb, 0, F.lds); }
            else { const bf16_t* pb = PROJ + (size_t)b * S_ * PP + h * 64; const float* fc = FCUM + (size_t)(b * 8 + h) * S_;
                const att::Desc d{pb + C_FQ, PP, pb + C_FK, PP, pb + C_FV, PP, OB + (size_t)b * S_ * 1024 + 512 + h * 64, 1024, fc, nullptr, nullptr};
                const int NT = 4 * (qb + 1); const float lim = fc[qb * 256] + thr;
                int j0 = 0;
                { const int ja = F.lane, jb2 = 64 + F.lane;
                  const bool ka = ja < NT ? (fc[64 * ja + 63] <= lim) : true, kb = jb2 < NT ? (fc[64 * jb2 + 63] <= lim) : true;
                  const unsigned long long ma = __ballot(ka), mb = __ballot(kb);
                  j0 = ma ? __builtin_ctzll(ma) : (mb ? 64 + __builtin_ctzll(mb) : NT - 4); }
                if (j0 > NT - 4) j0 = NT - 4;
                att::attn_unit<4, true>(d, qb, j0, F.lds); }
            if (F.tid == 0) qslot[0] = unext;
            __syncthreads();
            u = qslot[0];
            __syncthreads();
        }
    }
    SEAM(6);
    if (IN(7)) {
        pg8::Gemm g{OB, WO, T_, 1024, 1024, 1024}; pg8::StaticOrder S; S.init(T_, 1024, F.G, (int)blockIdx.x);
        pg8::EpiDelta E{MOD, DELTA};
        pg8::gemm_phase<pg8::EpiDelta, pg8::StaticOrder, true, true>(F.lds, g, S, E);
    }
    SEAM(7);
    if (IN(8)) modrows2(x, DELTA, norm2_g, MOD, 3, 4, nullptr, H2Q, HS, F.gw, F.NGW, F.lane);
    SEAM(8);
    if (IN(9)) {
        pg8::Gemm g{(const bf16_t*)H2Q, (const bf16_t*)WPQQ, T_, 2048, 512, 512}; pg8::StaticOrder S; S.init(T_, 2048, F.G, (int)blockIdx.x); pg8::EpiStoreI8 E{QP, 2048, HS, WPQS};
        pg8::gemm_phase<pg8::EpiStoreI8, pg8::StaticOrder, true, true, true>(F.lds, g, S, E);
    }
    SEAM(9);
    if (IN(10)) { for (int w = F.gw; w < (T_ / 32) * 4; w += F.NGW) pk::topk_item2(QP, SKB, EID, GATE, w, F.lane); }
    SEAM(10);
    {
        const int ng = F.G < 8 ? F.G : 8; const int vx = (int)blockIdx.x % ng, rank = (int)blockIdx.x / ng, nrank = (F.G - vx + ng - 1) / ng;
        const int gwv = rank * NWAVES + F.wave, ngwv = nrank * NWAVES;
        const int grp = F.lane >> 3, sub = F.lane & 7;
        int* PA = (int*)(ws + WS_PROJ);
        int* WQH = (int*)(ws + WS_KA); float* WSC = (float*)(ws + WS_KA + 8 * MiB);
        if (IN(11)) {
            for (int s = vx; s < 8; s += ng) {
                const unsigned char* UQs = UQ + (size_t)s * (16384 * 128) + 16 * sub;
                int t = gwv; int4 ev[4]; int4 hq = make_int4(0, 0, 0, 0);
#pragma unroll
                for (int k = 0; k < 4; ++k) ev[k] = make_int4(0, 0, 0, 0);
                if (t < T_) {
#pragma unroll
                    for (int k = 0; k < 4; ++k) ev[k] = *(const int4*)(EID + (size_t)t * 128 + grp * 16 + 4 * k);
                    hq = *(const int4*)(H2Q + (size_t)t * 1024 + 128 * s + 16 * sub); }
                while (t < T_) {
                    const int tn = t + ngwv; int4 evn[4]; int4 hqn = make_int4(0, 0, 0, 0);
#pragma unroll
                    for (int k = 0; k < 4; ++k) evn[k] = make_int4(0, 0, 0, 0);
                    if (tn < T_) {
#pragma unroll
                        for (int k = 0; k < 4; ++k) evn[k] = *(const int4*)(EID + (size_t)tn * 128 + grp * 16 + 4 * k);
                        hqn = *(const int4*)(H2Q + (size_t)tn * 1024 + 128 * s + 16 * sub); }
                    gx::u_token(UQs, ev, hq, PA + ((size_t)s * T_ + t) * 128, F.lane);
                    t = tn; hq = hqn;
#pragma unroll
                    for (int k = 0; k < 4; ++k) ev[k] = evn[k];
                }
            }
        }
        SEAM(11);
        if (IN(12)) {
            for (int t = F.gw; t < T_; t += F.NGW) {
                int i0 = 0, i1 = 0;
#pragma unroll
                for (int s = 0; s < 8; ++s) { const int2 p = *(const int2*)(PA + ((size_t)s * T_ + t) * 128 + 2 * F.lane); i0 += p.x; i1 += p.y; }
                const int2 e2 = *(const int2*)(EID + (size_t)t * 128 + 2 * F.lane); const float2 g2 = *(const float2*)(GATE + (size_t)t * 128 + 2 * F.lane); const float hs = HS[t];
                const float w0 = g2.x * gx::gelu_t((float)i0 * SU[e2.x] * hs) * SV[e2.x], w1 = g2.y * gx::gelu_t((float)i1 * SU[e2.y] * hs) * SV[e2.y];
                float wm = fmaxf(fabsf(w0), fabsf(w1));
#pragma unroll
                for (int o = 1; o < 64; o <<= 1) wm = fmaxf(wm, __shfl_xor(wm, o));
                const float inv = wm > 0.f ? 127.f / wm : 0.f;
                const int q0 = (int)rintf(w0 * inv), q1 = (int)rintf(w1 * inv);
                const unsigned h2 = (unsigned)(q0 & 255) | ((unsigned)(q1 & 255) << 8);
                const unsigned h2p = __shfl_xor(h2, 1);
                if ((F.lane & 1) == 0) WQH[(size_t)t * 32 + (F.lane >> 1)] = (int)(h2 | (h2p << 16));
                if (F.lane == 0) WSC[t] = wm * (1.f / 127.f);
            }
        }
        SEAM(12);
        if (IN(13)) {
            for (int s = vx; s < 8; s += ng) {
                const unsigned char* VQs = VQ + (size_t)s * (16384 * 128) + 16 * sub;
                int t = gwv; int4 ev[4]; int4 wh = make_int4(0, 0, 0, 0); float wsc = 0.f;
#pragma unroll
                for (int k = 0; k < 4; ++k) ev[k] = make_int4(0, 0, 0, 0);
                if (t < T_) {
#pragma unroll
                    for (int k = 0; k < 4; ++k) ev[k] = *(const int4*)(EID + (size_t)t * 128 + grp * 16 + 4 * k);
                    wh = *(const int4*)(WQH + (size_t)t * 32 + grp * 4); wsc = WSC[t]; }
                while (t < T_) {
                    const int tn = t + ngwv; int4 evn[4]; int4 whn = make_int4(0, 0, 0, 0); float wscn = 0.f;
#pragma unroll
                    for (int k = 0; k < 4; ++k) evn[k] = make_int4(0, 0, 0, 0);
                    if (tn < T_) {
#pragma unroll
                        for (int k = 0; k < 4; ++k) evn[k] = *(const int4*)(EID + (size_t)tn * 128 + grp * 16 + 4 * k);
                        whn = *(const int4*)(WQH + (size_t)tn * 32 + grp * 4); wscn = WSC[tn]; }
                    float* dstrow = out + (size_t)t * 1024;
                    gx::v_token(VQs, ev, wh, wsc, MOD + (t / S_) * 6144 + 5 * 1024, x + (size_t)t * 1024, DELTA + (size_t)t * 1024, dstrow, s, F.lane);
                    t = tn; wh = whn; wsc = wscn;
#pragma unroll
                    for (int k = 0; k < 4; ++k) ev[k] = evn[k];
                }
            }
        }
    }
#undef IN
#undef SEAM
}

static int g_grid = 0;
static void launch_mega(const Args& base, int lo, int hi, int li, hipStream_t stream) {
    Args a = base; a.ph_lo = lo; a.ph_hi = hi; a.li = li;
    hipLaunchKernelGGL(mega_fwd, dim3(g_grid), dim3(NWAVES * 64), LDS_BYTES, stream, a);
}

extern "C" void kernel_launch(void* const* d_in, const int* in_sizes, int n_in, void* d_out, int out_size, void* d_ws, size_t ws_size, hipStream_t stream) {
    if (g_grid == 0) {
        int dev = 0, cus = 0;
        (void)hipGetDevice(&dev); (void)hipDeviceGetAttribute(&cus, hipDeviceAttributeMultiprocessorCount, dev);
        (void)hipFuncSetAttribute((const void*)mega_fwd, hipFuncAttributeMaxDynamicSharedMemorySize, LDS_BYTES);
        int per_cu = 0; (void)hipOccupancyMaxActiveBlocksPerMultiprocessor(&per_cu, (const void*)mega_fwd, NWAVES * 64, LDS_BYTES);
        (void)hipGetLastError();
        g_grid = cus > 0 ? cus : 256;
        if (per_cu < 1) fprintf(stderr, "kernel_launch: occupancy query says %d blocks/CU\n", per_cu);
    }
    float* out = (float*)d_out; unsigned char* ws = (unsigned char*)d_ws;
    (void)hipMemsetAsync(ws + WS_CTL, 0, CTL_ZERO_BYTES, stream);
    Args base{}; for (int i = 0; i < 22; ++i) base.in[i] = d_in[i]; base.out = out; base.ws = ws;

    launch_mega(base, 0, 14, 0, stream);
}
```

```cpp
#include <hip/hip_runtime.h>
#include <cstdint>
#include <cstdio>
#include <cmath>

typedef unsigned short bf16_t;
constexpr int B_ = 4, S_ = 8192, D_ = 1024, T_ = B_ * S_;
constexpr int PP = 2304;
constexpr int C_CQ = 0, C_CKV = 384, C_KPE = 640, C_FQ = 672, C_FK = 1184, C_FV = 1696, C_FL = 2208, INW = 2216;
constexpr float EPS = 1e-6f;
constexpr float LOG2E = 1.4426950408889634f;
constexpr float C2A = 0.10206207261596577f * LOG2E;
constexpr float C2F = 0.125f * LOG2E;

__device__ __forceinline__ float bf2f(bf16_t v) { return __uint_as_float(((unsigned)v) << 16); }
__device__ __forceinline__ bf16_t f2bf(float f) { unsigned u = __float_as_uint(f); return (bf16_t)((u + 0x7fffu + ((u >> 16) & 1u)) >> 16); }
__device__ __forceinline__ unsigned pk2(float lo, float hi) { return (unsigned)f2bf(lo) | ((unsigned)f2bf(hi) << 16); }
__device__ __forceinline__ float lo2f(unsigned w) { return __uint_as_float(w << 16); }
__device__ __forceinline__ float hi2f(unsigned w) { return __uint_as_float(w & 0xffff0000u); }
__device__ __forceinline__ float wave_sum(float v) {
#pragma unroll
    for (int o = 1; o < 64; o <<= 1) v += __shfl_xor(v, o);
    return v;
}

constexpr size_t MiB = 1u << 20;
constexpr size_t WS_MOD = 1 * MiB;
constexpr size_t WS_FL = 3 * MiB;
constexpr size_t WS_FCUM = 4 * MiB;
constexpr size_t WS_LOGF = 5 * MiB;
constexpr size_t WS_ROPE = 6 * MiB;
constexpr size_t WS_XN = 88 * MiB;
constexpr size_t WS_PROJ = 152 * MiB;
constexpr size_t WS_KVRAW = 296 * MiB;
constexpr size_t WS_QA = 360 * MiB;
constexpr size_t WS_KA = 408 * MiB;

__device__ __forceinline__ void unpack8(const uint4 raw, float* v) {
    v[0] = lo2f(raw.x); v[1] = hi2f(raw.x); v[2] = lo2f(raw.y); v[3] = hi2f(raw.y); v[4] = lo2f(raw.z); v[5] = hi2f(raw.z); v[6] = lo2f(raw.w); v[7] = hi2f(raw.w);
}
__device__ __forceinline__ void fcum_item(const float* LOGF, float* FCUM, int item, int lane) {
    const float4* src = (const float4*)(LOGF + (size_t)item * S_ + 128 * lane);
    float4 v[32]; float tot = 0.f;
#pragma unroll
    for (int i = 0; i < 32; ++i) v[i] = src[i];
#pragma unroll
    for (int i = 0; i < 32; ++i) tot += (v[i].x + v[i].y) + (v[i].z + v[i].w);
    float incl = tot;
#pragma unroll
    for (int o = 1; o < 64; o <<= 1) { const float t = __shfl_up(incl, o); if (lane >= o) incl += t; }
    float run = incl - tot;
    float4* dst = (float4*)(FCUM + (size_t)item * S_ + 128 * lane);
#pragma unroll
    for (int i = 0; i < 32; ++i) { float4 o; run += v[i].x; o.x = run; run += v[i].y; o.y = run; run += v[i].z; o.z = run; run += v[i].w; o.w = run; dst[i] = o; }
}

struct MlaIn { uint4 qn, kn; unsigned q1, q2, k1, k2; float2 cs0, cs1; };
__device__ __forceinline__ void mlaprep_load(MlaIn& M, const bf16_t* QRAW, const bf16_t* KVRAW, const bf16_t* PROJ, const float2* ROPE, int row, int lane) {
    const int h = lane >> 3, p = lane & 7;
    const bf16_t* q = QRAW + (size_t)row * 768 + h * 96; const bf16_t* kp = PROJ + (size_t)row * PP + C_KPE;
    M.qn = *(const uint4*)(q + 8 * p); M.q1 = *(const unsigned*)(q + 64 + 2 * p); M.q2 = *(const unsigned*)(q + 80 + 2 * p);
    M.kn = *(const uint4*)(KVRAW + (size_t)row * 1024 + h * 128 + 8 * p); M.k1 = *(const unsigned*)(kp + 2 * p); M.k2 = *(const unsigned*)(kp + 16 + 2 * p);
    M.cs0 = ROPE[(size_t)row * 16 + 2 * p]; M.cs1 = ROPE[(size_t)row * 16 + 2 * p + 1];
}
__device__ __forceinline__ void mlaprep_finish(const MlaIn& M, bf16_t* QRAW, bf16_t* KA, const float* g_q, const float* g_k, int row, int lane) {
    const int h = lane >> 3, p = lane & 7;
#pragma unroll
    for (int which = 0; which < 2; ++which) {
        const float* g = which == 0 ? g_q : g_k; const float sc = which == 0 ? C2A : 1.f;
        float v[8]; unpack8(which == 0 ? M.qn : M.kn, v); const unsigned r1 = which == 0 ? M.q1 : M.k1, r2 = which == 0 ? M.q2 : M.k2;
        float a0 = lo2f(r1), a1 = hi2f(r1), b0 = lo2f(r2), b1 = hi2f(r2);
        float ss = a0 * a0 + a1 * a1 + b0 * b0 + b1 * b1;
#pragma unroll
        for (int i = 0; i < 8; ++i) ss += v[i] * v[i];
        ss += __shfl_xor(ss, 1); ss += __shfl_xor(ss, 2); ss += __shfl_xor(ss, 4);
        const float r = rsqrtf(ss * (1.f / 96.f) + EPS);
        const float* gn = g + 8 * p;
        a0 *= r * g[64 + 2 * p]; a1 *= r * g[64 + 2 * p + 1]; b0 *= r * g[80 + 2 * p]; b1 *= r * g[80 + 2 * p + 1];
        const float ra0 = a0 * M.cs0.x - b0 * M.cs0.y, rb0 = b0 * M.cs0.x + a0 * M.cs0.y, ra1 = a1 * M.cs1.x - b1 * M.cs1.y, rb1 = b1 * M.cs1.x + a1 * M.cs1.y;
        uint4 o; o.x = pk2(v[0] * r * gn[0] * sc, v[1] * r * gn[1] * sc); o.y = pk2(v[2] * r * gn[2] * sc, v[3] * r * gn[3] * sc);
        o.z = pk2(v[4] * r * gn[4] * sc, v[5] * r * gn[5] * sc); o.w = pk2(v[6] * r * gn[6] * sc, v[7] * r * gn[7] * sc);
        bf16_t* dst = (which == 0 ? QRAW : KA) + (size_t)row * 768 + h * 96;
        *(uint4*)(dst + 8 * p) = o; *(unsigned*)(dst + 64 + 2 * p) = pk2(ra0 * sc, ra1 * sc); *(unsigned*)(dst + 80 + 2 * p) = pk2(rb0 * sc, rb1 * sc);
    }
}
namespace pg8 {
#define PG8_LAS __attribute__((address_space(3)))
typedef unsigned short bf16_t;
typedef short bf16x8 __attribute__((ext_vector_type(8)));
typedef float f32x4 __attribute__((ext_vector_type(4)));
typedef unsigned u32x4 __attribute__((ext_vector_type(4)));
constexpr int BM = 256, BK = 64, HALF = 128, HTB = HALF * BK * 2  , STAGE_BYTES = 8 * HTB, NXCD = 8, WGM = 8;

__host__ __device__ __forceinline__ int lds_byte(int r, int c) { const int st = (r >> 4) * 2 + (c >> 5), rr = r & 15, cc = c & 31, ob = rr * 64 + cc * 2; return st * 1024 + (ob ^ (((ob >> 9) & 1) << 5)); }
__host__ __device__ __forceinline__ void stage_rc(int b, int& R, int& C) { const int st = b / 1024, sb = b % 1024, swz = sb ^ (((sb >> 9) & 1) << 5); R = (st >> 1) * 16 + swz / 64; C = (st & 1) * 32 + (swz % 64) / 2; }
__host__ __device__ __forceinline__ int perm32(int rho) { const int n = rho >> 4, i = rho & 15; return 8 * (i >> 2) + 4 * n + (i & 3); }

struct Unit { int pm, pn; };
struct Gemm { const bf16_t* A; const bf16_t* Bt; int M, N, K, lda; };

struct StaticOrder {
    int nM, nN, nwg, G, c;
    __host__ __device__ void init(int M, int N, int G_, int c_) { nM = M / BM; nN = N / BM; nwg = nM * nN; G = G_; c = c_; }
    __host__ __device__ bool next(int i, Unit& u) const {
        const long L = (long)i * G + c; if (L >= nwg) return false;
        int wgid = (int)L; { const int q = nwg / NXCD, r = nwg % NXCD, xcd = wgid % NXCD, off = wgid / NXCD; wgid = (xcd < r ? xcd * (q + 1) : r * (q + 1) + (xcd - r) * q) + off; }
        const int nig = WGM * nN, gid = wgid / nig, fm = gid * WGM, gsz = (nM - fm) < WGM ? (nM - fm) : WGM;
        u.pm = fm + ((wgid % nig) % gsz); u.pn = (wgid % nig) / gsz; return true;
    }
    __device__ __forceinline__ void a_ready(const Unit&) const {}
    __device__ __forceinline__ void done(const Unit&) const {}
};
__device__ __forceinline__ unsigned cvt_pk_bf16(float lo, float hi) { unsigned r; asm volatile("v_cvt_pk_bf16_f32 %0, %1, %2" : "=v"(r) : "v"(lo), "v"(hi)); return r; }
typedef float f32x2 __attribute__((ext_vector_type(2)));
typedef int i32x4 __attribute__((ext_vector_type(4)));
template <bool I8> struct AccT { typedef f32x4 type; };
template <> struct AccT<true> { typedef i32x4 type; };
__device__ __forceinline__ f32x4 mma16(const bf16x8 b, const bf16x8 a, const f32x4 c) { return __builtin_amdgcn_mfma_f32_16x16x32_bf16(b, a, c, 0, 0, 0); }
__device__ __forceinline__ i32x4 mma16(const bf16x8 b, const bf16x8 a, const i32x4 c) { return __builtin_amdgcn_mfma_i32_16x16x64_i8(__builtin_bit_cast(i32x4, b), __builtin_bit_cast(i32x4, a), c, 0, 0, 0); }
template <class Epi, class Sched, bool ALIGN_EPI = false, bool SP2 = false, bool I8 = false>
__device__ __forceinline__ void gemm_phase(PG8_LAS unsigned char* lds, const Gemm g, const Sched& S, const Epi& E) {
    int tid_ = threadIdx.x; if constexpr (Epi::RESETUP) asm volatile("" : "+v"(tid_));
    const int tid = tid_, wid = __builtin_amdgcn_readfirstlane(tid >> 6), lane = tid & 63, wr = wid >> 2, wc = wid & 3, fr = lane & 15, fq = lane >> 4;
    const int K = g.K, nt = K / BK;
    unsigned voffA[2], voffB[2]; int aoff, boff;
#define PG8_LANE_SETUP do { int t_ = tid; asm volatile("" : "+v"(t_)); const int l_ = t_ & 63, fr_ = l_ & 15, fq_ = l_ >> 4; \
        _Pragma("unroll") for (int i = 0; i < 2; ++i) { int R, C; stage_rc(t_ * 16 + i * 8192, R, C); const int Rb = Epi::PERM ? ((R & ~31) + perm32(R & 31)) : R; \
            voffA[i] = (unsigned)(R * g.lda + C) * 2u; voffB[i] = (unsigned)(Rb * K + C) * 2u; } \
        aoff = lds_byte(wr * 64 + fr_, fq_ * 8); boff = lds_byte(wc * 32 + fr_, fq_ * 8); } while (0)
    PG8_LANE_SETUP;
    const size_t kstep = (size_t)(BK * 2);
    const size_t hstepA = (size_t)HALF * g.lda * 2, hstepB = (size_t)HALF * K * 2;
    const size_t tstepA = 2 * hstepA, tstepB = 2 * hstepB;
    const unsigned ldsw = (unsigned)wid * 1024u;
#define PG8_SA(b, h) (((b) * 2 + (h)) * HTB)
#define PG8_SB(b, h) ((4 + (b) * 2 + (h)) * HTB)
#define PG8_STAGE(bufoff, gbase, voff) do { _Pragma("unroll") for (int _i = 0; _i < 2; ++_i) \
        __builtin_amdgcn_global_load_lds((const unsigned*)((const char*)(gbase) + (voff)[_i]), (PG8_LAS unsigned*)(lds + (bufoff) + ldsw + _i * 8192), 16, 0, 0); } while (0)
#define PG8_LDA(dst, b, h) do { _Pragma("unroll") for (int m = 0; m < 4; ++m) _Pragma("unroll") for (int k = 0; k < 2; ++k) dst[m][k] = *(const PG8_LAS bf16x8*)(lds + PG8_SA(b, h) + aoff + m * 2048 + k * 1024); } while (0)
#define PG8_LDB(dst, b, h) do { _Pragma("unroll") for (int n = 0; n < 2; ++n) _Pragma("unroll") for (int k = 0; k < 2; ++k) dst[n][k] = *(const PG8_LAS bf16x8*)(lds + PG8_SB(b, h) + boff + n * 2048 + k * 1024); } while (0)
#define PG8_MMA(ai, bj, At, Bt) do { __builtin_amdgcn_s_setprio(1); _Pragma("unroll") for (int m = 0; m < 4; ++m) _Pragma("unroll") for (int n = 0; n < 2; ++n) _Pragma("unroll") for (int k = 0; k < 2; ++k) \
        acc[ai][bj][m][n] = mma16(Bt[n][k], At[m][k], acc[ai][bj][m][n]); __builtin_amdgcn_s_setprio(0); } while (0)
#define PG8_WAIT_V(n) asm volatile("s_waitcnt vmcnt(" #n ")" ::: "memory")
#define PG8_WAIT_L(n) asm volatile("s_waitcnt lgkmcnt(" #n ")" ::: "memory")
#define PG8_BAR __builtin_amdgcn_s_barrier()
#define PG8_SCHED __builtin_amdgcn_sched_barrier(0)
    Unit cur, nxt; int ui = 0;
    if (!S.next(0, cur)) return;
    typedef typename AccT<I8>::type accv; accv acc[2][2][4][2];
#pragma unroll
    for (int a = 0; a < 2; ++a)
#pragma unroll
        for (int b = 0; b < 2; ++b)
#pragma unroll
            for (int m = 0; m < 4; ++m)
#pragma unroll
                for (int n = 0; n < 2; ++n) acc[a][b][m][n] = accv{};
    bf16x8 At[4][2], B0[2][2], B1[2][2];
    const char* cA = (const char*)g.A + (size_t)cur.pm * tstepA; const char* cB = (const char*)g.Bt + (size_t)cur.pn * tstepB;
    S.a_ready(cur);
    if constexpr (SP2) {
        PG8_STAGE(PG8_SB(0, 0), cB, voffB); PG8_STAGE(PG8_SB(0, 1), cB + hstepB, voffB); PG8_STAGE(PG8_SA(0, 0), cA, voffA); PG8_STAGE(PG8_SA(0, 1), cA + hstepA, voffA);
        if (wr == 1) PG8_BAR;
        PG8_WAIT_V(2); PG8_BAR;
        PG8_STAGE(PG8_SB(1, 0), cB + kstep, voffB); PG8_STAGE(PG8_SA(1, 0), cA + kstep, voffA); PG8_STAGE(PG8_SB(1, 1), cB + hstepB + kstep, voffB);
        PG8_WAIT_V(6); PG8_BAR;
    } else {
        PG8_STAGE(PG8_SB(0, 0), cB, voffB); PG8_STAGE(PG8_SA(0, 0), cA, voffA); PG8_STAGE(PG8_SB(0, 1), cB + hstepB, voffB); PG8_STAGE(PG8_SA(0, 1), cA + hstepA, voffA);
        if (wr == 1) PG8_BAR;
        PG8_WAIT_V(4); PG8_BAR;
        PG8_STAGE(PG8_SB(1, 0), cB + kstep, voffB); PG8_STAGE(PG8_SA(1, 0), cA + kstep, voffA); PG8_STAGE(PG8_SB(1, 1), cB + hstepB + kstep, voffB);
        PG8_WAIT_V(6); PG8_BAR;
    }
    for (;;) {
        const bool has_next = S.next(ui + 1, nxt);
        const char* nA = has_next ? (const char*)g.A + (size_t)nxt.pm * tstepA : cA; const char* nB = has_next ? (const char*)g.Bt + (size_t)nxt.pn * tstepB : cB;
        for (int t = 0; t < nt; t += 2) {
            const bool last = (t == nt - 2);
            const char* a1 = cA + (size_t)(t + 1) * kstep;
            const char* a2 = last ? nA : cA + (size_t)(t + 2) * kstep; const char* b2 = last ? nB : cB + (size_t)(t + 2) * kstep;
            const char* a3 = a2 + kstep; const char* b3 = b2 + kstep;
            if (last && has_next) S.a_ready(nxt);
            if constexpr (SP2) {
            PG8_LDB(B0, 0, 0); PG8_LDB(B1, 0, 1); PG8_SCHED; PG8_LDA(At, 0, 0); PG8_STAGE(PG8_SA(1, 1), a1 + hstepA, voffA);
            PG8_WAIT_V(8); PG8_WAIT_L(0); PG8_BAR; PG8_MMA(0, 0, At, B0); PG8_MMA(0, 1, At, B1); PG8_BAR; PG8_SCHED;
            PG8_LDA(At, 0, 1); PG8_STAGE(PG8_SB(0, 0), b2, voffB); PG8_STAGE(PG8_SB(0, 1), b2 + hstepB, voffB); PG8_STAGE(PG8_SA(0, 0), a2, voffA);
            PG8_WAIT_V(8); PG8_WAIT_L(0); PG8_BAR; PG8_MMA(1, 0, At, B0); PG8_MMA(1, 1, At, B1); PG8_BAR; PG8_SCHED;
            PG8_LDB(B0, 1, 0); PG8_LDB(B1, 1, 1); PG8_SCHED; PG8_LDA(At, 1, 0); PG8_STAGE(PG8_SA(0, 1), a2 + hstepA, voffA);
            PG8_WAIT_V(8); PG8_WAIT_L(0); PG8_BAR; PG8_MMA(0, 0, At, B0); PG8_MMA(0, 1, At, B1); PG8_BAR; PG8_SCHED;
            PG8_LDA(At, 1, 1); PG8_STAGE(PG8_SB(1, 0), b3, voffB); PG8_STAGE(PG8_SB(1, 1), b3 + hstepB, voffB); PG8_STAGE(PG8_SA(1, 0), a3, voffA);
            PG8_WAIT_V(8); PG8_WAIT_L(0); PG8_BAR; PG8_MMA(1, 0, At, B0); PG8_MMA(1, 1, At, B1); PG8_BAR; PG8_SCHED;
            } else {
            PG8_LDB(B0, 0, 0); PG8_SCHED; PG8_LDA(At, 0, 0); PG8_STAGE(PG8_SA(1, 1), a1 + hstepA, voffA);
            PG8_WAIT_L(8); PG8_BAR; PG8_WAIT_L(0); PG8_MMA(0, 0, At, B0); PG8_BAR; PG8_SCHED;
            PG8_LDB(B1, 0, 1); PG8_STAGE(PG8_SB(0, 0), b2, voffB);
            PG8_BAR; PG8_WAIT_L(0); PG8_MMA(0, 1, At, B1); PG8_BAR;
            PG8_LDA(At, 0, 1); PG8_STAGE(PG8_SA(0, 0), a2, voffA);
            PG8_BAR; PG8_WAIT_L(0); PG8_MMA(1, 0, At, B0); PG8_BAR; PG8_SCHED;
            PG8_STAGE(PG8_SB(0, 1), b2 + hstepB, voffB);
            PG8_WAIT_V(6); PG8_BAR; PG8_MMA(1, 1, At, B1); PG8_BAR;
            PG8_LDB(B0, 1, 0); PG8_SCHED; PG8_LDA(At, 1, 0); PG8_STAGE(PG8_SA(0, 1), a2 + hstepA, voffA);
            PG8_WAIT_L(8); PG8_BAR; PG8_WAIT_L(0); PG8_MMA(0, 0, At, B0); PG8_BAR; PG8_SCHED;
            PG8_LDB(B1, 1, 1); PG8_STAGE(PG8_SB(1, 0), b3, voffB);
            PG8_BAR; PG8_WAIT_L(0); PG8_MMA(0, 1, At, B1); PG8_BAR;
            PG8_LDA(At, 1, 1); PG8_STAGE(PG8_SA(1, 0), a3, voffA);
            PG8_BAR; PG8_WAIT_L(0); PG8_MMA(1, 0, At, B0); PG8_BAR; PG8_SCHED;
            PG8_STAGE(PG8_SB(1, 1), b3 + hstepB, voffB);
            PG8_WAIT_V(6); PG8_BAR; PG8_MMA(1, 1, At, B1); PG8_BAR;
            }
        }
        if constexpr (ALIGN_EPI) { if (wr == 0) PG8_BAR; }
        if constexpr (!Epi::AFTER_DRAIN) {
            if constexpr (Epi::RESETUP) { int t_ = tid; asm volatile("" : "+v"(t_)); E(acc, cur, wr, wc, t_ & 15, (t_ & 63) >> 4); }
            else E(acc, cur, wr, wc, fr, fq);
            S.done(cur); }
        if (!has_next) break;
#pragma unroll
        for (int a = 0; a < 2; ++a)
#pragma unroll
            for (int b = 0; b < 2; ++b)
#pragma unroll
                for (int m = 0; m < 4; ++m)
#pragma unroll
                    for (int n = 0; n < 2; ++n) acc[a][b][m][n] = accv{};
        cur = nxt; cA = nA; cB = nB; ++ui;
        if constexpr (Epi::RESETUP) PG8_LANE_SETUP;
        if constexpr (ALIGN_EPI) { if (wr == 1) PG8_BAR; }
    }
    PG8_WAIT_V(0);
    if constexpr (!ALIGN_EPI) { if (wr == 0) PG8_BAR; }
    PG8_BAR;
    if constexpr (Epi::AFTER_DRAIN) { E.fused(acc, cur, wr, wc, fr, fq, lds, wid, lane); S.done(cur); }
#undef PG8_LANE_SETUP
#undef PG8_SA
#undef PG8_SB
#undef PG8_STAGE
#undef PG8_LDA
#undef PG8_LDB
#undef PG8_MMA
#undef PG8_WAIT_V
#undef PG8_WAIT_L
#undef PG8_BAR
#undef PG8_SCHED
}
}


#define GAS __attribute__((address_space(1)))
#define LAS __attribute__((address_space(3)))
typedef float f32x4 __attribute__((ext_vector_type(4)));
typedef unsigned u32x4 __attribute__((ext_vector_type(4)));
#define XB_TMO      128
#define XB_XCNT(j)  (256  + 64 * (j))
#define XB_XSUB(j)  (1280 + 64 * (j))
#define XB_XGEN(j)  (2304 + 64 * (j))
#define XB_TOP      3328
#define XB_TOPGEN   3392
#define XCD_BAR_WORDS 3456
#define XB_SPIN_CAP (1u << 18)

__device__ __forceinline__ unsigned xb_ld(unsigned* p)              { return __hip_atomic_load(p, __ATOMIC_RELAXED, __HIP_MEMORY_SCOPE_AGENT); }
__device__ __forceinline__ unsigned xb_add(unsigned* p, unsigned v) { return __hip_atomic_fetch_add(p, v, __ATOMIC_RELAXED, __HIP_MEMORY_SCOPE_AGENT); }
__device__ __forceinline__ unsigned xb_xcc_id() { return (unsigned)__builtin_amdgcn_s_getreg((3 << 11) | 20) & 0xFu; }
#define XB_SPIN(cond, bar) do { unsigned _sp = 0; while (cond) { __builtin_amdgcn_s_sleep(1); \
    if ((++_sp & 255u) == 0u) { if (xb_ld(&(bar)[XB_TMO])) break; if (_sp > XB_SPIN_CAP) { atomicAdd(&(bar)[XB_TMO], 1u); break; } } } } while (0)

struct XcdBarrier {
    unsigned* bar; unsigned x;
    volatile LAS unsigned* st;
};

__device__ __forceinline__ XcdBarrier xcd_barrier_post(unsigned* bar, volatile LAS unsigned* st) {
    XcdBarrier b; b.bar = bar; b.x = xb_xcc_id(); b.st = st;
    if (threadIdx.x == 0) (void)xb_add(&bar[XB_XCNT(b.x)], 1u);
    return b;
}
__device__ __forceinline__ void xcd_barrier_complete(unsigned* bar, unsigned x, unsigned& nloc, unsigned& nx) {
    const unsigned G = gridDim.x * gridDim.y * gridDim.z;
    unsigned sum, cnt, mine, sp = 0u;
    for (;;) {
        sum = 0u; cnt = 0u; mine = 0u;
#pragma unroll
        for (unsigned j = 0; j < 16; ++j) { const unsigned c = xb_ld(&bar[XB_XCNT(j)]); sum += c; cnt += (c > 0u) ? 1u : 0u; mine = (j == x) ? c : mine; }
        if (sum == G) break;
        __builtin_amdgcn_s_sleep(1);
        if ((++sp & 255u) == 0u) { if (xb_ld(&bar[XB_TMO])) break; if (sp > XB_SPIN_CAP) { atomicAdd(&bar[XB_TMO], 1u); break; } }
    }
    nloc = mine > 0u ? mine : 1u; nx = cnt > 0u ? cnt : 1u;
}

__device__ __forceinline__ void xcd_barrier(const XcdBarrier& b) {
    asm volatile("s_waitcnt vmcnt(0)" ::: "memory");
    __syncthreads();
    if (threadIdx.x == 0) {
        unsigned* bar = b.bar;
        __builtin_amdgcn_s_waitcnt(0);
        unsigned nloc = b.st[0], nx = b.st[1];
        if (nloc == 0u) { xcd_barrier_complete(bar, b.x, nloc, nx); b.st[0] = nloc; b.st[1] = nx; }
        const unsigned old = xb_add(&bar[XB_XSUB(b.x)], 1u);
        const unsigned gen = old / nloc;
        if (old + 1u == (gen + 1u) * nloc) {
            __builtin_amdgcn_fence(__ATOMIC_RELEASE, "agent");
            asm volatile("s_waitcnt vmcnt(0)" ::: "memory");
            const unsigned og = xb_add(&bar[XB_TOP], 1u);
            const unsigned tg = og / nx;
            if (og + 1u == (tg + 1u) * nx) xb_add(&bar[XB_TOPGEN], 1u);
            else XB_SPIN(xb_ld(&bar[XB_TOPGEN]) == tg, bar);
            __builtin_amdgcn_fence(__ATOMIC_ACQUIRE, "agent");
            xb_add(&bar[XB_XGEN(b.x)], 1u);
            asm volatile("s_waitcnt vmcnt(0)" ::: "memory");
        } else {
            XB_SPIN(xb_ld(&bar[XB_XGEN(b.x)]) == gen, bar);
            __builtin_amdgcn_fence(__ATOMIC_ACQUIRE, "agent");
            asm volatile("s_waitcnt vmcnt(0)" ::: "memory");
        }
    }
    __syncthreads();
}


constexpr int NWAVES = 8;
constexpr int RING_BYTES = 131072, LDSCTL_OFF = RING_BYTES, MISC_OFF = LDSCTL_OFF + 320, LDS_BYTES = 147456;
constexpr size_t WS_CTL = 0, CTL_ZERO_BYTES = 1 * MiB;
constexpr int CW_BAR = 4096, N_BAR_REGIONS = 16;
static_assert((CW_BAR + N_BAR_REGIONS * XCD_BAR_WORDS) * 4 <= (int)CTL_ZERO_BYTES, "barrier words inside the memset region");
constexpr size_t WS_WIN = 10 * MiB;
constexpr size_t WS_WUQ = 15 * MiB;
constexpr size_t WS_WUKV = 16 * MiB;
constexpr size_t WS_WO = 17 * MiB;
constexpr size_t WS_WPQ = 19 * MiB;
constexpr size_t WS_SK = 23 * MiB;
constexpr size_t WS_U16 = 24 * MiB;
constexpr size_t WS_V16 = 56 * MiB;


namespace att {
typedef short bf16x8 __attribute__((ext_vector_type(8)));
typedef short s16x4 __attribute__((ext_vector_type(4)));
typedef float f32x16 __attribute__((ext_vector_type(16)));
constexpr int LK = 0, KSLOT = 12288, LV = 2 * KSLOT, VSLOT = 8192, LB = LV + 2 * VSLOT, BSLOT = 256, LWS = LB + 2 * BSLOT, LOST = LWS + 8 * 256, ATT_LDS = LOST + 8 * 4096;
static_assert(ATT_LDS <= 131072, "attention scratch fits the ring region");
struct Desc { const bf16_t* Q; int pq; const bf16_t* K; int pk; const bf16_t* V; int pv; bf16_t* O; int po; const float* FC; const float* QS; const float2* RP; };

__device__ __forceinline__ int crow(int r, int hi) { return (r & 3) + 8 * (r >> 2) + 4 * hi; }
__device__ __forceinline__ float xmax32(float v) { auto rr = __builtin_amdgcn_permlane32_swap(__float_as_uint(v), __float_as_uint(v), false, false); return fmaxf(__uint_as_float(rr[0]), __uint_as_float(rr[1])); }
__device__ __forceinline__ float xsum32(float v) { auto rr = __builtin_amdgcn_permlane32_swap(__float_as_uint(v), __float_as_uint(v), false, false); return __uint_as_float(rr[0]) + __uint_as_float(rr[1]); }
__device__ __forceinline__ unsigned cvtpk(float lo, float hi) { typedef float f2 __attribute__((ext_vector_type(2))); typedef __bf16 b2 __attribute__((ext_vector_type(2))); f2 v = {lo, hi}; b2 b = __builtin_convertvector(v, b2); return __builtin_bit_cast(unsigned, b); }
typedef short v4i16_t __attribute__((ext_vector_type(4)));
__device__ __forceinline__ s16x4 vtr(LAS const unsigned char* p) { return __builtin_bit_cast(s16x4, __builtin_amdgcn_ds_read_tr16_b64_v4i16((LAS v4i16_t*)p)); }

template <int KS, bool BIAS>
__device__ __forceinline__ void attn_unit(const Desc& d, int qb, int j0, LAS unsigned char* shm) {
    const int tid = threadIdx.x, lane = tid & 63, r32 = lane & 31, hi = lane >> 5; const int wid = __builtin_amdgcn_readfirstlane(tid >> 6);
    const int q0 = qb * 256, NT = (q0 + 256) / 64;
    LAS float* wsf = (LAS float*)(shm + LWS) + wid * 64;
    bf16x8 qr[KS];
    { const bf16_t* qp = d.Q + (size_t)(q0 + wid * 32 + r32) * d.pq + hi * 8;
#pragma unroll
      for (int d0 = 0; d0 < KS; ++d0) qr[d0] = *(const bf16x8*)(qp + d0 * 16); }
    if (!BIAS) {
        const int qrow = q0 + wid * 32 + r32;
        const float2 ss = *(const float2*)(d.QS + (size_t)qrow * 16);
        const f32x4* cp = (const f32x4*)(d.RP + (size_t)qrow * 16 + hi * 8);
        const f32x4 cs0 = cp[0], cs1 = cp[1], cs2 = cp[2], cs3 = cp[3];
        const float rr = rsqrtf((ss.x + ss.y) * (1.f / 96.f) + EPS) * C2A;
#pragma unroll
        for (int d0 = 0; d0 < 4; ++d0) { const u32x4 w = __builtin_bit_cast(u32x4, qr[d0]); u32x4 o;
#pragma unroll
            for (int i = 0; i < 4; ++i) o[i] = cvtpk(lo2f(w[i]) * rr, hi2f(w[i]) * rr);
            qr[d0] = __builtin_bit_cast(bf16x8, o); }
        { const u32x4 wa = __builtin_bit_cast(u32x4, qr[4]), wb = __builtin_bit_cast(u32x4, qr[5]); u32x4 oa, ob;
#pragma unroll
          for (int i = 0; i < 4; ++i) { const f32x4 c = i == 0 ? cs0 : i == 1 ? cs1 : i == 2 ? cs2 : cs3;
              const float a0 = lo2f(wa[i]) * rr, a1 = hi2f(wa[i]) * rr, b0 = lo2f(wb[i]) * rr, b1 = hi2f(wb[i]) * rr;
              oa[i] = cvtpk(a0 * c[0] - b0 * c[1], a1 * c[2] - b1 * c[3]); ob[i] = cvtpk(b0 * c[0] + a0 * c[1], b1 * c[2] + a1 * c[3]); }
          qr[4] = __builtin_bit_cast(bf16x8, oa); qr[5] = __builtin_bit_cast(bf16x8, ob); }
    }
    const float fcref = BIAS ? d.FC[q0] : 0.f;
    const bf16_t* ksrc0 = d.K + (size_t)lane * d.pk + wid * 8;
    const bf16_t* ksrc1 = d.K + (size_t)lane * d.pk + (8 + wid) * 8;
    const bf16_t* vsrc = d.V + (size_t)(16 * (wid & 3) + (lane >> 2)) * d.pv + (wid >> 2) * 32 + (lane & 3) * 8;
    const int kdst0 = LK + wid * 1024 + lane * 16, kdst1 = LK + (8 + wid) * 1024 + lane * 16, vdst = LV + wid * 1024 + lane * 16;
    const bool k2 = (KS > 4) && (wid < 2 * KS - 8);
    u32x4 kr0, kr1, vr; float br = 0.f;
#define ATT_LOAD(t, slot) do { \
        __builtin_amdgcn_global_load_lds((const unsigned*)(ksrc0 + (size_t)(t) * 64 * d.pk), (LAS unsigned*)(shm + LK + wid * 1024 + (slot) * KSLOT), 16, 0, 0); \
        if (k2) __builtin_amdgcn_global_load_lds((const unsigned*)(ksrc1 + (size_t)(t) * 64 * d.pk), (LAS unsigned*)(shm + LK + (8 + wid) * 1024 + (slot) * KSLOT), 16, 0, 0); \
        __builtin_amdgcn_global_load_lds((const unsigned*)(vsrc + (size_t)(t) * 64 * d.pv), (LAS unsigned*)(shm + LV + wid * 1024 + (slot) * VSLOT), 16, 0, 0); \
        if (BIAS && wid == 4) br = d.FC[(t) * 64 + lane]; } while (0)
#define ATT_WRITE(slot) do { if (BIAS && wid == 4) *(LAS float*)(shm + LB + (slot) * BSLOT + lane * 4) = (fcref - br) * LOG2E; } while (0)
    f32x16 o0, o1, negm;
#pragma unroll
    for (int r = 0; r < 16; ++r) { o0[r] = 0.f; o1[r] = 0.f; negm[r] = 0.f; }
    float mref = 0.f, l = 0.f;
    constexpr float THR = BIAS ? 40.f : 8.f;
    const int qrel = wid * 32 + r32;
    const int kfrag = LK + hi * 1024 + r32 * 16;
    const int vfrag = LV + ((lane >> 4) & 1) * 32 + (lane & 3) * 8 + (4 * hi + ((lane & 15) >> 2)) * 64;
    ATT_LOAD(j0, 0); ATT_WRITE(0);
    __syncthreads();
    for (int t = j0; t < NT; ++t) {
        const int slot = (t - j0) & 1;
        if (t + 1 < NT) ATT_LOAD(t + 1, slot ^ 1);
        const int jb = t - (NT - 4);
        if (!(jb >= 0 && 64 * jb > 32 * wid + 31)) {
            f32x16 p0, p1;
            if (BIAS) {
                LAS const unsigned char* bp = shm + LB + slot * BSLOT + 16 * hi;
#pragma unroll
                for (int g = 0; g < 4; ++g) { const f32x4 a = *(LAS const f32x4*)(bp + 32 * g), b = *(LAS const f32x4*)(bp + 128 + 32 * g);
#pragma unroll
                    for (int i = 0; i < 4; ++i) { p0[4 * g + i] = a[i] + negm[4 * g + i]; p1[4 * g + i] = b[i] + negm[4 * g + i]; } }
            } else { p0 = negm; p1 = negm; }
            LAS const unsigned char* kp = shm + kfrag + slot * KSLOT;
#pragma unroll
            for (int d0 = 0; d0 < KS; ++d0) {
                const bf16x8 a0 = *(LAS const bf16x8*)(kp + d0 * 2048), a1 = *(LAS const bf16x8*)(kp + d0 * 2048 + 512);
                p0 = __builtin_amdgcn_mfma_f32_32x32x16_bf16(a0, qr[d0], p0, 0, 0, 0);
                p1 = __builtin_amdgcn_mfma_f32_32x32x16_bf16(a1, qr[d0], p1, 0, 0, 0);
            }
            if (jb >= 0) {
                const int kb = 64 * jb + 4 * hi;
#pragma unroll
                for (int r = 0; r < 16; ++r) { const int kv = kb + (r & 3) + 8 * (r >> 2); if (kv > qrel) p0[r] = -INFINITY; if (kv + 32 > qrel) p1[r] = -INFINITY; }
            }
            float ra = __builtin_fmaxf(__builtin_fmaxf(p0[0], p0[1]), p1[0]), rb = __builtin_fmaxf(__builtin_fmaxf(p0[2], p0[3]), p1[1]);
            ra = __builtin_fmaxf(__builtin_fmaxf(ra, p1[2]), p1[3]);
#pragma unroll
            for (int r = 4; r < 16; r += 4) { ra = __builtin_fmaxf(__builtin_fmaxf(ra, p0[r]), p0[r + 1]); rb = __builtin_fmaxf(__builtin_fmaxf(rb, p0[r + 2]), p0[r + 3]);
                ra = __builtin_fmaxf(__builtin_fmaxf(ra, p1[r]), p1[r + 1]); rb = __builtin_fmaxf(__builtin_fmaxf(rb, p1[r + 2]), p1[r + 3]); }
            const float rm = xmax32(__builtin_fmaxf(ra, rb));
            if (__any(rm > THR) || t == j0) {
                const float dl = t == j0 ? rm : __builtin_fmaxf(rm, 0.f);
                mref += dl;
#pragma unroll
                for (int r = 0; r < 16; ++r) { p0[r] -= dl; p1[r] -= dl; negm[r] = -mref; }
                if (t != j0) {
                    const float alpha = __builtin_amdgcn_exp2f(-dl);
                    l *= alpha;
                    if (hi == 0) wsf[r32] = alpha;
#pragma unroll
                    for (int g = 0; g < 4; ++g) { const f32x4 a = *(LAS const f32x4*)(wsf + 8 * g + 4 * hi);
#pragma unroll
                        for (int i = 0; i < 4; ++i) { o0[4 * g + i] *= a[i]; o1[4 * g + i] *= a[i]; } }
                }
            }
            float s0 = 0.f, s1 = 0.f, s2 = 0.f, s3 = 0.f;
#pragma unroll
            for (int r = 0; r < 16; r += 2) { p0[r] = __builtin_amdgcn_exp2f(p0[r]); p0[r + 1] = __builtin_amdgcn_exp2f(p0[r + 1]); p1[r] = __builtin_amdgcn_exp2f(p1[r]); p1[r + 1] = __builtin_amdgcn_exp2f(p1[r + 1]);
                s0 += p0[r]; s1 += p0[r + 1]; s2 += p1[r]; s3 += p1[r + 1]; }
            l += (s0 + s1) + (s2 + s3);
            LAS const unsigned char* vp = shm + vfrag + slot * VSLOT;
#pragma unroll
            for (int ks = 0; ks < 4; ++ks) {
                const f32x16& pp = ks < 2 ? p0 : p1; const int bq = (ks & 1) * 8;
                u32x4 pw; pw.x = cvtpk(pp[bq], pp[bq + 1]); pw.y = cvtpk(pp[bq + 2], pp[bq + 3]); pw.z = cvtpk(pp[bq + 4], pp[bq + 5]); pw.w = cvtpk(pp[bq + 6], pp[bq + 7]);
                const bf16x8 pa = __builtin_bit_cast(bf16x8, pw);
                const s16x4 l0 = vtr(vp + ks * 1024), h0 = vtr(vp + ks * 1024 + 512), l1 = vtr(vp + 4096 + ks * 1024), h1 = vtr(vp + 4096 + ks * 1024 + 512);
                const bf16x8 v0 = {l0[0], l0[1], l0[2], l0[3], h0[0], h0[1], h0[2], h0[3]}, v1 = {l1[0], l1[1], l1[2], l1[3], h1[0], h1[1], h1[2], h1[3]};
                o0 = __builtin_amdgcn_mfma_f32_32x32x16_bf16(pa, v0, o0, 0, 0, 0);
                o1 = __builtin_amdgcn_mfma_f32_32x32x16_bf16(pa, v1, o1, 0, 0, 0);
            }
        }
        if (t + 1 < NT) ATT_WRITE(slot ^ 1);
        __syncthreads();
    }
#undef ATT_LOAD
#undef ATT_WRITE
    l = xsum32(l);
    if (hi == 0) wsf[32 + r32] = l;
    float rli[16];
#pragma unroll
    for (int g = 0; g < 4; ++g) { const f32x4 a = *(LAS const f32x4*)(wsf + 32 + 8 * g + 4 * hi);
#pragma unroll
        for (int i = 0; i < 4; ++i) rli[4 * g + i] = 1.f / a[i]; }
    LAS bf16_t* stg = (LAS bf16_t*)(shm + LOST) + wid * 2048;
#pragma unroll
    for (int r = 0; r < 16; ++r) { const int orow = crow(r, hi); stg[orow * 64 + r32] = f2bf(o0[r] * rli[r]); stg[orow * 64 + 32 + r32] = f2bf(o1[r] * rli[r]); }
    bf16_t* Ow = d.O + (size_t)(q0 + wid * 32) * d.po;
#pragma unroll
    for (int i = 0; i < 4; ++i) { const int row = i * 8 + (lane >> 3), ch = lane & 7; const u32x4 v = *(LAS const u32x4*)(stg + row * 64 + ch * 8); *(u32x4*)(Ow + (size_t)row * d.po + ch * 8) = v; }
    __syncthreads();
}
}


namespace pk {
typedef short bf16x8 __attribute__((ext_vector_type(8)));
typedef float f32x16 __attribute__((ext_vector_type(16)));
template <int I> struct COff { static constexpr int v = COff<I - 1>::v + 16 / I; };
template <> struct COff<0> { static constexpr int v = 0; };
static_assert(COff<16>::v == 50, "50 candidates can reach the top 16 of a sorted 16 x 16 sum grid");
__device__ __forceinline__ void cef(float& a, float& b) { const float mx = fmaxf(a, b), mn = fminf(a, b); a = mx; b = mn; }
__device__ __forceinline__ void sort16f(float (&v)[16]) {
#pragma unroll
    for (int k = 2; k <= 16; k <<= 1)
#pragma unroll
        for (int j = k >> 1; j >= 1; j >>= 1)
#pragma unroll
            for (int i = 0; i < 16; ++i) { const int l = i ^ j; if (l > i) { if ((i & k) == 0) cef(v[i], v[l]); else cef(v[l], v[i]); } }
}
__device__ __forceinline__ void merge16f(float (&a)[16], const float (&b)[16]) {
#pragma unroll
    for (int i = 0; i < 16; ++i) a[i] = fmaxf(a[i], b[15 - i]);
#pragma unroll
    for (int j = 8; j >= 1; j >>= 1)
#pragma unroll
        for (int i = 0; i < 16; ++i) { const int l = i ^ j; if (l > i) cef(a[i], a[l]); }
}
__device__ __forceinline__ float keyf(float v, unsigned code, unsigned mask) { return __uint_as_float((__float_as_uint(v) & mask) | code); }
template <int I> __device__ __forceinline__ void fill_candf(float (&c)[64], const float (&s1)[16], const float (&s2)[16]) {
    if constexpr (I < 16) {
#pragma unroll
        for (int j = 0; j < 16 / (I + 1); ++j) c[COff<I>::v + j] = keyf(s1[I] + s2[j], (unsigned)(255 - (I * 16 + j)), 0xFFFFFF00u);
        fill_candf<I + 1>(c, s1, s2);
    }
}
__device__ __forceinline__ void head_half(const bf16_t* QP, const bf16_t* SK, int t, int h, int p, int r32, int hi, const unsigned (&lowc)[16], float (&own)[16]) {
    const bf16_t* qrow = QP + (size_t)t * 2048 + h * 256 + p * 128 + hi * 8;
    bf16x8 qf[8];
#pragma unroll
    for (int d0 = 0; d0 < 8; ++d0) qf[d0] = *(const bf16x8*)(qrow + d0 * 16);
    const bf16_t* skb = SK + (size_t)((h * 2 + p) * 128 + r32) * 128 + hi * 8;
#pragma unroll 1
    for (int kt = 0; kt < 4; ++kt) {
        f32x16 acc;
#pragma unroll
        for (int r = 0; r < 16; ++r) acc[r] = 0.f;
#pragma unroll
        for (int d0 = 0; d0 < 8; ++d0) { const bf16x8 a = *(const bf16x8*)(skb + (size_t)kt * 32 * 128 + d0 * 16); acc = __builtin_amdgcn_mfma_f32_32x32x16_bf16(a, qf[d0], acc, 0, 0, 0); }
        float cur[16];
#pragma unroll
        for (int r = 0; r < 16; ++r) cur[r] = keyf(acc[r], lowc[r] - 32u * (unsigned)kt, 0xFFFFFF80u);
        sort16f(cur);
        if (kt == 0) {
#pragma unroll
            for (int r = 0; r < 16; ++r) own[r] = cur[r];
        } else merge16f(own, cur);
    }
}
__device__ __forceinline__ void topk_item2(const bf16_t* QP, const bf16_t* SK, int* EID, float* GATE, int item, int lane) {
    const int tg = item >> 2, hp = item & 3, r32 = lane & 31, hi = lane >> 5;
    const int t = tg * 32 + r32;
    unsigned lowc[16];
#pragma unroll
    for (int r = 0; r < 16; ++r) lowc[r] = (unsigned)(127 - ((r & 3) + 8 * (r >> 2)) - 4 * hi);
    float finA[16], finB[16];
#pragma unroll
    for (int hh = 0; hh < 2; ++hh) {
        const int h = 2 * hp + hh;
        float own0[16], own1[16];
        head_half(QP, SK, t, h, 0, r32, hi, lowc, own0);
        head_half(QP, SK, t, h, 1, r32, hi, lowc, own1);
        float fin[16], oth[16];
#pragma unroll
        for (int i = 0; i < 16; ++i) { auto rr = __builtin_amdgcn_permlane32_swap(__float_as_uint(own0[i]), __float_as_uint(own1[i]), false, false); fin[i] = __uint_as_float(rr[0]); oth[i] = __uint_as_float(rr[1]); }
        merge16f(fin, oth);
#pragma unroll
        for (int i = 0; i < 16; ++i) { if (hh == 0) finA[i] = fin[i]; else finB[i] = fin[i]; }
    }
    float s1[16], s2[16];
#pragma unroll
    for (int i = 0; i < 16; ++i) { auto rr = __builtin_amdgcn_permlane32_swap(__float_as_uint(finA[i]), __float_as_uint(finB[i]), false, false); s1[i] = __uint_as_float(rr[0]); s2[i] = __uint_as_float(rr[1]); }
    const int h = 2 * hp + hi;
    unsigned long long i1lo = 0ull, i1hi = 0ull, i2lo = 0ull, i2hi = 0ull;
#pragma unroll
    for (int i = 0; i < 16; ++i) {
        const unsigned long long a = (unsigned long long)(127u - (__float_as_uint(s1[i]) & 0x7Fu)) << (8 * (i & 7)), b = (unsigned long long)(127u - (__float_as_uint(s2[i]) & 0x7Fu)) << (8 * (i & 7));
        if (i < 8) { i1lo |= a; i2lo |= b; } else { i1hi |= a; i2hi |= b; } }
    float c64[64];
#pragma unroll
    for (int i = 50; i < 64; ++i) c64[i] = -INFINITY;
    fill_candf<0>(c64, s1, s2);
    float top[16];
    {
        float g1[16], g2[16], g3[16];
#pragma unroll
        for (int i = 0; i < 16; ++i) { top[i] = c64[i]; g1[i] = c64[16 + i]; g2[i] = c64[32 + i]; g3[i] = c64[48 + i]; }
        sort16f(g1); sort16f(g2); sort16f(g3);
        merge16f(top, g1); merge16f(g2, g3); merge16f(top, g2);
    }
    float ev[16]; float sum = 0.f; const float mx = top[0];
#pragma unroll
    for (int r = 0; r < 16; ++r) { ev[r] = __expf(top[r] - mx); sum += ev[r]; }
    const float rs = 1.f / sum;
    int* ep = EID + (size_t)t * 128 + h * 16; float* gp = GATE + (size_t)t * 128 + h * 16;
#pragma unroll
    for (int q4 = 0; q4 < 4; ++q4) { int ee[4];
#pragma unroll
        for (int z = 0; z < 4; ++z) { const int code = 255 - (int)(__float_as_uint(top[q4 * 4 + z]) & 0xFFu), i = code >> 4, j = code & 15;
            const unsigned e1 = (unsigned)(((i & 8) ? i1hi : i1lo) >> (8 * (i & 7))) & 0xFFu, e2 = (unsigned)(((j & 8) ? i2hi : i2lo) >> (8 * (j & 7))) & 0xFFu; ee[z] = (int)(e1 * 128u + e2); }
        *(int4*)(ep + q4 * 4) = make_int4(ee[0], ee[1], ee[2], ee[3]);
        *(float4*)(gp + q4 * 4) = make_float4(ev[q4 * 4] * rs, ev[q4 * 4 + 1] * rs, ev[q4 * 4 + 2] * rs, ev[q4 * 4 + 3] * rs); }
}
}


namespace gx {
typedef unsigned char u8x4 __attribute__((ext_vector_type(4)));
__device__ __forceinline__ int sdot16(const int4 a, const int4 b) {
    int s = __builtin_amdgcn_sdot4(a.x, b.x, 0, false); s = __builtin_amdgcn_sdot4(a.y, b.y, s, false); s = __builtin_amdgcn_sdot4(a.z, b.z, s, false); return __builtin_amdgcn_sdot4(a.w, b.w, s, false);
}
__device__ __forceinline__ float gelu_t(float x) { const float u = 0.7978845608028654f * (x + 0.044715f * x * x * x); return 0.5f * x * (1.f + tanhf(u)); }

__device__ __forceinline__ int hx(int lo, int hi, bool up, int bit) { const int send = up ? lo : hi, keep = up ? hi : lo; return keep + __shfl_xor(send, bit); }

__device__ __forceinline__ void u_gather(const unsigned char* UQs  , unsigned sub16  , const int4 (&ev)[4], int4 (&rows)[16]) {
    const int e[16] = {ev[0].x, ev[0].y, ev[0].z, ev[0].w, ev[1].x, ev[1].y, ev[1].z, ev[1].w, ev[2].x, ev[2].y, ev[2].z, ev[2].w, ev[3].x, ev[3].y, ev[3].z, ev[3].w};
#pragma unroll
    for (int i = 0; i < 16; ++i) rows[i] = *(const int4*)(UQs + (((unsigned)e[i] << 7) | sub16));
}
__device__ __forceinline__ void u_compute(const int4 (&rows)[16], const int4 hq, int* PArow, int lane) {
    int p[16];
#pragma unroll
    for (int i = 0; i < 16; ++i) p[i] = sdot16(rows[i], hq);
    const bool b2 = (lane & 4) != 0, b1 = (lane & 2) != 0, b0 = (lane & 1) != 0;
    int q[8], r[4];
#pragma unroll
    for (int k = 0; k < 8; ++k) q[k] = hx(p[k], p[8 + k], b2, 4);
#pragma unroll
    for (int k = 0; k < 4; ++k) r[k] = hx(q[k], q[4 + k], b1, 2);
    const int z0 = hx(r[0], r[2], b0, 1), z1 = hx(r[1], r[3], b0, 1);
    *(int2*)(PArow + 2 * lane) = make_int2(z0, z1);
}

__device__ __forceinline__ void v_gather(const unsigned char* VQs  , unsigned sub16  , const int4 (&ev)[4], uint4 (&rows)[16]) {
    const int e[16] = {ev[0].x, ev[0].y, ev[0].z, ev[0].w, ev[1].x, ev[1].y, ev[1].z, ev[1].w, ev[2].x, ev[2].y, ev[2].z, ev[2].w, ev[3].x, ev[3].y, ev[3].z, ev[3].w};
#pragma unroll
    for (int i = 0; i < 16; ++i) rows[i] = *(const uint4*)(VQs + (((unsigned)e[i] << 7) | sub16));
}
__device__ __forceinline__ void v_token(const uint4 (&rows)[16], const int4 wh, float wscale, const float* gate2, const float* x1row, const bf16_t* dlrow, float* outrow, int s, int lane) {
    const int whv[4] = {wh.x, wh.y, wh.z, wh.w};
    int ah[16];
#pragma unroll
    for (int c = 0; c < 16; ++c) ah[c] = 0;
#pragma unroll
    for (int g = 0; g < 4; ++g) {
#pragma unroll
        for (int d = 0; d < 4; ++d) {
            const unsigned A = d == 0 ? rows[4 * g].x : d == 1 ? rows[4 * g].y : d == 2 ? rows[4 * g].z : rows[4 * g].w;
            const unsigned B = d == 0 ? rows[4 * g + 1].x : d == 1 ? rows[4 * g + 1].y : d == 2 ? rows[4 * g + 1].z : rows[4 * g + 1].w;
            const unsigned C = d == 0 ? rows[4 * g + 2].x : d == 1 ? rows[4 * g + 2].y : d == 2 ? rows[4 * g + 2].z : rows[4 * g + 2].w;
            const unsigned D = d == 0 ? rows[4 * g + 3].x : d == 1 ? rows[4 * g + 3].y : d == 2 ? rows[4 * g + 3].z : rows[4 * g + 3].w;
            const unsigned ab01 = __builtin_amdgcn_perm(A, B, 0x01050004u), ab23 = __builtin_amdgcn_perm(A, B, 0x03070206u);
            const unsigned cd01 = __builtin_amdgcn_perm(C, D, 0x01050004u), cd23 = __builtin_amdgcn_perm(C, D, 0x03070206u);
            const int q0 = (int)__builtin_amdgcn_perm(ab01, cd01, 0x01000504u), q1 = (int)__builtin_amdgcn_perm(ab01, cd01, 0x03020706u);
            const int q2 = (int)__builtin_amdgcn_perm(ab23, cd23, 0x01000504u), q3 = (int)__builtin_amdgcn_perm(ab23, cd23, 0x03020706u);
            ah[4 * d + 0] = __builtin_amdgcn_sdot4(q0, whv[g], ah[4 * d + 0], false);
            ah[4 * d + 1] = __builtin_amdgcn_sdot4(q1, whv[g], ah[4 * d + 1], false);
            ah[4 * d + 2] = __builtin_amdgcn_sdot4(q2, whv[g], ah[4 * d + 2], false);
            ah[4 * d + 3] = __builtin_amdgcn_sdot4(q3, whv[g], ah[4 * d + 3], false);
        }
    }
    int y[16];
#pragma unroll
    for (int c = 0; c < 16; ++c) y[c] = ah[c];
    const bool b5 = (lane & 32) != 0, b4 = (lane & 16) != 0, b3 = (lane & 8) != 0;
    int z[8], q[4];
#pragma unroll
    for (int k = 0; k < 8; ++k) { auto rr = __builtin_amdgcn_permlane32_swap((unsigned)y[k], (unsigned)y[8 + k], false, false); z[k] = (int)rr[0] + (int)rr[1]; }
#pragma unroll
    for (int k = 0; k < 4; ++k) { auto rr = __builtin_amdgcn_permlane16_swap((unsigned)z[k], (unsigned)z[4 + k], false, false); q[k] = (int)rr[0] + (int)rr[1]; }
    const int r0 = hx(q[0], q[2], b3, 8), r1 = hx(q[1], q[3], b3, 8);
    const int col = 128 * s + 16 * (lane & 7) + (b5 ? 8 : 0) + (b4 ? 4 : 0) + (b3 ? 2 : 0);
    const float2 g2 = *(const float2*)(gate2 + col); float2 x1 = *(const float2*)(x1row + col); { const unsigned dd = *(const unsigned*)(dlrow + col); x1.x += lo2f(dd); x1.y += hi2f(dd); }
    x1.x += g2.x * wscale * (float)r0; x1.y += g2.y * wscale * (float)r1;
    *(float2*)(outrow + col) = x1;
}
}

constexpr size_t WS_SU = 2 * MiB, WS_SV = 2 * MiB + 65536, WS_HS = 2 * MiB + 131072;
constexpr size_t WS_UQ = 24 * MiB, WS_VQ = 40 * MiB, WS_H2Q = 56 * MiB;
constexpr size_t WS_XS = 2 * MiB + 262144, WS_WINS = 2 * MiB + 393216, WS_WPQS = 2 * MiB + 409600;
constexpr size_t WS_WINQ = 456 * MiB, WS_WPQQ = 460 * MiB;
constexpr size_t WS_SSQQ = 462 * MiB, WS_SSQK = 3 * MiB;
constexpr size_t WS_SSQ = 464 * MiB;
constexpr size_t WS_A = WS_KA;
struct Args { const void* in[22]; float* out; unsigned char* ws; int ph_lo, ph_hi, li, pad; };

struct Frame {
    LAS unsigned char* lds;
    int tid, lane, wave, G, gw, NGW;
};

__host__ __device__ __forceinline__ int nat_col(int rho) {
    if (rho < 672) return rho;
    if (rho < 680) return C_FL + (rho - 672);
    if (rho < 768) return -1;
    if (rho < 1792) { const int t = (rho - 768) >> 8, c = (rho - 768) & 255, bj = c >> 7, wc = (c & 127) >> 5, i = c & 31; return (t < 2 ? C_FQ : C_FK) + 64 * (4 * (t & 1) + wc) + 32 * bj + i; }
    return C_FV + (rho - 1792);
}
__host__ __device__ __forceinline__ int nat_col_q(int n) {
    const int pn = n >> 8, c = n & 255, bj = c >> 7, wc = (c & 127) >> 5, i5 = c & 31;
    if (pn < 2) return (4 * pn + wc) * 96 + 32 * bj + i5;
    const int fq = i5 >> 3, k = i5 & 7; return (2 * wc + (fq >> 1)) * 96 + 64 + 16 * bj + (fq & 1) * 8 + k;
}
__host__ __device__ __forceinline__ int nat_col_kv(int n) {
    const int pn = n >> 8, c = n & 255, bj = c >> 7, wc = (c & 127) >> 5, i5 = c & 31;
    return (4 * (pn & 1) + wc) * 128 + (pn >= 2 ? 64 : 0) + 32 * bj + i5;
}
namespace pg8 {
struct EpiProjI8 {
    static constexpr bool PERM = true, AFTER_DRAIN = false, RESETUP = false;
    bf16_t* P; float* LOGF; float* SSQ; const float* rs; const float* cs; const float* g_fq; const float* g_fk; const float* b_f; float* SSQK;
    __device__ __forceinline__ void operator()(const i32x4 (&acc)[2][2][4][2], const Unit& u, int wr, int wc, int fr, int fq) const {
        const int row0 = u.pm * BM + wr * 64 + fr, rho0 = u.pn * BM + wc * 32 + 8 * fq, pn = u.pn;
        f32x4 c0[2], c1[2];
#pragma unroll
        for (int bj = 0; bj < 2; ++bj) { c0[bj] = *(const f32x4*)(cs + rho0 + bj * HALF); c1[bj] = *(const f32x4*)(cs + rho0 + bj * HALF + 4); }
        const bool fox = pn >= 3 && pn <= 6, isq = pn < 5;
        f32x4 g0[2], g1[2];
        if (fox) { const float* g = (isq ? g_fq : g_fk) + 8 * fq;
#pragma unroll
            for (int bj = 0; bj < 2; ++bj) { g0[bj] = *(const f32x4*)(g + 32 * bj); g1[bj] = *(const f32x4*)(g + 32 * bj + 4); } }
        float r8[8];
#pragma unroll
        for (int i = 0; i < 8; ++i) r8[i] = rs[row0 + (i >> 2) * HALF + (i & 3) * 16];
#pragma unroll
        for (int ai = 0; ai < 2; ++ai)
#pragma unroll
            for (int m = 0; m < 4; ++m) {
                const int row = row0 + ai * HALF + m * 16; bf16_t* rowp = P + (size_t)row * PP; const float r = r8[ai * 4 + m];
                f32x4 v0[2], v1[2];
#pragma unroll
                for (int bj = 0; bj < 2; ++bj) { const i32x4 a0 = acc[ai][bj][m][0], a1 = acc[ai][bj][m][1];
                    v0[bj] = (f32x4){(float)a0[0] * r * c0[bj][0], (float)a0[1] * r * c0[bj][1], (float)a0[2] * r * c0[bj][2], (float)a0[3] * r * c0[bj][3]};
                    v1[bj] = (f32x4){(float)a1[0] * r * c1[bj][0], (float)a1[1] * r * c1[bj][1], (float)a1[2] * r * c1[bj][2], (float)a1[3] * r * c1[bj][3]}; }
                float ssb[2];
#pragma unroll
                for (int bj = 0; bj < 2; ++bj) { float q = (v0[bj][0] * v0[bj][0] + v0[bj][1] * v0[bj][1]) + (v0[bj][2] * v0[bj][2] + v0[bj][3] * v0[bj][3]) + (v1[bj][0] * v1[bj][0] + v1[bj][1] * v1[bj][1]) + (v1[bj][2] * v1[bj][2] + v1[bj][3] * v1[bj][3]);
                    { auto r16 = __builtin_amdgcn_permlane16_swap(__float_as_uint(q), __float_as_uint(q), false, false); q = __uint_as_float(r16[0]) + __uint_as_float(r16[1]); }
                    { auto r32 = __builtin_amdgcn_permlane32_swap(__float_as_uint(q), __float_as_uint(q), false, false); q = __uint_as_float(r32[0]) + __uint_as_float(r32[1]); }
                    ssb[bj] = q; }
                if (pn == 2 && wc == 0 && fq == 0) SSQK[row] = ssb[1];
                if (fox) {
                    const float rr = rsqrtf((ssb[0] + ssb[1]) * (1.f / 64.f) + EPS) * (isq ? C2F : 1.f);
                    const int dst = (isq ? C_FQ : C_FK) + 64 * (4 * ((pn - 3) & 1) + wc) + 8 * fq;
#pragma unroll
                    for (int bj = 0; bj < 2; ++bj) { u32x4 w; w.x = cvt_pk_bf16(v0[bj][0] * rr * g0[bj][0], v0[bj][1] * rr * g0[bj][1]); w.y = cvt_pk_bf16(v0[bj][2] * rr * g0[bj][2], v0[bj][3] * rr * g0[bj][3]);
                        w.z = cvt_pk_bf16(v1[bj][0] * rr * g1[bj][0], v1[bj][1] * rr * g1[bj][1]); w.w = cvt_pk_bf16(v1[bj][2] * rr * g1[bj][2], v1[bj][3] * rr * g1[bj][3]);
                        *(u32x4*)(rowp + dst + 32 * bj) = w; }
                } else {
#pragma unroll
                    for (int bj = 0; bj < 2; ++bj) {
                        const int rho = rho0 + bj * HALF;
                        if (rho == 672) {
                            const float z[8] = {v0[bj][0], v0[bj][1], v0[bj][2], v0[bj][3], v1[bj][0], v1[bj][1], v1[bj][2], v1[bj][3]};
                            const int b = row / S_, sq = row % S_;
#pragma unroll
                            for (int h = 0; h < 8; ++h) { const float zz = z[h] + b_f[h]; LOGF[((size_t)b * 8 + h) * S_ + sq] = fminf(zz, 0.f) - log1pf(expf(-fabsf(zz))); }
                        } else if (rho < 672 || rho >= 1792) {
                            const int dst = rho < 672 ? rho : C_FV + (rho - 1792);
                            u32x4 w; w.x = cvt_pk_bf16(v0[bj][0], v0[bj][1]); w.y = cvt_pk_bf16(v0[bj][2], v0[bj][3]); w.z = cvt_pk_bf16(v1[bj][0], v1[bj][1]); w.w = cvt_pk_bf16(v1[bj][2], v1[bj][3]);
                            *(u32x4*)(rowp + dst) = w;
                            if (fq == 0 && rho < 640) {
                                if (pn == 0) { if (bj == 1) SSQ[(size_t)row * 16 + wc] = ssb[0] + ssb[1]; }
                                else if (pn == 1) SSQ[(size_t)row * 16 + (bj == 0 ? 4 : 8) + wc] = ssb[bj];
                                else SSQ[(size_t)row * 16 + 12 + wc] = ssb[bj];
                            }
                        }
                    }
                }
            }
    }
};
struct EpiStoreRms {
    static constexpr bool PERM = true, AFTER_DRAIN = false, RESETUP = false;
    bf16_t* O; int ldc; const float* SSQ; int slot0; float inv_cnt;
    __device__ __forceinline__ void operator()(const f32x4 (&acc)[2][2][4][2], const Unit& u, int wr, int wc, int fr, int fq) const {
        const int row0 = u.pm * BM + wr * 64 + fr, col0 = u.pn * BM + wc * 32 + 8 * fq;
#pragma unroll
        for (int ai = 0; ai < 2; ++ai)
#pragma unroll
            for (int m = 0; m < 4; ++m) { const int row = row0 + ai * HALF + m * 16; bf16_t* rowp = O + (size_t)row * ldc + col0;
                const f32x4 sa = *(const f32x4*)(SSQ + (size_t)row * 16 + slot0), sb = *(const f32x4*)(SSQ + (size_t)row * 16 + slot0 + 4);
                const float r = rsqrtf(((sa[0] + sa[1]) + (sa[2] + sa[3]) + (sb[0] + sb[1]) + (sb[2] + sb[3])) * inv_cnt + EPS);
#pragma unroll
                for (int bj = 0; bj < 2; ++bj) { const f32x4 v0 = acc[ai][bj][m][0] * r, v1 = acc[ai][bj][m][1] * r;
                    u32x4 w; w.x = cvt_pk_bf16(v0[0], v0[1]); w.y = cvt_pk_bf16(v0[2], v0[3]); w.z = cvt_pk_bf16(v1[0], v1[1]); w.w = cvt_pk_bf16(v1[2], v1[3]);
                    *(u32x4*)(rowp + bj * HALF) = w; } }
    }
};
#define EPI_SUM16 { auto r16 = __builtin_amdgcn_permlane16_swap(__float_as_uint(q), __float_as_uint(q), false, false); q = __uint_as_float(r16[0]) + __uint_as_float(r16[1]); }
#define EPI_SUM32 { auto r32 = __builtin_amdgcn_permlane32_swap(__float_as_uint(q), __float_as_uint(q), false, false); q = __uint_as_float(r32[0]) + __uint_as_float(r32[1]); }
__device__ __forceinline__ float sumsq8(const f32x4 a, const f32x4 b) { return (a[0] * a[0] + a[1] * a[1]) + (a[2] * a[2] + a[3] * a[3]) + (b[0] * b[0] + b[1] * b[1]) + (b[2] * b[2] + b[3] * b[3]); }
__device__ __forceinline__ void row_rms4(float (&r)[4], const float* SSQ8  , int row0, float inv_cnt) {
    f32x4 sa[4], sb[4];
#pragma unroll
    for (int i = 0; i < 4; ++i) { const int row = row0 + i * 16; sa[i] = *(const f32x4*)(SSQ8 + (unsigned)row * 16u); sb[i] = *(const f32x4*)(SSQ8 + (unsigned)row * 16u + 4); }
#pragma unroll
    for (int i = 0; i < 4; ++i) r[i] = rsqrtf(((sa[i][0] + sa[i][1]) + (sa[i][2] + sa[i][3]) + (sb[i][0] + sb[i][1]) + (sb[i][2] + sb[i][3])) * inv_cnt + EPS);
}
struct EpiMlaQ {
    static constexpr bool PERM = true, AFTER_DRAIN = false, RESETUP = true;
    bf16_t* QA; float* SSQQ; const float* SSQ; const float* g;
    __device__ __forceinline__ void operator()(const f32x4 (&acc)[2][2][4][2], const Unit& u, int wr, int wc, int fr, int fq) const {
        const int row0 = u.pm * BM + wr * 64 + fr, pn = u.pn;
        const bool rope = pn == 2;
        const int h = rope ? 2 * wc + (fq >> 1) : 4 * pn + wc, dA = rope ? 64 + (fq & 1) * 8 : 8 * fq, dstep = rope ? 16 : 32;
        const bool wr_ss = rope ? (fq & 1) == 0 : fq == 0;
        f32x4 g0[2], g1[2];
#pragma unroll
        for (int bj = 0; bj < 2; ++bj) { g0[bj] = *(const f32x4*)(g + dA + dstep * bj); g1[bj] = *(const f32x4*)(g + dA + dstep * bj + 4); }
#pragma unroll
        for (int ai = 0; ai < 2; ++ai) {
            float r[4]; row_rms4(r, SSQ, row0 + ai * HALF, 1.f / 384.f);
#pragma unroll
            for (int m = 0; m < 4; ++m) { const int row = row0 + ai * HALF + m * 16; bf16_t* rowp = QA + (unsigned)row * 768u + h * 96 + dA; const float rr = r[m];
                float q = (sumsq8(acc[ai][0][m][0], acc[ai][0][m][1]) + sumsq8(acc[ai][1][m][0], acc[ai][1][m][1])) * (rr * rr);
                EPI_SUM16
                if (!rope) EPI_SUM32
                if (wr_ss) SSQQ[(unsigned)row * 16u + 2 * h + (rope ? 1 : 0)] = q;
#pragma unroll
                for (int bj = 0; bj < 2; ++bj) { const f32x4 v0 = acc[ai][bj][m][0] * g0[bj] * rr, v1 = acc[ai][bj][m][1] * g1[bj] * rr;
                    u32x4 w; w.x = cvt_pk_bf16(v0[0], v0[1]); w.y = cvt_pk_bf16(v0[2], v0[3]); w.z = cvt_pk_bf16(v1[0], v1[1]); w.w = cvt_pk_bf16(v1[2], v1[3]);
                    *(u32x4*)(rowp + dstep * bj) = w; } }
            __builtin_amdgcn_sched_barrier(0);
        }
    }
};
struct EpiMlaKV {
    static constexpr bool PERM = true, AFTER_DRAIN = false, RESETUP = true;
    bf16_t* KA; bf16_t* KV; const float* SSQ; const float* SSQK; const bf16_t* P; const float* g; const float2* ROPE;
    __device__ __forceinline__ void operator()(const f32x4 (&acc)[2][2][4][2], const Unit& u, int wr, int wc, int fr, int fq) const {
        const int row0 = u.pm * BM + wr * 64 + fr, pn = u.pn, h = 4 * (pn & 1) + wc;
        if (pn >= 2) {
#pragma unroll
            for (int ai = 0; ai < 2; ++ai) {
                float r[4]; row_rms4(r, SSQ + 8, row0 + ai * HALF, 1.f / 256.f);
#pragma unroll
                for (int m = 0; m < 4; ++m) { const int row = row0 + ai * HALF + m * 16; bf16_t* rowp = KV + (unsigned)row * 1024u + h * 128 + 64 + 8 * fq; const float rr = r[m];
#pragma unroll
                    for (int bj = 0; bj < 2; ++bj) { const f32x4 v0 = acc[ai][bj][m][0] * rr, v1 = acc[ai][bj][m][1] * rr;
                        u32x4 w; w.x = cvt_pk_bf16(v0[0], v0[1]); w.y = cvt_pk_bf16(v0[2], v0[3]); w.z = cvt_pk_bf16(v1[0], v1[1]); w.w = cvt_pk_bf16(v1[2], v1[3]);
                        *(u32x4*)(rowp + 32 * bj) = w; } }
                __builtin_amdgcn_sched_barrier(0);
            }
        } else {
            f32x4 g0[2], g1[2];
#pragma unroll
            for (int bj = 0; bj < 2; ++bj) { g0[bj] = *(const f32x4*)(g + 32 * bj + 8 * fq); g1[bj] = *(const f32x4*)(g + 32 * bj + 8 * fq + 4); }
            const f32x4 ga = *(const f32x4*)(g + 64 + 4 * fq), gb = *(const f32x4*)(g + 80 + 4 * fq);
#pragma unroll
            for (int ai = 0; ai < 2; ++ai) {
                float r[4], sk[4]; row_rms4(r, SSQ + 8, row0 + ai * HALF, 1.f / 256.f);
#pragma unroll
                for (int m = 0; m < 4; ++m) sk[m] = SSQK[row0 + ai * HALF + m * 16];
                __builtin_amdgcn_sched_barrier(0);
#pragma unroll
                for (int m2 = 0; m2 < 2; ++m2) {
                uint2 p1[4], p2[4]; f32x4 c0[4], c1[4];
#pragma unroll
                for (int m = 2 * m2; m < 2 * m2 + 2; ++m) { const int row = row0 + ai * HALF + m * 16;
                    p1[m] = *(const uint2*)(P + (unsigned)row * (unsigned)PP + C_KPE + 4 * fq); p2[m] = *(const uint2*)(P + (unsigned)row * (unsigned)PP + C_KPE + 16 + 4 * fq);
                    const f32x4* cp = (const f32x4*)(ROPE + (unsigned)row * 16u + 4 * fq); c0[m] = cp[0]; c1[m] = cp[1]; }
#pragma unroll
                for (int m = 2 * m2; m < 2 * m2 + 2; ++m) { const int row = row0 + ai * HALF + m * 16; bf16_t* rowp = KA + (unsigned)row * 768u + h * 96; const float rl = r[m];
                    float q = (sumsq8(acc[ai][0][m][0], acc[ai][0][m][1]) + sumsq8(acc[ai][1][m][0], acc[ai][1][m][1])) * (rl * rl);
                    EPI_SUM16 EPI_SUM32
                    const float rr = rsqrtf((q + sk[m]) * (1.f / 96.f) + EPS), rs = rl * rr;
#pragma unroll
                    for (int bj = 0; bj < 2; ++bj) { const f32x4 v0 = acc[ai][bj][m][0] * g0[bj] * rs, v1 = acc[ai][bj][m][1] * g1[bj] * rs;
                        u32x4 w; w.x = cvt_pk_bf16(v0[0], v0[1]); w.y = cvt_pk_bf16(v0[2], v0[3]); w.z = cvt_pk_bf16(v1[0], v1[1]); w.w = cvt_pk_bf16(v1[2], v1[3]);
                        *(u32x4*)(rowp + 32 * bj + 8 * fq) = w; }
                    const f32x4 a = (f32x4){lo2f(p1[m].x), hi2f(p1[m].x), lo2f(p1[m].y), hi2f(p1[m].y)} * ga * rr, b = (f32x4){lo2f(p2[m].x), hi2f(p2[m].x), lo2f(p2[m].y), hi2f(p2[m].y)} * gb * rr;
                    uint2 w1, w2;
                    w1.x = cvt_pk_bf16(a[0] * c0[m][0] - b[0] * c0[m][1], a[1] * c0[m][2] - b[1] * c0[m][3]); w2.x = cvt_pk_bf16(b[0] * c0[m][0] + a[0] * c0[m][1], b[1] * c0[m][2] + a[1] * c0[m][3]);
                    w1.y = cvt_pk_bf16(a[2] * c1[m][0] - b[2] * c1[m][1], a[3] * c1[m][2] - b[3] * c1[m][3]); w2.y = cvt_pk_bf16(b[2] * c1[m][0] + a[2] * c1[m][1], b[3] * c1[m][2] + a[3] * c1[m][3]);
                    *(uint2*)(rowp + 64 + 4 * fq) = w1; *(uint2*)(rowp + 80 + 4 * fq) = w2; }
                __builtin_amdgcn_sched_barrier(0);
                }
            }
        }
    }
};
struct EpiStoreI8 {
    static constexpr bool PERM = true, AFTER_DRAIN = false, RESETUP = false;
    bf16_t* O; int ldc; const float* rs; const float* cs;
    __device__ __forceinline__ void operator()(const i32x4 (&acc)[2][2][4][2], const Unit& u, int wr, int wc, int fr, int fq) const {
        const int row0 = u.pm * BM + wr * 64 + fr, col0 = u.pn * BM + wc * 32 + 8 * fq;
        f32x4 c0[2], c1[2];
#pragma unroll
        for (int bj = 0; bj < 2; ++bj) { c0[bj] = *(const f32x4*)(cs + col0 + bj * HALF); c1[bj] = *(const f32x4*)(cs + col0 + bj * HALF + 4); }
        float r8[8];
#pragma unroll
        for (int i = 0; i < 8; ++i) r8[i] = rs[row0 + (i >> 2) * HALF + (i & 3) * 16];
#pragma unroll
        for (int ai = 0; ai < 2; ++ai)
#pragma unroll
            for (int m = 0; m < 4; ++m) { const int row = row0 + ai * HALF + m * 16; bf16_t* rowp = O + (size_t)row * ldc + col0; const float r = r8[ai * 4 + m];
#pragma unroll
                for (int bj = 0; bj < 2; ++bj) { const i32x4 a0 = acc[ai][bj][m][0], a1 = acc[ai][bj][m][1];
                    u32x4 w; w.x = cvt_pk_bf16((float)a0[0] * r * c0[bj][0], (float)a0[1] * r * c0[bj][1]); w.y = cvt_pk_bf16((float)a0[2] * r * c0[bj][2], (float)a0[3] * r * c0[bj][3]);
                    w.z = cvt_pk_bf16((float)a1[0] * r * c1[bj][0], (float)a1[1] * r * c1[bj][1]); w.w = cvt_pk_bf16((float)a1[2] * r * c1[bj][2], (float)a1[3] * r * c1[bj][3]);
                    *(u32x4*)(rowp + bj * HALF) = w; } }
    }
};
struct EpiDelta {
    static constexpr bool PERM = true, AFTER_DRAIN = false, RESETUP = false;
    const float* MOD; bf16_t* DL;
    __device__ __forceinline__ void operator()(const f32x4 (&acc)[2][2][4][2], const Unit& u, int wr, int wc, int fr, int fq) const {
        const int row0 = u.pm * BM + wr * 64 + fr, col0 = u.pn * BM + wc * 32 + 8 * fq;
        const int b = (u.pm * BM) / S_;
        f32x4 g0[2], g1[2];
#pragma unroll
        for (int bj = 0; bj < 2; ++bj) { g0[bj] = *(const f32x4*)(MOD + b * 6144 + 2 * 1024 + col0 + bj * HALF); g1[bj] = *(const f32x4*)(MOD + b * 6144 + 2 * 1024 + col0 + bj * HALF + 4); }
#pragma unroll
        for (int ai = 0; ai < 2; ++ai)
#pragma unroll
            for (int m = 0; m < 4; ++m) { bf16_t* rowp = DL + (size_t)(row0 + ai * HALF + m * 16) * 1024 + col0;
#pragma unroll
                for (int bj = 0; bj < 2; ++bj) { const f32x4 v0 = acc[ai][bj][m][0] * g0[bj], v1 = acc[ai][bj][m][1] * g1[bj];
                    u32x4 w; w.x = cvt_pk_bf16(v0[0], v0[1]); w.y = cvt_pk_bf16(v0[2], v0[3]); w.z = cvt_pk_bf16(v1[0], v1[1]); w.w = cvt_pk_bf16(v1[2], v1[3]);
                    *(u32x4*)(rowp + bj * HALF) = w; } }
    }
};
}

__device__ __forceinline__ void p0_transpose_item(const float* W, int K, int N, int Npad, bf16_t* WT, LAS float* scr, int item, int lane, const float* kscale = nullptr, int cmap = 0) {
    const int nblk = Npad / 32, kb = item / nblk, nb = item % nblk, k0 = 64 * kb, n0 = 32 * nb;
    const int nn = cmap == 1 ? nat_col_q(n0 + (lane & 31)) : cmap == 2 ? nat_col_kv(n0 + (lane & 31)) : n0 + (lane & 31);
#pragma unroll 8
    for (int i = 0; i < 32; ++i) { const int kk = 2 * i + (lane >> 5); scr[kk * 33 + (lane & 31)] = nn < N ? W[(size_t)(k0 + kk) * N + nn] * (kscale ? kscale[k0 + kk] : 1.f) : 0.f; }
    asm volatile("s_waitcnt lgkmcnt(0)" ::: "memory");
    const int c = lane & 7;
#pragma unroll
    for (int j = 0; j < 4; ++j) { const int n = (lane >> 3) + 8 * j; const LAS float* s = scr + (8 * c) * 33 + n;
        u32x4 o; o.x = pk2(s[0 * 33], s[1 * 33]); o.y = pk2(s[2 * 33], s[3 * 33]); o.z = pk2(s[4 * 33], s[5 * 33]); o.w = pk2(s[6 * 33], s[7 * 33]);
        *(u32x4*)(WT + (size_t)(n0 + n) * K + k0 + 8 * c) = o; }
    asm volatile("s_waitcnt lgkmcnt(0)" ::: "memory");
}
__device__ __forceinline__ void p0_mod_block(const float* c, const float* w_ada, const float* b_ada, float* mod, LAS unsigned char* lds, int item, int wave, int lane) {
    LAS float* sil = (LAS float*)(lds + wave * 2048);
    LAS float* part = (LAS float*)(lds + 16384);
    for (int i = lane; i < 512; i += 64) { const int b = i >> 7, kk = i & 127; const float cv = c[b * 1024 + wave * 128 + kk]; sil[kk * 4 + b] = cv / (1.f + expf(-cv)); }
    asm volatile("s_waitcnt lgkmcnt(0)" ::: "memory");
    const int j = item * 64 + lane;
    const float* wp = w_ada + (size_t)(wave * 128) * 6144 + j;
    float a0 = 0.f, a1 = 0.f, a2 = 0.f, a3 = 0.f;
#pragma unroll 16
    for (int k = 0; k < 128; ++k) { const float w = wp[(size_t)k * 6144]; const f32x4 s = *(const LAS f32x4*)(sil + k * 4); a0 += s[0] * w; a1 += s[1] * w; a2 += s[2] * w; a3 += s[3] * w; }
    part[(wave * 4 + 0) * 64 + lane] = a0; part[(wave * 4 + 1) * 64 + lane] = a1; part[(wave * 4 + 2) * 64 + lane] = a2; part[(wave * 4 + 3) * 64 + lane] = a3;
    __syncthreads();
    if (wave < 4) { float acc = b_ada[j];
#pragma unroll
        for (int w = 0; w < 8; ++w) acc += part[(w * 4 + wave) * 64 + lane];
        mod[wave * 6144 + j] = acc; }
    __syncthreads();
}

struct ModIn { float4 v[4]; };
__device__ __forceinline__ void modrow_load(ModIn& M, const float* X, const bf16_t* DL, int row, int lane) {
    const float4* xr = (const float4*)(X + (size_t)row * 1024) + lane;
#pragma unroll
    for (int j = 0; j < 4; ++j) M.v[j] = xr[64 * j];
    if (DL) {
#pragma unroll
        for (int j = 0; j < 4; ++j) { const uint2 dd = *(const uint2*)(DL + (size_t)row * 1024 + 4 * lane + 256 * j); M.v[j].x += lo2f(dd.x); M.v[j].y += hi2f(dd.x); M.v[j].z += lo2f(dd.y); M.v[j].w += hi2f(dd.y); }
    }
}
__device__ __forceinline__ void modrow_finish(ModIn& M, const float* g, const float* mod, int shift_idx, int scale_idx, bf16_t* out, unsigned char* outq, float* hs, int row, int lane) {
    const int b = row / S_; float ss = 0.f;
#pragma unroll
    for (int j = 0; j < 4; ++j) ss += (M.v[j].x * M.v[j].x + M.v[j].y * M.v[j].y) + (M.v[j].z * M.v[j].z + M.v[j].w * M.v[j].w);
    ss = wave_sum(ss);
    const float r = rsqrtf(ss * (1.f / 1024.f) + EPS);
    const float* sh = mod + b * 6144 + shift_idx * 1024; const float* sc = mod + b * 6144 + scale_idx * 1024;
    float am = 0.f;
#pragma unroll
    for (int j = 0; j < 4; ++j) {
        const int col = 4 * lane + 256 * j; float4& v = M.v[j];
        const float4 g4 = *(const float4*)(g + col), s4 = *(const float4*)(sc + col), h4 = *(const float4*)(sh + col);
        v.x = v.x * r * g4.x * (1.f + s4.x) + h4.x; v.y = v.y * r * g4.y * (1.f + s4.y) + h4.y; v.z = v.z * r * g4.z * (1.f + s4.z) + h4.z; v.w = v.w * r * g4.w * (1.f + s4.w) + h4.w;
        if (out) { uint2 w; w.x = pk2(v.x, v.y); w.y = pk2(v.z, v.w); *(uint2*)(out + (size_t)row * 1024 + col) = w; }
        am = fmaxf(am, fmaxf(fmaxf(fabsf(v.x), fabsf(v.y)), fmaxf(fabsf(v.z), fabsf(v.w))));
    }
    if (outq) {
#pragma unroll
        for (int o = 1; o < 64; o <<= 1) am = fmaxf(am, __shfl_xor(am, o));
        const float inv = am > 0.f ? 127.f / am : 0.f;
#pragma unroll
        for (int j = 0; j < 4; ++j) { const float4 v = M.v[j]; const int q0 = (int)rintf(v.x * inv), q1 = (int)rintf(v.y * inv), q2 = (int)rintf(v.z * inv), q3 = (int)rintf(v.w * inv);
            *(unsigned*)(outq + (size_t)row * 1024 + 4 * lane + 256 * j) = (unsigned)(q0 & 255) | ((unsigned)(q1 & 255) << 8) | ((unsigned)(q2 & 255) << 16) | ((unsigned)(q3 & 255) << 24); }
        if (lane == 0) hs[row] = am * (1.f / 127.f);
    }
}
__device__ __forceinline__ void modrows2(const float* X, const bf16_t* DL, const float* g, const float* mod, int shift_idx, int scale_idx, bf16_t* out, unsigned char* outq, float* hs, int gw, int ngw, int lane) {
    for (int row = gw; row < T_; row += 2 * ngw) {
        const int row2 = row + ngw; ModIn Ma, Mb;
        modrow_load(Ma, X, DL, row, lane); if (row2 < T_) modrow_load(Mb, X, DL, row2, lane);
        modrow_finish(Ma, g, mod, shift_idx, scale_idx, out, outq, hs, row, lane); if (row2 < T_) modrow_finish(Mb, g, mod, shift_idx, scale_idx, out, outq, hs, row2, lane);
    }
}
__device__ __forceinline__ void quant4(const float* peer_u, const float* peer_v, unsigned char* UQ, unsigned char* VQ, float* SU, float* SV, int r0, int lane) {
    float4 v[4][4]; float am[4];
#pragma unroll
    for (int q = 0; q < 4; ++q) { const int r = r0 + q; const float* src = (r < 16384 ? peer_u + (size_t)r * 1024 : peer_v + (size_t)(r - 16384) * 1024);
#pragma unroll
        for (int j = 0; j < 4; ++j) v[q][j] = ((const float4*)src)[lane + 64 * j]; }
#pragma unroll
    for (int q = 0; q < 4; ++q) { float a = 0.f;
#pragma unroll
        for (int j = 0; j < 4; ++j) a = fmaxf(a, fmaxf(fmaxf(fabsf(v[q][j].x), fabsf(v[q][j].y)), fmaxf(fabsf(v[q][j].z), fabsf(v[q][j].w))));
        am[q] = a; }
#pragma unroll
    for (int o = 1; o < 64; o <<= 1) {
#pragma unroll
        for (int q = 0; q < 4; ++q) am[q] = fmaxf(am[q], __shfl_xor(am[q], o)); }
#pragma unroll
    for (int q = 0; q < 4; ++q) { const int r = r0 + q; unsigned char* dst = (r < 16384 ? UQ + (size_t)r * 128 : VQ + (size_t)(r - 16384) * 128); float* sc = (r < 16384 ? SU + r : SV + (r - 16384));
        const float inv = am[q] > 0.f ? 127.f / am[q] : 0.f;
#pragma unroll
        for (int j = 0; j < 4; ++j) { const float4 x = v[q][j]; const int q0 = (int)rintf(x.x * inv), q1 = (int)rintf(x.y * inv), q2 = (int)rintf(x.z * inv), q3 = (int)rintf(x.w * inv);
            *(unsigned*)(dst + (size_t)(((4 * lane + 256 * j) >> 7) * (16384 * 128)) + ((4 * lane + 256 * j) & 127)) = (unsigned)(q0 & 255) | ((unsigned)(q1 & 255) << 8) | ((unsigned)(q2 & 255) << 16) | ((unsigned)(q3 & 255) << 24); }
        if (lane == 0) *sc = am[q] * (1.f / 127.f); }
}

__global__ void __launch_bounds__(NWAVES * 64, 2) mega_fwd(Args args) {
    extern __shared__ __attribute__((aligned(16))) unsigned char lds[];
    Frame F;
    F.lds = (LAS unsigned char*)lds;
    volatile LAS unsigned* MISC = (volatile LAS unsigned*)(F.lds + MISC_OFF);
    F.tid = threadIdx.x; F.lane = F.tid & 63; F.wave = __builtin_amdgcn_readfirstlane(F.tid >> 6);
    F.G = gridDim.x; F.gw = blockIdx.x * NWAVES + F.wave; F.NGW = F.G * NWAVES;
    unsigned char* ws = args.ws;
    unsigned* ctl = (unsigned*)(ws + WS_CTL);
    const float* x = (const float*)args.in[0]; const float* c = (const float*)args.in[1]; const int* positions = (const int*)args.in[2];
    const float* w_ada = (const float*)args.in[3]; const float* b_ada = (const float*)args.in[4]; const float* norm1_g = (const float*)args.in[5];
    const float* w_in = (const float*)args.in[6]; const float* mla_qa_g = (const float*)args.in[7]; const float* mla_kva_g = (const float*)args.in[8];
    const float* w_uq = (const float*)args.in[9]; const float* w_ukv = (const float*)args.in[10]; const float* mla_q_g = (const float*)args.in[11];
    const float* mla_k_g = (const float*)args.in[12]; const float* fox_q_g = (const float*)args.in[13]; const float* fox_k_g = (const float*)args.in[14];
    const float* b_f = (const float*)args.in[15]; const float* w_o = (const float*)args.in[16]; const float* norm2_g = (const float*)args.in[17];
    const float* w_pq = (const float*)args.in[18]; const float* sub_keys = (const float*)args.in[19]; const float* peer_u = (const float*)args.in[20]; const float* peer_v = (const float*)args.in[21];
    float* out = args.out;
    float* MOD = (float*)(ws + WS_MOD); float* FL = (float*)(ws + WS_FL); float* FCUM = (float*)(ws + WS_FCUM); float* LOGF = (float*)(ws + WS_LOGF); float2* ROPE = (float2*)(ws + WS_ROPE);
    bf16_t* XN = (bf16_t*)(ws + WS_XN); bf16_t* PROJ = (bf16_t*)(ws + WS_PROJ); bf16_t* KVRAW = (bf16_t*)(ws + WS_KVRAW); bf16_t* QA = (bf16_t*)(ws + WS_QA); bf16_t* KA = (bf16_t*)(ws + WS_KA);
    bf16_t* WIN = (bf16_t*)(ws + WS_WIN); bf16_t* WUQ = (bf16_t*)(ws + WS_WUQ); bf16_t* WUKV = (bf16_t*)(ws + WS_WUKV); bf16_t* WO = (bf16_t*)(ws + WS_WO); bf16_t* WPQ = (bf16_t*)(ws + WS_WPQ); bf16_t* SKB = (bf16_t*)(ws + WS_SK);
    float* SSQ = (float*)(ws + WS_SSQ); float* SSQQ = (float*)(ws + WS_SSQQ); float* SSQK = (float*)(ws + WS_SSQK); bf16_t* DELTA = (bf16_t*)(ws + WS_KVRAW);
    unsigned char* XNQ = ws + WS_XN; float* XS = (float*)(ws + WS_XS); unsigned char* WINQ = ws + WS_WINQ; unsigned char* WPQQ = ws + WS_WPQQ; float* WINS = (float*)(ws + WS_WINS); float* WPQS = (float*)(ws + WS_WPQS);
    unsigned char* UQ = ws + WS_UQ; unsigned char* VQ = ws + WS_VQ; unsigned char* H2Q = ws + WS_H2Q; float* SU = (float*)(ws + WS_SU); float* SV = (float*)(ws + WS_SV); float* HS = (float*)(ws + WS_HS); float* AP = (float*)(ws + WS_A);
    bf16_t* OB = XN; bf16_t* H2 = XN; bf16_t* QP = PROJ; int* EID = (int*)(ws + WS_QA); float* GATE = (float*)(ws + WS_QA + 16 * MiB);
    (void)sub_keys; (void)peer_u; (void)peer_v; (void)positions; (void)KA; (void)FCUM; (void)LOGF; (void)ROPE; (void)mla_q_g; (void)mla_k_g; (void)b_f; (void)fox_q_g; (void)fox_k_g; (void)mla_qa_g; (void)mla_kva_g;

    for (int u = F.tid; u < (LDS_BYTES - LDSCTL_OFF) / 4; u += NWAVES * 64) ((LAS unsigned*)(F.lds + LDSCTL_OFF))[u] = 0u;
    __syncthreads();
    const int lo = args.ph_lo, hi = args.ph_hi;
    XcdBarrier bar; bar.bar = ctl + CW_BAR + args.li * XCD_BAR_WORDS; bar.x = 0; bar.st = nullptr;
    if (hi - lo > 1) bar = xcd_barrier_post(ctl + CW_BAR + args.li * XCD_BAR_WORDS, MISC + 8);
#define IN(k) (lo <= (k) && (k) < hi)
#define SEAM(k) do { if (IN(k) && IN((k) + 1)) xcd_barrier(bar); } while (0)

    if (IN(0)) {
        LAS float* scr = (LAS float*)(F.lds + F.wave * 16384);
        constexpr int I_MOD = 96, I_IN = 16 * 72, I_UQ = 6 * 24, I_UKV = 4 * 32, I_O = 16 * 32, I_PQ = 16 * 64;
        constexpr int I_SK = 512;
        constexpr int NITEMS = I_IN + I_UQ + I_UKV + I_O + I_PQ + I_SK;
        {
            const float invf = (float)exp2(-(double)(F.lane & 15) * (13.287712379549449 / 16.0));
            for (int r4 = F.gw * 4; r4 < T_; r4 += F.NGW * 4) { const int row = r4 + (F.lane >> 4);
                const double a = (double)((float)positions[row] * invf), n = rint(a * 0.15915494309189535); const float red = (float)(a - n * 6.283185307179586);
                ROPE[(size_t)row * 16 + (F.lane & 15)] = make_float2(__cosf(red), __sinf(red)); }
        }
        for (int mi = (int)blockIdx.x; mi < I_MOD; mi += F.G) p0_mod_block(c, w_ada, b_ada, MOD, F.lds, mi, F.wave, F.lane);
        for (int it = F.gw; it < NITEMS; it += F.NGW) {
            int r = it;
            if (r < I_IN) { p0_transpose_item(w_in, 1024, INW, PP, WIN, scr, r, F.lane); continue; } r -= I_IN;
            if (r < I_UQ) { p0_transpose_item(w_uq, 384, 768, 768, WUQ, scr, r, F.lane, mla_qa_g, 1); continue; } r -= I_UQ;
            if (r < I_UKV) { p0_transpose_item(w_ukv, 256, 1024, 1024, WUKV, scr, r, F.lane, mla_kva_g, 2); continue; } r -= I_UKV;
            if (r < I_O) { p0_transpose_item(w_o, 1024, 1024, 1024, WO, scr, r, F.lane); continue; } r -= I_O;
            if (r < I_PQ) { p0_transpose_item(w_pq, 1024, 2048, 2048, WPQ, scr, r, F.lane); continue; } r -= I_PQ;
            { const float4* src = (const float4*)(sub_keys + (size_t)r * 512) + F.lane * 2; const float4 a = src[0], b2 = src[1];
              u32x4 o; o.x = pk2(a.x, a.y); o.y = pk2(a.z, a.w); o.z = pk2(b2.x, b2.y); o.w = pk2(b2.z, b2.w); *(u32x4*)(SKB + (size_t)r * 512 + F.lane * 8) = o; }
        }
    }
    SEAM(0);
    if (IN(1)) {
        for (int r = F.gw; r < PP + 2048; r += F.NGW) {
            const int nc = r < PP ? nat_col(r) : 0;
            const bf16_t* src = r < PP ? WIN + (size_t)(nc < 0 ? 0 : nc) * 1024 : WPQ + (size_t)(r - PP) * 1024; unsigned char* dst = r < PP ? WINQ + (size_t)r * 1024 : WPQQ + (size_t)(r - PP) * 1024; float* sc = r < PP ? WINS + r : WPQS + (r - PP);
            float v[16]; unpack8(*(const uint4*)(src + F.lane * 16), v); unpack8(*(const uint4*)(src + F.lane * 16 + 8), v + 8);
            if (nc < 0) {
#pragma unroll
                for (int i = 0; i < 16; ++i) v[i] = 0.f; }
            float am = 0.f;
#pragma unroll
            for (int i = 0; i < 16; ++i) am = fmaxf(am, fabsf(v[i]));
#pragma unroll
            for (int o = 1; o < 64; o <<= 1) am = fmaxf(am, __shfl_xor(am, o));
            const float inv = am > 0.f ? 127.f / am : 0.f; unsigned q[4];
#pragma unroll
            for (int i = 0; i < 4; ++i) q[i] = (unsigned)((int)rintf(v[4 * i] * inv) & 255) | ((unsigned)((int)rintf(v[4 * i + 1] * inv) & 255) << 8) | ((unsigned)((int)rintf(v[4 * i + 2] * inv) & 255) << 16) | ((unsigned)((int)rintf(v[4 * i + 3] * inv) & 255) << 24);
            *(uint4*)(dst + F.lane * 16) = make_uint4(q[0], q[1], q[2], q[3]);
            if (F.lane == 0) *sc = am * (1.f / 127.f);
        }
        modrows2(x, nullptr, norm1_g, MOD, 0, 1, nullptr, XNQ, XS, F.gw, F.NGW, F.lane);
    }
    SEAM(1);
    if (IN(2)) {
        pg8::Gemm g{(const bf16_t*)XNQ, (const bf16_t*)WINQ, T_, PP, 512, 512}; pg8::StaticOrder S; S.init(T_, PP, F.G, (int)blockIdx.x);
        pg8::EpiProjI8 E{PROJ, LOGF, SSQ, XS, WINS, fox_q_g, fox_k_g, b_f, SSQK};
        pg8::gemm_phase<pg8::EpiProjI8, pg8::StaticOrder, true, true, true>(F.lds, g, S, E);
    }
    SEAM(2);
    if (IN(4)) {
        { const int fb = F.G >= 160 ? 128 : 0; if (F.wave == 0 && (int)blockIdx.x >= fb && (int)blockIdx.x < fb + 32) fcum_item(LOGF, FCUM, (int)blockIdx.x - fb, F.lane); }
        { pg8::Gemm g{PROJ + C_CQ, WUQ, T_, 768, 384, PP}; pg8::StaticOrder S; S.init(T_, 768, F.G, (int)blockIdx.x); pg8::EpiMlaQ E{QA, SSQQ, SSQ, mla_q_g};
          pg8::gemm_phase<pg8::EpiMlaQ, pg8::StaticOrder, true, true>(F.lds, g, S, E); }
        { pg8::Gemm g{PROJ + C_CKV, WUKV, T_, 1024, 256, PP}; pg8::StaticOrder S; S.init(T_, 1024, F.G, (int)blockIdx.x); pg8::EpiMlaKV E{KA, KVRAW, SSQ, SSQK, PROJ, mla_k_g, ROPE};
          pg8::gemm_phase<pg8::EpiMlaKV, pg8::StaticOrder, true, true>(F.lds, g, S, E); }
    }
    SEAM(4);
    if (IN(6)) {
        volatile LAS unsigned* qslot = MISC + 16;
        float thr;
        { float gq = fabsf(fox_q_g[F.lane]), gk = fabsf(fox_k_g[F.lane]);
#pragma unroll
          for (int o = 1; o < 64; o <<= 1) { gq = fmaxf(gq, __shfl_xor(gq, o)); gk = fmaxf(gk, __shfl_xor(gk, o)); }
          thr = 104.5f + 2.f * 1.02f * 8.f * gq * gk; }
        unsigned* qctr = ctl + 64;
        if (F.tid == 0) qslot[0] = atomicAdd(qctr, 1u);
        __syncthreads();
        unsigned u = qslot[0];
        while (u < 2048u + 1024u) {
            unsigned unext = 0u;
            if (F.tid == 0) unext = atomicAdd(qctr, 1u);
            if (u >= 2048u) {
                quant4(peer_u, peer_v, UQ, VQ, SU, SV, (int)(u - 2048u) * 32 + F.wave * 4, F.lane);
                if (F.tid == 0) qslot[0] = unext;
                __syncthreads();
                u = qslot[0];
                __syncthreads();
                continue;
            }
            const int grp = (int)(u >> 10), bh = (int)(u & 31u), qb = 31 - (int)((u >> 5) & 31u), b = bh >> 3, h = bh & 7;
            if (grp == 0) { const att::Desc d{QA + (size_t)b * S_ * 768 + h * 96, 768, KA + (size_t)b * S_ * 768 + h * 96, 768, KVRAW + (size_t)b * S_ * 1024 + h * 128 + 64, 1024, OB + (size_t)b * S_ * 1024 + h * 64, 1024, nullptr, SSQQ + (size_t)b * S_ * 16 + 2 * h, ROPE + (size_t)b * S_ * 16};
                att::attn_unit<6, false>(d, qb, 0, F.lds); }
            else { const bf16_t* pb = PROJ + (size_t)b * S_ * PP + h * 64; const float* fc = FCUM + (size_t)(b * 8 + h) * S_;
                const att::Desc d{pb + C_FQ, PP, pb + C_FK, PP, pb + C_FV, PP, OB + (size_t)b * S_ * 1024 + 512 + h * 64, 1024, fc, nullptr, nullptr};
                const int NT = 4 * (qb + 1); const float lim = fc[qb * 256] + thr;
                int j0 = 0;
                { const int ja = F.lane, jb2 = 64 + F.lane;
                  const bool ka = ja < NT ? (fc[64 * ja + 63] <= lim) : true, kb = jb2 < NT ? (fc[64 * jb2 + 63] <= lim) : true;
                  const unsigned long long ma = __ballot(ka), mb = __ballot(kb);
                  j0 = ma ? __builtin_ctzll(ma) : (mb ? 64 + __builtin_ctzll(mb) : NT - 4); }
                if (j0 > NT - 4) j0 = NT - 4;
                att::attn_unit<4, true>(d, qb, j0, F.lds); }
            if (F.tid == 0) qslot[0] = unext;
            __syncthreads();
            u = qslot[0];
            __syncthreads();
        }
    }
    SEAM(6);
    if (IN(7)) {
        pg8::Gemm g{OB, WO, T_, 1024, 1024, 1024}; pg8::StaticOrder S; S.init(T_, 1024, F.G, (int)blockIdx.x);
        pg8::EpiDelta E{MOD, DELTA};
        pg8::gemm_phase<pg8::EpiDelta, pg8::StaticOrder, true, true>(F.lds, g, S, E);
    }
    SEAM(7);
    if (IN(8)) modrows2(x, DELTA, norm2_g, MOD, 3, 4, nullptr, H2Q, HS, F.gw, F.NGW, F.lane);
    SEAM(8);
    if (IN(9)) {
        pg8::Gemm g{(const bf16_t*)H2Q, (const bf16_t*)WPQQ, T_, 2048, 512, 512}; pg8::StaticOrder S; S.init(T_, 2048, F.G, (int)blockIdx.x); pg8::EpiStoreI8 E{QP, 2048, HS, WPQS};
        pg8::gemm_phase<pg8::EpiStoreI8, pg8::StaticOrder, true, true, true>(F.lds, g, S, E);
    }
    SEAM(9);
    if (IN(10)) { for (int w = F.gw; w < (T_ / 32) * 4; w += F.NGW) pk::topk_item2(QP, SKB, EID, GATE, w, F.lane); }
    SEAM(10);
    {
        const int ng = F.G < 8 ? F.G : 8; const int vx = (int)blockIdx.x % ng, rank = (int)blockIdx.x / ng, nrank = (F.G - vx + ng - 1) / ng;
        const int gwv = rank * NWAVES + F.wave, ngwv = nrank * NWAVES;
        const int grp = F.lane >> 3, sub = F.lane & 7;
        int* PA = (int*)(ws + WS_PROJ);
        int* WQH = (int*)(ws + WS_KA); float* WSC = (float*)(ws + WS_KA + 8 * MiB);
        if (IN(11)) {
            for (int s = vx; s < 8; s += ng) {
                const unsigned char* UQs = UQ + (size_t)s * (16384 * 128);
                int t = gwv; int4 ev0[4], ev1[4], rows0[16], rows1[16]; int4 hq0 = make_int4(0, 0, 0, 0), hq1 = hq0;
#pragma unroll
                for (int k = 0; k < 4; ++k) { ev0[k] = make_int4(0, 0, 0, 0); ev1[k] = make_int4(0, 0, 0, 0); }
#define U_LOAD_IDS(EV, HQ, tt) do { _Pragma("unroll") for (int k = 0; k < 4; ++k) EV[k] = *(const int4*)(EID + (size_t)(tt) * 128 + grp * 16 + 4 * k); \
                    HQ = *(const int4*)(H2Q + (size_t)(tt) * 1024 + 128 * s + 16 * sub); } while (0)
                { const int ta = t < T_ ? t : T_ - 1, tb = t + ngwv < T_ ? t + ngwv : T_ - 1; U_LOAD_IDS(ev0, hq0, ta); U_LOAD_IDS(ev1, hq1, tb); }
                gx::u_gather(UQs, 16u * (unsigned)sub, ev0, rows0);
#define U_STEP(EVW, EVR, ROWSW, ROWSR) do { const int t1 = t + ngwv, t2 = t + 2 * ngwv, t2c = t2 < T_ ? t2 : T_ - 1; int4 hq2; \
                    U_LOAD_IDS(EVW, hq2, t2c); \
                    gx::u_gather(UQs, 16u * (unsigned)sub, EVR, ROWSW); \
                    gx::u_compute(ROWSR, hq0, PA + ((size_t)s * T_ + t) * 128, F.lane); \
                    hq0 = hq1; hq1 = hq2; t = t1; } while (0)
                while (t < T_) {
                    U_STEP(ev0, ev1, rows1, rows0);
                    if (t >= T_) break;
                    U_STEP(ev1, ev0, rows0, rows1);
                }
#undef U_STEP
#undef U_LOAD_IDS
            }
        }
        SEAM(11);
        if (IN(12)) {
            for (int t = F.gw; t < T_; t += F.NGW) {
                int i0 = 0, i1 = 0;
#pragma unroll
                for (int s = 0; s < 8; ++s) { const int2 p = *(const int2*)(PA + ((size_t)s * T_ + t) * 128 + 2 * F.lane); i0 += p.x; i1 += p.y; }
                const int2 e2 = *(const int2*)(EID + (size_t)t * 128 + 2 * F.lane); const float2 g2 = *(const float2*)(GATE + (size_t)t * 128 + 2 * F.lane); const float hs = HS[t];
                const float w0 = g2.x * gx::gelu_t((float)i0 * SU[e2.x] * hs) * SV[e2.x], w1 = g2.y * gx::gelu_t((float)i1 * SU[e2.y] * hs) * SV[e2.y];
                float wm = fmaxf(fabsf(w0), fabsf(w1));
#pragma unroll
                for (int o = 1; o < 64; o <<= 1) wm = fmaxf(wm, __shfl_xor(wm, o));
                const float inv = wm > 0.f ? 127.f / wm : 0.f;
                const int q0 = (int)rintf(w0 * inv), q1 = (int)rintf(w1 * inv);
                const unsigned h2 = (unsigned)(q0 & 255) | ((unsigned)(q1 & 255) << 8);
                const unsigned h2p = __shfl_xor(h2, 1);
                if ((F.lane & 1) == 0) WQH[(size_t)t * 32 + (F.lane >> 1)] = (int)(h2 | (h2p << 16));
                if (F.lane == 0) WSC[t] = wm * (1.f / 127.f);
            }
        }
        SEAM(12);
        if (IN(13)) {
            for (int s = vx; s < 8; s += ng) {
                const unsigned char* VQs = VQ + (size_t)s * (16384 * 128);
                int t = gwv; int4 ev0[4], ev1[4]; uint4 rows0[16], rows1[16]; int4 wh0, wh1; float ws0, ws1;
#define V_LOAD_IDS(EV, WH, WS, tt) do { _Pragma("unroll") for (int k = 0; k < 4; ++k) EV[k] = *(const int4*)(EID + (size_t)(tt) * 128 + grp * 16 + 4 * k); \
                    WH = *(const int4*)(WQH + (size_t)(tt) * 32 + grp * 4); WS = WSC[tt]; } while (0)
                { const int ta = t < T_ ? t : T_ - 1, tb = t + ngwv < T_ ? t + ngwv : T_ - 1; V_LOAD_IDS(ev0, wh0, ws0, ta); V_LOAD_IDS(ev1, wh1, ws1, tb); }
                gx::v_gather(VQs, 16u * (unsigned)sub, ev0, rows0);
#define V_STEP(EVW, EVR, ROWSW, ROWSR) do { const int t1 = t + ngwv, t2 = t + 2 * ngwv, t2c = t2 < T_ ? t2 : T_ - 1; int4 wh2; float ws2; \
                    V_LOAD_IDS(EVW, wh2, ws2, t2c); \
                    gx::v_gather(VQs, 16u * (unsigned)sub, EVR, ROWSW); \
                    gx::v_token(ROWSR, wh0, ws0, MOD + (t / S_) * 6144 + 5 * 1024, x + (size_t)t * 1024, DELTA + (size_t)t * 1024, out + (size_t)t * 1024, s, F.lane); \
                    wh0 = wh1; ws0 = ws1; wh1 = wh2; ws1 = ws2; t = t1; } while (0)
                while (t < T_) {
                    V_STEP(ev0, ev1, rows1, rows0);
                    if (t >= T_) break;
                    V_STEP(ev1, ev0, rows0, rows1);
                }
#undef V_STEP
#undef V_LOAD_IDS
            }
        }
    }
#undef IN
#undef SEAM
}

static int g_grid = 0;
static void launch_mega(const Args& base, int lo, int hi, int li, hipStream_t stream) {
    Args a = base; a.ph_lo = lo; a.ph_hi = hi; a.li = li;
    hipLaunchKernelGGL(mega_fwd, dim3(g_grid), dim3(NWAVES * 64), LDS_BYTES, stream, a);
}

extern "C" void kernel_launch(void* const* d_in, const int* in_sizes, int n_in, void* d_out, int out_size, void* d_ws, size_t ws_size, hipStream_t stream) {
    if (g_grid == 0) {
        int dev = 0, cus = 0;
        (void)hipGetDevice(&dev); (void)hipDeviceGetAttribute(&cus, hipDeviceAttributeMultiprocessorCount, dev);
        (void)hipFuncSetAttribute((const void*)mega_fwd, hipFuncAttributeMaxDynamicSharedMemorySize, LDS_BYTES);
        int per_cu = 0; (void)hipOccupancyMaxActiveBlocksPerMultiprocessor(&per_cu, (const void*)mega_fwd, NWAVES * 64, LDS_BYTES);
        (void)hipGetLastError();
        g_grid = cus > 0 ? cus : 256;
        if (per_cu < 1) fprintf(stderr, "kernel_launch: occupancy query says %d blocks/CU\n", per_cu);
    }
    float* out = (float*)d_out; unsigned char* ws = (unsigned char*)d_ws;
    (void)hipMemsetAsync(ws + WS_CTL, 0, CTL_ZERO_BYTES, stream);
    Args base{}; for (int i = 0; i < 22; ++i) base.in[i] = d_in[i]; base.out = out; base.ws = ws;

    launch_mega(base, 0, 14, 0, stream);
}
```

```cpp
#include <hip/hip_runtime.h>
#include <cstdint>
#include <cstdio>
#include <cmath>

typedef unsigned short bf16_t;
constexpr int B_ = 4, S_ = 8192, D_ = 1024, T_ = B_ * S_;
constexpr int PP = 2304;
constexpr int C_CQ = 0, C_CKV = 384, C_KPE = 640, C_FQ = 672, C_FK = 1184, C_FV = 1696, C_FL = 2208, INW = 2216;
constexpr float EPS = 1e-6f;
constexpr float LOG2E = 1.4426950408889634f;
constexpr float C2A = 0.10206207261596577f * LOG2E;
constexpr float C2F = 0.125f * LOG2E;

__device__ __forceinline__ float bf2f(bf16_t v) { return __uint_as_float(((unsigned)v) << 16); }
__device__ __forceinline__ bf16_t f2bf(float f) { unsigned u = __float_as_uint(f); return (bf16_t)((u + 0x7fffu + ((u >> 16) & 1u)) >> 16); }
__device__ __forceinline__ unsigned pk2(float lo, float hi) { return (unsigned)f2bf(lo) | ((unsigned)f2bf(hi) << 16); }
__device__ __forceinline__ float lo2f(unsigned w) { return __uint_as_float(w << 16); }
__device__ __forceinline__ float hi2f(unsigned w) { return __uint_as_float(w & 0xffff0000u); }
__device__ __forceinline__ float wave_sum(float v) {
#pragma unroll
    for (int o = 1; o < 64; o <<= 1) v += __shfl_xor(v, o);
    return v;
}

constexpr size_t MiB = 1u << 20;
constexpr size_t WS_MOD = 1 * MiB;
constexpr size_t WS_FL = 3 * MiB;
constexpr size_t WS_FCUM = 4 * MiB;
constexpr size_t WS_LOGF = 5 * MiB;
constexpr size_t WS_ROPE = 6 * MiB;
constexpr size_t WS_XN = 88 * MiB;
constexpr size_t WS_PROJ = 152 * MiB;
constexpr size_t WS_KVRAW = 296 * MiB;
constexpr size_t WS_QA = 360 * MiB;
constexpr size_t WS_KA = 408 * MiB;

__device__ __forceinline__ void unpack8(const uint4 raw, float* v) {
    v[0] = lo2f(raw.x); v[1] = hi2f(raw.x); v[2] = lo2f(raw.y); v[3] = hi2f(raw.y); v[4] = lo2f(raw.z); v[5] = hi2f(raw.z); v[6] = lo2f(raw.w); v[7] = hi2f(raw.w);
}
__device__ __forceinline__ void fcum_item(const float* LOGF, float* FCUM, int item, int lane) {
    const float4* src = (const float4*)(LOGF + (size_t)item * S_ + 128 * lane);
    float4 v[32]; float tot = 0.f;
#pragma unroll
    for (int i = 0; i < 32; ++i) v[i] = src[i];
#pragma unroll
    for (int i = 0; i < 32; ++i) tot += (v[i].x + v[i].y) + (v[i].z + v[i].w);
    float incl = tot;
#pragma unroll
    for (int o = 1; o < 64; o <<= 1) { const float t = __shfl_up(incl, o); if (lane >= o) incl += t; }
    float run = incl - tot;
    float4* dst = (float4*)(FCUM + (size_t)item * S_ + 128 * lane);
#pragma unroll
    for (int i = 0; i < 32; ++i) { float4 o; run += v[i].x; o.x = run; run += v[i].y; o.y = run; run += v[i].z; o.z = run; run += v[i].w; o.w = run; dst[i] = o; }
}

struct MlaIn { uint4 qn, kn; unsigned q1, q2, k1, k2; float2 cs0, cs1; };
__device__ __forceinline__ void mlaprep_load(MlaIn& M, const bf16_t* QRAW, const bf16_t* KVRAW, const bf16_t* PROJ, const float2* ROPE, int row, int lane) {
    const int h = lane >> 3, p = lane & 7;
    const bf16_t* q = QRAW + (size_t)row * 768 + h * 96; const bf16_t* kp = PROJ + (size_t)row * PP + C_KPE;
    M.qn = *(const uint4*)(q + 8 * p); M.q1 = *(const unsigned*)(q + 64 + 2 * p); M.q2 = *(const unsigned*)(q + 80 + 2 * p);
    M.kn = *(const uint4*)(KVRAW + (size_t)row * 1024 + h * 128 + 8 * p); M.k1 = *(const unsigned*)(kp + 2 * p); M.k2 = *(const unsigned*)(kp + 16 + 2 * p);
    M.cs0 = ROPE[(size_t)row * 16 + 2 * p]; M.cs1 = ROPE[(size_t)row * 16 + 2 * p + 1];
}
__device__ __forceinline__ void mlaprep_finish(const MlaIn& M, bf16_t* QRAW, bf16_t* KA, const float* g_q, const float* g_k, int row, int lane) {
    const int h = lane >> 3, p = lane & 7;
#pragma unroll
    for (int which = 0; which < 2; ++which) {
        const float* g = which == 0 ? g_q : g_k; const float sc = which == 0 ? C2A : 1.f;
        float v[8]; unpack8(which == 0 ? M.qn : M.kn, v); const unsigned r1 = which == 0 ? M.q1 : M.k1, r2 = which == 0 ? M.q2 : M.k2;
        float a0 = lo2f(r1), a1 = hi2f(r1), b0 = lo2f(r2), b1 = hi2f(r2);
        float ss = a0 * a0 + a1 * a1 + b0 * b0 + b1 * b1;
#pragma unroll
        for (int i = 0; i < 8; ++i) ss += v[i] * v[i];
        ss += __shfl_xor(ss, 1); ss += __shfl_xor(ss, 2); ss += __shfl_xor(ss, 4);
        const float r = rsqrtf(ss * (1.f / 96.f) + EPS);
        const float* gn = g + 8 * p;
        a0 *= r * g[64 + 2 * p]; a1 *= r * g[64 + 2 * p + 1]; b0 *= r * g[80 + 2 * p]; b1 *= r * g[80 + 2 * p + 1];
        const float ra0 = a0 * M.cs0.x - b0 * M.cs0.y, rb0 = b0 * M.cs0.x + a0 * M.cs0.y, ra1 = a1 * M.cs1.x - b1 * M.cs1.y, rb1 = b1 * M.cs1.x + a1 * M.cs1.y;
        uint4 o; o.x = pk2(v[0] * r * gn[0] * sc, v[1] * r * gn[1] * sc); o.y = pk2(v[2] * r * gn[2] * sc, v[3] * r * gn[3] * sc);
        o.z = pk2(v[4] * r * gn[4] * sc, v[5] * r * gn[5] * sc); o.w = pk2(v[6] * r * gn[6] * sc, v[7] * r * gn[7] * sc);
        bf16_t* dst = (which == 0 ? QRAW : KA) + (size_t)row * 768 + h * 96;
        *(uint4*)(dst + 8 * p) = o; *(unsigned*)(dst + 64 + 2 * p) = pk2(ra0 * sc, ra1 * sc); *(unsigned*)(dst + 80 + 2 * p) = pk2(rb0 * sc, rb1 * sc);
    }
}
namespace pg8 {
#define PG8_LAS __attribute__((address_space(3)))
typedef unsigned short bf16_t;
typedef short bf16x8 __attribute__((ext_vector_type(8)));
typedef float f32x4 __attribute__((ext_vector_type(4)));
typedef unsigned u32x4 __attribute__((ext_vector_type(4)));
constexpr int BM = 256, BK = 64, HALF = 128, HTB = HALF * BK * 2  , STAGE_BYTES = 8 * HTB, NXCD = 8, WGM = 8;

__host__ __device__ __forceinline__ int lds_byte(int r, int c) { const int st = (r >> 4) * 2 + (c >> 5), rr = r & 15, cc = c & 31, ob = rr * 64 + cc * 2; return st * 1024 + (ob ^ (((ob >> 9) & 1) << 5)); }
__host__ __device__ __forceinline__ void stage_rc(int b, int& R, int& C) { const int st = b / 1024, sb = b % 1024, swz = sb ^ (((sb >> 9) & 1) << 5); R = (st >> 1) * 16 + swz / 64; C = (st & 1) * 32 + (swz % 64) / 2; }
__host__ __device__ __forceinline__ int perm32(int rho) { const int n = rho >> 4, i = rho & 15; return 8 * (i >> 2) + 4 * n + (i & 3); }

struct Unit { int pm, pn; };
struct Gemm { const bf16_t* A; const bf16_t* Bt; int M, N, K, lda; };

struct PairOrder {
    int pm, pn0;
    __device__ __forceinline__ bool next(int i, Unit& u) const { if (i >= 2) return false; u.pm = pm; u.pn = pn0 + i; return true; }
    __device__ __forceinline__ void a_ready(const Unit&) const {}
    __device__ __forceinline__ void done(const Unit&) const {}
};
struct StaticOrder {
    int nM, nN, nwg, G, c;
    __host__ __device__ void init(int M, int N, int G_, int c_) { nM = M / BM; nN = N / BM; nwg = nM * nN; G = G_; c = c_; }
    __host__ __device__ bool next(int i, Unit& u) const {
        const long L = (long)i * G + c; if (L >= nwg) return false;
        int wgid = (int)L; { const int q = nwg / NXCD, r = nwg % NXCD, xcd = wgid % NXCD, off = wgid / NXCD; wgid = (xcd < r ? xcd * (q + 1) : r * (q + 1) + (xcd - r) * q) + off; }
        const int nig = WGM * nN, gid = wgid / nig, fm = gid * WGM, gsz = (nM - fm) < WGM ? (nM - fm) : WGM;
        u.pm = fm + ((wgid % nig) % gsz); u.pn = (wgid % nig) / gsz; return true;
    }
    __device__ __forceinline__ void a_ready(const Unit&) const {}
    __device__ __forceinline__ void done(const Unit&) const {}
};
__device__ __forceinline__ unsigned cvt_pk_bf16(float lo, float hi) { unsigned r; asm volatile("v_cvt_pk_bf16_f32 %0, %1, %2" : "=v"(r) : "v"(lo), "v"(hi)); return r; }
typedef float f32x2 __attribute__((ext_vector_type(2)));
typedef int i32x4 __attribute__((ext_vector_type(4)));
template <bool I8> struct AccT { typedef f32x4 type; };
template <> struct AccT<true> { typedef i32x4 type; };
__device__ __forceinline__ f32x4 mma16(const bf16x8 b, const bf16x8 a, const f32x4 c) { return __builtin_amdgcn_mfma_f32_16x16x32_bf16(b, a, c, 0, 0, 0); }
__device__ __forceinline__ i32x4 mma16(const bf16x8 b, const bf16x8 a, const i32x4 c) { return __builtin_amdgcn_mfma_i32_16x16x64_i8(__builtin_bit_cast(i32x4, b), __builtin_bit_cast(i32x4, a), c, 0, 0, 0); }
template <class Epi, class Sched, bool ALIGN_EPI = false, bool SP2 = false, bool I8 = false>
__device__ __forceinline__ void gemm_phase(PG8_LAS unsigned char* lds, const Gemm g, const Sched& S, const Epi& E) {
    int tid_ = threadIdx.x; if constexpr (Epi::RESETUP) asm volatile("" : "+v"(tid_));
    const int tid = tid_, wid = __builtin_amdgcn_readfirstlane(tid >> 6), lane = tid & 63, wr = wid >> 2, wc = wid & 3, fr = lane & 15, fq = lane >> 4;
    const int K = g.K, nt = K / BK;
    unsigned voffA[2], voffB[2]; int aoff, boff;
#define PG8_LANE_SETUP do { int t_ = tid; asm volatile("" : "+v"(t_)); const int l_ = t_ & 63, fr_ = l_ & 15, fq_ = l_ >> 4; \
        _Pragma("unroll") for (int i = 0; i < 2; ++i) { int R, C; stage_rc(t_ * 16 + i * 8192, R, C); const int Rb = Epi::PERM ? ((R & ~31) + perm32(R & 31)) : R; \
            voffA[i] = (unsigned)(R * g.lda + C) * 2u; voffB[i] = (unsigned)(Rb * K + C) * 2u; } \
        aoff = lds_byte(wr * 64 + fr_, fq_ * 8); boff = lds_byte(wc * 32 + fr_, fq_ * 8); } while (0)
    PG8_LANE_SETUP;
    const size_t kstep = (size_t)(BK * 2);
    const size_t hstepA = (size_t)HALF * g.lda * 2, hstepB = (size_t)HALF * K * 2;
    const size_t tstepA = 2 * hstepA, tstepB = 2 * hstepB;
    const unsigned ldsw = (unsigned)wid * 1024u;
#define PG8_SA(b, h) (((b) * 2 + (h)) * HTB)
#define PG8_SB(b, h) ((4 + (b) * 2 + (h)) * HTB)
#define PG8_STAGE(bufoff, gbase, voff) do { _Pragma("unroll") for (int _i = 0; _i < 2; ++_i) \
        __builtin_amdgcn_global_load_lds((const unsigned*)((const char*)(gbase) + (voff)[_i]), (PG8_LAS unsigned*)(lds + (bufoff) + ldsw + _i * 8192), 16, 0, 0); } while (0)
#define PG8_LDA(dst, b, h) do { _Pragma("unroll") for (int m = 0; m < 4; ++m) _Pragma("unroll") for (int k = 0; k < 2; ++k) dst[m][k] = *(const PG8_LAS bf16x8*)(lds + PG8_SA(b, h) + aoff + m * 2048 + k * 1024); } while (0)
#define PG8_LDB(dst, b, h) do { _Pragma("unroll") for (int n = 0; n < 2; ++n) _Pragma("unroll") for (int k = 0; k < 2; ++k) dst[n][k] = *(const PG8_LAS bf16x8*)(lds + PG8_SB(b, h) + boff + n * 2048 + k * 1024); } while (0)
#define PG8_MMA(ai, bj, At, Bt) do { __builtin_amdgcn_s_setprio(1); _Pragma("unroll") for (int m = 0; m < 4; ++m) _Pragma("unroll") for (int n = 0; n < 2; ++n) _Pragma("unroll") for (int k = 0; k < 2; ++k) \
        acc[ai][bj][m][n] = mma16(Bt[n][k], At[m][k], acc[ai][bj][m][n]); __builtin_amdgcn_s_setprio(0); } while (0)
#define PG8_WAIT_V(n) asm volatile("s_waitcnt vmcnt(" #n ")" ::: "memory")
#define PG8_WAIT_L(n) asm volatile("s_waitcnt lgkmcnt(" #n ")" ::: "memory")
#define PG8_BAR __builtin_amdgcn_s_barrier()
#define PG8_SCHED __builtin_amdgcn_sched_barrier(0)
    Unit cur, nxt; int ui = 0;
    if (!S.next(0, cur)) return;
    typedef typename AccT<I8>::type accv; accv acc[2][2][4][2];
#pragma unroll
    for (int a = 0; a < 2; ++a)
#pragma unroll
        for (int b = 0; b < 2; ++b)
#pragma unroll
            for (int m = 0; m < 4; ++m)
#pragma unroll
                for (int n = 0; n < 2; ++n) acc[a][b][m][n] = accv{};
    bf16x8 At[4][2], B0[2][2], B1[2][2];
    const char* cA = (const char*)g.A + (size_t)cur.pm * tstepA; const char* cB = (const char*)g.Bt + (size_t)cur.pn * tstepB;
    S.a_ready(cur);
    if constexpr (SP2) {
        PG8_STAGE(PG8_SB(0, 0), cB, voffB); PG8_STAGE(PG8_SB(0, 1), cB + hstepB, voffB); PG8_STAGE(PG8_SA(0, 0), cA, voffA); PG8_STAGE(PG8_SA(0, 1), cA + hstepA, voffA);
        if (wr == 1) PG8_BAR;
        PG8_WAIT_V(2); PG8_BAR;
        PG8_STAGE(PG8_SB(1, 0), cB + kstep, voffB); PG8_STAGE(PG8_SA(1, 0), cA + kstep, voffA); PG8_STAGE(PG8_SB(1, 1), cB + hstepB + kstep, voffB);
        PG8_WAIT_V(6); PG8_BAR;
    } else {
        PG8_STAGE(PG8_SB(0, 0), cB, voffB); PG8_STAGE(PG8_SA(0, 0), cA, voffA); PG8_STAGE(PG8_SB(0, 1), cB + hstepB, voffB); PG8_STAGE(PG8_SA(0, 1), cA + hstepA, voffA);
        if (wr == 1) PG8_BAR;
        PG8_WAIT_V(4); PG8_BAR;
        PG8_STAGE(PG8_SB(1, 0), cB + kstep, voffB); PG8_STAGE(PG8_SA(1, 0), cA + kstep, voffA); PG8_STAGE(PG8_SB(1, 1), cB + hstepB + kstep, voffB);
        PG8_WAIT_V(6); PG8_BAR;
    }
    for (;;) {
        const bool has_next = S.next(ui + 1, nxt);
        const char* nA = has_next ? (const char*)g.A + (size_t)nxt.pm * tstepA : cA; const char* nB = has_next ? (const char*)g.Bt + (size_t)nxt.pn * tstepB : cB;
        for (int t = 0; t < nt; t += 2) {
            const bool last = (t == nt - 2);
            const char* a1 = cA + (size_t)(t + 1) * kstep;
            const char* a2 = last ? nA : cA + (size_t)(t + 2) * kstep; const char* b2 = last ? nB : cB + (size_t)(t + 2) * kstep;
            const char* a3 = a2 + kstep; const char* b3 = b2 + kstep;
            if (last && has_next) S.a_ready(nxt);
            if constexpr (SP2) {
            PG8_LDB(B0, 0, 0); PG8_LDB(B1, 0, 1); PG8_SCHED; PG8_LDA(At, 0, 0); PG8_STAGE(PG8_SA(1, 1), a1 + hstepA, voffA);
            PG8_WAIT_V(8); PG8_WAIT_L(0); PG8_BAR; PG8_MMA(0, 0, At, B0); PG8_MMA(0, 1, At, B1); PG8_BAR; PG8_SCHED;
            PG8_LDA(At, 0, 1); PG8_STAGE(PG8_SB(0, 0), b2, voffB); PG8_STAGE(PG8_SB(0, 1), b2 + hstepB, voffB); PG8_STAGE(PG8_SA(0, 0), a2, voffA);
            PG8_WAIT_V(8); PG8_WAIT_L(0); PG8_BAR; PG8_MMA(1, 0, At, B0); PG8_MMA(1, 1, At, B1); PG8_BAR; PG8_SCHED;
            PG8_LDB(B0, 1, 0); PG8_LDB(B1, 1, 1); PG8_SCHED; PG8_LDA(At, 1, 0); PG8_STAGE(PG8_SA(0, 1), a2 + hstepA, voffA);
            PG8_WAIT_V(8); PG8_WAIT_L(0); PG8_BAR; PG8_MMA(0, 0, At, B0); PG8_MMA(0, 1, At, B1); PG8_BAR; PG8_SCHED;
            PG8_LDA(At, 1, 1); PG8_STAGE(PG8_SB(1, 0), b3, voffB); PG8_STAGE(PG8_SB(1, 1), b3 + hstepB, voffB); PG8_STAGE(PG8_SA(1, 0), a3, voffA);
            PG8_WAIT_V(8); PG8_WAIT_L(0); PG8_BAR; PG8_MMA(1, 0, At, B0); PG8_MMA(1, 1, At, B1); PG8_BAR; PG8_SCHED;
            } else {
            PG8_LDB(B0, 0, 0); PG8_SCHED; PG8_LDA(At, 0, 0); PG8_STAGE(PG8_SA(1, 1), a1 + hstepA, voffA);
            PG8_WAIT_L(8); PG8_BAR; PG8_WAIT_L(0); PG8_MMA(0, 0, At, B0); PG8_BAR; PG8_SCHED;
            PG8_LDB(B1, 0, 1); PG8_STAGE(PG8_SB(0, 0), b2, voffB);
            PG8_BAR; PG8_WAIT_L(0); PG8_MMA(0, 1, At, B1); PG8_BAR;
            PG8_LDA(At, 0, 1); PG8_STAGE(PG8_SA(0, 0), a2, voffA);
            PG8_BAR; PG8_WAIT_L(0); PG8_MMA(1, 0, At, B0); PG8_BAR; PG8_SCHED;
            PG8_STAGE(PG8_SB(0, 1), b2 + hstepB, voffB);
            PG8_WAIT_V(6); PG8_BAR; PG8_MMA(1, 1, At, B1); PG8_BAR;
            PG8_LDB(B0, 1, 0); PG8_SCHED; PG8_LDA(At, 1, 0); PG8_STAGE(PG8_SA(0, 1), a2 + hstepA, voffA);
            PG8_WAIT_L(8); PG8_BAR; PG8_WAIT_L(0); PG8_MMA(0, 0, At, B0); PG8_BAR; PG8_SCHED;
            PG8_LDB(B1, 1, 1); PG8_STAGE(PG8_SB(1, 0), b3, voffB);
            PG8_BAR; PG8_WAIT_L(0); PG8_MMA(0, 1, At, B1); PG8_BAR;
            PG8_LDA(At, 1, 1); PG8_STAGE(PG8_SA(1, 0), a3, voffA);
            PG8_BAR; PG8_WAIT_L(0); PG8_MMA(1, 0, At, B0); PG8_BAR; PG8_SCHED;
            PG8_STAGE(PG8_SB(1, 1), b3 + hstepB, voffB);
            PG8_WAIT_V(6); PG8_BAR; PG8_MMA(1, 1, At, B1); PG8_BAR;
            }
        }
        if constexpr (ALIGN_EPI) { if (wr == 0) PG8_BAR; }
        if constexpr (!Epi::AFTER_DRAIN) {
            if constexpr (Epi::RESETUP) { int t_ = tid; asm volatile("" : "+v"(t_)); E(acc, cur, wr, wc, t_ & 15, (t_ & 63) >> 4); }
            else E(acc, cur, wr, wc, fr, fq);
            S.done(cur); }
        if (!has_next) break;
#pragma unroll
        for (int a = 0; a < 2; ++a)
#pragma unroll
            for (int b = 0; b < 2; ++b)
#pragma unroll
                for (int m = 0; m < 4; ++m)
#pragma unroll
                    for (int n = 0; n < 2; ++n) acc[a][b][m][n] = accv{};
        cur = nxt; cA = nA; cB = nB; ++ui;
        if constexpr (Epi::RESETUP) PG8_LANE_SETUP;
        if constexpr (ALIGN_EPI) { if (wr == 1) PG8_BAR; }
    }
    PG8_WAIT_V(0);
    if constexpr (!ALIGN_EPI) { if (wr == 0) PG8_BAR; }
    PG8_BAR;
    if constexpr (Epi::AFTER_DRAIN) { E.fused(acc, cur, wr, wc, fr, fq, lds, wid, lane); S.done(cur); }
#undef PG8_LANE_SETUP
#undef PG8_SA
#undef PG8_SB
#undef PG8_STAGE
#undef PG8_LDA
#undef PG8_LDB
#undef PG8_MMA
#undef PG8_WAIT_V
#undef PG8_WAIT_L
#undef PG8_BAR
#undef PG8_SCHED
}
}


#define GAS __attribute__((address_space(1)))
#define LAS __attribute__((address_space(3)))
typedef float f32x4 __attribute__((ext_vector_type(4)));
typedef unsigned u32x4 __attribute__((ext_vector_type(4)));
#define XB_TMO      128
#define XB_XCNT(j)  (256  + 64 * (j))
#define XB_XSUB(j)  (1280 + 64 * (j))
#define XB_XGEN(j)  (2304 + 64 * (j))
#define XB_TOP      3328
#define XB_TOPGEN   3392
#define XCD_BAR_WORDS 3456
#define XB_SPIN_CAP (1u << 18)

__device__ __forceinline__ unsigned xb_ld(unsigned* p)              { return __hip_atomic_load(p, __ATOMIC_RELAXED, __HIP_MEMORY_SCOPE_AGENT); }
__device__ __forceinline__ unsigned xb_add(unsigned* p, unsigned v) { return __hip_atomic_fetch_add(p, v, __ATOMIC_RELAXED, __HIP_MEMORY_SCOPE_AGENT); }
__device__ __forceinline__ unsigned xb_xcc_id() { return (unsigned)__builtin_amdgcn_s_getreg((3 << 11) | 20) & 0xFu; }
#define XB_SPIN(cond, bar) do { unsigned _sp = 0; while (cond) { __builtin_amdgcn_s_sleep(1); \
    if ((++_sp & 255u) == 0u) { if (xb_ld(&(bar)[XB_TMO])) break; if (_sp > XB_SPIN_CAP) { atomicAdd(&(bar)[XB_TMO], 1u); break; } } } } while (0)

struct XcdBarrier {
    unsigned* bar; unsigned x;
    volatile LAS unsigned* st;
};

__device__ __forceinline__ XcdBarrier xcd_barrier_post(unsigned* bar, volatile LAS unsigned* st) {
    XcdBarrier b; b.bar = bar; b.x = xb_xcc_id(); b.st = st;
    if (threadIdx.x == 0) (void)xb_add(&bar[XB_XCNT(b.x)], 1u);
    return b;
}
__device__ __forceinline__ void xcd_barrier_complete(unsigned* bar, unsigned x, unsigned& nloc, unsigned& nx) {
    const unsigned G = gridDim.x * gridDim.y * gridDim.z;
    unsigned sum, cnt, mine, sp = 0u;
    for (;;) {
        sum = 0u; cnt = 0u; mine = 0u;
#pragma unroll
        for (unsigned j = 0; j < 16; ++j) { const unsigned c = xb_ld(&bar[XB_XCNT(j)]); sum += c; cnt += (c > 0u) ? 1u : 0u; mine = (j == x) ? c : mine; }
        if (sum == G) break;
        __builtin_amdgcn_s_sleep(1);
        if ((++sp & 255u) == 0u) { if (xb_ld(&bar[XB_TMO])) break; if (sp > XB_SPIN_CAP) { atomicAdd(&bar[XB_TMO], 1u); break; } }
    }
    nloc = mine > 0u ? mine : 1u; nx = cnt > 0u ? cnt : 1u;
}

__device__ __forceinline__ void xcd_barrier(const XcdBarrier& b) {
    asm volatile("s_waitcnt vmcnt(0)" ::: "memory");
    __syncthreads();
    if (threadIdx.x == 0) {
        unsigned* bar = b.bar;
        __builtin_amdgcn_s_waitcnt(0);
        unsigned nloc = b.st[0], nx = b.st[1];
        if (nloc == 0u) { xcd_barrier_complete(bar, b.x, nloc, nx); b.st[0] = nloc; b.st[1] = nx; }
        const unsigned old = xb_add(&bar[XB_XSUB(b.x)], 1u);
        const unsigned gen = old / nloc;
        if (old + 1u == (gen + 1u) * nloc) {
            __builtin_amdgcn_fence(__ATOMIC_RELEASE, "agent");
            asm volatile("s_waitcnt vmcnt(0)" ::: "memory");
            const unsigned og = xb_add(&bar[XB_TOP], 1u);
            const unsigned tg = og / nx;
            if (og + 1u == (tg + 1u) * nx) xb_add(&bar[XB_TOPGEN], 1u);
            else XB_SPIN(xb_ld(&bar[XB_TOPGEN]) == tg, bar);
            __builtin_amdgcn_fence(__ATOMIC_ACQUIRE, "agent");
            xb_add(&bar[XB_XGEN(b.x)], 1u);
            asm volatile("s_waitcnt vmcnt(0)" ::: "memory");
        } else {
            XB_SPIN(xb_ld(&bar[XB_XGEN(b.x)]) == gen, bar);
            __builtin_amdgcn_fence(__ATOMIC_ACQUIRE, "agent");
            asm volatile("s_waitcnt vmcnt(0)" ::: "memory");
        }
    }
    __syncthreads();
}


constexpr int NWAVES = 8;
constexpr int RING_BYTES = 131072, LDSCTL_OFF = RING_BYTES, MISC_OFF = LDSCTL_OFF + 320, LDS_BYTES = 147456;
constexpr size_t WS_CTL = 0, CTL_ZERO_BYTES = 1 * MiB;
constexpr int CW_BAR = 4096, N_BAR_REGIONS = 16;
static_assert((CW_BAR + N_BAR_REGIONS * XCD_BAR_WORDS) * 4 <= (int)CTL_ZERO_BYTES, "barrier words inside the memset region");
constexpr size_t WS_WIN = 10 * MiB;
constexpr size_t WS_WUQ = 15 * MiB;
constexpr size_t WS_WUKV = 16 * MiB;
constexpr size_t WS_WO = 17 * MiB;
constexpr size_t WS_WPQ = 19 * MiB;
constexpr size_t WS_SK = 23 * MiB;
constexpr size_t WS_U16 = 24 * MiB;
constexpr size_t WS_V16 = 56 * MiB;


namespace att {
typedef short bf16x8 __attribute__((ext_vector_type(8)));
typedef short s16x4 __attribute__((ext_vector_type(4)));
typedef float f32x16 __attribute__((ext_vector_type(16)));
constexpr int LK = 0, KSLOT = 12288, LV = 2 * KSLOT, VSLOT = 8192, LB = LV + 2 * VSLOT, BSLOT = 256, LWS = LB + 2 * BSLOT, LOST = LWS + 8 * 256, ATT_LDS = LOST + 8 * 4096;
static_assert(ATT_LDS <= 131072, "attention scratch fits the ring region");
struct Desc { const bf16_t* Q; int pq; const bf16_t* K; int pk; const bf16_t* V; int pv; bf16_t* O; int po; const float* FC; const float* QS; const float2* RP; };

__device__ __forceinline__ int crow(int r, int hi) { return (r & 3) + 8 * (r >> 2) + 4 * hi; }
__device__ __forceinline__ float xmax32(float v) { auto rr = __builtin_amdgcn_permlane32_swap(__float_as_uint(v), __float_as_uint(v), false, false); return fmaxf(__uint_as_float(rr[0]), __uint_as_float(rr[1])); }
__device__ __forceinline__ float xsum32(float v) { auto rr = __builtin_amdgcn_permlane32_swap(__float_as_uint(v), __float_as_uint(v), false, false); return __uint_as_float(rr[0]) + __uint_as_float(rr[1]); }
__device__ __forceinline__ unsigned cvtpk(float lo, float hi) { typedef float f2 __attribute__((ext_vector_type(2))); typedef __bf16 b2 __attribute__((ext_vector_type(2))); f2 v = {lo, hi}; b2 b = __builtin_convertvector(v, b2); return __builtin_bit_cast(unsigned, b); }
typedef short v4i16_t __attribute__((ext_vector_type(4)));
__device__ __forceinline__ s16x4 vtr(LAS const unsigned char* p) { return __builtin_bit_cast(s16x4, __builtin_amdgcn_ds_read_tr16_b64_v4i16((LAS v4i16_t*)p)); }

template <int KS, bool BIAS, bool SREF>
__device__ __forceinline__ void attn_unit(const Desc& d, int qb, int j0, LAS unsigned char* shm) {
    const int tid = threadIdx.x, lane = tid & 63, r32 = lane & 31, hi = lane >> 5; const int wid = __builtin_amdgcn_readfirstlane(tid >> 6);
    const int q0 = qb * 256, NT = (q0 + 256) / 64;
    LAS float* wsf = (LAS float*)(shm + LWS) + wid * 64;
    bf16x8 qr[KS];
    { const bf16_t* qp = d.Q + (size_t)(q0 + wid * 32 + r32) * d.pq + hi * 8;
#pragma unroll
      for (int d0 = 0; d0 < KS; ++d0) qr[d0] = *(const bf16x8*)(qp + d0 * 16); }
    if (!BIAS) {
        const int qrow = q0 + wid * 32 + r32;
        const float2 ss = *(const float2*)(d.QS + (size_t)qrow * 16);
        const f32x4* cp = (const f32x4*)(d.RP + (size_t)qrow * 16 + hi * 8);
        const f32x4 cs0 = cp[0], cs1 = cp[1], cs2 = cp[2], cs3 = cp[3];
        const float rr = rsqrtf((ss.x + ss.y) * (1.f / 96.f) + EPS) * C2A;
#pragma unroll
        for (int d0 = 0; d0 < 4; ++d0) { const u32x4 w = __builtin_bit_cast(u32x4, qr[d0]); u32x4 o;
#pragma unroll
            for (int i = 0; i < 4; ++i) o[i] = cvtpk(lo2f(w[i]) * rr, hi2f(w[i]) * rr);
            qr[d0] = __builtin_bit_cast(bf16x8, o); }
        { const u32x4 wa = __builtin_bit_cast(u32x4, qr[4]), wb = __builtin_bit_cast(u32x4, qr[5]); u32x4 oa, ob;
#pragma unroll
          for (int i = 0; i < 4; ++i) { const f32x4 c = i == 0 ? cs0 : i == 1 ? cs1 : i == 2 ? cs2 : cs3;
              const float a0 = lo2f(wa[i]) * rr, a1 = hi2f(wa[i]) * rr, b0 = lo2f(wb[i]) * rr, b1 = hi2f(wb[i]) * rr;
              oa[i] = cvtpk(a0 * c[0] - b0 * c[1], a1 * c[2] - b1 * c[3]); ob[i] = cvtpk(b0 * c[0] + a0 * c[1], b1 * c[2] + a1 * c[3]); }
          qr[4] = __builtin_bit_cast(bf16x8, oa); qr[5] = __builtin_bit_cast(bf16x8, ob); }
    }
    const float fcref = BIAS ? d.FC[q0] : 0.f;
    const bf16_t* ksrc0 = d.K + (size_t)lane * d.pk + wid * 8;
    const bf16_t* ksrc1 = d.K + (size_t)lane * d.pk + (8 + wid) * 8;
    const bf16_t* vsrc = d.V + (size_t)(16 * (wid & 3) + (lane >> 2)) * d.pv + (wid >> 2) * 32 + (lane & 3) * 8;
    const int kdst0 = LK + wid * 1024 + lane * 16, kdst1 = LK + (8 + wid) * 1024 + lane * 16, vdst = LV + wid * 1024 + lane * 16;
    const bool k2 = (KS > 4) && (wid < 2 * KS - 8);
    u32x4 kr0, kr1, vr; float br = 0.f;
#define ATT_LOAD(t, slot) do { \
        __builtin_amdgcn_global_load_lds((const unsigned*)(ksrc0 + (size_t)(t) * 64 * d.pk), (LAS unsigned*)(shm + LK + wid * 1024 + (slot) * KSLOT), 16, 0, 0); \
        if (k2) __builtin_amdgcn_global_load_lds((const unsigned*)(ksrc1 + (size_t)(t) * 64 * d.pk), (LAS unsigned*)(shm + LK + (8 + wid) * 1024 + (slot) * KSLOT), 16, 0, 0); \
        __builtin_amdgcn_global_load_lds((const unsigned*)(vsrc + (size_t)(t) * 64 * d.pv), (LAS unsigned*)(shm + LV + wid * 1024 + (slot) * VSLOT), 16, 0, 0); \
        if (BIAS && wid == 4) br = d.FC[(t) * 64 + lane]; } while (0)
#define ATT_WRITE(slot) do { if (BIAS && wid == 4) *(LAS float*)(shm + LB + (slot) * BSLOT + lane * 4) = (fcref - br) * LOG2E; } while (0)
    f32x16 o0, o1, negm;
#pragma unroll
    for (int r = 0; r < 16; ++r) { o0[r] = 0.f; o1[r] = 0.f; negm[r] = 0.f; }
    if (SREF && BIAS) { const float nl = (d.FC[q0 + wid * 32 + r32] - fcref) * LOG2E;
#pragma unroll
        for (int r = 0; r < 16; ++r) negm[r] = nl; }
    float mref = 0.f, l = 0.f;
    constexpr float THR = BIAS ? 40.f : 8.f;
    const int qrel = wid * 32 + r32;
    const int kfrag = LK + hi * 1024 + r32 * 16;
    const int vfrag = LV + ((lane >> 4) & 1) * 32 + (lane & 3) * 8 + (4 * hi + ((lane & 15) >> 2)) * 64;
    ATT_LOAD(j0, 0); ATT_WRITE(0);
    __syncthreads();
    for (int t = j0; t < NT; ++t) {
        const int slot = (t - j0) & 1;
        if (t + 1 < NT) ATT_LOAD(t + 1, slot ^ 1);
        const int jb = t - (NT - 4);
        if (!(jb >= 0 && 64 * jb > 32 * wid + 31)) {
            f32x16 p0, p1;
            if (BIAS) {
                LAS const unsigned char* bp = shm + LB + slot * BSLOT + 16 * hi;
#pragma unroll
                for (int g = 0; g < 4; ++g) { const f32x4 a = *(LAS const f32x4*)(bp + 32 * g), b = *(LAS const f32x4*)(bp + 128 + 32 * g);
#pragma unroll
                    for (int i = 0; i < 4; ++i) { p0[4 * g + i] = a[i] + negm[4 * g + i]; p1[4 * g + i] = b[i] + negm[4 * g + i]; } }
            } else { p0 = negm; p1 = negm; }
            LAS const unsigned char* kp = shm + kfrag + slot * KSLOT;
#pragma unroll
            for (int d0 = 0; d0 < KS; ++d0) {
                const bf16x8 a0 = *(LAS const bf16x8*)(kp + d0 * 2048), a1 = *(LAS const bf16x8*)(kp + d0 * 2048 + 512);
                p0 = __builtin_amdgcn_mfma_f32_32x32x16_bf16(a0, qr[d0], p0, 0, 0, 0);
                p1 = __builtin_amdgcn_mfma_f32_32x32x16_bf16(a1, qr[d0], p1, 0, 0, 0);
            }
            if (jb >= 0) {
                const int kb = 64 * jb + 4 * hi;
#pragma unroll
                for (int r = 0; r < 16; ++r) { const int kv = kb + (r & 3) + 8 * (r >> 2); if (kv > qrel) p0[r] = -INFINITY; if (kv + 32 > qrel) p1[r] = -INFINITY; }
            }
            if (!SREF) {
            float ra = __builtin_fmaxf(__builtin_fmaxf(p0[0], p0[1]), p1[0]), rb = __builtin_fmaxf(__builtin_fmaxf(p0[2], p0[3]), p1[1]);
            ra = __builtin_fmaxf(__builtin_fmaxf(ra, p1[2]), p1[3]);
#pragma unroll
            for (int r = 4; r < 16; r += 4) { ra = __builtin_fmaxf(__builtin_fmaxf(ra, p0[r]), p0[r + 1]); rb = __builtin_fmaxf(__builtin_fmaxf(rb, p0[r + 2]), p0[r + 3]);
                ra = __builtin_fmaxf(__builtin_fmaxf(ra, p1[r]), p1[r + 1]); rb = __builtin_fmaxf(__builtin_fmaxf(rb, p1[r + 2]), p1[r + 3]); }
            const float rm = xmax32(__builtin_fmaxf(ra, rb));
            if (__any(rm > THR) || t == j0) {
                const float dl = t == j0 ? rm : __builtin_fmaxf(rm, 0.f);
                mref += dl;
#pragma unroll
                for (int r = 0; r < 16; ++r) { p0[r] -= dl; p1[r] -= dl; negm[r] = -mref; }
                if (t != j0) {
                    const float alpha = __builtin_amdgcn_exp2f(-dl);
                    l *= alpha;
                    if (hi == 0) wsf[r32] = alpha;
#pragma unroll
                    for (int g = 0; g < 4; ++g) { const f32x4 a = *(LAS const f32x4*)(wsf + 8 * g + 4 * hi);
#pragma unroll
                        for (int i = 0; i < 4; ++i) { o0[4 * g + i] *= a[i]; o1[4 * g + i] *= a[i]; } }
                }
            }
            }
            float s0 = 0.f, s1 = 0.f, s2 = 0.f, s3 = 0.f;
#pragma unroll
            for (int r = 0; r < 16; r += 2) { p0[r] = __builtin_amdgcn_exp2f(p0[r]); p0[r + 1] = __builtin_amdgcn_exp2f(p0[r + 1]); p1[r] = __builtin_amdgcn_exp2f(p1[r]); p1[r + 1] = __builtin_amdgcn_exp2f(p1[r + 1]);
                s0 += p0[r]; s1 += p0[r + 1]; s2 += p1[r]; s3 += p1[r + 1]; }
            l += (s0 + s1) + (s2 + s3);
            LAS const unsigned char* vp = shm + vfrag + slot * VSLOT;
#pragma unroll
            for (int ks = 0; ks < 4; ++ks) {
                const f32x16& pp = ks < 2 ? p0 : p1; const int bq = (ks & 1) * 8;
                u32x4 pw; pw.x = cvtpk(pp[bq], pp[bq + 1]); pw.y = cvtpk(pp[bq + 2], pp[bq + 3]); pw.z = cvtpk(pp[bq + 4], pp[bq + 5]); pw.w = cvtpk(pp[bq + 6], pp[bq + 7]);
                const bf16x8 pa = __builtin_bit_cast(bf16x8, pw);
                const s16x4 l0 = vtr(vp + ks * 1024), h0 = vtr(vp + ks * 1024 + 512), l1 = vtr(vp + 4096 + ks * 1024), h1 = vtr(vp + 4096 + ks * 1024 + 512);
                const bf16x8 v0 = {l0[0], l0[1], l0[2], l0[3], h0[0], h0[1], h0[2], h0[3]}, v1 = {l1[0], l1[1], l1[2], l1[3], h1[0], h1[1], h1[2], h1[3]};
                o0 = __builtin_amdgcn_mfma_f32_32x32x16_bf16(pa, v0, o0, 0, 0, 0);
                o1 = __builtin_amdgcn_mfma_f32_32x32x16_bf16(pa, v1, o1, 0, 0, 0);
            }
        }
        if (t + 1 < NT) ATT_WRITE(slot ^ 1);
        __syncthreads();
    }
#undef ATT_LOAD
#undef ATT_WRITE
    l = xsum32(l);
    if (hi == 0) wsf[32 + r32] = l;
    float rli[16];
#pragma unroll
    for (int g = 0; g < 4; ++g) { const f32x4 a = *(LAS const f32x4*)(wsf + 32 + 8 * g + 4 * hi);
#pragma unroll
        for (int i = 0; i < 4; ++i) rli[4 * g + i] = __builtin_amdgcn_rcpf(a[i]); }
    LAS bf16_t* stg = (LAS bf16_t*)(shm + LOST) + wid * 2048;
#pragma unroll
    for (int r = 0; r < 16; ++r) { const int orow = crow(r, hi); const unsigned w = cvtpk(o0[r] * rli[r], o1[r] * rli[r]);
        stg[orow * 64 + r32] = (bf16_t)(w & 0xffffu); stg[orow * 64 + 32 + r32] = (bf16_t)(w >> 16); }
    bf16_t* Ow = d.O + (size_t)(q0 + wid * 32) * d.po;
#pragma unroll
    for (int i = 0; i < 4; ++i) { const int row = i * 8 + (lane >> 3), ch = lane & 7; const u32x4 v = *(LAS const u32x4*)(stg + row * 64 + ch * 8); *(u32x4*)(Ow + (size_t)row * d.po + ch * 8) = v; }
    __syncthreads();
}
}


namespace pk {
typedef short bf16x8 __attribute__((ext_vector_type(8)));
typedef float f32x16 __attribute__((ext_vector_type(16)));
template <int I> struct COff { static constexpr int v = COff<I - 1>::v + 16 / I; };
template <> struct COff<0> { static constexpr int v = 0; };
static_assert(COff<16>::v == 50, "50 candidates can reach the top 16 of a sorted 16 x 16 sum grid");
__device__ __forceinline__ void cef(float& a, float& b) { const float mx = fmaxf(a, b), mn = fminf(a, b); a = mx; b = mn; }
__device__ __forceinline__ void sort16f(float (&v)[16]) {
#pragma unroll
    for (int k = 2; k <= 16; k <<= 1)
#pragma unroll
        for (int j = k >> 1; j >= 1; j >>= 1)
#pragma unroll
            for (int i = 0; i < 16; ++i) { const int l = i ^ j; if (l > i) { if ((i & k) == 0) cef(v[i], v[l]); else cef(v[l], v[i]); } }
}
__device__ __forceinline__ void merge16f(float (&a)[16], const float (&b)[16]) {
#pragma unroll
    for (int i = 0; i < 16; ++i) a[i] = fmaxf(a[i], b[15 - i]);
#pragma unroll
    for (int j = 8; j >= 1; j >>= 1)
#pragma unroll
        for (int i = 0; i < 16; ++i) { const int l = i ^ j; if (l > i) cef(a[i], a[l]); }
}
__device__ __forceinline__ float keyf(float v, unsigned code, unsigned mask) { return __uint_as_float((__float_as_uint(v) & mask) | code); }
template <int I> __device__ __forceinline__ void fill_candf(float (&c)[64], const float (&s1)[16], const float (&s2)[16]) {
    if constexpr (I < 16) {
#pragma unroll
        for (int j = 0; j < 16 / (I + 1); ++j) c[COff<I>::v + j] = keyf(s1[I] + s2[j], (unsigned)(255 - (I * 16 + j)), 0xFFFFFF00u);
        fill_candf<I + 1>(c, s1, s2);
    }
}
__device__ __forceinline__ void head_half(const bf16_t* QP, const bf16_t* SK, int t, int h, int p, int r32, int hi, const unsigned (&lowc)[16], float (&own)[16]) {
    const bf16_t* qrow = QP + (size_t)t * 2048 + h * 256 + p * 128 + hi * 8;
    bf16x8 qf[8];
#pragma unroll
    for (int d0 = 0; d0 < 8; ++d0) qf[d0] = *(const bf16x8*)(qrow + d0 * 16);
    const bf16_t* skb = SK + (size_t)((h * 2 + p) * 128 + r32) * 128 + hi * 8;
#pragma unroll 1
    for (int kt = 0; kt < 4; ++kt) {
        f32x16 acc;
#pragma unroll
        for (int r = 0; r < 16; ++r) acc[r] = 0.f;
        bf16x8 fr[8];
#pragma unroll
        for (int d0 = 0; d0 < 8; ++d0) fr[d0] = *(const bf16x8*)(skb + (size_t)kt * 32 * 128 + d0 * 16);
        __builtin_amdgcn_sched_barrier(0);
#pragma unroll
        for (int d0 = 0; d0 < 8; ++d0) acc = __builtin_amdgcn_mfma_f32_32x32x16_bf16(fr[d0], qf[d0], acc, 0, 0, 0);
        float cur[16];
#pragma unroll
        for (int r = 0; r < 16; ++r) cur[r] = keyf(acc[r], lowc[r] - 32u * (unsigned)kt, 0xFFFFFF80u);
        sort16f(cur);
        if (kt == 0) {
#pragma unroll
            for (int r = 0; r < 16; ++r) own[r] = cur[r];
        } else merge16f(own, cur);
    }
}
__device__ __forceinline__ void topk_item2(const bf16_t* QP, const bf16_t* SK, int* EID, float* GATE, int item, int lane) {
    const int tg = item >> 2, hp = item & 3, r32 = lane & 31, hi = lane >> 5;
    const int t = tg * 32 + r32;
    unsigned lowc[16];
#pragma unroll
    for (int r = 0; r < 16; ++r) lowc[r] = (unsigned)(127 - ((r & 3) + 8 * (r >> 2)) - 4 * hi);
    float finA[16], finB[16];
#pragma unroll
    for (int hh = 0; hh < 2; ++hh) {
        const int h = 2 * hp + hh;
        float own0[16], own1[16];
        head_half(QP, SK, t, h, 0, r32, hi, lowc, own0);
        head_half(QP, SK, t, h, 1, r32, hi, lowc, own1);
        float fin[16], oth[16];
#pragma unroll
        for (int i = 0; i < 16; ++i) { auto rr = __builtin_amdgcn_permlane32_swap(__float_as_uint(own0[i]), __float_as_uint(own1[i]), false, false); fin[i] = __uint_as_float(rr[0]); oth[i] = __uint_as_float(rr[1]); }
        merge16f(fin, oth);
#pragma unroll
        for (int i = 0; i < 16; ++i) { if (hh == 0) finA[i] = fin[i]; else finB[i] = fin[i]; }
    }
    float s1[16], s2[16];
#pragma unroll
    for (int i = 0; i < 16; ++i) { auto rr = __builtin_amdgcn_permlane32_swap(__float_as_uint(finA[i]), __float_as_uint(finB[i]), false, false); s1[i] = __uint_as_float(rr[0]); s2[i] = __uint_as_float(rr[1]); }
    const int h = 2 * hp + hi;
    unsigned long long i1lo = 0ull, i1hi = 0ull, i2lo = 0ull, i2hi = 0ull;
#pragma unroll
    for (int i = 0; i < 16; ++i) {
        const unsigned long long a = (unsigned long long)(127u - (__float_as_uint(s1[i]) & 0x7Fu)) << (8 * (i & 7)), b = (unsigned long long)(127u - (__float_as_uint(s2[i]) & 0x7Fu)) << (8 * (i & 7));
        if (i < 8) { i1lo |= a; i2lo |= b; } else { i1hi |= a; i2hi |= b; } }
    float c64[64];
#pragma unroll
    for (int i = 50; i < 64; ++i) c64[i] = -INFINITY;
    fill_candf<0>(c64, s1, s2);
    float top[16];
    {
        float g1[16], g2[16], g3[16];
#pragma unroll
        for (int i = 0; i < 16; ++i) { top[i] = c64[i]; g1[i] = c64[16 + i]; g2[i] = c64[32 + i]; g3[i] = c64[48 + i]; }
        sort16f(g1); sort16f(g2); sort16f(g3);
        merge16f(top, g1); merge16f(g2, g3); merge16f(top, g2);
    }
    float ev[16]; float sum = 0.f; const float mx = top[0];
#pragma unroll
    for (int r = 0; r < 16; ++r) { ev[r] = __expf(top[r] - mx); sum += ev[r]; }
    const float rs = 1.f / sum;
    int* ep = EID + (size_t)t * 128 + h * 16; float* gp = GATE + (size_t)t * 128 + h * 16;
#pragma unroll
    for (int q4 = 0; q4 < 4; ++q4) { int ee[4];
#pragma unroll
        for (int z = 0; z < 4; ++z) { const int code = 255 - (int)(__float_as_uint(top[q4 * 4 + z]) & 0xFFu), i = code >> 4, j = code & 15;
            const unsigned e1 = (unsigned)(((i & 8) ? i1hi : i1lo) >> (8 * (i & 7))) & 0xFFu, e2 = (unsigned)(((j & 8) ? i2hi : i2lo) >> (8 * (j & 7))) & 0xFFu; ee[z] = (int)(e1 * 128u + e2); }
        *(int4*)(ep + q4 * 4) = make_int4(ee[0], ee[1], ee[2], ee[3]);
        *(float4*)(gp + q4 * 4) = make_float4(ev[q4 * 4] * rs, ev[q4 * 4 + 1] * rs, ev[q4 * 4 + 2] * rs, ev[q4 * 4 + 3] * rs); }
}
}


namespace gx {
typedef unsigned char u8x4 __attribute__((ext_vector_type(4)));
__device__ __forceinline__ int sdot16(const int4 a, const int4 b) {
    int s = __builtin_amdgcn_sdot4(a.x, b.x, 0, false); s = __builtin_amdgcn_sdot4(a.y, b.y, s, false); s = __builtin_amdgcn_sdot4(a.z, b.z, s, false); return __builtin_amdgcn_sdot4(a.w, b.w, s, false);
}
__device__ __forceinline__ float gelu_t(float x) { const float u = 0.7978845608028654f * (x + 0.044715f * x * x * x); const float th = 1.f - 2.f * __builtin_amdgcn_rcpf(1.f + __expf(2.f * u)); return 0.5f * x * (1.f + th); }

__device__ __forceinline__ int hx(int lo, int hi, bool up, int bit) { const int send = up ? lo : hi, keep = up ? hi : lo; return keep + __shfl_xor(send, bit); }

__device__ __forceinline__ void u_gather(const unsigned char* UQs  , unsigned sub16  , const int4 (&ev)[4], int4 (&rows)[16]) {
    const int e[16] = {ev[0].x, ev[0].y, ev[0].z, ev[0].w, ev[1].x, ev[1].y, ev[1].z, ev[1].w, ev[2].x, ev[2].y, ev[2].z, ev[2].w, ev[3].x, ev[3].y, ev[3].z, ev[3].w};
#pragma unroll
    for (int i = 0; i < 16; ++i) rows[i] = *(const int4*)(UQs + (((unsigned)e[i] << 7) | sub16));
}
__device__ __forceinline__ void u_compute(const int4 (&rows)[16], const int4 ha, const int4 hb, int* PArow, int lane) {
    int p[16];
#pragma unroll
    for (int i = 0; i < 16; ++i) {
        int a = __builtin_amdgcn_sdot8(rows[i].x, ha.x, 0, false), b = __builtin_amdgcn_sdot8(rows[i].x, hb.x, 0, false);
        a = __builtin_amdgcn_sdot8(rows[i].y, ha.y, a, false); b = __builtin_amdgcn_sdot8(rows[i].y, hb.y, b, false);
        a = __builtin_amdgcn_sdot8(rows[i].z, ha.z, a, false); b = __builtin_amdgcn_sdot8(rows[i].z, hb.z, b, false);
        a = __builtin_amdgcn_sdot8(rows[i].w, ha.w, a, false); b = __builtin_amdgcn_sdot8(rows[i].w, hb.w, b, false);
        p[i] = (a << 4) + b; }
    const bool b2 = (lane & 4) != 0, b1 = (lane & 2) != 0, b0 = (lane & 1) != 0;
    int q[8], r[4];
#pragma unroll
    for (int k = 0; k < 8; ++k) q[k] = hx(p[k], p[8 + k], b2, 4);
#pragma unroll
    for (int k = 0; k < 4; ++k) r[k] = hx(q[k], q[4 + k], b1, 2);
    const int z0 = hx(r[0], r[2], b0, 1), z1 = hx(r[1], r[3], b0, 1);
    *(int2*)(PArow + 2 * lane) = make_int2(z0, z1);
}

__device__ __forceinline__ void v_gather(const unsigned char* VQs  , unsigned sub16  , const int4 (&ev)[4], uint4 (&rows)[16]) {
    const int e[16] = {ev[0].x, ev[0].y, ev[0].z, ev[0].w, ev[1].x, ev[1].y, ev[1].z, ev[1].w, ev[2].x, ev[2].y, ev[2].z, ev[2].w, ev[3].x, ev[3].y, ev[3].z, ev[3].w};
#pragma unroll
    for (int i = 0; i < 16; ++i) rows[i] = *(const uint4*)(VQs + (((unsigned)e[i] << 7) | sub16));
}
__device__ __forceinline__ void v_token(const uint4 (&rows)[16], const int4 wh, float wscale, const float2 g2, const float* x1row, const bf16_t* dlrow, float* outrow, int s, int lane) {
    const unsigned whv[4] = {(unsigned)wh.x, (unsigned)wh.y, (unsigned)wh.z, (unsigned)wh.w};
    int ah[16];
#pragma unroll
    for (int c = 0; c < 16; ++c) ah[c] = 0;
#pragma unroll
    for (int g = 0; g < 4; ++g) {
        const int wab0 = (int)(whv[g] & 0xFFFFu), wab1 = (int)(whv[g] << 16), wcd0 = (int)(whv[g] >> 16), wcd1 = (int)(whv[g] & 0xFFFF0000u);
#pragma unroll
        for (int d = 0; d < 4; ++d) {
            const unsigned A = d == 0 ? rows[4 * g].x : d == 1 ? rows[4 * g].y : d == 2 ? rows[4 * g].z : rows[4 * g].w;
            const unsigned B = d == 0 ? rows[4 * g + 1].x : d == 1 ? rows[4 * g + 1].y : d == 2 ? rows[4 * g + 1].z : rows[4 * g + 1].w;
            const unsigned C = d == 0 ? rows[4 * g + 2].x : d == 1 ? rows[4 * g + 2].y : d == 2 ? rows[4 * g + 2].z : rows[4 * g + 2].w;
            const unsigned D = d == 0 ? rows[4 * g + 3].x : d == 1 ? rows[4 * g + 3].y : d == 2 ? rows[4 * g + 3].z : rows[4 * g + 3].w;
            const int ab01 = (int)__builtin_amdgcn_perm(A, B, 0x01050004u), ab23 = (int)__builtin_amdgcn_perm(A, B, 0x03070206u);
            const int cd01 = (int)__builtin_amdgcn_perm(C, D, 0x01050004u), cd23 = (int)__builtin_amdgcn_perm(C, D, 0x03070206u);
            ah[4 * d + 0] = __builtin_amdgcn_sdot4(cd01, wcd0, __builtin_amdgcn_sdot4(ab01, wab0, ah[4 * d + 0], false), false);
            ah[4 * d + 1] = __builtin_amdgcn_sdot4(cd01, wcd1, __builtin_amdgcn_sdot4(ab01, wab1, ah[4 * d + 1], false), false);
            ah[4 * d + 2] = __builtin_amdgcn_sdot4(cd23, wcd0, __builtin_amdgcn_sdot4(ab23, wab0, ah[4 * d + 2], false), false);
            ah[4 * d + 3] = __builtin_amdgcn_sdot4(cd23, wcd1, __builtin_amdgcn_sdot4(ab23, wab1, ah[4 * d + 3], false), false);
        }
    }
    int y[16];
#pragma unroll
    for (int c = 0; c < 16; ++c) y[c] = ah[c];
    const bool b5 = (lane & 32) != 0, b4 = (lane & 16) != 0, b3 = (lane & 8) != 0;
    int z[8], q[4];
#pragma unroll
    for (int k = 0; k < 8; ++k) { auto rr = __builtin_amdgcn_permlane32_swap((unsigned)y[k], (unsigned)y[8 + k], false, false); z[k] = (int)rr[0] + (int)rr[1]; }
#pragma unroll
    for (int k = 0; k < 4; ++k) { auto rr = __builtin_amdgcn_permlane16_swap((unsigned)z[k], (unsigned)z[4 + k], false, false); q[k] = (int)rr[0] + (int)rr[1]; }
    const int r0 = hx(q[0], q[2], b3, 8), r1 = hx(q[1], q[3], b3, 8);
    const int col = 128 * s + 16 * (lane & 7) + (b5 ? 8 : 0) + (b4 ? 4 : 0) + (b3 ? 2 : 0);
    float2 x1; { const unsigned dd = *(const unsigned*)(dlrow + col); x1.x = lo2f(dd); x1.y = hi2f(dd); }
    x1.x += g2.x * wscale * (float)r0; x1.y += g2.y * wscale * (float)r1;
    *(float2*)(outrow + col) = x1;
}
__device__ __forceinline__ int dot4z(int a, int b) { int r; asm("v_dot4_i32_i8 %0, %1, %2, 0" : "=v"(r) : "v"(a), "v"(b)); return r; }
__device__ __forceinline__ void v_token4(const uint4 (&rows)[16], const int4 wh, float wscale, LAS const float* g2t  , const unsigned (&x1d)[2]  , float* outrow, int s, int lane) {
    const unsigned whv[4] = {(unsigned)wh.x, (unsigned)wh.y, (unsigned)wh.z, (unsigned)wh.w};
    int aL[16], aH[16];
#pragma unroll
    for (int g = 0; g < 4; ++g) {
        const int wq = (int)whv[g];
#pragma unroll
        for (int d = 0; d < 4; ++d) {
            const unsigned A = d == 0 ? rows[4 * g].x : d == 1 ? rows[4 * g].y : d == 2 ? rows[4 * g].z : rows[4 * g].w;
            const unsigned B = d == 0 ? rows[4 * g + 1].x : d == 1 ? rows[4 * g + 1].y : d == 2 ? rows[4 * g + 1].z : rows[4 * g + 1].w;
            const unsigned C = d == 0 ? rows[4 * g + 2].x : d == 1 ? rows[4 * g + 2].y : d == 2 ? rows[4 * g + 2].z : rows[4 * g + 2].w;
            const unsigned D = d == 0 ? rows[4 * g + 3].x : d == 1 ? rows[4 * g + 3].y : d == 2 ? rows[4 * g + 3].z : rows[4 * g + 3].w;
            const unsigned t01 = __builtin_amdgcn_perm(A, B, 0x01050004u), t23 = __builtin_amdgcn_perm(A, B, 0x03070206u);
            const unsigned u01 = __builtin_amdgcn_perm(C, D, 0x01050004u), u23 = __builtin_amdgcn_perm(C, D, 0x03070206u);
            const unsigned c0 = __builtin_amdgcn_perm(t01, u01, 0x01000504u), c1 = __builtin_amdgcn_perm(t01, u01, 0x03020706u);
            const unsigned c2 = __builtin_amdgcn_perm(t23, u23, 0x01000504u), c3 = __builtin_amdgcn_perm(t23, u23, 0x03020706u);
            { const int m0 = (int)(c0 & 0xF0F0F0F0u), m1 = (int)(c1 & 0xF0F0F0F0u), m2 = (int)(c2 & 0xF0F0F0F0u), m3 = (int)(c3 & 0xF0F0F0F0u);
              aH[4 * d + 0] = g == 0 ? dot4z(m0, wq) : __builtin_amdgcn_sdot4(m0, wq, aH[4 * d + 0], false); aL[4 * d + 0] = g == 0 ? dot4z((int)c0, wq) : __builtin_amdgcn_sdot4((int)c0, wq, aL[4 * d + 0], false);
              aH[4 * d + 1] = g == 0 ? dot4z(m1, wq) : __builtin_amdgcn_sdot4(m1, wq, aH[4 * d + 1], false); aL[4 * d + 1] = g == 0 ? dot4z((int)c1, wq) : __builtin_amdgcn_sdot4((int)c1, wq, aL[4 * d + 1], false);
              aH[4 * d + 2] = g == 0 ? dot4z(m2, wq) : __builtin_amdgcn_sdot4(m2, wq, aH[4 * d + 2], false); aL[4 * d + 2] = g == 0 ? dot4z((int)c2, wq) : __builtin_amdgcn_sdot4((int)c2, wq, aL[4 * d + 2], false);
              aH[4 * d + 3] = g == 0 ? dot4z(m3, wq) : __builtin_amdgcn_sdot4(m3, wq, aH[4 * d + 3], false); aL[4 * d + 3] = g == 0 ? dot4z((int)c3, wq) : __builtin_amdgcn_sdot4((int)c3, wq, aL[4 * d + 3], false); }
        }
    }
    { const int k8 = 8 * __builtin_amdgcn_sdot4((int)whv[3], 0x01010101, __builtin_amdgcn_sdot4((int)whv[2], 0x01010101, __builtin_amdgcn_sdot4((int)whv[1], 0x01010101, __builtin_amdgcn_sdot4((int)whv[0], 0x01010101, 0, false), false), false), false);
#pragma unroll
      for (int c = 0; c < 16; ++c) aL[c] = aL[c] - aH[c] - k8; }
    const bool b5 = (lane & 32) != 0, b4 = (lane & 16) != 0, b3 = (lane & 8) != 0;
#pragma unroll
    for (int pl = 0; pl < 2; ++pl) {
        int (&y)[16] = pl ? aH : aL;
        int z[8], q[4];
#pragma unroll
        for (int k = 0; k < 8; ++k) { auto rr = __builtin_amdgcn_permlane32_swap((unsigned)y[k], (unsigned)y[8 + k], false, false); z[k] = (int)rr[0] + (int)rr[1]; }
#pragma unroll
        for (int k = 0; k < 4; ++k) { auto rr = __builtin_amdgcn_permlane16_swap((unsigned)z[k], (unsigned)z[4 + k], false, false); q[k] = (int)rr[0] + (int)rr[1]; }
        const int r0 = hx(q[0], q[2], b3, 8), r1 = hx(q[1], q[3], b3, 8);
        const int col = 256 * s + 32 * (lane & 7) + 16 * pl + (b5 ? 8 : 0) + (b4 ? 4 : 0) + (b3 ? 2 : 0);
        float2 x1; { const unsigned dd = x1d[pl]; x1.x = lo2f(dd); x1.y = hi2f(dd); }
        typedef float f32x2_t __attribute__((ext_vector_type(2)));
        const f32x2_t g2 = *(LAS const f32x2_t*)(g2t + pl * 128 + 2 * lane);
        const float wsp = pl ? wscale : wscale * 16.f;
        x1.x += g2.x * wsp * (float)r0; x1.y += g2.y * wsp * (float)r1;
        *(float2*)(outrow + col) = x1;
    }
}
}

constexpr size_t WS_SU = 2 * MiB, WS_SV = 2 * MiB + 65536, WS_HS = 2 * MiB + 131072;
constexpr size_t WS_UQ = 24 * MiB, WS_VQ = 40 * MiB, WS_H2Q = 56 * MiB;
constexpr size_t WS_XS = 2 * MiB + 262144, WS_WINS = 2 * MiB + 393216, WS_WPQS = 2 * MiB + 409600;
constexpr size_t WS_WINQ = 456 * MiB, WS_WPQQ = 460 * MiB;
constexpr size_t WS_SSQQ = 462 * MiB, WS_SSQK = 3 * MiB;
constexpr size_t WS_SSQ = 464 * MiB;
constexpr size_t WS_A = WS_KA;
struct Args { const void* in[22]; float* out; unsigned char* ws; int ph_lo, ph_hi, li, pad; };

struct Frame {
    LAS unsigned char* lds;
    int tid, lane, wave, G, gw, NGW;
};

__host__ __device__ __forceinline__ int nat_col(int rho) {
    if (rho < 672) return rho;
    if (rho < 680) return C_FL + (rho - 672);
    if (rho < 768) return -1;
    if (rho < 1792) { const int t = (rho - 768) >> 8, c = (rho - 768) & 255, bj = c >> 7, wc = (c & 127) >> 5, i = c & 31; return (t < 2 ? C_FQ : C_FK) + 64 * (4 * (t & 1) + wc) + 32 * bj + i; }
    return C_FV + (rho - 1792);
}
__host__ __device__ __forceinline__ int nat_col_q(int n) {
    const int pn = n >> 8, c = n & 255, bj = c >> 7, wc = (c & 127) >> 5, i5 = c & 31;
    if (pn < 2) return (4 * pn + wc) * 96 + 32 * bj + i5;
    const int fq = i5 >> 3, k = i5 & 7; return (2 * wc + (fq >> 1)) * 96 + 64 + 16 * bj + (fq & 1) * 8 + k;
}
__host__ __device__ __forceinline__ int nat_col_kv(int n) {
    const int pn = n >> 8, c = n & 255, bj = c >> 7, wc = (c & 127) >> 5, i5 = c & 31;
    return (4 * (pn & 1) + wc) * 128 + (pn >= 2 ? 64 : 0) + 32 * bj + i5;
}
namespace pg8 {
struct EpiProjI8 {
    static constexpr bool PERM = true, AFTER_DRAIN = false, RESETUP = false;
    bf16_t* P; float* LOGF; float* SSQ; const float* rs; const float* cs; const float* g_fq; const float* g_fk; const float* b_f; float* SSQK;
    __device__ __forceinline__ void operator()(const i32x4 (&acc)[2][2][4][2], const Unit& u, int wr, int wc, int fr, int fq) const {
        const int row0 = u.pm * BM + wr * 64 + fr, rho0 = u.pn * BM + wc * 32 + 8 * fq, pn = u.pn;
        f32x4 c0[2], c1[2];
#pragma unroll
        for (int bj = 0; bj < 2; ++bj) { c0[bj] = *(const f32x4*)(cs + rho0 + bj * HALF); c1[bj] = *(const f32x4*)(cs + rho0 + bj * HALF + 4); }
        const bool fox = pn >= 3 && pn <= 6, isq = pn < 5;
        f32x4 g0[2], g1[2];
        if (fox) { const float* g = (isq ? g_fq : g_fk) + 8 * fq;
#pragma unroll
            for (int bj = 0; bj < 2; ++bj) { g0[bj] = *(const f32x4*)(g + 32 * bj); g1[bj] = *(const f32x4*)(g + 32 * bj + 4); } }
        float r8[8];
#pragma unroll
        for (int i = 0; i < 8; ++i) r8[i] = rs[row0 + (i >> 2) * HALF + (i & 3) * 16];
#pragma unroll
        for (int ai = 0; ai < 2; ++ai)
#pragma unroll
            for (int m = 0; m < 4; ++m) {
                const int row = row0 + ai * HALF + m * 16; bf16_t* rowp = P + (size_t)row * PP; const float r = r8[ai * 4 + m];
                f32x4 v0[2], v1[2];
#pragma unroll
                for (int bj = 0; bj < 2; ++bj) { const i32x4 a0 = acc[ai][bj][m][0], a1 = acc[ai][bj][m][1];
                    v0[bj] = (f32x4){(float)a0[0] * r * c0[bj][0], (float)a0[1] * r * c0[bj][1], (float)a0[2] * r * c0[bj][2], (float)a0[3] * r * c0[bj][3]};
                    v1[bj] = (f32x4){(float)a1[0] * r * c1[bj][0], (float)a1[1] * r * c1[bj][1], (float)a1[2] * r * c1[bj][2], (float)a1[3] * r * c1[bj][3]}; }
                float ssb[2];
#pragma unroll
                for (int bj = 0; bj < 2; ++bj) { float q = (v0[bj][0] * v0[bj][0] + v0[bj][1] * v0[bj][1]) + (v0[bj][2] * v0[bj][2] + v0[bj][3] * v0[bj][3]) + (v1[bj][0] * v1[bj][0] + v1[bj][1] * v1[bj][1]) + (v1[bj][2] * v1[bj][2] + v1[bj][3] * v1[bj][3]);
                    { auto r16 = __builtin_amdgcn_permlane16_swap(__float_as_uint(q), __float_as_uint(q), false, false); q = __uint_as_float(r16[0]) + __uint_as_float(r16[1]); }
                    { auto r32 = __builtin_amdgcn_permlane32_swap(__float_as_uint(q), __float_as_uint(q), false, false); q = __uint_as_float(r32[0]) + __uint_as_float(r32[1]); }
                    ssb[bj] = q; }
                if (pn == 2 && wc == 0 && fq == 0) SSQK[row] = ssb[1];
                if (fox) {
                    const float rr = rsqrtf((ssb[0] + ssb[1]) * (1.f / 64.f) + EPS) * (isq ? C2F : 1.f);
                    const int dst = (isq ? C_FQ : C_FK) + 64 * (4 * ((pn - 3) & 1) + wc) + 8 * fq;
#pragma unroll
                    for (int bj = 0; bj < 2; ++bj) { u32x4 w; w.x = cvt_pk_bf16(v0[bj][0] * rr * g0[bj][0], v0[bj][1] * rr * g0[bj][1]); w.y = cvt_pk_bf16(v0[bj][2] * rr * g0[bj][2], v0[bj][3] * rr * g0[bj][3]);
                        w.z = cvt_pk_bf16(v1[bj][0] * rr * g1[bj][0], v1[bj][1] * rr * g1[bj][1]); w.w = cvt_pk_bf16(v1[bj][2] * rr * g1[bj][2], v1[bj][3] * rr * g1[bj][3]);
                        *(u32x4*)(rowp + dst + 32 * bj) = w; }
                } else {
#pragma unroll
                    for (int bj = 0; bj < 2; ++bj) {
                        const int rho = rho0 + bj * HALF;
                        if (rho == 672) {
                            const float z[8] = {v0[bj][0], v0[bj][1], v0[bj][2], v0[bj][3], v1[bj][0], v1[bj][1], v1[bj][2], v1[bj][3]};
                            const int b = row / S_, sq = row % S_;
#pragma unroll
                            for (int h = 0; h < 8; ++h) { const float zz = z[h] + b_f[h]; LOGF[((size_t)b * 8 + h) * S_ + sq] = fminf(zz, 0.f) - __logf(1.f + __expf(-fabsf(zz))); }
                        } else if (rho < 672 || rho >= 1792) {
                            const int dst = rho < 672 ? rho : C_FV + (rho - 1792);
                            u32x4 w; w.x = cvt_pk_bf16(v0[bj][0], v0[bj][1]); w.y = cvt_pk_bf16(v0[bj][2], v0[bj][3]); w.z = cvt_pk_bf16(v1[bj][0], v1[bj][1]); w.w = cvt_pk_bf16(v1[bj][2], v1[bj][3]);
                            *(u32x4*)(rowp + dst) = w;
                            if (fq == 0 && rho < 640) {
                                if (pn == 0) { if (bj == 1) SSQ[(size_t)row * 16 + wc] = ssb[0] + ssb[1]; }
                                else if (pn == 1) SSQ[(size_t)row * 16 + (bj == 0 ? 4 : 8) + wc] = ssb[bj];
                                else SSQ[(size_t)row * 16 + 12 + wc] = ssb[bj];
                            }
                        }
                    }
                }
            }
    }
};
struct EpiStoreRms {
    static constexpr bool PERM = true, AFTER_DRAIN = false, RESETUP = false;
    bf16_t* O; int ldc; const float* SSQ; int slot0; float inv_cnt;
    __device__ __forceinline__ void operator()(const f32x4 (&acc)[2][2][4][2], const Unit& u, int wr, int wc, int fr, int fq) const {
        const int row0 = u.pm * BM + wr * 64 + fr, col0 = u.pn * BM + wc * 32 + 8 * fq;
#pragma unroll
        for (int ai = 0; ai < 2; ++ai)
#pragma unroll
            for (int m = 0; m < 4; ++m) { const int row = row0 + ai * HALF + m * 16; bf16_t* rowp = O + (size_t)row * ldc + col0;
                const f32x4 sa = *(const f32x4*)(SSQ + (size_t)row * 16 + slot0), sb = *(const f32x4*)(SSQ + (size_t)row * 16 + slot0 + 4);
                const float r = rsqrtf(((sa[0] + sa[1]) + (sa[2] + sa[3]) + (sb[0] + sb[1]) + (sb[2] + sb[3])) * inv_cnt + EPS);
#pragma unroll
                for (int bj = 0; bj < 2; ++bj) { const f32x4 v0 = acc[ai][bj][m][0] * r, v1 = acc[ai][bj][m][1] * r;
                    u32x4 w; w.x = cvt_pk_bf16(v0[0], v0[1]); w.y = cvt_pk_bf16(v0[2], v0[3]); w.z = cvt_pk_bf16(v1[0], v1[1]); w.w = cvt_pk_bf16(v1[2], v1[3]);
                    *(u32x4*)(rowp + bj * HALF) = w; } }
    }
};
#define EPI_SUM16 { auto r16 = __builtin_amdgcn_permlane16_swap(__float_as_uint(q), __float_as_uint(q), false, false); q = __uint_as_float(r16[0]) + __uint_as_float(r16[1]); }
#define EPI_SUM32 { auto r32 = __builtin_amdgcn_permlane32_swap(__float_as_uint(q), __float_as_uint(q), false, false); q = __uint_as_float(r32[0]) + __uint_as_float(r32[1]); }
__device__ __forceinline__ float sumsq8(const f32x4 a, const f32x4 b) { return (a[0] * a[0] + a[1] * a[1]) + (a[2] * a[2] + a[3] * a[3]) + (b[0] * b[0] + b[1] * b[1]) + (b[2] * b[2] + b[3] * b[3]); }
__device__ __forceinline__ void row_rms4(float (&r)[4], const float* SSQ8  , int row0, float inv_cnt) {
    f32x4 sa[4], sb[4];
#pragma unroll
    for (int i = 0; i < 4; ++i) { const int row = row0 + i * 16; sa[i] = *(const f32x4*)(SSQ8 + (unsigned)row * 16u); sb[i] = *(const f32x4*)(SSQ8 + (unsigned)row * 16u + 4); }
#pragma unroll
    for (int i = 0; i < 4; ++i) r[i] = rsqrtf(((sa[i][0] + sa[i][1]) + (sa[i][2] + sa[i][3]) + (sb[i][0] + sb[i][1]) + (sb[i][2] + sb[i][3])) * inv_cnt + EPS);
}
struct EpiMlaQ {
    static constexpr bool PERM = true, AFTER_DRAIN = false, RESETUP = true;
    bf16_t* QA; float* SSQQ; const float* SSQ; const float* g;
    __device__ __forceinline__ void operator()(const f32x4 (&acc)[2][2][4][2], const Unit& u, int wr, int wc, int fr, int fq) const {
        const int row0 = u.pm * BM + wr * 64 + fr, pn = u.pn;
        const bool rope = pn == 2;
        const int h = rope ? 2 * wc + (fq >> 1) : 4 * pn + wc, dA = rope ? 64 + (fq & 1) * 8 : 8 * fq, dstep = rope ? 16 : 32;
        const bool wr_ss = rope ? (fq & 1) == 0 : fq == 0;
        f32x4 g0[2], g1[2];
#pragma unroll
        for (int bj = 0; bj < 2; ++bj) { g0[bj] = *(const f32x4*)(g + dA + dstep * bj); g1[bj] = *(const f32x4*)(g + dA + dstep * bj + 4); }
#pragma unroll
        for (int ai = 0; ai < 2; ++ai) {
            float r[4]; row_rms4(r, SSQ, row0 + ai * HALF, 1.f / 384.f);
#pragma unroll
            for (int m = 0; m < 4; ++m) { const int row = row0 + ai * HALF + m * 16; bf16_t* rowp = QA + (unsigned)row * 768u + h * 96 + dA; const float rr = r[m];
                float q = (sumsq8(acc[ai][0][m][0], acc[ai][0][m][1]) + sumsq8(acc[ai][1][m][0], acc[ai][1][m][1])) * (rr * rr);
                EPI_SUM16
                if (!rope) EPI_SUM32
                if (wr_ss) SSQQ[(unsigned)row * 16u + 2 * h + (rope ? 1 : 0)] = q;
#pragma unroll
                for (int bj = 0; bj < 2; ++bj) { const f32x4 v0 = acc[ai][bj][m][0] * g0[bj] * rr, v1 = acc[ai][bj][m][1] * g1[bj] * rr;
                    u32x4 w; w.x = cvt_pk_bf16(v0[0], v0[1]); w.y = cvt_pk_bf16(v0[2], v0[3]); w.z = cvt_pk_bf16(v1[0], v1[1]); w.w = cvt_pk_bf16(v1[2], v1[3]);
                    *(u32x4*)(rowp + dstep * bj) = w; } }
            __builtin_amdgcn_sched_barrier(0);
        }
    }
};
struct EpiMlaKV {
    static constexpr bool PERM = true, AFTER_DRAIN = false, RESETUP = true;
    bf16_t* KA; bf16_t* KV; const float* SSQ; const float* SSQK; const bf16_t* P; const float* g; const float2* ROPE;
    __device__ __forceinline__ void operator()(const f32x4 (&acc)[2][2][4][2], const Unit& u, int wr, int wc, int fr, int fq) const {
        const int row0 = u.pm * BM + wr * 64 + fr, pn = u.pn, h = 4 * (pn & 1) + wc;
        if (pn >= 2) {
#pragma unroll
            for (int ai = 0; ai < 2; ++ai) {
                float r[4]; row_rms4(r, SSQ + 8, row0 + ai * HALF, 1.f / 256.f);
#pragma unroll
                for (int m = 0; m < 4; ++m) { const int row = row0 + ai * HALF + m * 16; bf16_t* rowp = KV + (unsigned)row * 1024u + h * 128 + 64 + 8 * fq; const float rr = r[m];
#pragma unroll
                    for (int bj = 0; bj < 2; ++bj) { const f32x4 v0 = acc[ai][bj][m][0] * rr, v1 = acc[ai][bj][m][1] * rr;
                        u32x4 w; w.x = cvt_pk_bf16(v0[0], v0[1]); w.y = cvt_pk_bf16(v0[2], v0[3]); w.z = cvt_pk_bf16(v1[0], v1[1]); w.w = cvt_pk_bf16(v1[2], v1[3]);
                        *(u32x4*)(rowp + 32 * bj) = w; } }
                __builtin_amdgcn_sched_barrier(0);
            }
        } else {
            f32x4 g0[2], g1[2];
#pragma unroll
            for (int bj = 0; bj < 2; ++bj) { g0[bj] = *(const f32x4*)(g + 32 * bj + 8 * fq); g1[bj] = *(const f32x4*)(g + 32 * bj + 8 * fq + 4); }
            const f32x4 ga = *(const f32x4*)(g + 64 + 4 * fq), gb = *(const f32x4*)(g + 80 + 4 * fq);
#pragma unroll
            for (int ai = 0; ai < 2; ++ai) {
                float r[4], sk[4]; row_rms4(r, SSQ + 8, row0 + ai * HALF, 1.f / 256.f);
#pragma unroll
                for (int m = 0; m < 4; ++m) sk[m] = SSQK[row0 + ai * HALF + m * 16];
                __builtin_amdgcn_sched_barrier(0);
#pragma unroll
                for (int m2 = 0; m2 < 2; ++m2) {
                uint2 p1[4], p2[4]; f32x4 c0[4], c1[4];
#pragma unroll
                for (int m = 2 * m2; m < 2 * m2 + 2; ++m) { const int row = row0 + ai * HALF + m * 16;
                    p1[m] = *(const uint2*)(P + (unsigned)row * (unsigned)PP + C_KPE + 4 * fq); p2[m] = *(const uint2*)(P + (unsigned)row * (unsigned)PP + C_KPE + 16 + 4 * fq);
                    const f32x4* cp = (const f32x4*)(ROPE + (unsigned)row * 16u + 4 * fq); c0[m] = cp[0]; c1[m] = cp[1]; }
#pragma unroll
                for (int m = 2 * m2; m < 2 * m2 + 2; ++m) { const int row = row0 + ai * HALF + m * 16; bf16_t* rowp = KA + (unsigned)row * 768u + h * 96; const float rl = r[m];
                    float q = (sumsq8(acc[ai][0][m][0], acc[ai][0][m][1]) + sumsq8(acc[ai][1][m][0], acc[ai][1][m][1])) * (rl * rl);
                    EPI_SUM16 EPI_SUM32
                    const float rr = rsqrtf((q + sk[m]) * (1.f / 96.f) + EPS), rs = rl * rr;
#pragma unroll
                    for (int bj = 0; bj < 2; ++bj) { const f32x4 v0 = acc[ai][bj][m][0] * g0[bj] * rs, v1 = acc[ai][bj][m][1] * g1[bj] * rs;
                        u32x4 w; w.x = cvt_pk_bf16(v0[0], v0[1]); w.y = cvt_pk_bf16(v0[2], v0[3]); w.z = cvt_pk_bf16(v1[0], v1[1]); w.w = cvt_pk_bf16(v1[2], v1[3]);
                        *(u32x4*)(rowp + 32 * bj + 8 * fq) = w; }
                    const f32x4 a = (f32x4){lo2f(p1[m].x), hi2f(p1[m].x), lo2f(p1[m].y), hi2f(p1[m].y)} * ga * rr, b = (f32x4){lo2f(p2[m].x), hi2f(p2[m].x), lo2f(p2[m].y), hi2f(p2[m].y)} * gb * rr;
                    uint2 w1, w2;
                    w1.x = cvt_pk_bf16(a[0] * c0[m][0] - b[0] * c0[m][1], a[1] * c0[m][2] - b[1] * c0[m][3]); w2.x = cvt_pk_bf16(b[0] * c0[m][0] + a[0] * c0[m][1], b[1] * c0[m][2] + a[1] * c0[m][3]);
                    w1.y = cvt_pk_bf16(a[2] * c1[m][0] - b[2] * c1[m][1], a[3] * c1[m][2] - b[3] * c1[m][3]); w2.y = cvt_pk_bf16(b[2] * c1[m][0] + a[2] * c1[m][1], b[3] * c1[m][2] + a[3] * c1[m][3]);
                    *(uint2*)(rowp + 64 + 4 * fq) = w1; *(uint2*)(rowp + 80 + 4 * fq) = w2; }
                __builtin_amdgcn_sched_barrier(0);
                }
            }
        }
    }
};
struct EpiStoreI8 {
    static constexpr bool PERM = true, AFTER_DRAIN = false, RESETUP = false;
    bf16_t* O; int ldc; const float* rs; const float* cs;
    __device__ __forceinline__ void operator()(const i32x4 (&acc)[2][2][4][2], const Unit& u, int wr, int wc, int fr, int fq) const {
        const int row0 = u.pm * BM + wr * 64 + fr, col0 = u.pn * BM + wc * 32 + 8 * fq;
        f32x4 c0[2], c1[2];
#pragma unroll
        for (int bj = 0; bj < 2; ++bj) { c0[bj] = *(const f32x4*)(cs + col0 + bj * HALF); c1[bj] = *(const f32x4*)(cs + col0 + bj * HALF + 4); }
        float r8[8];
#pragma unroll
        for (int i = 0; i < 8; ++i) r8[i] = rs[row0 + (i >> 2) * HALF + (i & 3) * 16];
#pragma unroll
        for (int ai = 0; ai < 2; ++ai)
#pragma unroll
            for (int m = 0; m < 4; ++m) { const int row = row0 + ai * HALF + m * 16; bf16_t* rowp = O + (size_t)row * ldc + col0; const float r = r8[ai * 4 + m];
#pragma unroll
                for (int bj = 0; bj < 2; ++bj) { const i32x4 a0 = acc[ai][bj][m][0], a1 = acc[ai][bj][m][1];
                    u32x4 w; w.x = cvt_pk_bf16((float)a0[0] * r * c0[bj][0], (float)a0[1] * r * c0[bj][1]); w.y = cvt_pk_bf16((float)a0[2] * r * c0[bj][2], (float)a0[3] * r * c0[bj][3]);
                    w.z = cvt_pk_bf16((float)a1[0] * r * c1[bj][0], (float)a1[1] * r * c1[bj][1]); w.w = cvt_pk_bf16((float)a1[2] * r * c1[bj][2], (float)a1[3] * r * c1[bj][3]);
                    *(u32x4*)(rowp + bj * HALF) = w; } }
    }
};
struct EpiDelta {
    static constexpr bool PERM = true, AFTER_DRAIN = false, RESETUP = false;
    const float* MOD; bf16_t* DL; const float* X;
    __device__ __forceinline__ void operator()(const f32x4 (&acc)[2][2][4][2], const Unit& u, int wr, int wc, int fr, int fq) const {
        const int row0 = u.pm * BM + wr * 64 + fr, col0 = u.pn * BM + wc * 32 + 8 * fq;
        const int b = (u.pm * BM) / S_;
        f32x4 g0[2], g1[2];
#pragma unroll
        for (int bj = 0; bj < 2; ++bj) { g0[bj] = *(const f32x4*)(MOD + b * 6144 + 2 * 1024 + col0 + bj * HALF); g1[bj] = *(const f32x4*)(MOD + b * 6144 + 2 * 1024 + col0 + bj * HALF + 4); }
#pragma unroll
        for (int ai = 0; ai < 2; ++ai)
#pragma unroll
            for (int m2 = 0; m2 < 2; ++m2) {
                f32x4 xa[2][2], xb[2][2];
#pragma unroll
                for (int mm = 0; mm < 2; ++mm) { const float* xr = X + (size_t)(row0 + ai * HALF + (2 * m2 + mm) * 16) * 1024 + col0;
#pragma unroll
                    for (int bj = 0; bj < 2; ++bj) { xa[mm][bj] = *(const f32x4*)(xr + bj * HALF); xb[mm][bj] = *(const f32x4*)(xr + bj * HALF + 4); } }
#pragma unroll
                for (int mm = 0; mm < 2; ++mm) { const int m = 2 * m2 + mm; bf16_t* rowp = DL + (size_t)(row0 + ai * HALF + m * 16) * 1024 + col0;
#pragma unroll
                    for (int bj = 0; bj < 2; ++bj) { const f32x4 v0 = acc[ai][bj][m][0] * g0[bj] + xa[mm][bj], v1 = acc[ai][bj][m][1] * g1[bj] + xb[mm][bj];
                        u32x4 w; w.x = cvt_pk_bf16(v0[0], v0[1]); w.y = cvt_pk_bf16(v0[2], v0[3]); w.z = cvt_pk_bf16(v1[0], v1[1]); w.w = cvt_pk_bf16(v1[2], v1[3]);
                        *(u32x4*)(rowp + bj * HALF) = w; } }
            }
    }
};
}

__device__ __forceinline__ void p0_transpose_item(const float* W, int K, int N, int Npad, bf16_t* WT, LAS float* scr, int item, int lane, const float* kscale = nullptr, int cmap = 0) {
    const int nblk = Npad / 32, kb = item / nblk, nb = item % nblk, k0 = 64 * kb, n0 = 32 * nb;
    const int nn = cmap == 1 ? nat_col_q(n0 + (lane & 31)) : cmap == 2 ? nat_col_kv(n0 + (lane & 31)) : n0 + (lane & 31);
#pragma unroll 8
    for (int i = 0; i < 32; ++i) { const int kk = 2 * i + (lane >> 5); scr[kk * 33 + (lane & 31)] = nn < N ? W[(size_t)(k0 + kk) * N + nn] * (kscale ? kscale[k0 + kk] : 1.f) : 0.f; }
    asm volatile("s_waitcnt lgkmcnt(0)" ::: "memory");
    const int c = lane & 7;
#pragma unroll
    for (int j = 0; j < 4; ++j) { const int n = (lane >> 3) + 8 * j; const LAS float* s = scr + (8 * c) * 33 + n;
        u32x4 o; o.x = pk2(s[0 * 33], s[1 * 33]); o.y = pk2(s[2 * 33], s[3 * 33]); o.z = pk2(s[4 * 33], s[5 * 33]); o.w = pk2(s[6 * 33], s[7 * 33]);
        *(u32x4*)(WT + (size_t)(n0 + n) * K + k0 + 8 * c) = o; }
    asm volatile("s_waitcnt lgkmcnt(0)" ::: "memory");
}
__device__ __forceinline__ void p0_mod_block(const float* c, const float* w_ada, const float* b_ada, float* mod, LAS unsigned char* lds, int item, int wave, int lane) {
    LAS float* sil = (LAS float*)(lds + wave * 2048);
    LAS float* part = (LAS float*)(lds + 16384);
    for (int i = lane; i < 512; i += 64) { const int b = i >> 7, kk = i & 127; const float cv = c[b * 1024 + wave * 128 + kk]; sil[kk * 4 + b] = cv / (1.f + expf(-cv)); }
    asm volatile("s_waitcnt lgkmcnt(0)" ::: "memory");
    const int j = item * 64 + lane;
    const float* wp = w_ada + (size_t)(wave * 128) * 6144 + j;
    float a0 = 0.f, a1 = 0.f, a2 = 0.f, a3 = 0.f;
#pragma unroll 16
    for (int k = 0; k < 128; ++k) { const float w = wp[(size_t)k * 6144]; const f32x4 s = *(const LAS f32x4*)(sil + k * 4); a0 += s[0] * w; a1 += s[1] * w; a2 += s[2] * w; a3 += s[3] * w; }
    part[(wave * 4 + 0) * 64 + lane] = a0; part[(wave * 4 + 1) * 64 + lane] = a1; part[(wave * 4 + 2) * 64 + lane] = a2; part[(wave * 4 + 3) * 64 + lane] = a3;
    __syncthreads();
    if (wave < 4) { float acc = b_ada[j];
#pragma unroll
        for (int w = 0; w < 8; ++w) acc += part[(w * 4 + wave) * 64 + lane];
        mod[wave * 6144 + j] = acc; }
    __syncthreads();
}

struct ModIn { float4 v[4]; };
__device__ __forceinline__ void modrow_load(ModIn& M, const float* X, const bf16_t* DL, int row, int lane) {
    if (X) { const float4* xr = (const float4*)(X + (size_t)row * 1024) + lane;
#pragma unroll
        for (int j = 0; j < 4; ++j) M.v[j] = xr[64 * j];
    } else {
#pragma unroll
        for (int j = 0; j < 4; ++j) { const uint2 dd = *(const uint2*)(DL + (size_t)row * 1024 + 4 * lane + 256 * j); M.v[j] = make_float4(lo2f(dd.x), hi2f(dd.x), lo2f(dd.y), hi2f(dd.y)); }
    }
}
__device__ __forceinline__ void modrow_finish(ModIn& M, const float* g, const float* mod, int shift_idx, int scale_idx, bf16_t* out, unsigned char* outq, float* hs, int row, int lane) {
    const int b = row / S_; float ss = 0.f;
#pragma unroll
    for (int j = 0; j < 4; ++j) ss += (M.v[j].x * M.v[j].x + M.v[j].y * M.v[j].y) + (M.v[j].z * M.v[j].z + M.v[j].w * M.v[j].w);
    ss = wave_sum(ss);
    const float r = rsqrtf(ss * (1.f / 1024.f) + EPS);
    const float* sh = mod + b * 6144 + shift_idx * 1024; const float* sc = mod + b * 6144 + scale_idx * 1024;
    float am = 0.f;
#pragma unroll
    for (int j = 0; j < 4; ++j) {
        const int col = 4 * lane + 256 * j; float4& v = M.v[j];
        const float4 g4 = *(const float4*)(g + col), s4 = *(const float4*)(sc + col), h4 = *(const float4*)(sh + col);
        v.x = v.x * r * g4.x * (1.f + s4.x) + h4.x; v.y = v.y * r * g4.y * (1.f + s4.y) + h4.y; v.z = v.z * r * g4.z * (1.f + s4.z) + h4.z; v.w = v.w * r * g4.w * (1.f + s4.w) + h4.w;
        if (out) { uint2 w; w.x = pk2(v.x, v.y); w.y = pk2(v.z, v.w); *(uint2*)(out + (size_t)row * 1024 + col) = w; }
        am = fmaxf(am, fmaxf(fmaxf(fabsf(v.x), fabsf(v.y)), fmaxf(fabsf(v.z), fabsf(v.w))));
    }
    if (outq) {
#pragma unroll
        for (int o = 1; o < 64; o <<= 1) am = fmaxf(am, __shfl_xor(am, o));
        const float inv = am > 0.f ? 119.f / am : 0.f;
#pragma unroll
        for (int j = 0; j < 4; ++j) { const float4 v = M.v[j]; const int q0 = (int)rintf(v.x * inv), q1 = (int)rintf(v.y * inv), q2 = (int)rintf(v.z * inv), q3 = (int)rintf(v.w * inv);
            *(unsigned*)(outq + (size_t)row * 1024 + 4 * lane + 256 * j) = (unsigned)(q0 & 255) | ((unsigned)(q1 & 255) << 8) | ((unsigned)(q2 & 255) << 16) | ((unsigned)(q3 & 255) << 24); }
        if (lane == 0) hs[row] = am * (1.f / 119.f);
    }
}
__device__ __forceinline__ void modrows2(const float* X, const bf16_t* DL, const float* g, const float* mod, int shift_idx, int scale_idx, bf16_t* out, unsigned char* outq, float* hs, int gw, int ngw, int lane) {
    for (int row = gw; row < T_; row += 2 * ngw) {
        const int row2 = row + ngw; ModIn Ma, Mb;
        modrow_load(Ma, X, DL, row, lane); if (row2 < T_) modrow_load(Mb, X, DL, row2, lane);
        modrow_finish(Ma, g, mod, shift_idx, scale_idx, out, outq, hs, row, lane); if (row2 < T_) modrow_finish(Mb, g, mod, shift_idx, scale_idx, out, outq, hs, row2, lane);
    }
}
__device__ __forceinline__ void quant4(const float* peer_u, const float* peer_v, unsigned char* UQ, unsigned char* VQ, float* SU, float* SV, int r0, int lane) {
    float4 v[4][4]; float am[4];
#pragma unroll
    for (int q = 0; q < 4; ++q) { const int r = r0 + q; const float* src = (r < 16384 ? peer_u + (size_t)r * 1024 : peer_v + (size_t)(r - 16384) * 1024);
#pragma unroll
        for (int j = 0; j < 4; ++j) v[q][j] = ((const float4*)src)[lane + 64 * j]; }
#pragma unroll
    for (int q = 0; q < 4; ++q) { float a = 0.f;
#pragma unroll
        for (int j = 0; j < 4; ++j) a = fmaxf(a, fmaxf(fmaxf(fabsf(v[q][j].x), fabsf(v[q][j].y)), fmaxf(fabsf(v[q][j].z), fabsf(v[q][j].w))));
        am[q] = a; }
#pragma unroll
    for (int o = 1; o < 64; o <<= 1) {
#pragma unroll
        for (int q = 0; q < 4; ++q) am[q] = fmaxf(am[q], __shfl_xor(am[q], o)); }
#pragma unroll
    for (int q = 0; q < 4; ++q) { const int r = r0 + q; unsigned char* dst = (r < 16384 ? UQ + (size_t)r * 128 : VQ + (size_t)(r - 16384) * 128); float* sc = (r < 16384 ? SU + r : SV + (r - 16384));
        {
            const float inv = am[q] > 0.f ? 7.f / (0.80f * am[q]) : 0.f;
#pragma unroll
            for (int j = 0; j < 4; ++j) { const float4 x = v[q][j];
                const int q0 = (int)fminf(fmaxf(rintf(x.x * inv), -7.f), 7.f), q1 = (int)fminf(fmaxf(rintf(x.y * inv), -7.f), 7.f), q2 = (int)fminf(fmaxf(rintf(x.z * inv), -7.f), 7.f), q3 = (int)fminf(fmaxf(rintf(x.w * inv), -7.f), 7.f);
                const int ob = (r >= 16384 && (lane & 4) == 0) ? 8 : 0;
                const unsigned nb = (unsigned)((q0 + ob) & 15) | ((unsigned)((q1 + ob) & 15) << 8) | ((unsigned)((q2 + ob) & 15) << 16) | ((unsigned)((q3 + ob) & 15) << 24);
                const unsigned pn = (unsigned)__shfl_xor((int)nb, 4);
                if ((lane & 4) == 0) *(unsigned*)(dst + (size_t)j * (16384 * 128) + (lane >> 3) * 16 + (lane & 3) * 4) = nb | (pn << 4); }
            if (lane == 0) *sc = am[q] * (r < 16384 ? 0.80f / 7.f : 0.80f / (7.f * 16.f));
        }
    }
}

__global__ void __launch_bounds__(NWAVES * 64, 2) mega_fwd(Args args) {
    extern __shared__ __attribute__((aligned(16))) unsigned char lds[];
    Frame F;
    F.lds = (LAS unsigned char*)lds;
    volatile LAS unsigned* MISC = (volatile LAS unsigned*)(F.lds + MISC_OFF);
    F.tid = threadIdx.x; F.lane = F.tid & 63; F.wave = __builtin_amdgcn_readfirstlane(F.tid >> 6);
    F.G = gridDim.x; F.gw = blockIdx.x * NWAVES + F.wave; F.NGW = F.G * NWAVES;
    unsigned char* ws = args.ws;
    unsigned* ctl = (unsigned*)(ws + WS_CTL);
    const float* x = (const float*)args.in[0]; const float* c = (const float*)args.in[1]; const int* positions = (const int*)args.in[2];
    const float* w_ada = (const float*)args.in[3]; const float* b_ada = (const float*)args.in[4]; const float* norm1_g = (const float*)args.in[5];
    const float* w_in = (const float*)args.in[6]; const float* mla_qa_g = (const float*)args.in[7]; const float* mla_kva_g = (const float*)args.in[8];
    const float* w_uq = (const float*)args.in[9]; const float* w_ukv = (const float*)args.in[10]; const float* mla_q_g = (const float*)args.in[11];
    const float* mla_k_g = (const float*)args.in[12]; const float* fox_q_g = (const float*)args.in[13]; const float* fox_k_g = (const float*)args.in[14];
    const float* b_f = (const float*)args.in[15]; const float* w_o = (const float*)args.in[16]; const float* norm2_g = (const float*)args.in[17];
    const float* w_pq = (const float*)args.in[18]; const float* sub_keys = (const float*)args.in[19]; const float* peer_u = (const float*)args.in[20]; const float* peer_v = (const float*)args.in[21];
    float* out = args.out;
    float* MOD = (float*)(ws + WS_MOD); float* FL = (float*)(ws + WS_FL); float* FCUM = (float*)(ws + WS_FCUM); float* LOGF = (float*)(ws + WS_LOGF); float2* ROPE = (float2*)(ws + WS_ROPE);
    bf16_t* XN = (bf16_t*)(ws + WS_XN); bf16_t* PROJ = (bf16_t*)(ws + WS_PROJ); bf16_t* KVRAW = (bf16_t*)(ws + WS_KVRAW); bf16_t* QA = (bf16_t*)(ws + WS_QA); bf16_t* KA = (bf16_t*)(ws + WS_KA);
    bf16_t* WIN = (bf16_t*)(ws + WS_WIN); bf16_t* WUQ = (bf16_t*)(ws + WS_WUQ); bf16_t* WUKV = (bf16_t*)(ws + WS_WUKV); bf16_t* WO = (bf16_t*)(ws + WS_WO); bf16_t* WPQ = (bf16_t*)(ws + WS_WPQ); bf16_t* SKB = (bf16_t*)(ws + WS_SK);
    float* SSQ = (float*)(ws + WS_SSQ); float* SSQQ = (float*)(ws + WS_SSQQ); float* SSQK = (float*)(ws + WS_SSQK); bf16_t* DELTA = (bf16_t*)(ws + WS_KVRAW);
    unsigned char* XNQ = ws + WS_XN; float* XS = (float*)(ws + WS_XS); unsigned char* WINQ = ws + WS_WINQ; unsigned char* WPQQ = ws + WS_WPQQ; float* WINS = (float*)(ws + WS_WINS); float* WPQS = (float*)(ws + WS_WPQS);
    unsigned char* UQ = ws + WS_UQ; unsigned char* VQ = ws + WS_VQ; unsigned char* H2Q = ws + WS_H2Q; float* SU = (float*)(ws + WS_SU); float* SV = (float*)(ws + WS_SV); float* HS = (float*)(ws + WS_HS); float* AP = (float*)(ws + WS_A);
    bf16_t* OB = XN; bf16_t* H2 = XN; bf16_t* QP = PROJ; int* EID = (int*)(ws + WS_QA); float* GATE = (float*)(ws + WS_QA + 16 * MiB);
    (void)sub_keys; (void)peer_u; (void)peer_v; (void)positions; (void)KA; (void)FCUM; (void)LOGF; (void)ROPE; (void)mla_q_g; (void)mla_k_g; (void)b_f; (void)fox_q_g; (void)fox_k_g; (void)mla_qa_g; (void)mla_kva_g;

    for (int u = F.tid; u < (LDS_BYTES - LDSCTL_OFF) / 4; u += NWAVES * 64) ((LAS unsigned*)(F.lds + LDSCTL_OFF))[u] = 0u;
    __syncthreads();
    const int lo = args.ph_lo, hi = args.ph_hi;
    XcdBarrier bar; bar.bar = ctl + CW_BAR + args.li * XCD_BAR_WORDS; bar.x = 0; bar.st = nullptr;
    if (hi - lo > 1) bar = xcd_barrier_post(ctl + CW_BAR + args.li * XCD_BAR_WORDS, MISC + 8);
#define IN(k) (lo <= (k) && (k) < hi)
#define SEAM(k) do { if (IN(k) && IN((k) + 1)) xcd_barrier(bar); } while (0)

    if (IN(0)) {
        LAS float* scr = (LAS float*)(F.lds + F.wave * 16384);
        constexpr int I_MOD = 96, I_IN = 16 * 72, I_UQ = 6 * 24, I_UKV = 4 * 32, I_O = 16 * 32, I_PQ = 16 * 64;
        constexpr int I_SK = 512;
        constexpr int NITEMS = I_IN + I_UQ + I_UKV + I_O + I_PQ + I_SK;
        {
            const float invf = (float)exp2(-(double)(F.lane & 15) * (13.287712379549449 / 16.0));
            for (int r4 = F.gw * 4; r4 < T_; r4 += F.NGW * 4) { const int row = r4 + (F.lane >> 4);
                const double a = (double)((float)positions[row] * invf), n = rint(a * 0.15915494309189535); const float red = (float)(a - n * 6.283185307179586);
                ROPE[(size_t)row * 16 + (F.lane & 15)] = make_float2(__cosf(red), __sinf(red)); }
        }
        for (int mi = (int)blockIdx.x; mi < I_MOD; mi += F.G) p0_mod_block(c, w_ada, b_ada, MOD, F.lds, mi, F.wave, F.lane);
        for (int it = F.gw; it < NITEMS; it += F.NGW) {
            int r = it;
            if (r < I_IN) { p0_transpose_item(w_in, 1024, INW, PP, WIN, scr, r, F.lane); continue; } r -= I_IN;
            if (r < I_UQ) { p0_transpose_item(w_uq, 384, 768, 768, WUQ, scr, r, F.lane, mla_qa_g, 1); continue; } r -= I_UQ;
            if (r < I_UKV) { p0_transpose_item(w_ukv, 256, 1024, 1024, WUKV, scr, r, F.lane, mla_kva_g, 2); continue; } r -= I_UKV;
            if (r < I_O) { p0_transpose_item(w_o, 1024, 1024, 1024, WO, scr, r, F.lane); continue; } r -= I_O;
            if (r < I_PQ) { p0_transpose_item(w_pq, 1024, 2048, 2048, WPQ, scr, r, F.lane); continue; } r -= I_PQ;
            { const float4* src = (const float4*)(sub_keys + (size_t)r * 512) + F.lane * 2; const float4 a = src[0], b2 = src[1];
              u32x4 o; o.x = pk2(a.x, a.y); o.y = pk2(a.z, a.w); o.z = pk2(b2.x, b2.y); o.w = pk2(b2.z, b2.w); *(u32x4*)(SKB + (size_t)r * 512 + F.lane * 8) = o; }
        }
    }
    SEAM(0);
    if (IN(1)) {
        for (int r = F.gw; r < PP + 2048; r += F.NGW) {
            const int nc = r < PP ? nat_col(r) : 0;
            const bf16_t* src = r < PP ? WIN + (size_t)(nc < 0 ? 0 : nc) * 1024 : WPQ + (size_t)(r - PP) * 1024; unsigned char* dst = r < PP ? WINQ + (size_t)r * 1024 : WPQQ + (size_t)(r - PP) * 1024; float* sc = r < PP ? WINS + r : WPQS + (r - PP);
            float v[16]; unpack8(*(const uint4*)(src + F.lane * 16), v); unpack8(*(const uint4*)(src + F.lane * 16 + 8), v + 8);
            if (nc < 0) {
#pragma unroll
                for (int i = 0; i < 16; ++i) v[i] = 0.f; }
            float am = 0.f;
#pragma unroll
            for (int i = 0; i < 16; ++i) am = fmaxf(am, fabsf(v[i]));
#pragma unroll
            for (int o = 1; o < 64; o <<= 1) am = fmaxf(am, __shfl_xor(am, o));
            const float inv = am > 0.f ? 127.f / am : 0.f; unsigned q[4];
#pragma unroll
            for (int i = 0; i < 4; ++i) q[i] = (unsigned)((int)rintf(v[4 * i] * inv) & 255) | ((unsigned)((int)rintf(v[4 * i + 1] * inv) & 255) << 8) | ((unsigned)((int)rintf(v[4 * i + 2] * inv) & 255) << 16) | ((unsigned)((int)rintf(v[4 * i + 3] * inv) & 255) << 24);
            *(uint4*)(dst + F.lane * 16) = make_uint4(q[0], q[1], q[2], q[3]);
            if (F.lane == 0) *sc = am * (1.f / 127.f);
        }
        modrows2(x, nullptr, norm1_g, MOD, 0, 1, nullptr, XNQ, XS, F.gw, F.NGW, F.lane);
    }
    SEAM(1);
    if (IN(2)) {
        pg8::Gemm g{(const bf16_t*)XNQ, (const bf16_t*)WINQ, T_, PP, 512, 512}; pg8::StaticOrder S; S.init(T_, PP, F.G, (int)blockIdx.x);
        pg8::EpiProjI8 E{PROJ, LOGF, SSQ, XS, WINS, fox_q_g, fox_k_g, b_f, SSQK};
        pg8::gemm_phase<pg8::EpiProjI8, pg8::StaticOrder, true, true, true>(F.lds, g, S, E);
    }
    SEAM(2);
    if (IN(4)) {
        { const int fb = F.G >= 160 ? 128 : 0; if (F.wave == 0 && (int)blockIdx.x >= fb && (int)blockIdx.x < fb + 32) fcum_item(LOGF, FCUM, (int)blockIdx.x - fb, F.lane); }
        { pg8::Gemm g{PROJ + C_CQ, WUQ, T_, 768, 384, PP}; pg8::StaticOrder S; S.init(T_, 768, F.G, (int)blockIdx.x); pg8::EpiMlaQ E{QA, SSQQ, SSQ, mla_q_g};
          pg8::gemm_phase<pg8::EpiMlaQ, pg8::StaticOrder, true, true>(F.lds, g, S, E); }
        { pg8::Gemm g{PROJ + C_CKV, WUKV, T_, 1024, 256, PP}; pg8::StaticOrder S; S.init(T_, 1024, F.G, (int)blockIdx.x); pg8::EpiMlaKV E{KA, KVRAW, SSQ, SSQK, PROJ, mla_k_g, ROPE};
          pg8::gemm_phase<pg8::EpiMlaKV, pg8::StaticOrder, true, true>(F.lds, g, S, E); }
    }
    SEAM(4);
    if (IN(6)) {
        volatile LAS unsigned* qslot = MISC + 16;
        float thr; bool sref_mla, sref_fox;
        { float gq = fabsf(fox_q_g[F.lane]), gk = fabsf(fox_k_g[F.lane]);
#pragma unroll
          for (int o = 1; o < 64; o <<= 1) { gq = fmaxf(gq, __shfl_xor(gq, o)); gk = fmaxf(gk, __shfl_xor(gk, o)); }
          thr = 104.5f + 2.f * 1.02f * 8.f * gq * gk;
          sref_fox = 1.03f * 11.55f * gq * gk <= 40.f; }
        { float gq = fmaxf(fabsf(mla_q_g[F.lane]), F.lane < 32 ? fabsf(mla_q_g[64 + F.lane]) : 0.f), gk = fmaxf(fabsf(mla_k_g[F.lane]), F.lane < 32 ? fabsf(mla_k_g[64 + F.lane]) : 0.f);
#pragma unroll
          for (int o = 1; o < 64; o <<= 1) { gq = fmaxf(gq, __shfl_xor(gq, o)); gk = fmaxf(gk, __shfl_xor(gk, o)); }
          sref_mla = 1.03f * 14.15f * gq * gk <= 40.f; }
        unsigned* qctr = ctl + 64;
        if (F.tid == 0) qslot[0] = atomicAdd(qctr, 1u);
        __syncthreads();
        unsigned u = qslot[0];
        while (u < 2048u + 1024u) {
            unsigned unext = 0u;
            if (F.tid == 0) unext = atomicAdd(qctr, 1u);
            if (u >= 2048u) {
                quant4(peer_u, peer_v, UQ, VQ, SU, SV, (int)(u - 2048u) * 32 + F.wave * 4, F.lane);
                if (F.tid == 0) qslot[0] = unext;
                __syncthreads();
                u = qslot[0];
                __syncthreads();
                continue;
            }
            const int grp = (int)(u >> 10), bh = (int)(u & 31u), qb = 31 - (int)((u >> 5) & 31u), b = bh >> 3, h = bh & 7;
            if (grp == 0) { const att::Desc d{QA + (size_t)b * S_ * 768 + h * 96, 768, KA + (size_t)b * S_ * 768 + h * 96, 768, KVRAW + (size_t)b * S_ * 1024 + h * 128 + 64, 1024, OB + (size_t)b * S_ * 1024 + h * 64, 1024, nullptr, SSQQ + (size_t)b * S_ * 16 + 2 * h, ROPE + (size_t)b * S_ * 16};
                if (sref_mla) att::attn_unit<6, false, true>(d, qb, 0, F.lds); else att::attn_unit<6, false, false>(d, qb, 0, F.lds); }
            else { const bf16_t* pb = PROJ + (size_t)b * S_ * PP + h * 64; const float* fc = FCUM + (size_t)(b * 8 + h) * S_;
                const att::Desc d{pb + C_FQ, PP, pb + C_FK, PP, pb + C_FV, PP, OB + (size_t)b * S_ * 1024 + 512 + h * 64, 1024, fc, nullptr, nullptr};
                const int NT = 4 * (qb + 1); const float lim = fc[qb * 256] + thr;
                int j0 = 0;
                { const int ja = F.lane, jb2 = 64 + F.lane;
                  const bool ka = ja < NT ? (fc[64 * ja + 63] <= lim) : true, kb = jb2 < NT ? (fc[64 * jb2 + 63] <= lim) : true;
                  const unsigned long long ma = __ballot(ka), mb = __ballot(kb);
                  j0 = ma ? __builtin_ctzll(ma) : (mb ? 64 + __builtin_ctzll(mb) : NT - 4); }
                if (j0 > NT - 4) j0 = NT - 4;
                if (sref_fox) att::attn_unit<4, true, true>(d, qb, j0, F.lds); else att::attn_unit<4, true, false>(d, qb, j0, F.lds); }
            if (F.tid == 0) qslot[0] = unext;
            __syncthreads();
            u = qslot[0];
            __syncthreads();
        }
    }
    SEAM(6);
    if (IN(7)) {
        pg8::Gemm g{OB, WO, T_, 1024, 1024, 1024}; pg8::StaticOrder S; S.init(T_, 1024, F.G, (int)blockIdx.x);
        pg8::EpiDelta E{MOD, DELTA, x};
        pg8::gemm_phase<pg8::EpiDelta, pg8::StaticOrder, true, true>(F.lds, g, S, E);
    }
    SEAM(7);
    if (IN(8)) modrows2(nullptr, DELTA, norm2_g, MOD, 3, 4, nullptr, H2Q, HS, F.gw, F.NGW, F.lane);
    SEAM(8);
    if (IN(9)) {
        pg8::Gemm g{(const bf16_t*)H2Q, (const bf16_t*)WPQQ, T_, 2048, 512, 512}; pg8::EpiStoreI8 E{QP, 2048, HS, WPQS};
        const int c = (int)blockIdx.x;
#pragma unroll 1
        for (int p = c, i = 0; p < (T_ / 256) * 4; p += F.G, ++i) {
            int pm = p >> 2, hp = p & 3;
            if (F.G == 256) { const int li = c >> 3; pm = (c & 7) + 8 * (i * 8 + (li >> 2)); hp = li & 3; }
            pg8::PairOrder S{pm, 2 * hp};
            pg8::gemm_phase<pg8::EpiStoreI8, pg8::PairOrder, true, true, true>(F.lds, g, S, E);
            pk::topk_item2(QP, SKB, EID, GATE, (pm * 8 + F.wave) * 4 + hp, F.lane);
        }
    }
    SEAM(10);
    {
        const int ng = F.G < 8 ? F.G : 8; const int vx = (int)blockIdx.x % ng, rank = (int)blockIdx.x / ng, nrank = (F.G - vx + ng - 1) / ng;
        const int gwv = rank * NWAVES + F.wave, ngwv = nrank * NWAVES;
        const int grp = F.lane >> 3, sub = F.lane & 7;
        typedef unsigned u32x2_t __attribute__((ext_vector_type(2)));
        int* PA = (int*)(ws + WS_PROJ);
        int* WQH = (int*)(ws + WS_KA); float* WSC = (float*)(ws + WS_KA + 8 * MiB);
        if (IN(11)) {
            const int nsl = ng == 8 ? 1 : 4, tpart = ng == 8 ? (vx >> 2) : 0, nparts = ng == 8 ? 2 : 1;
            for (int si = 0; si < nsl; ++si) {
                const int s = ng == 8 ? (vx & 3) : vx + si * ng; if (s >= 4) break;
                const unsigned char* UQs = UQ + (size_t)s * (16384 * 128);
                const int tstep = nparts * ngwv;
                int t = gwv + tpart * ngwv; int4 ev0[4], ev1[4], rows0[16], rows1[16]; int4 hl0, hh0, hl1, hh1; int2 rawA, rawB; int rhA, rhB;
                LAS unsigned char* idl = F.lds + F.wave * 1024;
#define UDIG_AN(w) ((((((w) ^ 0x80808080u) + 0x08080808u) >> 4) & 0x0F0F0F0Fu) ^ 0x08080808u)
#define UDIG_A(lo, hi) ((int)(UDIG_AN(lo) | (UDIG_AN(hi) << 4)))
#define UDIG_B(lo, hi) ((int)(((lo) & 0x0F0F0F0Fu) | (((hi) & 0x0F0F0F0Fu) << 4)))
#define U_RAW(RAW, RH, tt) do { RAW = *(const int2*)(EID + (size_t)(tt) * 128 + 2 * F.lane); RH = *(const int*)(H2Q + (size_t)(tt) * 1024 + 256 * s + 4 * F.lane); } while (0)
#define U_IDS_LDS(EV, HL, HH, RAW, RH) do { *(LAS u32x2_t*)(idl + 8 * F.lane) = (u32x2_t){(unsigned)RAW.x, (unsigned)RAW.y}; *(LAS int*)(idl + 512 + 4 * F.lane) = RH; \
                    _Pragma("unroll") for (int k = 0; k < 4; ++k) { const u32x4 e_ = *(LAS const u32x4*)(idl + grp * 64 + 16 * k); EV[k] = make_int4((int)e_.x, (int)e_.y, (int)e_.z, (int)e_.w); } \
                    { const u32x4 h_ = *(LAS const u32x4*)(idl + 512 + sub * 32), g_ = *(LAS const u32x4*)(idl + 512 + sub * 32 + 16); \
                      HL = make_int4(UDIG_A(h_.x, g_.x), UDIG_A(h_.y, g_.y), UDIG_A(h_.z, g_.z), UDIG_A(h_.w, g_.w)); HH = make_int4(UDIG_B(h_.x, g_.x), UDIG_B(h_.y, g_.y), UDIG_B(h_.z, g_.z), UDIG_B(h_.w, g_.w)); } } while (0)
                { const int ta = t < T_ ? t : T_ - 1, tb = t + tstep < T_ ? t + tstep : T_ - 1, tc = t + 2 * tstep < T_ ? t + 2 * tstep : T_ - 1;
                  U_RAW(rawA, rhA, ta); U_RAW(rawB, rhB, tb);
                  U_IDS_LDS(ev0, hl0, hh0, rawA, rhA); U_IDS_LDS(ev1, hl1, hh1, rawB, rhB); U_RAW(rawA, rhA, tc); }
                gx::u_gather(UQs, 16u * (unsigned)sub, ev0, rows0);
#define U_STEP(EVW, EVR, ROWSW, ROWSR, RAWW, RHW, RAWR, RHR) do { const int t1 = t + tstep, t3 = t + 3 * tstep, t3c = t3 < T_ ? t3 : T_ - 1; int4 hl2, hh2; \
                    U_RAW(RAWW, RHW, t3c); \
                    U_IDS_LDS(EVW, hl2, hh2, RAWR, RHR); \
                    gx::u_gather(UQs, 16u * (unsigned)sub, EVR, ROWSW); \
                    gx::u_compute(ROWSR, hl0, hh0, PA + ((size_t)s * T_ + t) * 128, F.lane); \
                    hl0 = hl1; hh0 = hh1; hl1 = hl2; hh1 = hh2; t = t1; } while (0)
                while (t < T_) {
                    U_STEP(ev0, ev1, rows1, rows0, rawB, rhB, rawA, rhA);
                    if (t >= T_) break;
                    U_STEP(ev1, ev0, rows0, rows1, rawA, rhA, rawB, rhB);
                }
#undef U_RAW
#undef U_IDS_LDS
#undef U_STEP
#undef UDIG_AN
#undef UDIG_A
#undef UDIG_B
            }
        }
        SEAM(11);
        if (IN(12)) {
            for (int t = F.gw; t < T_; t += F.NGW) {
                int i0 = 0, i1 = 0;
#pragma unroll
                for (int s = 0; s < 4; ++s) { const int2 p = *(const int2*)(PA + ((size_t)s * T_ + t) * 128 + 2 * F.lane); i0 += p.x; i1 += p.y; }
                const int2 e2 = *(const int2*)(EID + (size_t)t * 128 + 2 * F.lane); const float2 g2 = *(const float2*)(GATE + (size_t)t * 128 + 2 * F.lane); const float hs = HS[t];
                const float w0 = g2.x * gx::gelu_t((float)i0 * SU[e2.x] * hs) * SV[e2.x], w1 = g2.y * gx::gelu_t((float)i1 * SU[e2.y] * hs) * SV[e2.y];
                float wm = fmaxf(fabsf(w0), fabsf(w1));
#pragma unroll
                for (int o = 1; o < 64; o <<= 1) wm = fmaxf(wm, __shfl_xor(wm, o));
                const float inv = wm > 0.f ? 127.f / wm : 0.f;
                const int q0 = (int)rintf(w0 * inv), q1 = (int)rintf(w1 * inv);
                const unsigned h2 = (unsigned)(q0 & 255) | ((unsigned)(q1 & 255) << 8);
                const unsigned h2p = __shfl_xor(h2, 1);
                if ((F.lane & 1) == 0) WQH[(size_t)t * 32 + (F.lane >> 1)] = (int)(h2 | (h2p << 16));
                if (F.lane == 0) WSC[t] = wm * (1.f / 127.f);
            }
        }
        SEAM(12);
        if (IN(13)) {
            const int nsl = ng == 8 ? 1 : 4, tpart = ng == 8 ? (vx >> 2) : 0, nparts = ng == 8 ? 2 : 1;
            for (int si = 0; si < nsl; ++si) {
                const int s = ng == 8 ? (vx & 3) : vx + si * ng; if (s >= 4) break;
                const unsigned char* VQs = VQ + (size_t)s * (16384 * 128);
                const int tstep = nparts * ngwv;
                int t = gwv + tpart * ngwv; int4 ev0[4], ev1[4]; uint4 rows0[16], rows1[16]; int4 wh0, wh1; float ws0, ws1; int2 rawA, rawB; int rwA, rwB;
                LAS unsigned char* idl = F.lds + F.wave * 1024;
                LAS float* g2l = (LAS float*)(F.lds + 8192 + F.wave * 4096);
                const int xcol = 256 * s + 32 * (F.lane & 7) + ((F.lane & 32) ? 8 : 0) + ((F.lane & 16) ? 4 : 0) + ((F.lane & 8) ? 2 : 0);
                { typedef float f32x2_t __attribute__((ext_vector_type(2)));
#pragma unroll
                  for (int bb = 0; bb < 4; ++bb)
#pragma unroll
                      for (int pl = 0; pl < 2; ++pl) { const int gcol = 256 * s + 32 * (F.lane & 7) + 16 * pl + ((F.lane & 32) ? 8 : 0) + ((F.lane & 16) ? 4 : 0) + ((F.lane & 8) ? 2 : 0);
                          const float2 g = *(const float2*)(MOD + bb * 6144 + 5 * 1024 + gcol); *(LAS f32x2_t*)(g2l + (bb * 2 + pl) * 128 + 2 * F.lane) = (f32x2_t){g.x, g.y}; } }
#define V_RAW(RAW, RW, WS, tt) do { RAW = *(const int2*)(EID + (size_t)(tt) * 128 + 2 * F.lane); RW = WQH[(size_t)(tt) * 32 + (F.lane & 31)]; WS = WSC[tt]; } while (0)
#define V_IDS_LDS(EV, WH, RAW, RW) do { *(LAS u32x2_t*)(idl + 8 * F.lane) = (u32x2_t){(unsigned)RAW.x, (unsigned)RAW.y}; *(LAS int*)(idl + 512 + 4 * (F.lane & 31)) = RW; \
                    _Pragma("unroll") for (int k = 0; k < 4; ++k) { const u32x4 e_ = *(LAS const u32x4*)(idl + grp * 64 + 16 * k); EV[k] = make_int4((int)e_.x, (int)e_.y, (int)e_.z, (int)e_.w); } \
                    { const u32x4 w_ = *(LAS const u32x4*)(idl + 512 + grp * 16); WH = make_int4((int)w_.x, (int)w_.y, (int)w_.z, (int)w_.w); } } while (0)
                float wsA, wsB;
                { const int ta = t < T_ ? t : T_ - 1, tb = t + tstep < T_ ? t + tstep : T_ - 1, tc = t + 2 * tstep < T_ ? t + 2 * tstep : T_ - 1;
                  V_RAW(rawA, rwA, ws0, ta); V_RAW(rawB, rwB, ws1, tb);
                  V_IDS_LDS(ev0, wh0, rawA, rwA); V_IDS_LDS(ev1, wh1, rawB, rwB); V_RAW(rawA, rwA, wsA, tc); wsB = 0.f; }
                gx::v_gather(VQs, 16u * (unsigned)sub, ev0, rows0);
#define V_STEP(EVW, EVR, ROWSW, ROWSR, RAWW, RWW, WSW, RAWR, RWR, WSR) do { const int t1 = t + tstep, t3 = t + 3 * tstep, t3c = t3 < T_ ? t3 : T_ - 1; int4 wh2; \
                    V_RAW(RAWW, RWW, WSW, t3c); \
                    unsigned x1d[2]; x1d[0] = *(const unsigned*)(DELTA + (size_t)t * 1024 + xcol); x1d[1] = *(const unsigned*)(DELTA + (size_t)t * 1024 + xcol + 16); \
                    __builtin_amdgcn_sched_barrier(0);       \
                    V_IDS_LDS(EVW, wh2, RAWR, RWR); \
                    gx::v_gather(VQs, 16u * (unsigned)sub, EVR, ROWSW); \
                    gx::v_token4(ROWSR, wh0, ws0, g2l + (t >> 13) * 256, x1d, out + (size_t)t * 1024, s, F.lane); \
                    wh0 = wh1; ws0 = ws1; wh1 = wh2; ws1 = WSR; t = t1; } while (0)
                while (t < T_) {
                    V_STEP(ev0, ev1, rows1, rows0, rawB, rwB, wsB, rawA, rwA, wsA);
                    if (t >= T_) break;
                    V_STEP(ev1, ev0, rows0, rows1, rawA, rwA, wsA, rawB, rwB, wsB);
                }
#undef V_RAW
#undef V_IDS_LDS
#undef V_STEP
            }
        }
    }
#undef IN
#undef SEAM
}

static int g_grid = 0;
static void launch_mega(const Args& base, int lo, int hi, int li, hipStream_t stream) {
    Args a = base; a.ph_lo = lo; a.ph_hi = hi; a.li = li;
    hipLaunchKernelGGL(mega_fwd, dim3(g_grid), dim3(NWAVES * 64), LDS_BYTES, stream, a);
}

extern "C" void kernel_launch(void* const* d_in, const int* in_sizes, int n_in, void* d_out, int out_size, void* d_ws, size_t ws_size, hipStream_t stream) {
    if (g_grid == 0) {
        int dev = 0, cus = 0;
        (void)hipGetDevice(&dev); (void)hipDeviceGetAttribute(&cus, hipDeviceAttributeMultiprocessorCount, dev);
        (void)hipFuncSetAttribute((const void*)mega_fwd, hipFuncAttributeMaxDynamicSharedMemorySize, LDS_BYTES);
        int per_cu = 0; (void)hipOccupancyMaxActiveBlocksPerMultiprocessor(&per_cu, (const void*)mega_fwd, NWAVES * 64, LDS_BYTES);
        (void)hipGetLastError();
        g_grid = cus > 0 ? cus : 256;
        if (per_cu < 1) fprintf(stderr, "kernel_launch: occupancy query says %d blocks/CU\n", per_cu);
    }
    float* out = (float*)d_out; unsigned char* ws = (unsigned char*)d_ws;
    (void)hipMemsetAsync(ws + WS_CTL, 0, CTL_ZERO_BYTES, stream);
    Args base{}; for (int i = 0; i < 22; ++i) base.in[i] = d_in[i]; base.out = out; base.ws = ws;

    launch_mega(base, 0, 14, 0, stream);
}
```
